# Optimizing an MI355X kernel written in HIP

```python
import math
import jax, jax.numpy as jnp
from jax import lax
import numpy as np

D_MODEL = 1024
BATCH = 8
SEQ = 2048
DEPTH = 2
DEC_BATCH = 128
DEC_SEQ = 4
PAST_LEN = 16384
PAGE_SIZE = 128

N_MIXERS = 2
N_RWKV_LAYERS = (DEPTH + 1) // 2
N_MLSTM_LAYERS = DEPTH // 2

RW_HEAD = 64
RW_HEADS = D_MODEL // RW_HEAD
RW_DECAY_LORA = 64
RW_AAA_LORA = 64
RW_GATE_LORA = 160
RW_GN_EPS = 64e-5

ML_HEADS = 8
ML_DV = D_MODEL // ML_HEADS
ML_DK = ML_DV // 2
ML_QK = ML_HEADS * ML_DK
ML_CONV = 4
ML_CHUNK = 64
ML_IN = 2 * ML_QK + ML_HEADS * ML_DV + D_MODEL + 2 * ML_HEADS

D_FF = 2816
NORM_EPS = 1e-6

RW_NAMES = ('rw_mu', 'rw_wr', 'rw_wk', 'rw_wv', 'rw_wo', 'rw_w0', 'rw_w1', 'rw_w2', 'rw_a0', 'rw_a1', 'rw_a2',
            'rw_g1', 'rw_g2', 'rw_k_k', 'rw_k_a', 'rw_r_k', 'rw_gn_w', 'rw_gn_b')
ML_NAMES = ('ml_w_in', 'ml_b_if', 'ml_conv_w', 'ml_conv_b', 'ml_norm_w', 'ml_w_out')

kernel_name = 'rwkv7_mlstm_macaron_step'


def rmsnorm(x, g):
    xf = x.astype(jnp.float32)
    y = xf * lax.rsqrt(jnp.mean(xf * xf, -1, keepdims=True) + NORM_EPS)
    return (y * g.astype(jnp.float32)).astype(x.dtype)


def swiglu(x, wg, wu, wd):
    return (jax.nn.silu(x @ wg) * (x @ wu)) @ wd


def rwkv7_time_mix(xn, shift0, S0, mu, wr, wk, wv, wo, w0, w1, w2, a0, a1, a2, g1, g2, k_k, k_a, r_k, gn_w, gn_b):
    B, T, D = xn.shape
    H, N = RW_HEADS, RW_HEAD
    xf = xn.astype(jnp.float32)
    xprev = jnp.concatenate([shift0.astype(jnp.float32)[:, None], xf[:, :-1]], axis=1)
    xx = xprev - xf
    mu = mu.astype(jnp.float32)
    xr, xw, xk, xv, xa, xg = [xf + xx * mu[c] for c in range(6)]
    r = xr @ wr
    w = -jax.nn.softplus(-(w0 + jnp.tanh(xw @ w1) @ w2)) - 0.5
    k = xk @ wk
    v = xv @ wv
    a = jax.nn.sigmoid(a0 + (xa @ a1) @ a2)
    g = jax.nn.sigmoid(xg @ g1) @ g2
    heads = lambda z: z.reshape(B, T, H, N).astype(jnp.float32)
    kk = heads(k * k_k)
    kk = kk / jnp.maximum(jnp.linalg.norm(kk, axis=-1, keepdims=True), 1e-12)
    k = k * (1.0 + (a - 1.0) * k_a)
    r_h, k_h, v_h, a_h = heads(r), heads(k), heads(v), heads(a)
    decay = jnp.exp(-jnp.exp(heads(w)))
    b_h = kk * a_h

    def step(S, inp):
        r_t, d_t, k_t, v_t, kk_t, b_t = inp
        sa = jnp.einsum('bhvk,bhk->bhv', S, -kk_t)
        S = S * d_t[:, :, None, :] + sa[..., None] * b_t[:, :, None, :] + v_t[..., None] * k_t[:, :, None, :]
        return S, jnp.einsum('bhvk,bhk->bhv', S, r_t)

    tm = lambda z: jnp.swapaxes(z, 0, 1)
    S_T, y = lax.scan(step, S0.astype(jnp.float32), (tm(r_h), tm(decay), tm(k_h), tm(v_h), tm(kk), tm(b_h)))
    y = tm(y)
    mean = jnp.mean(y, -1, keepdims=True)
    var = jnp.mean(jnp.square(y - mean), -1, keepdims=True)
    y = ((y - mean) * lax.rsqrt(var + RW_GN_EPS)).reshape(B, T, D) * gn_w + gn_b
    bonus = jnp.sum(r_h * k_h * r_k, -1, keepdims=True) * v_h
    y = y + bonus.reshape(B, T, D)
    out = (y * g) @ wo
    return out.astype(xn.dtype), S_T, xf[:, -1]


def mlstm_mix(xn, conv0, C0, n0, m0, w_in, b_if, conv_w, conv_b, norm_w, w_out):
    B, T, D = xn.shape
    H, DK, DV = ML_HEADS, ML_DK, ML_DV
    proj = (xn @ w_in).astype(jnp.float32)
    qk_raw, v, o_pre, if_pre = jnp.split(proj, [2 * ML_QK, 2 * ML_QK + H * DV, 2 * ML_QK + H * DV + D], axis=-1)
    xpad = jnp.concatenate([conv0.astype(jnp.float32), qk_raw], axis=1)
    qk = conv_b.astype(jnp.float32) + sum(conv_w[j].astype(jnp.float32) * xpad[:, j:j + T] for j in range(ML_CONV))
    qk = jax.nn.silu(qk)
    new_conv = xpad[:, T:]
    q, k = jnp.split(qk, 2, axis=-1)
    q = q.reshape(B, T, H, DK) * (DK ** -0.5)
    k = k.reshape(B, T, H, DK)
    v = v.reshape(B, T, H, DV)
    o = jax.nn.sigmoid(o_pre)
    if_pre = if_pre + b_if.astype(jnp.float32)
    logi = if_pre[..., :H]
    logf = jax.nn.log_sigmoid(if_pre[..., H:])

    L = math.gcd(T, ML_CHUNK)
    NC = T // L

    def chunks(z):
        z = z.reshape(B, NC, L, H, *z.shape[3:])
        return jnp.moveaxis(z, (1, 3), (0, 2))

    causal = jnp.tril(jnp.ones((L, L), bool))

    def chunk_step(carry, inp):
        C, n, m = carry
        q_c, k_c, v_c, li, lf = inp
        b = jnp.cumsum(lf, axis=-1)
        g_inter = b + m[..., None]
        Dlog = jnp.where(causal, b[..., :, None] - b[..., None, :] + li[..., None, :], -jnp.inf)
        m_t = jnp.maximum(g_inter, Dlog.max(-1))
        Dw = jnp.exp(Dlog - m_t[..., None])
        w_inter = jnp.exp(g_inter - m_t)
        S = jnp.einsum('bhtk,bhsk->bhts', q_c, k_c) * Dw
        num = w_inter[..., None] * jnp.einsum('bhvk,bhtk->bhtv', C, q_c) + jnp.einsum('bhts,bhsv->bhtv', S, v_c)
        den = w_inter * jnp.einsum('bhk,bhtk->bht', n, q_c) + S.sum(-1)
        h = num / jnp.maximum(jnp.abs(den), jnp.exp(-m_t))[..., None]
        m_new = m_t[..., -1]
        w_state = jnp.exp(b[..., -1] + m - m_new)
        w_s = jnp.exp(b[..., -1:] - b + li - m_new[..., None])
        C = w_state[..., None, None] * C + jnp.einsum('bhs,bhsv,bhsk->bhvk', w_s, v_c, k_c)
        n = w_state[..., None] * n + jnp.einsum('bhs,bhsk->bhk', w_s, k_c)
        return (C, n, m_new), h

    carry0 = (C0.astype(jnp.float32), n0.astype(jnp.float32), m0.astype(jnp.float32))
    (C_T, n_T, m_T), h = lax.scan(chunk_step, carry0, (chunks(q), chunks(k), chunks(v), chunks(logi), chunks(logf)))
    h = jnp.moveaxis(h, (0, 2), (1, 3)).reshape(B, T, H, DV)
    h = h * lax.rsqrt(jnp.mean(h * h, -1, keepdims=True) + NORM_EPS)
    h = h.reshape(B, T, H * DV) * norm_w
    out = (h * o) @ w_out
    return out.astype(xn.dtype), C_T, n_T, m_T, new_conv


def trunk(x, rw_S, rw_shift, ml_C, ml_n, ml_m, ml_conv, p):
    new_rw_S, new_rw_shift = [], []
    new_C, new_n, new_m, new_conv = [], [], [], []
    for i in range(DEPTH):
        x = x + 0.5 * swiglu(rmsnorm(x, p['norm_ffa'][i]), p['ffa_wg'][i], p['ffa_wu'][i], p['ffa_wd'][i])
        h = rmsnorm(x, p['norm_mix'][i])
        j = i // N_MIXERS
        if i % N_MIXERS == 0:
            out, S, sh = rwkv7_time_mix(h, rw_shift[j], rw_S[j], *[p[nm][j] for nm in RW_NAMES])
            new_rw_S.append(S)
            new_rw_shift.append(sh)
        else:
            out, C, n, m, cb = mlstm_mix(h, ml_conv[j], ml_C[j], ml_n[j], ml_m[j], *[p[nm][j] for nm in ML_NAMES])
            new_C.append(C)
            new_n.append(n)
            new_m.append(m)
            new_conv.append(cb)
        x = x + out
        x = x + 0.5 * swiglu(rmsnorm(x, p['norm_ffb'][i]), p['ffb_wg'][i], p['ffb_wu'][i], p['ffb_wd'][i])
    y = rmsnorm(x, p['norm_final'])
    return (y, jnp.stack(new_rw_S), jnp.stack(new_rw_shift), jnp.stack(new_C), jnp.stack(new_n),
            jnp.stack(new_m), jnp.stack(new_conv))


def setup_inputs(seed: int = 0) -> dict:
    key = jax.random.key(seed)
    keys = iter(jax.random.split(key, 64))

    def nrm(shape, scale):
        return scale * jax.random.normal(next(keys), shape, jnp.float32)

    def uni(shape, lo, hi):
        return jax.random.uniform(next(keys), shape, jnp.float32, lo, hi)

    def gain(shape):
        return 1.0 + nrm(shape, 0.02)

    NR, NM, D = N_RWKV_LAYERS, N_MLSTM_LAYERS, D_MODEL
    return {
        'x_prompt': nrm((BATCH, SEQ, D), 1.0),
        'x_sample': nrm((DEC_BATCH, DEC_SEQ, D), 1.0),
        'state_rwkv_S': nrm((NR, DEC_BATCH, RW_HEADS, RW_HEAD, RW_HEAD), 0.2),
        'state_rwkv_shift': nrm((NR, DEC_BATCH, D), 1.0),
        'state_mlstm_C': nrm((NM, DEC_BATCH, ML_HEADS, ML_DV, ML_DK), 0.1),
        'state_mlstm_n': nrm((NM, DEC_BATCH, ML_HEADS, ML_DK), 0.1),
        'state_mlstm_m': nrm((NM, DEC_BATCH, ML_HEADS), 1.0),
        'state_mlstm_conv': nrm((NM, DEC_BATCH, ML_CONV - 1, 2 * ML_QK), 1.0),
        'norm_ffa': gain((DEPTH, D)),
        'ffa_wg': nrm((DEPTH, D, D_FF), D ** -0.5),
        'ffa_wu': nrm((DEPTH, D, D_FF), D ** -0.5),
        'ffa_wd': nrm((DEPTH, D_FF, D), D_FF ** -0.5),
        'norm_mix': gain((DEPTH, D)),
        'norm_ffb': gain((DEPTH, D)),
        'ffb_wg': nrm((DEPTH, D, D_FF), D ** -0.5),
        'ffb_wu': nrm((DEPTH, D, D_FF), D ** -0.5),
        'ffb_wd': nrm((DEPTH, D_FF, D), D_FF ** -0.5),
        'rw_mu': uni((NR, 6, D), 0.0, 1.0),
        'rw_wr': nrm((NR, D, D), D ** -0.5),
        'rw_wk': nrm((NR, D, D), D ** -0.5),
        'rw_wv': nrm((NR, D, D), D ** -0.5),
        'rw_wo': nrm((NR, D, D), D ** -0.5),
        'rw_w0': uni((NR, D), -6.0, -1.0),
        'rw_w1': nrm((NR, D, RW_DECAY_LORA), D ** -0.5),
        'rw_w2': nrm((NR, RW_DECAY_LORA, D), 0.1 * RW_DECAY_LORA ** -0.5),
        'rw_a0': nrm((NR, D), 0.1),
        'rw_a1': nrm((NR, D, RW_AAA_LORA), D ** -0.5),
        'rw_a2': nrm((NR, RW_AAA_LORA, D), 0.1 * RW_AAA_LORA ** -0.5),
        'rw_g1': nrm((NR, D, RW_GATE_LORA), D ** -0.5),
        'rw_g2': nrm((NR, RW_GATE_LORA, D), RW_GATE_LORA ** -0.5),
        'rw_k_k': 0.85 + nrm((NR, D), 0.05),
        'rw_k_a': 1.0 + nrm((NR, D), 0.05),
        'rw_r_k': nrm((NR, RW_HEADS, RW_HEAD), 0.1),
        'rw_gn_w': gain((NR, D)),
        'rw_gn_b': nrm((NR, D), 0.02),
        'ml_w_in': nrm((NM, D, ML_IN), D ** -0.5),
        'ml_b_if': jnp.concatenate([nrm((NM, ML_HEADS), 0.1), 3.0 + nrm((NM, ML_HEADS), 0.5)], axis=-1),
        'ml_conv_w': nrm((NM, ML_CONV, 2 * ML_QK), 0.5),
        'ml_conv_b': nrm((NM, 2 * ML_QK), 0.02),
        'ml_norm_w': gain((NM, ML_HEADS * ML_DV)),
        'ml_w_out': nrm((NM, ML_HEADS * ML_DV, D), (ML_HEADS * ML_DV) ** -0.5),
        'norm_final': gain((D,)),
    }


def reference(x_prompt, x_sample, state_rwkv_S, state_rwkv_shift, state_mlstm_C, state_mlstm_n, state_mlstm_m,
              state_mlstm_conv, norm_ffa, ffa_wg, ffa_wu, ffa_wd, norm_mix, norm_ffb, ffb_wg, ffb_wu, ffb_wd,
              rw_mu, rw_wr, rw_wk, rw_wv, rw_wo, rw_w0, rw_w1, rw_w2, rw_a0, rw_a1, rw_a2, rw_g1, rw_g2,
              rw_k_k, rw_k_a, rw_r_k, rw_gn_w, rw_gn_b, ml_w_in, ml_b_if, ml_conv_w, ml_conv_b, ml_norm_w,
              ml_w_out, norm_final):
    p = dict(norm_ffa=norm_ffa, ffa_wg=ffa_wg, ffa_wu=ffa_wu, ffa_wd=ffa_wd, norm_mix=norm_mix,
             norm_ffb=norm_ffb, ffb_wg=ffb_wg, ffb_wu=ffb_wu, ffb_wd=ffb_wd,
             rw_mu=rw_mu, rw_wr=rw_wr, rw_wk=rw_wk, rw_wv=rw_wv, rw_wo=rw_wo, rw_w0=rw_w0, rw_w1=rw_w1,
             rw_w2=rw_w2, rw_a0=rw_a0, rw_a1=rw_a1, rw_a2=rw_a2, rw_g1=rw_g1, rw_g2=rw_g2, rw_k_k=rw_k_k,
             rw_k_a=rw_k_a, rw_r_k=rw_r_k, rw_gn_w=rw_gn_w, rw_gn_b=rw_gn_b,
             ml_w_in=ml_w_in, ml_b_if=ml_b_if, ml_conv_w=ml_conv_w, ml_conv_b=ml_conv_b,
             ml_norm_w=ml_norm_w, ml_w_out=ml_w_out, norm_final=norm_final)
    B = x_prompt.shape[0]
    f32 = jnp.float32
    z_rw_S = jnp.zeros((N_RWKV_LAYERS, B, RW_HEADS, RW_HEAD, RW_HEAD), f32)
    z_rw_shift = jnp.zeros((N_RWKV_LAYERS, B, D_MODEL), f32)
    z_C = jnp.zeros((N_MLSTM_LAYERS, B, ML_HEADS, ML_DV, ML_DK), f32)
    z_n = jnp.zeros((N_MLSTM_LAYERS, B, ML_HEADS, ML_DK), f32)
    z_m = jnp.zeros((N_MLSTM_LAYERS, B, ML_HEADS), f32)
    z_conv = jnp.zeros((N_MLSTM_LAYERS, B, ML_CONV - 1, 2 * ML_QK), f32)
    y_prompt, p_rw_S, p_rw_shift, p_C, p_n, p_m, p_conv = trunk(
        x_prompt, z_rw_S, z_rw_shift, z_C, z_n, z_m, z_conv, p)
    y_sample, s_rw_S, s_rw_shift, s_C, s_n, s_m, s_conv = trunk(
        x_sample, state_rwkv_S, state_rwkv_shift, state_mlstm_C, state_mlstm_n, state_mlstm_m,
        state_mlstm_conv, p)
    return (y_prompt, y_sample, p_rw_S, p_rw_shift, p_C, p_n, p_m, p_conv,
            s_rw_S, s_rw_shift, s_C, s_n, s_m, s_conv)
```

```cpp
#include <hip/hip_runtime.h>
#include <cstdio>
#include <cstdint>
namespace pg8 {
#define PG8_LAS __attribute__((address_space(3)))
typedef unsigned short bf16_t;
typedef short bf16x8 __attribute__((ext_vector_type(8)));
typedef float f32x4 __attribute__((ext_vector_type(4)));
typedef unsigned u32x4 __attribute__((ext_vector_type(4)));
constexpr int BM = 256, BK = 64, HALF = 128, HTB = HALF * BK * 2  , STAGE_BYTES = 8 * HTB, NXCD = 8, WGM = 8;

__host__ __device__ __forceinline__ int lds_byte(int r, int c) { const int st = (r >> 4) * 2 + (c >> 5), rr = r & 15, cc = c & 31, ob = rr * 64 + cc * 2; return st * 1024 + (ob ^ (((ob >> 9) & 1) << 5)); }
__host__ __device__ __forceinline__ void stage_rc(int b, int& R, int& C) { const int st = b / 1024, sb = b % 1024, swz = sb ^ (((sb >> 9) & 1) << 5); R = (st >> 1) * 16 + swz / 64; C = (st & 1) * 32 + (swz % 64) / 2; }
__host__ __device__ __forceinline__ int perm32(int rho) { const int n = rho >> 4, i = rho & 15; return 8 * (i >> 2) + 4 * n + (i & 3); }

struct Unit { int pm, pn, k0, nt, slab; };
struct Gemm { const bf16_t* A; const bf16_t* Bt; int M, N, K; };

struct UnitOrder {
    int nM, nN, nwg, G, c, ntf, tailS;
    __device__ __forceinline__ void init(int nM_, int nN_, int K, int G_, int c_, int tailS_) { nM = nM_; nN = nN_; nwg = nM * nN; G = G_; c = c_; ntf = K / BK; tailS = tailS_; }
    __device__ __forceinline__ bool next(int i, Unit& u) const {
        long L = (long)i * G + c;
        if (L < nwg) {
            int wgid = (int)L; { const int q = nwg / NXCD, r = nwg % NXCD, xcd = wgid % NXCD, off = wgid / NXCD; wgid = (xcd < r ? xcd * (q + 1) : r * (q + 1) + (xcd - r) * q) + off; }
            const int nig = WGM * nN, gid = wgid / nig, fm = gid * WGM, gsz = (nM - fm) < WGM ? (nM - fm) : WGM;
            u.pm = fm + ((wgid % nig) % gsz); u.pn = (wgid % nig) / gsz; u.k0 = 0; u.nt = ntf; u.slab = -1; return true;
        }
        L -= nwg; if (L >= 8 * tailS) return false;
        const int tile = (int)L / tailS, sl = (int)L % tailS;
        u.pm = 64 + (tile >> 2); u.pn = tile & 3; u.k0 = sl * 256; u.nt = 4; u.slab = sl; return true;
    }
    __device__ __forceinline__ void a_ready(const Unit&) const {}
    __device__ __forceinline__ void done(const Unit&) const {}
};
template <class Epi, class Sched, bool ALIGN_EPI = false, bool SP2 = false>
__device__ __forceinline__ void gemm_phase(PG8_LAS unsigned char* lds, const Gemm g, const Sched& S, const Epi& E, const int tid) {
    const int wid = __builtin_amdgcn_readfirstlane(tid >> 6), lane = tid & 63, wr = wid >> 2, wc = wid & 3, fr = lane & 15, fq = lane >> 4;
    const int K = g.K;
    unsigned voffA[2], voffB[2];
#pragma unroll
    for (int i = 0; i < 2; ++i) { int R, C; stage_rc(tid * 16 + i * 8192, R, C); const int Rb = Epi::PERM ? ((R & ~31) + perm32(R & 31)) : R;
        voffA[i] = (unsigned)(R * K + C) * 2u; voffB[i] = (unsigned)(Rb * K + C) * 2u; }
    const size_t kstep = (size_t)(BK * 2);
    const size_t hstep = (size_t)HALF * K * 2;
    const size_t tstep = 2 * hstep;
    const unsigned ldsw = (unsigned)wid * 1024u;
    const int aoff = lds_byte(wr * 64 + fr, fq * 8), boff = lds_byte(wc * 32 + fr, fq * 8);
#define PG8_SA(b, h) (((b) * 2 + (h)) * HTB)
#define PG8_SB(b, h) ((4 + (b) * 2 + (h)) * HTB)
#define PG8_STAGE(bufoff, gbase, voff) do { _Pragma("unroll") for (int _i = 0; _i < 2; ++_i) \
        __builtin_amdgcn_global_load_lds((const unsigned*)((const char*)(gbase) + (voff)[_i]), (PG8_LAS unsigned*)(lds + (bufoff) + ldsw + _i * 8192), 16, 0, 0); } while (0)
#define PG8_LDA(dst, b, h) do { _Pragma("unroll") for (int m = 0; m < 4; ++m) _Pragma("unroll") for (int k = 0; k < 2; ++k) dst[m][k] = *(const PG8_LAS bf16x8*)(lds + PG8_SA(b, h) + aoff + m * 2048 + k * 1024); } while (0)
#define PG8_LDB(dst, b, h) do { _Pragma("unroll") for (int n = 0; n < 2; ++n) _Pragma("unroll") for (int k = 0; k < 2; ++k) dst[n][k] = *(const PG8_LAS bf16x8*)(lds + PG8_SB(b, h) + boff + n * 2048 + k * 1024); } while (0)
#define PG8_MMA(ai, bj, At, Bt) do { __builtin_amdgcn_s_setprio(1); _Pragma("unroll") for (int m = 0; m < 4; ++m) _Pragma("unroll") for (int n = 0; n < 2; ++n) _Pragma("unroll") for (int k = 0; k < 2; ++k) \
        acc[ai][bj][m][n] = __builtin_amdgcn_mfma_f32_16x16x32_bf16(Bt[n][k], At[m][k], acc[ai][bj][m][n], 0, 0, 0); __builtin_amdgcn_s_setprio(0); } while (0)
#define PG8_WAIT_V(n) asm volatile("s_waitcnt vmcnt(" #n ")" ::: "memory")
#define PG8_WAIT_L(n) asm volatile("s_waitcnt lgkmcnt(" #n ")" ::: "memory")
#define PG8_BAR __builtin_amdgcn_s_barrier()
#define PG8_SCHED __builtin_amdgcn_sched_barrier(0)
    Unit cur, nxt; int ui = 0;
    if (!S.next(0, cur)) return;
    f32x4 acc[2][2][4][2];
#pragma unroll
    for (int a = 0; a < 2; ++a)
#pragma unroll
        for (int b = 0; b < 2; ++b)
#pragma unroll
            for (int m = 0; m < 4; ++m)
#pragma unroll
                for (int n = 0; n < 2; ++n) acc[a][b][m][n] = (f32x4){0.f, 0.f, 0.f, 0.f};
    bf16x8 At[4][2], B0[2][2], B1[2][2];
    const char* cA = (const char*)g.A + (size_t)cur.pm * tstep + (size_t)cur.k0 * 2; const char* cB = (const char*)g.Bt + (size_t)cur.pn * tstep + (size_t)cur.k0 * 2;
    S.a_ready(cur);
    if constexpr (SP2) {
        PG8_STAGE(PG8_SB(0, 0), cB, voffB); PG8_STAGE(PG8_SB(0, 1), cB + hstep, voffB); PG8_STAGE(PG8_SA(0, 0), cA, voffA); PG8_STAGE(PG8_SA(0, 1), cA + hstep, voffA);
        if (wr == 1) PG8_BAR;
        PG8_WAIT_V(2); PG8_BAR;
        PG8_STAGE(PG8_SB(1, 0), cB + kstep, voffB); PG8_STAGE(PG8_SA(1, 0), cA + kstep, voffA); PG8_STAGE(PG8_SB(1, 1), cB + hstep + kstep, voffB);
        PG8_WAIT_V(6); PG8_BAR;
    } else {
        PG8_STAGE(PG8_SB(0, 0), cB, voffB); PG8_STAGE(PG8_SA(0, 0), cA, voffA); PG8_STAGE(PG8_SB(0, 1), cB + hstep, voffB); PG8_STAGE(PG8_SA(0, 1), cA + hstep, voffA);
        if (wr == 1) PG8_BAR;
        PG8_WAIT_V(4); PG8_BAR;
        PG8_STAGE(PG8_SB(1, 0), cB + kstep, voffB); PG8_STAGE(PG8_SA(1, 0), cA + kstep, voffA); PG8_STAGE(PG8_SB(1, 1), cB + hstep + kstep, voffB);
        PG8_WAIT_V(6); PG8_BAR;
    }
    for (;;) {
        const bool has_next = S.next(ui + 1, nxt);
        const char* nA = has_next ? (const char*)g.A + (size_t)nxt.pm * tstep + (size_t)nxt.k0 * 2 : cA; const char* nB = has_next ? (const char*)g.Bt + (size_t)nxt.pn * tstep + (size_t)nxt.k0 * 2 : cB;
        const int nt = cur.nt;
        for (int t = 0; t < nt; t += 2) {
            const bool last = (t == nt - 2);
            const char* a1 = cA + (size_t)(t + 1) * kstep;
            const char* a2 = last ? nA : cA + (size_t)(t + 2) * kstep; const char* b2 = last ? nB : cB + (size_t)(t + 2) * kstep;
            const char* a3 = a2 + kstep; const char* b3 = b2 + kstep;
            if (last && has_next) S.a_ready(nxt);
            if constexpr (SP2) {
            PG8_LDB(B0, 0, 0); PG8_LDB(B1, 0, 1); PG8_SCHED; PG8_LDA(At, 0, 0); PG8_STAGE(PG8_SA(1, 1), a1 + hstep, voffA);
            PG8_WAIT_V(8); PG8_WAIT_L(0); PG8_BAR; PG8_MMA(0, 0, At, B0); PG8_MMA(0, 1, At, B1); PG8_BAR; PG8_SCHED;
            PG8_LDA(At, 0, 1); PG8_STAGE(PG8_SB(0, 0), b2, voffB); PG8_STAGE(PG8_SB(0, 1), b2 + hstep, voffB); PG8_STAGE(PG8_SA(0, 0), a2, voffA);
            PG8_WAIT_V(8); PG8_WAIT_L(0); PG8_BAR; PG8_MMA(1, 0, At, B0); PG8_MMA(1, 1, At, B1); PG8_BAR; PG8_SCHED;
            PG8_LDB(B0, 1, 0); PG8_LDB(B1, 1, 1); PG8_SCHED; PG8_LDA(At, 1, 0); PG8_STAGE(PG8_SA(0, 1), a2 + hstep, voffA);
            PG8_WAIT_V(8); PG8_WAIT_L(0); PG8_BAR; PG8_MMA(0, 0, At, B0); PG8_MMA(0, 1, At, B1); PG8_BAR; PG8_SCHED;
            PG8_LDA(At, 1, 1); PG8_STAGE(PG8_SB(1, 0), b3, voffB); PG8_STAGE(PG8_SB(1, 1), b3 + hstep, voffB); PG8_STAGE(PG8_SA(1, 0), a3, voffA);
            PG8_WAIT_V(8); PG8_WAIT_L(0); PG8_BAR; PG8_MMA(1, 0, At, B0); PG8_MMA(1, 1, At, B1); PG8_BAR; PG8_SCHED;
            } else {
            PG8_LDB(B0, 0, 0); PG8_SCHED; PG8_LDA(At, 0, 0); PG8_STAGE(PG8_SA(1, 1), a1 + hstep, voffA);
            PG8_WAIT_L(8); PG8_BAR; PG8_WAIT_L(0); PG8_MMA(0, 0, At, B0); PG8_BAR; PG8_SCHED;
            PG8_LDB(B1, 0, 1); PG8_STAGE(PG8_SB(0, 0), b2, voffB);
            PG8_BAR; PG8_WAIT_L(0); PG8_MMA(0, 1, At, B1); PG8_BAR;
            PG8_LDA(At, 0, 1); PG8_STAGE(PG8_SA(0, 0), a2, voffA);
            PG8_BAR; PG8_WAIT_L(0); PG8_MMA(1, 0, At, B0); PG8_BAR; PG8_SCHED;
            PG8_STAGE(PG8_SB(0, 1), b2 + hstep, voffB);
            PG8_WAIT_V(6); PG8_BAR; PG8_MMA(1, 1, At, B1); PG8_BAR;
            PG8_LDB(B0, 1, 0); PG8_SCHED; PG8_LDA(At, 1, 0); PG8_STAGE(PG8_SA(0, 1), a2 + hstep, voffA);
            PG8_WAIT_L(8); PG8_BAR; PG8_WAIT_L(0); PG8_MMA(0, 0, At, B0); PG8_BAR; PG8_SCHED;
            PG8_LDB(B1, 1, 1); PG8_STAGE(PG8_SB(1, 0), b3, voffB);
            PG8_BAR; PG8_WAIT_L(0); PG8_MMA(0, 1, At, B1); PG8_BAR;
            PG8_LDA(At, 1, 1); PG8_STAGE(PG8_SA(1, 0), a3, voffA);
            PG8_BAR; PG8_WAIT_L(0); PG8_MMA(1, 0, At, B0); PG8_BAR; PG8_SCHED;
            PG8_STAGE(PG8_SB(1, 1), b3 + hstep, voffB);
            PG8_WAIT_V(6); PG8_BAR; PG8_MMA(1, 1, At, B1); PG8_BAR;
            }
        }
        if constexpr (ALIGN_EPI) { if (wr == 0) PG8_BAR; }
        if constexpr (!Epi::AFTER_DRAIN) { E(acc, cur, wr, wc, fr, fq); S.done(cur); }
        if (!has_next) break;
#pragma unroll
        for (int a = 0; a < 2; ++a)
#pragma unroll
            for (int b = 0; b < 2; ++b)
#pragma unroll
                for (int m = 0; m < 4; ++m)
#pragma unroll
                    for (int n = 0; n < 2; ++n) acc[a][b][m][n] = (f32x4){0.f, 0.f, 0.f, 0.f};
        cur = nxt; cA = nA; cB = nB; ++ui;
        if constexpr (ALIGN_EPI) { if (wr == 1) PG8_BAR; }
    }
    PG8_WAIT_V(0);
    if constexpr (!ALIGN_EPI) { if (wr == 0) PG8_BAR; }
    PG8_BAR;
    if constexpr (Epi::AFTER_DRAIN) { E.fused(acc, cur, wr, wc, fr, fq, lds, wid, lane); S.done(cur); }
#undef PG8_SA
#undef PG8_SB
#undef PG8_STAGE
#undef PG8_LDA
#undef PG8_LDB
#undef PG8_MMA
#undef PG8_WAIT_V
#undef PG8_WAIT_L
#undef PG8_BAR
#undef PG8_SCHED
}
}

#define GAS __attribute__((address_space(1)))
#define LAS __attribute__((address_space(3)))
typedef unsigned short bf16;
typedef unsigned v4u __attribute__((ext_vector_type(4)));
typedef float f32x4 __attribute__((ext_vector_type(4)));
typedef short bf16x8 __attribute__((ext_vector_type(8)));
typedef GAS unsigned gu32;
typedef GAS unsigned long long gu64;
#define RLX_AGENT __ATOMIC_RELAXED, __HIP_MEMORY_SCOPE_AGENT
#define LDS_WAIT() asm volatile("s_waitcnt lgkmcnt(0)" ::: "memory")
#define VM_WAIT() asm volatile("s_waitcnt vmcnt(0)" ::: "memory")
__device__ __forceinline__ unsigned long long rt() { return __builtin_amdgcn_s_memrealtime(); }
__device__ __forceinline__ unsigned f2bf(float f) { unsigned u = __builtin_bit_cast(unsigned, f); return (u + 0x7fffu + ((u >> 16) & 1u)) >> 16; }
__device__ __forceinline__ unsigned pk2(float lo, float hi) { return f2bf(lo) | (f2bf(hi) << 16); }

#define XB_TMO      128
#define XB_XCNT(j)  (256  + 64 * (j))
#define XB_XSUB(j)  (1280 + 64 * (j))
#define XB_XGEN(j)  (2304 + 64 * (j))
#define XB_TOP      3328
#define XB_TOPGEN   3392
#define XCD_BAR_WORDS 3456
#define XB_SPIN_CAP (1u << 18)

__device__ __forceinline__ unsigned xb_ld(unsigned* p)              { return __hip_atomic_load(p, __ATOMIC_RELAXED, __HIP_MEMORY_SCOPE_AGENT); }
__device__ __forceinline__ unsigned xb_add(unsigned* p, unsigned v) { return __hip_atomic_fetch_add(p, v, __ATOMIC_RELAXED, __HIP_MEMORY_SCOPE_AGENT); }
__device__ __forceinline__ unsigned xb_xcc_id() { return (unsigned)__builtin_amdgcn_s_getreg((3 << 11) | 20) & 0xFu; }
#define XB_SPIN(cond, bar) do { unsigned _sp = 0; while (cond) { __builtin_amdgcn_s_sleep(1); \
    if ((++_sp & 255u) == 0u) { if (xb_ld(&(bar)[XB_TMO])) break; if (_sp > XB_SPIN_CAP) { atomicAdd(&(bar)[XB_TMO], 1u); break; } } } } while (0)

struct XcdBarrier {
    unsigned* bar; unsigned x;
    volatile LAS unsigned* st;
};

__device__ __forceinline__ XcdBarrier xcd_barrier_post(unsigned* bar, volatile LAS unsigned* st) {
    XcdBarrier b; b.bar = bar; b.x = xb_xcc_id(); b.st = st;
    if (threadIdx.x == 0) (void)xb_add(&bar[XB_XCNT(b.x)], 1u);
    return b;
}
__device__ __forceinline__ void xcd_barrier_complete(unsigned* bar, unsigned x, unsigned& nloc, unsigned& nx) {
    const unsigned G = gridDim.x * gridDim.y * gridDim.z;
    unsigned sum, cnt, mine, sp = 0u;
    for (;;) {
        sum = 0u; cnt = 0u; mine = 0u;
#pragma unroll
        for (unsigned j = 0; j < 16; ++j) { const unsigned c = xb_ld(&bar[XB_XCNT(j)]); sum += c; cnt += (c > 0u) ? 1u : 0u; mine = (j == x) ? c : mine; }
        if (sum == G) break;
        __builtin_amdgcn_s_sleep(1);
        if ((++sp & 255u) == 0u) { if (xb_ld(&bar[XB_TMO])) break; if (sp > XB_SPIN_CAP) { atomicAdd(&bar[XB_TMO], 1u); break; } }
    }
    nloc = mine > 0u ? mine : 1u; nx = cnt > 0u ? cnt : 1u;
}

__device__ __forceinline__ void xcd_barrier(const XcdBarrier& b) {
    asm volatile("s_waitcnt vmcnt(0)" ::: "memory");
    __syncthreads();
    if (threadIdx.x == 0) {
        unsigned* bar = b.bar;
        __builtin_amdgcn_s_waitcnt(0);
        unsigned nloc = b.st[0], nx = b.st[1];
        if (nloc == 0u) { xcd_barrier_complete(bar, b.x, nloc, nx); b.st[0] = nloc; b.st[1] = nx; }
        const unsigned old = xb_add(&bar[XB_XSUB(b.x)], 1u);
        const unsigned gen = old / nloc;
        if (old + 1u == (gen + 1u) * nloc) {
            __builtin_amdgcn_fence(__ATOMIC_RELEASE, "agent");
            asm volatile("s_waitcnt vmcnt(0)" ::: "memory");
            const unsigned og = xb_add(&bar[XB_TOP], 1u);
            const unsigned tg = og / nx;
            if (og + 1u == (tg + 1u) * nx) xb_add(&bar[XB_TOPGEN], 1u);
            else XB_SPIN(xb_ld(&bar[XB_TOPGEN]) == tg, bar);
            __builtin_amdgcn_fence(__ATOMIC_ACQUIRE, "agent");
            xb_add(&bar[XB_XGEN(b.x)], 1u);
            asm volatile("s_waitcnt vmcnt(0)" ::: "memory");
        } else {
            XB_SPIN(xb_ld(&bar[XB_XGEN(b.x)]) == gen, bar);
            __builtin_amdgcn_fence(__ATOMIC_ACQUIRE, "agent");
            asm volatile("s_waitcnt vmcnt(0)" ::: "memory");
        }
    }
    __syncthreads();
}

constexpr int NWAVES = 8;
constexpr int D = 1024, FF = 2816;
constexpr int PB = 8, PT = 2048, SB = 128, STK = 4;
constexpr int MP = PB * PT, MS = SB * STK, M = MP + MS;
constexpr int NRW = 3584, KRW = 2048, NL2 = 3072, KL2 = 384, NIN = 3328;
constexpr float NORM_EPS = 1e-6f, GN_EPS = 64e-5f;
typedef pg8::bf16_t bf16;

constexpr size_t MiB = 1u << 20;
constexpr size_t WS_CTL = 0, CTL_ZERO_BYTES = 64 * 1024;
constexpr size_t WS_W = 1 * MiB;
constexpr size_t WS_XR = 20 * MiB;
constexpr size_t WS_BIG = 86 * MiB;
constexpr size_t WS_END = 256 * MiB;
constexpr size_t W_GU = 0, W_D = (size_t)2 * FF * D * 2;
constexpr size_t W_RW = 0, W_L2 = (size_t)NRW * KRW * 2, W_O = W_L2 + (size_t)NL2 * KL2 * 2;
constexpr size_t W_IN = 0, W_OUT = (size_t)NIN * D * 2;
static_assert(W_D + (size_t)D * FF * 2 <= 19 * MiB && W_O + (size_t)D * D * 2 <= 19 * MiB && W_OUT + (size_t)D * D * 2 <= 19 * MiB, "weights region");
constexpr size_t B_H = 0, B_XN = 91 * MiB, B_SLAB = 124 * MiB;
constexpr size_t B_ACAT = 0, B_R = 66 * MiB, B_K = 99 * MiB, B_V = 132 * MiB, B_DEC = 0, B_AA = 33 * MiB;
constexpr size_t B_QKR = 0, B_VV = 33 * MiB, B_HO = 66 * MiB, B_OO = 124 * MiB, B_IF = 157 * MiB;
static_assert((size_t)M * FF * 2 <= 91 * MiB && (size_t)M * D * 2 == 33 * MiB && B_IF + (size_t)M * 16 * 4 <= 170 * MiB && B_SLAB + (size_t)11 * MS * D * 4 <= 170 * MiB, "BIG map");
constexpr size_t OS_GG = 0, OS_LORA = 33 * MiB;
static_assert(OS_LORA + (size_t)M * KL2 * 2 <= (size_t)MP * D * 4, "d_out scratch");
constexpr size_t O_Y = 0, O_P_S = 17301504, O_P_SHIFT = 17825792, O_P_C = 17833984, O_P_N = 18358272, O_P_M = 18362368, O_P_CONV = 18362432,
                 O_S_S = 18387008, O_S_SHIFT = 26775616, O_S_C = 26906688, O_S_N = 35295296, O_S_M = 35360832, O_S_CONV = 35361856, O_END = 35755072;
constexpr int CW_BAR = 1024;

constexpr int RING_BYTES = 131072, LDSCTL_OFF = RING_BYTES, MISC_OFF = LDSCTL_OFF + 320, TAB_OFF = LDSCTL_OFF + 1024, LDS_BYTES = 147456;

enum { I_XP = 0, I_XS, I_RS, I_RSHIFT, I_MC, I_MN, I_MM, I_MCONV, I_NFA, I_FAWG, I_FAWU, I_FAWD, I_NMIX, I_NFB, I_FBWG, I_FBWU, I_FBWD,
       I_MU, I_WR, I_WK, I_WV, I_WO, I_W0, I_W1, I_W2, I_A0, I_A1, I_A2, I_G1, I_G2, I_KK, I_KA, I_RK, I_GNW, I_GNB,
       I_WIN, I_BIF, I_CW, I_CB, I_MNW, I_WOUT, I_NFIN, N_IN };

typedef __bf16 bf16x2_t __attribute__((ext_vector_type(2)));
typedef float f32x2_t __attribute__((ext_vector_type(2)));
__device__ __forceinline__ unsigned pkbf(float lo, float hi) { f32x2_t v = {lo, hi}; bf16x2_t b = __builtin_convertvector(v, bf16x2_t); return __builtin_bit_cast(unsigned, b); }
__device__ __forceinline__ float bflo(unsigned u) { return __builtin_bit_cast(float, u << 16); }
__device__ __forceinline__ float bfhi(unsigned u) { return __builtin_bit_cast(float, u & 0xffff0000u); }
__device__ __forceinline__ float bf1(unsigned short u) { return __builtin_bit_cast(float, (unsigned)u << 16); }
__device__ __forceinline__ unsigned short f2bf1(float f) { return (unsigned short)(pkbf(f, 0.f) & 0xffffu); }
__device__ __forceinline__ void unpack8(v4u w, float (&o)[8]) { o[0] = bflo(w.x); o[1] = bfhi(w.x); o[2] = bflo(w.y); o[3] = bfhi(w.y); o[4] = bflo(w.z); o[5] = bfhi(w.z); o[6] = bflo(w.w); o[7] = bfhi(w.w); }
__device__ __forceinline__ v4u pack8(const float (&o)[8]) { v4u w; w.x = pkbf(o[0], o[1]); w.y = pkbf(o[2], o[3]); w.z = pkbf(o[4], o[5]); w.w = pkbf(o[6], o[7]); return w; }
__device__ __forceinline__ float sigmoidf_(float x) { return 1.f / (1.f + __expf(-x)); }
__device__ __forceinline__ float siluf_(float x) { return x / (1.f + __expf(-x)); }
__device__ __forceinline__ float tanhf_(float x) { return 1.f - 2.f / (__expf(2.f * x) + 1.f); }
__device__ __forceinline__ float logsigmoidf_(float x) { return fminf(x, 0.f) - log1pf(__expf(-fabsf(x))); }
template <int CTRL> __device__ __forceinline__ float dppf(float x) { return __builtin_bit_cast(float, __builtin_amdgcn_update_dpp(0, __builtin_bit_cast(int, x), CTRL, 0xF, 0xF, true)); }
__device__ __forceinline__ float red4(float x) { x += dppf<0xB1>(x); x += dppf<0x4E>(x); return x; }
__device__ __forceinline__ float red8(float x) { x = red4(x); x += dppf<0x141>(x); return x; }
__device__ __forceinline__ float red16(float x) { x = red8(x); x += dppf<0x140>(x); return x; }
__device__ __forceinline__ float wave_sum(float v) {
#pragma unroll
    for (int o = 1; o < 64; o <<= 1) v += __shfl_xor(v, o);
    return v;
}

struct Frame {
    LAS unsigned char* lds;
    volatile LAS unsigned* MISC;
    gu32* ctl;
    volatile LAS unsigned long long* tab;
    int tid, lane, wave, vcu, G;
};
__device__ __forceinline__ const float* inptr(const Frame& F, int i) { const unsigned long long v = F.tab[i];
    const unsigned lo = __builtin_amdgcn_readfirstlane((unsigned)v), hi = __builtin_amdgcn_readfirstlane((unsigned)(v >> 32)); return (const float*)(((unsigned long long)hi << 32) | lo); }

using pg8::Unit; using pg8::BM; using pg8::HALF;
__device__ __forceinline__ void st8bf(bf16* p, f32x4 v0, f32x4 v1) { v4u w; w.x = pkbf(v0[0], v0[1]); w.y = pkbf(v0[2], v0[3]); w.z = pkbf(v1[0], v1[1]); w.w = pkbf(v1[2], v1[3]); *(v4u*)p = w; }

struct EpiSwiglu {
    static constexpr bool PERM = true, AFTER_DRAIN = false;
    bf16* H;
    __device__ __forceinline__ void operator()(const f32x4 (&acc)[2][2][4][2], const Unit& u, int wr, int wc, int fr, int fq) const {
        const int row0 = u.pm * BM + wr * 64 + fr, col0 = u.pn * 128 + wc * 32 + 8 * fq;
#pragma unroll
        for (int ai = 0; ai < 2; ++ai)
#pragma unroll
            for (int m = 0; m < 4; ++m) {
                f32x4 o[2];
#pragma unroll
                for (int n = 0; n < 2; ++n)
#pragma unroll
                    for (int i = 0; i < 4; ++i) { const float g = acc[ai][0][m][n][i], up = acc[ai][1][m][n][i]; o[n][i] = siluf_(g) * up; }
                st8bf(H + (size_t)(row0 + ai * HALF + m * 16) * FF + col0, o[0], o[1]);
            }
    }
};
struct EpiRes {
    static constexpr bool PERM = false, AFTER_DRAIN = false;
    const float* base; float* out; float* slab; float coef;
    __device__ __forceinline__ void operator()(const f32x4 (&acc)[2][2][4][2], const Unit& u, int wr, int wc, int fr, int fq) const {
        const int row0 = u.pm * BM + wr * 64 + fr, col0 = u.pn * BM + wc * 32 + 4 * fq;
        if (u.slab < 0) {
#pragma unroll
            for (int ai = 0; ai < 2; ++ai)
#pragma unroll
                for (int m = 0; m < 4; ++m) { const size_t ro = (size_t)(row0 + ai * HALF + m * 16) * D + col0;
#pragma unroll
                    for (int bj = 0; bj < 2; ++bj)
#pragma unroll
                        for (int n = 0; n < 2; ++n) { const f32x4 b = *(const f32x4*)(base + ro + bj * HALF + n * 16); *(f32x4*)(out + ro + bj * HALF + n * 16) = b + acc[ai][bj][m][n] * coef; } }
        } else {
            float* sl = slab + (size_t)u.slab * MS * D;
#pragma unroll
            for (int ai = 0; ai < 2; ++ai)
#pragma unroll
                for (int m = 0; m < 4; ++m) { const size_t ro = (size_t)(row0 + ai * HALF + m * 16 - MP) * D + col0;
#pragma unroll
                    for (int bj = 0; bj < 2; ++bj)
#pragma unroll
                        for (int n = 0; n < 2; ++n) *(f32x4*)(sl + ro + bj * HALF + n * 16) = acc[ai][bj][m][n]; }
        }
    }
};
struct EpiRw {
    static constexpr bool PERM = true, AFTER_DRAIN = false;
    bf16 *R, *K, *V, *L;
    __device__ __forceinline__ void operator()(const f32x4 (&acc)[2][2][4][2], const Unit& u, int wr, int wc, int fr, int fq) const {
        const int row0 = u.pm * BM + wr * 64 + fr;
        if (u.pn < 12) {
            bf16 *p0 = R, *p1 = K, *p2 = V; asm volatile("" : "+s"(p0), "+s"(p1), "+s"(p2));
            bf16* dst = u.pn < 4 ? p0 : (u.pn < 8 ? p1 : p2); const int col0 = (u.pn & 3) * BM + wc * 32 + 8 * fq;
#pragma unroll
            for (int ai = 0; ai < 2; ++ai)
#pragma unroll
                for (int m = 0; m < 4; ++m) { bf16* rp = dst + (size_t)(row0 + ai * HALF + m * 16) * D + col0;
#pragma unroll
                    for (int bj = 0; bj < 2; ++bj) st8bf(rp + bj * HALF, acc[ai][bj][m][0], acc[ai][bj][m][1]); }
        } else {
#pragma unroll
            for (int bj = 0; bj < 2; ++bj) {
                const int lc = (u.pn - 12) * BM + bj * HALF + wc * 32 + 8 * fq;
                if (lc >= KL2) continue;
                const int act = lc < 64 ? 1 : (lc < 128 ? 0 : (lc < 288 ? 2 : 3));
#pragma unroll
                for (int ai = 0; ai < 2; ++ai)
#pragma unroll
                    for (int m = 0; m < 4; ++m) {
                        f32x4 o[2];
#pragma unroll
                        for (int n = 0; n < 2; ++n)
#pragma unroll
                            for (int i = 0; i < 4; ++i) { const float x = acc[ai][bj][m][n][i]; o[n][i] = act == 1 ? tanhf_(x) : (act == 0 ? x : (act == 2 ? sigmoidf_(x) : 0.f)); }
                        st8bf(L + (size_t)(row0 + ai * HALF + m * 16) * KL2 + lc, o[0], o[1]);
                    }
            }
        }
    }
};
struct EpiL2 {
    static constexpr bool PERM = true, AFTER_DRAIN = false;
    bf16 *DEC, *AA, *GG; const float *w0, *a0;
    __device__ __forceinline__ void operator()(const f32x4 (&acc)[2][2][4][2], const Unit& u, int wr, int wc, int fr, int fq) const {
        const int row0 = u.pm * BM + wr * 64 + fr, kind = u.pn >> 2, col0 = (u.pn & 3) * BM + wc * 32 + 8 * fq;
        bf16 *p0 = DEC, *p1 = AA, *p2 = GG; const float *q0 = w0, *q1 = a0; asm volatile("" : "+s"(p0), "+s"(p1), "+s"(p2), "+s"(q0), "+s"(q1));
        bf16* dst = kind == 0 ? p0 : (kind == 1 ? p1 : p2); const float* bias = kind == 0 ? q0 : q1;
#pragma unroll
        for (int bj = 0; bj < 2; ++bj) {
            f32x4 bv[2];
#pragma unroll
            for (int n = 0; n < 2; ++n) bv[n] = kind < 2 ? *(const f32x4*)(bias + col0 + bj * HALF + 4 * n) : (f32x4){0.f, 0.f, 0.f, 0.f};
#pragma unroll
            for (int ai = 0; ai < 2; ++ai)
#pragma unroll
                for (int m = 0; m < 4; ++m) {
                    f32x4 o[2];
#pragma unroll
                    for (int n = 0; n < 2; ++n)
#pragma unroll
                        for (int i = 0; i < 4; ++i) { const float z = acc[ai][bj][m][n][i] + bv[n][i];
                            o[n][i] = kind == 0 ? (1.f - __expf(-0.60653065971f * sigmoidf_(z))) : (kind == 1 ? sigmoidf_(z) : z); }
                    st8bf(dst + (size_t)(row0 + ai * HALF + m * 16) * D + col0 + bj * HALF, o[0], o[1]);
                }
        }
    }
};
struct EpiIn {
    static constexpr bool PERM = true, AFTER_DRAIN = false;
    bf16 *QKR, *VV, *OO; float* IF; const float* bif;
    __device__ __forceinline__ void operator()(const f32x4 (&acc)[2][2][4][2], const Unit& u, int wr, int wc, int fr, int fq) const {
        const int row0 = u.pm * BM + wr * 64 + fr;
        if (u.pn < 12) {
            bf16 *p0 = QKR, *p1 = VV, *p2 = OO; asm volatile("" : "+s"(p0), "+s"(p1), "+s"(p2));
            const int kind = u.pn >> 2; bf16* dst = kind == 0 ? p0 : (kind == 1 ? p1 : p2); const int col0 = (u.pn & 3) * BM + wc * 32 + 8 * fq;
#pragma unroll
            for (int ai = 0; ai < 2; ++ai)
#pragma unroll
                for (int m = 0; m < 4; ++m) { bf16* rp = dst + (size_t)(row0 + ai * HALF + m * 16) * D + col0;
#pragma unroll
                    for (int bj = 0; bj < 2; ++bj) { f32x4 a = acc[ai][bj][m][0], b = acc[ai][bj][m][1];
                        if (kind == 2) {
#pragma unroll
                            for (int i = 0; i < 4; ++i) { a[i] = sigmoidf_(a[i]); b[i] = sigmoidf_(b[i]); } }
                        st8bf(rp + bj * HALF, a, b); } }
        } else if (u.pn == 12 && wc == 0 && fq < 2) {
            const f32x4 b0 = *(const f32x4*)(bif + 8 * fq), b1 = *(const f32x4*)(bif + 8 * fq + 4);
#pragma unroll
            for (int ai = 0; ai < 2; ++ai)
#pragma unroll
                for (int m = 0; m < 4; ++m) { f32x4 a = acc[ai][0][m][0] + b0, b = acc[ai][0][m][1] + b1;
                    if (fq == 1) {
#pragma unroll
                        for (int i = 0; i < 4; ++i) { a[i] = logsigmoidf_(a[i]); b[i] = logsigmoidf_(b[i]); } }
                    float* rp = IF + (size_t)(row0 + ai * HALF + m * 16) * 16 + 8 * fq; *(f32x4*)rp = a; *(f32x4*)(rp + 4) = b; }
        }
    }
};

struct CJ { const float* W; const float* sc; bf16* WT; int K, N, Npad, ldk, koff, rmode, roff, smode; };
__device__ __forceinline__ int cj_items(const CJ& j) { return (j.K / 64) * (j.Npad / 32); }
__device__ __forceinline__ void conv_item(const CJ& J, LAS float* scr, int item, int lane) {
    const int nblk = J.Npad / 32, kb = item / nblk, nb = item % nblk, k0 = 64 * kb, n0 = 32 * nb;
    const int nn = n0 + (lane & 31); const bool nok = nn < J.N;
#pragma unroll 8
    for (int i = 0; i < 32; ++i) { const int kk = 2 * i + (lane >> 5); float w = nok ? J.W[(size_t)(k0 + kk) * J.N + nn] : 0.f;
        if (J.smode) { const float s = J.sc[k0 + kk]; w *= (J.smode == 1 ? s : 1.f - s); }
        scr[kk * 33 + (lane & 31)] = w; }
    LDS_WAIT(); asm volatile("" ::: "memory");
    const int rowbase = J.rmode == 0 ? J.roff + n0 : (n0 >> 7) * 256 + (n0 & 127) + J.roff;
    const int c = lane & 7;
#pragma unroll
    for (int j = 0; j < 4; ++j) { const int n = (lane >> 3) + 8 * j; const LAS float* s = scr + (8 * c) * 33 + n;
        v4u o; o.x = pkbf(s[0 * 33], s[1 * 33]); o.y = pkbf(s[2 * 33], s[3 * 33]); o.z = pkbf(s[4 * 33], s[5 * 33]); o.w = pkbf(s[6 * 33], s[7 * 33]);
        *(GAS v4u*)(J.WT + (size_t)(rowbase + n) * J.ldk + J.koff + k0 + 8 * c) = o; }
    LDS_WAIT(); asm volatile("" ::: "memory");
}
__device__ __forceinline__ CJ get_job(const Frame& F, int kind, int j, int layer, int ab, bf16* Wb) {
    CJ J; J.sc = nullptr; J.smode = 0; J.koff = 0; J.rmode = 0; J.roff = 0;
    if (kind == 0) {
        const float* wg = inptr(F, ab ? I_FBWG : I_FAWG) + (size_t)layer * D * FF; const float* wu = inptr(F, ab ? I_FBWU : I_FAWU) + (size_t)layer * D * FF; const float* wd = inptr(F, ab ? I_FBWD : I_FAWD) + (size_t)layer * D * FF;
        if (j < 2) { J.W = j == 0 ? wg : wu; J.K = D; J.N = FF; J.Npad = FF; J.WT = Wb + W_GU / 2; J.ldk = D; J.rmode = 1; J.roff = j == 0 ? 0 : 128; }
        else { J.W = wd; J.K = FF; J.N = D; J.Npad = D; J.WT = Wb + W_D / 2; J.ldk = FF; }
    } else if (kind == 1) {
        if (j < 12) {
            const int s = j >> 1, half = j & 1;
            J.W = inptr(F, s == 0 ? I_WR : (s == 1 ? I_WK : (s == 2 ? I_WV : (s == 3 ? I_W1 : (s == 4 ? I_A1 : I_G1)))));
            J.N = s < 3 ? 1024 : (s < 5 ? 64 : 160); J.Npad = s < 3 ? 1024 : (s < 5 ? 64 : 384);
            J.roff = s < 3 ? 1024 * s : (s == 3 ? 3072 : (s == 4 ? 3136 : 3200));
            const int mui = s == 0 ? 0 : (s == 1 ? 2 : (s == 2 ? 3 : (s == 3 ? 1 : (s == 4 ? 4 : 5))));
            J.sc = inptr(F, I_MU) + mui * D; J.smode = half ? 1 : 2; J.koff = half * D; J.K = D; J.ldk = KRW; J.WT = Wb + W_RW / 2;
        } else { J.W = inptr(F, I_WO); J.K = D; J.N = D; J.Npad = D; J.WT = Wb + W_O / 2; J.ldk = D; }
    } else {
        if (j == 0) { J.W = inptr(F, I_WIN); J.K = D; J.N = 3088; J.Npad = NIN; J.WT = Wb + W_IN / 2; J.ldk = D; }
        else { J.W = inptr(F, I_WOUT); J.K = D; J.N = D; J.Npad = D; J.WT = Wb + W_OUT / 2; J.ldk = D; }
    }
    return J;
}
__device__ __forceinline__ void convert_weights(const Frame& F, int kind, int layer, int ab, bf16* Wb) {
    LAS float* scr = (LAS float*)(F.lds + F.wave * 16384);
    const int gw = F.vcu * NWAVES + F.wave, NGW = F.G * NWAVES;
    const int njobs = kind == 0 ? 3 : (kind == 1 ? 13 : 2);
    int total = 0;
    for (int j = 0; j < njobs; ++j) { const CJ J = get_job(F, kind, j, layer, ab, Wb); total += cj_items(J); }
    for (int g = gw; g < total; g += NGW) {
        int r = g, j = 0; CJ J = get_job(F, kind, 0, layer, ab, Wb);
        while (r >= cj_items(J)) { r -= cj_items(J); ++j; J = get_job(F, kind, j, layer, ab, Wb); }
        conv_item(J, scr, r, F.lane);
    }
    if (kind == 1) {
        bf16* WT = Wb + W_L2 / 2; const float* w2 = inptr(F, I_W2); const float* a2 = inptr(F, I_A2); const float* g2 = inptr(F, I_G2);
        for (int idx = (F.vcu * NWAVES + F.wave) * 64 + F.lane; idx < 48 * NL2; idx += F.G * NWAVES * 64) {
            const int c = idx / NL2, n = idx % NL2, type = n >> 10, jj = n & 1023;
            const float* src = nullptr;
            if (type == 0 && c < 8) src = w2 + (size_t)(8 * c) * D + jj;
            else if (type == 1 && c >= 8 && c < 16) src = a2 + (size_t)(8 * (c - 8)) * D + jj;
            else if (type == 2 && c >= 16 && c < 36) src = g2 + (size_t)(8 * (c - 16)) * D + jj;
            float v[8];
#pragma unroll
            for (int e = 0; e < 8; ++e) v[e] = src ? src[(size_t)e * D] : 0.f;
            *(GAS v4u*)(WT + (size_t)n * KL2 + 8 * c) = pack8(v);
        }
    }
}

template <int MODE>
__device__ __forceinline__ void norm_rows(const Frame& F, const float* base_p, const float* base_s, int nslab, float coef, const float* slab, float* xr,
                                          const float* gain, bf16* dst, const float* shift_in, float* out) {
    const int gw = F.vcu * NWAVES + F.wave, NGW = F.G * NWAVES, lane = F.lane;
    f32x4 gv[4];
#pragma unroll
    for (int j = 0; j < 4; ++j) gv[j] = *(const f32x4*)(gain + 256 * j + 4 * lane);
    for (int m = gw; m < M; m += NGW) {
        const bool samp = m >= MP;
        const float* src = samp ? base_s + (size_t)(m - MP) * D : base_p + (size_t)m * D;
        f32x4 v[4];
#pragma unroll
        for (int j = 0; j < 4; ++j) v[j] = *(const f32x4*)(src + 256 * j + 4 * lane);
        if (samp && nslab > 0) {
            for (int s = 0; s < nslab; ++s) { const float* sp = slab + ((size_t)s * MS + (m - MP)) * D;
#pragma unroll
                for (int j = 0; j < 4; ++j) v[j] += *(const f32x4*)(sp + 256 * j + 4 * lane) * coef; }
            if (MODE != 2) {
#pragma unroll
                for (int j = 0; j < 4; ++j) *(f32x4*)(xr + (size_t)m * D + 256 * j + 4 * lane) = v[j]; }
        }
        float ss = 0.f;
#pragma unroll
        for (int j = 0; j < 4; ++j) ss += (v[j].x * v[j].x + v[j].y * v[j].y) + (v[j].z * v[j].z + v[j].w * v[j].w);
        const float r = 1.0f / sqrtf(wave_sum(ss) * (1.f / D) + NORM_EPS);
#pragma unroll
        for (int j = 0; j < 4; ++j) v[j] = v[j] * r * gv[j];
        if (MODE == 2) {
#pragma unroll
            for (int j = 0; j < 4; ++j) *(f32x4*)(out + O_Y + (size_t)m * D + 256 * j + 4 * lane) = v[j];
        } else if (MODE == 0) {
#pragma unroll
            for (int j = 0; j < 4; ++j) { const unsigned long long w = (unsigned long long)pkbf(v[j].x, v[j].y) | ((unsigned long long)pkbf(v[j].z, v[j].w) << 32);
                *(unsigned long long*)(dst + (size_t)m * D + 256 * j + 4 * lane) = w; }
        } else {
            int t, b; bool first, last;
            if (!samp) { t = m & (PT - 1); b = m >> 11; first = t == 0; last = t == PT - 1; } else { const int mm = m - MP; t = mm & 3; b = mm >> 2; first = t == 0; last = t == 3; }
#pragma unroll
            for (int j = 0; j < 4; ++j) { const unsigned long long w = (unsigned long long)pkbf(v[j].x, v[j].y) | ((unsigned long long)pkbf(v[j].z, v[j].w) << 32);
                *(unsigned long long*)(dst + (size_t)m * (2 * D) + 256 * j + 4 * lane) = w;
                if (!last) *(unsigned long long*)(dst + (size_t)(m + 1) * (2 * D) + D + 256 * j + 4 * lane) = w;
                else *(f32x4*)(out + (samp ? O_S_SHIFT : O_P_SHIFT) + (size_t)b * D + 256 * j + 4 * lane) = v[j];
                if (first) { unsigned long long z = 0ull;
                    if (samp) { const f32x4 s = *(const f32x4*)(shift_in + (size_t)b * D + 256 * j + 4 * lane); z = (unsigned long long)pkbf(s.x, s.y) | ((unsigned long long)pkbf(s.z, s.w) << 32); }
                    *(unsigned long long*)(dst + (size_t)m * (2 * D) + D + 256 * j + 4 * lane) = z; }
            }
        }
    }
}

constexpr int RW_KK = 0, RW_DD = 4096, RW_BB = 8192, RW_KP = 12288, RW_RR = 16384, RW_VV = 20480, RW_YY = 24576;
__device__ __forceinline__ void rwkv_chain(const Frame& F, int row0, int T, int h, const float* S0, float* ST,
                                           const bf16* Rb, const bf16* Kb, const bf16* Vb, const bf16* Db, const bf16* Ab, bf16* Gb,
                                           const float* k_k, const float* k_a, const float* r_k, const float* gn_w, const float* gn_b) {
    LAS float* L = (LAS float*)F.lds;
    const int tid = F.tid, lane = F.lane, w = F.wave;
    const int cg = tid & 7, tt = tid >> 3;
    const int srow = 8 * w + (lane >> 3);
    float S[8];
    if (S0) { const f32x4 a = *(const f32x4*)(S0 + srow * 64 + 8 * cg), b = *(const f32x4*)(S0 + srow * 64 + 8 * cg + 4);
        S[0] = a.x; S[1] = a.y; S[2] = a.z; S[3] = a.w; S[4] = b.x; S[5] = b.y; S[6] = b.z; S[7] = b.w; }
    else {
#pragma unroll
        for (int j = 0; j < 8; ++j) S[j] = 0.f; }
    const int ch = h * 64 + 8 * cg;
    float ckk[8], cka[8], crk[8], cgw[8], cgb[8];
#pragma unroll
    for (int j = 0; j < 8; ++j) { ckk[j] = k_k[ch + j]; cka[j] = k_a[ch + j]; crk[j] = r_k[ch + j]; cgw[j] = gn_w[ch + j]; cgb[j] = gn_b[ch + j]; }
    const int nch = (T + 63) >> 6;
    v4u pr = {0, 0, 0, 0}, pk = pr, pv = pr, pd = pr, pa = pr, pg = pr;
    { const int nt0 = T < 64 ? T : 64;
      if (tt < nt0) { const size_t off = (size_t)(row0 + tt) * D + ch;
          pr = *(const v4u*)(Rb + off); pk = *(const v4u*)(Kb + off); pv = *(const v4u*)(Vb + off); pd = *(const v4u*)(Db + off); pa = *(const v4u*)(Ab + off); pg = *(const v4u*)(Gb + off); } }
    float bon = 0.f, vv[8], gg[8];
    for (int c = 0; c < nch; ++c) {
        const int nt = (T - 64 * c) < 64 ? (T - 64 * c) : 64;
        const bool valid = tt < nt;
        {
            float r8[8], k8[8], d8[8], a8[8];
            unpack8(pr, r8); unpack8(pk, k8); unpack8(pv, vv); unpack8(pd, d8); unpack8(pa, a8); unpack8(pg, gg);
            float kk[8], ss = 0.f;
#pragma unroll
            for (int j = 0; j < 8; ++j) { kk[j] = k8[j] * ckk[j]; ss += kk[j] * kk[j]; }
            ss = red8(ss);
            const float inv = 1.f / fmaxf(sqrtf(ss), 1e-12f);
            float kp[8], bsum = 0.f;
#pragma unroll
            for (int j = 0; j < 8; ++j) { kk[j] *= inv; kp[j] = k8[j] * (1.f + (a8[j] - 1.f) * cka[j]); bsum += r8[j] * kp[j] * crk[j]; }
            bon = red8(bsum);
            if (valid) {
                LAS float* p = L + tt * 64 + 8 * cg;
                *(LAS f32x4*)(p + RW_KK) = (f32x4){-kk[0], -kk[1], -kk[2], -kk[3]}; *(LAS f32x4*)(p + RW_KK + 4) = (f32x4){-kk[4], -kk[5], -kk[6], -kk[7]};
                *(LAS f32x4*)(p + RW_DD) = (f32x4){1.f - d8[0], 1.f - d8[1], 1.f - d8[2], 1.f - d8[3]}; *(LAS f32x4*)(p + RW_DD + 4) = (f32x4){1.f - d8[4], 1.f - d8[5], 1.f - d8[6], 1.f - d8[7]};
                *(LAS f32x4*)(p + RW_BB) = (f32x4){kk[0] * a8[0], kk[1] * a8[1], kk[2] * a8[2], kk[3] * a8[3]}; *(LAS f32x4*)(p + RW_BB + 4) = (f32x4){kk[4] * a8[4], kk[5] * a8[5], kk[6] * a8[6], kk[7] * a8[7]};
                *(LAS f32x4*)(p + RW_KP) = (f32x4){kp[0], kp[1], kp[2], kp[3]}; *(LAS f32x4*)(p + RW_KP + 4) = (f32x4){kp[4], kp[5], kp[6], kp[7]};
                *(LAS f32x4*)(p + RW_RR) = (f32x4){r8[0], r8[1], r8[2], r8[3]}; *(LAS f32x4*)(p + RW_RR + 4) = (f32x4){r8[4], r8[5], r8[6], r8[7]};
                *(LAS f32x4*)(p + RW_VV) = (f32x4){vv[0], vv[1], vv[2], vv[3]}; *(LAS f32x4*)(p + RW_VV + 4) = (f32x4){vv[4], vv[5], vv[6], vv[7]};
            }
        }
        __syncthreads();
        if (c + 1 < nch) { const int nt1 = (T - 64 * (c + 1)) < 64 ? (T - 64 * (c + 1)) : 64;
            if (tt < nt1) { const size_t off = (size_t)(row0 + 64 * (c + 1) + tt) * D + ch;
                pr = *(const v4u*)(Rb + off); pk = *(const v4u*)(Kb + off); pv = *(const v4u*)(Vb + off); pd = *(const v4u*)(Db + off); pa = *(const v4u*)(Ab + off); pg = *(const v4u*)(Gb + off); } }
#pragma unroll 4
        for (int t = 0; t < nt; ++t) {
            const LAS float* p = L + t * 64 + 8 * cg;
            const f32x4 n0 = *(const LAS f32x4*)(p + RW_KK), n1 = *(const LAS f32x4*)(p + RW_KK + 4);
            const f32x4 d0 = *(const LAS f32x4*)(p + RW_DD), d1 = *(const LAS f32x4*)(p + RW_DD + 4);
            const f32x4 b0 = *(const LAS f32x4*)(p + RW_BB), b1 = *(const LAS f32x4*)(p + RW_BB + 4);
            const f32x4 q0 = *(const LAS f32x4*)(p + RW_KP), q1 = *(const LAS f32x4*)(p + RW_KP + 4);
            const f32x4 r0 = *(const LAS f32x4*)(p + RW_RR), r1 = *(const LAS f32x4*)(p + RW_RR + 4);
            const float vr = L[RW_VV + t * 64 + srow];
            float sa = (S[0] * n0.x + S[1] * n0.y) + (S[2] * n0.z + S[3] * n0.w) + (S[4] * n1.x + S[5] * n1.y) + (S[6] * n1.z + S[7] * n1.w);
            sa = red8(sa);
            S[0] = S[0] * d0.x + (sa * b0.x + vr * q0.x); S[1] = S[1] * d0.y + (sa * b0.y + vr * q0.y); S[2] = S[2] * d0.z + (sa * b0.z + vr * q0.z); S[3] = S[3] * d0.w + (sa * b0.w + vr * q0.w);
            S[4] = S[4] * d1.x + (sa * b1.x + vr * q1.x); S[5] = S[5] * d1.y + (sa * b1.y + vr * q1.y); S[6] = S[6] * d1.z + (sa * b1.z + vr * q1.z); S[7] = S[7] * d1.w + (sa * b1.w + vr * q1.w);
            float y = (S[0] * r0.x + S[1] * r0.y) + (S[2] * r0.z + S[3] * r0.w) + (S[4] * r1.x + S[5] * r1.y) + (S[6] * r1.z + S[7] * r1.w);
            y = red8(y);
            if (cg == 0) L[RW_YY + t * 64 + srow] = y;
        }
        __syncthreads();
        {
            f32x4 y0 = {0.f, 0.f, 0.f, 0.f}, y1 = y0;
            if (valid) { y0 = *(const LAS f32x4*)(L + RW_YY + tt * 64 + 8 * cg); y1 = *(const LAS f32x4*)(L + RW_YY + tt * 64 + 8 * cg + 4); }
            float yy[8] = {y0.x, y0.y, y0.z, y0.w, y1.x, y1.y, y1.z, y1.w};
            float s1 = 0.f;
#pragma unroll
            for (int j = 0; j < 8; ++j) s1 += yy[j];
            const float mean = red8(s1) * (1.f / 64.f);
            float s2 = 0.f;
#pragma unroll
            for (int j = 0; j < 8; ++j) { yy[j] -= mean; s2 += yy[j] * yy[j]; }
            const float rstd = 1.0f / sqrtf(red8(s2) * (1.f / 64.f) + GN_EPS);
            float o[8];
#pragma unroll
            for (int j = 0; j < 8; ++j) o[j] = ((yy[j] * rstd) * cgw[j] + cgb[j] + bon * vv[j]) * gg[j];
            if (valid) *(v4u*)(Gb + (size_t)(row0 + 64 * c + tt) * D + ch) = pack8(o);
        }
    }
    *(f32x4*)(ST + srow * 64 + 8 * cg) = (f32x4){S[0], S[1], S[2], S[3]}; *(f32x4*)(ST + srow * 64 + 8 * cg + 4) = (f32x4){S[4], S[5], S[6], S[7]};
    __syncthreads();
}

constexpr int PBY = 144;
constexpr int ML_Q = 0, ML_K = 9216, ML_KT = 18432, ML_VT = 27648, ML_S = 46080, ML_C = 55296, ML_F = 73728;
constexpr int MF_N = 0, MF_BM = 64, MF_AV = 128, MF_WI = 192, MF_WS = 256, MF_EI = 320, MF_QN = 384, MF_RS = 448, MF_HS = 576, MF_SC = 704, MF_CW = 712;
typedef __attribute__((address_space(3))) unsigned short lds_u16;
#define MFMA16(a, b, c) __builtin_amdgcn_mfma_f32_16x16x32_bf16((a), (b), (c), 0, 0, 0)
__device__ __forceinline__ void mlstm_prompt_chain(const Frame& F, int b, int hh, const bf16* QKR, const bf16* VVb, const bf16* OOb, const float* IFb, bf16* HOb,
                                                   const float* conv_w, const float* conv_b, const float* norm_w, float* out) {
    LAS unsigned char* lds = F.lds; LAS float* Fl = (LAS float*)(lds + ML_F);
    const int tid = F.tid, lane = F.lane, w = F.wave, fr = lane & 15, fq = lane >> 4;
    for (int i = tid; i < 128 * 72; i += 512) ((lds_u16*)(lds + ML_C))[i] = 0;
    if (tid < 64) Fl[MF_N + tid] = 0.f;
    for (int i = tid; i < 640; i += 512) { const int j = i >> 7, c = i & 127, gc = c < 64 ? hh * 64 + c : 512 + hh * 64 + (c - 64); Fl[MF_CW + i] = j < 4 ? conv_w[j * D + gc] : conv_b[gc]; }
    f32x4 Cacc[4];
#pragma unroll
    for (int k = 0; k < 4; ++k) Cacc[k] = (f32x4){0.f, 0.f, 0.f, 0.f};
    float m_prev = 0.f;
    __syncthreads();
    const int g = tid & 15;
    const int qkcol = g < 8 ? hh * 64 + 8 * g : 512 + hh * 64 + 8 * (g - 8);
    for (int c = 0; c < PT / 64; ++c) {
        const int rowc = b * PT + 64 * c;
        if (w == 0) {
            const float li = IFb[(size_t)(rowc + lane) * 16 + hh], lf = IFb[(size_t)(rowc + lane) * 16 + 8 + hh];
            float bc = lf;
#pragma unroll
            for (int o = 1; o < 64; o <<= 1) { const float x = __shfl_up(bc, o); if (lane >= o) bc += x; }
            const float av = li - bc; float pm = av;
#pragma unroll
            for (int o = 1; o < 64; o <<= 1) { const float x = __shfl_up(pm, o); if (lane >= o) pm = fmaxf(pm, x); }
            const float mt = fmaxf(bc + m_prev, bc + pm);
            const float m_new = __shfl(mt, 63), b63 = __shfl(bc, 63);
            Fl[MF_BM + lane] = bc - mt; Fl[MF_AV + lane] = av; Fl[MF_WI + lane] = __expf(bc + m_prev - mt); Fl[MF_WS + lane] = __expf(b63 + av - m_new); Fl[MF_EI + lane] = __expf(-mt);
            if (lane == 0) Fl[MF_SC] = __expf(b63 + m_prev - m_new);
            m_prev = m_new;
        }
        float kreg[2][8];
#pragma unroll
        for (int i = 0; i < 2; ++i) {
            const int t = (tid >> 4) + 32 * i;
            float x[4][8];
#pragma unroll
            for (int j = 0; j < 4; ++j) { const int tok = 64 * c + t - 3 + j;
                if (tok >= 0) { const v4u wv = *(const v4u*)(QKR + (size_t)(b * PT + tok) * D + qkcol); unpack8(wv, x[j]); }
                else {
#pragma unroll
                    for (int e = 0; e < 8; ++e) x[j][e] = 0.f; } }
            float val[8];
#pragma unroll
            for (int e = 0; e < 8; ++e) { float a = Fl[MF_CW + 4 * 128 + 8 * g + e];
#pragma unroll
                for (int j = 0; j < 4; ++j) a += Fl[MF_CW + j * 128 + 8 * g + e] * x[j][e];
                val[e] = siluf_(a); }
            if (g < 8) {
#pragma unroll
                for (int e = 0; e < 8; ++e) val[e] *= 0.125f;
                *(LAS v4u*)(lds + ML_Q + t * PBY + 16 * g) = pack8(val);
            } else { *(LAS v4u*)(lds + ML_K + t * PBY + 16 * (g - 8)) = pack8(val); }
#pragma unroll
            for (int e = 0; e < 8; ++e) kreg[i][e] = val[e];
            const v4u vw = *(const v4u*)(VVb + (size_t)(rowc + t) * D + hh * 128 + 8 * g);
            lds_u16* vt = (lds_u16*)(lds + ML_VT) + (8 * g) * 72 + t;
            vt[0 * 72] = (unsigned short)(vw.x & 0xffffu); vt[1 * 72] = (unsigned short)(vw.x >> 16); vt[2 * 72] = (unsigned short)(vw.y & 0xffffu); vt[3 * 72] = (unsigned short)(vw.y >> 16);
            vt[4 * 72] = (unsigned short)(vw.z & 0xffffu); vt[5 * 72] = (unsigned short)(vw.z >> 16); vt[6 * 72] = (unsigned short)(vw.w & 0xffffu); vt[7 * 72] = (unsigned short)(vw.w >> 16);
        }
        __syncthreads();
        if (g >= 8) {
#pragma unroll
            for (int i = 0; i < 2; ++i) { const int t = (tid >> 4) + 32 * i; const float wsv = Fl[MF_WS + t];
                lds_u16* kt = (lds_u16*)(lds + ML_KT) + (8 * (g - 8)) * 72 + t;
#pragma unroll
                for (int e = 0; e < 8; ++e) kt[e * 72] = f2bf1(kreg[i][e] * wsv); }
        }
        { const int tq = tid >> 3, p = tid & 7; float q8[8]; unpack8(*(const LAS v4u*)(lds + ML_Q + tq * PBY + 16 * p), q8);
          float dsum = 0.f;
#pragma unroll
          for (int e = 0; e < 8; ++e) dsum += q8[e] * Fl[MF_N + 8 * p + e];
          dsum = red8(dsum); if (p == 0) Fl[MF_QN + tq] = dsum; }
        { const int ti = w >> 1; float rs[4] = {0.f, 0.f, 0.f, 0.f};
#pragma unroll
          for (int jj = 0; jj < 2; ++jj) { const int sj = 2 * (w & 1) + jj; f32x4 acc = {0.f, 0.f, 0.f, 0.f};
#pragma unroll
              for (int ks = 0; ks < 2; ++ks) { const bf16x8 a = *(const LAS bf16x8*)(lds + ML_Q + (16 * ti + fr) * PBY + ks * 64 + fq * 16), bb = *(const LAS bf16x8*)(lds + ML_K + (16 * sj + fr) * PBY + ks * 64 + fq * 16);
                  acc = MFMA16(a, bb, acc); }
              const int s = 16 * sj + fr; const float as = Fl[MF_AV + s];
#pragma unroll
              for (int r = 0; r < 4; ++r) { const int t = 16 * ti + 4 * fq + r; const float val = s <= t ? acc[r] * __expf(Fl[MF_BM + t] + as) : 0.f;
                  ((lds_u16*)(lds + ML_S))[t * 72 + s] = f2bf1(val); rs[r] += val; } }
#pragma unroll
          for (int r = 0; r < 4; ++r) { const float x = red16(rs[r]); if (fr == 0) Fl[MF_RS + (16 * ti + 4 * fq + r) * 2 + (w & 1)] = x; } }
        __syncthreads();
        float hv[4][4];
        { const int ti = w & 3; float wi[4], den[4], ei[4], hq[4];
#pragma unroll
          for (int r = 0; r < 4; ++r) { const int t = 16 * ti + 4 * fq + r; wi[r] = Fl[MF_WI + t]; ei[r] = Fl[MF_EI + t]; den[r] = wi[r] * Fl[MF_QN + t] + Fl[MF_RS + 2 * t] + Fl[MF_RS + 2 * t + 1]; hq[r] = 0.f; }
#pragma unroll
          for (int i = 0; i < 4; ++i) { const int vt = 4 * (w >> 2) + i; f32x4 accA = {0.f, 0.f, 0.f, 0.f}, accB = accA;
#pragma unroll
              for (int ks = 0; ks < 2; ++ks) {
                  const bf16x8 aq = *(const LAS bf16x8*)(lds + ML_Q + (16 * ti + fr) * PBY + ks * 64 + fq * 16), bc = *(const LAS bf16x8*)(lds + ML_C + (16 * vt + fr) * PBY + ks * 64 + fq * 16);
                  accA = MFMA16(aq, bc, accA);
                  const bf16x8 as = *(const LAS bf16x8*)(lds + ML_S + (16 * ti + fr) * PBY + ks * 64 + fq * 16), bv = *(const LAS bf16x8*)(lds + ML_VT + (16 * vt + fr) * PBY + ks * 64 + fq * 16);
                  accB = MFMA16(as, bv, accB); }
#pragma unroll
              for (int r = 0; r < 4; ++r) { const float num = wi[r] * accA[r] + accB[r]; const float hh_ = num / fmaxf(fabsf(den[r]), ei[r]); hv[i][r] = hh_; hq[r] += hh_ * hh_; } }
#pragma unroll
          for (int r = 0; r < 4; ++r) { const float x = red16(hq[r]); if (fr == 0) Fl[MF_HS + (16 * ti + 4 * fq + r) * 2 + (w >> 2)] = x; } }
        __syncthreads();
        { const int ti = w & 3;
#pragma unroll
          for (int r = 0; r < 4; ++r) { const int t = 16 * ti + 4 * fq + r; const float sc = 1.0f / sqrtf((Fl[MF_HS + 2 * t] + Fl[MF_HS + 2 * t + 1]) * (1.f / 128.f) + NORM_EPS);
#pragma unroll
              for (int i = 0; i < 4; ++i) { const int gcol = hh * 128 + 16 * (4 * (w >> 2) + i) + fr; const size_t off = (size_t)(rowc + t) * D + gcol;
                  HOb[off] = f2bf1(hv[i][r] * sc * norm_w[gcol] * bf1(OOb[off])); } } }
        { const float wst = Fl[MF_SC];
#pragma unroll
          for (int kt = 0; kt < 4; ++kt) { Cacc[kt] = Cacc[kt] * wst;
#pragma unroll
              for (int ks = 0; ks < 2; ++ks) { const bf16x8 a = *(const LAS bf16x8*)(lds + ML_VT + (16 * w + fr) * PBY + ks * 64 + fq * 16), bb = *(const LAS bf16x8*)(lds + ML_KT + (16 * kt + fr) * PBY + ks * 64 + fq * 16);
                  Cacc[kt] = MFMA16(a, bb, Cacc[kt]); }
#pragma unroll
              for (int r = 0; r < 4; ++r) ((lds_u16*)(lds + ML_C))[(16 * w + 4 * fq + r) * 72 + 16 * kt + fr] = f2bf1(Cacc[kt][r]); }
          if (w == 0) { float sum = 0.f;
#pragma unroll
              for (int q = 0; q < 8; ++q) { float k8[8]; unpack8(*(const LAS v4u*)(lds + ML_KT + lane * PBY + 16 * q), k8);
#pragma unroll
                  for (int e = 0; e < 8; ++e) sum += k8[e]; }
              Fl[MF_N + lane] = wst * Fl[MF_N + lane] + sum; } }
        __syncthreads();
    }
#pragma unroll
    for (int kt = 0; kt < 4; ++kt)
#pragma unroll
        for (int r = 0; r < 4; ++r) out[O_P_C + ((size_t)(b * 8 + hh) * 128 + 16 * w + 4 * fq + r) * 64 + 16 * kt + fr] = Cacc[kt][r];
    if (w == 0) { out[O_P_N + (size_t)(b * 8 + hh) * 64 + lane] = Fl[MF_N + lane]; if (lane == 0) out[O_P_M + b * 8 + hh] = m_prev; }
    if (tid < 384) { const int j = tid >> 7, c = tid & 127, gc = c < 64 ? hh * 64 + c : 512 + hh * 64 + (c - 64);
        out[O_P_CONV + (size_t)(b * 3 + j) * D + gc] = bf1(QKR[(size_t)(b * PT + PT - 3 + j) * D + gc]); }
    __syncthreads();
}
__device__ __forceinline__ void mlstm_sample_item(const Frame& F, int b, int hh, const bf16* QKR, const bf16* VVb, const bf16* OOb, const float* IFb, bf16* HOb,
                                                  const float* conv_w, const float* conv_b, const float* norm_w, const float* C0, const float* n0, const float* m0p, const float* conv0, float* out) {
    LAS float* L = (LAS float*)F.lds;
    constexpr int LQ = 0, LK = 256, LV = 512, LS = 1024, LQN = 1040, LHS = 1048;
    const int tid = F.tid, lane = F.lane, w = F.wave, row0 = MP + 4 * b;
    float li[4], lf[4];
#pragma unroll
    for (int t = 0; t < 4; ++t) { li[t] = IFb[(size_t)(row0 + t) * 16 + hh]; lf[t] = IFb[(size_t)(row0 + t) * 16 + 8 + hh]; }
    const float m0 = m0p[b * 8 + hh];
    float bc[4], av[4], mt[4], wi[4], wsv[4], ei[4], bm[4];
    { float run = 0.f, pm = -3.0e38f;
#pragma unroll
      for (int t = 0; t < 4; ++t) { run += lf[t]; bc[t] = run; av[t] = li[t] - run; pm = fmaxf(pm, av[t]); mt[t] = fmaxf(run + m0, run + pm); } }
    const float m_new = mt[3], wst = __expf(bc[3] + m0 - m_new);
#pragma unroll
    for (int t = 0; t < 4; ++t) { wi[t] = __expf(bc[t] + m0 - mt[t]); wsv[t] = __expf(bc[3] + av[t] - m_new); ei[t] = __expf(-mt[t]); bm[t] = bc[t] - mt[t]; }
    { const int t = tid >> 7, c = tid & 127, gc = c < 64 ? hh * 64 + c : 512 + hh * 64 + (c - 64);
      float x[4];
#pragma unroll
      for (int j = 0; j < 4; ++j) { const int p = t + j; x[j] = p < 3 ? conv0[(size_t)(b * 3 + p) * D + gc] : bf1(QKR[(size_t)(row0 + p - 3) * D + gc]); }
      float a = conv_b[gc];
#pragma unroll
      for (int j = 0; j < 4; ++j) a += conv_w[j * D + gc] * x[j];
      const float val = siluf_(a);
      if (c < 64) L[LQ + t * 64 + c] = val * 0.125f; else L[LK + t * 64 + (c - 64)] = val;
      if (t >= 1) out[O_S_CONV + (size_t)(b * 3 + t - 1) * D + gc] = x[3];
      L[LV + t * 128 + c] = bf1(VVb[(size_t)(row0 + t) * D + hh * 128 + c]); }
    __syncthreads();
    if (w == 0) { const int pair = lane >> 2, t = pair >> 2, s = pair & 3, part = lane & 3; float dsum = 0.f;
#pragma unroll
        for (int e = 0; e < 16; ++e) dsum += L[LQ + t * 64 + 16 * part + e] * L[LK + s * 64 + 16 * part + e];
        dsum = red4(dsum);
        const float bmt = t == 0 ? bm[0] : (t == 1 ? bm[1] : (t == 2 ? bm[2] : bm[3])), avs = s == 0 ? av[0] : (s == 1 ? av[1] : (s == 2 ? av[2] : av[3]));
        if (part == 0) L[LS + pair] = s <= t ? dsum * __expf(bmt + avs) : 0.f; }
    if (w == 1) { const int t = lane >> 4, part = lane & 15; float dsum = 0.f;
#pragma unroll
        for (int e = 0; e < 4; ++e) dsum += L[LQ + t * 64 + 4 * part + e] * n0[(size_t)(b * 8 + hh) * 64 + 4 * part + e];
        dsum = red16(dsum); if (part == 0) L[LQN + t] = dsum; }
    __syncthreads();
    const int v = tid >> 2, kq = tid & 3;
    float hvv[4];
    { const size_t coff = ((size_t)(b * 8 + hh) * 128 + v) * 64 + 16 * kq;
      float c0[16];
#pragma unroll
      for (int e4 = 0; e4 < 4; ++e4) { const f32x4 x = *(const f32x4*)(C0 + coff + 4 * e4); c0[4 * e4] = x.x; c0[4 * e4 + 1] = x.y; c0[4 * e4 + 2] = x.z; c0[4 * e4 + 3] = x.w; }
#pragma unroll
      for (int t = 0; t < 4; ++t) { float part = 0.f;
#pragma unroll
          for (int e = 0; e < 16; ++e) part += c0[e] * L[LQ + t * 64 + 16 * kq + e];
          const float inter = red4(part);
          float num = wi[t] * inter, den = wi[t] * L[LQN + t];
#pragma unroll
          for (int s = 0; s < 4; ++s) { const float sm = L[LS + t * 4 + s]; num += sm * L[LV + s * 128 + v]; den += sm; }
          hvv[t] = num / fmaxf(fabsf(den), ei[t]); }
#pragma unroll
      for (int t = 0; t < 4; ++t) { const float x = wave_sum(kq == 0 ? hvv[t] * hvv[t] : 0.f); if (lane == 0) L[LHS + w * 4 + t] = x; }
      float cn[16];
#pragma unroll
      for (int e = 0; e < 16; ++e) { float a = wst * c0[e];
#pragma unroll
          for (int s = 0; s < 4; ++s) a += wsv[s] * L[LV + s * 128 + v] * L[LK + s * 64 + 16 * kq + e];
          cn[e] = a; }
#pragma unroll
      for (int e4 = 0; e4 < 4; ++e4) *(f32x4*)(out + O_S_C + coff + 4 * e4) = (f32x4){cn[4 * e4], cn[4 * e4 + 1], cn[4 * e4 + 2], cn[4 * e4 + 3]}; }
    __syncthreads();
    if (kq == 0) {
#pragma unroll
        for (int t = 0; t < 4; ++t) { float tot = 0.f;
#pragma unroll
            for (int ww = 0; ww < 8; ++ww) tot += L[LHS + ww * 4 + t];
            const float sc = 1.0f / sqrtf(tot * (1.f / 128.f) + NORM_EPS); const size_t off = (size_t)(row0 + t) * D + hh * 128 + v;
            HOb[off] = f2bf1(hvv[t] * sc * norm_w[hh * 128 + v] * bf1(OOb[off])); } }
    if (tid < 64) { float a = wst * n0[(size_t)(b * 8 + hh) * 64 + tid];
#pragma unroll
        for (int s = 0; s < 4; ++s) a += wsv[s] * L[LK + s * 64 + tid];
        out[O_S_N + (size_t)(b * 8 + hh) * 64 + tid] = a; }
    if (tid == 0) out[O_S_M + b * 8 + hh] = m_new;
    __syncthreads();
}

#ifndef MK_N_LAUNCHES
#define MK_N_LAUNCHES 1
#endif
constexpr int N_PHASES = 22;
#ifndef EN_MASK
#define EN_MASK 0xff
#endif
constexpr bool EN_NORM = EN_MASK & 1, EN_UP = EN_MASK & 2, EN_RES = EN_MASK & 4, EN_RW = EN_MASK & 8, EN_L2 = EN_MASK & 16, EN_SCAN = EN_MASK & 32, EN_IN = EN_MASK & 64, EN_ML = EN_MASK & 128;
struct Args { const float* in[N_IN]; float* out; unsigned char* ws; int ph_lo, ph_hi; };
__global__ void __launch_bounds__(NWAVES * 64, 2) mega_fwd(Args args) {
    extern __shared__ __attribute__((aligned(16))) unsigned char lds_raw[];
    { const int t0 = threadIdx.x;
      for (int u = t0; u < (LDS_BYTES - LDSCTL_OFF) / 4; u += NWAVES * 64) ((LAS unsigned*)((LAS unsigned char*)lds_raw + LDSCTL_OFF))[u] = 0u; }
    __syncthreads();
    { const int t0 = threadIdx.x; if (t0 < N_IN) ((LAS unsigned long long*)((LAS unsigned char*)lds_raw + TAB_OFF))[t0] = (unsigned long long)args.in[t0]; }
    __syncthreads();
    XcdBarrier bar; bar.bar = (unsigned*)((gu32*)(args.ws + WS_CTL) + CW_BAR); bar.x = 0; bar.st = nullptr;
    if (args.ph_hi - args.ph_lo > 1) bar = xcd_barrier_post((unsigned*)((gu32*)(args.ws + WS_CTL) + CW_BAR), (volatile LAS unsigned*)((LAS unsigned char*)lds_raw + MISC_OFF) + 8);
    for (int ph = args.ph_lo; ph < args.ph_hi; ++ph) {
        int tid_ = threadIdx.x; asm volatile("" : "+v"(tid_));
        unsigned char* ws = args.ws; float* out = args.out; asm volatile("" : "+s"(ws), "+s"(out));
        Frame F;
        F.lds = (LAS unsigned char*)lds_raw;
        F.MISC = (volatile LAS unsigned*)(F.lds + MISC_OFF);
        F.tid = tid_; F.lane = F.tid & 63; F.wave = __builtin_amdgcn_readfirstlane(F.tid >> 6);
        F.G = gridDim.x; { const int bx = blockIdx.x; F.vcu = (F.G % 8 == 0) ? (bx % 8) * (F.G / 8) + bx / 8 : bx; }
        F.ctl = (gu32*)(ws + WS_CTL); F.tab = (volatile LAS unsigned long long*)(F.lds + TAB_OFF);
        bf16* Wb = (bf16*)(ws + WS_W); float* XR = (float*)(ws + WS_XR); unsigned char* big = ws + WS_BIG;
        bf16* Hb = (bf16*)(big + B_H); bf16* XN = (bf16*)(big + B_XN); float* SLAB = (float*)(big + B_SLAB);
        bf16* ACAT = (bf16*)(big + B_ACAT); bf16* Rb = (bf16*)(big + B_R); bf16* Kb = (bf16*)(big + B_K); bf16* Vb = (bf16*)(big + B_V); bf16* DECb = (bf16*)(big + B_DEC); bf16* AAb = (bf16*)(big + B_AA);
        bf16* QKR = (bf16*)(big + B_QKR); bf16* VVb = (bf16*)(big + B_VV); bf16* HOb = (bf16*)(big + B_HO); bf16* OOb = (bf16*)(big + B_OO); float* IFb = (float*)(big + B_IF);
        bf16* GGb = (bf16*)((unsigned char*)out + OS_GG); bf16* LORA = (bf16*)((unsigned char*)out + OS_LORA);
        const int c_id = (int)blockIdx.x;
        if (EN_NORM && (ph == 0 || ph == 3 || ph == 8 || ph == 11 || ph == 14 || ph == 18 || ph == 21)) {
            int kind = 0, layer = 0, ab = 0, nslab = 0; float coef = 0.5f; const float* gain = nullptr;
            if (ph == 0) { kind = 0; layer = 0; ab = 0; gain = inptr(F, I_NFA); nslab = 0; }
            else if (ph == 3) { kind = 1; gain = inptr(F, I_NMIX); nslab = 11; }
            else if (ph == 8) { kind = 0; layer = 0; ab = 1; gain = inptr(F, I_NFB); nslab = 4; coef = 1.f; }
            else if (ph == 11) { kind = 0; layer = 1; ab = 0; gain = inptr(F, I_NFA) + D; nslab = 11; }
            else if (ph == 14) { kind = 2; gain = inptr(F, I_NMIX) + D; nslab = 11; }
            else if (ph == 18) { kind = 0; layer = 1; ab = 1; gain = inptr(F, I_NFB) + D; nslab = 4; coef = 1.f; }
            else { kind = -1; gain = inptr(F, I_NFIN); nslab = 11; }
            if (kind >= 0) convert_weights(F, kind, layer, ab, Wb);
            const float* base_p = ph == 0 ? inptr(F, I_XP) : XR; const float* base_s = (ph == 0 || ph == 3) ? inptr(F, I_XS) : XR + (size_t)MP * D;
            if (ph == 3) norm_rows<1>(F, base_p, base_s, nslab, coef, SLAB, XR, gain, ACAT, inptr(F, I_RSHIFT), out);
            else if (ph == 21) norm_rows<2>(F, base_p, base_s, nslab, coef, SLAB, XR, gain, nullptr, nullptr, out);
            else norm_rows<0>(F, base_p, base_s, nslab, coef, SLAB, XR, gain, XN, nullptr, out);
        } else if (EN_UP && (ph == 1 || ph == 9 || ph == 12 || ph == 19)) {
            pg8::Gemm g{XN, Wb + W_GU / 2, M, 2 * FF, D}; pg8::UnitOrder S; S.init(M / 256, 2 * FF / 256, D, F.G, c_id, 0);
            EpiSwiglu E{Hb};
            pg8::gemm_phase<EpiSwiglu, pg8::UnitOrder, true, true>(F.lds, g, S, E, F.tid);
        } else if (EN_RES && (ph == 2 || ph == 7 || ph == 10 || ph == 13 || ph == 17 || ph == 20)) {
            const bf16* A = Hb; const bf16* Bt = Wb + W_D / 2; int K = FF; float coef = 0.5f; const float* base = XR;
            if (ph == 2) base = inptr(F, I_XP);
            if (ph == 7) { A = GGb; Bt = Wb + W_O / 2; K = D; coef = 1.f; }
            if (ph == 17) { A = HOb; Bt = Wb + W_OUT / 2; K = D; coef = 1.f; }
            pg8::Gemm g{A, Bt, M, D, K}; pg8::UnitOrder S; S.init(MP / 256, D / 256, K, F.G, c_id, K / 256);
            EpiRes E{base, XR, SLAB, coef};
            pg8::gemm_phase<EpiRes, pg8::UnitOrder, true, true>(F.lds, g, S, E, F.tid);
        } else if (EN_RW && ph == 4) {
            pg8::Gemm g{ACAT, Wb + W_RW / 2, M, NRW, KRW}; pg8::UnitOrder S; S.init(M / 256, NRW / 256, KRW, F.G, c_id, 0);
            EpiRw E{Rb, Kb, Vb, LORA};
            pg8::gemm_phase<EpiRw, pg8::UnitOrder, true, true>(F.lds, g, S, E, F.tid);
        } else if (EN_L2 && ph == 5) {
            pg8::Gemm g{LORA, Wb + W_L2 / 2, M, NL2, KL2}; pg8::UnitOrder S; S.init(M / 256, NL2 / 256, KL2, F.G, c_id, 0);
            EpiL2 E{DECb, AAb, GGb, inptr(F, I_W0), inptr(F, I_A0)};
            pg8::gemm_phase<EpiL2, pg8::UnitOrder, true, true>(F.lds, g, S, E, F.tid);
        } else if (EN_SCAN && ph == 6) {
            const int Hh = F.G >= 256 ? 128 : (F.G / 2 > 0 ? F.G / 2 : 1);
            if (F.vcu < Hh) {
                for (int i = F.vcu; i < PB * 16; i += Hh) { const int b = i >> 4, h = i & 15;
                    rwkv_chain(F, b * PT, PT, h, nullptr, out + O_P_S + (size_t)i * 4096, Rb, Kb, Vb, DECb, AAb, GGb, inptr(F, I_KK), inptr(F, I_KA), inptr(F, I_RK), inptr(F, I_GNW), inptr(F, I_GNB)); }
            }
            if (F.vcu >= Hh || F.G == 1) {
                const int st = F.G == 1 ? 1 : F.G - Hh;
                for (int i = F.G == 1 ? 0 : F.vcu - Hh; i < SB * 16; i += st) { const int b = i >> 4, h = i & 15;
                    rwkv_chain(F, MP + b * STK, STK, h, inptr(F, I_RS) + (size_t)i * 4096, out + O_S_S + (size_t)i * 4096, Rb, Kb, Vb, DECb, AAb, GGb, inptr(F, I_KK), inptr(F, I_KA), inptr(F, I_RK), inptr(F, I_GNW), inptr(F, I_GNB)); }
            }
        } else if (EN_IN && ph == 15) {
            pg8::Gemm g{XN, Wb + W_IN / 2, M, NIN, D}; pg8::UnitOrder S; S.init(M / 256, NIN / 256, D, F.G, c_id, 0);
            EpiIn E{QKR, VVb, OOb, IFb, inptr(F, I_BIF)};
            pg8::gemm_phase<EpiIn, pg8::UnitOrder, true, true>(F.lds, g, S, E, F.tid);
        } else if (EN_ML && ph == 16) {
            const int Hh = F.G >= 128 ? 64 : (F.G / 2 > 0 ? F.G / 2 : 1);
            if (F.vcu < Hh) {
                for (int i = F.vcu; i < PB * 8; i += Hh) mlstm_prompt_chain(F, i >> 3, i & 7, QKR, VVb, OOb, IFb, HOb, inptr(F, I_CW), inptr(F, I_CB), inptr(F, I_MNW), out);
            }
            if (F.vcu >= Hh || F.G == 1) {
                const int st = F.G == 1 ? 1 : F.G - Hh;
                for (int i = F.G == 1 ? 0 : F.vcu - Hh; i < SB * 8; i += st)
                    mlstm_sample_item(F, i >> 3, i & 7, QKR, VVb, OOb, IFb, HOb, inptr(F, I_CW), inptr(F, I_CB), inptr(F, I_MNW), inptr(F, I_MC), inptr(F, I_MN), inptr(F, I_MM), inptr(F, I_MCONV), out);
            }
        }
        if (ph + 1 < args.ph_hi) xcd_barrier(bar);
    }
}

extern "C" void kernel_launch(void* const* d_in, const int* in_sizes, int n_in, void* d_out, int out_size, void* d_ws, size_t ws_size, hipStream_t stream) {
    static int grid = 0;
    if (grid == 0) {
        if (n_in != N_IN || out_size != (int)O_END || ws_size < WS_END) { fprintf(stderr, "kernel_launch: unexpected shapes (n_in %d, out %d, ws %zu); nothing launched\n", n_in, out_size, ws_size); grid = -1; return; }
        int dev = 0, cus = 0, per_cu = 0;
        if (hipGetDevice(&dev) != hipSuccess || hipDeviceGetAttribute(&cus, hipDeviceAttributeMultiprocessorCount, dev) != hipSuccess) { grid = -1; return; }
        if (hipFuncSetAttribute((const void*)mega_fwd, hipFuncAttributeMaxDynamicSharedMemorySize, LDS_BYTES) != hipSuccess) { fprintf(stderr, "kernel_launch: hipFuncSetAttribute failed\n"); grid = -1; return; }
        if (hipOccupancyMaxActiveBlocksPerMultiprocessor(&per_cu, (const void*)mega_fwd, NWAVES * 64, LDS_BYTES) != hipSuccess || per_cu < 1) { fprintf(stderr, "kernel_launch: occupancy query says %d\n", per_cu); per_cu = 1; }
        (void)hipGetLastError();
        grid = cus;
    }
    if (grid < 0) return;
    (void)hipMemsetAsync((char*)d_ws + WS_CTL, 0, CTL_ZERO_BYTES, stream);
    Args a{};
    for (int i = 0; i < N_IN; ++i) a.in[i] = (const float*)d_in[i];
    a.out = (float*)d_out; a.ws = (unsigned char*)d_ws;
#if MK_N_LAUNCHES == 1
    a.ph_lo = 0; a.ph_hi = N_PHASES;
    { void* kargs[] = {(void*)&a};
      const hipError_t e = hipLaunchCooperativeKernel((const void*)mega_fwd, dim3(grid), dim3(NWAVES * 64), kargs, LDS_BYTES, stream);
      if (e != hipSuccess) fprintf(stderr, "kernel_launch: cooperative launch failed: %s (grid %d)\n", hipGetErrorString(e), grid); }
#else
    for (int p = 0; p < N_PHASES; ++p) { a.ph_lo = p; a.ph_hi = p + 1; hipLaunchKernelGGL(mega_fwd, dim3(grid), dim3(NWAVES * 64), LDS_BYTES, stream, a); }
#endif
}
```

```cpp
#include <hip/hip_runtime.h>
#include <cstdio>
#include <cstdint>
namespace pg8 {
#define PG8_LAS __attribute__((address_space(3)))
typedef unsigned short bf16_t;
typedef short bf16x8 __attribute__((ext_vector_type(8)));
typedef float f32x4 __attribute__((ext_vector_type(4)));
typedef unsigned u32x4 __attribute__((ext_vector_type(4)));
constexpr int BM = 256, BK = 64, HALF = 128, HTB = HALF * BK * 2  , STAGE_BYTES = 8 * HTB, NXCD = 8, WGM = 8;

__host__ __device__ __forceinline__ int lds_byte(int r, int c) { const int st = (r >> 4) * 2 + (c >> 5), rr = r & 15, cc = c & 31, ob = rr * 64 + cc * 2; return st * 1024 + (ob ^ (((ob >> 9) & 1) << 5)); }
__host__ __device__ __forceinline__ void stage_rc(int b, int& R, int& C) { const int st = b / 1024, sb = b % 1024, swz = sb ^ (((sb >> 9) & 1) << 5); R = (st >> 1) * 16 + swz / 64; C = (st & 1) * 32 + (swz % 64) / 2; }
__host__ __device__ __forceinline__ int perm32(int rho) { const int n = rho >> 4, i = rho & 15; return 8 * (i >> 2) + 4 * n + (i & 3); }

struct Unit { int pm, pn, k0, nt, slab; };
struct Gemm { const bf16_t* A; const bf16_t* Bt; int M, N, K; };

struct UnitOrder {
    int nM, nN, nwg, G, c, ntf, tailS;
    __device__ __forceinline__ void init(int nM_, int nN_, int K, int G_, int c_, int tailS_) { nM = nM_; nN = nN_; nwg = nM * nN; G = G_; c = c_; ntf = K / BK; tailS = tailS_; }
    __device__ __forceinline__ bool next(int i, Unit& u) const {
        long L = (long)i * G + c;
        if (L < nwg) {
            int wgid = (int)L; { const int q = nwg / NXCD, r = nwg % NXCD, xcd = wgid % NXCD, off = wgid / NXCD; wgid = (xcd < r ? xcd * (q + 1) : r * (q + 1) + (xcd - r) * q) + off; }
            const int nig = WGM * nN, gid = wgid / nig, fm = gid * WGM, gsz = (nM - fm) < WGM ? (nM - fm) : WGM;
            u.pm = fm + ((wgid % nig) % gsz); u.pn = (wgid % nig) / gsz; u.k0 = 0; u.nt = ntf; u.slab = -1; return true;
        }
        L -= nwg; if (L >= 8 * tailS) return false;
        const int tile = (int)L / tailS, sl = (int)L % tailS;
        u.pm = 64 + (tile >> 2); u.pn = tile & 3; u.k0 = sl * 256; u.nt = 4; u.slab = sl; return true;
    }
    __device__ __forceinline__ void a_ready(const Unit&) const {}
    __device__ __forceinline__ void done(const Unit&) const {}
};
template <class Epi, class Sched, bool ALIGN_EPI = false, bool SP2 = false>
__device__ __forceinline__ void gemm_phase(PG8_LAS unsigned char* lds, const Gemm g, const Sched& S, const Epi& E, const int tid) {
    const int wid = __builtin_amdgcn_readfirstlane(tid >> 6), lane = tid & 63, wr = wid >> 2, wc = wid & 3, fr = lane & 15, fq = lane >> 4;
    const int K = g.K;
    unsigned voffA[2], voffB[2];
#pragma unroll
    for (int i = 0; i < 2; ++i) { int R, C; stage_rc(tid * 16 + i * 8192, R, C); const int Rb = Epi::PERM ? ((R & ~31) + perm32(R & 31)) : R;
        voffA[i] = (unsigned)(R * K + C) * 2u; voffB[i] = (unsigned)(Rb * K + C) * 2u; }
    const size_t kstep = (size_t)(BK * 2);
    const size_t hstep = (size_t)HALF * K * 2;
    const size_t tstep = 2 * hstep;
    const unsigned ldsw = (unsigned)wid * 1024u;
    const int aoff = lds_byte(wr * 64 + fr, fq * 8), boff = lds_byte(wc * 32 + fr, fq * 8);
#define PG8_SA(b, h) (((b) * 2 + (h)) * HTB)
#define PG8_SB(b, h) ((4 + (b) * 2 + (h)) * HTB)
#define PG8_STAGE(bufoff, gbase, voff) do { _Pragma("unroll") for (int _i = 0; _i < 2; ++_i) \
        __builtin_amdgcn_global_load_lds((const unsigned*)((const char*)(gbase) + (voff)[_i]), (PG8_LAS unsigned*)(lds + (bufoff) + ldsw + _i * 8192), 16, 0, 0); } while (0)
#define PG8_LDA(dst, b, h) do { _Pragma("unroll") for (int m = 0; m < 4; ++m) _Pragma("unroll") for (int k = 0; k < 2; ++k) dst[m][k] = *(const PG8_LAS bf16x8*)(lds + PG8_SA(b, h) + aoff + m * 2048 + k * 1024); } while (0)
#define PG8_LDB(dst, b, h) do { _Pragma("unroll") for (int n = 0; n < 2; ++n) _Pragma("unroll") for (int k = 0; k < 2; ++k) dst[n][k] = *(const PG8_LAS bf16x8*)(lds + PG8_SB(b, h) + boff + n * 2048 + k * 1024); } while (0)
#define PG8_MMA(ai, bj, At, Bt) do { __builtin_amdgcn_s_setprio(1); _Pragma("unroll") for (int m = 0; m < 4; ++m) _Pragma("unroll") for (int n = 0; n < 2; ++n) _Pragma("unroll") for (int k = 0; k < 2; ++k) \
        acc[ai][bj][m][n] = __builtin_amdgcn_mfma_f32_16x16x32_bf16(Bt[n][k], At[m][k], acc[ai][bj][m][n], 0, 0, 0); __builtin_amdgcn_s_setprio(0); } while (0)
#define PG8_WAIT_V(n) asm volatile("s_waitcnt vmcnt(" #n ")" ::: "memory")
#define PG8_WAIT_L(n) asm volatile("s_waitcnt lgkmcnt(" #n ")" ::: "memory")
#define PG8_BAR __builtin_amdgcn_s_barrier()
#define PG8_SCHED __builtin_amdgcn_sched_barrier(0)
    Unit cur, nxt; int ui = 0;
    if (!S.next(0, cur)) return;
    f32x4 acc[2][2][4][2];
#pragma unroll
    for (int a = 0; a < 2; ++a)
#pragma unroll
        for (int b = 0; b < 2; ++b)
#pragma unroll
            for (int m = 0; m < 4; ++m)
#pragma unroll
                for (int n = 0; n < 2; ++n) acc[a][b][m][n] = (f32x4){0.f, 0.f, 0.f, 0.f};
    bf16x8 At[4][2], B0[2][2], B1[2][2];
    const char* cA = (const char*)g.A + (size_t)cur.pm * tstep + (size_t)cur.k0 * 2; const char* cB = (const char*)g.Bt + (size_t)cur.pn * tstep + (size_t)cur.k0 * 2;
    S.a_ready(cur);
    if constexpr (SP2) {
        PG8_STAGE(PG8_SB(0, 0), cB, voffB); PG8_STAGE(PG8_SB(0, 1), cB + hstep, voffB); PG8_STAGE(PG8_SA(0, 0), cA, voffA); PG8_STAGE(PG8_SA(0, 1), cA + hstep, voffA);
        if (wr == 1) PG8_BAR;
        PG8_WAIT_V(2); PG8_BAR;
        PG8_STAGE(PG8_SB(1, 0), cB + kstep, voffB); PG8_STAGE(PG8_SA(1, 0), cA + kstep, voffA); PG8_STAGE(PG8_SB(1, 1), cB + hstep + kstep, voffB);
        PG8_WAIT_V(6); PG8_BAR;
    } else {
        PG8_STAGE(PG8_SB(0, 0), cB, voffB); PG8_STAGE(PG8_SA(0, 0), cA, voffA); PG8_STAGE(PG8_SB(0, 1), cB + hstep, voffB); PG8_STAGE(PG8_SA(0, 1), cA + hstep, voffA);
        if (wr == 1) PG8_BAR;
        PG8_WAIT_V(4); PG8_BAR;
        PG8_STAGE(PG8_SB(1, 0), cB + kstep, voffB); PG8_STAGE(PG8_SA(1, 0), cA + kstep, voffA); PG8_STAGE(PG8_SB(1, 1), cB + hstep + kstep, voffB);
        PG8_WAIT_V(6); PG8_BAR;
    }
    for (;;) {
        const bool has_next = S.next(ui + 1, nxt);
        const char* nA = has_next ? (const char*)g.A + (size_t)nxt.pm * tstep + (size_t)nxt.k0 * 2 : cA; const char* nB = has_next ? (const char*)g.Bt + (size_t)nxt.pn * tstep + (size_t)nxt.k0 * 2 : cB;
        const int nt = cur.nt;
        for (int t = 0; t < nt; t += 2) {
            const bool last = (t == nt - 2);
            const char* a1 = cA + (size_t)(t + 1) * kstep;
            const char* a2 = last ? nA : cA + (size_t)(t + 2) * kstep; const char* b2 = last ? nB : cB + (size_t)(t + 2) * kstep;
            const char* a3 = a2 + kstep; const char* b3 = b2 + kstep;
            if (last && has_next) S.a_ready(nxt);
            if constexpr (SP2) {
            PG8_LDB(B0, 0, 0); PG8_LDB(B1, 0, 1); PG8_SCHED; PG8_LDA(At, 0, 0); PG8_STAGE(PG8_SA(1, 1), a1 + hstep, voffA);
            PG8_WAIT_V(8); PG8_WAIT_L(0); PG8_BAR; PG8_MMA(0, 0, At, B0); PG8_MMA(0, 1, At, B1); PG8_BAR; PG8_SCHED;
            PG8_LDA(At, 0, 1); PG8_STAGE(PG8_SB(0, 0), b2, voffB); PG8_STAGE(PG8_SB(0, 1), b2 + hstep, voffB); PG8_STAGE(PG8_SA(0, 0), a2, voffA);
            PG8_WAIT_V(8); PG8_WAIT_L(0); PG8_BAR; PG8_MMA(1, 0, At, B0); PG8_MMA(1, 1, At, B1); PG8_BAR; PG8_SCHED;
            PG8_LDB(B0, 1, 0); PG8_LDB(B1, 1, 1); PG8_SCHED; PG8_LDA(At, 1, 0); PG8_STAGE(PG8_SA(0, 1), a2 + hstep, voffA);
            PG8_WAIT_V(8); PG8_WAIT_L(0); PG8_BAR; PG8_MMA(0, 0, At, B0); PG8_MMA(0, 1, At, B1); PG8_BAR; PG8_SCHED;
            PG8_LDA(At, 1, 1); PG8_STAGE(PG8_SB(1, 0), b3, voffB); PG8_STAGE(PG8_SB(1, 1), b3 + hstep, voffB); PG8_STAGE(PG8_SA(1, 0), a3, voffA);
            PG8_WAIT_V(8); PG8_WAIT_L(0); PG8_BAR; PG8_MMA(1, 0, At, B0); PG8_MMA(1, 1, At, B1); PG8_BAR; PG8_SCHED;
            } else {
            PG8_LDB(B0, 0, 0); PG8_SCHED; PG8_LDA(At, 0, 0); PG8_STAGE(PG8_SA(1, 1), a1 + hstep, voffA);
            PG8_WAIT_L(8); PG8_BAR; PG8_WAIT_L(0); PG8_MMA(0, 0, At, B0); PG8_BAR; PG8_SCHED;
            PG8_LDB(B1, 0, 1); PG8_STAGE(PG8_SB(0, 0), b2, voffB);
            PG8_BAR; PG8_WAIT_L(0); PG8_MMA(0, 1, At, B1); PG8_BAR;
            PG8_LDA(At, 0, 1); PG8_STAGE(PG8_SA(0, 0), a2, voffA);
            PG8_BAR; PG8_WAIT_L(0); PG8_MMA(1, 0, At, B0); PG8_BAR; PG8_SCHED;
            PG8_STAGE(PG8_SB(0, 1), b2 + hstep, voffB);
            PG8_WAIT_V(6); PG8_BAR; PG8_MMA(1, 1, At, B1); PG8_BAR;
            PG8_LDB(B0, 1, 0); PG8_SCHED; PG8_LDA(At, 1, 0); PG8_STAGE(PG8_SA(0, 1), a2 + hstep, voffA);
            PG8_WAIT_L(8); PG8_BAR; PG8_WAIT_L(0); PG8_MMA(0, 0, At, B0); PG8_BAR; PG8_SCHED;
            PG8_LDB(B1, 1, 1); PG8_STAGE(PG8_SB(1, 0), b3, voffB);
            PG8_BAR; PG8_WAIT_L(0); PG8_MMA(0, 1, At, B1); PG8_BAR;
            PG8_LDA(At, 1, 1); PG8_STAGE(PG8_SA(1, 0), a3, voffA);
            PG8_BAR; PG8_WAIT_L(0); PG8_MMA(1, 0, At, B0); PG8_BAR; PG8_SCHED;
            PG8_STAGE(PG8_SB(1, 1), b3 + hstep, voffB);
            PG8_WAIT_V(6); PG8_BAR; PG8_MMA(1, 1, At, B1); PG8_BAR;
            }
        }
        if constexpr (ALIGN_EPI) { if (wr == 0) PG8_BAR; }
        if constexpr (!Epi::AFTER_DRAIN) { E(acc, cur, wr, wc, fr, fq); S.done(cur); }
        if (!has_next) break;
#pragma unroll
        for (int a = 0; a < 2; ++a)
#pragma unroll
            for (int b = 0; b < 2; ++b)
#pragma unroll
                for (int m = 0; m < 4; ++m)
#pragma unroll
                    for (int n = 0; n < 2; ++n) acc[a][b][m][n] = (f32x4){0.f, 0.f, 0.f, 0.f};
        cur = nxt; cA = nA; cB = nB; ++ui;
        if constexpr (ALIGN_EPI) { if (wr == 1) PG8_BAR; }
    }
    PG8_WAIT_V(0);
    if constexpr (!ALIGN_EPI) { if (wr == 0) PG8_BAR; }
    PG8_BAR;
    if constexpr (Epi::AFTER_DRAIN) { E.fused(acc, cur, wr, wc, fr, fq, lds, wid, lane); S.done(cur); }
#undef PG8_SA
#undef PG8_SB
#undef PG8_STAGE
#undef PG8_LDA
#undef PG8_LDB
#undef PG8_MMA
#undef PG8_WAIT_V
#undef PG8_WAIT_L
#undef PG8_BAR
#undef PG8_SCHED
}
}

#define GAS __attribute__((address_space(1)))
#define LAS __attribute__((address_space(3)))
typedef unsigned short bf16;
typedef unsigned v4u __attribute__((ext_vector_type(4)));
typedef float f32x4 __attribute__((ext_vector_type(4)));
typedef short bf16x8 __attribute__((ext_vector_type(8)));
typedef GAS unsigned gu32;
typedef GAS unsigned long long gu64;
#define RLX_AGENT __ATOMIC_RELAXED, __HIP_MEMORY_SCOPE_AGENT
#define LDS_WAIT() asm volatile("s_waitcnt lgkmcnt(0)" ::: "memory")
#define VM_WAIT() asm volatile("s_waitcnt vmcnt(0)" ::: "memory")
__device__ __forceinline__ unsigned long long rt() { return __builtin_amdgcn_s_memrealtime(); }
__device__ __forceinline__ unsigned f2bf(float f) { unsigned u = __builtin_bit_cast(unsigned, f); return (u + 0x7fffu + ((u >> 16) & 1u)) >> 16; }
__device__ __forceinline__ unsigned pk2(float lo, float hi) { return f2bf(lo) | (f2bf(hi) << 16); }

#define XB_TMO      128
#define XB_XCNT(j)  (256  + 64 * (j))
#define XB_XSUB(j)  (1280 + 64 * (j))
#define XB_XGEN(j)  (2304 + 64 * (j))
#define XB_TOP      3328
#define XB_TOPGEN   3392
#define XCD_BAR_WORDS 3456
#define XB_SPIN_CAP (1u << 18)

__device__ __forceinline__ unsigned xb_ld(unsigned* p)              { return __hip_atomic_load(p, __ATOMIC_RELAXED, __HIP_MEMORY_SCOPE_AGENT); }
__device__ __forceinline__ unsigned xb_add(unsigned* p, unsigned v) { return __hip_atomic_fetch_add(p, v, __ATOMIC_RELAXED, __HIP_MEMORY_SCOPE_AGENT); }
__device__ __forceinline__ unsigned xb_xcc_id() { return (unsigned)__builtin_amdgcn_s_getreg((3 << 11) | 20) & 0xFu; }
#define XB_SPIN(cond, bar) do { unsigned _sp = 0; while (cond) { __builtin_amdgcn_s_sleep(1); \
    if ((++_sp & 255u) == 0u) { if (xb_ld(&(bar)[XB_TMO])) break; if (_sp > XB_SPIN_CAP) { atomicAdd(&(bar)[XB_TMO], 1u); break; } } } } while (0)

struct XcdBarrier {
    unsigned* bar; unsigned x;
    volatile LAS unsigned* st;
};

__device__ __forceinline__ XcdBarrier xcd_barrier_post(unsigned* bar, volatile LAS unsigned* st) {
    XcdBarrier b; b.bar = bar; b.x = xb_xcc_id(); b.st = st;
    if (threadIdx.x == 0) (void)xb_add(&bar[XB_XCNT(b.x)], 1u);
    return b;
}
__device__ __forceinline__ void xcd_barrier_complete(unsigned* bar, unsigned x, unsigned& nloc, unsigned& nx) {
    const unsigned G = gridDim.x * gridDim.y * gridDim.z;
    unsigned sum, cnt, mine, sp = 0u;
    for (;;) {
        sum = 0u; cnt = 0u; mine = 0u;
#pragma unroll
        for (unsigned j = 0; j < 16; ++j) { const unsigned c = xb_ld(&bar[XB_XCNT(j)]); sum += c; cnt += (c > 0u) ? 1u : 0u; mine = (j == x) ? c : mine; }
        if (sum == G) break;
        __builtin_amdgcn_s_sleep(1);
        if ((++sp & 255u) == 0u) { if (xb_ld(&bar[XB_TMO])) break; if (sp > XB_SPIN_CAP) { atomicAdd(&bar[XB_TMO], 1u); break; } }
    }
    nloc = mine > 0u ? mine : 1u; nx = cnt > 0u ? cnt : 1u;
}

__device__ __forceinline__ void xcd_barrier(const XcdBarrier& b) {
    asm volatile("s_waitcnt vmcnt(0)" ::: "memory");
    __syncthreads();
    if (threadIdx.x == 0) {
        unsigned* bar = b.bar;
        __builtin_amdgcn_s_waitcnt(0);
        unsigned nloc = b.st[0], nx = b.st[1];
        if (nloc == 0u) { xcd_barrier_complete(bar, b.x, nloc, nx); b.st[0] = nloc; b.st[1] = nx; }
        const unsigned old = xb_add(&bar[XB_XSUB(b.x)], 1u);
        const unsigned gen = old / nloc;
        if (old + 1u == (gen + 1u) * nloc) {
            __builtin_amdgcn_fence(__ATOMIC_RELEASE, "agent");
            asm volatile("s_waitcnt vmcnt(0)" ::: "memory");
            const unsigned og = xb_add(&bar[XB_TOP], 1u);
            const unsigned tg = og / nx;
            if (og + 1u == (tg + 1u) * nx) xb_add(&bar[XB_TOPGEN], 1u);
            else XB_SPIN(xb_ld(&bar[XB_TOPGEN]) == tg, bar);
            __builtin_amdgcn_fence(__ATOMIC_ACQUIRE, "agent");
            xb_add(&bar[XB_XGEN(b.x)], 1u);
            asm volatile("s_waitcnt vmcnt(0)" ::: "memory");
        } else {
            XB_SPIN(xb_ld(&bar[XB_XGEN(b.x)]) == gen, bar);
            __builtin_amdgcn_fence(__ATOMIC_ACQUIRE, "agent");
            asm volatile("s_waitcnt vmcnt(0)" ::: "memory");
        }
    }
    __syncthreads();
}

constexpr int NWAVES = 8;
constexpr int D = 1024, FF = 2816;
constexpr int PB = 8, PT = 2048, SB = 128, STK = 4;
constexpr int MP = PB * PT, MS = SB * STK, M = MP + MS;
constexpr int NRW = 3584, KRW = 2048, NL2 = 3072, KL2 = 384, NIN = 3328;
constexpr float NORM_EPS = 1e-6f, GN_EPS = 64e-5f;
typedef pg8::bf16_t bf16;

constexpr size_t MiB = 1u << 20;
constexpr size_t WS_CTL = 0, CTL_ZERO_BYTES = 64 * 1024;
constexpr size_t WS_W = 1 * MiB;
constexpr size_t WS_XR = 20 * MiB;
constexpr size_t WS_BIG = 86 * MiB;
constexpr size_t WS_END = 256 * MiB;
constexpr size_t W_GU = 0, W_D = (size_t)2 * FF * D * 2;
constexpr size_t W_RW = 0, W_L2 = (size_t)NRW * KRW * 2, W_O = W_L2 + (size_t)NL2 * KL2 * 2;
constexpr size_t W_IN = 0, W_OUT = (size_t)NIN * D * 2;
static_assert(W_D + (size_t)D * FF * 2 <= 19 * MiB && W_O + (size_t)D * D * 2 <= 19 * MiB && W_OUT + (size_t)D * D * 2 <= 19 * MiB, "weights region");
constexpr size_t B_H = 0, B_XN = 91 * MiB, B_SLAB = 124 * MiB;
constexpr size_t B_ACAT = 0, B_R = 66 * MiB, B_K = 99 * MiB, B_V = 132 * MiB, B_DEC = 0, B_AA = 33 * MiB;
constexpr size_t B_QKR = 0, B_VV = 33 * MiB, B_HO = 66 * MiB, B_OO = 124 * MiB, B_IF = 157 * MiB;
static_assert((size_t)M * FF * 2 <= 91 * MiB && (size_t)M * D * 2 == 33 * MiB && B_IF + (size_t)M * 16 * 4 <= 170 * MiB && B_SLAB + (size_t)11 * MS * D * 4 <= 170 * MiB, "BIG map");
constexpr size_t OS_GG = 0, OS_LORA = 33 * MiB;
static_assert(OS_LORA + (size_t)M * KL2 * 2 <= (size_t)MP * D * 4, "d_out scratch");
constexpr size_t O_Y = 0, O_P_S = 17301504, O_P_SHIFT = 17825792, O_P_C = 17833984, O_P_N = 18358272, O_P_M = 18362368, O_P_CONV = 18362432,
                 O_S_S = 18387008, O_S_SHIFT = 26775616, O_S_C = 26906688, O_S_N = 35295296, O_S_M = 35360832, O_S_CONV = 35361856, O_END = 35755072;
constexpr int CW_BAR = 1024;

constexpr int RING_BYTES = 131072, LDSCTL_OFF = RING_BYTES, MISC_OFF = LDSCTL_OFF + 320, TAB_OFF = LDSCTL_OFF + 1024, LDS_BYTES = 147456;

enum { I_XP = 0, I_XS, I_RS, I_RSHIFT, I_MC, I_MN, I_MM, I_MCONV, I_NFA, I_FAWG, I_FAWU, I_FAWD, I_NMIX, I_NFB, I_FBWG, I_FBWU, I_FBWD,
       I_MU, I_WR, I_WK, I_WV, I_WO, I_W0, I_W1, I_W2, I_A0, I_A1, I_A2, I_G1, I_G2, I_KK, I_KA, I_RK, I_GNW, I_GNB,
       I_WIN, I_BIF, I_CW, I_CB, I_MNW, I_WOUT, I_NFIN, N_IN };

typedef __bf16 bf16x2_t __attribute__((ext_vector_type(2)));
typedef float f32x2_t __attribute__((ext_vector_type(2)));
__device__ __forceinline__ unsigned pkbf(float lo, float hi) { f32x2_t v = {lo, hi}; bf16x2_t b = __builtin_convertvector(v, bf16x2_t); return __builtin_bit_cast(unsigned, b); }
__device__ __forceinline__ float bflo(unsigned u) { return __builtin_bit_cast(float, u << 16); }
__device__ __forceinline__ float bfhi(unsigned u) { return __builtin_bit_cast(float, u & 0xffff0000u); }
__device__ __forceinline__ float bf1(unsigned short u) { return __builtin_bit_cast(float, (unsigned)u << 16); }
__device__ __forceinline__ unsigned short f2bf1(float f) { return (unsigned short)(pkbf(f, 0.f) & 0xffffu); }
__device__ __forceinline__ void unpack8(v4u w, float (&o)[8]) { o[0] = bflo(w.x); o[1] = bfhi(w.x); o[2] = bflo(w.y); o[3] = bfhi(w.y); o[4] = bflo(w.z); o[5] = bfhi(w.z); o[6] = bflo(w.w); o[7] = bfhi(w.w); }
__device__ __forceinline__ v4u pack8(const float (&o)[8]) { v4u w; w.x = pkbf(o[0], o[1]); w.y = pkbf(o[2], o[3]); w.z = pkbf(o[4], o[5]); w.w = pkbf(o[6], o[7]); return w; }
__device__ __forceinline__ float sigmoidf_(float x) { return __builtin_amdgcn_rcpf(1.f + __expf(-x)); }
__device__ __forceinline__ float siluf_(float x) { return x * __builtin_amdgcn_rcpf(1.f + __expf(-x)); }
__device__ __forceinline__ float tanhf_(float x) { return 1.f - 2.f * __builtin_amdgcn_rcpf(__expf(2.f * x) + 1.f); }
__device__ __forceinline__ float logsigmoidf_(float x) { return fminf(x, 0.f) - log1pf(__expf(-fabsf(x))); }
template <int CTRL> __device__ __forceinline__ float dppf(float x) { return __builtin_bit_cast(float, __builtin_amdgcn_update_dpp(0, __builtin_bit_cast(int, x), CTRL, 0xF, 0xF, true)); }
__device__ __forceinline__ float red4(float x) { x += dppf<0xB1>(x); x += dppf<0x4E>(x); return x; }
__device__ __forceinline__ float red8(float x) { x = red4(x); x += dppf<0x141>(x); return x; }
__device__ __forceinline__ float red16(float x) { x = red8(x); x += dppf<0x140>(x); return x; }
__device__ __forceinline__ float wave_sum(float v) {
#pragma unroll
    for (int o = 1; o < 64; o <<= 1) v += __shfl_xor(v, o);
    return v;
}

struct Frame {
    LAS unsigned char* lds;
    volatile LAS unsigned* MISC;
    gu32* ctl;
    volatile LAS unsigned long long* tab;
    int tid, lane, wave, vcu, G;
};
__device__ __forceinline__ const float* inptr(const Frame& F, int i) { const unsigned long long v = F.tab[i];
    const unsigned lo = __builtin_amdgcn_readfirstlane((unsigned)v), hi = __builtin_amdgcn_readfirstlane((unsigned)(v >> 32)); return (const float*)(const GAS float*)(((unsigned long long)hi << 32) | lo); }

using pg8::Unit; using pg8::BM; using pg8::HALF;
__device__ __forceinline__ void st8bf(bf16* p, f32x4 v0, f32x4 v1) { v4u w; w.x = pkbf(v0[0], v0[1]); w.y = pkbf(v0[2], v0[3]); w.z = pkbf(v1[0], v1[1]); w.w = pkbf(v1[2], v1[3]); *(v4u*)p = w; }

struct EpiSwiglu {
    static constexpr bool PERM = true, AFTER_DRAIN = false;
    bf16* H;
    __device__ __forceinline__ void operator()(const f32x4 (&acc)[2][2][4][2], const Unit& u, int wr, int wc, int fr, int fq) const {
        const int row0 = u.pm * BM + wr * 64 + fr, col0 = u.pn * 128 + wc * 32 + 8 * fq;
#pragma unroll
        for (int ai = 0; ai < 2; ++ai)
#pragma unroll
            for (int m = 0; m < 4; ++m) {
                f32x4 o[2];
#pragma unroll
                for (int n = 0; n < 2; ++n)
#pragma unroll
                    for (int i = 0; i < 4; ++i) { const float g = acc[ai][0][m][n][i], up = acc[ai][1][m][n][i]; o[n][i] = siluf_(g) * up; }
                st8bf(H + (size_t)(row0 + ai * HALF + m * 16) * FF + col0, o[0], o[1]);
            }
    }
};
struct EpiRes {
    static constexpr bool PERM = false, AFTER_DRAIN = false;
    const float* base; float* out; float* slab; float coef;
    __device__ __forceinline__ void operator()(const f32x4 (&acc)[2][2][4][2], const Unit& u, int wr, int wc, int fr, int fq) const {
        const int row0 = u.pm * BM + wr * 64 + fr, col0 = u.pn * BM + wc * 32 + 4 * fq;
        if (u.slab < 0) {
#pragma unroll
            for (int ai = 0; ai < 2; ++ai)
#pragma unroll
                for (int m = 0; m < 4; ++m) { const size_t ro = (size_t)(row0 + ai * HALF + m * 16) * D + col0;
#pragma unroll
                    for (int bj = 0; bj < 2; ++bj)
#pragma unroll
                        for (int n = 0; n < 2; ++n) { const f32x4 b = *(const f32x4*)(base + ro + bj * HALF + n * 16); *(f32x4*)(out + ro + bj * HALF + n * 16) = b + acc[ai][bj][m][n] * coef; } }
        } else {
            float* sl = slab + (size_t)u.slab * MS * D;
#pragma unroll
            for (int ai = 0; ai < 2; ++ai)
#pragma unroll
                for (int m = 0; m < 4; ++m) { const size_t ro = (size_t)(row0 + ai * HALF + m * 16 - MP) * D + col0;
#pragma unroll
                    for (int bj = 0; bj < 2; ++bj)
#pragma unroll
                        for (int n = 0; n < 2; ++n) *(f32x4*)(sl + ro + bj * HALF + n * 16) = acc[ai][bj][m][n]; }
        }
    }
};
struct EpiRw {
    static constexpr bool PERM = true, AFTER_DRAIN = false;
    bf16 *R, *K, *V, *L;
    __device__ __forceinline__ void operator()(const f32x4 (&acc)[2][2][4][2], const Unit& u, int wr, int wc, int fr, int fq) const {
        const int row0 = u.pm * BM + wr * 64 + fr;
        if (u.pn < 12) {
            bf16 *p0 = R, *p1 = K, *p2 = V; asm volatile("" : "+s"(p0), "+s"(p1), "+s"(p2));
            bf16* dst = u.pn < 4 ? p0 : (u.pn < 8 ? p1 : p2); const int col0 = (u.pn & 3) * BM + wc * 32 + 8 * fq;
#pragma unroll
            for (int ai = 0; ai < 2; ++ai)
#pragma unroll
                for (int m = 0; m < 4; ++m) { bf16* rp = dst + (size_t)(row0 + ai * HALF + m * 16) * D + col0;
#pragma unroll
                    for (int bj = 0; bj < 2; ++bj) st8bf(rp + bj * HALF, acc[ai][bj][m][0], acc[ai][bj][m][1]); }
        } else {
#pragma unroll
            for (int bj = 0; bj < 2; ++bj) {
                const int lc = (u.pn - 12) * BM + bj * HALF + wc * 32 + 8 * fq;
                if (lc >= KL2) continue;
                const int act = lc < 64 ? 1 : (lc < 128 ? 0 : (lc < 288 ? 2 : 3));
#pragma unroll
                for (int ai = 0; ai < 2; ++ai)
#pragma unroll
                    for (int m = 0; m < 4; ++m) {
                        f32x4 o[2];
#pragma unroll
                        for (int n = 0; n < 2; ++n)
#pragma unroll
                            for (int i = 0; i < 4; ++i) { const float x = acc[ai][bj][m][n][i]; o[n][i] = act == 1 ? tanhf_(x) : (act == 0 ? x : (act == 2 ? sigmoidf_(x) : 0.f)); }
                        st8bf(L + (size_t)(row0 + ai * HALF + m * 16) * KL2 + lc, o[0], o[1]);
                    }
            }
        }
    }
};
struct EpiL2 {
    static constexpr bool PERM = true, AFTER_DRAIN = false;
    bf16 *DEC, *AA, *GG; const float *w0, *a0;
    __device__ __forceinline__ void operator()(const f32x4 (&acc)[2][2][4][2], const Unit& u, int wr, int wc, int fr, int fq) const {
        const int row0 = u.pm * BM + wr * 64 + fr, kind = u.pn >> 2, col0 = (u.pn & 3) * BM + wc * 32 + 8 * fq;
        bf16 *p0 = DEC, *p1 = AA, *p2 = GG; const float *q0 = w0, *q1 = a0; asm volatile("" : "+s"(p0), "+s"(p1), "+s"(p2), "+s"(q0), "+s"(q1));
        bf16* dst = kind == 0 ? p0 : (kind == 1 ? p1 : p2); const float* bias = kind == 0 ? q0 : q1;
#pragma unroll
        for (int bj = 0; bj < 2; ++bj) {
            f32x4 bv[2];
#pragma unroll
            for (int n = 0; n < 2; ++n) bv[n] = kind < 2 ? *(const f32x4*)(bias + col0 + bj * HALF + 4 * n) : (f32x4){0.f, 0.f, 0.f, 0.f};
#pragma unroll
            for (int ai = 0; ai < 2; ++ai)
#pragma unroll
                for (int m = 0; m < 4; ++m) {
                    f32x4 o[2];
#pragma unroll
                    for (int n = 0; n < 2; ++n)
#pragma unroll
                        for (int i = 0; i < 4; ++i) { const float z = acc[ai][bj][m][n][i] + bv[n][i];
                            o[n][i] = kind == 0 ? (1.f - __expf(-0.60653065971f * sigmoidf_(z))) : (kind == 1 ? sigmoidf_(z) : z); }
                    st8bf(dst + (size_t)(row0 + ai * HALF + m * 16) * D + col0 + bj * HALF, o[0], o[1]);
                }
        }
    }
};
struct EpiIn {
    static constexpr bool PERM = true, AFTER_DRAIN = false;
    bf16 *QKR, *VV, *OO; float* IF; const float* bif;
    __device__ __forceinline__ void operator()(const f32x4 (&acc)[2][2][4][2], const Unit& u, int wr, int wc, int fr, int fq) const {
        const int row0 = u.pm * BM + wr * 64 + fr;
        if (u.pn < 12) {
            bf16 *p0 = QKR, *p1 = VV, *p2 = OO; asm volatile("" : "+s"(p0), "+s"(p1), "+s"(p2));
            const int kind = u.pn >> 2; bf16* dst = kind == 0 ? p0 : (kind == 1 ? p1 : p2); const int col0 = (u.pn & 3) * BM + wc * 32 + 8 * fq;
#pragma unroll
            for (int ai = 0; ai < 2; ++ai)
#pragma unroll
                for (int m = 0; m < 4; ++m) { bf16* rp = dst + (size_t)(row0 + ai * HALF + m * 16) * D + col0;
#pragma unroll
                    for (int bj = 0; bj < 2; ++bj) { f32x4 a = acc[ai][bj][m][0], b = acc[ai][bj][m][1];
                        if (kind == 2) {
#pragma unroll
                            for (int i = 0; i < 4; ++i) { a[i] = sigmoidf_(a[i]); b[i] = sigmoidf_(b[i]); } }
                        st8bf(rp + bj * HALF, a, b); } }
        } else if (u.pn == 12 && wc == 0 && fq < 2) {
            const f32x4 b0 = *(const f32x4*)(bif + 8 * fq), b1 = *(const f32x4*)(bif + 8 * fq + 4);
#pragma unroll
            for (int ai = 0; ai < 2; ++ai)
#pragma unroll
                for (int m = 0; m < 4; ++m) { f32x4 a = acc[ai][0][m][0] + b0, b = acc[ai][0][m][1] + b1;
                    if (fq == 1) {
#pragma unroll
                        for (int i = 0; i < 4; ++i) { a[i] = logsigmoidf_(a[i]); b[i] = logsigmoidf_(b[i]); } }
                    float* rp = IF + (size_t)(row0 + ai * HALF + m * 16) * 16 + 8 * fq; *(f32x4*)rp = a; *(f32x4*)(rp + 4) = b; }
        }
    }
};

struct CJ { const float* W; const float* sc; bf16* WT; int K, N, Npad, ldk, koff, rmode, roff, smode; };
__device__ __forceinline__ int cj_items(const CJ& j) { return (j.K / 64) * (j.Npad / 32); }
__device__ __forceinline__ void conv_item(const CJ& J, LAS float* scr, int item, int lane) {
    const int nblk = J.Npad / 32, kb = item / nblk, nb = item % nblk, k0 = 64 * kb, n0 = 32 * nb;
    const int nn = n0 + (lane & 31); const bool nok = nn < J.N;
#pragma unroll 8
    for (int i = 0; i < 32; ++i) { const int kk = 2 * i + (lane >> 5); float w = nok ? J.W[(size_t)(k0 + kk) * J.N + nn] : 0.f;
        if (J.smode) { const float s = J.sc[k0 + kk]; w *= (J.smode == 1 ? s : 1.f - s); }
        scr[kk * 33 + (lane & 31)] = w; }
    LDS_WAIT(); asm volatile("" ::: "memory");
    const int rowbase = J.rmode == 0 ? J.roff + n0 : (n0 >> 7) * 256 + (n0 & 127) + J.roff;
    const int c = lane & 7;
#pragma unroll
    for (int j = 0; j < 4; ++j) { const int n = (lane >> 3) + 8 * j; const LAS float* s = scr + (8 * c) * 33 + n;
        v4u o; o.x = pkbf(s[0 * 33], s[1 * 33]); o.y = pkbf(s[2 * 33], s[3 * 33]); o.z = pkbf(s[4 * 33], s[5 * 33]); o.w = pkbf(s[6 * 33], s[7 * 33]);
        *(GAS v4u*)(J.WT + (size_t)(rowbase + n) * J.ldk + J.koff + k0 + 8 * c) = o; }
    LDS_WAIT(); asm volatile("" ::: "memory");
}
__device__ __forceinline__ CJ get_job(const Frame& F, int kind, int j, int layer, int ab, bf16* Wb) {
    CJ J; J.sc = nullptr; J.smode = 0; J.koff = 0; J.rmode = 0; J.roff = 0;
    if (kind == 0) {
        const float* wg = inptr(F, ab ? I_FBWG : I_FAWG) + (size_t)layer * D * FF; const float* wu = inptr(F, ab ? I_FBWU : I_FAWU) + (size_t)layer * D * FF; const float* wd = inptr(F, ab ? I_FBWD : I_FAWD) + (size_t)layer * D * FF;
        if (j < 2) { J.W = j == 0 ? wg : wu; J.K = D; J.N = FF; J.Npad = FF; J.WT = Wb + W_GU / 2; J.ldk = D; J.rmode = 1; J.roff = j == 0 ? 0 : 128; }
        else { J.W = wd; J.K = FF; J.N = D; J.Npad = D; J.WT = Wb + W_D / 2; J.ldk = FF; }
    } else if (kind == 1) {
        if (j < 12) {
            const int s = j >> 1, half = j & 1;
            J.W = inptr(F, s == 0 ? I_WR : (s == 1 ? I_WK : (s == 2 ? I_WV : (s == 3 ? I_W1 : (s == 4 ? I_A1 : I_G1)))));
            J.N = s < 3 ? 1024 : (s < 5 ? 64 : 160); J.Npad = s < 3 ? 1024 : (s < 5 ? 64 : 384);
            J.roff = s < 3 ? 1024 * s : (s == 3 ? 3072 : (s == 4 ? 3136 : 3200));
            const int mui = s == 0 ? 0 : (s == 1 ? 2 : (s == 2 ? 3 : (s == 3 ? 1 : (s == 4 ? 4 : 5))));
            J.sc = inptr(F, I_MU) + mui * D; J.smode = half ? 1 : 2; J.koff = half * D; J.K = D; J.ldk = KRW; J.WT = Wb + W_RW / 2;
        } else { J.W = inptr(F, I_WO); J.K = D; J.N = D; J.Npad = D; J.WT = Wb + W_O / 2; J.ldk = D; }
    } else {
        if (j == 0) { J.W = inptr(F, I_WIN); J.K = D; J.N = 3088; J.Npad = NIN; J.WT = Wb + W_IN / 2; J.ldk = D; }
        else { J.W = inptr(F, I_WOUT); J.K = D; J.N = D; J.Npad = D; J.WT = Wb + W_OUT / 2; J.ldk = D; }
    }
    return J;
}
__device__ __forceinline__ void convert_weights(const Frame& F, int kind, int layer, int ab, bf16* Wb) {
    LAS float* scr = (LAS float*)(F.lds + F.wave * 16384);
    const int gw = F.vcu * NWAVES + F.wave, NGW = F.G * NWAVES;
    const int njobs = kind == 0 ? 3 : (kind == 1 ? 13 : 2);
    int total = 0;
    for (int j = 0; j < njobs; ++j) { const CJ J = get_job(F, kind, j, layer, ab, Wb); total += cj_items(J); }
    for (int g = gw; g < total; g += NGW) {
        int r = g, j = 0; CJ J = get_job(F, kind, 0, layer, ab, Wb);
        while (r >= cj_items(J)) { r -= cj_items(J); ++j; J = get_job(F, kind, j, layer, ab, Wb); }
        conv_item(J, scr, r, F.lane);
    }
    if (kind == 1) {
        bf16* WT = Wb + W_L2 / 2; const float* w2 = inptr(F, I_W2); const float* a2 = inptr(F, I_A2); const float* g2 = inptr(F, I_G2);
        for (int idx = (F.vcu * NWAVES + F.wave) * 64 + F.lane; idx < 48 * NL2; idx += F.G * NWAVES * 64) {
            const int c = idx / NL2, n = idx % NL2, type = n >> 10, jj = n & 1023;
            const float* src = nullptr;
            if (type == 0 && c < 8) src = w2 + (size_t)(8 * c) * D + jj;
            else if (type == 1 && c >= 8 && c < 16) src = a2 + (size_t)(8 * (c - 8)) * D + jj;
            else if (type == 2 && c >= 16 && c < 36) src = g2 + (size_t)(8 * (c - 16)) * D + jj;
            float v[8];
#pragma unroll
            for (int e = 0; e < 8; ++e) v[e] = src ? src[(size_t)e * D] : 0.f;
            *(GAS v4u*)(WT + (size_t)n * KL2 + 8 * c) = pack8(v);
        }
    }
}

template <int MODE>
__device__ __forceinline__ void norm_rows(const Frame& F, const float* base_p, const float* base_s, int nslab, float coef, const float* slab, float* xr,
                                          const float* gain, bf16* dst, const float* shift_in, float* out) {
    const int gw = F.vcu * NWAVES + F.wave, NGW = F.G * NWAVES, lane = F.lane;
    f32x4 gv[4];
#pragma unroll
    for (int j = 0; j < 4; ++j) gv[j] = *(const f32x4*)(gain + 256 * j + 4 * lane);
    for (int m = gw; m < M; m += NGW) {
        const bool samp = m >= MP;
        const float* src = samp ? base_s + (size_t)(m - MP) * D : base_p + (size_t)m * D;
        f32x4 v[4];
#pragma unroll
        for (int j = 0; j < 4; ++j) v[j] = *(const f32x4*)(src + 256 * j + 4 * lane);
        if (samp && nslab > 0) {
            for (int s = 0; s < nslab; ++s) { const float* sp = slab + ((size_t)s * MS + (m - MP)) * D;
#pragma unroll
                for (int j = 0; j < 4; ++j) v[j] += *(const f32x4*)(sp + 256 * j + 4 * lane) * coef; }
            if (MODE != 2) {
#pragma unroll
                for (int j = 0; j < 4; ++j) *(f32x4*)(xr + (size_t)m * D + 256 * j + 4 * lane) = v[j]; }
        }
        float ss = 0.f;
#pragma unroll
        for (int j = 0; j < 4; ++j) ss += (v[j].x * v[j].x + v[j].y * v[j].y) + (v[j].z * v[j].z + v[j].w * v[j].w);
        const float r = 1.0f / sqrtf(wave_sum(ss) * (1.f / D) + NORM_EPS);
#pragma unroll
        for (int j = 0; j < 4; ++j) v[j] = v[j] * r * gv[j];
        if (MODE == 2) {
#pragma unroll
            for (int j = 0; j < 4; ++j) *(f32x4*)(out + O_Y + (size_t)m * D + 256 * j + 4 * lane) = v[j];
        } else if (MODE == 0) {
#pragma unroll
            for (int j = 0; j < 4; ++j) { const unsigned long long w = (unsigned long long)pkbf(v[j].x, v[j].y) | ((unsigned long long)pkbf(v[j].z, v[j].w) << 32);
                *(unsigned long long*)(dst + (size_t)m * D + 256 * j + 4 * lane) = w; }
        } else {
            int t, b; bool first, last;
            if (!samp) { t = m & (PT - 1); b = m >> 11; first = t == 0; last = t == PT - 1; } else { const int mm = m - MP; t = mm & 3; b = mm >> 2; first = t == 0; last = t == 3; }
#pragma unroll
            for (int j = 0; j < 4; ++j) { const unsigned long long w = (unsigned long long)pkbf(v[j].x, v[j].y) | ((unsigned long long)pkbf(v[j].z, v[j].w) << 32);
                *(unsigned long long*)(dst + (size_t)m * (2 * D) + 256 * j + 4 * lane) = w;
                if (!last) *(unsigned long long*)(dst + (size_t)(m + 1) * (2 * D) + D + 256 * j + 4 * lane) = w;
                else *(f32x4*)(out + (samp ? O_S_SHIFT : O_P_SHIFT) + (size_t)b * D + 256 * j + 4 * lane) = v[j];
                if (first) { unsigned long long z = 0ull;
                    if (samp) { const f32x4 s = *(const f32x4*)(shift_in + (size_t)b * D + 256 * j + 4 * lane); z = (unsigned long long)pkbf(s.x, s.y) | ((unsigned long long)pkbf(s.z, s.w) << 32); }
                    *(unsigned long long*)(dst + (size_t)m * (2 * D) + D + 256 * j + 4 * lane) = z; }
            }
        }
    }
}

constexpr int RW_KK = 0, RW_DD = 4096, RW_BB = 8192, RW_KP = 12288, RW_RR = 16384, RW_VV = 20480, RW_YY = 24576;
__device__ __forceinline__ void rwkv_chain(const Frame& F, int row0, int T, int h, const float* S0, float* ST,
                                           const bf16* Rb, const bf16* Kb, const bf16* Vb, const bf16* Db, const bf16* Ab, bf16* Gb,
                                           const float* k_k, const float* k_a, const float* r_k, const float* gn_w, const float* gn_b, const bool do_store, const int pvar) {
    LAS float* L = (LAS float*)F.lds;
    const int tid = F.tid, lane = F.lane, w = F.wave;
    const int cg = tid & 7, tt = tid >> 3;
    const int srow = 8 * w + (lane >> 3);
    float S[8];
    if (S0) { const f32x4 a = *(const f32x4*)(S0 + srow * 64 + 8 * cg), b = *(const f32x4*)(S0 + srow * 64 + 8 * cg + 4);
        S[0] = a.x; S[1] = a.y; S[2] = a.z; S[3] = a.w; S[4] = b.x; S[5] = b.y; S[6] = b.z; S[7] = b.w; }
    else {
#pragma unroll
        for (int j = 0; j < 8; ++j) S[j] = 0.f; }
    const int ch = h * 64 + 8 * cg;
    float ckk[8], cka[8], crk[8], cgw[8], cgb[8];
#pragma unroll
    for (int j = 0; j < 8; ++j) { ckk[j] = k_k[ch + j]; cka[j] = k_a[ch + j]; crk[j] = r_k[ch + j]; cgw[j] = gn_w[ch + j]; cgb[j] = gn_b[ch + j]; }
    const int nch = (T + 63) >> 6;
    v4u pr = {0, 0, 0, 0}, pk = pr, pv = pr, pd = pr, pa = pr, pg = pr;
    { const int nt0 = T < 64 ? T : 64;
      if (tt < nt0) { const size_t off = (size_t)(row0 + tt) * D + ch;
          pr = *(const v4u*)(Rb + off); pk = *(const v4u*)(Kb + off); pv = *(const v4u*)(Vb + off); pd = *(const v4u*)(Db + off); pa = *(const v4u*)(Ab + off); pg = *(const v4u*)(Gb + off); } }
    float bon = 0.f, vv[8], gg[8];
    for (int c = 0; c < nch; ++c) {
        const int nt = (T - 64 * c) < 64 ? (T - 64 * c) : 64;
        const bool valid = tt < nt;
        {
            float r8[8], k8[8], d8[8], a8[8];
            unpack8(pr, r8); unpack8(pk, k8); unpack8(pv, vv); unpack8(pd, d8); unpack8(pa, a8); unpack8(pg, gg);
            float kk[8], ss = 0.f;
#pragma unroll
            for (int j = 0; j < 8; ++j) { kk[j] = k8[j] * ckk[j]; ss += kk[j] * kk[j]; }
            ss = red8(ss);
            const float inv = __builtin_amdgcn_rsqf(fmaxf(ss, 1e-24f));
            float kp[8], bsum = 0.f;
#pragma unroll
            for (int j = 0; j < 8; ++j) { kk[j] *= inv; kp[j] = k8[j] * (1.f + (a8[j] - 1.f) * cka[j]); bsum += r8[j] * kp[j] * crk[j]; }
            bon = red8(bsum);
            if (valid) {
                LAS float* p = L + tt * 64 + 8 * cg;
                *(LAS f32x4*)(p + RW_KK) = (f32x4){-kk[0], -kk[1], -kk[2], -kk[3]}; *(LAS f32x4*)(p + RW_KK + 4) = (f32x4){-kk[4], -kk[5], -kk[6], -kk[7]};
                *(LAS f32x4*)(p + RW_DD) = (f32x4){1.f - d8[0], 1.f - d8[1], 1.f - d8[2], 1.f - d8[3]}; *(LAS f32x4*)(p + RW_DD + 4) = (f32x4){1.f - d8[4], 1.f - d8[5], 1.f - d8[6], 1.f - d8[7]};
                *(LAS f32x4*)(p + RW_BB) = (f32x4){kk[0] * a8[0], kk[1] * a8[1], kk[2] * a8[2], kk[3] * a8[3]}; *(LAS f32x4*)(p + RW_BB + 4) = (f32x4){kk[4] * a8[4], kk[5] * a8[5], kk[6] * a8[6], kk[7] * a8[7]};
                *(LAS f32x4*)(p + RW_KP) = (f32x4){kp[0], kp[1], kp[2], kp[3]}; *(LAS f32x4*)(p + RW_KP + 4) = (f32x4){kp[4], kp[5], kp[6], kp[7]};
                *(LAS f32x4*)(p + RW_RR) = (f32x4){r8[0], r8[1], r8[2], r8[3]}; *(LAS f32x4*)(p + RW_RR + 4) = (f32x4){r8[4], r8[5], r8[6], r8[7]};
                *(LAS f32x4*)(p + RW_VV) = (f32x4){vv[0], vv[1], vv[2], vv[3]}; *(LAS f32x4*)(p + RW_VV + 4) = (f32x4){vv[4], vv[5], vv[6], vv[7]};
            }
        }
        __syncthreads();
        if (c + 1 < nch) { const int nt1 = (T - 64 * (c + 1)) < 64 ? (T - 64 * (c + 1)) : 64;
            if (tt < nt1) { const size_t off = (size_t)(row0 + 64 * (c + 1) + tt) * D + ch;
                pr = *(const v4u*)(Rb + off); pk = *(const v4u*)(Kb + off); pv = *(const v4u*)(Vb + off); pd = *(const v4u*)(Db + off); pa = *(const v4u*)(Ab + off); pg = *(const v4u*)(Gb + off); } }
        {
            typedef float f2 __attribute__((ext_vector_type(2)));
            f2 S2[4] = {{S[0], S[1]}, {S[2], S[3]}, {S[4], S[5]}, {S[6], S[7]}};
            const LAS float* p = L + 8 * cg;
            LAS float* yw = L + RW_YY + srow;
            const LAS float* vp = L + RW_VV + srow;
#define RW_LD(N, Dd, B, Q, R, VR, t_) do { const LAS float* p_ = p + (t_) * 64; \
                N[0] = *(const LAS f32x4*)(p_ + RW_KK); N[1] = *(const LAS f32x4*)(p_ + RW_KK + 4); Dd[0] = *(const LAS f32x4*)(p_ + RW_DD); Dd[1] = *(const LAS f32x4*)(p_ + RW_DD + 4); \
                B[0] = *(const LAS f32x4*)(p_ + RW_BB); B[1] = *(const LAS f32x4*)(p_ + RW_BB + 4); Q[0] = *(const LAS f32x4*)(p_ + RW_KP); Q[1] = *(const LAS f32x4*)(p_ + RW_KP + 4); \
                R[0] = *(const LAS f32x4*)(p_ + RW_RR); R[1] = *(const LAS f32x4*)(p_ + RW_RR + 4); VR = vp[(t_) * 64]; } while (0)
#define RW_STEP(N, Dd, B, Q, R, VR, t_) do { \
                f2 a_ = S2[0] * (f2){N[0].x, N[0].y}; a_ = S2[1] * (f2){N[0].z, N[0].w} + a_; a_ = S2[2] * (f2){N[1].x, N[1].y} + a_; a_ = S2[3] * (f2){N[1].z, N[1].w} + a_; \
                const float sa_ = red8(a_.x + a_.y); const f2 sv_ = {sa_, sa_}, vv_ = {VR, VR}; \
                S2[0] = S2[0] * (f2){Dd[0].x, Dd[0].y} + (sv_ * (f2){B[0].x, B[0].y} + vv_ * (f2){Q[0].x, Q[0].y}); \
                S2[1] = S2[1] * (f2){Dd[0].z, Dd[0].w} + (sv_ * (f2){B[0].z, B[0].w} + vv_ * (f2){Q[0].z, Q[0].w}); \
                S2[2] = S2[2] * (f2){Dd[1].x, Dd[1].y} + (sv_ * (f2){B[1].x, B[1].y} + vv_ * (f2){Q[1].x, Q[1].y}); \
                S2[3] = S2[3] * (f2){Dd[1].z, Dd[1].w} + (sv_ * (f2){B[1].z, B[1].w} + vv_ * (f2){Q[1].z, Q[1].w}); \
                f2 y_ = S2[0] * (f2){R[0].x, R[0].y}; y_ = S2[1] * (f2){R[0].z, R[0].w} + y_; y_ = S2[2] * (f2){R[1].x, R[1].y} + y_; y_ = S2[3] * (f2){R[1].z, R[1].w} + y_; \
                yw[(t_) * 64] = red8(y_.x + y_.y); } while (0)
            f32x4 nA[2], dA[2], bA[2], qA[2], rA[2], nB[2], dB[2], bB[2], qB[2], rB[2]; float vA, vB;
            RW_LD(nA, dA, bA, qA, rA, vA, 0);
            int t = 0;
            if (pvar != 3)
            for (; t + 2 <= nt; t += 2) {
                RW_LD(nB, dB, bB, qB, rB, vB, t + 1);
                RW_STEP(nA, dA, bA, qA, rA, vA, t);
                RW_LD(nA, dA, bA, qA, rA, vA, (t + 2 < nt ? t + 2 : t + 1));
                RW_STEP(nB, dB, bB, qB, rB, vB, t + 1);
            }
            if (t < nt) RW_STEP(nA, dA, bA, qA, rA, vA, t);
#undef RW_LD
#undef RW_STEP
            S[0] = S2[0].x; S[1] = S2[0].y; S[2] = S2[1].x; S[3] = S2[1].y; S[4] = S2[2].x; S[5] = S2[2].y; S[6] = S2[3].x; S[7] = S2[3].y;
        }
        __syncthreads();
        if (pvar != 4) {
            f32x4 y0 = {0.f, 0.f, 0.f, 0.f}, y1 = y0;
            if (valid) { y0 = *(const LAS f32x4*)(L + RW_YY + tt * 64 + 8 * cg); y1 = *(const LAS f32x4*)(L + RW_YY + tt * 64 + 8 * cg + 4); }
            float yy[8] = {y0.x, y0.y, y0.z, y0.w, y1.x, y1.y, y1.z, y1.w};
            float s1 = 0.f;
#pragma unroll
            for (int j = 0; j < 8; ++j) s1 += yy[j];
            const float mean = red8(s1) * (1.f / 64.f);
            float s2 = 0.f;
#pragma unroll
            for (int j = 0; j < 8; ++j) { yy[j] -= mean; s2 += yy[j] * yy[j]; }
            const float rstd = __builtin_amdgcn_rsqf(red8(s2) * (1.f / 64.f) + GN_EPS);
            float o[8];
#pragma unroll
            for (int j = 0; j < 8; ++j) o[j] = ((yy[j] * rstd) * cgw[j] + cgb[j] + bon * vv[j]) * gg[j];
            if (valid && do_store) *(v4u*)(Gb + (size_t)(row0 + 64 * c + tt) * D + ch) = pack8(o);
        }
    }
    *(f32x4*)(ST + srow * 64 + 8 * cg) = (f32x4){S[0], S[1], S[2], S[3]}; *(f32x4*)(ST + srow * 64 + 8 * cg + 4) = (f32x4){S[4], S[5], S[6], S[7]};
    __syncthreads();
}

constexpr int PBY = 144;
constexpr int RPY = 272;
constexpr int ML_RQK = 0, ML_S = 0, ML_KT = 9216, ML_RV = 18432, ML_Q = 35840, ML_K = 45056, ML_HB = 35840, ML_VT = 54272, ML_C = 72704, ML_F = 91136;
constexpr int MF_N = 0, MF_QN = 64, MF_RS = 128, MF_HS = 256, MF_CW = 384, MF_B63 = 1024, MF_P63 = 1056, MF_MC = 1088  , MF_GB = 1152, MF_GP = MF_GB + 2048, MF_GA = MF_GP + 2048;
typedef __attribute__((address_space(3))) unsigned short lds_u16;
#define MFMA16(a, b, c) __builtin_amdgcn_mfma_f32_16x16x32_bf16((a), (b), (c), 0, 0, 0)
__device__ __forceinline__ void mlstm_prompt_chain(const Frame& F, int b, int hh, const bf16* QKR, const bf16* VVb, const bf16* OOb, const float* IFb, bf16* HOb,
                                                   const float* conv_w, const float* conv_b, const float* norm_w, float* out, const int pvar) {
    LAS unsigned char* lds = F.lds; LAS float* Fl = (LAS float*)(lds + ML_F);
    const int tid = F.tid, lane = F.lane, w = F.wave, fr = lane & 15, fq = lane >> 4;
    for (int i = tid; i < 128 * 72; i += 512) ((lds_u16*)(lds + ML_C))[i] = 0;
    if (tid < 64) Fl[MF_N + tid] = 0.f;
    for (int i = tid; i < 640; i += 512) { const int j = i >> 7, c = i & 127, gc = c < 64 ? hh * 64 + c : 512 + hh * 64 + (c - 64); Fl[MF_CW + i] = j < 4 ? conv_w[j * D + gc] : conv_b[gc]; }
    f32x4 Cacc[4];
#pragma unroll
    for (int k = 0; k < 4; ++k) Cacc[k] = (f32x4){0.f, 0.f, 0.f, 0.f};
    const int og = tid & 15, ot = tid >> 4;
    float nw[8];
#pragma unroll
    for (int e = 0; e < 8; ++e) nw[e] = norm_w[hh * 128 + 8 * og + e];
    v4u rq[3], rv[2], ro[2];
#define ML_LOAD_QKV(cc) do { const int rowc_ = b * PT + 64 * (cc); \
        _Pragma("unroll") for (int i = 0; i < 3; ++i) { const int q = tid + 512 * i, r = q >> 4, j = q & 15, tok = 64 * (cc) - 3 + r; rq[i] = (v4u){0u, 0u, 0u, 0u}; \
            if (q < 67 * 16 && tok >= 0) rq[i] = *(const v4u*)(QKR + (size_t)(b * PT + tok) * D + (j < 8 ? hh * 64 + 8 * j : 512 + hh * 64 + 8 * (j - 8))); } \
        _Pragma("unroll") for (int i = 0; i < 2; ++i) rv[i] = *(const v4u*)(VVb + (size_t)(rowc_ + ot + 32 * i) * D + hh * 128 + 8 * og); \
        } while (0)
#define ML_LOAD_O(cc) do { const int rowc_ = b * PT + 64 * (cc); \
        _Pragma("unroll") for (int i = 0; i < 2; ++i) ro[i] = *(const v4u*)(OOb + (size_t)(rowc_ + ot + 32 * i) * D + hh * 128 + 8 * og); } while (0)
    ML_LOAD_QKV(0);
#pragma unroll
    for (int q = 0; q < 4; ++q) { const int cc = w + 8 * q; const size_t ro_ = (size_t)(b * PT + 64 * cc + lane) * 16;
        const float li = IFb[ro_ + hh], lf = IFb[ro_ + 8 + hh];
        float bc = lf;
#pragma unroll
        for (int o = 1; o < 64; o <<= 1) { const float x = __shfl_up(bc, o); if (lane >= o) bc += x; }
        const float av = li - bc; float pm = av;
#pragma unroll
        for (int o = 1; o < 64; o <<= 1) { const float x = __shfl_up(pm, o); if (lane >= o) pm = fmaxf(pm, x); }
        Fl[MF_GB + cc * 64 + lane] = bc; Fl[MF_GP + cc * 64 + lane] = pm; Fl[MF_GA + cc * 64 + lane] = av;
        if (lane == 63) { Fl[MF_B63 + cc] = bc; Fl[MF_P63 + cc] = pm; } }
    __syncthreads();
    if (tid == 0) { float mm = 0.f;
        for (int cc = 0; cc < PT / 64; ++cc) { Fl[MF_MC + cc] = mm; const float b6 = Fl[MF_B63 + cc]; mm = fmaxf(b6 + mm, b6 + Fl[MF_P63 + cc]); }
        Fl[MF_MC + PT / 64] = mm; }
    __syncthreads();
    constexpr int NC = PT / 64;
    for (int c = 0; c < NC; ++c) {
        const int rowc = b * PT + 64 * c;
        const float m_c = Fl[MF_MC + c], m_n = Fl[MF_MC + c + 1], b63 = Fl[MF_B63 + c];
#pragma unroll
        for (int i = 0; i < 3; ++i) { const int q = tid + 512 * i; if (q < 67 * 16) *(LAS v4u*)(lds + ML_RQK + (q >> 4) * RPY + 16 * (q & 15)) = rq[i]; }
#pragma unroll
        for (int i = 0; i < 2; ++i) *(LAS v4u*)(lds + ML_RV + (ot + 32 * i) * RPY + 16 * og) = rv[i];
        if (c + 1 < NC) ML_LOAD_QKV(c + 1);
        ML_LOAD_O(c);
        __syncthreads();
        float kreg[8] = {0.f, 0.f, 0.f, 0.f, 0.f, 0.f, 0.f, 0.f};
        if (pvar != 3)
#pragma unroll
        for (int i = 0; i < 2; ++i) {
            const int g = w + 8 * i, t = lane;
            float x[4][8];
#pragma unroll
            for (int j = 0; j < 4; ++j) unpack8(*(const LAS v4u*)(lds + ML_RQK + (t + j) * RPY + 16 * g), x[j]);
            float val[8];
#pragma unroll
            for (int h2 = 0; h2 < 2; ++h2) { f32x4 a = *(const LAS f32x4*)(Fl + MF_CW + 4 * 128 + 8 * g + 4 * h2);
#pragma unroll
                for (int j = 0; j < 4; ++j) { const f32x4 cw = *(const LAS f32x4*)(Fl + MF_CW + j * 128 + 8 * g + 4 * h2);
                    a.x += cw.x * x[j][4 * h2]; a.y += cw.y * x[j][4 * h2 + 1]; a.z += cw.z * x[j][4 * h2 + 2]; a.w += cw.w * x[j][4 * h2 + 3]; }
                val[4 * h2] = siluf_(a.x); val[4 * h2 + 1] = siluf_(a.y); val[4 * h2 + 2] = siluf_(a.z); val[4 * h2 + 3] = siluf_(a.w); }
            if (i == 0) {
#pragma unroll
                for (int e = 0; e < 8; ++e) val[e] *= 0.125f;
                *(LAS v4u*)(lds + ML_Q + t * PBY + 16 * w) = pack8(val);
            } else { *(LAS v4u*)(lds + ML_K + t * PBY + 16 * w) = pack8(val);
#pragma unroll
                for (int e = 0; e < 8; ++e) kreg[e] = val[e]; }
            const v4u vw = *(const LAS v4u*)(lds + ML_RV + t * RPY + 16 * g);
            lds_u16* vt = (lds_u16*)(lds + ML_VT) + (8 * g) * 72 + t;
            vt[0 * 72] = (unsigned short)(vw.x & 0xffffu); vt[1 * 72] = (unsigned short)(vw.x >> 16); vt[2 * 72] = (unsigned short)(vw.y & 0xffffu); vt[3 * 72] = (unsigned short)(vw.y >> 16);
            vt[4 * 72] = (unsigned short)(vw.z & 0xffffu); vt[5 * 72] = (unsigned short)(vw.z >> 16); vt[6 * 72] = (unsigned short)(vw.w & 0xffffu); vt[7 * 72] = (unsigned short)(vw.w >> 16);
        }
        __syncthreads();
        if (pvar != 4) {
        { const float wsv = __expf(b63 + Fl[MF_GA + c * 64 + lane] - m_n); lds_u16* kt = (lds_u16*)(lds + ML_KT) + (8 * w) * 72 + lane;
#pragma unroll
          for (int e = 0; e < 8; ++e) kt[e * 72] = f2bf1(kreg[e] * wsv); }
        { const int tq = tid >> 3, p = tid & 7; float q8[8]; unpack8(*(const LAS v4u*)(lds + ML_Q + tq * PBY + 16 * p), q8);
          float dsum = 0.f;
#pragma unroll
          for (int e = 0; e < 8; ++e) dsum += q8[e] * Fl[MF_N + 8 * p + e];
          dsum = red8(dsum); if (p == 0) Fl[MF_QN + tq] = dsum; }
        { const int ti = w >> 1; float rs[4] = {0.f, 0.f, 0.f, 0.f};
#pragma unroll
          for (int jj = 0; jj < 2; ++jj) { const int sj = 2 * (w & 1) + jj; f32x4 acc = {0.f, 0.f, 0.f, 0.f};
#pragma unroll
              for (int ks = 0; ks < 2; ++ks) { const bf16x8 a = *(const LAS bf16x8*)(lds + ML_Q + (16 * ti + fr) * PBY + ks * 64 + fq * 16), bb = *(const LAS bf16x8*)(lds + ML_K + (16 * sj + fr) * PBY + ks * 64 + fq * 16);
                  acc = MFMA16(a, bb, acc); }
              const int s = 16 * sj + fr; const float as = Fl[MF_GA + c * 64 + s];
#pragma unroll
              for (int r = 0; r < 4; ++r) { const int t = 16 * ti + 4 * fq + r; const float val = s <= t ? acc[r] * __expf(as - fmaxf(m_c, Fl[MF_GP + c * 64 + t])) : 0.f;
                  ((lds_u16*)(lds + ML_S))[t * 72 + s] = f2bf1(val); rs[r] += val; } }
#pragma unroll
          for (int r = 0; r < 4; ++r) { const float x = red16(rs[r]); if (fr == 0) Fl[MF_RS + (16 * ti + 4 * fq + r) * 2 + (w & 1)] = x; } }
        }
        __syncthreads();
        float hv[4][4] = {};
        if (pvar != 5) { const int ti = w & 3; float wi[4], den[4], ei[4], hq[4];
#pragma unroll
          for (int r = 0; r < 4; ++r) { const int t = 16 * ti + 4 * fq + r; const float mx = fmaxf(m_c, Fl[MF_GP + c * 64 + t]); wi[r] = __expf(m_c - mx); ei[r] = __expf(-(Fl[MF_GB + c * 64 + t] + mx)); den[r] = wi[r] * Fl[MF_QN + t] + Fl[MF_RS + 2 * t] + Fl[MF_RS + 2 * t + 1]; hq[r] = 0.f; }
#pragma unroll
          for (int i = 0; i < 4; ++i) { const int vt = 4 * (w >> 2) + i; f32x4 accA = {0.f, 0.f, 0.f, 0.f}, accB = accA;
#pragma unroll
              for (int ks = 0; ks < 2; ++ks) {
                  const bf16x8 aq = *(const LAS bf16x8*)(lds + ML_Q + (16 * ti + fr) * PBY + ks * 64 + fq * 16), bc = *(const LAS bf16x8*)(lds + ML_C + (16 * vt + fr) * PBY + ks * 64 + fq * 16);
                  accA = MFMA16(aq, bc, accA);
                  const bf16x8 as = *(const LAS bf16x8*)(lds + ML_S + (16 * ti + fr) * PBY + ks * 64 + fq * 16), bv = *(const LAS bf16x8*)(lds + ML_VT + (16 * vt + fr) * PBY + ks * 64 + fq * 16);
                  accB = MFMA16(as, bv, accB); }
#pragma unroll
              for (int r = 0; r < 4; ++r) { const float num = wi[r] * accA[r] + accB[r]; const float hh_ = num * __builtin_amdgcn_rcpf(fmaxf(fabsf(den[r]), ei[r])); hv[i][r] = hh_; hq[r] += hh_ * hh_; } }
#pragma unroll
          for (int r = 0; r < 4; ++r) { const float x = red16(hq[r]); if (fr == 0) Fl[MF_HS + (16 * ti + 4 * fq + r) * 2 + (w >> 2)] = x; } }
        __syncthreads();
        if (pvar != 6) {
        { const int ti = w & 3;
#pragma unroll
          for (int r = 0; r < 4; ++r) { const int t = 16 * ti + 4 * fq + r; const float sc = __builtin_amdgcn_rsqf((Fl[MF_HS + 2 * t] + Fl[MF_HS + 2 * t + 1]) * (1.f / 128.f) + NORM_EPS);
#pragma unroll
              for (int i = 0; i < 4; ++i) ((lds_u16*)(lds + ML_HB))[t * (RPY / 2) + 16 * (4 * (w >> 2) + i) + fr] = f2bf1(hv[i][r] * sc); } }
        { const float wst = __expf(b63 + m_c - m_n);
#pragma unroll
          for (int kt = 0; kt < 4; ++kt) { Cacc[kt] = Cacc[kt] * wst;
#pragma unroll
              for (int ks = 0; ks < 2; ++ks) { const bf16x8 a = *(const LAS bf16x8*)(lds + ML_VT + (16 * w + fr) * PBY + ks * 64 + fq * 16), bb = *(const LAS bf16x8*)(lds + ML_KT + (16 * kt + fr) * PBY + ks * 64 + fq * 16);
                  Cacc[kt] = MFMA16(a, bb, Cacc[kt]); }
#pragma unroll
              for (int r = 0; r < 4; ++r) ((lds_u16*)(lds + ML_C))[(16 * w + 4 * fq + r) * 72 + 16 * kt + fr] = f2bf1(Cacc[kt][r]); }
          if (w == 0) { float sum = 0.f;
#pragma unroll
              for (int q = 0; q < 8; ++q) { float k8[8]; unpack8(*(const LAS v4u*)(lds + ML_KT + lane * PBY + 16 * q), k8);
#pragma unroll
                  for (int e = 0; e < 8; ++e) sum += k8[e]; }
              Fl[MF_N + lane] = wst * Fl[MF_N + lane] + sum; } }
        }
        __syncthreads();
        if (pvar != 7)
#pragma unroll
        for (int i = 0; i < 2; ++i) { const int t = ot + 32 * i; float h8[8], o8[8]; unpack8(*(const LAS v4u*)(lds + ML_HB + t * RPY + 16 * og), h8); unpack8(ro[i], o8);
#pragma unroll
            for (int e = 0; e < 8; ++e) h8[e] = h8[e] * nw[e] * o8[e];
            *(v4u*)(HOb + (size_t)(rowc + t) * D + hh * 128 + 8 * og) = pack8(h8); }
    }
#undef ML_LOAD_QKV
#undef ML_LOAD_O
#pragma unroll
    for (int kt = 0; kt < 4; ++kt)
#pragma unroll
        for (int r = 0; r < 4; ++r) out[O_P_C + ((size_t)(b * 8 + hh) * 128 + 16 * w + 4 * fq + r) * 64 + 16 * kt + fr] = Cacc[kt][r];
    if (w == 0) { out[O_P_N + (size_t)(b * 8 + hh) * 64 + lane] = Fl[MF_N + lane]; if (lane == 0) out[O_P_M + b * 8 + hh] = Fl[MF_MC + PT / 64]; }
    if (tid < 384) { const int j = tid >> 7, c = tid & 127, gc = c < 64 ? hh * 64 + c : 512 + hh * 64 + (c - 64);
        out[O_P_CONV + (size_t)(b * 3 + j) * D + gc] = bf1(QKR[(size_t)(b * PT + PT - 3 + j) * D + gc]); }
    __syncthreads();
}
__device__ __forceinline__ void mlstm_sample_item(const Frame& F, int b, int hh, const bf16* QKR, const bf16* VVb, const bf16* OOb, const float* IFb, bf16* HOb,
                                                  const float* conv_w, const float* conv_b, const float* norm_w, const float* C0, const float* n0, const float* m0p, const float* conv0, float* out) {
    LAS float* L = (LAS float*)F.lds;
    constexpr int LQ = 0, LK = 256, LV = 512, LS = 1024, LQN = 1040, LHS = 1048;
    const int tid = F.tid, lane = F.lane, w = F.wave, row0 = MP + 4 * b;
    float li[4], lf[4];
#pragma unroll
    for (int t = 0; t < 4; ++t) { li[t] = IFb[(size_t)(row0 + t) * 16 + hh]; lf[t] = IFb[(size_t)(row0 + t) * 16 + 8 + hh]; }
    const float m0 = m0p[b * 8 + hh];
    float bc[4], av[4], mt[4], wi[4], wsv[4], ei[4], bm[4];
    { float run = 0.f, pm = -3.0e38f;
#pragma unroll
      for (int t = 0; t < 4; ++t) { run += lf[t]; bc[t] = run; av[t] = li[t] - run; pm = fmaxf(pm, av[t]); mt[t] = fmaxf(run + m0, run + pm); } }
    const float m_new = mt[3], wst = __expf(bc[3] + m0 - m_new);
#pragma unroll
    for (int t = 0; t < 4; ++t) { wi[t] = __expf(bc[t] + m0 - mt[t]); wsv[t] = __expf(bc[3] + av[t] - m_new); ei[t] = __expf(-mt[t]); bm[t] = bc[t] - mt[t]; }
    { const int t = tid >> 7, c = tid & 127, gc = c < 64 ? hh * 64 + c : 512 + hh * 64 + (c - 64);
      float x[4];
#pragma unroll
      for (int j = 0; j < 4; ++j) { const int p = t + j; x[j] = p < 3 ? conv0[(size_t)(b * 3 + p) * D + gc] : bf1(QKR[(size_t)(row0 + p - 3) * D + gc]); }
      float a = conv_b[gc];
#pragma unroll
      for (int j = 0; j < 4; ++j) a += conv_w[j * D + gc] * x[j];
      const float val = siluf_(a);
      if (c < 64) L[LQ + t * 64 + c] = val * 0.125f; else L[LK + t * 64 + (c - 64)] = val;
      if (t >= 1) out[O_S_CONV + (size_t)(b * 3 + t - 1) * D + gc] = x[3];
      L[LV + t * 128 + c] = bf1(VVb[(size_t)(row0 + t) * D + hh * 128 + c]); }
    __syncthreads();
    if (w == 0) { const int pair = lane >> 2, t = pair >> 2, s = pair & 3, part = lane & 3; float dsum = 0.f;
#pragma unroll
        for (int e = 0; e < 16; ++e) dsum += L[LQ + t * 64 + 16 * part + e] * L[LK + s * 64 + 16 * part + e];
        dsum = red4(dsum);
        const float bmt = t == 0 ? bm[0] : (t == 1 ? bm[1] : (t == 2 ? bm[2] : bm[3])), avs = s == 0 ? av[0] : (s == 1 ? av[1] : (s == 2 ? av[2] : av[3]));
        if (part == 0) L[LS + pair] = s <= t ? dsum * __expf(bmt + avs) : 0.f; }
    if (w == 1) { const int t = lane >> 4, part = lane & 15; float dsum = 0.f;
#pragma unroll
        for (int e = 0; e < 4; ++e) dsum += L[LQ + t * 64 + 4 * part + e] * n0[(size_t)(b * 8 + hh) * 64 + 4 * part + e];
        dsum = red16(dsum); if (part == 0) L[LQN + t] = dsum; }
    __syncthreads();
    const int v = tid >> 2, kq = tid & 3;
    float hvv[4];
    { const size_t coff = ((size_t)(b * 8 + hh) * 128 + v) * 64 + 16 * kq;
      float c0[16];
#pragma unroll
      for (int e4 = 0; e4 < 4; ++e4) { const f32x4 x = *(const f32x4*)(C0 + coff + 4 * e4); c0[4 * e4] = x.x; c0[4 * e4 + 1] = x.y; c0[4 * e4 + 2] = x.z; c0[4 * e4 + 3] = x.w; }
#pragma unroll
      for (int t = 0; t < 4; ++t) { float part = 0.f;
#pragma unroll
          for (int e = 0; e < 16; ++e) part += c0[e] * L[LQ + t * 64 + 16 * kq + e];
          const float inter = red4(part);
          float num = wi[t] * inter, den = wi[t] * L[LQN + t];
#pragma unroll
          for (int s = 0; s < 4; ++s) { const float sm = L[LS + t * 4 + s]; num += sm * L[LV + s * 128 + v]; den += sm; }
          hvv[t] = num / fmaxf(fabsf(den), ei[t]); }
#pragma unroll
      for (int t = 0; t < 4; ++t) { const float x = wave_sum(kq == 0 ? hvv[t] * hvv[t] : 0.f); if (lane == 0) L[LHS + w * 4 + t] = x; }
      float cn[16];
#pragma unroll
      for (int e = 0; e < 16; ++e) { float a = wst * c0[e];
#pragma unroll
          for (int s = 0; s < 4; ++s) a += wsv[s] * L[LV + s * 128 + v] * L[LK + s * 64 + 16 * kq + e];
          cn[e] = a; }
#pragma unroll
      for (int e4 = 0; e4 < 4; ++e4) *(f32x4*)(out + O_S_C + coff + 4 * e4) = (f32x4){cn[4 * e4], cn[4 * e4 + 1], cn[4 * e4 + 2], cn[4 * e4 + 3]}; }
    __syncthreads();
    if (kq == 0) {
#pragma unroll
        for (int t = 0; t < 4; ++t) { float tot = 0.f;
#pragma unroll
            for (int ww = 0; ww < 8; ++ww) tot += L[LHS + ww * 4 + t];
            const float sc = 1.0f / sqrtf(tot * (1.f / 128.f) + NORM_EPS); const size_t off = (size_t)(row0 + t) * D + hh * 128 + v;
            HOb[off] = f2bf1(hvv[t] * sc * norm_w[hh * 128 + v] * bf1(OOb[off])); } }
    if (tid < 64) { float a = wst * n0[(size_t)(b * 8 + hh) * 64 + tid];
#pragma unroll
        for (int s = 0; s < 4; ++s) a += wsv[s] * L[LK + s * 64 + tid];
        out[O_S_N + (size_t)(b * 8 + hh) * 64 + tid] = a; }
    if (tid == 0) out[O_S_M + b * 8 + hh] = m_new;
    __syncthreads();
}

#ifndef MK_N_LAUNCHES
#define MK_N_LAUNCHES 1
#endif
constexpr int N_PHASES = 22;
#ifndef PROBE_PH
#define PROBE_PH (-1)
#define PROBE_N 1
#endif
#ifndef PROBE_VAR
#define PROBE_VAR 0
#endif
#ifndef EN_MASK
#define EN_MASK 0xff
#endif
constexpr bool EN_NORM = EN_MASK & 1, EN_UP = EN_MASK & 2, EN_RES = EN_MASK & 4, EN_RW = EN_MASK & 8, EN_L2 = EN_MASK & 16, EN_SCAN = EN_MASK & 32, EN_IN = EN_MASK & 64, EN_ML = EN_MASK & 128;
struct Args { const float* in[N_IN]; float* out; unsigned char* ws; int ph_lo, ph_hi; };
__global__ void __launch_bounds__(NWAVES * 64, 2) mega_fwd(Args args) {
    extern __shared__ __attribute__((aligned(16))) unsigned char lds_raw[];
    { const int t0 = threadIdx.x;
      for (int u = t0; u < (LDS_BYTES - LDSCTL_OFF) / 4; u += NWAVES * 64) ((LAS unsigned*)((LAS unsigned char*)lds_raw + LDSCTL_OFF))[u] = 0u; }
    __syncthreads();
    { const int t0 = threadIdx.x; if (t0 < N_IN) ((LAS unsigned long long*)((LAS unsigned char*)lds_raw + TAB_OFF))[t0] = (unsigned long long)args.in[t0]; }
    __syncthreads();
    XcdBarrier bar; bar.bar = (unsigned*)((gu32*)(args.ws + WS_CTL) + CW_BAR); bar.x = 0; bar.st = nullptr;
    if (args.ph_hi - args.ph_lo > 1) bar = xcd_barrier_post((unsigned*)((gu32*)(args.ws + WS_CTL) + CW_BAR), (volatile LAS unsigned*)((LAS unsigned char*)lds_raw + MISC_OFF) + 8);
    int ph = args.ph_lo, rep = 0;
    while (ph < args.ph_hi) {
        int tid_ = threadIdx.x; asm volatile("" : "+v"(tid_));
        unsigned char* ws = args.ws; float* out = args.out;
        Frame F;
        F.lds = (LAS unsigned char*)lds_raw;
        F.MISC = (volatile LAS unsigned*)(F.lds + MISC_OFF);
        F.tid = tid_; F.lane = F.tid & 63; F.wave = __builtin_amdgcn_readfirstlane(F.tid >> 6);
        F.G = gridDim.x; { const int bx = blockIdx.x; F.vcu = (F.G % 8 == 0) ? (bx % 8) * (F.G / 8) + bx / 8 : bx; }
        F.ctl = (gu32*)(ws + WS_CTL); F.tab = (volatile LAS unsigned long long*)(F.lds + TAB_OFF);
        bf16* Wb = (bf16*)(ws + WS_W); float* XR = (float*)(ws + WS_XR); unsigned char* big = ws + WS_BIG;
        bf16* Hb = (bf16*)(big + B_H); bf16* XN = (bf16*)(big + B_XN); float* SLAB = (float*)(big + B_SLAB);
        bf16* ACAT = (bf16*)(big + B_ACAT); bf16* Rb = (bf16*)(big + B_R); bf16* Kb = (bf16*)(big + B_K); bf16* Vb = (bf16*)(big + B_V); bf16* DECb = (bf16*)(big + B_DEC); bf16* AAb = (bf16*)(big + B_AA);
        bf16* QKR = (bf16*)(big + B_QKR); bf16* VVb = (bf16*)(big + B_VV); bf16* HOb = (bf16*)(big + B_HO); bf16* OOb = (bf16*)(big + B_OO); float* IFb = (float*)(big + B_IF);
        bf16* GGb = (bf16*)((unsigned char*)out + OS_GG); bf16* LORA = (bf16*)((unsigned char*)out + OS_LORA);
        const int c_id = (int)blockIdx.x;
        const int nrep = ph == PROBE_PH ? PROBE_N : 1;
        const int pvar = (rep + 1 < nrep) ? PROBE_VAR : 0;
        if (EN_NORM && (ph == 0 || ph == 3 || ph == 8 || ph == 11 || ph == 14 || ph == 18 || ph == 21)) {
            int kind = 0, layer = 0, ab = 0, nslab = 0; float coef = 0.5f; const float* gain = nullptr;
            if (ph == 0) { kind = 0; layer = 0; ab = 0; gain = inptr(F, I_NFA); nslab = 0; }
            else if (ph == 3) { kind = 1; gain = inptr(F, I_NMIX); nslab = 11; }
            else if (ph == 8) { kind = 0; layer = 0; ab = 1; gain = inptr(F, I_NFB); nslab = 4; coef = 1.f; }
            else if (ph == 11) { kind = 0; layer = 1; ab = 0; gain = inptr(F, I_NFA) + D; nslab = 11; }
            else if (ph == 14) { kind = 2; gain = inptr(F, I_NMIX) + D; nslab = 11; }
            else if (ph == 18) { kind = 0; layer = 1; ab = 1; gain = inptr(F, I_NFB) + D; nslab = 4; coef = 1.f; }
            else { kind = -1; gain = inptr(F, I_NFIN); nslab = 11; }
            if (kind >= 0) convert_weights(F, kind, layer, ab, Wb);
            const float* base_p = ph == 0 ? inptr(F, I_XP) : XR; const float* base_s = (ph == 0 || ph == 3) ? inptr(F, I_XS) : XR + (size_t)MP * D;
            if (ph == 3) norm_rows<1>(F, base_p, base_s, nslab, coef, SLAB, XR, gain, ACAT, inptr(F, I_RSHIFT), out);
            else if (ph == 21) norm_rows<2>(F, base_p, base_s, nslab, coef, SLAB, XR, gain, nullptr, nullptr, out);
            else norm_rows<0>(F, base_p, base_s, nslab, coef, SLAB, XR, gain, XN, nullptr, out);
        } else if (EN_UP && (ph == 1 || ph == 9 || ph == 12 || ph == 19)) {
            pg8::Gemm g{XN, Wb + W_GU / 2, M, 2 * FF, D}; pg8::UnitOrder S; S.init(M / 256, 2 * FF / 256, D, F.G, c_id, 0);
            EpiSwiglu E{Hb};
            pg8::gemm_phase<EpiSwiglu, pg8::UnitOrder, true, true>(F.lds, g, S, E, F.tid);
        } else if (EN_RES && (ph == 2 || ph == 7 || ph == 10 || ph == 13 || ph == 17 || ph == 20)) {
            const bf16* A = Hb; const bf16* Bt = Wb + W_D / 2; int K = FF; float coef = 0.5f; const float* base = XR;
            if (ph == 2) base = inptr(F, I_XP);
            if (ph == 7) { A = GGb; Bt = Wb + W_O / 2; K = D; coef = 1.f; }
            if (ph == 17) { A = HOb; Bt = Wb + W_OUT / 2; K = D; coef = 1.f; }
            pg8::Gemm g{A, Bt, M, D, K}; pg8::UnitOrder S; S.init(MP / 256, D / 256, K, F.G, c_id, K / 256);
            EpiRes E{base, XR, SLAB, coef};
            pg8::gemm_phase<EpiRes, pg8::UnitOrder, true, true>(F.lds, g, S, E, F.tid);
        } else if (EN_RW && ph == 4) {
            pg8::Gemm g{ACAT, Wb + W_RW / 2, M, NRW, KRW}; pg8::UnitOrder S; S.init(M / 256, NRW / 256, KRW, F.G, c_id, 0);
            EpiRw E{Rb, Kb, Vb, LORA};
            pg8::gemm_phase<EpiRw, pg8::UnitOrder, true, true>(F.lds, g, S, E, F.tid);
        } else if (EN_L2 && ph == 5) {
            pg8::Gemm g{LORA, Wb + W_L2 / 2, M, NL2, KL2}; pg8::UnitOrder S; S.init(M / 256, NL2 / 256, KL2, F.G, c_id, 0);
            EpiL2 E{DECb, AAb, GGb, inptr(F, I_W0), inptr(F, I_A0)};
            pg8::gemm_phase<EpiL2, pg8::UnitOrder, true, true>(F.lds, g, S, E, F.tid);
        } else if (EN_SCAN && ph == 6) {
            const int Hh = F.G >= 256 ? 128 : (F.G / 2 > 0 ? F.G / 2 : 1);
            if (F.vcu < Hh && pvar != 2) {
                for (int i = F.vcu; i < PB * 16; i += Hh) { const int b = i >> 4, h = i & 15;
                    rwkv_chain(F, b * PT, PT, h, nullptr, out + O_P_S + (size_t)i * 4096, Rb, Kb, Vb, DECb, AAb, GGb, inptr(F, I_KK), inptr(F, I_KA), inptr(F, I_RK), inptr(F, I_GNW), inptr(F, I_GNB), rep + 1 == nrep, pvar); }
            }
            if ((F.vcu >= Hh || F.G == 1) && pvar != 1) {
                const int st = F.G == 1 ? 1 : F.G - Hh;
                for (int i = F.G == 1 ? 0 : F.vcu - Hh; i < SB * 16; i += st) { const int b = i >> 4, h = i & 15;
                    rwkv_chain(F, MP + b * STK, STK, h, inptr(F, I_RS) + (size_t)i * 4096, out + O_S_S + (size_t)i * 4096, Rb, Kb, Vb, DECb, AAb, GGb, inptr(F, I_KK), inptr(F, I_KA), inptr(F, I_RK), inptr(F, I_GNW), inptr(F, I_GNB), rep + 1 == nrep, pvar); }
            }
        } else if (EN_IN && ph == 15) {
            pg8::Gemm g{XN, Wb + W_IN / 2, M, NIN, D}; pg8::UnitOrder S; S.init(M / 256, NIN / 256, D, F.G, c_id, 0);
            EpiIn E{QKR, VVb, OOb, IFb, inptr(F, I_BIF)};
            pg8::gemm_phase<EpiIn, pg8::UnitOrder, true, true>(F.lds, g, S, E, F.tid);
        } else if (EN_ML && ph == 16) {
            const int Hh = F.G >= 128 ? 64 : (F.G / 2 > 0 ? F.G / 2 : 1);
            if (F.vcu < Hh && pvar != 2) {
                for (int i = F.vcu; i < PB * 8; i += Hh) mlstm_prompt_chain(F, i >> 3, i & 7, QKR, VVb, OOb, IFb, HOb, inptr(F, I_CW), inptr(F, I_CB), inptr(F, I_MNW), out, pvar);
            }
            if ((F.vcu >= Hh || F.G == 1) && pvar != 1 && pvar < 3) {
                const int st = F.G == 1 ? 1 : F.G - Hh;
                for (int i = F.G == 1 ? 0 : F.vcu - Hh; i < SB * 8; i += st)
                    mlstm_sample_item(F, i >> 3, i & 7, QKR, VVb, OOb, IFb, HOb, inptr(F, I_CW), inptr(F, I_CB), inptr(F, I_MNW), inptr(F, I_MC), inptr(F, I_MN), inptr(F, I_MM), inptr(F, I_MCONV), out);
            }
        }
        if (++rep < nrep) continue;
        rep = 0;
        if (ph + 1 < args.ph_hi) xcd_barrier(bar);
        ++ph;
    }
}

extern "C" void kernel_launch(void* const* d_in, const int* in_sizes, int n_in, void* d_out, int out_size, void* d_ws, size_t ws_size, hipStream_t stream) {
    static int grid = 0;
    if (grid == 0) {
        if (n_in != N_IN || out_size != (int)O_END || ws_size < WS_END) { fprintf(stderr, "kernel_launch: unexpected shapes (n_in %d, out %d, ws %zu); nothing launched\n", n_in, out_size, ws_size); grid = -1; return; }
        int dev = 0, cus = 0, per_cu = 0;
        if (hipGetDevice(&dev) != hipSuccess || hipDeviceGetAttribute(&cus, hipDeviceAttributeMultiprocessorCount, dev) != hipSuccess) { grid = -1; return; }
        if (hipFuncSetAttribute((const void*)mega_fwd, hipFuncAttributeMaxDynamicSharedMemorySize, LDS_BYTES) != hipSuccess) { fprintf(stderr, "kernel_launch: hipFuncSetAttribute failed\n"); grid = -1; return; }
        if (hipOccupancyMaxActiveBlocksPerMultiprocessor(&per_cu, (const void*)mega_fwd, NWAVES * 64, LDS_BYTES) != hipSuccess || per_cu < 1) { fprintf(stderr, "kernel_launch: occupancy query says %d\n", per_cu); per_cu = 1; }
        (void)hipGetLastError();
        grid = cus;
    }
    if (grid < 0) return;
    (void)hipMemsetAsync((char*)d_ws + WS_CTL, 0, CTL_ZERO_BYTES, stream);
    Args a{};
    for (int i = 0; i < N_IN; ++i) a.in[i] = (const float*)d_in[i];
    a.out = (float*)d_out; a.ws = (unsigned char*)d_ws;
#if MK_N_LAUNCHES == 1
    a.ph_lo = 0; a.ph_hi = N_PHASES;
    { void* kargs[] = {(void*)&a};
      const hipError_t e = hipLaunchCooperativeKernel((const void*)mega_fwd, dim3(grid), dim3(NWAVES * 64), kargs, LDS_BYTES, stream);
      if (e != hipSuccess) fprintf(stderr, "kernel_launch: cooperative launch failed: %s (grid %d)\n", hipGetErrorString(e), grid); }
#else
    for (int p = 0; p < N_PHASES; ++p) { a.ph_lo = p; a.ph_hi = p + 1; hipLaunchKernelGGL(mega_fwd, dim3(grid), dim3(NWAVES * 64), LDS_BYTES, stream, a); }
#endif
}
```

```cpp
#include <hip/hip_runtime.h>
#include <cstdio>
#include <cstdint>
namespace pg8 {
#define PG8_LAS __attribute__((address_space(3)))
typedef unsigned short bf16_t;
typedef short bf16x8 __attribute__((ext_vector_type(8)));
typedef float f32x4 __attribute__((ext_vector_type(4)));
typedef unsigned u32x4 __attribute__((ext_vector_type(4)));
constexpr int BM = 256, BK = 64, HALF = 128, HTB = HALF * BK * 2  , STAGE_BYTES = 8 * HTB, NXCD = 8, WGM = 8;

__host__ __device__ __forceinline__ int lds_byte(int r, int c) { const int st = (r >> 4) * 2 + (c >> 5), rr = r & 15, cc = c & 31, ob = rr * 64 + cc * 2; return st * 1024 + (ob ^ (((ob >> 9) & 1) << 5)); }
__host__ __device__ __forceinline__ void stage_rc(int b, int& R, int& C) { const int st = b / 1024, sb = b % 1024, swz = sb ^ (((sb >> 9) & 1) << 5); R = (st >> 1) * 16 + swz / 64; C = (st & 1) * 32 + (swz % 64) / 2; }
__host__ __device__ __forceinline__ int perm32(int rho) { const int n = rho >> 4, i = rho & 15; return 8 * (i >> 2) + 4 * n + (i & 3); }

struct Unit { int pm, pn, k0, nt, slab; };
struct Gemm { const bf16_t* A; const bf16_t* Bt; int M, N, K; };

struct UnitOrder {
    int nM, nN, nwg, G, c, ntf, tailS;
    __device__ __forceinline__ void init(int nM_, int nN_, int K, int G_, int c_, int tailS_) { nM = nM_; nN = nN_; nwg = nM * nN; G = G_; c = c_; ntf = K / BK; tailS = tailS_; }
    __device__ __forceinline__ bool next(int i, Unit& u) const {
        long L = (long)i * G + c;
        if (L < nwg) {
            int wgid = (int)L; { const int q = nwg / NXCD, r = nwg % NXCD, xcd = wgid % NXCD, off = wgid / NXCD; wgid = (xcd < r ? xcd * (q + 1) : r * (q + 1) + (xcd - r) * q) + off; }
            const int nig = WGM * nN, gid = wgid / nig, fm = gid * WGM, gsz = (nM - fm) < WGM ? (nM - fm) : WGM;
            u.pm = fm + ((wgid % nig) % gsz); u.pn = (wgid % nig) / gsz; u.k0 = 0; u.nt = ntf; u.slab = -1;
            if (tailS < 0) { u.nt = 4; u.k0 = u.pn >= 8 ? 128 : 0; }
            return true;
        }
        L -= nwg; if (tailS <= 0 || L >= 8 * tailS) return false;
        int tile, sl; if (tailS == 4) { tile = (int)L >> 2; sl = (int)L & 3; } else { tile = (int)L / 11; sl = (int)L - 11 * tile; }
        u.pm = 64 + (tile >> 2); u.pn = tile & 3; u.k0 = sl * 256; u.nt = 4; u.slab = sl; return true;
    }
    __device__ __forceinline__ void a_ready(const Unit&) const {}
    __device__ __forceinline__ void done(const Unit&) const {}
};
template <class Epi, class Sched, bool ALIGN_EPI = false, bool SP2 = false>
__device__ __forceinline__ void gemm_phase(PG8_LAS unsigned char* lds, const Gemm g, const Sched& S, const Epi& E, const int tid) {
    const int wid = __builtin_amdgcn_readfirstlane(tid >> 6), lane = tid & 63, wr = wid >> 2, wc = wid & 3, fr = lane & 15, fq = lane >> 4;
    const int K = g.K;
    unsigned voffA[2], voffB[2];
#pragma unroll
    for (int i = 0; i < 2; ++i) { int R, C; stage_rc(tid * 16 + i * 8192, R, C); const int Rb = Epi::PERM ? ((R & ~31) + perm32(R & 31)) : R;
        voffA[i] = (unsigned)(R * K + C) * 2u; voffB[i] = (unsigned)(Rb * K + C) * 2u; }
    const size_t kstep = (size_t)(BK * 2);
    const size_t hstep = (size_t)HALF * K * 2;
    const size_t tstep = 2 * hstep;
    const unsigned ldsw = (unsigned)wid * 1024u;
    const int aoff = lds_byte(wr * 64 + fr, fq * 8), boff = lds_byte(wc * 32 + fr, fq * 8);
#define PG8_SA(b, h) (((b) * 2 + (h)) * HTB)
#define PG8_SB(b, h) ((4 + (b) * 2 + (h)) * HTB)
#define PG8_STAGE(bufoff, gbase, voff) do { _Pragma("unroll") for (int _i = 0; _i < 2; ++_i) \
        __builtin_amdgcn_global_load_lds((const unsigned*)((const char*)(gbase) + (voff)[_i]), (PG8_LAS unsigned*)(lds + (bufoff) + ldsw + _i * 8192), 16, 0, 0); } while (0)
#define PG8_LDA(dst, b, h) do { _Pragma("unroll") for (int m = 0; m < 4; ++m) _Pragma("unroll") for (int k = 0; k < 2; ++k) dst[m][k] = *(const PG8_LAS bf16x8*)(lds + PG8_SA(b, h) + aoff + m * 2048 + k * 1024); } while (0)
#define PG8_LDB(dst, b, h) do { _Pragma("unroll") for (int n = 0; n < 2; ++n) _Pragma("unroll") for (int k = 0; k < 2; ++k) dst[n][k] = *(const PG8_LAS bf16x8*)(lds + PG8_SB(b, h) + boff + n * 2048 + k * 1024); } while (0)
#define PG8_MMA(ai, bj, At, Bt) do { __builtin_amdgcn_s_setprio(1); _Pragma("unroll") for (int m = 0; m < 4; ++m) _Pragma("unroll") for (int n = 0; n < 2; ++n) _Pragma("unroll") for (int k = 0; k < 2; ++k) \
        acc[ai][bj][m][n] = __builtin_amdgcn_mfma_f32_16x16x32_bf16(Bt[n][k], At[m][k], acc[ai][bj][m][n], 0, 0, 0); __builtin_amdgcn_s_setprio(0); } while (0)
#define PG8_WAIT_V(n) asm volatile("s_waitcnt vmcnt(" #n ")" ::: "memory")
#define PG8_WAIT_L(n) asm volatile("s_waitcnt lgkmcnt(" #n ")" ::: "memory")
#define PG8_BAR __builtin_amdgcn_s_barrier()
#define PG8_SCHED __builtin_amdgcn_sched_barrier(0)
    Unit cur, nxt; int ui = 0;
    if (!S.next(0, cur)) return;
    f32x4 acc[2][2][4][2];
#pragma unroll
    for (int a = 0; a < 2; ++a)
#pragma unroll
        for (int b = 0; b < 2; ++b)
#pragma unroll
            for (int m = 0; m < 4; ++m)
#pragma unroll
                for (int n = 0; n < 2; ++n) acc[a][b][m][n] = (f32x4){0.f, 0.f, 0.f, 0.f};
    bf16x8 At[4][2], B0[2][2], B1[2][2];
    const char* cA = (const char*)g.A + (size_t)cur.pm * tstep + (size_t)cur.k0 * 2; const char* cB = (const char*)g.Bt + (size_t)cur.pn * tstep + (size_t)cur.k0 * 2;
    S.a_ready(cur);
    if constexpr (SP2) {
        PG8_STAGE(PG8_SB(0, 0), cB, voffB); PG8_STAGE(PG8_SB(0, 1), cB + hstep, voffB); PG8_STAGE(PG8_SA(0, 0), cA, voffA); PG8_STAGE(PG8_SA(0, 1), cA + hstep, voffA);
        if (wr == 1) PG8_BAR;
        PG8_WAIT_V(2); PG8_BAR;
        PG8_STAGE(PG8_SB(1, 0), cB + kstep, voffB); PG8_STAGE(PG8_SA(1, 0), cA + kstep, voffA); PG8_STAGE(PG8_SB(1, 1), cB + hstep + kstep, voffB);
        PG8_WAIT_V(6); PG8_BAR;
    } else {
        PG8_STAGE(PG8_SB(0, 0), cB, voffB); PG8_STAGE(PG8_SA(0, 0), cA, voffA); PG8_STAGE(PG8_SB(0, 1), cB + hstep, voffB); PG8_STAGE(PG8_SA(0, 1), cA + hstep, voffA);
        if (wr == 1) PG8_BAR;
        PG8_WAIT_V(4); PG8_BAR;
        PG8_STAGE(PG8_SB(1, 0), cB + kstep, voffB); PG8_STAGE(PG8_SA(1, 0), cA + kstep, voffA); PG8_STAGE(PG8_SB(1, 1), cB + hstep + kstep, voffB);
        PG8_WAIT_V(6); PG8_BAR;
    }
    for (;;) {
        const bool has_next = S.next(ui + 1, nxt);
        const char* nA = has_next ? (const char*)g.A + (size_t)nxt.pm * tstep + (size_t)nxt.k0 * 2 : cA; const char* nB = has_next ? (const char*)g.Bt + (size_t)nxt.pn * tstep + (size_t)nxt.k0 * 2 : cB;
        const int nt = cur.nt;
        for (int t = 0; t < nt; t += 2) {
            const bool last = (t == nt - 2);
            const char* a1 = cA + (size_t)(t + 1) * kstep;
            const char* a2 = last ? nA : cA + (size_t)(t + 2) * kstep; const char* b2 = last ? nB : cB + (size_t)(t + 2) * kstep;
            const char* a3 = a2 + kstep; const char* b3 = b2 + kstep;
            if (last && has_next) S.a_ready(nxt);
            if constexpr (SP2) {
            PG8_LDB(B0, 0, 0); PG8_LDB(B1, 0, 1); PG8_SCHED; PG8_LDA(At, 0, 0); PG8_STAGE(PG8_SA(1, 1), a1 + hstep, voffA);
            PG8_WAIT_V(8); PG8_WAIT_L(0); PG8_BAR; PG8_MMA(0, 0, At, B0); PG8_MMA(0, 1, At, B1); PG8_BAR; PG8_SCHED;
            PG8_LDA(At, 0, 1); PG8_STAGE(PG8_SB(0, 0), b2, voffB); PG8_STAGE(PG8_SB(0, 1), b2 + hstep, voffB); PG8_STAGE(PG8_SA(0, 0), a2, voffA);
            PG8_WAIT_V(8); PG8_WAIT_L(0); PG8_BAR; PG8_MMA(1, 0, At, B0); PG8_MMA(1, 1, At, B1); PG8_BAR; PG8_SCHED;
            PG8_LDB(B0, 1, 0); PG8_LDB(B1, 1, 1); PG8_SCHED; PG8_LDA(At, 1, 0); PG8_STAGE(PG8_SA(0, 1), a2 + hstep, voffA);
            PG8_WAIT_V(8); PG8_WAIT_L(0); PG8_BAR; PG8_MMA(0, 0, At, B0); PG8_MMA(0, 1, At, B1); PG8_BAR; PG8_SCHED;
            PG8_LDA(At, 1, 1); PG8_STAGE(PG8_SB(1, 0), b3, voffB); PG8_STAGE(PG8_SB(1, 1), b3 + hstep, voffB); PG8_STAGE(PG8_SA(1, 0), a3, voffA);
            PG8_WAIT_V(8); PG8_WAIT_L(0); PG8_BAR; PG8_MMA(1, 0, At, B0); PG8_MMA(1, 1, At, B1); PG8_BAR; PG8_SCHED;
            } else {
            PG8_LDB(B0, 0, 0); PG8_SCHED; PG8_LDA(At, 0, 0); PG8_STAGE(PG8_SA(1, 1), a1 + hstep, voffA);
            PG8_WAIT_L(8); PG8_BAR; PG8_WAIT_L(0); PG8_MMA(0, 0, At, B0); PG8_BAR; PG8_SCHED;
            PG8_LDB(B1, 0, 1); PG8_STAGE(PG8_SB(0, 0), b2, voffB);
            PG8_BAR; PG8_WAIT_L(0); PG8_MMA(0, 1, At, B1); PG8_BAR;
            PG8_LDA(At, 0, 1); PG8_STAGE(PG8_SA(0, 0), a2, voffA);
            PG8_BAR; PG8_WAIT_L(0); PG8_MMA(1, 0, At, B0); PG8_BAR; PG8_SCHED;
            PG8_STAGE(PG8_SB(0, 1), b2 + hstep, voffB);
            PG8_WAIT_V(6); PG8_BAR; PG8_MMA(1, 1, At, B1); PG8_BAR;
            PG8_LDB(B0, 1, 0); PG8_SCHED; PG8_LDA(At, 1, 0); PG8_STAGE(PG8_SA(0, 1), a2 + hstep, voffA);
            PG8_WAIT_L(8); PG8_BAR; PG8_WAIT_L(0); PG8_MMA(0, 0, At, B0); PG8_BAR; PG8_SCHED;
            PG8_LDB(B1, 1, 1); PG8_STAGE(PG8_SB(1, 0), b3, voffB);
            PG8_BAR; PG8_WAIT_L(0); PG8_MMA(0, 1, At, B1); PG8_BAR;
            PG8_LDA(At, 1, 1); PG8_STAGE(PG8_SA(1, 0), a3, voffA);
            PG8_BAR; PG8_WAIT_L(0); PG8_MMA(1, 0, At, B0); PG8_BAR; PG8_SCHED;
            PG8_STAGE(PG8_SB(1, 1), b3 + hstep, voffB);
            PG8_WAIT_V(6); PG8_BAR; PG8_MMA(1, 1, At, B1); PG8_BAR;
            }
        }
        if constexpr (ALIGN_EPI) { if (wr == 0) PG8_BAR; }
        if constexpr (!Epi::AFTER_DRAIN) { E(acc, cur, wr, wc, fr, fq); S.done(cur); }
        if (!has_next) break;
#pragma unroll
        for (int a = 0; a < 2; ++a)
#pragma unroll
            for (int b = 0; b < 2; ++b)
#pragma unroll
                for (int m = 0; m < 4; ++m)
#pragma unroll
                    for (int n = 0; n < 2; ++n) acc[a][b][m][n] = (f32x4){0.f, 0.f, 0.f, 0.f};
        cur = nxt; cA = nA; cB = nB; ++ui;
        if constexpr (ALIGN_EPI) { if (wr == 1) PG8_BAR; }
    }
    PG8_WAIT_V(0);
    if constexpr (!ALIGN_EPI) { if (wr == 0) PG8_BAR; }
    PG8_BAR;
    if constexpr (Epi::AFTER_DRAIN) { E.fused(acc, cur, wr, wc, fr, fq, lds, wid, lane); S.done(cur); }
#undef PG8_SA
#undef PG8_SB
#undef PG8_STAGE
#undef PG8_LDA
#undef PG8_LDB
#undef PG8_MMA
#undef PG8_WAIT_V
#undef PG8_WAIT_L
#undef PG8_BAR
#undef PG8_SCHED
}
}

#define GAS __attribute__((address_space(1)))
#define LAS __attribute__((address_space(3)))
typedef unsigned short bf16;
typedef unsigned v4u __attribute__((ext_vector_type(4)));
typedef float f32x4 __attribute__((ext_vector_type(4)));
typedef short bf16x8 __attribute__((ext_vector_type(8)));
typedef GAS unsigned gu32;
typedef GAS unsigned long long gu64;
#define RLX_AGENT __ATOMIC_RELAXED, __HIP_MEMORY_SCOPE_AGENT
#define LDS_WAIT() asm volatile("s_waitcnt lgkmcnt(0)" ::: "memory")
#define VM_WAIT() asm volatile("s_waitcnt vmcnt(0)" ::: "memory")
__device__ __forceinline__ unsigned long long rt() { return __builtin_amdgcn_s_memrealtime(); }
__device__ __forceinline__ unsigned f2bf(float f) { unsigned u = __builtin_bit_cast(unsigned, f); return (u + 0x7fffu + ((u >> 16) & 1u)) >> 16; }
__device__ __forceinline__ unsigned pk2(float lo, float hi) { return f2bf(lo) | (f2bf(hi) << 16); }

#define XB_TMO      128
#define XB_XCNT(j)  (256  + 64 * (j))
#define XB_XSUB(j)  (1280 + 64 * (j))
#define XB_XGEN(j)  (2304 + 64 * (j))
#define XB_TOP      3328
#define XB_TOPGEN   3392
#define XCD_BAR_WORDS 3456
#define XB_SPIN_CAP (1u << 18)

__device__ __forceinline__ unsigned xb_ld(unsigned* p)              { return __hip_atomic_load(p, __ATOMIC_RELAXED, __HIP_MEMORY_SCOPE_AGENT); }
__device__ __forceinline__ unsigned xb_add(unsigned* p, unsigned v) { return __hip_atomic_fetch_add(p, v, __ATOMIC_RELAXED, __HIP_MEMORY_SCOPE_AGENT); }
__device__ __forceinline__ unsigned xb_xcc_id() { return (unsigned)__builtin_amdgcn_s_getreg((3 << 11) | 20) & 0xFu; }
#define XB_SPIN(cond, bar) do { unsigned _sp = 0; while (cond) { __builtin_amdgcn_s_sleep(1); \
    if ((++_sp & 255u) == 0u) { if (xb_ld(&(bar)[XB_TMO])) break; if (_sp > XB_SPIN_CAP) { atomicAdd(&(bar)[XB_TMO], 1u); break; } } } } while (0)

struct XcdBarrier {
    unsigned* bar; unsigned x;
    volatile LAS unsigned* st;
};

__device__ __forceinline__ XcdBarrier xcd_barrier_post(unsigned* bar, volatile LAS unsigned* st) {
    XcdBarrier b; b.bar = bar; b.x = xb_xcc_id(); b.st = st;
    if (threadIdx.x == 0) (void)xb_add(&bar[XB_XCNT(b.x)], 1u);
    return b;
}
__device__ __forceinline__ void xcd_barrier_complete(unsigned* bar, unsigned x, unsigned& nloc, unsigned& nx) {
    const unsigned G = gridDim.x * gridDim.y * gridDim.z;
    unsigned sum, cnt, mine, sp = 0u;
    for (;;) {
        sum = 0u; cnt = 0u; mine = 0u;
#pragma unroll
        for (unsigned j = 0; j < 16; ++j) { const unsigned c = xb_ld(&bar[XB_XCNT(j)]); sum += c; cnt += (c > 0u) ? 1u : 0u; mine = (j == x) ? c : mine; }
        if (sum == G) break;
        __builtin_amdgcn_s_sleep(1);
        if ((++sp & 255u) == 0u) { if (xb_ld(&bar[XB_TMO])) break; if (sp > XB_SPIN_CAP) { atomicAdd(&bar[XB_TMO], 1u); break; } }
    }
    nloc = mine > 0u ? mine : 1u; nx = cnt > 0u ? cnt : 1u;
}

__device__ __forceinline__ void xcd_barrier(const XcdBarrier& b) {
    asm volatile("s_waitcnt vmcnt(0)" ::: "memory");
    __syncthreads();
    if (threadIdx.x == 0) {
        unsigned* bar = b.bar;
        __builtin_amdgcn_s_waitcnt(0);
        unsigned nloc = b.st[0], nx = b.st[1];
        if (nloc == 0u) { xcd_barrier_complete(bar, b.x, nloc, nx); b.st[0] = nloc; b.st[1] = nx; }
        const unsigned old = xb_add(&bar[XB_XSUB(b.x)], 1u);
        const unsigned gen = old / nloc;
        if (old + 1u == (gen + 1u) * nloc) {
            __builtin_amdgcn_fence(__ATOMIC_RELEASE, "agent");
            asm volatile("s_waitcnt vmcnt(0)" ::: "memory");
            const unsigned og = xb_add(&bar[XB_TOP], 1u);
            const unsigned tg = og / nx;
            if (og + 1u == (tg + 1u) * nx) xb_add(&bar[XB_TOPGEN], 1u);
            else XB_SPIN(xb_ld(&bar[XB_TOPGEN]) == tg, bar);
            __builtin_amdgcn_fence(__ATOMIC_ACQUIRE, "agent");
            xb_add(&bar[XB_XGEN(b.x)], 1u);
            asm volatile("s_waitcnt vmcnt(0)" ::: "memory");
        } else {
            XB_SPIN(xb_ld(&bar[XB_XGEN(b.x)]) == gen, bar);
            __builtin_amdgcn_fence(__ATOMIC_ACQUIRE, "agent");
            asm volatile("s_waitcnt vmcnt(0)" ::: "memory");
        }
    }
    __syncthreads();
}

constexpr int NWAVES = 8;
constexpr int D = 1024, FF = 2816;
constexpr int PB = 8, PT = 2048, SB = 128, STK = 4;
constexpr int MP = PB * PT, MS = SB * STK, M = MP + MS;
constexpr int NRW = 3584, KRW = 2048, NL2 = 3072, KL2 = 384, NIN = 3328;
constexpr float NORM_EPS = 1e-6f, GN_EPS = 64e-5f;
typedef pg8::bf16_t bf16;

constexpr size_t MiB = 1u << 20;
constexpr size_t WS_CTL = 0, CTL_ZERO_BYTES = 64 * 1024;
constexpr size_t WS_W = 1 * MiB;
constexpr size_t WS_XR = 20 * MiB;
constexpr size_t WS_BIG = 86 * MiB;
constexpr size_t WS_END = 256 * MiB;
constexpr size_t WS_YRAW = 256 * MiB, WS_BON = 288 * MiB, WS_END2 = 289 * MiB;
constexpr size_t W_GU = 0, W_D = (size_t)2 * FF * D * 2;
constexpr size_t W_RW = 0, W_L2 = (size_t)NRW * KRW * 2, W_O = W_L2 + (size_t)NL2 * KL2 * 2;
constexpr size_t W_IN = 0, W_OUT = (size_t)NIN * D * 2;
static_assert(W_D + (size_t)D * FF * 2 <= 19 * MiB && W_O + (size_t)D * D * 2 <= 19 * MiB && W_OUT + (size_t)D * D * 2 <= 19 * MiB, "weights region");
constexpr size_t B_H = 0, B_XN = 91 * MiB, B_SLAB = 124 * MiB;
constexpr size_t B_ACAT = 0, B_R = 66 * MiB, B_K = 99 * MiB, B_V = 132 * MiB, B_DEC = 0, B_AA = 33 * MiB;
constexpr size_t B_QKR = 0, B_VV = 33 * MiB, B_HO = 66 * MiB, B_OO = 124 * MiB, B_IF = 157 * MiB;
static_assert((size_t)M * FF * 2 <= 91 * MiB && (size_t)M * D * 2 == 33 * MiB && B_IF + (size_t)M * 16 * 4 <= 170 * MiB && B_SLAB + (size_t)11 * MS * D * 4 <= 170 * MiB, "BIG map");
constexpr size_t OS_GG = 0, OS_LORA = 33 * MiB;
static_assert(OS_LORA + (size_t)M * KL2 * 2 <= (size_t)MP * D * 4, "d_out scratch");
constexpr size_t O_Y = 0, O_P_S = 17301504, O_P_SHIFT = 17825792, O_P_C = 17833984, O_P_N = 18358272, O_P_M = 18362368, O_P_CONV = 18362432,
                 O_S_S = 18387008, O_S_SHIFT = 26775616, O_S_C = 26906688, O_S_N = 35295296, O_S_M = 35360832, O_S_CONV = 35361856, O_END = 35755072;
constexpr int CW_BAR = 1024;

constexpr int RING_BYTES = 131072, LDSCTL_OFF = RING_BYTES, MISC_OFF = LDSCTL_OFF + 320, TAB_OFF = LDSCTL_OFF + 1024, LDS_BYTES = 147456;

enum { I_XP = 0, I_XS, I_RS, I_RSHIFT, I_MC, I_MN, I_MM, I_MCONV, I_NFA, I_FAWG, I_FAWU, I_FAWD, I_NMIX, I_NFB, I_FBWG, I_FBWU, I_FBWD,
       I_MU, I_WR, I_WK, I_WV, I_WO, I_W0, I_W1, I_W2, I_A0, I_A1, I_A2, I_G1, I_G2, I_KK, I_KA, I_RK, I_GNW, I_GNB,
       I_WIN, I_BIF, I_CW, I_CB, I_MNW, I_WOUT, I_NFIN, N_IN };

typedef __bf16 bf16x2_t __attribute__((ext_vector_type(2)));
typedef float f32x2_t __attribute__((ext_vector_type(2)));
__device__ __forceinline__ unsigned pkbf(float lo, float hi) { f32x2_t v = {lo, hi}; bf16x2_t b = __builtin_convertvector(v, bf16x2_t); return __builtin_bit_cast(unsigned, b); }
__device__ __forceinline__ float bflo(unsigned u) { return __builtin_bit_cast(float, u << 16); }
__device__ __forceinline__ float bfhi(unsigned u) { return __builtin_bit_cast(float, u & 0xffff0000u); }
__device__ __forceinline__ float bf1(unsigned short u) { return __builtin_bit_cast(float, (unsigned)u << 16); }
__device__ __forceinline__ unsigned short f2bf1(float f) { return (unsigned short)(pkbf(f, 0.f) & 0xffffu); }
__device__ __forceinline__ void unpack8(v4u w, float (&o)[8]) { o[0] = bflo(w.x); o[1] = bfhi(w.x); o[2] = bflo(w.y); o[3] = bfhi(w.y); o[4] = bflo(w.z); o[5] = bfhi(w.z); o[6] = bflo(w.w); o[7] = bfhi(w.w); }
__device__ __forceinline__ v4u pack8(const float (&o)[8]) { v4u w; w.x = pkbf(o[0], o[1]); w.y = pkbf(o[2], o[3]); w.z = pkbf(o[4], o[5]); w.w = pkbf(o[6], o[7]); return w; }
__device__ __forceinline__ float sigmoidf_(float x) { return __builtin_amdgcn_rcpf(1.f + __expf(-x)); }
__device__ __forceinline__ float siluf_(float x) { return x * __builtin_amdgcn_rcpf(1.f + __expf(-x)); }
__device__ __forceinline__ float tanhf_(float x) { return 1.f - 2.f * __builtin_amdgcn_rcpf(__expf(2.f * x) + 1.f); }
__device__ __forceinline__ float logsigmoidf_(float x) { return fminf(x, 0.f) - log1pf(__expf(-fabsf(x))); }
template <int CTRL> __device__ __forceinline__ float dppf(float x) { return __builtin_bit_cast(float, __builtin_amdgcn_update_dpp(0, __builtin_bit_cast(int, x), CTRL, 0xF, 0xF, true)); }
__device__ __forceinline__ float red4(float x) { x += dppf<0xB1>(x); x += dppf<0x4E>(x); return x; }
__device__ __forceinline__ float red8(float x) { x = red4(x); x += dppf<0x141>(x); return x; }
__device__ __forceinline__ float red16(float x) { x = red8(x); x += dppf<0x140>(x); return x; }
__device__ __forceinline__ float wave_sum(float v) {
#pragma unroll
    for (int o = 1; o < 64; o <<= 1) v += __shfl_xor(v, o);
    return v;
}

struct Frame {
    LAS unsigned char* lds;
    volatile LAS unsigned* MISC;
    gu32* ctl;
    volatile LAS unsigned long long* tab;
    int tid, lane, wave, vcu, G;
};
__device__ __forceinline__ const float* inptr(const Frame& F, int i) { const unsigned long long v = F.tab[i];
    const unsigned lo = __builtin_amdgcn_readfirstlane((unsigned)v), hi = __builtin_amdgcn_readfirstlane((unsigned)(v >> 32)); return (const float*)(const GAS float*)(((unsigned long long)hi << 32) | lo); }

using pg8::Unit; using pg8::BM; using pg8::HALF;
__device__ __forceinline__ void st8bf(bf16* p, f32x4 v0, f32x4 v1) { v4u w; w.x = pkbf(v0[0], v0[1]); w.y = pkbf(v0[2], v0[3]); w.z = pkbf(v1[0], v1[1]); w.w = pkbf(v1[2], v1[3]); *(v4u*)p = w; }

struct EpiSwiglu {
    static constexpr bool PERM = true, AFTER_DRAIN = false;
    bf16* H; int pvar;
    __device__ __forceinline__ void operator()(const f32x4 (&acc)[2][2][4][2], const Unit& u, int wr, int wc, int fr, int fq) const {
        if (pvar == 3) return;
        const int row0 = u.pm * BM + wr * 64 + fr, col0 = u.pn * 128 + wc * 32 + 8 * fq;
#pragma unroll
        for (int ai = 0; ai < 2; ++ai)
#pragma unroll
            for (int m = 0; m < 4; ++m) {
                f32x4 o[2];
#pragma unroll
                for (int n = 0; n < 2; ++n)
#pragma unroll
                    for (int i = 0; i < 4; ++i) { const float g = acc[ai][0][m][n][i], up = acc[ai][1][m][n][i]; o[n][i] = siluf_(g) * up; }
                st8bf(H + (size_t)(row0 + ai * HALF + m * 16) * FF + col0, o[0], o[1]);
            }
    }
};
struct EpiRes {
    static constexpr bool PERM = false, AFTER_DRAIN = false;
    const float* base; float* out; float* slab; float coef;
    __device__ __forceinline__ void operator()(const f32x4 (&acc)[2][2][4][2], const Unit& u, int wr, int wc, int fr, int fq) const {
        const int row0 = u.pm * BM + wr * 64 + fr, col0 = u.pn * BM + wc * 32 + 4 * fq;
        if (u.slab < 0) {
#pragma unroll
            for (int ai = 0; ai < 2; ++ai)
#pragma unroll
                for (int m = 0; m < 4; ++m) { const size_t ro = (size_t)(row0 + ai * HALF + m * 16) * D + col0;
#pragma unroll
                    for (int bj = 0; bj < 2; ++bj)
#pragma unroll
                        for (int n = 0; n < 2; ++n) { const f32x4 b = *(const f32x4*)(base + ro + bj * HALF + n * 16); *(f32x4*)(out + ro + bj * HALF + n * 16) = b + acc[ai][bj][m][n] * coef; } }
        } else {
            float* sl = slab + (size_t)u.slab * MS * D;
#pragma unroll
            for (int ai = 0; ai < 2; ++ai)
#pragma unroll
                for (int m = 0; m < 4; ++m) { const size_t ro = (size_t)(row0 + ai * HALF + m * 16 - MP) * D + col0;
#pragma unroll
                    for (int bj = 0; bj < 2; ++bj)
#pragma unroll
                        for (int n = 0; n < 2; ++n) *(f32x4*)(sl + ro + bj * HALF + n * 16) = acc[ai][bj][m][n]; }
        }
    }
};
struct EpiRw {
    static constexpr bool PERM = true, AFTER_DRAIN = false;
    bf16 *R, *K, *V, *L;
    __device__ __forceinline__ void operator()(const f32x4 (&acc)[2][2][4][2], const Unit& u, int wr, int wc, int fr, int fq) const {
        const int row0 = u.pm * BM + wr * 64 + fr;
        if (u.pn < 12) {
            bf16 *p0 = R, *p1 = K, *p2 = V; asm volatile("" : "+s"(p0), "+s"(p1), "+s"(p2));
            bf16* dst = u.pn < 4 ? p0 : (u.pn < 8 ? p1 : p2); const int col0 = (u.pn & 3) * BM + wc * 32 + 8 * fq;
#pragma unroll
            for (int ai = 0; ai < 2; ++ai)
#pragma unroll
                for (int m = 0; m < 4; ++m) { bf16* rp = dst + (size_t)(row0 + ai * HALF + m * 16) * D + col0;
#pragma unroll
                    for (int bj = 0; bj < 2; ++bj) st8bf(rp + bj * HALF, acc[ai][bj][m][0], acc[ai][bj][m][1]); }
        } else {
#pragma unroll
            for (int bj = 0; bj < 2; ++bj) {
                const int lc = (u.pn - 12) * BM + bj * HALF + wc * 32 + 8 * fq;
                if (lc >= KL2) continue;
                const int act = lc < 64 ? 1 : (lc < 128 ? 0 : (lc < 288 ? 2 : 3));
#pragma unroll
                for (int ai = 0; ai < 2; ++ai)
#pragma unroll
                    for (int m = 0; m < 4; ++m) {
                        f32x4 o[2];
#pragma unroll
                        for (int n = 0; n < 2; ++n)
#pragma unroll
                            for (int i = 0; i < 4; ++i) { const float x = acc[ai][bj][m][n][i]; o[n][i] = act == 1 ? tanhf_(x) : (act == 0 ? x : (act == 2 ? sigmoidf_(x) : 0.f)); }
                        st8bf(L + (size_t)(row0 + ai * HALF + m * 16) * KL2 + lc, o[0], o[1]);
                    }
            }
        }
    }
};
struct EpiL2 {
    static constexpr bool PERM = true, AFTER_DRAIN = false;
    bf16 *DEC, *AA, *GG; const float *w0, *a0;
    __device__ __forceinline__ void operator()(const f32x4 (&acc)[2][2][4][2], const Unit& u, int wr, int wc, int fr, int fq) const {
        const int row0 = u.pm * BM + wr * 64 + fr, kind = u.pn >> 2, col0 = (u.pn & 3) * BM + wc * 32 + 8 * fq;
        bf16 *p0 = DEC, *p1 = AA, *p2 = GG; const float *q0 = w0, *q1 = a0; asm volatile("" : "+s"(p0), "+s"(p1), "+s"(p2), "+s"(q0), "+s"(q1));
        bf16* dst = kind == 0 ? p0 : (kind == 1 ? p1 : p2); const float* bias = kind == 0 ? q0 : q1;
#pragma unroll
        for (int bj = 0; bj < 2; ++bj) {
            f32x4 bv[2];
#pragma unroll
            for (int n = 0; n < 2; ++n) bv[n] = kind < 2 ? *(const f32x4*)(bias + col0 + bj * HALF + 4 * n) : (f32x4){0.f, 0.f, 0.f, 0.f};
#pragma unroll
            for (int ai = 0; ai < 2; ++ai)
#pragma unroll
                for (int m = 0; m < 4; ++m) {
                    f32x4 o[2];
#pragma unroll
                    for (int n = 0; n < 2; ++n)
#pragma unroll
                        for (int i = 0; i < 4; ++i) { const float z = acc[ai][bj][m][n][i] + bv[n][i];
                            o[n][i] = kind == 0 ? (1.f - __expf(-0.60653065971f * sigmoidf_(z))) : (kind == 1 ? sigmoidf_(z) : z); }
                    st8bf(dst + (size_t)(row0 + ai * HALF + m * 16) * D + col0 + bj * HALF, o[0], o[1]);
                }
        }
    }
};
struct EpiIn {
    static constexpr bool PERM = true, AFTER_DRAIN = false;
    bf16 *QKR, *VV, *OO; float* IF; const float* bif;
    __device__ __forceinline__ void operator()(const f32x4 (&acc)[2][2][4][2], const Unit& u, int wr, int wc, int fr, int fq) const {
        const int row0 = u.pm * BM + wr * 64 + fr;
        if (u.pn < 12) {
            bf16 *p0 = QKR, *p1 = VV, *p2 = OO; asm volatile("" : "+s"(p0), "+s"(p1), "+s"(p2));
            const int kind = u.pn >> 2; bf16* dst = kind == 0 ? p0 : (kind == 1 ? p1 : p2); const int col0 = (u.pn & 3) * BM + wc * 32 + 8 * fq;
#pragma unroll
            for (int ai = 0; ai < 2; ++ai)
#pragma unroll
                for (int m = 0; m < 4; ++m) { bf16* rp = dst + (size_t)(row0 + ai * HALF + m * 16) * D + col0;
#pragma unroll
                    for (int bj = 0; bj < 2; ++bj) { f32x4 a = acc[ai][bj][m][0], b = acc[ai][bj][m][1];
                        if (kind == 2) {
#pragma unroll
                            for (int i = 0; i < 4; ++i) { a[i] = sigmoidf_(a[i]); b[i] = sigmoidf_(b[i]); } }
                        st8bf(rp + bj * HALF, a, b); } }
        } else if (u.pn == 12 && wc == 0 && fq < 2) {
            const f32x4 b0 = *(const f32x4*)(bif + 8 * fq), b1 = *(const f32x4*)(bif + 8 * fq + 4);
#pragma unroll
            for (int ai = 0; ai < 2; ++ai)
#pragma unroll
                for (int m = 0; m < 4; ++m) { f32x4 a = acc[ai][0][m][0] + b0, b = acc[ai][0][m][1] + b1;
                    if (fq == 1) {
#pragma unroll
                        for (int i = 0; i < 4; ++i) { a[i] = logsigmoidf_(a[i]); b[i] = logsigmoidf_(b[i]); } }
                    float* rp = IF + (size_t)(row0 + ai * HALF + m * 16) * 16 + 8 * fq; *(f32x4*)rp = a; *(f32x4*)(rp + 4) = b; }
        }
    }
};

struct CJ { const float* W; const float* sc; bf16* WT; int K, N, Npad, ldk, koff, rmode, roff, smode; };
__device__ __forceinline__ int cj_items(const CJ& j) { return (j.K / 64) * (j.Npad / 32); }
__device__ __forceinline__ void conv_item(const CJ& J, LAS float* scr, int item, int lane) {
    const int nblk = J.Npad / 32, kb = item / nblk, nb = item % nblk, k0 = 64 * kb, n0 = 32 * nb;
    const int nn = n0 + (lane & 31); const bool nok = nn < J.N;
#pragma unroll 8
    for (int i = 0; i < 32; ++i) { const int kk = 2 * i + (lane >> 5); float w = nok ? J.W[(size_t)(k0 + kk) * J.N + nn] : 0.f;
        if (J.smode) { const float s = J.sc[k0 + kk]; w *= (J.smode == 1 ? s : 1.f - s); }
        scr[kk * 33 + (lane & 31)] = w; }
    LDS_WAIT(); asm volatile("" ::: "memory");
    const int rowbase = J.rmode == 0 ? J.roff + n0 : (n0 >> 7) * 256 + (n0 & 127) + J.roff;
    const int c = lane & 7;
#pragma unroll
    for (int j = 0; j < 4; ++j) { const int n = (lane >> 3) + 8 * j; const LAS float* s = scr + (8 * c) * 33 + n;
        v4u o; o.x = pkbf(s[0 * 33], s[1 * 33]); o.y = pkbf(s[2 * 33], s[3 * 33]); o.z = pkbf(s[4 * 33], s[5 * 33]); o.w = pkbf(s[6 * 33], s[7 * 33]);
        *(GAS v4u*)(J.WT + (size_t)(rowbase + n) * J.ldk + J.koff + k0 + 8 * c) = o; }
    LDS_WAIT(); asm volatile("" ::: "memory");
}
__device__ __forceinline__ CJ get_job(const Frame& F, int kind, int j, int layer, int ab, bf16* Wb) {
    CJ J; J.sc = nullptr; J.smode = 0; J.koff = 0; J.rmode = 0; J.roff = 0;
    if (kind == 0) {
        const float* wg = inptr(F, ab ? I_FBWG : I_FAWG) + (size_t)layer * D * FF; const float* wu = inptr(F, ab ? I_FBWU : I_FAWU) + (size_t)layer * D * FF; const float* wd = inptr(F, ab ? I_FBWD : I_FAWD) + (size_t)layer * D * FF;
        if (j < 2) { J.W = j == 0 ? wg : wu; J.K = D; J.N = FF; J.Npad = FF; J.WT = Wb + W_GU / 2; J.ldk = D; J.rmode = 1; J.roff = j == 0 ? 0 : 128; }
        else { J.W = wd; J.K = FF; J.N = D; J.Npad = D; J.WT = Wb + W_D / 2; J.ldk = FF; }
    } else if (kind == 1) {
        if (j < 12) {
            const int s = j >> 1, half = j & 1;
            J.W = inptr(F, s == 0 ? I_WR : (s == 1 ? I_WK : (s == 2 ? I_WV : (s == 3 ? I_W1 : (s == 4 ? I_A1 : I_G1)))));
            J.N = s < 3 ? 1024 : (s < 5 ? 64 : 160); J.Npad = s < 3 ? 1024 : (s < 5 ? 64 : 384);
            J.roff = s < 3 ? 1024 * s : (s == 3 ? 3072 : (s == 4 ? 3136 : 3200));
            const int mui = s == 0 ? 0 : (s == 1 ? 2 : (s == 2 ? 3 : (s == 3 ? 1 : (s == 4 ? 4 : 5))));
            J.sc = inptr(F, I_MU) + mui * D; J.smode = half ? 1 : 2; J.koff = half * D; J.K = D; J.ldk = KRW; J.WT = Wb + W_RW / 2;
        } else { J.W = inptr(F, I_WO); J.K = D; J.N = D; J.Npad = D; J.WT = Wb + W_O / 2; J.ldk = D; }
    } else {
        if (j == 0) { J.W = inptr(F, I_WIN); J.K = D; J.N = 3088; J.Npad = NIN; J.WT = Wb + W_IN / 2; J.ldk = D; }
        else { J.W = inptr(F, I_WOUT); J.K = D; J.N = D; J.Npad = D; J.WT = Wb + W_OUT / 2; J.ldk = D; }
    }
    return J;
}
__device__ __forceinline__ void convert_weights(const Frame& F, int kind, int layer, int ab, bf16* Wb) {
    LAS float* scr = (LAS float*)(F.lds + F.wave * 16384);
    const int gw = F.vcu * NWAVES + F.wave, NGW = F.G * NWAVES;
    const int njobs = kind == 0 ? 3 : (kind == 1 ? 13 : 2);
    int total = 0;
    for (int j = 0; j < njobs; ++j) { const CJ J = get_job(F, kind, j, layer, ab, Wb); total += cj_items(J); }
    for (int g = gw; g < total; g += NGW) {
        int r = g, j = 0; CJ J = get_job(F, kind, 0, layer, ab, Wb);
        while (r >= cj_items(J)) { r -= cj_items(J); ++j; J = get_job(F, kind, j, layer, ab, Wb); }
        conv_item(J, scr, r, F.lane);
    }
    if (kind == 1) {
        bf16* WT = Wb + W_L2 / 2; const float* w2 = inptr(F, I_W2); const float* a2 = inptr(F, I_A2); const float* g2 = inptr(F, I_G2);
        for (int idx = (F.vcu * NWAVES + F.wave) * 64 + F.lane; idx < 48 * NL2; idx += F.G * NWAVES * 64) {
            const int c = idx / NL2, n = idx % NL2, type = n >> 10, jj = n & 1023;
            const float* src = nullptr;
            if (type == 0 && c < 8) src = w2 + (size_t)(8 * c) * D + jj;
            else if (type == 1 && c >= 8 && c < 16) src = a2 + (size_t)(8 * (c - 8)) * D + jj;
            else if (type == 2 && c >= 16 && c < 36) src = g2 + (size_t)(8 * (c - 16)) * D + jj;
            float v[8];
#pragma unroll
            for (int e = 0; e < 8; ++e) v[e] = src ? src[(size_t)e * D] : 0.f;
            *(GAS v4u*)(WT + (size_t)n * KL2 + 8 * c) = pack8(v);
        }
    }
}

template <int MODE>
__device__ __forceinline__ void norm_rows(const Frame& F, const float* base_p, const float* base_s, int nslab, float coef, const float* slab, float* xr,
                                          const float* gain, bf16* dst, const float* shift_in, float* out) {
    const int gw = F.vcu * NWAVES + F.wave, NGW = F.G * NWAVES, lane = F.lane;
    f32x4 gv[4];
#pragma unroll
    for (int j = 0; j < 4; ++j) gv[j] = *(const f32x4*)(gain + 256 * j + 4 * lane);
    for (int m = gw; m < M; m += NGW) {
        const bool samp = m >= MP;
        const float* src = samp ? base_s + (size_t)(m - MP) * D : base_p + (size_t)m * D;
        f32x4 v[4];
#pragma unroll
        for (int j = 0; j < 4; ++j) v[j] = *(const f32x4*)(src + 256 * j + 4 * lane);
        if (samp && nslab > 0) {
            for (int s = 0; s < nslab; ++s) { const float* sp = slab + ((size_t)s * MS + (m - MP)) * D;
#pragma unroll
                for (int j = 0; j < 4; ++j) v[j] += *(const f32x4*)(sp + 256 * j + 4 * lane) * coef; }
            if (MODE != 2) {
#pragma unroll
                for (int j = 0; j < 4; ++j) *(f32x4*)(xr + (size_t)m * D + 256 * j + 4 * lane) = v[j]; }
        }
        float ss = 0.f;
#pragma unroll
        for (int j = 0; j < 4; ++j) ss += (v[j].x * v[j].x + v[j].y * v[j].y) + (v[j].z * v[j].z + v[j].w * v[j].w);
        const float r = 1.0f / sqrtf(wave_sum(ss) * (1.f / D) + NORM_EPS);
#pragma unroll
        for (int j = 0; j < 4; ++j) v[j] = v[j] * r * gv[j];
        if (MODE == 2) {
#pragma unroll
            for (int j = 0; j < 4; ++j) *(f32x4*)(out + O_Y + (size_t)m * D + 256 * j + 4 * lane) = v[j];
        } else if (MODE == 0) {
#pragma unroll
            for (int j = 0; j < 4; ++j) { const unsigned long long w = (unsigned long long)pkbf(v[j].x, v[j].y) | ((unsigned long long)pkbf(v[j].z, v[j].w) << 32);
                *(unsigned long long*)(dst + (size_t)m * D + 256 * j + 4 * lane) = w; }
        } else {
            int t, b; bool first, last;
            if (!samp) { t = m & (PT - 1); b = m >> 11; first = t == 0; last = t == PT - 1; } else { const int mm = m - MP; t = mm & 3; b = mm >> 2; first = t == 0; last = t == 3; }
#pragma unroll
            for (int j = 0; j < 4; ++j) { const unsigned long long w = (unsigned long long)pkbf(v[j].x, v[j].y) | ((unsigned long long)pkbf(v[j].z, v[j].w) << 32);
                *(unsigned long long*)(dst + (size_t)m * (2 * D) + 256 * j + 4 * lane) = w;
                if (!last) *(unsigned long long*)(dst + (size_t)(m + 1) * (2 * D) + D + 256 * j + 4 * lane) = w;
                else *(f32x4*)(out + (samp ? O_S_SHIFT : O_P_SHIFT) + (size_t)b * D + 256 * j + 4 * lane) = v[j];
                if (first) { unsigned long long z = 0ull;
                    if (samp) { const f32x4 s = *(const f32x4*)(shift_in + (size_t)b * D + 256 * j + 4 * lane); z = (unsigned long long)pkbf(s.x, s.y) | ((unsigned long long)pkbf(s.z, s.w) << 32); }
                    *(unsigned long long*)(dst + (size_t)m * (2 * D) + D + 256 * j + 4 * lane) = z; }
            }
        }
    }
}

constexpr int RW_KK = 0, RW_DD = 4096, RW_BB = 8192, RW_KP = 12288, RW_RR = 16384, RW_VV = 20480, RW_YY = 24576;
__device__ __forceinline__ void rwkv_chain(const Frame& F, int row0, int T, int h, const float* S0, float* ST,
                                           const bf16* Rb, const bf16* Kb, const bf16* Vb, const bf16* Db, const bf16* Ab, bf16* Gb,
                                           const float* k_k, const float* k_a, const float* r_k, const float* gn_w, const float* gn_b, const bool do_store, const int pvar) {
    LAS float* L = (LAS float*)F.lds;
    const int tid = F.tid, lane = F.lane, w = F.wave;
    const int cg = tid & 7, tt = tid >> 3;
    const int srow = 8 * w + (lane >> 3);
    float S[8];
    if (S0) { const f32x4 a = *(const f32x4*)(S0 + srow * 64 + 8 * cg), b = *(const f32x4*)(S0 + srow * 64 + 8 * cg + 4);
        S[0] = a.x; S[1] = a.y; S[2] = a.z; S[3] = a.w; S[4] = b.x; S[5] = b.y; S[6] = b.z; S[7] = b.w; }
    else {
#pragma unroll
        for (int j = 0; j < 8; ++j) S[j] = 0.f; }
    const int ch = h * 64 + 8 * cg;
    float ckk[8], cka[8], crk[8], cgw[8], cgb[8];
#pragma unroll
    for (int j = 0; j < 8; ++j) { ckk[j] = k_k[ch + j]; cka[j] = k_a[ch + j]; crk[j] = r_k[ch + j]; cgw[j] = gn_w[ch + j]; cgb[j] = gn_b[ch + j]; }
    const int nch = (T + 63) >> 6;
    v4u pr = {0, 0, 0, 0}, pk = pr, pv = pr, pd = pr, pa = pr, pg = pr;
    { const int nt0 = T < 64 ? T : 64;
      if (tt < nt0) { const size_t off = (size_t)(row0 + tt) * D + ch;
          pr = *(const v4u*)(Rb + off); pk = *(const v4u*)(Kb + off); pv = *(const v4u*)(Vb + off); pd = *(const v4u*)(Db + off); pa = *(const v4u*)(Ab + off); pg = *(const v4u*)(Gb + off); } }
    float bon = 0.f, vv[8], gg[8];
    for (int c = 0; c < nch; ++c) {
        const int nt = (T - 64 * c) < 64 ? (T - 64 * c) : 64;
        const bool valid = tt < nt;
        {
            float r8[8], k8[8], d8[8], a8[8];
            unpack8(pr, r8); unpack8(pk, k8); unpack8(pv, vv); unpack8(pd, d8); unpack8(pa, a8); unpack8(pg, gg);
            float kk[8], ss = 0.f;
#pragma unroll
            for (int j = 0; j < 8; ++j) { kk[j] = k8[j] * ckk[j]; ss += kk[j] * kk[j]; }
            ss = red8(ss);
            const float inv = __builtin_amdgcn_rsqf(fmaxf(ss, 1e-24f));
            float kp[8], bsum = 0.f;
#pragma unroll
            for (int j = 0; j < 8; ++j) { kk[j] *= inv; kp[j] = k8[j] * (1.f + (a8[j] - 1.f) * cka[j]); bsum += r8[j] * kp[j] * crk[j]; }
            bon = red8(bsum);
            if (valid) {
                LAS float* p = L + tt * 64 + 8 * cg;
                *(LAS f32x4*)(p + RW_KK) = (f32x4){-kk[0], -kk[1], -kk[2], -kk[3]}; *(LAS f32x4*)(p + RW_KK + 4) = (f32x4){-kk[4], -kk[5], -kk[6], -kk[7]};
                *(LAS f32x4*)(p + RW_DD) = (f32x4){1.f - d8[0], 1.f - d8[1], 1.f - d8[2], 1.f - d8[3]}; *(LAS f32x4*)(p + RW_DD + 4) = (f32x4){1.f - d8[4], 1.f - d8[5], 1.f - d8[6], 1.f - d8[7]};
                *(LAS f32x4*)(p + RW_BB) = (f32x4){kk[0] * a8[0], kk[1] * a8[1], kk[2] * a8[2], kk[3] * a8[3]}; *(LAS f32x4*)(p + RW_BB + 4) = (f32x4){kk[4] * a8[4], kk[5] * a8[5], kk[6] * a8[6], kk[7] * a8[7]};
                *(LAS f32x4*)(p + RW_KP) = (f32x4){kp[0], kp[1], kp[2], kp[3]}; *(LAS f32x4*)(p + RW_KP + 4) = (f32x4){kp[4], kp[5], kp[6], kp[7]};
                *(LAS f32x4*)(p + RW_RR) = (f32x4){r8[0], r8[1], r8[2], r8[3]}; *(LAS f32x4*)(p + RW_RR + 4) = (f32x4){r8[4], r8[5], r8[6], r8[7]};
                *(LAS f32x4*)(p + RW_VV) = (f32x4){vv[0], vv[1], vv[2], vv[3]}; *(LAS f32x4*)(p + RW_VV + 4) = (f32x4){vv[4], vv[5], vv[6], vv[7]};
            }
        }
        __syncthreads();
        if (c + 1 < nch) { const int nt1 = (T - 64 * (c + 1)) < 64 ? (T - 64 * (c + 1)) : 64;
            if (tt < nt1) { const size_t off = (size_t)(row0 + 64 * (c + 1) + tt) * D + ch;
                pr = *(const v4u*)(Rb + off); pk = *(const v4u*)(Kb + off); pv = *(const v4u*)(Vb + off); pd = *(const v4u*)(Db + off); pa = *(const v4u*)(Ab + off); pg = *(const v4u*)(Gb + off); } }
        {
            typedef float f2 __attribute__((ext_vector_type(2)));
            f2 S2[4] = {{S[0], S[1]}, {S[2], S[3]}, {S[4], S[5]}, {S[6], S[7]}};
            const LAS float* p = L + 8 * cg;
            LAS float* yw = L + RW_YY + srow;
            const LAS float* vp = L + RW_VV + srow;
#define RW_LD(N, Dd, B, Q, R, VR, t_) do { const LAS float* p_ = p + (t_) * 64; \
                N[0] = *(const LAS f32x4*)(p_ + RW_KK); N[1] = *(const LAS f32x4*)(p_ + RW_KK + 4); Dd[0] = *(const LAS f32x4*)(p_ + RW_DD); Dd[1] = *(const LAS f32x4*)(p_ + RW_DD + 4); \
                B[0] = *(const LAS f32x4*)(p_ + RW_BB); B[1] = *(const LAS f32x4*)(p_ + RW_BB + 4); Q[0] = *(const LAS f32x4*)(p_ + RW_KP); Q[1] = *(const LAS f32x4*)(p_ + RW_KP + 4); \
                R[0] = *(const LAS f32x4*)(p_ + RW_RR); R[1] = *(const LAS f32x4*)(p_ + RW_RR + 4); VR = vp[(t_) * 64]; } while (0)
#define RW_STEP(N, Dd, B, Q, R, VR, t_) do { \
                f2 a_ = S2[0] * (f2){N[0].x, N[0].y}; a_ = S2[1] * (f2){N[0].z, N[0].w} + a_; a_ = S2[2] * (f2){N[1].x, N[1].y} + a_; a_ = S2[3] * (f2){N[1].z, N[1].w} + a_; \
                const float sa_ = red8(a_.x + a_.y); const f2 sv_ = {sa_, sa_}, vv_ = {VR, VR}; \
                S2[0] = S2[0] * (f2){Dd[0].x, Dd[0].y} + (sv_ * (f2){B[0].x, B[0].y} + vv_ * (f2){Q[0].x, Q[0].y}); \
                S2[1] = S2[1] * (f2){Dd[0].z, Dd[0].w} + (sv_ * (f2){B[0].z, B[0].w} + vv_ * (f2){Q[0].z, Q[0].w}); \
                S2[2] = S2[2] * (f2){Dd[1].x, Dd[1].y} + (sv_ * (f2){B[1].x, B[1].y} + vv_ * (f2){Q[1].x, Q[1].y}); \
                S2[3] = S2[3] * (f2){Dd[1].z, Dd[1].w} + (sv_ * (f2){B[1].z, B[1].w} + vv_ * (f2){Q[1].z, Q[1].w}); \
                f2 y_ = S2[0] * (f2){R[0].x, R[0].y}; y_ = S2[1] * (f2){R[0].z, R[0].w} + y_; y_ = S2[2] * (f2){R[1].x, R[1].y} + y_; y_ = S2[3] * (f2){R[1].z, R[1].w} + y_; \
                yw[(t_) * 64] = red8(y_.x + y_.y); } while (0)
            f32x4 nA[2], dA[2], bA[2], qA[2], rA[2], nB[2], dB[2], bB[2], qB[2], rB[2]; float vA, vB;
            RW_LD(nA, dA, bA, qA, rA, vA, 0);
            int t = 0;
            if (pvar != 3)
            for (; t + 2 <= nt; t += 2) {
                RW_LD(nB, dB, bB, qB, rB, vB, t + 1);
                RW_STEP(nA, dA, bA, qA, rA, vA, t);
                RW_LD(nA, dA, bA, qA, rA, vA, (t + 2 < nt ? t + 2 : t + 1));
                RW_STEP(nB, dB, bB, qB, rB, vB, t + 1);
            }
            if (t < nt) RW_STEP(nA, dA, bA, qA, rA, vA, t);
#undef RW_LD
#undef RW_STEP
            S[0] = S2[0].x; S[1] = S2[0].y; S[2] = S2[1].x; S[3] = S2[1].y; S[4] = S2[2].x; S[5] = S2[2].y; S[6] = S2[3].x; S[7] = S2[3].y;
        }
        __syncthreads();
        if (pvar != 4) {
            f32x4 y0 = {0.f, 0.f, 0.f, 0.f}, y1 = y0;
            if (valid) { y0 = *(const LAS f32x4*)(L + RW_YY + tt * 64 + 8 * cg); y1 = *(const LAS f32x4*)(L + RW_YY + tt * 64 + 8 * cg + 4); }
            float yy[8] = {y0.x, y0.y, y0.z, y0.w, y1.x, y1.y, y1.z, y1.w};
            float s1 = 0.f;
#pragma unroll
            for (int j = 0; j < 8; ++j) s1 += yy[j];
            const float mean = red8(s1) * (1.f / 64.f);
            float s2 = 0.f;
#pragma unroll
            for (int j = 0; j < 8; ++j) { yy[j] -= mean; s2 += yy[j] * yy[j]; }
            const float rstd = __builtin_amdgcn_rsqf(red8(s2) * (1.f / 64.f) + GN_EPS);
            float o[8];
#pragma unroll
            for (int j = 0; j < 8; ++j) o[j] = ((yy[j] * rstd) * cgw[j] + cgb[j] + bon * vv[j]) * gg[j];
            if (valid && do_store) *(v4u*)(Gb + (size_t)(row0 + 64 * c + tt) * D + ch) = pack8(o);
        }
    }
    *(f32x4*)(ST + srow * 64 + 8 * cg) = (f32x4){S[0], S[1], S[2], S[3]}; *(f32x4*)(ST + srow * 64 + 8 * cg + 4) = (f32x4){S[4], S[5], S[6], S[7]};
    __syncthreads();
}

constexpr int RH_TC = 32, RH_BUF = 12288;
constexpr int RH_KK = 0, RH_DD = 2048, RH_BB = 4096, RH_KP = 6144, RH_RR = 8192, RH_VV = 10240, RH_YY = 11264;
__device__ __forceinline__ void rwkv_half_chain(const Frame& F, int b, int h, int half, float* ST, const bf16* Rb, const bf16* Kb, const bf16* Vb, const bf16* Db, const bf16* Ab,
                                                bf16* YRAW, float* BON, const float* k_k, const float* k_a, const float* r_k, const int pvar) {
    LAS float* L = (LAS float*)F.lds;
    const int tid = F.tid, lane = F.lane, w = F.wave, row0 = b * PT;
    constexpr int nch = PT / RH_TC;
    if (w < 4) {
        const int srow = 8 * w + (lane >> 3), cq = lane & 7;
        f32x4 S4 = {0.f, 0.f, 0.f, 0.f}, S5 = S4;
        __syncthreads();
        __builtin_amdgcn_s_setprio(3);
        for (int c = 0; c < nch; ++c) {
            const LAS float* p = L + (c & 1) * RH_BUF + 8 * cq;
            LAS float* yw = L + (c & 1) * RH_BUF + RH_YY + srow;
            const LAS float* vp = L + (c & 1) * RH_BUF + RH_VV + srow;
#define RH_LD(N, Dd, B, Q, R, VR, t_) do { const LAS float* p_ = p + (t_) * 64; \
                N[0] = *(const LAS f32x4*)(p_ + RH_KK); N[1] = *(const LAS f32x4*)(p_ + RH_KK + 4); Dd[0] = *(const LAS f32x4*)(p_ + RH_DD); Dd[1] = *(const LAS f32x4*)(p_ + RH_DD + 4); \
                B[0] = *(const LAS f32x4*)(p_ + RH_BB); B[1] = *(const LAS f32x4*)(p_ + RH_BB + 4); Q[0] = *(const LAS f32x4*)(p_ + RH_KP); Q[1] = *(const LAS f32x4*)(p_ + RH_KP + 4); \
                R[0] = *(const LAS f32x4*)(p_ + RH_RR); R[1] = *(const LAS f32x4*)(p_ + RH_RR + 4); VR = vp[(t_) * 32]; } while (0)
#define RH_STEP(N, Dd, B, Q, R, VR, t_) do { \
                const f32x4 pa_ = S4 * N[0] + S5 * N[1]; const float sa_ = red8((pa_.x + pa_.y) + (pa_.z + pa_.w)); \
                S4 = S4 * Dd[0] + (B[0] * sa_ + Q[0] * VR); S5 = S5 * Dd[1] + (B[1] * sa_ + Q[1] * VR); \
                const f32x4 ya_ = S4 * R[0] + S5 * R[1]; yw[(t_) * 32] = red8((ya_.x + ya_.y) + (ya_.z + ya_.w)); } while (0)
            f32x4 nA[2], dA[2], bA[2], qA[2], rA[2], nB[2], dB[2], bB[2], qB[2], rB[2]; float vA, vB;
            RH_LD(nA, dA, bA, qA, rA, vA, 0);
            if (pvar != 3)
            for (int t = 0; t < RH_TC; t += 2) {
                RH_LD(nB, dB, bB, qB, rB, vB, t + 1);
                RH_STEP(nA, dA, bA, qA, rA, vA, t);
                RH_LD(nA, dA, bA, qA, rA, vA, (t + 2 < RH_TC ? t + 2 : t + 1));
                RH_STEP(nB, dB, bB, qB, rB, vB, t + 1);
            }
#undef RH_LD
#undef RH_STEP
            __syncthreads();
        }
        __builtin_amdgcn_s_setprio(0);
        *(f32x4*)(ST + (32 * half + srow) * 64 + 8 * cq) = S4; *(f32x4*)(ST + (32 * half + srow) * 64 + 8 * cq + 4) = S5;
    } else {
        const int ht = tid - 256, cg = ht & 7, tt = ht >> 3;
        const int ch = h * 64 + 8 * cg, vch = h * 64 + 32 * half + 4 * cg;
        float ckk[8], cka[8], crk[8];
#pragma unroll
        for (int j = 0; j < 8; ++j) { ckk[j] = k_k[ch + j]; cka[j] = k_a[ch + j]; crk[j] = r_k[ch + j]; }
        v4u pr, pk, pd, pa; uint2 pv;
#define RH_LOAD(cc) do { const size_t off_ = (size_t)(row0 + RH_TC * (cc) + tt) * D; pr = *(const v4u*)(Rb + off_ + ch); pk = *(const v4u*)(Kb + off_ + ch); pd = *(const v4u*)(Db + off_ + ch); \
            pa = *(const v4u*)(Ab + off_ + ch); pv = *(const uint2*)(Vb + off_ + vch); } while (0)
#define RH_PREP(cc) do { float r8[8], k8[8], d8[8], a8[8]; unpack8(pr, r8); unpack8(pk, k8); unpack8(pd, d8); unpack8(pa, a8); \
            float kk[8], ss = 0.f; _Pragma("unroll") for (int j = 0; j < 8; ++j) { kk[j] = k8[j] * ckk[j]; ss += kk[j] * kk[j]; } \
            ss = red8(ss); const float inv = __builtin_amdgcn_rsqf(fmaxf(ss, 1e-24f)); \
            float kp[8], bsum = 0.f; _Pragma("unroll") for (int j = 0; j < 8; ++j) { kk[j] *= inv; kp[j] = k8[j] * (1.f + (a8[j] - 1.f) * cka[j]); bsum += r8[j] * kp[j] * crk[j]; } \
            const float bon = red8(bsum); if (half == 0 && cg == 0) BON[(size_t)(row0 + RH_TC * (cc) + tt) * 16 + h] = bon; \
            LAS float* p = L + ((cc) & 1) * RH_BUF + tt * 64 + 8 * cg; \
            *(LAS f32x4*)(p + RH_KK) = (f32x4){-kk[0], -kk[1], -kk[2], -kk[3]}; *(LAS f32x4*)(p + RH_KK + 4) = (f32x4){-kk[4], -kk[5], -kk[6], -kk[7]}; \
            *(LAS f32x4*)(p + RH_DD) = (f32x4){1.f - d8[0], 1.f - d8[1], 1.f - d8[2], 1.f - d8[3]}; *(LAS f32x4*)(p + RH_DD + 4) = (f32x4){1.f - d8[4], 1.f - d8[5], 1.f - d8[6], 1.f - d8[7]}; \
            *(LAS f32x4*)(p + RH_BB) = (f32x4){kk[0] * a8[0], kk[1] * a8[1], kk[2] * a8[2], kk[3] * a8[3]}; *(LAS f32x4*)(p + RH_BB + 4) = (f32x4){kk[4] * a8[4], kk[5] * a8[5], kk[6] * a8[6], kk[7] * a8[7]}; \
            *(LAS f32x4*)(p + RH_KP) = (f32x4){kp[0], kp[1], kp[2], kp[3]}; *(LAS f32x4*)(p + RH_KP + 4) = (f32x4){kp[4], kp[5], kp[6], kp[7]}; \
            *(LAS f32x4*)(p + RH_RR) = (f32x4){r8[0], r8[1], r8[2], r8[3]}; *(LAS f32x4*)(p + RH_RR + 4) = (f32x4){r8[4], r8[5], r8[6], r8[7]}; \
            *(LAS f32x4*)(L + ((cc) & 1) * RH_BUF + RH_VV + tt * 32 + 4 * cg) = (f32x4){bflo(pv.x), bfhi(pv.x), bflo(pv.y), bfhi(pv.y)}; } while (0)
#define RH_POST(cc) do { const f32x4 y4 = *(const LAS f32x4*)(L + ((cc) & 1) * RH_BUF + RH_YY + tt * 32 + 4 * cg); uint2 o; o.x = pkbf(y4.x, y4.y); o.y = pkbf(y4.z, y4.w); \
            *(uint2*)(YRAW + (size_t)(row0 + RH_TC * (cc) + tt) * D + vch) = o; } while (0)
        RH_LOAD(0); RH_PREP(0); RH_LOAD(1);
        __syncthreads();
        for (int c = 0; c < nch; ++c) {
            if (c > 0) RH_POST(c - 1);
            if (c + 1 < nch) { RH_PREP(c + 1); if (c + 2 < nch) RH_LOAD(c + 2); }
            __syncthreads();
        }
        RH_POST(nch - 1);
#undef RH_LOAD
#undef RH_PREP
#undef RH_POST
    }
    __syncthreads();
}
__device__ __forceinline__ void rwkv_finish(const Frame& F, const bf16* YRAW, const float* BON, const bf16* Vb, bf16* Gb, const float* gn_w, const float* gn_b) {
    const int gt = (F.vcu * NWAVES + F.wave) * 64 + F.lane, NT = F.G * NWAVES * 64;
    for (int task = gt; task < MP * 128; task += NT) {
        const int cg = task & 7, hh = (task >> 3) & 15, row = task >> 7; const size_t off = (size_t)row * D + hh * 64 + 8 * cg;
        float yy[8], vv[8], gg[8]; unpack8(*(const v4u*)(YRAW + off), yy); unpack8(*(const v4u*)(Vb + off), vv); unpack8(*(const v4u*)(Gb + off), gg);
        const float bon = BON[(size_t)row * 16 + hh];
        float s1 = 0.f;
#pragma unroll
        for (int j = 0; j < 8; ++j) s1 += yy[j];
        const float mean = red8(s1) * (1.f / 64.f);
        float s2 = 0.f;
#pragma unroll
        for (int j = 0; j < 8; ++j) { yy[j] -= mean; s2 += yy[j] * yy[j]; }
        const float rstd = __builtin_amdgcn_rsqf(red8(s2) * (1.f / 64.f) + GN_EPS);
        const f32x4 w0 = *(const f32x4*)(gn_w + hh * 64 + 8 * cg), w1 = *(const f32x4*)(gn_w + hh * 64 + 8 * cg + 4), b0 = *(const f32x4*)(gn_b + hh * 64 + 8 * cg), b1 = *(const f32x4*)(gn_b + hh * 64 + 8 * cg + 4);
        const float gw[8] = {w0.x, w0.y, w0.z, w0.w, w1.x, w1.y, w1.z, w1.w}, gb[8] = {b0.x, b0.y, b0.z, b0.w, b1.x, b1.y, b1.z, b1.w};
        float o[8];
#pragma unroll
        for (int j = 0; j < 8; ++j) o[j] = ((yy[j] * rstd) * gw[j] + gb[j] + bon * vv[j]) * gg[j];
        *(v4u*)(Gb + off) = pack8(o);
    }
}

constexpr int PBY = 144;
constexpr int RPY = 272;
constexpr int ML_RQK = 0, ML_S = 0, ML_KT = 9216, ML_RV = 18432, ML_Q = 35840, ML_K = 45056, ML_HB = 35840, ML_VT = 54272, ML_C = 72704, ML_F = 91136;
constexpr int MF_N = 0, MF_QN = 64, MF_RS = 128, MF_HS = 256, MF_CW = 384, MF_B63 = 1024, MF_P63 = 1056, MF_MC = 1088  , MF_GB = 1152, MF_GP = MF_GB + 2048, MF_GA = MF_GP + 2048;
typedef __attribute__((address_space(3))) unsigned short lds_u16;
#define MFMA16(a, b, c) __builtin_amdgcn_mfma_f32_16x16x32_bf16((a), (b), (c), 0, 0, 0)
__device__ __forceinline__ void mlstm_prompt_chain(const Frame& F, int b, int hh, const bf16* QKR, const bf16* VVb, const bf16* OOb, const float* IFb, bf16* HOb,
                                                   const float* conv_w, const float* conv_b, const float* norm_w, float* out, const int pvar) {
    LAS unsigned char* lds = F.lds; LAS float* Fl = (LAS float*)(lds + ML_F);
    const int tid = F.tid, lane = F.lane, w = F.wave, fr = lane & 15, fq = lane >> 4;
    for (int i = tid; i < 128 * 72; i += 512) ((lds_u16*)(lds + ML_C))[i] = 0;
    if (tid < 64) Fl[MF_N + tid] = 0.f;
    for (int i = tid; i < 640; i += 512) { const int j = i >> 7, c = i & 127, gc = c < 64 ? hh * 64 + c : 512 + hh * 64 + (c - 64); Fl[MF_CW + i] = j < 4 ? conv_w[j * D + gc] : conv_b[gc]; }
    f32x4 Cacc[4];
#pragma unroll
    for (int k = 0; k < 4; ++k) Cacc[k] = (f32x4){0.f, 0.f, 0.f, 0.f};
    const int og = tid & 15, ot = tid >> 4;
    float nw[8];
#pragma unroll
    for (int e = 0; e < 8; ++e) nw[e] = norm_w[hh * 128 + 8 * og + e];
    v4u rq[3], rv[2], ro[2];
#define ML_LOAD_QKV(cc) do { const int rowc_ = b * PT + 64 * (cc); \
        _Pragma("unroll") for (int i = 0; i < 3; ++i) { const int q = tid + 512 * i, r = q >> 4, j = q & 15, tok = 64 * (cc) - 3 + r; rq[i] = (v4u){0u, 0u, 0u, 0u}; \
            if (q < 67 * 16 && tok >= 0) rq[i] = *(const v4u*)(QKR + (size_t)(b * PT + tok) * D + (j < 8 ? hh * 64 + 8 * j : 512 + hh * 64 + 8 * (j - 8))); } \
        _Pragma("unroll") for (int i = 0; i < 2; ++i) rv[i] = *(const v4u*)(VVb + (size_t)(rowc_ + ot + 32 * i) * D + hh * 128 + 8 * og); \
        } while (0)
#define ML_LOAD_O(cc) do { const int rowc_ = b * PT + 64 * (cc); \
        _Pragma("unroll") for (int i = 0; i < 2; ++i) ro[i] = *(const v4u*)(OOb + (size_t)(rowc_ + ot + 32 * i) * D + hh * 128 + 8 * og); } while (0)
    ML_LOAD_QKV(0);
#pragma unroll
    for (int q = 0; q < 4; ++q) { const int cc = w + 8 * q; const size_t ro_ = (size_t)(b * PT + 64 * cc + lane) * 16;
        const float li = IFb[ro_ + hh], lf = IFb[ro_ + 8 + hh];
        float bc = lf;
#pragma unroll
        for (int o = 1; o < 64; o <<= 1) { const float x = __shfl_up(bc, o); if (lane >= o) bc += x; }
        const float av = li - bc; float pm = av;
#pragma unroll
        for (int o = 1; o < 64; o <<= 1) { const float x = __shfl_up(pm, o); if (lane >= o) pm = fmaxf(pm, x); }
        Fl[MF_GB + cc * 64 + lane] = bc; Fl[MF_GP + cc * 64 + lane] = pm; Fl[MF_GA + cc * 64 + lane] = av;
        if (lane == 63) { Fl[MF_B63 + cc] = bc; Fl[MF_P63 + cc] = pm; } }
    __syncthreads();
    if (tid == 0) { float mm = 0.f;
        for (int cc = 0; cc < PT / 64; ++cc) { Fl[MF_MC + cc] = mm; const float b6 = Fl[MF_B63 + cc]; mm = fmaxf(b6 + mm, b6 + Fl[MF_P63 + cc]); }
        Fl[MF_MC + PT / 64] = mm; }
    __syncthreads();
    constexpr int NC = PT / 64;
    for (int c = 0; c < NC; ++c) {
        const int rowc = b * PT + 64 * c;
        const float m_c = Fl[MF_MC + c], m_n = Fl[MF_MC + c + 1], b63 = Fl[MF_B63 + c];
#pragma unroll
        for (int i = 0; i < 3; ++i) { const int q = tid + 512 * i; if (q < 67 * 16) *(LAS v4u*)(lds + ML_RQK + (q >> 4) * RPY + 16 * (q & 15)) = rq[i]; }
#pragma unroll
        for (int i = 0; i < 2; ++i) *(LAS v4u*)(lds + ML_RV + (ot + 32 * i) * RPY + 16 * og) = rv[i];
        if (c + 1 < NC) ML_LOAD_QKV(c + 1);
        ML_LOAD_O(c);
        __syncthreads();
        float kreg[8] = {0.f, 0.f, 0.f, 0.f, 0.f, 0.f, 0.f, 0.f};
        if (pvar != 3)
#pragma unroll
        for (int i = 0; i < 2; ++i) {
            const int g = w + 8 * i, t = lane;
            float x[4][8];
#pragma unroll
            for (int j = 0; j < 4; ++j) unpack8(*(const LAS v4u*)(lds + ML_RQK + (t + j) * RPY + 16 * g), x[j]);
            float val[8];
#pragma unroll
            for (int h2 = 0; h2 < 2; ++h2) { f32x4 a = *(const LAS f32x4*)(Fl + MF_CW + 4 * 128 + 8 * g + 4 * h2);
#pragma unroll
                for (int j = 0; j < 4; ++j) { const f32x4 cw = *(const LAS f32x4*)(Fl + MF_CW + j * 128 + 8 * g + 4 * h2);
                    a.x += cw.x * x[j][4 * h2]; a.y += cw.y * x[j][4 * h2 + 1]; a.z += cw.z * x[j][4 * h2 + 2]; a.w += cw.w * x[j][4 * h2 + 3]; }
                val[4 * h2] = siluf_(a.x); val[4 * h2 + 1] = siluf_(a.y); val[4 * h2 + 2] = siluf_(a.z); val[4 * h2 + 3] = siluf_(a.w); }
            if (i == 0) {
#pragma unroll
                for (int e = 0; e < 8; ++e) val[e] *= 0.125f;
                *(LAS v4u*)(lds + ML_Q + t * PBY + 16 * w) = pack8(val);
            } else { *(LAS v4u*)(lds + ML_K + t * PBY + 16 * w) = pack8(val);
#pragma unroll
                for (int e = 0; e < 8; ++e) kreg[e] = val[e]; }
            const v4u vw = *(const LAS v4u*)(lds + ML_RV + t * RPY + 16 * g);
            lds_u16* vt = (lds_u16*)(lds + ML_VT) + (8 * g) * 72 + t;
            vt[0 * 72] = (unsigned short)(vw.x & 0xffffu); vt[1 * 72] = (unsigned short)(vw.x >> 16); vt[2 * 72] = (unsigned short)(vw.y & 0xffffu); vt[3 * 72] = (unsigned short)(vw.y >> 16);
            vt[4 * 72] = (unsigned short)(vw.z & 0xffffu); vt[5 * 72] = (unsigned short)(vw.z >> 16); vt[6 * 72] = (unsigned short)(vw.w & 0xffffu); vt[7 * 72] = (unsigned short)(vw.w >> 16);
        }
        __syncthreads();
        if (pvar != 4) {
        { const float wsv = __expf(b63 + Fl[MF_GA + c * 64 + lane] - m_n); lds_u16* kt = (lds_u16*)(lds + ML_KT) + (8 * w) * 72 + lane;
#pragma unroll
          for (int e = 0; e < 8; ++e) kt[e * 72] = f2bf1(kreg[e] * wsv); }
        { const int tq = tid >> 3, p = tid & 7; float q8[8]; unpack8(*(const LAS v4u*)(lds + ML_Q + tq * PBY + 16 * p), q8);
          float dsum = 0.f;
#pragma unroll
          for (int e = 0; e < 8; ++e) dsum += q8[e] * Fl[MF_N + 8 * p + e];
          dsum = red8(dsum); if (p == 0) Fl[MF_QN + tq] = dsum; }
        { const int ti = w >> 1; float rs[4] = {0.f, 0.f, 0.f, 0.f};
#pragma unroll
          for (int jj = 0; jj < 2; ++jj) { const int sj = 2 * (w & 1) + jj; f32x4 acc = {0.f, 0.f, 0.f, 0.f};
#pragma unroll
              for (int ks = 0; ks < 2; ++ks) { const bf16x8 a = *(const LAS bf16x8*)(lds + ML_Q + (16 * ti + fr) * PBY + ks * 64 + fq * 16), bb = *(const LAS bf16x8*)(lds + ML_K + (16 * sj + fr) * PBY + ks * 64 + fq * 16);
                  acc = MFMA16(a, bb, acc); }
              const int s = 16 * sj + fr; const float as = Fl[MF_GA + c * 64 + s];
#pragma unroll
              for (int r = 0; r < 4; ++r) { const int t = 16 * ti + 4 * fq + r; const float val = s <= t ? acc[r] * __expf(as - fmaxf(m_c, Fl[MF_GP + c * 64 + t])) : 0.f;
                  ((lds_u16*)(lds + ML_S))[t * 72 + s] = f2bf1(val); rs[r] += val; } }
#pragma unroll
          for (int r = 0; r < 4; ++r) { const float x = red16(rs[r]); if (fr == 0) Fl[MF_RS + (16 * ti + 4 * fq + r) * 2 + (w & 1)] = x; } }
        }
        __syncthreads();
        float hv[4][4] = {};
        if (pvar != 5) { const int ti = w & 3; float wi[4], den[4], ei[4], hq[4];
#pragma unroll
          for (int r = 0; r < 4; ++r) { const int t = 16 * ti + 4 * fq + r; const float mx = fmaxf(m_c, Fl[MF_GP + c * 64 + t]); wi[r] = __expf(m_c - mx); ei[r] = __expf(-(Fl[MF_GB + c * 64 + t] + mx)); den[r] = wi[r] * Fl[MF_QN + t] + Fl[MF_RS + 2 * t] + Fl[MF_RS + 2 * t + 1]; hq[r] = 0.f; }
#pragma unroll
          for (int i = 0; i < 4; ++i) { const int vt = 4 * (w >> 2) + i; f32x4 accA = {0.f, 0.f, 0.f, 0.f}, accB = accA;
#pragma unroll
              for (int ks = 0; ks < 2; ++ks) {
                  const bf16x8 aq = *(const LAS bf16x8*)(lds + ML_Q + (16 * ti + fr) * PBY + ks * 64 + fq * 16), bc = *(const LAS bf16x8*)(lds + ML_C + (16 * vt + fr) * PBY + ks * 64 + fq * 16);
                  accA = MFMA16(aq, bc, accA);
                  const bf16x8 as = *(const LAS bf16x8*)(lds + ML_S + (16 * ti + fr) * PBY + ks * 64 + fq * 16), bv = *(const LAS bf16x8*)(lds + ML_VT + (16 * vt + fr) * PBY + ks * 64 + fq * 16);
                  accB = MFMA16(as, bv, accB); }
#pragma unroll
              for (int r = 0; r < 4; ++r) { const float num = wi[r] * accA[r] + accB[r]; const float hh_ = num * __builtin_amdgcn_rcpf(fmaxf(fabsf(den[r]), ei[r])); hv[i][r] = hh_; hq[r] += hh_ * hh_; } }
#pragma unroll
          for (int r = 0; r < 4; ++r) { const float x = red16(hq[r]); if (fr == 0) Fl[MF_HS + (16 * ti + 4 * fq + r) * 2 + (w >> 2)] = x; } }
        __syncthreads();
        if (pvar != 6) {
        { const int ti = w & 3;
#pragma unroll
          for (int r = 0; r < 4; ++r) { const int t = 16 * ti + 4 * fq + r; const float sc = __builtin_amdgcn_rsqf((Fl[MF_HS + 2 * t] + Fl[MF_HS + 2 * t + 1]) * (1.f / 128.f) + NORM_EPS);
#pragma unroll
              for (int i = 0; i < 4; ++i) ((lds_u16*)(lds + ML_HB))[t * (RPY / 2) + 16 * (4 * (w >> 2) + i) + fr] = f2bf1(hv[i][r] * sc); } }
        { const float wst = __expf(b63 + m_c - m_n);
#pragma unroll
          for (int kt = 0; kt < 4; ++kt) { Cacc[kt] = Cacc[kt] * wst;
#pragma unroll
              for (int ks = 0; ks < 2; ++ks) { const bf16x8 a = *(const LAS bf16x8*)(lds + ML_VT + (16 * w + fr) * PBY + ks * 64 + fq * 16), bb = *(const LAS bf16x8*)(lds + ML_KT + (16 * kt + fr) * PBY + ks * 64 + fq * 16);
                  Cacc[kt] = MFMA16(a, bb, Cacc[kt]); }
#pragma unroll
              for (int r = 0; r < 4; ++r) ((lds_u16*)(lds + ML_C))[(16 * w + 4 * fq + r) * 72 + 16 * kt + fr] = f2bf1(Cacc[kt][r]); }
          if (w == 0) { float sum = 0.f;
#pragma unroll
              for (int q = 0; q < 8; ++q) { float k8[8]; unpack8(*(const LAS v4u*)(lds + ML_KT + lane * PBY + 16 * q), k8);
#pragma unroll
                  for (int e = 0; e < 8; ++e) sum += k8[e]; }
              Fl[MF_N + lane] = wst * Fl[MF_N + lane] + sum; } }
        }
        __syncthreads();
        if (pvar != 7)
#pragma unroll
        for (int i = 0; i < 2; ++i) { const int t = ot + 32 * i; float h8[8], o8[8]; unpack8(*(const LAS v4u*)(lds + ML_HB + t * RPY + 16 * og), h8); unpack8(ro[i], o8);
#pragma unroll
            for (int e = 0; e < 8; ++e) h8[e] = h8[e] * nw[e] * o8[e];
            *(v4u*)(HOb + (size_t)(rowc + t) * D + hh * 128 + 8 * og) = pack8(h8); }
    }
#undef ML_LOAD_QKV
#undef ML_LOAD_O
#pragma unroll
    for (int kt = 0; kt < 4; ++kt)
#pragma unroll
        for (int r = 0; r < 4; ++r) out[O_P_C + ((size_t)(b * 8 + hh) * 128 + 16 * w + 4 * fq + r) * 64 + 16 * kt + fr] = Cacc[kt][r];
    if (w == 0) { out[O_P_N + (size_t)(b * 8 + hh) * 64 + lane] = Fl[MF_N + lane]; if (lane == 0) out[O_P_M + b * 8 + hh] = Fl[MF_MC + PT / 64]; }
    if (tid < 384) { const int j = tid >> 7, c = tid & 127, gc = c < 64 ? hh * 64 + c : 512 + hh * 64 + (c - 64);
        out[O_P_CONV + (size_t)(b * 3 + j) * D + gc] = bf1(QKR[(size_t)(b * PT + PT - 3 + j) * D + gc]); }
    __syncthreads();
}
__device__ __forceinline__ void mlstm_sample_item(const Frame& F, int b, int hh, const bf16* QKR, const bf16* VVb, const bf16* OOb, const float* IFb, bf16* HOb,
                                                  const float* conv_w, const float* conv_b, const float* norm_w, const float* C0, const float* n0, const float* m0p, const float* conv0, float* out) {
    LAS float* L = (LAS float*)F.lds;
    constexpr int LQ = 0, LK = 256, LV = 512, LS = 1024, LQN = 1040, LHS = 1048;
    const int tid = F.tid, lane = F.lane, w = F.wave, row0 = MP + 4 * b;
    float li[4], lf[4];
#pragma unroll
    for (int t = 0; t < 4; ++t) { li[t] = IFb[(size_t)(row0 + t) * 16 + hh]; lf[t] = IFb[(size_t)(row0 + t) * 16 + 8 + hh]; }
    const float m0 = m0p[b * 8 + hh];
    float bc[4], av[4], mt[4], wi[4], wsv[4], ei[4], bm[4];
    { float run = 0.f, pm = -3.0e38f;
#pragma unroll
      for (int t = 0; t < 4; ++t) { run += lf[t]; bc[t] = run; av[t] = li[t] - run; pm = fmaxf(pm, av[t]); mt[t] = fmaxf(run + m0, run + pm); } }
    const float m_new = mt[3], wst = __expf(bc[3] + m0 - m_new);
#pragma unroll
    for (int t = 0; t < 4; ++t) { wi[t] = __expf(bc[t] + m0 - mt[t]); wsv[t] = __expf(bc[3] + av[t] - m_new); ei[t] = __expf(-mt[t]); bm[t] = bc[t] - mt[t]; }
    { const int t = tid >> 7, c = tid & 127, gc = c < 64 ? hh * 64 + c : 512 + hh * 64 + (c - 64);
      float x[4];
#pragma unroll
      for (int j = 0; j < 4; ++j) { const int p = t + j; x[j] = p < 3 ? conv0[(size_t)(b * 3 + p) * D + gc] : bf1(QKR[(size_t)(row0 + p - 3) * D + gc]); }
      float a = conv_b[gc];
#pragma unroll
      for (int j = 0; j < 4; ++j) a += conv_w[j * D + gc] * x[j];
      const float val = siluf_(a);
      if (c < 64) L[LQ + t * 64 + c] = val * 0.125f; else L[LK + t * 64 + (c - 64)] = val;
      if (t >= 1) out[O_S_CONV + (size_t)(b * 3 + t - 1) * D + gc] = x[3];
      L[LV + t * 128 + c] = bf1(VVb[(size_t)(row0 + t) * D + hh * 128 + c]); }
    __syncthreads();
    if (w == 0) { const int pair = lane >> 2, t = pair >> 2, s = pair & 3, part = lane & 3; float dsum = 0.f;
#pragma unroll
        for (int e = 0; e < 16; ++e) dsum += L[LQ + t * 64 + 16 * part + e] * L[LK + s * 64 + 16 * part + e];
        dsum = red4(dsum);
        const float bmt = t == 0 ? bm[0] : (t == 1 ? bm[1] : (t == 2 ? bm[2] : bm[3])), avs = s == 0 ? av[0] : (s == 1 ? av[1] : (s == 2 ? av[2] : av[3]));
        if (part == 0) L[LS + pair] = s <= t ? dsum * __expf(bmt + avs) : 0.f; }
    if (w == 1) { const int t = lane >> 4, part = lane & 15; float dsum = 0.f;
#pragma unroll
        for (int e = 0; e < 4; ++e) dsum += L[LQ + t * 64 + 4 * part + e] * n0[(size_t)(b * 8 + hh) * 64 + 4 * part + e];
        dsum = red16(dsum); if (part == 0) L[LQN + t] = dsum; }
    __syncthreads();
    const int v = tid >> 2, kq = tid & 3;
    float hvv[4];
    { const size_t coff = ((size_t)(b * 8 + hh) * 128 + v) * 64 + 16 * kq;
      float c0[16];
#pragma unroll
      for (int e4 = 0; e4 < 4; ++e4) { const f32x4 x = *(const f32x4*)(C0 + coff + 4 * e4); c0[4 * e4] = x.x; c0[4 * e4 + 1] = x.y; c0[4 * e4 + 2] = x.z; c0[4 * e4 + 3] = x.w; }
#pragma unroll
      for (int t = 0; t < 4; ++t) { float part = 0.f;
#pragma unroll
          for (int e = 0; e < 16; ++e) part += c0[e] * L[LQ + t * 64 + 16 * kq + e];
          const float inter = red4(part);
          float num = wi[t] * inter, den = wi[t] * L[LQN + t];
#pragma unroll
          for (int s = 0; s < 4; ++s) { const float sm = L[LS + t * 4 + s]; num += sm * L[LV + s * 128 + v]; den += sm; }
          hvv[t] = num / fmaxf(fabsf(den), ei[t]); }
#pragma unroll
      for (int t = 0; t < 4; ++t) { const float x = wave_sum(kq == 0 ? hvv[t] * hvv[t] : 0.f); if (lane == 0) L[LHS + w * 4 + t] = x; }
      float cn[16];
#pragma unroll
      for (int e = 0; e < 16; ++e) { float a = wst * c0[e];
#pragma unroll
          for (int s = 0; s < 4; ++s) a += wsv[s] * L[LV + s * 128 + v] * L[LK + s * 64 + 16 * kq + e];
          cn[e] = a; }
#pragma unroll
      for (int e4 = 0; e4 < 4; ++e4) *(f32x4*)(out + O_S_C + coff + 4 * e4) = (f32x4){cn[4 * e4], cn[4 * e4 + 1], cn[4 * e4 + 2], cn[4 * e4 + 3]}; }
    __syncthreads();
    if (kq == 0) {
#pragma unroll
        for (int t = 0; t < 4; ++t) { float tot = 0.f;
#pragma unroll
            for (int ww = 0; ww < 8; ++ww) tot += L[LHS + ww * 4 + t];
            const float sc = 1.0f / sqrtf(tot * (1.f / 128.f) + NORM_EPS); const size_t off = (size_t)(row0 + t) * D + hh * 128 + v;
            HOb[off] = f2bf1(hvv[t] * sc * norm_w[hh * 128 + v] * bf1(OOb[off])); } }
    if (tid < 64) { float a = wst * n0[(size_t)(b * 8 + hh) * 64 + tid];
#pragma unroll
        for (int s = 0; s < 4; ++s) a += wsv[s] * L[LK + s * 64 + tid];
        out[O_S_N + (size_t)(b * 8 + hh) * 64 + tid] = a; }
    if (tid == 0) out[O_S_M + b * 8 + hh] = m_new;
    __syncthreads();
}

#ifndef MK_N_LAUNCHES
#define MK_N_LAUNCHES 1
#endif
constexpr int N_PHASES = 22;
#ifndef PROBE_PH
#define PROBE_PH (-1)
#define PROBE_N 1
#endif
#ifndef PROBE_VAR
#define PROBE_VAR 0
#endif
#ifndef EN_MASK
#define EN_MASK 0xff
#endif
constexpr bool EN_NORM = EN_MASK & 1, EN_UP = EN_MASK & 2, EN_RES = EN_MASK & 4, EN_RW = EN_MASK & 8, EN_L2 = EN_MASK & 16, EN_SCAN = EN_MASK & 32, EN_IN = EN_MASK & 64, EN_ML = EN_MASK & 128;
struct Args { const float* in[N_IN]; float* out; unsigned char* ws; int ph_lo, ph_hi; };
__global__ void __launch_bounds__(NWAVES * 64, 2) mega_fwd(Args args) {
    extern __shared__ __attribute__((aligned(16))) unsigned char lds_raw[];
    { const int t0 = threadIdx.x;
      for (int u = t0; u < (LDS_BYTES - LDSCTL_OFF) / 4; u += NWAVES * 64) ((LAS unsigned*)((LAS unsigned char*)lds_raw + LDSCTL_OFF))[u] = 0u; }
    __syncthreads();
    { const int t0 = threadIdx.x; if (t0 < N_IN) ((LAS unsigned long long*)((LAS unsigned char*)lds_raw + TAB_OFF))[t0] = (unsigned long long)args.in[t0]; }
    __syncthreads();
    XcdBarrier bar; bar.bar = (unsigned*)((gu32*)(args.ws + WS_CTL) + CW_BAR); bar.x = 0; bar.st = nullptr;
    if (args.ph_hi - args.ph_lo > 1) bar = xcd_barrier_post((unsigned*)((gu32*)(args.ws + WS_CTL) + CW_BAR), (volatile LAS unsigned*)((LAS unsigned char*)lds_raw + MISC_OFF) + 8);
    int ph = args.ph_lo, rep = 0;
    while (ph < args.ph_hi) {
        int tid_ = threadIdx.x; asm volatile("" : "+v"(tid_));
        unsigned char* ws = args.ws; float* out = args.out;
        Frame F;
        F.lds = (LAS unsigned char*)lds_raw;
        F.MISC = (volatile LAS unsigned*)(F.lds + MISC_OFF);
        F.tid = tid_; F.lane = F.tid & 63; F.wave = __builtin_amdgcn_readfirstlane(F.tid >> 6);
        F.G = gridDim.x; { const int bx = blockIdx.x; F.vcu = (F.G % 8 == 0) ? (bx % 8) * (F.G / 8) + bx / 8 : bx; }
        F.ctl = (gu32*)(ws + WS_CTL); F.tab = (volatile LAS unsigned long long*)(F.lds + TAB_OFF);
        bf16* Wb = (bf16*)(ws + WS_W); float* XR = (float*)(ws + WS_XR); unsigned char* big = ws + WS_BIG;
        bf16* Hb = (bf16*)(big + B_H); bf16* XN = (bf16*)(big + B_XN); float* SLAB = (float*)(big + B_SLAB);
        bf16* ACAT = (bf16*)(big + B_ACAT); bf16* Rb = (bf16*)(big + B_R); bf16* Kb = (bf16*)(big + B_K); bf16* Vb = (bf16*)(big + B_V); bf16* DECb = (bf16*)(big + B_DEC); bf16* AAb = (bf16*)(big + B_AA);
        bf16* QKR = (bf16*)(big + B_QKR); bf16* VVb = (bf16*)(big + B_VV); bf16* HOb = (bf16*)(big + B_HO); bf16* OOb = (bf16*)(big + B_OO); float* IFb = (float*)(big + B_IF);
        bf16* GGb = (bf16*)((unsigned char*)out + OS_GG); bf16* LORA = (bf16*)((unsigned char*)out + OS_LORA);
        const int c_id = (int)blockIdx.x;
        const int nrep = ph == PROBE_PH ? PROBE_N : 1;
        const int pvar = (rep + 1 < nrep) ? PROBE_VAR : 0;
        if (EN_NORM && (ph == 0 || ph == 3 || ph == 8 || ph == 11 || ph == 14 || ph == 18 || ph == 21)) {
            int kind = 0, layer = 0, ab = 0, nslab = 0; float coef = 0.5f; const float* gain = nullptr;
            if (ph == 0) { kind = 0; layer = 0; ab = 0; gain = inptr(F, I_NFA); nslab = 0; }
            else if (ph == 3) { kind = 1; gain = inptr(F, I_NMIX); nslab = 11; }
            else if (ph == 8) { kind = 0; layer = 0; ab = 1; gain = inptr(F, I_NFB); nslab = 4; coef = 1.f; }
            else if (ph == 11) { kind = 0; layer = 1; ab = 0; gain = inptr(F, I_NFA) + D; nslab = 11; }
            else if (ph == 14) { kind = 2; gain = inptr(F, I_NMIX) + D; nslab = 11; }
            else if (ph == 18) { kind = 0; layer = 1; ab = 1; gain = inptr(F, I_NFB) + D; nslab = 4; coef = 1.f; }
            else { kind = -1; gain = inptr(F, I_NFIN); nslab = 11; }
            if (kind >= 0) convert_weights(F, kind, layer, ab, Wb);
            const float* base_p = ph == 0 ? inptr(F, I_XP) : XR; const float* base_s = (ph == 0 || ph == 3) ? inptr(F, I_XS) : XR + (size_t)MP * D;
            if (ph == 3) norm_rows<1>(F, base_p, base_s, nslab, coef, SLAB, XR, gain, ACAT, inptr(F, I_RSHIFT), out);
            else if (ph == 21) norm_rows<2>(F, base_p, base_s, nslab, coef, SLAB, XR, gain, nullptr, nullptr, out);
            else norm_rows<0>(F, base_p, base_s, nslab, coef, SLAB, XR, gain, XN, nullptr, out);
        } else if (EN_UP && (ph == 1 || ph == 9 || ph == 12 || ph == 19)) {
            pg8::Gemm g{XN, Wb + W_GU / 2, M, 2 * FF, D}; pg8::UnitOrder S; S.init(M / 256, 2 * FF / 256, D, F.G, c_id, 0);
            EpiSwiglu E{Hb, pvar};
            pg8::gemm_phase<EpiSwiglu, pg8::UnitOrder, true, true>(F.lds, g, S, E, F.tid);
        } else if (EN_RES && (ph == 2 || ph == 7 || ph == 10 || ph == 13 || ph == 17 || ph == 20)) {
            const bf16* A = Hb; const bf16* Bt = Wb + W_D / 2; int K = FF; float coef = 0.5f; const float* base = XR;
            if (ph == 2) base = inptr(F, I_XP);
            if (ph == 7) { A = GGb; Bt = Wb + W_O / 2; K = D; coef = 1.f;
                rwkv_finish(F, (const bf16*)(ws + WS_YRAW), (const float*)(ws + WS_BON), Vb, GGb, inptr(F, I_GNW), inptr(F, I_GNB)); xcd_barrier(bar); }
            if (ph == 17) { A = HOb; Bt = Wb + W_OUT / 2; K = D; coef = 1.f; }
            pg8::Gemm g{A, Bt, M, D, K}; pg8::UnitOrder S; S.init(MP / 256, D / 256, K, F.G, c_id, K / 256);
            EpiRes E{base, XR, SLAB, coef};
            pg8::gemm_phase<EpiRes, pg8::UnitOrder, true, true>(F.lds, g, S, E, F.tid);
        } else if (EN_RW && ph == 4) {
            pg8::Gemm g{ACAT, Wb + W_RW / 2, M, NRW, KRW}; pg8::UnitOrder S; S.init(M / 256, NRW / 256, KRW, F.G, c_id, 0);
            EpiRw E{Rb, Kb, Vb, LORA};
            pg8::gemm_phase<EpiRw, pg8::UnitOrder, true, true>(F.lds, g, S, E, F.tid);
        } else if (EN_L2 && ph == 5) {
            pg8::Gemm g{LORA, Wb + W_L2 / 2, M, NL2, KL2}; pg8::UnitOrder S; S.init(M / 256, NL2 / 256, KL2, F.G, c_id, -1);
            EpiL2 E{DECb, AAb, GGb, inptr(F, I_W0), inptr(F, I_A0)};
            pg8::gemm_phase<EpiL2, pg8::UnitOrder, true, true>(F.lds, g, S, E, F.tid);
        } else if (EN_SCAN && ph == 6) {
            if (pvar != 1) {
                for (int i = F.vcu; i < SB * 16; i += F.G) { const int b = i >> 4, h = i & 15;
                    rwkv_chain(F, MP + b * STK, STK, h, inptr(F, I_RS) + (size_t)i * 4096, out + O_S_S + (size_t)i * 4096, Rb, Kb, Vb, DECb, AAb, GGb, inptr(F, I_KK), inptr(F, I_KA), inptr(F, I_RK), inptr(F, I_GNW), inptr(F, I_GNB), rep + 1 == nrep, pvar); }
            }
            if (pvar != 2) {
                for (int i = F.vcu; i < 2 * PB * 16; i += F.G) { const int chain = i & 127, half = i >> 7;
                    rwkv_half_chain(F, chain >> 4, chain & 15, half, out + O_P_S + (size_t)chain * 4096, Rb, Kb, Vb, DECb, AAb, (bf16*)(ws + WS_YRAW), (float*)(ws + WS_BON), inptr(F, I_KK), inptr(F, I_KA), inptr(F, I_RK), pvar); }
            }
        } else if (EN_IN && ph == 15) {
            pg8::Gemm g{XN, Wb + W_IN / 2, M, NIN, D}; pg8::UnitOrder S; S.init(M / 256, NIN / 256, D, F.G, c_id, 0);
            EpiIn E{QKR, VVb, OOb, IFb, inptr(F, I_BIF)};
            pg8::gemm_phase<EpiIn, pg8::UnitOrder, true, true>(F.lds, g, S, E, F.tid);
        } else if (EN_ML && ph == 16) {
            const int Hh = F.G >= 128 ? 64 : (F.G / 2 > 0 ? F.G / 2 : 1);
            if (F.vcu < Hh && pvar != 2) {
                for (int i = F.vcu; i < PB * 8; i += Hh) mlstm_prompt_chain(F, i >> 3, i & 7, QKR, VVb, OOb, IFb, HOb, inptr(F, I_CW), inptr(F, I_CB), inptr(F, I_MNW), out, pvar);
            }
            if ((F.vcu >= Hh || F.G == 1) && pvar != 1 && pvar < 3) {
                const int st = F.G == 1 ? 1 : F.G - Hh;
                for (int i = F.G == 1 ? 0 : F.vcu - Hh; i < SB * 8; i += st)
                    mlstm_sample_item(F, i >> 3, i & 7, QKR, VVb, OOb, IFb, HOb, inptr(F, I_CW), inptr(F, I_CB), inptr(F, I_MNW), inptr(F, I_MC), inptr(F, I_MN), inptr(F, I_MM), inptr(F, I_MCONV), out);
            }
        }
        if (++rep < nrep) continue;
        rep = 0;
        if (ph + 1 < args.ph_hi) xcd_barrier(bar);
        ++ph;
    }
}

extern "C" void kernel_launch(void* const* d_in, const int* in_sizes, int n_in, void* d_out, int out_size, void* d_ws, size_t ws_size, hipStream_t stream) {
    static int grid = 0;
    if (grid == 0) {
        if (n_in != N_IN || out_size != (int)O_END || ws_size < WS_END2) { fprintf(stderr, "kernel_launch: unexpected shapes (n_in %d, out %d, ws %zu); nothing launched\n", n_in, out_size, ws_size); grid = -1; return; }
        int dev = 0, cus = 0, per_cu = 0;
        if (hipGetDevice(&dev) != hipSuccess || hipDeviceGetAttribute(&cus, hipDeviceAttributeMultiprocessorCount, dev) != hipSuccess) { grid = -1; return; }
        if (hipFuncSetAttribute((const void*)mega_fwd, hipFuncAttributeMaxDynamicSharedMemorySize, LDS_BYTES) != hipSuccess) { fprintf(stderr, "kernel_launch: hipFuncSetAttribute failed\n"); grid = -1; return; }
        if (hipOccupancyMaxActiveBlocksPerMultiprocessor(&per_cu, (const void*)mega_fwd, NWAVES * 64, LDS_BYTES) != hipSuccess || per_cu < 1) { fprintf(stderr, "kernel_launch: occupancy query says %d\n", per_cu); per_cu = 1; }
        (void)hipGetLastError();
        grid = cus;
    }
    if (grid < 0) return;
    (void)hipMemsetAsync((char*)d_ws + WS_CTL, 0, CTL_ZERO_BYTES, stream);
    Args a{};
    for (int i = 0; i < N_IN; ++i) a.in[i] = (const float*)d_in[i];
    a.out = (float*)d_out; a.ws = (unsigned char*)d_ws;
#if MK_N_LAUNCHES == 1
    a.ph_lo = 0; a.ph_hi = N_PHASES;
    { void* kargs[] = {(void*)&a};
      const hipError_t e = hipLaunchCooperativeKernel((const void*)mega_fwd, dim3(grid), dim3(NWAVES * 64), kargs, LDS_BYTES, stream);
      if (e != hipSuccess) fprintf(stderr, "kernel_launch: cooperative launch failed: %s (grid %d)\n", hipGetErrorString(e), grid); }
#else
    for (int p = 0; p < N_PHASES; ++p) { a.ph_lo = p; a.ph_hi = p + 1; hipLaunchKernelGGL(mega_fwd, dim3(grid), dim3(NWAVES * 64), LDS_BYTES, stream, a); }
#endif
}
```

```cpp
#include <hip/hip_runtime.h>
#include <cstdio>
#include <cstdint>
namespace pg8 {
#define PG8_LAS __attribute__((address_space(3)))
typedef unsigned short bf16_t;
typedef short bf16x8 __attribute__((ext_vector_type(8)));
typedef float f32x4 __attribute__((ext_vector_type(4)));
typedef unsigned u32x4 __attribute__((ext_vector_type(4)));
constexpr int BM = 256, BK = 64, HALF = 128, HTB = HALF * BK * 2  , STAGE_BYTES = 8 * HTB, NXCD = 8, WGM = 8;

__host__ __device__ __forceinline__ int lds_byte(int r, int c) { const int st = (r >> 4) * 2 + (c >> 5), rr = r & 15, cc = c & 31, ob = rr * 64 + cc * 2; return st * 1024 + (ob ^ (((ob >> 9) & 1) << 5)); }
__host__ __device__ __forceinline__ void stage_rc(int b, int& R, int& C) { const int st = b / 1024, sb = b % 1024, swz = sb ^ (((sb >> 9) & 1) << 5); R = (st >> 1) * 16 + swz / 64; C = (st & 1) * 32 + (swz % 64) / 2; }
__host__ __device__ __forceinline__ int perm32(int rho) { const int n = rho >> 4, i = rho & 15; return 8 * (i >> 2) + 4 * n + (i & 3); }

struct Unit { int pm, pn, k0, nt, slab; };
struct Gemm { const bf16_t* A; const bf16_t* Bt; int M, N, K; };

struct UnitOrder {
    int nM, nN, nwg, G, c, ntf, tailS;
    __device__ __forceinline__ void init(int nM_, int nN_, int K, int G_, int c_, int tailS_) { nM = nM_; nN = nN_; nwg = nM * nN; G = G_; c = c_; ntf = K / BK; tailS = tailS_; }
    __device__ __forceinline__ bool next(int i, Unit& u) const {
        long L = (long)i * G + c;
        if (L < nwg) {
            int wgid = (int)L; { const int q = nwg / NXCD, r = nwg % NXCD, xcd = wgid % NXCD, off = wgid / NXCD; wgid = (xcd < r ? xcd * (q + 1) : r * (q + 1) + (xcd - r) * q) + off; }
            const int nig = WGM * nN, gid = wgid / nig, fm = gid * WGM, gsz = (nM - fm) < WGM ? (nM - fm) : WGM;
            u.pm = fm + ((wgid % nig) % gsz); u.pn = (wgid % nig) / gsz; u.k0 = 0; u.nt = ntf; u.slab = -1;
            if (tailS < 0) { u.nt = 4; u.k0 = u.pn >= 8 ? 128 : 0; }
            return true;
        }
        L -= nwg; if (tailS <= 0 || L >= 8 * tailS) return false;
        int tile, sl; if (tailS == 4) { tile = (int)L >> 2; sl = (int)L & 3; } else { tile = (int)L / 11; sl = (int)L - 11 * tile; }
        u.pm = 64 + (tile >> 2); u.pn = tile & 3; u.k0 = sl * 256; u.nt = 4; u.slab = sl; return true;
    }
    __device__ __forceinline__ void a_ready(const Unit&) const {}
    __device__ __forceinline__ void done(const Unit&) const {}
};
template <class Epi, class Sched, bool ALIGN_EPI = false, bool SP2 = false>
__device__ __forceinline__ void gemm_phase(PG8_LAS unsigned char* lds, const Gemm g, const Sched& S, const Epi& E, const int tid) {
    const int wid = __builtin_amdgcn_readfirstlane(tid >> 6), lane = tid & 63, wr = wid >> 2, wc = wid & 3, fr = lane & 15, fq = lane >> 4;
    const int K = g.K;
    unsigned voffA[2], voffB[2];
#pragma unroll
    for (int i = 0; i < 2; ++i) { int R, C; stage_rc(tid * 16 + i * 8192, R, C); const int Rb = Epi::PERM ? ((R & ~31) + perm32(R & 31)) : R;
        voffA[i] = (unsigned)(R * K + C) * 2u; voffB[i] = (unsigned)(Rb * K + C) * 2u; }
    const size_t kstep = (size_t)(BK * 2);
    const size_t hstep = (size_t)HALF * K * 2;
    const size_t tstep = 2 * hstep;
    const unsigned ldsw = (unsigned)wid * 1024u;
    const int aoff = lds_byte(wr * 64 + fr, fq * 8), boff = lds_byte(wc * 32 + fr, fq * 8);
#define PG8_SA(b, h) (((b) * 2 + (h)) * HTB)
#define PG8_SB(b, h) ((4 + (b) * 2 + (h)) * HTB)
#define PG8_STAGE(bufoff, gbase, voff) do { _Pragma("unroll") for (int _i = 0; _i < 2; ++_i) \
        __builtin_amdgcn_global_load_lds((const unsigned*)((const char*)(gbase) + (voff)[_i]), (PG8_LAS unsigned*)(lds + (bufoff) + ldsw + _i * 8192), 16, 0, 0); } while (0)
#define PG8_LDA(dst, b, h) do { _Pragma("unroll") for (int m = 0; m < 4; ++m) _Pragma("unroll") for (int k = 0; k < 2; ++k) dst[m][k] = *(const PG8_LAS bf16x8*)(lds + PG8_SA(b, h) + aoff + m * 2048 + k * 1024); } while (0)
#define PG8_LDB(dst, b, h) do { _Pragma("unroll") for (int n = 0; n < 2; ++n) _Pragma("unroll") for (int k = 0; k < 2; ++k) dst[n][k] = *(const PG8_LAS bf16x8*)(lds + PG8_SB(b, h) + boff + n * 2048 + k * 1024); } while (0)
#define PG8_MMA(ai, bj, At, Bt) do { __builtin_amdgcn_s_setprio(1); _Pragma("unroll") for (int m = 0; m < 4; ++m) _Pragma("unroll") for (int n = 0; n < 2; ++n) _Pragma("unroll") for (int k = 0; k < 2; ++k) \
        acc[ai][bj][m][n] = __builtin_amdgcn_mfma_f32_16x16x32_bf16(Bt[n][k], At[m][k], acc[ai][bj][m][n], 0, 0, 0); __builtin_amdgcn_s_setprio(0); } while (0)
#define PG8_WAIT_V(n) asm volatile("s_waitcnt vmcnt(" #n ")" ::: "memory")
#define PG8_WAIT_L(n) asm volatile("s_waitcnt lgkmcnt(" #n ")" ::: "memory")
#define PG8_BAR __builtin_amdgcn_s_barrier()
#define PG8_SCHED __builtin_amdgcn_sched_barrier(0)
    Unit cur, nxt; int ui = 0;
    if (!S.next(0, cur)) return;
    f32x4 acc[2][2][4][2];
#pragma unroll
    for (int a = 0; a < 2; ++a)
#pragma unroll
        for (int b = 0; b < 2; ++b)
#pragma unroll
            for (int m = 0; m < 4; ++m)
#pragma unroll
                for (int n = 0; n < 2; ++n) acc[a][b][m][n] = (f32x4){0.f, 0.f, 0.f, 0.f};
    bf16x8 At[4][2], B0[2][2], B1[2][2];
    const char* cA = (const char*)g.A + (size_t)cur.pm * tstep + (size_t)cur.k0 * 2; const char* cB = (const char*)g.Bt + (size_t)cur.pn * tstep + (size_t)cur.k0 * 2;
    S.a_ready(cur);
    if constexpr (SP2) {
        PG8_STAGE(PG8_SB(0, 0), cB, voffB); PG8_STAGE(PG8_SB(0, 1), cB + hstep, voffB); PG8_STAGE(PG8_SA(0, 0), cA, voffA); PG8_STAGE(PG8_SA(0, 1), cA + hstep, voffA);
        if (wr == 1) PG8_BAR;
        PG8_WAIT_V(2); PG8_BAR;
        PG8_STAGE(PG8_SB(1, 0), cB + kstep, voffB); PG8_STAGE(PG8_SA(1, 0), cA + kstep, voffA); PG8_STAGE(PG8_SB(1, 1), cB + hstep + kstep, voffB);
        PG8_WAIT_V(6); PG8_BAR;
    } else {
        PG8_STAGE(PG8_SB(0, 0), cB, voffB); PG8_STAGE(PG8_SA(0, 0), cA, voffA); PG8_STAGE(PG8_SB(0, 1), cB + hstep, voffB); PG8_STAGE(PG8_SA(0, 1), cA + hstep, voffA);
        if (wr == 1) PG8_BAR;
        PG8_WAIT_V(4); PG8_BAR;
        PG8_STAGE(PG8_SB(1, 0), cB + kstep, voffB); PG8_STAGE(PG8_SA(1, 0), cA + kstep, voffA); PG8_STAGE(PG8_SB(1, 1), cB + hstep + kstep, voffB);
        PG8_WAIT_V(6); PG8_BAR;
    }
    for (;;) {
        const bool has_next = S.next(ui + 1, nxt);
        const char* nA = has_next ? (const char*)g.A + (size_t)nxt.pm * tstep + (size_t)nxt.k0 * 2 : cA; const char* nB = has_next ? (const char*)g.Bt + (size_t)nxt.pn * tstep + (size_t)nxt.k0 * 2 : cB;
        const int nt = cur.nt;
        for (int t = 0; t < nt; t += 2) {
            const bool last = (t == nt - 2);
            const char* a1 = cA + (size_t)(t + 1) * kstep;
            const char* a2 = last ? nA : cA + (size_t)(t + 2) * kstep; const char* b2 = last ? nB : cB + (size_t)(t + 2) * kstep;
            const char* a3 = a2 + kstep; const char* b3 = b2 + kstep;
            if (last && has_next) S.a_ready(nxt);
            if constexpr (SP2) {
            PG8_LDB(B0, 0, 0); PG8_LDB(B1, 0, 1); PG8_SCHED; PG8_LDA(At, 0, 0); PG8_STAGE(PG8_SA(1, 1), a1 + hstep, voffA);
            PG8_WAIT_V(8); PG8_WAIT_L(0); PG8_BAR; PG8_MMA(0, 0, At, B0); PG8_MMA(0, 1, At, B1); PG8_BAR; PG8_SCHED;
            PG8_LDA(At, 0, 1); PG8_STAGE(PG8_SB(0, 0), b2, voffB); PG8_STAGE(PG8_SB(0, 1), b2 + hstep, voffB); PG8_STAGE(PG8_SA(0, 0), a2, voffA);
            PG8_WAIT_V(8); PG8_WAIT_L(0); PG8_BAR; PG8_MMA(1, 0, At, B0); PG8_MMA(1, 1, At, B1); PG8_BAR; PG8_SCHED;
            PG8_LDB(B0, 1, 0); PG8_LDB(B1, 1, 1); PG8_SCHED; PG8_LDA(At, 1, 0); PG8_STAGE(PG8_SA(0, 1), a2 + hstep, voffA);
            PG8_WAIT_V(8); PG8_WAIT_L(0); PG8_BAR; PG8_MMA(0, 0, At, B0); PG8_MMA(0, 1, At, B1); PG8_BAR; PG8_SCHED;
            PG8_LDA(At, 1, 1); PG8_STAGE(PG8_SB(1, 0), b3, voffB); PG8_STAGE(PG8_SB(1, 1), b3 + hstep, voffB); PG8_STAGE(PG8_SA(1, 0), a3, voffA);
            PG8_WAIT_V(8); PG8_WAIT_L(0); PG8_BAR; PG8_MMA(1, 0, At, B0); PG8_MMA(1, 1, At, B1); PG8_BAR; PG8_SCHED;
            } else {
            PG8_LDB(B0, 0, 0); PG8_SCHED; PG8_LDA(At, 0, 0); PG8_STAGE(PG8_SA(1, 1), a1 + hstep, voffA);
            PG8_WAIT_L(8); PG8_BAR; PG8_WAIT_L(0); PG8_MMA(0, 0, At, B0); PG8_BAR; PG8_SCHED;
            PG8_LDB(B1, 0, 1); PG8_STAGE(PG8_SB(0, 0), b2, voffB);
            PG8_BAR; PG8_WAIT_L(0); PG8_MMA(0, 1, At, B1); PG8_BAR;
            PG8_LDA(At, 0, 1); PG8_STAGE(PG8_SA(0, 0), a2, voffA);
            PG8_BAR; PG8_WAIT_L(0); PG8_MMA(1, 0, At, B0); PG8_BAR; PG8_SCHED;
            PG8_STAGE(PG8_SB(0, 1), b2 + hstep, voffB);
            PG8_WAIT_V(6); PG8_BAR; PG8_MMA(1, 1, At, B1); PG8_BAR;
            PG8_LDB(B0, 1, 0); PG8_SCHED; PG8_LDA(At, 1, 0); PG8_STAGE(PG8_SA(0, 1), a2 + hstep, voffA);
            PG8_WAIT_L(8); PG8_BAR; PG8_WAIT_L(0); PG8_MMA(0, 0, At, B0); PG8_BAR; PG8_SCHED;
            PG8_LDB(B1, 1, 1); PG8_STAGE(PG8_SB(1, 0), b3, voffB);
            PG8_BAR; PG8_WAIT_L(0); PG8_MMA(0, 1, At, B1); PG8_BAR;
            PG8_LDA(At, 1, 1); PG8_STAGE(PG8_SA(1, 0), a3, voffA);
            PG8_BAR; PG8_WAIT_L(0); PG8_MMA(1, 0, At, B0); PG8_BAR; PG8_SCHED;
            PG8_STAGE(PG8_SB(1, 1), b3 + hstep, voffB);
            PG8_WAIT_V(6); PG8_BAR; PG8_MMA(1, 1, At, B1); PG8_BAR;
            }
        }
        if constexpr (ALIGN_EPI) { if (wr == 0) PG8_BAR; }
        if constexpr (!Epi::AFTER_DRAIN) { E(acc, cur, wr, wc, fr, fq); S.done(cur); }
        if (!has_next) break;
#pragma unroll
        for (int a = 0; a < 2; ++a)
#pragma unroll
            for (int b = 0; b < 2; ++b)
#pragma unroll
                for (int m = 0; m < 4; ++m)
#pragma unroll
                    for (int n = 0; n < 2; ++n) acc[a][b][m][n] = (f32x4){0.f, 0.f, 0.f, 0.f};
        cur = nxt; cA = nA; cB = nB; ++ui;
        if constexpr (ALIGN_EPI) { if (wr == 1) PG8_BAR; }
    }
    PG8_WAIT_V(0);
    if constexpr (!ALIGN_EPI) { if (wr == 0) PG8_BAR; }
    PG8_BAR;
    if constexpr (Epi::AFTER_DRAIN) { E.fused(acc, cur, wr, wc, fr, fq, lds, wid, lane); S.done(cur); }
#undef PG8_SA
#undef PG8_SB
#undef PG8_STAGE
#undef PG8_LDA
#undef PG8_LDB
#undef PG8_MMA
#undef PG8_WAIT_V
#undef PG8_WAIT_L
#undef PG8_BAR
#undef PG8_SCHED
}
}

#define GAS __attribute__((address_space(1)))
#define LAS __attribute__((address_space(3)))
typedef unsigned short bf16;
typedef unsigned v4u __attribute__((ext_vector_type(4)));
typedef float f32x4 __attribute__((ext_vector_type(4)));
typedef short bf16x8 __attribute__((ext_vector_type(8)));
typedef GAS unsigned gu32;
typedef GAS unsigned long long gu64;
#define RLX_AGENT __ATOMIC_RELAXED, __HIP_MEMORY_SCOPE_AGENT
#define LDS_WAIT() asm volatile("s_waitcnt lgkmcnt(0)" ::: "memory")
#define VM_WAIT() asm volatile("s_waitcnt vmcnt(0)" ::: "memory")
__device__ __forceinline__ unsigned long long rt() { return __builtin_amdgcn_s_memrealtime(); }
__device__ __forceinline__ unsigned f2bf(float f) { unsigned u = __builtin_bit_cast(unsigned, f); return (u + 0x7fffu + ((u >> 16) & 1u)) >> 16; }
__device__ __forceinline__ unsigned pk2(float lo, float hi) { return f2bf(lo) | (f2bf(hi) << 16); }

#define XB_TMO      128
#define XB_XCNT(j)  (256  + 64 * (j))
#define XB_XSUB(j)  (1280 + 64 * (j))
#define XB_XGEN(j)  (2304 + 64 * (j))
#define XB_TOP      3328
#define XB_TOPGEN   3392
#define XCD_BAR_WORDS 3456
#define XB_SPIN_CAP (1u << 18)

__device__ __forceinline__ unsigned xb_ld(unsigned* p)              { return __hip_atomic_load(p, __ATOMIC_RELAXED, __HIP_MEMORY_SCOPE_AGENT); }
__device__ __forceinline__ unsigned xb_add(unsigned* p, unsigned v) { return __hip_atomic_fetch_add(p, v, __ATOMIC_RELAXED, __HIP_MEMORY_SCOPE_AGENT); }
__device__ __forceinline__ unsigned xb_xcc_id() { return (unsigned)__builtin_amdgcn_s_getreg((3 << 11) | 20) & 0xFu; }
#define XB_SPIN(cond, bar) do { unsigned _sp = 0; while (cond) { __builtin_amdgcn_s_sleep(1); \
    if ((++_sp & 255u) == 0u) { if (xb_ld(&(bar)[XB_TMO])) break; if (_sp > XB_SPIN_CAP) { atomicAdd(&(bar)[XB_TMO], 1u); break; } } } } while (0)

struct XcdBarrier {
    unsigned* bar; unsigned x;
    volatile LAS unsigned* st;
};

__device__ __forceinline__ XcdBarrier xcd_barrier_post(unsigned* bar, volatile LAS unsigned* st) {
    XcdBarrier b; b.bar = bar; b.x = xb_xcc_id(); b.st = st;
    if (threadIdx.x == 0) (void)xb_add(&bar[XB_XCNT(b.x)], 1u);
    return b;
}
__device__ __forceinline__ void xcd_barrier_complete(unsigned* bar, unsigned x, unsigned& nloc, unsigned& nx) {
    const unsigned G = gridDim.x * gridDim.y * gridDim.z;
    unsigned sum, cnt, mine, sp = 0u;
    for (;;) {
        sum = 0u; cnt = 0u; mine = 0u;
#pragma unroll
        for (unsigned j = 0; j < 16; ++j) { const unsigned c = xb_ld(&bar[XB_XCNT(j)]); sum += c; cnt += (c > 0u) ? 1u : 0u; mine = (j == x) ? c : mine; }
        if (sum == G) break;
        __builtin_amdgcn_s_sleep(1);
        if ((++sp & 255u) == 0u) { if (xb_ld(&bar[XB_TMO])) break; if (sp > XB_SPIN_CAP) { atomicAdd(&bar[XB_TMO], 1u); break; } }
    }
    nloc = mine > 0u ? mine : 1u; nx = cnt > 0u ? cnt : 1u;
}

__device__ __forceinline__ void xcd_barrier(const XcdBarrier& b) {
    asm volatile("s_waitcnt vmcnt(0)" ::: "memory");
    __syncthreads();
    if (threadIdx.x == 0) {
        unsigned* bar = b.bar;
        __builtin_amdgcn_s_waitcnt(0);
        unsigned nloc = b.st[0], nx = b.st[1];
        if (nloc == 0u) { xcd_barrier_complete(bar, b.x, nloc, nx); b.st[0] = nloc; b.st[1] = nx; }
        const unsigned old = xb_add(&bar[XB_XSUB(b.x)], 1u);
        const unsigned gen = old / nloc;
        if (old + 1u == (gen + 1u) * nloc) {
            __builtin_amdgcn_fence(__ATOMIC_RELEASE, "agent");
            asm volatile("s_waitcnt vmcnt(0)" ::: "memory");
            const unsigned og = xb_add(&bar[XB_TOP], 1u);
            const unsigned tg = og / nx;
            if (og + 1u == (tg + 1u) * nx) xb_add(&bar[XB_TOPGEN], 1u);
            else XB_SPIN(xb_ld(&bar[XB_TOPGEN]) == tg, bar);
            __builtin_amdgcn_fence(__ATOMIC_ACQUIRE, "agent");
            xb_add(&bar[XB_XGEN(b.x)], 1u);
            asm volatile("s_waitcnt vmcnt(0)" ::: "memory");
        } else {
            XB_SPIN(xb_ld(&bar[XB_XGEN(b.x)]) == gen, bar);
            __builtin_amdgcn_fence(__ATOMIC_ACQUIRE, "agent");
            asm volatile("s_waitcnt vmcnt(0)" ::: "memory");
        }
    }
    __syncthreads();
}

constexpr int NWAVES = 8;
constexpr int D = 1024, FF = 2816;
constexpr int PB = 8, PT = 2048, SB = 128, STK = 4;
constexpr int MP = PB * PT, MS = SB * STK, M = MP + MS;
constexpr int NRW = 3584, KRW = 2048, NL2 = 3072, KL2 = 384, NIN = 3328;
constexpr float NORM_EPS = 1e-6f, GN_EPS = 64e-5f;
typedef pg8::bf16_t bf16;

constexpr size_t MiB = 1u << 20;
constexpr size_t WS_CTL = 0, CTL_ZERO_BYTES = 64 * 1024;
constexpr size_t WS_W = 1 * MiB;
constexpr size_t WS_XR = 20 * MiB;
constexpr size_t WS_BIG = 86 * MiB;
constexpr size_t WS_END = 256 * MiB;
constexpr size_t WS_YRAW = 256 * MiB, WS_BON = 288 * MiB, WS_W2 = 289 * MiB  , WS_END2 = 308 * MiB;
constexpr size_t W_GU = 0, W_D = (size_t)2 * FF * D * 2;
constexpr size_t W_RW = 0, W_L2 = (size_t)NRW * KRW * 2, W_O = W_L2 + (size_t)NL2 * KL2 * 2;
constexpr size_t W_IN = 0, W_OUT = (size_t)NIN * D * 2;
static_assert(W_D + (size_t)D * FF * 2 <= 19 * MiB && W_O + (size_t)D * D * 2 <= 19 * MiB && W_OUT + (size_t)D * D * 2 <= 19 * MiB, "weights region");
constexpr size_t B_H = 0, B_XN = 91 * MiB, B_SLAB = 124 * MiB;
constexpr size_t B_ACAT = 0, B_R = 66 * MiB, B_K = 99 * MiB, B_V = 132 * MiB, B_DEC = 0, B_AA = 33 * MiB;
constexpr size_t B_QKR = 0, B_VV = 33 * MiB, B_HO = 66 * MiB, B_OO = 124 * MiB, B_IF = 157 * MiB;
static_assert((size_t)M * FF * 2 <= 91 * MiB && (size_t)M * D * 2 == 33 * MiB && B_IF + (size_t)M * 16 * 4 <= 170 * MiB && B_SLAB + (size_t)11 * MS * D * 4 <= 170 * MiB, "BIG map");
constexpr size_t OS_GG = 0, OS_LORA = 33 * MiB;
static_assert(OS_LORA + (size_t)M * KL2 * 2 <= (size_t)MP * D * 4, "d_out scratch");
constexpr size_t O_Y = 0, O_P_S = 17301504, O_P_SHIFT = 17825792, O_P_C = 17833984, O_P_N = 18358272, O_P_M = 18362368, O_P_CONV = 18362432,
                 O_S_S = 18387008, O_S_SHIFT = 26775616, O_S_C = 26906688, O_S_N = 35295296, O_S_M = 35360832, O_S_CONV = 35361856, O_END = 35755072;
constexpr int CW_BAR = 1024;

constexpr int RING_BYTES = 131072, LDSCTL_OFF = RING_BYTES, MISC_OFF = LDSCTL_OFF + 320, TAB_OFF = LDSCTL_OFF + 1024, LDS_BYTES = 147456;

enum { I_XP = 0, I_XS, I_RS, I_RSHIFT, I_MC, I_MN, I_MM, I_MCONV, I_NFA, I_FAWG, I_FAWU, I_FAWD, I_NMIX, I_NFB, I_FBWG, I_FBWU, I_FBWD,
       I_MU, I_WR, I_WK, I_WV, I_WO, I_W0, I_W1, I_W2, I_A0, I_A1, I_A2, I_G1, I_G2, I_KK, I_KA, I_RK, I_GNW, I_GNB,
       I_WIN, I_BIF, I_CW, I_CB, I_MNW, I_WOUT, I_NFIN, N_IN };

typedef __bf16 bf16x2_t __attribute__((ext_vector_type(2)));
typedef float f32x2_t __attribute__((ext_vector_type(2)));
__device__ __forceinline__ unsigned pkbf(float lo, float hi) { f32x2_t v = {lo, hi}; bf16x2_t b = __builtin_convertvector(v, bf16x2_t); return __builtin_bit_cast(unsigned, b); }
__device__ __forceinline__ float bflo(unsigned u) { return __builtin_bit_cast(float, u << 16); }
__device__ __forceinline__ float bfhi(unsigned u) { return __builtin_bit_cast(float, u & 0xffff0000u); }
__device__ __forceinline__ float bf1(unsigned short u) { return __builtin_bit_cast(float, (unsigned)u << 16); }
__device__ __forceinline__ unsigned short f2bf1(float f) { return (unsigned short)(pkbf(f, 0.f) & 0xffffu); }
__device__ __forceinline__ void unpack8(v4u w, float (&o)[8]) { o[0] = bflo(w.x); o[1] = bfhi(w.x); o[2] = bflo(w.y); o[3] = bfhi(w.y); o[4] = bflo(w.z); o[5] = bfhi(w.z); o[6] = bflo(w.w); o[7] = bfhi(w.w); }
__device__ __forceinline__ v4u pack8(const float (&o)[8]) { v4u w; w.x = pkbf(o[0], o[1]); w.y = pkbf(o[2], o[3]); w.z = pkbf(o[4], o[5]); w.w = pkbf(o[6], o[7]); return w; }
__device__ __forceinline__ float sigmoidf_(float x) { return __builtin_amdgcn_rcpf(1.f + __expf(-x)); }
__device__ __forceinline__ float siluf_(float x) { return x * __builtin_amdgcn_rcpf(1.f + __expf(-x)); }
__device__ __forceinline__ float tanhf_(float x) { return 1.f - 2.f * __builtin_amdgcn_rcpf(__expf(2.f * x) + 1.f); }
__device__ __forceinline__ float logsigmoidf_(float x) { return fminf(x, 0.f) - log1pf(__expf(-fabsf(x))); }
template <int CTRL> __device__ __forceinline__ float dppf(float x) { return __builtin_bit_cast(float, __builtin_amdgcn_update_dpp(0, __builtin_bit_cast(int, x), CTRL, 0xF, 0xF, true)); }
__device__ __forceinline__ float red4(float x) { x += dppf<0xB1>(x); x += dppf<0x4E>(x); return x; }
__device__ __forceinline__ float red8(float x) { x = red4(x); x += dppf<0x141>(x); return x; }
__device__ __forceinline__ float red16(float x) { x = red8(x); x += dppf<0x140>(x); return x; }
__device__ __forceinline__ float wave_sum(float v) {
#pragma unroll
    for (int o = 1; o < 64; o <<= 1) v += __shfl_xor(v, o);
    return v;
}

struct Frame {
    LAS unsigned char* lds;
    volatile LAS unsigned* MISC;
    gu32* ctl;
    volatile LAS unsigned long long* tab;
    int tid, lane, wave, vcu, G;
};
__device__ __forceinline__ const float* inptr(const Frame& F, int i) { const unsigned long long v = F.tab[i];
    const unsigned lo = __builtin_amdgcn_readfirstlane((unsigned)v), hi = __builtin_amdgcn_readfirstlane((unsigned)(v >> 32)); return (const float*)(const GAS float*)(((unsigned long long)hi << 32) | lo); }

using pg8::Unit; using pg8::BM; using pg8::HALF;
__device__ __forceinline__ void st8bf(bf16* p, f32x4 v0, f32x4 v1) { v4u w; w.x = pkbf(v0[0], v0[1]); w.y = pkbf(v0[2], v0[3]); w.z = pkbf(v1[0], v1[1]); w.w = pkbf(v1[2], v1[3]); *(v4u*)p = w; }

struct EpiSwiglu {
    static constexpr bool PERM = true, AFTER_DRAIN = false;
    bf16* H; int pvar;
    __device__ __forceinline__ void operator()(const f32x4 (&acc)[2][2][4][2], const Unit& u, int wr, int wc, int fr, int fq) const {
        if (pvar == 3) return;
        const int row0 = u.pm * BM + wr * 64 + fr, col0 = u.pn * 128 + wc * 32 + 8 * fq;
#pragma unroll
        for (int ai = 0; ai < 2; ++ai)
#pragma unroll
            for (int m = 0; m < 4; ++m) {
                f32x4 o[2];
#pragma unroll
                for (int n = 0; n < 2; ++n)
#pragma unroll
                    for (int i = 0; i < 4; ++i) { const float g = acc[ai][0][m][n][i], up = acc[ai][1][m][n][i]; o[n][i] = siluf_(g) * up; }
                st8bf(H + (size_t)(row0 + ai * HALF + m * 16) * FF + col0, o[0], o[1]);
            }
    }
};
struct EpiRes {
    static constexpr bool PERM = false, AFTER_DRAIN = false;
    const float* base; float* out; float* slab; float coef;
    __device__ __forceinline__ void operator()(const f32x4 (&acc)[2][2][4][2], const Unit& u, int wr, int wc, int fr, int fq) const {
        const int row0 = u.pm * BM + wr * 64 + fr, col0 = u.pn * BM + wc * 32 + 4 * fq;
        if (u.slab < 0) {
#pragma unroll
            for (int ai = 0; ai < 2; ++ai)
#pragma unroll
                for (int m = 0; m < 4; ++m) { const size_t ro = (size_t)(row0 + ai * HALF + m * 16) * D + col0;
#pragma unroll
                    for (int bj = 0; bj < 2; ++bj)
#pragma unroll
                        for (int n = 0; n < 2; ++n) { const f32x4 b = *(const f32x4*)(base + ro + bj * HALF + n * 16); *(f32x4*)(out + ro + bj * HALF + n * 16) = b + acc[ai][bj][m][n] * coef; } }
        } else {
            float* sl = slab + (size_t)u.slab * MS * D;
#pragma unroll
            for (int ai = 0; ai < 2; ++ai)
#pragma unroll
                for (int m = 0; m < 4; ++m) { const size_t ro = (size_t)(row0 + ai * HALF + m * 16 - MP) * D + col0;
#pragma unroll
                    for (int bj = 0; bj < 2; ++bj)
#pragma unroll
                        for (int n = 0; n < 2; ++n) *(f32x4*)(sl + ro + bj * HALF + n * 16) = acc[ai][bj][m][n]; }
        }
    }
};
struct EpiRw {
    static constexpr bool PERM = true, AFTER_DRAIN = false;
    bf16 *R, *K, *V, *L;
    __device__ __forceinline__ void operator()(const f32x4 (&acc)[2][2][4][2], const Unit& u, int wr, int wc, int fr, int fq) const {
        const int row0 = u.pm * BM + wr * 64 + fr;
        if (u.pn < 12) {
            bf16 *p0 = R, *p1 = K, *p2 = V; asm volatile("" : "+s"(p0), "+s"(p1), "+s"(p2));
            bf16* dst = u.pn < 4 ? p0 : (u.pn < 8 ? p1 : p2); const int col0 = (u.pn & 3) * BM + wc * 32 + 8 * fq;
#pragma unroll
            for (int ai = 0; ai < 2; ++ai)
#pragma unroll
                for (int m = 0; m < 4; ++m) { bf16* rp = dst + (size_t)(row0 + ai * HALF + m * 16) * D + col0;
#pragma unroll
                    for (int bj = 0; bj < 2; ++bj) st8bf(rp + bj * HALF, acc[ai][bj][m][0], acc[ai][bj][m][1]); }
        } else {
#pragma unroll
            for (int bj = 0; bj < 2; ++bj) {
                const int lc = (u.pn - 12) * BM + bj * HALF + wc * 32 + 8 * fq;
                if (lc >= KL2) continue;
                const int act = lc < 64 ? 1 : (lc < 128 ? 0 : (lc < 288 ? 2 : 3));
#pragma unroll
                for (int ai = 0; ai < 2; ++ai)
#pragma unroll
                    for (int m = 0; m < 4; ++m) {
                        f32x4 o[2];
#pragma unroll
                        for (int n = 0; n < 2; ++n)
#pragma unroll
                            for (int i = 0; i < 4; ++i) { const float x = acc[ai][bj][m][n][i]; o[n][i] = act == 1 ? tanhf_(x) : (act == 0 ? x : (act == 2 ? sigmoidf_(x) : 0.f)); }
                        st8bf(L + (size_t)(row0 + ai * HALF + m * 16) * KL2 + lc, o[0], o[1]);
                    }
            }
        }
    }
};
struct EpiL2 {
    static constexpr bool PERM = true, AFTER_DRAIN = false;
    bf16 *DEC, *AA, *GG; const float *w0, *a0;
    __device__ __forceinline__ void operator()(const f32x4 (&acc)[2][2][4][2], const Unit& u, int wr, int wc, int fr, int fq) const {
        const int row0 = u.pm * BM + wr * 64 + fr, kind = u.pn >> 2, col0 = (u.pn & 3) * BM + wc * 32 + 8 * fq;
        bf16 *p0 = DEC, *p1 = AA, *p2 = GG; const float *q0 = w0, *q1 = a0; asm volatile("" : "+s"(p0), "+s"(p1), "+s"(p2), "+s"(q0), "+s"(q1));
        bf16* dst = kind == 0 ? p0 : (kind == 1 ? p1 : p2); const float* bias = kind == 0 ? q0 : q1;
#pragma unroll
        for (int bj = 0; bj < 2; ++bj) {
            f32x4 bv[2];
#pragma unroll
            for (int n = 0; n < 2; ++n) bv[n] = kind < 2 ? *(const f32x4*)(bias + col0 + bj * HALF + 4 * n) : (f32x4){0.f, 0.f, 0.f, 0.f};
#pragma unroll
            for (int ai = 0; ai < 2; ++ai)
#pragma unroll
                for (int m = 0; m < 4; ++m) {
                    f32x4 o[2];
#pragma unroll
                    for (int n = 0; n < 2; ++n)
#pragma unroll
                        for (int i = 0; i < 4; ++i) { const float z = acc[ai][bj][m][n][i] + bv[n][i];
                            o[n][i] = kind == 0 ? (1.f - __expf(-0.60653065971f * sigmoidf_(z))) : (kind == 1 ? sigmoidf_(z) : z); }
                    st8bf(dst + (size_t)(row0 + ai * HALF + m * 16) * D + col0 + bj * HALF, o[0], o[1]);
                }
        }
    }
};
struct EpiIn {
    static constexpr bool PERM = true, AFTER_DRAIN = false;
    bf16 *QKR, *VV, *OO; float* IF; const float* bif;
    __device__ __forceinline__ void operator()(const f32x4 (&acc)[2][2][4][2], const Unit& u, int wr, int wc, int fr, int fq) const {
        const int row0 = u.pm * BM + wr * 64 + fr;
        if (u.pn < 12) {
            bf16 *p0 = QKR, *p1 = VV, *p2 = OO; asm volatile("" : "+s"(p0), "+s"(p1), "+s"(p2));
            const int kind = u.pn >> 2; bf16* dst = kind == 0 ? p0 : (kind == 1 ? p1 : p2); const int col0 = (u.pn & 3) * BM + wc * 32 + 8 * fq;
#pragma unroll
            for (int ai = 0; ai < 2; ++ai)
#pragma unroll
                for (int m = 0; m < 4; ++m) { bf16* rp = dst + (size_t)(row0 + ai * HALF + m * 16) * D + col0;
#pragma unroll
                    for (int bj = 0; bj < 2; ++bj) { f32x4 a = acc[ai][bj][m][0], b = acc[ai][bj][m][1];
                        if (kind == 2) {
#pragma unroll
                            for (int i = 0; i < 4; ++i) { a[i] = sigmoidf_(a[i]); b[i] = sigmoidf_(b[i]); } }
                        st8bf(rp + bj * HALF, a, b); } }
        } else if (u.pn == 12 && wc == 0 && fq < 2) {
            const f32x4 b0 = *(const f32x4*)(bif + 8 * fq), b1 = *(const f32x4*)(bif + 8 * fq + 4);
#pragma unroll
            for (int ai = 0; ai < 2; ++ai)
#pragma unroll
                for (int m = 0; m < 4; ++m) { f32x4 a = acc[ai][0][m][0] + b0, b = acc[ai][0][m][1] + b1;
                    if (fq == 1) {
#pragma unroll
                        for (int i = 0; i < 4; ++i) { a[i] = logsigmoidf_(a[i]); b[i] = logsigmoidf_(b[i]); } }
                    float* rp = IF + (size_t)(row0 + ai * HALF + m * 16) * 16 + 8 * fq; *(f32x4*)rp = a; *(f32x4*)(rp + 4) = b; }
        }
    }
};

struct CJ { const float* W; const float* sc; bf16* WT; int K, N, Npad, ldk, koff, rmode, roff, smode; };
__device__ __forceinline__ int cj_items(const CJ& j) { return (j.K / 64) * (j.Npad / 32); }
__device__ __forceinline__ void conv_item(const CJ& J, LAS float* scr, int item, int lane) {
    const int nblk = J.Npad / 32, kb = item / nblk, nb = item % nblk, k0 = 64 * kb, n0 = 32 * nb;
    const int nn = n0 + (lane & 31); const bool nok = nn < J.N;
#pragma unroll 8
    for (int i = 0; i < 32; ++i) { const int kk = 2 * i + (lane >> 5); float w = nok ? J.W[(size_t)(k0 + kk) * J.N + nn] : 0.f;
        if (J.smode) { const float s = J.sc[k0 + kk]; w *= (J.smode == 1 ? s : 1.f - s); }
        scr[kk * 33 + (lane & 31)] = w; }
    LDS_WAIT(); asm volatile("" ::: "memory");
    const int rowbase = J.rmode == 0 ? J.roff + n0 : (n0 >> 7) * 256 + (n0 & 127) + J.roff;
    const int c = lane & 7;
#pragma unroll
    for (int j = 0; j < 4; ++j) { const int n = (lane >> 3) + 8 * j; const LAS float* s = scr + (8 * c) * 33 + n;
        v4u o; o.x = pkbf(s[0 * 33], s[1 * 33]); o.y = pkbf(s[2 * 33], s[3 * 33]); o.z = pkbf(s[4 * 33], s[5 * 33]); o.w = pkbf(s[6 * 33], s[7 * 33]);
        *(GAS v4u*)(J.WT + (size_t)(rowbase + n) * J.ldk + J.koff + k0 + 8 * c) = o; }
    LDS_WAIT(); asm volatile("" ::: "memory");
}
__device__ __forceinline__ CJ get_job(const Frame& F, int kind, int j, int layer, int ab, bf16* Wb) {
    CJ J; J.sc = nullptr; J.smode = 0; J.koff = 0; J.rmode = 0; J.roff = 0;
    if (kind == 0) {
        const float* wg = inptr(F, ab ? I_FBWG : I_FAWG) + (size_t)layer * D * FF; const float* wu = inptr(F, ab ? I_FBWU : I_FAWU) + (size_t)layer * D * FF; const float* wd = inptr(F, ab ? I_FBWD : I_FAWD) + (size_t)layer * D * FF;
        if (j < 2) { J.W = j == 0 ? wg : wu; J.K = D; J.N = FF; J.Npad = FF; J.WT = Wb + W_GU / 2; J.ldk = D; J.rmode = 1; J.roff = j == 0 ? 0 : 128; }
        else { J.W = wd; J.K = FF; J.N = D; J.Npad = D; J.WT = Wb + W_D / 2; J.ldk = FF; }
    } else if (kind == 1) {
        if (j < 12) {
            const int s = j >> 1, half = j & 1;
            J.W = inptr(F, s == 0 ? I_WR : (s == 1 ? I_WK : (s == 2 ? I_WV : (s == 3 ? I_W1 : (s == 4 ? I_A1 : I_G1)))));
            J.N = s < 3 ? 1024 : (s < 5 ? 64 : 160); J.Npad = s < 3 ? 1024 : (s < 5 ? 64 : 384);
            J.roff = s < 3 ? 1024 * s : (s == 3 ? 3072 : (s == 4 ? 3136 : 3200));
            const int mui = s == 0 ? 0 : (s == 1 ? 2 : (s == 2 ? 3 : (s == 3 ? 1 : (s == 4 ? 4 : 5))));
            J.sc = inptr(F, I_MU) + mui * D; J.smode = half ? 1 : 2; J.koff = half * D; J.K = D; J.ldk = KRW; J.WT = Wb + W_RW / 2;
        } else { J.W = inptr(F, I_WO); J.K = D; J.N = D; J.Npad = D; J.WT = Wb + W_O / 2; J.ldk = D; }
    } else {
        if (j == 0) { J.W = inptr(F, I_WIN); J.K = D; J.N = 3088; J.Npad = NIN; J.WT = Wb + W_IN / 2; J.ldk = D; }
        else { J.W = inptr(F, I_WOUT); J.K = D; J.N = D; J.Npad = D; J.WT = Wb + W_OUT / 2; J.ldk = D; }
    }
    return J;
}
__device__ __forceinline__ void convert_weights(const Frame& F, int kind, int layer, int ab, bf16* Wb, const int cu0 = 0) {
    LAS float* scr = (LAS float*)(F.lds + F.wave * 16384);
    const int gw = (F.vcu - cu0) * NWAVES + F.wave, NGW = (F.G - cu0) * NWAVES;
    const int njobs = kind == 0 ? 3 : (kind == 1 ? 13 : 2);
    int total = 0;
    for (int j = 0; j < njobs; ++j) { const CJ J = get_job(F, kind, j, layer, ab, Wb); total += cj_items(J); }
    for (int g = gw; g < total; g += NGW) {
        int r = g, j = 0; CJ J = get_job(F, kind, 0, layer, ab, Wb);
        while (r >= cj_items(J)) { r -= cj_items(J); ++j; J = get_job(F, kind, j, layer, ab, Wb); }
        conv_item(J, scr, r, F.lane);
    }
    if (kind == 1) {
        bf16* WT = Wb + W_L2 / 2; const float* w2 = inptr(F, I_W2); const float* a2 = inptr(F, I_A2); const float* g2 = inptr(F, I_G2);
        for (int idx = (F.vcu * NWAVES + F.wave) * 64 + F.lane; idx < 48 * NL2; idx += F.G * NWAVES * 64) {
            const int c = idx / NL2, n = idx % NL2, type = n >> 10, jj = n & 1023;
            const float* src = nullptr;
            if (type == 0 && c < 8) src = w2 + (size_t)(8 * c) * D + jj;
            else if (type == 1 && c >= 8 && c < 16) src = a2 + (size_t)(8 * (c - 8)) * D + jj;
            else if (type == 2 && c >= 16 && c < 36) src = g2 + (size_t)(8 * (c - 16)) * D + jj;
            float v[8];
#pragma unroll
            for (int e = 0; e < 8; ++e) v[e] = src ? src[(size_t)e * D] : 0.f;
            *(GAS v4u*)(WT + (size_t)n * KL2 + 8 * c) = pack8(v);
        }
    }
}

template <int MODE>
__device__ __forceinline__ void norm_rows(const Frame& F, const float* base_p, const float* base_s, int nslab, float coef, const float* slab, float* xr,
                                          const float* gain, bf16* dst, const float* shift_in, float* out) {
    const int gw = F.vcu * NWAVES + F.wave, NGW = F.G * NWAVES, lane = F.lane;
    f32x4 gv[4];
#pragma unroll
    for (int j = 0; j < 4; ++j) gv[j] = *(const f32x4*)(gain + 256 * j + 4 * lane);
    for (int m = gw; m < M; m += NGW) {
        const bool samp = m >= MP;
        const float* src = samp ? base_s + (size_t)(m - MP) * D : base_p + (size_t)m * D;
        f32x4 v[4];
#pragma unroll
        for (int j = 0; j < 4; ++j) v[j] = *(const f32x4*)(src + 256 * j + 4 * lane);
        if (samp && nslab > 0) {
            for (int s = 0; s < nslab; ++s) { const float* sp = slab + ((size_t)s * MS + (m - MP)) * D;
#pragma unroll
                for (int j = 0; j < 4; ++j) v[j] += *(const f32x4*)(sp + 256 * j + 4 * lane) * coef; }
            if (MODE != 2) {
#pragma unroll
                for (int j = 0; j < 4; ++j) *(f32x4*)(xr + (size_t)m * D + 256 * j + 4 * lane) = v[j]; }
        }
        float ss = 0.f;
#pragma unroll
        for (int j = 0; j < 4; ++j) ss += (v[j].x * v[j].x + v[j].y * v[j].y) + (v[j].z * v[j].z + v[j].w * v[j].w);
        const float r = 1.0f / sqrtf(wave_sum(ss) * (1.f / D) + NORM_EPS);
#pragma unroll
        for (int j = 0; j < 4; ++j) v[j] = v[j] * r * gv[j];
        if (MODE == 2) {
#pragma unroll
            for (int j = 0; j < 4; ++j) *(f32x4*)(out + O_Y + (size_t)m * D + 256 * j + 4 * lane) = v[j];
        } else if (MODE == 0) {
#pragma unroll
            for (int j = 0; j < 4; ++j) { const unsigned long long w = (unsigned long long)pkbf(v[j].x, v[j].y) | ((unsigned long long)pkbf(v[j].z, v[j].w) << 32);
                *(unsigned long long*)(dst + (size_t)m * D + 256 * j + 4 * lane) = w; }
        } else {
            int t, b; bool first, last;
            if (!samp) { t = m & (PT - 1); b = m >> 11; first = t == 0; last = t == PT - 1; } else { const int mm = m - MP; t = mm & 3; b = mm >> 2; first = t == 0; last = t == 3; }
#pragma unroll
            for (int j = 0; j < 4; ++j) { const unsigned long long w = (unsigned long long)pkbf(v[j].x, v[j].y) | ((unsigned long long)pkbf(v[j].z, v[j].w) << 32);
                *(unsigned long long*)(dst + (size_t)m * (2 * D) + 256 * j + 4 * lane) = w;
                if (!last) *(unsigned long long*)(dst + (size_t)(m + 1) * (2 * D) + D + 256 * j + 4 * lane) = w;
                else *(f32x4*)(out + (samp ? O_S_SHIFT : O_P_SHIFT) + (size_t)b * D + 256 * j + 4 * lane) = v[j];
                if (first) { unsigned long long z = 0ull;
                    if (samp) { const f32x4 s = *(const f32x4*)(shift_in + (size_t)b * D + 256 * j + 4 * lane); z = (unsigned long long)pkbf(s.x, s.y) | ((unsigned long long)pkbf(s.z, s.w) << 32); }
                    *(unsigned long long*)(dst + (size_t)m * (2 * D) + D + 256 * j + 4 * lane) = z; }
            }
        }
    }
}

constexpr int RW_KK = 0, RW_DD = 4096, RW_BB = 8192, RW_KP = 12288, RW_RR = 16384, RW_VV = 20480, RW_YY = 24576;
__device__ __forceinline__ void rwkv_chain(const Frame& F, int row0, int T, int h, const float* S0, float* ST,
                                           const bf16* Rb, const bf16* Kb, const bf16* Vb, const bf16* Db, const bf16* Ab, bf16* Gb,
                                           const float* k_k, const float* k_a, const float* r_k, const float* gn_w, const float* gn_b, const bool do_store, const int pvar) {
    LAS float* L = (LAS float*)F.lds;
    const int tid = F.tid, lane = F.lane, w = F.wave;
    const int cg = tid & 7, tt = tid >> 3;
    const int srow = 8 * w + (lane >> 3);
    float S[8];
    if (S0) { const f32x4 a = *(const f32x4*)(S0 + srow * 64 + 8 * cg), b = *(const f32x4*)(S0 + srow * 64 + 8 * cg + 4);
        S[0] = a.x; S[1] = a.y; S[2] = a.z; S[3] = a.w; S[4] = b.x; S[5] = b.y; S[6] = b.z; S[7] = b.w; }
    else {
#pragma unroll
        for (int j = 0; j < 8; ++j) S[j] = 0.f; }
    const int ch = h * 64 + 8 * cg;
    float ckk[8], cka[8], crk[8], cgw[8], cgb[8];
#pragma unroll
    for (int j = 0; j < 8; ++j) { ckk[j] = k_k[ch + j]; cka[j] = k_a[ch + j]; crk[j] = r_k[ch + j]; cgw[j] = gn_w[ch + j]; cgb[j] = gn_b[ch + j]; }
    const int nch = (T + 63) >> 6;
    v4u pr = {0, 0, 0, 0}, pk = pr, pv = pr, pd = pr, pa = pr, pg = pr;
    { const int nt0 = T < 64 ? T : 64;
      if (tt < nt0) { const size_t off = (size_t)(row0 + tt) * D + ch;
          pr = *(const v4u*)(Rb + off); pk = *(const v4u*)(Kb + off); pv = *(const v4u*)(Vb + off); pd = *(const v4u*)(Db + off); pa = *(const v4u*)(Ab + off); pg = *(const v4u*)(Gb + off); } }
    float bon = 0.f, vv[8], gg[8];
    for (int c = 0; c < nch; ++c) {
        const int nt = (T - 64 * c) < 64 ? (T - 64 * c) : 64;
        const bool valid = tt < nt;
        {
            float r8[8], k8[8], d8[8], a8[8];
            unpack8(pr, r8); unpack8(pk, k8); unpack8(pv, vv); unpack8(pd, d8); unpack8(pa, a8); unpack8(pg, gg);
            float kk[8], ss = 0.f;
#pragma unroll
            for (int j = 0; j < 8; ++j) { kk[j] = k8[j] * ckk[j]; ss += kk[j] * kk[j]; }
            ss = red8(ss);
            const float inv = __builtin_amdgcn_rsqf(fmaxf(ss, 1e-24f));
            float kp[8], bsum = 0.f;
#pragma unroll
            for (int j = 0; j < 8; ++j) { kk[j] *= inv; kp[j] = k8[j] * (1.f + (a8[j] - 1.f) * cka[j]); bsum += r8[j] * kp[j] * crk[j]; }
            bon = red8(bsum);
            if (valid) {
                LAS float* p = L + tt * 64 + 8 * cg;
                *(LAS f32x4*)(p + RW_KK) = (f32x4){-kk[0], -kk[1], -kk[2], -kk[3]}; *(LAS f32x4*)(p + RW_KK + 4) = (f32x4){-kk[4], -kk[5], -kk[6], -kk[7]};
                *(LAS f32x4*)(p + RW_DD) = (f32x4){1.f - d8[0], 1.f - d8[1], 1.f - d8[2], 1.f - d8[3]}; *(LAS f32x4*)(p + RW_DD + 4) = (f32x4){1.f - d8[4], 1.f - d8[5], 1.f - d8[6], 1.f - d8[7]};
                *(LAS f32x4*)(p + RW_BB) = (f32x4){kk[0] * a8[0], kk[1] * a8[1], kk[2] * a8[2], kk[3] * a8[3]}; *(LAS f32x4*)(p + RW_BB + 4) = (f32x4){kk[4] * a8[4], kk[5] * a8[5], kk[6] * a8[6], kk[7] * a8[7]};
                *(LAS f32x4*)(p + RW_KP) = (f32x4){kp[0], kp[1], kp[2], kp[3]}; *(LAS f32x4*)(p + RW_KP + 4) = (f32x4){kp[4], kp[5], kp[6], kp[7]};
                *(LAS f32x4*)(p + RW_RR) = (f32x4){r8[0], r8[1], r8[2], r8[3]}; *(LAS f32x4*)(p + RW_RR + 4) = (f32x4){r8[4], r8[5], r8[6], r8[7]};
                *(LAS f32x4*)(p + RW_VV) = (f32x4){vv[0], vv[1], vv[2], vv[3]}; *(LAS f32x4*)(p + RW_VV + 4) = (f32x4){vv[4], vv[5], vv[6], vv[7]};
            }
        }
        __syncthreads();
        if (c + 1 < nch) { const int nt1 = (T - 64 * (c + 1)) < 64 ? (T - 64 * (c + 1)) : 64;
            if (tt < nt1) { const size_t off = (size_t)(row0 + 64 * (c + 1) + tt) * D + ch;
                pr = *(const v4u*)(Rb + off); pk = *(const v4u*)(Kb + off); pv = *(const v4u*)(Vb + off); pd = *(const v4u*)(Db + off); pa = *(const v4u*)(Ab + off); pg = *(const v4u*)(Gb + off); } }
        {
            typedef float f2 __attribute__((ext_vector_type(2)));
            f2 S2[4] = {{S[0], S[1]}, {S[2], S[3]}, {S[4], S[5]}, {S[6], S[7]}};
            const LAS float* p = L + 8 * cg;
            LAS float* yw = L + RW_YY + srow;
            const LAS float* vp = L + RW_VV + srow;
#define RW_LD(N, Dd, B, Q, R, VR, t_) do { const LAS float* p_ = p + (t_) * 64; \
                N[0] = *(const LAS f32x4*)(p_ + RW_KK); N[1] = *(const LAS f32x4*)(p_ + RW_KK + 4); Dd[0] = *(const LAS f32x4*)(p_ + RW_DD); Dd[1] = *(const LAS f32x4*)(p_ + RW_DD + 4); \
                B[0] = *(const LAS f32x4*)(p_ + RW_BB); B[1] = *(const LAS f32x4*)(p_ + RW_BB + 4); Q[0] = *(const LAS f32x4*)(p_ + RW_KP); Q[1] = *(const LAS f32x4*)(p_ + RW_KP + 4); \
                R[0] = *(const LAS f32x4*)(p_ + RW_RR); R[1] = *(const LAS f32x4*)(p_ + RW_RR + 4); VR = vp[(t_) * 64]; } while (0)
#define RW_STEP(N, Dd, B, Q, R, VR, t_) do { \
                f2 a_ = S2[0] * (f2){N[0].x, N[0].y}; a_ = S2[1] * (f2){N[0].z, N[0].w} + a_; a_ = S2[2] * (f2){N[1].x, N[1].y} + a_; a_ = S2[3] * (f2){N[1].z, N[1].w} + a_; \
                const float sa_ = red8(a_.x + a_.y); const f2 sv_ = {sa_, sa_}, vv_ = {VR, VR}; \
                S2[0] = S2[0] * (f2){Dd[0].x, Dd[0].y} + (sv_ * (f2){B[0].x, B[0].y} + vv_ * (f2){Q[0].x, Q[0].y}); \
                S2[1] = S2[1] * (f2){Dd[0].z, Dd[0].w} + (sv_ * (f2){B[0].z, B[0].w} + vv_ * (f2){Q[0].z, Q[0].w}); \
                S2[2] = S2[2] * (f2){Dd[1].x, Dd[1].y} + (sv_ * (f2){B[1].x, B[1].y} + vv_ * (f2){Q[1].x, Q[1].y}); \
                S2[3] = S2[3] * (f2){Dd[1].z, Dd[1].w} + (sv_ * (f2){B[1].z, B[1].w} + vv_ * (f2){Q[1].z, Q[1].w}); \
                f2 y_ = S2[0] * (f2){R[0].x, R[0].y}; y_ = S2[1] * (f2){R[0].z, R[0].w} + y_; y_ = S2[2] * (f2){R[1].x, R[1].y} + y_; y_ = S2[3] * (f2){R[1].z, R[1].w} + y_; \
                yw[(t_) * 64] = red8(y_.x + y_.y); } while (0)
            f32x4 nA[2], dA[2], bA[2], qA[2], rA[2], nB[2], dB[2], bB[2], qB[2], rB[2]; float vA, vB;
            RW_LD(nA, dA, bA, qA, rA, vA, 0);
            int t = 0;
            if (pvar != 3)
            for (; t + 2 <= nt; t += 2) {
                RW_LD(nB, dB, bB, qB, rB, vB, t + 1);
                RW_STEP(nA, dA, bA, qA, rA, vA, t);
                RW_LD(nA, dA, bA, qA, rA, vA, (t + 2 < nt ? t + 2 : t + 1));
                RW_STEP(nB, dB, bB, qB, rB, vB, t + 1);
            }
            if (t < nt) RW_STEP(nA, dA, bA, qA, rA, vA, t);
#undef RW_LD
#undef RW_STEP
            S[0] = S2[0].x; S[1] = S2[0].y; S[2] = S2[1].x; S[3] = S2[1].y; S[4] = S2[2].x; S[5] = S2[2].y; S[6] = S2[3].x; S[7] = S2[3].y;
        }
        __syncthreads();
        if (pvar != 4) {
            f32x4 y0 = {0.f, 0.f, 0.f, 0.f}, y1 = y0;
            if (valid) { y0 = *(const LAS f32x4*)(L + RW_YY + tt * 64 + 8 * cg); y1 = *(const LAS f32x4*)(L + RW_YY + tt * 64 + 8 * cg + 4); }
            float yy[8] = {y0.x, y0.y, y0.z, y0.w, y1.x, y1.y, y1.z, y1.w};
            float s1 = 0.f;
#pragma unroll
            for (int j = 0; j < 8; ++j) s1 += yy[j];
            const float mean = red8(s1) * (1.f / 64.f);
            float s2 = 0.f;
#pragma unroll
            for (int j = 0; j < 8; ++j) { yy[j] -= mean; s2 += yy[j] * yy[j]; }
            const float rstd = __builtin_amdgcn_rsqf(red8(s2) * (1.f / 64.f) + GN_EPS);
            float o[8];
#pragma unroll
            for (int j = 0; j < 8; ++j) o[j] = ((yy[j] * rstd) * cgw[j] + cgb[j] + bon * vv[j]) * gg[j];
            if (valid && do_store) *(v4u*)(Gb + (size_t)(row0 + 64 * c + tt) * D + ch) = pack8(o);
        }
    }
    *(f32x4*)(ST + srow * 64 + 8 * cg) = (f32x4){S[0], S[1], S[2], S[3]}; *(f32x4*)(ST + srow * 64 + 8 * cg + 4) = (f32x4){S[4], S[5], S[6], S[7]};
    __syncthreads();
}

constexpr int RH_TC = 32, RH_BUF = 12288;
constexpr int RH_KK = 0, RH_DD = 2048, RH_BB = 4096, RH_KP = 6144, RH_RR = 8192, RH_VV = 10240, RH_YY = 11264;
__device__ __forceinline__ void rwkv_half_chain(const Frame& F, int b, int h, int half, float* ST, const bf16* Rb, const bf16* Kb, const bf16* Vb, const bf16* Db, const bf16* Ab,
                                                bf16* YRAW, float* BON, const float* k_k, const float* k_a, const float* r_k, const int pvar) {
    LAS float* L = (LAS float*)F.lds;
    const int tid = F.tid, lane = F.lane, w = F.wave, row0 = b * PT;
    constexpr int nch = PT / RH_TC;
    if (w < 4) {
        const int srow = 8 * w + (lane >> 3), cq = lane & 7;
        f32x4 S4 = {0.f, 0.f, 0.f, 0.f}, S5 = S4;
        __syncthreads();
        __builtin_amdgcn_s_setprio(3);
        for (int c = 0; c < nch; ++c) {
            const LAS float* p = L + (c & 1) * RH_BUF + 8 * cq;
            LAS float* yw = L + (c & 1) * RH_BUF + RH_YY + srow;
            const LAS float* vp = L + (c & 1) * RH_BUF + RH_VV + srow;
#define RH_LD(N, Dd, B, Q, R, VR, t_) do { const LAS float* p_ = p + (t_) * 64; \
                N[0] = *(const LAS f32x4*)(p_ + RH_KK); N[1] = *(const LAS f32x4*)(p_ + RH_KK + 4); Dd[0] = *(const LAS f32x4*)(p_ + RH_DD); Dd[1] = *(const LAS f32x4*)(p_ + RH_DD + 4); \
                B[0] = *(const LAS f32x4*)(p_ + RH_BB); B[1] = *(const LAS f32x4*)(p_ + RH_BB + 4); Q[0] = *(const LAS f32x4*)(p_ + RH_KP); Q[1] = *(const LAS f32x4*)(p_ + RH_KP + 4); \
                R[0] = *(const LAS f32x4*)(p_ + RH_RR); R[1] = *(const LAS f32x4*)(p_ + RH_RR + 4); VR = vp[(t_) * 32]; } while (0)
#define RH_STEP(N, Dd, B, Q, R, VR, t_) do { \
                const f32x4 pa_ = S4 * N[0] + S5 * N[1]; const float sa_ = red8((pa_.x + pa_.y) + (pa_.z + pa_.w)); \
                S4 = S4 * Dd[0] + (B[0] * sa_ + Q[0] * VR); S5 = S5 * Dd[1] + (B[1] * sa_ + Q[1] * VR); \
                const f32x4 ya_ = S4 * R[0] + S5 * R[1]; yw[(t_) * 32] = red8((ya_.x + ya_.y) + (ya_.z + ya_.w)); } while (0)
            f32x4 nA[2], dA[2], bA[2], qA[2], rA[2], nB[2], dB[2], bB[2], qB[2], rB[2]; float vA, vB;
            RH_LD(nA, dA, bA, qA, rA, vA, 0);
            if (pvar != 3)
            for (int t = 0; t < RH_TC; t += 2) {
                RH_LD(nB, dB, bB, qB, rB, vB, t + 1);
                RH_STEP(nA, dA, bA, qA, rA, vA, t);
                RH_LD(nA, dA, bA, qA, rA, vA, (t + 2 < RH_TC ? t + 2 : t + 1));
                RH_STEP(nB, dB, bB, qB, rB, vB, t + 1);
            }
#undef RH_LD
#undef RH_STEP
            __syncthreads();
        }
        __builtin_amdgcn_s_setprio(0);
        *(f32x4*)(ST + (32 * half + srow) * 64 + 8 * cq) = S4; *(f32x4*)(ST + (32 * half + srow) * 64 + 8 * cq + 4) = S5;
    } else {
        const int ht = tid - 256, cg = ht & 7, tt = ht >> 3;
        const int ch = h * 64 + 8 * cg, vch = h * 64 + 32 * half + 4 * cg;
        float ckk[8], cka[8], crk[8];
#pragma unroll
        for (int j = 0; j < 8; ++j) { ckk[j] = k_k[ch + j]; cka[j] = k_a[ch + j]; crk[j] = r_k[ch + j]; }
        v4u pr, pk, pd, pa; uint2 pv;
#define RH_LOAD(cc) do { const size_t off_ = (size_t)(row0 + RH_TC * (cc) + tt) * D; pr = *(const v4u*)(Rb + off_ + ch); pk = *(const v4u*)(Kb + off_ + ch); pd = *(const v4u*)(Db + off_ + ch); \
            pa = *(const v4u*)(Ab + off_ + ch); pv = *(const uint2*)(Vb + off_ + vch); } while (0)
#define RH_PREP(cc) do { float r8[8], k8[8], d8[8], a8[8]; unpack8(pr, r8); unpack8(pk, k8); unpack8(pd, d8); unpack8(pa, a8); \
            float kk[8], ss = 0.f; _Pragma("unroll") for (int j = 0; j < 8; ++j) { kk[j] = k8[j] * ckk[j]; ss += kk[j] * kk[j]; } \
            ss = red8(ss); const float inv = __builtin_amdgcn_rsqf(fmaxf(ss, 1e-24f)); \
            float kp[8], bsum = 0.f; _Pragma("unroll") for (int j = 0; j < 8; ++j) { kk[j] *= inv; kp[j] = k8[j] * (1.f + (a8[j] - 1.f) * cka[j]); bsum += r8[j] * kp[j] * crk[j]; } \
            const float bon = red8(bsum); if (half == 0 && cg == 0) BON[(size_t)(row0 + RH_TC * (cc) + tt) * 16 + h] = bon; \
            LAS float* p = L + ((cc) & 1) * RH_BUF + tt * 64 + 8 * cg; \
            *(LAS f32x4*)(p + RH_KK) = (f32x4){-kk[0], -kk[1], -kk[2], -kk[3]}; *(LAS f32x4*)(p + RH_KK + 4) = (f32x4){-kk[4], -kk[5], -kk[6], -kk[7]}; \
            *(LAS f32x4*)(p + RH_DD) = (f32x4){1.f - d8[0], 1.f - d8[1], 1.f - d8[2], 1.f - d8[3]}; *(LAS f32x4*)(p + RH_DD + 4) = (f32x4){1.f - d8[4], 1.f - d8[5], 1.f - d8[6], 1.f - d8[7]}; \
            *(LAS f32x4*)(p + RH_BB) = (f32x4){kk[0] * a8[0], kk[1] * a8[1], kk[2] * a8[2], kk[3] * a8[3]}; *(LAS f32x4*)(p + RH_BB + 4) = (f32x4){kk[4] * a8[4], kk[5] * a8[5], kk[6] * a8[6], kk[7] * a8[7]}; \
            *(LAS f32x4*)(p + RH_KP) = (f32x4){kp[0], kp[1], kp[2], kp[3]}; *(LAS f32x4*)(p + RH_KP + 4) = (f32x4){kp[4], kp[5], kp[6], kp[7]}; \
            *(LAS f32x4*)(p + RH_RR) = (f32x4){r8[0], r8[1], r8[2], r8[3]}; *(LAS f32x4*)(p + RH_RR + 4) = (f32x4){r8[4], r8[5], r8[6], r8[7]}; \
            *(LAS f32x4*)(L + ((cc) & 1) * RH_BUF + RH_VV + tt * 32 + 4 * cg) = (f32x4){bflo(pv.x), bfhi(pv.x), bflo(pv.y), bfhi(pv.y)}; } while (0)
#define RH_POST(cc) do { const f32x4 y4 = *(const LAS f32x4*)(L + ((cc) & 1) * RH_BUF + RH_YY + tt * 32 + 4 * cg); uint2 o; o.x = pkbf(y4.x, y4.y); o.y = pkbf(y4.z, y4.w); \
            *(uint2*)(YRAW + (size_t)(row0 + RH_TC * (cc) + tt) * D + vch) = o; } while (0)
        RH_LOAD(0); RH_PREP(0); RH_LOAD(1);
        __syncthreads();
        for (int c = 0; c < nch; ++c) {
            if (c > 0) RH_POST(c - 1);
            if (c + 1 < nch) { RH_PREP(c + 1); if (c + 2 < nch) RH_LOAD(c + 2); }
            __syncthreads();
        }
        RH_POST(nch - 1);
#undef RH_LOAD
#undef RH_PREP
#undef RH_POST
    }
    __syncthreads();
}
__device__ __forceinline__ void rwkv_finish(const Frame& F, const bf16* YRAW, const float* BON, const bf16* Vb, bf16* Gb, const float* gn_w, const float* gn_b) {
    const int gt = (F.vcu * NWAVES + F.wave) * 64 + F.lane, NT = F.G * NWAVES * 64;
    for (int task = gt; task < MP * 128; task += NT) {
        const int cg = task & 7, hh = (task >> 3) & 15, row = task >> 7; const size_t off = (size_t)row * D + hh * 64 + 8 * cg;
        float yy[8], vv[8], gg[8]; unpack8(*(const v4u*)(YRAW + off), yy); unpack8(*(const v4u*)(Vb + off), vv); unpack8(*(const v4u*)(Gb + off), gg);
        const float bon = BON[(size_t)row * 16 + hh];
        float s1 = 0.f;
#pragma unroll
        for (int j = 0; j < 8; ++j) s1 += yy[j];
        const float mean = red8(s1) * (1.f / 64.f);
        float s2 = 0.f;
#pragma unroll
        for (int j = 0; j < 8; ++j) { yy[j] -= mean; s2 += yy[j] * yy[j]; }
        const float rstd = __builtin_amdgcn_rsqf(red8(s2) * (1.f / 64.f) + GN_EPS);
        const f32x4 w0 = *(const f32x4*)(gn_w + hh * 64 + 8 * cg), w1 = *(const f32x4*)(gn_w + hh * 64 + 8 * cg + 4), b0 = *(const f32x4*)(gn_b + hh * 64 + 8 * cg), b1 = *(const f32x4*)(gn_b + hh * 64 + 8 * cg + 4);
        const float gw[8] = {w0.x, w0.y, w0.z, w0.w, w1.x, w1.y, w1.z, w1.w}, gb[8] = {b0.x, b0.y, b0.z, b0.w, b1.x, b1.y, b1.z, b1.w};
        float o[8];
#pragma unroll
        for (int j = 0; j < 8; ++j) o[j] = ((yy[j] * rstd) * gw[j] + gb[j] + bon * vv[j]) * gg[j];
        *(v4u*)(Gb + off) = pack8(o);
    }
}

constexpr int PBY = 144;
constexpr int RPY = 272;
constexpr int ML_RQK = 0, ML_S = 0, ML_KT = 9216, ML_RV = 18432, ML_Q = 35840, ML_K = 45056, ML_HB = 35840, ML_VT = 54272, ML_C = 72704, ML_F = 91136;
constexpr int MF_N = 0, MF_QN = 64, MF_RS = 128, MF_HS = 256, MF_CW = 384, MF_B63 = 1024, MF_P63 = 1056, MF_MC = 1088  , MF_GB = 1152, MF_GP = MF_GB + 2048, MF_GA = MF_GP + 2048;
typedef __attribute__((address_space(3))) unsigned short lds_u16;
#define MFMA16(a, b, c) __builtin_amdgcn_mfma_f32_16x16x32_bf16((a), (b), (c), 0, 0, 0)
__device__ __forceinline__ void mlstm_prompt_chain(const Frame& F, int b, int hh, const bf16* QKR, const bf16* VVb, const bf16* OOb, const float* IFb, bf16* HOb,
                                                   const float* conv_w, const float* conv_b, const float* norm_w, float* out, const int pvar) {
    LAS unsigned char* lds = F.lds; LAS float* Fl = (LAS float*)(lds + ML_F);
    const int tid = F.tid, lane = F.lane, w = F.wave, fr = lane & 15, fq = lane >> 4;
    for (int i = tid; i < 128 * 72; i += 512) ((lds_u16*)(lds + ML_C))[i] = 0;
    if (tid < 64) Fl[MF_N + tid] = 0.f;
    for (int i = tid; i < 640; i += 512) { const int j = i >> 7, c = i & 127, gc = c < 64 ? hh * 64 + c : 512 + hh * 64 + (c - 64); Fl[MF_CW + i] = j < 4 ? conv_w[j * D + gc] : conv_b[gc]; }
    f32x4 Cacc[4];
#pragma unroll
    for (int k = 0; k < 4; ++k) Cacc[k] = (f32x4){0.f, 0.f, 0.f, 0.f};
    const int og = tid & 15, ot = tid >> 4;
    float nw[8];
#pragma unroll
    for (int e = 0; e < 8; ++e) nw[e] = norm_w[hh * 128 + 8 * og + e];
    v4u rq[3], rv[2], ro[2];
#define ML_LOAD_QKV(cc) do { const int rowc_ = b * PT + 64 * (cc); \
        _Pragma("unroll") for (int i = 0; i < 3; ++i) { const int q = tid + 512 * i, r = q >> 4, j = q & 15, tok = 64 * (cc) - 3 + r; rq[i] = (v4u){0u, 0u, 0u, 0u}; \
            if (q < 67 * 16 && tok >= 0) rq[i] = *(const v4u*)(QKR + (size_t)(b * PT + tok) * D + (j < 8 ? hh * 64 + 8 * j : 512 + hh * 64 + 8 * (j - 8))); } \
        _Pragma("unroll") for (int i = 0; i < 2; ++i) rv[i] = *(const v4u*)(VVb + (size_t)(rowc_ + ot + 32 * i) * D + hh * 128 + 8 * og); \
        } while (0)
#define ML_LOAD_O(cc) do { const int rowc_ = b * PT + 64 * (cc); \
        _Pragma("unroll") for (int i = 0; i < 2; ++i) ro[i] = *(const v4u*)(OOb + (size_t)(rowc_ + ot + 32 * i) * D + hh * 128 + 8 * og); } while (0)
    ML_LOAD_QKV(0);
#pragma unroll
    for (int q = 0; q < 4; ++q) { const int cc = w + 8 * q; const size_t ro_ = (size_t)(b * PT + 64 * cc + lane) * 16;
        const float li = IFb[ro_ + hh], lf = IFb[ro_ + 8 + hh];
        float bc = lf;
#pragma unroll
        for (int o = 1; o < 64; o <<= 1) { const float x = __shfl_up(bc, o); if (lane >= o) bc += x; }
        const float av = li - bc; float pm = av;
#pragma unroll
        for (int o = 1; o < 64; o <<= 1) { const float x = __shfl_up(pm, o); if (lane >= o) pm = fmaxf(pm, x); }
        Fl[MF_GB + cc * 64 + lane] = bc; Fl[MF_GP + cc * 64 + lane] = pm; Fl[MF_GA + cc * 64 + lane] = av;
        if (lane == 63) { Fl[MF_B63 + cc] = bc; Fl[MF_P63 + cc] = pm; } }
    __syncthreads();
    if (tid == 0) { float mm = 0.f;
        for (int cc = 0; cc < PT / 64; ++cc) { Fl[MF_MC + cc] = mm; const float b6 = Fl[MF_B63 + cc]; mm = fmaxf(b6 + mm, b6 + Fl[MF_P63 + cc]); }
        Fl[MF_MC + PT / 64] = mm; }
    __syncthreads();
    constexpr int NC = PT / 64;
    for (int c = 0; c < NC; ++c) {
        const int rowc = b * PT + 64 * c;
        const float m_c = Fl[MF_MC + c], m_n = Fl[MF_MC + c + 1], b63 = Fl[MF_B63 + c];
#pragma unroll
        for (int i = 0; i < 3; ++i) { const int q = tid + 512 * i; if (q < 67 * 16) *(LAS v4u*)(lds + ML_RQK + (q >> 4) * RPY + 16 * (q & 15)) = rq[i]; }
#pragma unroll
        for (int i = 0; i < 2; ++i) *(LAS v4u*)(lds + ML_RV + (ot + 32 * i) * RPY + 16 * og) = rv[i];
        if (c + 1 < NC) ML_LOAD_QKV(c + 1);
        ML_LOAD_O(c);
        __syncthreads();
        float kreg[8] = {0.f, 0.f, 0.f, 0.f, 0.f, 0.f, 0.f, 0.f};
        if (pvar != 3)
#pragma unroll
        for (int i = 0; i < 2; ++i) {
            const int g = w + 8 * i, t = lane;
            float x[4][8];
#pragma unroll
            for (int j = 0; j < 4; ++j) unpack8(*(const LAS v4u*)(lds + ML_RQK + (t + j) * RPY + 16 * g), x[j]);
            float val[8];
#pragma unroll
            for (int h2 = 0; h2 < 2; ++h2) { f32x4 a = *(const LAS f32x4*)(Fl + MF_CW + 4 * 128 + 8 * g + 4 * h2);
#pragma unroll
                for (int j = 0; j < 4; ++j) { const f32x4 cw = *(const LAS f32x4*)(Fl + MF_CW + j * 128 + 8 * g + 4 * h2);
                    a.x += cw.x * x[j][4 * h2]; a.y += cw.y * x[j][4 * h2 + 1]; a.z += cw.z * x[j][4 * h2 + 2]; a.w += cw.w * x[j][4 * h2 + 3]; }
                val[4 * h2] = siluf_(a.x); val[4 * h2 + 1] = siluf_(a.y); val[4 * h2 + 2] = siluf_(a.z); val[4 * h2 + 3] = siluf_(a.w); }
            if (i == 0) {
#pragma unroll
                for (int e = 0; e < 8; ++e) val[e] *= 0.125f;
                *(LAS v4u*)(lds + ML_Q + t * PBY + 16 * w) = pack8(val);
            } else { *(LAS v4u*)(lds + ML_K + t * PBY + 16 * w) = pack8(val);
#pragma unroll
                for (int e = 0; e < 8; ++e) kreg[e] = val[e]; }
            const v4u vw = *(const LAS v4u*)(lds + ML_RV + t * RPY + 16 * g);
            lds_u16* vt = (lds_u16*)(lds + ML_VT) + (8 * g) * 72 + t;
            vt[0 * 72] = (unsigned short)(vw.x & 0xffffu); vt[1 * 72] = (unsigned short)(vw.x >> 16); vt[2 * 72] = (unsigned short)(vw.y & 0xffffu); vt[3 * 72] = (unsigned short)(vw.y >> 16);
            vt[4 * 72] = (unsigned short)(vw.z & 0xffffu); vt[5 * 72] = (unsigned short)(vw.z >> 16); vt[6 * 72] = (unsigned short)(vw.w & 0xffffu); vt[7 * 72] = (unsigned short)(vw.w >> 16);
        }
        __syncthreads();
        if (pvar != 4) {
        { const float wsv = __expf(b63 + Fl[MF_GA + c * 64 + lane] - m_n); lds_u16* kt = (lds_u16*)(lds + ML_KT) + (8 * w) * 72 + lane;
#pragma unroll
          for (int e = 0; e < 8; ++e) kt[e * 72] = f2bf1(kreg[e] * wsv); }
        { const int tq = tid >> 3, p = tid & 7; float q8[8]; unpack8(*(const LAS v4u*)(lds + ML_Q + tq * PBY + 16 * p), q8);
          float dsum = 0.f;
#pragma unroll
          for (int e = 0; e < 8; ++e) dsum += q8[e] * Fl[MF_N + 8 * p + e];
          dsum = red8(dsum); if (p == 0) Fl[MF_QN + tq] = dsum; }
        { const int ti = w >> 1; float rs[4] = {0.f, 0.f, 0.f, 0.f};
#pragma unroll
          for (int jj = 0; jj < 2; ++jj) { const int sj = 2 * (w & 1) + jj; f32x4 acc = {0.f, 0.f, 0.f, 0.f};
#pragma unroll
              for (int ks = 0; ks < 2; ++ks) { const bf16x8 a = *(const LAS bf16x8*)(lds + ML_Q + (16 * ti + fr) * PBY + ks * 64 + fq * 16), bb = *(const LAS bf16x8*)(lds + ML_K + (16 * sj + fr) * PBY + ks * 64 + fq * 16);
                  acc = MFMA16(a, bb, acc); }
              const int s = 16 * sj + fr; const float as = Fl[MF_GA + c * 64 + s];
#pragma unroll
              for (int r = 0; r < 4; ++r) { const int t = 16 * ti + 4 * fq + r; const float val = s <= t ? acc[r] * __expf(as - fmaxf(m_c, Fl[MF_GP + c * 64 + t])) : 0.f;
                  ((lds_u16*)(lds + ML_S))[t * 72 + s] = f2bf1(val); rs[r] += val; } }
#pragma unroll
          for (int r = 0; r < 4; ++r) { const float x = red16(rs[r]); if (fr == 0) Fl[MF_RS + (16 * ti + 4 * fq + r) * 2 + (w & 1)] = x; } }
        }
        __syncthreads();
        float hv[4][4] = {};
        if (pvar != 5) { const int ti = w & 3; float wi[4], den[4], ei[4], hq[4];
#pragma unroll
          for (int r = 0; r < 4; ++r) { const int t = 16 * ti + 4 * fq + r; const float mx = fmaxf(m_c, Fl[MF_GP + c * 64 + t]); wi[r] = __expf(m_c - mx); ei[r] = __expf(-(Fl[MF_GB + c * 64 + t] + mx)); den[r] = wi[r] * Fl[MF_QN + t] + Fl[MF_RS + 2 * t] + Fl[MF_RS + 2 * t + 1]; hq[r] = 0.f; }
#pragma unroll
          for (int i = 0; i < 4; ++i) { const int vt = 4 * (w >> 2) + i; f32x4 accA = {0.f, 0.f, 0.f, 0.f}, accB = accA;
#pragma unroll
              for (int ks = 0; ks < 2; ++ks) {
                  const bf16x8 aq = *(const LAS bf16x8*)(lds + ML_Q + (16 * ti + fr) * PBY + ks * 64 + fq * 16), bc = *(const LAS bf16x8*)(lds + ML_C + (16 * vt + fr) * PBY + ks * 64 + fq * 16);
                  accA = MFMA16(aq, bc, accA);
                  const bf16x8 as = *(const LAS bf16x8*)(lds + ML_S + (16 * ti + fr) * PBY + ks * 64 + fq * 16), bv = *(const LAS bf16x8*)(lds + ML_VT + (16 * vt + fr) * PBY + ks * 64 + fq * 16);
                  accB = MFMA16(as, bv, accB); }
#pragma unroll
              for (int r = 0; r < 4; ++r) { const float num = wi[r] * accA[r] + accB[r]; const float hh_ = num * __builtin_amdgcn_rcpf(fmaxf(fabsf(den[r]), ei[r])); hv[i][r] = hh_; hq[r] += hh_ * hh_; } }
#pragma unroll
          for (int r = 0; r < 4; ++r) { const float x = red16(hq[r]); if (fr == 0) Fl[MF_HS + (16 * ti + 4 * fq + r) * 2 + (w >> 2)] = x; } }
        __syncthreads();
        if (pvar != 6) {
        { const int ti = w & 3;
#pragma unroll
          for (int r = 0; r < 4; ++r) { const int t = 16 * ti + 4 * fq + r; const float sc = __builtin_amdgcn_rsqf((Fl[MF_HS + 2 * t] + Fl[MF_HS + 2 * t + 1]) * (1.f / 128.f) + NORM_EPS);
#pragma unroll
              for (int i = 0; i < 4; ++i) ((lds_u16*)(lds + ML_HB))[t * (RPY / 2) + 16 * (4 * (w >> 2) + i) + fr] = f2bf1(hv[i][r] * sc); } }
        { const float wst = __expf(b63 + m_c - m_n);
#pragma unroll
          for (int kt = 0; kt < 4; ++kt) { Cacc[kt] = Cacc[kt] * wst;
#pragma unroll
              for (int ks = 0; ks < 2; ++ks) { const bf16x8 a = *(const LAS bf16x8*)(lds + ML_VT + (16 * w + fr) * PBY + ks * 64 + fq * 16), bb = *(const LAS bf16x8*)(lds + ML_KT + (16 * kt + fr) * PBY + ks * 64 + fq * 16);
                  Cacc[kt] = MFMA16(a, bb, Cacc[kt]); }
#pragma unroll
              for (int r = 0; r < 4; ++r) ((lds_u16*)(lds + ML_C))[(16 * w + 4 * fq + r) * 72 + 16 * kt + fr] = f2bf1(Cacc[kt][r]); }
          if (w == 0) { float sum = 0.f;
#pragma unroll
              for (int q = 0; q < 8; ++q) { float k8[8]; unpack8(*(const LAS v4u*)(lds + ML_KT + lane * PBY + 16 * q), k8);
#pragma unroll
                  for (int e = 0; e < 8; ++e) sum += k8[e]; }
              Fl[MF_N + lane] = wst * Fl[MF_N + lane] + sum; } }
        }
        __syncthreads();
        if (pvar != 7)
#pragma unroll
        for (int i = 0; i < 2; ++i) { const int t = ot + 32 * i; float h8[8], o8[8]; unpack8(*(const LAS v4u*)(lds + ML_HB + t * RPY + 16 * og), h8); unpack8(ro[i], o8);
#pragma unroll
            for (int e = 0; e < 8; ++e) h8[e] = h8[e] * nw[e] * o8[e];
            *(v4u*)(HOb + (size_t)(rowc + t) * D + hh * 128 + 8 * og) = pack8(h8); }
    }
#undef ML_LOAD_QKV
#undef ML_LOAD_O
#pragma unroll
    for (int kt = 0; kt < 4; ++kt)
#pragma unroll
        for (int r = 0; r < 4; ++r) out[O_P_C + ((size_t)(b * 8 + hh) * 128 + 16 * w + 4 * fq + r) * 64 + 16 * kt + fr] = Cacc[kt][r];
    if (w == 0) { out[O_P_N + (size_t)(b * 8 + hh) * 64 + lane] = Fl[MF_N + lane]; if (lane == 0) out[O_P_M + b * 8 + hh] = Fl[MF_MC + PT / 64]; }
    if (tid < 384) { const int j = tid >> 7, c = tid & 127, gc = c < 64 ? hh * 64 + c : 512 + hh * 64 + (c - 64);
        out[O_P_CONV + (size_t)(b * 3 + j) * D + gc] = bf1(QKR[(size_t)(b * PT + PT - 3 + j) * D + gc]); }
    __syncthreads();
}
__device__ __forceinline__ void mlstm_sample_item(const Frame& F, int b, int hh, const bf16* QKR, const bf16* VVb, const bf16* OOb, const float* IFb, bf16* HOb,
                                                  const float* conv_w, const float* conv_b, const float* norm_w, const float* C0, const float* n0, const float* m0p, const float* conv0, float* out) {
    LAS float* L = (LAS float*)F.lds;
    constexpr int LQ = 0, LK = 256, LV = 512, LS = 1024, LQN = 1040, LHS = 1048;
    const int tid = F.tid, lane = F.lane, w = F.wave, row0 = MP + 4 * b;
    float li[4], lf[4];
#pragma unroll
    for (int t = 0; t < 4; ++t) { li[t] = IFb[(size_t)(row0 + t) * 16 + hh]; lf[t] = IFb[(size_t)(row0 + t) * 16 + 8 + hh]; }
    const float m0 = m0p[b * 8 + hh];
    float bc[4], av[4], mt[4], wi[4], wsv[4], ei[4], bm[4];
    { float run = 0.f, pm = -3.0e38f;
#pragma unroll
      for (int t = 0; t < 4; ++t) { run += lf[t]; bc[t] = run; av[t] = li[t] - run; pm = fmaxf(pm, av[t]); mt[t] = fmaxf(run + m0, run + pm); } }
    const float m_new = mt[3], wst = __expf(bc[3] + m0 - m_new);
#pragma unroll
    for (int t = 0; t < 4; ++t) { wi[t] = __expf(bc[t] + m0 - mt[t]); wsv[t] = __expf(bc[3] + av[t] - m_new); ei[t] = __expf(-mt[t]); bm[t] = bc[t] - mt[t]; }
    { const int t = tid >> 7, c = tid & 127, gc = c < 64 ? hh * 64 + c : 512 + hh * 64 + (c - 64);
      float x[4];
#pragma unroll
      for (int j = 0; j < 4; ++j) { const int p = t + j; x[j] = p < 3 ? conv0[(size_t)(b * 3 + p) * D + gc] : bf1(QKR[(size_t)(row0 + p - 3) * D + gc]); }
      float a = conv_b[gc];
#pragma unroll
      for (int j = 0; j < 4; ++j) a += conv_w[j * D + gc] * x[j];
      const float val = siluf_(a);
      if (c < 64) L[LQ + t * 64 + c] = val * 0.125f; else L[LK + t * 64 + (c - 64)] = val;
      if (t >= 1) out[O_S_CONV + (size_t)(b * 3 + t - 1) * D + gc] = x[3];
      L[LV + t * 128 + c] = bf1(VVb[(size_t)(row0 + t) * D + hh * 128 + c]); }
    __syncthreads();
    if (w == 0) { const int pair = lane >> 2, t = pair >> 2, s = pair & 3, part = lane & 3; float dsum = 0.f;
#pragma unroll
        for (int e = 0; e < 16; ++e) dsum += L[LQ + t * 64 + 16 * part + e] * L[LK + s * 64 + 16 * part + e];
        dsum = red4(dsum);
        const float bmt = t == 0 ? bm[0] : (t == 1 ? bm[1] : (t == 2 ? bm[2] : bm[3])), avs = s == 0 ? av[0] : (s == 1 ? av[1] : (s == 2 ? av[2] : av[3]));
        if (part == 0) L[LS + pair] = s <= t ? dsum * __expf(bmt + avs) : 0.f; }
    if (w == 1) { const int t = lane >> 4, part = lane & 15; float dsum = 0.f;
#pragma unroll
        for (int e = 0; e < 4; ++e) dsum += L[LQ + t * 64 + 4 * part + e] * n0[(size_t)(b * 8 + hh) * 64 + 4 * part + e];
        dsum = red16(dsum); if (part == 0) L[LQN + t] = dsum; }
    __syncthreads();
    const int v = tid >> 2, kq = tid & 3;
    float hvv[4];
    { const size_t coff = ((size_t)(b * 8 + hh) * 128 + v) * 64 + 16 * kq;
      float c0[16];
#pragma unroll
      for (int e4 = 0; e4 < 4; ++e4) { const f32x4 x = *(const f32x4*)(C0 + coff + 4 * e4); c0[4 * e4] = x.x; c0[4 * e4 + 1] = x.y; c0[4 * e4 + 2] = x.z; c0[4 * e4 + 3] = x.w; }
#pragma unroll
      for (int t = 0; t < 4; ++t) { float part = 0.f;
#pragma unroll
          for (int e = 0; e < 16; ++e) part += c0[e] * L[LQ + t * 64 + 16 * kq + e];
          const float inter = red4(part);
          float num = wi[t] * inter, den = wi[t] * L[LQN + t];
#pragma unroll
          for (int s = 0; s < 4; ++s) { const float sm = L[LS + t * 4 + s]; num += sm * L[LV + s * 128 + v]; den += sm; }
          hvv[t] = num / fmaxf(fabsf(den), ei[t]); }
#pragma unroll
      for (int t = 0; t < 4; ++t) { const float x = wave_sum(kq == 0 ? hvv[t] * hvv[t] : 0.f); if (lane == 0) L[LHS + w * 4 + t] = x; }
      float cn[16];
#pragma unroll
      for (int e = 0; e < 16; ++e) { float a = wst * c0[e];
#pragma unroll
          for (int s = 0; s < 4; ++s) a += wsv[s] * L[LV + s * 128 + v] * L[LK + s * 64 + 16 * kq + e];
          cn[e] = a; }
#pragma unroll
      for (int e4 = 0; e4 < 4; ++e4) *(f32x4*)(out + O_S_C + coff + 4 * e4) = (f32x4){cn[4 * e4], cn[4 * e4 + 1], cn[4 * e4 + 2], cn[4 * e4 + 3]}; }
    __syncthreads();
    if (kq == 0) {
#pragma unroll
        for (int t = 0; t < 4; ++t) { float tot = 0.f;
#pragma unroll
            for (int ww = 0; ww < 8; ++ww) tot += L[LHS + ww * 4 + t];
            const float sc = 1.0f / sqrtf(tot * (1.f / 128.f) + NORM_EPS); const size_t off = (size_t)(row0 + t) * D + hh * 128 + v;
            HOb[off] = f2bf1(hvv[t] * sc * norm_w[hh * 128 + v] * bf1(OOb[off])); } }
    if (tid < 64) { float a = wst * n0[(size_t)(b * 8 + hh) * 64 + tid];
#pragma unroll
        for (int s = 0; s < 4; ++s) a += wsv[s] * L[LK + s * 64 + tid];
        out[O_S_N + (size_t)(b * 8 + hh) * 64 + tid] = a; }
    if (tid == 0) out[O_S_M + b * 8 + hh] = m_new;
    __syncthreads();
}

#ifndef MK_N_LAUNCHES
#define MK_N_LAUNCHES 1
#endif
constexpr int N_PHASES = 22;
#ifndef PROBE_PH
#define PROBE_PH (-1)
#define PROBE_N 1
#endif
#ifndef PROBE_VAR
#define PROBE_VAR 0
#endif
#ifndef EN_MASK
#define EN_MASK 0xff
#endif
constexpr bool EN_NORM = EN_MASK & 1, EN_UP = EN_MASK & 2, EN_RES = EN_MASK & 4, EN_RW = EN_MASK & 8, EN_L2 = EN_MASK & 16, EN_SCAN = EN_MASK & 32, EN_IN = EN_MASK & 64, EN_ML = EN_MASK & 128;
struct Args { const float* in[N_IN]; float* out; unsigned char* ws; int ph_lo, ph_hi; };
__global__ void __launch_bounds__(NWAVES * 64, 2) mega_fwd(Args args) {
    extern __shared__ __attribute__((aligned(16))) unsigned char lds_raw[];
    { const int t0 = threadIdx.x;
      for (int u = t0; u < (LDS_BYTES - LDSCTL_OFF) / 4; u += NWAVES * 64) ((LAS unsigned*)((LAS unsigned char*)lds_raw + LDSCTL_OFF))[u] = 0u; }
    __syncthreads();
    { const int t0 = threadIdx.x; if (t0 < N_IN) ((LAS unsigned long long*)((LAS unsigned char*)lds_raw + TAB_OFF))[t0] = (unsigned long long)args.in[t0]; }
    __syncthreads();
    XcdBarrier bar; bar.bar = (unsigned*)((gu32*)(args.ws + WS_CTL) + CW_BAR); bar.x = 0; bar.st = nullptr;
    if (args.ph_hi - args.ph_lo > 1) bar = xcd_barrier_post((unsigned*)((gu32*)(args.ws + WS_CTL) + CW_BAR), (volatile LAS unsigned*)((LAS unsigned char*)lds_raw + MISC_OFF) + 8);
    int ph = args.ph_lo, rep = 0;
    while (ph < args.ph_hi) {
        int tid_ = threadIdx.x; asm volatile("" : "+v"(tid_));
        unsigned char* ws = args.ws; float* out = args.out;
        Frame F;
        F.lds = (LAS unsigned char*)lds_raw;
        F.MISC = (volatile LAS unsigned*)(F.lds + MISC_OFF);
        F.tid = tid_; F.lane = F.tid & 63; F.wave = __builtin_amdgcn_readfirstlane(F.tid >> 6);
        F.G = gridDim.x; { const int bx = blockIdx.x; F.vcu = (F.G % 8 == 0) ? (bx % 8) * (F.G / 8) + bx / 8 : bx; }
        F.ctl = (gu32*)(ws + WS_CTL); F.tab = (volatile LAS unsigned long long*)(F.lds + TAB_OFF);
        bf16* Wb = (bf16*)(ws + WS_W); float* XR = (float*)(ws + WS_XR); unsigned char* big = ws + WS_BIG;
        bf16* Hb = (bf16*)(big + B_H); bf16* XN = (bf16*)(big + B_XN); float* SLAB = (float*)(big + B_SLAB);
        bf16* ACAT = (bf16*)(big + B_ACAT); bf16* Rb = (bf16*)(big + B_R); bf16* Kb = (bf16*)(big + B_K); bf16* Vb = (bf16*)(big + B_V); bf16* DECb = (bf16*)(big + B_DEC); bf16* AAb = (bf16*)(big + B_AA);
        bf16* QKR = (bf16*)(big + B_QKR); bf16* VVb = (bf16*)(big + B_VV); bf16* HOb = (bf16*)(big + B_HO); bf16* OOb = (bf16*)(big + B_OO); float* IFb = (float*)(big + B_IF);
        bf16* GGb = (bf16*)((unsigned char*)out + OS_GG); bf16* LORA = (bf16*)((unsigned char*)out + OS_LORA);
        const int c_id = (int)blockIdx.x;
        const int nrep = ph == PROBE_PH ? PROBE_N : 1;
        const int pvar = (rep + 1 < nrep) ? PROBE_VAR : 0;
        if (EN_NORM && (ph == 0 || ph == 3 || ph == 8 || ph == 11 || ph == 14 || ph == 18 || ph == 21)) {
            int kind = 0, layer = 0, ab = 0, nslab = 0; float coef = 0.5f; const float* gain = nullptr;
            if (ph == 0) { kind = 0; layer = 0; ab = 0; gain = inptr(F, I_NFA); nslab = 0; }
            else if (ph == 3) { kind = 1; gain = inptr(F, I_NMIX); nslab = 11; }
            else if (ph == 8) { kind = 0; layer = 0; ab = 1; gain = inptr(F, I_NFB); nslab = 4; coef = 1.f; }
            else if (ph == 11) { kind = 0; layer = 1; ab = 0; gain = inptr(F, I_NFA) + D; nslab = 11; }
            else if (ph == 14) { kind = 2; gain = inptr(F, I_NMIX) + D; nslab = 11; }
            else if (ph == 18) { kind = -1; gain = inptr(F, I_NFB) + D; nslab = 4; coef = 1.f; }
            else { kind = -1; gain = inptr(F, I_NFIN); nslab = 11; }
            if (kind >= 0) convert_weights(F, kind, layer, ab, Wb);
            const float* base_p = ph == 0 ? inptr(F, I_XP) : XR; const float* base_s = (ph == 0 || ph == 3) ? inptr(F, I_XS) : XR + (size_t)MP * D;
            if (ph == 3) norm_rows<1>(F, base_p, base_s, nslab, coef, SLAB, XR, gain, ACAT, inptr(F, I_RSHIFT), out);
            else if (ph == 21) norm_rows<2>(F, base_p, base_s, nslab, coef, SLAB, XR, gain, nullptr, nullptr, out);
            else norm_rows<0>(F, base_p, base_s, nslab, coef, SLAB, XR, gain, XN, nullptr, out);
        } else if (EN_UP && (ph == 1 || ph == 9 || ph == 12 || ph == 19)) {
            const bf16* Wu = ph == 19 ? (const bf16*)(ws + WS_W2) : Wb;
            pg8::Gemm g{XN, Wu + W_GU / 2, M, 2 * FF, D}; pg8::UnitOrder S; S.init(M / 256, 2 * FF / 256, D, F.G, c_id, 0);
            EpiSwiglu E{Hb, pvar};
            pg8::gemm_phase<EpiSwiglu, pg8::UnitOrder, true, true>(F.lds, g, S, E, F.tid);
        } else if (EN_RES && (ph == 2 || ph == 7 || ph == 10 || ph == 13 || ph == 17 || ph == 20)) {
            const bf16* A = Hb; const bf16* Bt = (ph == 20 ? (const bf16*)(ws + WS_W2) : Wb) + W_D / 2; int K = FF; float coef = 0.5f; const float* base = XR;
            if (ph == 2) base = inptr(F, I_XP);
            if (ph == 7) { A = GGb; Bt = Wb + W_O / 2; K = D; coef = 1.f;
                rwkv_finish(F, (const bf16*)(ws + WS_YRAW), (const float*)(ws + WS_BON), Vb, GGb, inptr(F, I_GNW), inptr(F, I_GNB)); xcd_barrier(bar); }
            if (ph == 17) { A = HOb; Bt = Wb + W_OUT / 2; K = D; coef = 1.f; }
            pg8::Gemm g{A, Bt, M, D, K}; pg8::UnitOrder S; S.init(MP / 256, D / 256, K, F.G, c_id, K / 256);
            EpiRes E{base, XR, SLAB, coef};
            pg8::gemm_phase<EpiRes, pg8::UnitOrder, true, true>(F.lds, g, S, E, F.tid);
        } else if (EN_RW && ph == 4) {
            pg8::Gemm g{ACAT, Wb + W_RW / 2, M, NRW, KRW}; pg8::UnitOrder S; S.init(M / 256, NRW / 256, KRW, F.G, c_id, 0);
            EpiRw E{Rb, Kb, Vb, LORA};
            pg8::gemm_phase<EpiRw, pg8::UnitOrder, true, true>(F.lds, g, S, E, F.tid);
        } else if (EN_L2 && ph == 5) {
            pg8::Gemm g{LORA, Wb + W_L2 / 2, M, NL2, KL2}; pg8::UnitOrder S; S.init(M / 256, NL2 / 256, KL2, F.G, c_id, -1);
            EpiL2 E{DECb, AAb, GGb, inptr(F, I_W0), inptr(F, I_A0)};
            pg8::gemm_phase<EpiL2, pg8::UnitOrder, true, true>(F.lds, g, S, E, F.tid);
        } else if (EN_SCAN && ph == 6) {
            if (pvar != 1) {
                for (int i = F.vcu; i < SB * 16; i += F.G) { const int b = i >> 4, h = i & 15;
                    rwkv_chain(F, MP + b * STK, STK, h, inptr(F, I_RS) + (size_t)i * 4096, out + O_S_S + (size_t)i * 4096, Rb, Kb, Vb, DECb, AAb, GGb, inptr(F, I_KK), inptr(F, I_KA), inptr(F, I_RK), inptr(F, I_GNW), inptr(F, I_GNB), rep + 1 == nrep, pvar); }
            }
            if (pvar != 2) {
                for (int i = F.vcu; i < 2 * PB * 16; i += F.G) { const int chain = i & 127, half = i >> 7;
                    rwkv_half_chain(F, chain >> 4, chain & 15, half, out + O_P_S + (size_t)chain * 4096, Rb, Kb, Vb, DECb, AAb, (bf16*)(ws + WS_YRAW), (float*)(ws + WS_BON), inptr(F, I_KK), inptr(F, I_KA), inptr(F, I_RK), pvar); }
            }
        } else if (EN_IN && ph == 15) {
            pg8::Gemm g{XN, Wb + W_IN / 2, M, NIN, D}; pg8::UnitOrder S; S.init(M / 256, NIN / 256, D, F.G, c_id, 0);
            EpiIn E{QKR, VVb, OOb, IFb, inptr(F, I_BIF)};
            pg8::gemm_phase<EpiIn, pg8::UnitOrder, true, true>(F.lds, g, S, E, F.tid);
        } else if (EN_ML && ph == 16) {
            const int Hh = F.G >= 128 ? 64 : (F.G / 2 > 0 ? F.G / 2 : 1);
            if (F.vcu < Hh && pvar != 2) {
                for (int i = F.vcu; i < PB * 8; i += Hh) mlstm_prompt_chain(F, i >> 3, i & 7, QKR, VVb, OOb, IFb, HOb, inptr(F, I_CW), inptr(F, I_CB), inptr(F, I_MNW), out, pvar);
            }
            if ((F.vcu >= Hh || F.G == 1) && pvar != 1 && pvar < 3) {
                const int st = F.G == 1 ? 1 : F.G - Hh;
                for (int i = F.G == 1 ? 0 : F.vcu - Hh; i < SB * 8; i += st)
                    mlstm_sample_item(F, i >> 3, i & 7, QKR, VVb, OOb, IFb, HOb, inptr(F, I_CW), inptr(F, I_CB), inptr(F, I_MNW), inptr(F, I_MC), inptr(F, I_MN), inptr(F, I_MM), inptr(F, I_MCONV), out);
            }
            if (F.vcu >= Hh && F.G > Hh && rep + 1 == nrep) convert_weights(F, 0, 1, 1, (bf16*)(ws + WS_W2), Hh);
        }
        if (++rep < nrep) continue;
        rep = 0;
        if (ph + 1 < args.ph_hi) xcd_barrier(bar);
        ++ph;
    }
}

extern "C" void kernel_launch(void* const* d_in, const int* in_sizes, int n_in, void* d_out, int out_size, void* d_ws, size_t ws_size, hipStream_t stream) {
    static int grid = 0;
    if (grid == 0) {
        if (n_in != N_IN || out_size != (int)O_END || ws_size < WS_END2) { fprintf(stderr, "kernel_launch: unexpected shapes (n_in %d, out %d, ws %zu); nothing launched\n", n_in, out_size, ws_size); grid = -1; return; }
        int dev = 0, cus = 0, per_cu = 0;
        if (hipGetDevice(&dev) != hipSuccess || hipDeviceGetAttribute(&cus, hipDeviceAttributeMultiprocessorCount, dev) != hipSuccess) { grid = -1; return; }
        if (hipFuncSetAttribute((const void*)mega_fwd, hipFuncAttributeMaxDynamicSharedMemorySize, LDS_BYTES) != hipSuccess) { fprintf(stderr, "kernel_launch: hipFuncSetAttribute failed\n"); grid = -1; return; }
        if (hipOccupancyMaxActiveBlocksPerMultiprocessor(&per_cu, (const void*)mega_fwd, NWAVES * 64, LDS_BYTES) != hipSuccess || per_cu < 1) { fprintf(stderr, "kernel_launch: occupancy query says %d\n", per_cu); per_cu = 1; }
        (void)hipGetLastError();
        grid = cus;
    }
    if (grid < 0) return;
    (void)hipMemsetAsync((char*)d_ws + WS_CTL, 0, CTL_ZERO_BYTES, stream);
    Args a{};
    for (int i = 0; i < N_IN; ++i) a.in[i] = (const float*)d_in[i];
    a.out = (float*)d_out; a.ws = (unsigned char*)d_ws;
#if MK_N_LAUNCHES == 1
    a.ph_lo = 0; a.ph_hi = N_PHASES;
    { void* kargs[] = {(void*)&a};
      const hipError_t e = hipLaunchCooperativeKernel((const void*)mega_fwd, dim3(grid), dim3(NWAVES * 64), kargs, LDS_BYTES, stream);
      if (e != hipSuccess) fprintf(stderr, "kernel_launch: cooperative launch failed: %s (grid %d)\n", hipGetErrorString(e), grid); }
#else
    for (int p = 0; p < N_PHASES; ++p) { a.ph_lo = p; a.ph_hi = p + 1; hipLaunchKernelGGL(mega_fwd, dim3(grid), dim3(NWAVES * 64), LDS_BYTES, stream, a); }
#endif
}
```

```cpp
#include <hip/hip_runtime.h>
#include <cstdio>
#include <cstdint>
namespace pg8 {
#define PG8_LAS __attribute__((address_space(3)))
typedef unsigned short bf16_t;
typedef short bf16x8 __attribute__((ext_vector_type(8)));
typedef float f32x4 __attribute__((ext_vector_type(4)));
typedef unsigned u32x4 __attribute__((ext_vector_type(4)));
constexpr int BM = 256, BK = 64, HALF = 128, HTB = HALF * BK * 2  , STAGE_BYTES = 8 * HTB, NXCD = 8, WGM = 8;

__host__ __device__ __forceinline__ int lds_byte(int r, int c) { const int st = (r >> 4) * 2 + (c >> 5), rr = r & 15, cc = c & 31, ob = rr * 64 + cc * 2; return st * 1024 + (ob ^ (((ob >> 9) & 1) << 5)); }
__host__ __device__ __forceinline__ void stage_rc(int b, int& R, int& C) { const int st = b / 1024, sb = b % 1024, swz = sb ^ (((sb >> 9) & 1) << 5); R = (st >> 1) * 16 + swz / 64; C = (st & 1) * 32 + (swz % 64) / 2; }
__host__ __device__ __forceinline__ int perm32(int rho) { const int n = rho >> 4, i = rho & 15; return 8 * (i >> 2) + 4 * n + (i & 3); }

struct Unit { int pm, pn, k0, nt, slab; };
struct Gemm { const bf16_t* A; const bf16_t* Bt; int M, N, K; };

struct UnitOrder {
    int nM, nN, nwg, G, c, ntf, tailS;
    __device__ __forceinline__ void init(int nM_, int nN_, int K, int G_, int c_, int tailS_) { nM = nM_; nN = nN_; nwg = nM * nN; G = G_; c = c_; ntf = K / BK; tailS = tailS_; }
    __device__ __forceinline__ bool next(int i, Unit& u) const {
        long L = (long)i * G + c;
        if (L < nwg) {
            int wgid = (int)L; { const int q = nwg / NXCD, r = nwg % NXCD, xcd = wgid % NXCD, off = wgid / NXCD; wgid = (xcd < r ? xcd * (q + 1) : r * (q + 1) + (xcd - r) * q) + off; }
            const int nig = WGM * nN, gid = wgid / nig, fm = gid * WGM, gsz = (nM - fm) < WGM ? (nM - fm) : WGM;
            u.pm = fm + ((wgid % nig) % gsz); u.pn = (wgid % nig) / gsz; u.k0 = 0; u.nt = ntf; u.slab = -1;
            if (tailS < 0) { u.nt = 4; u.k0 = u.pn >= 8 ? 128 : 0; }
            return true;
        }
        L -= nwg; if (tailS <= 0 || L >= 8 * tailS) return false;
        int tile, sl; if (tailS == 4) { tile = (int)L >> 2; sl = (int)L & 3; } else { tile = (int)L / 11; sl = (int)L - 11 * tile; }
        u.pm = 64 + (tile >> 2); u.pn = tile & 3; u.k0 = sl * 256; u.nt = 4; u.slab = sl; return true;
    }
    __device__ __forceinline__ void a_ready(const Unit&) const {}
    __device__ __forceinline__ void done(const Unit&) const {}
};
template <class Epi, class Sched, bool ALIGN_EPI = false, bool SP2 = false>
__device__ __forceinline__ void gemm_phase(PG8_LAS unsigned char* lds, const Gemm g, const Sched& S, const Epi& E, const int tid) {
    const int wid = __builtin_amdgcn_readfirstlane(tid >> 6), lane = tid & 63, wr = wid >> 2, wc = wid & 3, fr = lane & 15, fq = lane >> 4;
    const int K = g.K;
    unsigned voffA[2], voffB[2];
#pragma unroll
    for (int i = 0; i < 2; ++i) { int R, C; stage_rc(tid * 16 + i * 8192, R, C); const int Rb = Epi::PERM ? ((R & ~31) + perm32(R & 31)) : R;
        voffA[i] = (unsigned)(R * K + C) * 2u; voffB[i] = (unsigned)(Rb * K + C) * 2u; }
    const size_t kstep = (size_t)(BK * 2);
    const size_t hstep = (size_t)HALF * K * 2;
    const size_t tstep = 2 * hstep;
    const unsigned ldsw = (unsigned)wid * 1024u;
    const int aoff = lds_byte(wr * 64 + fr, fq * 8), boff = lds_byte(wc * 32 + fr, fq * 8);
#define PG8_SA(b, h) (((b) * 2 + (h)) * HTB)
#define PG8_SB(b, h) ((4 + (b) * 2 + (h)) * HTB)
#define PG8_STAGE(bufoff, gbase, voff) do { _Pragma("unroll") for (int _i = 0; _i < 2; ++_i) \
        __builtin_amdgcn_global_load_lds((const unsigned*)((const char*)(gbase) + (voff)[_i]), (PG8_LAS unsigned*)(lds + (bufoff) + ldsw + _i * 8192), 16, 0, 0); } while (0)
#define PG8_LDA(dst, b, h) do { _Pragma("unroll") for (int m = 0; m < 4; ++m) _Pragma("unroll") for (int k = 0; k < 2; ++k) dst[m][k] = *(const PG8_LAS bf16x8*)(lds + PG8_SA(b, h) + aoff + m * 2048 + k * 1024); } while (0)
#define PG8_LDB(dst, b, h) do { _Pragma("unroll") for (int n = 0; n < 2; ++n) _Pragma("unroll") for (int k = 0; k < 2; ++k) dst[n][k] = *(const PG8_LAS bf16x8*)(lds + PG8_SB(b, h) + boff + n * 2048 + k * 1024); } while (0)
#define PG8_MMA(ai, bj, At, Bt) do { __builtin_amdgcn_s_setprio(1); _Pragma("unroll") for (int m = 0; m < 4; ++m) _Pragma("unroll") for (int n = 0; n < 2; ++n) _Pragma("unroll") for (int k = 0; k < 2; ++k) \
        acc[ai][bj][m][n] = __builtin_amdgcn_mfma_f32_16x16x32_bf16(Bt[n][k], At[m][k], acc[ai][bj][m][n], 0, 0, 0); __builtin_amdgcn_s_setprio(0); } while (0)
#define PG8_WAIT_V(n) asm volatile("s_waitcnt vmcnt(" #n ")" ::: "memory")
#define PG8_WAIT_L(n) asm volatile("s_waitcnt lgkmcnt(" #n ")" ::: "memory")
#define PG8_BAR __builtin_amdgcn_s_barrier()
#define PG8_SCHED __builtin_amdgcn_sched_barrier(0)
    Unit cur, nxt; int ui = 0;
    if (!S.next(0, cur)) return;
    f32x4 acc[2][2][4][2];
#pragma unroll
    for (int a = 0; a < 2; ++a)
#pragma unroll
        for (int b = 0; b < 2; ++b)
#pragma unroll
            for (int m = 0; m < 4; ++m)
#pragma unroll
                for (int n = 0; n < 2; ++n) acc[a][b][m][n] = (f32x4){0.f, 0.f, 0.f, 0.f};
    bf16x8 At[4][2], B0[2][2], B1[2][2];
    const char* cA = (const char*)g.A + (size_t)cur.pm * tstep + (size_t)cur.k0 * 2; const char* cB = (const char*)g.Bt + (size_t)cur.pn * tstep + (size_t)cur.k0 * 2;
    S.a_ready(cur);
    if constexpr (SP2) {
        PG8_STAGE(PG8_SB(0, 0), cB, voffB); PG8_STAGE(PG8_SB(0, 1), cB + hstep, voffB); PG8_STAGE(PG8_SA(0, 0), cA, voffA); PG8_STAGE(PG8_SA(0, 1), cA + hstep, voffA);
        if (wr == 1) PG8_BAR;
        PG8_WAIT_V(2); PG8_BAR;
        PG8_STAGE(PG8_SB(1, 0), cB + kstep, voffB); PG8_STAGE(PG8_SA(1, 0), cA + kstep, voffA); PG8_STAGE(PG8_SB(1, 1), cB + hstep + kstep, voffB);
        PG8_WAIT_V(6); PG8_BAR;
    } else {
        PG8_STAGE(PG8_SB(0, 0), cB, voffB); PG8_STAGE(PG8_SA(0, 0), cA, voffA); PG8_STAGE(PG8_SB(0, 1), cB + hstep, voffB); PG8_STAGE(PG8_SA(0, 1), cA + hstep, voffA);
        if (wr == 1) PG8_BAR;
        PG8_WAIT_V(4); PG8_BAR;
        PG8_STAGE(PG8_SB(1, 0), cB + kstep, voffB); PG8_STAGE(PG8_SA(1, 0), cA + kstep, voffA); PG8_STAGE(PG8_SB(1, 1), cB + hstep + kstep, voffB);
        PG8_WAIT_V(6); PG8_BAR;
    }
    for (;;) {
        const bool has_next = S.next(ui + 1, nxt);
        const char* nA = has_next ? (const char*)g.A + (size_t)nxt.pm * tstep + (size_t)nxt.k0 * 2 : cA; const char* nB = has_next ? (const char*)g.Bt + (size_t)nxt.pn * tstep + (size_t)nxt.k0 * 2 : cB;
        const int nt = cur.nt;
        for (int t = 0; t < nt; t += 2) {
            const bool last = (t == nt - 2);
            const char* a1 = cA + (size_t)(t + 1) * kstep;
            const char* a2 = last ? nA : cA + (size_t)(t + 2) * kstep; const char* b2 = last ? nB : cB + (size_t)(t + 2) * kstep;
            const char* a3 = a2 + kstep; const char* b3 = b2 + kstep;
            if (last && has_next) S.a_ready(nxt);
            if constexpr (SP2) {
            PG8_LDB(B0, 0, 0); PG8_LDB(B1, 0, 1); PG8_SCHED; PG8_LDA(At, 0, 0); PG8_STAGE(PG8_SA(1, 1), a1 + hstep, voffA);
            PG8_WAIT_V(8); PG8_WAIT_L(0); PG8_BAR; PG8_MMA(0, 0, At, B0); PG8_MMA(0, 1, At, B1); PG8_BAR; PG8_SCHED;
            PG8_LDA(At, 0, 1); PG8_STAGE(PG8_SB(0, 0), b2, voffB); PG8_STAGE(PG8_SB(0, 1), b2 + hstep, voffB); PG8_STAGE(PG8_SA(0, 0), a2, voffA);
            PG8_WAIT_V(8); PG8_WAIT_L(0); PG8_BAR; PG8_MMA(1, 0, At, B0); PG8_MMA(1, 1, At, B1); PG8_BAR; PG8_SCHED;
            PG8_LDB(B0, 1, 0); PG8_LDB(B1, 1, 1); PG8_SCHED; PG8_LDA(At, 1, 0); PG8_STAGE(PG8_SA(0, 1), a2 + hstep, voffA);
            PG8_WAIT_V(8); PG8_WAIT_L(0); PG8_BAR; PG8_MMA(0, 0, At, B0); PG8_MMA(0, 1, At, B1); PG8_BAR; PG8_SCHED;
            PG8_LDA(At, 1, 1); PG8_STAGE(PG8_SB(1, 0), b3, voffB); PG8_STAGE(PG8_SB(1, 1), b3 + hstep, voffB); PG8_STAGE(PG8_SA(1, 0), a3, voffA);
            PG8_WAIT_V(8); PG8_WAIT_L(0); PG8_BAR; PG8_MMA(1, 0, At, B0); PG8_MMA(1, 1, At, B1); PG8_BAR; PG8_SCHED;
            } else {
            PG8_LDB(B0, 0, 0); PG8_SCHED; PG8_LDA(At, 0, 0); PG8_STAGE(PG8_SA(1, 1), a1 + hstep, voffA);
            PG8_WAIT_L(8); PG8_BAR; PG8_WAIT_L(0); PG8_MMA(0, 0, At, B0); PG8_BAR; PG8_SCHED;
            PG8_LDB(B1, 0, 1); PG8_STAGE(PG8_SB(0, 0), b2, voffB);
            PG8_BAR; PG8_WAIT_L(0); PG8_MMA(0, 1, At, B1); PG8_BAR;
            PG8_LDA(At, 0, 1); PG8_STAGE(PG8_SA(0, 0), a2, voffA);
            PG8_BAR; PG8_WAIT_L(0); PG8_MMA(1, 0, At, B0); PG8_BAR; PG8_SCHED;
            PG8_STAGE(PG8_SB(0, 1), b2 + hstep, voffB);
            PG8_WAIT_V(6); PG8_BAR; PG8_MMA(1, 1, At, B1); PG8_BAR;
            PG8_LDB(B0, 1, 0); PG8_SCHED; PG8_LDA(At, 1, 0); PG8_STAGE(PG8_SA(0, 1), a2 + hstep, voffA);
            PG8_WAIT_L(8); PG8_BAR; PG8_WAIT_L(0); PG8_MMA(0, 0, At, B0); PG8_BAR; PG8_SCHED;
            PG8_LDB(B1, 1, 1); PG8_STAGE(PG8_SB(1, 0), b3, voffB);
            PG8_BAR; PG8_WAIT_L(0); PG8_MMA(0, 1, At, B1); PG8_BAR;
            PG8_LDA(At, 1, 1); PG8_STAGE(PG8_SA(1, 0), a3, voffA);
            PG8_BAR; PG8_WAIT_L(0); PG8_MMA(1, 0, At, B0); PG8_BAR; PG8_SCHED;
            PG8_STAGE(PG8_SB(1, 1), b3 + hstep, voffB);
            PG8_WAIT_V(6); PG8_BAR; PG8_MMA(1, 1, At, B1); PG8_BAR;
            }
        }
        if constexpr (ALIGN_EPI) { if (wr == 0) PG8_BAR; }
        if constexpr (!Epi::AFTER_DRAIN) { E(acc, cur, wr, wc, fr, fq); S.done(cur); }
        if (!has_next) break;
#pragma unroll
        for (int a = 0; a < 2; ++a)
#pragma unroll
            for (int b = 0; b < 2; ++b)
#pragma unroll
                for (int m = 0; m < 4; ++m)
#pragma unroll
                    for (int n = 0; n < 2; ++n) acc[a][b][m][n] = (f32x4){0.f, 0.f, 0.f, 0.f};
        cur = nxt; cA = nA; cB = nB; ++ui;
        if constexpr (ALIGN_EPI) { if (wr == 1) PG8_BAR; }
    }
    PG8_WAIT_V(0);
    if constexpr (!ALIGN_EPI) { if (wr == 0) PG8_BAR; }
    PG8_BAR;
    if constexpr (Epi::AFTER_DRAIN) { E.fused(acc, cur, wr, wc, fr, fq, lds, wid, lane); S.done(cur); }
#undef PG8_SA
#undef PG8_SB
#undef PG8_STAGE
#undef PG8_LDA
#undef PG8_LDB
#undef PG8_MMA
#undef PG8_WAIT_V
#undef PG8_WAIT_L
#undef PG8_BAR
#undef PG8_SCHED
}
}

#define GAS __attribute__((address_space(1)))
#define LAS __attribute__((address_space(3)))
typedef unsigned short bf16;
typedef unsigned v4u __attribute__((ext_vector_type(4)));
typedef float f32x4 __attribute__((ext_vector_type(4)));
typedef short bf16x8 __attribute__((ext_vector_type(8)));
typedef GAS unsigned gu32;
typedef GAS unsigned long long gu64;
#define RLX_AGENT __ATOMIC_RELAXED, __HIP_MEMORY_SCOPE_AGENT
#define LDS_WAIT() asm volatile("s_waitcnt lgkmcnt(0)" ::: "memory")
#define VM_WAIT() asm volatile("s_waitcnt vmcnt(0)" ::: "memory")
__device__ __forceinline__ unsigned long long rt() { return __builtin_amdgcn_s_memrealtime(); }
__device__ __forceinline__ unsigned f2bf(float f) { unsigned u = __builtin_bit_cast(unsigned, f); return (u + 0x7fffu + ((u >> 16) & 1u)) >> 16; }
__device__ __forceinline__ unsigned pk2(float lo, float hi) { return f2bf(lo) | (f2bf(hi) << 16); }

#define XB_TMO      128
#define XB_XCNT(j)  (256  + 64 * (j))
#define XB_XSUB(j)  (1280 + 64 * (j))
#define XB_XGEN(j)  (2304 + 64 * (j))
#define XB_TOP      3328
#define XB_TOPGEN   3392
#define XCD_BAR_WORDS 3456
#define XB_SPIN_CAP (1u << 18)

__device__ __forceinline__ unsigned xb_ld(unsigned* p)              { return __hip_atomic_load(p, __ATOMIC_RELAXED, __HIP_MEMORY_SCOPE_AGENT); }
__device__ __forceinline__ unsigned xb_add(unsigned* p, unsigned v) { return __hip_atomic_fetch_add(p, v, __ATOMIC_RELAXED, __HIP_MEMORY_SCOPE_AGENT); }
__device__ __forceinline__ unsigned xb_xcc_id() { return (unsigned)__builtin_amdgcn_s_getreg((3 << 11) | 20) & 0xFu; }
#define XB_SPIN(cond, bar) do { unsigned _sp = 0; while (cond) { __builtin_amdgcn_s_sleep(1); \
    if ((++_sp & 255u) == 0u) { if (xb_ld(&(bar)[XB_TMO])) break; if (_sp > XB_SPIN_CAP) { atomicAdd(&(bar)[XB_TMO], 1u); break; } } } } while (0)

struct XcdBarrier {
    unsigned* bar; unsigned x;
    volatile LAS unsigned* st;
};

__device__ __forceinline__ XcdBarrier xcd_barrier_post(unsigned* bar, volatile LAS unsigned* st) {
    XcdBarrier b; b.bar = bar; b.x = xb_xcc_id(); b.st = st;
    if (threadIdx.x == 0) (void)xb_add(&bar[XB_XCNT(b.x)], 1u);
    return b;
}
__device__ __forceinline__ void xcd_barrier_complete(unsigned* bar, unsigned x, unsigned& nloc, unsigned& nx) {
    const unsigned G = gridDim.x * gridDim.y * gridDim.z;
    unsigned sum, cnt, mine, sp = 0u;
    for (;;) {
        sum = 0u; cnt = 0u; mine = 0u;
#pragma unroll
        for (unsigned j = 0; j < 16; ++j) { const unsigned c = xb_ld(&bar[XB_XCNT(j)]); sum += c; cnt += (c > 0u) ? 1u : 0u; mine = (j == x) ? c : mine; }
        if (sum == G) break;
        __builtin_amdgcn_s_sleep(1);
        if ((++sp & 255u) == 0u) { if (xb_ld(&bar[XB_TMO])) break; if (sp > XB_SPIN_CAP) { atomicAdd(&bar[XB_TMO], 1u); break; } }
    }
    nloc = mine > 0u ? mine : 1u; nx = cnt > 0u ? cnt : 1u;
}

__device__ __forceinline__ void xcd_barrier(const XcdBarrier& b) {
    asm volatile("s_waitcnt vmcnt(0)" ::: "memory");
    __syncthreads();
    if (threadIdx.x == 0) {
        unsigned* bar = b.bar;
        __builtin_amdgcn_s_waitcnt(0);
        unsigned nloc = b.st[0], nx = b.st[1];
        if (nloc == 0u) { xcd_barrier_complete(bar, b.x, nloc, nx); b.st[0] = nloc; b.st[1] = nx; }
        const unsigned old = xb_add(&bar[XB_XSUB(b.x)], 1u);
        const unsigned gen = old / nloc;
        if (old + 1u == (gen + 1u) * nloc) {
            __builtin_amdgcn_fence(__ATOMIC_RELEASE, "agent");
            asm volatile("s_waitcnt vmcnt(0)" ::: "memory");
            const unsigned og = xb_add(&bar[XB_TOP], 1u);
            const unsigned tg = og / nx;
            if (og + 1u == (tg + 1u) * nx) xb_add(&bar[XB_TOPGEN], 1u);
            else XB_SPIN(xb_ld(&bar[XB_TOPGEN]) == tg, bar);
            __builtin_amdgcn_fence(__ATOMIC_ACQUIRE, "agent");
            xb_add(&bar[XB_XGEN(b.x)], 1u);
            asm volatile("s_waitcnt vmcnt(0)" ::: "memory");
        } else {
            XB_SPIN(xb_ld(&bar[XB_XGEN(b.x)]) == gen, bar);
            __builtin_amdgcn_fence(__ATOMIC_ACQUIRE, "agent");
            asm volatile("s_waitcnt vmcnt(0)" ::: "memory");
        }
    }
    __syncthreads();
}

constexpr int NWAVES = 8;
constexpr int D = 1024, FF = 2816;
constexpr int PB = 8, PT = 2048, SB = 128, STK = 4;
constexpr int MP = PB * PT, MS = SB * STK, M = MP + MS;
constexpr int NRW = 3584, KRW = 2048, NL2 = 3072, KL2 = 384, NIN = 3328;
constexpr float NORM_EPS = 1e-6f, GN_EPS = 64e-5f;
typedef pg8::bf16_t bf16;

constexpr size_t MiB = 1u << 20;
constexpr size_t WS_CTL = 0, CTL_ZERO_BYTES = 64 * 1024;
constexpr size_t WS_W = 1 * MiB;
constexpr size_t WS_XR = 20 * MiB;
constexpr size_t WS_BIG = 86 * MiB;
constexpr size_t WS_END = 256 * MiB;
constexpr size_t WS_YRAW = 256 * MiB, WS_BON = 288 * MiB, WS_W2 = 289 * MiB  , WS_END2 = 308 * MiB;
constexpr size_t W_GU = 0, W_D = (size_t)2 * FF * D * 2;
constexpr size_t W_RW = 0, W_L2 = (size_t)NRW * KRW * 2, W_O = W_L2 + (size_t)NL2 * KL2 * 2;
constexpr size_t W_IN = 0, W_OUT = (size_t)NIN * D * 2;
static_assert(W_D + (size_t)D * FF * 2 <= 19 * MiB && W_O + (size_t)D * D * 2 <= 19 * MiB && W_OUT + (size_t)D * D * 2 <= 19 * MiB, "weights region");
constexpr size_t B_H = 0, B_XN = 91 * MiB, B_SLAB = 124 * MiB;
constexpr size_t B_ACAT = 0, B_R = 66 * MiB, B_K = 99 * MiB, B_V = 132 * MiB, B_DEC = 0, B_AA = 33 * MiB;
constexpr size_t B_QKR = 0, B_VV = 33 * MiB, B_HO = 66 * MiB, B_OO = 124 * MiB, B_IF = 157 * MiB;
static_assert((size_t)M * FF * 2 <= 91 * MiB && (size_t)M * D * 2 == 33 * MiB && B_IF + (size_t)M * 16 * 4 <= 170 * MiB && B_SLAB + (size_t)11 * MS * D * 4 <= 170 * MiB, "BIG map");
constexpr size_t OS_GG = 0, OS_LORA = 33 * MiB;
static_assert(OS_LORA + (size_t)M * KL2 * 2 <= (size_t)MP * D * 4, "d_out scratch");
constexpr size_t O_Y = 0, O_P_S = 17301504, O_P_SHIFT = 17825792, O_P_C = 17833984, O_P_N = 18358272, O_P_M = 18362368, O_P_CONV = 18362432,
                 O_S_S = 18387008, O_S_SHIFT = 26775616, O_S_C = 26906688, O_S_N = 35295296, O_S_M = 35360832, O_S_CONV = 35361856, O_END = 35755072;
constexpr int CW_BAR = 1024;

constexpr int RING_BYTES = 131072, LDSCTL_OFF = RING_BYTES, MISC_OFF = LDSCTL_OFF + 320, TAB_OFF = LDSCTL_OFF + 1024, LDS_BYTES = 147456;

enum { I_XP = 0, I_XS, I_RS, I_RSHIFT, I_MC, I_MN, I_MM, I_MCONV, I_NFA, I_FAWG, I_FAWU, I_FAWD, I_NMIX, I_NFB, I_FBWG, I_FBWU, I_FBWD,
       I_MU, I_WR, I_WK, I_WV, I_WO, I_W0, I_W1, I_W2, I_A0, I_A1, I_A2, I_G1, I_G2, I_KK, I_KA, I_RK, I_GNW, I_GNB,
       I_WIN, I_BIF, I_CW, I_CB, I_MNW, I_WOUT, I_NFIN, N_IN };

typedef __bf16 bf16x2_t __attribute__((ext_vector_type(2)));
typedef float f32x2_t __attribute__((ext_vector_type(2)));
__device__ __forceinline__ unsigned pkbf(float lo, float hi) { f32x2_t v = {lo, hi}; bf16x2_t b = __builtin_convertvector(v, bf16x2_t); return __builtin_bit_cast(unsigned, b); }
__device__ __forceinline__ float bflo(unsigned u) { return __builtin_bit_cast(float, u << 16); }
__device__ __forceinline__ float bfhi(unsigned u) { return __builtin_bit_cast(float, u & 0xffff0000u); }
__device__ __forceinline__ float bf1(unsigned short u) { return __builtin_bit_cast(float, (unsigned)u << 16); }
__device__ __forceinline__ unsigned short f2bf1(float f) { return (unsigned short)(pkbf(f, 0.f) & 0xffffu); }
__device__ __forceinline__ void unpack8(v4u w, float (&o)[8]) { o[0] = bflo(w.x); o[1] = bfhi(w.x); o[2] = bflo(w.y); o[3] = bfhi(w.y); o[4] = bflo(w.z); o[5] = bfhi(w.z); o[6] = bflo(w.w); o[7] = bfhi(w.w); }
__device__ __forceinline__ v4u pack8(const float (&o)[8]) { v4u w; w.x = pkbf(o[0], o[1]); w.y = pkbf(o[2], o[3]); w.z = pkbf(o[4], o[5]); w.w = pkbf(o[6], o[7]); return w; }
__device__ __forceinline__ float sigmoidf_(float x) { return __builtin_amdgcn_rcpf(1.f + __expf(-x)); }
__device__ __forceinline__ float siluf_(float x) { return x * __builtin_amdgcn_rcpf(1.f + __expf(-x)); }
__device__ __forceinline__ float tanhf_(float x) { return 1.f - 2.f * __builtin_amdgcn_rcpf(__expf(2.f * x) + 1.f); }
__device__ __forceinline__ float logsigmoidf_(float x) { return fminf(x, 0.f) - log1pf(__expf(-fabsf(x))); }
template <int CTRL> __device__ __forceinline__ float dppf(float x) { return __builtin_bit_cast(float, __builtin_amdgcn_update_dpp(0, __builtin_bit_cast(int, x), CTRL, 0xF, 0xF, true)); }
__device__ __forceinline__ float red4(float x) { x += dppf<0xB1>(x); x += dppf<0x4E>(x); return x; }
__device__ __forceinline__ float red8(float x) { x = red4(x); x += dppf<0x141>(x); return x; }
__device__ __forceinline__ float red16(float x) { x = red8(x); x += dppf<0x140>(x); return x; }
__device__ __forceinline__ float wave_sum(float v) {
#pragma unroll
    for (int o = 1; o < 64; o <<= 1) v += __shfl_xor(v, o);
    return v;
}

struct Frame {
    LAS unsigned char* lds;
    volatile LAS unsigned* MISC;
    gu32* ctl;
    volatile LAS unsigned long long* tab;
    int tid, lane, wave, vcu, G;
};
__device__ __forceinline__ const float* inptr(const Frame& F, int i) { const unsigned long long v = F.tab[i];
    const unsigned lo = __builtin_amdgcn_readfirstlane((unsigned)v), hi = __builtin_amdgcn_readfirstlane((unsigned)(v >> 32)); return (const float*)(const GAS float*)(((unsigned long long)hi << 32) | lo); }

using pg8::Unit; using pg8::BM; using pg8::HALF;
__device__ __forceinline__ void st8bf(bf16* p, f32x4 v0, f32x4 v1) { v4u w; w.x = pkbf(v0[0], v0[1]); w.y = pkbf(v0[2], v0[3]); w.z = pkbf(v1[0], v1[1]); w.w = pkbf(v1[2], v1[3]); *(v4u*)p = w; }

struct EpiSwiglu {
    static constexpr bool PERM = true, AFTER_DRAIN = false;
    bf16* H; int pvar;
    __device__ __forceinline__ void operator()(const f32x4 (&acc)[2][2][4][2], const Unit& u, int wr, int wc, int fr, int fq) const {
        if (pvar == 3) return;
        const int row0 = u.pm * BM + wr * 64 + fr, col0 = u.pn * 128 + wc * 32 + 8 * fq;
#pragma unroll
        for (int ai = 0; ai < 2; ++ai)
#pragma unroll
            for (int m = 0; m < 4; ++m) {
                f32x4 o[2];
#pragma unroll
                for (int n = 0; n < 2; ++n)
#pragma unroll
                    for (int i = 0; i < 4; ++i) { const float g = acc[ai][0][m][n][i], up = acc[ai][1][m][n][i]; o[n][i] = siluf_(g) * up; }
                st8bf(H + (size_t)(row0 + ai * HALF + m * 16) * FF + col0, o[0], o[1]);
            }
    }
};
struct EpiRes {
    static constexpr bool PERM = false, AFTER_DRAIN = false;
    const float* base; float* out; float* slab; float coef;
    __device__ __forceinline__ void operator()(const f32x4 (&acc)[2][2][4][2], const Unit& u, int wr, int wc, int fr, int fq) const {
        const int row0 = u.pm * BM + wr * 64 + fr, col0 = u.pn * BM + wc * 32 + 4 * fq;
        if (u.slab < 0) {
#pragma unroll
            for (int ai = 0; ai < 2; ++ai)
#pragma unroll
                for (int m = 0; m < 4; ++m) { const size_t ro = (size_t)(row0 + ai * HALF + m * 16) * D + col0;
#pragma unroll
                    for (int bj = 0; bj < 2; ++bj)
#pragma unroll
                        for (int n = 0; n < 2; ++n) { const f32x4 b = *(const f32x4*)(base + ro + bj * HALF + n * 16); *(f32x4*)(out + ro + bj * HALF + n * 16) = b + acc[ai][bj][m][n] * coef; } }
        } else {
            float* sl = slab + (size_t)u.slab * MS * D;
#pragma unroll
            for (int ai = 0; ai < 2; ++ai)
#pragma unroll
                for (int m = 0; m < 4; ++m) { const size_t ro = (size_t)(row0 + ai * HALF + m * 16 - MP) * D + col0;
#pragma unroll
                    for (int bj = 0; bj < 2; ++bj)
#pragma unroll
                        for (int n = 0; n < 2; ++n) *(f32x4*)(sl + ro + bj * HALF + n * 16) = acc[ai][bj][m][n]; }
        }
    }
};
struct EpiRw {
    static constexpr bool PERM = true, AFTER_DRAIN = false;
    bf16 *R, *K, *V, *L;
    __device__ __forceinline__ void operator()(const f32x4 (&acc)[2][2][4][2], const Unit& u, int wr, int wc, int fr, int fq) const {
        const int row0 = u.pm * BM + wr * 64 + fr;
        if (u.pn < 12) {
            bf16 *p0 = R, *p1 = K, *p2 = V; asm volatile("" : "+s"(p0), "+s"(p1), "+s"(p2));
            bf16* dst = u.pn < 4 ? p0 : (u.pn < 8 ? p1 : p2); const int col0 = (u.pn & 3) * BM + wc * 32 + 8 * fq;
#pragma unroll
            for (int ai = 0; ai < 2; ++ai)
#pragma unroll
                for (int m = 0; m < 4; ++m) { bf16* rp = dst + (size_t)(row0 + ai * HALF + m * 16) * D + col0;
#pragma unroll
                    for (int bj = 0; bj < 2; ++bj) st8bf(rp + bj * HALF, acc[ai][bj][m][0], acc[ai][bj][m][1]); }
        } else {
#pragma unroll
            for (int bj = 0; bj < 2; ++bj) {
                const int lc = (u.pn - 12) * BM + bj * HALF + wc * 32 + 8 * fq;
                if (lc >= KL2) continue;
                const int act = lc < 64 ? 1 : (lc < 128 ? 0 : (lc < 288 ? 2 : 3));
#pragma unroll
                for (int ai = 0; ai < 2; ++ai)
#pragma unroll
                    for (int m = 0; m < 4; ++m) {
                        f32x4 o[2];
#pragma unroll
                        for (int n = 0; n < 2; ++n)
#pragma unroll
                            for (int i = 0; i < 4; ++i) { const float x = acc[ai][bj][m][n][i]; o[n][i] = act == 1 ? tanhf_(x) : (act == 0 ? x : (act == 2 ? sigmoidf_(x) : 0.f)); }
                        st8bf(L + (size_t)(row0 + ai * HALF + m * 16) * KL2 + lc, o[0], o[1]);
                    }
            }
        }
    }
};
struct EpiL2 {
    static constexpr bool PERM = true, AFTER_DRAIN = false;
    bf16 *DEC, *AA, *GG; const float *w0, *a0;
    __device__ __forceinline__ void operator()(const f32x4 (&acc)[2][2][4][2], const Unit& u, int wr, int wc, int fr, int fq) const {
        const int row0 = u.pm * BM + wr * 64 + fr, kind = u.pn >> 2, col0 = (u.pn & 3) * BM + wc * 32 + 8 * fq;
        bf16 *p0 = DEC, *p1 = AA, *p2 = GG; const float *q0 = w0, *q1 = a0; asm volatile("" : "+s"(p0), "+s"(p1), "+s"(p2), "+s"(q0), "+s"(q1));
        bf16* dst = kind == 0 ? p0 : (kind == 1 ? p1 : p2); const float* bias = kind == 0 ? q0 : q1;
#pragma unroll
        for (int bj = 0; bj < 2; ++bj) {
            f32x4 bv[2];
#pragma unroll
            for (int n = 0; n < 2; ++n) bv[n] = kind < 2 ? *(const f32x4*)(bias + col0 + bj * HALF + 4 * n) : (f32x4){0.f, 0.f, 0.f, 0.f};
#pragma unroll
            for (int ai = 0; ai < 2; ++ai)
#pragma unroll
                for (int m = 0; m < 4; ++m) {
                    f32x4 o[2];
#pragma unroll
                    for (int n = 0; n < 2; ++n)
#pragma unroll
                        for (int i = 0; i < 4; ++i) { const float z = acc[ai][bj][m][n][i] + bv[n][i];
                            o[n][i] = kind == 0 ? (1.f - __expf(-0.60653065971f * sigmoidf_(z))) : (kind == 1 ? sigmoidf_(z) : z); }
                    st8bf(dst + (size_t)(row0 + ai * HALF + m * 16) * D + col0 + bj * HALF, o[0], o[1]);
                }
        }
    }
};
struct EpiIn {
    static constexpr bool PERM = true, AFTER_DRAIN = false;
    bf16 *QKR, *VV, *OO; float* IF; const float* bif;
    __device__ __forceinline__ void operator()(const f32x4 (&acc)[2][2][4][2], const Unit& u, int wr, int wc, int fr, int fq) const {
        const int row0 = u.pm * BM + wr * 64 + fr;
        if (u.pn < 12) {
            bf16 *p0 = QKR, *p1 = VV, *p2 = OO; asm volatile("" : "+s"(p0), "+s"(p1), "+s"(p2));
            const int kind = u.pn >> 2; bf16* dst = kind == 0 ? p0 : (kind == 1 ? p1 : p2); const int col0 = (u.pn & 3) * BM + wc * 32 + 8 * fq;
#pragma unroll
            for (int ai = 0; ai < 2; ++ai)
#pragma unroll
                for (int m = 0; m < 4; ++m) { bf16* rp = dst + (size_t)(row0 + ai * HALF + m * 16) * D + col0;
#pragma unroll
                    for (int bj = 0; bj < 2; ++bj) { f32x4 a = acc[ai][bj][m][0], b = acc[ai][bj][m][1];
                        if (kind == 2) {
#pragma unroll
                            for (int i = 0; i < 4; ++i) { a[i] = sigmoidf_(a[i]); b[i] = sigmoidf_(b[i]); } }
                        st8bf(rp + bj * HALF, a, b); } }
        } else if (u.pn == 12 && wc == 0 && fq < 2) {
            const f32x4 b0 = *(const f32x4*)(bif + 8 * fq), b1 = *(const f32x4*)(bif + 8 * fq + 4);
#pragma unroll
            for (int ai = 0; ai < 2; ++ai)
#pragma unroll
                for (int m = 0; m < 4; ++m) { f32x4 a = acc[ai][0][m][0] + b0, b = acc[ai][0][m][1] + b1;
                    if (fq == 1) {
#pragma unroll
                        for (int i = 0; i < 4; ++i) { a[i] = logsigmoidf_(a[i]); b[i] = logsigmoidf_(b[i]); } }
                    float* rp = IF + (size_t)(row0 + ai * HALF + m * 16) * 16 + 8 * fq; *(f32x4*)rp = a; *(f32x4*)(rp + 4) = b; }
        }
    }
};

struct CJ { const float* W; const float* sc; bf16* WT; int K, N, Npad, ldk, koff, rmode, roff, smode; };
__device__ __forceinline__ int cj_items(const CJ& j) { return (j.K / 64) * (j.Npad / 32); }
__device__ __forceinline__ void conv_item(const CJ& J, LAS float* scr, int item, int lane) {
    const int nblk = J.Npad / 32, kb = item / nblk, nb = item % nblk, k0 = 64 * kb, n0 = 32 * nb;
    const int nn = n0 + (lane & 31); const bool nok = nn < J.N;
#pragma unroll 8
    for (int i = 0; i < 32; ++i) { const int kk = 2 * i + (lane >> 5); float w = nok ? J.W[(size_t)(k0 + kk) * J.N + nn] : 0.f;
        if (J.smode) { const float s = J.sc[k0 + kk]; w *= (J.smode == 1 ? s : 1.f - s); }
        scr[kk * 33 + (lane & 31)] = w; }
    LDS_WAIT(); asm volatile("" ::: "memory");
    const int rowbase = J.rmode == 0 ? J.roff + n0 : (n0 >> 7) * 256 + (n0 & 127) + J.roff;
    const int c = lane & 7;
#pragma unroll
    for (int j = 0; j < 4; ++j) { const int n = (lane >> 3) + 8 * j; const LAS float* s = scr + (8 * c) * 33 + n;
        v4u o; o.x = pkbf(s[0 * 33], s[1 * 33]); o.y = pkbf(s[2 * 33], s[3 * 33]); o.z = pkbf(s[4 * 33], s[5 * 33]); o.w = pkbf(s[6 * 33], s[7 * 33]);
        *(GAS v4u*)(J.WT + (size_t)(rowbase + n) * J.ldk + J.koff + k0 + 8 * c) = o; }
    LDS_WAIT(); asm volatile("" ::: "memory");
}
__device__ __forceinline__ CJ get_job(const Frame& F, int kind, int j, int layer, int ab, bf16* Wb) {
    CJ J; J.sc = nullptr; J.smode = 0; J.koff = 0; J.rmode = 0; J.roff = 0;
    if (kind == 0) {
        const float* wg = inptr(F, ab ? I_FBWG : I_FAWG) + (size_t)layer * D * FF; const float* wu = inptr(F, ab ? I_FBWU : I_FAWU) + (size_t)layer * D * FF; const float* wd = inptr(F, ab ? I_FBWD : I_FAWD) + (size_t)layer * D * FF;
        if (j < 2) { J.W = j == 0 ? wg : wu; J.K = D; J.N = FF; J.Npad = FF; J.WT = Wb + W_GU / 2; J.ldk = D; J.rmode = 1; J.roff = j == 0 ? 0 : 128; }
        else { J.W = wd; J.K = FF; J.N = D; J.Npad = D; J.WT = Wb + W_D / 2; J.ldk = FF; }
    } else if (kind == 1) {
        if (j < 12) {
            const int s = j >> 1, half = j & 1;
            J.W = inptr(F, s == 0 ? I_WR : (s == 1 ? I_WK : (s == 2 ? I_WV : (s == 3 ? I_W1 : (s == 4 ? I_A1 : I_G1)))));
            J.N = s < 3 ? 1024 : (s < 5 ? 64 : 160); J.Npad = s < 3 ? 1024 : (s < 5 ? 64 : 384);
            J.roff = s < 3 ? 1024 * s : (s == 3 ? 3072 : (s == 4 ? 3136 : 3200));
            const int mui = s == 0 ? 0 : (s == 1 ? 2 : (s == 2 ? 3 : (s == 3 ? 1 : (s == 4 ? 4 : 5))));
            J.sc = inptr(F, I_MU) + mui * D; J.smode = half ? 1 : 2; J.koff = half * D; J.K = D; J.ldk = KRW; J.WT = Wb + W_RW / 2;
        } else { J.W = inptr(F, I_WO); J.K = D; J.N = D; J.Npad = D; J.WT = Wb + W_O / 2; J.ldk = D; }
    } else {
        if (j == 0) { J.W = inptr(F, I_WIN); J.K = D; J.N = 3088; J.Npad = NIN; J.WT = Wb + W_IN / 2; J.ldk = D; }
        else { J.W = inptr(F, I_WOUT); J.K = D; J.N = D; J.Npad = D; J.WT = Wb + W_OUT / 2; J.ldk = D; }
    }
    return J;
}
__device__ __forceinline__ void convert_weights(const Frame& F, int kind, int layer, int ab, bf16* Wb, const int cu0 = 0) {
    LAS float* scr = (LAS float*)(F.lds + F.wave * 16384);
    const int gw = (F.vcu - cu0) * NWAVES + F.wave, NGW = (F.G - cu0) * NWAVES;
    const int njobs = kind == 0 ? 3 : (kind == 1 ? 13 : 2);
    int total = 0;
    for (int j = 0; j < njobs; ++j) { const CJ J = get_job(F, kind, j, layer, ab, Wb); total += cj_items(J); }
    for (int g = gw; g < total; g += NGW) {
        int r = g, j = 0; CJ J = get_job(F, kind, 0, layer, ab, Wb);
        while (r >= cj_items(J)) { r -= cj_items(J); ++j; J = get_job(F, kind, j, layer, ab, Wb); }
        conv_item(J, scr, r, F.lane);
    }
    if (kind == 1) {
        bf16* WT = Wb + W_L2 / 2; const float* w2 = inptr(F, I_W2); const float* a2 = inptr(F, I_A2); const float* g2 = inptr(F, I_G2);
        for (int idx = (F.vcu * NWAVES + F.wave) * 64 + F.lane; idx < 48 * NL2; idx += F.G * NWAVES * 64) {
            const int c = idx / NL2, n = idx % NL2, type = n >> 10, jj = n & 1023;
            const float* src = nullptr;
            if (type == 0 && c < 8) src = w2 + (size_t)(8 * c) * D + jj;
            else if (type == 1 && c >= 8 && c < 16) src = a2 + (size_t)(8 * (c - 8)) * D + jj;
            else if (type == 2 && c >= 16 && c < 36) src = g2 + (size_t)(8 * (c - 16)) * D + jj;
            float v[8];
#pragma unroll
            for (int e = 0; e < 8; ++e) v[e] = src ? src[(size_t)e * D] : 0.f;
            *(GAS v4u*)(WT + (size_t)n * KL2 + 8 * c) = pack8(v);
        }
    }
}

template <int MODE>
__device__ __forceinline__ void norm_rows(const Frame& F, const float* base_p, const float* base_s, int nslab, float coef, const float* slab, float* xr,
                                          const float* gain, bf16* dst, const float* shift_in, float* out) {
    const int gw = F.vcu * NWAVES + F.wave, NGW = F.G * NWAVES, lane = F.lane;
    f32x4 gv[4];
#pragma unroll
    for (int j = 0; j < 4; ++j) gv[j] = *(const f32x4*)(gain + 256 * j + 4 * lane);
    for (int m = gw; m < M; m += NGW) {
        const bool samp = m >= MP;
        const float* src = samp ? base_s + (size_t)(m - MP) * D : base_p + (size_t)m * D;
        f32x4 v[4];
#pragma unroll
        for (int j = 0; j < 4; ++j) v[j] = *(const f32x4*)(src + 256 * j + 4 * lane);
        if (samp && nslab > 0) {
            for (int s = 0; s < nslab; ++s) { const float* sp = slab + ((size_t)s * MS + (m - MP)) * D;
#pragma unroll
                for (int j = 0; j < 4; ++j) v[j] += *(const f32x4*)(sp + 256 * j + 4 * lane) * coef; }
            if (MODE != 2) {
#pragma unroll
                for (int j = 0; j < 4; ++j) *(f32x4*)(xr + (size_t)m * D + 256 * j + 4 * lane) = v[j]; }
        }
        float ss = 0.f;
#pragma unroll
        for (int j = 0; j < 4; ++j) ss += (v[j].x * v[j].x + v[j].y * v[j].y) + (v[j].z * v[j].z + v[j].w * v[j].w);
        const float r = 1.0f / sqrtf(wave_sum(ss) * (1.f / D) + NORM_EPS);
#pragma unroll
        for (int j = 0; j < 4; ++j) v[j] = v[j] * r * gv[j];
        if (MODE == 2) {
#pragma unroll
            for (int j = 0; j < 4; ++j) *(f32x4*)(out + O_Y + (size_t)m * D + 256 * j + 4 * lane) = v[j];
        } else if (MODE == 0) {
#pragma unroll
            for (int j = 0; j < 4; ++j) { const unsigned long long w = (unsigned long long)pkbf(v[j].x, v[j].y) | ((unsigned long long)pkbf(v[j].z, v[j].w) << 32);
                *(unsigned long long*)(dst + (size_t)m * D + 256 * j + 4 * lane) = w; }
        } else {
            int t, b; bool first, last;
            if (!samp) { t = m & (PT - 1); b = m >> 11; first = t == 0; last = t == PT - 1; } else { const int mm = m - MP; t = mm & 3; b = mm >> 2; first = t == 0; last = t == 3; }
#pragma unroll
            for (int j = 0; j < 4; ++j) { const unsigned long long w = (unsigned long long)pkbf(v[j].x, v[j].y) | ((unsigned long long)pkbf(v[j].z, v[j].w) << 32);
                *(unsigned long long*)(dst + (size_t)m * (2 * D) + 256 * j + 4 * lane) = w;
                if (!last) *(unsigned long long*)(dst + (size_t)(m + 1) * (2 * D) + D + 256 * j + 4 * lane) = w;
                else *(f32x4*)(out + (samp ? O_S_SHIFT : O_P_SHIFT) + (size_t)b * D + 256 * j + 4 * lane) = v[j];
                if (first) { unsigned long long z = 0ull;
                    if (samp) { const f32x4 s = *(const f32x4*)(shift_in + (size_t)b * D + 256 * j + 4 * lane); z = (unsigned long long)pkbf(s.x, s.y) | ((unsigned long long)pkbf(s.z, s.w) << 32); }
                    *(unsigned long long*)(dst + (size_t)m * (2 * D) + D + 256 * j + 4 * lane) = z; }
            }
        }
    }
}

constexpr int RW_KK = 0, RW_DD = 4096, RW_BB = 8192, RW_KP = 12288, RW_RR = 16384, RW_VV = 20480, RW_YY = 24576;
__device__ __forceinline__ void rwkv_chain(const Frame& F, int row0, int T, int h, const float* S0, float* ST,
                                           const bf16* Rb, const bf16* Kb, const bf16* Vb, const bf16* Db, const bf16* Ab, bf16* Gb,
                                           const float* k_k, const float* k_a, const float* r_k, const float* gn_w, const float* gn_b, const bool do_store, const int pvar) {
    LAS float* L = (LAS float*)F.lds;
    const int tid = F.tid, lane = F.lane, w = F.wave;
    const int cg = tid & 7, tt = tid >> 3;
    const int srow = 8 * w + (lane >> 3);
    float S[8];
    if (S0) { const f32x4 a = *(const f32x4*)(S0 + srow * 64 + 8 * cg), b = *(const f32x4*)(S0 + srow * 64 + 8 * cg + 4);
        S[0] = a.x; S[1] = a.y; S[2] = a.z; S[3] = a.w; S[4] = b.x; S[5] = b.y; S[6] = b.z; S[7] = b.w; }
    else {
#pragma unroll
        for (int j = 0; j < 8; ++j) S[j] = 0.f; }
    const int ch = h * 64 + 8 * cg;
    float ckk[8], cka[8], crk[8], cgw[8], cgb[8];
#pragma unroll
    for (int j = 0; j < 8; ++j) { ckk[j] = k_k[ch + j]; cka[j] = k_a[ch + j]; crk[j] = r_k[ch + j]; cgw[j] = gn_w[ch + j]; cgb[j] = gn_b[ch + j]; }
    const int nch = (T + 63) >> 6;
    v4u pr = {0, 0, 0, 0}, pk = pr, pv = pr, pd = pr, pa = pr, pg = pr;
    { const int nt0 = T < 64 ? T : 64;
      if (tt < nt0) { const size_t off = (size_t)(row0 + tt) * D + ch;
          pr = *(const v4u*)(Rb + off); pk = *(const v4u*)(Kb + off); pv = *(const v4u*)(Vb + off); pd = *(const v4u*)(Db + off); pa = *(const v4u*)(Ab + off); pg = *(const v4u*)(Gb + off); } }
    float bon = 0.f, vv[8], gg[8];
    for (int c = 0; c < nch; ++c) {
        const int nt = (T - 64 * c) < 64 ? (T - 64 * c) : 64;
        const bool valid = tt < nt;
        {
            float r8[8], k8[8], d8[8], a8[8];
            unpack8(pr, r8); unpack8(pk, k8); unpack8(pv, vv); unpack8(pd, d8); unpack8(pa, a8); unpack8(pg, gg);
            float kk[8], ss = 0.f;
#pragma unroll
            for (int j = 0; j < 8; ++j) { kk[j] = k8[j] * ckk[j]; ss += kk[j] * kk[j]; }
            ss = red8(ss);
            const float inv = __builtin_amdgcn_rsqf(fmaxf(ss, 1e-24f));
            float kp[8], bsum = 0.f;
#pragma unroll
            for (int j = 0; j < 8; ++j) { kk[j] *= inv; kp[j] = k8[j] * (1.f + (a8[j] - 1.f) * cka[j]); bsum += r8[j] * kp[j] * crk[j]; }
            bon = red8(bsum);
            if (valid) {
                LAS float* p = L + tt * 64 + 8 * cg;
                *(LAS f32x4*)(p + RW_KK) = (f32x4){-kk[0], -kk[1], -kk[2], -kk[3]}; *(LAS f32x4*)(p + RW_KK + 4) = (f32x4){-kk[4], -kk[5], -kk[6], -kk[7]};
                *(LAS f32x4*)(p + RW_DD) = (f32x4){1.f - d8[0], 1.f - d8[1], 1.f - d8[2], 1.f - d8[3]}; *(LAS f32x4*)(p + RW_DD + 4) = (f32x4){1.f - d8[4], 1.f - d8[5], 1.f - d8[6], 1.f - d8[7]};
                *(LAS f32x4*)(p + RW_BB) = (f32x4){kk[0] * a8[0], kk[1] * a8[1], kk[2] * a8[2], kk[3] * a8[3]}; *(LAS f32x4*)(p + RW_BB + 4) = (f32x4){kk[4] * a8[4], kk[5] * a8[5], kk[6] * a8[6], kk[7] * a8[7]};
                *(LAS f32x4*)(p + RW_KP) = (f32x4){kp[0], kp[1], kp[2], kp[3]}; *(LAS f32x4*)(p + RW_KP + 4) = (f32x4){kp[4], kp[5], kp[6], kp[7]};
                *(LAS f32x4*)(p + RW_RR) = (f32x4){r8[0], r8[1], r8[2], r8[3]}; *(LAS f32x4*)(p + RW_RR + 4) = (f32x4){r8[4], r8[5], r8[6], r8[7]};
                *(LAS f32x4*)(p + RW_VV) = (f32x4){vv[0], vv[1], vv[2], vv[3]}; *(LAS f32x4*)(p + RW_VV + 4) = (f32x4){vv[4], vv[5], vv[6], vv[7]};
            }
        }
        __syncthreads();
        if (c + 1 < nch) { const int nt1 = (T - 64 * (c + 1)) < 64 ? (T - 64 * (c + 1)) : 64;
            if (tt < nt1) { const size_t off = (size_t)(row0 + 64 * (c + 1) + tt) * D + ch;
                pr = *(const v4u*)(Rb + off); pk = *(const v4u*)(Kb + off); pv = *(const v4u*)(Vb + off); pd = *(const v4u*)(Db + off); pa = *(const v4u*)(Ab + off); pg = *(const v4u*)(Gb + off); } }
        {
            typedef float f2 __attribute__((ext_vector_type(2)));
            f2 S2[4] = {{S[0], S[1]}, {S[2], S[3]}, {S[4], S[5]}, {S[6], S[7]}};
            const LAS float* p = L + 8 * cg;
            LAS float* yw = L + RW_YY + srow;
            const LAS float* vp = L + RW_VV + srow;
#define RW_LD(N, Dd, B, Q, R, VR, t_) do { const LAS float* p_ = p + (t_) * 64; \
                N[0] = *(const LAS f32x4*)(p_ + RW_KK); N[1] = *(const LAS f32x4*)(p_ + RW_KK + 4); Dd[0] = *(const LAS f32x4*)(p_ + RW_DD); Dd[1] = *(const LAS f32x4*)(p_ + RW_DD + 4); \
                B[0] = *(const LAS f32x4*)(p_ + RW_BB); B[1] = *(const LAS f32x4*)(p_ + RW_BB + 4); Q[0] = *(const LAS f32x4*)(p_ + RW_KP); Q[1] = *(const LAS f32x4*)(p_ + RW_KP + 4); \
                R[0] = *(const LAS f32x4*)(p_ + RW_RR); R[1] = *(const LAS f32x4*)(p_ + RW_RR + 4); VR = vp[(t_) * 64]; } while (0)
#define RW_STEP(N, Dd, B, Q, R, VR, t_) do { \
                f2 a_ = S2[0] * (f2){N[0].x, N[0].y}; a_ = S2[1] * (f2){N[0].z, N[0].w} + a_; a_ = S2[2] * (f2){N[1].x, N[1].y} + a_; a_ = S2[3] * (f2){N[1].z, N[1].w} + a_; \
                const float sa_ = red8(a_.x + a_.y); const f2 sv_ = {sa_, sa_}, vv_ = {VR, VR}; \
                S2[0] = S2[0] * (f2){Dd[0].x, Dd[0].y} + (sv_ * (f2){B[0].x, B[0].y} + vv_ * (f2){Q[0].x, Q[0].y}); \
                S2[1] = S2[1] * (f2){Dd[0].z, Dd[0].w} + (sv_ * (f2){B[0].z, B[0].w} + vv_ * (f2){Q[0].z, Q[0].w}); \
                S2[2] = S2[2] * (f2){Dd[1].x, Dd[1].y} + (sv_ * (f2){B[1].x, B[1].y} + vv_ * (f2){Q[1].x, Q[1].y}); \
                S2[3] = S2[3] * (f2){Dd[1].z, Dd[1].w} + (sv_ * (f2){B[1].z, B[1].w} + vv_ * (f2){Q[1].z, Q[1].w}); \
                f2 y_ = S2[0] * (f2){R[0].x, R[0].y}; y_ = S2[1] * (f2){R[0].z, R[0].w} + y_; y_ = S2[2] * (f2){R[1].x, R[1].y} + y_; y_ = S2[3] * (f2){R[1].z, R[1].w} + y_; \
                yw[(t_) * 64] = red8(y_.x + y_.y); } while (0)
            f32x4 nA[2], dA[2], bA[2], qA[2], rA[2]; float vA;
            for (int t = 0; t < nt; ++t) { RW_LD(nA, dA, bA, qA, rA, vA, t); RW_STEP(nA, dA, bA, qA, rA, vA, t); }
#undef RW_LD
#undef RW_STEP
            S[0] = S2[0].x; S[1] = S2[0].y; S[2] = S2[1].x; S[3] = S2[1].y; S[4] = S2[2].x; S[5] = S2[2].y; S[6] = S2[3].x; S[7] = S2[3].y;
        }
        __syncthreads();
        if (pvar != 4) {
            f32x4 y0 = {0.f, 0.f, 0.f, 0.f}, y1 = y0;
            if (valid) { y0 = *(const LAS f32x4*)(L + RW_YY + tt * 64 + 8 * cg); y1 = *(const LAS f32x4*)(L + RW_YY + tt * 64 + 8 * cg + 4); }
            float yy[8] = {y0.x, y0.y, y0.z, y0.w, y1.x, y1.y, y1.z, y1.w};
            float s1 = 0.f;
#pragma unroll
            for (int j = 0; j < 8; ++j) s1 += yy[j];
            const float mean = red8(s1) * (1.f / 64.f);
            float s2 = 0.f;
#pragma unroll
            for (int j = 0; j < 8; ++j) { yy[j] -= mean; s2 += yy[j] * yy[j]; }
            const float rstd = __builtin_amdgcn_rsqf(red8(s2) * (1.f / 64.f) + GN_EPS);
            float o[8];
#pragma unroll
            for (int j = 0; j < 8; ++j) o[j] = ((yy[j] * rstd) * cgw[j] + cgb[j] + bon * vv[j]) * gg[j];
            if (valid && do_store) *(v4u*)(Gb + (size_t)(row0 + 64 * c + tt) * D + ch) = pack8(o);
        }
    }
    *(f32x4*)(ST + srow * 64 + 8 * cg) = (f32x4){S[0], S[1], S[2], S[3]}; *(f32x4*)(ST + srow * 64 + 8 * cg + 4) = (f32x4){S[4], S[5], S[6], S[7]};
    __syncthreads();
}

constexpr int RH_TC = 32, RH_BUF = 12288;
constexpr int RH_KK = 0, RH_DD = 2048, RH_BB = 4096, RH_KP = 6144, RH_RR = 8192, RH_VV = 10240, RH_YY = 11264;
__device__ __forceinline__ void rwkv_half_chain(const Frame& F, int b, int h, int half, float* ST, const bf16* Rb, const bf16* Kb, const bf16* Vb, const bf16* Db, const bf16* Ab,
                                                bf16* YRAW, float* BON, const float* k_k, const float* k_a, const float* r_k, const int pvar) {
    LAS float* L = (LAS float*)F.lds;
    const int tid = F.tid, lane = F.lane, w = F.wave, row0 = b * PT;
    constexpr int nch = PT / RH_TC;
    if (w < 4) {
        const int srow = 8 * w + (lane >> 3), cq = lane & 7;
        f32x4 S4 = {0.f, 0.f, 0.f, 0.f}, S5 = S4;
        __syncthreads();
        __builtin_amdgcn_s_setprio(3);
        for (int c = 0; c < nch; ++c) {
            const LAS float* p = L + (c & 1) * RH_BUF + 8 * cq;
            LAS float* yw = L + (c & 1) * RH_BUF + RH_YY + srow;
            const LAS float* vp = L + (c & 1) * RH_BUF + RH_VV + srow;
#define RH_LD(N, Dd, B, Q, R, VR, t_) do { const LAS float* p_ = p + (t_) * 64; \
                N[0] = *(const LAS f32x4*)(p_ + RH_KK); N[1] = *(const LAS f32x4*)(p_ + RH_KK + 4); Dd[0] = *(const LAS f32x4*)(p_ + RH_DD); Dd[1] = *(const LAS f32x4*)(p_ + RH_DD + 4); \
                B[0] = *(const LAS f32x4*)(p_ + RH_BB); B[1] = *(const LAS f32x4*)(p_ + RH_BB + 4); Q[0] = *(const LAS f32x4*)(p_ + RH_KP); Q[1] = *(const LAS f32x4*)(p_ + RH_KP + 4); \
                R[0] = *(const LAS f32x4*)(p_ + RH_RR); R[1] = *(const LAS f32x4*)(p_ + RH_RR + 4); VR = vp[(t_) * 32]; } while (0)
#define RH_STEP(N, Dd, B, Q, R, VR, t_) do { \
                const f32x4 pa_ = S4 * N[0] + S5 * N[1]; const float sa_ = red8((pa_.x + pa_.y) + (pa_.z + pa_.w)); \
                S4 = S4 * Dd[0] + (B[0] * sa_ + Q[0] * VR); S5 = S5 * Dd[1] + (B[1] * sa_ + Q[1] * VR); \
                const f32x4 ya_ = S4 * R[0] + S5 * R[1]; yw[(t_) * 32] = red8((ya_.x + ya_.y) + (ya_.z + ya_.w)); } while (0)
            f32x4 nA[2], dA[2], bA[2], qA[2], rA[2], nB[2], dB[2], bB[2], qB[2], rB[2]; float vA, vB;
            RH_LD(nA, dA, bA, qA, rA, vA, 0);
            if (pvar != 3)
            for (int t = 0; t < RH_TC; t += 2) {
                RH_LD(nB, dB, bB, qB, rB, vB, t + 1);
                RH_STEP(nA, dA, bA, qA, rA, vA, t);
                RH_LD(nA, dA, bA, qA, rA, vA, (t + 2 < RH_TC ? t + 2 : t + 1));
                RH_STEP(nB, dB, bB, qB, rB, vB, t + 1);
            }
#undef RH_LD
#undef RH_STEP
            __syncthreads();
        }
        __builtin_amdgcn_s_setprio(0);
        *(f32x4*)(ST + (32 * half + srow) * 64 + 8 * cq) = S4; *(f32x4*)(ST + (32 * half + srow) * 64 + 8 * cq + 4) = S5;
    } else {
        const int ht = tid - 256, cg = ht & 7, tt = ht >> 3;
        const int ch = h * 64 + 8 * cg, vch = h * 64 + 32 * half + 4 * cg;
        float ckk[8], cka[8], crk[8];
#pragma unroll
        for (int j = 0; j < 8; ++j) { ckk[j] = k_k[ch + j]; cka[j] = k_a[ch + j]; crk[j] = r_k[ch + j]; }
        v4u pr, pk, pd, pa; uint2 pv;
#define RH_LOAD(cc) do { const size_t off_ = (size_t)(row0 + RH_TC * (cc) + tt) * D; pr = *(const v4u*)(Rb + off_ + ch); pk = *(const v4u*)(Kb + off_ + ch); pd = *(const v4u*)(Db + off_ + ch); \
            pa = *(const v4u*)(Ab + off_ + ch); pv = *(const uint2*)(Vb + off_ + vch); } while (0)
#define RH_PREP(cc) do { float r8[8], k8[8], d8[8], a8[8]; unpack8(pr, r8); unpack8(pk, k8); unpack8(pd, d8); unpack8(pa, a8); \
            float kk[8], ss = 0.f; _Pragma("unroll") for (int j = 0; j < 8; ++j) { kk[j] = k8[j] * ckk[j]; ss += kk[j] * kk[j]; } \
            ss = red8(ss); const float inv = __builtin_amdgcn_rsqf(fmaxf(ss, 1e-24f)); \
            float kp[8], bsum = 0.f; _Pragma("unroll") for (int j = 0; j < 8; ++j) { kk[j] *= inv; kp[j] = k8[j] * (1.f + (a8[j] - 1.f) * cka[j]); bsum += r8[j] * kp[j] * crk[j]; } \
            const float bon = red8(bsum); if (half == 0 && cg == 0) BON[(size_t)(row0 + RH_TC * (cc) + tt) * 16 + h] = bon; \
            LAS float* p = L + ((cc) & 1) * RH_BUF + tt * 64 + 8 * cg; \
            *(LAS f32x4*)(p + RH_KK) = (f32x4){-kk[0], -kk[1], -kk[2], -kk[3]}; *(LAS f32x4*)(p + RH_KK + 4) = (f32x4){-kk[4], -kk[5], -kk[6], -kk[7]}; \
            *(LAS f32x4*)(p + RH_DD) = (f32x4){1.f - d8[0], 1.f - d8[1], 1.f - d8[2], 1.f - d8[3]}; *(LAS f32x4*)(p + RH_DD + 4) = (f32x4){1.f - d8[4], 1.f - d8[5], 1.f - d8[6], 1.f - d8[7]}; \
            *(LAS f32x4*)(p + RH_BB) = (f32x4){kk[0] * a8[0], kk[1] * a8[1], kk[2] * a8[2], kk[3] * a8[3]}; *(LAS f32x4*)(p + RH_BB + 4) = (f32x4){kk[4] * a8[4], kk[5] * a8[5], kk[6] * a8[6], kk[7] * a8[7]}; \
            *(LAS f32x4*)(p + RH_KP) = (f32x4){kp[0], kp[1], kp[2], kp[3]}; *(LAS f32x4*)(p + RH_KP + 4) = (f32x4){kp[4], kp[5], kp[6], kp[7]}; \
            *(LAS f32x4*)(p + RH_RR) = (f32x4){r8[0], r8[1], r8[2], r8[3]}; *(LAS f32x4*)(p + RH_RR + 4) = (f32x4){r8[4], r8[5], r8[6], r8[7]}; \
            *(LAS f32x4*)(L + ((cc) & 1) * RH_BUF + RH_VV + tt * 32 + 4 * cg) = (f32x4){bflo(pv.x), bfhi(pv.x), bflo(pv.y), bfhi(pv.y)}; } while (0)
#define RH_POST(cc) do { const f32x4 y4 = *(const LAS f32x4*)(L + ((cc) & 1) * RH_BUF + RH_YY + tt * 32 + 4 * cg); uint2 o; o.x = pkbf(y4.x, y4.y); o.y = pkbf(y4.z, y4.w); \
            *(uint2*)(YRAW + (size_t)(row0 + RH_TC * (cc) + tt) * D + vch) = o; } while (0)
        RH_LOAD(0); RH_PREP(0); RH_LOAD(1);
        __syncthreads();
        for (int c = 0; c < nch; ++c) {
            if (c > 0) RH_POST(c - 1);
            if (c + 1 < nch) { RH_PREP(c + 1); if (c + 2 < nch) RH_LOAD(c + 2); }
            __syncthreads();
        }
        RH_POST(nch - 1);
#undef RH_LOAD
#undef RH_PREP
#undef RH_POST
    }
    __syncthreads();
}
__device__ __forceinline__ void rwkv_finish(const Frame& F, const bf16* YRAW, const float* BON, const bf16* Vb, bf16* Gb, const float* gn_w, const float* gn_b) {
    const int gt = (F.vcu * NWAVES + F.wave) * 64 + F.lane, NT = F.G * NWAVES * 64;
    for (int task = gt; task < MP * 128; task += NT) {
        const int cg = task & 7, hh = (task >> 3) & 15, row = task >> 7; const size_t off = (size_t)row * D + hh * 64 + 8 * cg;
        float yy[8], vv[8], gg[8]; unpack8(*(const v4u*)(YRAW + off), yy); unpack8(*(const v4u*)(Vb + off), vv); unpack8(*(const v4u*)(Gb + off), gg);
        const float bon = BON[(size_t)row * 16 + hh];
        float s1 = 0.f;
#pragma unroll
        for (int j = 0; j < 8; ++j) s1 += yy[j];
        const float mean = red8(s1) * (1.f / 64.f);
        float s2 = 0.f;
#pragma unroll
        for (int j = 0; j < 8; ++j) { yy[j] -= mean; s2 += yy[j] * yy[j]; }
        const float rstd = __builtin_amdgcn_rsqf(red8(s2) * (1.f / 64.f) + GN_EPS);
        const f32x4 w0 = *(const f32x4*)(gn_w + hh * 64 + 8 * cg), w1 = *(const f32x4*)(gn_w + hh * 64 + 8 * cg + 4), b0 = *(const f32x4*)(gn_b + hh * 64 + 8 * cg), b1 = *(const f32x4*)(gn_b + hh * 64 + 8 * cg + 4);
        const float gw[8] = {w0.x, w0.y, w0.z, w0.w, w1.x, w1.y, w1.z, w1.w}, gb[8] = {b0.x, b0.y, b0.z, b0.w, b1.x, b1.y, b1.z, b1.w};
        float o[8];
#pragma unroll
        for (int j = 0; j < 8; ++j) o[j] = ((yy[j] * rstd) * gw[j] + gb[j] + bon * vv[j]) * gg[j];
        *(v4u*)(Gb + off) = pack8(o);
    }
}

constexpr int PBY = 144;
constexpr int RPY = 272;
constexpr int ML_RQK = 0, ML_S = 0, ML_KT = 9216, ML_RV = 18432, ML_Q = 35840, ML_K = 45056, ML_HB = 35840, ML_VT = 54272, ML_C = 72704, ML_F = 91136;
constexpr int MF_N = 0, MF_QN = 64, MF_RS = 128, MF_HS = 256, MF_CW = 384, MF_B63 = 1024, MF_P63 = 1056, MF_MC = 1088  , MF_GB = 1152, MF_GP = MF_GB + 2048, MF_GA = MF_GP + 2048;
typedef __attribute__((address_space(3))) unsigned short lds_u16;
#define MFMA16(a, b, c) __builtin_amdgcn_mfma_f32_16x16x32_bf16((a), (b), (c), 0, 0, 0)
__device__ __forceinline__ void mlstm_prompt_chain(const Frame& F, int b, int hh, const bf16* QKR, const bf16* VVb, const bf16* OOb, const float* IFb, bf16* HOb,
                                                   const float* conv_w, const float* conv_b, const float* norm_w, float* out, const int pvar) {
    LAS unsigned char* lds = F.lds; LAS float* Fl = (LAS float*)(lds + ML_F);
    const int tid = F.tid, lane = F.lane, w = F.wave, fr = lane & 15, fq = lane >> 4;
    for (int i = tid; i < 128 * 72; i += 512) ((lds_u16*)(lds + ML_C))[i] = 0;
    if (tid < 64) Fl[MF_N + tid] = 0.f;
    for (int i = tid; i < 640; i += 512) { const int j = i >> 7, c = i & 127, gc = c < 64 ? hh * 64 + c : 512 + hh * 64 + (c - 64); Fl[MF_CW + i] = j < 4 ? conv_w[j * D + gc] : conv_b[gc]; }
    f32x4 Cacc[4];
#pragma unroll
    for (int k = 0; k < 4; ++k) Cacc[k] = (f32x4){0.f, 0.f, 0.f, 0.f};
    const int og = tid & 15, ot = tid >> 4;
    float nw[8];
#pragma unroll
    for (int e = 0; e < 8; ++e) nw[e] = norm_w[hh * 128 + 8 * og + e];
    v4u rq[3], rv[2], ro[2];
#define ML_LOAD_QKV(cc) do { const int rowc_ = b * PT + 64 * (cc); \
        _Pragma("unroll") for (int i = 0; i < 3; ++i) { const int q = tid + 512 * i, r = q >> 4, j = q & 15, tok = 64 * (cc) - 3 + r; rq[i] = (v4u){0u, 0u, 0u, 0u}; \
            if (q < 67 * 16 && tok >= 0) rq[i] = *(const v4u*)(QKR + (size_t)(b * PT + tok) * D + (j < 8 ? hh * 64 + 8 * j : 512 + hh * 64 + 8 * (j - 8))); } \
        _Pragma("unroll") for (int i = 0; i < 2; ++i) rv[i] = *(const v4u*)(VVb + (size_t)(rowc_ + ot + 32 * i) * D + hh * 128 + 8 * og); \
        } while (0)
#define ML_LOAD_O(cc) do { const int rowc_ = b * PT + 64 * (cc); \
        _Pragma("unroll") for (int i = 0; i < 2; ++i) ro[i] = *(const v4u*)(OOb + (size_t)(rowc_ + ot + 32 * i) * D + hh * 128 + 8 * og); } while (0)
    ML_LOAD_QKV(0);
#pragma unroll
    for (int q = 0; q < 4; ++q) { const int cc = w + 8 * q; const size_t ro_ = (size_t)(b * PT + 64 * cc + lane) * 16;
        const float li = IFb[ro_ + hh], lf = IFb[ro_ + 8 + hh];
        float bc = lf;
#pragma unroll
        for (int o = 1; o < 64; o <<= 1) { const float x = __shfl_up(bc, o); if (lane >= o) bc += x; }
        const float av = li - bc; float pm = av;
#pragma unroll
        for (int o = 1; o < 64; o <<= 1) { const float x = __shfl_up(pm, o); if (lane >= o) pm = fmaxf(pm, x); }
        Fl[MF_GB + cc * 64 + lane] = bc; Fl[MF_GP + cc * 64 + lane] = pm; Fl[MF_GA + cc * 64 + lane] = av;
        if (lane == 63) { Fl[MF_B63 + cc] = bc; Fl[MF_P63 + cc] = pm; } }
    __syncthreads();
    if (tid == 0) { float mm = 0.f;
        for (int cc = 0; cc < PT / 64; ++cc) { Fl[MF_MC + cc] = mm; const float b6 = Fl[MF_B63 + cc]; mm = fmaxf(b6 + mm, b6 + Fl[MF_P63 + cc]); }
        Fl[MF_MC + PT / 64] = mm; }
    __syncthreads();
    constexpr int NC = PT / 64;
    for (int c = 0; c < NC; ++c) {
        const int rowc = b * PT + 64 * c;
        const float m_c = Fl[MF_MC + c], m_n = Fl[MF_MC + c + 1], b63 = Fl[MF_B63 + c];
#pragma unroll
        for (int i = 0; i < 3; ++i) { const int q = tid + 512 * i; if (q < 67 * 16) *(LAS v4u*)(lds + ML_RQK + (q >> 4) * RPY + 16 * (q & 15)) = rq[i]; }
#pragma unroll
        for (int i = 0; i < 2; ++i) *(LAS v4u*)(lds + ML_RV + (ot + 32 * i) * RPY + 16 * og) = rv[i];
        if (c + 1 < NC) ML_LOAD_QKV(c + 1);
        ML_LOAD_O(c);
        __syncthreads();
        float kreg[8] = {0.f, 0.f, 0.f, 0.f, 0.f, 0.f, 0.f, 0.f};
        if (pvar != 3)
#pragma unroll
        for (int i = 0; i < 2; ++i) {
            const int g = w + 8 * i, t = lane;
            float x[4][8];
#pragma unroll
            for (int j = 0; j < 4; ++j) unpack8(*(const LAS v4u*)(lds + ML_RQK + (t + j) * RPY + 16 * g), x[j]);
            float val[8];
#pragma unroll
            for (int h2 = 0; h2 < 2; ++h2) { f32x4 a = *(const LAS f32x4*)(Fl + MF_CW + 4 * 128 + 8 * g + 4 * h2);
#pragma unroll
                for (int j = 0; j < 4; ++j) { const f32x4 cw = *(const LAS f32x4*)(Fl + MF_CW + j * 128 + 8 * g + 4 * h2);
                    a.x += cw.x * x[j][4 * h2]; a.y += cw.y * x[j][4 * h2 + 1]; a.z += cw.z * x[j][4 * h2 + 2]; a.w += cw.w * x[j][4 * h2 + 3]; }
                val[4 * h2] = siluf_(a.x); val[4 * h2 + 1] = siluf_(a.y); val[4 * h2 + 2] = siluf_(a.z); val[4 * h2 + 3] = siluf_(a.w); }
            if (i == 0) {
#pragma unroll
                for (int e = 0; e < 8; ++e) val[e] *= 0.125f;
                *(LAS v4u*)(lds + ML_Q + t * PBY + 16 * w) = pack8(val);
            } else { *(LAS v4u*)(lds + ML_K + t * PBY + 16 * w) = pack8(val);
#pragma unroll
                for (int e = 0; e < 8; ++e) kreg[e] = val[e]; }
            const v4u vw = *(const LAS v4u*)(lds + ML_RV + t * RPY + 16 * g);
            lds_u16* vt = (lds_u16*)(lds + ML_VT) + (8 * g) * 72 + t;
            vt[0 * 72] = (unsigned short)(vw.x & 0xffffu); vt[1 * 72] = (unsigned short)(vw.x >> 16); vt[2 * 72] = (unsigned short)(vw.y & 0xffffu); vt[3 * 72] = (unsigned short)(vw.y >> 16);
            vt[4 * 72] = (unsigned short)(vw.z & 0xffffu); vt[5 * 72] = (unsigned short)(vw.z >> 16); vt[6 * 72] = (unsigned short)(vw.w & 0xffffu); vt[7 * 72] = (unsigned short)(vw.w >> 16);
        }
        __syncthreads();
        if (pvar != 4) {
        { const float wsv = __expf(b63 + Fl[MF_GA + c * 64 + lane] - m_n); lds_u16* kt = (lds_u16*)(lds + ML_KT) + (8 * w) * 72 + lane;
#pragma unroll
          for (int e = 0; e < 8; ++e) kt[e * 72] = f2bf1(kreg[e] * wsv); }
        { const int tq = tid >> 3, p = tid & 7; float q8[8]; unpack8(*(const LAS v4u*)(lds + ML_Q + tq * PBY + 16 * p), q8);
          float dsum = 0.f;
#pragma unroll
          for (int e = 0; e < 8; ++e) dsum += q8[e] * Fl[MF_N + 8 * p + e];
          dsum = red8(dsum); if (p == 0) Fl[MF_QN + tq] = dsum; }
        { const int ti = w >> 1; float rs[4] = {0.f, 0.f, 0.f, 0.f};
#pragma unroll
          for (int jj = 0; jj < 2; ++jj) { const int sj = 2 * (w & 1) + jj; f32x4 acc = {0.f, 0.f, 0.f, 0.f};
#pragma unroll
              for (int ks = 0; ks < 2; ++ks) { const bf16x8 a = *(const LAS bf16x8*)(lds + ML_Q + (16 * ti + fr) * PBY + ks * 64 + fq * 16), bb = *(const LAS bf16x8*)(lds + ML_K + (16 * sj + fr) * PBY + ks * 64 + fq * 16);
                  acc = MFMA16(a, bb, acc); }
              const int s = 16 * sj + fr; const float as = Fl[MF_GA + c * 64 + s];
#pragma unroll
              for (int r = 0; r < 4; ++r) { const int t = 16 * ti + 4 * fq + r; const float val = s <= t ? acc[r] * __expf(as - fmaxf(m_c, Fl[MF_GP + c * 64 + t])) : 0.f;
                  ((lds_u16*)(lds + ML_S))[t * 72 + s] = f2bf1(val); rs[r] += val; } }
#pragma unroll
          for (int r = 0; r < 4; ++r) { const float x = red16(rs[r]); if (fr == 0) Fl[MF_RS + (16 * ti + 4 * fq + r) * 2 + (w & 1)] = x; } }
        }
        __syncthreads();
        float hv[4][4] = {};
        if (pvar != 5) { const int ti = w & 3; float wi[4], den[4], ei[4], hq[4];
#pragma unroll
          for (int r = 0; r < 4; ++r) { const int t = 16 * ti + 4 * fq + r; const float mx = fmaxf(m_c, Fl[MF_GP + c * 64 + t]); wi[r] = __expf(m_c - mx); ei[r] = __expf(-(Fl[MF_GB + c * 64 + t] + mx)); den[r] = wi[r] * Fl[MF_QN + t] + Fl[MF_RS + 2 * t] + Fl[MF_RS + 2 * t + 1]; hq[r] = 0.f; }
#pragma unroll
          for (int i = 0; i < 4; ++i) { const int vt = 4 * (w >> 2) + i; f32x4 accA = {0.f, 0.f, 0.f, 0.f}, accB = accA;
#pragma unroll
              for (int ks = 0; ks < 2; ++ks) {
                  const bf16x8 aq = *(const LAS bf16x8*)(lds + ML_Q + (16 * ti + fr) * PBY + ks * 64 + fq * 16), bc = *(const LAS bf16x8*)(lds + ML_C + (16 * vt + fr) * PBY + ks * 64 + fq * 16);
                  accA = MFMA16(aq, bc, accA);
                  const bf16x8 as = *(const LAS bf16x8*)(lds + ML_S + (16 * ti + fr) * PBY + ks * 64 + fq * 16), bv = *(const LAS bf16x8*)(lds + ML_VT + (16 * vt + fr) * PBY + ks * 64 + fq * 16);
                  accB = MFMA16(as, bv, accB); }
#pragma unroll
              for (int r = 0; r < 4; ++r) { const float num = wi[r] * accA[r] + accB[r]; const float hh_ = num * __builtin_amdgcn_rcpf(fmaxf(fabsf(den[r]), ei[r])); hv[i][r] = hh_; hq[r] += hh_ * hh_; } }
#pragma unroll
          for (int r = 0; r < 4; ++r) { const float x = red16(hq[r]); if (fr == 0) Fl[MF_HS + (16 * ti + 4 * fq + r) * 2 + (w >> 2)] = x; } }
        __syncthreads();
        if (pvar != 6) {
        { const int ti = w & 3;
#pragma unroll
          for (int r = 0; r < 4; ++r) { const int t = 16 * ti + 4 * fq + r; const float sc = __builtin_amdgcn_rsqf((Fl[MF_HS + 2 * t] + Fl[MF_HS + 2 * t + 1]) * (1.f / 128.f) + NORM_EPS);
#pragma unroll
              for (int i = 0; i < 4; ++i) ((lds_u16*)(lds + ML_HB))[t * (RPY / 2) + 16 * (4 * (w >> 2) + i) + fr] = f2bf1(hv[i][r] * sc); } }
        { const float wst = __expf(b63 + m_c - m_n);
#pragma unroll
          for (int kt = 0; kt < 4; ++kt) { Cacc[kt] = Cacc[kt] * wst;
#pragma unroll
              for (int ks = 0; ks < 2; ++ks) { const bf16x8 a = *(const LAS bf16x8*)(lds + ML_VT + (16 * w + fr) * PBY + ks * 64 + fq * 16), bb = *(const LAS bf16x8*)(lds + ML_KT + (16 * kt + fr) * PBY + ks * 64 + fq * 16);
                  Cacc[kt] = MFMA16(a, bb, Cacc[kt]); }
#pragma unroll
              for (int r = 0; r < 4; ++r) ((lds_u16*)(lds + ML_C))[(16 * w + 4 * fq + r) * 72 + 16 * kt + fr] = f2bf1(Cacc[kt][r]); }
          if (w == 0) { float sum = 0.f;
#pragma unroll
              for (int q = 0; q < 8; ++q) { float k8[8]; unpack8(*(const LAS v4u*)(lds + ML_KT + lane * PBY + 16 * q), k8);
#pragma unroll
                  for (int e = 0; e < 8; ++e) sum += k8[e]; }
              Fl[MF_N + lane] = wst * Fl[MF_N + lane] + sum; } }
        }
        __syncthreads();
        if (pvar != 7)
#pragma unroll
        for (int i = 0; i < 2; ++i) { const int t = ot + 32 * i; float h8[8], o8[8]; unpack8(*(const LAS v4u*)(lds + ML_HB + t * RPY + 16 * og), h8); unpack8(ro[i], o8);
#pragma unroll
            for (int e = 0; e < 8; ++e) h8[e] = h8[e] * nw[e] * o8[e];
            *(v4u*)(HOb + (size_t)(rowc + t) * D + hh * 128 + 8 * og) = pack8(h8); }
    }
#undef ML_LOAD_QKV
#undef ML_LOAD_O
#pragma unroll
    for (int kt = 0; kt < 4; ++kt)
#pragma unroll
        for (int r = 0; r < 4; ++r) out[O_P_C + ((size_t)(b * 8 + hh) * 128 + 16 * w + 4 * fq + r) * 64 + 16 * kt + fr] = Cacc[kt][r];
    if (w == 0) { out[O_P_N + (size_t)(b * 8 + hh) * 64 + lane] = Fl[MF_N + lane]; if (lane == 0) out[O_P_M + b * 8 + hh] = Fl[MF_MC + PT / 64]; }
    if (tid < 384) { const int j = tid >> 7, c = tid & 127, gc = c < 64 ? hh * 64 + c : 512 + hh * 64 + (c - 64);
        out[O_P_CONV + (size_t)(b * 3 + j) * D + gc] = bf1(QKR[(size_t)(b * PT + PT - 3 + j) * D + gc]); }
    __syncthreads();
}
__device__ __forceinline__ void mlstm_sample_item(const Frame& F, int b, int hh, const bf16* QKR, const bf16* VVb, const bf16* OOb, const float* IFb, bf16* HOb,
                                                  const float* conv_w, const float* conv_b, const float* norm_w, const float* C0, const float* n0, const float* m0p, const float* conv0, float* out) {
    LAS float* L = (LAS float*)F.lds;
    constexpr int LQ = 0, LK = 256, LV = 512, LS = 1024, LQN = 1040, LHS = 1048;
    const int tid = F.tid, lane = F.lane, w = F.wave, row0 = MP + 4 * b;
    float li[4], lf[4];
#pragma unroll
    for (int t = 0; t < 4; ++t) { li[t] = IFb[(size_t)(row0 + t) * 16 + hh]; lf[t] = IFb[(size_t)(row0 + t) * 16 + 8 + hh]; }
    const float m0 = m0p[b * 8 + hh];
    float bc[4], av[4], mt[4], wi[4], wsv[4], ei[4], bm[4];
    { float run = 0.f, pm = -3.0e38f;
#pragma unroll
      for (int t = 0; t < 4; ++t) { run += lf[t]; bc[t] = run; av[t] = li[t] - run; pm = fmaxf(pm, av[t]); mt[t] = fmaxf(run + m0, run + pm); } }
    const float m_new = mt[3], wst = __expf(bc[3] + m0 - m_new);
#pragma unroll
    for (int t = 0; t < 4; ++t) { wi[t] = __expf(bc[t] + m0 - mt[t]); wsv[t] = __expf(bc[3] + av[t] - m_new); ei[t] = __expf(-mt[t]); bm[t] = bc[t] - mt[t]; }
    { const int t = tid >> 7, c = tid & 127, gc = c < 64 ? hh * 64 + c : 512 + hh * 64 + (c - 64);
      float x[4];
#pragma unroll
      for (int j = 0; j < 4; ++j) { const int p = t + j; x[j] = p < 3 ? conv0[(size_t)(b * 3 + p) * D + gc] : bf1(QKR[(size_t)(row0 + p - 3) * D + gc]); }
      float a = conv_b[gc];
#pragma unroll
      for (int j = 0; j < 4; ++j) a += conv_w[j * D + gc] * x[j];
      const float val = siluf_(a);
      if (c < 64) L[LQ + t * 64 + c] = val * 0.125f; else L[LK + t * 64 + (c - 64)] = val;
      if (t >= 1) out[O_S_CONV + (size_t)(b * 3 + t - 1) * D + gc] = x[3];
      L[LV + t * 128 + c] = bf1(VVb[(size_t)(row0 + t) * D + hh * 128 + c]); }
    __syncthreads();
    if (w == 0) { const int pair = lane >> 2, t = pair >> 2, s = pair & 3, part = lane & 3; float dsum = 0.f;
#pragma unroll
        for (int e = 0; e < 16; ++e) dsum += L[LQ + t * 64 + 16 * part + e] * L[LK + s * 64 + 16 * part + e];
        dsum = red4(dsum);
        const float bmt = t == 0 ? bm[0] : (t == 1 ? bm[1] : (t == 2 ? bm[2] : bm[3])), avs = s == 0 ? av[0] : (s == 1 ? av[1] : (s == 2 ? av[2] : av[3]));
        if (part == 0) L[LS + pair] = s <= t ? dsum * __expf(bmt + avs) : 0.f; }
    if (w == 1) { const int t = lane >> 4, part = lane & 15; float dsum = 0.f;
#pragma unroll
        for (int e = 0; e < 4; ++e) dsum += L[LQ + t * 64 + 4 * part + e] * n0[(size_t)(b * 8 + hh) * 64 + 4 * part + e];
        dsum = red16(dsum); if (part == 0) L[LQN + t] = dsum; }
    __syncthreads();
    const int v = tid >> 2, kq = tid & 3;
    float hvv[4];
    { const size_t coff = ((size_t)(b * 8 + hh) * 128 + v) * 64 + 16 * kq;
      float c0[16];
#pragma unroll
      for (int e4 = 0; e4 < 4; ++e4) { const f32x4 x = *(const f32x4*)(C0 + coff + 4 * e4); c0[4 * e4] = x.x; c0[4 * e4 + 1] = x.y; c0[4 * e4 + 2] = x.z; c0[4 * e4 + 3] = x.w; }
#pragma unroll
      for (int t = 0; t < 4; ++t) { float part = 0.f;
#pragma unroll
          for (int e = 0; e < 16; ++e) part += c0[e] * L[LQ + t * 64 + 16 * kq + e];
          const float inter = red4(part);
          float num = wi[t] * inter, den = wi[t] * L[LQN + t];
#pragma unroll
          for (int s = 0; s < 4; ++s) { const float sm = L[LS + t * 4 + s]; num += sm * L[LV + s * 128 + v]; den += sm; }
          hvv[t] = num / fmaxf(fabsf(den), ei[t]); }
#pragma unroll
      for (int t = 0; t < 4; ++t) { const float x = wave_sum(kq == 0 ? hvv[t] * hvv[t] : 0.f); if (lane == 0) L[LHS + w * 4 + t] = x; }
      float cn[16];
#pragma unroll
      for (int e = 0; e < 16; ++e) { float a = wst * c0[e];
#pragma unroll
          for (int s = 0; s < 4; ++s) a += wsv[s] * L[LV + s * 128 + v] * L[LK + s * 64 + 16 * kq + e];
          cn[e] = a; }
#pragma unroll
      for (int e4 = 0; e4 < 4; ++e4) *(f32x4*)(out + O_S_C + coff + 4 * e4) = (f32x4){cn[4 * e4], cn[4 * e4 + 1], cn[4 * e4 + 2], cn[4 * e4 + 3]}; }
    __syncthreads();
    if (kq == 0) {
#pragma unroll
        for (int t = 0; t < 4; ++t) { float tot = 0.f;
#pragma unroll
            for (int ww = 0; ww < 8; ++ww) tot += L[LHS + ww * 4 + t];
            const float sc = 1.0f / sqrtf(tot * (1.f / 128.f) + NORM_EPS); const size_t off = (size_t)(row0 + t) * D + hh * 128 + v;
            HOb[off] = f2bf1(hvv[t] * sc * norm_w[hh * 128 + v] * bf1(OOb[off])); } }
    if (tid < 64) { float a = wst * n0[(size_t)(b * 8 + hh) * 64 + tid];
#pragma unroll
        for (int s = 0; s < 4; ++s) a += wsv[s] * L[LK + s * 64 + tid];
        out[O_S_N + (size_t)(b * 8 + hh) * 64 + tid] = a; }
    if (tid == 0) out[O_S_M + b * 8 + hh] = m_new;
    __syncthreads();
}

constexpr int CA_AH = 0, CA_BH = 9216, CA_KH = 18432, CA_RH = 27648, CA_BT = 36864, CA_KT = 46080, CA_VT = 55296, CA_AB = 64512, CA_AK = 73728, CA_RB = 82944, CA_RK = 92160, CA_XT = 101376,
              CA_TD = 119808, CA_NF = 123904, CA_GL = 128000, CA_LG = CA_AB  , CA_AT = CA_KH  ;
__device__ __forceinline__ bf16x8 ldsfrag(LAS unsigned char* lds, int base, int row, int ks, int fq) { return *(const LAS bf16x8*)(lds + base + row * PBY + ks * 64 + fq * 16); }
__device__ __forceinline__ void rwkv_chunk_item(const Frame& F, int chain, int chunk, bf16* Rb, bf16* Kb, bf16* Vb, bf16* Db, bf16* Ab, bf16* Gb,
                                                const float* k_k, const float* k_a, const float* r_k, const float* gn_w, const float* gn_b, bf16* dummy, v4u (&pf)[6], const int nchain, const int nchunk) {
    LAS unsigned char* lds = F.lds;
    const int tid = F.tid, lane = F.lane, w = F.wave, fr = lane & 15, fq = lane >> 4, cg = tid & 7, tt = tid >> 3;
    const int h = chain & 15, row0 = (chain >> 4) * PT + 64 * chunk, ch = h * 64 + 8 * cg;
    const size_t goff = (size_t)(row0 + tt) * D + ch;
    LAS float* LG = (LAS float*)(lds + CA_LG); LAS float* GLf = (LAS float*)(lds + CA_GL);
    float r8[8], kp[8], av[8], bv[8], ld[8];
    {
        float k8[8], v8[8], d8[8], a8[8], g8[8];
        unpack8(pf[0], r8); unpack8(pf[1], k8); unpack8(pf[2], v8); unpack8(pf[3], d8); unpack8(pf[4], a8); unpack8(pf[5], g8);
        float ss = 0.f;
#pragma unroll
        for (int j = 0; j < 8; ++j) { av[j] = k8[j] * k_k[ch + j]; ss += av[j] * av[j]; }
        ss = red8(ss); const float inv = __builtin_amdgcn_rsqf(fmaxf(ss, 1e-24f));
        float bsum = 0.f;
#pragma unroll
        for (int j = 0; j < 8; ++j) { const float kk = av[j] * inv; kp[j] = k8[j] * (1.f + (a8[j] - 1.f) * k_a[ch + j]); bv[j] = kk * a8[j]; av[j] = -kk; bsum += r8[j] * kp[j] * r_k[ch + j]; ld[j] = __logf(1.f - d8[j]); }
        const float bon = red8(bsum);
        float og[8], ob[8];
#pragma unroll
        for (int j = 0; j < 8; ++j) { LG[(8 * cg + j) * 64 + tt] = ld[j]; ((lds_u16*)(lds + CA_VT))[(8 * cg + j) * 72 + tt] = f2bf1(v8[j]);
            og[j] = gn_w[ch + j] * g8[j]; ob[j] = (gn_b[ch + j] + bon * v8[j]) * g8[j]; }
        *(v4u*)((dummy ? dummy : Ab) + goff) = pack8(og); *(v4u*)((dummy ? dummy : Gb) + goff) = pack8(ob);
    }
    for (int i = tid; i < 128 * 36; i += 512) ((LAS unsigned*)(lds + CA_XT))[i] = 0u;
    __syncthreads();
    { float x[8];
#pragma unroll
      for (int q = 0; q < 8; ++q) x[q] = LG[(8 * w + q) * 64 + lane];
#pragma unroll
      for (int q = 0; q < 8; ++q) {
          float v = x[q];
          v += __builtin_bit_cast(float, __builtin_amdgcn_update_dpp(0, __builtin_bit_cast(int, v), 0x111, 0xF, 0xF, true));
          v += __builtin_bit_cast(float, __builtin_amdgcn_update_dpp(0, __builtin_bit_cast(int, v), 0x112, 0xF, 0xF, true));
          v += __builtin_bit_cast(float, __builtin_amdgcn_update_dpp(0, __builtin_bit_cast(int, v), 0x114, 0xF, 0xF, true));
          v += __builtin_bit_cast(float, __builtin_amdgcn_update_dpp(0, __builtin_bit_cast(int, v), 0x118, 0xF, 0xF, true));
          v += __builtin_bit_cast(float, __builtin_amdgcn_update_dpp(0, __builtin_bit_cast(int, v), 0x142, 0xA, 0xF, false));
          v += __builtin_bit_cast(float, __builtin_amdgcn_update_dpp(0, __builtin_bit_cast(int, v), 0x143, 0xC, 0xF, false));
          x[q] = v; }
#pragma unroll
      for (int q = 0; q < 8; ++q) LG[(8 * w + q) * 64 + lane] = x[q]; }
    __syncthreads();
    {
        float ah[8], bh[8], kh[8], rh[8];
#pragma unroll
        for (int j = 0; j < 8; ++j) { const float lg = LG[(8 * cg + j) * 64 + tt]; const float G = __expf(lg), Gm1 = __expf(lg - ld[j]), Gi = __expf(-lg);
            ah[j] = av[j] * Gm1; bh[j] = bv[j] * Gi; kh[j] = kp[j] * Gi; rh[j] = r8[j] * G;
            ((lds_u16*)(lds + CA_BT))[(8 * cg + j) * 72 + tt] = f2bf1(bh[j]); ((lds_u16*)(lds + CA_KT))[(8 * cg + j) * 72 + tt] = f2bf1(kh[j]);
            if (tt == 63) GLf[8 * cg + j] = G; }
        *(LAS v4u*)(lds + CA_AH + tt * PBY + 16 * cg) = pack8(ah); *(LAS v4u*)(lds + CA_BH + tt * PBY + 16 * cg) = pack8(bh);
        *(LAS v4u*)(lds + CA_KH + tt * PBY + 16 * cg) = pack8(kh); *(LAS v4u*)(lds + CA_RH + tt * PBY + 16 * cg) = pack8(rh);
    }
    __syncthreads();
    {
        const int mi = w >> 1, ti0 = 2 * (w & 1); const int abase = mi < 2 ? CA_AH : CA_RH, bbase = (mi & 1) ? CA_KH : CA_BH, dbase = CA_AB + mi * 9216;
        bf16x8 af[2][2], bfr[4][2];
#pragma unroll
        for (int a = 0; a < 2; ++a)
#pragma unroll
            for (int ks = 0; ks < 2; ++ks) af[a][ks] = ldsfrag(lds, abase, 16 * (ti0 + a) + fr, ks, fq);
#pragma unroll
        for (int sj = 0; sj < 4; ++sj)
#pragma unroll
            for (int ks = 0; ks < 2; ++ks) bfr[sj][ks] = ldsfrag(lds, bbase, 16 * sj + fr, ks, fq);
#pragma unroll
        for (int a = 0; a < 2; ++a)
#pragma unroll
            for (int sj = 0; sj < 4; ++sj) { const int ti = ti0 + a; f32x4 acc = {0.f, 0.f, 0.f, 0.f};
#pragma unroll
                for (int ks = 0; ks < 2; ++ks) acc = MFMA16(bfr[sj][ks], af[a][ks], acc);
                const int t = 16 * ti + fr;
#pragma unroll
                for (int r = 0; r < 4; ++r) { const int s = 16 * sj + 4 * fq + r; acc[r] = (mi < 2 ? s < t : s <= t) ? acc[r] : 0.f; }
                typedef unsigned u2v_ __attribute__((ext_vector_type(2))); u2v_ pw; pw.x = pkbf(acc[0], acc[1]); pw.y = pkbf(acc[2], acc[3]);
                *(LAS u2v_*)(lds + dbase + (t * 72 + 16 * sj + 4 * fq) * 2) = pw;
                if (mi == 0 && ti == sj) *(LAS f32x4*)(lds + CA_NF + (ti * 256 + fr * 16 + 4 * fq) * 4) = acc; }
    }
    __syncthreads();
    f32x4 rhs[4];
    if (w == 0) { const int blk = fq, c = fr; const LAS float* N = (const LAS float*)(lds + CA_NF) + blk * 256; float T[16];
#pragma unroll
        for (int i = 0; i < 16; ++i) { float s = (i == c) ? 1.f : 0.f;
#pragma unroll
            for (int j = 0; j < i; ++j) s += N[i * 16 + j] * T[j];
            T[i] = s; }
        lds_u16* td = (lds_u16*)(lds + CA_TD) + blk * 512;
#pragma unroll
        for (int i = 0; i < 16; ++i) { td[i * 32 + c] = f2bf1(T[i]); td[i * 32 + 16 + c] = 0; } }
    if (w < 4) {
#pragma unroll
        for (int i = 0; i < 4; ++i)
#pragma unroll
            for (int r = 0; r < 4; ++r) rhs[i][r] = bf1(((lds_u16*)(lds + CA_AH))[(16 * i + 4 * fq + r) * 72 + 16 * w + fr]);
    } else {
#pragma unroll
        for (int i = 0; i < 4; ++i) { f32x4 acc = {0.f, 0.f, 0.f, 0.f};
#pragma unroll
            for (int ks = 0; ks < 2; ++ks) acc = MFMA16(ldsfrag(lds, CA_AK, 16 * i + fr, ks, fq), ldsfrag(lds, CA_VT, 16 * (w - 4) + fr, ks, fq), acc);
            rhs[i] = acc; }
    }
    __syncthreads();
    {
        LAS unsigned char* AT = lds + CA_AT + w * 1024;
        *(LAS unsigned long long*)(AT + fr * 64 + 32 + fq * 8) = 0ull;
#pragma unroll
        for (int i = 0; i < 4; ++i) { f32x4 acc = rhs[i];
#pragma unroll
            for (int ks = 0; ks < 2; ++ks) acc = MFMA16(ldsfrag(lds, CA_AB, 16 * i + fr, ks, fq), ldsfrag(lds, CA_XT, 16 * w + fr, ks, fq), acc);
            typedef unsigned u2v __attribute__((ext_vector_type(2)));
            u2v pa; pa.x = pkbf(acc[0], acc[1]); pa.y = pkbf(acc[2], acc[3]);
            *(LAS u2v*)(AT + fr * 64 + fq * 8) = pa;
            asm volatile("s_waitcnt lgkmcnt(0)" ::: "memory");
            f32x4 xi = {0.f, 0.f, 0.f, 0.f};
            xi = MFMA16(*(const LAS bf16x8*)(lds + CA_TD + i * 1024 + fr * 64 + fq * 16), *(const LAS bf16x8*)(AT + fr * 64 + fq * 16), xi);
            u2v px; px.x = pkbf(xi[0], xi[1]); px.y = pkbf(xi[2], xi[3]);
            *(LAS u2v*)(lds + CA_XT + (16 * w + fr) * PBY + (16 * i + 4 * fq) * 2) = px;
            asm volatile("s_waitcnt lgkmcnt(0)" ::: "memory"); }
    }
    __syncthreads();
    if (nchain >= 0) { const size_t no = (size_t)((nchain >> 4) * PT + 64 * nchunk + tt) * D + (nchain & 15) * 64 + 8 * cg;
        pf[0] = *(const v4u*)(Rb + no); pf[1] = *(const v4u*)(Kb + no); pf[2] = *(const v4u*)(Vb + no); pf[3] = *(const v4u*)(Db + no); pf[4] = *(const v4u*)(Ab + no); pf[5] = *(const v4u*)(Gb + no); }
    {
        const int mi = w >> 1, ti0 = 2 * (w & 1); const int obase = mi == 0 ? CA_AB : (mi == 1 ? CA_AK : (mi == 2 ? CA_AH : CA_KH));
        const int a1 = mi < 2 ? CA_RB : (mi == 2 ? CA_BT : CA_XT), a1o = mi == 3 ? 64 : 0, b1 = mi == 3 ? CA_BT : CA_XT, b1o = mi == 1 ? 64 : 0;
        const int a2 = mi == 1 ? CA_RK : CA_VT, b2 = mi == 1 ? CA_VT : CA_KT; const bool two = (mi & 1) != 0;
        bf16x8 af[2][2], bfr[4][2];
#pragma unroll
        for (int a = 0; a < 2; ++a)
#pragma unroll
            for (int ks = 0; ks < 2; ++ks) af[a][ks] = ldsfrag(lds, a1, a1o + 16 * (ti0 + a) + fr, ks, fq);
#pragma unroll
        for (int tj = 0; tj < 4; ++tj)
#pragma unroll
            for (int ks = 0; ks < 2; ++ks) bfr[tj][ks] = ldsfrag(lds, b1, b1o + 16 * tj + fr, ks, fq);
        f32x4 acc[2][4];
#pragma unroll
        for (int a = 0; a < 2; ++a)
#pragma unroll
            for (int tj = 0; tj < 4; ++tj) { acc[a][tj] = (f32x4){0.f, 0.f, 0.f, 0.f};
#pragma unroll
                for (int ks = 0; ks < 2; ++ks) acc[a][tj] = MFMA16(bfr[tj][ks], af[a][ks], acc[a][tj]); }
        if (two) {
#pragma unroll
            for (int a = 0; a < 2; ++a)
#pragma unroll
                for (int ks = 0; ks < 2; ++ks) af[a][ks] = ldsfrag(lds, a2, 16 * (ti0 + a) + fr, ks, fq);
#pragma unroll
            for (int tj = 0; tj < 4; ++tj)
#pragma unroll
                for (int ks = 0; ks < 2; ++ks) bfr[tj][ks] = ldsfrag(lds, b2, 16 * tj + fr, ks, fq);
#pragma unroll
            for (int a = 0; a < 2; ++a)
#pragma unroll
                for (int tj = 0; tj < 4; ++tj)
#pragma unroll
                    for (int ks = 0; ks < 2; ++ks) acc[a][tj] = MFMA16(bfr[tj][ks], af[a][ks], acc[a][tj]);
        }
#pragma unroll
        for (int a = 0; a < 2; ++a) { const int row = 16 * (ti0 + a) + fr; const float glr = GLf[row];
#pragma unroll
            for (int tj = 0; tj < 4; ++tj) { const int col = 16 * tj + 4 * fq; f32x4 val = acc[a][tj];
                typedef unsigned u2v_ __attribute__((ext_vector_type(2)));
                if (mi == 0) { const u2v_ rr = *(const LAS u2v_*)(lds + CA_RH + (row * 72 + col) * 2); val += (f32x4){bflo(rr.x), bfhi(rr.x), bflo(rr.y), bfhi(rr.y)}; }
                else if (mi == 2) {
#pragma unroll
                    for (int r = 0; r < 4; ++r) val[r] = glr * (val[r] + (row == col + r ? 1.f : 0.f)); }
                else if (mi == 3) val = val * *(const LAS f32x4*)(GLf + col);
                u2v_ pw; pw.x = pkbf(val[0], val[1]); pw.y = pkbf(val[2], val[3]);
                *(LAS u2v_*)(lds + obase + (row * 72 + col) * 2) = pw; } }
    }
    __syncthreads();
    *(v4u*)((dummy ? dummy : Rb) + goff) = *(const LAS v4u*)(lds + CA_AB + tt * PBY + 16 * cg);
    *(v4u*)((dummy ? dummy : Vb) + goff) = *(const LAS v4u*)(lds + CA_AK + tt * PBY + 16 * cg);
    *(v4u*)((dummy ? dummy : Kb) + goff) = *(const LAS v4u*)(lds + CA_AH + tt * PBY + 16 * cg);
    *(v4u*)((dummy ? dummy : Db) + goff) = *(const LAS v4u*)(lds + CA_KH + tt * PBY + 16 * cg);
    __syncthreads();
}
constexpr int CB_S = 0, CB_P2 = 9216, CB_P3 = 18432, CB_Y0 = 27648, CB_Z0 = 36864, CB_YS = 46080  ;
__device__ __forceinline__ void rwkv_state_chain(const Frame& F, int chain, float* ST, const bf16* Rb, const bf16* Kb, const bf16* Vb, const bf16* Db, const bf16* Ab, bf16* Gb, bf16* dummy) {
    LAS unsigned char* lds = F.lds;
    const int tid = F.tid, lane = F.lane, w = F.wave, fr = lane & 15, fq = lane >> 4, cg = tid & 7, tt = tid >> 3;
    const int h = chain & 15, rowc0 = (chain >> 4) * PT, ch = h * 64 + 8 * cg;
    for (int i = tid; i < 64 * 36; i += 512) ((LAS unsigned*)(lds + CB_S))[i] = 0u;
    f32x4 Sacc[2];
    Sacc[0] = (f32x4){0.f, 0.f, 0.f, 0.f}; Sacc[1] = Sacc[0];
    v4u q2, q3, qy, qz, qg, qb;
#define CB_LOAD(cc) do { const size_t o_ = (size_t)(rowc0 + 64 * (cc) + tt) * D + ch; q2 = *(const v4u*)(Rb + o_); q3 = *(const v4u*)(Kb + o_); qy = *(const v4u*)(Vb + o_); qz = *(const v4u*)(Db + o_); \
        qg = *(const v4u*)(Ab + o_); qb = *(const v4u*)(Gb + o_); } while (0)
    CB_LOAD(0);
    for (int c = 0; c < PT / 64; ++c) {
        *(LAS v4u*)(lds + CB_P2 + tt * PBY + 16 * cg) = q2; *(LAS v4u*)(lds + CB_P3 + tt * PBY + 16 * cg) = q3;
        *(LAS v4u*)(lds + CB_Y0 + tt * PBY + 16 * cg) = qy; *(LAS v4u*)(lds + CB_Z0 + tt * PBY + 16 * cg) = qz;
        float gw[8], gb[8]; unpack8(qg, gw); unpack8(qb, gb);
        if (c + 1 < PT / 64) CB_LOAD(c + 1);
        __syncthreads();
        f32x4 yacc[2];
#pragma unroll
        for (int q = 0; q < 2; ++q) { const int tq = 2 * w + q, ti = tq >> 2, tj = tq & 3;
            f32x4 ya, sa;
#pragma unroll
            for (int r = 0; r < 4; ++r) { ya[r] = bf1(((lds_u16*)(lds + CB_Y0))[(16 * ti + 4 * fq + r) * 72 + 16 * tj + fr]); sa[r] = bf1(((lds_u16*)(lds + CB_Z0))[(16 * ti + 4 * fq + r) * 72 + 16 * tj + fr]); }
#pragma unroll
            for (int ks = 0; ks < 2; ++ks) { ya = MFMA16(ldsfrag(lds, CB_P2, 16 * ti + fr, ks, fq), ldsfrag(lds, CB_S, 16 * tj + fr, ks, fq), ya);
                                             sa = MFMA16(ldsfrag(lds, CB_S, 16 * ti + fr, ks, fq), ldsfrag(lds, CB_P3, 16 * tj + fr, ks, fq), sa); }
            yacc[q] = ya; Sacc[q] = sa; }
        __syncthreads();
#pragma unroll
        for (int q = 0; q < 2; ++q) { const int tq = 2 * w + q, ti = tq >> 2, tj = tq & 3;
#pragma unroll
            for (int r = 0; r < 4; ++r) { ((lds_u16*)(lds + CB_S))[(16 * ti + 4 * fq + r) * 72 + 16 * tj + fr] = f2bf1(Sacc[q][r]);
                                          ((LAS float*)(lds + CB_YS))[(16 * ti + 4 * fq + r) * 64 + 16 * tj + fr] = yacc[q][r]; } }
        __syncthreads();
        { const f32x4 y0 = *(const LAS f32x4*)(lds + CB_YS + (tt * 64 + 8 * cg) * 4), y1 = *(const LAS f32x4*)(lds + CB_YS + (tt * 64 + 8 * cg + 4) * 4);
          float yy[8] = {y0.x, y0.y, y0.z, y0.w, y1.x, y1.y, y1.z, y1.w}; float s1 = 0.f;
#pragma unroll
          for (int j = 0; j < 8; ++j) s1 += yy[j];
          const float mean = red8(s1) * (1.f / 64.f); float s2 = 0.f;
#pragma unroll
          for (int j = 0; j < 8; ++j) { yy[j] -= mean; s2 += yy[j] * yy[j]; }
          const float rstd = __builtin_amdgcn_rsqf(red8(s2) * (1.f / 64.f) + GN_EPS);
          float o[8];
#pragma unroll
          for (int j = 0; j < 8; ++j) o[j] = (yy[j] * rstd) * gw[j] + gb[j];
          *(v4u*)((dummy ? dummy : Gb) + (size_t)(rowc0 + 64 * c + tt) * D + ch) = pack8(o); }
    }
#undef CB_LOAD
#pragma unroll
    for (int q = 0; q < 2; ++q) { const int tq = 2 * w + q, ti = tq >> 2, tj = tq & 3;
#pragma unroll
        for (int r = 0; r < 4; ++r) ST[(16 * ti + 4 * fq + r) * 64 + 16 * tj + fr] = Sacc[q][r]; }
    __syncthreads();
}

#ifndef MK_N_LAUNCHES
#define MK_N_LAUNCHES 1
#endif
constexpr int N_PHASES = 22;
#ifndef PROBE_PH
#define PROBE_PH (-1)
#define PROBE_N 1
#endif
#ifndef PROBE_VAR
#define PROBE_VAR 0
#endif
#ifndef EN_MASK
#define EN_MASK 0xff
#endif
constexpr bool EN_NORM = EN_MASK & 1, EN_UP = EN_MASK & 2, EN_RES = EN_MASK & 4, EN_RW = EN_MASK & 8, EN_L2 = EN_MASK & 16, EN_SCAN = EN_MASK & 32, EN_IN = EN_MASK & 64, EN_ML = EN_MASK & 128;
struct Args { const float* in[N_IN]; float* out; unsigned char* ws; int ph_lo, ph_hi; };
__global__ void __launch_bounds__(NWAVES * 64, 2) mega_fwd(Args args) {
    extern __shared__ __attribute__((aligned(16))) unsigned char lds_raw[];
    { const int t0 = threadIdx.x;
      for (int u = t0; u < (LDS_BYTES - LDSCTL_OFF) / 4; u += NWAVES * 64) ((LAS unsigned*)((LAS unsigned char*)lds_raw + LDSCTL_OFF))[u] = 0u; }
    __syncthreads();
    { const int t0 = threadIdx.x; if (t0 < N_IN) ((LAS unsigned long long*)((LAS unsigned char*)lds_raw + TAB_OFF))[t0] = (unsigned long long)args.in[t0]; }
    __syncthreads();
    XcdBarrier bar; bar.bar = (unsigned*)((gu32*)(args.ws + WS_CTL) + CW_BAR); bar.x = 0; bar.st = nullptr;
    if (args.ph_hi - args.ph_lo > 1) bar = xcd_barrier_post((unsigned*)((gu32*)(args.ws + WS_CTL) + CW_BAR), (volatile LAS unsigned*)((LAS unsigned char*)lds_raw + MISC_OFF) + 8);
    int ph = args.ph_lo, rep = 0;
    while (ph < args.ph_hi) {
        int tid_ = threadIdx.x; asm volatile("" : "+v"(tid_));
        unsigned char* ws = args.ws; float* out = args.out;
        Frame F;
        F.lds = (LAS unsigned char*)lds_raw;
        F.MISC = (volatile LAS unsigned*)(F.lds + MISC_OFF);
        F.tid = tid_; F.lane = F.tid & 63; F.wave = __builtin_amdgcn_readfirstlane(F.tid >> 6);
        F.G = gridDim.x; { const int bx = blockIdx.x; F.vcu = (F.G % 8 == 0) ? (bx % 8) * (F.G / 8) + bx / 8 : bx; }
        F.ctl = (gu32*)(ws + WS_CTL); F.tab = (volatile LAS unsigned long long*)(F.lds + TAB_OFF);
        bf16* Wb = (bf16*)(ws + WS_W); float* XR = (float*)(ws + WS_XR); unsigned char* big = ws + WS_BIG;
        bf16* Hb = (bf16*)(big + B_H); bf16* XN = (bf16*)(big + B_XN); float* SLAB = (float*)(big + B_SLAB);
        bf16* ACAT = (bf16*)(big + B_ACAT); bf16* Rb = (bf16*)(big + B_R); bf16* Kb = (bf16*)(big + B_K); bf16* Vb = (bf16*)(big + B_V); bf16* DECb = (bf16*)(big + B_DEC); bf16* AAb = (bf16*)(big + B_AA);
        bf16* QKR = (bf16*)(big + B_QKR); bf16* VVb = (bf16*)(big + B_VV); bf16* HOb = (bf16*)(big + B_HO); bf16* OOb = (bf16*)(big + B_OO); float* IFb = (float*)(big + B_IF);
        bf16* GGb = (bf16*)((unsigned char*)out + OS_GG); bf16* LORA = (bf16*)((unsigned char*)out + OS_LORA);
        const int c_id = (int)blockIdx.x;
        const int nrep = (ph == PROBE_PH && ph != 6) ? PROBE_N : 1;
        const int pvar = (rep + 1 < nrep) ? PROBE_VAR : 0;
        if (EN_NORM && (ph == 0 || ph == 3 || ph == 8 || ph == 11 || ph == 14 || ph == 18 || ph == 21)) {
            int kind = 0, layer = 0, ab = 0, nslab = 0; float coef = 0.5f; const float* gain = nullptr;
            if (ph == 0) { kind = 0; layer = 0; ab = 0; gain = inptr(F, I_NFA); nslab = 0; }
            else if (ph == 3) { kind = 1; gain = inptr(F, I_NMIX); nslab = 11; }
            else if (ph == 8) { kind = 0; layer = 0; ab = 1; gain = inptr(F, I_NFB); nslab = 4; coef = 1.f; }
            else if (ph == 11) { kind = 0; layer = 1; ab = 0; gain = inptr(F, I_NFA) + D; nslab = 11; }
            else if (ph == 14) { kind = 2; gain = inptr(F, I_NMIX) + D; nslab = 11; }
            else if (ph == 18) { kind = -1; gain = inptr(F, I_NFB) + D; nslab = 4; coef = 1.f; }
            else { kind = -1; gain = inptr(F, I_NFIN); nslab = 11; }
            if (kind >= 0) convert_weights(F, kind, layer, ab, Wb);
            const float* base_p = ph == 0 ? inptr(F, I_XP) : XR; const float* base_s = (ph == 0 || ph == 3) ? inptr(F, I_XS) : XR + (size_t)MP * D;
            if (ph == 3) norm_rows<1>(F, base_p, base_s, nslab, coef, SLAB, XR, gain, ACAT, inptr(F, I_RSHIFT), out);
            else if (ph == 21) norm_rows<2>(F, base_p, base_s, nslab, coef, SLAB, XR, gain, nullptr, nullptr, out);
            else norm_rows<0>(F, base_p, base_s, nslab, coef, SLAB, XR, gain, XN, nullptr, out);
        } else if (EN_UP && (ph == 1 || ph == 9 || ph == 12 || ph == 19)) {
            const bf16* Wu = ph == 19 ? (const bf16*)(ws + WS_W2) : Wb;
            pg8::Gemm g{XN, Wu + W_GU / 2, M, 2 * FF, D}; pg8::UnitOrder S; S.init(M / 256, 2 * FF / 256, D, F.G, c_id, 0);
            EpiSwiglu E{Hb, pvar};
            pg8::gemm_phase<EpiSwiglu, pg8::UnitOrder, true, true>(F.lds, g, S, E, F.tid);
        } else if (EN_RES && (ph == 2 || ph == 7 || ph == 10 || ph == 13 || ph == 17 || ph == 20)) {
            const bf16* A = Hb; const bf16* Bt = (ph == 20 ? (const bf16*)(ws + WS_W2) : Wb) + W_D / 2; int K = FF; float coef = 0.5f; const float* base = XR;
            if (ph == 2) base = inptr(F, I_XP);
            if (ph == 7) { A = GGb; Bt = Wb + W_O / 2; K = D; coef = 1.f; }
            if (ph == 17) { A = HOb; Bt = Wb + W_OUT / 2; K = D; coef = 1.f; }
            pg8::Gemm g{A, Bt, M, D, K}; pg8::UnitOrder S; S.init(MP / 256, D / 256, K, F.G, c_id, K / 256);
            EpiRes E{base, XR, SLAB, coef};
            pg8::gemm_phase<EpiRes, pg8::UnitOrder, true, true>(F.lds, g, S, E, F.tid);
        } else if (EN_RW && ph == 4) {
            pg8::Gemm g{ACAT, Wb + W_RW / 2, M, NRW, KRW}; pg8::UnitOrder S; S.init(M / 256, NRW / 256, KRW, F.G, c_id, 0);
            EpiRw E{Rb, Kb, Vb, LORA};
            pg8::gemm_phase<EpiRw, pg8::UnitOrder, true, true>(F.lds, g, S, E, F.tid);
        } else if (EN_L2 && ph == 5) {
            pg8::Gemm g{LORA, Wb + W_L2 / 2, M, NL2, KL2}; pg8::UnitOrder S; S.init(M / 256, NL2 / 256, KL2, F.G, c_id, -1);
            EpiL2 E{DECb, AAb, GGb, inptr(F, I_W0), inptr(F, I_A0)};
            pg8::gemm_phase<EpiL2, pg8::UnitOrder, true, true>(F.lds, g, S, E, F.tid);
        } else if (EN_SCAN && ph == 6) {
            bf16* dummy = (bf16*)(ws + WS_YRAW);
            for (int dr = (PROBE_PH == 6 && PROBE_VAR == 5) ? PROBE_N - 1 : 0; dr >= 0; --dr) {
                v4u pf[6];
                { const int it = F.vcu, cg_ = F.tid & 7, tt_ = F.tid >> 3; const size_t o = (size_t)(((it >> 5) >> 4) * PT + 64 * (it & 31) + tt_) * D + ((it >> 5) & 15) * 64 + 8 * cg_;
                  pf[0] = *(const v4u*)(Rb + o); pf[1] = *(const v4u*)(Kb + o); pf[2] = *(const v4u*)(Vb + o); pf[3] = *(const v4u*)(DECb + o); pf[4] = *(const v4u*)(AAb + o); pf[5] = *(const v4u*)(GGb + o); }
                for (int it = F.vcu; it < PB * 16 * (PT / 64); it += F.G) { const int nx = it + F.G < PB * 16 * (PT / 64) ? it + F.G : -1;
                    rwkv_chunk_item(F, it >> 5, it & 31, Rb, Kb, Vb, DECb, AAb, GGb, inptr(F, I_KK), inptr(F, I_KA), inptr(F, I_RK), inptr(F, I_GNW), inptr(F, I_GNB), dr ? dummy : nullptr, pf, nx < 0 ? -1 : nx >> 5, nx & 31); }
            }
            xcd_barrier(bar);
            for (int dr = (PROBE_PH == 6 && PROBE_VAR == 6) ? PROBE_N - 1 : 0; dr >= 0; --dr)
                if (F.vcu < 128) rwkv_state_chain(F, F.vcu, out + O_P_S + (size_t)F.vcu * 4096, Rb, Kb, Vb, DECb, AAb, GGb, dr ? dummy : nullptr);
            { const int i0 = F.vcu < 128 ? 2 * F.vcu : 256 + 14 * (F.vcu - 128), i1 = F.vcu < 128 ? i0 + 2 : i0 + 14;
              for (int i = i0; i < i1; ++i) { const int b = i >> 4, h = i & 15;
                  rwkv_chain(F, MP + b * STK, STK, h, inptr(F, I_RS) + (size_t)i * 4096, out + O_S_S + (size_t)i * 4096, Rb, Kb, Vb, DECb, AAb, GGb, inptr(F, I_KK), inptr(F, I_KA), inptr(F, I_RK), inptr(F, I_GNW), inptr(F, I_GNB), true, 0); } }
        } else if (EN_IN && ph == 15) {
            pg8::Gemm g{XN, Wb + W_IN / 2, M, NIN, D}; pg8::UnitOrder S; S.init(M / 256, NIN / 256, D, F.G, c_id, 0);
            EpiIn E{QKR, VVb, OOb, IFb, inptr(F, I_BIF)};
            pg8::gemm_phase<EpiIn, pg8::UnitOrder, true, true>(F.lds, g, S, E, F.tid);
        } else if (EN_ML && ph == 16) {
            const int Hh = F.G >= 128 ? 64 : (F.G / 2 > 0 ? F.G / 2 : 1);
            if (F.vcu < Hh && pvar != 2) {
                for (int i = F.vcu; i < PB * 8; i += Hh) mlstm_prompt_chain(F, i >> 3, i & 7, QKR, VVb, OOb, IFb, HOb, inptr(F, I_CW), inptr(F, I_CB), inptr(F, I_MNW), out, pvar);
            }
            if ((F.vcu >= Hh || F.G == 1) && pvar != 1 && pvar < 3) {
                const int st = F.G == 1 ? 1 : F.G - Hh;
                for (int i = F.G == 1 ? 0 : F.vcu - Hh; i < SB * 8; i += st)
                    mlstm_sample_item(F, i >> 3, i & 7, QKR, VVb, OOb, IFb, HOb, inptr(F, I_CW), inptr(F, I_CB), inptr(F, I_MNW), inptr(F, I_MC), inptr(F, I_MN), inptr(F, I_MM), inptr(F, I_MCONV), out);
            }
            if (F.vcu >= Hh && F.G > Hh && rep + 1 == nrep) convert_weights(F, 0, 1, 1, (bf16*)(ws + WS_W2), Hh);
        }
        if (++rep < nrep) continue;
        rep = 0;
        if (ph + 1 < args.ph_hi) xcd_barrier(bar);
        ++ph;
    }
}

extern "C" void kernel_launch(void* const* d_in, const int* in_sizes, int n_in, void* d_out, int out_size, void* d_ws, size_t ws_size, hipStream_t stream) {
    static int grid = 0;
    if (grid == 0) {
        if (n_in != N_IN || out_size != (int)O_END || ws_size < WS_END2) { fprintf(stderr, "kernel_launch: unexpected shapes (n_in %d, out %d, ws %zu); nothing launched\n", n_in, out_size, ws_size); grid = -1; return; }
        int dev = 0, cus = 0, per_cu = 0;
        if (hipGetDevice(&dev) != hipSuccess || hipDeviceGetAttribute(&cus, hipDeviceAttributeMultiprocessorCount, dev) != hipSuccess) { grid = -1; return; }
        if (hipFuncSetAttribute((const void*)mega_fwd, hipFuncAttributeMaxDynamicSharedMemorySize, LDS_BYTES) != hipSuccess) { fprintf(stderr, "kernel_launch: hipFuncSetAttribute failed\n"); grid = -1; return; }
        if (hipOccupancyMaxActiveBlocksPerMultiprocessor(&per_cu, (const void*)mega_fwd, NWAVES * 64, LDS_BYTES) != hipSuccess || per_cu < 1) { fprintf(stderr, "kernel_launch: occupancy query says %d\n", per_cu); per_cu = 1; }
        (void)hipGetLastError();
        grid = cus;
    }
    if (grid < 0) return;
    (void)hipMemsetAsync((char*)d_ws + WS_CTL, 0, CTL_ZERO_BYTES, stream);
    Args a{};
    for (int i = 0; i < N_IN; ++i) a.in[i] = (const float*)d_in[i];
    a.out = (float*)d_out; a.ws = (unsigned char*)d_ws;
#if MK_N_LAUNCHES == 1
    a.ph_lo = 0; a.ph_hi = N_PHASES;
    { void* kargs[] = {(void*)&a};
      const hipError_t e = hipLaunchCooperativeKernel((const void*)mega_fwd, dim3(grid), dim3(NWAVES * 64), kargs, LDS_BYTES, stream);
      if (e != hipSuccess) fprintf(stderr, "kernel_launch: cooperative launch failed: %s (grid %d)\n", hipGetErrorString(e), grid); }
#else
    for (int p = 0; p < N_PHASES; ++p) { a.ph_lo = p; a.ph_hi = p + 1; hipLaunchKernelGGL(mega_fwd, dim3(grid), dim3(NWAVES * 64), LDS_BYTES, stream, a); }
#endif
}
```

```cpp
#include <hip/hip_runtime.h>
#include <cstdio>
#include <cstdint>
namespace pg8 {
#define PG8_LAS __attribute__((address_space(3)))
typedef unsigned short bf16_t;
typedef short bf16x8 __attribute__((ext_vector_type(8)));
typedef float f32x4 __attribute__((ext_vector_type(4)));
typedef unsigned u32x4 __attribute__((ext_vector_type(4)));
constexpr int BM = 256, BK = 64, HALF = 128, HTB = HALF * BK * 2  , STAGE_BYTES = 8 * HTB, NXCD = 8, WGM = 8;

__host__ __device__ __forceinline__ int lds_byte(int r, int c) { const int st = (r >> 4) * 2 + (c >> 5), rr = r & 15, cc = c & 31, ob = rr * 64 + cc * 2; return st * 1024 + (ob ^ (((ob >> 9) & 1) << 5)); }
__host__ __device__ __forceinline__ void stage_rc(int b, int& R, int& C) { const int st = b / 1024, sb = b % 1024, swz = sb ^ (((sb >> 9) & 1) << 5); R = (st >> 1) * 16 + swz / 64; C = (st & 1) * 32 + (swz % 64) / 2; }
__host__ __device__ __forceinline__ int perm32(int rho) { const int n = rho >> 4, i = rho & 15; return 8 * (i >> 2) + 4 * n + (i & 3); }

struct Unit { int pm, pn, k0, nt, slab; };
struct Gemm { const bf16_t* A; const bf16_t* Bt; int M, N, K; };

struct UnitOrder {
    int nM, nN, nwg, G, c, ntf, tailS;
    __device__ __forceinline__ void init(int nM_, int nN_, int K, int G_, int c_, int tailS_) { nM = nM_; nN = nN_; nwg = nM * nN; G = G_; c = c_; ntf = K / BK; tailS = tailS_; }
    __device__ __forceinline__ bool next(int i, Unit& u) const {
        long L = (long)i * G + c;
        if (L < nwg) {
            int wgid = (int)L; { const int q = nwg / NXCD, r = nwg % NXCD, xcd = wgid % NXCD, off = wgid / NXCD; wgid = (xcd < r ? xcd * (q + 1) : r * (q + 1) + (xcd - r) * q) + off; }
            const int nig = WGM * nN, gid = wgid / nig, fm = gid * WGM, gsz = (nM - fm) < WGM ? (nM - fm) : WGM;
            u.pm = fm + ((wgid % nig) % gsz); u.pn = (wgid % nig) / gsz; u.k0 = 0; u.nt = ntf; u.slab = -1;
            if (tailS < 0) { u.nt = 4; u.k0 = u.pn >= 8 ? 128 : 0; }
            return true;
        }
        L -= nwg; if (tailS <= 0 || L >= 8 * tailS) return false;
        int tile, sl; if (tailS == 4) { tile = (int)L >> 2; sl = (int)L & 3; } else { tile = (int)L / 11; sl = (int)L - 11 * tile; }
        u.pm = 64 + (tile >> 2); u.pn = tile & 3; u.k0 = sl * 256; u.nt = 4; u.slab = sl; return true;
    }
    __device__ __forceinline__ void a_ready(const Unit&) const {}
    __device__ __forceinline__ void done(const Unit&) const {}
};
template <class Epi, class Sched, bool ALIGN_EPI = false, bool SP2 = false>
__device__ __forceinline__ void gemm_phase(PG8_LAS unsigned char* lds, const Gemm g, const Sched& S, const Epi& E, const int tid) {
    const int wid = __builtin_amdgcn_readfirstlane(tid >> 6), lane = tid & 63, wr = wid >> 2, wc = wid & 3, fr = lane & 15, fq = lane >> 4;
    const int K = g.K;
    unsigned voffA[2], voffB[2];
#pragma unroll
    for (int i = 0; i < 2; ++i) { int R, C; stage_rc(tid * 16 + i * 8192, R, C); const int Rb = Epi::PERM ? ((R & ~31) + perm32(R & 31)) : R;
        voffA[i] = (unsigned)(R * K + C) * 2u; voffB[i] = (unsigned)(Rb * K + C) * 2u; }
    const size_t kstep = (size_t)(BK * 2);
    const size_t hstep = (size_t)HALF * K * 2;
    const size_t tstep = 2 * hstep;
    const unsigned ldsw = (unsigned)wid * 1024u;
    const int aoff = lds_byte(wr * 64 + fr, fq * 8), boff = lds_byte(wc * 32 + fr, fq * 8);
#define PG8_SA(b, h) (((b) * 2 + (h)) * HTB)
#define PG8_SB(b, h) ((4 + (b) * 2 + (h)) * HTB)
#define PG8_STAGE(bufoff, gbase, voff) do { _Pragma("unroll") for (int _i = 0; _i < 2; ++_i) \
        __builtin_amdgcn_global_load_lds((const unsigned*)((const char*)(gbase) + (voff)[_i]), (PG8_LAS unsigned*)(lds + (bufoff) + ldsw + _i * 8192), 16, 0, 0); } while (0)
#define PG8_LDA(dst, b, h) do { _Pragma("unroll") for (int m = 0; m < 4; ++m) _Pragma("unroll") for (int k = 0; k < 2; ++k) dst[m][k] = *(const PG8_LAS bf16x8*)(lds + PG8_SA(b, h) + aoff + m * 2048 + k * 1024); } while (0)
#define PG8_LDB(dst, b, h) do { _Pragma("unroll") for (int n = 0; n < 2; ++n) _Pragma("unroll") for (int k = 0; k < 2; ++k) dst[n][k] = *(const PG8_LAS bf16x8*)(lds + PG8_SB(b, h) + boff + n * 2048 + k * 1024); } while (0)
#define PG8_MMA(ai, bj, At, Bt) do { __builtin_amdgcn_s_setprio(1); _Pragma("unroll") for (int m = 0; m < 4; ++m) _Pragma("unroll") for (int n = 0; n < 2; ++n) _Pragma("unroll") for (int k = 0; k < 2; ++k) \
        acc[ai][bj][m][n] = __builtin_amdgcn_mfma_f32_16x16x32_bf16(Bt[n][k], At[m][k], acc[ai][bj][m][n], 0, 0, 0); __builtin_amdgcn_s_setprio(0); } while (0)
#define PG8_WAIT_V(n) asm volatile("s_waitcnt vmcnt(" #n ")" ::: "memory")
#define PG8_WAIT_L(n) asm volatile("s_waitcnt lgkmcnt(" #n ")" ::: "memory")
#define PG8_BAR __builtin_amdgcn_s_barrier()
#define PG8_SCHED __builtin_amdgcn_sched_barrier(0)
    Unit cur, nxt; int ui = 0;
    if (!S.next(0, cur)) return;
    f32x4 acc[2][2][4][2];
#pragma unroll
    for (int a = 0; a < 2; ++a)
#pragma unroll
        for (int b = 0; b < 2; ++b)
#pragma unroll
            for (int m = 0; m < 4; ++m)
#pragma unroll
                for (int n = 0; n < 2; ++n) acc[a][b][m][n] = (f32x4){0.f, 0.f, 0.f, 0.f};
    bf16x8 At[4][2], B0[2][2], B1[2][2];
    const char* cA = (const char*)g.A + (size_t)cur.pm * tstep + (size_t)cur.k0 * 2; const char* cB = (const char*)g.Bt + (size_t)cur.pn * tstep + (size_t)cur.k0 * 2;
    S.a_ready(cur);
    if constexpr (SP2) {
        PG8_STAGE(PG8_SB(0, 0), cB, voffB); PG8_STAGE(PG8_SB(0, 1), cB + hstep, voffB); PG8_STAGE(PG8_SA(0, 0), cA, voffA); PG8_STAGE(PG8_SA(0, 1), cA + hstep, voffA);
        if (wr == 1) PG8_BAR;
        PG8_WAIT_V(2); PG8_BAR;
        PG8_STAGE(PG8_SB(1, 0), cB + kstep, voffB); PG8_STAGE(PG8_SA(1, 0), cA + kstep, voffA); PG8_STAGE(PG8_SB(1, 1), cB + hstep + kstep, voffB);
        PG8_WAIT_V(6); PG8_BAR;
    } else {
        PG8_STAGE(PG8_SB(0, 0), cB, voffB); PG8_STAGE(PG8_SA(0, 0), cA, voffA); PG8_STAGE(PG8_SB(0, 1), cB + hstep, voffB); PG8_STAGE(PG8_SA(0, 1), cA + hstep, voffA);
        if (wr == 1) PG8_BAR;
        PG8_WAIT_V(4); PG8_BAR;
        PG8_STAGE(PG8_SB(1, 0), cB + kstep, voffB); PG8_STAGE(PG8_SA(1, 0), cA + kstep, voffA); PG8_STAGE(PG8_SB(1, 1), cB + hstep + kstep, voffB);
        PG8_WAIT_V(6); PG8_BAR;
    }
    for (;;) {
        const bool has_next = S.next(ui + 1, nxt);
        const char* nA = has_next ? (const char*)g.A + (size_t)nxt.pm * tstep + (size_t)nxt.k0 * 2 : cA; const char* nB = has_next ? (const char*)g.Bt + (size_t)nxt.pn * tstep + (size_t)nxt.k0 * 2 : cB;
        const int nt = cur.nt;
        for (int t = 0; t < nt; t += 2) {
            const bool last = (t == nt - 2);
            const char* a1 = cA + (size_t)(t + 1) * kstep;
            const char* a2 = last ? nA : cA + (size_t)(t + 2) * kstep; const char* b2 = last ? nB : cB + (size_t)(t + 2) * kstep;
            const char* a3 = a2 + kstep; const char* b3 = b2 + kstep;
            if (last && has_next) S.a_ready(nxt);
            if constexpr (SP2) {
            PG8_LDB(B0, 0, 0); PG8_LDB(B1, 0, 1); PG8_SCHED; PG8_LDA(At, 0, 0); PG8_STAGE(PG8_SA(1, 1), a1 + hstep, voffA);
            PG8_WAIT_V(8); PG8_WAIT_L(0); PG8_BAR; PG8_MMA(0, 0, At, B0); PG8_MMA(0, 1, At, B1); PG8_BAR; PG8_SCHED;
            PG8_LDA(At, 0, 1); PG8_STAGE(PG8_SB(0, 0), b2, voffB); PG8_STAGE(PG8_SB(0, 1), b2 + hstep, voffB); PG8_STAGE(PG8_SA(0, 0), a2, voffA);
            PG8_WAIT_V(8); PG8_WAIT_L(0); PG8_BAR; PG8_MMA(1, 0, At, B0); PG8_MMA(1, 1, At, B1); PG8_BAR; PG8_SCHED;
            PG8_LDB(B0, 1, 0); PG8_LDB(B1, 1, 1); PG8_SCHED; PG8_LDA(At, 1, 0); PG8_STAGE(PG8_SA(0, 1), a2 + hstep, voffA);
            PG8_WAIT_V(8); PG8_WAIT_L(0); PG8_BAR; PG8_MMA(0, 0, At, B0); PG8_MMA(0, 1, At, B1); PG8_BAR; PG8_SCHED;
            PG8_LDA(At, 1, 1); PG8_STAGE(PG8_SB(1, 0), b3, voffB); PG8_STAGE(PG8_SB(1, 1), b3 + hstep, voffB); PG8_STAGE(PG8_SA(1, 0), a3, voffA);
            PG8_WAIT_V(8); PG8_WAIT_L(0); PG8_BAR; PG8_MMA(1, 0, At, B0); PG8_MMA(1, 1, At, B1); PG8_BAR; PG8_SCHED;
            } else {
            PG8_LDB(B0, 0, 0); PG8_SCHED; PG8_LDA(At, 0, 0); PG8_STAGE(PG8_SA(1, 1), a1 + hstep, voffA);
            PG8_WAIT_L(8); PG8_BAR; PG8_WAIT_L(0); PG8_MMA(0, 0, At, B0); PG8_BAR; PG8_SCHED;
            PG8_LDB(B1, 0, 1); PG8_STAGE(PG8_SB(0, 0), b2, voffB);
            PG8_BAR; PG8_WAIT_L(0); PG8_MMA(0, 1, At, B1); PG8_BAR;
            PG8_LDA(At, 0, 1); PG8_STAGE(PG8_SA(0, 0), a2, voffA);
            PG8_BAR; PG8_WAIT_L(0); PG8_MMA(1, 0, At, B0); PG8_BAR; PG8_SCHED;
            PG8_STAGE(PG8_SB(0, 1), b2 + hstep, voffB);
            PG8_WAIT_V(6); PG8_BAR; PG8_MMA(1, 1, At, B1); PG8_BAR;
            PG8_LDB(B0, 1, 0); PG8_SCHED; PG8_LDA(At, 1, 0); PG8_STAGE(PG8_SA(0, 1), a2 + hstep, voffA);
            PG8_WAIT_L(8); PG8_BAR; PG8_WAIT_L(0); PG8_MMA(0, 0, At, B0); PG8_BAR; PG8_SCHED;
            PG8_LDB(B1, 1, 1); PG8_STAGE(PG8_SB(1, 0), b3, voffB);
            PG8_BAR; PG8_WAIT_L(0); PG8_MMA(0, 1, At, B1); PG8_BAR;
            PG8_LDA(At, 1, 1); PG8_STAGE(PG8_SA(1, 0), a3, voffA);
            PG8_BAR; PG8_WAIT_L(0); PG8_MMA(1, 0, At, B0); PG8_BAR; PG8_SCHED;
            PG8_STAGE(PG8_SB(1, 1), b3 + hstep, voffB);
            PG8_WAIT_V(6); PG8_BAR; PG8_MMA(1, 1, At, B1); PG8_BAR;
            }
        }
        if constexpr (ALIGN_EPI) { if (wr == 0) PG8_BAR; }
        if constexpr (!Epi::AFTER_DRAIN) { E(acc, cur, wr, wc, fr, fq); S.done(cur); }
        if (!has_next) break;
#pragma unroll
        for (int a = 0; a < 2; ++a)
#pragma unroll
            for (int b = 0; b < 2; ++b)
#pragma unroll
                for (int m = 0; m < 4; ++m)
#pragma unroll
                    for (int n = 0; n < 2; ++n) acc[a][b][m][n] = (f32x4){0.f, 0.f, 0.f, 0.f};
        cur = nxt; cA = nA; cB = nB; ++ui;
        if constexpr (ALIGN_EPI) { if (wr == 1) PG8_BAR; }
    }
    PG8_WAIT_V(0);
    if constexpr (!ALIGN_EPI) { if (wr == 0) PG8_BAR; }
    PG8_BAR;
    if constexpr (Epi::AFTER_DRAIN) { E.fused(acc, cur, wr, wc, fr, fq, lds, wid, lane); S.done(cur); }
#undef PG8_SA
#undef PG8_SB
#undef PG8_STAGE
#undef PG8_LDA
#undef PG8_LDB
#undef PG8_MMA
#undef PG8_WAIT_V
#undef PG8_WAIT_L
#undef PG8_BAR
#undef PG8_SCHED
}
}

#define GAS __attribute__((address_space(1)))
#define LAS __attribute__((address_space(3)))
typedef unsigned short bf16;
typedef unsigned v4u __attribute__((ext_vector_type(4)));
typedef float f32x4 __attribute__((ext_vector_type(4)));
typedef short bf16x8 __attribute__((ext_vector_type(8)));
typedef GAS unsigned gu32;
typedef GAS unsigned long long gu64;
#define RLX_AGENT __ATOMIC_RELAXED, __HIP_MEMORY_SCOPE_AGENT
#define LDS_WAIT() asm volatile("s_waitcnt lgkmcnt(0)" ::: "memory")
#define VM_WAIT() asm volatile("s_waitcnt vmcnt(0)" ::: "memory")
__device__ __forceinline__ unsigned long long rt() { return __builtin_amdgcn_s_memrealtime(); }
__device__ __forceinline__ unsigned f2bf(float f) { unsigned u = __builtin_bit_cast(unsigned, f); return (u + 0x7fffu + ((u >> 16) & 1u)) >> 16; }
__device__ __forceinline__ unsigned pk2(float lo, float hi) { return f2bf(lo) | (f2bf(hi) << 16); }

#define XB_TMO      128
#define XB_XCNT(j)  (256  + 64 * (j))
#define XB_XSUB(j)  (1280 + 64 * (j))
#define XB_XGEN(j)  (2304 + 64 * (j))
#define XB_TOP      3328
#define XB_TOPGEN   3392
#define XCD_BAR_WORDS 3456
#define XB_SPIN_CAP (1u << 18)

__device__ __forceinline__ unsigned xb_ld(unsigned* p)              { return __hip_atomic_load(p, __ATOMIC_RELAXED, __HIP_MEMORY_SCOPE_AGENT); }
__device__ __forceinline__ unsigned xb_add(unsigned* p, unsigned v) { return __hip_atomic_fetch_add(p, v, __ATOMIC_RELAXED, __HIP_MEMORY_SCOPE_AGENT); }
__device__ __forceinline__ unsigned xb_xcc_id() { return (unsigned)__builtin_amdgcn_s_getreg((3 << 11) | 20) & 0xFu; }
#define XB_SPIN(cond, bar) do { unsigned _sp = 0; while (cond) { __builtin_amdgcn_s_sleep(1); \
    if ((++_sp & 255u) == 0u) { if (xb_ld(&(bar)[XB_TMO])) break; if (_sp > XB_SPIN_CAP) { atomicAdd(&(bar)[XB_TMO], 1u); break; } } } } while (0)

struct XcdBarrier {
    unsigned* bar; unsigned x;
    volatile LAS unsigned* st;
};

__device__ __forceinline__ XcdBarrier xcd_barrier_post(unsigned* bar, volatile LAS unsigned* st) {
    XcdBarrier b; b.bar = bar; b.x = xb_xcc_id(); b.st = st;
    if (threadIdx.x == 0) (void)xb_add(&bar[XB_XCNT(b.x)], 1u);
    return b;
}
__device__ __forceinline__ void xcd_barrier_complete(unsigned* bar, unsigned x, unsigned& nloc, unsigned& nx) {
    const unsigned G = gridDim.x * gridDim.y * gridDim.z;
    unsigned sum, cnt, mine, sp = 0u;
    for (;;) {
        sum = 0u; cnt = 0u; mine = 0u;
#pragma unroll
        for (unsigned j = 0; j < 16; ++j) { const unsigned c = xb_ld(&bar[XB_XCNT(j)]); sum += c; cnt += (c > 0u) ? 1u : 0u; mine = (j == x) ? c : mine; }
        if (sum == G) break;
        __builtin_amdgcn_s_sleep(1);
        if ((++sp & 255u) == 0u) { if (xb_ld(&bar[XB_TMO])) break; if (sp > XB_SPIN_CAP) { atomicAdd(&bar[XB_TMO], 1u); break; } }
    }
    nloc = mine > 0u ? mine : 1u; nx = cnt > 0u ? cnt : 1u;
}

__device__ __forceinline__ void xcd_barrier(const XcdBarrier& b) {
    asm volatile("s_waitcnt vmcnt(0)" ::: "memory");
    __syncthreads();
    if (threadIdx.x == 0) {
        unsigned* bar = b.bar;
        __builtin_amdgcn_s_waitcnt(0);
        unsigned nloc = b.st[0], nx = b.st[1];
        if (nloc == 0u) { xcd_barrier_complete(bar, b.x, nloc, nx); b.st[0] = nloc; b.st[1] = nx; }
        const unsigned old = xb_add(&bar[XB_XSUB(b.x)], 1u);
        const unsigned gen = old / nloc;
        if (old + 1u == (gen + 1u) * nloc) {
            __builtin_amdgcn_fence(__ATOMIC_RELEASE, "agent");
            asm volatile("s_waitcnt vmcnt(0)" ::: "memory");
            const unsigned og = xb_add(&bar[XB_TOP], 1u);
            const unsigned tg = og / nx;
            if (og + 1u == (tg + 1u) * nx) xb_add(&bar[XB_TOPGEN], 1u);
            else XB_SPIN(xb_ld(&bar[XB_TOPGEN]) == tg, bar);
            __builtin_amdgcn_fence(__ATOMIC_ACQUIRE, "agent");
            xb_add(&bar[XB_XGEN(b.x)], 1u);
            asm volatile("s_waitcnt vmcnt(0)" ::: "memory");
        } else {
            XB_SPIN(xb_ld(&bar[XB_XGEN(b.x)]) == gen, bar);
            __builtin_amdgcn_fence(__ATOMIC_ACQUIRE, "agent");
            asm volatile("s_waitcnt vmcnt(0)" ::: "memory");
        }
    }
    __syncthreads();
}

constexpr int NWAVES = 8;
constexpr int D = 1024, FF = 2816;
constexpr int PB = 8, PT = 2048, SB = 128, STK = 4;
constexpr int MP = PB * PT, MS = SB * STK, M = MP + MS;
constexpr int NRW = 3584, KRW = 2048, NL2 = 3072, KL2 = 384, NIN = 3328;
constexpr float NORM_EPS = 1e-6f, GN_EPS = 64e-5f;
typedef pg8::bf16_t bf16;

constexpr size_t MiB = 1u << 20;
constexpr size_t WS_CTL = 0, CTL_ZERO_BYTES = 64 * 1024;
constexpr size_t WS_W = 1 * MiB;
constexpr size_t WS_XR = 20 * MiB;
constexpr size_t WS_BIG = 86 * MiB;
constexpr size_t WS_END = 256 * MiB;
constexpr size_t WS_YRAW = 256 * MiB, WS_BON = 288 * MiB, WS_W2 = 289 * MiB  , WS_END2 = 308 * MiB;
constexpr size_t W_GU = 0, W_D = (size_t)2 * FF * D * 2;
constexpr size_t W_RW = 0, W_L2 = (size_t)NRW * KRW * 2, W_O = W_L2 + (size_t)NL2 * KL2 * 2;
constexpr size_t W_IN = 0, W_OUT = (size_t)NIN * D * 2;
static_assert(W_D + (size_t)D * FF * 2 <= 19 * MiB && W_O + (size_t)D * D * 2 <= 19 * MiB && W_OUT + (size_t)D * D * 2 <= 19 * MiB, "weights region");
constexpr size_t B_H = 0, B_XN = 91 * MiB, B_SLAB = 124 * MiB;
constexpr size_t B_ACAT = 0, B_R = 66 * MiB, B_K = 99 * MiB, B_V = 132 * MiB, B_DEC = 0, B_AA = 33 * MiB;
constexpr size_t B_QKR = 0, B_VV = 33 * MiB, B_HO = 66 * MiB, B_OO = 124 * MiB, B_IF = 157 * MiB;
static_assert((size_t)M * FF * 2 <= 91 * MiB && (size_t)M * D * 2 == 33 * MiB && B_IF + (size_t)M * 16 * 4 <= 170 * MiB && B_SLAB + (size_t)11 * MS * D * 4 <= 170 * MiB, "BIG map");
constexpr size_t OS_GG = 0, OS_LORA = 33 * MiB;
static_assert(OS_LORA + (size_t)M * KL2 * 2 <= (size_t)MP * D * 4, "d_out scratch");
constexpr size_t O_Y = 0, O_P_S = 17301504, O_P_SHIFT = 17825792, O_P_C = 17833984, O_P_N = 18358272, O_P_M = 18362368, O_P_CONV = 18362432,
                 O_S_S = 18387008, O_S_SHIFT = 26775616, O_S_C = 26906688, O_S_N = 35295296, O_S_M = 35360832, O_S_CONV = 35361856, O_END = 35755072;
constexpr int CW_BAR = 1024;

constexpr int RING_BYTES = 131072, LDSCTL_OFF = RING_BYTES, MISC_OFF = LDSCTL_OFF + 320, TAB_OFF = LDSCTL_OFF + 1024, LDS_BYTES = 147456;

enum { I_XP = 0, I_XS, I_RS, I_RSHIFT, I_MC, I_MN, I_MM, I_MCONV, I_NFA, I_FAWG, I_FAWU, I_FAWD, I_NMIX, I_NFB, I_FBWG, I_FBWU, I_FBWD,
       I_MU, I_WR, I_WK, I_WV, I_WO, I_W0, I_W1, I_W2, I_A0, I_A1, I_A2, I_G1, I_G2, I_KK, I_KA, I_RK, I_GNW, I_GNB,
       I_WIN, I_BIF, I_CW, I_CB, I_MNW, I_WOUT, I_NFIN, N_IN };

typedef __bf16 bf16x2_t __attribute__((ext_vector_type(2)));
typedef float f32x2_t __attribute__((ext_vector_type(2)));
__device__ __forceinline__ unsigned pkbf(float lo, float hi) { f32x2_t v = {lo, hi}; bf16x2_t b = __builtin_convertvector(v, bf16x2_t); return __builtin_bit_cast(unsigned, b); }
__device__ __forceinline__ float bflo(unsigned u) { return __builtin_bit_cast(float, u << 16); }
__device__ __forceinline__ float bfhi(unsigned u) { return __builtin_bit_cast(float, u & 0xffff0000u); }
__device__ __forceinline__ float bf1(unsigned short u) { return __builtin_bit_cast(float, (unsigned)u << 16); }
__device__ __forceinline__ unsigned short f2bf1(float f) { return (unsigned short)(pkbf(f, 0.f) & 0xffffu); }
__device__ __forceinline__ void unpack8(v4u w, float (&o)[8]) { o[0] = bflo(w.x); o[1] = bfhi(w.x); o[2] = bflo(w.y); o[3] = bfhi(w.y); o[4] = bflo(w.z); o[5] = bfhi(w.z); o[6] = bflo(w.w); o[7] = bfhi(w.w); }
__device__ __forceinline__ v4u pack8(const float (&o)[8]) { v4u w; w.x = pkbf(o[0], o[1]); w.y = pkbf(o[2], o[3]); w.z = pkbf(o[4], o[5]); w.w = pkbf(o[6], o[7]); return w; }
__device__ __forceinline__ float sigmoidf_(float x) { return __builtin_amdgcn_rcpf(1.f + __expf(-x)); }
__device__ __forceinline__ float siluf_(float x) { return x * __builtin_amdgcn_rcpf(1.f + __expf(-x)); }
__device__ __forceinline__ float tanhf_(float x) { return 1.f - 2.f * __builtin_amdgcn_rcpf(__expf(2.f * x) + 1.f); }
__device__ __forceinline__ float logsigmoidf_(float x) { return fminf(x, 0.f) - log1pf(__expf(-fabsf(x))); }
template <int CTRL> __device__ __forceinline__ float dppf(float x) { return __builtin_bit_cast(float, __builtin_amdgcn_update_dpp(0, __builtin_bit_cast(int, x), CTRL, 0xF, 0xF, true)); }
__device__ __forceinline__ float red4(float x) { x += dppf<0xB1>(x); x += dppf<0x4E>(x); return x; }
__device__ __forceinline__ float red8(float x) { x = red4(x); x += dppf<0x141>(x); return x; }
__device__ __forceinline__ float red16(float x) { x = red8(x); x += dppf<0x140>(x); return x; }
__device__ __forceinline__ float wave_sum(float v) {
#pragma unroll
    for (int o = 1; o < 64; o <<= 1) v += __shfl_xor(v, o);
    return v;
}

struct Frame {
    LAS unsigned char* lds;
    volatile LAS unsigned* MISC;
    gu32* ctl;
    volatile LAS unsigned long long* tab;
    int tid, lane, wave, vcu, G;
};
__device__ __forceinline__ const float* inptr(const Frame& F, int i) { const unsigned long long v = F.tab[i];
    const unsigned lo = __builtin_amdgcn_readfirstlane((unsigned)v), hi = __builtin_amdgcn_readfirstlane((unsigned)(v >> 32)); return (const float*)(const GAS float*)(((unsigned long long)hi << 32) | lo); }

using pg8::Unit; using pg8::BM; using pg8::HALF;
__device__ __forceinline__ void st8bf(bf16* p, f32x4 v0, f32x4 v1) { v4u w; w.x = pkbf(v0[0], v0[1]); w.y = pkbf(v0[2], v0[3]); w.z = pkbf(v1[0], v1[1]); w.w = pkbf(v1[2], v1[3]); *(v4u*)p = w; }

struct EpiSwiglu {
    static constexpr bool PERM = true, AFTER_DRAIN = false;
    bf16* H; int pvar;
    __device__ __forceinline__ void operator()(const f32x4 (&acc)[2][2][4][2], const Unit& u, int wr, int wc, int fr, int fq) const {
        if (pvar == 3) return;
        const int row0 = u.pm * BM + wr * 64 + fr, col0 = u.pn * 128 + wc * 32 + 8 * fq;
#pragma unroll
        for (int ai = 0; ai < 2; ++ai)
#pragma unroll
            for (int m = 0; m < 4; ++m) {
                f32x4 o[2];
#pragma unroll
                for (int n = 0; n < 2; ++n)
#pragma unroll
                    for (int i = 0; i < 4; ++i) { const float g = acc[ai][0][m][n][i], up = acc[ai][1][m][n][i]; o[n][i] = siluf_(g) * up; }
                st8bf(H + (size_t)(row0 + ai * HALF + m * 16) * FF + col0, o[0], o[1]);
            }
    }
};
struct EpiRes {
    static constexpr bool PERM = false, AFTER_DRAIN = false;
    const float* base; float* out; float* slab; float coef;
    __device__ __forceinline__ void operator()(const f32x4 (&acc)[2][2][4][2], const Unit& u, int wr, int wc, int fr, int fq) const {
        const int row0 = u.pm * BM + wr * 64 + fr, col0 = u.pn * BM + wc * 32 + 4 * fq;
        if (u.slab < 0) {
#pragma unroll
            for (int ai = 0; ai < 2; ++ai)
#pragma unroll
                for (int m = 0; m < 4; ++m) { const size_t ro = (size_t)(row0 + ai * HALF + m * 16) * D + col0;
#pragma unroll
                    for (int bj = 0; bj < 2; ++bj)
#pragma unroll
                        for (int n = 0; n < 2; ++n) { const f32x4 b = *(const f32x4*)(base + ro + bj * HALF + n * 16); *(f32x4*)(out + ro + bj * HALF + n * 16) = b + acc[ai][bj][m][n] * coef; } }
        } else {
            float* sl = slab + (size_t)u.slab * MS * D;
#pragma unroll
            for (int ai = 0; ai < 2; ++ai)
#pragma unroll
                for (int m = 0; m < 4; ++m) { const size_t ro = (size_t)(row0 + ai * HALF + m * 16 - MP) * D + col0;
#pragma unroll
                    for (int bj = 0; bj < 2; ++bj)
#pragma unroll
                        for (int n = 0; n < 2; ++n) *(f32x4*)(sl + ro + bj * HALF + n * 16) = acc[ai][bj][m][n]; }
        }
    }
};
struct EpiRw {
    static constexpr bool PERM = true, AFTER_DRAIN = false;
    bf16 *R, *K, *V, *L;
    __device__ __forceinline__ void operator()(const f32x4 (&acc)[2][2][4][2], const Unit& u, int wr, int wc, int fr, int fq) const {
        const int row0 = u.pm * BM + wr * 64 + fr;
        if (u.pn < 12) {
            bf16 *p0 = R, *p1 = K, *p2 = V; asm volatile("" : "+s"(p0), "+s"(p1), "+s"(p2));
            bf16* dst = u.pn < 4 ? p0 : (u.pn < 8 ? p1 : p2); const int col0 = (u.pn & 3) * BM + wc * 32 + 8 * fq;
#pragma unroll
            for (int ai = 0; ai < 2; ++ai)
#pragma unroll
                for (int m = 0; m < 4; ++m) { bf16* rp = dst + (size_t)(row0 + ai * HALF + m * 16) * D + col0;
#pragma unroll
                    for (int bj = 0; bj < 2; ++bj) st8bf(rp + bj * HALF, acc[ai][bj][m][0], acc[ai][bj][m][1]); }
        } else {
#pragma unroll
            for (int bj = 0; bj < 2; ++bj) {
                const int lc = (u.pn - 12) * BM + bj * HALF + wc * 32 + 8 * fq;
                if (lc >= KL2) continue;
                const int act = lc < 64 ? 1 : (lc < 128 ? 0 : (lc < 288 ? 2 : 3));
#pragma unroll
                for (int ai = 0; ai < 2; ++ai)
#pragma unroll
                    for (int m = 0; m < 4; ++m) {
                        f32x4 o[2];
#pragma unroll
                        for (int n = 0; n < 2; ++n)
#pragma unroll
                            for (int i = 0; i < 4; ++i) { const float x = acc[ai][bj][m][n][i]; o[n][i] = act == 1 ? tanhf_(x) : (act == 0 ? x : (act == 2 ? sigmoidf_(x) : 0.f)); }
                        st8bf(L + (size_t)(row0 + ai * HALF + m * 16) * KL2 + lc, o[0], o[1]);
                    }
            }
        }
    }
};
struct EpiL2 {
    static constexpr bool PERM = true, AFTER_DRAIN = false;
    bf16 *DEC, *AA, *GG; const float *w0, *a0;
    __device__ __forceinline__ void operator()(const f32x4 (&acc)[2][2][4][2], const Unit& u, int wr, int wc, int fr, int fq) const {
        const int row0 = u.pm * BM + wr * 64 + fr, kind = u.pn >> 2, col0 = (u.pn & 3) * BM + wc * 32 + 8 * fq;
        bf16 *p0 = DEC, *p1 = AA, *p2 = GG; const float *q0 = w0, *q1 = a0; asm volatile("" : "+s"(p0), "+s"(p1), "+s"(p2), "+s"(q0), "+s"(q1));
        bf16* dst = kind == 0 ? p0 : (kind == 1 ? p1 : p2); const float* bias = kind == 0 ? q0 : q1;
#pragma unroll
        for (int bj = 0; bj < 2; ++bj) {
            f32x4 bv[2];
#pragma unroll
            for (int n = 0; n < 2; ++n) bv[n] = kind < 2 ? *(const f32x4*)(bias + col0 + bj * HALF + 4 * n) : (f32x4){0.f, 0.f, 0.f, 0.f};
#pragma unroll
            for (int ai = 0; ai < 2; ++ai)
#pragma unroll
                for (int m = 0; m < 4; ++m) {
                    f32x4 o[2];
#pragma unroll
                    for (int n = 0; n < 2; ++n)
#pragma unroll
                        for (int i = 0; i < 4; ++i) { const float z = acc[ai][bj][m][n][i] + bv[n][i];
                            o[n][i] = kind == 0 ? (1.f - __expf(-0.60653065971f * sigmoidf_(z))) : (kind == 1 ? sigmoidf_(z) : z); }
                    st8bf(dst + (size_t)(row0 + ai * HALF + m * 16) * D + col0 + bj * HALF, o[0], o[1]);
                }
        }
    }
};
struct EpiIn {
    static constexpr bool PERM = true, AFTER_DRAIN = false;
    bf16 *QKR, *VV, *OO; float* IF; const float* bif;
    __device__ __forceinline__ void operator()(const f32x4 (&acc)[2][2][4][2], const Unit& u, int wr, int wc, int fr, int fq) const {
        const int row0 = u.pm * BM + wr * 64 + fr;
        if (u.pn < 12) {
            bf16 *p0 = QKR, *p1 = VV, *p2 = OO; asm volatile("" : "+s"(p0), "+s"(p1), "+s"(p2));
            const int kind = u.pn >> 2; bf16* dst = kind == 0 ? p0 : (kind == 1 ? p1 : p2); const int col0 = (u.pn & 3) * BM + wc * 32 + 8 * fq;
#pragma unroll
            for (int ai = 0; ai < 2; ++ai)
#pragma unroll
                for (int m = 0; m < 4; ++m) { bf16* rp = dst + (size_t)(row0 + ai * HALF + m * 16) * D + col0;
#pragma unroll
                    for (int bj = 0; bj < 2; ++bj) { f32x4 a = acc[ai][bj][m][0], b = acc[ai][bj][m][1];
                        if (kind == 2) {
#pragma unroll
                            for (int i = 0; i < 4; ++i) { a[i] = sigmoidf_(a[i]); b[i] = sigmoidf_(b[i]); } }
                        st8bf(rp + bj * HALF, a, b); } }
        } else if (u.pn == 12 && wc == 0 && fq < 2) {
            const f32x4 b0 = *(const f32x4*)(bif + 8 * fq), b1 = *(const f32x4*)(bif + 8 * fq + 4);
#pragma unroll
            for (int ai = 0; ai < 2; ++ai)
#pragma unroll
                for (int m = 0; m < 4; ++m) { f32x4 a = acc[ai][0][m][0] + b0, b = acc[ai][0][m][1] + b1;
                    if (fq == 1) {
#pragma unroll
                        for (int i = 0; i < 4; ++i) { a[i] = logsigmoidf_(a[i]); b[i] = logsigmoidf_(b[i]); } }
                    float* rp = IF + (size_t)(row0 + ai * HALF + m * 16) * 16 + 8 * fq; *(f32x4*)rp = a; *(f32x4*)(rp + 4) = b; }
        }
    }
};

struct CJ { const float* W; const float* sc; bf16* WT; int K, N, Npad, ldk, koff, rmode, roff, smode; };
__device__ __forceinline__ int cj_items(const CJ& j) { return (j.K / 64) * (j.Npad / 32); }
__device__ __forceinline__ void conv_item(const CJ& J, LAS float* scr, int item, int lane) {
    const int nblk = J.Npad / 32, kb = item / nblk, nb = item % nblk, k0 = 64 * kb, n0 = 32 * nb;
    const int nn = n0 + (lane & 31); const bool nok = nn < J.N;
#pragma unroll 8
    for (int i = 0; i < 32; ++i) { const int kk = 2 * i + (lane >> 5); float w = nok ? J.W[(size_t)(k0 + kk) * J.N + nn] : 0.f;
        if (J.smode) { const float s = J.sc[k0 + kk]; w *= (J.smode == 1 ? s : 1.f - s); }
        scr[kk * 33 + (lane & 31)] = w; }
    LDS_WAIT(); asm volatile("" ::: "memory");
    const int rowbase = J.rmode == 0 ? J.roff + n0 : (n0 >> 7) * 256 + (n0 & 127) + J.roff;
    const int c = lane & 7;
#pragma unroll
    for (int j = 0; j < 4; ++j) { const int n = (lane >> 3) + 8 * j; const LAS float* s = scr + (8 * c) * 33 + n;
        v4u o; o.x = pkbf(s[0 * 33], s[1 * 33]); o.y = pkbf(s[2 * 33], s[3 * 33]); o.z = pkbf(s[4 * 33], s[5 * 33]); o.w = pkbf(s[6 * 33], s[7 * 33]);
        *(GAS v4u*)(J.WT + (size_t)(rowbase + n) * J.ldk + J.koff + k0 + 8 * c) = o; }
    LDS_WAIT(); asm volatile("" ::: "memory");
}
__device__ __forceinline__ CJ get_job(const Frame& F, int kind, int j, int layer, int ab, bf16* Wb) {
    CJ J; J.sc = nullptr; J.smode = 0; J.koff = 0; J.rmode = 0; J.roff = 0;
    if (kind == 0) {
        const float* wg = inptr(F, ab ? I_FBWG : I_FAWG) + (size_t)layer * D * FF; const float* wu = inptr(F, ab ? I_FBWU : I_FAWU) + (size_t)layer * D * FF; const float* wd = inptr(F, ab ? I_FBWD : I_FAWD) + (size_t)layer * D * FF;
        if (j < 2) { J.W = j == 0 ? wg : wu; J.K = D; J.N = FF; J.Npad = FF; J.WT = Wb + W_GU / 2; J.ldk = D; J.rmode = 1; J.roff = j == 0 ? 0 : 128; }
        else { J.W = wd; J.K = FF; J.N = D; J.Npad = D; J.WT = Wb + W_D / 2; J.ldk = FF; }
    } else if (kind == 1) {
        if (j < 12) {
            const int s = j >> 1, half = j & 1;
            J.W = inptr(F, s == 0 ? I_WR : (s == 1 ? I_WK : (s == 2 ? I_WV : (s == 3 ? I_W1 : (s == 4 ? I_A1 : I_G1)))));
            J.N = s < 3 ? 1024 : (s < 5 ? 64 : 160); J.Npad = s < 3 ? 1024 : (s < 5 ? 64 : 384);
            J.roff = s < 3 ? 1024 * s : (s == 3 ? 3072 : (s == 4 ? 3136 : 3200));
            const int mui = s == 0 ? 0 : (s == 1 ? 2 : (s == 2 ? 3 : (s == 3 ? 1 : (s == 4 ? 4 : 5))));
            J.sc = inptr(F, I_MU) + mui * D; J.smode = half ? 1 : 2; J.koff = half * D; J.K = D; J.ldk = KRW; J.WT = Wb + W_RW / 2;
        } else { J.W = inptr(F, I_WO); J.K = D; J.N = D; J.Npad = D; J.WT = Wb + W_O / 2; J.ldk = D; }
    } else {
        if (j == 0) { J.W = inptr(F, I_WIN); J.K = D; J.N = 3088; J.Npad = NIN; J.WT = Wb + W_IN / 2; J.ldk = D; }
        else { J.W = inptr(F, I_WOUT); J.K = D; J.N = D; J.Npad = D; J.WT = Wb + W_OUT / 2; J.ldk = D; }
    }
    return J;
}
__device__ __forceinline__ void convert_weights(const Frame& F, int kind, int layer, int ab, bf16* Wb, const int cu0 = 0) {
    LAS float* scr = (LAS float*)(F.lds + F.wave * 16384);
    const int gw = (F.vcu - cu0) * NWAVES + F.wave, NGW = (F.G - cu0) * NWAVES;
    const int njobs = kind == 0 ? 3 : (kind == 1 ? 13 : 2);
    int total = 0;
    for (int j = 0; j < njobs; ++j) { const CJ J = get_job(F, kind, j, layer, ab, Wb); total += cj_items(J); }
    for (int g = gw; g < total; g += NGW) {
        int r = g, j = 0; CJ J = get_job(F, kind, 0, layer, ab, Wb);
        while (r >= cj_items(J)) { r -= cj_items(J); ++j; J = get_job(F, kind, j, layer, ab, Wb); }
        conv_item(J, scr, r, F.lane);
    }
    if (kind == 1) {
        bf16* WT = Wb + W_L2 / 2; const float* w2 = inptr(F, I_W2); const float* a2 = inptr(F, I_A2); const float* g2 = inptr(F, I_G2);
        for (int idx = (F.vcu * NWAVES + F.wave) * 64 + F.lane; idx < 48 * NL2; idx += F.G * NWAVES * 64) {
            const int c = idx / NL2, n = idx % NL2, type = n >> 10, jj = n & 1023;
            const float* src = nullptr;
            if (type == 0 && c < 8) src = w2 + (size_t)(8 * c) * D + jj;
            else if (type == 1 && c >= 8 && c < 16) src = a2 + (size_t)(8 * (c - 8)) * D + jj;
            else if (type == 2 && c >= 16 && c < 36) src = g2 + (size_t)(8 * (c - 16)) * D + jj;
            float v[8];
#pragma unroll
            for (int e = 0; e < 8; ++e) v[e] = src ? src[(size_t)e * D] : 0.f;
            *(GAS v4u*)(WT + (size_t)n * KL2 + 8 * c) = pack8(v);
        }
    }
}

template <int MODE>
__device__ __forceinline__ void norm_rows(const Frame& F, const float* base_p, const float* base_s, int nslab, float coef, const float* slab, float* xr,
                                          const float* gain, bf16* dst, const float* shift_in, float* out) {
    const int gw = F.vcu * NWAVES + F.wave, NGW = F.G * NWAVES, lane = F.lane;
    f32x4 gv[4];
#pragma unroll
    for (int j = 0; j < 4; ++j) gv[j] = *(const f32x4*)(gain + 256 * j + 4 * lane);
    for (int m = gw; m < M; m += NGW) {
        const bool samp = m >= MP;
        const float* src = samp ? base_s + (size_t)(m - MP) * D : base_p + (size_t)m * D;
        f32x4 v[4];
#pragma unroll
        for (int j = 0; j < 4; ++j) v[j] = *(const f32x4*)(src + 256 * j + 4 * lane);
        if (samp && nslab > 0) {
            for (int s = 0; s < nslab; ++s) { const float* sp = slab + ((size_t)s * MS + (m - MP)) * D;
#pragma unroll
                for (int j = 0; j < 4; ++j) v[j] += *(const f32x4*)(sp + 256 * j + 4 * lane) * coef; }
            if (MODE != 2) {
#pragma unroll
                for (int j = 0; j < 4; ++j) *(f32x4*)(xr + (size_t)m * D + 256 * j + 4 * lane) = v[j]; }
        }
        float ss = 0.f;
#pragma unroll
        for (int j = 0; j < 4; ++j) ss += (v[j].x * v[j].x + v[j].y * v[j].y) + (v[j].z * v[j].z + v[j].w * v[j].w);
        const float r = 1.0f / sqrtf(wave_sum(ss) * (1.f / D) + NORM_EPS);
#pragma unroll
        for (int j = 0; j < 4; ++j) v[j] = v[j] * r * gv[j];
        if (MODE == 2) {
#pragma unroll
            for (int j = 0; j < 4; ++j) *(f32x4*)(out + O_Y + (size_t)m * D + 256 * j + 4 * lane) = v[j];
        } else if (MODE == 0) {
#pragma unroll
            for (int j = 0; j < 4; ++j) { const unsigned long long w = (unsigned long long)pkbf(v[j].x, v[j].y) | ((unsigned long long)pkbf(v[j].z, v[j].w) << 32);
                *(unsigned long long*)(dst + (size_t)m * D + 256 * j + 4 * lane) = w; }
        } else {
            int t, b; bool first, last;
            if (!samp) { t = m & (PT - 1); b = m >> 11; first = t == 0; last = t == PT - 1; } else { const int mm = m - MP; t = mm & 3; b = mm >> 2; first = t == 0; last = t == 3; }
#pragma unroll
            for (int j = 0; j < 4; ++j) { const unsigned long long w = (unsigned long long)pkbf(v[j].x, v[j].y) | ((unsigned long long)pkbf(v[j].z, v[j].w) << 32);
                *(unsigned long long*)(dst + (size_t)m * (2 * D) + 256 * j + 4 * lane) = w;
                if (!last) *(unsigned long long*)(dst + (size_t)(m + 1) * (2 * D) + D + 256 * j + 4 * lane) = w;
                else *(f32x4*)(out + (samp ? O_S_SHIFT : O_P_SHIFT) + (size_t)b * D + 256 * j + 4 * lane) = v[j];
                if (first) { unsigned long long z = 0ull;
                    if (samp) { const f32x4 s = *(const f32x4*)(shift_in + (size_t)b * D + 256 * j + 4 * lane); z = (unsigned long long)pkbf(s.x, s.y) | ((unsigned long long)pkbf(s.z, s.w) << 32); }
                    *(unsigned long long*)(dst + (size_t)m * (2 * D) + D + 256 * j + 4 * lane) = z; }
            }
        }
    }
}

constexpr int RW_KK = 0, RW_DD = 4096, RW_BB = 8192, RW_KP = 12288, RW_RR = 16384, RW_VV = 20480, RW_YY = 24576;
__device__ __forceinline__ void rwkv_chain(const Frame& F, int row0, int T, int h, const float* S0, float* ST,
                                           const bf16* Rb, const bf16* Kb, const bf16* Vb, const bf16* Db, const bf16* Ab, bf16* Gb,
                                           const float* k_k, const float* k_a, const float* r_k, const float* gn_w, const float* gn_b, const bool do_store, const int pvar) {
    LAS float* L = (LAS float*)F.lds;
    const int tid = F.tid, lane = F.lane, w = F.wave;
    const int cg = tid & 7, tt = tid >> 3;
    const int srow = 8 * w + (lane >> 3);
    float S[8];
    if (S0) { const f32x4 a = *(const f32x4*)(S0 + srow * 64 + 8 * cg), b = *(const f32x4*)(S0 + srow * 64 + 8 * cg + 4);
        S[0] = a.x; S[1] = a.y; S[2] = a.z; S[3] = a.w; S[4] = b.x; S[5] = b.y; S[6] = b.z; S[7] = b.w; }
    else {
#pragma unroll
        for (int j = 0; j < 8; ++j) S[j] = 0.f; }
    const int ch = h * 64 + 8 * cg;
    float ckk[8], cka[8], crk[8], cgw[8], cgb[8];
#pragma unroll
    for (int j = 0; j < 8; ++j) { ckk[j] = k_k[ch + j]; cka[j] = k_a[ch + j]; crk[j] = r_k[ch + j]; cgw[j] = gn_w[ch + j]; cgb[j] = gn_b[ch + j]; }
    const int nch = (T + 63) >> 6;
    v4u pr = {0, 0, 0, 0}, pk = pr, pv = pr, pd = pr, pa = pr, pg = pr;
    { const int nt0 = T < 64 ? T : 64;
      if (tt < nt0) { const size_t off = (size_t)(row0 + tt) * D + ch;
          pr = *(const v4u*)(Rb + off); pk = *(const v4u*)(Kb + off); pv = *(const v4u*)(Vb + off); pd = *(const v4u*)(Db + off); pa = *(const v4u*)(Ab + off); pg = *(const v4u*)(Gb + off); } }
    float bon = 0.f, vv[8], gg[8];
    for (int c = 0; c < nch; ++c) {
        const int nt = (T - 64 * c) < 64 ? (T - 64 * c) : 64;
        const bool valid = tt < nt;
        {
            float r8[8], k8[8], d8[8], a8[8];
            unpack8(pr, r8); unpack8(pk, k8); unpack8(pv, vv); unpack8(pd, d8); unpack8(pa, a8); unpack8(pg, gg);
            float kk[8], ss = 0.f;
#pragma unroll
            for (int j = 0; j < 8; ++j) { kk[j] = k8[j] * ckk[j]; ss += kk[j] * kk[j]; }
            ss = red8(ss);
            const float inv = __builtin_amdgcn_rsqf(fmaxf(ss, 1e-24f));
            float kp[8], bsum = 0.f;
#pragma unroll
            for (int j = 0; j < 8; ++j) { kk[j] *= inv; kp[j] = k8[j] * (1.f + (a8[j] - 1.f) * cka[j]); bsum += r8[j] * kp[j] * crk[j]; }
            bon = red8(bsum);
            if (valid) {
                LAS float* p = L + tt * 64 + 8 * cg;
                *(LAS f32x4*)(p + RW_KK) = (f32x4){-kk[0], -kk[1], -kk[2], -kk[3]}; *(LAS f32x4*)(p + RW_KK + 4) = (f32x4){-kk[4], -kk[5], -kk[6], -kk[7]};
                *(LAS f32x4*)(p + RW_DD) = (f32x4){1.f - d8[0], 1.f - d8[1], 1.f - d8[2], 1.f - d8[3]}; *(LAS f32x4*)(p + RW_DD + 4) = (f32x4){1.f - d8[4], 1.f - d8[5], 1.f - d8[6], 1.f - d8[7]};
                *(LAS f32x4*)(p + RW_BB) = (f32x4){kk[0] * a8[0], kk[1] * a8[1], kk[2] * a8[2], kk[3] * a8[3]}; *(LAS f32x4*)(p + RW_BB + 4) = (f32x4){kk[4] * a8[4], kk[5] * a8[5], kk[6] * a8[6], kk[7] * a8[7]};
                *(LAS f32x4*)(p + RW_KP) = (f32x4){kp[0], kp[1], kp[2], kp[3]}; *(LAS f32x4*)(p + RW_KP + 4) = (f32x4){kp[4], kp[5], kp[6], kp[7]};
                *(LAS f32x4*)(p + RW_RR) = (f32x4){r8[0], r8[1], r8[2], r8[3]}; *(LAS f32x4*)(p + RW_RR + 4) = (f32x4){r8[4], r8[5], r8[6], r8[7]};
                *(LAS f32x4*)(p + RW_VV) = (f32x4){vv[0], vv[1], vv[2], vv[3]}; *(LAS f32x4*)(p + RW_VV + 4) = (f32x4){vv[4], vv[5], vv[6], vv[7]};
            }
        }
        __syncthreads();
        if (c + 1 < nch) { const int nt1 = (T - 64 * (c + 1)) < 64 ? (T - 64 * (c + 1)) : 64;
            if (tt < nt1) { const size_t off = (size_t)(row0 + 64 * (c + 1) + tt) * D + ch;
                pr = *(const v4u*)(Rb + off); pk = *(const v4u*)(Kb + off); pv = *(const v4u*)(Vb + off); pd = *(const v4u*)(Db + off); pa = *(const v4u*)(Ab + off); pg = *(const v4u*)(Gb + off); } }
        {
            typedef float f2 __attribute__((ext_vector_type(2)));
            f2 S2[4] = {{S[0], S[1]}, {S[2], S[3]}, {S[4], S[5]}, {S[6], S[7]}};
            const LAS float* p = L + 8 * cg;
            LAS float* yw = L + RW_YY + srow;
            const LAS float* vp = L + RW_VV + srow;
#define RW_LD(N, Dd, B, Q, R, VR, t_) do { const LAS float* p_ = p + (t_) * 64; \
                N[0] = *(const LAS f32x4*)(p_ + RW_KK); N[1] = *(const LAS f32x4*)(p_ + RW_KK + 4); Dd[0] = *(const LAS f32x4*)(p_ + RW_DD); Dd[1] = *(const LAS f32x4*)(p_ + RW_DD + 4); \
                B[0] = *(const LAS f32x4*)(p_ + RW_BB); B[1] = *(const LAS f32x4*)(p_ + RW_BB + 4); Q[0] = *(const LAS f32x4*)(p_ + RW_KP); Q[1] = *(const LAS f32x4*)(p_ + RW_KP + 4); \
                R[0] = *(const LAS f32x4*)(p_ + RW_RR); R[1] = *(const LAS f32x4*)(p_ + RW_RR + 4); VR = vp[(t_) * 64]; } while (0)
#define RW_STEP(N, Dd, B, Q, R, VR, t_) do { \
                f2 a_ = S2[0] * (f2){N[0].x, N[0].y}; a_ = S2[1] * (f2){N[0].z, N[0].w} + a_; a_ = S2[2] * (f2){N[1].x, N[1].y} + a_; a_ = S2[3] * (f2){N[1].z, N[1].w} + a_; \
                const float sa_ = red8(a_.x + a_.y); const f2 sv_ = {sa_, sa_}, vv_ = {VR, VR}; \
                S2[0] = S2[0] * (f2){Dd[0].x, Dd[0].y} + (sv_ * (f2){B[0].x, B[0].y} + vv_ * (f2){Q[0].x, Q[0].y}); \
                S2[1] = S2[1] * (f2){Dd[0].z, Dd[0].w} + (sv_ * (f2){B[0].z, B[0].w} + vv_ * (f2){Q[0].z, Q[0].w}); \
                S2[2] = S2[2] * (f2){Dd[1].x, Dd[1].y} + (sv_ * (f2){B[1].x, B[1].y} + vv_ * (f2){Q[1].x, Q[1].y}); \
                S2[3] = S2[3] * (f2){Dd[1].z, Dd[1].w} + (sv_ * (f2){B[1].z, B[1].w} + vv_ * (f2){Q[1].z, Q[1].w}); \
                f2 y_ = S2[0] * (f2){R[0].x, R[0].y}; y_ = S2[1] * (f2){R[0].z, R[0].w} + y_; y_ = S2[2] * (f2){R[1].x, R[1].y} + y_; y_ = S2[3] * (f2){R[1].z, R[1].w} + y_; \
                yw[(t_) * 64] = red8(y_.x + y_.y); } while (0)
            f32x4 nA[2], dA[2], bA[2], qA[2], rA[2]; float vA;
            for (int t = 0; t < nt; ++t) { RW_LD(nA, dA, bA, qA, rA, vA, t); RW_STEP(nA, dA, bA, qA, rA, vA, t); }
#undef RW_LD
#undef RW_STEP
            S[0] = S2[0].x; S[1] = S2[0].y; S[2] = S2[1].x; S[3] = S2[1].y; S[4] = S2[2].x; S[5] = S2[2].y; S[6] = S2[3].x; S[7] = S2[3].y;
        }
        __syncthreads();
        if (pvar != 4) {
            f32x4 y0 = {0.f, 0.f, 0.f, 0.f}, y1 = y0;
            if (valid) { y0 = *(const LAS f32x4*)(L + RW_YY + tt * 64 + 8 * cg); y1 = *(const LAS f32x4*)(L + RW_YY + tt * 64 + 8 * cg + 4); }
            float yy[8] = {y0.x, y0.y, y0.z, y0.w, y1.x, y1.y, y1.z, y1.w};
            float s1 = 0.f;
#pragma unroll
            for (int j = 0; j < 8; ++j) s1 += yy[j];
            const float mean = red8(s1) * (1.f / 64.f);
            float s2 = 0.f;
#pragma unroll
            for (int j = 0; j < 8; ++j) { yy[j] -= mean; s2 += yy[j] * yy[j]; }
            const float rstd = __builtin_amdgcn_rsqf(red8(s2) * (1.f / 64.f) + GN_EPS);
            float o[8];
#pragma unroll
            for (int j = 0; j < 8; ++j) o[j] = ((yy[j] * rstd) * cgw[j] + cgb[j] + bon * vv[j]) * gg[j];
            if (valid && do_store) *(v4u*)(Gb + (size_t)(row0 + 64 * c + tt) * D + ch) = pack8(o);
        }
    }
    *(f32x4*)(ST + srow * 64 + 8 * cg) = (f32x4){S[0], S[1], S[2], S[3]}; *(f32x4*)(ST + srow * 64 + 8 * cg + 4) = (f32x4){S[4], S[5], S[6], S[7]};
    __syncthreads();
}

constexpr int RH_TC = 32, RH_BUF = 12288;
constexpr int RH_KK = 0, RH_DD = 2048, RH_BB = 4096, RH_KP = 6144, RH_RR = 8192, RH_VV = 10240, RH_YY = 11264;
__device__ __forceinline__ void rwkv_half_chain(const Frame& F, int b, int h, int half, float* ST, const bf16* Rb, const bf16* Kb, const bf16* Vb, const bf16* Db, const bf16* Ab,
                                                bf16* YRAW, float* BON, const float* k_k, const float* k_a, const float* r_k, const int pvar) {
    LAS float* L = (LAS float*)F.lds;
    const int tid = F.tid, lane = F.lane, w = F.wave, row0 = b * PT;
    constexpr int nch = PT / RH_TC;
    if (w < 4) {
        const int srow = 8 * w + (lane >> 3), cq = lane & 7;
        f32x4 S4 = {0.f, 0.f, 0.f, 0.f}, S5 = S4;
        __syncthreads();
        __builtin_amdgcn_s_setprio(3);
        for (int c = 0; c < nch; ++c) {
            const LAS float* p = L + (c & 1) * RH_BUF + 8 * cq;
            LAS float* yw = L + (c & 1) * RH_BUF + RH_YY + srow;
            const LAS float* vp = L + (c & 1) * RH_BUF + RH_VV + srow;
#define RH_LD(N, Dd, B, Q, R, VR, t_) do { const LAS float* p_ = p + (t_) * 64; \
                N[0] = *(const LAS f32x4*)(p_ + RH_KK); N[1] = *(const LAS f32x4*)(p_ + RH_KK + 4); Dd[0] = *(const LAS f32x4*)(p_ + RH_DD); Dd[1] = *(const LAS f32x4*)(p_ + RH_DD + 4); \
                B[0] = *(const LAS f32x4*)(p_ + RH_BB); B[1] = *(const LAS f32x4*)(p_ + RH_BB + 4); Q[0] = *(const LAS f32x4*)(p_ + RH_KP); Q[1] = *(const LAS f32x4*)(p_ + RH_KP + 4); \
                R[0] = *(const LAS f32x4*)(p_ + RH_RR); R[1] = *(const LAS f32x4*)(p_ + RH_RR + 4); VR = vp[(t_) * 32]; } while (0)
#define RH_STEP(N, Dd, B, Q, R, VR, t_) do { \
                const f32x4 pa_ = S4 * N[0] + S5 * N[1]; const float sa_ = red8((pa_.x + pa_.y) + (pa_.z + pa_.w)); \
                S4 = S4 * Dd[0] + (B[0] * sa_ + Q[0] * VR); S5 = S5 * Dd[1] + (B[1] * sa_ + Q[1] * VR); \
                const f32x4 ya_ = S4 * R[0] + S5 * R[1]; yw[(t_) * 32] = red8((ya_.x + ya_.y) + (ya_.z + ya_.w)); } while (0)
            f32x4 nA[2], dA[2], bA[2], qA[2], rA[2], nB[2], dB[2], bB[2], qB[2], rB[2]; float vA, vB;
            RH_LD(nA, dA, bA, qA, rA, vA, 0);
            if (pvar != 3)
            for (int t = 0; t < RH_TC; t += 2) {
                RH_LD(nB, dB, bB, qB, rB, vB, t + 1);
                RH_STEP(nA, dA, bA, qA, rA, vA, t);
                RH_LD(nA, dA, bA, qA, rA, vA, (t + 2 < RH_TC ? t + 2 : t + 1));
                RH_STEP(nB, dB, bB, qB, rB, vB, t + 1);
            }
#undef RH_LD
#undef RH_STEP
            __syncthreads();
        }
        __builtin_amdgcn_s_setprio(0);
        *(f32x4*)(ST + (32 * half + srow) * 64 + 8 * cq) = S4; *(f32x4*)(ST + (32 * half + srow) * 64 + 8 * cq + 4) = S5;
    } else {
        const int ht = tid - 256, cg = ht & 7, tt = ht >> 3;
        const int ch = h * 64 + 8 * cg, vch = h * 64 + 32 * half + 4 * cg;
        float ckk[8], cka[8], crk[8];
#pragma unroll
        for (int j = 0; j < 8; ++j) { ckk[j] = k_k[ch + j]; cka[j] = k_a[ch + j]; crk[j] = r_k[ch + j]; }
        v4u pr, pk, pd, pa; uint2 pv;
#define RH_LOAD(cc) do { const size_t off_ = (size_t)(row0 + RH_TC * (cc) + tt) * D; pr = *(const v4u*)(Rb + off_ + ch); pk = *(const v4u*)(Kb + off_ + ch); pd = *(const v4u*)(Db + off_ + ch); \
            pa = *(const v4u*)(Ab + off_ + ch); pv = *(const uint2*)(Vb + off_ + vch); } while (0)
#define RH_PREP(cc) do { float r8[8], k8[8], d8[8], a8[8]; unpack8(pr, r8); unpack8(pk, k8); unpack8(pd, d8); unpack8(pa, a8); \
            float kk[8], ss = 0.f; _Pragma("unroll") for (int j = 0; j < 8; ++j) { kk[j] = k8[j] * ckk[j]; ss += kk[j] * kk[j]; } \
            ss = red8(ss); const float inv = __builtin_amdgcn_rsqf(fmaxf(ss, 1e-24f)); \
            float kp[8], bsum = 0.f; _Pragma("unroll") for (int j = 0; j < 8; ++j) { kk[j] *= inv; kp[j] = k8[j] * (1.f + (a8[j] - 1.f) * cka[j]); bsum += r8[j] * kp[j] * crk[j]; } \
            const float bon = red8(bsum); if (half == 0 && cg == 0) BON[(size_t)(row0 + RH_TC * (cc) + tt) * 16 + h] = bon; \
            LAS float* p = L + ((cc) & 1) * RH_BUF + tt * 64 + 8 * cg; \
            *(LAS f32x4*)(p + RH_KK) = (f32x4){-kk[0], -kk[1], -kk[2], -kk[3]}; *(LAS f32x4*)(p + RH_KK + 4) = (f32x4){-kk[4], -kk[5], -kk[6], -kk[7]}; \
            *(LAS f32x4*)(p + RH_DD) = (f32x4){1.f - d8[0], 1.f - d8[1], 1.f - d8[2], 1.f - d8[3]}; *(LAS f32x4*)(p + RH_DD + 4) = (f32x4){1.f - d8[4], 1.f - d8[5], 1.f - d8[6], 1.f - d8[7]}; \
            *(LAS f32x4*)(p + RH_BB) = (f32x4){kk[0] * a8[0], kk[1] * a8[1], kk[2] * a8[2], kk[3] * a8[3]}; *(LAS f32x4*)(p + RH_BB + 4) = (f32x4){kk[4] * a8[4], kk[5] * a8[5], kk[6] * a8[6], kk[7] * a8[7]}; \
            *(LAS f32x4*)(p + RH_KP) = (f32x4){kp[0], kp[1], kp[2], kp[3]}; *(LAS f32x4*)(p + RH_KP + 4) = (f32x4){kp[4], kp[5], kp[6], kp[7]}; \
            *(LAS f32x4*)(p + RH_RR) = (f32x4){r8[0], r8[1], r8[2], r8[3]}; *(LAS f32x4*)(p + RH_RR + 4) = (f32x4){r8[4], r8[5], r8[6], r8[7]}; \
            *(LAS f32x4*)(L + ((cc) & 1) * RH_BUF + RH_VV + tt * 32 + 4 * cg) = (f32x4){bflo(pv.x), bfhi(pv.x), bflo(pv.y), bfhi(pv.y)}; } while (0)
#define RH_POST(cc) do { const f32x4 y4 = *(const LAS f32x4*)(L + ((cc) & 1) * RH_BUF + RH_YY + tt * 32 + 4 * cg); uint2 o; o.x = pkbf(y4.x, y4.y); o.y = pkbf(y4.z, y4.w); \
            *(uint2*)(YRAW + (size_t)(row0 + RH_TC * (cc) + tt) * D + vch) = o; } while (0)
        RH_LOAD(0); RH_PREP(0); RH_LOAD(1);
        __syncthreads();
        for (int c = 0; c < nch; ++c) {
            if (c > 0) RH_POST(c - 1);
            if (c + 1 < nch) { RH_PREP(c + 1); if (c + 2 < nch) RH_LOAD(c + 2); }
            __syncthreads();
        }
        RH_POST(nch - 1);
#undef RH_LOAD
#undef RH_PREP
#undef RH_POST
    }
    __syncthreads();
}
__device__ __forceinline__ void rwkv_finish(const Frame& F, const bf16* YRAW, const float* BON, const bf16* Vb, bf16* Gb, const float* gn_w, const float* gn_b) {
    const int gt = (F.vcu * NWAVES + F.wave) * 64 + F.lane, NT = F.G * NWAVES * 64;
    for (int task = gt; task < MP * 128; task += NT) {
        const int cg = task & 7, hh = (task >> 3) & 15, row = task >> 7; const size_t off = (size_t)row * D + hh * 64 + 8 * cg;
        float yy[8], vv[8], gg[8]; unpack8(*(const v4u*)(YRAW + off), yy); unpack8(*(const v4u*)(Vb + off), vv); unpack8(*(const v4u*)(Gb + off), gg);
        const float bon = BON[(size_t)row * 16 + hh];
        float s1 = 0.f;
#pragma unroll
        for (int j = 0; j < 8; ++j) s1 += yy[j];
        const float mean = red8(s1) * (1.f / 64.f);
        float s2 = 0.f;
#pragma unroll
        for (int j = 0; j < 8; ++j) { yy[j] -= mean; s2 += yy[j] * yy[j]; }
        const float rstd = __builtin_amdgcn_rsqf(red8(s2) * (1.f / 64.f) + GN_EPS);
        const f32x4 w0 = *(const f32x4*)(gn_w + hh * 64 + 8 * cg), w1 = *(const f32x4*)(gn_w + hh * 64 + 8 * cg + 4), b0 = *(const f32x4*)(gn_b + hh * 64 + 8 * cg), b1 = *(const f32x4*)(gn_b + hh * 64 + 8 * cg + 4);
        const float gw[8] = {w0.x, w0.y, w0.z, w0.w, w1.x, w1.y, w1.z, w1.w}, gb[8] = {b0.x, b0.y, b0.z, b0.w, b1.x, b1.y, b1.z, b1.w};
        float o[8];
#pragma unroll
        for (int j = 0; j < 8; ++j) o[j] = ((yy[j] * rstd) * gw[j] + gb[j] + bon * vv[j]) * gg[j];
        *(v4u*)(Gb + off) = pack8(o);
    }
}

constexpr int PBY = 144;
constexpr int RPY = 272;
constexpr int ML_RQK = 0, ML_S = 0, ML_KT = 9216, ML_RV = 18432, ML_Q = 35840, ML_K = 45056, ML_HB = 35840, ML_VT = 54272, ML_C = 72704, ML_F = 91136;
constexpr int MF_N = 0, MF_QN = 64, MF_RS = 128, MF_HS = 256, MF_CW = 384, MF_B63 = 1024, MF_P63 = 1056, MF_MC = 1088  , MF_GB = 1152, MF_GP = MF_GB + 2048, MF_GA = MF_GP + 2048;
typedef __attribute__((address_space(3))) unsigned short lds_u16;
#define MFMA16(a, b, c) __builtin_amdgcn_mfma_f32_16x16x32_bf16((a), (b), (c), 0, 0, 0)
__device__ __forceinline__ void mlstm_prompt_chain(const Frame& F, int b, int hh, const bf16* QKR, const bf16* VVb, const bf16* OOb, const float* IFb, bf16* HOb,
                                                   const float* conv_w, const float* conv_b, const float* norm_w, float* out, const int pvar) {
    LAS unsigned char* lds = F.lds; LAS float* Fl = (LAS float*)(lds + ML_F);
    const int tid = F.tid, lane = F.lane, w = F.wave, fr = lane & 15, fq = lane >> 4;
    for (int i = tid; i < 128 * 72; i += 512) ((lds_u16*)(lds + ML_C))[i] = 0;
    if (tid < 64) Fl[MF_N + tid] = 0.f;
    for (int i = tid; i < 640; i += 512) { const int j = i >> 7, c = i & 127, gc = c < 64 ? hh * 64 + c : 512 + hh * 64 + (c - 64); Fl[MF_CW + i] = j < 4 ? conv_w[j * D + gc] : conv_b[gc]; }
    f32x4 Cacc[4];
#pragma unroll
    for (int k = 0; k < 4; ++k) Cacc[k] = (f32x4){0.f, 0.f, 0.f, 0.f};
    const int og = tid & 15, ot = tid >> 4;
    float nw[8];
#pragma unroll
    for (int e = 0; e < 8; ++e) nw[e] = norm_w[hh * 128 + 8 * og + e];
    v4u rq[3], rv[2], ro[2];
#define ML_LOAD_QKV(cc) do { const int rowc_ = b * PT + 64 * (cc); \
        _Pragma("unroll") for (int i = 0; i < 3; ++i) { const int q = tid + 512 * i, r = q >> 4, j = q & 15, tok = 64 * (cc) - 3 + r; rq[i] = (v4u){0u, 0u, 0u, 0u}; \
            if (q < 67 * 16 && tok >= 0) rq[i] = *(const v4u*)(QKR + (size_t)(b * PT + tok) * D + (j < 8 ? hh * 64 + 8 * j : 512 + hh * 64 + 8 * (j - 8))); } \
        _Pragma("unroll") for (int i = 0; i < 2; ++i) rv[i] = *(const v4u*)(VVb + (size_t)(rowc_ + ot + 32 * i) * D + hh * 128 + 8 * og); \
        } while (0)
#define ML_LOAD_O(cc) do { const int rowc_ = b * PT + 64 * (cc); \
        _Pragma("unroll") for (int i = 0; i < 2; ++i) ro[i] = *(const v4u*)(OOb + (size_t)(rowc_ + ot + 32 * i) * D + hh * 128 + 8 * og); } while (0)
    ML_LOAD_QKV(0);
#pragma unroll
    for (int q = 0; q < 4; ++q) { const int cc = w + 8 * q; const size_t ro_ = (size_t)(b * PT + 64 * cc + lane) * 16;
        const float li = IFb[ro_ + hh], lf = IFb[ro_ + 8 + hh];
        float bc = lf;
#pragma unroll
        for (int o = 1; o < 64; o <<= 1) { const float x = __shfl_up(bc, o); if (lane >= o) bc += x; }
        const float av = li - bc; float pm = av;
#pragma unroll
        for (int o = 1; o < 64; o <<= 1) { const float x = __shfl_up(pm, o); if (lane >= o) pm = fmaxf(pm, x); }
        Fl[MF_GB + cc * 64 + lane] = bc; Fl[MF_GP + cc * 64 + lane] = pm; Fl[MF_GA + cc * 64 + lane] = av;
        if (lane == 63) { Fl[MF_B63 + cc] = bc; Fl[MF_P63 + cc] = pm; } }
    __syncthreads();
    if (tid == 0) { float mm = 0.f;
        for (int cc = 0; cc < PT / 64; ++cc) { Fl[MF_MC + cc] = mm; const float b6 = Fl[MF_B63 + cc]; mm = fmaxf(b6 + mm, b6 + Fl[MF_P63 + cc]); }
        Fl[MF_MC + PT / 64] = mm; }
    __syncthreads();
    constexpr int NC = PT / 64;
    for (int c = 0; c < NC; ++c) {
        const int rowc = b * PT + 64 * c;
        const float m_c = Fl[MF_MC + c], m_n = Fl[MF_MC + c + 1], b63 = Fl[MF_B63 + c];
#pragma unroll
        for (int i = 0; i < 3; ++i) { const int q = tid + 512 * i; if (q < 67 * 16) *(LAS v4u*)(lds + ML_RQK + (q >> 4) * RPY + 16 * (q & 15)) = rq[i]; }
#pragma unroll
        for (int i = 0; i < 2; ++i) *(LAS v4u*)(lds + ML_RV + (ot + 32 * i) * RPY + 16 * og) = rv[i];
        if (c + 1 < NC) ML_LOAD_QKV(c + 1);
        ML_LOAD_O(c);
        __syncthreads();
        float kreg[8] = {0.f, 0.f, 0.f, 0.f, 0.f, 0.f, 0.f, 0.f};
        if (pvar != 3)
#pragma unroll
        for (int i = 0; i < 2; ++i) {
            const int g = w + 8 * i, t = lane;
            float x[4][8];
#pragma unroll
            for (int j = 0; j < 4; ++j) unpack8(*(const LAS v4u*)(lds + ML_RQK + (t + j) * RPY + 16 * g), x[j]);
            float val[8];
#pragma unroll
            for (int h2 = 0; h2 < 2; ++h2) { f32x4 a = *(const LAS f32x4*)(Fl + MF_CW + 4 * 128 + 8 * g + 4 * h2);
#pragma unroll
                for (int j = 0; j < 4; ++j) { const f32x4 cw = *(const LAS f32x4*)(Fl + MF_CW + j * 128 + 8 * g + 4 * h2);
                    a.x += cw.x * x[j][4 * h2]; a.y += cw.y * x[j][4 * h2 + 1]; a.z += cw.z * x[j][4 * h2 + 2]; a.w += cw.w * x[j][4 * h2 + 3]; }
                val[4 * h2] = siluf_(a.x); val[4 * h2 + 1] = siluf_(a.y); val[4 * h2 + 2] = siluf_(a.z); val[4 * h2 + 3] = siluf_(a.w); }
            if (i == 0) {
#pragma unroll
                for (int e = 0; e < 8; ++e) val[e] *= 0.125f;
                *(LAS v4u*)(lds + ML_Q + t * PBY + 16 * w) = pack8(val);
            } else { *(LAS v4u*)(lds + ML_K + t * PBY + 16 * w) = pack8(val);
#pragma unroll
                for (int e = 0; e < 8; ++e) kreg[e] = val[e]; }
            const v4u vw = *(const LAS v4u*)(lds + ML_RV + t * RPY + 16 * g);
            lds_u16* vt = (lds_u16*)(lds + ML_VT) + (8 * g) * 72 + t;
            vt[0 * 72] = (unsigned short)(vw.x & 0xffffu); vt[1 * 72] = (unsigned short)(vw.x >> 16); vt[2 * 72] = (unsigned short)(vw.y & 0xffffu); vt[3 * 72] = (unsigned short)(vw.y >> 16);
            vt[4 * 72] = (unsigned short)(vw.z & 0xffffu); vt[5 * 72] = (unsigned short)(vw.z >> 16); vt[6 * 72] = (unsigned short)(vw.w & 0xffffu); vt[7 * 72] = (unsigned short)(vw.w >> 16);
        }
        __syncthreads();
        if (pvar != 4) {
        { const float wsv = __expf(b63 + Fl[MF_GA + c * 64 + lane] - m_n); lds_u16* kt = (lds_u16*)(lds + ML_KT) + (8 * w) * 72 + lane;
#pragma unroll
          for (int e = 0; e < 8; ++e) kt[e * 72] = f2bf1(kreg[e] * wsv); }
        { const int tq = tid >> 3, p = tid & 7; float q8[8]; unpack8(*(const LAS v4u*)(lds + ML_Q + tq * PBY + 16 * p), q8);
          float dsum = 0.f;
#pragma unroll
          for (int e = 0; e < 8; ++e) dsum += q8[e] * Fl[MF_N + 8 * p + e];
          dsum = red8(dsum); if (p == 0) Fl[MF_QN + tq] = dsum; }
        { const int ti = w >> 1; float rs[4] = {0.f, 0.f, 0.f, 0.f};
#pragma unroll
          for (int jj = 0; jj < 2; ++jj) { const int sj = 2 * (w & 1) + jj; f32x4 acc = {0.f, 0.f, 0.f, 0.f};
#pragma unroll
              for (int ks = 0; ks < 2; ++ks) { const bf16x8 a = *(const LAS bf16x8*)(lds + ML_Q + (16 * ti + fr) * PBY + ks * 64 + fq * 16), bb = *(const LAS bf16x8*)(lds + ML_K + (16 * sj + fr) * PBY + ks * 64 + fq * 16);
                  acc = MFMA16(a, bb, acc); }
              const int s = 16 * sj + fr; const float as = Fl[MF_GA + c * 64 + s];
#pragma unroll
              for (int r = 0; r < 4; ++r) { const int t = 16 * ti + 4 * fq + r; const float val = s <= t ? acc[r] * __expf(as - fmaxf(m_c, Fl[MF_GP + c * 64 + t])) : 0.f;
                  ((lds_u16*)(lds + ML_S))[t * 72 + s] = f2bf1(val); rs[r] += val; } }
#pragma unroll
          for (int r = 0; r < 4; ++r) { const float x = red16(rs[r]); if (fr == 0) Fl[MF_RS + (16 * ti + 4 * fq + r) * 2 + (w & 1)] = x; } }
        }
        __syncthreads();
        float hv[4][4] = {};
        if (pvar != 5) { const int ti = w & 3; float wi[4], den[4], ei[4], hq[4];
#pragma unroll
          for (int r = 0; r < 4; ++r) { const int t = 16 * ti + 4 * fq + r; const float mx = fmaxf(m_c, Fl[MF_GP + c * 64 + t]); wi[r] = __expf(m_c - mx); ei[r] = __expf(-(Fl[MF_GB + c * 64 + t] + mx)); den[r] = wi[r] * Fl[MF_QN + t] + Fl[MF_RS + 2 * t] + Fl[MF_RS + 2 * t + 1]; hq[r] = 0.f; }
#pragma unroll
          for (int i = 0; i < 4; ++i) { const int vt = 4 * (w >> 2) + i; f32x4 accA = {0.f, 0.f, 0.f, 0.f}, accB = accA;
#pragma unroll
              for (int ks = 0; ks < 2; ++ks) {
                  const bf16x8 aq = *(const LAS bf16x8*)(lds + ML_Q + (16 * ti + fr) * PBY + ks * 64 + fq * 16), bc = *(const LAS bf16x8*)(lds + ML_C + (16 * vt + fr) * PBY + ks * 64 + fq * 16);
                  accA = MFMA16(aq, bc, accA);
                  const bf16x8 as = *(const LAS bf16x8*)(lds + ML_S + (16 * ti + fr) * PBY + ks * 64 + fq * 16), bv = *(const LAS bf16x8*)(lds + ML_VT + (16 * vt + fr) * PBY + ks * 64 + fq * 16);
                  accB = MFMA16(as, bv, accB); }
#pragma unroll
              for (int r = 0; r < 4; ++r) { const float num = wi[r] * accA[r] + accB[r]; const float hh_ = num * __builtin_amdgcn_rcpf(fmaxf(fabsf(den[r]), ei[r])); hv[i][r] = hh_; hq[r] += hh_ * hh_; } }
#pragma unroll
          for (int r = 0; r < 4; ++r) { const float x = red16(hq[r]); if (fr == 0) Fl[MF_HS + (16 * ti + 4 * fq + r) * 2 + (w >> 2)] = x; } }
        __syncthreads();
        if (pvar != 6) {
        { const int ti = w & 3;
#pragma unroll
          for (int r = 0; r < 4; ++r) { const int t = 16 * ti + 4 * fq + r; const float sc = __builtin_amdgcn_rsqf((Fl[MF_HS + 2 * t] + Fl[MF_HS + 2 * t + 1]) * (1.f / 128.f) + NORM_EPS);
#pragma unroll
              for (int i = 0; i < 4; ++i) ((lds_u16*)(lds + ML_HB))[t * (RPY / 2) + 16 * (4 * (w >> 2) + i) + fr] = f2bf1(hv[i][r] * sc); } }
        { const float wst = __expf(b63 + m_c - m_n);
#pragma unroll
          for (int kt = 0; kt < 4; ++kt) { Cacc[kt] = Cacc[kt] * wst;
#pragma unroll
              for (int ks = 0; ks < 2; ++ks) { const bf16x8 a = *(const LAS bf16x8*)(lds + ML_VT + (16 * w + fr) * PBY + ks * 64 + fq * 16), bb = *(const LAS bf16x8*)(lds + ML_KT + (16 * kt + fr) * PBY + ks * 64 + fq * 16);
                  Cacc[kt] = MFMA16(a, bb, Cacc[kt]); }
#pragma unroll
              for (int r = 0; r < 4; ++r) ((lds_u16*)(lds + ML_C))[(16 * w + 4 * fq + r) * 72 + 16 * kt + fr] = f2bf1(Cacc[kt][r]); }
          if (w == 0) { float sum = 0.f;
#pragma unroll
              for (int q = 0; q < 8; ++q) { float k8[8]; unpack8(*(const LAS v4u*)(lds + ML_KT + lane * PBY + 16 * q), k8);
#pragma unroll
                  for (int e = 0; e < 8; ++e) sum += k8[e]; }
              Fl[MF_N + lane] = wst * Fl[MF_N + lane] + sum; } }
        }
        __syncthreads();
        if (pvar != 7)
#pragma unroll
        for (int i = 0; i < 2; ++i) { const int t = ot + 32 * i; float h8[8], o8[8]; unpack8(*(const LAS v4u*)(lds + ML_HB + t * RPY + 16 * og), h8); unpack8(ro[i], o8);
#pragma unroll
            for (int e = 0; e < 8; ++e) h8[e] = h8[e] * nw[e] * o8[e];
            *(v4u*)(HOb + (size_t)(rowc + t) * D + hh * 128 + 8 * og) = pack8(h8); }
    }
#undef ML_LOAD_QKV
#undef ML_LOAD_O
#pragma unroll
    for (int kt = 0; kt < 4; ++kt)
#pragma unroll
        for (int r = 0; r < 4; ++r) out[O_P_C + ((size_t)(b * 8 + hh) * 128 + 16 * w + 4 * fq + r) * 64 + 16 * kt + fr] = Cacc[kt][r];
    if (w == 0) { out[O_P_N + (size_t)(b * 8 + hh) * 64 + lane] = Fl[MF_N + lane]; if (lane == 0) out[O_P_M + b * 8 + hh] = Fl[MF_MC + PT / 64]; }
    if (tid < 384) { const int j = tid >> 7, c = tid & 127, gc = c < 64 ? hh * 64 + c : 512 + hh * 64 + (c - 64);
        out[O_P_CONV + (size_t)(b * 3 + j) * D + gc] = bf1(QKR[(size_t)(b * PT + PT - 3 + j) * D + gc]); }
    __syncthreads();
}
__device__ __forceinline__ void mlstm_sample_item(const Frame& F, int b, int hh, const bf16* QKR, const bf16* VVb, const bf16* OOb, const float* IFb, bf16* HOb,
                                                  const float* conv_w, const float* conv_b, const float* norm_w, const float* C0, const float* n0, const float* m0p, const float* conv0, float* out) {
    LAS float* L = (LAS float*)F.lds;
    constexpr int LQ = 0, LK = 256, LV = 512, LS = 1024, LQN = 1040, LHS = 1048;
    const int tid = F.tid, lane = F.lane, w = F.wave, row0 = MP + 4 * b;
    float li[4], lf[4];
#pragma unroll
    for (int t = 0; t < 4; ++t) { li[t] = IFb[(size_t)(row0 + t) * 16 + hh]; lf[t] = IFb[(size_t)(row0 + t) * 16 + 8 + hh]; }
    const float m0 = m0p[b * 8 + hh];
    float bc[4], av[4], mt[4], wi[4], wsv[4], ei[4], bm[4];
    { float run = 0.f, pm = -3.0e38f;
#pragma unroll
      for (int t = 0; t < 4; ++t) { run += lf[t]; bc[t] = run; av[t] = li[t] - run; pm = fmaxf(pm, av[t]); mt[t] = fmaxf(run + m0, run + pm); } }
    const float m_new = mt[3], wst = __expf(bc[3] + m0 - m_new);
#pragma unroll
    for (int t = 0; t < 4; ++t) { wi[t] = __expf(bc[t] + m0 - mt[t]); wsv[t] = __expf(bc[3] + av[t] - m_new); ei[t] = __expf(-mt[t]); bm[t] = bc[t] - mt[t]; }
    { const int t = tid >> 7, c = tid & 127, gc = c < 64 ? hh * 64 + c : 512 + hh * 64 + (c - 64);
      float x[4];
#pragma unroll
      for (int j = 0; j < 4; ++j) { const int p = t + j; x[j] = p < 3 ? conv0[(size_t)(b * 3 + p) * D + gc] : bf1(QKR[(size_t)(row0 + p - 3) * D + gc]); }
      float a = conv_b[gc];
#pragma unroll
      for (int j = 0; j < 4; ++j) a += conv_w[j * D + gc] * x[j];
      const float val = siluf_(a);
      if (c < 64) L[LQ + t * 64 + c] = val * 0.125f; else L[LK + t * 64 + (c - 64)] = val;
      if (t >= 1) out[O_S_CONV + (size_t)(b * 3 + t - 1) * D + gc] = x[3];
      L[LV + t * 128 + c] = bf1(VVb[(size_t)(row0 + t) * D + hh * 128 + c]); }
    __syncthreads();
    if (w == 0) { const int pair = lane >> 2, t = pair >> 2, s = pair & 3, part = lane & 3; float dsum = 0.f;
#pragma unroll
        for (int e = 0; e < 16; ++e) dsum += L[LQ + t * 64 + 16 * part + e] * L[LK + s * 64 + 16 * part + e];
        dsum = red4(dsum);
        const float bmt = t == 0 ? bm[0] : (t == 1 ? bm[1] : (t == 2 ? bm[2] : bm[3])), avs = s == 0 ? av[0] : (s == 1 ? av[1] : (s == 2 ? av[2] : av[3]));
        if (part == 0) L[LS + pair] = s <= t ? dsum * __expf(bmt + avs) : 0.f; }
    if (w == 1) { const int t = lane >> 4, part = lane & 15; float dsum = 0.f;
#pragma unroll
        for (int e = 0; e < 4; ++e) dsum += L[LQ + t * 64 + 4 * part + e] * n0[(size_t)(b * 8 + hh) * 64 + 4 * part + e];
        dsum = red16(dsum); if (part == 0) L[LQN + t] = dsum; }
    __syncthreads();
    const int v = tid >> 2, kq = tid & 3;
    float hvv[4];
    { const size_t coff = ((size_t)(b * 8 + hh) * 128 + v) * 64 + 16 * kq;
      float c0[16];
#pragma unroll
      for (int e4 = 0; e4 < 4; ++e4) { const f32x4 x = *(const f32x4*)(C0 + coff + 4 * e4); c0[4 * e4] = x.x; c0[4 * e4 + 1] = x.y; c0[4 * e4 + 2] = x.z; c0[4 * e4 + 3] = x.w; }
#pragma unroll
      for (int t = 0; t < 4; ++t) { float part = 0.f;
#pragma unroll
          for (int e = 0; e < 16; ++e) part += c0[e] * L[LQ + t * 64 + 16 * kq + e];
          const float inter = red4(part);
          float num = wi[t] * inter, den = wi[t] * L[LQN + t];
#pragma unroll
          for (int s = 0; s < 4; ++s) { const float sm = L[LS + t * 4 + s]; num += sm * L[LV + s * 128 + v]; den += sm; }
          hvv[t] = num / fmaxf(fabsf(den), ei[t]); }
#pragma unroll
      for (int t = 0; t < 4; ++t) { const float x = wave_sum(kq == 0 ? hvv[t] * hvv[t] : 0.f); if (lane == 0) L[LHS + w * 4 + t] = x; }
      float cn[16];
#pragma unroll
      for (int e = 0; e < 16; ++e) { float a = wst * c0[e];
#pragma unroll
          for (int s = 0; s < 4; ++s) a += wsv[s] * L[LV + s * 128 + v] * L[LK + s * 64 + 16 * kq + e];
          cn[e] = a; }
#pragma unroll
      for (int e4 = 0; e4 < 4; ++e4) *(f32x4*)(out + O_S_C + coff + 4 * e4) = (f32x4){cn[4 * e4], cn[4 * e4 + 1], cn[4 * e4 + 2], cn[4 * e4 + 3]}; }
    __syncthreads();
    if (kq == 0) {
#pragma unroll
        for (int t = 0; t < 4; ++t) { float tot = 0.f;
#pragma unroll
            for (int ww = 0; ww < 8; ++ww) tot += L[LHS + ww * 4 + t];
            const float sc = 1.0f / sqrtf(tot * (1.f / 128.f) + NORM_EPS); const size_t off = (size_t)(row0 + t) * D + hh * 128 + v;
            HOb[off] = f2bf1(hvv[t] * sc * norm_w[hh * 128 + v] * bf1(OOb[off])); } }
    if (tid < 64) { float a = wst * n0[(size_t)(b * 8 + hh) * 64 + tid];
#pragma unroll
        for (int s = 0; s < 4; ++s) a += wsv[s] * L[LK + s * 64 + tid];
        out[O_S_N + (size_t)(b * 8 + hh) * 64 + tid] = a; }
    if (tid == 0) out[O_S_M + b * 8 + hh] = m_new;
    __syncthreads();
}

constexpr int CA_AH = 0, CA_BH = 9216, CA_KH = 18432, CA_RH = 27648, CA_BT = 36864, CA_KT = 46080, CA_VT = 55296, CA_AB = 64512, CA_AK = 73728, CA_RB = 82944, CA_RK = 92160, CA_XT = 101376,
              CA_TD = 119808, CA_NF = 123904, CA_GL = 128000, CA_LG = CA_AB  , CA_AT = CA_KH  ;
__device__ __forceinline__ bf16x8 ldsfrag(LAS unsigned char* lds, int base, int row, int ks, int fq) { return *(const LAS bf16x8*)(lds + base + row * PBY + ks * 64 + fq * 16); }
__device__ __forceinline__ void rwkv_chunk_item(const Frame& F, int chain, int chunk, bf16* Rb, bf16* Kb, bf16* Vb, bf16* Db, bf16* Ab, bf16* Gb,
                                                const float* k_k, const float* k_a, const float* r_k, float* BON, bf16* dummy, v4u (&pf)[6], const int nchain, const int nchunk) {
    LAS unsigned char* lds = F.lds;
    const int tid = F.tid, lane = F.lane, w = F.wave, fr = lane & 15, fq = lane >> 4, cg = tid & 7, tt = tid >> 3;
    const int h = chain & 15, row0 = (chain >> 4) * PT + 64 * chunk, ch = h * 64 + 8 * cg;
    const size_t goff = (size_t)(row0 + tt) * D + ch;
    LAS float* LG = (LAS float*)(lds + CA_LG); LAS float* GLf = (LAS float*)(lds + CA_GL);
    float r8[8], kp[8], av[8], bv[8], rd[8];
    {
        float k8[8], v8[8], d8[8], a8[8];
        unpack8(pf[0], r8); unpack8(pf[1], k8); unpack8(pf[2], v8); unpack8(pf[3], d8); unpack8(pf[4], a8);
        float ss = 0.f;
#pragma unroll
        for (int j = 0; j < 8; ++j) { av[j] = k8[j] * k_k[ch + j]; ss += av[j] * av[j]; }
        ss = red8(ss); const float inv = __builtin_amdgcn_rsqf(fmaxf(ss, 1e-24f));
        float bsum = 0.f;
#pragma unroll
        for (int j = 0; j < 8; ++j) { const float kk = av[j] * inv; kp[j] = k8[j] * (1.f + (a8[j] - 1.f) * k_a[ch + j]); bv[j] = kk * a8[j]; av[j] = -kk; bsum += r8[j] * kp[j] * r_k[ch + j]; rd[j] = __builtin_amdgcn_rcpf(1.f - d8[j]); }
        const float bon = red8(bsum);
#pragma unroll
        for (int j = 0; j < 8; ++j) { LG[(8 * cg + j) * 64 + tt] = __logf(1.f - d8[j]); ((lds_u16*)(lds + CA_VT))[(8 * cg + j) * 72 + tt] = f2bf1(v8[j]); }
        if (cg == 0 && !dummy) BON[(size_t)(row0 + tt) * 16 + h] = bon;
    }
    for (int i = tid; i < 128 * 9; i += 512) ((LAS v4u*)(lds + CA_XT))[i] = (v4u){0u, 0u, 0u, 0u};
    __syncthreads();
    { float x[8];
#pragma unroll
      for (int q = 0; q < 8; ++q) x[q] = LG[(8 * w + q) * 64 + lane];
#pragma unroll
      for (int q = 0; q < 8; ++q) {
          float v = x[q];
          v += __builtin_bit_cast(float, __builtin_amdgcn_update_dpp(0, __builtin_bit_cast(int, v), 0x111, 0xF, 0xF, true));
          v += __builtin_bit_cast(float, __builtin_amdgcn_update_dpp(0, __builtin_bit_cast(int, v), 0x112, 0xF, 0xF, true));
          v += __builtin_bit_cast(float, __builtin_amdgcn_update_dpp(0, __builtin_bit_cast(int, v), 0x114, 0xF, 0xF, true));
          v += __builtin_bit_cast(float, __builtin_amdgcn_update_dpp(0, __builtin_bit_cast(int, v), 0x118, 0xF, 0xF, true));
          v += __builtin_bit_cast(float, __builtin_amdgcn_update_dpp(0, __builtin_bit_cast(int, v), 0x142, 0xA, 0xF, false));
          v += __builtin_bit_cast(float, __builtin_amdgcn_update_dpp(0, __builtin_bit_cast(int, v), 0x143, 0xC, 0xF, false));
          x[q] = v; }
#pragma unroll
      for (int q = 0; q < 8; ++q) LG[(8 * w + q) * 64 + lane] = x[q]; }
    __syncthreads();
    {
        float ah[8], bh[8], kh[8], rh[8];
#pragma unroll
        for (int j = 0; j < 8; ++j) { const float lg = LG[(8 * cg + j) * 64 + tt]; const float G = __expf(lg), Gm1 = G * rd[j], Gi = __builtin_amdgcn_rcpf(G);
            ah[j] = av[j] * Gm1; bh[j] = bv[j] * Gi; kh[j] = kp[j] * Gi; rh[j] = r8[j] * G;
            ((lds_u16*)(lds + CA_BT))[(8 * cg + j) * 72 + tt] = f2bf1(bh[j]); ((lds_u16*)(lds + CA_KT))[(8 * cg + j) * 72 + tt] = f2bf1(kh[j]);
            if (tt == 63) GLf[8 * cg + j] = G; }
        *(LAS v4u*)(lds + CA_AH + tt * PBY + 16 * cg) = pack8(ah); *(LAS v4u*)(lds + CA_BH + tt * PBY + 16 * cg) = pack8(bh);
        *(LAS v4u*)(lds + CA_KH + tt * PBY + 16 * cg) = pack8(kh); *(LAS v4u*)(lds + CA_RH + tt * PBY + 16 * cg) = pack8(rh);
    }
    __syncthreads();
    {
        const int mi = w >> 1, ti0 = 2 * (w & 1); const int abase = mi < 2 ? CA_AH : CA_RH, bbase = (mi & 1) ? CA_KH : CA_BH, dbase = CA_AB + mi * 9216;
        bf16x8 af[2][2], bfr[4][2];
#pragma unroll
        for (int a = 0; a < 2; ++a)
#pragma unroll
            for (int ks = 0; ks < 2; ++ks) af[a][ks] = ldsfrag(lds, abase, 16 * (ti0 + a) + fr, ks, fq);
#pragma unroll
        for (int sj = 0; sj < 4; ++sj)
#pragma unroll
            for (int ks = 0; ks < 2; ++ks) bfr[sj][ks] = ldsfrag(lds, bbase, 16 * sj + fr, ks, fq);
#pragma unroll
        for (int a = 0; a < 2; ++a)
#pragma unroll
            for (int sj = 0; sj < 4; ++sj) { const int ti = ti0 + a; f32x4 acc = {0.f, 0.f, 0.f, 0.f};
#pragma unroll
                for (int ks = 0; ks < 2; ++ks) acc = MFMA16(bfr[sj][ks], af[a][ks], acc);
                const int t = 16 * ti + fr;
#pragma unroll
                for (int r = 0; r < 4; ++r) { const int s = 16 * sj + 4 * fq + r; acc[r] = (mi < 2 ? s < t : s <= t) ? acc[r] : 0.f; }
                typedef unsigned u2v_ __attribute__((ext_vector_type(2))); u2v_ pw; pw.x = pkbf(acc[0], acc[1]); pw.y = pkbf(acc[2], acc[3]);
                *(LAS u2v_*)(lds + dbase + (t * 72 + 16 * sj + 4 * fq) * 2) = pw;
                if (mi == 0 && ti == sj) *(LAS f32x4*)(lds + CA_NF + (ti * 256 + fr * 16 + 4 * fq) * 4) = acc; }
    }
    __syncthreads();
    f32x4 rhs[4];
    if (w == 0) { const int blk = fq, c = fr; const LAS float* N = (const LAS float*)(lds + CA_NF) + blk * 256; float T[16];
#pragma unroll
        for (int i = 0; i < 16; ++i) { float s = (i == c) ? 1.f : 0.f;
#pragma unroll
            for (int j = 0; j < i; ++j) s += N[i * 16 + j] * T[j];
            T[i] = s; }
        lds_u16* td = (lds_u16*)(lds + CA_TD) + blk * 512;
#pragma unroll
        for (int i = 0; i < 16; ++i) { td[i * 32 + c] = f2bf1(T[i]); td[i * 32 + 16 + c] = 0; } }
    if (w < 4) {
#pragma unroll
        for (int i = 0; i < 4; ++i)
#pragma unroll
            for (int r = 0; r < 4; ++r) rhs[i][r] = bf1(((lds_u16*)(lds + CA_AH))[(16 * i + 4 * fq + r) * 72 + 16 * w + fr]);
    } else {
#pragma unroll
        for (int i = 0; i < 4; ++i) { f32x4 acc = {0.f, 0.f, 0.f, 0.f};
#pragma unroll
            for (int ks = 0; ks < 2; ++ks) acc = MFMA16(ldsfrag(lds, CA_AK, 16 * i + fr, ks, fq), ldsfrag(lds, CA_VT, 16 * (w - 4) + fr, ks, fq), acc);
            rhs[i] = acc; }
    }
    __syncthreads();
    {
        LAS unsigned char* AT = lds + CA_AT + w * 1024;
        *(LAS unsigned long long*)(AT + fr * 64 + 32 + fq * 8) = 0ull;
#pragma unroll
        for (int i = 0; i < 4; ++i) { f32x4 acc = rhs[i];
#pragma unroll
            for (int ks = 0; ks < 2; ++ks) acc = MFMA16(ldsfrag(lds, CA_AB, 16 * i + fr, ks, fq), ldsfrag(lds, CA_XT, 16 * w + fr, ks, fq), acc);
            typedef unsigned u2v __attribute__((ext_vector_type(2)));
            u2v pa; pa.x = pkbf(acc[0], acc[1]); pa.y = pkbf(acc[2], acc[3]);
            *(LAS u2v*)(AT + fr * 64 + fq * 8) = pa;
            asm volatile("s_waitcnt lgkmcnt(0)" ::: "memory");
            f32x4 xi = {0.f, 0.f, 0.f, 0.f};
            xi = MFMA16(*(const LAS bf16x8*)(lds + CA_TD + i * 1024 + fr * 64 + fq * 16), *(const LAS bf16x8*)(AT + fr * 64 + fq * 16), xi);
            u2v px; px.x = pkbf(xi[0], xi[1]); px.y = pkbf(xi[2], xi[3]);
            *(LAS u2v*)(lds + CA_XT + (16 * w + fr) * PBY + (16 * i + 4 * fq) * 2) = px;
            asm volatile("s_waitcnt lgkmcnt(0)" ::: "memory"); }
    }
    __syncthreads();
    if (nchain >= 0) { const size_t no = (size_t)((nchain >> 4) * PT + 64 * nchunk + tt) * D + (nchain & 15) * 64 + 8 * cg;
        pf[0] = *(const v4u*)(Rb + no); pf[1] = *(const v4u*)(Kb + no); pf[2] = *(const v4u*)(Vb + no); pf[3] = *(const v4u*)(Db + no); pf[4] = *(const v4u*)(Ab + no); }
    {
        const int mi = w >> 1, ti0 = 2 * (w & 1); const int obase = mi == 0 ? CA_AB : (mi == 1 ? CA_AK : (mi == 2 ? CA_AH : CA_KH));
        const int a1 = mi < 2 ? CA_RB : (mi == 2 ? CA_BT : CA_XT), a1o = mi == 3 ? 64 : 0, b1 = mi == 3 ? CA_BT : CA_XT, b1o = mi == 1 ? 64 : 0;
        const int a2 = mi == 1 ? CA_RK : CA_VT, b2 = mi == 1 ? CA_VT : CA_KT; const bool two = (mi & 1) != 0;
        bf16x8 af[2][2], bfr[4][2];
#pragma unroll
        for (int a = 0; a < 2; ++a)
#pragma unroll
            for (int ks = 0; ks < 2; ++ks) af[a][ks] = ldsfrag(lds, a1, a1o + 16 * (ti0 + a) + fr, ks, fq);
#pragma unroll
        for (int tj = 0; tj < 4; ++tj)
#pragma unroll
            for (int ks = 0; ks < 2; ++ks) bfr[tj][ks] = ldsfrag(lds, b1, b1o + 16 * tj + fr, ks, fq);
        f32x4 acc[2][4];
#pragma unroll
        for (int a = 0; a < 2; ++a)
#pragma unroll
            for (int tj = 0; tj < 4; ++tj) { acc[a][tj] = (f32x4){0.f, 0.f, 0.f, 0.f};
#pragma unroll
                for (int ks = 0; ks < 2; ++ks) acc[a][tj] = MFMA16(bfr[tj][ks], af[a][ks], acc[a][tj]); }
        if (two) {
#pragma unroll
            for (int a = 0; a < 2; ++a)
#pragma unroll
                for (int ks = 0; ks < 2; ++ks) af[a][ks] = ldsfrag(lds, a2, 16 * (ti0 + a) + fr, ks, fq);
#pragma unroll
            for (int tj = 0; tj < 4; ++tj)
#pragma unroll
                for (int ks = 0; ks < 2; ++ks) bfr[tj][ks] = ldsfrag(lds, b2, 16 * tj + fr, ks, fq);
#pragma unroll
            for (int a = 0; a < 2; ++a)
#pragma unroll
                for (int tj = 0; tj < 4; ++tj)
#pragma unroll
                    for (int ks = 0; ks < 2; ++ks) acc[a][tj] = MFMA16(bfr[tj][ks], af[a][ks], acc[a][tj]);
        }
#pragma unroll
        for (int a = 0; a < 2; ++a) { const int row = 16 * (ti0 + a) + fr; const float glr = GLf[row];
#pragma unroll
            for (int tj = 0; tj < 4; ++tj) { const int col = 16 * tj + 4 * fq; f32x4 val = acc[a][tj];
                typedef unsigned u2v_ __attribute__((ext_vector_type(2)));
                if (mi == 0) { const u2v_ rr = *(const LAS u2v_*)(lds + CA_RH + (row * 72 + col) * 2); val += (f32x4){bflo(rr.x), bfhi(rr.x), bflo(rr.y), bfhi(rr.y)}; }
                else if (mi == 2) {
#pragma unroll
                    for (int r = 0; r < 4; ++r) val[r] = glr * (val[r] + (row == col + r ? 1.f : 0.f)); }
                else if (mi == 3) val = val * *(const LAS f32x4*)(GLf + col);
                u2v_ pw; pw.x = pkbf(val[0], val[1]); pw.y = pkbf(val[2], val[3]);
                *(LAS u2v_*)(lds + obase + (row * 72 + col) * 2) = pw; } }
    }
    __syncthreads();
    *(v4u*)((dummy ? dummy : Rb) + goff) = *(const LAS v4u*)(lds + CA_AB + tt * PBY + 16 * cg);
    *(v4u*)((dummy ? dummy : Ab) + goff) = *(const LAS v4u*)(lds + CA_AK + tt * PBY + 16 * cg);
    *(v4u*)((dummy ? dummy : Kb) + goff) = *(const LAS v4u*)(lds + CA_AH + tt * PBY + 16 * cg);
    *(v4u*)((dummy ? dummy : Db) + goff) = *(const LAS v4u*)(lds + CA_KH + tt * PBY + 16 * cg);
    __syncthreads();
}
constexpr int CB_S = 0, CB_P2 = 9216, CB_P3 = 18432, CB_Y0 = 27648, CB_Z0 = 36864, CB_YS = 46080  ;
__device__ __forceinline__ void rwkv_state_chain(const Frame& F, int chain, float* ST, const bf16* Rb, const bf16* Kb, const bf16* Vb, const bf16* Db, const bf16* Ab, bf16* Gb, const float* BON, const float* gn_w, const float* gn_b, bf16* dummy) {
    LAS unsigned char* lds = F.lds;
    const int tid = F.tid, lane = F.lane, w = F.wave, fr = lane & 15, fq = lane >> 4, cg = tid & 7, tt = tid >> 3;
    const int h = chain & 15, rowc0 = (chain >> 4) * PT, ch = h * 64 + 8 * cg;
    for (int i = tid; i < 64 * 36; i += 512) ((LAS unsigned*)(lds + CB_S))[i] = 0u;
    f32x4 Sacc[2];
    Sacc[0] = (f32x4){0.f, 0.f, 0.f, 0.f}; Sacc[1] = Sacc[0];
    v4u q2, q3, qy, qz, qg, qb; float qbon;
    float cgw[8], cgb[8];
#pragma unroll
    for (int j = 0; j < 8; ++j) { cgw[j] = gn_w[ch + j]; cgb[j] = gn_b[ch + j]; }
#define CB_LOAD(cc) do { const size_t o_ = (size_t)(rowc0 + 64 * (cc) + tt) * D + ch; q2 = *(const v4u*)(Rb + o_); q3 = *(const v4u*)(Kb + o_); qy = *(const v4u*)(Ab + o_); qz = *(const v4u*)(Db + o_); \
        qg = *(const v4u*)(Gb + o_); qb = *(const v4u*)(Vb + o_); qbon = BON[(size_t)(rowc0 + 64 * (cc) + tt) * 16 + h]; } while (0)
    CB_LOAD(0);
    for (int c = 0; c < PT / 64; ++c) {
        *(LAS v4u*)(lds + CB_P2 + tt * PBY + 16 * cg) = q2; *(LAS v4u*)(lds + CB_P3 + tt * PBY + 16 * cg) = q3;
        *(LAS v4u*)(lds + CB_Y0 + tt * PBY + 16 * cg) = qy; *(LAS v4u*)(lds + CB_Z0 + tt * PBY + 16 * cg) = qz;
        float gw[8], gb[8]; unpack8(qg, gw); unpack8(qb, gb);
        const float bonc = qbon;
        if (c + 1 < PT / 64) CB_LOAD(c + 1);
        __syncthreads();
        f32x4 yacc[2];
#pragma unroll
        for (int q = 0; q < 2; ++q) { const int tq = 2 * w + q, ti = tq >> 2, tj = tq & 3;
            f32x4 ya, sa;
#pragma unroll
            for (int r = 0; r < 4; ++r) { ya[r] = bf1(((lds_u16*)(lds + CB_Y0))[(16 * ti + 4 * fq + r) * 72 + 16 * tj + fr]); sa[r] = bf1(((lds_u16*)(lds + CB_Z0))[(16 * ti + 4 * fq + r) * 72 + 16 * tj + fr]); }
#pragma unroll
            for (int ks = 0; ks < 2; ++ks) { ya = MFMA16(ldsfrag(lds, CB_P2, 16 * ti + fr, ks, fq), ldsfrag(lds, CB_S, 16 * tj + fr, ks, fq), ya);
                                             sa = MFMA16(ldsfrag(lds, CB_S, 16 * ti + fr, ks, fq), ldsfrag(lds, CB_P3, 16 * tj + fr, ks, fq), sa); }
            yacc[q] = ya; Sacc[q] = sa; }
        __syncthreads();
#pragma unroll
        for (int q = 0; q < 2; ++q) { const int tq = 2 * w + q, ti = tq >> 2, tj = tq & 3;
#pragma unroll
            for (int r = 0; r < 4; ++r) { ((lds_u16*)(lds + CB_S))[(16 * ti + 4 * fq + r) * 72 + 16 * tj + fr] = f2bf1(Sacc[q][r]);
                                          ((LAS float*)(lds + CB_YS))[(16 * ti + 4 * fq + r) * 64 + 16 * tj + fr] = yacc[q][r]; } }
        __syncthreads();
        { const f32x4 y0 = *(const LAS f32x4*)(lds + CB_YS + (tt * 64 + 8 * cg) * 4), y1 = *(const LAS f32x4*)(lds + CB_YS + (tt * 64 + 8 * cg + 4) * 4);
          float yy[8] = {y0.x, y0.y, y0.z, y0.w, y1.x, y1.y, y1.z, y1.w}; float s1 = 0.f;
#pragma unroll
          for (int j = 0; j < 8; ++j) s1 += yy[j];
          const float mean = red8(s1) * (1.f / 64.f); float s2 = 0.f;
#pragma unroll
          for (int j = 0; j < 8; ++j) { yy[j] -= mean; s2 += yy[j] * yy[j]; }
          const float rstd = __builtin_amdgcn_rsqf(red8(s2) * (1.f / 64.f) + GN_EPS);
          float o[8];
#pragma unroll
          for (int j = 0; j < 8; ++j) o[j] = ((yy[j] * rstd) * cgw[j] + cgb[j] + bonc * gb[j]) * gw[j];
          *(v4u*)((dummy ? dummy : Gb) + (size_t)(rowc0 + 64 * c + tt) * D + ch) = pack8(o); }
    }
#undef CB_LOAD
#pragma unroll
    for (int q = 0; q < 2; ++q) { const int tq = 2 * w + q, ti = tq >> 2, tj = tq & 3;
#pragma unroll
        for (int r = 0; r < 4; ++r) ST[(16 * ti + 4 * fq + r) * 64 + 16 * tj + fr] = Sacc[q][r]; }
    __syncthreads();
}

#ifndef MK_N_LAUNCHES
#define MK_N_LAUNCHES 1
#endif
constexpr int N_PHASES = 22;
#ifndef PROBE_PH
#define PROBE_PH (-1)
#define PROBE_N 1
#endif
#ifndef PROBE_VAR
#define PROBE_VAR 0
#endif
#ifndef EN_MASK
#define EN_MASK 0xff
#endif
constexpr bool EN_NORM = EN_MASK & 1, EN_UP = EN_MASK & 2, EN_RES = EN_MASK & 4, EN_RW = EN_MASK & 8, EN_L2 = EN_MASK & 16, EN_SCAN = EN_MASK & 32, EN_IN = EN_MASK & 64, EN_ML = EN_MASK & 128;
struct Args { const float* in[N_IN]; float* out; unsigned char* ws; int ph_lo, ph_hi; };
__global__ void __launch_bounds__(NWAVES * 64, 2) mega_fwd(Args args) {
    extern __shared__ __attribute__((aligned(16))) unsigned char lds_raw[];
    { const int t0 = threadIdx.x;
      for (int u = t0; u < (LDS_BYTES - LDSCTL_OFF) / 4; u += NWAVES * 64) ((LAS unsigned*)((LAS unsigned char*)lds_raw + LDSCTL_OFF))[u] = 0u; }
    __syncthreads();
    { const int t0 = threadIdx.x; if (t0 < N_IN) ((LAS unsigned long long*)((LAS unsigned char*)lds_raw + TAB_OFF))[t0] = (unsigned long long)args.in[t0]; }
    __syncthreads();
    XcdBarrier bar; bar.bar = (unsigned*)((gu32*)(args.ws + WS_CTL) + CW_BAR); bar.x = 0; bar.st = nullptr;
    if (args.ph_hi - args.ph_lo > 1) bar = xcd_barrier_post((unsigned*)((gu32*)(args.ws + WS_CTL) + CW_BAR), (volatile LAS unsigned*)((LAS unsigned char*)lds_raw + MISC_OFF) + 8);
    int ph = args.ph_lo, rep = 0;
    while (ph < args.ph_hi) {
        int tid_ = threadIdx.x; asm volatile("" : "+v"(tid_));
        unsigned char* ws = args.ws; float* out = args.out;
        Frame F;
        F.lds = (LAS unsigned char*)lds_raw;
        F.MISC = (volatile LAS unsigned*)(F.lds + MISC_OFF);
        F.tid = tid_; F.lane = F.tid & 63; F.wave = __builtin_amdgcn_readfirstlane(F.tid >> 6);
        F.G = gridDim.x; { const int bx = blockIdx.x; F.vcu = (F.G % 8 == 0) ? (bx % 8) * (F.G / 8) + bx / 8 : bx; }
        F.ctl = (gu32*)(ws + WS_CTL); F.tab = (volatile LAS unsigned long long*)(F.lds + TAB_OFF);
        bf16* Wb = (bf16*)(ws + WS_W); float* XR = (float*)(ws + WS_XR); unsigned char* big = ws + WS_BIG;
        bf16* Hb = (bf16*)(big + B_H); bf16* XN = (bf16*)(big + B_XN); float* SLAB = (float*)(big + B_SLAB);
        bf16* ACAT = (bf16*)(big + B_ACAT); bf16* Rb = (bf16*)(big + B_R); bf16* Kb = (bf16*)(big + B_K); bf16* Vb = (bf16*)(big + B_V); bf16* DECb = (bf16*)(big + B_DEC); bf16* AAb = (bf16*)(big + B_AA);
        bf16* QKR = (bf16*)(big + B_QKR); bf16* VVb = (bf16*)(big + B_VV); bf16* HOb = (bf16*)(big + B_HO); bf16* OOb = (bf16*)(big + B_OO); float* IFb = (float*)(big + B_IF);
        bf16* GGb = (bf16*)((unsigned char*)out + OS_GG); bf16* LORA = (bf16*)((unsigned char*)out + OS_LORA);
        const int c_id = (int)blockIdx.x;
        const int nrep = (ph == PROBE_PH && ph != 6) ? PROBE_N : 1;
        const int pvar = (rep + 1 < nrep) ? PROBE_VAR : 0;
        if (EN_NORM && (ph == 0 || ph == 3 || ph == 8 || ph == 11 || ph == 14 || ph == 18 || ph == 21)) {
            int kind = 0, layer = 0, ab = 0, nslab = 0; float coef = 0.5f; const float* gain = nullptr;
            if (ph == 0) { kind = 0; layer = 0; ab = 0; gain = inptr(F, I_NFA); nslab = 0; }
            else if (ph == 3) { kind = 1; gain = inptr(F, I_NMIX); nslab = 11; }
            else if (ph == 8) { kind = 0; layer = 0; ab = 1; gain = inptr(F, I_NFB); nslab = 4; coef = 1.f; }
            else if (ph == 11) { kind = 0; layer = 1; ab = 0; gain = inptr(F, I_NFA) + D; nslab = 11; }
            else if (ph == 14) { kind = 2; gain = inptr(F, I_NMIX) + D; nslab = 11; }
            else if (ph == 18) { kind = -1; gain = inptr(F, I_NFB) + D; nslab = 4; coef = 1.f; }
            else { kind = -1; gain = inptr(F, I_NFIN); nslab = 11; }
            if (kind >= 0) convert_weights(F, kind, layer, ab, Wb);
            const float* base_p = ph == 0 ? inptr(F, I_XP) : XR; const float* base_s = (ph == 0 || ph == 3) ? inptr(F, I_XS) : XR + (size_t)MP * D;
            if (ph == 3) norm_rows<1>(F, base_p, base_s, nslab, coef, SLAB, XR, gain, ACAT, inptr(F, I_RSHIFT), out);
            else if (ph == 21) norm_rows<2>(F, base_p, base_s, nslab, coef, SLAB, XR, gain, nullptr, nullptr, out);
            else norm_rows<0>(F, base_p, base_s, nslab, coef, SLAB, XR, gain, XN, nullptr, out);
        } else if (EN_UP && (ph == 1 || ph == 9 || ph == 12 || ph == 19)) {
            const bf16* Wu = ph == 19 ? (const bf16*)(ws + WS_W2) : Wb;
            pg8::Gemm g{XN, Wu + W_GU / 2, M, 2 * FF, D}; pg8::UnitOrder S; S.init(M / 256, 2 * FF / 256, D, F.G, c_id, 0);
            EpiSwiglu E{Hb, pvar};
            pg8::gemm_phase<EpiSwiglu, pg8::UnitOrder, true, true>(F.lds, g, S, E, F.tid);
        } else if (EN_RES && (ph == 2 || ph == 7 || ph == 10 || ph == 13 || ph == 17 || ph == 20)) {
            const bf16* A = Hb; const bf16* Bt = (ph == 20 ? (const bf16*)(ws + WS_W2) : Wb) + W_D / 2; int K = FF; float coef = 0.5f; const float* base = XR;
            if (ph == 2) base = inptr(F, I_XP);
            if (ph == 7) { A = GGb; Bt = Wb + W_O / 2; K = D; coef = 1.f; }
            if (ph == 17) { A = HOb; Bt = Wb + W_OUT / 2; K = D; coef = 1.f; }
            pg8::Gemm g{A, Bt, M, D, K}; pg8::UnitOrder S; S.init(MP / 256, D / 256, K, F.G, c_id, K / 256);
            EpiRes E{base, XR, SLAB, coef};
            pg8::gemm_phase<EpiRes, pg8::UnitOrder, true, true>(F.lds, g, S, E, F.tid);
        } else if (EN_RW && ph == 4) {
            pg8::Gemm g{ACAT, Wb + W_RW / 2, M, NRW, KRW}; pg8::UnitOrder S; S.init(M / 256, NRW / 256, KRW, F.G, c_id, 0);
            EpiRw E{Rb, Kb, Vb, LORA};
            pg8::gemm_phase<EpiRw, pg8::UnitOrder, true, true>(F.lds, g, S, E, F.tid);
        } else if (EN_L2 && ph == 5) {
            pg8::Gemm g{LORA, Wb + W_L2 / 2, M, NL2, KL2}; pg8::UnitOrder S; S.init(M / 256, NL2 / 256, KL2, F.G, c_id, -1);
            EpiL2 E{DECb, AAb, GGb, inptr(F, I_W0), inptr(F, I_A0)};
            pg8::gemm_phase<EpiL2, pg8::UnitOrder, true, true>(F.lds, g, S, E, F.tid);
        } else if (EN_SCAN && ph == 6) {
            bf16* dummy = (bf16*)(ws + WS_YRAW);
            for (int dr = (PROBE_PH == 6 && PROBE_VAR == 5) ? PROBE_N - 1 : 0; dr >= 0; --dr) {
                v4u pf[6]; pf[5] = (v4u){0u, 0u, 0u, 0u};
                { const int it = F.vcu, cg_ = F.tid & 7, tt_ = F.tid >> 3; const size_t o = (size_t)(((it >> 5) >> 4) * PT + 64 * (it & 31) + tt_) * D + ((it >> 5) & 15) * 64 + 8 * cg_;
                  pf[0] = *(const v4u*)(Rb + o); pf[1] = *(const v4u*)(Kb + o); pf[2] = *(const v4u*)(Vb + o); pf[3] = *(const v4u*)(DECb + o); pf[4] = *(const v4u*)(AAb + o); }
                for (int it = F.vcu; it < PB * 16 * (PT / 64); it += F.G) { const int nx = it + F.G < PB * 16 * (PT / 64) ? it + F.G : -1;
                    rwkv_chunk_item(F, it >> 5, it & 31, Rb, Kb, Vb, DECb, AAb, GGb, inptr(F, I_KK), inptr(F, I_KA), inptr(F, I_RK), (float*)(ws + WS_BON), dr ? dummy : nullptr, pf, nx < 0 ? -1 : nx >> 5, nx & 31); }
            }
            xcd_barrier(bar);
            for (int dr = (PROBE_PH == 6 && PROBE_VAR == 6) ? PROBE_N - 1 : 0; dr >= 0; --dr)
                if (F.vcu < 128) rwkv_state_chain(F, F.vcu, out + O_P_S + (size_t)F.vcu * 4096, Rb, Kb, Vb, DECb, AAb, GGb, (const float*)(ws + WS_BON), inptr(F, I_GNW), inptr(F, I_GNB), dr ? dummy : nullptr);
            { const int i0 = F.vcu < 128 ? 2 * F.vcu : 256 + 14 * (F.vcu - 128), i1 = F.vcu < 128 ? i0 + 2 : i0 + 14;
              for (int i = i0; i < i1; ++i) { const int b = i >> 4, h = i & 15;
                  rwkv_chain(F, MP + b * STK, STK, h, inptr(F, I_RS) + (size_t)i * 4096, out + O_S_S + (size_t)i * 4096, Rb, Kb, Vb, DECb, AAb, GGb, inptr(F, I_KK), inptr(F, I_KA), inptr(F, I_RK), inptr(F, I_GNW), inptr(F, I_GNB), true, 0); } }
        } else if (EN_IN && ph == 15) {
            pg8::Gemm g{XN, Wb + W_IN / 2, M, NIN, D}; pg8::UnitOrder S; S.init(M / 256, NIN / 256, D, F.G, c_id, 0);
            EpiIn E{QKR, VVb, OOb, IFb, inptr(F, I_BIF)};
            pg8::gemm_phase<EpiIn, pg8::UnitOrder, true, true>(F.lds, g, S, E, F.tid);
        } else if (EN_ML && ph == 16) {
            const int Hh = F.G >= 128 ? 64 : (F.G / 2 > 0 ? F.G / 2 : 1);
            if (F.vcu < Hh && pvar != 2) {
                for (int i = F.vcu; i < PB * 8; i += Hh) mlstm_prompt_chain(F, i >> 3, i & 7, QKR, VVb, OOb, IFb, HOb, inptr(F, I_CW), inptr(F, I_CB), inptr(F, I_MNW), out, pvar);
            }
            if ((F.vcu >= Hh || F.G == 1) && pvar != 1 && pvar < 3) {
                const int st = F.G == 1 ? 1 : F.G - Hh;
                for (int i = F.G == 1 ? 0 : F.vcu - Hh; i < SB * 8; i += st)
                    mlstm_sample_item(F, i >> 3, i & 7, QKR, VVb, OOb, IFb, HOb, inptr(F, I_CW), inptr(F, I_CB), inptr(F, I_MNW), inptr(F, I_MC), inptr(F, I_MN), inptr(F, I_MM), inptr(F, I_MCONV), out);
            }
            if (F.vcu >= Hh && F.G > Hh && rep + 1 == nrep) convert_weights(F, 0, 1, 1, (bf16*)(ws + WS_W2), Hh);
        }
        if (++rep < nrep) continue;
        rep = 0;
        if (ph + 1 < args.ph_hi) xcd_barrier(bar);
        ++ph;
    }
}

extern "C" void kernel_launch(void* const* d_in, const int* in_sizes, int n_in, void* d_out, int out_size, void* d_ws, size_t ws_size, hipStream_t stream) {
    static int grid = 0;
    if (grid == 0) {
        if (n_in != N_IN || out_size != (int)O_END || ws_size < WS_END2) { fprintf(stderr, "kernel_launch: unexpected shapes (n_in %d, out %d, ws %zu); nothing launched\n", n_in, out_size, ws_size); grid = -1; return; }
        int dev = 0, cus = 0, per_cu = 0;
        if (hipGetDevice(&dev) != hipSuccess || hipDeviceGetAttribute(&cus, hipDeviceAttributeMultiprocessorCount, dev) != hipSuccess) { grid = -1; return; }
        if (hipFuncSetAttribute((const void*)mega_fwd, hipFuncAttributeMaxDynamicSharedMemorySize, LDS_BYTES) != hipSuccess) { fprintf(stderr, "kernel_launch: hipFuncSetAttribute failed\n"); grid = -1; return; }
        if (hipOccupancyMaxActiveBlocksPerMultiprocessor(&per_cu, (const void*)mega_fwd, NWAVES * 64, LDS_BYTES) != hipSuccess || per_cu < 1) { fprintf(stderr, "kernel_launch: occupancy query says %d\n", per_cu); per_cu = 1; }
        (void)hipGetLastError();
        grid = cus;
    }
    if (grid < 0) return;
    (void)hipMemsetAsync((char*)d_ws + WS_CTL, 0, CTL_ZERO_BYTES, stream);
    Args a{};
    for (int i = 0; i < N_IN; ++i) a.in[i] = (const float*)d_in[i];
    a.out = (float*)d_out; a.ws = (unsigned char*)d_ws;
#if MK_N_LAUNCHES == 1
    a.ph_lo = 0; a.ph_hi = N_PHASES;
    { void* kargs[] = {(void*)&a};
      const hipError_t e = hipLaunchCooperativeKernel((const void*)mega_fwd, dim3(grid), dim3(NWAVES * 64), kargs, LDS_BYTES, stream);
      if (e != hipSuccess) fprintf(stderr, "kernel_launch: cooperative launch failed: %s (grid %d)\n", hipGetErrorString(e), grid); }
#else
    for (int p = 0; p < N_PHASES; ++p) { a.ph_lo = p; a.ph_hi = p + 1; hipLaunchKernelGGL(mega_fwd, dim3(grid), dim3(NWAVES * 64), LDS_BYTES, stream, a); }
#endif
}
```

```cpp
#include <hip/hip_runtime.h>
#include <cstdio>
#include <cstdint>
namespace pg8 {
#define PG8_LAS __attribute__((address_space(3)))
typedef unsigned short bf16_t;
typedef short bf16x8 __attribute__((ext_vector_type(8)));
typedef float f32x4 __attribute__((ext_vector_type(4)));
typedef unsigned u32x4 __attribute__((ext_vector_type(4)));
constexpr int BM = 256, BK = 64, HALF = 128, HTB = HALF * BK * 2  , STAGE_BYTES = 8 * HTB, NXCD = 8, WGM = 8;

__host__ __device__ __forceinline__ int lds_byte(int r, int c) { const int st = (r >> 4) * 2 + (c >> 5), rr = r & 15, cc = c & 31, ob = rr * 64 + cc * 2; return st * 1024 + (ob ^ (((ob >> 9) & 1) << 5)); }
__host__ __device__ __forceinline__ void stage_rc(int b, int& R, int& C) { const int st = b / 1024, sb = b % 1024, swz = sb ^ (((sb >> 9) & 1) << 5); R = (st >> 1) * 16 + swz / 64; C = (st & 1) * 32 + (swz % 64) / 2; }
__host__ __device__ __forceinline__ int perm32(int rho) { const int n = rho >> 4, i = rho & 15; return 8 * (i >> 2) + 4 * n + (i & 3); }

struct Unit { int pm, pn, k0, nt, slab; };
struct Gemm { const bf16_t* A; const bf16_t* Bt; int M, N, K; };

struct UnitOrder {
    int nM, nN, nwg, G, c, ntf, tailS;
    __device__ __forceinline__ void init(int nM_, int nN_, int K, int G_, int c_, int tailS_) { nM = nM_; nN = nN_; nwg = nM * nN; G = G_; c = c_; ntf = K / BK; tailS = tailS_; }
    __device__ __forceinline__ bool next(int i, Unit& u) const {
        long L = (long)i * G + c;
        if (L < nwg) {
            int wgid = (int)L; { const int q = nwg / NXCD, r = nwg % NXCD, xcd = wgid % NXCD, off = wgid / NXCD; wgid = (xcd < r ? xcd * (q + 1) : r * (q + 1) + (xcd - r) * q) + off; }
            const int nig = WGM * nN, gid = wgid / nig, fm = gid * WGM, gsz = (nM - fm) < WGM ? (nM - fm) : WGM;
            u.pm = fm + ((wgid % nig) % gsz); u.pn = (wgid % nig) / gsz; u.k0 = 0; u.nt = ntf; u.slab = -1;
            if (tailS < 0) { u.nt = 4; u.k0 = u.pn >= 8 ? 128 : 0; }
            return true;
        }
        L -= nwg; if (tailS <= 0 || L >= 8 * tailS) return false;
        int tile, sl; if (tailS == 4) { tile = (int)L >> 2; sl = (int)L & 3; } else { tile = (int)L / 11; sl = (int)L - 11 * tile; }
        u.pm = 64 + (tile >> 2); u.pn = tile & 3; u.k0 = sl * 256; u.nt = 4; u.slab = sl; return true;
    }
    __device__ __forceinline__ void a_ready(const Unit&) const {}
    __device__ __forceinline__ void done(const Unit&) const {}
};
template <class Epi, class Sched, bool ALIGN_EPI = false, bool SP2 = false>
__device__ __forceinline__ void gemm_phase(PG8_LAS unsigned char* lds, const Gemm g, const Sched& S, const Epi& E, const int tid) {
    const int wid = __builtin_amdgcn_readfirstlane(tid >> 6), lane = tid & 63, wr = wid >> 2, wc = wid & 3, fr = lane & 15, fq = lane >> 4;
    const int K = g.K;
    unsigned voffA[2], voffB[2];
#pragma unroll
    for (int i = 0; i < 2; ++i) { int R, C; stage_rc(tid * 16 + i * 8192, R, C); const int Rb = Epi::PERM ? ((R & ~31) + perm32(R & 31)) : R;
        voffA[i] = (unsigned)(R * K + C) * 2u; voffB[i] = (unsigned)(Rb * K + C) * 2u; }
    const size_t kstep = (size_t)(BK * 2);
    const size_t hstep = (size_t)HALF * K * 2;
    const size_t tstep = 2 * hstep;
    const unsigned ldsw = (unsigned)wid * 1024u;
    const int aoff = lds_byte(wr * 64 + fr, fq * 8), boff = lds_byte(wc * 32 + fr, fq * 8);
#define PG8_SA(b, h) (((b) * 2 + (h)) * HTB)
#define PG8_SB(b, h) ((4 + (b) * 2 + (h)) * HTB)
#define PG8_STAGE(bufoff, gbase, voff) do { _Pragma("unroll") for (int _i = 0; _i < 2; ++_i) \
        __builtin_amdgcn_global_load_lds((const unsigned*)((const char*)(gbase) + (voff)[_i]), (PG8_LAS unsigned*)(lds + (bufoff) + ldsw + _i * 8192), 16, 0, 0); } while (0)
#define PG8_LDA(dst, b, h) do { _Pragma("unroll") for (int m = 0; m < 4; ++m) _Pragma("unroll") for (int k = 0; k < 2; ++k) dst[m][k] = *(const PG8_LAS bf16x8*)(lds + PG8_SA(b, h) + aoff + m * 2048 + k * 1024); } while (0)
#define PG8_LDB(dst, b, h) do { _Pragma("unroll") for (int n = 0; n < 2; ++n) _Pragma("unroll") for (int k = 0; k < 2; ++k) dst[n][k] = *(const PG8_LAS bf16x8*)(lds + PG8_SB(b, h) + boff + n * 2048 + k * 1024); } while (0)
#define PG8_MMA(ai, bj, At, Bt) do { __builtin_amdgcn_s_setprio(1); _Pragma("unroll") for (int m = 0; m < 4; ++m) _Pragma("unroll") for (int n = 0; n < 2; ++n) _Pragma("unroll") for (int k = 0; k < 2; ++k) \
        acc[ai][bj][m][n] = __builtin_amdgcn_mfma_f32_16x16x32_bf16(Bt[n][k], At[m][k], acc[ai][bj][m][n], 0, 0, 0); __builtin_amdgcn_s_setprio(0); } while (0)
#define PG8_WAIT_V(n) asm volatile("s_waitcnt vmcnt(" #n ")" ::: "memory")
#define PG8_WAIT_L(n) asm volatile("s_waitcnt lgkmcnt(" #n ")" ::: "memory")
#define PG8_BAR __builtin_amdgcn_s_barrier()
#define PG8_SCHED __builtin_amdgcn_sched_barrier(0)
    Unit cur, nxt; int ui = 0;
    if (!S.next(0, cur)) return;
    f32x4 acc[2][2][4][2];
#pragma unroll
    for (int a = 0; a < 2; ++a)
#pragma unroll
        for (int b = 0; b < 2; ++b)
#pragma unroll
            for (int m = 0; m < 4; ++m)
#pragma unroll
                for (int n = 0; n < 2; ++n) acc[a][b][m][n] = (f32x4){0.f, 0.f, 0.f, 0.f};
    bf16x8 At[4][2], B0[2][2], B1[2][2];
    const char* cA = (const char*)g.A + (size_t)cur.pm * tstep + (size_t)cur.k0 * 2; const char* cB = (const char*)g.Bt + (size_t)cur.pn * tstep + (size_t)cur.k0 * 2;
    S.a_ready(cur);
    if constexpr (SP2) {
        PG8_STAGE(PG8_SB(0, 0), cB, voffB); PG8_STAGE(PG8_SB(0, 1), cB + hstep, voffB); PG8_STAGE(PG8_SA(0, 0), cA, voffA); PG8_STAGE(PG8_SA(0, 1), cA + hstep, voffA);
        if (wr == 1) PG8_BAR;
        PG8_WAIT_V(2); PG8_BAR;
        PG8_STAGE(PG8_SB(1, 0), cB + kstep, voffB); PG8_STAGE(PG8_SA(1, 0), cA + kstep, voffA); PG8_STAGE(PG8_SB(1, 1), cB + hstep + kstep, voffB);
        PG8_WAIT_V(6); PG8_BAR;
    } else {
        PG8_STAGE(PG8_SB(0, 0), cB, voffB); PG8_STAGE(PG8_SA(0, 0), cA, voffA); PG8_STAGE(PG8_SB(0, 1), cB + hstep, voffB); PG8_STAGE(PG8_SA(0, 1), cA + hstep, voffA);
        if (wr == 1) PG8_BAR;
        PG8_WAIT_V(4); PG8_BAR;
        PG8_STAGE(PG8_SB(1, 0), cB + kstep, voffB); PG8_STAGE(PG8_SA(1, 0), cA + kstep, voffA); PG8_STAGE(PG8_SB(1, 1), cB + hstep + kstep, voffB);
        PG8_WAIT_V(6); PG8_BAR;
    }
    for (;;) {
        const bool has_next = S.next(ui + 1, nxt);
        const char* nA = has_next ? (const char*)g.A + (size_t)nxt.pm * tstep + (size_t)nxt.k0 * 2 : cA; const char* nB = has_next ? (const char*)g.Bt + (size_t)nxt.pn * tstep + (size_t)nxt.k0 * 2 : cB;
        const int nt = cur.nt;
        for (int t = 0; t < nt; t += 2) {
            const bool last = (t == nt - 2);
            const char* a1 = cA + (size_t)(t + 1) * kstep;
            const char* a2 = last ? nA : cA + (size_t)(t + 2) * kstep; const char* b2 = last ? nB : cB + (size_t)(t + 2) * kstep;
            const char* a3 = a2 + kstep; const char* b3 = b2 + kstep;
            if (last && has_next) S.a_ready(nxt);
            if constexpr (SP2) {
            PG8_LDB(B0, 0, 0); PG8_LDB(B1, 0, 1); PG8_SCHED; PG8_LDA(At, 0, 0); PG8_STAGE(PG8_SA(1, 1), a1 + hstep, voffA);
            PG8_WAIT_V(8); PG8_WAIT_L(0); PG8_BAR; PG8_MMA(0, 0, At, B0); PG8_MMA(0, 1, At, B1); PG8_BAR; PG8_SCHED;
            PG8_LDA(At, 0, 1); PG8_STAGE(PG8_SB(0, 0), b2, voffB); PG8_STAGE(PG8_SB(0, 1), b2 + hstep, voffB); PG8_STAGE(PG8_SA(0, 0), a2, voffA);
            PG8_WAIT_V(8); PG8_WAIT_L(0); PG8_BAR; PG8_MMA(1, 0, At, B0); PG8_MMA(1, 1, At, B1); PG8_BAR; PG8_SCHED;
            PG8_LDB(B0, 1, 0); PG8_LDB(B1, 1, 1); PG8_SCHED; PG8_LDA(At, 1, 0); PG8_STAGE(PG8_SA(0, 1), a2 + hstep, voffA);
            PG8_WAIT_V(8); PG8_WAIT_L(0); PG8_BAR; PG8_MMA(0, 0, At, B0); PG8_MMA(0, 1, At, B1); PG8_BAR; PG8_SCHED;
            PG8_LDA(At, 1, 1); PG8_STAGE(PG8_SB(1, 0), b3, voffB); PG8_STAGE(PG8_SB(1, 1), b3 + hstep, voffB); PG8_STAGE(PG8_SA(1, 0), a3, voffA);
            PG8_WAIT_V(8); PG8_WAIT_L(0); PG8_BAR; PG8_MMA(1, 0, At, B0); PG8_MMA(1, 1, At, B1); PG8_BAR; PG8_SCHED;
            } else {
            PG8_LDB(B0, 0, 0); PG8_SCHED; PG8_LDA(At, 0, 0); PG8_STAGE(PG8_SA(1, 1), a1 + hstep, voffA);
            PG8_WAIT_L(8); PG8_BAR; PG8_WAIT_L(0); PG8_MMA(0, 0, At, B0); PG8_BAR; PG8_SCHED;
            PG8_LDB(B1, 0, 1); PG8_STAGE(PG8_SB(0, 0), b2, voffB);
            PG8_BAR; PG8_WAIT_L(0); PG8_MMA(0, 1, At, B1); PG8_BAR;
            PG8_LDA(At, 0, 1); PG8_STAGE(PG8_SA(0, 0), a2, voffA);
            PG8_BAR; PG8_WAIT_L(0); PG8_MMA(1, 0, At, B0); PG8_BAR; PG8_SCHED;
            PG8_STAGE(PG8_SB(0, 1), b2 + hstep, voffB);
            PG8_WAIT_V(6); PG8_BAR; PG8_MMA(1, 1, At, B1); PG8_BAR;
            PG8_LDB(B0, 1, 0); PG8_SCHED; PG8_LDA(At, 1, 0); PG8_STAGE(PG8_SA(0, 1), a2 + hstep, voffA);
            PG8_WAIT_L(8); PG8_BAR; PG8_WAIT_L(0); PG8_MMA(0, 0, At, B0); PG8_BAR; PG8_SCHED;
            PG8_LDB(B1, 1, 1); PG8_STAGE(PG8_SB(1, 0), b3, voffB);
            PG8_BAR; PG8_WAIT_L(0); PG8_MMA(0, 1, At, B1); PG8_BAR;
            PG8_LDA(At, 1, 1); PG8_STAGE(PG8_SA(1, 0), a3, voffA);
            PG8_BAR; PG8_WAIT_L(0); PG8_MMA(1, 0, At, B0); PG8_BAR; PG8_SCHED;
            PG8_STAGE(PG8_SB(1, 1), b3 + hstep, voffB);
            PG8_WAIT_V(6); PG8_BAR; PG8_MMA(1, 1, At, B1); PG8_BAR;
            }
        }
        if constexpr (ALIGN_EPI) { if (wr == 0) PG8_BAR; }
        if constexpr (!Epi::AFTER_DRAIN) { E(acc, cur, wr, wc, fr, fq); S.done(cur); }
        if (!has_next) break;
#pragma unroll
        for (int a = 0; a < 2; ++a)
#pragma unroll
            for (int b = 0; b < 2; ++b)
#pragma unroll
                for (int m = 0; m < 4; ++m)
#pragma unroll
                    for (int n = 0; n < 2; ++n) acc[a][b][m][n] = (f32x4){0.f, 0.f, 0.f, 0.f};
        cur = nxt; cA = nA; cB = nB; ++ui;
        if constexpr (ALIGN_EPI) { if (wr == 1) PG8_BAR; }
    }
    PG8_WAIT_V(0);
    if constexpr (!ALIGN_EPI) { if (wr == 0) PG8_BAR; }
    PG8_BAR;
    if constexpr (Epi::AFTER_DRAIN) { E.fused(acc, cur, wr, wc, fr, fq, lds, wid, lane); S.done(cur); }
#undef PG8_SA
#undef PG8_SB
#undef PG8_STAGE
#undef PG8_LDA
#undef PG8_LDB
#undef PG8_MMA
#undef PG8_WAIT_V
#undef PG8_WAIT_L
#undef PG8_BAR
#undef PG8_SCHED
}
}

#define GAS __attribute__((address_space(1)))
#define LAS __attribute__((address_space(3)))
typedef unsigned short bf16;
typedef unsigned v4u __attribute__((ext_vector_type(4)));
typedef float f32x4 __attribute__((ext_vector_type(4)));
typedef short bf16x8 __attribute__((ext_vector_type(8)));
typedef GAS unsigned gu32;
typedef GAS unsigned long long gu64;
#define RLX_AGENT __ATOMIC_RELAXED, __HIP_MEMORY_SCOPE_AGENT
#define LDS_WAIT() asm volatile("s_waitcnt lgkmcnt(0)" ::: "memory")
#define VM_WAIT() asm volatile("s_waitcnt vmcnt(0)" ::: "memory")
__device__ __forceinline__ unsigned long long rt() { return __builtin_amdgcn_s_memrealtime(); }
__device__ __forceinline__ unsigned f2bf(float f) { unsigned u = __builtin_bit_cast(unsigned, f); return (u + 0x7fffu + ((u >> 16) & 1u)) >> 16; }
__device__ __forceinline__ unsigned pk2(float lo, float hi) { return f2bf(lo) | (f2bf(hi) << 16); }

#define XB_TMO      128
#define XB_XCNT(j)  (256  + 64 * (j))
#define XB_XSUB(j)  (1280 + 64 * (j))
#define XB_XGEN(j)  (2304 + 64 * (j))
#define XB_TOP      3328
#define XB_TOPGEN   3392
#define XCD_BAR_WORDS 3456
#define XB_SPIN_CAP (1u << 18)

__device__ __forceinline__ unsigned xb_ld(unsigned* p)              { return __hip_atomic_load(p, __ATOMIC_RELAXED, __HIP_MEMORY_SCOPE_AGENT); }
__device__ __forceinline__ unsigned xb_add(unsigned* p, unsigned v) { return __hip_atomic_fetch_add(p, v, __ATOMIC_RELAXED, __HIP_MEMORY_SCOPE_AGENT); }
__device__ __forceinline__ unsigned xb_xcc_id() { return (unsigned)__builtin_amdgcn_s_getreg((3 << 11) | 20) & 0xFu; }
#define XB_SPIN(cond, bar) do { unsigned _sp = 0; while (cond) { __builtin_amdgcn_s_sleep(1); \
    if ((++_sp & 255u) == 0u) { if (xb_ld(&(bar)[XB_TMO])) break; if (_sp > XB_SPIN_CAP) { atomicAdd(&(bar)[XB_TMO], 1u); break; } } } } while (0)

struct XcdBarrier {
    unsigned* bar; unsigned x;
    volatile LAS unsigned* st;
};

__device__ __forceinline__ XcdBarrier xcd_barrier_post(unsigned* bar, volatile LAS unsigned* st) {
    XcdBarrier b; b.bar = bar; b.x = xb_xcc_id(); b.st = st;
    if (threadIdx.x == 0) (void)xb_add(&bar[XB_XCNT(b.x)], 1u);
    return b;
}
__device__ __forceinline__ void xcd_barrier_complete(unsigned* bar, unsigned x, unsigned& nloc, unsigned& nx) {
    const unsigned G = gridDim.x * gridDim.y * gridDim.z;
    unsigned sum, cnt, mine, sp = 0u;
    for (;;) {
        sum = 0u; cnt = 0u; mine = 0u;
#pragma unroll
        for (unsigned j = 0; j < 16; ++j) { const unsigned c = xb_ld(&bar[XB_XCNT(j)]); sum += c; cnt += (c > 0u) ? 1u : 0u; mine = (j == x) ? c : mine; }
        if (sum == G) break;
        __builtin_amdgcn_s_sleep(1);
        if ((++sp & 255u) == 0u) { if (xb_ld(&bar[XB_TMO])) break; if (sp > XB_SPIN_CAP) { atomicAdd(&bar[XB_TMO], 1u); break; } }
    }
    nloc = mine > 0u ? mine : 1u; nx = cnt > 0u ? cnt : 1u;
}

__device__ __forceinline__ void xcd_barrier(const XcdBarrier& b) {
    asm volatile("s_waitcnt vmcnt(0)" ::: "memory");
    __syncthreads();
    if (threadIdx.x == 0) {
        unsigned* bar = b.bar;
        __builtin_amdgcn_s_waitcnt(0);
        unsigned nloc = b.st[0], nx = b.st[1];
        if (nloc == 0u) { xcd_barrier_complete(bar, b.x, nloc, nx); b.st[0] = nloc; b.st[1] = nx; }
        const unsigned old = xb_add(&bar[XB_XSUB(b.x)], 1u);
        const unsigned gen = old / nloc;
        if (old + 1u == (gen + 1u) * nloc) {
            __builtin_amdgcn_fence(__ATOMIC_RELEASE, "agent");
            asm volatile("s_waitcnt vmcnt(0)" ::: "memory");
            const unsigned og = xb_add(&bar[XB_TOP], 1u);
            const unsigned tg = og / nx;
            if (og + 1u == (tg + 1u) * nx) xb_add(&bar[XB_TOPGEN], 1u);
            else XB_SPIN(xb_ld(&bar[XB_TOPGEN]) == tg, bar);
            __builtin_amdgcn_fence(__ATOMIC_ACQUIRE, "agent");
            xb_add(&bar[XB_XGEN(b.x)], 1u);
            asm volatile("s_waitcnt vmcnt(0)" ::: "memory");
        } else {
            XB_SPIN(xb_ld(&bar[XB_XGEN(b.x)]) == gen, bar);
            __builtin_amdgcn_fence(__ATOMIC_ACQUIRE, "agent");
            asm volatile("s_waitcnt vmcnt(0)" ::: "memory");
        }
    }
    __syncthreads();
}

constexpr int NWAVES = 8;
constexpr int D = 1024, FF = 2816;
constexpr int PB = 8, PT = 2048, SB = 128, STK = 4;
constexpr int MP = PB * PT, MS = SB * STK, M = MP + MS;
constexpr int NRW = 3584, KRW = 2048, NL2 = 3072, KL2 = 384, NIN = 3328;
constexpr float NORM_EPS = 1e-6f, GN_EPS = 64e-5f;
typedef pg8::bf16_t bf16;

constexpr size_t MiB = 1u << 20;
constexpr size_t WS_CTL = 0, CTL_ZERO_BYTES = 64 * 1024;
constexpr size_t WS_W = 1 * MiB;
constexpr size_t WS_XR = 20 * MiB;
constexpr size_t WS_BIG = 86 * MiB;
constexpr size_t WS_END = 256 * MiB;
constexpr size_t WS_YRAW = 256 * MiB, WS_BON = 288 * MiB, WS_W2 = 289 * MiB  , WS_END2 = 308 * MiB;
constexpr size_t W_GU = 0, W_D = (size_t)2 * FF * D * 2;
constexpr size_t W_RW = 0, W_L2 = (size_t)NRW * KRW * 2, W_O = W_L2 + (size_t)NL2 * KL2 * 2;
constexpr size_t W_IN = 0, W_OUT = (size_t)NIN * D * 2;
static_assert(W_D + (size_t)D * FF * 2 <= 19 * MiB && W_O + (size_t)D * D * 2 <= 19 * MiB && W_OUT + (size_t)D * D * 2 <= 19 * MiB, "weights region");
constexpr size_t B_H = 0, B_XN = 91 * MiB, B_SLAB = 124 * MiB;
constexpr size_t B_ACAT = 0, B_R = 66 * MiB, B_K = 99 * MiB, B_V = 132 * MiB, B_DEC = 0, B_AA = 33 * MiB;
constexpr size_t B_QKR = 0, B_VV = 33 * MiB, B_HO = 66 * MiB, B_OO = 124 * MiB, B_IF = 157 * MiB;
static_assert((size_t)M * FF * 2 <= 91 * MiB && (size_t)M * D * 2 == 33 * MiB && B_IF + (size_t)M * 16 * 4 <= 170 * MiB && B_SLAB + (size_t)11 * MS * D * 4 <= 170 * MiB, "BIG map");
constexpr size_t OS_GG = 0, OS_LORA = 33 * MiB;
static_assert(OS_LORA + (size_t)M * KL2 * 2 <= (size_t)MP * D * 4, "d_out scratch");
constexpr size_t O_Y = 0, O_P_S = 17301504, O_P_SHIFT = 17825792, O_P_C = 17833984, O_P_N = 18358272, O_P_M = 18362368, O_P_CONV = 18362432,
                 O_S_S = 18387008, O_S_SHIFT = 26775616, O_S_C = 26906688, O_S_N = 35295296, O_S_M = 35360832, O_S_CONV = 35361856, O_END = 35755072;
constexpr int CW_BAR = 1024;

constexpr int RING_BYTES = 131072, LDSCTL_OFF = RING_BYTES, MISC_OFF = LDSCTL_OFF + 320, TAB_OFF = LDSCTL_OFF + 1024, LDS_BYTES = 147456;

enum { I_XP = 0, I_XS, I_RS, I_RSHIFT, I_MC, I_MN, I_MM, I_MCONV, I_NFA, I_FAWG, I_FAWU, I_FAWD, I_NMIX, I_NFB, I_FBWG, I_FBWU, I_FBWD,
       I_MU, I_WR, I_WK, I_WV, I_WO, I_W0, I_W1, I_W2, I_A0, I_A1, I_A2, I_G1, I_G2, I_KK, I_KA, I_RK, I_GNW, I_GNB,
       I_WIN, I_BIF, I_CW, I_CB, I_MNW, I_WOUT, I_NFIN, N_IN };

typedef __bf16 bf16x2_t __attribute__((ext_vector_type(2)));
typedef float f32x2_t __attribute__((ext_vector_type(2)));
__device__ __forceinline__ unsigned pkbf(float lo, float hi) { f32x2_t v = {lo, hi}; bf16x2_t b = __builtin_convertvector(v, bf16x2_t); return __builtin_bit_cast(unsigned, b); }
__device__ __forceinline__ float bflo(unsigned u) { return __builtin_bit_cast(float, u << 16); }
__device__ __forceinline__ float bfhi(unsigned u) { return __builtin_bit_cast(float, u & 0xffff0000u); }
__device__ __forceinline__ float bf1(unsigned short u) { return __builtin_bit_cast(float, (unsigned)u << 16); }
__device__ __forceinline__ unsigned short f2bf1(float f) { return (unsigned short)(pkbf(f, 0.f) & 0xffffu); }
__device__ __forceinline__ void unpack8(v4u w, float (&o)[8]) { o[0] = bflo(w.x); o[1] = bfhi(w.x); o[2] = bflo(w.y); o[3] = bfhi(w.y); o[4] = bflo(w.z); o[5] = bfhi(w.z); o[6] = bflo(w.w); o[7] = bfhi(w.w); }
__device__ __forceinline__ v4u pack8(const float (&o)[8]) { v4u w; w.x = pkbf(o[0], o[1]); w.y = pkbf(o[2], o[3]); w.z = pkbf(o[4], o[5]); w.w = pkbf(o[6], o[7]); return w; }
__device__ __forceinline__ float sigmoidf_(float x) { return __builtin_amdgcn_rcpf(1.f + __expf(-x)); }
__device__ __forceinline__ float siluf_(float x) { return x * __builtin_amdgcn_rcpf(1.f + __expf(-x)); }
__device__ __forceinline__ float tanhf_(float x) { return 1.f - 2.f * __builtin_amdgcn_rcpf(__expf(2.f * x) + 1.f); }
__device__ __forceinline__ float logsigmoidf_(float x) { return fminf(x, 0.f) - log1pf(__expf(-fabsf(x))); }
template <int CTRL> __device__ __forceinline__ float dppf(float x) { return __builtin_bit_cast(float, __builtin_amdgcn_update_dpp(0, __builtin_bit_cast(int, x), CTRL, 0xF, 0xF, true)); }
__device__ __forceinline__ float red4(float x) { x += dppf<0xB1>(x); x += dppf<0x4E>(x); return x; }
__device__ __forceinline__ float red8(float x) { x = red4(x); x += dppf<0x141>(x); return x; }
__device__ __forceinline__ float red16(float x) { x = red8(x); x += dppf<0x140>(x); return x; }
__device__ __forceinline__ float wave_sum(float v) {
#pragma unroll
    for (int o = 1; o < 64; o <<= 1) v += __shfl_xor(v, o);
    return v;
}

struct Frame {
    LAS unsigned char* lds;
    volatile LAS unsigned* MISC;
    gu32* ctl;
    volatile LAS unsigned long long* tab;
    int tid, lane, wave, vcu, G;
};
__device__ __forceinline__ const float* inptr(const Frame& F, int i) { const unsigned long long v = F.tab[i];
    const unsigned lo = __builtin_amdgcn_readfirstlane((unsigned)v), hi = __builtin_amdgcn_readfirstlane((unsigned)(v >> 32)); return (const float*)(const GAS float*)(((unsigned long long)hi << 32) | lo); }

using pg8::Unit; using pg8::BM; using pg8::HALF;
__device__ __forceinline__ void st8bf(bf16* p, f32x4 v0, f32x4 v1) { v4u w; w.x = pkbf(v0[0], v0[1]); w.y = pkbf(v0[2], v0[3]); w.z = pkbf(v1[0], v1[1]); w.w = pkbf(v1[2], v1[3]); *(v4u*)p = w; }

struct EpiSwiglu {
    static constexpr bool PERM = true, AFTER_DRAIN = false;
    bf16* H; int pvar;
    __device__ __forceinline__ void operator()(const f32x4 (&acc)[2][2][4][2], const Unit& u, int wr, int wc, int fr, int fq) const {
        if (pvar == 3) return;
        const int row0 = u.pm * BM + wr * 64 + fr, col0 = u.pn * 128 + wc * 32 + 8 * fq;
#pragma unroll
        for (int ai = 0; ai < 2; ++ai)
#pragma unroll
            for (int m = 0; m < 4; ++m) {
                f32x4 o[2];
#pragma unroll
                for (int n = 0; n < 2; ++n)
#pragma unroll
                    for (int i = 0; i < 4; ++i) { const float g = acc[ai][0][m][n][i], up = acc[ai][1][m][n][i]; o[n][i] = siluf_(g) * up; }
                st8bf(H + (size_t)(row0 + ai * HALF + m * 16) * FF + col0, o[0], o[1]);
            }
    }
};
struct EpiRes {
    static constexpr bool PERM = false, AFTER_DRAIN = false;
    const float* base; float* out; float* slab; float coef;
    __device__ __forceinline__ void operator()(const f32x4 (&acc)[2][2][4][2], const Unit& u, int wr, int wc, int fr, int fq) const {
        const int row0 = u.pm * BM + wr * 64 + fr, col0 = u.pn * BM + wc * 32 + 4 * fq;
        if (u.slab < 0) {
#pragma unroll
            for (int ai = 0; ai < 2; ++ai)
#pragma unroll
                for (int m = 0; m < 4; ++m) { const size_t ro = (size_t)(row0 + ai * HALF + m * 16) * D + col0;
#pragma unroll
                    for (int bj = 0; bj < 2; ++bj)
#pragma unroll
                        for (int n = 0; n < 2; ++n) { const f32x4 b = *(const f32x4*)(base + ro + bj * HALF + n * 16); *(f32x4*)(out + ro + bj * HALF + n * 16) = b + acc[ai][bj][m][n] * coef; } }
        } else {
            float* sl = slab + (size_t)u.slab * MS * D;
#pragma unroll
            for (int ai = 0; ai < 2; ++ai)
#pragma unroll
                for (int m = 0; m < 4; ++m) { const size_t ro = (size_t)(row0 + ai * HALF + m * 16 - MP) * D + col0;
#pragma unroll
                    for (int bj = 0; bj < 2; ++bj)
#pragma unroll
                        for (int n = 0; n < 2; ++n) *(f32x4*)(sl + ro + bj * HALF + n * 16) = acc[ai][bj][m][n]; }
        }
    }
};
struct EpiRw {
    static constexpr bool PERM = true, AFTER_DRAIN = false;
    bf16 *R, *K, *V, *L;
    __device__ __forceinline__ void operator()(const f32x4 (&acc)[2][2][4][2], const Unit& u, int wr, int wc, int fr, int fq) const {
        const int row0 = u.pm * BM + wr * 64 + fr;
        if (u.pn < 12) {
            bf16 *p0 = R, *p1 = K, *p2 = V; asm volatile("" : "+s"(p0), "+s"(p1), "+s"(p2));
            bf16* dst = u.pn < 4 ? p0 : (u.pn < 8 ? p1 : p2); const int col0 = (u.pn & 3) * BM + wc * 32 + 8 * fq;
#pragma unroll
            for (int ai = 0; ai < 2; ++ai)
#pragma unroll
                for (int m = 0; m < 4; ++m) { bf16* rp = dst + (size_t)(row0 + ai * HALF + m * 16) * D + col0;
#pragma unroll
                    for (int bj = 0; bj < 2; ++bj) st8bf(rp + bj * HALF, acc[ai][bj][m][0], acc[ai][bj][m][1]); }
        } else {
#pragma unroll
            for (int bj = 0; bj < 2; ++bj) {
                const int lc = (u.pn - 12) * BM + bj * HALF + wc * 32 + 8 * fq;
                if (lc >= KL2) continue;
                const int act = lc < 64 ? 1 : (lc < 128 ? 0 : (lc < 288 ? 2 : 3));
#pragma unroll
                for (int ai = 0; ai < 2; ++ai)
#pragma unroll
                    for (int m = 0; m < 4; ++m) {
                        f32x4 o[2];
#pragma unroll
                        for (int n = 0; n < 2; ++n)
#pragma unroll
                            for (int i = 0; i < 4; ++i) { const float x = acc[ai][bj][m][n][i]; o[n][i] = act == 1 ? tanhf_(x) : (act == 0 ? x : (act == 2 ? sigmoidf_(x) : 0.f)); }
                        st8bf(L + (size_t)(row0 + ai * HALF + m * 16) * KL2 + lc, o[0], o[1]);
                    }
            }
        }
    }
};
struct EpiL2 {
    static constexpr bool PERM = true, AFTER_DRAIN = false;
    bf16 *DEC, *AA, *GG; const float *w0, *a0;
    __device__ __forceinline__ void operator()(const f32x4 (&acc)[2][2][4][2], const Unit& u, int wr, int wc, int fr, int fq) const {
        const int row0 = u.pm * BM + wr * 64 + fr, kind = u.pn >> 2, col0 = (u.pn & 3) * BM + wc * 32 + 8 * fq;
        bf16 *p0 = DEC, *p1 = AA, *p2 = GG; const float *q0 = w0, *q1 = a0; asm volatile("" : "+s"(p0), "+s"(p1), "+s"(p2), "+s"(q0), "+s"(q1));
        bf16* dst = kind == 0 ? p0 : (kind == 1 ? p1 : p2); const float* bias = kind == 0 ? q0 : q1;
#pragma unroll
        for (int bj = 0; bj < 2; ++bj) {
            f32x4 bv[2];
#pragma unroll
            for (int n = 0; n < 2; ++n) bv[n] = kind < 2 ? *(const f32x4*)(bias + col0 + bj * HALF + 4 * n) : (f32x4){0.f, 0.f, 0.f, 0.f};
#pragma unroll
            for (int ai = 0; ai < 2; ++ai)
#pragma unroll
                for (int m = 0; m < 4; ++m) {
                    f32x4 o[2];
#pragma unroll
                    for (int n = 0; n < 2; ++n)
#pragma unroll
                        for (int i = 0; i < 4; ++i) { const float z = acc[ai][bj][m][n][i] + bv[n][i];
                            o[n][i] = kind == 0 ? (1.f - __expf(-0.60653065971f * sigmoidf_(z))) : (kind == 1 ? sigmoidf_(z) : z); }
                    st8bf(dst + (size_t)(row0 + ai * HALF + m * 16) * D + col0 + bj * HALF, o[0], o[1]);
                }
        }
    }
};
struct EpiIn {
    static constexpr bool PERM = true, AFTER_DRAIN = false;
    bf16 *QKR, *VV, *OO; float* IF; const float* bif;
    __device__ __forceinline__ void operator()(const f32x4 (&acc)[2][2][4][2], const Unit& u, int wr, int wc, int fr, int fq) const {
        const int row0 = u.pm * BM + wr * 64 + fr;
        if (u.pn < 12) {
            bf16 *p0 = QKR, *p1 = VV, *p2 = OO; asm volatile("" : "+s"(p0), "+s"(p1), "+s"(p2));
            const int kind = u.pn >> 2; bf16* dst = kind == 0 ? p0 : (kind == 1 ? p1 : p2); const int col0 = (u.pn & 3) * BM + wc * 32 + 8 * fq;
#pragma unroll
            for (int ai = 0; ai < 2; ++ai)
#pragma unroll
                for (int m = 0; m < 4; ++m) { bf16* rp = dst + (size_t)(row0 + ai * HALF + m * 16) * D + col0;
#pragma unroll
                    for (int bj = 0; bj < 2; ++bj) { f32x4 a = acc[ai][bj][m][0], b = acc[ai][bj][m][1];
                        if (kind == 2) {
#pragma unroll
                            for (int i = 0; i < 4; ++i) { a[i] = sigmoidf_(a[i]); b[i] = sigmoidf_(b[i]); } }
                        st8bf(rp + bj * HALF, a, b); } }
        } else if (u.pn == 12 && wc == 0 && fq < 2) {
            const f32x4 b0 = *(const f32x4*)(bif + 8 * fq), b1 = *(const f32x4*)(bif + 8 * fq + 4);
#pragma unroll
            for (int ai = 0; ai < 2; ++ai)
#pragma unroll
                for (int m = 0; m < 4; ++m) { f32x4 a = acc[ai][0][m][0] + b0, b = acc[ai][0][m][1] + b1;
                    if (fq == 1) {
#pragma unroll
                        for (int i = 0; i < 4; ++i) { a[i] = logsigmoidf_(a[i]); b[i] = logsigmoidf_(b[i]); } }
                    float* rp = IF + (size_t)(row0 + ai * HALF + m * 16) * 16 + 8 * fq; *(f32x4*)rp = a; *(f32x4*)(rp + 4) = b; }
        }
    }
};

struct CJ { const float* W; const float* sc; bf16* WT; int K, N, Npad, ldk, koff, rmode, roff, smode; };
__device__ __forceinline__ int cj_items(const CJ& j) { return (j.K / 64) * (j.Npad / 32); }
__device__ __forceinline__ void conv_item(const CJ& J, LAS float* scr, int item, int lane) {
    const int nblk = J.Npad / 32, kb = item / nblk, nb = item % nblk, k0 = 64 * kb, n0 = 32 * nb;
    const int nn = n0 + (lane & 31); const bool nok = nn < J.N;
#pragma unroll 8
    for (int i = 0; i < 32; ++i) { const int kk = 2 * i + (lane >> 5); float w = nok ? J.W[(size_t)(k0 + kk) * J.N + nn] : 0.f;
        if (J.smode) { const float s = J.sc[k0 + kk]; w *= (J.smode == 1 ? s : 1.f - s); }
        scr[kk * 33 + (lane & 31)] = w; }
    LDS_WAIT(); asm volatile("" ::: "memory");
    const int rowbase = J.rmode == 0 ? J.roff + n0 : (n0 >> 7) * 256 + (n0 & 127) + J.roff;
    const int c = lane & 7;
#pragma unroll
    for (int j = 0; j < 4; ++j) { const int n = (lane >> 3) + 8 * j; const LAS float* s = scr + (8 * c) * 33 + n;
        v4u o; o.x = pkbf(s[0 * 33], s[1 * 33]); o.y = pkbf(s[2 * 33], s[3 * 33]); o.z = pkbf(s[4 * 33], s[5 * 33]); o.w = pkbf(s[6 * 33], s[7 * 33]);
        *(GAS v4u*)(J.WT + (size_t)(rowbase + n) * J.ldk + J.koff + k0 + 8 * c) = o; }
    LDS_WAIT(); asm volatile("" ::: "memory");
}
__device__ __forceinline__ CJ get_job(const Frame& F, int kind, int j, int layer, int ab, bf16* Wb) {
    CJ J; J.sc = nullptr; J.smode = 0; J.koff = 0; J.rmode = 0; J.roff = 0;
    if (kind == 0) {
        const float* wg = inptr(F, ab ? I_FBWG : I_FAWG) + (size_t)layer * D * FF; const float* wu = inptr(F, ab ? I_FBWU : I_FAWU) + (size_t)layer * D * FF; const float* wd = inptr(F, ab ? I_FBWD : I_FAWD) + (size_t)layer * D * FF;
        if (j < 2) { J.W = j == 0 ? wg : wu; J.K = D; J.N = FF; J.Npad = FF; J.WT = Wb + W_GU / 2; J.ldk = D; J.rmode = 1; J.roff = j == 0 ? 0 : 128; }
        else { J.W = wd; J.K = FF; J.N = D; J.Npad = D; J.WT = Wb + W_D / 2; J.ldk = FF; }
    } else if (kind == 1) {
        if (j < 12) {
            const int s = j >> 1, half = j & 1;
            J.W = inptr(F, s == 0 ? I_WR : (s == 1 ? I_WK : (s == 2 ? I_WV : (s == 3 ? I_W1 : (s == 4 ? I_A1 : I_G1)))));
            J.N = s < 3 ? 1024 : (s < 5 ? 64 : 160); J.Npad = s < 3 ? 1024 : (s < 5 ? 64 : 384);
            J.roff = s < 3 ? 1024 * s : (s == 3 ? 3072 : (s == 4 ? 3136 : 3200));
            const int mui = s == 0 ? 0 : (s == 1 ? 2 : (s == 2 ? 3 : (s == 3 ? 1 : (s == 4 ? 4 : 5))));
            J.sc = inptr(F, I_MU) + mui * D; J.smode = half ? 1 : 2; J.koff = half * D; J.K = D; J.ldk = KRW; J.WT = Wb + W_RW / 2;
        } else { J.W = inptr(F, I_WO); J.K = D; J.N = D; J.Npad = D; J.WT = Wb + W_O / 2; J.ldk = D; }
    } else {
        if (j == 0) { J.W = inptr(F, I_WIN); J.K = D; J.N = 3088; J.Npad = NIN; J.WT = Wb + W_IN / 2; J.ldk = D; }
        else { J.W = inptr(F, I_WOUT); J.K = D; J.N = D; J.Npad = D; J.WT = Wb + W_OUT / 2; J.ldk = D; }
    }
    return J;
}
__device__ __forceinline__ void convert_weights(const Frame& F, int kind, int layer, int ab, bf16* Wb, const int cu0 = 0) {
    LAS float* scr = (LAS float*)(F.lds + F.wave * 16384);
    const int gw = (F.vcu - cu0) * NWAVES + F.wave, NGW = (F.G - cu0) * NWAVES;
    const int njobs = kind == 0 ? 3 : (kind == 1 ? 13 : 2);
    int total = 0;
    for (int j = 0; j < njobs; ++j) { const CJ J = get_job(F, kind, j, layer, ab, Wb); total += cj_items(J); }
    for (int g = gw; g < total; g += NGW) {
        int r = g, j = 0; CJ J = get_job(F, kind, 0, layer, ab, Wb);
        while (r >= cj_items(J)) { r -= cj_items(J); ++j; J = get_job(F, kind, j, layer, ab, Wb); }
        conv_item(J, scr, r, F.lane);
    }
    if (kind == 1) {
        bf16* WT = Wb + W_L2 / 2; const float* w2 = inptr(F, I_W2); const float* a2 = inptr(F, I_A2); const float* g2 = inptr(F, I_G2);
        for (int idx = (F.vcu * NWAVES + F.wave) * 64 + F.lane; idx < 48 * NL2; idx += F.G * NWAVES * 64) {
            const int c = idx / NL2, n = idx % NL2, type = n >> 10, jj = n & 1023;
            const float* src = nullptr;
            if (type == 0 && c < 8) src = w2 + (size_t)(8 * c) * D + jj;
            else if (type == 1 && c >= 8 && c < 16) src = a2 + (size_t)(8 * (c - 8)) * D + jj;
            else if (type == 2 && c >= 16 && c < 36) src = g2 + (size_t)(8 * (c - 16)) * D + jj;
            float v[8];
#pragma unroll
            for (int e = 0; e < 8; ++e) v[e] = src ? src[(size_t)e * D] : 0.f;
            *(GAS v4u*)(WT + (size_t)n * KL2 + 8 * c) = pack8(v);
        }
    }
}

template <int MODE>
__device__ __forceinline__ void norm_rows(const Frame& F, const float* base_p, const float* base_s, int nslab, float coef, const float* slab, float* xr,
                                          const float* gain, bf16* dst, const float* shift_in, float* out) {
    const int gw = F.vcu * NWAVES + F.wave, NGW = F.G * NWAVES, lane = F.lane;
    f32x4 gv[4];
#pragma unroll
    for (int j = 0; j < 4; ++j) gv[j] = *(const f32x4*)(gain + 256 * j + 4 * lane);
    for (int m = gw; m < M; m += NGW) {
        const bool samp = m >= MP;
        const float* src = samp ? base_s + (size_t)(m - MP) * D : base_p + (size_t)m * D;
        f32x4 v[4];
#pragma unroll
        for (int j = 0; j < 4; ++j) v[j] = *(const f32x4*)(src + 256 * j + 4 * lane);
        if (samp && nslab > 0) {
            for (int s = 0; s < nslab; ++s) { const float* sp = slab + ((size_t)s * MS + (m - MP)) * D;
#pragma unroll
                for (int j = 0; j < 4; ++j) v[j] += *(const f32x4*)(sp + 256 * j + 4 * lane) * coef; }
            if (MODE != 2) {
#pragma unroll
                for (int j = 0; j < 4; ++j) *(f32x4*)(xr + (size_t)m * D + 256 * j + 4 * lane) = v[j]; }
        }
        float ss = 0.f;
#pragma unroll
        for (int j = 0; j < 4; ++j) ss += (v[j].x * v[j].x + v[j].y * v[j].y) + (v[j].z * v[j].z + v[j].w * v[j].w);
        const float r = 1.0f / sqrtf(wave_sum(ss) * (1.f / D) + NORM_EPS);
#pragma unroll
        for (int j = 0; j < 4; ++j) v[j] = v[j] * r * gv[j];
        if (MODE == 2) {
#pragma unroll
            for (int j = 0; j < 4; ++j) *(f32x4*)(out + O_Y + (size_t)m * D + 256 * j + 4 * lane) = v[j];
        } else if (MODE == 0) {
#pragma unroll
            for (int j = 0; j < 4; ++j) { const unsigned long long w = (unsigned long long)pkbf(v[j].x, v[j].y) | ((unsigned long long)pkbf(v[j].z, v[j].w) << 32);
                *(unsigned long long*)(dst + (size_t)m * D + 256 * j + 4 * lane) = w; }
        } else {
            int t, b; bool first, last;
            if (!samp) { t = m & (PT - 1); b = m >> 11; first = t == 0; last = t == PT - 1; } else { const int mm = m - MP; t = mm & 3; b = mm >> 2; first = t == 0; last = t == 3; }
#pragma unroll
            for (int j = 0; j < 4; ++j) { const unsigned long long w = (unsigned long long)pkbf(v[j].x, v[j].y) | ((unsigned long long)pkbf(v[j].z, v[j].w) << 32);
                *(unsigned long long*)(dst + (size_t)m * (2 * D) + 256 * j + 4 * lane) = w;
                if (!last) *(unsigned long long*)(dst + (size_t)(m + 1) * (2 * D) + D + 256 * j + 4 * lane) = w;
                else *(f32x4*)(out + (samp ? O_S_SHIFT : O_P_SHIFT) + (size_t)b * D + 256 * j + 4 * lane) = v[j];
                if (first) { unsigned long long z = 0ull;
                    if (samp) { const f32x4 s = *(const f32x4*)(shift_in + (size_t)b * D + 256 * j + 4 * lane); z = (unsigned long long)pkbf(s.x, s.y) | ((unsigned long long)pkbf(s.z, s.w) << 32); }
                    *(unsigned long long*)(dst + (size_t)m * (2 * D) + D + 256 * j + 4 * lane) = z; }
            }
        }
    }
}

constexpr int RW_KK = 0, RW_DD = 4096, RW_BB = 8192, RW_KP = 12288, RW_RR = 16384, RW_VV = 20480, RW_YY = 24576;
__device__ __forceinline__ void rwkv_chain(const Frame& F, int row0, int T, int h, const float* S0, float* ST,
                                           const bf16* Rb, const bf16* Kb, const bf16* Vb, const bf16* Db, const bf16* Ab, bf16* Gb,
                                           const float* k_k, const float* k_a, const float* r_k, const float* gn_w, const float* gn_b, const bool do_store, const int pvar) {
    LAS float* L = (LAS float*)F.lds;
    const int tid = F.tid, lane = F.lane, w = F.wave;
    const int cg = tid & 7, tt = tid >> 3;
    const int srow = 8 * w + (lane >> 3);
    float S[8];
    if (S0) { const f32x4 a = *(const f32x4*)(S0 + srow * 64 + 8 * cg), b = *(const f32x4*)(S0 + srow * 64 + 8 * cg + 4);
        S[0] = a.x; S[1] = a.y; S[2] = a.z; S[3] = a.w; S[4] = b.x; S[5] = b.y; S[6] = b.z; S[7] = b.w; }
    else {
#pragma unroll
        for (int j = 0; j < 8; ++j) S[j] = 0.f; }
    const int ch = h * 64 + 8 * cg;
    float ckk[8], cka[8], crk[8], cgw[8], cgb[8];
#pragma unroll
    for (int j = 0; j < 8; ++j) { ckk[j] = k_k[ch + j]; cka[j] = k_a[ch + j]; crk[j] = r_k[ch + j]; cgw[j] = gn_w[ch + j]; cgb[j] = gn_b[ch + j]; }
    const int nch = (T + 63) >> 6;
    v4u pr = {0, 0, 0, 0}, pk = pr, pv = pr, pd = pr, pa = pr, pg = pr;
    { const int nt0 = T < 64 ? T : 64;
      if (tt < nt0) { const size_t off = (size_t)(row0 + tt) * D + ch;
          pr = *(const v4u*)(Rb + off); pk = *(const v4u*)(Kb + off); pv = *(const v4u*)(Vb + off); pd = *(const v4u*)(Db + off); pa = *(const v4u*)(Ab + off); pg = *(const v4u*)(Gb + off); } }
    float bon = 0.f, vv[8], gg[8];
    for (int c = 0; c < nch; ++c) {
        const int nt = (T - 64 * c) < 64 ? (T - 64 * c) : 64;
        const bool valid = tt < nt;
        {
            float r8[8], k8[8], d8[8], a8[8];
            unpack8(pr, r8); unpack8(pk, k8); unpack8(pv, vv); unpack8(pd, d8); unpack8(pa, a8); unpack8(pg, gg);
            float kk[8], ss = 0.f;
#pragma unroll
            for (int j = 0; j < 8; ++j) { kk[j] = k8[j] * ckk[j]; ss += kk[j] * kk[j]; }
            ss = red8(ss);
            const float inv = __builtin_amdgcn_rsqf(fmaxf(ss, 1e-24f));
            float kp[8], bsum = 0.f;
#pragma unroll
            for (int j = 0; j < 8; ++j) { kk[j] *= inv; kp[j] = k8[j] * (1.f + (a8[j] - 1.f) * cka[j]); bsum += r8[j] * kp[j] * crk[j]; }
            bon = red8(bsum);
            if (valid) {
                LAS float* p = L + tt * 64 + 8 * cg;
                *(LAS f32x4*)(p + RW_KK) = (f32x4){-kk[0], -kk[1], -kk[2], -kk[3]}; *(LAS f32x4*)(p + RW_KK + 4) = (f32x4){-kk[4], -kk[5], -kk[6], -kk[7]};
                *(LAS f32x4*)(p + RW_DD) = (f32x4){1.f - d8[0], 1.f - d8[1], 1.f - d8[2], 1.f - d8[3]}; *(LAS f32x4*)(p + RW_DD + 4) = (f32x4){1.f - d8[4], 1.f - d8[5], 1.f - d8[6], 1.f - d8[7]};
                *(LAS f32x4*)(p + RW_BB) = (f32x4){kk[0] * a8[0], kk[1] * a8[1], kk[2] * a8[2], kk[3] * a8[3]}; *(LAS f32x4*)(p + RW_BB + 4) = (f32x4){kk[4] * a8[4], kk[5] * a8[5], kk[6] * a8[6], kk[7] * a8[7]};
                *(LAS f32x4*)(p + RW_KP) = (f32x4){kp[0], kp[1], kp[2], kp[3]}; *(LAS f32x4*)(p + RW_KP + 4) = (f32x4){kp[4], kp[5], kp[6], kp[7]};
                *(LAS f32x4*)(p + RW_RR) = (f32x4){r8[0], r8[1], r8[2], r8[3]}; *(LAS f32x4*)(p + RW_RR + 4) = (f32x4){r8[4], r8[5], r8[6], r8[7]};
                *(LAS f32x4*)(p + RW_VV) = (f32x4){vv[0], vv[1], vv[2], vv[3]}; *(LAS f32x4*)(p + RW_VV + 4) = (f32x4){vv[4], vv[5], vv[6], vv[7]};
            }
        }
        __syncthreads();
        if (c + 1 < nch) { const int nt1 = (T - 64 * (c + 1)) < 64 ? (T - 64 * (c + 1)) : 64;
            if (tt < nt1) { const size_t off = (size_t)(row0 + 64 * (c + 1) + tt) * D + ch;
                pr = *(const v4u*)(Rb + off); pk = *(const v4u*)(Kb + off); pv = *(const v4u*)(Vb + off); pd = *(const v4u*)(Db + off); pa = *(const v4u*)(Ab + off); pg = *(const v4u*)(Gb + off); } }
        {
            typedef float f2 __attribute__((ext_vector_type(2)));
            f2 S2[4] = {{S[0], S[1]}, {S[2], S[3]}, {S[4], S[5]}, {S[6], S[7]}};
            const LAS float* p = L + 8 * cg;
            LAS float* yw = L + RW_YY + srow;
            const LAS float* vp = L + RW_VV + srow;
#define RW_LD(N, Dd, B, Q, R, VR, t_) do { const LAS float* p_ = p + (t_) * 64; \
                N[0] = *(const LAS f32x4*)(p_ + RW_KK); N[1] = *(const LAS f32x4*)(p_ + RW_KK + 4); Dd[0] = *(const LAS f32x4*)(p_ + RW_DD); Dd[1] = *(const LAS f32x4*)(p_ + RW_DD + 4); \
                B[0] = *(const LAS f32x4*)(p_ + RW_BB); B[1] = *(const LAS f32x4*)(p_ + RW_BB + 4); Q[0] = *(const LAS f32x4*)(p_ + RW_KP); Q[1] = *(const LAS f32x4*)(p_ + RW_KP + 4); \
                R[0] = *(const LAS f32x4*)(p_ + RW_RR); R[1] = *(const LAS f32x4*)(p_ + RW_RR + 4); VR = vp[(t_) * 64]; } while (0)
#define RW_STEP(N, Dd, B, Q, R, VR, t_) do { \
                f2 a_ = S2[0] * (f2){N[0].x, N[0].y}; a_ = S2[1] * (f2){N[0].z, N[0].w} + a_; a_ = S2[2] * (f2){N[1].x, N[1].y} + a_; a_ = S2[3] * (f2){N[1].z, N[1].w} + a_; \
                const float sa_ = red8(a_.x + a_.y); const f2 sv_ = {sa_, sa_}, vv_ = {VR, VR}; \
                S2[0] = S2[0] * (f2){Dd[0].x, Dd[0].y} + (sv_ * (f2){B[0].x, B[0].y} + vv_ * (f2){Q[0].x, Q[0].y}); \
                S2[1] = S2[1] * (f2){Dd[0].z, Dd[0].w} + (sv_ * (f2){B[0].z, B[0].w} + vv_ * (f2){Q[0].z, Q[0].w}); \
                S2[2] = S2[2] * (f2){Dd[1].x, Dd[1].y} + (sv_ * (f2){B[1].x, B[1].y} + vv_ * (f2){Q[1].x, Q[1].y}); \
                S2[3] = S2[3] * (f2){Dd[1].z, Dd[1].w} + (sv_ * (f2){B[1].z, B[1].w} + vv_ * (f2){Q[1].z, Q[1].w}); \
                f2 y_ = S2[0] * (f2){R[0].x, R[0].y}; y_ = S2[1] * (f2){R[0].z, R[0].w} + y_; y_ = S2[2] * (f2){R[1].x, R[1].y} + y_; y_ = S2[3] * (f2){R[1].z, R[1].w} + y_; \
                yw[(t_) * 64] = red8(y_.x + y_.y); } while (0)
            f32x4 nA[2], dA[2], bA[2], qA[2], rA[2]; float vA;
            for (int t = 0; t < nt; ++t) { RW_LD(nA, dA, bA, qA, rA, vA, t); RW_STEP(nA, dA, bA, qA, rA, vA, t); }
#undef RW_LD
#undef RW_STEP
            S[0] = S2[0].x; S[1] = S2[0].y; S[2] = S2[1].x; S[3] = S2[1].y; S[4] = S2[2].x; S[5] = S2[2].y; S[6] = S2[3].x; S[7] = S2[3].y;
        }
        __syncthreads();
        if (pvar != 4) {
            f32x4 y0 = {0.f, 0.f, 0.f, 0.f}, y1 = y0;
            if (valid) { y0 = *(const LAS f32x4*)(L + RW_YY + tt * 64 + 8 * cg); y1 = *(const LAS f32x4*)(L + RW_YY + tt * 64 + 8 * cg + 4); }
            float yy[8] = {y0.x, y0.y, y0.z, y0.w, y1.x, y1.y, y1.z, y1.w};
            float s1 = 0.f;
#pragma unroll
            for (int j = 0; j < 8; ++j) s1 += yy[j];
            const float mean = red8(s1) * (1.f / 64.f);
            float s2 = 0.f;
#pragma unroll
            for (int j = 0; j < 8; ++j) { yy[j] -= mean; s2 += yy[j] * yy[j]; }
            const float rstd = __builtin_amdgcn_rsqf(red8(s2) * (1.f / 64.f) + GN_EPS);
            float o[8];
#pragma unroll
            for (int j = 0; j < 8; ++j) o[j] = ((yy[j] * rstd) * cgw[j] + cgb[j] + bon * vv[j]) * gg[j];
            if (valid && do_store) *(v4u*)(Gb + (size_t)(row0 + 64 * c + tt) * D + ch) = pack8(o);
        }
    }
    *(f32x4*)(ST + srow * 64 + 8 * cg) = (f32x4){S[0], S[1], S[2], S[3]}; *(f32x4*)(ST + srow * 64 + 8 * cg + 4) = (f32x4){S[4], S[5], S[6], S[7]};
    __syncthreads();
}

constexpr int RH_TC = 32, RH_BUF = 12288;
constexpr int RH_KK = 0, RH_DD = 2048, RH_BB = 4096, RH_KP = 6144, RH_RR = 8192, RH_VV = 10240, RH_YY = 11264;
__device__ __forceinline__ void rwkv_half_chain(const Frame& F, int b, int h, int half, float* ST, const bf16* Rb, const bf16* Kb, const bf16* Vb, const bf16* Db, const bf16* Ab,
                                                bf16* YRAW, float* BON, const float* k_k, const float* k_a, const float* r_k, const int pvar) {
    LAS float* L = (LAS float*)F.lds;
    const int tid = F.tid, lane = F.lane, w = F.wave, row0 = b * PT;
    constexpr int nch = PT / RH_TC;
    if (w < 4) {
        const int srow = 8 * w + (lane >> 3), cq = lane & 7;
        f32x4 S4 = {0.f, 0.f, 0.f, 0.f}, S5 = S4;
        __syncthreads();
        __builtin_amdgcn_s_setprio(3);
        for (int c = 0; c < nch; ++c) {
            const LAS float* p = L + (c & 1) * RH_BUF + 8 * cq;
            LAS float* yw = L + (c & 1) * RH_BUF + RH_YY + srow;
            const LAS float* vp = L + (c & 1) * RH_BUF + RH_VV + srow;
#define RH_LD(N, Dd, B, Q, R, VR, t_) do { const LAS float* p_ = p + (t_) * 64; \
                N[0] = *(const LAS f32x4*)(p_ + RH_KK); N[1] = *(const LAS f32x4*)(p_ + RH_KK + 4); Dd[0] = *(const LAS f32x4*)(p_ + RH_DD); Dd[1] = *(const LAS f32x4*)(p_ + RH_DD + 4); \
                B[0] = *(const LAS f32x4*)(p_ + RH_BB); B[1] = *(const LAS f32x4*)(p_ + RH_BB + 4); Q[0] = *(const LAS f32x4*)(p_ + RH_KP); Q[1] = *(const LAS f32x4*)(p_ + RH_KP + 4); \
                R[0] = *(const LAS f32x4*)(p_ + RH_RR); R[1] = *(const LAS f32x4*)(p_ + RH_RR + 4); VR = vp[(t_) * 32]; } while (0)
#define RH_STEP(N, Dd, B, Q, R, VR, t_) do { \
                const f32x4 pa_ = S4 * N[0] + S5 * N[1]; const float sa_ = red8((pa_.x + pa_.y) + (pa_.z + pa_.w)); \
                S4 = S4 * Dd[0] + (B[0] * sa_ + Q[0] * VR); S5 = S5 * Dd[1] + (B[1] * sa_ + Q[1] * VR); \
                const f32x4 ya_ = S4 * R[0] + S5 * R[1]; yw[(t_) * 32] = red8((ya_.x + ya_.y) + (ya_.z + ya_.w)); } while (0)
            f32x4 nA[2], dA[2], bA[2], qA[2], rA[2], nB[2], dB[2], bB[2], qB[2], rB[2]; float vA, vB;
            RH_LD(nA, dA, bA, qA, rA, vA, 0);
            if (pvar != 3)
            for (int t = 0; t < RH_TC; t += 2) {
                RH_LD(nB, dB, bB, qB, rB, vB, t + 1);
                RH_STEP(nA, dA, bA, qA, rA, vA, t);
                RH_LD(nA, dA, bA, qA, rA, vA, (t + 2 < RH_TC ? t + 2 : t + 1));
                RH_STEP(nB, dB, bB, qB, rB, vB, t + 1);
            }
#undef RH_LD
#undef RH_STEP
            __syncthreads();
        }
        __builtin_amdgcn_s_setprio(0);
        *(f32x4*)(ST + (32 * half + srow) * 64 + 8 * cq) = S4; *(f32x4*)(ST + (32 * half + srow) * 64 + 8 * cq + 4) = S5;
    } else {
        const int ht = tid - 256, cg = ht & 7, tt = ht >> 3;
        const int ch = h * 64 + 8 * cg, vch = h * 64 + 32 * half + 4 * cg;
        float ckk[8], cka[8], crk[8];
#pragma unroll
        for (int j = 0; j < 8; ++j) { ckk[j] = k_k[ch + j]; cka[j] = k_a[ch + j]; crk[j] = r_k[ch + j]; }
        v4u pr, pk, pd, pa; uint2 pv;
#define RH_LOAD(cc) do { const size_t off_ = (size_t)(row0 + RH_TC * (cc) + tt) * D; pr = *(const v4u*)(Rb + off_ + ch); pk = *(const v4u*)(Kb + off_ + ch); pd = *(const v4u*)(Db + off_ + ch); \
            pa = *(const v4u*)(Ab + off_ + ch); pv = *(const uint2*)(Vb + off_ + vch); } while (0)
#define RH_PREP(cc) do { float r8[8], k8[8], d8[8], a8[8]; unpack8(pr, r8); unpack8(pk, k8); unpack8(pd, d8); unpack8(pa, a8); \
            float kk[8], ss = 0.f; _Pragma("unroll") for (int j = 0; j < 8; ++j) { kk[j] = k8[j] * ckk[j]; ss += kk[j] * kk[j]; } \
            ss = red8(ss); const float inv = __builtin_amdgcn_rsqf(fmaxf(ss, 1e-24f)); \
            float kp[8], bsum = 0.f; _Pragma("unroll") for (int j = 0; j < 8; ++j) { kk[j] *= inv; kp[j] = k8[j] * (1.f + (a8[j] - 1.f) * cka[j]); bsum += r8[j] * kp[j] * crk[j]; } \
            const float bon = red8(bsum); if (half == 0 && cg == 0) BON[(size_t)(row0 + RH_TC * (cc) + tt) * 16 + h] = bon; \
            LAS float* p = L + ((cc) & 1) * RH_BUF + tt * 64 + 8 * cg; \
            *(LAS f32x4*)(p + RH_KK) = (f32x4){-kk[0], -kk[1], -kk[2], -kk[3]}; *(LAS f32x4*)(p + RH_KK + 4) = (f32x4){-kk[4], -kk[5], -kk[6], -kk[7]}; \
            *(LAS f32x4*)(p + RH_DD) = (f32x4){1.f - d8[0], 1.f - d8[1], 1.f - d8[2], 1.f - d8[3]}; *(LAS f32x4*)(p + RH_DD + 4) = (f32x4){1.f - d8[4], 1.f - d8[5], 1.f - d8[6], 1.f - d8[7]}; \
            *(LAS f32x4*)(p + RH_BB) = (f32x4){kk[0] * a8[0], kk[1] * a8[1], kk[2] * a8[2], kk[3] * a8[3]}; *(LAS f32x4*)(p + RH_BB + 4) = (f32x4){kk[4] * a8[4], kk[5] * a8[5], kk[6] * a8[6], kk[7] * a8[7]}; \
            *(LAS f32x4*)(p + RH_KP) = (f32x4){kp[0], kp[1], kp[2], kp[3]}; *(LAS f32x4*)(p + RH_KP + 4) = (f32x4){kp[4], kp[5], kp[6], kp[7]}; \
            *(LAS f32x4*)(p + RH_RR) = (f32x4){r8[0], r8[1], r8[2], r8[3]}; *(LAS f32x4*)(p + RH_RR + 4) = (f32x4){r8[4], r8[5], r8[6], r8[7]}; \
            *(LAS f32x4*)(L + ((cc) & 1) * RH_BUF + RH_VV + tt * 32 + 4 * cg) = (f32x4){bflo(pv.x), bfhi(pv.x), bflo(pv.y), bfhi(pv.y)}; } while (0)
#define RH_POST(cc) do { const f32x4 y4 = *(const LAS f32x4*)(L + ((cc) & 1) * RH_BUF + RH_YY + tt * 32 + 4 * cg); uint2 o; o.x = pkbf(y4.x, y4.y); o.y = pkbf(y4.z, y4.w); \
            *(uint2*)(YRAW + (size_t)(row0 + RH_TC * (cc) + tt) * D + vch) = o; } while (0)
        RH_LOAD(0); RH_PREP(0); RH_LOAD(1);
        __syncthreads();
        for (int c = 0; c < nch; ++c) {
            if (c > 0) RH_POST(c - 1);
            if (c + 1 < nch) { RH_PREP(c + 1); if (c + 2 < nch) RH_LOAD(c + 2); }
            __syncthreads();
        }
        RH_POST(nch - 1);
#undef RH_LOAD
#undef RH_PREP
#undef RH_POST
    }
    __syncthreads();
}
__device__ __forceinline__ void rwkv_finish(const Frame& F, const bf16* YRAW, const float* BON, const bf16* Vb, bf16* Gb, const float* gn_w, const float* gn_b) {
    const int gt = (F.vcu * NWAVES + F.wave) * 64 + F.lane, NT = F.G * NWAVES * 64;
    for (int task = gt; task < MP * 128; task += NT) {
        const int cg = task & 7, hh = (task >> 3) & 15, row = task >> 7; const size_t off = (size_t)row * D + hh * 64 + 8 * cg;
        float yy[8], vv[8], gg[8]; unpack8(*(const v4u*)(YRAW + off), yy); unpack8(*(const v4u*)(Vb + off), vv); unpack8(*(const v4u*)(Gb + off), gg);
        const float bon = BON[(size_t)row * 16 + hh];
        float s1 = 0.f;
#pragma unroll
        for (int j = 0; j < 8; ++j) s1 += yy[j];
        const float mean = red8(s1) * (1.f / 64.f);
        float s2 = 0.f;
#pragma unroll
        for (int j = 0; j < 8; ++j) { yy[j] -= mean; s2 += yy[j] * yy[j]; }
        const float rstd = __builtin_amdgcn_rsqf(red8(s2) * (1.f / 64.f) + GN_EPS);
        const f32x4 w0 = *(const f32x4*)(gn_w + hh * 64 + 8 * cg), w1 = *(const f32x4*)(gn_w + hh * 64 + 8 * cg + 4), b0 = *(const f32x4*)(gn_b + hh * 64 + 8 * cg), b1 = *(const f32x4*)(gn_b + hh * 64 + 8 * cg + 4);
        const float gw[8] = {w0.x, w0.y, w0.z, w0.w, w1.x, w1.y, w1.z, w1.w}, gb[8] = {b0.x, b0.y, b0.z, b0.w, b1.x, b1.y, b1.z, b1.w};
        float o[8];
#pragma unroll
        for (int j = 0; j < 8; ++j) o[j] = ((yy[j] * rstd) * gw[j] + gb[j] + bon * vv[j]) * gg[j];
        *(v4u*)(Gb + off) = pack8(o);
    }
}

constexpr int PBY = 144;
constexpr int RPY = 272;
constexpr int ML_RQK = 0, ML_S = 0, ML_KT = 9216, ML_RV = 18432, ML_Q = 35840, ML_K = 45056, ML_HB = 35840, ML_VT = 54272, ML_C = 72704, ML_F = 91136;
constexpr int MF_N = 0, MF_QN = 64, MF_RS = 128, MF_HS = 256, MF_CW = 384, MF_B63 = 1024, MF_P63 = 1056, MF_MC = 1088  , MF_GB = 1152, MF_GP = MF_GB + 2048, MF_GA = MF_GP + 2048;
typedef __attribute__((address_space(3))) unsigned short lds_u16;
#define MFMA16(a, b, c) __builtin_amdgcn_mfma_f32_16x16x32_bf16((a), (b), (c), 0, 0, 0)
__device__ __forceinline__ void mlstm_prompt_chain(const Frame& F, int b, int hh, const bf16* QKR, const bf16* VVb, const bf16* OOb, const float* IFb, bf16* HOb,
                                                   const float* conv_w, const float* conv_b, const float* norm_w, float* out, const int pvar) {
    LAS unsigned char* lds = F.lds; LAS float* Fl = (LAS float*)(lds + ML_F);
    const int tid = F.tid, lane = F.lane, w = F.wave, fr = lane & 15, fq = lane >> 4;
    for (int i = tid; i < 128 * 72; i += 512) ((lds_u16*)(lds + ML_C))[i] = 0;
    if (tid < 64) Fl[MF_N + tid] = 0.f;
    for (int i = tid; i < 640; i += 512) { const int j = i >> 7, c = i & 127, gc = c < 64 ? hh * 64 + c : 512 + hh * 64 + (c - 64); Fl[MF_CW + i] = j < 4 ? conv_w[j * D + gc] : conv_b[gc]; }
    f32x4 Cacc[4];
#pragma unroll
    for (int k = 0; k < 4; ++k) Cacc[k] = (f32x4){0.f, 0.f, 0.f, 0.f};
    const int og = tid & 15, ot = tid >> 4;
    float nw[8];
#pragma unroll
    for (int e = 0; e < 8; ++e) nw[e] = norm_w[hh * 128 + 8 * og + e];
    v4u rq[3], rv[2], ro[2];
#define ML_LOAD_QKV(cc) do { const int rowc_ = b * PT + 64 * (cc); \
        _Pragma("unroll") for (int i = 0; i < 3; ++i) { const int q = tid + 512 * i, r = q >> 4, j = q & 15, tok = 64 * (cc) - 3 + r; rq[i] = (v4u){0u, 0u, 0u, 0u}; \
            if (q < 67 * 16 && tok >= 0) rq[i] = *(const v4u*)(QKR + (size_t)(b * PT + tok) * D + (j < 8 ? hh * 64 + 8 * j : 512 + hh * 64 + 8 * (j - 8))); } \
        _Pragma("unroll") for (int i = 0; i < 2; ++i) rv[i] = *(const v4u*)(VVb + (size_t)(rowc_ + ot + 32 * i) * D + hh * 128 + 8 * og); \
        } while (0)
#define ML_LOAD_O(cc) do { const int rowc_ = b * PT + 64 * (cc); \
        _Pragma("unroll") for (int i = 0; i < 2; ++i) ro[i] = *(const v4u*)(OOb + (size_t)(rowc_ + ot + 32 * i) * D + hh * 128 + 8 * og); } while (0)
    ML_LOAD_QKV(0);
#pragma unroll
    for (int q = 0; q < 4; ++q) { const int cc = w + 8 * q; const size_t ro_ = (size_t)(b * PT + 64 * cc + lane) * 16;
        const float li = IFb[ro_ + hh], lf = IFb[ro_ + 8 + hh];
        float bc = lf;
#pragma unroll
        for (int o = 1; o < 64; o <<= 1) { const float x = __shfl_up(bc, o); if (lane >= o) bc += x; }
        const float av = li - bc; float pm = av;
#pragma unroll
        for (int o = 1; o < 64; o <<= 1) { const float x = __shfl_up(pm, o); if (lane >= o) pm = fmaxf(pm, x); }
        Fl[MF_GB + cc * 64 + lane] = bc; Fl[MF_GP + cc * 64 + lane] = pm; Fl[MF_GA + cc * 64 + lane] = av;
        if (lane == 63) { Fl[MF_B63 + cc] = bc; Fl[MF_P63 + cc] = pm; } }
    __syncthreads();
    if (tid == 0) { float mm = 0.f;
        for (int cc = 0; cc < PT / 64; ++cc) { Fl[MF_MC + cc] = mm; const float b6 = Fl[MF_B63 + cc]; mm = fmaxf(b6 + mm, b6 + Fl[MF_P63 + cc]); }
        Fl[MF_MC + PT / 64] = mm; }
    __syncthreads();
    constexpr int NC = PT / 64;
    for (int c = 0; c < NC; ++c) {
        const int rowc = b * PT + 64 * c;
        const float m_c = Fl[MF_MC + c], m_n = Fl[MF_MC + c + 1], b63 = Fl[MF_B63 + c];
#pragma unroll
        for (int i = 0; i < 3; ++i) { const int q = tid + 512 * i; if (q < 67 * 16) *(LAS v4u*)(lds + ML_RQK + (q >> 4) * RPY + 16 * (q & 15)) = rq[i]; }
#pragma unroll
        for (int i = 0; i < 2; ++i) *(LAS v4u*)(lds + ML_RV + (ot + 32 * i) * RPY + 16 * og) = rv[i];
        if (c + 1 < NC) ML_LOAD_QKV(c + 1);
        ML_LOAD_O(c);
        __syncthreads();
        float kreg[8] = {0.f, 0.f, 0.f, 0.f, 0.f, 0.f, 0.f, 0.f};
        if (pvar != 3)
#pragma unroll
        for (int i = 0; i < 2; ++i) {
            const int g = w + 8 * i, t = lane;
            float x[4][8];
#pragma unroll
            for (int j = 0; j < 4; ++j) unpack8(*(const LAS v4u*)(lds + ML_RQK + (t + j) * RPY + 16 * g), x[j]);
            float val[8];
#pragma unroll
            for (int h2 = 0; h2 < 2; ++h2) { f32x4 a = *(const LAS f32x4*)(Fl + MF_CW + 4 * 128 + 8 * g + 4 * h2);
#pragma unroll
                for (int j = 0; j < 4; ++j) { const f32x4 cw = *(const LAS f32x4*)(Fl + MF_CW + j * 128 + 8 * g + 4 * h2);
                    a.x += cw.x * x[j][4 * h2]; a.y += cw.y * x[j][4 * h2 + 1]; a.z += cw.z * x[j][4 * h2 + 2]; a.w += cw.w * x[j][4 * h2 + 3]; }
                val[4 * h2] = siluf_(a.x); val[4 * h2 + 1] = siluf_(a.y); val[4 * h2 + 2] = siluf_(a.z); val[4 * h2 + 3] = siluf_(a.w); }
            if (i == 0) {
#pragma unroll
                for (int e = 0; e < 8; ++e) val[e] *= 0.125f;
                *(LAS v4u*)(lds + ML_Q + t * PBY + 16 * w) = pack8(val);
            } else { *(LAS v4u*)(lds + ML_K + t * PBY + 16 * w) = pack8(val);
#pragma unroll
                for (int e = 0; e < 8; ++e) kreg[e] = val[e]; }
            const v4u vw = *(const LAS v4u*)(lds + ML_RV + t * RPY + 16 * g);
            lds_u16* vt = (lds_u16*)(lds + ML_VT) + (8 * g) * 72 + t;
            vt[0 * 72] = (unsigned short)(vw.x & 0xffffu); vt[1 * 72] = (unsigned short)(vw.x >> 16); vt[2 * 72] = (unsigned short)(vw.y & 0xffffu); vt[3 * 72] = (unsigned short)(vw.y >> 16);
            vt[4 * 72] = (unsigned short)(vw.z & 0xffffu); vt[5 * 72] = (unsigned short)(vw.z >> 16); vt[6 * 72] = (unsigned short)(vw.w & 0xffffu); vt[7 * 72] = (unsigned short)(vw.w >> 16);
        }
        __syncthreads();
        if (pvar != 4) {
        { const float wsv = __expf(b63 + Fl[MF_GA + c * 64 + lane] - m_n); lds_u16* kt = (lds_u16*)(lds + ML_KT) + (8 * w) * 72 + lane;
#pragma unroll
          for (int e = 0; e < 8; ++e) kt[e * 72] = f2bf1(kreg[e] * wsv); }
        { const int tq = tid >> 3, p = tid & 7; float q8[8]; unpack8(*(const LAS v4u*)(lds + ML_Q + tq * PBY + 16 * p), q8);
          float dsum = 0.f;
#pragma unroll
          for (int e = 0; e < 8; ++e) dsum += q8[e] * Fl[MF_N + 8 * p + e];
          dsum = red8(dsum); if (p == 0) Fl[MF_QN + tq] = dsum; }
        { const int ti = w >> 1, t = 16 * ti + fr; float rsum = 0.f; const float mxt = fmaxf(m_c, Fl[MF_GP + c * 64 + t]);
          typedef unsigned u2v_ __attribute__((ext_vector_type(2)));
#pragma unroll
          for (int jj = 0; jj < 2; ++jj) { const int sj = 2 * (w & 1) + jj; f32x4 acc = {0.f, 0.f, 0.f, 0.f};
#pragma unroll
              for (int ks = 0; ks < 2; ++ks) { const bf16x8 a = *(const LAS bf16x8*)(lds + ML_Q + (16 * ti + fr) * PBY + ks * 64 + fq * 16), bb = *(const LAS bf16x8*)(lds + ML_K + (16 * sj + fr) * PBY + ks * 64 + fq * 16);
                  acc = MFMA16(bb, a, acc); }
              const f32x4 av4 = *(const LAS f32x4*)(Fl + MF_GA + c * 64 + 16 * sj + 4 * fq);
#pragma unroll
              for (int r = 0; r < 4; ++r) { const int s_ = 16 * sj + 4 * fq + r; const float val = s_ <= t ? acc[r] * __expf(av4[r] - mxt) : 0.f; acc[r] = val; rsum += val; }
              u2v_ pw; pw.x = pkbf(acc[0], acc[1]); pw.y = pkbf(acc[2], acc[3]);
              *(LAS u2v_*)(lds + ML_S + (t * 72 + 16 * sj + 4 * fq) * 2) = pw; }
          rsum += __shfl_xor(rsum, 16); rsum += __shfl_xor(rsum, 32);
          if (fq == 0) Fl[MF_RS + t * 2 + (w & 1)] = rsum; }
        }
        __syncthreads();
        float hv[4][4] = {};
        if (pvar != 5) { const int ti = w & 3, t = 16 * ti + fr;
          const float mx = fmaxf(m_c, Fl[MF_GP + c * 64 + t]), wi = __expf(m_c - mx), ei = __expf(-(Fl[MF_GB + c * 64 + t] + mx));
          const float rden = __builtin_amdgcn_rcpf(fmaxf(fabsf(wi * Fl[MF_QN + t] + Fl[MF_RS + 2 * t] + Fl[MF_RS + 2 * t + 1]), ei)); float hq = 0.f;
#pragma unroll
          for (int i = 0; i < 4; ++i) { const int vt = 4 * (w >> 2) + i; f32x4 accA = {0.f, 0.f, 0.f, 0.f}, accB = accA;
#pragma unroll
              for (int ks = 0; ks < 2; ++ks) {
                  const bf16x8 aq = *(const LAS bf16x8*)(lds + ML_Q + (16 * ti + fr) * PBY + ks * 64 + fq * 16), bc = *(const LAS bf16x8*)(lds + ML_C + (16 * vt + fr) * PBY + ks * 64 + fq * 16);
                  accA = MFMA16(bc, aq, accA);
                  const bf16x8 as = *(const LAS bf16x8*)(lds + ML_S + (16 * ti + fr) * PBY + ks * 64 + fq * 16), bv = *(const LAS bf16x8*)(lds + ML_VT + (16 * vt + fr) * PBY + ks * 64 + fq * 16);
                  accB = MFMA16(bv, as, accB); }
#pragma unroll
              for (int r = 0; r < 4; ++r) { const float hh_ = (wi * accA[r] + accB[r]) * rden; hv[i][r] = hh_; hq += hh_ * hh_; } }
          hq += __shfl_xor(hq, 16); hq += __shfl_xor(hq, 32);
          if (fq == 0) Fl[MF_HS + t * 2 + (w >> 2)] = hq; }
        __syncthreads();
        if (pvar != 6) {
        { const int ti = w & 3, t = 16 * ti + fr; const float sc = __builtin_amdgcn_rsqf((Fl[MF_HS + 2 * t] + Fl[MF_HS + 2 * t + 1]) * (1.f / 128.f) + NORM_EPS);
          typedef unsigned u2v_ __attribute__((ext_vector_type(2)));
#pragma unroll
          for (int i = 0; i < 4; ++i) { u2v_ pw; pw.x = pkbf(hv[i][0] * sc, hv[i][1] * sc); pw.y = pkbf(hv[i][2] * sc, hv[i][3] * sc);
              *(LAS u2v_*)(lds + ML_HB + t * RPY + (16 * (4 * (w >> 2) + i) + 4 * fq) * 2) = pw; } }
        { const float wst = __expf(b63 + m_c - m_n);
          typedef unsigned u2v_ __attribute__((ext_vector_type(2)));
#pragma unroll
          for (int kt = 0; kt < 4; ++kt) { Cacc[kt] = Cacc[kt] * wst;
#pragma unroll
              for (int ks = 0; ks < 2; ++ks) { const bf16x8 a = *(const LAS bf16x8*)(lds + ML_VT + (16 * w + fr) * PBY + ks * 64 + fq * 16), bb = *(const LAS bf16x8*)(lds + ML_KT + (16 * kt + fr) * PBY + ks * 64 + fq * 16);
                  Cacc[kt] = MFMA16(bb, a, Cacc[kt]); }
              u2v_ pw; pw.x = pkbf(Cacc[kt][0], Cacc[kt][1]); pw.y = pkbf(Cacc[kt][2], Cacc[kt][3]);
              *(LAS u2v_*)(lds + ML_C + ((16 * w + fr) * 72 + 16 * kt + 4 * fq) * 2) = pw; }
          if (w == 0) { float sum = 0.f;
#pragma unroll
              for (int q = 0; q < 8; ++q) { float k8[8]; unpack8(*(const LAS v4u*)(lds + ML_KT + lane * PBY + 16 * q), k8);
#pragma unroll
                  for (int e = 0; e < 8; ++e) sum += k8[e]; }
              Fl[MF_N + lane] = wst * Fl[MF_N + lane] + sum; } }
        }
        __syncthreads();
        if (pvar != 7)
#pragma unroll
        for (int i = 0; i < 2; ++i) { const int t = ot + 32 * i; float h8[8], o8[8]; unpack8(*(const LAS v4u*)(lds + ML_HB + t * RPY + 16 * og), h8); unpack8(ro[i], o8);
#pragma unroll
            for (int e = 0; e < 8; ++e) h8[e] = h8[e] * nw[e] * o8[e];
            *(v4u*)(HOb + (size_t)(rowc + t) * D + hh * 128 + 8 * og) = pack8(h8); }
    }
#undef ML_LOAD_QKV
#undef ML_LOAD_O
#pragma unroll
    for (int kt = 0; kt < 4; ++kt) *(f32x4*)(out + O_P_C + ((size_t)(b * 8 + hh) * 128 + 16 * w + fr) * 64 + 16 * kt + 4 * fq) = Cacc[kt];
    if (w == 0) { out[O_P_N + (size_t)(b * 8 + hh) * 64 + lane] = Fl[MF_N + lane]; if (lane == 0) out[O_P_M + b * 8 + hh] = Fl[MF_MC + PT / 64]; }
    if (tid < 384) { const int j = tid >> 7, c = tid & 127, gc = c < 64 ? hh * 64 + c : 512 + hh * 64 + (c - 64);
        out[O_P_CONV + (size_t)(b * 3 + j) * D + gc] = bf1(QKR[(size_t)(b * PT + PT - 3 + j) * D + gc]); }
    __syncthreads();
}
__device__ __forceinline__ void mlstm_sample_item(const Frame& F, int b, int hh, const bf16* QKR, const bf16* VVb, const bf16* OOb, const float* IFb, bf16* HOb,
                                                  const float* conv_w, const float* conv_b, const float* norm_w, const float* C0, const float* n0, const float* m0p, const float* conv0, float* out) {
    LAS float* L = (LAS float*)F.lds;
    constexpr int LQ = 0, LK = 256, LV = 512, LS = 1024, LQN = 1040, LHS = 1048;
    const int tid = F.tid, lane = F.lane, w = F.wave, row0 = MP + 4 * b;
    float li[4], lf[4];
#pragma unroll
    for (int t = 0; t < 4; ++t) { li[t] = IFb[(size_t)(row0 + t) * 16 + hh]; lf[t] = IFb[(size_t)(row0 + t) * 16 + 8 + hh]; }
    const float m0 = m0p[b * 8 + hh];
    float bc[4], av[4], mt[4], wi[4], wsv[4], ei[4], bm[4];
    { float run = 0.f, pm = -3.0e38f;
#pragma unroll
      for (int t = 0; t < 4; ++t) { run += lf[t]; bc[t] = run; av[t] = li[t] - run; pm = fmaxf(pm, av[t]); mt[t] = fmaxf(run + m0, run + pm); } }
    const float m_new = mt[3], wst = __expf(bc[3] + m0 - m_new);
#pragma unroll
    for (int t = 0; t < 4; ++t) { wi[t] = __expf(bc[t] + m0 - mt[t]); wsv[t] = __expf(bc[3] + av[t] - m_new); ei[t] = __expf(-mt[t]); bm[t] = bc[t] - mt[t]; }
    { const int t = tid >> 7, c = tid & 127, gc = c < 64 ? hh * 64 + c : 512 + hh * 64 + (c - 64);
      float x[4];
#pragma unroll
      for (int j = 0; j < 4; ++j) { const int p = t + j; x[j] = p < 3 ? conv0[(size_t)(b * 3 + p) * D + gc] : bf1(QKR[(size_t)(row0 + p - 3) * D + gc]); }
      float a = conv_b[gc];
#pragma unroll
      for (int j = 0; j < 4; ++j) a += conv_w[j * D + gc] * x[j];
      const float val = siluf_(a);
      if (c < 64) L[LQ + t * 64 + c] = val * 0.125f; else L[LK + t * 64 + (c - 64)] = val;
      if (t >= 1) out[O_S_CONV + (size_t)(b * 3 + t - 1) * D + gc] = x[3];
      L[LV + t * 128 + c] = bf1(VVb[(size_t)(row0 + t) * D + hh * 128 + c]); }
    __syncthreads();
    if (w == 0) { const int pair = lane >> 2, t = pair >> 2, s = pair & 3, part = lane & 3; float dsum = 0.f;
#pragma unroll
        for (int e = 0; e < 16; ++e) dsum += L[LQ + t * 64 + 16 * part + e] * L[LK + s * 64 + 16 * part + e];
        dsum = red4(dsum);
        const float bmt = t == 0 ? bm[0] : (t == 1 ? bm[1] : (t == 2 ? bm[2] : bm[3])), avs = s == 0 ? av[0] : (s == 1 ? av[1] : (s == 2 ? av[2] : av[3]));
        if (part == 0) L[LS + pair] = s <= t ? dsum * __expf(bmt + avs) : 0.f; }
    if (w == 1) { const int t = lane >> 4, part = lane & 15; float dsum = 0.f;
#pragma unroll
        for (int e = 0; e < 4; ++e) dsum += L[LQ + t * 64 + 4 * part + e] * n0[(size_t)(b * 8 + hh) * 64 + 4 * part + e];
        dsum = red16(dsum); if (part == 0) L[LQN + t] = dsum; }
    __syncthreads();
    const int v = tid >> 2, kq = tid & 3;
    float hvv[4];
    { const size_t coff = ((size_t)(b * 8 + hh) * 128 + v) * 64 + 16 * kq;
      float c0[16];
#pragma unroll
      for (int e4 = 0; e4 < 4; ++e4) { const f32x4 x = *(const f32x4*)(C0 + coff + 4 * e4); c0[4 * e4] = x.x; c0[4 * e4 + 1] = x.y; c0[4 * e4 + 2] = x.z; c0[4 * e4 + 3] = x.w; }
#pragma unroll
      for (int t = 0; t < 4; ++t) { float part = 0.f;
#pragma unroll
          for (int e = 0; e < 16; ++e) part += c0[e] * L[LQ + t * 64 + 16 * kq + e];
          const float inter = red4(part);
          float num = wi[t] * inter, den = wi[t] * L[LQN + t];
#pragma unroll
          for (int s = 0; s < 4; ++s) { const float sm = L[LS + t * 4 + s]; num += sm * L[LV + s * 128 + v]; den += sm; }
          hvv[t] = num / fmaxf(fabsf(den), ei[t]); }
#pragma unroll
      for (int t = 0; t < 4; ++t) { const float x = wave_sum(kq == 0 ? hvv[t] * hvv[t] : 0.f); if (lane == 0) L[LHS + w * 4 + t] = x; }
      float cn[16];
#pragma unroll
      for (int e = 0; e < 16; ++e) { float a = wst * c0[e];
#pragma unroll
          for (int s = 0; s < 4; ++s) a += wsv[s] * L[LV + s * 128 + v] * L[LK + s * 64 + 16 * kq + e];
          cn[e] = a; }
#pragma unroll
      for (int e4 = 0; e4 < 4; ++e4) *(f32x4*)(out + O_S_C + coff + 4 * e4) = (f32x4){cn[4 * e4], cn[4 * e4 + 1], cn[4 * e4 + 2], cn[4 * e4 + 3]}; }
    __syncthreads();
    if (kq == 0) {
#pragma unroll
        for (int t = 0; t < 4; ++t) { float tot = 0.f;
#pragma unroll
            for (int ww = 0; ww < 8; ++ww) tot += L[LHS + ww * 4 + t];
            const float sc = 1.0f / sqrtf(tot * (1.f / 128.f) + NORM_EPS); const size_t off = (size_t)(row0 + t) * D + hh * 128 + v;
            HOb[off] = f2bf1(hvv[t] * sc * norm_w[hh * 128 + v] * bf1(OOb[off])); } }
    if (tid < 64) { float a = wst * n0[(size_t)(b * 8 + hh) * 64 + tid];
#pragma unroll
        for (int s = 0; s < 4; ++s) a += wsv[s] * L[LK + s * 64 + tid];
        out[O_S_N + (size_t)(b * 8 + hh) * 64 + tid] = a; }
    if (tid == 0) out[O_S_M + b * 8 + hh] = m_new;
    __syncthreads();
}

constexpr int CA_AH = 0, CA_BH = 9216, CA_KH = 18432, CA_RH = 27648, CA_BT = 36864, CA_KT = 46080, CA_VT = 55296, CA_AB = 64512, CA_AK = 73728, CA_RB = 82944, CA_RK = 92160, CA_XT = 101376,
              CA_TD = 119808, CA_NF = 123904, CA_GL = 128000, CA_LG = CA_AB  , CA_AT = CA_KH  ;
__device__ __forceinline__ bf16x8 ldsfrag(LAS unsigned char* lds, int base, int row, int ks, int fq) { return *(const LAS bf16x8*)(lds + base + row * PBY + ks * 64 + fq * 16); }
__device__ __forceinline__ void rwkv_chunk_item(const Frame& F, int chain, int chunk, bf16* Rb, bf16* Kb, bf16* Vb, bf16* Db, bf16* Ab, bf16* Gb,
                                                const float* k_k, const float* k_a, const float* r_k, float* BON, bf16* dummy, v4u (&pf)[6], const int nchain, const int nchunk) {
    LAS unsigned char* lds = F.lds;
    const int tid = F.tid, lane = F.lane, w = F.wave, fr = lane & 15, fq = lane >> 4, cg = tid & 7, tt = tid >> 3;
    const int h = chain & 15, row0 = (chain >> 4) * PT + 64 * chunk, ch = h * 64 + 8 * cg;
    const size_t goff = (size_t)(row0 + tt) * D + ch;
    LAS float* LG = (LAS float*)(lds + CA_LG); LAS float* GLf = (LAS float*)(lds + CA_GL);
    float r8[8], kp[8], av[8], bv[8], rd[8];
    {
        float k8[8], v8[8], d8[8], a8[8];
        unpack8(pf[0], r8); unpack8(pf[1], k8); unpack8(pf[2], v8); unpack8(pf[3], d8); unpack8(pf[4], a8);
        float ss = 0.f;
#pragma unroll
        for (int j = 0; j < 8; ++j) { av[j] = k8[j] * k_k[ch + j]; ss += av[j] * av[j]; }
        ss = red8(ss); const float inv = __builtin_amdgcn_rsqf(fmaxf(ss, 1e-24f));
        float bsum = 0.f;
#pragma unroll
        for (int j = 0; j < 8; ++j) { const float kk = av[j] * inv; kp[j] = k8[j] * (1.f + (a8[j] - 1.f) * k_a[ch + j]); bv[j] = kk * a8[j]; av[j] = -kk; bsum += r8[j] * kp[j] * r_k[ch + j]; rd[j] = __builtin_amdgcn_rcpf(1.f - d8[j]); }
        const float bon = red8(bsum);
#pragma unroll
        for (int j = 0; j < 8; ++j) { LG[(8 * cg + j) * 64 + tt] = __logf(1.f - d8[j]); ((lds_u16*)(lds + CA_VT))[(8 * cg + j) * 72 + tt] = f2bf1(v8[j]); }
        if (cg == 0 && !dummy) BON[(size_t)(row0 + tt) * 16 + h] = bon;
    }
    for (int i = tid; i < 128 * 9; i += 512) ((LAS v4u*)(lds + CA_XT))[i] = (v4u){0u, 0u, 0u, 0u};
    __syncthreads();
    { float x[8];
#pragma unroll
      for (int q = 0; q < 8; ++q) x[q] = LG[(8 * w + q) * 64 + lane];
#pragma unroll
      for (int q = 0; q < 8; ++q) {
          float v = x[q];
          v += __builtin_bit_cast(float, __builtin_amdgcn_update_dpp(0, __builtin_bit_cast(int, v), 0x111, 0xF, 0xF, true));
          v += __builtin_bit_cast(float, __builtin_amdgcn_update_dpp(0, __builtin_bit_cast(int, v), 0x112, 0xF, 0xF, true));
          v += __builtin_bit_cast(float, __builtin_amdgcn_update_dpp(0, __builtin_bit_cast(int, v), 0x114, 0xF, 0xF, true));
          v += __builtin_bit_cast(float, __builtin_amdgcn_update_dpp(0, __builtin_bit_cast(int, v), 0x118, 0xF, 0xF, true));
          v += __builtin_bit_cast(float, __builtin_amdgcn_update_dpp(0, __builtin_bit_cast(int, v), 0x142, 0xA, 0xF, false));
          v += __builtin_bit_cast(float, __builtin_amdgcn_update_dpp(0, __builtin_bit_cast(int, v), 0x143, 0xC, 0xF, false));
          x[q] = v; }
#pragma unroll
      for (int q = 0; q < 8; ++q) LG[(8 * w + q) * 64 + lane] = x[q]; }
    __syncthreads();
    {
        float ah[8], bh[8], kh[8], rh[8];
#pragma unroll
        for (int j = 0; j < 8; ++j) { const float lg = LG[(8 * cg + j) * 64 + tt]; const float G = __expf(lg), Gm1 = G * rd[j], Gi = __builtin_amdgcn_rcpf(G);
            ah[j] = av[j] * Gm1; bh[j] = bv[j] * Gi; kh[j] = kp[j] * Gi; rh[j] = r8[j] * G;
            ((lds_u16*)(lds + CA_BT))[(8 * cg + j) * 72 + tt] = f2bf1(bh[j]); ((lds_u16*)(lds + CA_KT))[(8 * cg + j) * 72 + tt] = f2bf1(kh[j]);
            if (tt == 63) GLf[8 * cg + j] = G; }
        *(LAS v4u*)(lds + CA_AH + tt * PBY + 16 * cg) = pack8(ah); *(LAS v4u*)(lds + CA_BH + tt * PBY + 16 * cg) = pack8(bh);
        *(LAS v4u*)(lds + CA_KH + tt * PBY + 16 * cg) = pack8(kh); *(LAS v4u*)(lds + CA_RH + tt * PBY + 16 * cg) = pack8(rh);
    }
    __syncthreads();
    {
        const int mi = w >> 1, ti0 = 2 * (w & 1); const int abase = mi < 2 ? CA_AH : CA_RH, bbase = (mi & 1) ? CA_KH : CA_BH, dbase = CA_AB + mi * 9216;
        bf16x8 af[2][2], bfr[4][2];
#pragma unroll
        for (int a = 0; a < 2; ++a)
#pragma unroll
            for (int ks = 0; ks < 2; ++ks) af[a][ks] = ldsfrag(lds, abase, 16 * (ti0 + a) + fr, ks, fq);
#pragma unroll
        for (int sj = 0; sj < 4; ++sj)
#pragma unroll
            for (int ks = 0; ks < 2; ++ks) bfr[sj][ks] = ldsfrag(lds, bbase, 16 * sj + fr, ks, fq);
#pragma unroll
        for (int a = 0; a < 2; ++a)
#pragma unroll
            for (int sj = 0; sj < 4; ++sj) { const int ti = ti0 + a; f32x4 acc = {0.f, 0.f, 0.f, 0.f};
#pragma unroll
                for (int ks = 0; ks < 2; ++ks) acc = MFMA16(bfr[sj][ks], af[a][ks], acc);
                const int t = 16 * ti + fr;
#pragma unroll
                for (int r = 0; r < 4; ++r) { const int s = 16 * sj + 4 * fq + r; acc[r] = (mi < 2 ? s < t : s <= t) ? acc[r] : 0.f; }
                typedef unsigned u2v_ __attribute__((ext_vector_type(2))); u2v_ pw; pw.x = pkbf(acc[0], acc[1]); pw.y = pkbf(acc[2], acc[3]);
                *(LAS u2v_*)(lds + dbase + (t * 72 + 16 * sj + 4 * fq) * 2) = pw;
                if (mi == 0 && ti == sj) *(LAS f32x4*)(lds + CA_NF + (ti * 256 + fr * 16 + 4 * fq) * 4) = acc; }
    }
    __syncthreads();
    f32x4 rhs[4];
    if (w == 0) { const int blk = fq, c = fr; const LAS float* N = (const LAS float*)(lds + CA_NF) + blk * 256; float T[16];
#pragma unroll
        for (int i = 0; i < 16; ++i) { float s = (i == c) ? 1.f : 0.f;
#pragma unroll
            for (int j = 0; j < i; ++j) s += N[i * 16 + j] * T[j];
            T[i] = s; }
        lds_u16* td = (lds_u16*)(lds + CA_TD) + blk * 512;
#pragma unroll
        for (int i = 0; i < 16; ++i) { td[i * 32 + c] = f2bf1(T[i]); td[i * 32 + 16 + c] = 0; } }
    if (w < 4) {
#pragma unroll
        for (int i = 0; i < 4; ++i)
#pragma unroll
            for (int r = 0; r < 4; ++r) rhs[i][r] = bf1(((lds_u16*)(lds + CA_AH))[(16 * i + 4 * fq + r) * 72 + 16 * w + fr]);
    } else {
#pragma unroll
        for (int i = 0; i < 4; ++i) { f32x4 acc = {0.f, 0.f, 0.f, 0.f};
#pragma unroll
            for (int ks = 0; ks < 2; ++ks) acc = MFMA16(ldsfrag(lds, CA_AK, 16 * i + fr, ks, fq), ldsfrag(lds, CA_VT, 16 * (w - 4) + fr, ks, fq), acc);
            rhs[i] = acc; }
    }
    __syncthreads();
    {
        LAS unsigned char* AT = lds + CA_AT + w * 1024;
        *(LAS unsigned long long*)(AT + fr * 64 + 32 + fq * 8) = 0ull;
#pragma unroll
        for (int i = 0; i < 4; ++i) { f32x4 acc = rhs[i];
#pragma unroll
            for (int ks = 0; ks < 2; ++ks) acc = MFMA16(ldsfrag(lds, CA_AB, 16 * i + fr, ks, fq), ldsfrag(lds, CA_XT, 16 * w + fr, ks, fq), acc);
            typedef unsigned u2v __attribute__((ext_vector_type(2)));
            u2v pa; pa.x = pkbf(acc[0], acc[1]); pa.y = pkbf(acc[2], acc[3]);
            *(LAS u2v*)(AT + fr * 64 + fq * 8) = pa;
            asm volatile("s_waitcnt lgkmcnt(0)" ::: "memory");
            f32x4 xi = {0.f, 0.f, 0.f, 0.f};
            xi = MFMA16(*(const LAS bf16x8*)(lds + CA_TD + i * 1024 + fr * 64 + fq * 16), *(const LAS bf16x8*)(AT + fr * 64 + fq * 16), xi);
            u2v px; px.x = pkbf(xi[0], xi[1]); px.y = pkbf(xi[2], xi[3]);
            *(LAS u2v*)(lds + CA_XT + (16 * w + fr) * PBY + (16 * i + 4 * fq) * 2) = px;
            asm volatile("s_waitcnt lgkmcnt(0)" ::: "memory"); }
    }
    __syncthreads();
    if (nchain >= 0) { const size_t no = (size_t)((nchain >> 4) * PT + 64 * nchunk + tt) * D + (nchain & 15) * 64 + 8 * cg;
        pf[0] = *(const v4u*)(Rb + no); pf[1] = *(const v4u*)(Kb + no); pf[2] = *(const v4u*)(Vb + no); pf[3] = *(const v4u*)(Db + no); pf[4] = *(const v4u*)(Ab + no); }
    {
        const int mi = w >> 1, ti0 = 2 * (w & 1); const int obase = mi == 0 ? CA_AB : (mi == 1 ? CA_AK : (mi == 2 ? CA_AH : CA_KH));
        const int a1 = mi < 2 ? CA_RB : (mi == 2 ? CA_BT : CA_XT), a1o = mi == 3 ? 64 : 0, b1 = mi == 3 ? CA_BT : CA_XT, b1o = mi == 1 ? 64 : 0;
        const int a2 = mi == 1 ? CA_RK : CA_VT, b2 = mi == 1 ? CA_VT : CA_KT; const bool two = (mi & 1) != 0;
        bf16x8 af[2][2], bfr[4][2];
#pragma unroll
        for (int a = 0; a < 2; ++a)
#pragma unroll
            for (int ks = 0; ks < 2; ++ks) af[a][ks] = ldsfrag(lds, a1, a1o + 16 * (ti0 + a) + fr, ks, fq);
#pragma unroll
        for (int tj = 0; tj < 4; ++tj)
#pragma unroll
            for (int ks = 0; ks < 2; ++ks) bfr[tj][ks] = ldsfrag(lds, b1, b1o + 16 * tj + fr, ks, fq);
        f32x4 acc[2][4];
#pragma unroll
        for (int a = 0; a < 2; ++a)
#pragma unroll
            for (int tj = 0; tj < 4; ++tj) { acc[a][tj] = (f32x4){0.f, 0.f, 0.f, 0.f};
#pragma unroll
                for (int ks = 0; ks < 2; ++ks) acc[a][tj] = MFMA16(bfr[tj][ks], af[a][ks], acc[a][tj]); }
        if (two) {
#pragma unroll
            for (int a = 0; a < 2; ++a)
#pragma unroll
                for (int ks = 0; ks < 2; ++ks) af[a][ks] = ldsfrag(lds, a2, 16 * (ti0 + a) + fr, ks, fq);
#pragma unroll
            for (int tj = 0; tj < 4; ++tj)
#pragma unroll
                for (int ks = 0; ks < 2; ++ks) bfr[tj][ks] = ldsfrag(lds, b2, 16 * tj + fr, ks, fq);
#pragma unroll
            for (int a = 0; a < 2; ++a)
#pragma unroll
                for (int tj = 0; tj < 4; ++tj)
#pragma unroll
                    for (int ks = 0; ks < 2; ++ks) acc[a][tj] = MFMA16(bfr[tj][ks], af[a][ks], acc[a][tj]);
        }
#pragma unroll
        for (int a = 0; a < 2; ++a) { const int row = 16 * (ti0 + a) + fr; const float glr = GLf[row];
#pragma unroll
            for (int tj = 0; tj < 4; ++tj) { const int col = 16 * tj + 4 * fq; f32x4 val = acc[a][tj];
                typedef unsigned u2v_ __attribute__((ext_vector_type(2)));
                if (mi == 0) { const u2v_ rr = *(const LAS u2v_*)(lds + CA_RH + (row * 72 + col) * 2); val += (f32x4){bflo(rr.x), bfhi(rr.x), bflo(rr.y), bfhi(rr.y)}; }
                else if (mi == 2) {
#pragma unroll
                    for (int r = 0; r < 4; ++r) val[r] = glr * (val[r] + (row == col + r ? 1.f : 0.f)); }
                else if (mi == 3) val = val * *(const LAS f32x4*)(GLf + col);
                u2v_ pw; pw.x = pkbf(val[0], val[1]); pw.y = pkbf(val[2], val[3]);
                *(LAS u2v_*)(lds + obase + (row * 72 + col) * 2) = pw; } }
    }
    __syncthreads();
    *(v4u*)((dummy ? dummy : Rb) + goff) = *(const LAS v4u*)(lds + CA_AB + tt * PBY + 16 * cg);
    *(v4u*)((dummy ? dummy : Ab) + goff) = *(const LAS v4u*)(lds + CA_AK + tt * PBY + 16 * cg);
    *(v4u*)((dummy ? dummy : Kb) + goff) = *(const LAS v4u*)(lds + CA_AH + tt * PBY + 16 * cg);
    *(v4u*)((dummy ? dummy : Db) + goff) = *(const LAS v4u*)(lds + CA_KH + tt * PBY + 16 * cg);
    __syncthreads();
}
constexpr int CB_S = 0, CB_P2 = 9216, CB_P3 = 18432, CB_Y0 = 27648, CB_Z0 = 36864, CB_YS = 46080  ;
__device__ __forceinline__ void rwkv_state_chain(const Frame& F, int chain, float* ST, const bf16* Rb, const bf16* Kb, const bf16* Vb, const bf16* Db, const bf16* Ab, bf16* Gb, const float* BON, const float* gn_w, const float* gn_b, bf16* dummy) {
    LAS unsigned char* lds = F.lds;
    const int tid = F.tid, lane = F.lane, w = F.wave, fr = lane & 15, fq = lane >> 4, cg = tid & 7, tt = tid >> 3;
    const int h = chain & 15, rowc0 = (chain >> 4) * PT, ch = h * 64 + 8 * cg;
    for (int i = tid; i < 64 * 36; i += 512) ((LAS unsigned*)(lds + CB_S))[i] = 0u;
    f32x4 Sacc[2];
    Sacc[0] = (f32x4){0.f, 0.f, 0.f, 0.f}; Sacc[1] = Sacc[0];
    v4u q2, q3, qy, qz, qg, qb; float qbon;
    float cgw[8], cgb[8];
#pragma unroll
    for (int j = 0; j < 8; ++j) { cgw[j] = gn_w[ch + j]; cgb[j] = gn_b[ch + j]; }
#define CB_LOAD(cc) do { const size_t o_ = (size_t)(rowc0 + 64 * (cc) + tt) * D + ch; q2 = *(const v4u*)(Rb + o_); q3 = *(const v4u*)(Kb + o_); qy = *(const v4u*)(Ab + o_); qz = *(const v4u*)(Db + o_); \
        qg = *(const v4u*)(Gb + o_); qb = *(const v4u*)(Vb + o_); qbon = BON[(size_t)(rowc0 + 64 * (cc) + tt) * 16 + h]; } while (0)
    CB_LOAD(0);
    for (int c = 0; c < PT / 64; ++c) {
        *(LAS v4u*)(lds + CB_P2 + tt * PBY + 16 * cg) = q2; *(LAS v4u*)(lds + CB_P3 + tt * PBY + 16 * cg) = q3;
        *(LAS v4u*)(lds + CB_Y0 + tt * PBY + 16 * cg) = qy; *(LAS v4u*)(lds + CB_Z0 + tt * PBY + 16 * cg) = qz;
        float gw[8], gb[8]; unpack8(qg, gw); unpack8(qb, gb);
        const float bonc = qbon;
        if (c + 1 < PT / 64) CB_LOAD(c + 1);
        __syncthreads();
        f32x4 yacc[2];
        typedef unsigned u2v_ __attribute__((ext_vector_type(2)));
#pragma unroll
        for (int q = 0; q < 2; ++q) { const int tq = 2 * w + q, ti = tq >> 2, tj = tq & 3, row = 16 * ti + fr, col = 16 * tj + 4 * fq;
            const u2v_ y0 = *(const LAS u2v_*)(lds + CB_Y0 + (row * 72 + col) * 2), z0 = *(const LAS u2v_*)(lds + CB_Z0 + (row * 72 + col) * 2);
            f32x4 ya = {bflo(y0.x), bfhi(y0.x), bflo(y0.y), bfhi(y0.y)}, sa = {bflo(z0.x), bfhi(z0.x), bflo(z0.y), bfhi(z0.y)};
#pragma unroll
            for (int ks = 0; ks < 2; ++ks) { ya = MFMA16(ldsfrag(lds, CB_S, 16 * tj + fr, ks, fq), ldsfrag(lds, CB_P2, 16 * ti + fr, ks, fq), ya);
                                             sa = MFMA16(ldsfrag(lds, CB_P3, 16 * tj + fr, ks, fq), ldsfrag(lds, CB_S, 16 * ti + fr, ks, fq), sa); }
            yacc[q] = ya; Sacc[q] = sa; }
        __syncthreads();
#pragma unroll
        for (int q = 0; q < 2; ++q) { const int tq = 2 * w + q, ti = tq >> 2, tj = tq & 3, row = 16 * ti + fr, col = 16 * tj + 4 * fq;
            u2v_ pw; pw.x = pkbf(Sacc[q][0], Sacc[q][1]); pw.y = pkbf(Sacc[q][2], Sacc[q][3]);
            *(LAS u2v_*)(lds + CB_S + (row * 72 + col) * 2) = pw;
            *(LAS f32x4*)(lds + CB_YS + (row * 64 + col) * 4) = yacc[q]; }
        __syncthreads();
        { const f32x4 y0 = *(const LAS f32x4*)(lds + CB_YS + (tt * 64 + 8 * cg) * 4), y1 = *(const LAS f32x4*)(lds + CB_YS + (tt * 64 + 8 * cg + 4) * 4);
          float yy[8] = {y0.x, y0.y, y0.z, y0.w, y1.x, y1.y, y1.z, y1.w}; float s1 = 0.f;
#pragma unroll
          for (int j = 0; j < 8; ++j) s1 += yy[j];
          const float mean = red8(s1) * (1.f / 64.f); float s2 = 0.f;
#pragma unroll
          for (int j = 0; j < 8; ++j) { yy[j] -= mean; s2 += yy[j] * yy[j]; }
          const float rstd = __builtin_amdgcn_rsqf(red8(s2) * (1.f / 64.f) + GN_EPS);
          float o[8];
#pragma unroll
          for (int j = 0; j < 8; ++j) o[j] = ((yy[j] * rstd) * cgw[j] + cgb[j] + bonc * gb[j]) * gw[j];
          *(v4u*)((dummy ? dummy : Gb) + (size_t)(rowc0 + 64 * c + tt) * D + ch) = pack8(o); }
    }
#undef CB_LOAD
#pragma unroll
    for (int q = 0; q < 2; ++q) { const int tq = 2 * w + q, ti = tq >> 2, tj = tq & 3; *(f32x4*)(ST + (16 * ti + fr) * 64 + 16 * tj + 4 * fq) = Sacc[q]; }
    __syncthreads();
}

#ifndef MK_N_LAUNCHES
#define MK_N_LAUNCHES 1
#endif
constexpr int N_PHASES = 22;
#ifndef PROBE_PH
#define PROBE_PH (-1)
#define PROBE_N 1
#endif
#ifndef PROBE_VAR
#define PROBE_VAR 0
#endif
#ifndef EN_MASK
#define EN_MASK 0xff
#endif
constexpr bool EN_NORM = EN_MASK & 1, EN_UP = EN_MASK & 2, EN_RES = EN_MASK & 4, EN_RW = EN_MASK & 8, EN_L2 = EN_MASK & 16, EN_SCAN = EN_MASK & 32, EN_IN = EN_MASK & 64, EN_ML = EN_MASK & 128;
struct Args { const float* in[N_IN]; float* out; unsigned char* ws; int ph_lo, ph_hi; };
__global__ void __launch_bounds__(NWAVES * 64, 2) mega_fwd(Args args) {
    extern __shared__ __attribute__((aligned(16))) unsigned char lds_raw[];
    { const int t0 = threadIdx.x;
      for (int u = t0; u < (LDS_BYTES - LDSCTL_OFF) / 4; u += NWAVES * 64) ((LAS unsigned*)((LAS unsigned char*)lds_raw + LDSCTL_OFF))[u] = 0u; }
    __syncthreads();
    { const int t0 = threadIdx.x; if (t0 < N_IN) ((LAS unsigned long long*)((LAS unsigned char*)lds_raw + TAB_OFF))[t0] = (unsigned long long)args.in[t0]; }
    __syncthreads();
    XcdBarrier bar; bar.bar = (unsigned*)((gu32*)(args.ws + WS_CTL) + CW_BAR); bar.x = 0; bar.st = nullptr;
    if (args.ph_hi - args.ph_lo > 1) bar = xcd_barrier_post((unsigned*)((gu32*)(args.ws + WS_CTL) + CW_BAR), (volatile LAS unsigned*)((LAS unsigned char*)lds_raw + MISC_OFF) + 8);
    int ph = args.ph_lo, rep = 0;
    while (ph < args.ph_hi) {
        int tid_ = threadIdx.x; asm volatile("" : "+v"(tid_));
        unsigned char* ws = args.ws; float* out = args.out;
        Frame F;
        F.lds = (LAS unsigned char*)lds_raw;
        F.MISC = (volatile LAS unsigned*)(F.lds + MISC_OFF);
        F.tid = tid_; F.lane = F.tid & 63; F.wave = __builtin_amdgcn_readfirstlane(F.tid >> 6);
        F.G = gridDim.x; { const int bx = blockIdx.x; F.vcu = (F.G % 8 == 0) ? (bx % 8) * (F.G / 8) + bx / 8 : bx; }
        F.ctl = (gu32*)(ws + WS_CTL); F.tab = (volatile LAS unsigned long long*)(F.lds + TAB_OFF);
        bf16* Wb = (bf16*)(ws + WS_W); float* XR = (float*)(ws + WS_XR); unsigned char* big = ws + WS_BIG;
        bf16* Hb = (bf16*)(big + B_H); bf16* XN = (bf16*)(big + B_XN); float* SLAB = (float*)(big + B_SLAB);
        bf16* ACAT = (bf16*)(big + B_ACAT); bf16* Rb = (bf16*)(big + B_R); bf16* Kb = (bf16*)(big + B_K); bf16* Vb = (bf16*)(big + B_V); bf16* DECb = (bf16*)(big + B_DEC); bf16* AAb = (bf16*)(big + B_AA);
        bf16* QKR = (bf16*)(big + B_QKR); bf16* VVb = (bf16*)(big + B_VV); bf16* HOb = (bf16*)(big + B_HO); bf16* OOb = (bf16*)(big + B_OO); float* IFb = (float*)(big + B_IF);
        bf16* GGb = (bf16*)((unsigned char*)out + OS_GG); bf16* LORA = (bf16*)((unsigned char*)out + OS_LORA);
        const int c_id = (int)blockIdx.x;
        const int nrep = (ph == PROBE_PH && ph != 6) ? PROBE_N : 1;
        const int pvar = (rep + 1 < nrep) ? PROBE_VAR : 0;
        if (EN_NORM && (ph == 0 || ph == 3 || ph == 8 || ph == 11 || ph == 14 || ph == 18 || ph == 21)) {
            int kind = 0, layer = 0, ab = 0, nslab = 0; float coef = 0.5f; const float* gain = nullptr;
            if (ph == 0) { kind = 0; layer = 0; ab = 0; gain = inptr(F, I_NFA); nslab = 0; }
            else if (ph == 3) { kind = 1; gain = inptr(F, I_NMIX); nslab = 11; }
            else if (ph == 8) { kind = 0; layer = 0; ab = 1; gain = inptr(F, I_NFB); nslab = 4; coef = 1.f; }
            else if (ph == 11) { kind = 0; layer = 1; ab = 0; gain = inptr(F, I_NFA) + D; nslab = 11; }
            else if (ph == 14) { kind = 2; gain = inptr(F, I_NMIX) + D; nslab = 11; }
            else if (ph == 18) { kind = -1; gain = inptr(F, I_NFB) + D; nslab = 4; coef = 1.f; }
            else { kind = -1; gain = inptr(F, I_NFIN); nslab = 11; }
            if (kind >= 0) convert_weights(F, kind, layer, ab, Wb);
            const float* base_p = ph == 0 ? inptr(F, I_XP) : XR; const float* base_s = (ph == 0 || ph == 3) ? inptr(F, I_XS) : XR + (size_t)MP * D;
            if (ph == 3) norm_rows<1>(F, base_p, base_s, nslab, coef, SLAB, XR, gain, ACAT, inptr(F, I_RSHIFT), out);
            else if (ph == 21) norm_rows<2>(F, base_p, base_s, nslab, coef, SLAB, XR, gain, nullptr, nullptr, out);
            else norm_rows<0>(F, base_p, base_s, nslab, coef, SLAB, XR, gain, XN, nullptr, out);
        } else if (EN_UP && (ph == 1 || ph == 9 || ph == 12 || ph == 19)) {
            const bf16* Wu = ph == 19 ? (const bf16*)(ws + WS_W2) : Wb;
            pg8::Gemm g{XN, Wu + W_GU / 2, M, 2 * FF, D}; pg8::UnitOrder S; S.init(M / 256, 2 * FF / 256, D, F.G, c_id, 0);
            EpiSwiglu E{Hb, pvar};
            pg8::gemm_phase<EpiSwiglu, pg8::UnitOrder, true, true>(F.lds, g, S, E, F.tid);
        } else if (EN_RES && (ph == 2 || ph == 7 || ph == 10 || ph == 13 || ph == 17 || ph == 20)) {
            const bf16* A = Hb; const bf16* Bt = (ph == 20 ? (const bf16*)(ws + WS_W2) : Wb) + W_D / 2; int K = FF; float coef = 0.5f; const float* base = XR;
            if (ph == 2) base = inptr(F, I_XP);
            if (ph == 7) { A = GGb; Bt = Wb + W_O / 2; K = D; coef = 1.f; }
            if (ph == 17) { A = HOb; Bt = Wb + W_OUT / 2; K = D; coef = 1.f; }
            pg8::Gemm g{A, Bt, M, D, K}; pg8::UnitOrder S; S.init(MP / 256, D / 256, K, F.G, c_id, K / 256);
            EpiRes E{base, XR, SLAB, coef};
            pg8::gemm_phase<EpiRes, pg8::UnitOrder, true, true>(F.lds, g, S, E, F.tid);
        } else if (EN_RW && ph == 4) {
            pg8::Gemm g{ACAT, Wb + W_RW / 2, M, NRW, KRW}; pg8::UnitOrder S; S.init(M / 256, NRW / 256, KRW, F.G, c_id, 0);
            EpiRw E{Rb, Kb, Vb, LORA};
            pg8::gemm_phase<EpiRw, pg8::UnitOrder, true, true>(F.lds, g, S, E, F.tid);
        } else if (EN_L2 && ph == 5) {
            pg8::Gemm g{LORA, Wb + W_L2 / 2, M, NL2, KL2}; pg8::UnitOrder S; S.init(M / 256, NL2 / 256, KL2, F.G, c_id, -1);
            EpiL2 E{DECb, AAb, GGb, inptr(F, I_W0), inptr(F, I_A0)};
            pg8::gemm_phase<EpiL2, pg8::UnitOrder, true, true>(F.lds, g, S, E, F.tid);
        } else if (EN_SCAN && ph == 6) {
            bf16* dummy = (bf16*)(ws + WS_YRAW);
            for (int dr = (PROBE_PH == 6 && PROBE_VAR == 5) ? PROBE_N - 1 : 0; dr >= 0; --dr) {
                v4u pf[6]; pf[5] = (v4u){0u, 0u, 0u, 0u};
                { const int it = F.vcu, cg_ = F.tid & 7, tt_ = F.tid >> 3; const size_t o = (size_t)(((it >> 5) >> 4) * PT + 64 * (it & 31) + tt_) * D + ((it >> 5) & 15) * 64 + 8 * cg_;
                  pf[0] = *(const v4u*)(Rb + o); pf[1] = *(const v4u*)(Kb + o); pf[2] = *(const v4u*)(Vb + o); pf[3] = *(const v4u*)(DECb + o); pf[4] = *(const v4u*)(AAb + o); }
                for (int it = F.vcu; it < PB * 16 * (PT / 64); it += F.G) { const int nx = it + F.G < PB * 16 * (PT / 64) ? it + F.G : -1;
                    rwkv_chunk_item(F, it >> 5, it & 31, Rb, Kb, Vb, DECb, AAb, GGb, inptr(F, I_KK), inptr(F, I_KA), inptr(F, I_RK), (float*)(ws + WS_BON), dr ? dummy : nullptr, pf, nx < 0 ? -1 : nx >> 5, nx & 31); }
            }
            xcd_barrier(bar);
            for (int dr = (PROBE_PH == 6 && PROBE_VAR == 6) ? PROBE_N - 1 : 0; dr >= 0; --dr)
                if (F.vcu < 128) rwkv_state_chain(F, F.vcu, out + O_P_S + (size_t)F.vcu * 4096, Rb, Kb, Vb, DECb, AAb, GGb, (const float*)(ws + WS_BON), inptr(F, I_GNW), inptr(F, I_GNB), dr ? dummy : nullptr);
            { const int i0 = F.vcu < 128 ? 2 * F.vcu : 256 + 14 * (F.vcu - 128), i1 = F.vcu < 128 ? i0 + 2 : i0 + 14;
              for (int i = i0; i < i1; ++i) { const int b = i >> 4, h = i & 15;
                  rwkv_chain(F, MP + b * STK, STK, h, inptr(F, I_RS) + (size_t)i * 4096, out + O_S_S + (size_t)i * 4096, Rb, Kb, Vb, DECb, AAb, GGb, inptr(F, I_KK), inptr(F, I_KA), inptr(F, I_RK), inptr(F, I_GNW), inptr(F, I_GNB), true, 0); } }
        } else if (EN_IN && ph == 15) {
            pg8::Gemm g{XN, Wb + W_IN / 2, M, NIN, D}; pg8::UnitOrder S; S.init(M / 256, NIN / 256, D, F.G, c_id, 0);
            EpiIn E{QKR, VVb, OOb, IFb, inptr(F, I_BIF)};
            pg8::gemm_phase<EpiIn, pg8::UnitOrder, true, true>(F.lds, g, S, E, F.tid);
        } else if (EN_ML && ph == 16) {
            const int Hh = F.G >= 128 ? 64 : (F.G / 2 > 0 ? F.G / 2 : 1);
            if (F.vcu < Hh && pvar != 2) {
                for (int i = F.vcu; i < PB * 8; i += Hh) mlstm_prompt_chain(F, i >> 3, i & 7, QKR, VVb, OOb, IFb, HOb, inptr(F, I_CW), inptr(F, I_CB), inptr(F, I_MNW), out, pvar);
            }
            if ((F.vcu >= Hh || F.G == 1) && pvar != 1 && pvar < 3) {
                const int st = F.G == 1 ? 1 : F.G - Hh;
                for (int i = F.G == 1 ? 0 : F.vcu - Hh; i < SB * 8; i += st)
                    mlstm_sample_item(F, i >> 3, i & 7, QKR, VVb, OOb, IFb, HOb, inptr(F, I_CW), inptr(F, I_CB), inptr(F, I_MNW), inptr(F, I_MC), inptr(F, I_MN), inptr(F, I_MM), inptr(F, I_MCONV), out);
            }
            if (F.vcu >= Hh && F.G > Hh && rep + 1 == nrep) convert_weights(F, 0, 1, 1, (bf16*)(ws + WS_W2), Hh);
        }
        if (++rep < nrep) continue;
        rep = 0;
        if (ph + 1 < args.ph_hi) xcd_barrier(bar);
        ++ph;
    }
}

extern "C" void kernel_launch(void* const* d_in, const int* in_sizes, int n_in, void* d_out, int out_size, void* d_ws, size_t ws_size, hipStream_t stream) {
    static int grid = 0;
    if (grid == 0) {
        if (n_in != N_IN || out_size != (int)O_END || ws_size < WS_END2) { fprintf(stderr, "kernel_launch: unexpected shapes (n_in %d, out %d, ws %zu); nothing launched\n", n_in, out_size, ws_size); grid = -1; return; }
        int dev = 0, cus = 0, per_cu = 0;
        if (hipGetDevice(&dev) != hipSuccess || hipDeviceGetAttribute(&cus, hipDeviceAttributeMultiprocessorCount, dev) != hipSuccess) { grid = -1; return; }
        if (hipFuncSetAttribute((const void*)mega_fwd, hipFuncAttributeMaxDynamicSharedMemorySize, LDS_BYTES) != hipSuccess) { fprintf(stderr, "kernel_launch: hipFuncSetAttribute failed\n"); grid = -1; return; }
        if (hipOccupancyMaxActiveBlocksPerMultiprocessor(&per_cu, (const void*)mega_fwd, NWAVES * 64, LDS_BYTES) != hipSuccess || per_cu < 1) { fprintf(stderr, "kernel_launch: occupancy query says %d\n", per_cu); per_cu = 1; }
        (void)hipGetLastError();
        grid = cus;
    }
    if (grid < 0) return;
    (void)hipMemsetAsync((char*)d_ws + WS_CTL, 0, CTL_ZERO_BYTES, stream);
    Args a{};
    for (int i = 0; i < N_IN; ++i) a.in[i] = (const float*)d_in[i];
    a.out = (float*)d_out; a.ws = (unsigned char*)d_ws;
#if MK_N_LAUNCHES == 1
    a.ph_lo = 0; a.ph_hi = N_PHASES;
    { void* kargs[] = {(void*)&a};
      const hipError_t e = hipLaunchCooperativeKernel((const void*)mega_fwd, dim3(grid), dim3(NWAVES * 64), kargs, LDS_BYTES, stream);
      if (e != hipSuccess) fprintf(stderr, "kernel_launch: cooperative launch failed: %s (grid %d)\n", hipGetErrorString(e), grid); }
#else
    for (int p = 0; p < N_PHASES; ++p) { a.ph_lo = p; a.ph_hi = p + 1; hipLaunchKernelGGL(mega_fwd, dim3(grid), dim3(NWAVES * 64), LDS_BYTES, stream, a); }
#endif
}
```

```cpp
#include <hip/hip_runtime.h>
#include <cstdio>
#include <cstdint>
namespace pg8 {
#define PG8_LAS __attribute__((address_space(3)))
typedef unsigned short bf16_t;
typedef short bf16x8 __attribute__((ext_vector_type(8)));
typedef float f32x4 __attribute__((ext_vector_type(4)));
typedef unsigned u32x4 __attribute__((ext_vector_type(4)));
constexpr int BM = 256, BK = 64, HALF = 128, HTB = HALF * BK * 2  , STAGE_BYTES = 8 * HTB, NXCD = 8, WGM = 8;

__host__ __device__ __forceinline__ int lds_byte(int r, int c) { const int st = (r >> 4) * 2 + (c >> 5), rr = r & 15, cc = c & 31, ob = rr * 64 + cc * 2; return st * 1024 + (ob ^ (((ob >> 9) & 1) << 5)); }
__host__ __device__ __forceinline__ void stage_rc(int b, int& R, int& C) { const int st = b / 1024, sb = b % 1024, swz = sb ^ (((sb >> 9) & 1) << 5); R = (st >> 1) * 16 + swz / 64; C = (st & 1) * 32 + (swz % 64) / 2; }
__host__ __device__ __forceinline__ int perm32(int rho) { const int n = rho >> 4, i = rho & 15; return 8 * (i >> 2) + 4 * n + (i & 3); }

struct Unit { int pm, pn, k0, nt, slab; };
struct Gemm { const bf16_t* A; const bf16_t* Bt; int M, N, K; };

struct UnitOrder {
    int nM, nN, nwg, G, c, ntf, tailS;
    __device__ __forceinline__ void init(int nM_, int nN_, int K, int G_, int c_, int tailS_) { nM = nM_; nN = nN_; nwg = nM * nN; G = G_; c = c_; ntf = K / BK; tailS = tailS_; }
    __device__ __forceinline__ bool next(int i, Unit& u) const {
        long L = (long)i * G + c;
        if (L < nwg) {
            int wgid = (int)L; { const int q = nwg / NXCD, r = nwg % NXCD, xcd = wgid % NXCD, off = wgid / NXCD; wgid = (xcd < r ? xcd * (q + 1) : r * (q + 1) + (xcd - r) * q) + off; }
            const int nig = WGM * nN, gid = wgid / nig, fm = gid * WGM, gsz = (nM - fm) < WGM ? (nM - fm) : WGM;
            u.pm = fm + ((wgid % nig) % gsz); u.pn = (wgid % nig) / gsz; u.k0 = 0; u.nt = ntf; u.slab = -1;
            if (tailS < 0) { u.nt = 4; u.k0 = u.pn >= 8 ? 128 : 0; }
            return true;
        }
        L -= nwg; if (tailS <= 0 || L >= 8 * tailS) return false;
        int tile, sl; if (tailS == 4) { tile = (int)L >> 2; sl = (int)L & 3; } else { tile = (int)L / 11; sl = (int)L - 11 * tile; }
        u.pm = 64 + (tile >> 2); u.pn = tile & 3; u.k0 = sl * 256; u.nt = 4; u.slab = sl; return true;
    }
    __device__ __forceinline__ void a_ready(const Unit&) const {}
    __device__ __forceinline__ void done(const Unit&) const {}
};
template <class Epi, class Sched, bool ALIGN_EPI = false, bool SP2 = false>
__device__ __forceinline__ void gemm_phase(PG8_LAS unsigned char* lds, const Gemm g, const Sched& S, const Epi& E, const int tid) {
    const int wid = __builtin_amdgcn_readfirstlane(tid >> 6), lane = tid & 63, wr = wid >> 2, wc = wid & 3, fr = lane & 15, fq = lane >> 4;
    const int K = g.K;
    unsigned voffA[2], voffB[2];
#pragma unroll
    for (int i = 0; i < 2; ++i) { int R, C; stage_rc(tid * 16 + i * 8192, R, C); const int Rb = Epi::PERM ? ((R & ~31) + perm32(R & 31)) : R;
        voffA[i] = (unsigned)(R * K + C) * 2u; voffB[i] = (unsigned)(Rb * K + C) * 2u; }
    const size_t kstep = (size_t)(BK * 2);
    const size_t hstep = (size_t)HALF * K * 2;
    const size_t tstep = 2 * hstep;
    const unsigned ldsw = (unsigned)wid * 1024u;
    const int aoff = lds_byte(wr * 64 + fr, fq * 8), boff = lds_byte(wc * 32 + fr, fq * 8);
#define PG8_SA(b, h) (((b) * 2 + (h)) * HTB)
#define PG8_SB(b, h) ((4 + (b) * 2 + (h)) * HTB)
#define PG8_STAGE(bufoff, gbase, voff) do { _Pragma("unroll") for (int _i = 0; _i < 2; ++_i) \
        __builtin_amdgcn_global_load_lds((const unsigned*)((const char*)(gbase) + (voff)[_i]), (PG8_LAS unsigned*)(lds + (bufoff) + ldsw + _i * 8192), 16, 0, 0); } while (0)
#define PG8_LDA(dst, b, h) do { _Pragma("unroll") for (int m = 0; m < 4; ++m) _Pragma("unroll") for (int k = 0; k < 2; ++k) dst[m][k] = *(const PG8_LAS bf16x8*)(lds + PG8_SA(b, h) + aoff + m * 2048 + k * 1024); } while (0)
#define PG8_LDB(dst, b, h) do { _Pragma("unroll") for (int n = 0; n < 2; ++n) _Pragma("unroll") for (int k = 0; k < 2; ++k) dst[n][k] = *(const PG8_LAS bf16x8*)(lds + PG8_SB(b, h) + boff + n * 2048 + k * 1024); } while (0)
#define PG8_MMA(ai, bj, At, Bt) do { __builtin_amdgcn_s_setprio(1); _Pragma("unroll") for (int m = 0; m < 4; ++m) _Pragma("unroll") for (int n = 0; n < 2; ++n) _Pragma("unroll") for (int k = 0; k < 2; ++k) \
        acc[ai][bj][m][n] = __builtin_amdgcn_mfma_f32_16x16x32_bf16(Bt[n][k], At[m][k], acc[ai][bj][m][n], 0, 0, 0); __builtin_amdgcn_s_setprio(0); } while (0)
#define PG8_WAIT_V(n) asm volatile("s_waitcnt vmcnt(" #n ")" ::: "memory")
#define PG8_WAIT_L(n) asm volatile("s_waitcnt lgkmcnt(" #n ")" ::: "memory")
#define PG8_BAR __builtin_amdgcn_s_barrier()
#define PG8_SCHED __builtin_amdgcn_sched_barrier(0)
    Unit cur, nxt; int ui = 0;
    if (!S.next(0, cur)) return;
    f32x4 acc[2][2][4][2];
#pragma unroll
    for (int a = 0; a < 2; ++a)
#pragma unroll
        for (int b = 0; b < 2; ++b)
#pragma unroll
            for (int m = 0; m < 4; ++m)
#pragma unroll
                for (int n = 0; n < 2; ++n) acc[a][b][m][n] = (f32x4){0.f, 0.f, 0.f, 0.f};
    bf16x8 At[4][2], B0[2][2], B1[2][2];
    const char* cA = (const char*)g.A + (size_t)cur.pm * tstep + (size_t)cur.k0 * 2; const char* cB = (const char*)g.Bt + (size_t)cur.pn * tstep + (size_t)cur.k0 * 2;
    S.a_ready(cur);
    if constexpr (SP2) {
        PG8_STAGE(PG8_SB(0, 0), cB, voffB); PG8_STAGE(PG8_SB(0, 1), cB + hstep, voffB); PG8_STAGE(PG8_SA(0, 0), cA, voffA); PG8_STAGE(PG8_SA(0, 1), cA + hstep, voffA);
        if (wr == 1) PG8_BAR;
        PG8_WAIT_V(2); PG8_BAR;
        PG8_STAGE(PG8_SB(1, 0), cB + kstep, voffB); PG8_STAGE(PG8_SA(1, 0), cA + kstep, voffA); PG8_STAGE(PG8_SB(1, 1), cB + hstep + kstep, voffB);
        PG8_WAIT_V(6); PG8_BAR;
    } else {
        PG8_STAGE(PG8_SB(0, 0), cB, voffB); PG8_STAGE(PG8_SA(0, 0), cA, voffA); PG8_STAGE(PG8_SB(0, 1), cB + hstep, voffB); PG8_STAGE(PG8_SA(0, 1), cA + hstep, voffA);
        if (wr == 1) PG8_BAR;
        PG8_WAIT_V(4); PG8_BAR;
        PG8_STAGE(PG8_SB(1, 0), cB + kstep, voffB); PG8_STAGE(PG8_SA(1, 0), cA + kstep, voffA); PG8_STAGE(PG8_SB(1, 1), cB + hstep + kstep, voffB);
        PG8_WAIT_V(6); PG8_BAR;
    }
    for (;;) {
        const bool has_next = S.next(ui + 1, nxt);
        const char* nA = has_next ? (const char*)g.A + (size_t)nxt.pm * tstep + (size_t)nxt.k0 * 2 : cA; const char* nB = has_next ? (const char*)g.Bt + (size_t)nxt.pn * tstep + (size_t)nxt.k0 * 2 : cB;
        const int nt = cur.nt;
        for (int t = 0; t < nt; t += 2) {
            const bool last = (t == nt - 2);
            const char* a1 = cA + (size_t)(t + 1) * kstep;
            const char* a2 = last ? nA : cA + (size_t)(t + 2) * kstep; const char* b2 = last ? nB : cB + (size_t)(t + 2) * kstep;
            const char* a3 = a2 + kstep; const char* b3 = b2 + kstep;
            if (last && has_next) S.a_ready(nxt);
            if constexpr (SP2) {
            PG8_LDB(B0, 0, 0); PG8_LDB(B1, 0, 1); PG8_SCHED; PG8_LDA(At, 0, 0); PG8_STAGE(PG8_SA(1, 1), a1 + hstep, voffA);
            PG8_WAIT_V(8); PG8_WAIT_L(0); PG8_BAR; PG8_MMA(0, 0, At, B0); PG8_MMA(0, 1, At, B1); PG8_BAR; PG8_SCHED;
            PG8_LDA(At, 0, 1); PG8_STAGE(PG8_SB(0, 0), b2, voffB); PG8_STAGE(PG8_SB(0, 1), b2 + hstep, voffB); PG8_STAGE(PG8_SA(0, 0), a2, voffA);
            PG8_WAIT_V(8); PG8_WAIT_L(0); PG8_BAR; PG8_MMA(1, 0, At, B0); PG8_MMA(1, 1, At, B1); PG8_BAR; PG8_SCHED;
            PG8_LDB(B0, 1, 0); PG8_LDB(B1, 1, 1); PG8_SCHED; PG8_LDA(At, 1, 0); PG8_STAGE(PG8_SA(0, 1), a2 + hstep, voffA);
            PG8_WAIT_V(8); PG8_WAIT_L(0); PG8_BAR; PG8_MMA(0, 0, At, B0); PG8_MMA(0, 1, At, B1); PG8_BAR; PG8_SCHED;
            PG8_LDA(At, 1, 1); PG8_STAGE(PG8_SB(1, 0), b3, voffB); PG8_STAGE(PG8_SB(1, 1), b3 + hstep, voffB); PG8_STAGE(PG8_SA(1, 0), a3, voffA);
            PG8_WAIT_V(8); PG8_WAIT_L(0); PG8_BAR; PG8_MMA(1, 0, At, B0); PG8_MMA(1, 1, At, B1); PG8_BAR; PG8_SCHED;
            } else {
            PG8_LDB(B0, 0, 0); PG8_SCHED; PG8_LDA(At, 0, 0); PG8_STAGE(PG8_SA(1, 1), a1 + hstep, voffA);
            PG8_WAIT_L(8); PG8_BAR; PG8_WAIT_L(0); PG8_MMA(0, 0, At, B0); PG8_BAR; PG8_SCHED;
            PG8_LDB(B1, 0, 1); PG8_STAGE(PG8_SB(0, 0), b2, voffB);
            PG8_BAR; PG8_WAIT_L(0); PG8_MMA(0, 1, At, B1); PG8_BAR;
            PG8_LDA(At, 0, 1); PG8_STAGE(PG8_SA(0, 0), a2, voffA);
            PG8_BAR; PG8_WAIT_L(0); PG8_MMA(1, 0, At, B0); PG8_BAR; PG8_SCHED;
            PG8_STAGE(PG8_SB(0, 1), b2 + hstep, voffB);
            PG8_WAIT_V(6); PG8_BAR; PG8_MMA(1, 1, At, B1); PG8_BAR;
            PG8_LDB(B0, 1, 0); PG8_SCHED; PG8_LDA(At, 1, 0); PG8_STAGE(PG8_SA(0, 1), a2 + hstep, voffA);
            PG8_WAIT_L(8); PG8_BAR; PG8_WAIT_L(0); PG8_MMA(0, 0, At, B0); PG8_BAR; PG8_SCHED;
            PG8_LDB(B1, 1, 1); PG8_STAGE(PG8_SB(1, 0), b3, voffB);
            PG8_BAR; PG8_WAIT_L(0); PG8_MMA(0, 1, At, B1); PG8_BAR;
            PG8_LDA(At, 1, 1); PG8_STAGE(PG8_SA(1, 0), a3, voffA);
            PG8_BAR; PG8_WAIT_L(0); PG8_MMA(1, 0, At, B0); PG8_BAR; PG8_SCHED;
            PG8_STAGE(PG8_SB(1, 1), b3 + hstep, voffB);
            PG8_WAIT_V(6); PG8_BAR; PG8_MMA(1, 1, At, B1); PG8_BAR;
            }
        }
        if constexpr (ALIGN_EPI) { if (wr == 0) PG8_BAR; }
        if constexpr (!Epi::AFTER_DRAIN) { E(acc, cur, wr, wc, fr, fq); S.done(cur); }
        if (!has_next) break;
#pragma unroll
        for (int a = 0; a < 2; ++a)
#pragma unroll
            for (int b = 0; b < 2; ++b)
#pragma unroll
                for (int m = 0; m < 4; ++m)
#pragma unroll
                    for (int n = 0; n < 2; ++n) acc[a][b][m][n] = (f32x4){0.f, 0.f, 0.f, 0.f};
        cur = nxt; cA = nA; cB = nB; ++ui;
        if constexpr (ALIGN_EPI) { if (wr == 1) PG8_BAR; }
    }
    PG8_WAIT_V(0);
    if constexpr (!ALIGN_EPI) { if (wr == 0) PG8_BAR; }
    PG8_BAR;
    if constexpr (Epi::AFTER_DRAIN) { E.fused(acc, cur, wr, wc, fr, fq, lds, wid, lane); S.done(cur); }
#undef PG8_SA
#undef PG8_SB
#undef PG8_STAGE
#undef PG8_LDA
#undef PG8_LDB
#undef PG8_MMA
#undef PG8_WAIT_V
#undef PG8_WAIT_L
#undef PG8_BAR
#undef PG8_SCHED
}
}

#define GAS __attribute__((address_space(1)))
#define LAS __attribute__((address_space(3)))
typedef unsigned short bf16;
typedef unsigned v4u __attribute__((ext_vector_type(4)));
typedef float f32x4 __attribute__((ext_vector_type(4)));
typedef short bf16x8 __attribute__((ext_vector_type(8)));
typedef GAS unsigned gu32;
typedef GAS unsigned long long gu64;
#define RLX_AGENT __ATOMIC_RELAXED, __HIP_MEMORY_SCOPE_AGENT
#define LDS_WAIT() asm volatile("s_waitcnt lgkmcnt(0)" ::: "memory")
#define VM_WAIT() asm volatile("s_waitcnt vmcnt(0)" ::: "memory")
__device__ __forceinline__ unsigned long long rt() { return __builtin_amdgcn_s_memrealtime(); }
__device__ __forceinline__ unsigned f2bf(float f) { unsigned u = __builtin_bit_cast(unsigned, f); return (u + 0x7fffu + ((u >> 16) & 1u)) >> 16; }
__device__ __forceinline__ unsigned pk2(float lo, float hi) { return f2bf(lo) | (f2bf(hi) << 16); }

#define XB_TMO      128
#define XB_XCNT(j)  (256  + 64 * (j))
#define XB_XSUB(j)  (1280 + 64 * (j))
#define XB_XGEN(j)  (2304 + 64 * (j))
#define XB_TOP      3328
#define XB_TOPGEN   3392
#define XCD_BAR_WORDS 3456
#define XB_SPIN_CAP (1u << 18)

__device__ __forceinline__ unsigned xb_ld(unsigned* p)              { return __hip_atomic_load(p, __ATOMIC_RELAXED, __HIP_MEMORY_SCOPE_AGENT); }
__device__ __forceinline__ unsigned xb_add(unsigned* p, unsigned v) { return __hip_atomic_fetch_add(p, v, __ATOMIC_RELAXED, __HIP_MEMORY_SCOPE_AGENT); }
__device__ __forceinline__ unsigned xb_xcc_id() { return (unsigned)__builtin_amdgcn_s_getreg((3 << 11) | 20) & 0xFu; }
#define XB_SPIN(cond, bar) do { unsigned _sp = 0; while (cond) { __builtin_amdgcn_s_sleep(1); \
    if ((++_sp & 255u) == 0u) { if (xb_ld(&(bar)[XB_TMO])) break; if (_sp > XB_SPIN_CAP) { atomicAdd(&(bar)[XB_TMO], 1u); break; } } } } while (0)

struct XcdBarrier {
    unsigned* bar; unsigned x;
    volatile LAS unsigned* st;
};

__device__ __forceinline__ XcdBarrier xcd_barrier_post(unsigned* bar, volatile LAS unsigned* st) {
    XcdBarrier b; b.bar = bar; b.x = xb_xcc_id(); b.st = st;
    if (threadIdx.x == 0) (void)xb_add(&bar[XB_XCNT(b.x)], 1u);
    return b;
}
__device__ __forceinline__ void xcd_barrier_complete(unsigned* bar, unsigned x, unsigned& nloc, unsigned& nx) {
    const unsigned G = gridDim.x * gridDim.y * gridDim.z;
    unsigned sum, cnt, mine, sp = 0u;
    for (;;) {
        sum = 0u; cnt = 0u; mine = 0u;
#pragma unroll
        for (unsigned j = 0; j < 16; ++j) { const unsigned c = xb_ld(&bar[XB_XCNT(j)]); sum += c; cnt += (c > 0u) ? 1u : 0u; mine = (j == x) ? c : mine; }
        if (sum == G) break;
        __builtin_amdgcn_s_sleep(1);
        if ((++sp & 255u) == 0u) { if (xb_ld(&bar[XB_TMO])) break; if (sp > XB_SPIN_CAP) { atomicAdd(&bar[XB_TMO], 1u); break; } }
    }
    nloc = mine > 0u ? mine : 1u; nx = cnt > 0u ? cnt : 1u;
}

__device__ __forceinline__ void xcd_barrier(const XcdBarrier& b) {
    asm volatile("s_waitcnt vmcnt(0)" ::: "memory");
    __syncthreads();
    if (threadIdx.x == 0) {
        unsigned* bar = b.bar;
        __builtin_amdgcn_s_waitcnt(0);
        unsigned nloc = b.st[0], nx = b.st[1];
        if (nloc == 0u) { xcd_barrier_complete(bar, b.x, nloc, nx); b.st[0] = nloc; b.st[1] = nx; }
        const unsigned old = xb_add(&bar[XB_XSUB(b.x)], 1u);
        const unsigned gen = old / nloc;
        if (old + 1u == (gen + 1u) * nloc) {
            __builtin_amdgcn_fence(__ATOMIC_RELEASE, "agent");
            asm volatile("s_waitcnt vmcnt(0)" ::: "memory");
            const unsigned og = xb_add(&bar[XB_TOP], 1u);
            const unsigned tg = og / nx;
            if (og + 1u == (tg + 1u) * nx) xb_add(&bar[XB_TOPGEN], 1u);
            else XB_SPIN(xb_ld(&bar[XB_TOPGEN]) == tg, bar);
            __builtin_amdgcn_fence(__ATOMIC_ACQUIRE, "agent");
            xb_add(&bar[XB_XGEN(b.x)], 1u);
            asm volatile("s_waitcnt vmcnt(0)" ::: "memory");
        } else {
            XB_SPIN(xb_ld(&bar[XB_XGEN(b.x)]) == gen, bar);
            __builtin_amdgcn_fence(__ATOMIC_ACQUIRE, "agent");
            asm volatile("s_waitcnt vmcnt(0)" ::: "memory");
        }
    }
    __syncthreads();
}

constexpr int NWAVES = 8;
constexpr int D = 1024, FF = 2816;
constexpr int PB = 8, PT = 2048, SB = 128, STK = 4;
constexpr int MP = PB * PT, MS = SB * STK, M = MP + MS;
constexpr int NRW = 3584, KRW = 2048, NL2 = 3072, KL2 = 384, NIN = 3328;
constexpr float NORM_EPS = 1e-6f, GN_EPS = 64e-5f;
typedef pg8::bf16_t bf16;

constexpr size_t MiB = 1u << 20;
constexpr size_t WS_CTL = 0, CTL_ZERO_BYTES = 64 * 1024;
constexpr size_t WS_W = 1 * MiB;
constexpr size_t WS_XR = 20 * MiB;
constexpr size_t WS_BIG = 86 * MiB;
constexpr size_t WS_END = 256 * MiB;
constexpr size_t WS_YRAW = 256 * MiB, WS_BON = 288 * MiB, WS_W2 = 289 * MiB  , WS_END2 = 308 * MiB;
constexpr size_t W_GU = 0, W_D = (size_t)2 * FF * D * 2;
constexpr size_t W_RW = 0, W_L2 = (size_t)NRW * KRW * 2, W_O = W_L2 + (size_t)NL2 * KL2 * 2;
constexpr size_t W_IN = 0, W_OUT = (size_t)NIN * D * 2;
static_assert(W_D + (size_t)D * FF * 2 <= 19 * MiB && W_O + (size_t)D * D * 2 <= 19 * MiB && W_OUT + (size_t)D * D * 2 <= 19 * MiB, "weights region");
constexpr size_t B_H = 0, B_XN = 91 * MiB, B_SLAB = 124 * MiB;
constexpr size_t B_ACAT = 0, B_R = 66 * MiB, B_K = 99 * MiB, B_V = 132 * MiB, B_DEC = 0, B_AA = 33 * MiB;
constexpr size_t B_QKR = 0, B_VV = 33 * MiB, B_HO = 66 * MiB, B_OO = 124 * MiB, B_IF = 157 * MiB;
static_assert((size_t)M * FF * 2 <= 91 * MiB && (size_t)M * D * 2 == 33 * MiB && B_IF + (size_t)M * 16 * 4 <= 170 * MiB && B_SLAB + (size_t)11 * MS * D * 4 <= 170 * MiB, "BIG map");
constexpr size_t OS_GG = 0, OS_LORA = 33 * MiB;
static_assert(OS_LORA + (size_t)M * KL2 * 2 <= (size_t)MP * D * 4, "d_out scratch");
constexpr size_t O_Y = 0, O_P_S = 17301504, O_P_SHIFT = 17825792, O_P_C = 17833984, O_P_N = 18358272, O_P_M = 18362368, O_P_CONV = 18362432,
                 O_S_S = 18387008, O_S_SHIFT = 26775616, O_S_C = 26906688, O_S_N = 35295296, O_S_M = 35360832, O_S_CONV = 35361856, O_END = 35755072;
constexpr int CW_BAR = 1024;

constexpr int RING_BYTES = 131072, LDSCTL_OFF = RING_BYTES, MISC_OFF = LDSCTL_OFF + 320, TAB_OFF = LDSCTL_OFF + 1024, LDS_BYTES = 147456;

enum { I_XP = 0, I_XS, I_RS, I_RSHIFT, I_MC, I_MN, I_MM, I_MCONV, I_NFA, I_FAWG, I_FAWU, I_FAWD, I_NMIX, I_NFB, I_FBWG, I_FBWU, I_FBWD,
       I_MU, I_WR, I_WK, I_WV, I_WO, I_W0, I_W1, I_W2, I_A0, I_A1, I_A2, I_G1, I_G2, I_KK, I_KA, I_RK, I_GNW, I_GNB,
       I_WIN, I_BIF, I_CW, I_CB, I_MNW, I_WOUT, I_NFIN, N_IN };

typedef __bf16 bf16x2_t __attribute__((ext_vector_type(2)));
typedef float f32x2_t __attribute__((ext_vector_type(2)));
__device__ __forceinline__ unsigned pkbf(float lo, float hi) { f32x2_t v = {lo, hi}; bf16x2_t b = __builtin_convertvector(v, bf16x2_t); return __builtin_bit_cast(unsigned, b); }
__device__ __forceinline__ float bflo(unsigned u) { return __builtin_bit_cast(float, u << 16); }
__device__ __forceinline__ float bfhi(unsigned u) { return __builtin_bit_cast(float, u & 0xffff0000u); }
__device__ __forceinline__ float bf1(unsigned short u) { return __builtin_bit_cast(float, (unsigned)u << 16); }
__device__ __forceinline__ unsigned short f2bf1(float f) { return (unsigned short)(pkbf(f, 0.f) & 0xffffu); }
__device__ __forceinline__ void unpack8(v4u w, float (&o)[8]) { o[0] = bflo(w.x); o[1] = bfhi(w.x); o[2] = bflo(w.y); o[3] = bfhi(w.y); o[4] = bflo(w.z); o[5] = bfhi(w.z); o[6] = bflo(w.w); o[7] = bfhi(w.w); }
__device__ __forceinline__ v4u pack8(const float (&o)[8]) { v4u w; w.x = pkbf(o[0], o[1]); w.y = pkbf(o[2], o[3]); w.z = pkbf(o[4], o[5]); w.w = pkbf(o[6], o[7]); return w; }
__device__ __forceinline__ float sigmoidf_(float x) { return __builtin_amdgcn_rcpf(1.f + __expf(-x)); }
__device__ __forceinline__ float siluf_(float x) { return x * __builtin_amdgcn_rcpf(1.f + __expf(-x)); }
__device__ __forceinline__ float tanhf_(float x) { return 1.f - 2.f * __builtin_amdgcn_rcpf(__expf(2.f * x) + 1.f); }
__device__ __forceinline__ float logsigmoidf_(float x) { return fminf(x, 0.f) - log1pf(__expf(-fabsf(x))); }
template <int CTRL> __device__ __forceinline__ float dppf(float x) { return __builtin_bit_cast(float, __builtin_amdgcn_update_dpp(0, __builtin_bit_cast(int, x), CTRL, 0xF, 0xF, true)); }
__device__ __forceinline__ float red4(float x) { x += dppf<0xB1>(x); x += dppf<0x4E>(x); return x; }
__device__ __forceinline__ float red8(float x) { x = red4(x); x += dppf<0x141>(x); return x; }
__device__ __forceinline__ float red16(float x) { x = red8(x); x += dppf<0x140>(x); return x; }
__device__ __forceinline__ float wave_sum(float v) {
#pragma unroll
    for (int o = 1; o < 64; o <<= 1) v += __shfl_xor(v, o);
    return v;
}

struct Frame {
    LAS unsigned char* lds;
    volatile LAS unsigned* MISC;
    gu32* ctl;
    volatile LAS unsigned long long* tab;
    int tid, lane, wave, vcu, G;
};
__device__ __forceinline__ const float* inptr(const Frame& F, int i) { const unsigned long long v = F.tab[i];
    const unsigned lo = __builtin_amdgcn_readfirstlane((unsigned)v), hi = __builtin_amdgcn_readfirstlane((unsigned)(v >> 32)); return (const float*)(const GAS float*)(((unsigned long long)hi << 32) | lo); }

using pg8::Unit; using pg8::BM; using pg8::HALF;
__device__ __forceinline__ void st8bf(bf16* p, f32x4 v0, f32x4 v1) { v4u w; w.x = pkbf(v0[0], v0[1]); w.y = pkbf(v0[2], v0[3]); w.z = pkbf(v1[0], v1[1]); w.w = pkbf(v1[2], v1[3]); *(v4u*)p = w; }

struct EpiSwiglu {
    static constexpr bool PERM = true, AFTER_DRAIN = false;
    bf16* H; int pvar;
    __device__ __forceinline__ void operator()(const f32x4 (&acc)[2][2][4][2], const Unit& u, int wr, int wc, int fr, int fq) const {
        if (pvar == 3) return;
        const int row0 = u.pm * BM + wr * 64 + fr, col0 = u.pn * 128 + wc * 32 + 8 * fq;
#pragma unroll
        for (int ai = 0; ai < 2; ++ai)
#pragma unroll
            for (int m = 0; m < 4; ++m) {
                f32x4 o[2];
#pragma unroll
                for (int n = 0; n < 2; ++n)
#pragma unroll
                    for (int i = 0; i < 4; ++i) { const float g = acc[ai][0][m][n][i], up = acc[ai][1][m][n][i]; o[n][i] = siluf_(g) * up; }
                st8bf(H + (size_t)(row0 + ai * HALF + m * 16) * FF + col0, o[0], o[1]);
            }
    }
};
struct EpiRes {
    static constexpr bool PERM = false, AFTER_DRAIN = false;
    const float* base; float* out; float* slab; float coef;
    __device__ __forceinline__ void operator()(const f32x4 (&acc)[2][2][4][2], const Unit& u, int wr, int wc, int fr, int fq) const {
        const int row0 = u.pm * BM + wr * 64 + fr, col0 = u.pn * BM + wc * 32 + 4 * fq;
        if (u.slab < 0) {
#pragma unroll
            for (int ai = 0; ai < 2; ++ai)
#pragma unroll
                for (int m = 0; m < 4; ++m) { const size_t ro = (size_t)(row0 + ai * HALF + m * 16) * D + col0;
#pragma unroll
                    for (int bj = 0; bj < 2; ++bj)
#pragma unroll
                        for (int n = 0; n < 2; ++n) { const f32x4 b = *(const f32x4*)(base + ro + bj * HALF + n * 16); *(f32x4*)(out + ro + bj * HALF + n * 16) = b + acc[ai][bj][m][n] * coef; } }
        } else {
            float* sl = slab + (size_t)u.slab * MS * D;
#pragma unroll
            for (int ai = 0; ai < 2; ++ai)
#pragma unroll
                for (int m = 0; m < 4; ++m) { const size_t ro = (size_t)(row0 + ai * HALF + m * 16 - MP) * D + col0;
#pragma unroll
                    for (int bj = 0; bj < 2; ++bj)
#pragma unroll
                        for (int n = 0; n < 2; ++n) *(f32x4*)(sl + ro + bj * HALF + n * 16) = acc[ai][bj][m][n]; }
        }
    }
};
struct EpiRw {
    static constexpr bool PERM = true, AFTER_DRAIN = false;
    bf16 *R, *K, *V, *L;
    __device__ __forceinline__ void operator()(const f32x4 (&acc)[2][2][4][2], const Unit& u, int wr, int wc, int fr, int fq) const {
        const int row0 = u.pm * BM + wr * 64 + fr;
        if (u.pn < 12) {
            bf16 *p0 = R, *p1 = K, *p2 = V; asm volatile("" : "+s"(p0), "+s"(p1), "+s"(p2));
            bf16* dst = u.pn < 4 ? p0 : (u.pn < 8 ? p1 : p2); const int col0 = (u.pn & 3) * BM + wc * 32 + 8 * fq;
#pragma unroll
            for (int ai = 0; ai < 2; ++ai)
#pragma unroll
                for (int m = 0; m < 4; ++m) { bf16* rp = dst + (size_t)(row0 + ai * HALF + m * 16) * D + col0;
#pragma unroll
                    for (int bj = 0; bj < 2; ++bj) st8bf(rp + bj * HALF, acc[ai][bj][m][0], acc[ai][bj][m][1]); }
        } else {
#pragma unroll
            for (int bj = 0; bj < 2; ++bj) {
                const int lc = (u.pn - 12) * BM + bj * HALF + wc * 32 + 8 * fq;
                if (lc >= KL2) continue;
                const int act = lc < 64 ? 1 : (lc < 128 ? 0 : (lc < 288 ? 2 : 3));
#pragma unroll
                for (int ai = 0; ai < 2; ++ai)
#pragma unroll
                    for (int m = 0; m < 4; ++m) {
                        f32x4 o[2];
#pragma unroll
                        for (int n = 0; n < 2; ++n)
#pragma unroll
                            for (int i = 0; i < 4; ++i) { const float x = acc[ai][bj][m][n][i]; o[n][i] = act == 1 ? tanhf_(x) : (act == 0 ? x : (act == 2 ? sigmoidf_(x) : 0.f)); }
                        st8bf(L + (size_t)(row0 + ai * HALF + m * 16) * KL2 + lc, o[0], o[1]);
                    }
            }
        }
    }
};
struct EpiL2 {
    static constexpr bool PERM = true, AFTER_DRAIN = false;
    bf16 *DEC, *AA, *GG; const float *w0, *a0;
    __device__ __forceinline__ void operator()(const f32x4 (&acc)[2][2][4][2], const Unit& u, int wr, int wc, int fr, int fq) const {
        const int row0 = u.pm * BM + wr * 64 + fr, kind = u.pn >> 2, col0 = (u.pn & 3) * BM + wc * 32 + 8 * fq;
        bf16 *p0 = DEC, *p1 = AA, *p2 = GG; const float *q0 = w0, *q1 = a0; asm volatile("" : "+s"(p0), "+s"(p1), "+s"(p2), "+s"(q0), "+s"(q1));
        bf16* dst = kind == 0 ? p0 : (kind == 1 ? p1 : p2); const float* bias = kind == 0 ? q0 : q1;
#pragma unroll
        for (int bj = 0; bj < 2; ++bj) {
            f32x4 bv[2];
#pragma unroll
            for (int n = 0; n < 2; ++n) bv[n] = kind < 2 ? *(const f32x4*)(bias + col0 + bj * HALF + 4 * n) : (f32x4){0.f, 0.f, 0.f, 0.f};
#pragma unroll
            for (int ai = 0; ai < 2; ++ai)
#pragma unroll
                for (int m = 0; m < 4; ++m) {
                    f32x4 o[2];
#pragma unroll
                    for (int n = 0; n < 2; ++n)
#pragma unroll
                        for (int i = 0; i < 4; ++i) { const float z = acc[ai][bj][m][n][i] + bv[n][i];
                            o[n][i] = kind == 0 ? (1.f - __expf(-0.60653065971f * sigmoidf_(z))) : (kind == 1 ? sigmoidf_(z) : z); }
                    st8bf(dst + (size_t)(row0 + ai * HALF + m * 16) * D + col0 + bj * HALF, o[0], o[1]);
                }
        }
    }
};
struct EpiIn {
    static constexpr bool PERM = true, AFTER_DRAIN = false;
    bf16 *QKR, *VV, *OO; float* IF; const float* bif;
    __device__ __forceinline__ void operator()(const f32x4 (&acc)[2][2][4][2], const Unit& u, int wr, int wc, int fr, int fq) const {
        const int row0 = u.pm * BM + wr * 64 + fr;
        if (u.pn < 12) {
            bf16 *p0 = QKR, *p1 = VV, *p2 = OO; asm volatile("" : "+s"(p0), "+s"(p1), "+s"(p2));
            const int kind = u.pn >> 2; bf16* dst = kind == 0 ? p0 : (kind == 1 ? p1 : p2); const int col0 = (u.pn & 3) * BM + wc * 32 + 8 * fq;
#pragma unroll
            for (int ai = 0; ai < 2; ++ai)
#pragma unroll
                for (int m = 0; m < 4; ++m) { bf16* rp = dst + (size_t)(row0 + ai * HALF + m * 16) * D + col0;
#pragma unroll
                    for (int bj = 0; bj < 2; ++bj) { f32x4 a = acc[ai][bj][m][0], b = acc[ai][bj][m][1];
                        if (kind == 2) {
#pragma unroll
                            for (int i = 0; i < 4; ++i) { a[i] = sigmoidf_(a[i]); b[i] = sigmoidf_(b[i]); } }
                        st8bf(rp + bj * HALF, a, b); } }
        } else if (u.pn == 12 && wc == 0 && fq < 2) {
            const f32x4 b0 = *(const f32x4*)(bif + 8 * fq), b1 = *(const f32x4*)(bif + 8 * fq + 4);
#pragma unroll
            for (int ai = 0; ai < 2; ++ai)
#pragma unroll
                for (int m = 0; m < 4; ++m) { f32x4 a = acc[ai][0][m][0] + b0, b = acc[ai][0][m][1] + b1;
                    if (fq == 1) {
#pragma unroll
                        for (int i = 0; i < 4; ++i) { a[i] = logsigmoidf_(a[i]); b[i] = logsigmoidf_(b[i]); } }
                    float* rp = IF + (size_t)(row0 + ai * HALF + m * 16) * 16 + 8 * fq; *(f32x4*)rp = a; *(f32x4*)(rp + 4) = b; }
        }
    }
};

struct CJ { const float* W; const float* sc; bf16* WT; int K, N, Npad, ldk, koff, rmode, roff, smode; };
__device__ __forceinline__ int cj_items(const CJ& j) { return (j.K / 32) * (j.Npad / 32); }
__device__ __forceinline__ void conv_load(const CJ& J, int item, int lane, f32x4 (&w)[4], float (&sc)[4]) {
    const int nblk = J.Npad / 32, kb = item / nblk, nb = item % nblk, k0 = 32 * kb, n0 = 32 * nb;
    const int r = lane >> 3, c4 = 4 * (lane & 7); const bool nok = n0 + c4 < J.N;
#pragma unroll
    for (int i = 0; i < 4; ++i) { const int kk = k0 + r + 8 * i;
        w[i] = nok ? *(const f32x4*)(J.W + (size_t)kk * J.N + n0 + c4) : (f32x4){0.f, 0.f, 0.f, 0.f};
        float s = 1.f; if (J.smode) { s = J.sc[kk]; if (J.smode == 2) s = 1.f - s; }
        sc[i] = s; }
}
__device__ __forceinline__ void conv_store(const CJ& J, LAS float* scr, int item, int lane, const f32x4 (&w)[4], const float (&sc)[4]) {
    const int nblk = J.Npad / 32, kb = item / nblk, nb = item % nblk, k0 = 32 * kb, n0 = 32 * nb;
    const int r = lane >> 3, c4 = 4 * (lane & 7);
#pragma unroll
    for (int i = 0; i < 4; ++i) { const f32x4 f = w[i] * sc[i]; LAS float* d = scr + (r + 8 * i) * 33 + c4; d[0] = f[0]; d[1] = f[1]; d[2] = f[2]; d[3] = f[3]; }
    LDS_WAIT(); asm volatile("" ::: "memory");
    const int rowbase = J.rmode == 0 ? J.roff + n0 : (n0 >> 7) * 256 + (n0 & 127) + J.roff;
    const int c = lane & 3;
#pragma unroll
    for (int j = 0; j < 2; ++j) { const int n = (lane >> 2) + 16 * j; const LAS float* s = scr + (8 * c) * 33 + n;
        v4u o; o.x = pkbf(s[0 * 33], s[1 * 33]); o.y = pkbf(s[2 * 33], s[3 * 33]); o.z = pkbf(s[4 * 33], s[5 * 33]); o.w = pkbf(s[6 * 33], s[7 * 33]);
        *(GAS v4u*)(J.WT + (size_t)(rowbase + n) * J.ldk + J.koff + k0 + 8 * c) = o; }
    LDS_WAIT(); asm volatile("" ::: "memory");
}
__device__ __forceinline__ CJ get_job(const Frame& F, int kind, int j, int layer, int ab, bf16* Wb) {
    CJ J; J.sc = nullptr; J.smode = 0; J.koff = 0; J.rmode = 0; J.roff = 0;
    if (kind == 0) {
        const float* wg = inptr(F, ab ? I_FBWG : I_FAWG) + (size_t)layer * D * FF; const float* wu = inptr(F, ab ? I_FBWU : I_FAWU) + (size_t)layer * D * FF; const float* wd = inptr(F, ab ? I_FBWD : I_FAWD) + (size_t)layer * D * FF;
        if (j < 2) { J.W = j == 0 ? wg : wu; J.K = D; J.N = FF; J.Npad = FF; J.WT = Wb + W_GU / 2; J.ldk = D; J.rmode = 1; J.roff = j == 0 ? 0 : 128; }
        else { J.W = wd; J.K = FF; J.N = D; J.Npad = D; J.WT = Wb + W_D / 2; J.ldk = FF; }
    } else if (kind == 1) {
        if (j < 12) {
            const int s = j >> 1, half = j & 1;
            J.W = inptr(F, s == 0 ? I_WR : (s == 1 ? I_WK : (s == 2 ? I_WV : (s == 3 ? I_W1 : (s == 4 ? I_A1 : I_G1)))));
            J.N = s < 3 ? 1024 : (s < 5 ? 64 : 160); J.Npad = s < 3 ? 1024 : (s < 5 ? 64 : 384);
            J.roff = s < 3 ? 1024 * s : (s == 3 ? 3072 : (s == 4 ? 3136 : 3200));
            const int mui = s == 0 ? 0 : (s == 1 ? 2 : (s == 2 ? 3 : (s == 3 ? 1 : (s == 4 ? 4 : 5))));
            J.sc = inptr(F, I_MU) + mui * D; J.smode = half ? 1 : 2; J.koff = half * D; J.K = D; J.ldk = KRW; J.WT = Wb + W_RW / 2;
        } else { J.W = inptr(F, I_WO); J.K = D; J.N = D; J.Npad = D; J.WT = Wb + W_O / 2; J.ldk = D; }
    } else {
        if (j == 0) { J.W = inptr(F, I_WIN); J.K = D; J.N = 3088; J.Npad = NIN; J.WT = Wb + W_IN / 2; J.ldk = D; }
        else { J.W = inptr(F, I_WOUT); J.K = D; J.N = D; J.Npad = D; J.WT = Wb + W_OUT / 2; J.ldk = D; }
    }
    return J;
}
__device__ __forceinline__ void convert_weights(const Frame& F, int kind, int layer, int ab, bf16* Wb, const int cu0 = 0) {
    LAS float* scr = (LAS float*)(F.lds + F.wave * 16384);
    const int gw = (F.vcu - cu0) * NWAVES + F.wave, NGW = (F.G - cu0) * NWAVES;
    const int njobs = kind == 0 ? 3 : (kind == 1 ? 13 : 2);
    int total = 0;
    for (int j = 0; j < njobs; ++j) { const CJ J = get_job(F, kind, j, layer, ab, Wb); total += cj_items(J); }
    if (gw < total) {
        int r = gw, j = 0; CJ J = get_job(F, kind, 0, layer, ab, Wb);
        while (r >= cj_items(J)) { r -= cj_items(J); ++j; J = get_job(F, kind, j, layer, ab, Wb); }
        f32x4 w[4]; float sc[4];
        conv_load(J, r, F.lane, w, sc);
        for (int g = gw; g < total;) {
            const int gn = g + NGW; int rn = 0; CJ Jn = J; f32x4 wn[4]; float sn[4];
#pragma unroll
            for (int i = 0; i < 4; ++i) { wn[i] = (f32x4){0.f, 0.f, 0.f, 0.f}; sn[i] = 0.f; }
            if (gn < total) {
                rn = gn; int jn = 0; Jn = get_job(F, kind, 0, layer, ab, Wb);
                while (rn >= cj_items(Jn)) { rn -= cj_items(Jn); ++jn; Jn = get_job(F, kind, jn, layer, ab, Wb); }
                conv_load(Jn, rn, F.lane, wn, sn);
            }
            conv_store(J, scr, r, F.lane, w, sc);
            J = Jn; r = rn; g = gn;
#pragma unroll
            for (int i = 0; i < 4; ++i) { w[i] = wn[i]; sc[i] = sn[i]; }
        }
    }
    if (kind == 1) {
        bf16* WT = Wb + W_L2 / 2; const float* w2 = inptr(F, I_W2); const float* a2 = inptr(F, I_A2); const float* g2 = inptr(F, I_G2);
        for (int idx = (F.vcu * NWAVES + F.wave) * 64 + F.lane; idx < 48 * NL2; idx += F.G * NWAVES * 64) {
            const int c = idx / NL2, n = idx % NL2, type = n >> 10, jj = n & 1023;
            const float* src = nullptr;
            if (type == 0 && c < 8) src = w2 + (size_t)(8 * c) * D + jj;
            else if (type == 1 && c >= 8 && c < 16) src = a2 + (size_t)(8 * (c - 8)) * D + jj;
            else if (type == 2 && c >= 16 && c < 36) src = g2 + (size_t)(8 * (c - 16)) * D + jj;
            float v[8];
#pragma unroll
            for (int e = 0; e < 8; ++e) v[e] = src ? src[(size_t)e * D] : 0.f;
            *(GAS v4u*)(WT + (size_t)n * KL2 + 8 * c) = pack8(v);
        }
    }
}

template <int MODE>
__device__ __forceinline__ void norm_finish(const int m, f32x4 (&v)[4], const f32x4 (&gv)[4], bf16* dst, const float* shift_in, float* out, const int lane) {
    const bool samp = m >= MP;
    float ss = 0.f;
#pragma unroll
    for (int j = 0; j < 4; ++j) ss += (v[j].x * v[j].x + v[j].y * v[j].y) + (v[j].z * v[j].z + v[j].w * v[j].w);
    const float r = 1.0f / sqrtf(wave_sum(ss) * (1.f / D) + NORM_EPS);
#pragma unroll
    for (int j = 0; j < 4; ++j) v[j] = v[j] * r * gv[j];
    if (MODE == 2) {
#pragma unroll
        for (int j = 0; j < 4; ++j) *(f32x4*)(out + O_Y + (size_t)m * D + 256 * j + 4 * lane) = v[j];
    } else if (MODE == 0) {
#pragma unroll
        for (int j = 0; j < 4; ++j) { const unsigned long long w = (unsigned long long)pkbf(v[j].x, v[j].y) | ((unsigned long long)pkbf(v[j].z, v[j].w) << 32);
            *(unsigned long long*)(dst + (size_t)m * D + 256 * j + 4 * lane) = w; }
    } else {
        int t, b; bool first, last;
        if (!samp) { t = m & (PT - 1); b = m >> 11; first = t == 0; last = t == PT - 1; } else { const int mm = m - MP; t = mm & 3; b = mm >> 2; first = t == 0; last = t == 3; }
#pragma unroll
        for (int j = 0; j < 4; ++j) { const unsigned long long w = (unsigned long long)pkbf(v[j].x, v[j].y) | ((unsigned long long)pkbf(v[j].z, v[j].w) << 32);
            *(unsigned long long*)(dst + (size_t)m * (2 * D) + 256 * j + 4 * lane) = w;
            if (!last) *(unsigned long long*)(dst + (size_t)(m + 1) * (2 * D) + D + 256 * j + 4 * lane) = w;
            else *(f32x4*)(out + (samp ? O_S_SHIFT : O_P_SHIFT) + (size_t)b * D + 256 * j + 4 * lane) = v[j];
            if (first) { unsigned long long z = 0ull;
                if (samp) { const f32x4 s = *(const f32x4*)(shift_in + (size_t)b * D + 256 * j + 4 * lane); z = (unsigned long long)pkbf(s.x, s.y) | ((unsigned long long)pkbf(s.z, s.w) << 32); }
                *(unsigned long long*)(dst + (size_t)m * (2 * D) + D + 256 * j + 4 * lane) = z; }
        }
    }
}
template <int NS>
__device__ __forceinline__ void samp_row_load(const float* src, const float* slab, const int ms, const float coef, const int lane, f32x4 (&v)[4]) {
#pragma unroll
    for (int h = 0; h < 2; ++h) {
        f32x4 t[NS > 0 ? NS : 1][2], a[2];
#pragma unroll
        for (int jj = 0; jj < 2; ++jj) a[jj] = *(const f32x4*)(src + 256 * (2 * h + jj) + 4 * lane);
#pragma unroll
        for (int s = 0; s < NS; ++s)
#pragma unroll
            for (int jj = 0; jj < 2; ++jj) t[s][jj] = *(const f32x4*)(slab + ((size_t)s * MS + ms) * D + 256 * (2 * h + jj) + 4 * lane);
#pragma unroll
        for (int jj = 0; jj < 2; ++jj) {
#pragma unroll
            for (int s = 0; s < NS; ++s) a[jj] += t[s][jj] * coef;
            v[2 * h + jj] = a[jj]; }
    }
}
template <int MODE>
__device__ __forceinline__ void norm_rows(const Frame& F, const float* base_p, const float* base_s, int nslab, float coef, const float* slab, float* xr,
                                          const float* gain, bf16* dst, const float* shift_in, float* out, const int pvar = 0) {
    const int gw = F.vcu * NWAVES + F.wave, NGW = F.G * NWAVES, lane = F.lane;
    f32x4 gv[4];
#pragma unroll
    for (int j = 0; j < 4; ++j) gv[j] = *(const f32x4*)(gain + 256 * j + 4 * lane);
    for (int s = F.wave * F.G + F.vcu; s < MS; s += NWAVES * F.G) {
        const int m = MP + s; const float* src = base_s + (size_t)s * D; f32x4 v[4];
        if (nslab == 11) samp_row_load<11>(src, slab, s, coef, lane, v); else if (nslab == 4) samp_row_load<4>(src, slab, s, coef, lane, v); else samp_row_load<0>(src, slab, s, coef, lane, v);
        if (nslab > 0 && MODE != 2 && pvar == 0) {
#pragma unroll
            for (int j = 0; j < 4; ++j) *(f32x4*)(xr + (size_t)m * D + 256 * j + 4 * lane) = v[j]; }
        norm_finish<MODE>(m, v, gv, dst, shift_in, out, lane);
    }
    int m = gw; f32x4 v[4];
    if (m < MP) {
#pragma unroll
        for (int j = 0; j < 4; ++j) v[j] = *(const f32x4*)(base_p + (size_t)m * D + 256 * j + 4 * lane); }
    while (m < MP) {
        const int mn = m + NGW; f32x4 vn[4];
#pragma unroll
        for (int j = 0; j < 4; ++j) vn[j] = (f32x4){0.f, 0.f, 0.f, 0.f};
        if (mn < MP) {
#pragma unroll
            for (int j = 0; j < 4; ++j) vn[j] = *(const f32x4*)(base_p + (size_t)mn * D + 256 * j + 4 * lane); }
        norm_finish<MODE>(m, v, gv, dst, shift_in, out, lane);
#pragma unroll
        for (int j = 0; j < 4; ++j) v[j] = vn[j];
        m = mn;
    }
}

constexpr int RW_KK = 0, RW_DD = 4096, RW_BB = 8192, RW_KP = 12288, RW_RR = 16384, RW_VV = 20480, RW_YY = 24576;
__device__ __forceinline__ void rwkv_chain(const Frame& F, int row0, int T, int h, const float* S0, float* ST,
                                           const bf16* Rb, const bf16* Kb, const bf16* Vb, const bf16* Db, const bf16* Ab, bf16* Gb,
                                           const float* k_k, const float* k_a, const float* r_k, const float* gn_w, const float* gn_b, const bool do_store, const int pvar) {
    LAS float* L = (LAS float*)F.lds;
    const int tid = F.tid, lane = F.lane, w = F.wave;
    const int cg = tid & 7, tt = tid >> 3;
    const int srow = 8 * w + (lane >> 3);
    float S[8];
    if (S0) { const f32x4 a = *(const f32x4*)(S0 + srow * 64 + 8 * cg), b = *(const f32x4*)(S0 + srow * 64 + 8 * cg + 4);
        S[0] = a.x; S[1] = a.y; S[2] = a.z; S[3] = a.w; S[4] = b.x; S[5] = b.y; S[6] = b.z; S[7] = b.w; }
    else {
#pragma unroll
        for (int j = 0; j < 8; ++j) S[j] = 0.f; }
    const int ch = h * 64 + 8 * cg;
    float ckk[8], cka[8], crk[8], cgw[8], cgb[8];
#pragma unroll
    for (int j = 0; j < 8; ++j) { ckk[j] = k_k[ch + j]; cka[j] = k_a[ch + j]; crk[j] = r_k[ch + j]; cgw[j] = gn_w[ch + j]; cgb[j] = gn_b[ch + j]; }
    const int nch = (T + 63) >> 6;
    v4u pr = {0, 0, 0, 0}, pk = pr, pv = pr, pd = pr, pa = pr, pg = pr;
    { const int nt0 = T < 64 ? T : 64;
      if (tt < nt0) { const size_t off = (size_t)(row0 + tt) * D + ch;
          pr = *(const v4u*)(Rb + off); pk = *(const v4u*)(Kb + off); pv = *(const v4u*)(Vb + off); pd = *(const v4u*)(Db + off); pa = *(const v4u*)(Ab + off); pg = *(const v4u*)(Gb + off); } }
    float bon = 0.f, vv[8], gg[8];
    for (int c = 0; c < nch; ++c) {
        const int nt = (T - 64 * c) < 64 ? (T - 64 * c) : 64;
        const bool valid = tt < nt;
        {
            float r8[8], k8[8], d8[8], a8[8];
            unpack8(pr, r8); unpack8(pk, k8); unpack8(pv, vv); unpack8(pd, d8); unpack8(pa, a8); unpack8(pg, gg);
            float kk[8], ss = 0.f;
#pragma unroll
            for (int j = 0; j < 8; ++j) { kk[j] = k8[j] * ckk[j]; ss += kk[j] * kk[j]; }
            ss = red8(ss);
            const float inv = __builtin_amdgcn_rsqf(fmaxf(ss, 1e-24f));
            float kp[8], bsum = 0.f;
#pragma unroll
            for (int j = 0; j < 8; ++j) { kk[j] *= inv; kp[j] = k8[j] * (1.f + (a8[j] - 1.f) * cka[j]); bsum += r8[j] * kp[j] * crk[j]; }
            bon = red8(bsum);
            if (valid) {
                LAS float* p = L + tt * 64 + 8 * cg;
                *(LAS f32x4*)(p + RW_KK) = (f32x4){-kk[0], -kk[1], -kk[2], -kk[3]}; *(LAS f32x4*)(p + RW_KK + 4) = (f32x4){-kk[4], -kk[5], -kk[6], -kk[7]};
                *(LAS f32x4*)(p + RW_DD) = (f32x4){1.f - d8[0], 1.f - d8[1], 1.f - d8[2], 1.f - d8[3]}; *(LAS f32x4*)(p + RW_DD + 4) = (f32x4){1.f - d8[4], 1.f - d8[5], 1.f - d8[6], 1.f - d8[7]};
                *(LAS f32x4*)(p + RW_BB) = (f32x4){kk[0] * a8[0], kk[1] * a8[1], kk[2] * a8[2], kk[3] * a8[3]}; *(LAS f32x4*)(p + RW_BB + 4) = (f32x4){kk[4] * a8[4], kk[5] * a8[5], kk[6] * a8[6], kk[7] * a8[7]};
                *(LAS f32x4*)(p + RW_KP) = (f32x4){kp[0], kp[1], kp[2], kp[3]}; *(LAS f32x4*)(p + RW_KP + 4) = (f32x4){kp[4], kp[5], kp[6], kp[7]};
                *(LAS f32x4*)(p + RW_RR) = (f32x4){r8[0], r8[1], r8[2], r8[3]}; *(LAS f32x4*)(p + RW_RR + 4) = (f32x4){r8[4], r8[5], r8[6], r8[7]};
                *(LAS f32x4*)(p + RW_VV) = (f32x4){vv[0], vv[1], vv[2], vv[3]}; *(LAS f32x4*)(p + RW_VV + 4) = (f32x4){vv[4], vv[5], vv[6], vv[7]};
            }
        }
        __syncthreads();
        if (c + 1 < nch) { const int nt1 = (T - 64 * (c + 1)) < 64 ? (T - 64 * (c + 1)) : 64;
            if (tt < nt1) { const size_t off = (size_t)(row0 + 64 * (c + 1) + tt) * D + ch;
                pr = *(const v4u*)(Rb + off); pk = *(const v4u*)(Kb + off); pv = *(const v4u*)(Vb + off); pd = *(const v4u*)(Db + off); pa = *(const v4u*)(Ab + off); pg = *(const v4u*)(Gb + off); } }
        {
            typedef float f2 __attribute__((ext_vector_type(2)));
            f2 S2[4] = {{S[0], S[1]}, {S[2], S[3]}, {S[4], S[5]}, {S[6], S[7]}};
            const LAS float* p = L + 8 * cg;
            LAS float* yw = L + RW_YY + srow;
            const LAS float* vp = L + RW_VV + srow;
#define RW_LD(N, Dd, B, Q, R, VR, t_) do { const LAS float* p_ = p + (t_) * 64; \
                N[0] = *(const LAS f32x4*)(p_ + RW_KK); N[1] = *(const LAS f32x4*)(p_ + RW_KK + 4); Dd[0] = *(const LAS f32x4*)(p_ + RW_DD); Dd[1] = *(const LAS f32x4*)(p_ + RW_DD + 4); \
                B[0] = *(const LAS f32x4*)(p_ + RW_BB); B[1] = *(const LAS f32x4*)(p_ + RW_BB + 4); Q[0] = *(const LAS f32x4*)(p_ + RW_KP); Q[1] = *(const LAS f32x4*)(p_ + RW_KP + 4); \
                R[0] = *(const LAS f32x4*)(p_ + RW_RR); R[1] = *(const LAS f32x4*)(p_ + RW_RR + 4); VR = vp[(t_) * 64]; } while (0)
#define RW_STEP(N, Dd, B, Q, R, VR, t_) do { \
                f2 a_ = S2[0] * (f2){N[0].x, N[0].y}; a_ = S2[1] * (f2){N[0].z, N[0].w} + a_; a_ = S2[2] * (f2){N[1].x, N[1].y} + a_; a_ = S2[3] * (f2){N[1].z, N[1].w} + a_; \
                const float sa_ = red8(a_.x + a_.y); const f2 sv_ = {sa_, sa_}, vv_ = {VR, VR}; \
                S2[0] = S2[0] * (f2){Dd[0].x, Dd[0].y} + (sv_ * (f2){B[0].x, B[0].y} + vv_ * (f2){Q[0].x, Q[0].y}); \
                S2[1] = S2[1] * (f2){Dd[0].z, Dd[0].w} + (sv_ * (f2){B[0].z, B[0].w} + vv_ * (f2){Q[0].z, Q[0].w}); \
                S2[2] = S2[2] * (f2){Dd[1].x, Dd[1].y} + (sv_ * (f2){B[1].x, B[1].y} + vv_ * (f2){Q[1].x, Q[1].y}); \
                S2[3] = S2[3] * (f2){Dd[1].z, Dd[1].w} + (sv_ * (f2){B[1].z, B[1].w} + vv_ * (f2){Q[1].z, Q[1].w}); \
                f2 y_ = S2[0] * (f2){R[0].x, R[0].y}; y_ = S2[1] * (f2){R[0].z, R[0].w} + y_; y_ = S2[2] * (f2){R[1].x, R[1].y} + y_; y_ = S2[3] * (f2){R[1].z, R[1].w} + y_; \
                yw[(t_) * 64] = red8(y_.x + y_.y); } while (0)
            f32x4 nA[2], dA[2], bA[2], qA[2], rA[2]; float vA;
            for (int t = 0; t < nt; ++t) { RW_LD(nA, dA, bA, qA, rA, vA, t); RW_STEP(nA, dA, bA, qA, rA, vA, t); }
#undef RW_LD
#undef RW_STEP
            S[0] = S2[0].x; S[1] = S2[0].y; S[2] = S2[1].x; S[3] = S2[1].y; S[4] = S2[2].x; S[5] = S2[2].y; S[6] = S2[3].x; S[7] = S2[3].y;
        }
        __syncthreads();
        if (pvar != 4) {
            f32x4 y0 = {0.f, 0.f, 0.f, 0.f}, y1 = y0;
            if (valid) { y0 = *(const LAS f32x4*)(L + RW_YY + tt * 64 + 8 * cg); y1 = *(const LAS f32x4*)(L + RW_YY + tt * 64 + 8 * cg + 4); }
            float yy[8] = {y0.x, y0.y, y0.z, y0.w, y1.x, y1.y, y1.z, y1.w};
            float s1 = 0.f;
#pragma unroll
            for (int j = 0; j < 8; ++j) s1 += yy[j];
            const float mean = red8(s1) * (1.f / 64.f);
            float s2 = 0.f;
#pragma unroll
            for (int j = 0; j < 8; ++j) { yy[j] -= mean; s2 += yy[j] * yy[j]; }
            const float rstd = __builtin_amdgcn_rsqf(red8(s2) * (1.f / 64.f) + GN_EPS);
            float o[8];
#pragma unroll
            for (int j = 0; j < 8; ++j) o[j] = ((yy[j] * rstd) * cgw[j] + cgb[j] + bon * vv[j]) * gg[j];
            if (valid && do_store) *(v4u*)(Gb + (size_t)(row0 + 64 * c + tt) * D + ch) = pack8(o);
        }
    }
    *(f32x4*)(ST + srow * 64 + 8 * cg) = (f32x4){S[0], S[1], S[2], S[3]}; *(f32x4*)(ST + srow * 64 + 8 * cg + 4) = (f32x4){S[4], S[5], S[6], S[7]};
    __syncthreads();
}

constexpr int RH_TC = 32, RH_BUF = 12288;
constexpr int RH_KK = 0, RH_DD = 2048, RH_BB = 4096, RH_KP = 6144, RH_RR = 8192, RH_VV = 10240, RH_YY = 11264;
__device__ __forceinline__ void rwkv_half_chain(const Frame& F, int b, int h, int half, float* ST, const bf16* Rb, const bf16* Kb, const bf16* Vb, const bf16* Db, const bf16* Ab,
                                                bf16* YRAW, float* BON, const float* k_k, const float* k_a, const float* r_k, const int pvar) {
    LAS float* L = (LAS float*)F.lds;
    const int tid = F.tid, lane = F.lane, w = F.wave, row0 = b * PT;
    constexpr int nch = PT / RH_TC;
    if (w < 4) {
        const int srow = 8 * w + (lane >> 3), cq = lane & 7;
        f32x4 S4 = {0.f, 0.f, 0.f, 0.f}, S5 = S4;
        __syncthreads();
        __builtin_amdgcn_s_setprio(3);
        for (int c = 0; c < nch; ++c) {
            const LAS float* p = L + (c & 1) * RH_BUF + 8 * cq;
            LAS float* yw = L + (c & 1) * RH_BUF + RH_YY + srow;
            const LAS float* vp = L + (c & 1) * RH_BUF + RH_VV + srow;
#define RH_LD(N, Dd, B, Q, R, VR, t_) do { const LAS float* p_ = p + (t_) * 64; \
                N[0] = *(const LAS f32x4*)(p_ + RH_KK); N[1] = *(const LAS f32x4*)(p_ + RH_KK + 4); Dd[0] = *(const LAS f32x4*)(p_ + RH_DD); Dd[1] = *(const LAS f32x4*)(p_ + RH_DD + 4); \
                B[0] = *(const LAS f32x4*)(p_ + RH_BB); B[1] = *(const LAS f32x4*)(p_ + RH_BB + 4); Q[0] = *(const LAS f32x4*)(p_ + RH_KP); Q[1] = *(const LAS f32x4*)(p_ + RH_KP + 4); \
                R[0] = *(const LAS f32x4*)(p_ + RH_RR); R[1] = *(const LAS f32x4*)(p_ + RH_RR + 4); VR = vp[(t_) * 32]; } while (0)
#define RH_STEP(N, Dd, B, Q, R, VR, t_) do { \
                const f32x4 pa_ = S4 * N[0] + S5 * N[1]; const float sa_ = red8((pa_.x + pa_.y) + (pa_.z + pa_.w)); \
                S4 = S4 * Dd[0] + (B[0] * sa_ + Q[0] * VR); S5 = S5 * Dd[1] + (B[1] * sa_ + Q[1] * VR); \
                const f32x4 ya_ = S4 * R[0] + S5 * R[1]; yw[(t_) * 32] = red8((ya_.x + ya_.y) + (ya_.z + ya_.w)); } while (0)
            f32x4 nA[2], dA[2], bA[2], qA[2], rA[2], nB[2], dB[2], bB[2], qB[2], rB[2]; float vA, vB;
            RH_LD(nA, dA, bA, qA, rA, vA, 0);
            if (pvar != 3)
            for (int t = 0; t < RH_TC; t += 2) {
                RH_LD(nB, dB, bB, qB, rB, vB, t + 1);
                RH_STEP(nA, dA, bA, qA, rA, vA, t);
                RH_LD(nA, dA, bA, qA, rA, vA, (t + 2 < RH_TC ? t + 2 : t + 1));
                RH_STEP(nB, dB, bB, qB, rB, vB, t + 1);
            }
#undef RH_LD
#undef RH_STEP
            __syncthreads();
        }
        __builtin_amdgcn_s_setprio(0);
        *(f32x4*)(ST + (32 * half + srow) * 64 + 8 * cq) = S4; *(f32x4*)(ST + (32 * half + srow) * 64 + 8 * cq + 4) = S5;
    } else {
        const int ht = tid - 256, cg = ht & 7, tt = ht >> 3;
        const int ch = h * 64 + 8 * cg, vch = h * 64 + 32 * half + 4 * cg;
        float ckk[8], cka[8], crk[8];
#pragma unroll
        for (int j = 0; j < 8; ++j) { ckk[j] = k_k[ch + j]; cka[j] = k_a[ch + j]; crk[j] = r_k[ch + j]; }
        v4u pr, pk, pd, pa; uint2 pv;
#define RH_LOAD(cc) do { const size_t off_ = (size_t)(row0 + RH_TC * (cc) + tt) * D; pr = *(const v4u*)(Rb + off_ + ch); pk = *(const v4u*)(Kb + off_ + ch); pd = *(const v4u*)(Db + off_ + ch); \
            pa = *(const v4u*)(Ab + off_ + ch); pv = *(const uint2*)(Vb + off_ + vch); } while (0)
#define RH_PREP(cc) do { float r8[8], k8[8], d8[8], a8[8]; unpack8(pr, r8); unpack8(pk, k8); unpack8(pd, d8); unpack8(pa, a8); \
            float kk[8], ss = 0.f; _Pragma("unroll") for (int j = 0; j < 8; ++j) { kk[j] = k8[j] * ckk[j]; ss += kk[j] * kk[j]; } \
            ss = red8(ss); const float inv = __builtin_amdgcn_rsqf(fmaxf(ss, 1e-24f)); \
            float kp[8], bsum = 0.f; _Pragma("unroll") for (int j = 0; j < 8; ++j) { kk[j] *= inv; kp[j] = k8[j] * (1.f + (a8[j] - 1.f) * cka[j]); bsum += r8[j] * kp[j] * crk[j]; } \
            const float bon = red8(bsum); if (half == 0 && cg == 0) BON[(size_t)(row0 + RH_TC * (cc) + tt) * 16 + h] = bon; \
            LAS float* p = L + ((cc) & 1) * RH_BUF + tt * 64 + 8 * cg; \
            *(LAS f32x4*)(p + RH_KK) = (f32x4){-kk[0], -kk[1], -kk[2], -kk[3]}; *(LAS f32x4*)(p + RH_KK + 4) = (f32x4){-kk[4], -kk[5], -kk[6], -kk[7]}; \
            *(LAS f32x4*)(p + RH_DD) = (f32x4){1.f - d8[0], 1.f - d8[1], 1.f - d8[2], 1.f - d8[3]}; *(LAS f32x4*)(p + RH_DD + 4) = (f32x4){1.f - d8[4], 1.f - d8[5], 1.f - d8[6], 1.f - d8[7]}; \
            *(LAS f32x4*)(p + RH_BB) = (f32x4){kk[0] * a8[0], kk[1] * a8[1], kk[2] * a8[2], kk[3] * a8[3]}; *(LAS f32x4*)(p + RH_BB + 4) = (f32x4){kk[4] * a8[4], kk[5] * a8[5], kk[6] * a8[6], kk[7] * a8[7]}; \
            *(LAS f32x4*)(p + RH_KP) = (f32x4){kp[0], kp[1], kp[2], kp[3]}; *(LAS f32x4*)(p + RH_KP + 4) = (f32x4){kp[4], kp[5], kp[6], kp[7]}; \
            *(LAS f32x4*)(p + RH_RR) = (f32x4){r8[0], r8[1], r8[2], r8[3]}; *(LAS f32x4*)(p + RH_RR + 4) = (f32x4){r8[4], r8[5], r8[6], r8[7]}; \
            *(LAS f32x4*)(L + ((cc) & 1) * RH_BUF + RH_VV + tt * 32 + 4 * cg) = (f32x4){bflo(pv.x), bfhi(pv.x), bflo(pv.y), bfhi(pv.y)}; } while (0)
#define RH_POST(cc) do { const f32x4 y4 = *(const LAS f32x4*)(L + ((cc) & 1) * RH_BUF + RH_YY + tt * 32 + 4 * cg); uint2 o; o.x = pkbf(y4.x, y4.y); o.y = pkbf(y4.z, y4.w); \
            *(uint2*)(YRAW + (size_t)(row0 + RH_TC * (cc) + tt) * D + vch) = o; } while (0)
        RH_LOAD(0); RH_PREP(0); RH_LOAD(1);
        __syncthreads();
        for (int c = 0; c < nch; ++c) {
            if (c > 0) RH_POST(c - 1);
            if (c + 1 < nch) { RH_PREP(c + 1); if (c + 2 < nch) RH_LOAD(c + 2); }
            __syncthreads();
        }
        RH_POST(nch - 1);
#undef RH_LOAD
#undef RH_PREP
#undef RH_POST
    }
    __syncthreads();
}
__device__ __forceinline__ void rwkv_finish(const Frame& F, const bf16* YRAW, const float* BON, const bf16* Vb, bf16* Gb, const float* gn_w, const float* gn_b) {
    const int gt = (F.vcu * NWAVES + F.wave) * 64 + F.lane, NT = F.G * NWAVES * 64;
    for (int task = gt; task < MP * 128; task += NT) {
        const int cg = task & 7, hh = (task >> 3) & 15, row = task >> 7; const size_t off = (size_t)row * D + hh * 64 + 8 * cg;
        float yy[8], vv[8], gg[8]; unpack8(*(const v4u*)(YRAW + off), yy); unpack8(*(const v4u*)(Vb + off), vv); unpack8(*(const v4u*)(Gb + off), gg);
        const float bon = BON[(size_t)row * 16 + hh];
        float s1 = 0.f;
#pragma unroll
        for (int j = 0; j < 8; ++j) s1 += yy[j];
        const float mean = red8(s1) * (1.f / 64.f);
        float s2 = 0.f;
#pragma unroll
        for (int j = 0; j < 8; ++j) { yy[j] -= mean; s2 += yy[j] * yy[j]; }
        const float rstd = __builtin_amdgcn_rsqf(red8(s2) * (1.f / 64.f) + GN_EPS);
        const f32x4 w0 = *(const f32x4*)(gn_w + hh * 64 + 8 * cg), w1 = *(const f32x4*)(gn_w + hh * 64 + 8 * cg + 4), b0 = *(const f32x4*)(gn_b + hh * 64 + 8 * cg), b1 = *(const f32x4*)(gn_b + hh * 64 + 8 * cg + 4);
        const float gw[8] = {w0.x, w0.y, w0.z, w0.w, w1.x, w1.y, w1.z, w1.w}, gb[8] = {b0.x, b0.y, b0.z, b0.w, b1.x, b1.y, b1.z, b1.w};
        float o[8];
#pragma unroll
        for (int j = 0; j < 8; ++j) o[j] = ((yy[j] * rstd) * gw[j] + gb[j] + bon * vv[j]) * gg[j];
        *(v4u*)(Gb + off) = pack8(o);
    }
}

constexpr int PBY = 144;
constexpr int RPY = 272;
constexpr int ML_RQK = 0, ML_S = 0, ML_KT = 9216, ML_RV = 18432, ML_Q = 35840, ML_K = 45056, ML_HB = 35840, ML_VT = 54272, ML_C = 72704, ML_F = 91136;
constexpr int MF_N = 0, MF_QN = 64, MF_RS = 128, MF_HS = 256, MF_CW = 384, MF_B63 = 1024, MF_P63 = 1056, MF_MC = 1088  , MF_GB = 1152, MF_GP = MF_GB + 2048, MF_GA = MF_GP + 2048;
typedef __attribute__((address_space(3))) unsigned short lds_u16;
#define MFMA16(a, b, c) __builtin_amdgcn_mfma_f32_16x16x32_bf16((a), (b), (c), 0, 0, 0)
__device__ __forceinline__ void mlstm_prompt_chain(const Frame& F, int b, int hh, const bf16* QKR, const bf16* VVb, const bf16* OOb, const float* IFb, bf16* HOb,
                                                   const float* conv_w, const float* conv_b, const float* norm_w, float* out, const int pvar) {
    LAS unsigned char* lds = F.lds; LAS float* Fl = (LAS float*)(lds + ML_F);
    const int tid = F.tid, lane = F.lane, w = F.wave, fr = lane & 15, fq = lane >> 4;
    for (int i = tid; i < 128 * 72; i += 512) ((lds_u16*)(lds + ML_C))[i] = 0;
    if (tid < 64) Fl[MF_N + tid] = 0.f;
    for (int i = tid; i < 640; i += 512) { const int j = i >> 7, c = i & 127, gc = c < 64 ? hh * 64 + c : 512 + hh * 64 + (c - 64); Fl[MF_CW + i] = j < 4 ? conv_w[j * D + gc] : conv_b[gc]; }
    f32x4 Cacc[4];
#pragma unroll
    for (int k = 0; k < 4; ++k) Cacc[k] = (f32x4){0.f, 0.f, 0.f, 0.f};
    const int og = tid & 15, ot = tid >> 4;
    float nw[8];
#pragma unroll
    for (int e = 0; e < 8; ++e) nw[e] = norm_w[hh * 128 + 8 * og + e];
    v4u rq[3], rv[2], ro[2];
#define ML_LOAD_QKV(cc) do { const int rowc_ = b * PT + 64 * (cc); \
        _Pragma("unroll") for (int i = 0; i < 3; ++i) { const int q = tid + 512 * i, r = q >> 4, j = q & 15, tok = 64 * (cc) - 3 + r; rq[i] = (v4u){0u, 0u, 0u, 0u}; \
            if (q < 67 * 16 && tok >= 0) rq[i] = *(const v4u*)(QKR + (size_t)(b * PT + tok) * D + (j < 8 ? hh * 64 + 8 * j : 512 + hh * 64 + 8 * (j - 8))); } \
        _Pragma("unroll") for (int i = 0; i < 2; ++i) rv[i] = *(const v4u*)(VVb + (size_t)(rowc_ + ot + 32 * i) * D + hh * 128 + 8 * og); \
        } while (0)
#define ML_LOAD_O(cc) do { const int rowc_ = b * PT + 64 * (cc); \
        _Pragma("unroll") for (int i = 0; i < 2; ++i) ro[i] = *(const v4u*)(OOb + (size_t)(rowc_ + ot + 32 * i) * D + hh * 128 + 8 * og); } while (0)
    ML_LOAD_QKV(0);
#pragma unroll
    for (int q = 0; q < 4; ++q) { const int cc = w + 8 * q; const size_t ro_ = (size_t)(b * PT + 64 * cc + lane) * 16;
        const float li = IFb[ro_ + hh], lf = IFb[ro_ + 8 + hh];
        float bc = lf;
#pragma unroll
        for (int o = 1; o < 64; o <<= 1) { const float x = __shfl_up(bc, o); if (lane >= o) bc += x; }
        const float av = li - bc; float pm = av;
#pragma unroll
        for (int o = 1; o < 64; o <<= 1) { const float x = __shfl_up(pm, o); if (lane >= o) pm = fmaxf(pm, x); }
        Fl[MF_GB + cc * 64 + lane] = bc; Fl[MF_GP + cc * 64 + lane] = pm; Fl[MF_GA + cc * 64 + lane] = av;
        if (lane == 63) { Fl[MF_B63 + cc] = bc; Fl[MF_P63 + cc] = pm; } }
    __syncthreads();
    if (tid == 0) { float mm = 0.f;
        for (int cc = 0; cc < PT / 64; ++cc) { Fl[MF_MC + cc] = mm; const float b6 = Fl[MF_B63 + cc]; mm = fmaxf(b6 + mm, b6 + Fl[MF_P63 + cc]); }
        Fl[MF_MC + PT / 64] = mm; }
    __syncthreads();
    constexpr int NC = PT / 64;
    for (int c = 0; c < NC; ++c) {
        const int rowc = b * PT + 64 * c;
        const float m_c = Fl[MF_MC + c], m_n = Fl[MF_MC + c + 1], b63 = Fl[MF_B63 + c];
#pragma unroll
        for (int i = 0; i < 3; ++i) { const int q = tid + 512 * i; if (q < 67 * 16) *(LAS v4u*)(lds + ML_RQK + (q >> 4) * RPY + 16 * (q & 15)) = rq[i]; }
#pragma unroll
        for (int i = 0; i < 2; ++i) *(LAS v4u*)(lds + ML_RV + (ot + 32 * i) * RPY + 16 * og) = rv[i];
        if (c + 1 < NC) ML_LOAD_QKV(c + 1);
        ML_LOAD_O(c);
        __syncthreads();
        float kreg[8] = {0.f, 0.f, 0.f, 0.f, 0.f, 0.f, 0.f, 0.f};
        if (pvar != 3)
#pragma unroll
        for (int i = 0; i < 2; ++i) {
            const int g = w + 8 * i, t = lane;
            float x[4][8];
#pragma unroll
            for (int j = 0; j < 4; ++j) unpack8(*(const LAS v4u*)(lds + ML_RQK + (t + j) * RPY + 16 * g), x[j]);
            float val[8];
#pragma unroll
            for (int h2 = 0; h2 < 2; ++h2) { f32x4 a = *(const LAS f32x4*)(Fl + MF_CW + 4 * 128 + 8 * g + 4 * h2);
#pragma unroll
                for (int j = 0; j < 4; ++j) { const f32x4 cw = *(const LAS f32x4*)(Fl + MF_CW + j * 128 + 8 * g + 4 * h2);
                    a.x += cw.x * x[j][4 * h2]; a.y += cw.y * x[j][4 * h2 + 1]; a.z += cw.z * x[j][4 * h2 + 2]; a.w += cw.w * x[j][4 * h2 + 3]; }
                val[4 * h2] = siluf_(a.x); val[4 * h2 + 1] = siluf_(a.y); val[4 * h2 + 2] = siluf_(a.z); val[4 * h2 + 3] = siluf_(a.w); }
            if (i == 0) {
#pragma unroll
                for (int e = 0; e < 8; ++e) val[e] *= 0.125f;
                *(LAS v4u*)(lds + ML_Q + t * PBY + 16 * w) = pack8(val);
            } else { *(LAS v4u*)(lds + ML_K + t * PBY + 16 * w) = pack8(val);
#pragma unroll
                for (int e = 0; e < 8; ++e) kreg[e] = val[e]; }
            const v4u vw = *(const LAS v4u*)(lds + ML_RV + t * RPY + 16 * g);
            lds_u16* vt = (lds_u16*)(lds + ML_VT) + (8 * g) * 72 + t;
            vt[0 * 72] = (unsigned short)(vw.x & 0xffffu); vt[1 * 72] = (unsigned short)(vw.x >> 16); vt[2 * 72] = (unsigned short)(vw.y & 0xffffu); vt[3 * 72] = (unsigned short)(vw.y >> 16);
            vt[4 * 72] = (unsigned short)(vw.z & 0xffffu); vt[5 * 72] = (unsigned short)(vw.z >> 16); vt[6 * 72] = (unsigned short)(vw.w & 0xffffu); vt[7 * 72] = (unsigned short)(vw.w >> 16);
        }
        __syncthreads();
        if (pvar != 4) {
        { const float wsv = __expf(b63 + Fl[MF_GA + c * 64 + lane] - m_n); lds_u16* kt = (lds_u16*)(lds + ML_KT) + (8 * w) * 72 + lane;
#pragma unroll
          for (int e = 0; e < 8; ++e) kt[e * 72] = f2bf1(kreg[e] * wsv); }
        { const int tq = tid >> 3, p = tid & 7; float q8[8]; unpack8(*(const LAS v4u*)(lds + ML_Q + tq * PBY + 16 * p), q8);
          float dsum = 0.f;
#pragma unroll
          for (int e = 0; e < 8; ++e) dsum += q8[e] * Fl[MF_N + 8 * p + e];
          dsum = red8(dsum); if (p == 0) Fl[MF_QN + tq] = dsum; }
        { const int ti = w >> 1, t = 16 * ti + fr; float rsum = 0.f; const float mxt = fmaxf(m_c, Fl[MF_GP + c * 64 + t]);
          typedef unsigned u2v_ __attribute__((ext_vector_type(2)));
#pragma unroll
          for (int jj = 0; jj < 2; ++jj) { const int sj = 2 * (w & 1) + jj; f32x4 acc = {0.f, 0.f, 0.f, 0.f};
#pragma unroll
              for (int ks = 0; ks < 2; ++ks) { const bf16x8 a = *(const LAS bf16x8*)(lds + ML_Q + (16 * ti + fr) * PBY + ks * 64 + fq * 16), bb = *(const LAS bf16x8*)(lds + ML_K + (16 * sj + fr) * PBY + ks * 64 + fq * 16);
                  acc = MFMA16(bb, a, acc); }
              const f32x4 av4 = *(const LAS f32x4*)(Fl + MF_GA + c * 64 + 16 * sj + 4 * fq);
#pragma unroll
              for (int r = 0; r < 4; ++r) { const int s_ = 16 * sj + 4 * fq + r; const float val = s_ <= t ? acc[r] * __expf(av4[r] - mxt) : 0.f; acc[r] = val; rsum += val; }
              u2v_ pw; pw.x = pkbf(acc[0], acc[1]); pw.y = pkbf(acc[2], acc[3]);
              *(LAS u2v_*)(lds + ML_S + (t * 72 + 16 * sj + 4 * fq) * 2) = pw; }
          rsum += __shfl_xor(rsum, 16); rsum += __shfl_xor(rsum, 32);
          if (fq == 0) Fl[MF_RS + t * 2 + (w & 1)] = rsum; }
        }
        __syncthreads();
        float hv[4][4] = {};
        if (pvar != 5) { const int ti = w & 3, t = 16 * ti + fr;
          const float mx = fmaxf(m_c, Fl[MF_GP + c * 64 + t]), wi = __expf(m_c - mx), ei = __expf(-(Fl[MF_GB + c * 64 + t] + mx));
          const float rden = __builtin_amdgcn_rcpf(fmaxf(fabsf(wi * Fl[MF_QN + t] + Fl[MF_RS + 2 * t] + Fl[MF_RS + 2 * t + 1]), ei)); float hq = 0.f;
#pragma unroll
          for (int i = 0; i < 4; ++i) { const int vt = 4 * (w >> 2) + i; f32x4 accA = {0.f, 0.f, 0.f, 0.f}, accB = accA;
#pragma unroll
              for (int ks = 0; ks < 2; ++ks) {
                  const bf16x8 aq = *(const LAS bf16x8*)(lds + ML_Q + (16 * ti + fr) * PBY + ks * 64 + fq * 16), bc = *(const LAS bf16x8*)(lds + ML_C + (16 * vt + fr) * PBY + ks * 64 + fq * 16);
                  accA = MFMA16(bc, aq, accA);
                  const bf16x8 as = *(const LAS bf16x8*)(lds + ML_S + (16 * ti + fr) * PBY + ks * 64 + fq * 16), bv = *(const LAS bf16x8*)(lds + ML_VT + (16 * vt + fr) * PBY + ks * 64 + fq * 16);
                  accB = MFMA16(bv, as, accB); }
#pragma unroll
              for (int r = 0; r < 4; ++r) { const float hh_ = (wi * accA[r] + accB[r]) * rden; hv[i][r] = hh_; hq += hh_ * hh_; } }
          hq += __shfl_xor(hq, 16); hq += __shfl_xor(hq, 32);
          if (fq == 0) Fl[MF_HS + t * 2 + (w >> 2)] = hq; }
        __syncthreads();
        if (pvar != 6) {
        { const int ti = w & 3, t = 16 * ti + fr; const float sc = __builtin_amdgcn_rsqf((Fl[MF_HS + 2 * t] + Fl[MF_HS + 2 * t + 1]) * (1.f / 128.f) + NORM_EPS);
          typedef unsigned u2v_ __attribute__((ext_vector_type(2)));
#pragma unroll
          for (int i = 0; i < 4; ++i) { u2v_ pw; pw.x = pkbf(hv[i][0] * sc, hv[i][1] * sc); pw.y = pkbf(hv[i][2] * sc, hv[i][3] * sc);
              *(LAS u2v_*)(lds + ML_HB + t * RPY + (16 * (4 * (w >> 2) + i) + 4 * fq) * 2) = pw; } }
        { const float wst = __expf(b63 + m_c - m_n);
          typedef unsigned u2v_ __attribute__((ext_vector_type(2)));
#pragma unroll
          for (int kt = 0; kt < 4; ++kt) { Cacc[kt] = Cacc[kt] * wst;
#pragma unroll
              for (int ks = 0; ks < 2; ++ks) { const bf16x8 a = *(const LAS bf16x8*)(lds + ML_VT + (16 * w + fr) * PBY + ks * 64 + fq * 16), bb = *(const LAS bf16x8*)(lds + ML_KT + (16 * kt + fr) * PBY + ks * 64 + fq * 16);
                  Cacc[kt] = MFMA16(bb, a, Cacc[kt]); }
              u2v_ pw; pw.x = pkbf(Cacc[kt][0], Cacc[kt][1]); pw.y = pkbf(Cacc[kt][2], Cacc[kt][3]);
              *(LAS u2v_*)(lds + ML_C + ((16 * w + fr) * 72 + 16 * kt + 4 * fq) * 2) = pw; }
          if (w == 0) { float sum = 0.f;
#pragma unroll
              for (int q = 0; q < 8; ++q) { float k8[8]; unpack8(*(const LAS v4u*)(lds + ML_KT + lane * PBY + 16 * q), k8);
#pragma unroll
                  for (int e = 0; e < 8; ++e) sum += k8[e]; }
              Fl[MF_N + lane] = wst * Fl[MF_N + lane] + sum; } }
        }
        __syncthreads();
        if (pvar != 7)
#pragma unroll
        for (int i = 0; i < 2; ++i) { const int t = ot + 32 * i; float h8[8], o8[8]; unpack8(*(const LAS v4u*)(lds + ML_HB + t * RPY + 16 * og), h8); unpack8(ro[i], o8);
#pragma unroll
            for (int e = 0; e < 8; ++e) h8[e] = h8[e] * nw[e] * o8[e];
            *(v4u*)(HOb + (size_t)(rowc + t) * D + hh * 128 + 8 * og) = pack8(h8); }
    }
#undef ML_LOAD_QKV
#undef ML_LOAD_O
#pragma unroll
    for (int kt = 0; kt < 4; ++kt) *(f32x4*)(out + O_P_C + ((size_t)(b * 8 + hh) * 128 + 16 * w + fr) * 64 + 16 * kt + 4 * fq) = Cacc[kt];
    if (w == 0) { out[O_P_N + (size_t)(b * 8 + hh) * 64 + lane] = Fl[MF_N + lane]; if (lane == 0) out[O_P_M + b * 8 + hh] = Fl[MF_MC + PT / 64]; }
    if (tid < 384) { const int j = tid >> 7, c = tid & 127, gc = c < 64 ? hh * 64 + c : 512 + hh * 64 + (c - 64);
        out[O_P_CONV + (size_t)(b * 3 + j) * D + gc] = bf1(QKR[(size_t)(b * PT + PT - 3 + j) * D + gc]); }
    __syncthreads();
}
__device__ __forceinline__ void mlstm_sample_item(const Frame& F, int b, int hh, const bf16* QKR, const bf16* VVb, const bf16* OOb, const float* IFb, bf16* HOb,
                                                  const float* conv_w, const float* conv_b, const float* norm_w, const float* C0, const float* n0, const float* m0p, const float* conv0, float* out) {
    LAS float* L = (LAS float*)F.lds;
    constexpr int LQ = 0, LK = 256, LV = 512, LS = 1024, LQN = 1040, LHS = 1048;
    const int tid = F.tid, lane = F.lane, w = F.wave, row0 = MP + 4 * b;
    float li[4], lf[4];
#pragma unroll
    for (int t = 0; t < 4; ++t) { li[t] = IFb[(size_t)(row0 + t) * 16 + hh]; lf[t] = IFb[(size_t)(row0 + t) * 16 + 8 + hh]; }
    const float m0 = m0p[b * 8 + hh];
    float bc[4], av[4], mt[4], wi[4], wsv[4], ei[4], bm[4];
    { float run = 0.f, pm = -3.0e38f;
#pragma unroll
      for (int t = 0; t < 4; ++t) { run += lf[t]; bc[t] = run; av[t] = li[t] - run; pm = fmaxf(pm, av[t]); mt[t] = fmaxf(run + m0, run + pm); } }
    const float m_new = mt[3], wst = __expf(bc[3] + m0 - m_new);
#pragma unroll
    for (int t = 0; t < 4; ++t) { wi[t] = __expf(bc[t] + m0 - mt[t]); wsv[t] = __expf(bc[3] + av[t] - m_new); ei[t] = __expf(-mt[t]); bm[t] = bc[t] - mt[t]; }
    { const int t = tid >> 7, c = tid & 127, gc = c < 64 ? hh * 64 + c : 512 + hh * 64 + (c - 64);
      float x[4];
#pragma unroll
      for (int j = 0; j < 4; ++j) { const int p = t + j; x[j] = p < 3 ? conv0[(size_t)(b * 3 + p) * D + gc] : bf1(QKR[(size_t)(row0 + p - 3) * D + gc]); }
      float a = conv_b[gc];
#pragma unroll
      for (int j = 0; j < 4; ++j) a += conv_w[j * D + gc] * x[j];
      const float val = siluf_(a);
      if (c < 64) L[LQ + t * 64 + c] = val * 0.125f; else L[LK + t * 64 + (c - 64)] = val;
      if (t >= 1) out[O_S_CONV + (size_t)(b * 3 + t - 1) * D + gc] = x[3];
      L[LV + t * 128 + c] = bf1(VVb[(size_t)(row0 + t) * D + hh * 128 + c]); }
    __syncthreads();
    if (w == 0) { const int pair = lane >> 2, t = pair >> 2, s = pair & 3, part = lane & 3; float dsum = 0.f;
#pragma unroll
        for (int e = 0; e < 16; ++e) dsum += L[LQ + t * 64 + 16 * part + e] * L[LK + s * 64 + 16 * part + e];
        dsum = red4(dsum);
        const float bmt = t == 0 ? bm[0] : (t == 1 ? bm[1] : (t == 2 ? bm[2] : bm[3])), avs = s == 0 ? av[0] : (s == 1 ? av[1] : (s == 2 ? av[2] : av[3]));
        if (part == 0) L[LS + pair] = s <= t ? dsum * __expf(bmt + avs) : 0.f; }
    if (w == 1) { const int t = lane >> 4, part = lane & 15; float dsum = 0.f;
#pragma unroll
        for (int e = 0; e < 4; ++e) dsum += L[LQ + t * 64 + 4 * part + e] * n0[(size_t)(b * 8 + hh) * 64 + 4 * part + e];
        dsum = red16(dsum); if (part == 0) L[LQN + t] = dsum; }
    __syncthreads();
    const int v = tid >> 2, kq = tid & 3;
    float hvv[4];
    { const size_t coff = ((size_t)(b * 8 + hh) * 128 + v) * 64 + 16 * kq;
      float c0[16];
#pragma unroll
      for (int e4 = 0; e4 < 4; ++e4) { const f32x4 x = *(const f32x4*)(C0 + coff + 4 * e4); c0[4 * e4] = x.x; c0[4 * e4 + 1] = x.y; c0[4 * e4 + 2] = x.z; c0[4 * e4 + 3] = x.w; }
#pragma unroll
      for (int t = 0; t < 4; ++t) { float part = 0.f;
#pragma unroll
          for (int e = 0; e < 16; ++e) part += c0[e] * L[LQ + t * 64 + 16 * kq + e];
          const float inter = red4(part);
          float num = wi[t] * inter, den = wi[t] * L[LQN + t];
#pragma unroll
          for (int s = 0; s < 4; ++s) { const float sm = L[LS + t * 4 + s]; num += sm * L[LV + s * 128 + v]; den += sm; }
          hvv[t] = num / fmaxf(fabsf(den), ei[t]); }
#pragma unroll
      for (int t = 0; t < 4; ++t) { const float x = wave_sum(kq == 0 ? hvv[t] * hvv[t] : 0.f); if (lane == 0) L[LHS + w * 4 + t] = x; }
      float cn[16];
#pragma unroll
      for (int e = 0; e < 16; ++e) { float a = wst * c0[e];
#pragma unroll
          for (int s = 0; s < 4; ++s) a += wsv[s] * L[LV + s * 128 + v] * L[LK + s * 64 + 16 * kq + e];
          cn[e] = a; }
#pragma unroll
      for (int e4 = 0; e4 < 4; ++e4) *(f32x4*)(out + O_S_C + coff + 4 * e4) = (f32x4){cn[4 * e4], cn[4 * e4 + 1], cn[4 * e4 + 2], cn[4 * e4 + 3]}; }
    __syncthreads();
    if (kq == 0) {
#pragma unroll
        for (int t = 0; t < 4; ++t) { float tot = 0.f;
#pragma unroll
            for (int ww = 0; ww < 8; ++ww) tot += L[LHS + ww * 4 + t];
            const float sc = 1.0f / sqrtf(tot * (1.f / 128.f) + NORM_EPS); const size_t off = (size_t)(row0 + t) * D + hh * 128 + v;
            HOb[off] = f2bf1(hvv[t] * sc * norm_w[hh * 128 + v] * bf1(OOb[off])); } }
    if (tid < 64) { float a = wst * n0[(size_t)(b * 8 + hh) * 64 + tid];
#pragma unroll
        for (int s = 0; s < 4; ++s) a += wsv[s] * L[LK + s * 64 + tid];
        out[O_S_N + (size_t)(b * 8 + hh) * 64 + tid] = a; }
    if (tid == 0) out[O_S_M + b * 8 + hh] = m_new;
    __syncthreads();
}

constexpr int CA_AH = 0, CA_BH = 9216, CA_KH = 18432, CA_RH = 27648, CA_BT = 36864, CA_KT = 46080, CA_VT = 55296, CA_AB = 64512, CA_AK = 73728, CA_RB = 82944, CA_RK = 92160, CA_XT = 101376,
              CA_TD = 119808, CA_NF = 123904, CA_GL = 128000, CA_LG = CA_AB  , CA_AT = CA_KH  ;
__device__ __forceinline__ bf16x8 ldsfrag(LAS unsigned char* lds, int base, int row, int ks, int fq) { return *(const LAS bf16x8*)(lds + base + row * PBY + ks * 64 + fq * 16); }
__device__ __forceinline__ void rwkv_chunk_item(const Frame& F, int chain, int chunk, bf16* Rb, bf16* Kb, bf16* Vb, bf16* Db, bf16* Ab, bf16* Gb,
                                                const float* k_k, const float* k_a, const float* r_k, float* BON, bf16* dummy, v4u (&pf)[6], const int nchain, const int nchunk) {
    LAS unsigned char* lds = F.lds;
    const int tid = F.tid, lane = F.lane, w = F.wave, fr = lane & 15, fq = lane >> 4, cg = tid & 7, tt = tid >> 3;
    const int h = chain & 15, row0 = (chain >> 4) * PT + 64 * chunk, ch = h * 64 + 8 * cg;
    const size_t goff = (size_t)(row0 + tt) * D + ch;
    LAS float* LG = (LAS float*)(lds + CA_LG); LAS float* GLf = (LAS float*)(lds + CA_GL);
    float r8[8], kp[8], av[8], bv[8], rd[8];
    {
        float k8[8], v8[8], d8[8], a8[8];
        unpack8(pf[0], r8); unpack8(pf[1], k8); unpack8(pf[2], v8); unpack8(pf[3], d8); unpack8(pf[4], a8);
        float ss = 0.f;
#pragma unroll
        for (int j = 0; j < 8; ++j) { av[j] = k8[j] * k_k[ch + j]; ss += av[j] * av[j]; }
        ss = red8(ss); const float inv = __builtin_amdgcn_rsqf(fmaxf(ss, 1e-24f));
        float bsum = 0.f;
#pragma unroll
        for (int j = 0; j < 8; ++j) { const float kk = av[j] * inv; kp[j] = k8[j] * (1.f + (a8[j] - 1.f) * k_a[ch + j]); bv[j] = kk * a8[j]; av[j] = -kk; bsum += r8[j] * kp[j] * r_k[ch + j]; rd[j] = __builtin_amdgcn_rcpf(1.f - d8[j]); }
        const float bon = red8(bsum);
#pragma unroll
        for (int j = 0; j < 8; ++j) { LG[(8 * cg + j) * 64 + tt] = __logf(1.f - d8[j]); ((lds_u16*)(lds + CA_VT))[(8 * cg + j) * 72 + tt] = f2bf1(v8[j]); }
        if (cg == 0 && !dummy) BON[(size_t)(row0 + tt) * 16 + h] = bon;
    }
    for (int i = tid; i < 128 * 9; i += 512) ((LAS v4u*)(lds + CA_XT))[i] = (v4u){0u, 0u, 0u, 0u};
    __syncthreads();
    { float x[8];
#pragma unroll
      for (int q = 0; q < 8; ++q) x[q] = LG[(8 * w + q) * 64 + lane];
#pragma unroll
      for (int q = 0; q < 8; ++q) {
          float v = x[q];
          v += __builtin_bit_cast(float, __builtin_amdgcn_update_dpp(0, __builtin_bit_cast(int, v), 0x111, 0xF, 0xF, true));
          v += __builtin_bit_cast(float, __builtin_amdgcn_update_dpp(0, __builtin_bit_cast(int, v), 0x112, 0xF, 0xF, true));
          v += __builtin_bit_cast(float, __builtin_amdgcn_update_dpp(0, __builtin_bit_cast(int, v), 0x114, 0xF, 0xF, true));
          v += __builtin_bit_cast(float, __builtin_amdgcn_update_dpp(0, __builtin_bit_cast(int, v), 0x118, 0xF, 0xF, true));
          v += __builtin_bit_cast(float, __builtin_amdgcn_update_dpp(0, __builtin_bit_cast(int, v), 0x142, 0xA, 0xF, false));
          v += __builtin_bit_cast(float, __builtin_amdgcn_update_dpp(0, __builtin_bit_cast(int, v), 0x143, 0xC, 0xF, false));
          x[q] = v; }
#pragma unroll
      for (int q = 0; q < 8; ++q) LG[(8 * w + q) * 64 + lane] = x[q]; }
    __syncthreads();
    {
        float ah[8], bh[8], kh[8], rh[8];
#pragma unroll
        for (int j = 0; j < 8; ++j) { const float lg = LG[(8 * cg + j) * 64 + tt]; const float G = __expf(lg), Gm1 = G * rd[j], Gi = __builtin_amdgcn_rcpf(G);
            ah[j] = av[j] * Gm1; bh[j] = bv[j] * Gi; kh[j] = kp[j] * Gi; rh[j] = r8[j] * G;
            ((lds_u16*)(lds + CA_BT))[(8 * cg + j) * 72 + tt] = f2bf1(bh[j]); ((lds_u16*)(lds + CA_KT))[(8 * cg + j) * 72 + tt] = f2bf1(kh[j]);
            if (tt == 63) GLf[8 * cg + j] = G; }
        *(LAS v4u*)(lds + CA_AH + tt * PBY + 16 * cg) = pack8(ah); *(LAS v4u*)(lds + CA_BH + tt * PBY + 16 * cg) = pack8(bh);
        *(LAS v4u*)(lds + CA_KH + tt * PBY + 16 * cg) = pack8(kh); *(LAS v4u*)(lds + CA_RH + tt * PBY + 16 * cg) = pack8(rh);
    }
    __syncthreads();
    {
        const int mi = w >> 1, ti0 = 2 * (w & 1); const int abase = mi < 2 ? CA_AH : CA_RH, bbase = (mi & 1) ? CA_KH : CA_BH, dbase = CA_AB + mi * 9216;
        bf16x8 af[2][2], bfr[4][2];
#pragma unroll
        for (int a = 0; a < 2; ++a)
#pragma unroll
            for (int ks = 0; ks < 2; ++ks) af[a][ks] = ldsfrag(lds, abase, 16 * (ti0 + a) + fr, ks, fq);
#pragma unroll
        for (int sj = 0; sj < 4; ++sj)
#pragma unroll
            for (int ks = 0; ks < 2; ++ks) bfr[sj][ks] = ldsfrag(lds, bbase, 16 * sj + fr, ks, fq);
#pragma unroll
        for (int a = 0; a < 2; ++a)
#pragma unroll
            for (int sj = 0; sj < 4; ++sj) { const int ti = ti0 + a; f32x4 acc = {0.f, 0.f, 0.f, 0.f};
#pragma unroll
                for (int ks = 0; ks < 2; ++ks) acc = MFMA16(bfr[sj][ks], af[a][ks], acc);
                const int t = 16 * ti + fr;
#pragma unroll
                for (int r = 0; r < 4; ++r) { const int s = 16 * sj + 4 * fq + r; acc[r] = (mi < 2 ? s < t : s <= t) ? acc[r] : 0.f; }
                typedef unsigned u2v_ __attribute__((ext_vector_type(2))); u2v_ pw; pw.x = pkbf(acc[0], acc[1]); pw.y = pkbf(acc[2], acc[3]);
                *(LAS u2v_*)(lds + dbase + (t * 72 + 16 * sj + 4 * fq) * 2) = pw;
                if (mi == 0 && ti == sj) *(LAS f32x4*)(lds + CA_NF + (ti * 256 + fr * 16 + 4 * fq) * 4) = acc; }
    }
    __syncthreads();
    f32x4 rhs[4];
    if (w == 0) { const int blk = fq, c = fr; const LAS float* N = (const LAS float*)(lds + CA_NF) + blk * 256; float T[16];
#pragma unroll
        for (int i = 0; i < 16; ++i) { float s = (i == c) ? 1.f : 0.f;
#pragma unroll
            for (int j = 0; j < i; ++j) s += N[i * 16 + j] * T[j];
            T[i] = s; }
        lds_u16* td = (lds_u16*)(lds + CA_TD) + blk * 512;
#pragma unroll
        for (int i = 0; i < 16; ++i) { td[i * 32 + c] = f2bf1(T[i]); td[i * 32 + 16 + c] = 0; } }
    if (w < 4) {
#pragma unroll
        for (int i = 0; i < 4; ++i)
#pragma unroll
            for (int r = 0; r < 4; ++r) rhs[i][r] = bf1(((lds_u16*)(lds + CA_AH))[(16 * i + 4 * fq + r) * 72 + 16 * w + fr]);
    } else {
#pragma unroll
        for (int i = 0; i < 4; ++i) { f32x4 acc = {0.f, 0.f, 0.f, 0.f};
#pragma unroll
            for (int ks = 0; ks < 2; ++ks) acc = MFMA16(ldsfrag(lds, CA_AK, 16 * i + fr, ks, fq), ldsfrag(lds, CA_VT, 16 * (w - 4) + fr, ks, fq), acc);
            rhs[i] = acc; }
    }
    __syncthreads();
    {
        LAS unsigned char* AT = lds + CA_AT + w * 1024;
        *(LAS unsigned long long*)(AT + fr * 64 + 32 + fq * 8) = 0ull;
#pragma unroll
        for (int i = 0; i < 4; ++i) { f32x4 acc = rhs[i];
#pragma unroll
            for (int ks = 0; ks < 2; ++ks) acc = MFMA16(ldsfrag(lds, CA_AB, 16 * i + fr, ks, fq), ldsfrag(lds, CA_XT, 16 * w + fr, ks, fq), acc);
            typedef unsigned u2v __attribute__((ext_vector_type(2)));
            u2v pa; pa.x = pkbf(acc[0], acc[1]); pa.y = pkbf(acc[2], acc[3]);
            *(LAS u2v*)(AT + fr * 64 + fq * 8) = pa;
            asm volatile("s_waitcnt lgkmcnt(0)" ::: "memory");
            f32x4 xi = {0.f, 0.f, 0.f, 0.f};
            xi = MFMA16(*(const LAS bf16x8*)(lds + CA_TD + i * 1024 + fr * 64 + fq * 16), *(const LAS bf16x8*)(AT + fr * 64 + fq * 16), xi);
            u2v px; px.x = pkbf(xi[0], xi[1]); px.y = pkbf(xi[2], xi[3]);
            *(LAS u2v*)(lds + CA_XT + (16 * w + fr) * PBY + (16 * i + 4 * fq) * 2) = px;
            asm volatile("s_waitcnt lgkmcnt(0)" ::: "memory"); }
    }
    __syncthreads();
    if (nchain >= 0) { const size_t no = (size_t)((nchain >> 4) * PT + 64 * nchunk + tt) * D + (nchain & 15) * 64 + 8 * cg;
        pf[0] = *(const v4u*)(Rb + no); pf[1] = *(const v4u*)(Kb + no); pf[2] = *(const v4u*)(Vb + no); pf[3] = *(const v4u*)(Db + no); pf[4] = *(const v4u*)(Ab + no); }
    {
        const int mi = w >> 1, ti0 = 2 * (w & 1); const int obase = mi == 0 ? CA_AB : (mi == 1 ? CA_AK : (mi == 2 ? CA_AH : CA_KH));
        const int a1 = mi < 2 ? CA_RB : (mi == 2 ? CA_BT : CA_XT), a1o = mi == 3 ? 64 : 0, b1 = mi == 3 ? CA_BT : CA_XT, b1o = mi == 1 ? 64 : 0;
        const int a2 = mi == 1 ? CA_RK : CA_VT, b2 = mi == 1 ? CA_VT : CA_KT; const bool two = (mi & 1) != 0;
        bf16x8 af[2][2], bfr[4][2];
#pragma unroll
        for (int a = 0; a < 2; ++a)
#pragma unroll
            for (int ks = 0; ks < 2; ++ks) af[a][ks] = ldsfrag(lds, a1, a1o + 16 * (ti0 + a) + fr, ks, fq);
#pragma unroll
        for (int tj = 0; tj < 4; ++tj)
#pragma unroll
            for (int ks = 0; ks < 2; ++ks) bfr[tj][ks] = ldsfrag(lds, b1, b1o + 16 * tj + fr, ks, fq);
        f32x4 acc[2][4];
#pragma unroll
        for (int a = 0; a < 2; ++a)
#pragma unroll
            for (int tj = 0; tj < 4; ++tj) { acc[a][tj] = (f32x4){0.f, 0.f, 0.f, 0.f};
#pragma unroll
                for (int ks = 0; ks < 2; ++ks) acc[a][tj] = MFMA16(bfr[tj][ks], af[a][ks], acc[a][tj]); }
        if (two) {
#pragma unroll
            for (int a = 0; a < 2; ++a)
#pragma unroll
                for (int ks = 0; ks < 2; ++ks) af[a][ks] = ldsfrag(lds, a2, 16 * (ti0 + a) + fr, ks, fq);
#pragma unroll
            for (int tj = 0; tj < 4; ++tj)
#pragma unroll
                for (int ks = 0; ks < 2; ++ks) bfr[tj][ks] = ldsfrag(lds, b2, 16 * tj + fr, ks, fq);
#pragma unroll
            for (int a = 0; a < 2; ++a)
#pragma unroll
                for (int tj = 0; tj < 4; ++tj)
#pragma unroll
                    for (int ks = 0; ks < 2; ++ks) acc[a][tj] = MFMA16(bfr[tj][ks], af[a][ks], acc[a][tj]);
        }
#pragma unroll
        for (int a = 0; a < 2; ++a) { const int row = 16 * (ti0 + a) + fr; const float glr = GLf[row];
#pragma unroll
            for (int tj = 0; tj < 4; ++tj) { const int col = 16 * tj + 4 * fq; f32x4 val = acc[a][tj];
                typedef unsigned u2v_ __attribute__((ext_vector_type(2)));
                if (mi == 0) { const u2v_ rr = *(const LAS u2v_*)(lds + CA_RH + (row * 72 + col) * 2); val += (f32x4){bflo(rr.x), bfhi(rr.x), bflo(rr.y), bfhi(rr.y)}; }
                else if (mi == 2) {
#pragma unroll
                    for (int r = 0; r < 4; ++r) val[r] = glr * (val[r] + (row == col + r ? 1.f : 0.f)); }
                else if (mi == 3) val = val * *(const LAS f32x4*)(GLf + col);
                u2v_ pw; pw.x = pkbf(val[0], val[1]); pw.y = pkbf(val[2], val[3]);
                *(LAS u2v_*)(lds + obase + (row * 72 + col) * 2) = pw; } }
    }
    __syncthreads();
    *(v4u*)((dummy ? dummy : Rb) + goff) = *(const LAS v4u*)(lds + CA_AB + tt * PBY + 16 * cg);
    *(v4u*)((dummy ? dummy : Ab) + goff) = *(const LAS v4u*)(lds + CA_AK + tt * PBY + 16 * cg);
    *(v4u*)((dummy ? dummy : Kb) + goff) = *(const LAS v4u*)(lds + CA_AH + tt * PBY + 16 * cg);
    *(v4u*)((dummy ? dummy : Db) + goff) = *(const LAS v4u*)(lds + CA_KH + tt * PBY + 16 * cg);
    __syncthreads();
}
constexpr int CB_S = 0, CB_P2 = 9216, CB_P3 = 18432, CB_Y0 = 27648, CB_Z0 = 36864, CB_YS = 46080  ;
__device__ __forceinline__ void rwkv_state_chain(const Frame& F, int chain, float* ST, const bf16* Rb, const bf16* Kb, const bf16* Vb, const bf16* Db, const bf16* Ab, bf16* Gb, const float* BON, const float* gn_w, const float* gn_b, bf16* dummy) {
    LAS unsigned char* lds = F.lds;
    const int tid = F.tid, lane = F.lane, w = F.wave, fr = lane & 15, fq = lane >> 4, cg = tid & 7, tt = tid >> 3;
    const int h = chain & 15, rowc0 = (chain >> 4) * PT, ch = h * 64 + 8 * cg;
    for (int i = tid; i < 64 * 36; i += 512) ((LAS unsigned*)(lds + CB_S))[i] = 0u;
    f32x4 Sacc[2];
    Sacc[0] = (f32x4){0.f, 0.f, 0.f, 0.f}; Sacc[1] = Sacc[0];
    v4u q2, q3, qy, qz, qg, qb; float qbon;
    float cgw[8], cgb[8];
#pragma unroll
    for (int j = 0; j < 8; ++j) { cgw[j] = gn_w[ch + j]; cgb[j] = gn_b[ch + j]; }
#define CB_LOAD(cc) do { const size_t o_ = (size_t)(rowc0 + 64 * (cc) + tt) * D + ch; q2 = *(const v4u*)(Rb + o_); q3 = *(const v4u*)(Kb + o_); qy = *(const v4u*)(Ab + o_); qz = *(const v4u*)(Db + o_); \
        qg = *(const v4u*)(Gb + o_); qb = *(const v4u*)(Vb + o_); qbon = BON[(size_t)(rowc0 + 64 * (cc) + tt) * 16 + h]; } while (0)
    CB_LOAD(0);
    for (int c = 0; c < PT / 64; ++c) {
        *(LAS v4u*)(lds + CB_P2 + tt * PBY + 16 * cg) = q2; *(LAS v4u*)(lds + CB_P3 + tt * PBY + 16 * cg) = q3;
        *(LAS v4u*)(lds + CB_Y0 + tt * PBY + 16 * cg) = qy; *(LAS v4u*)(lds + CB_Z0 + tt * PBY + 16 * cg) = qz;
        float gw[8], gb[8]; unpack8(qg, gw); unpack8(qb, gb);
        const float bonc = qbon;
        if (c + 1 < PT / 64) CB_LOAD(c + 1);
        __syncthreads();
        f32x4 yacc[2];
        typedef unsigned u2v_ __attribute__((ext_vector_type(2)));
#pragma unroll
        for (int q = 0; q < 2; ++q) { const int tq = 2 * w + q, ti = tq >> 2, tj = tq & 3, row = 16 * ti + fr, col = 16 * tj + 4 * fq;
            const u2v_ y0 = *(const LAS u2v_*)(lds + CB_Y0 + (row * 72 + col) * 2), z0 = *(const LAS u2v_*)(lds + CB_Z0 + (row * 72 + col) * 2);
            f32x4 ya = {bflo(y0.x), bfhi(y0.x), bflo(y0.y), bfhi(y0.y)}, sa = {bflo(z0.x), bfhi(z0.x), bflo(z0.y), bfhi(z0.y)};
#pragma unroll
            for (int ks = 0; ks < 2; ++ks) { ya = MFMA16(ldsfrag(lds, CB_S, 16 * tj + fr, ks, fq), ldsfrag(lds, CB_P2, 16 * ti + fr, ks, fq), ya);
                                             sa = MFMA16(ldsfrag(lds, CB_P3, 16 * tj + fr, ks, fq), ldsfrag(lds, CB_S, 16 * ti + fr, ks, fq), sa); }
            yacc[q] = ya; Sacc[q] = sa; }
        __syncthreads();
#pragma unroll
        for (int q = 0; q < 2; ++q) { const int tq = 2 * w + q, ti = tq >> 2, tj = tq & 3, row = 16 * ti + fr, col = 16 * tj + 4 * fq;
            u2v_ pw; pw.x = pkbf(Sacc[q][0], Sacc[q][1]); pw.y = pkbf(Sacc[q][2], Sacc[q][3]);
            *(LAS u2v_*)(lds + CB_S + (row * 72 + col) * 2) = pw;
            *(LAS f32x4*)(lds + CB_YS + (row * 64 + col) * 4) = yacc[q]; }
        __syncthreads();
        { const f32x4 y0 = *(const LAS f32x4*)(lds + CB_YS + (tt * 64 + 8 * cg) * 4), y1 = *(const LAS f32x4*)(lds + CB_YS + (tt * 64 + 8 * cg + 4) * 4);
          float yy[8] = {y0.x, y0.y, y0.z, y0.w, y1.x, y1.y, y1.z, y1.w}; float s1 = 0.f;
#pragma unroll
          for (int j = 0; j < 8; ++j) s1 += yy[j];
          const float mean = red8(s1) * (1.f / 64.f); float s2 = 0.f;
#pragma unroll
          for (int j = 0; j < 8; ++j) { yy[j] -= mean; s2 += yy[j] * yy[j]; }
          const float rstd = __builtin_amdgcn_rsqf(red8(s2) * (1.f / 64.f) + GN_EPS);
          float o[8];
#pragma unroll
          for (int j = 0; j < 8; ++j) o[j] = ((yy[j] * rstd) * cgw[j] + cgb[j] + bonc * gb[j]) * gw[j];
          *(v4u*)((dummy ? dummy : Gb) + (size_t)(rowc0 + 64 * c + tt) * D + ch) = pack8(o); }
    }
#undef CB_LOAD
#pragma unroll
    for (int q = 0; q < 2; ++q) { const int tq = 2 * w + q, ti = tq >> 2, tj = tq & 3; *(f32x4*)(ST + (16 * ti + fr) * 64 + 16 * tj + 4 * fq) = Sacc[q]; }
    __syncthreads();
}

#ifndef MK_N_LAUNCHES
#define MK_N_LAUNCHES 1
#endif
constexpr int N_PHASES = 22;
#ifndef PROBE_PH
#define PROBE_PH (-1)
#define PROBE_N 1
#endif
#ifndef PROBE_VAR
#define PROBE_VAR 0
#endif
#ifndef EN_MASK
#define EN_MASK 0xff
#endif
constexpr bool EN_NORM = EN_MASK & 1, EN_UP = EN_MASK & 2, EN_RES = EN_MASK & 4, EN_RW = EN_MASK & 8, EN_L2 = EN_MASK & 16, EN_SCAN = EN_MASK & 32, EN_IN = EN_MASK & 64, EN_ML = EN_MASK & 128;
struct Args { const float* in[N_IN]; float* out; unsigned char* ws; int ph_lo, ph_hi; };
__global__ void __launch_bounds__(NWAVES * 64, 2) mega_fwd(Args args) {
    extern __shared__ __attribute__((aligned(16))) unsigned char lds_raw[];
    { const int t0 = threadIdx.x;
      for (int u = t0; u < (LDS_BYTES - LDSCTL_OFF) / 4; u += NWAVES * 64) ((LAS unsigned*)((LAS unsigned char*)lds_raw + LDSCTL_OFF))[u] = 0u; }
    __syncthreads();
    { const int t0 = threadIdx.x; if (t0 < N_IN) ((LAS unsigned long long*)((LAS unsigned char*)lds_raw + TAB_OFF))[t0] = (unsigned long long)args.in[t0]; }
    __syncthreads();
    XcdBarrier bar; bar.bar = (unsigned*)((gu32*)(args.ws + WS_CTL) + CW_BAR); bar.x = 0; bar.st = nullptr;
    if (args.ph_hi - args.ph_lo > 1) bar = xcd_barrier_post((unsigned*)((gu32*)(args.ws + WS_CTL) + CW_BAR), (volatile LAS unsigned*)((LAS unsigned char*)lds_raw + MISC_OFF) + 8);
    int ph = args.ph_lo, rep = 0;
    while (ph < args.ph_hi) {
        int tid_ = threadIdx.x; asm volatile("" : "+v"(tid_));
        unsigned char* ws = args.ws; float* out = args.out;
        Frame F;
        F.lds = (LAS unsigned char*)lds_raw;
        F.MISC = (volatile LAS unsigned*)(F.lds + MISC_OFF);
        F.tid = tid_; F.lane = F.tid & 63; F.wave = __builtin_amdgcn_readfirstlane(F.tid >> 6);
        F.G = gridDim.x; { const int bx = blockIdx.x; F.vcu = (F.G % 8 == 0) ? (bx % 8) * (F.G / 8) + bx / 8 : bx; }
        F.ctl = (gu32*)(ws + WS_CTL); F.tab = (volatile LAS unsigned long long*)(F.lds + TAB_OFF);
        bf16* Wb = (bf16*)(ws + WS_W); float* XR = (float*)(ws + WS_XR); unsigned char* big = ws + WS_BIG;
        bf16* Hb = (bf16*)(big + B_H); bf16* XN = (bf16*)(big + B_XN); float* SLAB = (float*)(big + B_SLAB);
        bf16* ACAT = (bf16*)(big + B_ACAT); bf16* Rb = (bf16*)(big + B_R); bf16* Kb = (bf16*)(big + B_K); bf16* Vb = (bf16*)(big + B_V); bf16* DECb = (bf16*)(big + B_DEC); bf16* AAb = (bf16*)(big + B_AA);
        bf16* QKR = (bf16*)(big + B_QKR); bf16* VVb = (bf16*)(big + B_VV); bf16* HOb = (bf16*)(big + B_HO); bf16* OOb = (bf16*)(big + B_OO); float* IFb = (float*)(big + B_IF);
        bf16* GGb = (bf16*)((unsigned char*)out + OS_GG); bf16* LORA = (bf16*)((unsigned char*)out + OS_LORA);
        const int c_id = (int)blockIdx.x;
        const int nrep = (ph == PROBE_PH && ph != 6) ? PROBE_N : 1;
        const int pvar = (rep + 1 < nrep) ? PROBE_VAR : 0;
        if (EN_NORM && (ph == 0 || ph == 3 || ph == 8 || ph == 11 || ph == 14 || ph == 18 || ph == 21)) {
            int kind = 0, layer = 0, ab = 0, nslab = 0; float coef = 0.5f; const float* gain = nullptr;
            if (ph == 0) { kind = 0; layer = 0; ab = 0; gain = inptr(F, I_NFA); nslab = 0; }
            else if (ph == 3) { kind = 1; gain = inptr(F, I_NMIX); nslab = 11; }
            else if (ph == 8) { kind = 0; layer = 0; ab = 1; gain = inptr(F, I_NFB); nslab = 4; coef = 1.f; }
            else if (ph == 11) { kind = 0; layer = 1; ab = 0; gain = inptr(F, I_NFA) + D; nslab = 11; }
            else if (ph == 14) { kind = 2; gain = inptr(F, I_NMIX) + D; nslab = 11; }
            else if (ph == 18) { kind = -1; gain = inptr(F, I_NFB) + D; nslab = 4; coef = 1.f; }
            else { kind = -1; gain = inptr(F, I_NFIN); nslab = 11; }
            if (kind >= 0) convert_weights(F, kind, layer, ab, Wb);
            const float* base_p = ph == 0 ? inptr(F, I_XP) : XR; const float* base_s = (ph == 0 || ph == 3) ? inptr(F, I_XS) : XR + (size_t)MP * D;
            if (ph == 3) norm_rows<1>(F, base_p, base_s, nslab, coef, SLAB, XR, gain, ACAT, inptr(F, I_RSHIFT), out, pvar);
            else if (ph == 21) norm_rows<2>(F, base_p, base_s, nslab, coef, SLAB, XR, gain, nullptr, nullptr, out, pvar);
            else norm_rows<0>(F, base_p, base_s, nslab, coef, SLAB, XR, gain, XN, nullptr, out, pvar);
        } else if (EN_UP && (ph == 1 || ph == 9 || ph == 12 || ph == 19)) {
            const bf16* Wu = ph == 19 ? (const bf16*)(ws + WS_W2) : Wb;
            pg8::Gemm g{XN, Wu + W_GU / 2, M, 2 * FF, D}; pg8::UnitOrder S; S.init(M / 256, 2 * FF / 256, D, F.G, c_id, 0);
            EpiSwiglu E{Hb, pvar};
            pg8::gemm_phase<EpiSwiglu, pg8::UnitOrder, true, true>(F.lds, g, S, E, F.tid);
        } else if (EN_RES && (ph == 2 || ph == 7 || ph == 10 || ph == 13 || ph == 17 || ph == 20)) {
            const bf16* A = Hb; const bf16* Bt = (ph == 20 ? (const bf16*)(ws + WS_W2) : Wb) + W_D / 2; int K = FF; float coef = 0.5f; const float* base = XR;
            if (ph == 2) base = inptr(F, I_XP);
            if (ph == 7) { A = GGb; Bt = Wb + W_O / 2; K = D; coef = 1.f; }
            if (ph == 17) { A = HOb; Bt = Wb + W_OUT / 2; K = D; coef = 1.f; }
            pg8::Gemm g{A, Bt, M, D, K}; pg8::UnitOrder S; S.init(MP / 256, D / 256, K, F.G, c_id, K / 256);
            EpiRes E{base, XR, SLAB, coef};
            pg8::gemm_phase<EpiRes, pg8::UnitOrder, true, true>(F.lds, g, S, E, F.tid);
        } else if (EN_RW && ph == 4) {
            pg8::Gemm g{ACAT, Wb + W_RW / 2, M, NRW, KRW}; pg8::UnitOrder S; S.init(M / 256, NRW / 256, KRW, F.G, c_id, 0);
            EpiRw E{Rb, Kb, Vb, LORA};
            pg8::gemm_phase<EpiRw, pg8::UnitOrder, true, true>(F.lds, g, S, E, F.tid);
        } else if (EN_L2 && ph == 5) {
            pg8::Gemm g{LORA, Wb + W_L2 / 2, M, NL2, KL2}; pg8::UnitOrder S; S.init(M / 256, NL2 / 256, KL2, F.G, c_id, -1);
            EpiL2 E{DECb, AAb, GGb, inptr(F, I_W0), inptr(F, I_A0)};
            pg8::gemm_phase<EpiL2, pg8::UnitOrder, true, true>(F.lds, g, S, E, F.tid);
        } else if (EN_SCAN && ph == 6) {
            bf16* dummy = (bf16*)(ws + WS_YRAW);
            for (int dr = (PROBE_PH == 6 && PROBE_VAR == 5) ? PROBE_N - 1 : 0; dr >= 0; --dr) {
                v4u pf[6]; pf[5] = (v4u){0u, 0u, 0u, 0u};
                { const int it = F.vcu, cg_ = F.tid & 7, tt_ = F.tid >> 3; const size_t o = (size_t)(((it >> 5) >> 4) * PT + 64 * (it & 31) + tt_) * D + ((it >> 5) & 15) * 64 + 8 * cg_;
                  pf[0] = *(const v4u*)(Rb + o); pf[1] = *(const v4u*)(Kb + o); pf[2] = *(const v4u*)(Vb + o); pf[3] = *(const v4u*)(DECb + o); pf[4] = *(const v4u*)(AAb + o); }
                for (int it = F.vcu; it < PB * 16 * (PT / 64); it += F.G) { const int nx = it + F.G < PB * 16 * (PT / 64) ? it + F.G : -1;
                    rwkv_chunk_item(F, it >> 5, it & 31, Rb, Kb, Vb, DECb, AAb, GGb, inptr(F, I_KK), inptr(F, I_KA), inptr(F, I_RK), (float*)(ws + WS_BON), dr ? dummy : nullptr, pf, nx < 0 ? -1 : nx >> 5, nx & 31); }
            }
            xcd_barrier(bar);
            for (int dr = (PROBE_PH == 6 && PROBE_VAR == 6) ? PROBE_N - 1 : 0; dr >= 0; --dr)
                if (F.vcu < 128) rwkv_state_chain(F, F.vcu, out + O_P_S + (size_t)F.vcu * 4096, Rb, Kb, Vb, DECb, AAb, GGb, (const float*)(ws + WS_BON), inptr(F, I_GNW), inptr(F, I_GNB), dr ? dummy : nullptr);
            { const int i0 = F.vcu < 128 ? 2 * F.vcu : 256 + 14 * (F.vcu - 128), i1 = F.vcu < 128 ? i0 + 2 : i0 + 14;
              for (int i = i0; i < i1; ++i) { const int b = i >> 4, h = i & 15;
                  rwkv_chain(F, MP + b * STK, STK, h, inptr(F, I_RS) + (size_t)i * 4096, out + O_S_S + (size_t)i * 4096, Rb, Kb, Vb, DECb, AAb, GGb, inptr(F, I_KK), inptr(F, I_KA), inptr(F, I_RK), inptr(F, I_GNW), inptr(F, I_GNB), true, 0); } }
        } else if (EN_IN && ph == 15) {
            pg8::Gemm g{XN, Wb + W_IN / 2, M, NIN, D}; pg8::UnitOrder S; S.init(M / 256, NIN / 256, D, F.G, c_id, 0);
            EpiIn E{QKR, VVb, OOb, IFb, inptr(F, I_BIF)};
            pg8::gemm_phase<EpiIn, pg8::UnitOrder, true, true>(F.lds, g, S, E, F.tid);
        } else if (EN_ML && ph == 16) {
            const int Hh = F.G >= 128 ? 64 : (F.G / 2 > 0 ? F.G / 2 : 1);
            if (F.vcu < Hh && pvar != 2) {
                for (int i = F.vcu; i < PB * 8; i += Hh) mlstm_prompt_chain(F, i >> 3, i & 7, QKR, VVb, OOb, IFb, HOb, inptr(F, I_CW), inptr(F, I_CB), inptr(F, I_MNW), out, pvar);
            }
            if ((F.vcu >= Hh || F.G == 1) && pvar != 1 && pvar < 3) {
                const int st = F.G == 1 ? 1 : F.G - Hh;
                for (int i = F.G == 1 ? 0 : F.vcu - Hh; i < SB * 8; i += st)
                    mlstm_sample_item(F, i >> 3, i & 7, QKR, VVb, OOb, IFb, HOb, inptr(F, I_CW), inptr(F, I_CB), inptr(F, I_MNW), inptr(F, I_MC), inptr(F, I_MN), inptr(F, I_MM), inptr(F, I_MCONV), out);
            }
            if (F.vcu >= Hh && F.G > Hh && rep + 1 == nrep) convert_weights(F, 0, 1, 1, (bf16*)(ws + WS_W2), Hh);
        }
        if (++rep < nrep) continue;
        rep = 0;
        if (ph + 1 < args.ph_hi) xcd_barrier(bar);
        ++ph;
    }
}

extern "C" void kernel_launch(void* const* d_in, const int* in_sizes, int n_in, void* d_out, int out_size, void* d_ws, size_t ws_size, hipStream_t stream) {
    static int grid = 0;
    if (grid == 0) {
        if (n_in != N_IN || out_size != (int)O_END || ws_size < WS_END2) { fprintf(stderr, "kernel_launch: unexpected shapes (n_in %d, out %d, ws %zu); nothing launched\n", n_in, out_size, ws_size); grid = -1; return; }
        int dev = 0, cus = 0, per_cu = 0;
        if (hipGetDevice(&dev) != hipSuccess || hipDeviceGetAttribute(&cus, hipDeviceAttributeMultiprocessorCount, dev) != hipSuccess) { grid = -1; return; }
        if (hipFuncSetAttribute((const void*)mega_fwd, hipFuncAttributeMaxDynamicSharedMemorySize, LDS_BYTES) != hipSuccess) { fprintf(stderr, "kernel_launch: hipFuncSetAttribute failed\n"); grid = -1; return; }
        if (hipOccupancyMaxActiveBlocksPerMultiprocessor(&per_cu, (const void*)mega_fwd, NWAVES * 64, LDS_BYTES) != hipSuccess || per_cu < 1) { fprintf(stderr, "kernel_launch: occupancy query says %d\n", per_cu); per_cu = 1; }
        (void)hipGetLastError();
        grid = cus;
    }
    if (grid < 0) return;
    (void)hipMemsetAsync((char*)d_ws + WS_CTL, 0, CTL_ZERO_BYTES, stream);
    Args a{};
    for (int i = 0; i < N_IN; ++i) a.in[i] = (const float*)d_in[i];
    a.out = (float*)d_out; a.ws = (unsigned char*)d_ws;
#if MK_N_LAUNCHES == 1
    a.ph_lo = 0; a.ph_hi = N_PHASES;
    { void* kargs[] = {(void*)&a};
      const hipError_t e = hipLaunchCooperativeKernel((const void*)mega_fwd, dim3(grid), dim3(NWAVES * 64), kargs, LDS_BYTES, stream);
      if (e != hipSuccess) fprintf(stderr, "kernel_launch: cooperative launch failed: %s (grid %d)\n", hipGetErrorString(e), grid); }
#else
    for (int p = 0; p < N_PHASES; ++p) { a.ph_lo = p; a.ph_hi = p + 1; hipLaunchKernelGGL(mega_fwd, dim3(grid), dim3(NWAVES * 64), LDS_BYTES, stream, a); }
#endif
}
```

```cpp
#include <hip/hip_runtime.h>
#include <cstdio>
#include <cstdint>
namespace pg8 {
#define PG8_LAS __attribute__((address_space(3)))
typedef unsigned short bf16_t;
typedef short bf16x8 __attribute__((ext_vector_type(8)));
typedef float f32x4 __attribute__((ext_vector_type(4)));
typedef unsigned u32x4 __attribute__((ext_vector_type(4)));
constexpr int BM = 256, BK = 64, HALF = 128, HTB = HALF * BK * 2  , STAGE_BYTES = 8 * HTB, NXCD = 8, WGM = 8;

__host__ __device__ __forceinline__ int lds_byte(int r, int c) { const int st = (r >> 4) * 2 + (c >> 5), rr = r & 15, cc = c & 31, ob = rr * 64 + cc * 2; return st * 1024 + (ob ^ (((ob >> 9) & 1) << 5)); }
__host__ __device__ __forceinline__ void stage_rc(int b, int& R, int& C) { const int st = b / 1024, sb = b % 1024, swz = sb ^ (((sb >> 9) & 1) << 5); R = (st >> 1) * 16 + swz / 64; C = (st & 1) * 32 + (swz % 64) / 2; }
__host__ __device__ __forceinline__ int perm32(int rho) { const int n = rho >> 4, i = rho & 15; return 8 * (i >> 2) + 4 * n + (i & 3); }

struct Unit { int pm, pn, k0, nt, slab; };
struct Gemm { const bf16_t* A; const bf16_t* Bt; int M, N, K; };

struct UnitOrder {
    int nM, nN, nwg, G, c, ntf, tailS;
    __device__ __forceinline__ void init(int nM_, int nN_, int K, int G_, int c_, int tailS_) { nM = nM_; nN = nN_; nwg = nM * nN; G = G_; c = c_; ntf = K / BK; tailS = tailS_; }
    __device__ __forceinline__ bool next(int i, Unit& u) const {
        long L = (long)i * G + c;
        if (L < nwg) {
            int wgid = (int)L; { const int q = nwg / NXCD, r = nwg % NXCD, xcd = wgid % NXCD, off = wgid / NXCD; wgid = (xcd < r ? xcd * (q + 1) : r * (q + 1) + (xcd - r) * q) + off; }
            const int nig = WGM * nN, gid = wgid / nig, fm = gid * WGM, gsz = (nM - fm) < WGM ? (nM - fm) : WGM;
            u.pm = fm + ((wgid % nig) % gsz); u.pn = (wgid % nig) / gsz; u.k0 = 0; u.nt = ntf; u.slab = -1;
            if (tailS < 0) { u.nt = 4; u.k0 = u.pn >= 8 ? 128 : 0; }
            return true;
        }
        L -= nwg; if (tailS <= 0 || L >= 8 * tailS) return false;
        int tile, sl; if (tailS == 4) { tile = (int)L >> 2; sl = (int)L & 3; } else { tile = (int)L / 11; sl = (int)L - 11 * tile; }
        u.pm = 64 + (tile >> 2); u.pn = tile & 3; u.k0 = sl * 256; u.nt = 4; u.slab = sl; return true;
    }
    __device__ __forceinline__ void a_ready(const Unit&) const {}
    __device__ __forceinline__ void done(const Unit&) const {}
};
template <class Epi, class Sched, bool ALIGN_EPI = false, bool SP2 = false>
__device__ __forceinline__ void gemm_phase(PG8_LAS unsigned char* lds, const Gemm g, const Sched& S, const Epi& E, const int tid) {
    const int wid = __builtin_amdgcn_readfirstlane(tid >> 6), lane = tid & 63, wr = wid >> 2, wc = wid & 3, fr = lane & 15, fq = lane >> 4;
    const int K = g.K;
    unsigned voffA[2], voffB[2];
#pragma unroll
    for (int i = 0; i < 2; ++i) { int R, C; stage_rc(tid * 16 + i * 8192, R, C); const int Rb = Epi::PERM ? ((R & ~31) + perm32(R & 31)) : R;
        voffA[i] = (unsigned)(R * K + C) * 2u; voffB[i] = (unsigned)(Rb * K + C) * 2u; }
    const size_t kstep = (size_t)(BK * 2);
    const size_t hstep = (size_t)HALF * K * 2;
    const size_t tstep = 2 * hstep;
    const unsigned ldsw = (unsigned)wid * 1024u;
    const int aoff = lds_byte(wr * 64 + fr, fq * 8), boff = lds_byte(wc * 32 + fr, fq * 8);
#define PG8_SA(b, h) (((b) * 2 + (h)) * HTB)
#define PG8_SB(b, h) ((4 + (b) * 2 + (h)) * HTB)
#define PG8_STAGE(bufoff, gbase, voff) do { _Pragma("unroll") for (int _i = 0; _i < 2; ++_i) \
        __builtin_amdgcn_global_load_lds((const unsigned*)((const char*)(gbase) + (voff)[_i]), (PG8_LAS unsigned*)(lds + (bufoff) + ldsw + _i * 8192), 16, 0, 0); } while (0)
#define PG8_LDA(dst, b, h) do { _Pragma("unroll") for (int m = 0; m < 4; ++m) _Pragma("unroll") for (int k = 0; k < 2; ++k) dst[m][k] = *(const PG8_LAS bf16x8*)(lds + PG8_SA(b, h) + aoff + m * 2048 + k * 1024); } while (0)
#define PG8_LDB(dst, b, h) do { _Pragma("unroll") for (int n = 0; n < 2; ++n) _Pragma("unroll") for (int k = 0; k < 2; ++k) dst[n][k] = *(const PG8_LAS bf16x8*)(lds + PG8_SB(b, h) + boff + n * 2048 + k * 1024); } while (0)
#define PG8_MMA(ai, bj, At, Bt) do { __builtin_amdgcn_s_setprio(1); _Pragma("unroll") for (int m = 0; m < 4; ++m) _Pragma("unroll") for (int n = 0; n < 2; ++n) _Pragma("unroll") for (int k = 0; k < 2; ++k) \
        acc[ai][bj][m][n] = __builtin_amdgcn_mfma_f32_16x16x32_bf16(Bt[n][k], At[m][k], acc[ai][bj][m][n], 0, 0, 0); __builtin_amdgcn_s_setprio(0); } while (0)
#define PG8_WAIT_V(n) asm volatile("s_waitcnt vmcnt(" #n ")" ::: "memory")
#define PG8_WAIT_L(n) asm volatile("s_waitcnt lgkmcnt(" #n ")" ::: "memory")
#define PG8_BAR __builtin_amdgcn_s_barrier()
#define PG8_SCHED __builtin_amdgcn_sched_barrier(0)
    Unit cur, nxt; int ui = 0;
    if (!S.next(0, cur)) return;
    f32x4 acc[2][2][4][2];
#pragma unroll
    for (int a = 0; a < 2; ++a)
#pragma unroll
        for (int b = 0; b < 2; ++b)
#pragma unroll
            for (int m = 0; m < 4; ++m)
#pragma unroll
                for (int n = 0; n < 2; ++n) acc[a][b][m][n] = (f32x4){0.f, 0.f, 0.f, 0.f};
    bf16x8 At[4][2], B0[2][2], B1[2][2];
    const char* cA = (const char*)g.A + (size_t)cur.pm * tstep + (size_t)cur.k0 * 2; const char* cB = (const char*)g.Bt + (size_t)cur.pn * tstep + (size_t)cur.k0 * 2;
    S.a_ready(cur);
    if constexpr (SP2) {
        PG8_STAGE(PG8_SB(0, 0), cB, voffB); PG8_STAGE(PG8_SB(0, 1), cB + hstep, voffB); PG8_STAGE(PG8_SA(0, 0), cA, voffA); PG8_STAGE(PG8_SA(0, 1), cA + hstep, voffA);
        if (wr == 1) PG8_BAR;
        PG8_WAIT_V(2); PG8_BAR;
        PG8_STAGE(PG8_SB(1, 0), cB + kstep, voffB); PG8_STAGE(PG8_SA(1, 0), cA + kstep, voffA); PG8_STAGE(PG8_SB(1, 1), cB + hstep + kstep, voffB);
        PG8_WAIT_V(6); PG8_BAR;
    } else {
        PG8_STAGE(PG8_SB(0, 0), cB, voffB); PG8_STAGE(PG8_SA(0, 0), cA, voffA); PG8_STAGE(PG8_SB(0, 1), cB + hstep, voffB); PG8_STAGE(PG8_SA(0, 1), cA + hstep, voffA);
        if (wr == 1) PG8_BAR;
        PG8_WAIT_V(4); PG8_BAR;
        PG8_STAGE(PG8_SB(1, 0), cB + kstep, voffB); PG8_STAGE(PG8_SA(1, 0), cA + kstep, voffA); PG8_STAGE(PG8_SB(1, 1), cB + hstep + kstep, voffB);
        PG8_WAIT_V(6); PG8_BAR;
    }
    for (;;) {
        const bool has_next = S.next(ui + 1, nxt);
        const char* nA = has_next ? (const char*)g.A + (size_t)nxt.pm * tstep + (size_t)nxt.k0 * 2 : cA; const char* nB = has_next ? (const char*)g.Bt + (size_t)nxt.pn * tstep + (size_t)nxt.k0 * 2 : cB;
        const int nt = cur.nt;
        for (int t = 0; t < nt; t += 2) {
            const bool last = (t == nt - 2);
            const char* a1 = cA + (size_t)(t + 1) * kstep;
            const char* a2 = last ? nA : cA + (size_t)(t + 2) * kstep; const char* b2 = last ? nB : cB + (size_t)(t + 2) * kstep;
            const char* a3 = a2 + kstep; const char* b3 = b2 + kstep;
            if (last && has_next) S.a_ready(nxt);
            if constexpr (SP2) {
            PG8_LDB(B0, 0, 0); PG8_LDB(B1, 0, 1); PG8_SCHED; PG8_LDA(At, 0, 0); PG8_STAGE(PG8_SA(1, 1), a1 + hstep, voffA);
            PG8_WAIT_V(8); PG8_WAIT_L(0); PG8_BAR; PG8_MMA(0, 0, At, B0); PG8_MMA(0, 1, At, B1); PG8_BAR; PG8_SCHED;
            PG8_LDA(At, 0, 1); PG8_STAGE(PG8_SB(0, 0), b2, voffB); PG8_STAGE(PG8_SB(0, 1), b2 + hstep, voffB); PG8_STAGE(PG8_SA(0, 0), a2, voffA);
            PG8_WAIT_V(8); PG8_WAIT_L(0); PG8_BAR; PG8_MMA(1, 0, At, B0); PG8_MMA(1, 1, At, B1); PG8_BAR; PG8_SCHED;
            PG8_LDB(B0, 1, 0); PG8_LDB(B1, 1, 1); PG8_SCHED; PG8_LDA(At, 1, 0); PG8_STAGE(PG8_SA(0, 1), a2 + hstep, voffA);
            PG8_WAIT_V(8); PG8_WAIT_L(0); PG8_BAR; PG8_MMA(0, 0, At, B0); PG8_MMA(0, 1, At, B1); PG8_BAR; PG8_SCHED;
            PG8_LDA(At, 1, 1); PG8_STAGE(PG8_SB(1, 0), b3, voffB); PG8_STAGE(PG8_SB(1, 1), b3 + hstep, voffB); PG8_STAGE(PG8_SA(1, 0), a3, voffA);
            PG8_WAIT_V(8); PG8_WAIT_L(0); PG8_BAR; PG8_MMA(1, 0, At, B0); PG8_MMA(1, 1, At, B1); PG8_BAR; PG8_SCHED;
            } else {
            PG8_LDB(B0, 0, 0); PG8_SCHED; PG8_LDA(At, 0, 0); PG8_STAGE(PG8_SA(1, 1), a1 + hstep, voffA);
            PG8_WAIT_L(8); PG8_BAR; PG8_WAIT_L(0); PG8_MMA(0, 0, At, B0); PG8_BAR; PG8_SCHED;
            PG8_LDB(B1, 0, 1); PG8_STAGE(PG8_SB(0, 0), b2, voffB);
            PG8_BAR; PG8_WAIT_L(0); PG8_MMA(0, 1, At, B1); PG8_BAR;
            PG8_LDA(At, 0, 1); PG8_STAGE(PG8_SA(0, 0), a2, voffA);
            PG8_BAR; PG8_WAIT_L(0); PG8_MMA(1, 0, At, B0); PG8_BAR; PG8_SCHED;
            PG8_STAGE(PG8_SB(0, 1), b2 + hstep, voffB);
            PG8_WAIT_V(6); PG8_BAR; PG8_MMA(1, 1, At, B1); PG8_BAR;
            PG8_LDB(B0, 1, 0); PG8_SCHED; PG8_LDA(At, 1, 0); PG8_STAGE(PG8_SA(0, 1), a2 + hstep, voffA);
            PG8_WAIT_L(8); PG8_BAR; PG8_WAIT_L(0); PG8_MMA(0, 0, At, B0); PG8_BAR; PG8_SCHED;
            PG8_LDB(B1, 1, 1); PG8_STAGE(PG8_SB(1, 0), b3, voffB);
            PG8_BAR; PG8_WAIT_L(0); PG8_MMA(0, 1, At, B1); PG8_BAR;
            PG8_LDA(At, 1, 1); PG8_STAGE(PG8_SA(1, 0), a3, voffA);
            PG8_BAR; PG8_WAIT_L(0); PG8_MMA(1, 0, At, B0); PG8_BAR; PG8_SCHED;
            PG8_STAGE(PG8_SB(1, 1), b3 + hstep, voffB);
            PG8_WAIT_V(6); PG8_BAR; PG8_MMA(1, 1, At, B1); PG8_BAR;
            }
        }
        if constexpr (ALIGN_EPI) { if (wr == 0) PG8_BAR; }
        if constexpr (!Epi::AFTER_DRAIN) { E(acc, cur, wr, wc, fr, fq); S.done(cur); }
        if (!has_next) break;
#pragma unroll
        for (int a = 0; a < 2; ++a)
#pragma unroll
            for (int b = 0; b < 2; ++b)
#pragma unroll
                for (int m = 0; m < 4; ++m)
#pragma unroll
                    for (int n = 0; n < 2; ++n) acc[a][b][m][n] = (f32x4){0.f, 0.f, 0.f, 0.f};
        cur = nxt; cA = nA; cB = nB; ++ui;
        if constexpr (ALIGN_EPI) { if (wr == 1) PG8_BAR; }
    }
    PG8_WAIT_V(0);
    if constexpr (!ALIGN_EPI) { if (wr == 0) PG8_BAR; }
    PG8_BAR;
    if constexpr (Epi::AFTER_DRAIN) { E.fused(acc, cur, wr, wc, fr, fq, lds, wid, lane); S.done(cur); }
#undef PG8_SA
#undef PG8_SB
#undef PG8_STAGE
#undef PG8_LDA
#undef PG8_LDB
#undef PG8_MMA
#undef PG8_WAIT_V
#undef PG8_WAIT_L
#undef PG8_BAR
#undef PG8_SCHED
}
}

#define GAS __attribute__((address_space(1)))
#define LAS __attribute__((address_space(3)))
typedef unsigned short bf16;
typedef unsigned v4u __attribute__((ext_vector_type(4)));
typedef float f32x4 __attribute__((ext_vector_type(4)));
typedef short bf16x8 __attribute__((ext_vector_type(8)));
typedef GAS unsigned gu32;
typedef GAS unsigned long long gu64;
#define RLX_AGENT __ATOMIC_RELAXED, __HIP_MEMORY_SCOPE_AGENT
#define LDS_WAIT() asm volatile("s_waitcnt lgkmcnt(0)" ::: "memory")
#define VM_WAIT() asm volatile("s_waitcnt vmcnt(0)" ::: "memory")
__device__ __forceinline__ unsigned long long rt() { return __builtin_amdgcn_s_memrealtime(); }
__device__ __forceinline__ unsigned f2bf(float f) { unsigned u = __builtin_bit_cast(unsigned, f); return (u + 0x7fffu + ((u >> 16) & 1u)) >> 16; }
__device__ __forceinline__ unsigned pk2(float lo, float hi) { return f2bf(lo) | (f2bf(hi) << 16); }

#define XB_TMO      128
#define XB_XCNT(j)  (256  + 64 * (j))
#define XB_XSUB(j)  (1280 + 64 * (j))
#define XB_XGEN(j)  (2304 + 64 * (j))
#define XB_TOP      3328
#define XB_TOPGEN   3392
#define XCD_BAR_WORDS 3456
#define XB_SPIN_CAP (1u << 18)

__device__ __forceinline__ unsigned xb_ld(unsigned* p)              { return __hip_atomic_load(p, __ATOMIC_RELAXED, __HIP_MEMORY_SCOPE_AGENT); }
__device__ __forceinline__ unsigned xb_add(unsigned* p, unsigned v) { return __hip_atomic_fetch_add(p, v, __ATOMIC_RELAXED, __HIP_MEMORY_SCOPE_AGENT); }
__device__ __forceinline__ unsigned xb_xcc_id() { return (unsigned)__builtin_amdgcn_s_getreg((3 << 11) | 20) & 0xFu; }
#define XB_SPIN(cond, bar) do { unsigned _sp = 0; while (cond) { __builtin_amdgcn_s_sleep(1); \
    if ((++_sp & 255u) == 0u) { if (xb_ld(&(bar)[XB_TMO])) break; if (_sp > XB_SPIN_CAP) { atomicAdd(&(bar)[XB_TMO], 1u); break; } } } } while (0)

struct XcdBarrier {
    unsigned* bar; unsigned x;
    volatile LAS unsigned* st;
};

__device__ __forceinline__ XcdBarrier xcd_barrier_post(unsigned* bar, volatile LAS unsigned* st) {
    XcdBarrier b; b.bar = bar; b.x = xb_xcc_id(); b.st = st;
    if (threadIdx.x == 0) (void)xb_add(&bar[XB_XCNT(b.x)], 1u);
    return b;
}
__device__ __forceinline__ void xcd_barrier_complete(unsigned* bar, unsigned x, unsigned& nloc, unsigned& nx) {
    const unsigned G = gridDim.x * gridDim.y * gridDim.z;
    unsigned sum, cnt, mine, sp = 0u;
    for (;;) {
        sum = 0u; cnt = 0u; mine = 0u;
#pragma unroll
        for (unsigned j = 0; j < 16; ++j) { const unsigned c = xb_ld(&bar[XB_XCNT(j)]); sum += c; cnt += (c > 0u) ? 1u : 0u; mine = (j == x) ? c : mine; }
        if (sum == G) break;
        __builtin_amdgcn_s_sleep(1);
        if ((++sp & 255u) == 0u) { if (xb_ld(&bar[XB_TMO])) break; if (sp > XB_SPIN_CAP) { atomicAdd(&bar[XB_TMO], 1u); break; } }
    }
    nloc = mine > 0u ? mine : 1u; nx = cnt > 0u ? cnt : 1u;
}

__device__ __forceinline__ void xcd_barrier(const XcdBarrier& b) {
    asm volatile("s_waitcnt vmcnt(0)" ::: "memory");
    __syncthreads();
    if (threadIdx.x == 0) {
        unsigned* bar = b.bar;
        __builtin_amdgcn_s_waitcnt(0);
        unsigned nloc = b.st[0], nx = b.st[1];
        if (nloc == 0u) { xcd_barrier_complete(bar, b.x, nloc, nx); b.st[0] = nloc; b.st[1] = nx; }
        const unsigned old = xb_add(&bar[XB_XSUB(b.x)], 1u);
        const unsigned gen = old / nloc;
        if (old + 1u == (gen + 1u) * nloc) {
            __builtin_amdgcn_fence(__ATOMIC_RELEASE, "agent");
            asm volatile("s_waitcnt vmcnt(0)" ::: "memory");
            const unsigned og = xb_add(&bar[XB_TOP], 1u);
            const unsigned tg = og / nx;
            if (og + 1u == (tg + 1u) * nx) xb_add(&bar[XB_TOPGEN], 1u);
            else XB_SPIN(xb_ld(&bar[XB_TOPGEN]) == tg, bar);
            __builtin_amdgcn_fence(__ATOMIC_ACQUIRE, "agent");
            xb_add(&bar[XB_XGEN(b.x)], 1u);
            asm volatile("s_waitcnt vmcnt(0)" ::: "memory");
        } else {
            XB_SPIN(xb_ld(&bar[XB_XGEN(b.x)]) == gen, bar);
            __builtin_amdgcn_fence(__ATOMIC_ACQUIRE, "agent");
            asm volatile("s_waitcnt vmcnt(0)" ::: "memory");
        }
    }
    __syncthreads();
}

constexpr int NWAVES = 8;
constexpr int D = 1024, FF = 2816;
constexpr int PB = 8, PT = 2048, SB = 128, STK = 4;
constexpr int MP = PB * PT, MS = SB * STK, M = MP + MS;
constexpr int NRW = 3584, KRW = 2048, NL2 = 3072, KL2 = 384, NIN = 3328;
constexpr float NORM_EPS = 1e-6f, GN_EPS = 64e-5f;
typedef pg8::bf16_t bf16;

constexpr size_t MiB = 1u << 20;
constexpr size_t WS_CTL = 0, CTL_ZERO_BYTES = 64 * 1024;
constexpr size_t WS_W = 1 * MiB;
constexpr size_t WS_XR = 20 * MiB;
constexpr size_t WS_BIG = 86 * MiB;
constexpr size_t WS_END = 256 * MiB;
constexpr size_t WS_YRAW = 256 * MiB, WS_BON = 288 * MiB, WS_W2 = 289 * MiB  , WS_END2 = 308 * MiB;
constexpr size_t W_GU = 0, W_D = (size_t)2 * FF * D * 2;
constexpr size_t W_RW = 0, W_L2 = (size_t)NRW * KRW * 2, W_O = W_L2 + (size_t)NL2 * KL2 * 2;
constexpr size_t W_IN = 0, W_OUT = (size_t)NIN * D * 2;
static_assert(W_D + (size_t)D * FF * 2 <= 19 * MiB && W_O + (size_t)D * D * 2 <= 19 * MiB && W_OUT + (size_t)D * D * 2 <= 19 * MiB, "weights region");
constexpr size_t B_H = 0, B_XN = 91 * MiB, B_SLAB = 124 * MiB;
constexpr size_t B_ACAT = 0, B_R = 66 * MiB, B_K = 99 * MiB, B_V = 132 * MiB, B_DEC = 0, B_AA = 33 * MiB;
constexpr size_t B_QKR = 0, B_VV = 33 * MiB, B_HO = 66 * MiB, B_OO = 124 * MiB, B_IF = 157 * MiB;
static_assert((size_t)M * FF * 2 <= 91 * MiB && (size_t)M * D * 2 == 33 * MiB && B_IF + (size_t)M * 16 * 4 <= 170 * MiB && B_SLAB + (size_t)11 * MS * D * 4 <= 170 * MiB, "BIG map");
constexpr size_t OS_GG = 0, OS_LORA = 33 * MiB;
static_assert(OS_LORA + (size_t)M * KL2 * 2 <= (size_t)MP * D * 4, "d_out scratch");
constexpr size_t O_Y = 0, O_P_S = 17301504, O_P_SHIFT = 17825792, O_P_C = 17833984, O_P_N = 18358272, O_P_M = 18362368, O_P_CONV = 18362432,
                 O_S_S = 18387008, O_S_SHIFT = 26775616, O_S_C = 26906688, O_S_N = 35295296, O_S_M = 35360832, O_S_CONV = 35361856, O_END = 35755072;
constexpr int CW_BAR = 1024;

constexpr int RING_BYTES = 131072, LDSCTL_OFF = RING_BYTES, MISC_OFF = LDSCTL_OFF + 320, TAB_OFF = LDSCTL_OFF + 1024, LDS_BYTES = 147456;

enum { I_XP = 0, I_XS, I_RS, I_RSHIFT, I_MC, I_MN, I_MM, I_MCONV, I_NFA, I_FAWG, I_FAWU, I_FAWD, I_NMIX, I_NFB, I_FBWG, I_FBWU, I_FBWD,
       I_MU, I_WR, I_WK, I_WV, I_WO, I_W0, I_W1, I_W2, I_A0, I_A1, I_A2, I_G1, I_G2, I_KK, I_KA, I_RK, I_GNW, I_GNB,
       I_WIN, I_BIF, I_CW, I_CB, I_MNW, I_WOUT, I_NFIN, N_IN };

typedef __bf16 bf16x2_t __attribute__((ext_vector_type(2)));
typedef float f32x2_t __attribute__((ext_vector_type(2)));
__device__ __forceinline__ unsigned pkbf(float lo, float hi) { f32x2_t v = {lo, hi}; bf16x2_t b = __builtin_convertvector(v, bf16x2_t); return __builtin_bit_cast(unsigned, b); }
__device__ __forceinline__ float bflo(unsigned u) { return __builtin_bit_cast(float, u << 16); }
__device__ __forceinline__ float bfhi(unsigned u) { return __builtin_bit_cast(float, u & 0xffff0000u); }
__device__ __forceinline__ float bf1(unsigned short u) { return __builtin_bit_cast(float, (unsigned)u << 16); }
__device__ __forceinline__ unsigned short f2bf1(float f) { return (unsigned short)(pkbf(f, 0.f) & 0xffffu); }
__device__ __forceinline__ void unpack8(v4u w, float (&o)[8]) { o[0] = bflo(w.x); o[1] = bfhi(w.x); o[2] = bflo(w.y); o[3] = bfhi(w.y); o[4] = bflo(w.z); o[5] = bfhi(w.z); o[6] = bflo(w.w); o[7] = bfhi(w.w); }
__device__ __forceinline__ v4u pack8(const float (&o)[8]) { v4u w; w.x = pkbf(o[0], o[1]); w.y = pkbf(o[2], o[3]); w.z = pkbf(o[4], o[5]); w.w = pkbf(o[6], o[7]); return w; }
__device__ __forceinline__ float sigmoidf_(float x) { return __builtin_amdgcn_rcpf(1.f + __expf(-x)); }
__device__ __forceinline__ float siluf_(float x) { return x * __builtin_amdgcn_rcpf(1.f + __expf(-x)); }
__device__ __forceinline__ float tanhf_(float x) { return 1.f - 2.f * __builtin_amdgcn_rcpf(__expf(2.f * x) + 1.f); }
__device__ __forceinline__ float logsigmoidf_(float x) { return fminf(x, 0.f) - log1pf(__expf(-fabsf(x))); }
template <int CTRL> __device__ __forceinline__ float dppf(float x) { return __builtin_bit_cast(float, __builtin_amdgcn_update_dpp(0, __builtin_bit_cast(int, x), CTRL, 0xF, 0xF, true)); }
__device__ __forceinline__ float red4(float x) { x += dppf<0xB1>(x); x += dppf<0x4E>(x); return x; }
__device__ __forceinline__ float red8(float x) { x = red4(x); x += dppf<0x141>(x); return x; }
__device__ __forceinline__ float red16(float x) { x = red8(x); x += dppf<0x140>(x); return x; }
__device__ __forceinline__ float wave_sum(float v) {
#pragma unroll
    for (int o = 1; o < 64; o <<= 1) v += __shfl_xor(v, o);
    return v;
}

struct Frame {
    LAS unsigned char* lds;
    volatile LAS unsigned* MISC;
    gu32* ctl;
    volatile LAS unsigned long long* tab;
    int tid, lane, wave, vcu, G;
};
__device__ __forceinline__ const float* inptr(const Frame& F, int i) { const unsigned long long v = F.tab[i];
    const unsigned lo = __builtin_amdgcn_readfirstlane((unsigned)v), hi = __builtin_amdgcn_readfirstlane((unsigned)(v >> 32)); return (const float*)(const GAS float*)(((unsigned long long)hi << 32) | lo); }

using pg8::Unit; using pg8::BM; using pg8::HALF;
__device__ __forceinline__ void st8bf(bf16* p, f32x4 v0, f32x4 v1) { v4u w; w.x = pkbf(v0[0], v0[1]); w.y = pkbf(v0[2], v0[3]); w.z = pkbf(v1[0], v1[1]); w.w = pkbf(v1[2], v1[3]); *(v4u*)p = w; }

struct EpiSwiglu {
    static constexpr bool PERM = true, AFTER_DRAIN = false;
    bf16* H; int pvar;
    __device__ __forceinline__ void operator()(const f32x4 (&acc)[2][2][4][2], const Unit& u, int wr, int wc, int fr, int fq) const {
        if (pvar == 3) return;
        const int row0 = u.pm * BM + wr * 64 + fr, col0 = u.pn * 128 + wc * 32 + 8 * fq;
#pragma unroll
        for (int ai = 0; ai < 2; ++ai)
#pragma unroll
            for (int m = 0; m < 4; ++m) {
                f32x4 o[2];
#pragma unroll
                for (int n = 0; n < 2; ++n)
#pragma unroll
                    for (int i = 0; i < 4; ++i) { const float g = acc[ai][0][m][n][i], up = acc[ai][1][m][n][i]; o[n][i] = siluf_(g) * up; }
                st8bf(H + (size_t)(row0 + ai * HALF + m * 16) * FF + col0, o[0], o[1]);
            }
    }
};
__device__ __forceinline__ void ld8bf(const bf16* p, f32x4& a, f32x4& b) { const v4u w = *(const v4u*)p; a = (f32x4){bflo(w.x), bfhi(w.x), bflo(w.y), bfhi(w.y)}; b = (f32x4){bflo(w.z), bfhi(w.z), bflo(w.w), bfhi(w.w)}; }
struct EpiRes {
    static constexpr bool PERM = true, AFTER_DRAIN = false;
    const float* basef; const bf16* baseb; bf16* out; float* slab; float coef;
    __device__ __forceinline__ void operator()(const f32x4 (&acc)[2][2][4][2], const Unit& u, int wr, int wc, int fr, int fq) const {
        const int row0 = u.pm * BM + wr * 64 + fr, col0 = u.pn * BM + wc * 32 + 8 * fq;
        if (u.slab < 0) {
            if (basef) {
#pragma unroll
                for (int ai = 0; ai < 2; ++ai)
#pragma unroll
                    for (int m = 0; m < 4; ++m) { const size_t ro = (size_t)(row0 + ai * HALF + m * 16) * D + col0;
#pragma unroll
                        for (int bj = 0; bj < 2; ++bj) { const f32x4 b0 = *(const f32x4*)(basef + ro + bj * HALF), b1 = *(const f32x4*)(basef + ro + bj * HALF + 4);
                            st8bf(out + ro + bj * HALF, b0 + acc[ai][bj][m][0] * coef, b1 + acc[ai][bj][m][1] * coef); } }
            } else {
#pragma unroll
                for (int ai = 0; ai < 2; ++ai)
#pragma unroll
                    for (int m = 0; m < 4; ++m) { const size_t ro = (size_t)(row0 + ai * HALF + m * 16) * D + col0;
#pragma unroll
                        for (int bj = 0; bj < 2; ++bj) { f32x4 b0, b1; ld8bf(baseb + ro + bj * HALF, b0, b1);
                            st8bf(out + ro + bj * HALF, b0 + acc[ai][bj][m][0] * coef, b1 + acc[ai][bj][m][1] * coef); } }
            }
        } else {
            float* sl = slab + (size_t)u.slab * MS * D;
#pragma unroll
            for (int ai = 0; ai < 2; ++ai)
#pragma unroll
                for (int m = 0; m < 4; ++m) { const size_t ro = (size_t)(row0 + ai * HALF + m * 16 - MP) * D + col0;
#pragma unroll
                    for (int bj = 0; bj < 2; ++bj) { *(f32x4*)(sl + ro + bj * HALF) = acc[ai][bj][m][0]; *(f32x4*)(sl + ro + bj * HALF + 4) = acc[ai][bj][m][1]; } }
        }
    }
};
struct EpiRw {
    static constexpr bool PERM = true, AFTER_DRAIN = false;
    bf16 *R, *K, *V, *L;
    __device__ __forceinline__ void operator()(const f32x4 (&acc)[2][2][4][2], const Unit& u, int wr, int wc, int fr, int fq) const {
        const int row0 = u.pm * BM + wr * 64 + fr;
        if (u.pn < 12) {
            bf16 *p0 = R, *p1 = K, *p2 = V; asm volatile("" : "+s"(p0), "+s"(p1), "+s"(p2));
            bf16* dst = u.pn < 4 ? p0 : (u.pn < 8 ? p1 : p2); const int col0 = (u.pn & 3) * BM + wc * 32 + 8 * fq;
#pragma unroll
            for (int ai = 0; ai < 2; ++ai)
#pragma unroll
                for (int m = 0; m < 4; ++m) { bf16* rp = dst + (size_t)(row0 + ai * HALF + m * 16) * D + col0;
#pragma unroll
                    for (int bj = 0; bj < 2; ++bj) st8bf(rp + bj * HALF, acc[ai][bj][m][0], acc[ai][bj][m][1]); }
        } else {
#pragma unroll
            for (int bj = 0; bj < 2; ++bj) {
                const int lc = (u.pn - 12) * BM + bj * HALF + wc * 32 + 8 * fq;
                if (lc >= KL2) continue;
                const int act = lc < 64 ? 1 : (lc < 128 ? 0 : (lc < 288 ? 2 : 3));
#pragma unroll
                for (int ai = 0; ai < 2; ++ai)
#pragma unroll
                    for (int m = 0; m < 4; ++m) {
                        f32x4 o[2];
#pragma unroll
                        for (int n = 0; n < 2; ++n)
#pragma unroll
                            for (int i = 0; i < 4; ++i) { const float x = acc[ai][bj][m][n][i]; o[n][i] = act == 1 ? tanhf_(x) : (act == 0 ? x : (act == 2 ? sigmoidf_(x) : 0.f)); }
                        st8bf(L + (size_t)(row0 + ai * HALF + m * 16) * KL2 + lc, o[0], o[1]);
                    }
            }
        }
    }
};
struct EpiL2 {
    static constexpr bool PERM = true, AFTER_DRAIN = false;
    bf16 *DEC, *AA, *GG; const float *w0, *a0;
    __device__ __forceinline__ void operator()(const f32x4 (&acc)[2][2][4][2], const Unit& u, int wr, int wc, int fr, int fq) const {
        const int row0 = u.pm * BM + wr * 64 + fr, kind = u.pn >> 2, col0 = (u.pn & 3) * BM + wc * 32 + 8 * fq;
        bf16 *p0 = DEC, *p1 = AA, *p2 = GG; const float *q0 = w0, *q1 = a0; asm volatile("" : "+s"(p0), "+s"(p1), "+s"(p2), "+s"(q0), "+s"(q1));
        bf16* dst = kind == 0 ? p0 : (kind == 1 ? p1 : p2); const float* bias = kind == 0 ? q0 : q1;
#pragma unroll
        for (int bj = 0; bj < 2; ++bj) {
            f32x4 bv[2];
#pragma unroll
            for (int n = 0; n < 2; ++n) bv[n] = kind < 2 ? *(const f32x4*)(bias + col0 + bj * HALF + 4 * n) : (f32x4){0.f, 0.f, 0.f, 0.f};
#pragma unroll
            for (int ai = 0; ai < 2; ++ai)
#pragma unroll
                for (int m = 0; m < 4; ++m) {
                    f32x4 o[2];
#pragma unroll
                    for (int n = 0; n < 2; ++n)
#pragma unroll
                        for (int i = 0; i < 4; ++i) { const float z = acc[ai][bj][m][n][i] + bv[n][i];
                            o[n][i] = kind == 0 ? (1.f - __expf(-0.60653065971f * sigmoidf_(z))) : (kind == 1 ? sigmoidf_(z) : z); }
                    st8bf(dst + (size_t)(row0 + ai * HALF + m * 16) * D + col0 + bj * HALF, o[0], o[1]);
                }
        }
    }
};
struct EpiIn {
    static constexpr bool PERM = true, AFTER_DRAIN = false;
    bf16 *QKR, *VV, *OO; float* IF; const float* bif;
    __device__ __forceinline__ void operator()(const f32x4 (&acc)[2][2][4][2], const Unit& u, int wr, int wc, int fr, int fq) const {
        const int row0 = u.pm * BM + wr * 64 + fr;
        if (u.pn < 12) {
            bf16 *p0 = QKR, *p1 = VV, *p2 = OO; asm volatile("" : "+s"(p0), "+s"(p1), "+s"(p2));
            const int kind = u.pn >> 2; bf16* dst = kind == 0 ? p0 : (kind == 1 ? p1 : p2); const int col0 = (u.pn & 3) * BM + wc * 32 + 8 * fq;
#pragma unroll
            for (int ai = 0; ai < 2; ++ai)
#pragma unroll
                for (int m = 0; m < 4; ++m) { bf16* rp = dst + (size_t)(row0 + ai * HALF + m * 16) * D + col0;
#pragma unroll
                    for (int bj = 0; bj < 2; ++bj) { f32x4 a = acc[ai][bj][m][0], b = acc[ai][bj][m][1];
                        if (kind == 2) {
#pragma unroll
                            for (int i = 0; i < 4; ++i) { a[i] = sigmoidf_(a[i]); b[i] = sigmoidf_(b[i]); } }
                        st8bf(rp + bj * HALF, a, b); } }
        } else if (u.pn == 12 && wc == 0 && fq < 2) {
            const f32x4 b0 = *(const f32x4*)(bif + 8 * fq), b1 = *(const f32x4*)(bif + 8 * fq + 4);
#pragma unroll
            for (int ai = 0; ai < 2; ++ai)
#pragma unroll
                for (int m = 0; m < 4; ++m) { f32x4 a = acc[ai][0][m][0] + b0, b = acc[ai][0][m][1] + b1;
                    if (fq == 1) {
#pragma unroll
                        for (int i = 0; i < 4; ++i) { a[i] = logsigmoidf_(a[i]); b[i] = logsigmoidf_(b[i]); } }
                    float* rp = IF + (size_t)(row0 + ai * HALF + m * 16) * 16 + 8 * fq; *(f32x4*)rp = a; *(f32x4*)(rp + 4) = b; }
        }
    }
};

struct CJ { const float* W; const float* sc; bf16* WT; int K, N, Npad, ldk, koff, rmode, roff, smode; };
__device__ __forceinline__ int cj_items(const CJ& j) { return (j.K / 32) * (j.Npad / 32); }
__device__ __forceinline__ void conv_load(const CJ& J, int item, int lane, f32x4 (&w)[4], float (&sc)[4]) {
    const int nblk = J.Npad / 32, kb = item / nblk, nb = item % nblk, k0 = 32 * kb, n0 = 32 * nb;
    const int r = lane >> 3, c4 = 4 * (lane & 7); const bool nok = n0 + c4 < J.N;
#pragma unroll
    for (int i = 0; i < 4; ++i) { const int kk = k0 + r + 8 * i;
        w[i] = nok ? *(const f32x4*)(J.W + (size_t)kk * J.N + n0 + c4) : (f32x4){0.f, 0.f, 0.f, 0.f};
        float s = 1.f; if (J.smode) { s = J.sc[kk]; if (J.smode == 2) s = 1.f - s; }
        sc[i] = s; }
}
__device__ __forceinline__ void conv_store(const CJ& J, LAS float* scr, int item, int lane, const f32x4 (&w)[4], const float (&sc)[4]) {
    const int nblk = J.Npad / 32, kb = item / nblk, nb = item % nblk, k0 = 32 * kb, n0 = 32 * nb;
    const int r = lane >> 3, c4 = 4 * (lane & 7);
#pragma unroll
    for (int i = 0; i < 4; ++i) { const f32x4 f = w[i] * sc[i]; LAS float* d = scr + (r + 8 * i) * 33 + c4; d[0] = f[0]; d[1] = f[1]; d[2] = f[2]; d[3] = f[3]; }
    LDS_WAIT(); asm volatile("" ::: "memory");
    const int rowbase = J.rmode == 0 ? J.roff + n0 : (n0 >> 7) * 256 + (n0 & 127) + J.roff;
    const int c = lane & 3;
#pragma unroll
    for (int j = 0; j < 2; ++j) { const int n = (lane >> 2) + 16 * j; const LAS float* s = scr + (8 * c) * 33 + n;
        v4u o; o.x = pkbf(s[0 * 33], s[1 * 33]); o.y = pkbf(s[2 * 33], s[3 * 33]); o.z = pkbf(s[4 * 33], s[5 * 33]); o.w = pkbf(s[6 * 33], s[7 * 33]);
        *(GAS v4u*)(J.WT + (size_t)(rowbase + n) * J.ldk + J.koff + k0 + 8 * c) = o; }
    LDS_WAIT(); asm volatile("" ::: "memory");
}
__device__ __forceinline__ CJ get_job(const Frame& F, int kind, int j, int layer, int ab, bf16* Wb) {
    CJ J; J.sc = nullptr; J.smode = 0; J.koff = 0; J.rmode = 0; J.roff = 0;
    if (kind == 0) {
        const float* wg = inptr(F, ab ? I_FBWG : I_FAWG) + (size_t)layer * D * FF; const float* wu = inptr(F, ab ? I_FBWU : I_FAWU) + (size_t)layer * D * FF; const float* wd = inptr(F, ab ? I_FBWD : I_FAWD) + (size_t)layer * D * FF;
        if (j < 2) { J.W = j == 0 ? wg : wu; J.K = D; J.N = FF; J.Npad = FF; J.WT = Wb + W_GU / 2; J.ldk = D; J.rmode = 1; J.roff = j == 0 ? 0 : 128; }
        else { J.W = wd; J.K = FF; J.N = D; J.Npad = D; J.WT = Wb + W_D / 2; J.ldk = FF; }
    } else if (kind == 1) {
        if (j < 12) {
            const int s = j >> 1, half = j & 1;
            J.W = inptr(F, s == 0 ? I_WR : (s == 1 ? I_WK : (s == 2 ? I_WV : (s == 3 ? I_W1 : (s == 4 ? I_A1 : I_G1)))));
            J.N = s < 3 ? 1024 : (s < 5 ? 64 : 160); J.Npad = s < 3 ? 1024 : (s < 5 ? 64 : 384);
            J.roff = s < 3 ? 1024 * s : (s == 3 ? 3072 : (s == 4 ? 3136 : 3200));
            const int mui = s == 0 ? 0 : (s == 1 ? 2 : (s == 2 ? 3 : (s == 3 ? 1 : (s == 4 ? 4 : 5))));
            J.sc = inptr(F, I_MU) + mui * D; J.smode = half ? 1 : 2; J.koff = half * D; J.K = D; J.ldk = KRW; J.WT = Wb + W_RW / 2;
        } else { J.W = inptr(F, I_WO); J.K = D; J.N = D; J.Npad = D; J.WT = Wb + W_O / 2; J.ldk = D; }
    } else {
        if (j == 0) { J.W = inptr(F, I_WIN); J.K = D; J.N = 3088; J.Npad = NIN; J.WT = Wb + W_IN / 2; J.ldk = D; }
        else { J.W = inptr(F, I_WOUT); J.K = D; J.N = D; J.Npad = D; J.WT = Wb + W_OUT / 2; J.ldk = D; }
    }
    return J;
}
__device__ __forceinline__ void convert_weights(const Frame& F, int kind, int layer, int ab, bf16* Wb, const int cu0 = 0) {
    LAS float* scr = (LAS float*)(F.lds + F.wave * 16384);
    const int gw = (F.vcu - cu0) * NWAVES + F.wave, NGW = (F.G - cu0) * NWAVES;
    const int njobs = kind == 0 ? 3 : (kind == 1 ? 13 : 2);
    int total = 0;
    for (int j = 0; j < njobs; ++j) { const CJ J = get_job(F, kind, j, layer, ab, Wb); total += cj_items(J); }
    if (gw < total) {
        int r = gw, j = 0; CJ J = get_job(F, kind, 0, layer, ab, Wb);
        while (r >= cj_items(J)) { r -= cj_items(J); ++j; J = get_job(F, kind, j, layer, ab, Wb); }
        f32x4 w[4]; float sc[4];
        conv_load(J, r, F.lane, w, sc);
        for (int g = gw; g < total;) {
            const int gn = g + NGW; int rn = 0; CJ Jn = J; f32x4 wn[4]; float sn[4];
#pragma unroll
            for (int i = 0; i < 4; ++i) { wn[i] = (f32x4){0.f, 0.f, 0.f, 0.f}; sn[i] = 0.f; }
            if (gn < total) {
                rn = gn; int jn = 0; Jn = get_job(F, kind, 0, layer, ab, Wb);
                while (rn >= cj_items(Jn)) { rn -= cj_items(Jn); ++jn; Jn = get_job(F, kind, jn, layer, ab, Wb); }
                conv_load(Jn, rn, F.lane, wn, sn);
            }
            conv_store(J, scr, r, F.lane, w, sc);
            J = Jn; r = rn; g = gn;
#pragma unroll
            for (int i = 0; i < 4; ++i) { w[i] = wn[i]; sc[i] = sn[i]; }
        }
    }
    if (kind == 1) {
        bf16* WT = Wb + W_L2 / 2; const float* w2 = inptr(F, I_W2); const float* a2 = inptr(F, I_A2); const float* g2 = inptr(F, I_G2);
        for (int idx = (F.vcu * NWAVES + F.wave) * 64 + F.lane; idx < 48 * NL2; idx += F.G * NWAVES * 64) {
            const int c = idx / NL2, n = idx % NL2, type = n >> 10, jj = n & 1023;
            const float* src = nullptr;
            if (type == 0 && c < 8) src = w2 + (size_t)(8 * c) * D + jj;
            else if (type == 1 && c >= 8 && c < 16) src = a2 + (size_t)(8 * (c - 8)) * D + jj;
            else if (type == 2 && c >= 16 && c < 36) src = g2 + (size_t)(8 * (c - 16)) * D + jj;
            float v[8];
#pragma unroll
            for (int e = 0; e < 8; ++e) v[e] = src ? src[(size_t)e * D] : 0.f;
            *(GAS v4u*)(WT + (size_t)n * KL2 + 8 * c) = pack8(v);
        }
    }
}

template <int MODE>
__device__ __forceinline__ void norm_finish(const int m, f32x4 (&v)[4], const f32x4 (&gv)[4], bf16* dst, const float* shift_in, float* out, const int lane) {
    const bool samp = m >= MP;
    float ss = 0.f;
#pragma unroll
    for (int j = 0; j < 4; ++j) ss += (v[j].x * v[j].x + v[j].y * v[j].y) + (v[j].z * v[j].z + v[j].w * v[j].w);
    const float r = 1.0f / sqrtf(wave_sum(ss) * (1.f / D) + NORM_EPS);
#pragma unroll
    for (int j = 0; j < 4; ++j) v[j] = v[j] * r * gv[j];
    if (MODE == 2) {
#pragma unroll
        for (int j = 0; j < 4; ++j) *(f32x4*)(out + O_Y + (size_t)m * D + 512 * (j >> 1) + 8 * lane + 4 * (j & 1)) = v[j];
    } else if (MODE == 0) {
#pragma unroll
        for (int j = 0; j < 2; ++j) st8bf(dst + (size_t)m * D + 512 * j + 8 * lane, v[2 * j], v[2 * j + 1]);
    } else {
        int t, b; bool first, last;
        if (!samp) { t = m & (PT - 1); b = m >> 11; first = t == 0; last = t == PT - 1; } else { const int mm = m - MP; t = mm & 3; b = mm >> 2; first = t == 0; last = t == 3; }
#pragma unroll
        for (int j = 0; j < 2; ++j) { const int eo = 512 * j + 8 * lane;
            st8bf(dst + (size_t)m * (2 * D) + eo, v[2 * j], v[2 * j + 1]);
            if (!last) st8bf(dst + (size_t)(m + 1) * (2 * D) + D + eo, v[2 * j], v[2 * j + 1]);
            else { float* so = out + (samp ? O_S_SHIFT : O_P_SHIFT) + (size_t)b * D + eo; *(f32x4*)so = v[2 * j]; *(f32x4*)(so + 4) = v[2 * j + 1]; }
            if (first) { f32x4 s0 = {0.f, 0.f, 0.f, 0.f}, s1 = s0;
                if (samp) { s0 = *(const f32x4*)(shift_in + (size_t)b * D + eo); s1 = *(const f32x4*)(shift_in + (size_t)b * D + eo + 4); }
                st8bf(dst + (size_t)m * (2 * D) + D + eo, s0, s1); }
        }
    }
}
template <bool F32>
__device__ __forceinline__ void row_load(const void* src, const size_t row, const int lane, f32x4 (&v)[4]) {
    if (F32) { const float* p = (const float*)src + row * D;
#pragma unroll
        for (int j = 0; j < 4; ++j) v[j] = *(const f32x4*)(p + 512 * (j >> 1) + 8 * lane + 4 * (j & 1));
    } else { const bf16* p = (const bf16*)src + row * D;
#pragma unroll
        for (int j = 0; j < 2; ++j) ld8bf(p + 512 * j + 8 * lane, v[2 * j], v[2 * j + 1]); }
}
template <int NS>
__device__ __forceinline__ void samp_row_fold(const float* slab, const int ms, const float coef, const int lane, f32x4 (&v)[4]) {
#pragma unroll
    for (int h = 0; h < 2; ++h) {
        f32x4 t[NS > 0 ? NS : 1][2];
#pragma unroll
        for (int s = 0; s < NS; ++s)
#pragma unroll
            for (int jj = 0; jj < 2; ++jj) t[s][jj] = *(const f32x4*)(slab + ((size_t)s * MS + ms) * D + 512 * h + 8 * lane + 4 * jj);
#pragma unroll
        for (int jj = 0; jj < 2; ++jj)
#pragma unroll
            for (int s = 0; s < NS; ++s) v[2 * h + jj] += t[s][jj] * coef;
    }
}
template <int MODE, bool PF32, bool SF32>
__device__ __forceinline__ void norm_rows(const Frame& F, const void* base_p, const void* base_s, int nslab, float coef, const float* slab, bf16* xr,
                                          const float* gain, bf16* dst, const float* shift_in, float* out, const int pvar = 0) {
    const int gw = F.vcu * NWAVES + F.wave, NGW = F.G * NWAVES, lane = F.lane;
    f32x4 gv[4];
#pragma unroll
    for (int j = 0; j < 4; ++j) gv[j] = *(const f32x4*)(gain + 512 * (j >> 1) + 8 * lane + 4 * (j & 1));
    for (int s = F.wave * F.G + F.vcu; s < MS; s += NWAVES * F.G) {
        const int m = MP + s; f32x4 v[4];
        row_load<SF32>(base_s, (size_t)s, lane, v);
        if (nslab == 11) samp_row_fold<11>(slab, s, coef, lane, v); else if (nslab == 4) samp_row_fold<4>(slab, s, coef, lane, v);
        if (nslab > 0 && MODE != 2 && pvar == 0) {
#pragma unroll
            for (int j = 0; j < 2; ++j) st8bf(xr + (size_t)m * D + 512 * j + 8 * lane, v[2 * j], v[2 * j + 1]); }
        norm_finish<MODE>(m, v, gv, dst, shift_in, out, lane);
    }
    int m = gw; f32x4 v[4];
    if (m < MP) row_load<PF32>(base_p, (size_t)m, lane, v);
    while (m < MP) {
        const int mn = m + NGW; f32x4 vn[4];
#pragma unroll
        for (int j = 0; j < 4; ++j) vn[j] = (f32x4){0.f, 0.f, 0.f, 0.f};
        if (mn < MP) row_load<PF32>(base_p, (size_t)mn, lane, vn);
        norm_finish<MODE>(m, v, gv, dst, shift_in, out, lane);
#pragma unroll
        for (int j = 0; j < 4; ++j) v[j] = vn[j];
        m = mn;
    }
}

constexpr int RW_KK = 0, RW_DD = 4096, RW_BB = 8192, RW_KP = 12288, RW_RR = 16384, RW_VV = 20480, RW_YY = 24576;
__device__ __forceinline__ void rwkv_chain(const Frame& F, int row0, int T, int h, const float* S0, float* ST,
                                           const bf16* Rb, const bf16* Kb, const bf16* Vb, const bf16* Db, const bf16* Ab, bf16* Gb,
                                           const float* k_k, const float* k_a, const float* r_k, const float* gn_w, const float* gn_b, const bool do_store, const int pvar) {
    LAS float* L = (LAS float*)F.lds;
    const int tid = F.tid, lane = F.lane, w = F.wave;
    const int cg = tid & 7, tt = tid >> 3;
    const int srow = 8 * w + (lane >> 3);
    float S[8];
    if (S0) { const f32x4 a = *(const f32x4*)(S0 + srow * 64 + 8 * cg), b = *(const f32x4*)(S0 + srow * 64 + 8 * cg + 4);
        S[0] = a.x; S[1] = a.y; S[2] = a.z; S[3] = a.w; S[4] = b.x; S[5] = b.y; S[6] = b.z; S[7] = b.w; }
    else {
#pragma unroll
        for (int j = 0; j < 8; ++j) S[j] = 0.f; }
    const int ch = h * 64 + 8 * cg;
    float ckk[8], cka[8], crk[8], cgw[8], cgb[8];
#pragma unroll
    for (int j = 0; j < 8; ++j) { ckk[j] = k_k[ch + j]; cka[j] = k_a[ch + j]; crk[j] = r_k[ch + j]; cgw[j] = gn_w[ch + j]; cgb[j] = gn_b[ch + j]; }
    const int nch = (T + 63) >> 6;
    v4u pr = {0, 0, 0, 0}, pk = pr, pv = pr, pd = pr, pa = pr, pg = pr;
    { const int nt0 = T < 64 ? T : 64;
      if (tt < nt0) { const size_t off = (size_t)(row0 + tt) * D + ch;
          pr = *(const v4u*)(Rb + off); pk = *(const v4u*)(Kb + off); pv = *(const v4u*)(Vb + off); pd = *(const v4u*)(Db + off); pa = *(const v4u*)(Ab + off); pg = *(const v4u*)(Gb + off); } }
    float bon = 0.f, vv[8], gg[8];
    for (int c = 0; c < nch; ++c) {
        const int nt = (T - 64 * c) < 64 ? (T - 64 * c) : 64;
        const bool valid = tt < nt;
        {
            float r8[8], k8[8], d8[8], a8[8];
            unpack8(pr, r8); unpack8(pk, k8); unpack8(pv, vv); unpack8(pd, d8); unpack8(pa, a8); unpack8(pg, gg);
            float kk[8], ss = 0.f;
#pragma unroll
            for (int j = 0; j < 8; ++j) { kk[j] = k8[j] * ckk[j]; ss += kk[j] * kk[j]; }
            ss = red8(ss);
            const float inv = __builtin_amdgcn_rsqf(fmaxf(ss, 1e-24f));
            float kp[8], bsum = 0.f;
#pragma unroll
            for (int j = 0; j < 8; ++j) { kk[j] *= inv; kp[j] = k8[j] * (1.f + (a8[j] - 1.f) * cka[j]); bsum += r8[j] * kp[j] * crk[j]; }
            bon = red8(bsum);
            if (valid) {
                LAS float* p = L + tt * 64 + 8 * cg;
                *(LAS f32x4*)(p + RW_KK) = (f32x4){-kk[0], -kk[1], -kk[2], -kk[3]}; *(LAS f32x4*)(p + RW_KK + 4) = (f32x4){-kk[4], -kk[5], -kk[6], -kk[7]};
                *(LAS f32x4*)(p + RW_DD) = (f32x4){1.f - d8[0], 1.f - d8[1], 1.f - d8[2], 1.f - d8[3]}; *(LAS f32x4*)(p + RW_DD + 4) = (f32x4){1.f - d8[4], 1.f - d8[5], 1.f - d8[6], 1.f - d8[7]};
                *(LAS f32x4*)(p + RW_BB) = (f32x4){kk[0] * a8[0], kk[1] * a8[1], kk[2] * a8[2], kk[3] * a8[3]}; *(LAS f32x4*)(p + RW_BB + 4) = (f32x4){kk[4] * a8[4], kk[5] * a8[5], kk[6] * a8[6], kk[7] * a8[7]};
                *(LAS f32x4*)(p + RW_KP) = (f32x4){kp[0], kp[1], kp[2], kp[3]}; *(LAS f32x4*)(p + RW_KP + 4) = (f32x4){kp[4], kp[5], kp[6], kp[7]};
                *(LAS f32x4*)(p + RW_RR) = (f32x4){r8[0], r8[1], r8[2], r8[3]}; *(LAS f32x4*)(p + RW_RR + 4) = (f32x4){r8[4], r8[5], r8[6], r8[7]};
                *(LAS f32x4*)(p + RW_VV) = (f32x4){vv[0], vv[1], vv[2], vv[3]}; *(LAS f32x4*)(p + RW_VV + 4) = (f32x4){vv[4], vv[5], vv[6], vv[7]};
            }
        }
        __syncthreads();
        if (c + 1 < nch) { const int nt1 = (T - 64 * (c + 1)) < 64 ? (T - 64 * (c + 1)) : 64;
            if (tt < nt1) { const size_t off = (size_t)(row0 + 64 * (c + 1) + tt) * D + ch;
                pr = *(const v4u*)(Rb + off); pk = *(const v4u*)(Kb + off); pv = *(const v4u*)(Vb + off); pd = *(const v4u*)(Db + off); pa = *(const v4u*)(Ab + off); pg = *(const v4u*)(Gb + off); } }
        {
            typedef float f2 __attribute__((ext_vector_type(2)));
            f2 S2[4] = {{S[0], S[1]}, {S[2], S[3]}, {S[4], S[5]}, {S[6], S[7]}};
            const LAS float* p = L + 8 * cg;
            LAS float* yw = L + RW_YY + srow;
            const LAS float* vp = L + RW_VV + srow;
#define RW_LD(N, Dd, B, Q, R, VR, t_) do { const LAS float* p_ = p + (t_) * 64; \
                N[0] = *(const LAS f32x4*)(p_ + RW_KK); N[1] = *(const LAS f32x4*)(p_ + RW_KK + 4); Dd[0] = *(const LAS f32x4*)(p_ + RW_DD); Dd[1] = *(const LAS f32x4*)(p_ + RW_DD + 4); \
                B[0] = *(const LAS f32x4*)(p_ + RW_BB); B[1] = *(const LAS f32x4*)(p_ + RW_BB + 4); Q[0] = *(const LAS f32x4*)(p_ + RW_KP); Q[1] = *(const LAS f32x4*)(p_ + RW_KP + 4); \
                R[0] = *(const LAS f32x4*)(p_ + RW_RR); R[1] = *(const LAS f32x4*)(p_ + RW_RR + 4); VR = vp[(t_) * 64]; } while (0)
#define RW_STEP(N, Dd, B, Q, R, VR, t_) do { \
                f2 a_ = S2[0] * (f2){N[0].x, N[0].y}; a_ = S2[1] * (f2){N[0].z, N[0].w} + a_; a_ = S2[2] * (f2){N[1].x, N[1].y} + a_; a_ = S2[3] * (f2){N[1].z, N[1].w} + a_; \
                const float sa_ = red8(a_.x + a_.y); const f2 sv_ = {sa_, sa_}, vv_ = {VR, VR}; \
                S2[0] = S2[0] * (f2){Dd[0].x, Dd[0].y} + (sv_ * (f2){B[0].x, B[0].y} + vv_ * (f2){Q[0].x, Q[0].y}); \
                S2[1] = S2[1] * (f2){Dd[0].z, Dd[0].w} + (sv_ * (f2){B[0].z, B[0].w} + vv_ * (f2){Q[0].z, Q[0].w}); \
                S2[2] = S2[2] * (f2){Dd[1].x, Dd[1].y} + (sv_ * (f2){B[1].x, B[1].y} + vv_ * (f2){Q[1].x, Q[1].y}); \
                S2[3] = S2[3] * (f2){Dd[1].z, Dd[1].w} + (sv_ * (f2){B[1].z, B[1].w} + vv_ * (f2){Q[1].z, Q[1].w}); \
                f2 y_ = S2[0] * (f2){R[0].x, R[0].y}; y_ = S2[1] * (f2){R[0].z, R[0].w} + y_; y_ = S2[2] * (f2){R[1].x, R[1].y} + y_; y_ = S2[3] * (f2){R[1].z, R[1].w} + y_; \
                yw[(t_) * 64] = red8(y_.x + y_.y); } while (0)
            f32x4 nA[2], dA[2], bA[2], qA[2], rA[2]; float vA;
            for (int t = 0; t < nt; ++t) { RW_LD(nA, dA, bA, qA, rA, vA, t); RW_STEP(nA, dA, bA, qA, rA, vA, t); }
#undef RW_LD
#undef RW_STEP
            S[0] = S2[0].x; S[1] = S2[0].y; S[2] = S2[1].x; S[3] = S2[1].y; S[4] = S2[2].x; S[5] = S2[2].y; S[6] = S2[3].x; S[7] = S2[3].y;
        }
        __syncthreads();
        if (pvar != 4) {
            f32x4 y0 = {0.f, 0.f, 0.f, 0.f}, y1 = y0;
            if (valid) { y0 = *(const LAS f32x4*)(L + RW_YY + tt * 64 + 8 * cg); y1 = *(const LAS f32x4*)(L + RW_YY + tt * 64 + 8 * cg + 4); }
            float yy[8] = {y0.x, y0.y, y0.z, y0.w, y1.x, y1.y, y1.z, y1.w};
            float s1 = 0.f;
#pragma unroll
            for (int j = 0; j < 8; ++j) s1 += yy[j];
            const float mean = red8(s1) * (1.f / 64.f);
            float s2 = 0.f;
#pragma unroll
            for (int j = 0; j < 8; ++j) { yy[j] -= mean; s2 += yy[j] * yy[j]; }
            const float rstd = __builtin_amdgcn_rsqf(red8(s2) * (1.f / 64.f) + GN_EPS);
            float o[8];
#pragma unroll
            for (int j = 0; j < 8; ++j) o[j] = ((yy[j] * rstd) * cgw[j] + cgb[j] + bon * vv[j]) * gg[j];
            if (valid && do_store) *(v4u*)(Gb + (size_t)(row0 + 64 * c + tt) * D + ch) = pack8(o);
        }
    }
    *(f32x4*)(ST + srow * 64 + 8 * cg) = (f32x4){S[0], S[1], S[2], S[3]}; *(f32x4*)(ST + srow * 64 + 8 * cg + 4) = (f32x4){S[4], S[5], S[6], S[7]};
    __syncthreads();
}

constexpr int RH_TC = 32, RH_BUF = 12288;
constexpr int RH_KK = 0, RH_DD = 2048, RH_BB = 4096, RH_KP = 6144, RH_RR = 8192, RH_VV = 10240, RH_YY = 11264;
__device__ __forceinline__ void rwkv_half_chain(const Frame& F, int b, int h, int half, float* ST, const bf16* Rb, const bf16* Kb, const bf16* Vb, const bf16* Db, const bf16* Ab,
                                                bf16* YRAW, float* BON, const float* k_k, const float* k_a, const float* r_k, const int pvar) {
    LAS float* L = (LAS float*)F.lds;
    const int tid = F.tid, lane = F.lane, w = F.wave, row0 = b * PT;
    constexpr int nch = PT / RH_TC;
    if (w < 4) {
        const int srow = 8 * w + (lane >> 3), cq = lane & 7;
        f32x4 S4 = {0.f, 0.f, 0.f, 0.f}, S5 = S4;
        __syncthreads();
        __builtin_amdgcn_s_setprio(3);
        for (int c = 0; c < nch; ++c) {
            const LAS float* p = L + (c & 1) * RH_BUF + 8 * cq;
            LAS float* yw = L + (c & 1) * RH_BUF + RH_YY + srow;
            const LAS float* vp = L + (c & 1) * RH_BUF + RH_VV + srow;
#define RH_LD(N, Dd, B, Q, R, VR, t_) do { const LAS float* p_ = p + (t_) * 64; \
                N[0] = *(const LAS f32x4*)(p_ + RH_KK); N[1] = *(const LAS f32x4*)(p_ + RH_KK + 4); Dd[0] = *(const LAS f32x4*)(p_ + RH_DD); Dd[1] = *(const LAS f32x4*)(p_ + RH_DD + 4); \
                B[0] = *(const LAS f32x4*)(p_ + RH_BB); B[1] = *(const LAS f32x4*)(p_ + RH_BB + 4); Q[0] = *(const LAS f32x4*)(p_ + RH_KP); Q[1] = *(const LAS f32x4*)(p_ + RH_KP + 4); \
                R[0] = *(const LAS f32x4*)(p_ + RH_RR); R[1] = *(const LAS f32x4*)(p_ + RH_RR + 4); VR = vp[(t_) * 32]; } while (0)
#define RH_STEP(N, Dd, B, Q, R, VR, t_) do { \
                const f32x4 pa_ = S4 * N[0] + S5 * N[1]; const float sa_ = red8((pa_.x + pa_.y) + (pa_.z + pa_.w)); \
                S4 = S4 * Dd[0] + (B[0] * sa_ + Q[0] * VR); S5 = S5 * Dd[1] + (B[1] * sa_ + Q[1] * VR); \
                const f32x4 ya_ = S4 * R[0] + S5 * R[1]; yw[(t_) * 32] = red8((ya_.x + ya_.y) + (ya_.z + ya_.w)); } while (0)
            f32x4 nA[2], dA[2], bA[2], qA[2], rA[2], nB[2], dB[2], bB[2], qB[2], rB[2]; float vA, vB;
            RH_LD(nA, dA, bA, qA, rA, vA, 0);
            if (pvar != 3)
            for (int t = 0; t < RH_TC; t += 2) {
                RH_LD(nB, dB, bB, qB, rB, vB, t + 1);
                RH_STEP(nA, dA, bA, qA, rA, vA, t);
                RH_LD(nA, dA, bA, qA, rA, vA, (t + 2 < RH_TC ? t + 2 : t + 1));
                RH_STEP(nB, dB, bB, qB, rB, vB, t + 1);
            }
#undef RH_LD
#undef RH_STEP
            __syncthreads();
        }
        __builtin_amdgcn_s_setprio(0);
        *(f32x4*)(ST + (32 * half + srow) * 64 + 8 * cq) = S4; *(f32x4*)(ST + (32 * half + srow) * 64 + 8 * cq + 4) = S5;
    } else {
        const int ht = tid - 256, cg = ht & 7, tt = ht >> 3;
        const int ch = h * 64 + 8 * cg, vch = h * 64 + 32 * half + 4 * cg;
        float ckk[8], cka[8], crk[8];
#pragma unroll
        for (int j = 0; j < 8; ++j) { ckk[j] = k_k[ch + j]; cka[j] = k_a[ch + j]; crk[j] = r_k[ch + j]; }
        v4u pr, pk, pd, pa; uint2 pv;
#define RH_LOAD(cc) do { const size_t off_ = (size_t)(row0 + RH_TC * (cc) + tt) * D; pr = *(const v4u*)(Rb + off_ + ch); pk = *(const v4u*)(Kb + off_ + ch); pd = *(const v4u*)(Db + off_ + ch); \
            pa = *(const v4u*)(Ab + off_ + ch); pv = *(const uint2*)(Vb + off_ + vch); } while (0)
#define RH_PREP(cc) do { float r8[8], k8[8], d8[8], a8[8]; unpack8(pr, r8); unpack8(pk, k8); unpack8(pd, d8); unpack8(pa, a8); \
            float kk[8], ss = 0.f; _Pragma("unroll") for (int j = 0; j < 8; ++j) { kk[j] = k8[j] * ckk[j]; ss += kk[j] * kk[j]; } \
            ss = red8(ss); const float inv = __builtin_amdgcn_rsqf(fmaxf(ss, 1e-24f)); \
            float kp[8], bsum = 0.f; _Pragma("unroll") for (int j = 0; j < 8; ++j) { kk[j] *= inv; kp[j] = k8[j] * (1.f + (a8[j] - 1.f) * cka[j]); bsum += r8[j] * kp[j] * crk[j]; } \
            const float bon = red8(bsum); if (half == 0 && cg == 0) BON[(size_t)(row0 + RH_TC * (cc) + tt) * 16 + h] = bon; \
            LAS float* p = L + ((cc) & 1) * RH_BUF + tt * 64 + 8 * cg; \
            *(LAS f32x4*)(p + RH_KK) = (f32x4){-kk[0], -kk[1], -kk[2], -kk[3]}; *(LAS f32x4*)(p + RH_KK + 4) = (f32x4){-kk[4], -kk[5], -kk[6], -kk[7]}; \
            *(LAS f32x4*)(p + RH_DD) = (f32x4){1.f - d8[0], 1.f - d8[1], 1.f - d8[2], 1.f - d8[3]}; *(LAS f32x4*)(p + RH_DD + 4) = (f32x4){1.f - d8[4], 1.f - d8[5], 1.f - d8[6], 1.f - d8[7]}; \
            *(LAS f32x4*)(p + RH_BB) = (f32x4){kk[0] * a8[0], kk[1] * a8[1], kk[2] * a8[2], kk[3] * a8[3]}; *(LAS f32x4*)(p + RH_BB + 4) = (f32x4){kk[4] * a8[4], kk[5] * a8[5], kk[6] * a8[6], kk[7] * a8[7]}; \
            *(LAS f32x4*)(p + RH_KP) = (f32x4){kp[0], kp[1], kp[2], kp[3]}; *(LAS f32x4*)(p + RH_KP + 4) = (f32x4){kp[4], kp[5], kp[6], kp[7]}; \
            *(LAS f32x4*)(p + RH_RR) = (f32x4){r8[0], r8[1], r8[2], r8[3]}; *(LAS f32x4*)(p + RH_RR + 4) = (f32x4){r8[4], r8[5], r8[6], r8[7]}; \
            *(LAS f32x4*)(L + ((cc) & 1) * RH_BUF + RH_VV + tt * 32 + 4 * cg) = (f32x4){bflo(pv.x), bfhi(pv.x), bflo(pv.y), bfhi(pv.y)}; } while (0)
#define RH_POST(cc) do { const f32x4 y4 = *(const LAS f32x4*)(L + ((cc) & 1) * RH_BUF + RH_YY + tt * 32 + 4 * cg); uint2 o; o.x = pkbf(y4.x, y4.y); o.y = pkbf(y4.z, y4.w); \
            *(uint2*)(YRAW + (size_t)(row0 + RH_TC * (cc) + tt) * D + vch) = o; } while (0)
        RH_LOAD(0); RH_PREP(0); RH_LOAD(1);
        __syncthreads();
        for (int c = 0; c < nch; ++c) {
            if (c > 0) RH_POST(c - 1);
            if (c + 1 < nch) { RH_PREP(c + 1); if (c + 2 < nch) RH_LOAD(c + 2); }
            __syncthreads();
        }
        RH_POST(nch - 1);
#undef RH_LOAD
#undef RH_PREP
#undef RH_POST
    }
    __syncthreads();
}
__device__ __forceinline__ void rwkv_finish(const Frame& F, const bf16* YRAW, const float* BON, const bf16* Vb, bf16* Gb, const float* gn_w, const float* gn_b) {
    const int gt = (F.vcu * NWAVES + F.wave) * 64 + F.lane, NT = F.G * NWAVES * 64;
    for (int task = gt; task < MP * 128; task += NT) {
        const int cg = task & 7, hh = (task >> 3) & 15, row = task >> 7; const size_t off = (size_t)row * D + hh * 64 + 8 * cg;
        float yy[8], vv[8], gg[8]; unpack8(*(const v4u*)(YRAW + off), yy); unpack8(*(const v4u*)(Vb + off), vv); unpack8(*(const v4u*)(Gb + off), gg);
        const float bon = BON[(size_t)row * 16 + hh];
        float s1 = 0.f;
#pragma unroll
        for (int j = 0; j < 8; ++j) s1 += yy[j];
        const float mean = red8(s1) * (1.f / 64.f);
        float s2 = 0.f;
#pragma unroll
        for (int j = 0; j < 8; ++j) { yy[j] -= mean; s2 += yy[j] * yy[j]; }
        const float rstd = __builtin_amdgcn_rsqf(red8(s2) * (1.f / 64.f) + GN_EPS);
        const f32x4 w0 = *(const f32x4*)(gn_w + hh * 64 + 8 * cg), w1 = *(const f32x4*)(gn_w + hh * 64 + 8 * cg + 4), b0 = *(const f32x4*)(gn_b + hh * 64 + 8 * cg), b1 = *(const f32x4*)(gn_b + hh * 64 + 8 * cg + 4);
        const float gw[8] = {w0.x, w0.y, w0.z, w0.w, w1.x, w1.y, w1.z, w1.w}, gb[8] = {b0.x, b0.y, b0.z, b0.w, b1.x, b1.y, b1.z, b1.w};
        float o[8];
#pragma unroll
        for (int j = 0; j < 8; ++j) o[j] = ((yy[j] * rstd) * gw[j] + gb[j] + bon * vv[j]) * gg[j];
        *(v4u*)(Gb + off) = pack8(o);
    }
}

constexpr int PBY = 144;
constexpr int RPY = 272;
constexpr int ML_RQK = 0, ML_S = 0, ML_KT = 9216, ML_RV = 18432, ML_Q = 35840, ML_K = 45056, ML_HB = 35840, ML_VT = 54272, ML_C = 72704, ML_F = 91136;
constexpr int MF_N = 0, MF_QN = 64, MF_RS = 128, MF_HS = 256, MF_CW = 384, MF_B63 = 1024, MF_P63 = 1056, MF_MC = 1088  , MF_GB = 1152, MF_GP = MF_GB + 2048, MF_GA = MF_GP + 2048;
typedef __attribute__((address_space(3))) unsigned short lds_u16;
#define MFMA16(a, b, c) __builtin_amdgcn_mfma_f32_16x16x32_bf16((a), (b), (c), 0, 0, 0)
__device__ __forceinline__ void mlstm_prompt_chain(const Frame& F, int b, int hh, const bf16* QKR, const bf16* VVb, const bf16* OOb, const float* IFb, bf16* HOb,
                                                   const float* conv_w, const float* conv_b, const float* norm_w, float* out, const int pvar) {
    LAS unsigned char* lds = F.lds; LAS float* Fl = (LAS float*)(lds + ML_F);
    const int tid = F.tid, lane = F.lane, w = F.wave, fr = lane & 15, fq = lane >> 4;
    for (int i = tid; i < 128 * 72; i += 512) ((lds_u16*)(lds + ML_C))[i] = 0;
    if (tid < 64) Fl[MF_N + tid] = 0.f;
    for (int i = tid; i < 640; i += 512) { const int j = i >> 7, c = i & 127, gc = c < 64 ? hh * 64 + c : 512 + hh * 64 + (c - 64); Fl[MF_CW + i] = j < 4 ? conv_w[j * D + gc] : conv_b[gc]; }
    f32x4 Cacc[4];
#pragma unroll
    for (int k = 0; k < 4; ++k) Cacc[k] = (f32x4){0.f, 0.f, 0.f, 0.f};
    const int og = tid & 15, ot = tid >> 4;
    float nw[8];
#pragma unroll
    for (int e = 0; e < 8; ++e) nw[e] = norm_w[hh * 128 + 8 * og + e];
    v4u rq[3], rv[2], ro[2];
#define ML_LOAD_QKV(cc) do { const int rowc_ = b * PT + 64 * (cc); \
        _Pragma("unroll") for (int i = 0; i < 3; ++i) { const int q = tid + 512 * i, r = q >> 4, j = q & 15, tok = 64 * (cc) - 3 + r; rq[i] = (v4u){0u, 0u, 0u, 0u}; \
            if (q < 67 * 16 && tok >= 0) rq[i] = *(const v4u*)(QKR + (size_t)(b * PT + tok) * D + (j < 8 ? hh * 64 + 8 * j : 512 + hh * 64 + 8 * (j - 8))); } \
        _Pragma("unroll") for (int i = 0; i < 2; ++i) rv[i] = *(const v4u*)(VVb + (size_t)(rowc_ + ot + 32 * i) * D + hh * 128 + 8 * og); \
        } while (0)
#define ML_LOAD_O(cc) do { const int rowc_ = b * PT + 64 * (cc); \
        _Pragma("unroll") for (int i = 0; i < 2; ++i) ro[i] = *(const v4u*)(OOb + (size_t)(rowc_ + ot + 32 * i) * D + hh * 128 + 8 * og); } while (0)
    ML_LOAD_QKV(0);
#pragma unroll
    for (int q = 0; q < 4; ++q) { const int cc = w + 8 * q; const size_t ro_ = (size_t)(b * PT + 64 * cc + lane) * 16;
        const float li = IFb[ro_ + hh], lf = IFb[ro_ + 8 + hh];
        float bc = lf;
#pragma unroll
        for (int o = 1; o < 64; o <<= 1) { const float x = __shfl_up(bc, o); if (lane >= o) bc += x; }
        const float av = li - bc; float pm = av;
#pragma unroll
        for (int o = 1; o < 64; o <<= 1) { const float x = __shfl_up(pm, o); if (lane >= o) pm = fmaxf(pm, x); }
        Fl[MF_GB + cc * 64 + lane] = bc; Fl[MF_GP + cc * 64 + lane] = pm; Fl[MF_GA + cc * 64 + lane] = av;
        if (lane == 63) { Fl[MF_B63 + cc] = bc; Fl[MF_P63 + cc] = pm; } }
    __syncthreads();
    if (tid == 0) { float mm = 0.f;
        for (int cc = 0; cc < PT / 64; ++cc) { Fl[MF_MC + cc] = mm; const float b6 = Fl[MF_B63 + cc]; mm = fmaxf(b6 + mm, b6 + Fl[MF_P63 + cc]); }
        Fl[MF_MC + PT / 64] = mm; }
    __syncthreads();
    constexpr int NC = PT / 64;
    for (int c = 0; c < NC; ++c) {
        const int rowc = b * PT + 64 * c;
        const float m_c = Fl[MF_MC + c], m_n = Fl[MF_MC + c + 1], b63 = Fl[MF_B63 + c];
#pragma unroll
        for (int i = 0; i < 3; ++i) { const int q = tid + 512 * i; if (q < 67 * 16) *(LAS v4u*)(lds + ML_RQK + (q >> 4) * RPY + 16 * (q & 15)) = rq[i]; }
#pragma unroll
        for (int i = 0; i < 2; ++i) *(LAS v4u*)(lds + ML_RV + (ot + 32 * i) * RPY + 16 * og) = rv[i];
        if (c + 1 < NC) ML_LOAD_QKV(c + 1);
        ML_LOAD_O(c);
        __syncthreads();
        float kreg[8] = {0.f, 0.f, 0.f, 0.f, 0.f, 0.f, 0.f, 0.f};
        if (pvar != 3)
#pragma unroll
        for (int i = 0; i < 2; ++i) {
            const int g = w + 8 * i, t = lane;
            float x[4][8];
#pragma unroll
            for (int j = 0; j < 4; ++j) unpack8(*(const LAS v4u*)(lds + ML_RQK + (t + j) * RPY + 16 * g), x[j]);
            float val[8];
#pragma unroll
            for (int h2 = 0; h2 < 2; ++h2) { f32x4 a = *(const LAS f32x4*)(Fl + MF_CW + 4 * 128 + 8 * g + 4 * h2);
#pragma unroll
                for (int j = 0; j < 4; ++j) { const f32x4 cw = *(const LAS f32x4*)(Fl + MF_CW + j * 128 + 8 * g + 4 * h2);
                    a.x += cw.x * x[j][4 * h2]; a.y += cw.y * x[j][4 * h2 + 1]; a.z += cw.z * x[j][4 * h2 + 2]; a.w += cw.w * x[j][4 * h2 + 3]; }
                val[4 * h2] = siluf_(a.x); val[4 * h2 + 1] = siluf_(a.y); val[4 * h2 + 2] = siluf_(a.z); val[4 * h2 + 3] = siluf_(a.w); }
            if (i == 0) {
#pragma unroll
                for (int e = 0; e < 8; ++e) val[e] *= 0.125f;
                *(LAS v4u*)(lds + ML_Q + t * PBY + 16 * w) = pack8(val);
            } else { *(LAS v4u*)(lds + ML_K + t * PBY + 16 * w) = pack8(val);
#pragma unroll
                for (int e = 0; e < 8; ++e) kreg[e] = val[e]; }
            const v4u vw = *(const LAS v4u*)(lds + ML_RV + t * RPY + 16 * g);
            lds_u16* vt = (lds_u16*)(lds + ML_VT) + (8 * g) * 72 + t;
            vt[0 * 72] = (unsigned short)(vw.x & 0xffffu); vt[1 * 72] = (unsigned short)(vw.x >> 16); vt[2 * 72] = (unsigned short)(vw.y & 0xffffu); vt[3 * 72] = (unsigned short)(vw.y >> 16);
            vt[4 * 72] = (unsigned short)(vw.z & 0xffffu); vt[5 * 72] = (unsigned short)(vw.z >> 16); vt[6 * 72] = (unsigned short)(vw.w & 0xffffu); vt[7 * 72] = (unsigned short)(vw.w >> 16);
        }
        __syncthreads();
        if (pvar != 4) {
        { const float wsv = __expf(b63 + Fl[MF_GA + c * 64 + lane] - m_n); lds_u16* kt = (lds_u16*)(lds + ML_KT) + (8 * w) * 72 + lane;
#pragma unroll
          for (int e = 0; e < 8; ++e) kt[e * 72] = f2bf1(kreg[e] * wsv); }
        { const int tq = tid >> 3, p = tid & 7; float q8[8]; unpack8(*(const LAS v4u*)(lds + ML_Q + tq * PBY + 16 * p), q8);
          float dsum = 0.f;
#pragma unroll
          for (int e = 0; e < 8; ++e) dsum += q8[e] * Fl[MF_N + 8 * p + e];
          dsum = red8(dsum); if (p == 0) Fl[MF_QN + tq] = dsum; }
        { const int ti = w >> 1, t = 16 * ti + fr; float rsum = 0.f; const float mxt = fmaxf(m_c, Fl[MF_GP + c * 64 + t]);
          typedef unsigned u2v_ __attribute__((ext_vector_type(2)));
#pragma unroll
          for (int jj = 0; jj < 2; ++jj) { const int sj = 2 * (w & 1) + jj; f32x4 acc = {0.f, 0.f, 0.f, 0.f};
#pragma unroll
              for (int ks = 0; ks < 2; ++ks) { const bf16x8 a = *(const LAS bf16x8*)(lds + ML_Q + (16 * ti + fr) * PBY + ks * 64 + fq * 16), bb = *(const LAS bf16x8*)(lds + ML_K + (16 * sj + fr) * PBY + ks * 64 + fq * 16);
                  acc = MFMA16(bb, a, acc); }
              const f32x4 av4 = *(const LAS f32x4*)(Fl + MF_GA + c * 64 + 16 * sj + 4 * fq);
#pragma unroll
              for (int r = 0; r < 4; ++r) { const int s_ = 16 * sj + 4 * fq + r; const float val = s_ <= t ? acc[r] * __expf(av4[r] - mxt) : 0.f; acc[r] = val; rsum += val; }
              u2v_ pw; pw.x = pkbf(acc[0], acc[1]); pw.y = pkbf(acc[2], acc[3]);
              *(LAS u2v_*)(lds + ML_S + (t * 72 + 16 * sj + 4 * fq) * 2) = pw; }
          rsum += __shfl_xor(rsum, 16); rsum += __shfl_xor(rsum, 32);
          if (fq == 0) Fl[MF_RS + t * 2 + (w & 1)] = rsum; }
        }
        __syncthreads();
        float hv[4][4] = {};
        if (pvar != 5) { const int ti = w & 3, t = 16 * ti + fr;
          const float mx = fmaxf(m_c, Fl[MF_GP + c * 64 + t]), wi = __expf(m_c - mx), ei = __expf(-(Fl[MF_GB + c * 64 + t] + mx));
          const float rden = __builtin_amdgcn_rcpf(fmaxf(fabsf(wi * Fl[MF_QN + t] + Fl[MF_RS + 2 * t] + Fl[MF_RS + 2 * t + 1]), ei)); float hq = 0.f;
#pragma unroll
          for (int i = 0; i < 4; ++i) { const int vt = 4 * (w >> 2) + i; f32x4 accA = {0.f, 0.f, 0.f, 0.f}, accB = accA;
#pragma unroll
              for (int ks = 0; ks < 2; ++ks) {
                  const bf16x8 aq = *(const LAS bf16x8*)(lds + ML_Q + (16 * ti + fr) * PBY + ks * 64 + fq * 16), bc = *(const LAS bf16x8*)(lds + ML_C + (16 * vt + fr) * PBY + ks * 64 + fq * 16);
                  accA = MFMA16(bc, aq, accA);
                  const bf16x8 as = *(const LAS bf16x8*)(lds + ML_S + (16 * ti + fr) * PBY + ks * 64 + fq * 16), bv = *(const LAS bf16x8*)(lds + ML_VT + (16 * vt + fr) * PBY + ks * 64 + fq * 16);
                  accB = MFMA16(bv, as, accB); }
#pragma unroll
              for (int r = 0; r < 4; ++r) { const float hh_ = (wi * accA[r] + accB[r]) * rden; hv[i][r] = hh_; hq += hh_ * hh_; } }
          hq += __shfl_xor(hq, 16); hq += __shfl_xor(hq, 32);
          if (fq == 0) Fl[MF_HS + t * 2 + (w >> 2)] = hq; }
        __syncthreads();
        if (pvar != 6) {
        { const int ti = w & 3, t = 16 * ti + fr; const float sc = __builtin_amdgcn_rsqf((Fl[MF_HS + 2 * t] + Fl[MF_HS + 2 * t + 1]) * (1.f / 128.f) + NORM_EPS);
          typedef unsigned u2v_ __attribute__((ext_vector_type(2)));
#pragma unroll
          for (int i = 0; i < 4; ++i) { u2v_ pw; pw.x = pkbf(hv[i][0] * sc, hv[i][1] * sc); pw.y = pkbf(hv[i][2] * sc, hv[i][3] * sc);
              *(LAS u2v_*)(lds + ML_HB + t * RPY + (16 * (4 * (w >> 2) + i) + 4 * fq) * 2) = pw; } }
        { const float wst = __expf(b63 + m_c - m_n);
          typedef unsigned u2v_ __attribute__((ext_vector_type(2)));
#pragma unroll
          for (int kt = 0; kt < 4; ++kt) { Cacc[kt] = Cacc[kt] * wst;
#pragma unroll
              for (int ks = 0; ks < 2; ++ks) { const bf16x8 a = *(const LAS bf16x8*)(lds + ML_VT + (16 * w + fr) * PBY + ks * 64 + fq * 16), bb = *(const LAS bf16x8*)(lds + ML_KT + (16 * kt + fr) * PBY + ks * 64 + fq * 16);
                  Cacc[kt] = MFMA16(bb, a, Cacc[kt]); }
              u2v_ pw; pw.x = pkbf(Cacc[kt][0], Cacc[kt][1]); pw.y = pkbf(Cacc[kt][2], Cacc[kt][3]);
              *(LAS u2v_*)(lds + ML_C + ((16 * w + fr) * 72 + 16 * kt + 4 * fq) * 2) = pw; }
          if (w == 0) { float sum = 0.f;
#pragma unroll
              for (int q = 0; q < 8; ++q) { float k8[8]; unpack8(*(const LAS v4u*)(lds + ML_KT + lane * PBY + 16 * q), k8);
#pragma unroll
                  for (int e = 0; e < 8; ++e) sum += k8[e]; }
              Fl[MF_N + lane] = wst * Fl[MF_N + lane] + sum; } }
        }
        __syncthreads();
        if (pvar != 7)
#pragma unroll
        for (int i = 0; i < 2; ++i) { const int t = ot + 32 * i; float h8[8], o8[8]; unpack8(*(const LAS v4u*)(lds + ML_HB + t * RPY + 16 * og), h8); unpack8(ro[i], o8);
#pragma unroll
            for (int e = 0; e < 8; ++e) h8[e] = h8[e] * nw[e] * o8[e];
            *(v4u*)(HOb + (size_t)(rowc + t) * D + hh * 128 + 8 * og) = pack8(h8); }
    }
#undef ML_LOAD_QKV
#undef ML_LOAD_O
#pragma unroll
    for (int kt = 0; kt < 4; ++kt) *(f32x4*)(out + O_P_C + ((size_t)(b * 8 + hh) * 128 + 16 * w + fr) * 64 + 16 * kt + 4 * fq) = Cacc[kt];
    if (w == 0) { out[O_P_N + (size_t)(b * 8 + hh) * 64 + lane] = Fl[MF_N + lane]; if (lane == 0) out[O_P_M + b * 8 + hh] = Fl[MF_MC + PT / 64]; }
    if (tid < 384) { const int j = tid >> 7, c = tid & 127, gc = c < 64 ? hh * 64 + c : 512 + hh * 64 + (c - 64);
        out[O_P_CONV + (size_t)(b * 3 + j) * D + gc] = bf1(QKR[(size_t)(b * PT + PT - 3 + j) * D + gc]); }
    __syncthreads();
}
__device__ __forceinline__ void mlstm_sample_item(const Frame& F, int b, int hh, const bf16* QKR, const bf16* VVb, const bf16* OOb, const float* IFb, bf16* HOb,
                                                  const float* conv_w, const float* conv_b, const float* norm_w, const float* C0, const float* n0, const float* m0p, const float* conv0, float* out) {
    LAS float* L = (LAS float*)F.lds;
    constexpr int LQ = 0, LK = 256, LV = 512, LS = 1024, LQN = 1040, LHS = 1048;
    const int tid = F.tid, lane = F.lane, w = F.wave, row0 = MP + 4 * b;
    float li[4], lf[4];
#pragma unroll
    for (int t = 0; t < 4; ++t) { li[t] = IFb[(size_t)(row0 + t) * 16 + hh]; lf[t] = IFb[(size_t)(row0 + t) * 16 + 8 + hh]; }
    const float m0 = m0p[b * 8 + hh];
    float bc[4], av[4], mt[4], wi[4], wsv[4], ei[4], bm[4];
    { float run = 0.f, pm = -3.0e38f;
#pragma unroll
      for (int t = 0; t < 4; ++t) { run += lf[t]; bc[t] = run; av[t] = li[t] - run; pm = fmaxf(pm, av[t]); mt[t] = fmaxf(run + m0, run + pm); } }
    const float m_new = mt[3], wst = __expf(bc[3] + m0 - m_new);
#pragma unroll
    for (int t = 0; t < 4; ++t) { wi[t] = __expf(bc[t] + m0 - mt[t]); wsv[t] = __expf(bc[3] + av[t] - m_new); ei[t] = __expf(-mt[t]); bm[t] = bc[t] - mt[t]; }
    { const int t = tid >> 7, c = tid & 127, gc = c < 64 ? hh * 64 + c : 512 + hh * 64 + (c - 64);
      float x[4];
#pragma unroll
      for (int j = 0; j < 4; ++j) { const int p = t + j; x[j] = p < 3 ? conv0[(size_t)(b * 3 + p) * D + gc] : bf1(QKR[(size_t)(row0 + p - 3) * D + gc]); }
      float a = conv_b[gc];
#pragma unroll
      for (int j = 0; j < 4; ++j) a += conv_w[j * D + gc] * x[j];
      const float val = siluf_(a);
      if (c < 64) L[LQ + t * 64 + c] = val * 0.125f; else L[LK + t * 64 + (c - 64)] = val;
      if (t >= 1) out[O_S_CONV + (size_t)(b * 3 + t - 1) * D + gc] = x[3];
      L[LV + t * 128 + c] = bf1(VVb[(size_t)(row0 + t) * D + hh * 128 + c]); }
    __syncthreads();
    if (w == 0) { const int pair = lane >> 2, t = pair >> 2, s = pair & 3, part = lane & 3; float dsum = 0.f;
#pragma unroll
        for (int e = 0; e < 16; ++e) dsum += L[LQ + t * 64 + 16 * part + e] * L[LK + s * 64 + 16 * part + e];
        dsum = red4(dsum);
        const float bmt = t == 0 ? bm[0] : (t == 1 ? bm[1] : (t == 2 ? bm[2] : bm[3])), avs = s == 0 ? av[0] : (s == 1 ? av[1] : (s == 2 ? av[2] : av[3]));
        if (part == 0) L[LS + pair] = s <= t ? dsum * __expf(bmt + avs) : 0.f; }
    if (w == 1) { const int t = lane >> 4, part = lane & 15; float dsum = 0.f;
#pragma unroll
        for (int e = 0; e < 4; ++e) dsum += L[LQ + t * 64 + 4 * part + e] * n0[(size_t)(b * 8 + hh) * 64 + 4 * part + e];
        dsum = red16(dsum); if (part == 0) L[LQN + t] = dsum; }
    __syncthreads();
    const int v = tid >> 2, kq = tid & 3;
    float hvv[4];
    { const size_t coff = ((size_t)(b * 8 + hh) * 128 + v) * 64 + 16 * kq;
      float c0[16];
#pragma unroll
      for (int e4 = 0; e4 < 4; ++e4) { const f32x4 x = *(const f32x4*)(C0 + coff + 4 * e4); c0[4 * e4] = x.x; c0[4 * e4 + 1] = x.y; c0[4 * e4 + 2] = x.z; c0[4 * e4 + 3] = x.w; }
#pragma unroll
      for (int t = 0; t < 4; ++t) { float part = 0.f;
#pragma unroll
          for (int e = 0; e < 16; ++e) part += c0[e] * L[LQ + t * 64 + 16 * kq + e];
          const float inter = red4(part);
          float num = wi[t] * inter, den = wi[t] * L[LQN + t];
#pragma unroll
          for (int s = 0; s < 4; ++s) { const float sm = L[LS + t * 4 + s]; num += sm * L[LV + s * 128 + v]; den += sm; }
          hvv[t] = num / fmaxf(fabsf(den), ei[t]); }
#pragma unroll
      for (int t = 0; t < 4; ++t) { const float x = wave_sum(kq == 0 ? hvv[t] * hvv[t] : 0.f); if (lane == 0) L[LHS + w * 4 + t] = x; }
      float cn[16];
#pragma unroll
      for (int e = 0; e < 16; ++e) { float a = wst * c0[e];
#pragma unroll
          for (int s = 0; s < 4; ++s) a += wsv[s] * L[LV + s * 128 + v] * L[LK + s * 64 + 16 * kq + e];
          cn[e] = a; }
#pragma unroll
      for (int e4 = 0; e4 < 4; ++e4) *(f32x4*)(out + O_S_C + coff + 4 * e4) = (f32x4){cn[4 * e4], cn[4 * e4 + 1], cn[4 * e4 + 2], cn[4 * e4 + 3]}; }
    __syncthreads();
    if (kq == 0) {
#pragma unroll
        for (int t = 0; t < 4; ++t) { float tot = 0.f;
#pragma unroll
            for (int ww = 0; ww < 8; ++ww) tot += L[LHS + ww * 4 + t];
            const float sc = 1.0f / sqrtf(tot * (1.f / 128.f) + NORM_EPS); const size_t off = (size_t)(row0 + t) * D + hh * 128 + v;
            HOb[off] = f2bf1(hvv[t] * sc * norm_w[hh * 128 + v] * bf1(OOb[off])); } }
    if (tid < 64) { float a = wst * n0[(size_t)(b * 8 + hh) * 64 + tid];
#pragma unroll
        for (int s = 0; s < 4; ++s) a += wsv[s] * L[LK + s * 64 + tid];
        out[O_S_N + (size_t)(b * 8 + hh) * 64 + tid] = a; }
    if (tid == 0) out[O_S_M + b * 8 + hh] = m_new;
    __syncthreads();
}

constexpr int CA_AH = 0, CA_BH = 9216, CA_KH = 18432, CA_RH = 27648, CA_BT = 36864, CA_KT = 46080, CA_VT = 55296, CA_AB = 64512, CA_AK = 73728, CA_RB = 82944, CA_RK = 92160, CA_XT = 101376,
              CA_TD = 119808, CA_NF = 123904, CA_GL = 128000, CA_LG = CA_AB  , CA_AT = CA_KH  ;
__device__ __forceinline__ bf16x8 ldsfrag(LAS unsigned char* lds, int base, int row, int ks, int fq) { return *(const LAS bf16x8*)(lds + base + row * PBY + ks * 64 + fq * 16); }
__device__ __forceinline__ void rwkv_chunk_item(const Frame& F, int chain, int chunk, bf16* Rb, bf16* Kb, bf16* Vb, bf16* Db, bf16* Ab, bf16* Gb,
                                                const float* k_k, const float* k_a, const float* r_k, float* BON, bf16* dummy, v4u (&pf)[6], const int nchain, const int nchunk) {
    LAS unsigned char* lds = F.lds;
    const int tid = F.tid, lane = F.lane, w = F.wave, fr = lane & 15, fq = lane >> 4, cg = tid & 7, tt = tid >> 3;
    const int h = chain & 15, row0 = (chain >> 4) * PT + 64 * chunk, ch = h * 64 + 8 * cg;
    const size_t goff = (size_t)(row0 + tt) * D + ch;
    LAS float* LG = (LAS float*)(lds + CA_LG); LAS float* GLf = (LAS float*)(lds + CA_GL);
    float r8[8], kp[8], av[8], bv[8], rd[8];
    {
        float k8[8], v8[8], d8[8], a8[8];
        unpack8(pf[0], r8); unpack8(pf[1], k8); unpack8(pf[2], v8); unpack8(pf[3], d8); unpack8(pf[4], a8);
        float ss = 0.f;
#pragma unroll
        for (int j = 0; j < 8; ++j) { av[j] = k8[j] * k_k[ch + j]; ss += av[j] * av[j]; }
        ss = red8(ss); const float inv = __builtin_amdgcn_rsqf(fmaxf(ss, 1e-24f));
        float bsum = 0.f;
#pragma unroll
        for (int j = 0; j < 8; ++j) { const float kk = av[j] * inv; kp[j] = k8[j] * (1.f + (a8[j] - 1.f) * k_a[ch + j]); bv[j] = kk * a8[j]; av[j] = -kk; bsum += r8[j] * kp[j] * r_k[ch + j]; rd[j] = __builtin_amdgcn_rcpf(1.f - d8[j]); }
        const float bon = red8(bsum);
#pragma unroll
        for (int j = 0; j < 8; ++j) { LG[(8 * cg + j) * 64 + tt] = __logf(1.f - d8[j]); ((lds_u16*)(lds + CA_VT))[(8 * cg + j) * 72 + tt] = f2bf1(v8[j]); }
        if (cg == 0 && !dummy) BON[(size_t)(row0 + tt) * 16 + h] = bon;
    }
    for (int i = tid; i < 128 * 9; i += 512) ((LAS v4u*)(lds + CA_XT))[i] = (v4u){0u, 0u, 0u, 0u};
    __syncthreads();
    { float x[8];
#pragma unroll
      for (int q = 0; q < 8; ++q) x[q] = LG[(8 * w + q) * 64 + lane];
#pragma unroll
      for (int q = 0; q < 8; ++q) {
          float v = x[q];
          v += __builtin_bit_cast(float, __builtin_amdgcn_update_dpp(0, __builtin_bit_cast(int, v), 0x111, 0xF, 0xF, true));
          v += __builtin_bit_cast(float, __builtin_amdgcn_update_dpp(0, __builtin_bit_cast(int, v), 0x112, 0xF, 0xF, true));
          v += __builtin_bit_cast(float, __builtin_amdgcn_update_dpp(0, __builtin_bit_cast(int, v), 0x114, 0xF, 0xF, true));
          v += __builtin_bit_cast(float, __builtin_amdgcn_update_dpp(0, __builtin_bit_cast(int, v), 0x118, 0xF, 0xF, true));
          v += __builtin_bit_cast(float, __builtin_amdgcn_update_dpp(0, __builtin_bit_cast(int, v), 0x142, 0xA, 0xF, false));
          v += __builtin_bit_cast(float, __builtin_amdgcn_update_dpp(0, __builtin_bit_cast(int, v), 0x143, 0xC, 0xF, false));
          x[q] = v; }
#pragma unroll
      for (int q = 0; q < 8; ++q) LG[(8 * w + q) * 64 + lane] = x[q]; }
    __syncthreads();
    {
        float ah[8], bh[8], kh[8], rh[8];
#pragma unroll
        for (int j = 0; j < 8; ++j) { const float lg = LG[(8 * cg + j) * 64 + tt]; const float G = __expf(lg), Gm1 = G * rd[j], Gi = __builtin_amdgcn_rcpf(G);
            ah[j] = av[j] * Gm1; bh[j] = bv[j] * Gi; kh[j] = kp[j] * Gi; rh[j] = r8[j] * G;
            ((lds_u16*)(lds + CA_BT))[(8 * cg + j) * 72 + tt] = f2bf1(bh[j]); ((lds_u16*)(lds + CA_KT))[(8 * cg + j) * 72 + tt] = f2bf1(kh[j]);
            if (tt == 63) GLf[8 * cg + j] = G; }
        *(LAS v4u*)(lds + CA_AH + tt * PBY + 16 * cg) = pack8(ah); *(LAS v4u*)(lds + CA_BH + tt * PBY + 16 * cg) = pack8(bh);
        *(LAS v4u*)(lds + CA_KH + tt * PBY + 16 * cg) = pack8(kh); *(LAS v4u*)(lds + CA_RH + tt * PBY + 16 * cg) = pack8(rh);
    }
    __syncthreads();
    {
        const int mi = w >> 1, ti0 = 2 * (w & 1); const int abase = mi < 2 ? CA_AH : CA_RH, bbase = (mi & 1) ? CA_KH : CA_BH, dbase = CA_AB + mi * 9216;
        bf16x8 af[2][2], bfr[4][2];
#pragma unroll
        for (int a = 0; a < 2; ++a)
#pragma unroll
            for (int ks = 0; ks < 2; ++ks) af[a][ks] = ldsfrag(lds, abase, 16 * (ti0 + a) + fr, ks, fq);
#pragma unroll
        for (int sj = 0; sj < 4; ++sj)
#pragma unroll
            for (int ks = 0; ks < 2; ++ks) bfr[sj][ks] = ldsfrag(lds, bbase, 16 * sj + fr, ks, fq);
#pragma unroll
        for (int a = 0; a < 2; ++a)
#pragma unroll
            for (int sj = 0; sj < 4; ++sj) { const int ti = ti0 + a; f32x4 acc = {0.f, 0.f, 0.f, 0.f};
#pragma unroll
                for (int ks = 0; ks < 2; ++ks) acc = MFMA16(bfr[sj][ks], af[a][ks], acc);
                const int t = 16 * ti + fr;
#pragma unroll
                for (int r = 0; r < 4; ++r) { const int s = 16 * sj + 4 * fq + r; acc[r] = (mi < 2 ? s < t : s <= t) ? acc[r] : 0.f; }
                typedef unsigned u2v_ __attribute__((ext_vector_type(2))); u2v_ pw; pw.x = pkbf(acc[0], acc[1]); pw.y = pkbf(acc[2], acc[3]);
                *(LAS u2v_*)(lds + dbase + (t * 72 + 16 * sj + 4 * fq) * 2) = pw;
                if (mi == 0 && ti == sj) *(LAS f32x4*)(lds + CA_NF + (ti * 256 + fr * 16 + 4 * fq) * 4) = acc; }
    }
    __syncthreads();
    f32x4 rhs[4];
    if (w == 0) { const int blk = fq, c = fr; const LAS float* N = (const LAS float*)(lds + CA_NF) + blk * 256; float T[16];
#pragma unroll
        for (int i = 0; i < 16; ++i) { float s = (i == c) ? 1.f : 0.f;
#pragma unroll
            for (int j = 0; j < i; ++j) s += N[i * 16 + j] * T[j];
            T[i] = s; }
        lds_u16* td = (lds_u16*)(lds + CA_TD) + blk * 512;
#pragma unroll
        for (int i = 0; i < 16; ++i) { td[i * 32 + c] = f2bf1(T[i]); td[i * 32 + 16 + c] = 0; } }
    if (w < 4) {
#pragma unroll
        for (int i = 0; i < 4; ++i)
#pragma unroll
            for (int r = 0; r < 4; ++r) rhs[i][r] = bf1(((lds_u16*)(lds + CA_AH))[(16 * i + 4 * fq + r) * 72 + 16 * w + fr]);
    } else {
#pragma unroll
        for (int i = 0; i < 4; ++i) { f32x4 acc = {0.f, 0.f, 0.f, 0.f};
#pragma unroll
            for (int ks = 0; ks < 2; ++ks) acc = MFMA16(ldsfrag(lds, CA_AK, 16 * i + fr, ks, fq), ldsfrag(lds, CA_VT, 16 * (w - 4) + fr, ks, fq), acc);
            rhs[i] = acc; }
    }
    __syncthreads();
    {
        LAS unsigned char* AT = lds + CA_AT + w * 1024;
        *(LAS unsigned long long*)(AT + fr * 64 + 32 + fq * 8) = 0ull;
#pragma unroll
        for (int i = 0; i < 4; ++i) { f32x4 acc = rhs[i];
#pragma unroll
            for (int ks = 0; ks < 2; ++ks) acc = MFMA16(ldsfrag(lds, CA_AB, 16 * i + fr, ks, fq), ldsfrag(lds, CA_XT, 16 * w + fr, ks, fq), acc);
            typedef unsigned u2v __attribute__((ext_vector_type(2)));
            u2v pa; pa.x = pkbf(acc[0], acc[1]); pa.y = pkbf(acc[2], acc[3]);
            *(LAS u2v*)(AT + fr * 64 + fq * 8) = pa;
            asm volatile("s_waitcnt lgkmcnt(0)" ::: "memory");
            f32x4 xi = {0.f, 0.f, 0.f, 0.f};
            xi = MFMA16(*(const LAS bf16x8*)(lds + CA_TD + i * 1024 + fr * 64 + fq * 16), *(const LAS bf16x8*)(AT + fr * 64 + fq * 16), xi);
            u2v px; px.x = pkbf(xi[0], xi[1]); px.y = pkbf(xi[2], xi[3]);
            *(LAS u2v*)(lds + CA_XT + (16 * w + fr) * PBY + (16 * i + 4 * fq) * 2) = px;
            asm volatile("s_waitcnt lgkmcnt(0)" ::: "memory"); }
    }
    __syncthreads();
    if (nchain >= 0) { const size_t no = (size_t)((nchain >> 4) * PT + 64 * nchunk + tt) * D + (nchain & 15) * 64 + 8 * cg;
        pf[0] = *(const v4u*)(Rb + no); pf[1] = *(const v4u*)(Kb + no); pf[2] = *(const v4u*)(Vb + no); pf[3] = *(const v4u*)(Db + no); pf[4] = *(const v4u*)(Ab + no); }
    {
        const int mi = w >> 1, ti0 = 2 * (w & 1); const int obase = mi == 0 ? CA_AB : (mi == 1 ? CA_AK : (mi == 2 ? CA_AH : CA_KH));
        const int a1 = mi < 2 ? CA_RB : (mi == 2 ? CA_BT : CA_XT), a1o = mi == 3 ? 64 : 0, b1 = mi == 3 ? CA_BT : CA_XT, b1o = mi == 1 ? 64 : 0;
        const int a2 = mi == 1 ? CA_RK : CA_VT, b2 = mi == 1 ? CA_VT : CA_KT; const bool two = (mi & 1) != 0;
        bf16x8 af[2][2], bfr[4][2];
#pragma unroll
        for (int a = 0; a < 2; ++a)
#pragma unroll
            for (int ks = 0; ks < 2; ++ks) af[a][ks] = ldsfrag(lds, a1, a1o + 16 * (ti0 + a) + fr, ks, fq);
#pragma unroll
        for (int tj = 0; tj < 4; ++tj)
#pragma unroll
            for (int ks = 0; ks < 2; ++ks) bfr[tj][ks] = ldsfrag(lds, b1, b1o + 16 * tj + fr, ks, fq);
        f32x4 acc[2][4];
#pragma unroll
        for (int a = 0; a < 2; ++a)
#pragma unroll
            for (int tj = 0; tj < 4; ++tj) { acc[a][tj] = (f32x4){0.f, 0.f, 0.f, 0.f};
#pragma unroll
                for (int ks = 0; ks < 2; ++ks) acc[a][tj] = MFMA16(bfr[tj][ks], af[a][ks], acc[a][tj]); }
        if (two) {
#pragma unroll
            for (int a = 0; a < 2; ++a)
#pragma unroll
                for (int ks = 0; ks < 2; ++ks) af[a][ks] = ldsfrag(lds, a2, 16 * (ti0 + a) + fr, ks, fq);
#pragma unroll
            for (int tj = 0; tj < 4; ++tj)
#pragma unroll
                for (int ks = 0; ks < 2; ++ks) bfr[tj][ks] = ldsfrag(lds, b2, 16 * tj + fr, ks, fq);
#pragma unroll
            for (int a = 0; a < 2; ++a)
#pragma unroll
                for (int tj = 0; tj < 4; ++tj)
#pragma unroll
                    for (int ks = 0; ks < 2; ++ks) acc[a][tj] = MFMA16(bfr[tj][ks], af[a][ks], acc[a][tj]);
        }
#pragma unroll
        for (int a = 0; a < 2; ++a) { const int row = 16 * (ti0 + a) + fr; const float glr = GLf[row];
#pragma unroll
            for (int tj = 0; tj < 4; ++tj) { const int col = 16 * tj + 4 * fq; f32x4 val = acc[a][tj];
                typedef unsigned u2v_ __attribute__((ext_vector_type(2)));
                if (mi == 0) { const u2v_ rr = *(const LAS u2v_*)(lds + CA_RH + (row * 72 + col) * 2); val += (f32x4){bflo(rr.x), bfhi(rr.x), bflo(rr.y), bfhi(rr.y)}; }
                else if (mi == 2) {
#pragma unroll
                    for (int r = 0; r < 4; ++r) val[r] = glr * (val[r] + (row == col + r ? 1.f : 0.f)); }
                else if (mi == 3) val = val * *(const LAS f32x4*)(GLf + col);
                u2v_ pw; pw.x = pkbf(val[0], val[1]); pw.y = pkbf(val[2], val[3]);
                *(LAS u2v_*)(lds + obase + (row * 72 + col) * 2) = pw; } }
    }
    __syncthreads();
    *(v4u*)((dummy ? dummy : Rb) + goff) = *(const LAS v4u*)(lds + CA_AB + tt * PBY + 16 * cg);
    *(v4u*)((dummy ? dummy : Ab) + goff) = *(const LAS v4u*)(lds + CA_AK + tt * PBY + 16 * cg);
    *(v4u*)((dummy ? dummy : Kb) + goff) = *(const LAS v4u*)(lds + CA_AH + tt * PBY + 16 * cg);
    *(v4u*)((dummy ? dummy : Db) + goff) = *(const LAS v4u*)(lds + CA_KH + tt * PBY + 16 * cg);
    __syncthreads();
}
constexpr int CB_S = 0, CB_P2 = 9216, CB_P3 = 18432, CB_Y0 = 27648, CB_Z0 = 36864, CB_YS = 46080  ;
__device__ __forceinline__ void rwkv_state_chain(const Frame& F, int chain, float* ST, const bf16* Rb, const bf16* Kb, const bf16* Vb, const bf16* Db, const bf16* Ab, bf16* Gb, const float* BON, const float* gn_w, const float* gn_b, bf16* dummy) {
    LAS unsigned char* lds = F.lds;
    const int tid = F.tid, lane = F.lane, w = F.wave, fr = lane & 15, fq = lane >> 4, cg = tid & 7, tt = tid >> 3;
    const int h = chain & 15, rowc0 = (chain >> 4) * PT, ch = h * 64 + 8 * cg;
    for (int i = tid; i < 64 * 36; i += 512) ((LAS unsigned*)(lds + CB_S))[i] = 0u;
    f32x4 Sacc[2];
    Sacc[0] = (f32x4){0.f, 0.f, 0.f, 0.f}; Sacc[1] = Sacc[0];
    v4u q2, q3, qy, qz, qg, qb; float qbon;
    float cgw[8], cgb[8];
#pragma unroll
    for (int j = 0; j < 8; ++j) { cgw[j] = gn_w[ch + j]; cgb[j] = gn_b[ch + j]; }
#define CB_LOAD(cc) do { const size_t o_ = (size_t)(rowc0 + 64 * (cc) + tt) * D + ch; q2 = *(const v4u*)(Rb + o_); q3 = *(const v4u*)(Kb + o_); qy = *(const v4u*)(Ab + o_); qz = *(const v4u*)(Db + o_); \
        qg = *(const v4u*)(Gb + o_); qb = *(const v4u*)(Vb + o_); qbon = BON[(size_t)(rowc0 + 64 * (cc) + tt) * 16 + h]; } while (0)
    CB_LOAD(0);
    for (int c = 0; c < PT / 64; ++c) {
        *(LAS v4u*)(lds + CB_P2 + tt * PBY + 16 * cg) = q2; *(LAS v4u*)(lds + CB_P3 + tt * PBY + 16 * cg) = q3;
        *(LAS v4u*)(lds + CB_Y0 + tt * PBY + 16 * cg) = qy; *(LAS v4u*)(lds + CB_Z0 + tt * PBY + 16 * cg) = qz;
        float gw[8], gb[8]; unpack8(qg, gw); unpack8(qb, gb);
        const float bonc = qbon;
        if (c + 1 < PT / 64) CB_LOAD(c + 1);
        __syncthreads();
        f32x4 yacc[2];
        typedef unsigned u2v_ __attribute__((ext_vector_type(2)));
#pragma unroll
        for (int q = 0; q < 2; ++q) { const int tq = 2 * w + q, ti = tq >> 2, tj = tq & 3, row = 16 * ti + fr, col = 16 * tj + 4 * fq;
            const u2v_ y0 = *(const LAS u2v_*)(lds + CB_Y0 + (row * 72 + col) * 2), z0 = *(const LAS u2v_*)(lds + CB_Z0 + (row * 72 + col) * 2);
            f32x4 ya = {bflo(y0.x), bfhi(y0.x), bflo(y0.y), bfhi(y0.y)}, sa = {bflo(z0.x), bfhi(z0.x), bflo(z0.y), bfhi(z0.y)};
#pragma unroll
            for (int ks = 0; ks < 2; ++ks) { ya = MFMA16(ldsfrag(lds, CB_S, 16 * tj + fr, ks, fq), ldsfrag(lds, CB_P2, 16 * ti + fr, ks, fq), ya);
                                             sa = MFMA16(ldsfrag(lds, CB_P3, 16 * tj + fr, ks, fq), ldsfrag(lds, CB_S, 16 * ti + fr, ks, fq), sa); }
            yacc[q] = ya; Sacc[q] = sa; }
        __syncthreads();
#pragma unroll
        for (int q = 0; q < 2; ++q) { const int tq = 2 * w + q, ti = tq >> 2, tj = tq & 3, row = 16 * ti + fr, col = 16 * tj + 4 * fq;
            u2v_ pw; pw.x = pkbf(Sacc[q][0], Sacc[q][1]); pw.y = pkbf(Sacc[q][2], Sacc[q][3]);
            *(LAS u2v_*)(lds + CB_S + (row * 72 + col) * 2) = pw;
            *(LAS f32x4*)(lds + CB_YS + (row * 64 + col) * 4) = yacc[q]; }
        __syncthreads();
        { const f32x4 y0 = *(const LAS f32x4*)(lds + CB_YS + (tt * 64 + 8 * cg) * 4), y1 = *(const LAS f32x4*)(lds + CB_YS + (tt * 64 + 8 * cg + 4) * 4);
          float yy[8] = {y0.x, y0.y, y0.z, y0.w, y1.x, y1.y, y1.z, y1.w}; float s1 = 0.f;
#pragma unroll
          for (int j = 0; j < 8; ++j) s1 += yy[j];
          const float mean = red8(s1) * (1.f / 64.f); float s2 = 0.f;
#pragma unroll
          for (int j = 0; j < 8; ++j) { yy[j] -= mean; s2 += yy[j] * yy[j]; }
          const float rstd = __builtin_amdgcn_rsqf(red8(s2) * (1.f / 64.f) + GN_EPS);
          float o[8];
#pragma unroll
          for (int j = 0; j < 8; ++j) o[j] = ((yy[j] * rstd) * cgw[j] + cgb[j] + bonc * gb[j]) * gw[j];
          *(v4u*)((dummy ? dummy : Gb) + (size_t)(rowc0 + 64 * c + tt) * D + ch) = pack8(o); }
    }
#undef CB_LOAD
#pragma unroll
    for (int q = 0; q < 2; ++q) { const int tq = 2 * w + q, ti = tq >> 2, tj = tq & 3; *(f32x4*)(ST + (16 * ti + fr) * 64 + 16 * tj + 4 * fq) = Sacc[q]; }
    __syncthreads();
}

#ifndef MK_N_LAUNCHES
#define MK_N_LAUNCHES 1
#endif
constexpr int N_PHASES = 22;
#ifndef PROBE_PH
#define PROBE_PH (-1)
#define PROBE_N 1
#endif
#ifndef PROBE_VAR
#define PROBE_VAR 0
#endif
#ifndef EN_MASK
#define EN_MASK 0xff
#endif
constexpr bool EN_NORM = EN_MASK & 1, EN_UP = EN_MASK & 2, EN_RES = EN_MASK & 4, EN_RW = EN_MASK & 8, EN_L2 = EN_MASK & 16, EN_SCAN = EN_MASK & 32, EN_IN = EN_MASK & 64, EN_ML = EN_MASK & 128;
struct Args { const float* in[N_IN]; float* out; unsigned char* ws; int ph_lo, ph_hi; };
__global__ void __launch_bounds__(NWAVES * 64, 2) mega_fwd(Args args) {
    extern __shared__ __attribute__((aligned(16))) unsigned char lds_raw[];
    { const int t0 = threadIdx.x;
      for (int u = t0; u < (LDS_BYTES - LDSCTL_OFF) / 4; u += NWAVES * 64) ((LAS unsigned*)((LAS unsigned char*)lds_raw + LDSCTL_OFF))[u] = 0u; }
    __syncthreads();
    { const int t0 = threadIdx.x; if (t0 < N_IN) ((LAS unsigned long long*)((LAS unsigned char*)lds_raw + TAB_OFF))[t0] = (unsigned long long)args.in[t0]; }
    __syncthreads();
    XcdBarrier bar; bar.bar = (unsigned*)((gu32*)(args.ws + WS_CTL) + CW_BAR); bar.x = 0; bar.st = nullptr;
    if (args.ph_hi - args.ph_lo > 1) bar = xcd_barrier_post((unsigned*)((gu32*)(args.ws + WS_CTL) + CW_BAR), (volatile LAS unsigned*)((LAS unsigned char*)lds_raw + MISC_OFF) + 8);
    int ph = args.ph_lo, rep = 0;
    while (ph < args.ph_hi) {
        int tid_ = threadIdx.x; asm volatile("" : "+v"(tid_));
        unsigned char* ws = args.ws; float* out = args.out;
        Frame F;
        F.lds = (LAS unsigned char*)lds_raw;
        F.MISC = (volatile LAS unsigned*)(F.lds + MISC_OFF);
        F.tid = tid_; F.lane = F.tid & 63; F.wave = __builtin_amdgcn_readfirstlane(F.tid >> 6);
        F.G = gridDim.x; { const int bx = blockIdx.x; F.vcu = (F.G % 8 == 0) ? (bx % 8) * (F.G / 8) + bx / 8 : bx; }
        F.ctl = (gu32*)(ws + WS_CTL); F.tab = (volatile LAS unsigned long long*)(F.lds + TAB_OFF);
        bf16* Wb = (bf16*)(ws + WS_W); bf16* XR = (bf16*)(ws + WS_XR); unsigned char* big = ws + WS_BIG;
        bf16* Hb = (bf16*)(big + B_H); bf16* XN = (bf16*)(big + B_XN); float* SLAB = (float*)(big + B_SLAB);
        bf16* ACAT = (bf16*)(big + B_ACAT); bf16* Rb = (bf16*)(big + B_R); bf16* Kb = (bf16*)(big + B_K); bf16* Vb = (bf16*)(big + B_V); bf16* DECb = (bf16*)(big + B_DEC); bf16* AAb = (bf16*)(big + B_AA);
        bf16* QKR = (bf16*)(big + B_QKR); bf16* VVb = (bf16*)(big + B_VV); bf16* HOb = (bf16*)(big + B_HO); bf16* OOb = (bf16*)(big + B_OO); float* IFb = (float*)(big + B_IF);
        bf16* GGb = (bf16*)((unsigned char*)out + OS_GG); bf16* LORA = (bf16*)((unsigned char*)out + OS_LORA);
        const int c_id = (int)blockIdx.x;
        const int nrep = (ph == PROBE_PH && ph != 6) ? PROBE_N : 1;
        const int pvar = (rep + 1 < nrep) ? PROBE_VAR : 0;
        if (EN_NORM && (ph == 0 || ph == 3 || ph == 8 || ph == 11 || ph == 14 || ph == 18 || ph == 21)) {
            int kind = 0, layer = 0, ab = 0, nslab = 0; float coef = 0.5f; const float* gain = nullptr;
            if (ph == 0) { kind = 0; layer = 0; ab = 0; gain = inptr(F, I_NFA); nslab = 0; }
            else if (ph == 3) { kind = 1; gain = inptr(F, I_NMIX); nslab = 11; }
            else if (ph == 8) { kind = 0; layer = 0; ab = 1; gain = inptr(F, I_NFB); nslab = 4; coef = 1.f; }
            else if (ph == 11) { kind = 0; layer = 1; ab = 0; gain = inptr(F, I_NFA) + D; nslab = 11; }
            else if (ph == 14) { kind = 2; gain = inptr(F, I_NMIX) + D; nslab = 11; }
            else if (ph == 18) { kind = -1; gain = inptr(F, I_NFB) + D; nslab = 4; coef = 1.f; }
            else { kind = -1; gain = inptr(F, I_NFIN); nslab = 11; }
            if (kind >= 0) convert_weights(F, kind, layer, ab, Wb);
            if (ph == 0) norm_rows<0, true, true>(F, inptr(F, I_XP), inptr(F, I_XS), nslab, coef, SLAB, XR, gain, XN, nullptr, out, pvar);
            else if (ph == 3) norm_rows<1, false, true>(F, XR, inptr(F, I_XS), nslab, coef, SLAB, XR, gain, ACAT, inptr(F, I_RSHIFT), out, pvar);
            else if (ph == 21) norm_rows<2, false, false>(F, XR, XR + (size_t)MP * D, nslab, coef, SLAB, XR, gain, nullptr, nullptr, out, pvar);
            else norm_rows<0, false, false>(F, XR, XR + (size_t)MP * D, nslab, coef, SLAB, XR, gain, XN, nullptr, out, pvar);
        } else if (EN_UP && (ph == 1 || ph == 9 || ph == 12 || ph == 19)) {
            const bf16* Wu = ph == 19 ? (const bf16*)(ws + WS_W2) : Wb;
            pg8::Gemm g{XN, Wu + W_GU / 2, M, 2 * FF, D}; pg8::UnitOrder S; S.init(M / 256, 2 * FF / 256, D, F.G, c_id, 0);
            EpiSwiglu E{Hb, pvar};
            pg8::gemm_phase<EpiSwiglu, pg8::UnitOrder, true, true>(F.lds, g, S, E, F.tid);
        } else if (EN_RES && (ph == 2 || ph == 7 || ph == 10 || ph == 13 || ph == 17 || ph == 20)) {
            const bf16* A = Hb; const bf16* Bt = (ph == 20 ? (const bf16*)(ws + WS_W2) : Wb) + W_D / 2; int K = FF; float coef = 0.5f; const float* basef = nullptr;
            if (ph == 2) basef = inptr(F, I_XP);
            if (ph == 7) { A = GGb; Bt = Wb + W_O / 2; K = D; coef = 1.f; }
            if (ph == 17) { A = HOb; Bt = Wb + W_OUT / 2; K = D; coef = 1.f; }
            pg8::Gemm g{A, Bt, M, D, K}; pg8::UnitOrder S; S.init(MP / 256, D / 256, K, F.G, c_id, K / 256);
            EpiRes E{basef, XR, XR, SLAB, coef};
            pg8::gemm_phase<EpiRes, pg8::UnitOrder, true, true>(F.lds, g, S, E, F.tid);
        } else if (EN_RW && ph == 4) {
            pg8::Gemm g{ACAT, Wb + W_RW / 2, M, NRW, KRW}; pg8::UnitOrder S; S.init(M / 256, NRW / 256, KRW, F.G, c_id, 0);
            EpiRw E{Rb, Kb, Vb, LORA};
            pg8::gemm_phase<EpiRw, pg8::UnitOrder, true, true>(F.lds, g, S, E, F.tid);
        } else if (EN_L2 && ph == 5) {
            pg8::Gemm g{LORA, Wb + W_L2 / 2, M, NL2, KL2}; pg8::UnitOrder S; S.init(M / 256, NL2 / 256, KL2, F.G, c_id, -1);
            EpiL2 E{DECb, AAb, GGb, inptr(F, I_W0), inptr(F, I_A0)};
            pg8::gemm_phase<EpiL2, pg8::UnitOrder, true, true>(F.lds, g, S, E, F.tid);
        } else if (EN_SCAN && ph == 6) {
            bf16* dummy = (bf16*)(ws + WS_YRAW);
            for (int dr = (PROBE_PH == 6 && PROBE_VAR == 5) ? PROBE_N - 1 : 0; dr >= 0; --dr) {
                v4u pf[6]; pf[5] = (v4u){0u, 0u, 0u, 0u};
                { const int it = F.vcu, cg_ = F.tid & 7, tt_ = F.tid >> 3; const size_t o = (size_t)(((it >> 5) >> 4) * PT + 64 * (it & 31) + tt_) * D + ((it >> 5) & 15) * 64 + 8 * cg_;
                  pf[0] = *(const v4u*)(Rb + o); pf[1] = *(const v4u*)(Kb + o); pf[2] = *(const v4u*)(Vb + o); pf[3] = *(const v4u*)(DECb + o); pf[4] = *(const v4u*)(AAb + o); }
                for (int it = F.vcu; it < PB * 16 * (PT / 64); it += F.G) { const int nx = it + F.G < PB * 16 * (PT / 64) ? it + F.G : -1;
                    rwkv_chunk_item(F, it >> 5, it & 31, Rb, Kb, Vb, DECb, AAb, GGb, inptr(F, I_KK), inptr(F, I_KA), inptr(F, I_RK), (float*)(ws + WS_BON), dr ? dummy : nullptr, pf, nx < 0 ? -1 : nx >> 5, nx & 31); }
            }
            xcd_barrier(bar);
            for (int dr = (PROBE_PH == 6 && PROBE_VAR == 6) ? PROBE_N - 1 : 0; dr >= 0; --dr)
                if (F.vcu < 128) rwkv_state_chain(F, F.vcu, out + O_P_S + (size_t)F.vcu * 4096, Rb, Kb, Vb, DECb, AAb, GGb, (const float*)(ws + WS_BON), inptr(F, I_GNW), inptr(F, I_GNB), dr ? dummy : nullptr);
            { const int i0 = F.vcu < 128 ? 2 * F.vcu : 256 + 14 * (F.vcu - 128), i1 = F.vcu < 128 ? i0 + 2 : i0 + 14;
              for (int i = i0; i < i1; ++i) { const int b = i >> 4, h = i & 15;
                  rwkv_chain(F, MP + b * STK, STK, h, inptr(F, I_RS) + (size_t)i * 4096, out + O_S_S + (size_t)i * 4096, Rb, Kb, Vb, DECb, AAb, GGb, inptr(F, I_KK), inptr(F, I_KA), inptr(F, I_RK), inptr(F, I_GNW), inptr(F, I_GNB), true, 0); } }
        } else if (EN_IN && ph == 15) {
            pg8::Gemm g{XN, Wb + W_IN / 2, M, NIN, D}; pg8::UnitOrder S; S.init(M / 256, NIN / 256, D, F.G, c_id, 0);
            EpiIn E{QKR, VVb, OOb, IFb, inptr(F, I_BIF)};
            pg8::gemm_phase<EpiIn, pg8::UnitOrder, true, true>(F.lds, g, S, E, F.tid);
        } else if (EN_ML && ph == 16) {
            const int Hh = F.G >= 128 ? 64 : (F.G / 2 > 0 ? F.G / 2 : 1);
            if (F.vcu < Hh && pvar != 2) {
                for (int i = F.vcu; i < PB * 8; i += Hh) mlstm_prompt_chain(F, i >> 3, i & 7, QKR, VVb, OOb, IFb, HOb, inptr(F, I_CW), inptr(F, I_CB), inptr(F, I_MNW), out, pvar);
            }
            if ((F.vcu >= Hh || F.G == 1) && pvar != 1 && pvar < 3) {
                const int st = F.G == 1 ? 1 : F.G - Hh;
                for (int i = F.G == 1 ? 0 : F.vcu - Hh; i < SB * 8; i += st)
                    mlstm_sample_item(F, i >> 3, i & 7, QKR, VVb, OOb, IFb, HOb, inptr(F, I_CW), inptr(F, I_CB), inptr(F, I_MNW), inptr(F, I_MC), inptr(F, I_MN), inptr(F, I_MM), inptr(F, I_MCONV), out);
            }
            if (F.vcu >= Hh && F.G > Hh && rep + 1 == nrep) convert_weights(F, 0, 1, 1, (bf16*)(ws + WS_W2), Hh);
        }
        if (++rep < nrep) continue;
        rep = 0;
        if (ph + 1 < args.ph_hi) xcd_barrier(bar);
        ++ph;
    }
}

extern "C" void kernel_launch(void* const* d_in, const int* in_sizes, int n_in, void* d_out, int out_size, void* d_ws, size_t ws_size, hipStream_t stream) {
    static int grid = 0;
    if (grid == 0) {
        if (n_in != N_IN || out_size != (int)O_END || ws_size < WS_END2) { fprintf(stderr, "kernel_launch: unexpected shapes (n_in %d, out %d, ws %zu); nothing launched\n", n_in, out_size, ws_size); grid = -1; return; }
        int dev = 0, cus = 0, per_cu = 0;
        if (hipGetDevice(&dev) != hipSuccess || hipDeviceGetAttribute(&cus, hipDeviceAttributeMultiprocessorCount, dev) != hipSuccess) { grid = -1; return; }
        if (hipFuncSetAttribute((const void*)mega_fwd, hipFuncAttributeMaxDynamicSharedMemorySize, LDS_BYTES) != hipSuccess) { fprintf(stderr, "kernel_launch: hipFuncSetAttribute failed\n"); grid = -1; return; }
        if (hipOccupancyMaxActiveBlocksPerMultiprocessor(&per_cu, (const void*)mega_fwd, NWAVES * 64, LDS_BYTES) != hipSuccess || per_cu < 1) { fprintf(stderr, "kernel_launch: occupancy query says %d\n", per_cu); per_cu = 1; }
        (void)hipGetLastError();
        grid = cus;
    }
    if (grid < 0) return;
    (void)hipMemsetAsync((char*)d_ws + WS_CTL, 0, CTL_ZERO_BYTES, stream);
    Args a{};
    for (int i = 0; i < N_IN; ++i) a.in[i] = (const float*)d_in[i];
    a.out = (float*)d_out; a.ws = (unsigned char*)d_ws;
#if MK_N_LAUNCHES == 1
    a.ph_lo = 0; a.ph_hi = N_PHASES;
    { void* kargs[] = {(void*)&a};
      const hipError_t e = hipLaunchCooperativeKernel((const void*)mega_fwd, dim3(grid), dim3(NWAVES * 64), kargs, LDS_BYTES, stream);
      if (e != hipSuccess) fprintf(stderr, "kernel_launch: cooperative launch failed: %s (grid %d)\n", hipGetErrorString(e), grid); }
#else
    for (int p = 0; p < N_PHASES; ++p) { a.ph_lo = p; a.ph_hi = p + 1; hipLaunchKernelGGL(mega_fwd, dim3(grid), dim3(NWAVES * 64), LDS_BYTES, stream, a); }
#endif
}
```

```cpp
#include <hip/hip_runtime.h>
#include <cstdio>
#include <cstdint>
namespace pg8 {
#define PG8_LAS __attribute__((address_space(3)))
typedef unsigned short bf16_t;
typedef short bf16x8 __attribute__((ext_vector_type(8)));
typedef float f32x4 __attribute__((ext_vector_type(4)));
typedef unsigned u32x4 __attribute__((ext_vector_type(4)));
constexpr int BM = 256, BK = 64, HALF = 128, HTB = HALF * BK * 2  , STAGE_BYTES = 8 * HTB, NXCD = 8, WGM = 8;

__host__ __device__ __forceinline__ int lds_byte(int r, int c) { const int st = (r >> 4) * 2 + (c >> 5), rr = r & 15, cc = c & 31, ob = rr * 64 + cc * 2; return st * 1024 + (ob ^ (((ob >> 9) & 1) << 5)); }
__host__ __device__ __forceinline__ void stage_rc(int b, int& R, int& C) { const int st = b / 1024, sb = b % 1024, swz = sb ^ (((sb >> 9) & 1) << 5); R = (st >> 1) * 16 + swz / 64; C = (st & 1) * 32 + (swz % 64) / 2; }
__host__ __device__ __forceinline__ int perm32(int rho) { const int n = rho >> 4, i = rho & 15; return 8 * (i >> 2) + 4 * n + (i & 3); }

struct Unit { int pm, pn, k0, nt, slab; };
struct Gemm { const bf16_t* A; const bf16_t* Bt; int M, N, K; };

struct UnitOrder {
    int nM, nN, nwg, G, c, ntf, tailS;
    __device__ __forceinline__ void init(int nM_, int nN_, int K, int G_, int c_, int tailS_) { nM = nM_; nN = nN_; nwg = nM * nN; G = G_; c = c_; ntf = K / BK; tailS = tailS_; }
    __device__ __forceinline__ bool next(int i, Unit& u) const {
        long L = (long)i * G + c;
        if (L < nwg) {
            int wgid = (int)L; { const int q = nwg / NXCD, r = nwg % NXCD, xcd = wgid % NXCD, off = wgid / NXCD; wgid = (xcd < r ? xcd * (q + 1) : r * (q + 1) + (xcd - r) * q) + off; }
            const int nig = WGM * nN, gid = wgid / nig, fm = gid * WGM, gsz = (nM - fm) < WGM ? (nM - fm) : WGM;
            u.pm = fm + ((wgid % nig) % gsz); u.pn = (wgid % nig) / gsz; u.k0 = 0; u.nt = ntf; u.slab = -1;
            if (tailS < 0) { u.nt = 4; u.k0 = u.pn >= 8 ? 128 : 0; }
            return true;
        }
        L -= nwg; if (tailS <= 0 || L >= 8 * tailS) return false;
        int tile, sl; if (tailS == 4) { tile = (int)L >> 2; sl = (int)L & 3; } else { tile = (int)L / 11; sl = (int)L - 11 * tile; }
        u.pm = 64 + (tile >> 2); u.pn = tile & 3; u.k0 = sl * 256; u.nt = 4; u.slab = sl; return true;
    }
    __device__ __forceinline__ void a_ready(const Unit&) const {}
    __device__ __forceinline__ void done(const Unit&) const {}
};
template <class Epi, class Sched, bool ALIGN_EPI = false, bool SP2 = false>
__device__ __forceinline__ void gemm_phase(PG8_LAS unsigned char* lds, const Gemm g, const Sched& S, const Epi& E, const int tid) {
    const int wid = __builtin_amdgcn_readfirstlane(tid >> 6), lane = tid & 63, wr = wid >> 2, wc = wid & 3, fr = lane & 15, fq = lane >> 4;
    const int K = g.K;
    unsigned voffA[2], voffB[2];
#pragma unroll
    for (int i = 0; i < 2; ++i) { int R, C; stage_rc(tid * 16 + i * 8192, R, C); const int Rb = Epi::PERM ? ((R & ~31) + perm32(R & 31)) : R;
        voffA[i] = (unsigned)(R * K + C) * 2u; voffB[i] = (unsigned)(Rb * K + C) * 2u; }
    const size_t kstep = (size_t)(BK * 2);
    const size_t hstep = (size_t)HALF * K * 2;
    const size_t tstep = 2 * hstep;
    const unsigned ldsw = (unsigned)wid * 1024u;
    const int aoff = lds_byte(wr * 64 + fr, fq * 8), boff = lds_byte(wc * 32 + fr, fq * 8);
#define PG8_SA(b, h) (((b) * 2 + (h)) * HTB)
#define PG8_SB(b, h) ((4 + (b) * 2 + (h)) * HTB)
#define PG8_STAGE(bufoff, gbase, voff) do { _Pragma("unroll") for (int _i = 0; _i < 2; ++_i) \
        __builtin_amdgcn_global_load_lds((const unsigned*)((const char*)(gbase) + (voff)[_i]), (PG8_LAS unsigned*)(lds + (bufoff) + ldsw + _i * 8192), 16, 0, 0); } while (0)
#define PG8_LDA(dst, b, h) do { _Pragma("unroll") for (int m = 0; m < 4; ++m) _Pragma("unroll") for (int k = 0; k < 2; ++k) dst[m][k] = *(const PG8_LAS bf16x8*)(lds + PG8_SA(b, h) + aoff + m * 2048 + k * 1024); } while (0)
#define PG8_LDB(dst, b, h) do { _Pragma("unroll") for (int n = 0; n < 2; ++n) _Pragma("unroll") for (int k = 0; k < 2; ++k) dst[n][k] = *(const PG8_LAS bf16x8*)(lds + PG8_SB(b, h) + boff + n * 2048 + k * 1024); } while (0)
#define PG8_MMA(ai, bj, At, Bt) do { __builtin_amdgcn_s_setprio(1); _Pragma("unroll") for (int m = 0; m < 4; ++m) _Pragma("unroll") for (int n = 0; n < 2; ++n) _Pragma("unroll") for (int k = 0; k < 2; ++k) \
        acc[ai][bj][m][n] = __builtin_amdgcn_mfma_f32_16x16x32_bf16(Bt[n][k], At[m][k], acc[ai][bj][m][n], 0, 0, 0); __builtin_amdgcn_s_setprio(0); } while (0)
#define PG8_WAIT_V(n) asm volatile("s_waitcnt vmcnt(" #n ")" ::: "memory")
#define PG8_WAIT_L(n) asm volatile("s_waitcnt lgkmcnt(" #n ")" ::: "memory")
#define PG8_BAR __builtin_amdgcn_s_barrier()
#define PG8_SCHED __builtin_amdgcn_sched_barrier(0)
    Unit cur, nxt; int ui = 0;
    if (!S.next(0, cur)) return;
    f32x4 acc[2][2][4][2];
#pragma unroll
    for (int a = 0; a < 2; ++a)
#pragma unroll
        for (int b = 0; b < 2; ++b)
#pragma unroll
            for (int m = 0; m < 4; ++m)
#pragma unroll
                for (int n = 0; n < 2; ++n) acc[a][b][m][n] = (f32x4){0.f, 0.f, 0.f, 0.f};
    bf16x8 At[4][2], B0[2][2], B1[2][2];
    const char* cA = (const char*)g.A + (size_t)cur.pm * tstep + (size_t)cur.k0 * 2; const char* cB = (const char*)g.Bt + (size_t)cur.pn * tstep + (size_t)cur.k0 * 2;
    S.a_ready(cur);
    if constexpr (SP2) {
        PG8_STAGE(PG8_SB(0, 0), cB, voffB); PG8_STAGE(PG8_SB(0, 1), cB + hstep, voffB); PG8_STAGE(PG8_SA(0, 0), cA, voffA); PG8_STAGE(PG8_SA(0, 1), cA + hstep, voffA);
        if (wr == 1) PG8_BAR;
        PG8_WAIT_V(2); PG8_BAR;
        PG8_STAGE(PG8_SB(1, 0), cB + kstep, voffB); PG8_STAGE(PG8_SA(1, 0), cA + kstep, voffA); PG8_STAGE(PG8_SB(1, 1), cB + hstep + kstep, voffB);
        PG8_WAIT_V(6); PG8_BAR;
    } else {
        PG8_STAGE(PG8_SB(0, 0), cB, voffB); PG8_STAGE(PG8_SA(0, 0), cA, voffA); PG8_STAGE(PG8_SB(0, 1), cB + hstep, voffB); PG8_STAGE(PG8_SA(0, 1), cA + hstep, voffA);
        if (wr == 1) PG8_BAR;
        PG8_WAIT_V(4); PG8_BAR;
        PG8_STAGE(PG8_SB(1, 0), cB + kstep, voffB); PG8_STAGE(PG8_SA(1, 0), cA + kstep, voffA); PG8_STAGE(PG8_SB(1, 1), cB + hstep + kstep, voffB);
        PG8_WAIT_V(6); PG8_BAR;
    }
    for (;;) {
        const bool has_next = S.next(ui + 1, nxt);
        const char* nA = has_next ? (const char*)g.A + (size_t)nxt.pm * tstep + (size_t)nxt.k0 * 2 : cA; const char* nB = has_next ? (const char*)g.Bt + (size_t)nxt.pn * tstep + (size_t)nxt.k0 * 2 : cB;
        const int nt = cur.nt;
        for (int t = 0; t < nt; t += 2) {
            const bool last = (t == nt - 2);
            const char* a1 = cA + (size_t)(t + 1) * kstep;
            const char* a2 = last ? nA : cA + (size_t)(t + 2) * kstep; const char* b2 = last ? nB : cB + (size_t)(t + 2) * kstep;
            const char* a3 = a2 + kstep; const char* b3 = b2 + kstep;
            if (last && has_next) S.a_ready(nxt);
            if constexpr (SP2) {
            PG8_LDB(B0, 0, 0); PG8_LDB(B1, 0, 1); PG8_SCHED; PG8_LDA(At, 0, 0); PG8_STAGE(PG8_SA(1, 1), a1 + hstep, voffA);
            PG8_WAIT_V(8); PG8_WAIT_L(0); PG8_BAR; PG8_MMA(0, 0, At, B0); PG8_MMA(0, 1, At, B1); PG8_BAR; PG8_SCHED;
            PG8_LDA(At, 0, 1); PG8_STAGE(PG8_SB(0, 0), b2, voffB); PG8_STAGE(PG8_SB(0, 1), b2 + hstep, voffB); PG8_STAGE(PG8_SA(0, 0), a2, voffA);
            PG8_WAIT_V(8); PG8_WAIT_L(0); PG8_BAR; PG8_MMA(1, 0, At, B0); PG8_MMA(1, 1, At, B1); PG8_BAR; PG8_SCHED;
            PG8_LDB(B0, 1, 0); PG8_LDB(B1, 1, 1); PG8_SCHED; PG8_LDA(At, 1, 0); PG8_STAGE(PG8_SA(0, 1), a2 + hstep, voffA);
            PG8_WAIT_V(8); PG8_WAIT_L(0); PG8_BAR; PG8_MMA(0, 0, At, B0); PG8_MMA(0, 1, At, B1); PG8_BAR; PG8_SCHED;
            PG8_LDA(At, 1, 1); PG8_STAGE(PG8_SB(1, 0), b3, voffB); PG8_STAGE(PG8_SB(1, 1), b3 + hstep, voffB); PG8_STAGE(PG8_SA(1, 0), a3, voffA);
            PG8_WAIT_V(8); PG8_WAIT_L(0); PG8_BAR; PG8_MMA(1, 0, At, B0); PG8_MMA(1, 1, At, B1); PG8_BAR; PG8_SCHED;
            } else {
            PG8_LDB(B0, 0, 0); PG8_SCHED; PG8_LDA(At, 0, 0); PG8_STAGE(PG8_SA(1, 1), a1 + hstep, voffA);
            PG8_WAIT_L(8); PG8_BAR; PG8_WAIT_L(0); PG8_MMA(0, 0, At, B0); PG8_BAR; PG8_SCHED;
            PG8_LDB(B1, 0, 1); PG8_STAGE(PG8_SB(0, 0), b2, voffB);
            PG8_BAR; PG8_WAIT_L(0); PG8_MMA(0, 1, At, B1); PG8_BAR;
            PG8_LDA(At, 0, 1); PG8_STAGE(PG8_SA(0, 0), a2, voffA);
            PG8_BAR; PG8_WAIT_L(0); PG8_MMA(1, 0, At, B0); PG8_BAR; PG8_SCHED;
            PG8_STAGE(PG8_SB(0, 1), b2 + hstep, voffB);
            PG8_WAIT_V(6); PG8_BAR; PG8_MMA(1, 1, At, B1); PG8_BAR;
            PG8_LDB(B0, 1, 0); PG8_SCHED; PG8_LDA(At, 1, 0); PG8_STAGE(PG8_SA(0, 1), a2 + hstep, voffA);
            PG8_WAIT_L(8); PG8_BAR; PG8_WAIT_L(0); PG8_MMA(0, 0, At, B0); PG8_BAR; PG8_SCHED;
            PG8_LDB(B1, 1, 1); PG8_STAGE(PG8_SB(1, 0), b3, voffB);
            PG8_BAR; PG8_WAIT_L(0); PG8_MMA(0, 1, At, B1); PG8_BAR;
            PG8_LDA(At, 1, 1); PG8_STAGE(PG8_SA(1, 0), a3, voffA);
            PG8_BAR; PG8_WAIT_L(0); PG8_MMA(1, 0, At, B0); PG8_BAR; PG8_SCHED;
            PG8_STAGE(PG8_SB(1, 1), b3 + hstep, voffB);
            PG8_WAIT_V(6); PG8_BAR; PG8_MMA(1, 1, At, B1); PG8_BAR;
            }
        }
        if constexpr (ALIGN_EPI) { if (wr == 0) PG8_BAR; }
        if constexpr (!Epi::AFTER_DRAIN) { E(acc, cur, wr, wc, fr, fq); S.done(cur); }
        if (!has_next) break;
#pragma unroll
        for (int a = 0; a < 2; ++a)
#pragma unroll
            for (int b = 0; b < 2; ++b)
#pragma unroll
                for (int m = 0; m < 4; ++m)
#pragma unroll
                    for (int n = 0; n < 2; ++n) acc[a][b][m][n] = (f32x4){0.f, 0.f, 0.f, 0.f};
        cur = nxt; cA = nA; cB = nB; ++ui;
        if constexpr (ALIGN_EPI) { if (wr == 1) PG8_BAR; }
    }
    PG8_WAIT_V(0);
    if constexpr (!ALIGN_EPI) { if (wr == 0) PG8_BAR; }
    PG8_BAR;
    if constexpr (Epi::AFTER_DRAIN) { E.fused(acc, cur, wr, wc, fr, fq, lds, wid, lane); S.done(cur); }
#undef PG8_SA
#undef PG8_SB
#undef PG8_STAGE
#undef PG8_LDA
#undef PG8_LDB
#undef PG8_MMA
#undef PG8_WAIT_V
#undef PG8_WAIT_L
#undef PG8_BAR
#undef PG8_SCHED
}
}

#define GAS __attribute__((address_space(1)))
#define LAS __attribute__((address_space(3)))
typedef unsigned short bf16;
typedef unsigned v4u __attribute__((ext_vector_type(4)));
typedef float f32x4 __attribute__((ext_vector_type(4)));
typedef short bf16x8 __attribute__((ext_vector_type(8)));
typedef GAS unsigned gu32;
typedef GAS unsigned long long gu64;
#define RLX_AGENT __ATOMIC_RELAXED, __HIP_MEMORY_SCOPE_AGENT
#define LDS_WAIT() asm volatile("s_waitcnt lgkmcnt(0)" ::: "memory")
#define VM_WAIT() asm volatile("s_waitcnt vmcnt(0)" ::: "memory")
__device__ __forceinline__ unsigned long long rt() { return __builtin_amdgcn_s_memrealtime(); }
__device__ __forceinline__ unsigned f2bf(float f) { unsigned u = __builtin_bit_cast(unsigned, f); return (u + 0x7fffu + ((u >> 16) & 1u)) >> 16; }
__device__ __forceinline__ unsigned pk2(float lo, float hi) { return f2bf(lo) | (f2bf(hi) << 16); }

#define XB_TMO      128
#define XB_XCNT(j)  (256  + 64 * (j))
#define XB_XSUB(j)  (1280 + 64 * (j))
#define XB_XGEN(j)  (2304 + 64 * (j))
#define XB_TOP      3328
#define XB_TOPGEN   3392
#define XCD_BAR_WORDS 3456
#define XB_SPIN_CAP (1u << 18)

__device__ __forceinline__ unsigned xb_ld(unsigned* p)              { return __hip_atomic_load(p, __ATOMIC_RELAXED, __HIP_MEMORY_SCOPE_AGENT); }
__device__ __forceinline__ unsigned xb_add(unsigned* p, unsigned v) { return __hip_atomic_fetch_add(p, v, __ATOMIC_RELAXED, __HIP_MEMORY_SCOPE_AGENT); }
__device__ __forceinline__ unsigned xb_xcc_id() { return (unsigned)__builtin_amdgcn_s_getreg((3 << 11) | 20) & 0xFu; }
#define XB_SPIN(cond, bar) do { unsigned _sp = 0; while (cond) { __builtin_amdgcn_s_sleep(1); \
    if ((++_sp & 255u) == 0u) { if (xb_ld(&(bar)[XB_TMO])) break; if (_sp > XB_SPIN_CAP) { atomicAdd(&(bar)[XB_TMO], 1u); break; } } } } while (0)

struct XcdBarrier {
    unsigned* bar; unsigned x;
    volatile LAS unsigned* st;
};

__device__ __forceinline__ XcdBarrier xcd_barrier_post(unsigned* bar, volatile LAS unsigned* st) {
    XcdBarrier b; b.bar = bar; b.x = xb_xcc_id(); b.st = st;
    if (threadIdx.x == 0) (void)xb_add(&bar[XB_XCNT(b.x)], 1u);
    return b;
}
__device__ __forceinline__ void xcd_barrier_complete(unsigned* bar, unsigned x, unsigned& nloc, unsigned& nx) {
    const unsigned G = gridDim.x * gridDim.y * gridDim.z;
    unsigned sum, cnt, mine, sp = 0u;
    for (;;) {
        sum = 0u; cnt = 0u; mine = 0u;
#pragma unroll
        for (unsigned j = 0; j < 16; ++j) { const unsigned c = xb_ld(&bar[XB_XCNT(j)]); sum += c; cnt += (c > 0u) ? 1u : 0u; mine = (j == x) ? c : mine; }
        if (sum == G) break;
        __builtin_amdgcn_s_sleep(1);
        if ((++sp & 255u) == 0u) { if (xb_ld(&bar[XB_TMO])) break; if (sp > XB_SPIN_CAP) { atomicAdd(&bar[XB_TMO], 1u); break; } }
    }
    nloc = mine > 0u ? mine : 1u; nx = cnt > 0u ? cnt : 1u;
}

__device__ __forceinline__ void xcd_barrier(const XcdBarrier& b) {
    asm volatile("s_waitcnt vmcnt(0)" ::: "memory");
    __syncthreads();
    if (threadIdx.x == 0) {
        unsigned* bar = b.bar;
        __builtin_amdgcn_s_waitcnt(0);
        unsigned nloc = b.st[0], nx = b.st[1];
        if (nloc == 0u) { xcd_barrier_complete(bar, b.x, nloc, nx); b.st[0] = nloc; b.st[1] = nx; }
        const unsigned old = xb_add(&bar[XB_XSUB(b.x)], 1u);
        const unsigned gen = old / nloc;
        if (old + 1u == (gen + 1u) * nloc) {
            __builtin_amdgcn_fence(__ATOMIC_RELEASE, "agent");
            asm volatile("s_waitcnt vmcnt(0)" ::: "memory");
            const unsigned og = xb_add(&bar[XB_TOP], 1u);
            const unsigned tg = og / nx;
            if (og + 1u == (tg + 1u) * nx) xb_add(&bar[XB_TOPGEN], 1u);
            else XB_SPIN(xb_ld(&bar[XB_TOPGEN]) == tg, bar);
            __builtin_amdgcn_fence(__ATOMIC_ACQUIRE, "agent");
            xb_add(&bar[XB_XGEN(b.x)], 1u);
            asm volatile("s_waitcnt vmcnt(0)" ::: "memory");
        } else {
            XB_SPIN(xb_ld(&bar[XB_XGEN(b.x)]) == gen, bar);
            __builtin_amdgcn_fence(__ATOMIC_ACQUIRE, "agent");
            asm volatile("s_waitcnt vmcnt(0)" ::: "memory");
        }
    }
    __syncthreads();
}

constexpr int NWAVES = 8;
constexpr int D = 1024, FF = 2816;
constexpr int PB = 8, PT = 2048, SB = 128, STK = 4;
constexpr int MP = PB * PT, MS = SB * STK, M = MP + MS;
constexpr int NRW = 3584, KRW = 2048, NL2 = 3072, KL2 = 384, NIN = 3328;
constexpr float NORM_EPS = 1e-6f, GN_EPS = 64e-5f;
typedef pg8::bf16_t bf16;

constexpr size_t MiB = 1u << 20;
constexpr size_t WS_CTL = 0, CTL_ZERO_BYTES = 64 * 1024;
constexpr size_t WS_W = 1 * MiB;
constexpr size_t WS_XR = 20 * MiB;
constexpr size_t WS_BIG = 86 * MiB;
constexpr size_t WS_END = 256 * MiB;
constexpr size_t WS_YRAW = 256 * MiB, WS_BON = 288 * MiB, WS_W2 = 289 * MiB  , WS_END2 = 308 * MiB;
constexpr size_t W_GU = 0, W_D = (size_t)2 * FF * D * 2;
constexpr size_t W_RW = 0, W_L2 = (size_t)NRW * KRW * 2, W_O = W_L2 + (size_t)NL2 * KL2 * 2;
constexpr size_t W_IN = 0, W_OUT = (size_t)NIN * D * 2;
static_assert(W_D + (size_t)D * FF * 2 <= 19 * MiB && W_O + (size_t)D * D * 2 <= 19 * MiB && W_OUT + (size_t)D * D * 2 <= 19 * MiB, "weights region");
constexpr size_t B_H = 0, B_XN = 91 * MiB, B_SLAB = 124 * MiB;
constexpr size_t B_ACAT = 0, B_R = 66 * MiB, B_K = 99 * MiB, B_V = 132 * MiB, B_DEC = 0, B_AA = 33 * MiB;
constexpr size_t B_QKR = 0, B_VV = 33 * MiB, B_HO = 66 * MiB, B_OO = 124 * MiB, B_IF = 157 * MiB;
static_assert((size_t)M * FF * 2 <= 91 * MiB && (size_t)M * D * 2 == 33 * MiB && B_IF + (size_t)M * 16 * 4 <= 170 * MiB && B_SLAB + (size_t)11 * MS * D * 4 <= 170 * MiB, "BIG map");
constexpr size_t OS_GG = 0, OS_LORA = 33 * MiB;
static_assert(OS_LORA + (size_t)M * KL2 * 2 <= (size_t)MP * D * 4, "d_out scratch");
constexpr size_t O_Y = 0, O_P_S = 17301504, O_P_SHIFT = 17825792, O_P_C = 17833984, O_P_N = 18358272, O_P_M = 18362368, O_P_CONV = 18362432,
                 O_S_S = 18387008, O_S_SHIFT = 26775616, O_S_C = 26906688, O_S_N = 35295296, O_S_M = 35360832, O_S_CONV = 35361856, O_END = 35755072;
constexpr int CW_BAR = 1024;

constexpr int RING_BYTES = 131072, LDSCTL_OFF = RING_BYTES, MISC_OFF = LDSCTL_OFF + 320, TAB_OFF = LDSCTL_OFF + 1024, LDS_BYTES = 147456;

enum { I_XP = 0, I_XS, I_RS, I_RSHIFT, I_MC, I_MN, I_MM, I_MCONV, I_NFA, I_FAWG, I_FAWU, I_FAWD, I_NMIX, I_NFB, I_FBWG, I_FBWU, I_FBWD,
       I_MU, I_WR, I_WK, I_WV, I_WO, I_W0, I_W1, I_W2, I_A0, I_A1, I_A2, I_G1, I_G2, I_KK, I_KA, I_RK, I_GNW, I_GNB,
       I_WIN, I_BIF, I_CW, I_CB, I_MNW, I_WOUT, I_NFIN, N_IN };

typedef __bf16 bf16x2_t __attribute__((ext_vector_type(2)));
typedef float f32x2_t __attribute__((ext_vector_type(2)));
__device__ __forceinline__ unsigned pkbf(float lo, float hi) { f32x2_t v = {lo, hi}; bf16x2_t b = __builtin_convertvector(v, bf16x2_t); return __builtin_bit_cast(unsigned, b); }
__device__ __forceinline__ float bflo(unsigned u) { return __builtin_bit_cast(float, u << 16); }
__device__ __forceinline__ float bfhi(unsigned u) { return __builtin_bit_cast(float, u & 0xffff0000u); }
__device__ __forceinline__ float bf1(unsigned short u) { return __builtin_bit_cast(float, (unsigned)u << 16); }
__device__ __forceinline__ unsigned short f2bf1(float f) { return (unsigned short)(pkbf(f, 0.f) & 0xffffu); }
__device__ __forceinline__ void unpack8(v4u w, float (&o)[8]) { o[0] = bflo(w.x); o[1] = bfhi(w.x); o[2] = bflo(w.y); o[3] = bfhi(w.y); o[4] = bflo(w.z); o[5] = bfhi(w.z); o[6] = bflo(w.w); o[7] = bfhi(w.w); }
__device__ __forceinline__ v4u pack8(const float (&o)[8]) { v4u w; w.x = pkbf(o[0], o[1]); w.y = pkbf(o[2], o[3]); w.z = pkbf(o[4], o[5]); w.w = pkbf(o[6], o[7]); return w; }
__device__ __forceinline__ float sigmoidf_(float x) { return __builtin_amdgcn_rcpf(1.f + __expf(-x)); }
__device__ __forceinline__ float siluf_(float x) { return x * __builtin_amdgcn_rcpf(1.f + __expf(-x)); }
__device__ __forceinline__ float tanhf_(float x) { return 1.f - 2.f * __builtin_amdgcn_rcpf(__expf(2.f * x) + 1.f); }
__device__ __forceinline__ float logsigmoidf_(float x) { return fminf(x, 0.f) - __logf(1.f + __expf(-fabsf(x))); }
template <int CTRL> __device__ __forceinline__ float dppf(float x) { return __builtin_bit_cast(float, __builtin_amdgcn_update_dpp(0, __builtin_bit_cast(int, x), CTRL, 0xF, 0xF, true)); }
__device__ __forceinline__ float red4(float x) { x += dppf<0xB1>(x); x += dppf<0x4E>(x); return x; }
__device__ __forceinline__ float red8(float x) { x = red4(x); x += dppf<0x141>(x); return x; }
__device__ __forceinline__ float red16(float x) { x = red8(x); x += dppf<0x140>(x); return x; }
__device__ __forceinline__ float wave_sum(float v) {
#pragma unroll
    for (int o = 1; o < 64; o <<= 1) v += __shfl_xor(v, o);
    return v;
}

struct Frame {
    LAS unsigned char* lds;
    volatile LAS unsigned* MISC;
    gu32* ctl;
    volatile LAS unsigned long long* tab;
    int tid, lane, wave, vcu, G;
};
__device__ __forceinline__ const float* inptr(const Frame& F, int i) { const unsigned long long v = F.tab[i];
    const unsigned lo = __builtin_amdgcn_readfirstlane((unsigned)v), hi = __builtin_amdgcn_readfirstlane((unsigned)(v >> 32)); return (const float*)(const GAS float*)(((unsigned long long)hi << 32) | lo); }

using pg8::Unit; using pg8::BM; using pg8::HALF;
__device__ __forceinline__ void st8bf(bf16* p, f32x4 v0, f32x4 v1) { v4u w; w.x = pkbf(v0[0], v0[1]); w.y = pkbf(v0[2], v0[3]); w.z = pkbf(v1[0], v1[1]); w.w = pkbf(v1[2], v1[3]); *(v4u*)p = w; }

struct EpiSwiglu {
    static constexpr bool PERM = true, AFTER_DRAIN = false;
    bf16* H; int pvar;
    __device__ __forceinline__ void operator()(const f32x4 (&acc)[2][2][4][2], const Unit& u, int wr, int wc, int fr, int fq) const {
        if (pvar == 3) return;
        const int row0 = u.pm * BM + wr * 64 + fr, col0 = u.pn * 128 + wc * 32 + 8 * fq;
#pragma unroll
        for (int ai = 0; ai < 2; ++ai)
#pragma unroll
            for (int m = 0; m < 4; ++m) {
                f32x4 o[2];
#pragma unroll
                for (int n = 0; n < 2; ++n)
#pragma unroll
                    for (int i = 0; i < 4; ++i) { const float g = acc[ai][0][m][n][i], up = acc[ai][1][m][n][i]; o[n][i] = siluf_(g) * up; }
                st8bf(H + (size_t)(row0 + ai * HALF + m * 16) * FF + col0, o[0], o[1]);
            }
    }
};
__device__ __forceinline__ void ld8bf(const bf16* p, f32x4& a, f32x4& b) { const v4u w = *(const v4u*)p; a = (f32x4){bflo(w.x), bfhi(w.x), bflo(w.y), bfhi(w.y)}; b = (f32x4){bflo(w.z), bfhi(w.z), bflo(w.w), bfhi(w.w)}; }
struct EpiRes {
    static constexpr bool PERM = true, AFTER_DRAIN = false;
    const float* basef; const bf16* baseb; bf16* out; float* slab; float coef;
    __device__ __forceinline__ void operator()(const f32x4 (&acc)[2][2][4][2], const Unit& u, int wr, int wc, int fr, int fq) const {
        const int row0 = u.pm * BM + wr * 64 + fr, col0 = u.pn * BM + wc * 32 + 8 * fq;
        if (u.slab < 0) {
            if (basef) {
#pragma unroll
                for (int ai = 0; ai < 2; ++ai)
#pragma unroll
                    for (int m = 0; m < 4; ++m) { const size_t ro = (size_t)(row0 + ai * HALF + m * 16) * D + col0;
#pragma unroll
                        for (int bj = 0; bj < 2; ++bj) { const f32x4 b0 = *(const f32x4*)(basef + ro + bj * HALF), b1 = *(const f32x4*)(basef + ro + bj * HALF + 4);
                            st8bf(out + ro + bj * HALF, b0 + acc[ai][bj][m][0] * coef, b1 + acc[ai][bj][m][1] * coef); } }
            } else {
#pragma unroll
                for (int ai = 0; ai < 2; ++ai)
#pragma unroll
                    for (int m = 0; m < 4; ++m) { const size_t ro = (size_t)(row0 + ai * HALF + m * 16) * D + col0;
#pragma unroll
                        for (int bj = 0; bj < 2; ++bj) { f32x4 b0, b1; ld8bf(baseb + ro + bj * HALF, b0, b1);
                            st8bf(out + ro + bj * HALF, b0 + acc[ai][bj][m][0] * coef, b1 + acc[ai][bj][m][1] * coef); } }
            }
        } else {
            float* sl = slab + (size_t)u.slab * MS * D;
#pragma unroll
            for (int ai = 0; ai < 2; ++ai)
#pragma unroll
                for (int m = 0; m < 4; ++m) { const size_t ro = (size_t)(row0 + ai * HALF + m * 16 - MP) * D + col0;
#pragma unroll
                    for (int bj = 0; bj < 2; ++bj) { *(f32x4*)(sl + ro + bj * HALF) = acc[ai][bj][m][0]; *(f32x4*)(sl + ro + bj * HALF + 4) = acc[ai][bj][m][1]; } }
        }
    }
};
struct EpiRw {
    static constexpr bool PERM = true, AFTER_DRAIN = false;
    bf16 *R, *K, *V, *L;
    __device__ __forceinline__ void operator()(const f32x4 (&acc)[2][2][4][2], const Unit& u, int wr, int wc, int fr, int fq) const {
        const int row0 = u.pm * BM + wr * 64 + fr;
        if (u.pn < 12) {
            bf16 *p0 = R, *p1 = K, *p2 = V; asm volatile("" : "+s"(p0), "+s"(p1), "+s"(p2));
            bf16* dst = u.pn < 4 ? p0 : (u.pn < 8 ? p1 : p2); const int col0 = (u.pn & 3) * BM + wc * 32 + 8 * fq;
#pragma unroll
            for (int ai = 0; ai < 2; ++ai)
#pragma unroll
                for (int m = 0; m < 4; ++m) { bf16* rp = dst + (size_t)(row0 + ai * HALF + m * 16) * D + col0;
#pragma unroll
                    for (int bj = 0; bj < 2; ++bj) st8bf(rp + bj * HALF, acc[ai][bj][m][0], acc[ai][bj][m][1]); }
        } else {
#pragma unroll
            for (int bj = 0; bj < 2; ++bj) {
                const int lc = (u.pn - 12) * BM + bj * HALF + wc * 32 + 8 * fq;
                if (lc >= KL2) continue;
                const int act = lc < 64 ? 1 : (lc < 128 ? 0 : (lc < 288 ? 2 : 3));
#pragma unroll
                for (int ai = 0; ai < 2; ++ai)
#pragma unroll
                    for (int m = 0; m < 4; ++m) {
                        f32x4 o[2];
#pragma unroll
                        for (int n = 0; n < 2; ++n)
#pragma unroll
                            for (int i = 0; i < 4; ++i) { const float x = acc[ai][bj][m][n][i]; o[n][i] = act == 1 ? tanhf_(x) : (act == 0 ? x : (act == 2 ? sigmoidf_(x) : 0.f)); }
                        st8bf(L + (size_t)(row0 + ai * HALF + m * 16) * KL2 + lc, o[0], o[1]);
                    }
            }
        }
    }
};
struct EpiL2 {
    static constexpr bool PERM = true, AFTER_DRAIN = false;
    bf16 *DEC, *AA, *GG; const float *w0, *a0;
    __device__ __forceinline__ void operator()(const f32x4 (&acc)[2][2][4][2], const Unit& u, int wr, int wc, int fr, int fq) const {
        const int row0 = u.pm * BM + wr * 64 + fr, kind = u.pn >> 2, col0 = (u.pn & 3) * BM + wc * 32 + 8 * fq;
        bf16 *p0 = DEC, *p1 = AA, *p2 = GG; const float *q0 = w0, *q1 = a0; asm volatile("" : "+s"(p0), "+s"(p1), "+s"(p2), "+s"(q0), "+s"(q1));
        bf16* dst = kind == 0 ? p0 : (kind == 1 ? p1 : p2); const float* bias = kind == 0 ? q0 : q1;
#pragma unroll
        for (int bj = 0; bj < 2; ++bj) {
            f32x4 bv[2];
#pragma unroll
            for (int n = 0; n < 2; ++n) bv[n] = kind < 2 ? *(const f32x4*)(bias + col0 + bj * HALF + 4 * n) : (f32x4){0.f, 0.f, 0.f, 0.f};
#pragma unroll
            for (int ai = 0; ai < 2; ++ai)
#pragma unroll
                for (int m = 0; m < 4; ++m) {
                    f32x4 o[2];
#pragma unroll
                    for (int n = 0; n < 2; ++n)
#pragma unroll
                        for (int i = 0; i < 4; ++i) { const float z = acc[ai][bj][m][n][i] + bv[n][i];
                            o[n][i] = kind == 0 ? (1.f - __expf(-0.60653065971f * sigmoidf_(z))) : (kind == 1 ? sigmoidf_(z) : z); }
                    st8bf(dst + (size_t)(row0 + ai * HALF + m * 16) * D + col0 + bj * HALF, o[0], o[1]);
                }
        }
    }
};
struct EpiIn {
    static constexpr bool PERM = true, AFTER_DRAIN = false;
    bf16 *QKR, *VV, *OO; float* IF; const float* bif; int pvar;
    __device__ __forceinline__ void operator()(const f32x4 (&acc)[2][2][4][2], const Unit& u, int wr, int wc, int fr, int fq) const {
        if (pvar == 3) return;
        const int row0 = u.pm * BM + wr * 64 + fr;
        if (u.pn < 12) {
            bf16 *p0 = QKR, *p1 = VV, *p2 = OO; asm volatile("" : "+s"(p0), "+s"(p1), "+s"(p2));
            const int kind = u.pn >> 2; bf16* dst = kind == 0 ? p0 : (kind == 1 ? p1 : p2); const int col0 = (u.pn & 3) * BM + wc * 32 + 8 * fq;
#pragma unroll
            for (int ai = 0; ai < 2; ++ai)
#pragma unroll
                for (int m = 0; m < 4; ++m) { bf16* rp = dst + (size_t)(row0 + ai * HALF + m * 16) * D + col0;
#pragma unroll
                    for (int bj = 0; bj < 2; ++bj) { f32x4 a = acc[ai][bj][m][0], b = acc[ai][bj][m][1];
                        if (kind == 2) {
#pragma unroll
                            for (int i = 0; i < 4; ++i) { a[i] = sigmoidf_(a[i]); b[i] = sigmoidf_(b[i]); } }
                        st8bf(rp + bj * HALF, a, b); } }
        } else if (u.pn == 12 && wc == 0 && fq < 2) {
            const f32x4 b0 = *(const f32x4*)(bif + 8 * fq), b1 = *(const f32x4*)(bif + 8 * fq + 4);
#pragma unroll
            for (int ai = 0; ai < 2; ++ai)
#pragma unroll
                for (int m = 0; m < 4; ++m) { f32x4 a = acc[ai][0][m][0] + b0, b = acc[ai][0][m][1] + b1;
                    if (fq == 1) {
#pragma unroll
                        for (int i = 0; i < 4; ++i) { a[i] = logsigmoidf_(a[i]); b[i] = logsigmoidf_(b[i]); } }
                    float* rp = IF + (size_t)(row0 + ai * HALF + m * 16) * 16 + 8 * fq; *(f32x4*)rp = a; *(f32x4*)(rp + 4) = b; }
        }
    }
};

struct CJ { const float* W; const float* sc; bf16* WT; int K, N, Npad, ldk, koff, rmode, roff, smode; };
__device__ __forceinline__ int cj_items(const CJ& j) { return (j.K / 32) * (j.Npad / 32); }
__device__ __forceinline__ void conv_load(const CJ& J, int item, int lane, f32x4 (&w)[4], float (&sc)[4]) {
    const int nblk = J.Npad / 32, kb = item / nblk, nb = item % nblk, k0 = 32 * kb, n0 = 32 * nb;
    const int r = lane >> 3, c4 = 4 * (lane & 7); const bool nok = n0 + c4 < J.N;
#pragma unroll
    for (int i = 0; i < 4; ++i) { const int kk = k0 + r + 8 * i;
        w[i] = nok ? *(const f32x4*)(J.W + (size_t)kk * J.N + n0 + c4) : (f32x4){0.f, 0.f, 0.f, 0.f};
        float s = 1.f; if (J.smode) { s = J.sc[kk]; if (J.smode == 2) s = 1.f - s; }
        sc[i] = s; }
}
__device__ __forceinline__ void conv_store(const CJ& J, LAS float* scr, int item, int lane, const f32x4 (&w)[4], const float (&sc)[4]) {
    const int nblk = J.Npad / 32, kb = item / nblk, nb = item % nblk, k0 = 32 * kb, n0 = 32 * nb;
    const int r = lane >> 3, c4 = 4 * (lane & 7);
#pragma unroll
    for (int i = 0; i < 4; ++i) { const f32x4 f = w[i] * sc[i]; LAS float* d = scr + (r + 8 * i) * 33 + c4; d[0] = f[0]; d[1] = f[1]; d[2] = f[2]; d[3] = f[3]; }
    LDS_WAIT(); asm volatile("" ::: "memory");
    const int rowbase = J.rmode == 0 ? J.roff + n0 : (n0 >> 7) * 256 + (n0 & 127) + J.roff;
    const int c = lane & 3;
#pragma unroll
    for (int j = 0; j < 2; ++j) { const int n = (lane >> 2) + 16 * j; const LAS float* s = scr + (8 * c) * 33 + n;
        v4u o; o.x = pkbf(s[0 * 33], s[1 * 33]); o.y = pkbf(s[2 * 33], s[3 * 33]); o.z = pkbf(s[4 * 33], s[5 * 33]); o.w = pkbf(s[6 * 33], s[7 * 33]);
        *(GAS v4u*)(J.WT + (size_t)(rowbase + n) * J.ldk + J.koff + k0 + 8 * c) = o; }
    LDS_WAIT(); asm volatile("" ::: "memory");
}
__device__ __forceinline__ CJ get_job(const Frame& F, int kind, int j, int layer, int ab, bf16* Wb) {
    CJ J; J.sc = nullptr; J.smode = 0; J.koff = 0; J.rmode = 0; J.roff = 0;
    if (kind == 0) {
        const float* wg = inptr(F, ab ? I_FBWG : I_FAWG) + (size_t)layer * D * FF; const float* wu = inptr(F, ab ? I_FBWU : I_FAWU) + (size_t)layer * D * FF; const float* wd = inptr(F, ab ? I_FBWD : I_FAWD) + (size_t)layer * D * FF;
        if (j < 2) { J.W = j == 0 ? wg : wu; J.K = D; J.N = FF; J.Npad = FF; J.WT = Wb + W_GU / 2; J.ldk = D; J.rmode = 1; J.roff = j == 0 ? 0 : 128; }
        else { J.W = wd; J.K = FF; J.N = D; J.Npad = D; J.WT = Wb + W_D / 2; J.ldk = FF; }
    } else if (kind == 1) {
        if (j < 12) {
            const int s = j >> 1, half = j & 1;
            J.W = inptr(F, s == 0 ? I_WR : (s == 1 ? I_WK : (s == 2 ? I_WV : (s == 3 ? I_W1 : (s == 4 ? I_A1 : I_G1)))));
            J.N = s < 3 ? 1024 : (s < 5 ? 64 : 160); J.Npad = s < 3 ? 1024 : (s < 5 ? 64 : 384);
            J.roff = s < 3 ? 1024 * s : (s == 3 ? 3072 : (s == 4 ? 3136 : 3200));
            const int mui = s == 0 ? 0 : (s == 1 ? 2 : (s == 2 ? 3 : (s == 3 ? 1 : (s == 4 ? 4 : 5))));
            J.sc = inptr(F, I_MU) + mui * D; J.smode = half ? 1 : 2; J.koff = half * D; J.K = D; J.ldk = KRW; J.WT = Wb + W_RW / 2;
        } else { J.W = inptr(F, I_WO); J.K = D; J.N = D; J.Npad = D; J.WT = Wb + W_O / 2; J.ldk = D; }
    } else {
        if (j == 0) { J.W = inptr(F, I_WIN); J.K = D; J.N = 3088; J.Npad = NIN; J.WT = Wb + W_IN / 2; J.ldk = D; }
        else { J.W = inptr(F, I_WOUT); J.K = D; J.N = D; J.Npad = D; J.WT = Wb + W_OUT / 2; J.ldk = D; }
    }
    return J;
}
__device__ __forceinline__ void convert_weights(const Frame& F, int kind, int layer, int ab, bf16* Wb, const int cu0 = 0) {
    LAS float* scr = (LAS float*)(F.lds + F.wave * 16384);
    const int gw = (F.vcu - cu0) * NWAVES + F.wave, NGW = (F.G - cu0) * NWAVES;
    const int njobs = kind == 0 ? 3 : (kind == 1 ? 13 : 2);
    int total = 0;
    for (int j = 0; j < njobs; ++j) { const CJ J = get_job(F, kind, j, layer, ab, Wb); total += cj_items(J); }
    if (gw < total) {
        int r = gw, j = 0; CJ J = get_job(F, kind, 0, layer, ab, Wb);
        while (r >= cj_items(J)) { r -= cj_items(J); ++j; J = get_job(F, kind, j, layer, ab, Wb); }
        f32x4 w[4]; float sc[4];
        conv_load(J, r, F.lane, w, sc);
        for (int g = gw; g < total;) {
            const int gn = g + NGW; int rn = 0; CJ Jn = J; f32x4 wn[4]; float sn[4];
#pragma unroll
            for (int i = 0; i < 4; ++i) { wn[i] = (f32x4){0.f, 0.f, 0.f, 0.f}; sn[i] = 0.f; }
            if (gn < total) {
                rn = gn; int jn = 0; Jn = get_job(F, kind, 0, layer, ab, Wb);
                while (rn >= cj_items(Jn)) { rn -= cj_items(Jn); ++jn; Jn = get_job(F, kind, jn, layer, ab, Wb); }
                conv_load(Jn, rn, F.lane, wn, sn);
            }
            conv_store(J, scr, r, F.lane, w, sc);
            J = Jn; r = rn; g = gn;
#pragma unroll
            for (int i = 0; i < 4; ++i) { w[i] = wn[i]; sc[i] = sn[i]; }
        }
    }
    if (kind == 1) {
        bf16* WT = Wb + W_L2 / 2; const float* w2 = inptr(F, I_W2); const float* a2 = inptr(F, I_A2); const float* g2 = inptr(F, I_G2);
        for (int idx = (F.vcu * NWAVES + F.wave) * 64 + F.lane; idx < 48 * NL2; idx += F.G * NWAVES * 64) {
            const int c = idx / NL2, n = idx % NL2, type = n >> 10, jj = n & 1023;
            const float* src = nullptr;
            if (type == 0 && c < 8) src = w2 + (size_t)(8 * c) * D + jj;
            else if (type == 1 && c >= 8 && c < 16) src = a2 + (size_t)(8 * (c - 8)) * D + jj;
            else if (type == 2 && c >= 16 && c < 36) src = g2 + (size_t)(8 * (c - 16)) * D + jj;
            float v[8];
#pragma unroll
            for (int e = 0; e < 8; ++e) v[e] = src ? src[(size_t)e * D] : 0.f;
            *(GAS v4u*)(WT + (size_t)n * KL2 + 8 * c) = pack8(v);
        }
    }
}

template <int MODE>
__device__ __forceinline__ void norm_finish(const int m, f32x4 (&v)[4], const f32x4 (&gv)[4], bf16* dst, const float* shift_in, float* out, const int lane) {
    const bool samp = m >= MP;
    float ss = 0.f;
#pragma unroll
    for (int j = 0; j < 4; ++j) ss += (v[j].x * v[j].x + v[j].y * v[j].y) + (v[j].z * v[j].z + v[j].w * v[j].w);
    const float r = 1.0f / sqrtf(wave_sum(ss) * (1.f / D) + NORM_EPS);
#pragma unroll
    for (int j = 0; j < 4; ++j) v[j] = v[j] * r * gv[j];
    if (MODE == 2) {
#pragma unroll
        for (int j = 0; j < 4; ++j) *(f32x4*)(out + O_Y + (size_t)m * D + 512 * (j >> 1) + 8 * lane + 4 * (j & 1)) = v[j];
    } else if (MODE == 0) {
#pragma unroll
        for (int j = 0; j < 2; ++j) st8bf(dst + (size_t)m * D + 512 * j + 8 * lane, v[2 * j], v[2 * j + 1]);
    } else {
        int t, b; bool first, last;
        if (!samp) { t = m & (PT - 1); b = m >> 11; first = t == 0; last = t == PT - 1; } else { const int mm = m - MP; t = mm & 3; b = mm >> 2; first = t == 0; last = t == 3; }
#pragma unroll
        for (int j = 0; j < 2; ++j) { const int eo = 512 * j + 8 * lane;
            st8bf(dst + (size_t)m * (2 * D) + eo, v[2 * j], v[2 * j + 1]);
            if (!last) st8bf(dst + (size_t)(m + 1) * (2 * D) + D + eo, v[2 * j], v[2 * j + 1]);
            else { float* so = out + (samp ? O_S_SHIFT : O_P_SHIFT) + (size_t)b * D + eo; *(f32x4*)so = v[2 * j]; *(f32x4*)(so + 4) = v[2 * j + 1]; }
            if (first) { f32x4 s0 = {0.f, 0.f, 0.f, 0.f}, s1 = s0;
                if (samp) { s0 = *(const f32x4*)(shift_in + (size_t)b * D + eo); s1 = *(const f32x4*)(shift_in + (size_t)b * D + eo + 4); }
                st8bf(dst + (size_t)m * (2 * D) + D + eo, s0, s1); }
        }
    }
}
template <bool F32>
__device__ __forceinline__ void row_load(const void* src, const size_t row, const int lane, f32x4 (&v)[4]) {
    if (F32) { const float* p = (const float*)src + row * D;
#pragma unroll
        for (int j = 0; j < 4; ++j) v[j] = *(const f32x4*)(p + 512 * (j >> 1) + 8 * lane + 4 * (j & 1));
    } else { const bf16* p = (const bf16*)src + row * D;
#pragma unroll
        for (int j = 0; j < 2; ++j) ld8bf(p + 512 * j + 8 * lane, v[2 * j], v[2 * j + 1]); }
}
template <int NS>
__device__ __forceinline__ void samp_row_fold(const float* slab, const int ms, const float coef, const int lane, f32x4 (&v)[4]) {
#pragma unroll
    for (int h = 0; h < 2; ++h) {
        f32x4 t[NS > 0 ? NS : 1][2];
#pragma unroll
        for (int s = 0; s < NS; ++s)
#pragma unroll
            for (int jj = 0; jj < 2; ++jj) t[s][jj] = *(const f32x4*)(slab + ((size_t)s * MS + ms) * D + 512 * h + 8 * lane + 4 * jj);
#pragma unroll
        for (int jj = 0; jj < 2; ++jj)
#pragma unroll
            for (int s = 0; s < NS; ++s) v[2 * h + jj] += t[s][jj] * coef;
    }
}
template <int MODE, bool PF32, bool SF32>
__device__ __forceinline__ void norm_rows(const Frame& F, const void* base_p, const void* base_s, int nslab, float coef, const float* slab, bf16* xr,
                                          const float* gain, bf16* dst, const float* shift_in, float* out, const int pvar = 0) {
    const int gw = F.vcu * NWAVES + F.wave, NGW = F.G * NWAVES, lane = F.lane;
    f32x4 gv[4];
#pragma unroll
    for (int j = 0; j < 4; ++j) gv[j] = *(const f32x4*)(gain + 512 * (j >> 1) + 8 * lane + 4 * (j & 1));
    for (int s = F.wave * F.G + F.vcu; s < MS; s += NWAVES * F.G) {
        const int m = MP + s; f32x4 v[4];
        row_load<SF32>(base_s, (size_t)s, lane, v);
        if (nslab == 11) samp_row_fold<11>(slab, s, coef, lane, v); else if (nslab == 4) samp_row_fold<4>(slab, s, coef, lane, v);
        if (nslab > 0 && MODE != 2 && pvar == 0) {
#pragma unroll
            for (int j = 0; j < 2; ++j) st8bf(xr + (size_t)m * D + 512 * j + 8 * lane, v[2 * j], v[2 * j + 1]); }
        norm_finish<MODE>(m, v, gv, dst, shift_in, out, lane);
    }
    int m = gw; f32x4 v[4];
    if (m < MP) row_load<PF32>(base_p, (size_t)m, lane, v);
    while (m < MP) {
        const int mn = m + NGW; f32x4 vn[4];
#pragma unroll
        for (int j = 0; j < 4; ++j) vn[j] = (f32x4){0.f, 0.f, 0.f, 0.f};
        if (mn < MP) row_load<PF32>(base_p, (size_t)mn, lane, vn);
        norm_finish<MODE>(m, v, gv, dst, shift_in, out, lane);
#pragma unroll
        for (int j = 0; j < 4; ++j) v[j] = vn[j];
        m = mn;
    }
}

constexpr int RW_KK = 0, RW_DD = 4096, RW_BB = 8192, RW_KP = 12288, RW_RR = 16384, RW_VV = 20480, RW_YY = 24576;
__device__ __forceinline__ void rwkv_chain(const Frame& F, int row0, int T, int h, const float* S0, float* ST,
                                           const bf16* Rb, const bf16* Kb, const bf16* Vb, const bf16* Db, const bf16* Ab, bf16* Gb,
                                           const float* k_k, const float* k_a, const float* r_k, const float* gn_w, const float* gn_b, const bool do_store, const int pvar) {
    LAS float* L = (LAS float*)F.lds;
    const int tid = F.tid, lane = F.lane, w = F.wave;
    const int cg = tid & 7, tt = tid >> 3;
    const int srow = 8 * w + (lane >> 3);
    float S[8];
    if (S0) { const f32x4 a = *(const f32x4*)(S0 + srow * 64 + 8 * cg), b = *(const f32x4*)(S0 + srow * 64 + 8 * cg + 4);
        S[0] = a.x; S[1] = a.y; S[2] = a.z; S[3] = a.w; S[4] = b.x; S[5] = b.y; S[6] = b.z; S[7] = b.w; }
    else {
#pragma unroll
        for (int j = 0; j < 8; ++j) S[j] = 0.f; }
    const int ch = h * 64 + 8 * cg;
    float ckk[8], cka[8], crk[8], cgw[8], cgb[8];
#pragma unroll
    for (int j = 0; j < 8; ++j) { ckk[j] = k_k[ch + j]; cka[j] = k_a[ch + j]; crk[j] = r_k[ch + j]; cgw[j] = gn_w[ch + j]; cgb[j] = gn_b[ch + j]; }
    const int nch = (T + 63) >> 6;
    v4u pr = {0, 0, 0, 0}, pk = pr, pv = pr, pd = pr, pa = pr, pg = pr;
    { const int nt0 = T < 64 ? T : 64;
      if (tt < nt0) { const size_t off = (size_t)(row0 + tt) * D + ch;
          pr = *(const v4u*)(Rb + off); pk = *(const v4u*)(Kb + off); pv = *(const v4u*)(Vb + off); pd = *(const v4u*)(Db + off); pa = *(const v4u*)(Ab + off); pg = *(const v4u*)(Gb + off); } }
    float bon = 0.f, vv[8], gg[8];
    for (int c = 0; c < nch; ++c) {
        const int nt = (T - 64 * c) < 64 ? (T - 64 * c) : 64;
        const bool valid = tt < nt;
        {
            float r8[8], k8[8], d8[8], a8[8];
            unpack8(pr, r8); unpack8(pk, k8); unpack8(pv, vv); unpack8(pd, d8); unpack8(pa, a8); unpack8(pg, gg);
            float kk[8], ss = 0.f;
#pragma unroll
            for (int j = 0; j < 8; ++j) { kk[j] = k8[j] * ckk[j]; ss += kk[j] * kk[j]; }
            ss = red8(ss);
            const float inv = __builtin_amdgcn_rsqf(fmaxf(ss, 1e-24f));
            float kp[8], bsum = 0.f;
#pragma unroll
            for (int j = 0; j < 8; ++j) { kk[j] *= inv; kp[j] = k8[j] * (1.f + (a8[j] - 1.f) * cka[j]); bsum += r8[j] * kp[j] * crk[j]; }
            bon = red8(bsum);
            if (valid) {
                LAS float* p = L + tt * 64 + 8 * cg;
                *(LAS f32x4*)(p + RW_KK) = (f32x4){-kk[0], -kk[1], -kk[2], -kk[3]}; *(LAS f32x4*)(p + RW_KK + 4) = (f32x4){-kk[4], -kk[5], -kk[6], -kk[7]};
                *(LAS f32x4*)(p + RW_DD) = (f32x4){1.f - d8[0], 1.f - d8[1], 1.f - d8[2], 1.f - d8[3]}; *(LAS f32x4*)(p + RW_DD + 4) = (f32x4){1.f - d8[4], 1.f - d8[5], 1.f - d8[6], 1.f - d8[7]};
                *(LAS f32x4*)(p + RW_BB) = (f32x4){kk[0] * a8[0], kk[1] * a8[1], kk[2] * a8[2], kk[3] * a8[3]}; *(LAS f32x4*)(p + RW_BB + 4) = (f32x4){kk[4] * a8[4], kk[5] * a8[5], kk[6] * a8[6], kk[7] * a8[7]};
                *(LAS f32x4*)(p + RW_KP) = (f32x4){kp[0], kp[1], kp[2], kp[3]}; *(LAS f32x4*)(p + RW_KP + 4) = (f32x4){kp[4], kp[5], kp[6], kp[7]};
                *(LAS f32x4*)(p + RW_RR) = (f32x4){r8[0], r8[1], r8[2], r8[3]}; *(LAS f32x4*)(p + RW_RR + 4) = (f32x4){r8[4], r8[5], r8[6], r8[7]};
                *(LAS f32x4*)(p + RW_VV) = (f32x4){vv[0], vv[1], vv[2], vv[3]}; *(LAS f32x4*)(p + RW_VV + 4) = (f32x4){vv[4], vv[5], vv[6], vv[7]};
            }
        }
        __syncthreads();
        if (c + 1 < nch) { const int nt1 = (T - 64 * (c + 1)) < 64 ? (T - 64 * (c + 1)) : 64;
            if (tt < nt1) { const size_t off = (size_t)(row0 + 64 * (c + 1) + tt) * D + ch;
                pr = *(const v4u*)(Rb + off); pk = *(const v4u*)(Kb + off); pv = *(const v4u*)(Vb + off); pd = *(const v4u*)(Db + off); pa = *(const v4u*)(Ab + off); pg = *(const v4u*)(Gb + off); } }
        {
            typedef float f2 __attribute__((ext_vector_type(2)));
            f2 S2[4] = {{S[0], S[1]}, {S[2], S[3]}, {S[4], S[5]}, {S[6], S[7]}};
            const LAS float* p = L + 8 * cg;
            LAS float* yw = L + RW_YY + srow;
            const LAS float* vp = L + RW_VV + srow;
#define RW_LD(N, Dd, B, Q, R, VR, t_) do { const LAS float* p_ = p + (t_) * 64; \
                N[0] = *(const LAS f32x4*)(p_ + RW_KK); N[1] = *(const LAS f32x4*)(p_ + RW_KK + 4); Dd[0] = *(const LAS f32x4*)(p_ + RW_DD); Dd[1] = *(const LAS f32x4*)(p_ + RW_DD + 4); \
                B[0] = *(const LAS f32x4*)(p_ + RW_BB); B[1] = *(const LAS f32x4*)(p_ + RW_BB + 4); Q[0] = *(const LAS f32x4*)(p_ + RW_KP); Q[1] = *(const LAS f32x4*)(p_ + RW_KP + 4); \
                R[0] = *(const LAS f32x4*)(p_ + RW_RR); R[1] = *(const LAS f32x4*)(p_ + RW_RR + 4); VR = vp[(t_) * 64]; } while (0)
#define RW_STEP(N, Dd, B, Q, R, VR, t_) do { \
                f2 a_ = S2[0] * (f2){N[0].x, N[0].y}; a_ = S2[1] * (f2){N[0].z, N[0].w} + a_; a_ = S2[2] * (f2){N[1].x, N[1].y} + a_; a_ = S2[3] * (f2){N[1].z, N[1].w} + a_; \
                const float sa_ = red8(a_.x + a_.y); const f2 sv_ = {sa_, sa_}, vv_ = {VR, VR}; \
                S2[0] = S2[0] * (f2){Dd[0].x, Dd[0].y} + (sv_ * (f2){B[0].x, B[0].y} + vv_ * (f2){Q[0].x, Q[0].y}); \
                S2[1] = S2[1] * (f2){Dd[0].z, Dd[0].w} + (sv_ * (f2){B[0].z, B[0].w} + vv_ * (f2){Q[0].z, Q[0].w}); \
                S2[2] = S2[2] * (f2){Dd[1].x, Dd[1].y} + (sv_ * (f2){B[1].x, B[1].y} + vv_ * (f2){Q[1].x, Q[1].y}); \
                S2[3] = S2[3] * (f2){Dd[1].z, Dd[1].w} + (sv_ * (f2){B[1].z, B[1].w} + vv_ * (f2){Q[1].z, Q[1].w}); \
                f2 y_ = S2[0] * (f2){R[0].x, R[0].y}; y_ = S2[1] * (f2){R[0].z, R[0].w} + y_; y_ = S2[2] * (f2){R[1].x, R[1].y} + y_; y_ = S2[3] * (f2){R[1].z, R[1].w} + y_; \
                yw[(t_) * 64] = red8(y_.x + y_.y); } while (0)
            f32x4 nA[2], dA[2], bA[2], qA[2], rA[2]; float vA;
            for (int t = 0; t < nt; ++t) { RW_LD(nA, dA, bA, qA, rA, vA, t); RW_STEP(nA, dA, bA, qA, rA, vA, t); }
#undef RW_LD
#undef RW_STEP
            S[0] = S2[0].x; S[1] = S2[0].y; S[2] = S2[1].x; S[3] = S2[1].y; S[4] = S2[2].x; S[5] = S2[2].y; S[6] = S2[3].x; S[7] = S2[3].y;
        }
        __syncthreads();
        if (pvar != 4) {
            f32x4 y0 = {0.f, 0.f, 0.f, 0.f}, y1 = y0;
            if (valid) { y0 = *(const LAS f32x4*)(L + RW_YY + tt * 64 + 8 * cg); y1 = *(const LAS f32x4*)(L + RW_YY + tt * 64 + 8 * cg + 4); }
            float yy[8] = {y0.x, y0.y, y0.z, y0.w, y1.x, y1.y, y1.z, y1.w};
            float s1 = 0.f;
#pragma unroll
            for (int j = 0; j < 8; ++j) s1 += yy[j];
            const float mean = red8(s1) * (1.f / 64.f);
            float s2 = 0.f;
#pragma unroll
            for (int j = 0; j < 8; ++j) { yy[j] -= mean; s2 += yy[j] * yy[j]; }
            const float rstd = __builtin_amdgcn_rsqf(red8(s2) * (1.f / 64.f) + GN_EPS);
            float o[8];
#pragma unroll
            for (int j = 0; j < 8; ++j) o[j] = ((yy[j] * rstd) * cgw[j] + cgb[j] + bon * vv[j]) * gg[j];
            if (valid && do_store) *(v4u*)(Gb + (size_t)(row0 + 64 * c + tt) * D + ch) = pack8(o);
        }
    }
    *(f32x4*)(ST + srow * 64 + 8 * cg) = (f32x4){S[0], S[1], S[2], S[3]}; *(f32x4*)(ST + srow * 64 + 8 * cg + 4) = (f32x4){S[4], S[5], S[6], S[7]};
    __syncthreads();
}

constexpr int RH_TC = 32, RH_BUF = 12288;
constexpr int RH_KK = 0, RH_DD = 2048, RH_BB = 4096, RH_KP = 6144, RH_RR = 8192, RH_VV = 10240, RH_YY = 11264;
__device__ __forceinline__ void rwkv_half_chain(const Frame& F, int b, int h, int half, float* ST, const bf16* Rb, const bf16* Kb, const bf16* Vb, const bf16* Db, const bf16* Ab,
                                                bf16* YRAW, float* BON, const float* k_k, const float* k_a, const float* r_k, const int pvar) {
    LAS float* L = (LAS float*)F.lds;
    const int tid = F.tid, lane = F.lane, w = F.wave, row0 = b * PT;
    constexpr int nch = PT / RH_TC;
    if (w < 4) {
        const int srow = 8 * w + (lane >> 3), cq = lane & 7;
        f32x4 S4 = {0.f, 0.f, 0.f, 0.f}, S5 = S4;
        __syncthreads();
        __builtin_amdgcn_s_setprio(3);
        for (int c = 0; c < nch; ++c) {
            const LAS float* p = L + (c & 1) * RH_BUF + 8 * cq;
            LAS float* yw = L + (c & 1) * RH_BUF + RH_YY + srow;
            const LAS float* vp = L + (c & 1) * RH_BUF + RH_VV + srow;
#define RH_LD(N, Dd, B, Q, R, VR, t_) do { const LAS float* p_ = p + (t_) * 64; \
                N[0] = *(const LAS f32x4*)(p_ + RH_KK); N[1] = *(const LAS f32x4*)(p_ + RH_KK + 4); Dd[0] = *(const LAS f32x4*)(p_ + RH_DD); Dd[1] = *(const LAS f32x4*)(p_ + RH_DD + 4); \
                B[0] = *(const LAS f32x4*)(p_ + RH_BB); B[1] = *(const LAS f32x4*)(p_ + RH_BB + 4); Q[0] = *(const LAS f32x4*)(p_ + RH_KP); Q[1] = *(const LAS f32x4*)(p_ + RH_KP + 4); \
                R[0] = *(const LAS f32x4*)(p_ + RH_RR); R[1] = *(const LAS f32x4*)(p_ + RH_RR + 4); VR = vp[(t_) * 32]; } while (0)
#define RH_STEP(N, Dd, B, Q, R, VR, t_) do { \
                const f32x4 pa_ = S4 * N[0] + S5 * N[1]; const float sa_ = red8((pa_.x + pa_.y) + (pa_.z + pa_.w)); \
                S4 = S4 * Dd[0] + (B[0] * sa_ + Q[0] * VR); S5 = S5 * Dd[1] + (B[1] * sa_ + Q[1] * VR); \
                const f32x4 ya_ = S4 * R[0] + S5 * R[1]; yw[(t_) * 32] = red8((ya_.x + ya_.y) + (ya_.z + ya_.w)); } while (0)
            f32x4 nA[2], dA[2], bA[2], qA[2], rA[2], nB[2], dB[2], bB[2], qB[2], rB[2]; float vA, vB;
            RH_LD(nA, dA, bA, qA, rA, vA, 0);
            if (pvar != 3)
            for (int t = 0; t < RH_TC; t += 2) {
                RH_LD(nB, dB, bB, qB, rB, vB, t + 1);
                RH_STEP(nA, dA, bA, qA, rA, vA, t);
                RH_LD(nA, dA, bA, qA, rA, vA, (t + 2 < RH_TC ? t + 2 : t + 1));
                RH_STEP(nB, dB, bB, qB, rB, vB, t + 1);
            }
#undef RH_LD
#undef RH_STEP
            __syncthreads();
        }
        __builtin_amdgcn_s_setprio(0);
        *(f32x4*)(ST + (32 * half + srow) * 64 + 8 * cq) = S4; *(f32x4*)(ST + (32 * half + srow) * 64 + 8 * cq + 4) = S5;
    } else {
        const int ht = tid - 256, cg = ht & 7, tt = ht >> 3;
        const int ch = h * 64 + 8 * cg, vch = h * 64 + 32 * half + 4 * cg;
        float ckk[8], cka[8], crk[8];
#pragma unroll
        for (int j = 0; j < 8; ++j) { ckk[j] = k_k[ch + j]; cka[j] = k_a[ch + j]; crk[j] = r_k[ch + j]; }
        v4u pr, pk, pd, pa; uint2 pv;
#define RH_LOAD(cc) do { const size_t off_ = (size_t)(row0 + RH_TC * (cc) + tt) * D; pr = *(const v4u*)(Rb + off_ + ch); pk = *(const v4u*)(Kb + off_ + ch); pd = *(const v4u*)(Db + off_ + ch); \
            pa = *(const v4u*)(Ab + off_ + ch); pv = *(const uint2*)(Vb + off_ + vch); } while (0)
#define RH_PREP(cc) do { float r8[8], k8[8], d8[8], a8[8]; unpack8(pr, r8); unpack8(pk, k8); unpack8(pd, d8); unpack8(pa, a8); \
            float kk[8], ss = 0.f; _Pragma("unroll") for (int j = 0; j < 8; ++j) { kk[j] = k8[j] * ckk[j]; ss += kk[j] * kk[j]; } \
            ss = red8(ss); const float inv = __builtin_amdgcn_rsqf(fmaxf(ss, 1e-24f)); \
            float kp[8], bsum = 0.f; _Pragma("unroll") for (int j = 0; j < 8; ++j) { kk[j] *= inv; kp[j] = k8[j] * (1.f + (a8[j] - 1.f) * cka[j]); bsum += r8[j] * kp[j] * crk[j]; } \
            const float bon = red8(bsum); if (half == 0 && cg == 0) BON[(size_t)(row0 + RH_TC * (cc) + tt) * 16 + h] = bon; \
            LAS float* p = L + ((cc) & 1) * RH_BUF + tt * 64 + 8 * cg; \
            *(LAS f32x4*)(p + RH_KK) = (f32x4){-kk[0], -kk[1], -kk[2], -kk[3]}; *(LAS f32x4*)(p + RH_KK + 4) = (f32x4){-kk[4], -kk[5], -kk[6], -kk[7]}; \
            *(LAS f32x4*)(p + RH_DD) = (f32x4){1.f - d8[0], 1.f - d8[1], 1.f - d8[2], 1.f - d8[3]}; *(LAS f32x4*)(p + RH_DD + 4) = (f32x4){1.f - d8[4], 1.f - d8[5], 1.f - d8[6], 1.f - d8[7]}; \
            *(LAS f32x4*)(p + RH_BB) = (f32x4){kk[0] * a8[0], kk[1] * a8[1], kk[2] * a8[2], kk[3] * a8[3]}; *(LAS f32x4*)(p + RH_BB + 4) = (f32x4){kk[4] * a8[4], kk[5] * a8[5], kk[6] * a8[6], kk[7] * a8[7]}; \
            *(LAS f32x4*)(p + RH_KP) = (f32x4){kp[0], kp[1], kp[2], kp[3]}; *(LAS f32x4*)(p + RH_KP + 4) = (f32x4){kp[4], kp[5], kp[6], kp[7]}; \
            *(LAS f32x4*)(p + RH_RR) = (f32x4){r8[0], r8[1], r8[2], r8[3]}; *(LAS f32x4*)(p + RH_RR + 4) = (f32x4){r8[4], r8[5], r8[6], r8[7]}; \
            *(LAS f32x4*)(L + ((cc) & 1) * RH_BUF + RH_VV + tt * 32 + 4 * cg) = (f32x4){bflo(pv.x), bfhi(pv.x), bflo(pv.y), bfhi(pv.y)}; } while (0)
#define RH_POST(cc) do { const f32x4 y4 = *(const LAS f32x4*)(L + ((cc) & 1) * RH_BUF + RH_YY + tt * 32 + 4 * cg); uint2 o; o.x = pkbf(y4.x, y4.y); o.y = pkbf(y4.z, y4.w); \
            *(uint2*)(YRAW + (size_t)(row0 + RH_TC * (cc) + tt) * D + vch) = o; } while (0)
        RH_LOAD(0); RH_PREP(0); RH_LOAD(1);
        __syncthreads();
        for (int c = 0; c < nch; ++c) {
            if (c > 0) RH_POST(c - 1);
            if (c + 1 < nch) { RH_PREP(c + 1); if (c + 2 < nch) RH_LOAD(c + 2); }
            __syncthreads();
        }
        RH_POST(nch - 1);
#undef RH_LOAD
#undef RH_PREP
#undef RH_POST
    }
    __syncthreads();
}
__device__ __forceinline__ void rwkv_finish(const Frame& F, const bf16* YRAW, const float* BON, const bf16* Vb, bf16* Gb, const float* gn_w, const float* gn_b) {
    const int gt = (F.vcu * NWAVES + F.wave) * 64 + F.lane, NT = F.G * NWAVES * 64;
    for (int task = gt; task < MP * 128; task += NT) {
        const int cg = task & 7, hh = (task >> 3) & 15, row = task >> 7; const size_t off = (size_t)row * D + hh * 64 + 8 * cg;
        float yy[8], vv[8], gg[8]; unpack8(*(const v4u*)(YRAW + off), yy); unpack8(*(const v4u*)(Vb + off), vv); unpack8(*(const v4u*)(Gb + off), gg);
        const float bon = BON[(size_t)row * 16 + hh];
        float s1 = 0.f;
#pragma unroll
        for (int j = 0; j < 8; ++j) s1 += yy[j];
        const float mean = red8(s1) * (1.f / 64.f);
        float s2 = 0.f;
#pragma unroll
        for (int j = 0; j < 8; ++j) { yy[j] -= mean; s2 += yy[j] * yy[j]; }
        const float rstd = __builtin_amdgcn_rsqf(red8(s2) * (1.f / 64.f) + GN_EPS);
        const f32x4 w0 = *(const f32x4*)(gn_w + hh * 64 + 8 * cg), w1 = *(const f32x4*)(gn_w + hh * 64 + 8 * cg + 4), b0 = *(const f32x4*)(gn_b + hh * 64 + 8 * cg), b1 = *(const f32x4*)(gn_b + hh * 64 + 8 * cg + 4);
        const float gw[8] = {w0.x, w0.y, w0.z, w0.w, w1.x, w1.y, w1.z, w1.w}, gb[8] = {b0.x, b0.y, b0.z, b0.w, b1.x, b1.y, b1.z, b1.w};
        float o[8];
#pragma unroll
        for (int j = 0; j < 8; ++j) o[j] = ((yy[j] * rstd) * gw[j] + gb[j] + bon * vv[j]) * gg[j];
        *(v4u*)(Gb + off) = pack8(o);
    }
}

constexpr int PBY = 144;
constexpr int RPY = 272;
constexpr int ML_RQK = 0, ML_S = 0, ML_KT = 9216, ML_RV = 18432, ML_Q = 35840, ML_K = 45056, ML_HB = 35840, ML_VT = 54272, ML_C = 72704, ML_F = 91136;
constexpr int MF_N = 0, MF_QN = 64, MF_RS = 128, MF_HS = 256, MF_CW = 384, MF_B63 = 1024, MF_P63 = 1056, MF_MC = 1088  , MF_GB = 1152, MF_GP = MF_GB + 2048, MF_GA = MF_GP + 2048;
typedef __attribute__((address_space(3))) unsigned short lds_u16;
#define MFMA16(a, b, c) __builtin_amdgcn_mfma_f32_16x16x32_bf16((a), (b), (c), 0, 0, 0)
__device__ __forceinline__ void mlstm_prompt_chain(const Frame& F, int b, int hh, const bf16* QKR, const bf16* VVb, const bf16* OOb, const float* IFb, bf16* HOb,
                                                   const float* conv_w, const float* conv_b, const float* norm_w, float* out, const int pvar) {
    LAS unsigned char* lds = F.lds; LAS float* Fl = (LAS float*)(lds + ML_F);
    const int tid = F.tid, lane = F.lane, w = F.wave, fr = lane & 15, fq = lane >> 4;
    for (int i = tid; i < 128 * 72; i += 512) ((lds_u16*)(lds + ML_C))[i] = 0;
    if (tid < 64) Fl[MF_N + tid] = 0.f;
    for (int i = tid; i < 640; i += 512) { const int j = i >> 7, c = i & 127, gc = c < 64 ? hh * 64 + c : 512 + hh * 64 + (c - 64); Fl[MF_CW + i] = j < 4 ? conv_w[j * D + gc] : conv_b[gc]; }
    f32x4 Cacc[4];
#pragma unroll
    for (int k = 0; k < 4; ++k) Cacc[k] = (f32x4){0.f, 0.f, 0.f, 0.f};
    const int og = tid & 15, ot = tid >> 4;
    float nw[8];
#pragma unroll
    for (int e = 0; e < 8; ++e) nw[e] = norm_w[hh * 128 + 8 * og + e];
    v4u rq[3], rv[2], ro[2];
#define ML_LOAD_QKV(cc) do { const int rowc_ = b * PT + 64 * (cc); \
        _Pragma("unroll") for (int i = 0; i < 3; ++i) { const int q = tid + 512 * i, r = q >> 4, j = q & 15, tok = 64 * (cc) - 3 + r; rq[i] = (v4u){0u, 0u, 0u, 0u}; \
            if (q < 67 * 16 && tok >= 0) rq[i] = *(const v4u*)(QKR + (size_t)(b * PT + tok) * D + (j < 8 ? hh * 64 + 8 * j : 512 + hh * 64 + 8 * (j - 8))); } \
        _Pragma("unroll") for (int i = 0; i < 2; ++i) rv[i] = *(const v4u*)(VVb + (size_t)(rowc_ + ot + 32 * i) * D + hh * 128 + 8 * og); \
        } while (0)
#define ML_LOAD_O(cc) do { const int rowc_ = b * PT + 64 * (cc); \
        _Pragma("unroll") for (int i = 0; i < 2; ++i) ro[i] = *(const v4u*)(OOb + (size_t)(rowc_ + ot + 32 * i) * D + hh * 128 + 8 * og); } while (0)
    ML_LOAD_QKV(0);
#pragma unroll
    for (int q = 0; q < 4; ++q) { const int cc = w + 8 * q; const size_t ro_ = (size_t)(b * PT + 64 * cc + lane) * 16;
        const float li = IFb[ro_ + hh], lf = IFb[ro_ + 8 + hh];
        float bc = lf;
#pragma unroll
        for (int o = 1; o < 64; o <<= 1) { const float x = __shfl_up(bc, o); if (lane >= o) bc += x; }
        const float av = li - bc; float pm = av;
#pragma unroll
        for (int o = 1; o < 64; o <<= 1) { const float x = __shfl_up(pm, o); if (lane >= o) pm = fmaxf(pm, x); }
        Fl[MF_GB + cc * 64 + lane] = bc; Fl[MF_GP + cc * 64 + lane] = pm; Fl[MF_GA + cc * 64 + lane] = av;
        if (lane == 63) { Fl[MF_B63 + cc] = bc; Fl[MF_P63 + cc] = pm; } }
    __syncthreads();
    if (tid == 0) { float mm = 0.f;
        for (int cc = 0; cc < PT / 64; ++cc) { Fl[MF_MC + cc] = mm; const float b6 = Fl[MF_B63 + cc]; mm = fmaxf(b6 + mm, b6 + Fl[MF_P63 + cc]); }
        Fl[MF_MC + PT / 64] = mm; }
    __syncthreads();
    constexpr int NC = PT / 64;
    for (int c = 0; c < NC; ++c) {
        const int rowc = b * PT + 64 * c;
        const float m_c = Fl[MF_MC + c], m_n = Fl[MF_MC + c + 1], b63 = Fl[MF_B63 + c];
#pragma unroll
        for (int i = 0; i < 3; ++i) { const int q = tid + 512 * i; if (q < 67 * 16) *(LAS v4u*)(lds + ML_RQK + (q >> 4) * RPY + 16 * (q & 15)) = rq[i]; }
#pragma unroll
        for (int i = 0; i < 2; ++i) *(LAS v4u*)(lds + ML_RV + (ot + 32 * i) * RPY + 16 * og) = rv[i];
        if (c + 1 < NC) ML_LOAD_QKV(c + 1);
        ML_LOAD_O(c);
        __syncthreads();
        float kreg[8] = {0.f, 0.f, 0.f, 0.f, 0.f, 0.f, 0.f, 0.f};
        if (pvar != 3)
#pragma unroll
        for (int i = 0; i < 2; ++i) {
            const int g = w + 8 * i, t = lane;
            float x[4][8];
#pragma unroll
            for (int j = 0; j < 4; ++j) unpack8(*(const LAS v4u*)(lds + ML_RQK + (t + j) * RPY + 16 * g), x[j]);
            float val[8];
#pragma unroll
            for (int h2 = 0; h2 < 2; ++h2) { f32x4 a = *(const LAS f32x4*)(Fl + MF_CW + 4 * 128 + 8 * g + 4 * h2);
#pragma unroll
                for (int j = 0; j < 4; ++j) { const f32x4 cw = *(const LAS f32x4*)(Fl + MF_CW + j * 128 + 8 * g + 4 * h2);
                    a.x += cw.x * x[j][4 * h2]; a.y += cw.y * x[j][4 * h2 + 1]; a.z += cw.z * x[j][4 * h2 + 2]; a.w += cw.w * x[j][4 * h2 + 3]; }
                val[4 * h2] = siluf_(a.x); val[4 * h2 + 1] = siluf_(a.y); val[4 * h2 + 2] = siluf_(a.z); val[4 * h2 + 3] = siluf_(a.w); }
            if (i == 0) {
#pragma unroll
                for (int e = 0; e < 8; ++e) val[e] *= 0.125f;
                *(LAS v4u*)(lds + ML_Q + t * PBY + 16 * w) = pack8(val);
            } else { *(LAS v4u*)(lds + ML_K + t * PBY + 16 * w) = pack8(val);
#pragma unroll
                for (int e = 0; e < 8; ++e) kreg[e] = val[e]; }
            const v4u vw = *(const LAS v4u*)(lds + ML_RV + t * RPY + 16 * g);
            lds_u16* vt = (lds_u16*)(lds + ML_VT) + (8 * g) * 72 + t;
            vt[0 * 72] = (unsigned short)(vw.x & 0xffffu); vt[1 * 72] = (unsigned short)(vw.x >> 16); vt[2 * 72] = (unsigned short)(vw.y & 0xffffu); vt[3 * 72] = (unsigned short)(vw.y >> 16);
            vt[4 * 72] = (unsigned short)(vw.z & 0xffffu); vt[5 * 72] = (unsigned short)(vw.z >> 16); vt[6 * 72] = (unsigned short)(vw.w & 0xffffu); vt[7 * 72] = (unsigned short)(vw.w >> 16);
        }
        __syncthreads();
        if (pvar != 4) {
        { const float wsv = __expf(b63 + Fl[MF_GA + c * 64 + lane] - m_n); lds_u16* kt = (lds_u16*)(lds + ML_KT) + (8 * w) * 72 + lane;
#pragma unroll
          for (int e = 0; e < 8; ++e) kt[e * 72] = f2bf1(kreg[e] * wsv); }
        { const int tq = tid >> 3, p = tid & 7; float q8[8]; unpack8(*(const LAS v4u*)(lds + ML_Q + tq * PBY + 16 * p), q8);
          float dsum = 0.f;
#pragma unroll
          for (int e = 0; e < 8; ++e) dsum += q8[e] * Fl[MF_N + 8 * p + e];
          dsum = red8(dsum); if (p == 0) Fl[MF_QN + tq] = dsum; }
        { const int ti = w >> 1, t = 16 * ti + fr; float rsum = 0.f; const float mxt = fmaxf(m_c, Fl[MF_GP + c * 64 + t]);
          typedef unsigned u2v_ __attribute__((ext_vector_type(2)));
#pragma unroll
          for (int jj = 0; jj < 2; ++jj) { const int sj = 2 * (w & 1) + jj; f32x4 acc = {0.f, 0.f, 0.f, 0.f};
#pragma unroll
              for (int ks = 0; ks < 2; ++ks) { const bf16x8 a = *(const LAS bf16x8*)(lds + ML_Q + (16 * ti + fr) * PBY + ks * 64 + fq * 16), bb = *(const LAS bf16x8*)(lds + ML_K + (16 * sj + fr) * PBY + ks * 64 + fq * 16);
                  acc = MFMA16(bb, a, acc); }
              const f32x4 av4 = *(const LAS f32x4*)(Fl + MF_GA + c * 64 + 16 * sj + 4 * fq);
#pragma unroll
              for (int r = 0; r < 4; ++r) { const int s_ = 16 * sj + 4 * fq + r; const float val = s_ <= t ? acc[r] * __expf(av4[r] - mxt) : 0.f; acc[r] = val; rsum += val; }
              u2v_ pw; pw.x = pkbf(acc[0], acc[1]); pw.y = pkbf(acc[2], acc[3]);
              *(LAS u2v_*)(lds + ML_S + (t * 72 + 16 * sj + 4 * fq) * 2) = pw; }
          rsum += __shfl_xor(rsum, 16); rsum += __shfl_xor(rsum, 32);
          if (fq == 0) Fl[MF_RS + t * 2 + (w & 1)] = rsum; }
        }
        __syncthreads();
        float hv[4][4] = {};
        if (pvar != 5) { const int ti = w & 3, t = 16 * ti + fr;
          const float mx = fmaxf(m_c, Fl[MF_GP + c * 64 + t]), wi = __expf(m_c - mx), ei = __expf(-(Fl[MF_GB + c * 64 + t] + mx));
          const float rden = __builtin_amdgcn_rcpf(fmaxf(fabsf(wi * Fl[MF_QN + t] + Fl[MF_RS + 2 * t] + Fl[MF_RS + 2 * t + 1]), ei)); float hq = 0.f;
#pragma unroll
          for (int i = 0; i < 4; ++i) { const int vt = 4 * (w >> 2) + i; f32x4 accA = {0.f, 0.f, 0.f, 0.f}, accB = accA;
#pragma unroll
              for (int ks = 0; ks < 2; ++ks) {
                  const bf16x8 aq = *(const LAS bf16x8*)(lds + ML_Q + (16 * ti + fr) * PBY + ks * 64 + fq * 16), bc = *(const LAS bf16x8*)(lds + ML_C + (16 * vt + fr) * PBY + ks * 64 + fq * 16);
                  accA = MFMA16(bc, aq, accA);
                  const bf16x8 as = *(const LAS bf16x8*)(lds + ML_S + (16 * ti + fr) * PBY + ks * 64 + fq * 16), bv = *(const LAS bf16x8*)(lds + ML_VT + (16 * vt + fr) * PBY + ks * 64 + fq * 16);
                  accB = MFMA16(bv, as, accB); }
#pragma unroll
              for (int r = 0; r < 4; ++r) { const float hh_ = (wi * accA[r] + accB[r]) * rden; hv[i][r] = hh_; hq += hh_ * hh_; } }
          hq += __shfl_xor(hq, 16); hq += __shfl_xor(hq, 32);
          if (fq == 0) Fl[MF_HS + t * 2 + (w >> 2)] = hq; }
        __syncthreads();
        if (pvar != 6) {
        { const int ti = w & 3, t = 16 * ti + fr; const float sc = __builtin_amdgcn_rsqf((Fl[MF_HS + 2 * t] + Fl[MF_HS + 2 * t + 1]) * (1.f / 128.f) + NORM_EPS);
          typedef unsigned u2v_ __attribute__((ext_vector_type(2)));
#pragma unroll
          for (int i = 0; i < 4; ++i) { u2v_ pw; pw.x = pkbf(hv[i][0] * sc, hv[i][1] * sc); pw.y = pkbf(hv[i][2] * sc, hv[i][3] * sc);
              *(LAS u2v_*)(lds + ML_HB + t * RPY + (16 * (4 * (w >> 2) + i) + 4 * fq) * 2) = pw; } }
        { const float wst = __expf(b63 + m_c - m_n);
          typedef unsigned u2v_ __attribute__((ext_vector_type(2)));
#pragma unroll
          for (int kt = 0; kt < 4; ++kt) { Cacc[kt] = Cacc[kt] * wst;
#pragma unroll
              for (int ks = 0; ks < 2; ++ks) { const bf16x8 a = *(const LAS bf16x8*)(lds + ML_VT + (16 * w + fr) * PBY + ks * 64 + fq * 16), bb = *(const LAS bf16x8*)(lds + ML_KT + (16 * kt + fr) * PBY + ks * 64 + fq * 16);
                  Cacc[kt] = MFMA16(bb, a, Cacc[kt]); }
              u2v_ pw; pw.x = pkbf(Cacc[kt][0], Cacc[kt][1]); pw.y = pkbf(Cacc[kt][2], Cacc[kt][3]);
              *(LAS u2v_*)(lds + ML_C + ((16 * w + fr) * 72 + 16 * kt + 4 * fq) * 2) = pw; }
          if (w == 0) { float sum = 0.f;
#pragma unroll
              for (int q = 0; q < 8; ++q) { float k8[8]; unpack8(*(const LAS v4u*)(lds + ML_KT + lane * PBY + 16 * q), k8);
#pragma unroll
                  for (int e = 0; e < 8; ++e) sum += k8[e]; }
              Fl[MF_N + lane] = wst * Fl[MF_N + lane] + sum; } }
        }
        __syncthreads();
        if (pvar != 7)
#pragma unroll
        for (int i = 0; i < 2; ++i) { const int t = ot + 32 * i; float h8[8], o8[8]; unpack8(*(const LAS v4u*)(lds + ML_HB + t * RPY + 16 * og), h8); unpack8(ro[i], o8);
#pragma unroll
            for (int e = 0; e < 8; ++e) h8[e] = h8[e] * nw[e] * o8[e];
            *(v4u*)(HOb + (size_t)(rowc + t) * D + hh * 128 + 8 * og) = pack8(h8); }
    }
#undef ML_LOAD_QKV
#undef ML_LOAD_O
#pragma unroll
    for (int kt = 0; kt < 4; ++kt) *(f32x4*)(out + O_P_C + ((size_t)(b * 8 + hh) * 128 + 16 * w + fr) * 64 + 16 * kt + 4 * fq) = Cacc[kt];
    if (w == 0) { out[O_P_N + (size_t)(b * 8 + hh) * 64 + lane] = Fl[MF_N + lane]; if (lane == 0) out[O_P_M + b * 8 + hh] = Fl[MF_MC + PT / 64]; }
    if (tid < 384) { const int j = tid >> 7, c = tid & 127, gc = c < 64 ? hh * 64 + c : 512 + hh * 64 + (c - 64);
        out[O_P_CONV + (size_t)(b * 3 + j) * D + gc] = bf1(QKR[(size_t)(b * PT + PT - 3 + j) * D + gc]); }
    __syncthreads();
}
__device__ __forceinline__ void mlstm_sample_item(const Frame& F, int b, int hh, const bf16* QKR, const bf16* VVb, const bf16* OOb, const float* IFb, bf16* HOb,
                                                  const float* conv_w, const float* conv_b, const float* norm_w, const float* C0, const float* n0, const float* m0p, const float* conv0, float* out) {
    LAS float* L = (LAS float*)F.lds;
    constexpr int LQ = 0, LK = 256, LV = 512, LS = 1024, LQN = 1040, LHS = 1048;
    const int tid = F.tid, lane = F.lane, w = F.wave, row0 = MP + 4 * b;
    float li[4], lf[4];
#pragma unroll
    for (int t = 0; t < 4; ++t) { li[t] = IFb[(size_t)(row0 + t) * 16 + hh]; lf[t] = IFb[(size_t)(row0 + t) * 16 + 8 + hh]; }
    const float m0 = m0p[b * 8 + hh];
    float bc[4], av[4], mt[4], wi[4], wsv[4], ei[4], bm[4];
    { float run = 0.f, pm = -3.0e38f;
#pragma unroll
      for (int t = 0; t < 4; ++t) { run += lf[t]; bc[t] = run; av[t] = li[t] - run; pm = fmaxf(pm, av[t]); mt[t] = fmaxf(run + m0, run + pm); } }
    const float m_new = mt[3], wst = __expf(bc[3] + m0 - m_new);
#pragma unroll
    for (int t = 0; t < 4; ++t) { wi[t] = __expf(bc[t] + m0 - mt[t]); wsv[t] = __expf(bc[3] + av[t] - m_new); ei[t] = __expf(-mt[t]); bm[t] = bc[t] - mt[t]; }
    { const int t = tid >> 7, c = tid & 127, gc = c < 64 ? hh * 64 + c : 512 + hh * 64 + (c - 64);
      float x[4];
#pragma unroll
      for (int j = 0; j < 4; ++j) { const int p = t + j; x[j] = p < 3 ? conv0[(size_t)(b * 3 + p) * D + gc] : bf1(QKR[(size_t)(row0 + p - 3) * D + gc]); }
      float a = conv_b[gc];
#pragma unroll
      for (int j = 0; j < 4; ++j) a += conv_w[j * D + gc] * x[j];
      const float val = siluf_(a);
      if (c < 64) L[LQ + t * 64 + c] = val * 0.125f; else L[LK + t * 64 + (c - 64)] = val;
      if (t >= 1) out[O_S_CONV + (size_t)(b * 3 + t - 1) * D + gc] = x[3];
      L[LV + t * 128 + c] = bf1(VVb[(size_t)(row0 + t) * D + hh * 128 + c]); }
    __syncthreads();
    if (w == 0) { const int pair = lane >> 2, t = pair >> 2, s = pair & 3, part = lane & 3; float dsum = 0.f;
#pragma unroll
        for (int e = 0; e < 16; ++e) dsum += L[LQ + t * 64 + 16 * part + e] * L[LK + s * 64 + 16 * part + e];
        dsum = red4(dsum);
        const float bmt = t == 0 ? bm[0] : (t == 1 ? bm[1] : (t == 2 ? bm[2] : bm[3])), avs = s == 0 ? av[0] : (s == 1 ? av[1] : (s == 2 ? av[2] : av[3]));
        if (part == 0) L[LS + pair] = s <= t ? dsum * __expf(bmt + avs) : 0.f; }
    if (w == 1) { const int t = lane >> 4, part = lane & 15; float dsum = 0.f;
#pragma unroll
        for (int e = 0; e < 4; ++e) dsum += L[LQ + t * 64 + 4 * part + e] * n0[(size_t)(b * 8 + hh) * 64 + 4 * part + e];
        dsum = red16(dsum); if (part == 0) L[LQN + t] = dsum; }
    __syncthreads();
    const int v = tid >> 2, kq = tid & 3;
    float hvv[4];
    { const size_t coff = ((size_t)(b * 8 + hh) * 128 + v) * 64 + 16 * kq;
      float c0[16];
#pragma unroll
      for (int e4 = 0; e4 < 4; ++e4) { const f32x4 x = *(const f32x4*)(C0 + coff + 4 * e4); c0[4 * e4] = x.x; c0[4 * e4 + 1] = x.y; c0[4 * e4 + 2] = x.z; c0[4 * e4 + 3] = x.w; }
#pragma unroll
      for (int t = 0; t < 4; ++t) { float part = 0.f;
#pragma unroll
          for (int e = 0; e < 16; ++e) part += c0[e] * L[LQ + t * 64 + 16 * kq + e];
          const float inter = red4(part);
          float num = wi[t] * inter, den = wi[t] * L[LQN + t];
#pragma unroll
          for (int s = 0; s < 4; ++s) { const float sm = L[LS + t * 4 + s]; num += sm * L[LV + s * 128 + v]; den += sm; }
          hvv[t] = num / fmaxf(fabsf(den), ei[t]); }
#pragma unroll
      for (int t = 0; t < 4; ++t) { const float x = wave_sum(kq == 0 ? hvv[t] * hvv[t] : 0.f); if (lane == 0) L[LHS + w * 4 + t] = x; }
      float cn[16];
#pragma unroll
      for (int e = 0; e < 16; ++e) { float a = wst * c0[e];
#pragma unroll
          for (int s = 0; s < 4; ++s) a += wsv[s] * L[LV + s * 128 + v] * L[LK + s * 64 + 16 * kq + e];
          cn[e] = a; }
#pragma unroll
      for (int e4 = 0; e4 < 4; ++e4) *(f32x4*)(out + O_S_C + coff + 4 * e4) = (f32x4){cn[4 * e4], cn[4 * e4 + 1], cn[4 * e4 + 2], cn[4 * e4 + 3]}; }
    __syncthreads();
    if (kq == 0) {
#pragma unroll
        for (int t = 0; t < 4; ++t) { float tot = 0.f;
#pragma unroll
            for (int ww = 0; ww < 8; ++ww) tot += L[LHS + ww * 4 + t];
            const float sc = 1.0f / sqrtf(tot * (1.f / 128.f) + NORM_EPS); const size_t off = (size_t)(row0 + t) * D + hh * 128 + v;
            HOb[off] = f2bf1(hvv[t] * sc * norm_w[hh * 128 + v] * bf1(OOb[off])); } }
    if (tid < 64) { float a = wst * n0[(size_t)(b * 8 + hh) * 64 + tid];
#pragma unroll
        for (int s = 0; s < 4; ++s) a += wsv[s] * L[LK + s * 64 + tid];
        out[O_S_N + (size_t)(b * 8 + hh) * 64 + tid] = a; }
    if (tid == 0) out[O_S_M + b * 8 + hh] = m_new;
    __syncthreads();
}

constexpr int CA_AH = 0, CA_BH = 9216, CA_KH = 18432, CA_RH = 27648, CA_BT = 36864, CA_KT = 46080, CA_VT = 55296, CA_AB = 64512, CA_AK = 73728, CA_RB = 82944, CA_RK = 92160, CA_XT = 101376,
              CA_TD = 119808, CA_NF = 123904, CA_GL = 128000, CA_LG = CA_AB  , CA_AT = CA_KH  ;
__device__ __forceinline__ bf16x8 ldsfrag(LAS unsigned char* lds, int base, int row, int ks, int fq) { return *(const LAS bf16x8*)(lds + base + row * PBY + ks * 64 + fq * 16); }
__device__ __forceinline__ void rwkv_chunk_item(const Frame& F, int chain, int chunk, bf16* Rb, bf16* Kb, bf16* Vb, bf16* Db, bf16* Ab, bf16* Gb,
                                                const float* k_k, const float* k_a, const float* r_k, float* BON, bf16* dummy, v4u (&pf)[6], const int nchain, const int nchunk) {
    LAS unsigned char* lds = F.lds;
    const int tid = F.tid, lane = F.lane, w = F.wave, fr = lane & 15, fq = lane >> 4, cg = tid & 7, tt = tid >> 3;
    const int h = chain & 15, row0 = (chain >> 4) * PT + 64 * chunk, ch = h * 64 + 8 * cg;
    const size_t goff = (size_t)(row0 + tt) * D + ch;
    LAS float* LG = (LAS float*)(lds + CA_LG); LAS float* GLf = (LAS float*)(lds + CA_GL);
    float r8[8], kp[8], av[8], bv[8], rd[8];
    {
        float k8[8], v8[8], d8[8], a8[8];
        unpack8(pf[0], r8); unpack8(pf[1], k8); unpack8(pf[2], v8); unpack8(pf[3], d8); unpack8(pf[4], a8);
        float ss = 0.f;
#pragma unroll
        for (int j = 0; j < 8; ++j) { av[j] = k8[j] * k_k[ch + j]; ss += av[j] * av[j]; }
        ss = red8(ss); const float inv = __builtin_amdgcn_rsqf(fmaxf(ss, 1e-24f));
        float bsum = 0.f;
#pragma unroll
        for (int j = 0; j < 8; ++j) { const float kk = av[j] * inv; kp[j] = k8[j] * (1.f + (a8[j] - 1.f) * k_a[ch + j]); bv[j] = kk * a8[j]; av[j] = -kk; bsum += r8[j] * kp[j] * r_k[ch + j]; rd[j] = __builtin_amdgcn_rcpf(1.f - d8[j]); }
        const float bon = red8(bsum);
#pragma unroll
        for (int j = 0; j < 8; ++j) { LG[(8 * cg + j) * 64 + tt] = __logf(1.f - d8[j]); ((lds_u16*)(lds + CA_VT))[(8 * cg + j) * 72 + tt] = f2bf1(v8[j]); }
        if (cg == 0 && !dummy) BON[(size_t)(row0 + tt) * 16 + h] = bon;
    }
    for (int i = tid; i < 128 * 9; i += 512) ((LAS v4u*)(lds + CA_XT))[i] = (v4u){0u, 0u, 0u, 0u};
    __syncthreads();
    { float x[8];
#pragma unroll
      for (int q = 0; q < 8; ++q) x[q] = LG[(8 * w + q) * 64 + lane];
#pragma unroll
      for (int q = 0; q < 8; ++q) {
          float v = x[q];
          v += __builtin_bit_cast(float, __builtin_amdgcn_update_dpp(0, __builtin_bit_cast(int, v), 0x111, 0xF, 0xF, true));
          v += __builtin_bit_cast(float, __builtin_amdgcn_update_dpp(0, __builtin_bit_cast(int, v), 0x112, 0xF, 0xF, true));
          v += __builtin_bit_cast(float, __builtin_amdgcn_update_dpp(0, __builtin_bit_cast(int, v), 0x114, 0xF, 0xF, true));
          v += __builtin_bit_cast(float, __builtin_amdgcn_update_dpp(0, __builtin_bit_cast(int, v), 0x118, 0xF, 0xF, true));
          v += __builtin_bit_cast(float, __builtin_amdgcn_update_dpp(0, __builtin_bit_cast(int, v), 0x142, 0xA, 0xF, false));
          v += __builtin_bit_cast(float, __builtin_amdgcn_update_dpp(0, __builtin_bit_cast(int, v), 0x143, 0xC, 0xF, false));
          x[q] = v; }
#pragma unroll
      for (int q = 0; q < 8; ++q) LG[(8 * w + q) * 64 + lane] = x[q]; }
    __syncthreads();
    {
        float ah[8], bh[8], kh[8], rh[8];
#pragma unroll
        for (int j = 0; j < 8; ++j) { const float lg = LG[(8 * cg + j) * 64 + tt]; const float G = __expf(lg), Gm1 = G * rd[j], Gi = __builtin_amdgcn_rcpf(G);
            ah[j] = av[j] * Gm1; bh[j] = bv[j] * Gi; kh[j] = kp[j] * Gi; rh[j] = r8[j] * G;
            ((lds_u16*)(lds + CA_BT))[(8 * cg + j) * 72 + tt] = f2bf1(bh[j]); ((lds_u16*)(lds + CA_KT))[(8 * cg + j) * 72 + tt] = f2bf1(kh[j]);
            if (tt == 63) GLf[8 * cg + j] = G; }
        *(LAS v4u*)(lds + CA_AH + tt * PBY + 16 * cg) = pack8(ah); *(LAS v4u*)(lds + CA_BH + tt * PBY + 16 * cg) = pack8(bh);
        *(LAS v4u*)(lds + CA_KH + tt * PBY + 16 * cg) = pack8(kh); *(LAS v4u*)(lds + CA_RH + tt * PBY + 16 * cg) = pack8(rh);
    }
    __syncthreads();
    {
        const int mi = w >> 1, ti0 = 2 * (w & 1); const int abase = mi < 2 ? CA_AH : CA_RH, bbase = (mi & 1) ? CA_KH : CA_BH, dbase = CA_AB + mi * 9216;
        bf16x8 af[2][2], bfr[4][2];
#pragma unroll
        for (int a = 0; a < 2; ++a)
#pragma unroll
            for (int ks = 0; ks < 2; ++ks) af[a][ks] = ldsfrag(lds, abase, 16 * (ti0 + a) + fr, ks, fq);
#pragma unroll
        for (int sj = 0; sj < 4; ++sj)
#pragma unroll
            for (int ks = 0; ks < 2; ++ks) bfr[sj][ks] = ldsfrag(lds, bbase, 16 * sj + fr, ks, fq);
#pragma unroll
        for (int a = 0; a < 2; ++a)
#pragma unroll
            for (int sj = 0; sj < 4; ++sj) { const int ti = ti0 + a; f32x4 acc = {0.f, 0.f, 0.f, 0.f};
#pragma unroll
                for (int ks = 0; ks < 2; ++ks) acc = MFMA16(bfr[sj][ks], af[a][ks], acc);
                const int t = 16 * ti + fr;
#pragma unroll
                for (int r = 0; r < 4; ++r) { const int s = 16 * sj + 4 * fq + r; acc[r] = (mi < 2 ? s < t : s <= t) ? acc[r] : 0.f; }
                typedef unsigned u2v_ __attribute__((ext_vector_type(2))); u2v_ pw; pw.x = pkbf(acc[0], acc[1]); pw.y = pkbf(acc[2], acc[3]);
                *(LAS u2v_*)(lds + dbase + (t * 72 + 16 * sj + 4 * fq) * 2) = pw;
                if (mi == 0 && ti == sj) *(LAS f32x4*)(lds + CA_NF + (ti * 256 + fr * 16 + 4 * fq) * 4) = acc; }
    }
    __syncthreads();
    f32x4 rhs[4];
    if (w == 0) { const int blk = fq, c = fr; const LAS float* N = (const LAS float*)(lds + CA_NF) + blk * 256; float T[16];
#pragma unroll
        for (int i = 0; i < 16; ++i) { float s = (i == c) ? 1.f : 0.f;
#pragma unroll
            for (int j = 0; j < i; ++j) s += N[i * 16 + j] * T[j];
            T[i] = s; }
        lds_u16* td = (lds_u16*)(lds + CA_TD) + blk * 512;
#pragma unroll
        for (int i = 0; i < 16; ++i) { td[i * 32 + c] = f2bf1(T[i]); td[i * 32 + 16 + c] = 0; } }
    if (w < 4) {
#pragma unroll
        for (int i = 0; i < 4; ++i)
#pragma unroll
            for (int r = 0; r < 4; ++r) rhs[i][r] = bf1(((lds_u16*)(lds + CA_AH))[(16 * i + 4 * fq + r) * 72 + 16 * w + fr]);
    } else {
#pragma unroll
        for (int i = 0; i < 4; ++i) { f32x4 acc = {0.f, 0.f, 0.f, 0.f};
#pragma unroll
            for (int ks = 0; ks < 2; ++ks) acc = MFMA16(ldsfrag(lds, CA_AK, 16 * i + fr, ks, fq), ldsfrag(lds, CA_VT, 16 * (w - 4) + fr, ks, fq), acc);
            rhs[i] = acc; }
    }
    __syncthreads();
    {
        LAS unsigned char* AT = lds + CA_AT + w * 1024;
        *(LAS unsigned long long*)(AT + fr * 64 + 32 + fq * 8) = 0ull;
#pragma unroll
        for (int i = 0; i < 4; ++i) { f32x4 acc = rhs[i];
#pragma unroll
            for (int ks = 0; ks < 2; ++ks) acc = MFMA16(ldsfrag(lds, CA_AB, 16 * i + fr, ks, fq), ldsfrag(lds, CA_XT, 16 * w + fr, ks, fq), acc);
            typedef unsigned u2v __attribute__((ext_vector_type(2)));
            u2v pa; pa.x = pkbf(acc[0], acc[1]); pa.y = pkbf(acc[2], acc[3]);
            *(LAS u2v*)(AT + fr * 64 + fq * 8) = pa;
            asm volatile("s_waitcnt lgkmcnt(0)" ::: "memory");
            f32x4 xi = {0.f, 0.f, 0.f, 0.f};
            xi = MFMA16(*(const LAS bf16x8*)(lds + CA_TD + i * 1024 + fr * 64 + fq * 16), *(const LAS bf16x8*)(AT + fr * 64 + fq * 16), xi);
            u2v px; px.x = pkbf(xi[0], xi[1]); px.y = pkbf(xi[2], xi[3]);
            *(LAS u2v*)(lds + CA_XT + (16 * w + fr) * PBY + (16 * i + 4 * fq) * 2) = px;
            asm volatile("s_waitcnt lgkmcnt(0)" ::: "memory"); }
    }
    __syncthreads();
    if (nchain >= 0) { const size_t no = (size_t)((nchain >> 4) * PT + 64 * nchunk + tt) * D + (nchain & 15) * 64 + 8 * cg;
        pf[0] = *(const v4u*)(Rb + no); pf[1] = *(const v4u*)(Kb + no); pf[2] = *(const v4u*)(Vb + no); pf[3] = *(const v4u*)(Db + no); pf[4] = *(const v4u*)(Ab + no); }
    {
        const int mi = w >> 1, ti0 = 2 * (w & 1); const int obase = mi == 0 ? CA_AB : (mi == 1 ? CA_AK : (mi == 2 ? CA_AH : CA_KH));
        const int a1 = mi < 2 ? CA_RB : (mi == 2 ? CA_BT : CA_XT), a1o = mi == 3 ? 64 : 0, b1 = mi == 3 ? CA_BT : CA_XT, b1o = mi == 1 ? 64 : 0;
        const int a2 = mi == 1 ? CA_RK : CA_VT, b2 = mi == 1 ? CA_VT : CA_KT; const bool two = (mi & 1) != 0;
        bf16x8 af[2][2], bfr[4][2];
#pragma unroll
        for (int a = 0; a < 2; ++a)
#pragma unroll
            for (int ks = 0; ks < 2; ++ks) af[a][ks] = ldsfrag(lds, a1, a1o + 16 * (ti0 + a) + fr, ks, fq);
#pragma unroll
        for (int tj = 0; tj < 4; ++tj)
#pragma unroll
            for (int ks = 0; ks < 2; ++ks) bfr[tj][ks] = ldsfrag(lds, b1, b1o + 16 * tj + fr, ks, fq);
        f32x4 acc[2][4];
#pragma unroll
        for (int a = 0; a < 2; ++a)
#pragma unroll
            for (int tj = 0; tj < 4; ++tj) { acc[a][tj] = (f32x4){0.f, 0.f, 0.f, 0.f};
#pragma unroll
                for (int ks = 0; ks < 2; ++ks) acc[a][tj] = MFMA16(bfr[tj][ks], af[a][ks], acc[a][tj]); }
        if (two) {
#pragma unroll
            for (int a = 0; a < 2; ++a)
#pragma unroll
                for (int ks = 0; ks < 2; ++ks) af[a][ks] = ldsfrag(lds, a2, 16 * (ti0 + a) + fr, ks, fq);
#pragma unroll
            for (int tj = 0; tj < 4; ++tj)
#pragma unroll
                for (int ks = 0; ks < 2; ++ks) bfr[tj][ks] = ldsfrag(lds, b2, 16 * tj + fr, ks, fq);
#pragma unroll
            for (int a = 0; a < 2; ++a)
#pragma unroll
                for (int tj = 0; tj < 4; ++tj)
#pragma unroll
                    for (int ks = 0; ks < 2; ++ks) acc[a][tj] = MFMA16(bfr[tj][ks], af[a][ks], acc[a][tj]);
        }
#pragma unroll
        for (int a = 0; a < 2; ++a) { const int row = 16 * (ti0 + a) + fr; const float glr = GLf[row];
#pragma unroll
            for (int tj = 0; tj < 4; ++tj) { const int col = 16 * tj + 4 * fq; f32x4 val = acc[a][tj];
                typedef unsigned u2v_ __attribute__((ext_vector_type(2)));
                if (mi == 0) { const u2v_ rr = *(const LAS u2v_*)(lds + CA_RH + (row * 72 + col) * 2); val += (f32x4){bflo(rr.x), bfhi(rr.x), bflo(rr.y), bfhi(rr.y)}; }
                else if (mi == 2) {
#pragma unroll
                    for (int r = 0; r < 4; ++r) val[r] = glr * (val[r] + (row == col + r ? 1.f : 0.f)); }
                else if (mi == 3) val = val * *(const LAS f32x4*)(GLf + col);
                u2v_ pw; pw.x = pkbf(val[0], val[1]); pw.y = pkbf(val[2], val[3]);
                *(LAS u2v_*)(lds + obase + (row * 72 + col) * 2) = pw; } }
    }
    __syncthreads();
    *(v4u*)((dummy ? dummy : Rb) + goff) = *(const LAS v4u*)(lds + CA_AB + tt * PBY + 16 * cg);
    *(v4u*)((dummy ? dummy : Ab) + goff) = *(const LAS v4u*)(lds + CA_AK + tt * PBY + 16 * cg);
    *(v4u*)((dummy ? dummy : Kb) + goff) = *(const LAS v4u*)(lds + CA_AH + tt * PBY + 16 * cg);
    *(v4u*)((dummy ? dummy : Db) + goff) = *(const LAS v4u*)(lds + CA_KH + tt * PBY + 16 * cg);
    __syncthreads();
}
constexpr int CB_S = 0, CB_P2 = 9216, CB_P3 = 18432, CB_Y0 = 27648, CB_Z0 = 36864, CB_YS = 46080  ;
__device__ __forceinline__ void rwkv_state_chain(const Frame& F, int chain, float* ST, const bf16* Rb, const bf16* Kb, const bf16* Vb, const bf16* Db, const bf16* Ab, bf16* Gb, const float* BON, const float* gn_w, const float* gn_b, bf16* dummy) {
    LAS unsigned char* lds = F.lds;
    const int tid = F.tid, lane = F.lane, w = F.wave, fr = lane & 15, fq = lane >> 4, cg = tid & 7, tt = tid >> 3;
    const int h = chain & 15, rowc0 = (chain >> 4) * PT, ch = h * 64 + 8 * cg;
    for (int i = tid; i < 64 * 36; i += 512) ((LAS unsigned*)(lds + CB_S))[i] = 0u;
    f32x4 Sacc[2];
    Sacc[0] = (f32x4){0.f, 0.f, 0.f, 0.f}; Sacc[1] = Sacc[0];
    v4u q2, q3, qy, qz, qg, qb; float qbon;
    float cgw[8], cgb[8];
#pragma unroll
    for (int j = 0; j < 8; ++j) { cgw[j] = gn_w[ch + j]; cgb[j] = gn_b[ch + j]; }
#define CB_LOAD(cc) do { const size_t o_ = (size_t)(rowc0 + 64 * (cc) + tt) * D + ch; q2 = *(const v4u*)(Rb + o_); q3 = *(const v4u*)(Kb + o_); qy = *(const v4u*)(Ab + o_); qz = *(const v4u*)(Db + o_); \
        qg = *(const v4u*)(Gb + o_); qb = *(const v4u*)(Vb + o_); qbon = BON[(size_t)(rowc0 + 64 * (cc) + tt) * 16 + h]; } while (0)
    CB_LOAD(0);
    for (int c = 0; c < PT / 64; ++c) {
        *(LAS v4u*)(lds + CB_P2 + tt * PBY + 16 * cg) = q2; *(LAS v4u*)(lds + CB_P3 + tt * PBY + 16 * cg) = q3;
        *(LAS v4u*)(lds + CB_Y0 + tt * PBY + 16 * cg) = qy; *(LAS v4u*)(lds + CB_Z0 + tt * PBY + 16 * cg) = qz;
        float gw[8], gb[8]; unpack8(qg, gw); unpack8(qb, gb);
        const float bonc = qbon;
        if (c + 1 < PT / 64) CB_LOAD(c + 1);
        __syncthreads();
        f32x4 yacc[2];
        typedef unsigned u2v_ __attribute__((ext_vector_type(2)));
#pragma unroll
        for (int q = 0; q < 2; ++q) { const int tq = 2 * w + q, ti = tq >> 2, tj = tq & 3, row = 16 * ti + fr, col = 16 * tj + 4 * fq;
            const u2v_ y0 = *(const LAS u2v_*)(lds + CB_Y0 + (row * 72 + col) * 2), z0 = *(const LAS u2v_*)(lds + CB_Z0 + (row * 72 + col) * 2);
            f32x4 ya = {bflo(y0.x), bfhi(y0.x), bflo(y0.y), bfhi(y0.y)}, sa = {bflo(z0.x), bfhi(z0.x), bflo(z0.y), bfhi(z0.y)};
#pragma unroll
            for (int ks = 0; ks < 2; ++ks) { ya = MFMA16(ldsfrag(lds, CB_S, 16 * tj + fr, ks, fq), ldsfrag(lds, CB_P2, 16 * ti + fr, ks, fq), ya);
                                             sa = MFMA16(ldsfrag(lds, CB_P3, 16 * tj + fr, ks, fq), ldsfrag(lds, CB_S, 16 * ti + fr, ks, fq), sa); }
            yacc[q] = ya; Sacc[q] = sa; }
        __syncthreads();
#pragma unroll
        for (int q = 0; q < 2; ++q) { const int tq = 2 * w + q, ti = tq >> 2, tj = tq & 3, row = 16 * ti + fr, col = 16 * tj + 4 * fq;
            u2v_ pw; pw.x = pkbf(Sacc[q][0], Sacc[q][1]); pw.y = pkbf(Sacc[q][2], Sacc[q][3]);
            *(LAS u2v_*)(lds + CB_S + (row * 72 + col) * 2) = pw;
            *(LAS f32x4*)(lds + CB_YS + (row * 64 + col) * 4) = yacc[q]; }
        __syncthreads();
        { const f32x4 y0 = *(const LAS f32x4*)(lds + CB_YS + (tt * 64 + 8 * cg) * 4), y1 = *(const LAS f32x4*)(lds + CB_YS + (tt * 64 + 8 * cg + 4) * 4);
          float yy[8] = {y0.x, y0.y, y0.z, y0.w, y1.x, y1.y, y1.z, y1.w}; float s1 = 0.f;
#pragma unroll
          for (int j = 0; j < 8; ++j) s1 += yy[j];
          const float mean = red8(s1) * (1.f / 64.f); float s2 = 0.f;
#pragma unroll
          for (int j = 0; j < 8; ++j) { yy[j] -= mean; s2 += yy[j] * yy[j]; }
          const float rstd = __builtin_amdgcn_rsqf(red8(s2) * (1.f / 64.f) + GN_EPS);
          float o[8];
#pragma unroll
          for (int j = 0; j < 8; ++j) o[j] = ((yy[j] * rstd) * cgw[j] + cgb[j] + bonc * gb[j]) * gw[j];
          *(v4u*)((dummy ? dummy : Gb) + (size_t)(rowc0 + 64 * c + tt) * D + ch) = pack8(o); }
    }
#undef CB_LOAD
#pragma unroll
    for (int q = 0; q < 2; ++q) { const int tq = 2 * w + q, ti = tq >> 2, tj = tq & 3; *(f32x4*)(ST + (16 * ti + fr) * 64 + 16 * tj + 4 * fq) = Sacc[q]; }
    __syncthreads();
}

#ifndef MK_N_LAUNCHES
#define MK_N_LAUNCHES 1
#endif
constexpr int N_PHASES = 22;
#ifndef PROBE_PH
#define PROBE_PH (-1)
#define PROBE_N 1
#endif
#ifndef PROBE_VAR
#define PROBE_VAR 0
#endif
#ifndef EN_MASK
#define EN_MASK 0xff
#endif
constexpr bool EN_NORM = EN_MASK & 1, EN_UP = EN_MASK & 2, EN_RES = EN_MASK & 4, EN_RW = EN_MASK & 8, EN_L2 = EN_MASK & 16, EN_SCAN = EN_MASK & 32, EN_IN = EN_MASK & 64, EN_ML = EN_MASK & 128;
struct Args { const float* in[N_IN]; float* out; unsigned char* ws; int ph_lo, ph_hi; };
__global__ void __launch_bounds__(NWAVES * 64, 2) mega_fwd(Args args) {
    extern __shared__ __attribute__((aligned(16))) unsigned char lds_raw[];
    { const int t0 = threadIdx.x;
      for (int u = t0; u < (LDS_BYTES - LDSCTL_OFF) / 4; u += NWAVES * 64) ((LAS unsigned*)((LAS unsigned char*)lds_raw + LDSCTL_OFF))[u] = 0u; }
    __syncthreads();
    { const int t0 = threadIdx.x; if (t0 < N_IN) ((LAS unsigned long long*)((LAS unsigned char*)lds_raw + TAB_OFF))[t0] = (unsigned long long)args.in[t0]; }
    __syncthreads();
    XcdBarrier bar; bar.bar = (unsigned*)((gu32*)(args.ws + WS_CTL) + CW_BAR); bar.x = 0; bar.st = nullptr;
    if (args.ph_hi - args.ph_lo > 1) bar = xcd_barrier_post((unsigned*)((gu32*)(args.ws + WS_CTL) + CW_BAR), (volatile LAS unsigned*)((LAS unsigned char*)lds_raw + MISC_OFF) + 8);
    int ph = args.ph_lo, rep = 0;
    while (ph < args.ph_hi) {
        int tid_ = threadIdx.x; asm volatile("" : "+v"(tid_));
        unsigned char* ws = args.ws; float* out = args.out;
        Frame F;
        F.lds = (LAS unsigned char*)lds_raw;
        F.MISC = (volatile LAS unsigned*)(F.lds + MISC_OFF);
        F.tid = tid_; F.lane = F.tid & 63; F.wave = __builtin_amdgcn_readfirstlane(F.tid >> 6);
        F.G = gridDim.x; { const int bx = blockIdx.x; F.vcu = (F.G % 8 == 0) ? (bx % 8) * (F.G / 8) + bx / 8 : bx; }
        F.ctl = (gu32*)(ws + WS_CTL); F.tab = (volatile LAS unsigned long long*)(F.lds + TAB_OFF);
        bf16* Wb = (bf16*)(ws + WS_W); bf16* XR = (bf16*)(ws + WS_XR); unsigned char* big = ws + WS_BIG;
        bf16* Hb = (bf16*)(big + B_H); bf16* XN = (bf16*)(big + B_XN); float* SLAB = (float*)(big + B_SLAB);
        bf16* ACAT = (bf16*)(big + B_ACAT); bf16* Rb = (bf16*)(big + B_R); bf16* Kb = (bf16*)(big + B_K); bf16* Vb = (bf16*)(big + B_V); bf16* DECb = (bf16*)(big + B_DEC); bf16* AAb = (bf16*)(big + B_AA);
        bf16* QKR = (bf16*)(big + B_QKR); bf16* VVb = (bf16*)(big + B_VV); bf16* HOb = (bf16*)(big + B_HO); bf16* OOb = (bf16*)(big + B_OO); float* IFb = (float*)(big + B_IF);
        bf16* GGb = (bf16*)((unsigned char*)out + OS_GG); bf16* LORA = (bf16*)((unsigned char*)out + OS_LORA);
        const int c_id = (int)blockIdx.x;
        const int nrep = (ph == PROBE_PH && ph != 6) ? PROBE_N : 1;
        const int pvar = (rep + 1 < nrep) ? PROBE_VAR : 0;
        if (EN_NORM && (ph == 0 || ph == 3 || ph == 8 || ph == 11 || ph == 14 || ph == 18 || ph == 21)) {
            int kind = 0, layer = 0, ab = 0, nslab = 0; float coef = 0.5f; const float* gain = nullptr;
            if (ph == 0) { kind = 0; layer = 0; ab = 0; gain = inptr(F, I_NFA); nslab = 0; }
            else if (ph == 3) { kind = 1; gain = inptr(F, I_NMIX); nslab = 11; }
            else if (ph == 8) { kind = 0; layer = 0; ab = 1; gain = inptr(F, I_NFB); nslab = 4; coef = 1.f; }
            else if (ph == 11) { kind = 0; layer = 1; ab = 0; gain = inptr(F, I_NFA) + D; nslab = 11; }
            else if (ph == 14) { kind = 2; gain = inptr(F, I_NMIX) + D; nslab = 11; }
            else if (ph == 18) { kind = -1; gain = inptr(F, I_NFB) + D; nslab = 4; coef = 1.f; }
            else { kind = -1; gain = inptr(F, I_NFIN); nslab = 11; }
            if (kind >= 0) convert_weights(F, kind, layer, ab, Wb);
            if (ph == 0) norm_rows<0, true, true>(F, inptr(F, I_XP), inptr(F, I_XS), nslab, coef, SLAB, XR, gain, XN, nullptr, out, pvar);
            else if (ph == 3) norm_rows<1, false, true>(F, XR, inptr(F, I_XS), nslab, coef, SLAB, XR, gain, ACAT, inptr(F, I_RSHIFT), out, pvar);
            else if (ph == 21) norm_rows<2, false, false>(F, XR, XR + (size_t)MP * D, nslab, coef, SLAB, XR, gain, nullptr, nullptr, out, pvar);
            else norm_rows<0, false, false>(F, XR, XR + (size_t)MP * D, nslab, coef, SLAB, XR, gain, XN, nullptr, out, pvar);
        } else if (EN_UP && (ph == 1 || ph == 9 || ph == 12 || ph == 19)) {
            const bf16* Wu = ph == 19 ? (const bf16*)(ws + WS_W2) : Wb;
            pg8::Gemm g{XN, Wu + W_GU / 2, M, 2 * FF, D}; pg8::UnitOrder S; S.init(M / 256, 2 * FF / 256, D, F.G, c_id, 0);
            EpiSwiglu E{Hb, pvar};
            pg8::gemm_phase<EpiSwiglu, pg8::UnitOrder, true, true>(F.lds, g, S, E, F.tid);
        } else if (EN_RES && (ph == 2 || ph == 7 || ph == 10 || ph == 13 || ph == 17 || ph == 20)) {
            const bf16* A = Hb; const bf16* Bt = (ph == 20 ? (const bf16*)(ws + WS_W2) : Wb) + W_D / 2; int K = FF; float coef = 0.5f; const float* basef = nullptr;
            if (ph == 2) basef = inptr(F, I_XP);
            if (ph == 7) { A = GGb; Bt = Wb + W_O / 2; K = D; coef = 1.f; }
            if (ph == 17) { A = HOb; Bt = Wb + W_OUT / 2; K = D; coef = 1.f; }
            pg8::Gemm g{A, Bt, M, D, K}; pg8::UnitOrder S; S.init(MP / 256, D / 256, K, F.G, c_id, K / 256);
            EpiRes E{basef, XR, XR, SLAB, coef};
            pg8::gemm_phase<EpiRes, pg8::UnitOrder, true, true>(F.lds, g, S, E, F.tid);
        } else if (EN_RW && ph == 4) {
            pg8::Gemm g{ACAT, Wb + W_RW / 2, M, NRW, KRW}; pg8::UnitOrder S; S.init(M / 256, NRW / 256, KRW, F.G, c_id, 0);
            EpiRw E{Rb, Kb, Vb, LORA};
            pg8::gemm_phase<EpiRw, pg8::UnitOrder, true, true>(F.lds, g, S, E, F.tid);
        } else if (EN_L2 && ph == 5) {
            pg8::Gemm g{LORA, Wb + W_L2 / 2, M, NL2, KL2}; pg8::UnitOrder S; S.init(M / 256, NL2 / 256, KL2, F.G, c_id, -1);
            EpiL2 E{DECb, AAb, GGb, inptr(F, I_W0), inptr(F, I_A0)};
            pg8::gemm_phase<EpiL2, pg8::UnitOrder, true, true>(F.lds, g, S, E, F.tid);
        } else if (EN_SCAN && ph == 6) {
            bf16* dummy = (bf16*)(ws + WS_YRAW);
            for (int dr = (PROBE_PH == 6 && PROBE_VAR == 5) ? PROBE_N - 1 : 0; dr >= 0; --dr) {
                v4u pf[6]; pf[5] = (v4u){0u, 0u, 0u, 0u};
                { const int it = F.vcu, cg_ = F.tid & 7, tt_ = F.tid >> 3; const size_t o = (size_t)(((it >> 5) >> 4) * PT + 64 * (it & 31) + tt_) * D + ((it >> 5) & 15) * 64 + 8 * cg_;
                  pf[0] = *(const v4u*)(Rb + o); pf[1] = *(const v4u*)(Kb + o); pf[2] = *(const v4u*)(Vb + o); pf[3] = *(const v4u*)(DECb + o); pf[4] = *(const v4u*)(AAb + o); }
                for (int it = F.vcu; it < PB * 16 * (PT / 64); it += F.G) { const int nx = it + F.G < PB * 16 * (PT / 64) ? it + F.G : -1;
                    rwkv_chunk_item(F, it >> 5, it & 31, Rb, Kb, Vb, DECb, AAb, GGb, inptr(F, I_KK), inptr(F, I_KA), inptr(F, I_RK), (float*)(ws + WS_BON), dr ? dummy : nullptr, pf, nx < 0 ? -1 : nx >> 5, nx & 31); }
            }
            xcd_barrier(bar);
            for (int dr = (PROBE_PH == 6 && PROBE_VAR == 6) ? PROBE_N - 1 : 0; dr >= 0; --dr)
                if (F.vcu < 128) rwkv_state_chain(F, F.vcu, out + O_P_S + (size_t)F.vcu * 4096, Rb, Kb, Vb, DECb, AAb, GGb, (const float*)(ws + WS_BON), inptr(F, I_GNW), inptr(F, I_GNB), dr ? dummy : nullptr);
            { const int i0 = F.vcu < 128 ? 2 * F.vcu : 256 + 14 * (F.vcu - 128), i1 = F.vcu < 128 ? i0 + 2 : i0 + 14;
              for (int i = i0; i < i1; ++i) { const int b = i >> 4, h = i & 15;
                  rwkv_chain(F, MP + b * STK, STK, h, inptr(F, I_RS) + (size_t)i * 4096, out + O_S_S + (size_t)i * 4096, Rb, Kb, Vb, DECb, AAb, GGb, inptr(F, I_KK), inptr(F, I_KA), inptr(F, I_RK), inptr(F, I_GNW), inptr(F, I_GNB), true, 0); } }
        } else if (EN_IN && ph == 15) {
            pg8::Gemm g{XN, Wb + W_IN / 2, M, NIN, D}; pg8::UnitOrder S; S.init(M / 256, NIN / 256, D, F.G, c_id, 0);
            EpiIn E{QKR, VVb, OOb, IFb, inptr(F, I_BIF), pvar};
            pg8::gemm_phase<EpiIn, pg8::UnitOrder, true, true>(F.lds, g, S, E, F.tid);
        } else if (EN_ML && ph == 16) {
            const int Hh = F.G >= 128 ? 64 : (F.G / 2 > 0 ? F.G / 2 : 1);
            if (F.vcu < Hh && pvar != 2) {
                for (int i = F.vcu; i < PB * 8; i += Hh) mlstm_prompt_chain(F, i >> 3, i & 7, QKR, VVb, OOb, IFb, HOb, inptr(F, I_CW), inptr(F, I_CB), inptr(F, I_MNW), out, pvar);
            }
            if ((F.vcu >= Hh || F.G == 1) && pvar != 1 && pvar < 3) {
                const int st = F.G == 1 ? 1 : F.G - Hh;
                for (int i = F.G == 1 ? 0 : F.vcu - Hh; i < SB * 8; i += st)
                    mlstm_sample_item(F, i >> 3, i & 7, QKR, VVb, OOb, IFb, HOb, inptr(F, I_CW), inptr(F, I_CB), inptr(F, I_MNW), inptr(F, I_MC), inptr(F, I_MN), inptr(F, I_MM), inptr(F, I_MCONV), out);
            }
            if (F.vcu >= Hh && F.G > Hh && rep + 1 == nrep) convert_weights(F, 0, 1, 1, (bf16*)(ws + WS_W2), Hh);
        }
        if (++rep < nrep) continue;
        rep = 0;
        if (ph + 1 < args.ph_hi) xcd_barrier(bar);
        ++ph;
    }
}

extern "C" void kernel_launch(void* const* d_in, const int* in_sizes, int n_in, void* d_out, int out_size, void* d_ws, size_t ws_size, hipStream_t stream) {
    static int grid = 0;
    if (grid == 0) {
        if (n_in != N_IN || out_size != (int)O_END || ws_size < WS_END2) { fprintf(stderr, "kernel_launch: unexpected shapes (n_in %d, out %d, ws %zu); nothing launched\n", n_in, out_size, ws_size); grid = -1; return; }
        int dev = 0, cus = 0, per_cu = 0;
        if (hipGetDevice(&dev) != hipSuccess || hipDeviceGetAttribute(&cus, hipDeviceAttributeMultiprocessorCount, dev) != hipSuccess) { grid = -1; return; }
        if (hipFuncSetAttribute((const void*)mega_fwd, hipFuncAttributeMaxDynamicSharedMemorySize, LDS_BYTES) != hipSuccess) { fprintf(stderr, "kernel_launch: hipFuncSetAttribute failed\n"); grid = -1; return; }
        if (hipOccupancyMaxActiveBlocksPerMultiprocessor(&per_cu, (const void*)mega_fwd, NWAVES * 64, LDS_BYTES) != hipSuccess || per_cu < 1) { fprintf(stderr, "kernel_launch: occupancy query says %d\n", per_cu); per_cu = 1; }
        (void)hipGetLastError();
        grid = cus;
    }
    if (grid < 0) return;
    (void)hipMemsetAsync((char*)d_ws + WS_CTL, 0, CTL_ZERO_BYTES, stream);
    Args a{};
    for (int i = 0; i < N_IN; ++i) a.in[i] = (const float*)d_in[i];
    a.out = (float*)d_out; a.ws = (unsigned char*)d_ws;
#if MK_N_LAUNCHES == 1
    a.ph_lo = 0; a.ph_hi = N_PHASES;
    { void* kargs[] = {(void*)&a};
      const hipError_t e = hipLaunchCooperativeKernel((const void*)mega_fwd, dim3(grid), dim3(NWAVES * 64), kargs, LDS_BYTES, stream);
      if (e != hipSuccess) fprintf(stderr, "kernel_launch: cooperative launch failed: %s (grid %d)\n", hipGetErrorString(e), grid); }
#else
    for (int p = 0; p < N_PHASES; ++p) { a.ph_lo = p; a.ph_hi = p + 1; hipLaunchKernelGGL(mega_fwd, dim3(grid), dim3(NWAVES * 64), LDS_BYTES, stream, a); }
#endif
}
```

```cpp
#include <hip/hip_runtime.h>
#include <cstdio>
#include <cstdint>
namespace pg8 {
#define PG8_LAS __attribute__((address_space(3)))
typedef unsigned short bf16_t;
typedef short bf16x8 __attribute__((ext_vector_type(8)));
typedef float f32x4 __attribute__((ext_vector_type(4)));
typedef unsigned u32x4 __attribute__((ext_vector_type(4)));
constexpr int BM = 256, BK = 64, HALF = 128, HTB = HALF * BK * 2  , STAGE_BYTES = 8 * HTB, NXCD = 8, WGM = 8;

__host__ __device__ __forceinline__ int lds_byte(int r, int c) { const int st = (r >> 4) * 2 + (c >> 5), rr = r & 15, cc = c & 31, ob = rr * 64 + cc * 2; return st * 1024 + (ob ^ (((ob >> 9) & 1) << 5)); }
__host__ __device__ __forceinline__ void stage_rc(int b, int& R, int& C) { const int st = b / 1024, sb = b % 1024, swz = sb ^ (((sb >> 9) & 1) << 5); R = (st >> 1) * 16 + swz / 64; C = (st & 1) * 32 + (swz % 64) / 2; }
__host__ __device__ __forceinline__ int perm32(int rho) { const int n = rho >> 4, i = rho & 15; return 8 * (i >> 2) + 4 * n + (i & 3); }

struct Unit { int pm, pn, k0, nt, slab; };
struct Gemm { const bf16_t* A; const bf16_t* Bt; int M, N, K; };

struct UnitOrder {
    int nM, nN, nwg, G, c, ntf, tailS;
    __device__ __forceinline__ void init(int nM_, int nN_, int K, int G_, int c_, int tailS_) { nM = nM_; nN = nN_; nwg = nM * nN; G = G_; c = c_; ntf = K / BK; tailS = tailS_; }
    __device__ __forceinline__ bool next(int i, Unit& u) const {
        long L = (long)i * G + c;
        if (L < nwg) {
            int wgid = (int)L; { const int q = nwg / NXCD, r = nwg % NXCD, xcd = wgid % NXCD, off = wgid / NXCD; wgid = (xcd < r ? xcd * (q + 1) : r * (q + 1) + (xcd - r) * q) + off; }
            const int nig = WGM * nN, gid = wgid / nig, fm = gid * WGM, gsz = (nM - fm) < WGM ? (nM - fm) : WGM;
            u.pm = fm + ((wgid % nig) % gsz); u.pn = (wgid % nig) / gsz; u.k0 = 0; u.nt = ntf; u.slab = -1;
            if (tailS < 0) { u.nt = 4; u.k0 = u.pn >= 8 ? 128 : 0; }
            return true;
        }
        L -= nwg; if (tailS <= 0 || L >= 8 * tailS) return false;
        int tile, sl; if (tailS == 4) { tile = (int)L >> 2; sl = (int)L & 3; } else { tile = (int)L / 11; sl = (int)L - 11 * tile; }
        u.pm = 64 + (tile >> 2); u.pn = tile & 3; u.k0 = sl * 256; u.nt = 4; u.slab = sl; return true;
    }
    __device__ __forceinline__ void a_ready(const Unit&) const {}
    __device__ __forceinline__ void done(const Unit&) const {}
};
template <class Epi, class Sched, bool ALIGN_EPI = false, bool SP2 = false>
__device__ __forceinline__ void gemm_phase(PG8_LAS unsigned char* lds, const Gemm g, const Sched& S, const Epi& E, const int tid) {
    const int wid = __builtin_amdgcn_readfirstlane(tid >> 6), lane = tid & 63, wr = wid >> 2, wc = wid & 3, fr = lane & 15, fq = lane >> 4;
    const int K = g.K;
    unsigned voffA[2], voffB[2];
#pragma unroll
    for (int i = 0; i < 2; ++i) { int R, C; stage_rc(tid * 16 + i * 8192, R, C); const int Rb = Epi::PERM ? ((R & ~31) + perm32(R & 31)) : R;
        voffA[i] = (unsigned)(R * K + C) * 2u; voffB[i] = (unsigned)(Rb * K + C) * 2u; }
    const size_t kstep = (size_t)(BK * 2);
    const size_t hstep = (size_t)HALF * K * 2;
    const size_t tstep = 2 * hstep;
    const unsigned ldsw = (unsigned)wid * 1024u;
    const int aoff = lds_byte(wr * 64 + fr, fq * 8), boff = lds_byte(wc * 32 + fr, fq * 8);
#define PG8_SA(b, h) (((b) * 2 + (h)) * HTB)
#define PG8_SB(b, h) ((4 + (b) * 2 + (h)) * HTB)
#define PG8_STAGE(bufoff, gbase, voff) do { _Pragma("unroll") for (int _i = 0; _i < 2; ++_i) \
        __builtin_amdgcn_global_load_lds((const unsigned*)((const char*)(gbase) + (voff)[_i]), (PG8_LAS unsigned*)(lds + (bufoff) + ldsw + _i * 8192), 16, 0, 0); } while (0)
#define PG8_LDA(dst, b, h) do { _Pragma("unroll") for (int m = 0; m < 4; ++m) _Pragma("unroll") for (int k = 0; k < 2; ++k) dst[m][k] = *(const PG8_LAS bf16x8*)(lds + PG8_SA(b, h) + aoff + m * 2048 + k * 1024); } while (0)
#define PG8_LDB(dst, b, h) do { _Pragma("unroll") for (int n = 0; n < 2; ++n) _Pragma("unroll") for (int k = 0; k < 2; ++k) dst[n][k] = *(const PG8_LAS bf16x8*)(lds + PG8_SB(b, h) + boff + n * 2048 + k * 1024); } while (0)
#define PG8_MMA(ai, bj, At, Bt) do { __builtin_amdgcn_s_setprio(1); _Pragma("unroll") for (int m = 0; m < 4; ++m) _Pragma("unroll") for (int n = 0; n < 2; ++n) _Pragma("unroll") for (int k = 0; k < 2; ++k) \
        acc[ai][bj][m][n] = __builtin_amdgcn_mfma_f32_16x16x32_bf16(Bt[n][k], At[m][k], acc[ai][bj][m][n], 0, 0, 0); __builtin_amdgcn_s_setprio(0); } while (0)
#define PG8_WAIT_V(n) asm volatile("s_waitcnt vmcnt(" #n ")" ::: "memory")
#define PG8_WAIT_L(n) asm volatile("s_waitcnt lgkmcnt(" #n ")" ::: "memory")
#define PG8_BAR __builtin_amdgcn_s_barrier()
#define PG8_SCHED __builtin_amdgcn_sched_barrier(0)
    Unit cur, nxt; int ui = 0;
    if (!S.next(0, cur)) return;
    f32x4 acc[2][2][4][2];
#pragma unroll
    for (int a = 0; a < 2; ++a)
#pragma unroll
        for (int b = 0; b < 2; ++b)
#pragma unroll
            for (int m = 0; m < 4; ++m)
#pragma unroll
                for (int n = 0; n < 2; ++n) acc[a][b][m][n] = (f32x4){0.f, 0.f, 0.f, 0.f};
    bf16x8 At[4][2], B0[2][2], B1[2][2];
    const char* cA = (const char*)g.A + (size_t)cur.pm * tstep + (size_t)cur.k0 * 2; const char* cB = (const char*)g.Bt + (size_t)cur.pn * tstep + (size_t)cur.k0 * 2;
    S.a_ready(cur);
    if constexpr (SP2) {
        PG8_STAGE(PG8_SB(0, 0), cB, voffB); PG8_STAGE(PG8_SB(0, 1), cB + hstep, voffB); PG8_STAGE(PG8_SA(0, 0), cA, voffA); PG8_STAGE(PG8_SA(0, 1), cA + hstep, voffA);
        if (wr == 1) PG8_BAR;
        PG8_WAIT_V(2); PG8_BAR;
        PG8_STAGE(PG8_SB(1, 0), cB + kstep, voffB); PG8_STAGE(PG8_SA(1, 0), cA + kstep, voffA); PG8_STAGE(PG8_SB(1, 1), cB + hstep + kstep, voffB);
        PG8_WAIT_V(6); PG8_BAR;
    } else {
        PG8_STAGE(PG8_SB(0, 0), cB, voffB); PG8_STAGE(PG8_SA(0, 0), cA, voffA); PG8_STAGE(PG8_SB(0, 1), cB + hstep, voffB); PG8_STAGE(PG8_SA(0, 1), cA + hstep, voffA);
        if (wr == 1) PG8_BAR;
        PG8_WAIT_V(4); PG8_BAR;
        PG8_STAGE(PG8_SB(1, 0), cB + kstep, voffB); PG8_STAGE(PG8_SA(1, 0), cA + kstep, voffA); PG8_STAGE(PG8_SB(1, 1), cB + hstep + kstep, voffB);
        PG8_WAIT_V(6); PG8_BAR;
    }
    for (;;) {
        const bool has_next = S.next(ui + 1, nxt);
        const char* nA = has_next ? (const char*)g.A + (size_t)nxt.pm * tstep + (size_t)nxt.k0 * 2 : cA; const char* nB = has_next ? (const char*)g.Bt + (size_t)nxt.pn * tstep + (size_t)nxt.k0 * 2 : cB;
        const int nt = cur.nt;
        for (int t = 0; t < nt; t += 2) {
            const bool last = (t == nt - 2);
            const char* a1 = cA + (size_t)(t + 1) * kstep;
            const char* a2 = last ? nA : cA + (size_t)(t + 2) * kstep; const char* b2 = last ? nB : cB + (size_t)(t + 2) * kstep;
            const char* a3 = a2 + kstep; const char* b3 = b2 + kstep;
            if (last && has_next) S.a_ready(nxt);
            if constexpr (SP2) {
            PG8_LDB(B0, 0, 0); PG8_LDB(B1, 0, 1); PG8_SCHED; PG8_LDA(At, 0, 0); PG8_STAGE(PG8_SA(1, 1), a1 + hstep, voffA);
            PG8_WAIT_V(8); PG8_WAIT_L(0); PG8_BAR; PG8_MMA(0, 0, At, B0); PG8_MMA(0, 1, At, B1); PG8_BAR; PG8_SCHED;
            PG8_LDA(At, 0, 1); PG8_STAGE(PG8_SB(0, 0), b2, voffB); PG8_STAGE(PG8_SB(0, 1), b2 + hstep, voffB); PG8_STAGE(PG8_SA(0, 0), a2, voffA);
            PG8_WAIT_V(8); PG8_WAIT_L(0); PG8_BAR; PG8_MMA(1, 0, At, B0); PG8_MMA(1, 1, At, B1); PG8_BAR; PG8_SCHED;
            PG8_LDB(B0, 1, 0); PG8_LDB(B1, 1, 1); PG8_SCHED; PG8_LDA(At, 1, 0); PG8_STAGE(PG8_SA(0, 1), a2 + hstep, voffA);
            PG8_WAIT_V(8); PG8_WAIT_L(0); PG8_BAR; PG8_MMA(0, 0, At, B0); PG8_MMA(0, 1, At, B1); PG8_BAR; PG8_SCHED;
            PG8_LDA(At, 1, 1); PG8_STAGE(PG8_SB(1, 0), b3, voffB); PG8_STAGE(PG8_SB(1, 1), b3 + hstep, voffB); PG8_STAGE(PG8_SA(1, 0), a3, voffA);
            PG8_WAIT_V(8); PG8_WAIT_L(0); PG8_BAR; PG8_MMA(1, 0, At, B0); PG8_MMA(1, 1, At, B1); PG8_BAR; PG8_SCHED;
            } else {
            PG8_LDB(B0, 0, 0); PG8_SCHED; PG8_LDA(At, 0, 0); PG8_STAGE(PG8_SA(1, 1), a1 + hstep, voffA);
            PG8_WAIT_L(8); PG8_BAR; PG8_WAIT_L(0); PG8_MMA(0, 0, At, B0); PG8_BAR; PG8_SCHED;
            PG8_LDB(B1, 0, 1); PG8_STAGE(PG8_SB(0, 0), b2, voffB);
            PG8_BAR; PG8_WAIT_L(0); PG8_MMA(0, 1, At, B1); PG8_BAR;
            PG8_LDA(At, 0, 1); PG8_STAGE(PG8_SA(0, 0), a2, voffA);
            PG8_BAR; PG8_WAIT_L(0); PG8_MMA(1, 0, At, B0); PG8_BAR; PG8_SCHED;
            PG8_STAGE(PG8_SB(0, 1), b2 + hstep, voffB);
            PG8_WAIT_V(6); PG8_BAR; PG8_MMA(1, 1, At, B1); PG8_BAR;
            PG8_LDB(B0, 1, 0); PG8_SCHED; PG8_LDA(At, 1, 0); PG8_STAGE(PG8_SA(0, 1), a2 + hstep, voffA);
            PG8_WAIT_L(8); PG8_BAR; PG8_WAIT_L(0); PG8_MMA(0, 0, At, B0); PG8_BAR; PG8_SCHED;
            PG8_LDB(B1, 1, 1); PG8_STAGE(PG8_SB(1, 0), b3, voffB);
            PG8_BAR; PG8_WAIT_L(0); PG8_MMA(0, 1, At, B1); PG8_BAR;
            PG8_LDA(At, 1, 1); PG8_STAGE(PG8_SA(1, 0), a3, voffA);
            PG8_BAR; PG8_WAIT_L(0); PG8_MMA(1, 0, At, B0); PG8_BAR; PG8_SCHED;
            PG8_STAGE(PG8_SB(1, 1), b3 + hstep, voffB);
            PG8_WAIT_V(6); PG8_BAR; PG8_MMA(1, 1, At, B1); PG8_BAR;
            }
        }
        if constexpr (ALIGN_EPI) { if (wr == 0) PG8_BAR; }
        if constexpr (!Epi::AFTER_DRAIN) { E(acc, cur, wr, wc, fr, fq); S.done(cur); }
        if (!has_next) break;
#pragma unroll
        for (int a = 0; a < 2; ++a)
#pragma unroll
            for (int b = 0; b < 2; ++b)
#pragma unroll
                for (int m = 0; m < 4; ++m)
#pragma unroll
                    for (int n = 0; n < 2; ++n) acc[a][b][m][n] = (f32x4){0.f, 0.f, 0.f, 0.f};
        cur = nxt; cA = nA; cB = nB; ++ui;
        if constexpr (ALIGN_EPI) { if (wr == 1) PG8_BAR; }
    }
    PG8_WAIT_V(0);
    if constexpr (!ALIGN_EPI) { if (wr == 0) PG8_BAR; }
    PG8_BAR;
    if constexpr (Epi::AFTER_DRAIN) { E.fused(acc, cur, wr, wc, fr, fq, lds, wid, lane); S.done(cur); }
#undef PG8_SA
#undef PG8_SB
#undef PG8_STAGE
#undef PG8_LDA
#undef PG8_LDB
#undef PG8_MMA
#undef PG8_WAIT_V
#undef PG8_WAIT_L
#undef PG8_BAR
#undef PG8_SCHED
}
}

#define GAS __attribute__((address_space(1)))
#define LAS __attribute__((address_space(3)))
typedef unsigned short bf16;
typedef unsigned v4u __attribute__((ext_vector_type(4)));
typedef float f32x4 __attribute__((ext_vector_type(4)));
typedef short bf16x8 __attribute__((ext_vector_type(8)));
typedef GAS unsigned gu32;
typedef GAS unsigned long long gu64;
#define RLX_AGENT __ATOMIC_RELAXED, __HIP_MEMORY_SCOPE_AGENT
#define LDS_WAIT() asm volatile("s_waitcnt lgkmcnt(0)" ::: "memory")
#define VM_WAIT() asm volatile("s_waitcnt vmcnt(0)" ::: "memory")
__device__ __forceinline__ unsigned long long rt() { return __builtin_amdgcn_s_memrealtime(); }
__device__ __forceinline__ unsigned f2bf(float f) { unsigned u = __builtin_bit_cast(unsigned, f); return (u + 0x7fffu + ((u >> 16) & 1u)) >> 16; }
__device__ __forceinline__ unsigned pk2(float lo, float hi) { return f2bf(lo) | (f2bf(hi) << 16); }

#define XB_TMO      128
#define XB_XCNT(j)  (256  + 64 * (j))
#define XB_XSUB(j)  (1280 + 64 * (j))
#define XB_XGEN(j)  (2304 + 64 * (j))
#define XB_TOP      3328
#define XB_TOPGEN   3392
#define XCD_BAR_WORDS 3456
#define XB_SPIN_CAP (1u << 18)

__device__ __forceinline__ unsigned xb_ld(unsigned* p)              { return __hip_atomic_load(p, __ATOMIC_RELAXED, __HIP_MEMORY_SCOPE_AGENT); }
__device__ __forceinline__ unsigned xb_add(unsigned* p, unsigned v) { return __hip_atomic_fetch_add(p, v, __ATOMIC_RELAXED, __HIP_MEMORY_SCOPE_AGENT); }
__device__ __forceinline__ unsigned xb_xcc_id() { return (unsigned)__builtin_amdgcn_s_getreg((3 << 11) | 20) & 0xFu; }
#define XB_SPIN(cond, bar) do { unsigned _sp = 0; while (cond) { __builtin_amdgcn_s_sleep(1); \
    if ((++_sp & 255u) == 0u) { if (xb_ld(&(bar)[XB_TMO])) break; if (_sp > XB_SPIN_CAP) { atomicAdd(&(bar)[XB_TMO], 1u); break; } } } } while (0)

struct XcdBarrier {
    unsigned* bar; unsigned x;
    volatile LAS unsigned* st;
};

__device__ __forceinline__ XcdBarrier xcd_barrier_post(unsigned* bar, volatile LAS unsigned* st) {
    XcdBarrier b; b.bar = bar; b.x = xb_xcc_id(); b.st = st;
    if (threadIdx.x == 0) (void)xb_add(&bar[XB_XCNT(b.x)], 1u);
    return b;
}
__device__ __forceinline__ void xcd_barrier_complete(unsigned* bar, unsigned x, unsigned& nloc, unsigned& nx) {
    const unsigned G = gridDim.x * gridDim.y * gridDim.z;
    unsigned sum, cnt, mine, sp = 0u;
    for (;;) {
        sum = 0u; cnt = 0u; mine = 0u;
#pragma unroll
        for (unsigned j = 0; j < 16; ++j) { const unsigned c = xb_ld(&bar[XB_XCNT(j)]); sum += c; cnt += (c > 0u) ? 1u : 0u; mine = (j == x) ? c : mine; }
        if (sum == G) break;
        __builtin_amdgcn_s_sleep(1);
        if ((++sp & 255u) == 0u) { if (xb_ld(&bar[XB_TMO])) break; if (sp > XB_SPIN_CAP) { atomicAdd(&bar[XB_TMO], 1u); break; } }
    }
    nloc = mine > 0u ? mine : 1u; nx = cnt > 0u ? cnt : 1u;
}

__device__ __forceinline__ void xcd_barrier(const XcdBarrier& b) {
    asm volatile("s_waitcnt vmcnt(0)" ::: "memory");
    __syncthreads();
    if (threadIdx.x == 0) {
        unsigned* bar = b.bar;
        __builtin_amdgcn_s_waitcnt(0);
        unsigned nloc = b.st[0], nx = b.st[1];
        if (nloc == 0u) { xcd_barrier_complete(bar, b.x, nloc, nx); b.st[0] = nloc; b.st[1] = nx; }
        const unsigned old = xb_add(&bar[XB_XSUB(b.x)], 1u);
        const unsigned gen = old / nloc;
        if (old + 1u == (gen + 1u) * nloc) {
            __builtin_amdgcn_fence(__ATOMIC_RELEASE, "agent");
            asm volatile("s_waitcnt vmcnt(0)" ::: "memory");
            const unsigned og = xb_add(&bar[XB_TOP], 1u);
            const unsigned tg = og / nx;
            if (og + 1u == (tg + 1u) * nx) xb_add(&bar[XB_TOPGEN], 1u);
            else XB_SPIN(xb_ld(&bar[XB_TOPGEN]) == tg, bar);
            __builtin_amdgcn_fence(__ATOMIC_ACQUIRE, "agent");
            xb_add(&bar[XB_XGEN(b.x)], 1u);
            asm volatile("s_waitcnt vmcnt(0)" ::: "memory");
        } else {
            XB_SPIN(xb_ld(&bar[XB_XGEN(b.x)]) == gen, bar);
            __builtin_amdgcn_fence(__ATOMIC_ACQUIRE, "agent");
            asm volatile("s_waitcnt vmcnt(0)" ::: "memory");
        }
    }
    __syncthreads();
}

constexpr int NWAVES = 8;
constexpr int D = 1024, FF = 2816;
constexpr int PB = 8, PT = 2048, SB = 128, STK = 4;
constexpr int MP = PB * PT, MS = SB * STK, M = MP + MS;
constexpr int NRW = 3584, KRW = 2048, NL2 = 3072, KL2 = 384, NIN = 3328;
constexpr float NORM_EPS = 1e-6f, GN_EPS = 64e-5f;
typedef pg8::bf16_t bf16;

constexpr size_t MiB = 1u << 20;
constexpr size_t WS_CTL = 0, CTL_ZERO_BYTES = 64 * 1024;
constexpr size_t WS_W = 1 * MiB;
constexpr size_t WS_XR = 20 * MiB;
constexpr size_t WS_BIG = 86 * MiB;
constexpr size_t WS_END = 256 * MiB;
constexpr size_t WS_YRAW = 256 * MiB, WS_BON = 288 * MiB, WS_W2 = 289 * MiB  , WS_END2 = 308 * MiB;
constexpr size_t W_GU = 0, W_D = (size_t)2 * FF * D * 2;
constexpr size_t W_RW = 0, W_L2 = (size_t)NRW * KRW * 2, W_O = W_L2 + (size_t)NL2 * KL2 * 2;
constexpr size_t W_IN = 0, W_OUT = (size_t)NIN * D * 2;
static_assert(W_D + (size_t)D * FF * 2 <= 19 * MiB && W_O + (size_t)D * D * 2 <= 19 * MiB && W_OUT + (size_t)D * D * 2 <= 19 * MiB, "weights region");
constexpr size_t B_H = 0, B_XN = 91 * MiB, B_SLAB = 124 * MiB;
constexpr size_t B_ACAT = 0, B_R = 66 * MiB, B_K = 99 * MiB, B_V = 132 * MiB, B_DEC = 0, B_AA = 33 * MiB;
constexpr size_t B_QKR = 0, B_VV = 33 * MiB, B_HO = 66 * MiB, B_OO = 124 * MiB, B_IF = 157 * MiB;
static_assert((size_t)M * FF * 2 <= 91 * MiB && (size_t)M * D * 2 == 33 * MiB && B_IF + (size_t)M * 16 * 4 <= 170 * MiB && B_SLAB + (size_t)11 * MS * D * 4 <= 170 * MiB, "BIG map");
constexpr size_t OS_GG = 0, OS_LORA = 33 * MiB;
static_assert(OS_LORA + (size_t)M * KL2 * 2 <= (size_t)MP * D * 4, "d_out scratch");
constexpr size_t O_Y = 0, O_P_S = 17301504, O_P_SHIFT = 17825792, O_P_C = 17833984, O_P_N = 18358272, O_P_M = 18362368, O_P_CONV = 18362432,
                 O_S_S = 18387008, O_S_SHIFT = 26775616, O_S_C = 26906688, O_S_N = 35295296, O_S_M = 35360832, O_S_CONV = 35361856, O_END = 35755072;
constexpr int CW_BAR = 1024;

constexpr int RING_BYTES = 131072, LDSCTL_OFF = RING_BYTES, MISC_OFF = LDSCTL_OFF + 320, TAB_OFF = LDSCTL_OFF + 1024, LDS_BYTES = 147456;

enum { I_XP = 0, I_XS, I_RS, I_RSHIFT, I_MC, I_MN, I_MM, I_MCONV, I_NFA, I_FAWG, I_FAWU, I_FAWD, I_NMIX, I_NFB, I_FBWG, I_FBWU, I_FBWD,
       I_MU, I_WR, I_WK, I_WV, I_WO, I_W0, I_W1, I_W2, I_A0, I_A1, I_A2, I_G1, I_G2, I_KK, I_KA, I_RK, I_GNW, I_GNB,
       I_WIN, I_BIF, I_CW, I_CB, I_MNW, I_WOUT, I_NFIN, N_IN };

typedef __bf16 bf16x2_t __attribute__((ext_vector_type(2)));
typedef float f32x2_t __attribute__((ext_vector_type(2)));
__device__ __forceinline__ unsigned pkbf(float lo, float hi) { f32x2_t v = {lo, hi}; bf16x2_t b = __builtin_convertvector(v, bf16x2_t); return __builtin_bit_cast(unsigned, b); }
__device__ __forceinline__ float bflo(unsigned u) { return __builtin_bit_cast(float, u << 16); }
__device__ __forceinline__ float bfhi(unsigned u) { return __builtin_bit_cast(float, u & 0xffff0000u); }
__device__ __forceinline__ float bf1(unsigned short u) { return __builtin_bit_cast(float, (unsigned)u << 16); }
__device__ __forceinline__ unsigned short f2bf1(float f) { return (unsigned short)(pkbf(f, 0.f) & 0xffffu); }
__device__ __forceinline__ void unpack8(v4u w, float (&o)[8]) { o[0] = bflo(w.x); o[1] = bfhi(w.x); o[2] = bflo(w.y); o[3] = bfhi(w.y); o[4] = bflo(w.z); o[5] = bfhi(w.z); o[6] = bflo(w.w); o[7] = bfhi(w.w); }
__device__ __forceinline__ v4u pack8(const float (&o)[8]) { v4u w; w.x = pkbf(o[0], o[1]); w.y = pkbf(o[2], o[3]); w.z = pkbf(o[4], o[5]); w.w = pkbf(o[6], o[7]); return w; }
__device__ __forceinline__ float sigmoidf_(float x) { return __builtin_amdgcn_rcpf(1.f + __expf(-x)); }
__device__ __forceinline__ float siluf_(float x) { return x * __builtin_amdgcn_rcpf(1.f + __expf(-x)); }
__device__ __forceinline__ float tanhf_(float x) { return 1.f - 2.f * __builtin_amdgcn_rcpf(__expf(2.f * x) + 1.f); }
__device__ __forceinline__ float logsigmoidf_(float x) { return fminf(x, 0.f) - __logf(1.f + __expf(-fabsf(x))); }
template <int CTRL> __device__ __forceinline__ float dppf(float x) { return __builtin_bit_cast(float, __builtin_amdgcn_update_dpp(0, __builtin_bit_cast(int, x), CTRL, 0xF, 0xF, true)); }
__device__ __forceinline__ float red4(float x) { x += dppf<0xB1>(x); x += dppf<0x4E>(x); return x; }
__device__ __forceinline__ float red8(float x) { x = red4(x); x += dppf<0x141>(x); return x; }
__device__ __forceinline__ float red16(float x) { x = red8(x); x += dppf<0x140>(x); return x; }
__device__ __forceinline__ float wave_sum(float v) {
#pragma unroll
    for (int o = 1; o < 64; o <<= 1) v += __shfl_xor(v, o);
    return v;
}

struct Frame {
    LAS unsigned char* lds;
    volatile LAS unsigned* MISC;
    gu32* ctl;
    volatile LAS unsigned long long* tab;
    int tid, lane, wave, vcu, G;
};
__device__ __forceinline__ const float* inptr(const Frame& F, int i) { const unsigned long long v = F.tab[i];
    const unsigned lo = __builtin_amdgcn_readfirstlane((unsigned)v), hi = __builtin_amdgcn_readfirstlane((unsigned)(v >> 32)); return (const float*)(const GAS float*)(((unsigned long long)hi << 32) | lo); }

using pg8::Unit; using pg8::BM; using pg8::HALF;
__device__ __forceinline__ void st8bf(bf16* p, f32x4 v0, f32x4 v1) { v4u w; w.x = pkbf(v0[0], v0[1]); w.y = pkbf(v0[2], v0[3]); w.z = pkbf(v1[0], v1[1]); w.w = pkbf(v1[2], v1[3]); *(v4u*)p = w; }

struct EpiSwiglu {
    static constexpr bool PERM = true, AFTER_DRAIN = false;
    bf16* H; int pvar;
    __device__ __forceinline__ void operator()(const f32x4 (&acc)[2][2][4][2], const Unit& u, int wr, int wc, int fr, int fq) const {
        if (pvar == 3) return;
        const int row0 = u.pm * BM + wr * 64 + fr, col0 = u.pn * 128 + wc * 32 + 8 * fq;
#pragma unroll
        for (int ai = 0; ai < 2; ++ai)
#pragma unroll
            for (int m = 0; m < 4; ++m) {
                f32x4 o[2];
#pragma unroll
                for (int n = 0; n < 2; ++n)
#pragma unroll
                    for (int i = 0; i < 4; ++i) { const float g = acc[ai][0][m][n][i], up = acc[ai][1][m][n][i]; o[n][i] = siluf_(g) * up; }
                st8bf(H + (size_t)(row0 + ai * HALF + m * 16) * FF + col0, o[0], o[1]);
            }
    }
};
__device__ __forceinline__ void ld8bf(const bf16* p, f32x4& a, f32x4& b) { const v4u w = *(const v4u*)p; a = (f32x4){bflo(w.x), bfhi(w.x), bflo(w.y), bfhi(w.y)}; b = (f32x4){bflo(w.z), bfhi(w.z), bflo(w.w), bfhi(w.w)}; }
struct EpiRes {
    static constexpr bool PERM = true, AFTER_DRAIN = false;
    const float* basef; const bf16* baseb; bf16* out; float* slab; float coef;
    __device__ __forceinline__ void operator()(const f32x4 (&acc)[2][2][4][2], const Unit& u, int wr, int wc, int fr, int fq) const {
        const int row0 = u.pm * BM + wr * 64 + fr, col0 = u.pn * BM + wc * 32 + 8 * fq;
        if (u.slab < 0) {
            if (basef) {
#pragma unroll
                for (int ai = 0; ai < 2; ++ai)
#pragma unroll
                    for (int m = 0; m < 4; ++m) { const size_t ro = (size_t)(row0 + ai * HALF + m * 16) * D + col0;
#pragma unroll
                        for (int bj = 0; bj < 2; ++bj) { const f32x4 b0 = *(const f32x4*)(basef + ro + bj * HALF), b1 = *(const f32x4*)(basef + ro + bj * HALF + 4);
                            st8bf(out + ro + bj * HALF, b0 + acc[ai][bj][m][0] * coef, b1 + acc[ai][bj][m][1] * coef); } }
            } else {
#pragma unroll
                for (int ai = 0; ai < 2; ++ai)
#pragma unroll
                    for (int m = 0; m < 4; ++m) { const size_t ro = (size_t)(row0 + ai * HALF + m * 16) * D + col0;
#pragma unroll
                        for (int bj = 0; bj < 2; ++bj) { f32x4 b0, b1; ld8bf(baseb + ro + bj * HALF, b0, b1);
                            st8bf(out + ro + bj * HALF, b0 + acc[ai][bj][m][0] * coef, b1 + acc[ai][bj][m][1] * coef); } }
            }
        } else {
            float* sl = slab + (size_t)u.slab * MS * D;
#pragma unroll
            for (int ai = 0; ai < 2; ++ai)
#pragma unroll
                for (int m = 0; m < 4; ++m) { const size_t ro = (size_t)(row0 + ai * HALF + m * 16 - MP) * D + col0;
#pragma unroll
                    for (int bj = 0; bj < 2; ++bj) { *(f32x4*)(sl + ro + bj * HALF) = acc[ai][bj][m][0]; *(f32x4*)(sl + ro + bj * HALF + 4) = acc[ai][bj][m][1]; } }
        }
    }
};
struct EpiRw {
    static constexpr bool PERM = true, AFTER_DRAIN = false;
    bf16 *R, *K, *V, *L;
    __device__ __forceinline__ void operator()(const f32x4 (&acc)[2][2][4][2], const Unit& u, int wr, int wc, int fr, int fq) const {
        const int row0 = u.pm * BM + wr * 64 + fr;
        if (u.pn < 12) {
            bf16 *p0 = R, *p1 = K, *p2 = V; asm volatile("" : "+s"(p0), "+s"(p1), "+s"(p2));
            bf16* dst = u.pn < 4 ? p0 : (u.pn < 8 ? p1 : p2); const int col0 = (u.pn & 3) * BM + wc * 32 + 8 * fq;
#pragma unroll
            for (int ai = 0; ai < 2; ++ai)
#pragma unroll
                for (int m = 0; m < 4; ++m) { bf16* rp = dst + (size_t)(row0 + ai * HALF + m * 16) * D + col0;
#pragma unroll
                    for (int bj = 0; bj < 2; ++bj) st8bf(rp + bj * HALF, acc[ai][bj][m][0], acc[ai][bj][m][1]); }
        } else {
#pragma unroll
            for (int bj = 0; bj < 2; ++bj) {
                const int lc = (u.pn - 12) * BM + bj * HALF + wc * 32 + 8 * fq;
                if (lc >= KL2) continue;
                const int act = lc < 64 ? 1 : (lc < 128 ? 0 : (lc < 288 ? 2 : 3));
#pragma unroll
                for (int ai = 0; ai < 2; ++ai)
#pragma unroll
                    for (int m = 0; m < 4; ++m) {
                        f32x4 o[2];
#pragma unroll
                        for (int n = 0; n < 2; ++n)
#pragma unroll
                            for (int i = 0; i < 4; ++i) { const float x = acc[ai][bj][m][n][i]; o[n][i] = act == 1 ? tanhf_(x) : (act == 0 ? x : (act == 2 ? sigmoidf_(x) : 0.f)); }
                        st8bf(L + (size_t)(row0 + ai * HALF + m * 16) * KL2 + lc, o[0], o[1]);
                    }
            }
        }
    }
};
struct EpiL2 {
    static constexpr bool PERM = true, AFTER_DRAIN = false;
    bf16 *DEC, *AA, *GG; const float *w0, *a0;
    __device__ __forceinline__ void operator()(const f32x4 (&acc)[2][2][4][2], const Unit& u, int wr, int wc, int fr, int fq) const {
        const int row0 = u.pm * BM + wr * 64 + fr, kind = u.pn >> 2, col0 = (u.pn & 3) * BM + wc * 32 + 8 * fq;
        bf16 *p0 = DEC, *p1 = AA, *p2 = GG; const float *q0 = w0, *q1 = a0; asm volatile("" : "+s"(p0), "+s"(p1), "+s"(p2), "+s"(q0), "+s"(q1));
        bf16* dst = kind == 0 ? p0 : (kind == 1 ? p1 : p2); const float* bias = kind == 0 ? q0 : q1;
#pragma unroll
        for (int bj = 0; bj < 2; ++bj) {
            f32x4 bv[2];
#pragma unroll
            for (int n = 0; n < 2; ++n) bv[n] = kind < 2 ? *(const f32x4*)(bias + col0 + bj * HALF + 4 * n) : (f32x4){0.f, 0.f, 0.f, 0.f};
#pragma unroll
            for (int ai = 0; ai < 2; ++ai)
#pragma unroll
                for (int m = 0; m < 4; ++m) {
                    f32x4 o[2];
#pragma unroll
                    for (int n = 0; n < 2; ++n)
#pragma unroll
                        for (int i = 0; i < 4; ++i) { const float z = acc[ai][bj][m][n][i] + bv[n][i];
                            o[n][i] = kind == 0 ? (1.f - __expf(-0.60653065971f * sigmoidf_(z))) : (kind == 1 ? sigmoidf_(z) : z); }
                    st8bf(dst + (size_t)(row0 + ai * HALF + m * 16) * D + col0 + bj * HALF, o[0], o[1]);
                }
        }
    }
};
struct EpiIn {
    static constexpr bool PERM = true, AFTER_DRAIN = false;
    bf16 *QKR, *VV, *OO; float* IF; const float* bif; int pvar;
    __device__ __forceinline__ void operator()(const f32x4 (&acc)[2][2][4][2], const Unit& u, int wr, int wc, int fr, int fq) const {
        if (pvar == 3) return;
        const int row0 = u.pm * BM + wr * 64 + fr;
        if (u.pn < 12) {
            bf16 *p0 = QKR, *p1 = VV, *p2 = OO; asm volatile("" : "+s"(p0), "+s"(p1), "+s"(p2));
            const int kind = u.pn >> 2; bf16* dst = kind == 0 ? p0 : (kind == 1 ? p1 : p2); const int col0 = (u.pn & 3) * BM + wc * 32 + 8 * fq;
#pragma unroll
            for (int ai = 0; ai < 2; ++ai)
#pragma unroll
                for (int m = 0; m < 4; ++m) { bf16* rp = dst + (size_t)(row0 + ai * HALF + m * 16) * D + col0;
#pragma unroll
                    for (int bj = 0; bj < 2; ++bj) { f32x4 a = acc[ai][bj][m][0], b = acc[ai][bj][m][1];
                        if (kind == 2) {
#pragma unroll
                            for (int i = 0; i < 4; ++i) { a[i] = sigmoidf_(a[i]); b[i] = sigmoidf_(b[i]); } }
                        st8bf(rp + bj * HALF, a, b); } }
        } else if (u.pn == 12 && wc == 0 && fq < 2) {
            const f32x4 b0 = *(const f32x4*)(bif + 8 * fq), b1 = *(const f32x4*)(bif + 8 * fq + 4);
#pragma unroll
            for (int ai = 0; ai < 2; ++ai)
#pragma unroll
                for (int m = 0; m < 4; ++m) { f32x4 a = acc[ai][0][m][0] + b0, b = acc[ai][0][m][1] + b1;
                    if (fq == 1) {
#pragma unroll
                        for (int i = 0; i < 4; ++i) { a[i] = logsigmoidf_(a[i]); b[i] = logsigmoidf_(b[i]); } }
                    float* rp = IF + (size_t)(row0 + ai * HALF + m * 16) * 16 + 8 * fq; *(f32x4*)rp = a; *(f32x4*)(rp + 4) = b; }
        }
    }
};

struct CJ { const float* W; const float* sc; bf16* WT; int K, N, Npad, ldk, koff, rmode, roff, smode; };
__device__ __forceinline__ int cj_items(const CJ& j) { return (j.K / 32) * (j.Npad / 32); }
__device__ __forceinline__ void conv_load(const CJ& J, int item, int lane, f32x4 (&w)[4], float (&sc)[4]) {
    const int nblk = J.Npad / 32, kb = item / nblk, nb = item % nblk, k0 = 32 * kb, n0 = 32 * nb;
    const int r = lane >> 3, c4 = 4 * (lane & 7); const bool nok = n0 + c4 < J.N;
#pragma unroll
    for (int i = 0; i < 4; ++i) { const int kk = k0 + r + 8 * i;
        w[i] = nok ? *(const f32x4*)(J.W + (size_t)kk * J.N + n0 + c4) : (f32x4){0.f, 0.f, 0.f, 0.f};
        float s = 1.f; if (J.smode) { s = J.sc[kk]; if (J.smode == 2) s = 1.f - s; }
        sc[i] = s; }
}
__device__ __forceinline__ void conv_store(const CJ& J, LAS float* scr, int item, int lane, const f32x4 (&w)[4], const float (&sc)[4]) {
    const int nblk = J.Npad / 32, kb = item / nblk, nb = item % nblk, k0 = 32 * kb, n0 = 32 * nb;
    const int r = lane >> 3, c4 = 4 * (lane & 7);
#pragma unroll
    for (int i = 0; i < 4; ++i) { const f32x4 f = w[i] * sc[i]; LAS float* d = scr + (r + 8 * i) * 33 + c4; d[0] = f[0]; d[1] = f[1]; d[2] = f[2]; d[3] = f[3]; }
    LDS_WAIT(); asm volatile("" ::: "memory");
    const int rowbase = J.rmode == 0 ? J.roff + n0 : (n0 >> 7) * 256 + (n0 & 127) + J.roff;
    const int c = lane & 3;
#pragma unroll
    for (int j = 0; j < 2; ++j) { const int n = (lane >> 2) + 16 * j; const LAS float* s = scr + (8 * c) * 33 + n;
        v4u o; o.x = pkbf(s[0 * 33], s[1 * 33]); o.y = pkbf(s[2 * 33], s[3 * 33]); o.z = pkbf(s[4 * 33], s[5 * 33]); o.w = pkbf(s[6 * 33], s[7 * 33]);
        *(GAS v4u*)(J.WT + (size_t)(rowbase + n) * J.ldk + J.koff + k0 + 8 * c) = o; }
    LDS_WAIT(); asm volatile("" ::: "memory");
}
__device__ __forceinline__ CJ get_job(const Frame& F, int kind, int j, int layer, int ab, bf16* Wb) {
    CJ J; J.sc = nullptr; J.smode = 0; J.koff = 0; J.rmode = 0; J.roff = 0;
    if (kind == 0) {
        const float* wg = inptr(F, ab ? I_FBWG : I_FAWG) + (size_t)layer * D * FF; const float* wu = inptr(F, ab ? I_FBWU : I_FAWU) + (size_t)layer * D * FF; const float* wd = inptr(F, ab ? I_FBWD : I_FAWD) + (size_t)layer * D * FF;
        if (j < 2) { J.W = j == 0 ? wg : wu; J.K = D; J.N = FF; J.Npad = FF; J.WT = Wb + W_GU / 2; J.ldk = D; J.rmode = 1; J.roff = j == 0 ? 0 : 128; }
        else { J.W = wd; J.K = FF; J.N = D; J.Npad = D; J.WT = Wb + W_D / 2; J.ldk = FF; }
    } else if (kind == 1) {
        if (j < 12) {
            const int s = j >> 1, half = j & 1;
            J.W = inptr(F, s == 0 ? I_WR : (s == 1 ? I_WK : (s == 2 ? I_WV : (s == 3 ? I_W1 : (s == 4 ? I_A1 : I_G1)))));
            J.N = s < 3 ? 1024 : (s < 5 ? 64 : 160); J.Npad = s < 3 ? 1024 : (s < 5 ? 64 : 384);
            J.roff = s < 3 ? 1024 * s : (s == 3 ? 3072 : (s == 4 ? 3136 : 3200));
            const int mui = s == 0 ? 0 : (s == 1 ? 2 : (s == 2 ? 3 : (s == 3 ? 1 : (s == 4 ? 4 : 5))));
            J.sc = inptr(F, I_MU) + mui * D; J.smode = half ? 1 : 2; J.koff = half * D; J.K = D; J.ldk = KRW; J.WT = Wb + W_RW / 2;
        } else { J.W = inptr(F, I_WO); J.K = D; J.N = D; J.Npad = D; J.WT = Wb + W_O / 2; J.ldk = D; }
    } else {
        if (j == 0) { J.W = inptr(F, I_WIN); J.K = D; J.N = 3088; J.Npad = NIN; J.WT = Wb + W_IN / 2; J.ldk = D; }
        else { J.W = inptr(F, I_WOUT); J.K = D; J.N = D; J.Npad = D; J.WT = Wb + W_OUT / 2; J.ldk = D; }
    }
    return J;
}
__device__ __forceinline__ void convert_weights(const Frame& F, int kind, int layer, int ab, bf16* Wb, const int cu0 = 0) {
    LAS float* scr = (LAS float*)(F.lds + F.wave * 16384);
    const int gw = (F.vcu - cu0) * NWAVES + F.wave, NGW = (F.G - cu0) * NWAVES;
    const int njobs = kind == 0 ? 3 : (kind == 1 ? 13 : 2);
    int total = 0;
    for (int j = 0; j < njobs; ++j) { const CJ J = get_job(F, kind, j, layer, ab, Wb); total += cj_items(J); }
    if (gw < total) {
        int r = gw, j = 0; CJ J = get_job(F, kind, 0, layer, ab, Wb);
        while (r >= cj_items(J)) { r -= cj_items(J); ++j; J = get_job(F, kind, j, layer, ab, Wb); }
        f32x4 w[4]; float sc[4];
        conv_load(J, r, F.lane, w, sc);
        for (int g = gw; g < total;) {
            const int gn = g + NGW; int rn = 0; CJ Jn = J; f32x4 wn[4]; float sn[4];
#pragma unroll
            for (int i = 0; i < 4; ++i) { wn[i] = (f32x4){0.f, 0.f, 0.f, 0.f}; sn[i] = 0.f; }
            if (gn < total) {
                rn = gn; int jn = 0; Jn = get_job(F, kind, 0, layer, ab, Wb);
                while (rn >= cj_items(Jn)) { rn -= cj_items(Jn); ++jn; Jn = get_job(F, kind, jn, layer, ab, Wb); }
                conv_load(Jn, rn, F.lane, wn, sn);
            }
            conv_store(J, scr, r, F.lane, w, sc);
            J = Jn; r = rn; g = gn;
#pragma unroll
            for (int i = 0; i < 4; ++i) { w[i] = wn[i]; sc[i] = sn[i]; }
        }
    }
    if (kind == 1) {
        bf16* WT = Wb + W_L2 / 2; const float* w2 = inptr(F, I_W2); const float* a2 = inptr(F, I_A2); const float* g2 = inptr(F, I_G2);
        for (int idx = (F.vcu * NWAVES + F.wave) * 64 + F.lane; idx < 48 * NL2; idx += F.G * NWAVES * 64) {
            const int c = idx / NL2, n = idx % NL2, type = n >> 10, jj = n & 1023;
            const float* src = nullptr;
            if (type == 0 && c < 8) src = w2 + (size_t)(8 * c) * D + jj;
            else if (type == 1 && c >= 8 && c < 16) src = a2 + (size_t)(8 * (c - 8)) * D + jj;
            else if (type == 2 && c >= 16 && c < 36) src = g2 + (size_t)(8 * (c - 16)) * D + jj;
            float v[8];
#pragma unroll
            for (int e = 0; e < 8; ++e) v[e] = src ? src[(size_t)e * D] : 0.f;
            *(GAS v4u*)(WT + (size_t)n * KL2 + 8 * c) = pack8(v);
        }
    }
}

template <int MODE>
__device__ __forceinline__ void norm_finish(const int m, f32x4 (&v)[4], const f32x4 (&gv)[4], bf16* dst, const float* shift_in, float* out, const int lane) {
    const bool samp = m >= MP;
    float ss = 0.f;
#pragma unroll
    for (int j = 0; j < 4; ++j) ss += (v[j].x * v[j].x + v[j].y * v[j].y) + (v[j].z * v[j].z + v[j].w * v[j].w);
    const float r = 1.0f / sqrtf(wave_sum(ss) * (1.f / D) + NORM_EPS);
#pragma unroll
    for (int j = 0; j < 4; ++j) v[j] = v[j] * r * gv[j];
    if (MODE == 2) {
#pragma unroll
        for (int j = 0; j < 4; ++j) *(f32x4*)(out + O_Y + (size_t)m * D + 512 * (j >> 1) + 8 * lane + 4 * (j & 1)) = v[j];
    } else if (MODE == 0) {
#pragma unroll
        for (int j = 0; j < 2; ++j) st8bf(dst + (size_t)m * D + 512 * j + 8 * lane, v[2 * j], v[2 * j + 1]);
    } else {
        int t, b; bool first, last;
        if (!samp) { t = m & (PT - 1); b = m >> 11; first = t == 0; last = t == PT - 1; } else { const int mm = m - MP; t = mm & 3; b = mm >> 2; first = t == 0; last = t == 3; }
#pragma unroll
        for (int j = 0; j < 2; ++j) { const int eo = 512 * j + 8 * lane;
            st8bf(dst + (size_t)m * (2 * D) + eo, v[2 * j], v[2 * j + 1]);
            if (!last) st8bf(dst + (size_t)(m + 1) * (2 * D) + D + eo, v[2 * j], v[2 * j + 1]);
            else { float* so = out + (samp ? O_S_SHIFT : O_P_SHIFT) + (size_t)b * D + eo; *(f32x4*)so = v[2 * j]; *(f32x4*)(so + 4) = v[2 * j + 1]; }
            if (first) { f32x4 s0 = {0.f, 0.f, 0.f, 0.f}, s1 = s0;
                if (samp) { s0 = *(const f32x4*)(shift_in + (size_t)b * D + eo); s1 = *(const f32x4*)(shift_in + (size_t)b * D + eo + 4); }
                st8bf(dst + (size_t)m * (2 * D) + D + eo, s0, s1); }
        }
    }
}
template <bool F32>
__device__ __forceinline__ void row_load(const void* src, const size_t row, const int lane, f32x4 (&v)[4]) {
    if (F32) { const float* p = (const float*)src + row * D;
#pragma unroll
        for (int j = 0; j < 4; ++j) v[j] = *(const f32x4*)(p + 512 * (j >> 1) + 8 * lane + 4 * (j & 1));
    } else { const bf16* p = (const bf16*)src + row * D;
#pragma unroll
        for (int j = 0; j < 2; ++j) ld8bf(p + 512 * j + 8 * lane, v[2 * j], v[2 * j + 1]); }
}
template <int NS>
__device__ __forceinline__ void samp_row_fold(const float* slab, const int ms, const float coef, const int lane, f32x4 (&v)[4]) {
#pragma unroll
    for (int h = 0; h < 2; ++h) {
        f32x4 t[NS > 0 ? NS : 1][2];
#pragma unroll
        for (int s = 0; s < NS; ++s)
#pragma unroll
            for (int jj = 0; jj < 2; ++jj) t[s][jj] = *(const f32x4*)(slab + ((size_t)s * MS + ms) * D + 512 * h + 8 * lane + 4 * jj);
#pragma unroll
        for (int jj = 0; jj < 2; ++jj)
#pragma unroll
            for (int s = 0; s < NS; ++s) v[2 * h + jj] += t[s][jj] * coef;
    }
}
template <int MODE, bool PF32, bool SF32>
__device__ __forceinline__ void norm_rows(const Frame& F, const void* base_p, const void* base_s, int nslab, float coef, const float* slab, bf16* xr,
                                          const float* gain, bf16* dst, const float* shift_in, float* out, const int pvar = 0) {
    const int gw = F.vcu * NWAVES + F.wave, NGW = F.G * NWAVES, lane = F.lane;
    f32x4 gv[4];
#pragma unroll
    for (int j = 0; j < 4; ++j) gv[j] = *(const f32x4*)(gain + 512 * (j >> 1) + 8 * lane + 4 * (j & 1));
    for (int s = F.wave * F.G + F.vcu; s < MS; s += NWAVES * F.G) {
        const int m = MP + s; f32x4 v[4];
        row_load<SF32>(base_s, (size_t)s, lane, v);
        if (nslab == 11) samp_row_fold<11>(slab, s, coef, lane, v); else if (nslab == 4) samp_row_fold<4>(slab, s, coef, lane, v);
        if (nslab > 0 && MODE != 2 && pvar == 0) {
#pragma unroll
            for (int j = 0; j < 2; ++j) st8bf(xr + (size_t)m * D + 512 * j + 8 * lane, v[2 * j], v[2 * j + 1]); }
        norm_finish<MODE>(m, v, gv, dst, shift_in, out, lane);
    }
    int m = gw; f32x4 v[4];
    if (m < MP) row_load<PF32>(base_p, (size_t)m, lane, v);
    while (m < MP) {
        const int mn = m + NGW; f32x4 vn[4];
#pragma unroll
        for (int j = 0; j < 4; ++j) vn[j] = (f32x4){0.f, 0.f, 0.f, 0.f};
        if (mn < MP) row_load<PF32>(base_p, (size_t)mn, lane, vn);
        norm_finish<MODE>(m, v, gv, dst, shift_in, out, lane);
#pragma unroll
        for (int j = 0; j < 4; ++j) v[j] = vn[j];
        m = mn;
    }
}

constexpr int RW_KK = 0, RW_DD = 4096, RW_BB = 8192, RW_KP = 12288, RW_RR = 16384, RW_VV = 20480, RW_YY = 24576;
__device__ __forceinline__ void rwkv_chain(const Frame& F, int row0, int T, int h, const float* S0, float* ST,
                                           const bf16* Rb, const bf16* Kb, const bf16* Vb, const bf16* Db, const bf16* Ab, bf16* Gb,
                                           const float* k_k, const float* k_a, const float* r_k, const float* gn_w, const float* gn_b, const bool do_store, const int pvar) {
    LAS float* L = (LAS float*)F.lds;
    const int tid = F.tid, lane = F.lane, w = F.wave;
    const int cg = tid & 7, tt = tid >> 3;
    const int srow = 8 * w + (lane >> 3);
    float S[8];
    if (S0) { const f32x4 a = *(const f32x4*)(S0 + srow * 64 + 8 * cg), b = *(const f32x4*)(S0 + srow * 64 + 8 * cg + 4);
        S[0] = a.x; S[1] = a.y; S[2] = a.z; S[3] = a.w; S[4] = b.x; S[5] = b.y; S[6] = b.z; S[7] = b.w; }
    else {
#pragma unroll
        for (int j = 0; j < 8; ++j) S[j] = 0.f; }
    const int ch = h * 64 + 8 * cg;
    float ckk[8], cka[8], crk[8], cgw[8], cgb[8];
#pragma unroll
    for (int j = 0; j < 8; ++j) { ckk[j] = k_k[ch + j]; cka[j] = k_a[ch + j]; crk[j] = r_k[ch + j]; cgw[j] = gn_w[ch + j]; cgb[j] = gn_b[ch + j]; }
    const int nch = (T + 63) >> 6;
    v4u pr = {0, 0, 0, 0}, pk = pr, pv = pr, pd = pr, pa = pr, pg = pr;
    { const int nt0 = T < 64 ? T : 64;
      if (tt < nt0) { const size_t off = (size_t)(row0 + tt) * D + ch;
          pr = *(const v4u*)(Rb + off); pk = *(const v4u*)(Kb + off); pv = *(const v4u*)(Vb + off); pd = *(const v4u*)(Db + off); pa = *(const v4u*)(Ab + off); pg = *(const v4u*)(Gb + off); } }
    float bon = 0.f, vv[8], gg[8];
    for (int c = 0; c < nch; ++c) {
        const int nt = (T - 64 * c) < 64 ? (T - 64 * c) : 64;
        const bool valid = tt < nt;
        {
            float r8[8], k8[8], d8[8], a8[8];
            unpack8(pr, r8); unpack8(pk, k8); unpack8(pv, vv); unpack8(pd, d8); unpack8(pa, a8); unpack8(pg, gg);
            float kk[8], ss = 0.f;
#pragma unroll
            for (int j = 0; j < 8; ++j) { kk[j] = k8[j] * ckk[j]; ss += kk[j] * kk[j]; }
            ss = red8(ss);
            const float inv = __builtin_amdgcn_rsqf(fmaxf(ss, 1e-24f));
            float kp[8], bsum = 0.f;
#pragma unroll
            for (int j = 0; j < 8; ++j) { kk[j] *= inv; kp[j] = k8[j] * (1.f + (a8[j] - 1.f) * cka[j]); bsum += r8[j] * kp[j] * crk[j]; }
            bon = red8(bsum);
            if (valid) {
                LAS float* p = L + tt * 64 + 8 * cg;
                *(LAS f32x4*)(p + RW_KK) = (f32x4){-kk[0], -kk[1], -kk[2], -kk[3]}; *(LAS f32x4*)(p + RW_KK + 4) = (f32x4){-kk[4], -kk[5], -kk[6], -kk[7]};
                *(LAS f32x4*)(p + RW_DD) = (f32x4){1.f - d8[0], 1.f - d8[1], 1.f - d8[2], 1.f - d8[3]}; *(LAS f32x4*)(p + RW_DD + 4) = (f32x4){1.f - d8[4], 1.f - d8[5], 1.f - d8[6], 1.f - d8[7]};
                *(LAS f32x4*)(p + RW_BB) = (f32x4){kk[0] * a8[0], kk[1] * a8[1], kk[2] * a8[2], kk[3] * a8[3]}; *(LAS f32x4*)(p + RW_BB + 4) = (f32x4){kk[4] * a8[4], kk[5] * a8[5], kk[6] * a8[6], kk[7] * a8[7]};
                *(LAS f32x4*)(p + RW_KP) = (f32x4){kp[0], kp[1], kp[2], kp[3]}; *(LAS f32x4*)(p + RW_KP + 4) = (f32x4){kp[4], kp[5], kp[6], kp[7]};
                *(LAS f32x4*)(p + RW_RR) = (f32x4){r8[0], r8[1], r8[2], r8[3]}; *(LAS f32x4*)(p + RW_RR + 4) = (f32x4){r8[4], r8[5], r8[6], r8[7]};
                *(LAS f32x4*)(p + RW_VV) = (f32x4){vv[0], vv[1], vv[2], vv[3]}; *(LAS f32x4*)(p + RW_VV + 4) = (f32x4){vv[4], vv[5], vv[6], vv[7]};
            }
        }
        __syncthreads();
        if (c + 1 < nch) { const int nt1 = (T - 64 * (c + 1)) < 64 ? (T - 64 * (c + 1)) : 64;
            if (tt < nt1) { const size_t off = (size_t)(row0 + 64 * (c + 1) + tt) * D + ch;
                pr = *(const v4u*)(Rb + off); pk = *(const v4u*)(Kb + off); pv = *(const v4u*)(Vb + off); pd = *(const v4u*)(Db + off); pa = *(const v4u*)(Ab + off); pg = *(const v4u*)(Gb + off); } }
        {
            typedef float f2 __attribute__((ext_vector_type(2)));
            f2 S2[4] = {{S[0], S[1]}, {S[2], S[3]}, {S[4], S[5]}, {S[6], S[7]}};
            const LAS float* p = L + 8 * cg;
            LAS float* yw = L + RW_YY + srow;
            const LAS float* vp = L + RW_VV + srow;
#define RW_LD(N, Dd, B, Q, R, VR, t_) do { const LAS float* p_ = p + (t_) * 64; \
                N[0] = *(const LAS f32x4*)(p_ + RW_KK); N[1] = *(const LAS f32x4*)(p_ + RW_KK + 4); Dd[0] = *(const LAS f32x4*)(p_ + RW_DD); Dd[1] = *(const LAS f32x4*)(p_ + RW_DD + 4); \
                B[0] = *(const LAS f32x4*)(p_ + RW_BB); B[1] = *(const LAS f32x4*)(p_ + RW_BB + 4); Q[0] = *(const LAS f32x4*)(p_ + RW_KP); Q[1] = *(const LAS f32x4*)(p_ + RW_KP + 4); \
                R[0] = *(const LAS f32x4*)(p_ + RW_RR); R[1] = *(const LAS f32x4*)(p_ + RW_RR + 4); VR = vp[(t_) * 64]; } while (0)
#define RW_STEP(N, Dd, B, Q, R, VR, t_) do { \
                f2 a_ = S2[0] * (f2){N[0].x, N[0].y}; a_ = S2[1] * (f2){N[0].z, N[0].w} + a_; a_ = S2[2] * (f2){N[1].x, N[1].y} + a_; a_ = S2[3] * (f2){N[1].z, N[1].w} + a_; \
                const float sa_ = red8(a_.x + a_.y); const f2 sv_ = {sa_, sa_}, vv_ = {VR, VR}; \
                S2[0] = S2[0] * (f2){Dd[0].x, Dd[0].y} + (sv_ * (f2){B[0].x, B[0].y} + vv_ * (f2){Q[0].x, Q[0].y}); \
                S2[1] = S2[1] * (f2){Dd[0].z, Dd[0].w} + (sv_ * (f2){B[0].z, B[0].w} + vv_ * (f2){Q[0].z, Q[0].w}); \
                S2[2] = S2[2] * (f2){Dd[1].x, Dd[1].y} + (sv_ * (f2){B[1].x, B[1].y} + vv_ * (f2){Q[1].x, Q[1].y}); \
                S2[3] = S2[3] * (f2){Dd[1].z, Dd[1].w} + (sv_ * (f2){B[1].z, B[1].w} + vv_ * (f2){Q[1].z, Q[1].w}); \
                f2 y_ = S2[0] * (f2){R[0].x, R[0].y}; y_ = S2[1] * (f2){R[0].z, R[0].w} + y_; y_ = S2[2] * (f2){R[1].x, R[1].y} + y_; y_ = S2[3] * (f2){R[1].z, R[1].w} + y_; \
                yw[(t_) * 64] = red8(y_.x + y_.y); } while (0)
            f32x4 nA[2], dA[2], bA[2], qA[2], rA[2]; float vA;
            for (int t = 0; t < nt; ++t) { RW_LD(nA, dA, bA, qA, rA, vA, t); RW_STEP(nA, dA, bA, qA, rA, vA, t); }
#undef RW_LD
#undef RW_STEP
            S[0] = S2[0].x; S[1] = S2[0].y; S[2] = S2[1].x; S[3] = S2[1].y; S[4] = S2[2].x; S[5] = S2[2].y; S[6] = S2[3].x; S[7] = S2[3].y;
        }
        __syncthreads();
        if (pvar != 4) {
            f32x4 y0 = {0.f, 0.f, 0.f, 0.f}, y1 = y0;
            if (valid) { y0 = *(const LAS f32x4*)(L + RW_YY + tt * 64 + 8 * cg); y1 = *(const LAS f32x4*)(L + RW_YY + tt * 64 + 8 * cg + 4); }
            float yy[8] = {y0.x, y0.y, y0.z, y0.w, y1.x, y1.y, y1.z, y1.w};
            float s1 = 0.f;
#pragma unroll
            for (int j = 0; j < 8; ++j) s1 += yy[j];
            const float mean = red8(s1) * (1.f / 64.f);
            float s2 = 0.f;
#pragma unroll
            for (int j = 0; j < 8; ++j) { yy[j] -= mean; s2 += yy[j] * yy[j]; }
            const float rstd = __builtin_amdgcn_rsqf(red8(s2) * (1.f / 64.f) + GN_EPS);
            float o[8];
#pragma unroll
            for (int j = 0; j < 8; ++j) o[j] = ((yy[j] * rstd) * cgw[j] + cgb[j] + bon * vv[j]) * gg[j];
            if (valid && do_store) *(v4u*)(Gb + (size_t)(row0 + 64 * c + tt) * D + ch) = pack8(o);
        }
    }
    *(f32x4*)(ST + srow * 64 + 8 * cg) = (f32x4){S[0], S[1], S[2], S[3]}; *(f32x4*)(ST + srow * 64 + 8 * cg + 4) = (f32x4){S[4], S[5], S[6], S[7]};
    __syncthreads();
}

constexpr int RH_TC = 32, RH_BUF = 12288;
constexpr int RH_KK = 0, RH_DD = 2048, RH_BB = 4096, RH_KP = 6144, RH_RR = 8192, RH_VV = 10240, RH_YY = 11264;
__device__ __forceinline__ void rwkv_half_chain(const Frame& F, int b, int h, int half, float* ST, const bf16* Rb, const bf16* Kb, const bf16* Vb, const bf16* Db, const bf16* Ab,
                                                bf16* YRAW, float* BON, const float* k_k, const float* k_a, const float* r_k, const int pvar) {
    LAS float* L = (LAS float*)F.lds;
    const int tid = F.tid, lane = F.lane, w = F.wave, row0 = b * PT;
    constexpr int nch = PT / RH_TC;
    if (w < 4) {
        const int srow = 8 * w + (lane >> 3), cq = lane & 7;
        f32x4 S4 = {0.f, 0.f, 0.f, 0.f}, S5 = S4;
        __syncthreads();
        __builtin_amdgcn_s_setprio(3);
        for (int c = 0; c < nch; ++c) {
            const LAS float* p = L + (c & 1) * RH_BUF + 8 * cq;
            LAS float* yw = L + (c & 1) * RH_BUF + RH_YY + srow;
            const LAS float* vp = L + (c & 1) * RH_BUF + RH_VV + srow;
#define RH_LD(N, Dd, B, Q, R, VR, t_) do { const LAS float* p_ = p + (t_) * 64; \
                N[0] = *(const LAS f32x4*)(p_ + RH_KK); N[1] = *(const LAS f32x4*)(p_ + RH_KK + 4); Dd[0] = *(const LAS f32x4*)(p_ + RH_DD); Dd[1] = *(const LAS f32x4*)(p_ + RH_DD + 4); \
                B[0] = *(const LAS f32x4*)(p_ + RH_BB); B[1] = *(const LAS f32x4*)(p_ + RH_BB + 4); Q[0] = *(const LAS f32x4*)(p_ + RH_KP); Q[1] = *(const LAS f32x4*)(p_ + RH_KP + 4); \
                R[0] = *(const LAS f32x4*)(p_ + RH_RR); R[1] = *(const LAS f32x4*)(p_ + RH_RR + 4); VR = vp[(t_) * 32]; } while (0)
#define RH_STEP(N, Dd, B, Q, R, VR, t_) do { \
                const f32x4 pa_ = S4 * N[0] + S5 * N[1]; const float sa_ = red8((pa_.x + pa_.y) + (pa_.z + pa_.w)); \
                S4 = S4 * Dd[0] + (B[0] * sa_ + Q[0] * VR); S5 = S5 * Dd[1] + (B[1] * sa_ + Q[1] * VR); \
                const f32x4 ya_ = S4 * R[0] + S5 * R[1]; yw[(t_) * 32] = red8((ya_.x + ya_.y) + (ya_.z + ya_.w)); } while (0)
            f32x4 nA[2], dA[2], bA[2], qA[2], rA[2], nB[2], dB[2], bB[2], qB[2], rB[2]; float vA, vB;
            RH_LD(nA, dA, bA, qA, rA, vA, 0);
            if (pvar != 3)
            for (int t = 0; t < RH_TC; t += 2) {
                RH_LD(nB, dB, bB, qB, rB, vB, t + 1);
                RH_STEP(nA, dA, bA, qA, rA, vA, t);
                RH_LD(nA, dA, bA, qA, rA, vA, (t + 2 < RH_TC ? t + 2 : t + 1));
                RH_STEP(nB, dB, bB, qB, rB, vB, t + 1);
            }
#undef RH_LD
#undef RH_STEP
            __syncthreads();
        }
        __builtin_amdgcn_s_setprio(0);
        *(f32x4*)(ST + (32 * half + srow) * 64 + 8 * cq) = S4; *(f32x4*)(ST + (32 * half + srow) * 64 + 8 * cq + 4) = S5;
    } else {
        const int ht = tid - 256, cg = ht & 7, tt = ht >> 3;
        const int ch = h * 64 + 8 * cg, vch = h * 64 + 32 * half + 4 * cg;
        float ckk[8], cka[8], crk[8];
#pragma unroll
        for (int j = 0; j < 8; ++j) { ckk[j] = k_k[ch + j]; cka[j] = k_a[ch + j]; crk[j] = r_k[ch + j]; }
        v4u pr, pk, pd, pa; uint2 pv;
#define RH_LOAD(cc) do { const size_t off_ = (size_t)(row0 + RH_TC * (cc) + tt) * D; pr = *(const v4u*)(Rb + off_ + ch); pk = *(const v4u*)(Kb + off_ + ch); pd = *(const v4u*)(Db + off_ + ch); \
            pa = *(const v4u*)(Ab + off_ + ch); pv = *(const uint2*)(Vb + off_ + vch); } while (0)
#define RH_PREP(cc) do { float r8[8], k8[8], d8[8], a8[8]; unpack8(pr, r8); unpack8(pk, k8); unpack8(pd, d8); unpack8(pa, a8); \
            float kk[8], ss = 0.f; _Pragma("unroll") for (int j = 0; j < 8; ++j) { kk[j] = k8[j] * ckk[j]; ss += kk[j] * kk[j]; } \
            ss = red8(ss); const float inv = __builtin_amdgcn_rsqf(fmaxf(ss, 1e-24f)); \
            float kp[8], bsum = 0.f; _Pragma("unroll") for (int j = 0; j < 8; ++j) { kk[j] *= inv; kp[j] = k8[j] * (1.f + (a8[j] - 1.f) * cka[j]); bsum += r8[j] * kp[j] * crk[j]; } \
            const float bon = red8(bsum); if (half == 0 && cg == 0) BON[(size_t)(row0 + RH_TC * (cc) + tt) * 16 + h] = bon; \
            LAS float* p = L + ((cc) & 1) * RH_BUF + tt * 64 + 8 * cg; \
            *(LAS f32x4*)(p + RH_KK) = (f32x4){-kk[0], -kk[1], -kk[2], -kk[3]}; *(LAS f32x4*)(p + RH_KK + 4) = (f32x4){-kk[4], -kk[5], -kk[6], -kk[7]}; \
            *(LAS f32x4*)(p + RH_DD) = (f32x4){1.f - d8[0], 1.f - d8[1], 1.f - d8[2], 1.f - d8[3]}; *(LAS f32x4*)(p + RH_DD + 4) = (f32x4){1.f - d8[4], 1.f - d8[5], 1.f - d8[6], 1.f - d8[7]}; \
            *(LAS f32x4*)(p + RH_BB) = (f32x4){kk[0] * a8[0], kk[1] * a8[1], kk[2] * a8[2], kk[3] * a8[3]}; *(LAS f32x4*)(p + RH_BB + 4) = (f32x4){kk[4] * a8[4], kk[5] * a8[5], kk[6] * a8[6], kk[7] * a8[7]}; \
            *(LAS f32x4*)(p + RH_KP) = (f32x4){kp[0], kp[1], kp[2], kp[3]}; *(LAS f32x4*)(p + RH_KP + 4) = (f32x4){kp[4], kp[5], kp[6], kp[7]}; \
            *(LAS f32x4*)(p + RH_RR) = (f32x4){r8[0], r8[1], r8[2], r8[3]}; *(LAS f32x4*)(p + RH_RR + 4) = (f32x4){r8[4], r8[5], r8[6], r8[7]}; \
            *(LAS f32x4*)(L + ((cc) & 1) * RH_BUF + RH_VV + tt * 32 + 4 * cg) = (f32x4){bflo(pv.x), bfhi(pv.x), bflo(pv.y), bfhi(pv.y)}; } while (0)
#define RH_POST(cc) do { const f32x4 y4 = *(const LAS f32x4*)(L + ((cc) & 1) * RH_BUF + RH_YY + tt * 32 + 4 * cg); uint2 o; o.x = pkbf(y4.x, y4.y); o.y = pkbf(y4.z, y4.w); \
            *(uint2*)(YRAW + (size_t)(row0 + RH_TC * (cc) + tt) * D + vch) = o; } while (0)
        RH_LOAD(0); RH_PREP(0); RH_LOAD(1);
        __syncthreads();
        for (int c = 0; c < nch; ++c) {
            if (c > 0) RH_POST(c - 1);
            if (c + 1 < nch) { RH_PREP(c + 1); if (c + 2 < nch) RH_LOAD(c + 2); }
            __syncthreads();
        }
        RH_POST(nch - 1);
#undef RH_LOAD
#undef RH_PREP
#undef RH_POST
    }
    __syncthreads();
}
__device__ __forceinline__ void rwkv_finish(const Frame& F, const bf16* YRAW, const float* BON, const bf16* Vb, bf16* Gb, const float* gn_w, const float* gn_b) {
    const int gt = (F.vcu * NWAVES + F.wave) * 64 + F.lane, NT = F.G * NWAVES * 64;
    for (int task = gt; task < MP * 128; task += NT) {
        const int cg = task & 7, hh = (task >> 3) & 15, row = task >> 7; const size_t off = (size_t)row * D + hh * 64 + 8 * cg;
        float yy[8], vv[8], gg[8]; unpack8(*(const v4u*)(YRAW + off), yy); unpack8(*(const v4u*)(Vb + off), vv); unpack8(*(const v4u*)(Gb + off), gg);
        const float bon = BON[(size_t)row * 16 + hh];
        float s1 = 0.f;
#pragma unroll
        for (int j = 0; j < 8; ++j) s1 += yy[j];
        const float mean = red8(s1) * (1.f / 64.f);
        float s2 = 0.f;
#pragma unroll
        for (int j = 0; j < 8; ++j) { yy[j] -= mean; s2 += yy[j] * yy[j]; }
        const float rstd = __builtin_amdgcn_rsqf(red8(s2) * (1.f / 64.f) + GN_EPS);
        const f32x4 w0 = *(const f32x4*)(gn_w + hh * 64 + 8 * cg), w1 = *(const f32x4*)(gn_w + hh * 64 + 8 * cg + 4), b0 = *(const f32x4*)(gn_b + hh * 64 + 8 * cg), b1 = *(const f32x4*)(gn_b + hh * 64 + 8 * cg + 4);
        const float gw[8] = {w0.x, w0.y, w0.z, w0.w, w1.x, w1.y, w1.z, w1.w}, gb[8] = {b0.x, b0.y, b0.z, b0.w, b1.x, b1.y, b1.z, b1.w};
        float o[8];
#pragma unroll
        for (int j = 0; j < 8; ++j) o[j] = ((yy[j] * rstd) * gw[j] + gb[j] + bon * vv[j]) * gg[j];
        *(v4u*)(Gb + off) = pack8(o);
    }
}

constexpr int PBY = 144;
constexpr int RPY = 272;
constexpr int ML_RQK = 0, ML_S = 0, ML_KT = 9216, ML_RV = 18432, ML_Q = 35840, ML_K = 45056, ML_HB = 35840, ML_VT = 54272, ML_C = 72704, ML_F = 91136;
constexpr int MF_N = 0, MF_QN = 64, MF_RS = 128, MF_HS = 256, MF_CW = 384, MF_B63 = 1024, MF_P63 = 1056, MF_MC = 1088  , MF_GB = 1152, MF_GP = MF_GB + 2048, MF_GA = MF_GP + 2048;
typedef __attribute__((address_space(3))) unsigned short lds_u16;
#define MFMA16(a, b, c) __builtin_amdgcn_mfma_f32_16x16x32_bf16((a), (b), (c), 0, 0, 0)
__device__ __forceinline__ void mlstm_gate_tables(const Frame& F, int b, int hh, const float* IFb) {
    LAS float* Fl = (LAS float*)(F.lds + ML_F); const int lane = F.lane, w = F.wave;
#pragma unroll
    for (int q = 0; q < 4; ++q) { const int cc = w + 8 * q; const size_t ro_ = (size_t)(b * PT + 64 * cc + lane) * 16;
        const float li = IFb[ro_ + hh], lf = IFb[ro_ + 8 + hh];
        float bc = lf;
#pragma unroll
        for (int o = 1; o < 64; o <<= 1) { const float x = __shfl_up(bc, o); if (lane >= o) bc += x; }
        const float av = li - bc; float pm = av;
#pragma unroll
        for (int o = 1; o < 64; o <<= 1) { const float x = __shfl_up(pm, o); if (lane >= o) pm = fmaxf(pm, x); }
        Fl[MF_GB + cc * 64 + lane] = bc; Fl[MF_GP + cc * 64 + lane] = pm; Fl[MF_GA + cc * 64 + lane] = av;
        if (lane == 63) { Fl[MF_B63 + cc] = bc; Fl[MF_P63 + cc] = pm; } }
    __syncthreads();
    if (F.tid == 0) { float mm = 0.f;
        for (int cc = 0; cc < PT / 64; ++cc) { Fl[MF_MC + cc] = mm; const float b6 = Fl[MF_B63 + cc]; mm = fmaxf(b6 + mm, b6 + Fl[MF_P63 + cc]); }
        Fl[MF_MC + PT / 64] = mm; }
    __syncthreads();
}
constexpr int ML_NSEG = 4, ML_SEGC = PT / 64 / ML_NSEG, ML_SEGSZ = 128 * 64 + 64;
__device__ __forceinline__ void mlstm_prompt_chain(const Frame& F, int b, int hh, const int seg, const bf16* QKR, const bf16* VVb, const bf16* OOb, const float* IFb, bf16* HOb,
                                                   const float* conv_w, const float* conv_b, const float* norm_w, float* NUM, float* DEN, bf16* Qs, float* SEG, const int pvar) {
    LAS unsigned char* lds = F.lds; LAS float* Fl = (LAS float*)(lds + ML_F);
    const bool defer = seg > 0; const int c_lo = seg * ML_SEGC, c_hi = c_lo + ML_SEGC;
    const int tid = F.tid, lane = F.lane, w = F.wave, fr = lane & 15, fq = lane >> 4;
    for (int i = tid; i < 128 * 72; i += 512) ((lds_u16*)(lds + ML_C))[i] = 0;
    if (tid < 64) Fl[MF_N + tid] = 0.f;
    for (int i = tid; i < 640; i += 512) { const int j = i >> 7, c = i & 127, gc = c < 64 ? hh * 64 + c : 512 + hh * 64 + (c - 64); Fl[MF_CW + i] = j < 4 ? conv_w[j * D + gc] : conv_b[gc]; }
    f32x4 Cacc[4];
#pragma unroll
    for (int k = 0; k < 4; ++k) Cacc[k] = (f32x4){0.f, 0.f, 0.f, 0.f};
    const int og = tid & 15, ot = tid >> 4;
    float nw[8];
#pragma unroll
    for (int e = 0; e < 8; ++e) nw[e] = norm_w[hh * 128 + 8 * og + e];
    v4u rq[3], rv[2], ro[2];
#define ML_LOAD_QKV(cc) do { const int rowc_ = b * PT + 64 * (cc); \
        _Pragma("unroll") for (int i = 0; i < 3; ++i) { const int q = tid + 512 * i, r = q >> 4, j = q & 15, tok = 64 * (cc) - 3 + r; rq[i] = (v4u){0u, 0u, 0u, 0u}; \
            if (q < 67 * 16 && tok >= 0) rq[i] = *(const v4u*)(QKR + (size_t)(b * PT + tok) * D + (j < 8 ? hh * 64 + 8 * j : 512 + hh * 64 + 8 * (j - 8))); } \
        _Pragma("unroll") for (int i = 0; i < 2; ++i) rv[i] = *(const v4u*)(VVb + (size_t)(rowc_ + ot + 32 * i) * D + hh * 128 + 8 * og); \
        } while (0)
#define ML_LOAD_O(cc) do { const int rowc_ = b * PT + 64 * (cc); \
        _Pragma("unroll") for (int i = 0; i < 2; ++i) ro[i] = *(const v4u*)(OOb + (size_t)(rowc_ + ot + 32 * i) * D + hh * 128 + 8 * og); } while (0)
    ML_LOAD_QKV(c_lo);
    mlstm_gate_tables(F, b, hh, IFb);
    for (int c = c_lo; c < c_hi; ++c) {
        const int rowc = b * PT + 64 * c;
        const float m_c = Fl[MF_MC + c], m_n = Fl[MF_MC + c + 1], b63 = Fl[MF_B63 + c];
#pragma unroll
        for (int i = 0; i < 3; ++i) { const int q = tid + 512 * i; if (q < 67 * 16) *(LAS v4u*)(lds + ML_RQK + (q >> 4) * RPY + 16 * (q & 15)) = rq[i]; }
#pragma unroll
        for (int i = 0; i < 2; ++i) *(LAS v4u*)(lds + ML_RV + (ot + 32 * i) * RPY + 16 * og) = rv[i];
        if (c + 1 < c_hi) ML_LOAD_QKV(c + 1);
        if (!defer) ML_LOAD_O(c);
        __syncthreads();
        float kreg[8] = {0.f, 0.f, 0.f, 0.f, 0.f, 0.f, 0.f, 0.f};
        if (pvar != 3)
#pragma unroll
        for (int i = 0; i < 2; ++i) {
            const int g = w + 8 * i, t = lane;
            float x[4][8];
#pragma unroll
            for (int j = 0; j < 4; ++j) unpack8(*(const LAS v4u*)(lds + ML_RQK + (t + j) * RPY + 16 * g), x[j]);
            float val[8];
#pragma unroll
            for (int h2 = 0; h2 < 2; ++h2) { f32x4 a = *(const LAS f32x4*)(Fl + MF_CW + 4 * 128 + 8 * g + 4 * h2);
#pragma unroll
                for (int j = 0; j < 4; ++j) { const f32x4 cw = *(const LAS f32x4*)(Fl + MF_CW + j * 128 + 8 * g + 4 * h2);
                    a.x += cw.x * x[j][4 * h2]; a.y += cw.y * x[j][4 * h2 + 1]; a.z += cw.z * x[j][4 * h2 + 2]; a.w += cw.w * x[j][4 * h2 + 3]; }
                val[4 * h2] = siluf_(a.x); val[4 * h2 + 1] = siluf_(a.y); val[4 * h2 + 2] = siluf_(a.z); val[4 * h2 + 3] = siluf_(a.w); }
            if (i == 0) {
#pragma unroll
                for (int e = 0; e < 8; ++e) val[e] *= 0.125f;
                *(LAS v4u*)(lds + ML_Q + t * PBY + 16 * w) = pack8(val);
            } else { *(LAS v4u*)(lds + ML_K + t * PBY + 16 * w) = pack8(val);
#pragma unroll
                for (int e = 0; e < 8; ++e) kreg[e] = val[e]; }
            const v4u vw = *(const LAS v4u*)(lds + ML_RV + t * RPY + 16 * g);
            lds_u16* vt = (lds_u16*)(lds + ML_VT) + (8 * g) * 72 + t;
            vt[0 * 72] = (unsigned short)(vw.x & 0xffffu); vt[1 * 72] = (unsigned short)(vw.x >> 16); vt[2 * 72] = (unsigned short)(vw.y & 0xffffu); vt[3 * 72] = (unsigned short)(vw.y >> 16);
            vt[4 * 72] = (unsigned short)(vw.z & 0xffffu); vt[5 * 72] = (unsigned short)(vw.z >> 16); vt[6 * 72] = (unsigned short)(vw.w & 0xffffu); vt[7 * 72] = (unsigned short)(vw.w >> 16);
        }
        __syncthreads();
        if (pvar != 4) {
        { const float wsv = __expf(b63 + Fl[MF_GA + c * 64 + lane] - m_n); lds_u16* kt = (lds_u16*)(lds + ML_KT) + (8 * w) * 72 + lane;
#pragma unroll
          for (int e = 0; e < 8; ++e) kt[e * 72] = f2bf1(kreg[e] * wsv); }
        { const int tq = tid >> 3, p = tid & 7; float q8[8]; unpack8(*(const LAS v4u*)(lds + ML_Q + tq * PBY + 16 * p), q8);
          float dsum = 0.f;
#pragma unroll
          for (int e = 0; e < 8; ++e) dsum += q8[e] * Fl[MF_N + 8 * p + e];
          dsum = red8(dsum); if (p == 0) Fl[MF_QN + tq] = dsum; }
        { const int ti = w >> 1, t = 16 * ti + fr; float rsum = 0.f; const float mxt = fmaxf(m_c, Fl[MF_GP + c * 64 + t]);
          typedef unsigned u2v_ __attribute__((ext_vector_type(2)));
#pragma unroll
          for (int jj = 0; jj < 2; ++jj) { const int sj = 2 * (w & 1) + jj; f32x4 acc = {0.f, 0.f, 0.f, 0.f};
#pragma unroll
              for (int ks = 0; ks < 2; ++ks) { const bf16x8 a = *(const LAS bf16x8*)(lds + ML_Q + (16 * ti + fr) * PBY + ks * 64 + fq * 16), bb = *(const LAS bf16x8*)(lds + ML_K + (16 * sj + fr) * PBY + ks * 64 + fq * 16);
                  acc = MFMA16(bb, a, acc); }
              const f32x4 av4 = *(const LAS f32x4*)(Fl + MF_GA + c * 64 + 16 * sj + 4 * fq);
#pragma unroll
              for (int r = 0; r < 4; ++r) { const int s_ = 16 * sj + 4 * fq + r; const float val = s_ <= t ? acc[r] * __expf(av4[r] - mxt) : 0.f; acc[r] = val; rsum += val; }
              u2v_ pw; pw.x = pkbf(acc[0], acc[1]); pw.y = pkbf(acc[2], acc[3]);
              *(LAS u2v_*)(lds + ML_S + (t * 72 + 16 * sj + 4 * fq) * 2) = pw; }
          rsum += __shfl_xor(rsum, 16); rsum += __shfl_xor(rsum, 32);
          if (fq == 0) Fl[MF_RS + t * 2 + (w & 1)] = rsum; }
        }
        __syncthreads();
        float hv[4][4] = {};
        if (pvar != 5) { const int ti = w & 3, t = 16 * ti + fr;
          const float mx = fmaxf(m_c, Fl[MF_GP + c * 64 + t]), wi = __expf(m_c - mx), ei = __expf(-(Fl[MF_GB + c * 64 + t] + mx));
          const float rden = __builtin_amdgcn_rcpf(fmaxf(fabsf(wi * Fl[MF_QN + t] + Fl[MF_RS + 2 * t] + Fl[MF_RS + 2 * t + 1]), ei)); float hq = 0.f;
#pragma unroll
          for (int i = 0; i < 4; ++i) { const int vt = 4 * (w >> 2) + i; f32x4 accA = {0.f, 0.f, 0.f, 0.f}, accB = accA;
#pragma unroll
              for (int ks = 0; ks < 2; ++ks) {
                  const bf16x8 aq = *(const LAS bf16x8*)(lds + ML_Q + (16 * ti + fr) * PBY + ks * 64 + fq * 16), bc = *(const LAS bf16x8*)(lds + ML_C + (16 * vt + fr) * PBY + ks * 64 + fq * 16);
                  accA = MFMA16(bc, aq, accA);
                  const bf16x8 as = *(const LAS bf16x8*)(lds + ML_S + (16 * ti + fr) * PBY + ks * 64 + fq * 16), bv = *(const LAS bf16x8*)(lds + ML_VT + (16 * vt + fr) * PBY + ks * 64 + fq * 16);
                  accB = MFMA16(bv, as, accB); }
              if (defer) { *(f32x4*)(NUM + (size_t)(rowc + t) * D + hh * 128 + 16 * vt + 4 * fq) = accA * wi + accB; }
              else {
#pragma unroll
              for (int r = 0; r < 4; ++r) { const float hh_ = (wi * accA[r] + accB[r]) * rden; hv[i][r] = hh_; hq += hh_ * hh_; } } }
          if (defer) { if (fq == 0 && (w >> 2) == 0) DEN[(size_t)(rowc + t) * 8 + hh] = wi * Fl[MF_QN + t] + Fl[MF_RS + 2 * t] + Fl[MF_RS + 2 * t + 1];
              *(v4u*)(Qs + (size_t)(rowc + (tid >> 3)) * 512 + hh * 64 + 8 * (tid & 7)) = *(const LAS v4u*)(lds + ML_Q + (tid >> 3) * PBY + 16 * (tid & 7)); }
          else { hq += __shfl_xor(hq, 16); hq += __shfl_xor(hq, 32);
              if (fq == 0) Fl[MF_HS + t * 2 + (w >> 2)] = hq; } }
        __syncthreads();
        if (pvar != 6) {
        if (!defer) { const int ti = w & 3, t = 16 * ti + fr; const float sc = __builtin_amdgcn_rsqf((Fl[MF_HS + 2 * t] + Fl[MF_HS + 2 * t + 1]) * (1.f / 128.f) + NORM_EPS);
          typedef unsigned u2v_ __attribute__((ext_vector_type(2)));
#pragma unroll
          for (int i = 0; i < 4; ++i) { u2v_ pw; pw.x = pkbf(hv[i][0] * sc, hv[i][1] * sc); pw.y = pkbf(hv[i][2] * sc, hv[i][3] * sc);
              *(LAS u2v_*)(lds + ML_HB + t * RPY + (16 * (4 * (w >> 2) + i) + 4 * fq) * 2) = pw; } }
        { const float wst = __expf(b63 + m_c - m_n);
          typedef unsigned u2v_ __attribute__((ext_vector_type(2)));
#pragma unroll
          for (int kt = 0; kt < 4; ++kt) { Cacc[kt] = Cacc[kt] * wst;
#pragma unroll
              for (int ks = 0; ks < 2; ++ks) { const bf16x8 a = *(const LAS bf16x8*)(lds + ML_VT + (16 * w + fr) * PBY + ks * 64 + fq * 16), bb = *(const LAS bf16x8*)(lds + ML_KT + (16 * kt + fr) * PBY + ks * 64 + fq * 16);
                  Cacc[kt] = MFMA16(bb, a, Cacc[kt]); }
              u2v_ pw; pw.x = pkbf(Cacc[kt][0], Cacc[kt][1]); pw.y = pkbf(Cacc[kt][2], Cacc[kt][3]);
              *(LAS u2v_*)(lds + ML_C + ((16 * w + fr) * 72 + 16 * kt + 4 * fq) * 2) = pw; }
          if (w == 0) { float sum = 0.f;
#pragma unroll
              for (int q = 0; q < 8; ++q) { float k8[8]; unpack8(*(const LAS v4u*)(lds + ML_KT + lane * PBY + 16 * q), k8);
#pragma unroll
                  for (int e = 0; e < 8; ++e) sum += k8[e]; }
              Fl[MF_N + lane] = wst * Fl[MF_N + lane] + sum; } }
        }
        __syncthreads();
        if (!defer)
#pragma unroll
        for (int i = 0; i < 2; ++i) { const int t = ot + 32 * i; float h8[8], o8[8]; unpack8(*(const LAS v4u*)(lds + ML_HB + t * RPY + 16 * og), h8); unpack8(ro[i], o8);
#pragma unroll
            for (int e = 0; e < 8; ++e) h8[e] = h8[e] * nw[e] * o8[e];
            *(v4u*)(HOb + (size_t)(rowc + t) * D + hh * 128 + 8 * og) = pack8(h8); }
    }
#undef ML_LOAD_QKV
#undef ML_LOAD_O
    { float* sp = SEG + (size_t)((b * 8 + hh) * ML_NSEG + seg) * ML_SEGSZ;
#pragma unroll
      for (int kt = 0; kt < 4; ++kt) *(f32x4*)(sp + (16 * w + fr) * 64 + 16 * kt + 4 * fq) = Cacc[kt];
      if (w == 0) sp[128 * 64 + lane] = Fl[MF_N + lane]; }
    __syncthreads();
}
__device__ __forceinline__ void mlstm_fix_seg(const Frame& F, int b, int hh, const int seg, const bf16* QKR, const bf16* OOb, const float* IFb, bf16* HOb, const float* norm_w,
                                              const float* NUM, const float* DEN, const bf16* Qs, const float* SEG, float* out) {
    LAS unsigned char* lds = F.lds; LAS float* Fl = (LAS float*)(lds + ML_F);
    const int tid = F.tid, lane = F.lane, w = F.wave, fr = lane & 15, fq = lane >> 4;
    const int og = tid & 15, ot = tid >> 4, chain = b * 8 + hh;
    typedef unsigned u2v_ __attribute__((ext_vector_type(2)));
    float nw[8];
#pragma unroll
    for (int e = 0; e < 8; ++e) nw[e] = norm_w[hh * 128 + 8 * og + e];
    const int c_lo = seg * ML_SEGC, c_hi = c_lo + ML_SEGC;
    v4u rq, ro[2]; f32x4 numl[4]; float denl;
#define MLF_LOAD(cc, RQ, RO, NL, DL) do { const int rowc_ = b * PT + 64 * (cc); \
        RQ = *(const v4u*)(Qs + (size_t)(rowc_ + (tid >> 3)) * 512 + hh * 64 + 8 * (tid & 7)); \
        _Pragma("unroll") for (int i = 0; i < 2; ++i) RO[i] = *(const v4u*)(OOb + (size_t)(rowc_ + ot + 32 * i) * D + hh * 128 + 8 * og); \
        _Pragma("unroll") for (int i = 0; i < 4; ++i) NL[i] = *(const f32x4*)(NUM + (size_t)(rowc_ + 16 * (w & 3) + fr) * D + hh * 128 + 16 * (4 * (w >> 2) + i) + 4 * fq); \
        DL = DEN[(size_t)(rowc_ + 16 * (w & 3) + fr) * 8 + hh]; } while (0)
    MLF_LOAD(c_lo, rq, ro, numl, denl);
    mlstm_gate_tables(F, b, hh, IFb);
    {
        f32x4 cin[4]; float nin = 0.f;
#pragma unroll
        for (int i = 0; i < 4; ++i) cin[i] = (f32x4){0.f, 0.f, 0.f, 0.f};
        for (int j = 0; j < seg; ++j) {
            float lw = 0.f;
            for (int cc = j * ML_SEGC; cc < (j + 1) * ML_SEGC; ++cc) lw += Fl[MF_B63 + cc] + Fl[MF_MC + cc] - Fl[MF_MC + cc + 1];
            const float Wj = __expf(lw); const float* sp = SEG + (size_t)(chain * ML_NSEG + j) * ML_SEGSZ;
#pragma unroll
            for (int i = 0; i < 4; ++i) cin[i] = cin[i] * Wj + *(const f32x4*)(sp + 4 * (tid + 512 * i));
            if (tid < 64) nin = nin * Wj + sp[128 * 64 + tid];
        }
#pragma unroll
        for (int i = 0; i < 4; ++i) { const int idx = tid + 512 * i, v = idx >> 4, k4 = (idx & 15) * 4; u2v_ pw; pw.x = pkbf(cin[i][0], cin[i][1]); pw.y = pkbf(cin[i][2], cin[i][3]);
            *(LAS u2v_*)(lds + ML_C + (v * 72 + k4) * 2) = pw; }
        if (tid < 64) Fl[MF_N + tid] = nin;
        if (seg == ML_NSEG - 1) {
            float lw = 0.f;
            for (int cc = seg * ML_SEGC; cc < (seg + 1) * ML_SEGC; ++cc) lw += Fl[MF_B63 + cc] + Fl[MF_MC + cc] - Fl[MF_MC + cc + 1];
            const float Wj = __expf(lw); const float* sp = SEG + (size_t)(chain * ML_NSEG + seg) * ML_SEGSZ;
#pragma unroll
            for (int i = 0; i < 4; ++i) *(f32x4*)(out + O_P_C + (size_t)chain * 8192 + 4 * (tid + 512 * i)) = cin[i] * Wj + *(const f32x4*)(sp + 4 * (tid + 512 * i));
            if (tid < 64) out[O_P_N + (size_t)chain * 64 + tid] = nin * Wj + sp[128 * 64 + tid];
            if (tid == 0) out[O_P_M + chain] = Fl[MF_MC + PT / 64];
            if (tid < 384) { const int j = tid >> 7, c = tid & 127, gc = c < 64 ? hh * 64 + c : 512 + hh * 64 + (c - 64);
                out[O_P_CONV + (size_t)(b * 3 + j) * D + gc] = bf1(QKR[(size_t)(b * PT + PT - 3 + j) * D + gc]); }
        }
    }
    float wc = 1.f;
    for (int c = c_lo; c < c_hi; ++c) {
        const int rowc = b * PT + 64 * c;
        const float m_c = Fl[MF_MC + c], m_n = Fl[MF_MC + c + 1], b63 = Fl[MF_B63 + c];
        *(LAS v4u*)(lds + ML_RQK + (tid >> 3) * PBY + 16 * (tid & 7)) = rq;
        v4u rqn = rq, ron[2] = {ro[0], ro[1]}; f32x4 numn[4] = {numl[0], numl[1], numl[2], numl[3]}; float denn = denl;
        if (c + 1 < c_hi) MLF_LOAD(c + 1, rqn, ron, numn, denn);
        __syncthreads();
        { const int tq = tid >> 3, p = tid & 7; float q8[8]; unpack8(*(const LAS v4u*)(lds + ML_RQK + tq * PBY + 16 * p), q8);
          float dsum = 0.f;
#pragma unroll
          for (int e = 0; e < 8; ++e) dsum += q8[e] * Fl[MF_N + 8 * p + e];
          dsum = red8(dsum); if (p == 0) Fl[MF_QN + tq] = dsum; }
        const int ti = w & 3, t = 16 * ti + fr;
        f32x4 accA[4];
#pragma unroll
        for (int i = 0; i < 4; ++i) { const int vt = 4 * (w >> 2) + i; accA[i] = (f32x4){0.f, 0.f, 0.f, 0.f};
#pragma unroll
            for (int ks = 0; ks < 2; ++ks) {
                const bf16x8 aq = *(const LAS bf16x8*)(lds + ML_RQK + (16 * ti + fr) * PBY + ks * 64 + fq * 16), bc = *(const LAS bf16x8*)(lds + ML_C + (16 * vt + fr) * PBY + ks * 64 + fq * 16);
                accA[i] = MFMA16(bc, aq, accA[i]); } }
        __syncthreads();
        float hv[4][4];
        { const float mx = fmaxf(m_c, Fl[MF_GP + c * 64 + t]), wi = __expf(m_c - mx) * wc, ei = __expf(-(Fl[MF_GB + c * 64 + t] + mx));
          const float rden = __builtin_amdgcn_rcpf(fmaxf(fabsf(wi * Fl[MF_QN + t] + denl), ei)); float hq = 0.f;
#pragma unroll
          for (int i = 0; i < 4; ++i)
#pragma unroll
              for (int r = 0; r < 4; ++r) { const float hh_ = (wi * accA[i][r] + numl[i][r]) * rden; hv[i][r] = hh_; hq += hh_ * hh_; }
          hq += __shfl_xor(hq, 16); hq += __shfl_xor(hq, 32);
          if (fq == 0) Fl[MF_HS + t * 2 + (w >> 2)] = hq; }
        __syncthreads();
        { const float sc = __builtin_amdgcn_rsqf((Fl[MF_HS + 2 * t] + Fl[MF_HS + 2 * t + 1]) * (1.f / 128.f) + NORM_EPS);
#pragma unroll
          for (int i = 0; i < 4; ++i) { u2v_ pw; pw.x = pkbf(hv[i][0] * sc, hv[i][1] * sc); pw.y = pkbf(hv[i][2] * sc, hv[i][3] * sc);
              *(LAS u2v_*)(lds + ML_HB + t * RPY + (16 * (4 * (w >> 2) + i) + 4 * fq) * 2) = pw; } }
        __syncthreads();
#pragma unroll
        for (int i = 0; i < 2; ++i) { const int t2 = ot + 32 * i; float h8[8], o8[8]; unpack8(*(const LAS v4u*)(lds + ML_HB + t2 * RPY + 16 * og), h8); unpack8(ro[i], o8);
#pragma unroll
            for (int e = 0; e < 8; ++e) h8[e] = h8[e] * nw[e] * o8[e];
            *(v4u*)(HOb + (size_t)(rowc + t2) * D + hh * 128 + 8 * og) = pack8(h8); }
        wc *= __expf(b63 + m_c - m_n);
        rq = rqn; ro[0] = ron[0]; ro[1] = ron[1]; denl = denn;
#pragma unroll
        for (int i = 0; i < 4; ++i) numl[i] = numn[i];
    }
#undef MLF_LOAD
    __syncthreads();
}
__device__ __forceinline__ void mlstm_sample_item(const Frame& F, int b, int hh, const bf16* QKR, const bf16* VVb, const bf16* OOb, const float* IFb, bf16* HOb,
                                                  const float* conv_w, const float* conv_b, const float* norm_w, const float* C0, const float* n0, const float* m0p, const float* conv0, float* out) {
    LAS float* L = (LAS float*)F.lds;
    constexpr int LQ = 0, LK = 256, LV = 512, LS = 1024, LQN = 1040, LHS = 1048;
    const int tid = F.tid, lane = F.lane, w = F.wave, row0 = MP + 4 * b;
    float li[4], lf[4];
#pragma unroll
    for (int t = 0; t < 4; ++t) { li[t] = IFb[(size_t)(row0 + t) * 16 + hh]; lf[t] = IFb[(size_t)(row0 + t) * 16 + 8 + hh]; }
    const float m0 = m0p[b * 8 + hh];
    float bc[4], av[4], mt[4], wi[4], wsv[4], ei[4], bm[4];
    { float run = 0.f, pm = -3.0e38f;
#pragma unroll
      for (int t = 0; t < 4; ++t) { run += lf[t]; bc[t] = run; av[t] = li[t] - run; pm = fmaxf(pm, av[t]); mt[t] = fmaxf(run + m0, run + pm); } }
    const float m_new = mt[3], wst = __expf(bc[3] + m0 - m_new);
#pragma unroll
    for (int t = 0; t < 4; ++t) { wi[t] = __expf(bc[t] + m0 - mt[t]); wsv[t] = __expf(bc[3] + av[t] - m_new); ei[t] = __expf(-mt[t]); bm[t] = bc[t] - mt[t]; }
    { const int t = tid >> 7, c = tid & 127, gc = c < 64 ? hh * 64 + c : 512 + hh * 64 + (c - 64);
      float x[4];
#pragma unroll
      for (int j = 0; j < 4; ++j) { const int p = t + j; x[j] = p < 3 ? conv0[(size_t)(b * 3 + p) * D + gc] : bf1(QKR[(size_t)(row0 + p - 3) * D + gc]); }
      float a = conv_b[gc];
#pragma unroll
      for (int j = 0; j < 4; ++j) a += conv_w[j * D + gc] * x[j];
      const float val = siluf_(a);
      if (c < 64) L[LQ + t * 64 + c] = val * 0.125f; else L[LK + t * 64 + (c - 64)] = val;
      if (t >= 1) out[O_S_CONV + (size_t)(b * 3 + t - 1) * D + gc] = x[3];
      L[LV + t * 128 + c] = bf1(VVb[(size_t)(row0 + t) * D + hh * 128 + c]); }
    __syncthreads();
    if (w == 0) { const int pair = lane >> 2, t = pair >> 2, s = pair & 3, part = lane & 3; float dsum = 0.f;
#pragma unroll
        for (int e = 0; e < 16; ++e) dsum += L[LQ + t * 64 + 16 * part + e] * L[LK + s * 64 + 16 * part + e];
        dsum = red4(dsum);
        const float bmt = t == 0 ? bm[0] : (t == 1 ? bm[1] : (t == 2 ? bm[2] : bm[3])), avs = s == 0 ? av[0] : (s == 1 ? av[1] : (s == 2 ? av[2] : av[3]));
        if (part == 0) L[LS + pair] = s <= t ? dsum * __expf(bmt + avs) : 0.f; }
    if (w == 1) { const int t = lane >> 4, part = lane & 15; float dsum = 0.f;
#pragma unroll
        for (int e = 0; e < 4; ++e) dsum += L[LQ + t * 64 + 4 * part + e] * n0[(size_t)(b * 8 + hh) * 64 + 4 * part + e];
        dsum = red16(dsum); if (part == 0) L[LQN + t] = dsum; }
    __syncthreads();
    const int v = tid >> 2, kq = tid & 3;
    float hvv[4];
    { const size_t coff = ((size_t)(b * 8 + hh) * 128 + v) * 64 + 16 * kq;
      float c0[16];
#pragma unroll
      for (int e4 = 0; e4 < 4; ++e4) { const f32x4 x = *(const f32x4*)(C0 + coff + 4 * e4); c0[4 * e4] = x.x; c0[4 * e4 + 1] = x.y; c0[4 * e4 + 2] = x.z; c0[4 * e4 + 3] = x.w; }
#pragma unroll
      for (int t = 0; t < 4; ++t) { float part = 0.f;
#pragma unroll
          for (int e = 0; e < 16; ++e) part += c0[e] * L[LQ + t * 64 + 16 * kq + e];
          const float inter = red4(part);
          float num = wi[t] * inter, den = wi[t] * L[LQN + t];
#pragma unroll
          for (int s = 0; s < 4; ++s) { const float sm = L[LS + t * 4 + s]; num += sm * L[LV + s * 128 + v]; den += sm; }
          hvv[t] = num / fmaxf(fabsf(den), ei[t]); }
#pragma unroll
      for (int t = 0; t < 4; ++t) { const float x = wave_sum(kq == 0 ? hvv[t] * hvv[t] : 0.f); if (lane == 0) L[LHS + w * 4 + t] = x; }
      float cn[16];
#pragma unroll
      for (int e = 0; e < 16; ++e) { float a = wst * c0[e];
#pragma unroll
          for (int s = 0; s < 4; ++s) a += wsv[s] * L[LV + s * 128 + v] * L[LK + s * 64 + 16 * kq + e];
          cn[e] = a; }
#pragma unroll
      for (int e4 = 0; e4 < 4; ++e4) *(f32x4*)(out + O_S_C + coff + 4 * e4) = (f32x4){cn[4 * e4], cn[4 * e4 + 1], cn[4 * e4 + 2], cn[4 * e4 + 3]}; }
    __syncthreads();
    if (kq == 0) {
#pragma unroll
        for (int t = 0; t < 4; ++t) { float tot = 0.f;
#pragma unroll
            for (int ww = 0; ww < 8; ++ww) tot += L[LHS + ww * 4 + t];
            const float sc = 1.0f / sqrtf(tot * (1.f / 128.f) + NORM_EPS); const size_t off = (size_t)(row0 + t) * D + hh * 128 + v;
            HOb[off] = f2bf1(hvv[t] * sc * norm_w[hh * 128 + v] * bf1(OOb[off])); } }
    if (tid < 64) { float a = wst * n0[(size_t)(b * 8 + hh) * 64 + tid];
#pragma unroll
        for (int s = 0; s < 4; ++s) a += wsv[s] * L[LK + s * 64 + tid];
        out[O_S_N + (size_t)(b * 8 + hh) * 64 + tid] = a; }
    if (tid == 0) out[O_S_M + b * 8 + hh] = m_new;
    __syncthreads();
}

constexpr int CA_AH = 0, CA_BH = 9216, CA_KH = 18432, CA_RH = 27648, CA_BT = 36864, CA_KT = 46080, CA_VT = 55296, CA_AB = 64512, CA_AK = 73728, CA_RB = 82944, CA_RK = 92160, CA_XT = 101376,
              CA_TD = 119808, CA_NF = 123904, CA_GL = 128000, CA_LG = CA_AB  , CA_AT = CA_KH  ;
__device__ __forceinline__ bf16x8 ldsfrag(LAS unsigned char* lds, int base, int row, int ks, int fq) { return *(const LAS bf16x8*)(lds + base + row * PBY + ks * 64 + fq * 16); }
__device__ __forceinline__ void rwkv_chunk_item(const Frame& F, int chain, int chunk, bf16* Rb, bf16* Kb, bf16* Vb, bf16* Db, bf16* Ab, bf16* Gb,
                                                const float* k_k, const float* k_a, const float* r_k, float* BON, bf16* dummy, v4u (&pf)[6], const int nchain, const int nchunk) {
    LAS unsigned char* lds = F.lds;
    const int tid = F.tid, lane = F.lane, w = F.wave, fr = lane & 15, fq = lane >> 4, cg = tid & 7, tt = tid >> 3;
    const int h = chain & 15, row0 = (chain >> 4) * PT + 64 * chunk, ch = h * 64 + 8 * cg;
    const size_t goff = (size_t)(row0 + tt) * D + ch;
    LAS float* LG = (LAS float*)(lds + CA_LG); LAS float* GLf = (LAS float*)(lds + CA_GL);
    float r8[8], kp[8], av[8], bv[8], rd[8];
    {
        float k8[8], v8[8], d8[8], a8[8];
        unpack8(pf[0], r8); unpack8(pf[1], k8); unpack8(pf[2], v8); unpack8(pf[3], d8); unpack8(pf[4], a8);
        float ss = 0.f;
#pragma unroll
        for (int j = 0; j < 8; ++j) { av[j] = k8[j] * k_k[ch + j]; ss += av[j] * av[j]; }
        ss = red8(ss); const float inv = __builtin_amdgcn_rsqf(fmaxf(ss, 1e-24f));
        float bsum = 0.f;
#pragma unroll
        for (int j = 0; j < 8; ++j) { const float kk = av[j] * inv; kp[j] = k8[j] * (1.f + (a8[j] - 1.f) * k_a[ch + j]); bv[j] = kk * a8[j]; av[j] = -kk; bsum += r8[j] * kp[j] * r_k[ch + j]; rd[j] = __builtin_amdgcn_rcpf(1.f - d8[j]); }
        const float bon = red8(bsum);
#pragma unroll
        for (int j = 0; j < 8; ++j) { LG[(8 * cg + j) * 64 + tt] = __logf(1.f - d8[j]); ((lds_u16*)(lds + CA_VT))[(8 * cg + j) * 72 + tt] = f2bf1(v8[j]); }
        if (cg == 0 && !dummy) BON[(size_t)(row0 + tt) * 16 + h] = bon;
    }
    for (int i = tid; i < 128 * 9; i += 512) ((LAS v4u*)(lds + CA_XT))[i] = (v4u){0u, 0u, 0u, 0u};
    __syncthreads();
    { float x[8];
#pragma unroll
      for (int q = 0; q < 8; ++q) x[q] = LG[(8 * w + q) * 64 + lane];
#pragma unroll
      for (int q = 0; q < 8; ++q) {
          float v = x[q];
          v += __builtin_bit_cast(float, __builtin_amdgcn_update_dpp(0, __builtin_bit_cast(int, v), 0x111, 0xF, 0xF, true));
          v += __builtin_bit_cast(float, __builtin_amdgcn_update_dpp(0, __builtin_bit_cast(int, v), 0x112, 0xF, 0xF, true));
          v += __builtin_bit_cast(float, __builtin_amdgcn_update_dpp(0, __builtin_bit_cast(int, v), 0x114, 0xF, 0xF, true));
          v += __builtin_bit_cast(float, __builtin_amdgcn_update_dpp(0, __builtin_bit_cast(int, v), 0x118, 0xF, 0xF, true));
          v += __builtin_bit_cast(float, __builtin_amdgcn_update_dpp(0, __builtin_bit_cast(int, v), 0x142, 0xA, 0xF, false));
          v += __builtin_bit_cast(float, __builtin_amdgcn_update_dpp(0, __builtin_bit_cast(int, v), 0x143, 0xC, 0xF, false));
          x[q] = v; }
#pragma unroll
      for (int q = 0; q < 8; ++q) LG[(8 * w + q) * 64 + lane] = x[q]; }
    __syncthreads();
    {
        float ah[8], bh[8], kh[8], rh[8];
#pragma unroll
        for (int j = 0; j < 8; ++j) { const float lg = LG[(8 * cg + j) * 64 + tt]; const float G = __expf(lg), Gm1 = G * rd[j], Gi = __builtin_amdgcn_rcpf(G);
            ah[j] = av[j] * Gm1; bh[j] = bv[j] * Gi; kh[j] = kp[j] * Gi; rh[j] = r8[j] * G;
            ((lds_u16*)(lds + CA_BT))[(8 * cg + j) * 72 + tt] = f2bf1(bh[j]); ((lds_u16*)(lds + CA_KT))[(8 * cg + j) * 72 + tt] = f2bf1(kh[j]);
            if (tt == 63) GLf[8 * cg + j] = G; }
        *(LAS v4u*)(lds + CA_AH + tt * PBY + 16 * cg) = pack8(ah); *(LAS v4u*)(lds + CA_BH + tt * PBY + 16 * cg) = pack8(bh);
        *(LAS v4u*)(lds + CA_KH + tt * PBY + 16 * cg) = pack8(kh); *(LAS v4u*)(lds + CA_RH + tt * PBY + 16 * cg) = pack8(rh);
    }
    __syncthreads();
    {
        const int mi = w >> 1, ti0 = 2 * (w & 1); const int abase = mi < 2 ? CA_AH : CA_RH, bbase = (mi & 1) ? CA_KH : CA_BH, dbase = CA_AB + mi * 9216;
        bf16x8 af[2][2], bfr[4][2];
#pragma unroll
        for (int a = 0; a < 2; ++a)
#pragma unroll
            for (int ks = 0; ks < 2; ++ks) af[a][ks] = ldsfrag(lds, abase, 16 * (ti0 + a) + fr, ks, fq);
#pragma unroll
        for (int sj = 0; sj < 4; ++sj)
#pragma unroll
            for (int ks = 0; ks < 2; ++ks) bfr[sj][ks] = ldsfrag(lds, bbase, 16 * sj + fr, ks, fq);
#pragma unroll
        for (int a = 0; a < 2; ++a)
#pragma unroll
            for (int sj = 0; sj < 4; ++sj) { const int ti = ti0 + a; f32x4 acc = {0.f, 0.f, 0.f, 0.f};
#pragma unroll
                for (int ks = 0; ks < 2; ++ks) acc = MFMA16(bfr[sj][ks], af[a][ks], acc);
                const int t = 16 * ti + fr;
#pragma unroll
                for (int r = 0; r < 4; ++r) { const int s = 16 * sj + 4 * fq + r; acc[r] = (mi < 2 ? s < t : s <= t) ? acc[r] : 0.f; }
                typedef unsigned u2v_ __attribute__((ext_vector_type(2))); u2v_ pw; pw.x = pkbf(acc[0], acc[1]); pw.y = pkbf(acc[2], acc[3]);
                *(LAS u2v_*)(lds + dbase + (t * 72 + 16 * sj + 4 * fq) * 2) = pw;
                if (mi == 0 && ti == sj) *(LAS f32x4*)(lds + CA_NF + (ti * 256 + fr * 16 + 4 * fq) * 4) = acc; }
    }
    __syncthreads();
    f32x4 rhs[4];
    if (w == 0) { const int blk = fq, c = fr; const LAS float* N = (const LAS float*)(lds + CA_NF) + blk * 256; float T[16];
#pragma unroll
        for (int i = 0; i < 16; ++i) { float s = (i == c) ? 1.f : 0.f;
#pragma unroll
            for (int j = 0; j < i; ++j) s += N[i * 16 + j] * T[j];
            T[i] = s; }
        lds_u16* td = (lds_u16*)(lds + CA_TD) + blk * 512;
#pragma unroll
        for (int i = 0; i < 16; ++i) { td[i * 32 + c] = f2bf1(T[i]); td[i * 32 + 16 + c] = 0; } }
    if (w < 4) {
#pragma unroll
        for (int i = 0; i < 4; ++i)
#pragma unroll
            for (int r = 0; r < 4; ++r) rhs[i][r] = bf1(((lds_u16*)(lds + CA_AH))[(16 * i + 4 * fq + r) * 72 + 16 * w + fr]);
    } else {
#pragma unroll
        for (int i = 0; i < 4; ++i) { f32x4 acc = {0.f, 0.f, 0.f, 0.f};
#pragma unroll
            for (int ks = 0; ks < 2; ++ks) acc = MFMA16(ldsfrag(lds, CA_AK, 16 * i + fr, ks, fq), ldsfrag(lds, CA_VT, 16 * (w - 4) + fr, ks, fq), acc);
            rhs[i] = acc; }
    }
    __syncthreads();
    {
        LAS unsigned char* AT = lds + CA_AT + w * 1024;
        *(LAS unsigned long long*)(AT + fr * 64 + 32 + fq * 8) = 0ull;
#pragma unroll
        for (int i = 0; i < 4; ++i) { f32x4 acc = rhs[i];
#pragma unroll
            for (int ks = 0; ks < 2; ++ks) acc = MFMA16(ldsfrag(lds, CA_AB, 16 * i + fr, ks, fq), ldsfrag(lds, CA_XT, 16 * w + fr, ks, fq), acc);
            typedef unsigned u2v __attribute__((ext_vector_type(2)));
            u2v pa; pa.x = pkbf(acc[0], acc[1]); pa.y = pkbf(acc[2], acc[3]);
            *(LAS u2v*)(AT + fr * 64 + fq * 8) = pa;
            asm volatile("s_waitcnt lgkmcnt(0)" ::: "memory");
            f32x4 xi = {0.f, 0.f, 0.f, 0.f};
            xi = MFMA16(*(const LAS bf16x8*)(lds + CA_TD + i * 1024 + fr * 64 + fq * 16), *(const LAS bf16x8*)(AT + fr * 64 + fq * 16), xi);
            u2v px; px.x = pkbf(xi[0], xi[1]); px.y = pkbf(xi[2], xi[3]);
            *(LAS u2v*)(lds + CA_XT + (16 * w + fr) * PBY + (16 * i + 4 * fq) * 2) = px;
            asm volatile("s_waitcnt lgkmcnt(0)" ::: "memory"); }
    }
    __syncthreads();
    if (nchain >= 0) { const size_t no = (size_t)((nchain >> 4) * PT + 64 * nchunk + tt) * D + (nchain & 15) * 64 + 8 * cg;
        pf[0] = *(const v4u*)(Rb + no); pf[1] = *(const v4u*)(Kb + no); pf[2] = *(const v4u*)(Vb + no); pf[3] = *(const v4u*)(Db + no); pf[4] = *(const v4u*)(Ab + no); }
    {
        const int mi = w >> 1, ti0 = 2 * (w & 1); const int obase = mi == 0 ? CA_AB : (mi == 1 ? CA_AK : (mi == 2 ? CA_AH : CA_KH));
        const int a1 = mi < 2 ? CA_RB : (mi == 2 ? CA_BT : CA_XT), a1o = mi == 3 ? 64 : 0, b1 = mi == 3 ? CA_BT : CA_XT, b1o = mi == 1 ? 64 : 0;
        const int a2 = mi == 1 ? CA_RK : CA_VT, b2 = mi == 1 ? CA_VT : CA_KT; const bool two = (mi & 1) != 0;
        bf16x8 af[2][2], bfr[4][2];
#pragma unroll
        for (int a = 0; a < 2; ++a)
#pragma unroll
            for (int ks = 0; ks < 2; ++ks) af[a][ks] = ldsfrag(lds, a1, a1o + 16 * (ti0 + a) + fr, ks, fq);
#pragma unroll
        for (int tj = 0; tj < 4; ++tj)
#pragma unroll
            for (int ks = 0; ks < 2; ++ks) bfr[tj][ks] = ldsfrag(lds, b1, b1o + 16 * tj + fr, ks, fq);
        f32x4 acc[2][4];
#pragma unroll
        for (int a = 0; a < 2; ++a)
#pragma unroll
            for (int tj = 0; tj < 4; ++tj) { acc[a][tj] = (f32x4){0.f, 0.f, 0.f, 0.f};
#pragma unroll
                for (int ks = 0; ks < 2; ++ks) acc[a][tj] = MFMA16(bfr[tj][ks], af[a][ks], acc[a][tj]); }
        if (two) {
#pragma unroll
            for (int a = 0; a < 2; ++a)
#pragma unroll
                for (int ks = 0; ks < 2; ++ks) af[a][ks] = ldsfrag(lds, a2, 16 * (ti0 + a) + fr, ks, fq);
#pragma unroll
            for (int tj = 0; tj < 4; ++tj)
#pragma unroll
                for (int ks = 0; ks < 2; ++ks) bfr[tj][ks] = ldsfrag(lds, b2, 16 * tj + fr, ks, fq);
#pragma unroll
            for (int a = 0; a < 2; ++a)
#pragma unroll
                for (int tj = 0; tj < 4; ++tj)
#pragma unroll
                    for (int ks = 0; ks < 2; ++ks) acc[a][tj] = MFMA16(bfr[tj][ks], af[a][ks], acc[a][tj]);
        }
#pragma unroll
        for (int a = 0; a < 2; ++a) { const int row = 16 * (ti0 + a) + fr; const float glr = GLf[row];
#pragma unroll
            for (int tj = 0; tj < 4; ++tj) { const int col = 16 * tj + 4 * fq; f32x4 val = acc[a][tj];
                typedef unsigned u2v_ __attribute__((ext_vector_type(2)));
                if (mi == 0) { const u2v_ rr = *(const LAS u2v_*)(lds + CA_RH + (row * 72 + col) * 2); val += (f32x4){bflo(rr.x), bfhi(rr.x), bflo(rr.y), bfhi(rr.y)}; }
                else if (mi == 2) {
#pragma unroll
                    for (int r = 0; r < 4; ++r) val[r] = glr * (val[r] + (row == col + r ? 1.f : 0.f)); }
                else if (mi == 3) val = val * *(const LAS f32x4*)(GLf + col);
                u2v_ pw; pw.x = pkbf(val[0], val[1]); pw.y = pkbf(val[2], val[3]);
                *(LAS u2v_*)(lds + obase + (row * 72 + col) * 2) = pw; } }
    }
    __syncthreads();
    *(v4u*)((dummy ? dummy : Rb) + goff) = *(const LAS v4u*)(lds + CA_AB + tt * PBY + 16 * cg);
    *(v4u*)((dummy ? dummy : Ab) + goff) = *(const LAS v4u*)(lds + CA_AK + tt * PBY + 16 * cg);
    *(v4u*)((dummy ? dummy : Kb) + goff) = *(const LAS v4u*)(lds + CA_AH + tt * PBY + 16 * cg);
    *(v4u*)((dummy ? dummy : Db) + goff) = *(const LAS v4u*)(lds + CA_KH + tt * PBY + 16 * cg);
    __syncthreads();
}
constexpr int CB_S = 0, CB_P2 = 9216, CB_P3 = 18432, CB_Y0 = 27648, CB_Z0 = 36864, CB_YS = 46080  ;
__device__ __forceinline__ void rwkv_state_chain(const Frame& F, int chain, float* ST, const bf16* Rb, const bf16* Kb, const bf16* Vb, const bf16* Db, const bf16* Ab, bf16* Gb, const float* BON, const float* gn_w, const float* gn_b, bf16* dummy) {
    LAS unsigned char* lds = F.lds;
    const int tid = F.tid, lane = F.lane, w = F.wave, fr = lane & 15, fq = lane >> 4, cg = tid & 7, tt = tid >> 3;
    const int h = chain & 15, rowc0 = (chain >> 4) * PT, ch = h * 64 + 8 * cg;
    for (int i = tid; i < 64 * 36; i += 512) ((LAS unsigned*)(lds + CB_S))[i] = 0u;
    f32x4 Sacc[2];
    Sacc[0] = (f32x4){0.f, 0.f, 0.f, 0.f}; Sacc[1] = Sacc[0];
    v4u q2, q3, qy, qz, qg, qb; float qbon;
    float cgw[8], cgb[8];
#pragma unroll
    for (int j = 0; j < 8; ++j) { cgw[j] = gn_w[ch + j]; cgb[j] = gn_b[ch + j]; }
#define CB_LOAD(cc) do { const size_t o_ = (size_t)(rowc0 + 64 * (cc) + tt) * D + ch; q2 = *(const v4u*)(Rb + o_); q3 = *(const v4u*)(Kb + o_); qy = *(const v4u*)(Ab + o_); qz = *(const v4u*)(Db + o_); \
        qg = *(const v4u*)(Gb + o_); qb = *(const v4u*)(Vb + o_); qbon = BON[(size_t)(rowc0 + 64 * (cc) + tt) * 16 + h]; } while (0)
    CB_LOAD(0);
    for (int c = 0; c < PT / 64; ++c) {
        *(LAS v4u*)(lds + CB_P2 + tt * PBY + 16 * cg) = q2; *(LAS v4u*)(lds + CB_P3 + tt * PBY + 16 * cg) = q3;
        *(LAS v4u*)(lds + CB_Y0 + tt * PBY + 16 * cg) = qy; *(LAS v4u*)(lds + CB_Z0 + tt * PBY + 16 * cg) = qz;
        float gw[8], gb[8]; unpack8(qg, gw); unpack8(qb, gb);
        const float bonc = qbon;
        if (c + 1 < PT / 64) CB_LOAD(c + 1);
        __syncthreads();
        f32x4 yacc[2];
        typedef unsigned u2v_ __attribute__((ext_vector_type(2)));
#pragma unroll
        for (int q = 0; q < 2; ++q) { const int tq = 2 * w + q, ti = tq >> 2, tj = tq & 3, row = 16 * ti + fr, col = 16 * tj + 4 * fq;
            const u2v_ y0 = *(const LAS u2v_*)(lds + CB_Y0 + (row * 72 + col) * 2), z0 = *(const LAS u2v_*)(lds + CB_Z0 + (row * 72 + col) * 2);
            f32x4 ya = {bflo(y0.x), bfhi(y0.x), bflo(y0.y), bfhi(y0.y)}, sa = {bflo(z0.x), bfhi(z0.x), bflo(z0.y), bfhi(z0.y)};
#pragma unroll
            for (int ks = 0; ks < 2; ++ks) { ya = MFMA16(ldsfrag(lds, CB_S, 16 * tj + fr, ks, fq), ldsfrag(lds, CB_P2, 16 * ti + fr, ks, fq), ya);
                                             sa = MFMA16(ldsfrag(lds, CB_P3, 16 * tj + fr, ks, fq), ldsfrag(lds, CB_S, 16 * ti + fr, ks, fq), sa); }
            yacc[q] = ya; Sacc[q] = sa; }
        __syncthreads();
#pragma unroll
        for (int q = 0; q < 2; ++q) { const int tq = 2 * w + q, ti = tq >> 2, tj = tq & 3, row = 16 * ti + fr, col = 16 * tj + 4 * fq;
            u2v_ pw; pw.x = pkbf(Sacc[q][0], Sacc[q][1]); pw.y = pkbf(Sacc[q][2], Sacc[q][3]);
            *(LAS u2v_*)(lds + CB_S + (row * 72 + col) * 2) = pw;
            *(LAS f32x4*)(lds + CB_YS + (row * 64 + col) * 4) = yacc[q]; }
        __syncthreads();
        { const f32x4 y0 = *(const LAS f32x4*)(lds + CB_YS + (tt * 64 + 8 * cg) * 4), y1 = *(const LAS f32x4*)(lds + CB_YS + (tt * 64 + 8 * cg + 4) * 4);
          float yy[8] = {y0.x, y0.y, y0.z, y0.w, y1.x, y1.y, y1.z, y1.w}; float s1 = 0.f;
#pragma unroll
          for (int j = 0; j < 8; ++j) s1 += yy[j];
          const float mean = red8(s1) * (1.f / 64.f); float s2 = 0.f;
#pragma unroll
          for (int j = 0; j < 8; ++j) { yy[j] -= mean; s2 += yy[j] * yy[j]; }
          const float rstd = __builtin_amdgcn_rsqf(red8(s2) * (1.f / 64.f) + GN_EPS);
          float o[8];
#pragma unroll
          for (int j = 0; j < 8; ++j) o[j] = ((yy[j] * rstd) * cgw[j] + cgb[j] + bonc * gb[j]) * gw[j];
          *(v4u*)((dummy ? dummy : Gb) + (size_t)(rowc0 + 64 * c + tt) * D + ch) = pack8(o); }
    }
#undef CB_LOAD
#pragma unroll
    for (int q = 0; q < 2; ++q) { const int tq = 2 * w + q, ti = tq >> 2, tj = tq & 3; *(f32x4*)(ST + (16 * ti + fr) * 64 + 16 * tj + 4 * fq) = Sacc[q]; }
    __syncthreads();
}

#ifndef MK_N_LAUNCHES
#define MK_N_LAUNCHES 1
#endif
constexpr int N_PHASES = 22;
#ifndef PROBE_PH
#define PROBE_PH (-1)
#define PROBE_N 1
#endif
#ifndef PROBE_VAR
#define PROBE_VAR 0
#endif
#ifndef EN_MASK
#define EN_MASK 0xff
#endif
constexpr bool EN_NORM = EN_MASK & 1, EN_UP = EN_MASK & 2, EN_RES = EN_MASK & 4, EN_RW = EN_MASK & 8, EN_L2 = EN_MASK & 16, EN_SCAN = EN_MASK & 32, EN_IN = EN_MASK & 64, EN_ML = EN_MASK & 128;
struct Args { const float* in[N_IN]; float* out; unsigned char* ws; int ph_lo, ph_hi; };
__global__ void __launch_bounds__(NWAVES * 64, 2) mega_fwd(Args args) {
    extern __shared__ __attribute__((aligned(16))) unsigned char lds_raw[];
    { const int t0 = threadIdx.x;
      for (int u = t0; u < (LDS_BYTES - LDSCTL_OFF) / 4; u += NWAVES * 64) ((LAS unsigned*)((LAS unsigned char*)lds_raw + LDSCTL_OFF))[u] = 0u; }
    __syncthreads();
    { const int t0 = threadIdx.x; if (t0 < N_IN) ((LAS unsigned long long*)((LAS unsigned char*)lds_raw + TAB_OFF))[t0] = (unsigned long long)args.in[t0]; }
    __syncthreads();
    XcdBarrier bar; bar.bar = (unsigned*)((gu32*)(args.ws + WS_CTL) + CW_BAR); bar.x = 0; bar.st = nullptr;
    if (args.ph_hi - args.ph_lo > 1) bar = xcd_barrier_post((unsigned*)((gu32*)(args.ws + WS_CTL) + CW_BAR), (volatile LAS unsigned*)((LAS unsigned char*)lds_raw + MISC_OFF) + 8);
    int ph = args.ph_lo, rep = 0;
    while (ph < args.ph_hi) {
        int tid_ = threadIdx.x; asm volatile("" : "+v"(tid_));
        unsigned char* ws = args.ws; float* out = args.out;
        Frame F;
        F.lds = (LAS unsigned char*)lds_raw;
        F.MISC = (volatile LAS unsigned*)(F.lds + MISC_OFF);
        F.tid = tid_; F.lane = F.tid & 63; F.wave = __builtin_amdgcn_readfirstlane(F.tid >> 6);
        F.G = gridDim.x; { const int bx = blockIdx.x; F.vcu = (F.G % 8 == 0) ? (bx % 8) * (F.G / 8) + bx / 8 : bx; }
        F.ctl = (gu32*)(ws + WS_CTL); F.tab = (volatile LAS unsigned long long*)(F.lds + TAB_OFF);
        bf16* Wb = (bf16*)(ws + WS_W); bf16* XR = (bf16*)(ws + WS_XR); unsigned char* big = ws + WS_BIG;
        bf16* Hb = (bf16*)(big + B_H); bf16* XN = (bf16*)(big + B_XN); float* SLAB = (float*)(big + B_SLAB);
        bf16* ACAT = (bf16*)(big + B_ACAT); bf16* Rb = (bf16*)(big + B_R); bf16* Kb = (bf16*)(big + B_K); bf16* Vb = (bf16*)(big + B_V); bf16* DECb = (bf16*)(big + B_DEC); bf16* AAb = (bf16*)(big + B_AA);
        bf16* QKR = (bf16*)(big + B_QKR); bf16* VVb = (bf16*)(big + B_VV); bf16* HOb = (bf16*)(big + B_HO); bf16* OOb = (bf16*)(big + B_OO); float* IFb = (float*)(big + B_IF);
        bf16* GGb = (bf16*)((unsigned char*)out + OS_GG); bf16* LORA = (bf16*)((unsigned char*)out + OS_LORA);
        const int c_id = (int)blockIdx.x;
        const int nrep = (ph == PROBE_PH && ph != 6) ? PROBE_N : 1;
        const int pvar = (rep + 1 < nrep) ? PROBE_VAR : 0;
        if (EN_NORM && (ph == 0 || ph == 3 || ph == 8 || ph == 11 || ph == 14 || ph == 18 || ph == 21)) {
            int kind = 0, layer = 0, ab = 0, nslab = 0; float coef = 0.5f; const float* gain = nullptr;
            if (ph == 0) { kind = 0; layer = 0; ab = 0; gain = inptr(F, I_NFA); nslab = 0; }
            else if (ph == 3) { kind = 1; gain = inptr(F, I_NMIX); nslab = 11; }
            else if (ph == 8) { kind = 0; layer = 0; ab = 1; gain = inptr(F, I_NFB); nslab = 4; coef = 1.f; }
            else if (ph == 11) { kind = 0; layer = 1; ab = 0; gain = inptr(F, I_NFA) + D; nslab = 11; }
            else if (ph == 14) { kind = 2; gain = inptr(F, I_NMIX) + D; nslab = 11; }
            else if (ph == 18) { kind = -1; gain = inptr(F, I_NFB) + D; nslab = 4; coef = 1.f; }
            else { kind = -1; gain = inptr(F, I_NFIN); nslab = 11; }
            if (kind >= 0) convert_weights(F, kind, layer, ab, Wb);
            if (ph == 0) norm_rows<0, true, true>(F, inptr(F, I_XP), inptr(F, I_XS), nslab, coef, SLAB, XR, gain, XN, nullptr, out, pvar);
            else if (ph == 3) norm_rows<1, false, true>(F, XR, inptr(F, I_XS), nslab, coef, SLAB, XR, gain, ACAT, inptr(F, I_RSHIFT), out, pvar);
            else if (ph == 21) norm_rows<2, false, false>(F, XR, XR + (size_t)MP * D, nslab, coef, SLAB, XR, gain, nullptr, nullptr, out, pvar);
            else norm_rows<0, false, false>(F, XR, XR + (size_t)MP * D, nslab, coef, SLAB, XR, gain, XN, nullptr, out, pvar);
        } else if (EN_UP && (ph == 1 || ph == 9 || ph == 12 || ph == 19)) {
            const bf16* Wu = ph == 19 ? (const bf16*)(ws + WS_W2) : Wb;
            pg8::Gemm g{XN, Wu + W_GU / 2, M, 2 * FF, D}; pg8::UnitOrder S; S.init(M / 256, 2 * FF / 256, D, F.G, c_id, 0);
            EpiSwiglu E{Hb, pvar};
            pg8::gemm_phase<EpiSwiglu, pg8::UnitOrder, true, true>(F.lds, g, S, E, F.tid);
        } else if (EN_RES && (ph == 2 || ph == 7 || ph == 10 || ph == 13 || ph == 17 || ph == 20)) {
            const bf16* A = Hb; const bf16* Bt = (ph == 20 ? (const bf16*)(ws + WS_W2) : Wb) + W_D / 2; int K = FF; float coef = 0.5f; const float* basef = nullptr;
            if (ph == 2) basef = inptr(F, I_XP);
            if (ph == 7) { A = GGb; Bt = Wb + W_O / 2; K = D; coef = 1.f; }
            if (ph == 17) { A = HOb; Bt = Wb + W_OUT / 2; K = D; coef = 1.f; }
            pg8::Gemm g{A, Bt, M, D, K}; pg8::UnitOrder S; S.init(MP / 256, D / 256, K, F.G, c_id, K / 256);
            EpiRes E{basef, XR, XR, SLAB, coef};
            pg8::gemm_phase<EpiRes, pg8::UnitOrder, true, true>(F.lds, g, S, E, F.tid);
        } else if (EN_RW && ph == 4) {
            pg8::Gemm g{ACAT, Wb + W_RW / 2, M, NRW, KRW}; pg8::UnitOrder S; S.init(M / 256, NRW / 256, KRW, F.G, c_id, 0);
            EpiRw E{Rb, Kb, Vb, LORA};
            pg8::gemm_phase<EpiRw, pg8::UnitOrder, true, true>(F.lds, g, S, E, F.tid);
        } else if (EN_L2 && ph == 5) {
            pg8::Gemm g{LORA, Wb + W_L2 / 2, M, NL2, KL2}; pg8::UnitOrder S; S.init(M / 256, NL2 / 256, KL2, F.G, c_id, -1);
            EpiL2 E{DECb, AAb, GGb, inptr(F, I_W0), inptr(F, I_A0)};
            pg8::gemm_phase<EpiL2, pg8::UnitOrder, true, true>(F.lds, g, S, E, F.tid);
        } else if (EN_SCAN && ph == 6) {
            bf16* dummy = (bf16*)(ws + WS_YRAW);
            for (int dr = (PROBE_PH == 6 && PROBE_VAR == 5) ? PROBE_N - 1 : 0; dr >= 0; --dr) {
                v4u pf[6]; pf[5] = (v4u){0u, 0u, 0u, 0u};
                { const int it = F.vcu, cg_ = F.tid & 7, tt_ = F.tid >> 3; const size_t o = (size_t)(((it >> 5) >> 4) * PT + 64 * (it & 31) + tt_) * D + ((it >> 5) & 15) * 64 + 8 * cg_;
                  pf[0] = *(const v4u*)(Rb + o); pf[1] = *(const v4u*)(Kb + o); pf[2] = *(const v4u*)(Vb + o); pf[3] = *(const v4u*)(DECb + o); pf[4] = *(const v4u*)(AAb + o); }
                for (int it = F.vcu; it < PB * 16 * (PT / 64); it += F.G) { const int nx = it + F.G < PB * 16 * (PT / 64) ? it + F.G : -1;
                    rwkv_chunk_item(F, it >> 5, it & 31, Rb, Kb, Vb, DECb, AAb, GGb, inptr(F, I_KK), inptr(F, I_KA), inptr(F, I_RK), (float*)(ws + WS_BON), dr ? dummy : nullptr, pf, nx < 0 ? -1 : nx >> 5, nx & 31); }
            }
            xcd_barrier(bar);
            for (int dr = (PROBE_PH == 6 && PROBE_VAR == 6) ? PROBE_N - 1 : 0; dr >= 0; --dr)
                if (F.vcu < 128) rwkv_state_chain(F, F.vcu, out + O_P_S + (size_t)F.vcu * 4096, Rb, Kb, Vb, DECb, AAb, GGb, (const float*)(ws + WS_BON), inptr(F, I_GNW), inptr(F, I_GNB), dr ? dummy : nullptr);
            { const int i0 = F.vcu < 128 ? 2 * F.vcu : 256 + 14 * (F.vcu - 128), i1 = F.vcu < 128 ? i0 + 2 : i0 + 14;
              for (int i = i0; i < i1; ++i) { const int b = i >> 4, h = i & 15;
                  rwkv_chain(F, MP + b * STK, STK, h, inptr(F, I_RS) + (size_t)i * 4096, out + O_S_S + (size_t)i * 4096, Rb, Kb, Vb, DECb, AAb, GGb, inptr(F, I_KK), inptr(F, I_KA), inptr(F, I_RK), inptr(F, I_GNW), inptr(F, I_GNB), true, 0); } }
        } else if (EN_IN && ph == 15) {
            pg8::Gemm g{XN, Wb + W_IN / 2, M, NIN, D}; pg8::UnitOrder S; S.init(M / 256, NIN / 256, D, F.G, c_id, 0);
            EpiIn E{QKR, VVb, OOb, IFb, inptr(F, I_BIF), pvar};
            pg8::gemm_phase<EpiIn, pg8::UnitOrder, true, true>(F.lds, g, S, E, F.tid);
        } else if (EN_ML && ph == 16) {
            float* NUM = out + O_Y; float* DEN = (float*)(ws + WS_BON); bf16* Qs = (bf16*)(big + 100 * MiB)  ; float* SEG = (float*)(ws + WS_YRAW);
            for (int i = F.vcu; i < PB * 8 * ML_NSEG; i += F.G) { const int chain = i & 63, seg = i >> 6;
                mlstm_prompt_chain(F, chain >> 3, chain & 7, seg, QKR, VVb, OOb, IFb, HOb, inptr(F, I_CW), inptr(F, I_CB), inptr(F, I_MNW), NUM, DEN, Qs, SEG, 0); }
            xcd_barrier(bar);
            for (int i = F.vcu; i < PB * 8 * (ML_NSEG - 1); i += F.G) { const int chain = i & 63, seg = 1 + (i >> 6);
                mlstm_fix_seg(F, chain >> 3, chain & 7, seg, QKR, OOb, IFb, HOb, inptr(F, I_MNW), NUM, DEN, Qs, SEG, out); }
            if (F.G == 256) {
                if (F.vcu >= 192) { for (int j = 0; j < 9; ++j) { const int i = (F.vcu - 192) * 9 + j;
                    mlstm_sample_item(F, i >> 3, i & 7, QKR, VVb, OOb, IFb, HOb, inptr(F, I_CW), inptr(F, I_CB), inptr(F, I_MNW), inptr(F, I_MC), inptr(F, I_MN), inptr(F, I_MM), inptr(F, I_MCONV), out); } }
                else { for (int i = 576 + F.vcu; i < SB * 8; i += 192)
                    mlstm_sample_item(F, i >> 3, i & 7, QKR, VVb, OOb, IFb, HOb, inptr(F, I_CW), inptr(F, I_CB), inptr(F, I_MNW), inptr(F, I_MC), inptr(F, I_MN), inptr(F, I_MM), inptr(F, I_MCONV), out); }
            } else {
                for (int i = F.vcu; i < SB * 8; i += F.G)
                    mlstm_sample_item(F, i >> 3, i & 7, QKR, VVb, OOb, IFb, HOb, inptr(F, I_CW), inptr(F, I_CB), inptr(F, I_MNW), inptr(F, I_MC), inptr(F, I_MN), inptr(F, I_MM), inptr(F, I_MCONV), out);
            }
            if (rep + 1 == nrep) convert_weights(F, 0, 1, 1, (bf16*)(ws + WS_W2));
        }
        if (++rep < nrep) continue;
        rep = 0;
        if (ph + 1 < args.ph_hi) xcd_barrier(bar);
        ++ph;
    }
}

extern "C" void kernel_launch(void* const* d_in, const int* in_sizes, int n_in, void* d_out, int out_size, void* d_ws, size_t ws_size, hipStream_t stream) {
    static int grid = 0;
    if (grid == 0) {
        if (n_in != N_IN || out_size != (int)O_END || ws_size < WS_END2) { fprintf(stderr, "kernel_launch: unexpected shapes (n_in %d, out %d, ws %zu); nothing launched\n", n_in, out_size, ws_size); grid = -1; return; }
        int dev = 0, cus = 0, per_cu = 0;
        if (hipGetDevice(&dev) != hipSuccess || hipDeviceGetAttribute(&cus, hipDeviceAttributeMultiprocessorCount, dev) != hipSuccess) { grid = -1; return; }
        if (hipFuncSetAttribute((const void*)mega_fwd, hipFuncAttributeMaxDynamicSharedMemorySize, LDS_BYTES) != hipSuccess) { fprintf(stderr, "kernel_launch: hipFuncSetAttribute failed\n"); grid = -1; return; }
        if (hipOccupancyMaxActiveBlocksPerMultiprocessor(&per_cu, (const void*)mega_fwd, NWAVES * 64, LDS_BYTES) != hipSuccess || per_cu < 1) { fprintf(stderr, "kernel_launch: occupancy query says %d\n", per_cu); per_cu = 1; }
        (void)hipGetLastError();
        grid = cus;
    }
    if (grid < 0) return;
    (void)hipMemsetAsync((char*)d_ws + WS_CTL, 0, CTL_ZERO_BYTES, stream);
    Args a{};
    for (int i = 0; i < N_IN; ++i) a.in[i] = (const float*)d_in[i];
    a.out = (float*)d_out; a.ws = (unsigned char*)d_ws;
#if MK_N_LAUNCHES == 1
    a.ph_lo = 0; a.ph_hi = N_PHASES;
    { void* kargs[] = {(void*)&a};
      const hipError_t e = hipLaunchCooperativeKernel((const void*)mega_fwd, dim3(grid), dim3(NWAVES * 64), kargs, LDS_BYTES, stream);
      if (e != hipSuccess) fprintf(stderr, "kernel_launch: cooperative launch failed: %s (grid %d)\n", hipGetErrorString(e), grid); }
#else
    for (int p = 0; p < N_PHASES; ++p) { a.ph_lo = p; a.ph_hi = p + 1; hipLaunchKernelGGL(mega_fwd, dim3(grid), dim3(NWAVES * 64), LDS_BYTES, stream, a); }
#endif
}
```

```cpp
#include <hip/hip_runtime.h>
#include <cstdio>
#include <cstdint>
namespace pg8 {
#define PG8_LAS __attribute__((address_space(3)))
typedef unsigned short bf16_t;
typedef short bf16x8 __attribute__((ext_vector_type(8)));
typedef float f32x4 __attribute__((ext_vector_type(4)));
typedef unsigned u32x4 __attribute__((ext_vector_type(4)));
constexpr int BM = 256, BK = 64, HALF = 128, HTB = HALF * BK * 2  , STAGE_BYTES = 8 * HTB, NXCD = 8, WGM = 8;

__host__ __device__ __forceinline__ int lds_byte(int r, int c) { const int st = (r >> 4) * 2 + (c >> 5), rr = r & 15, cc = c & 31, ob = rr * 64 + cc * 2; return st * 1024 + (ob ^ (((ob >> 9) & 1) << 5)); }
__host__ __device__ __forceinline__ void stage_rc(int b, int& R, int& C) { const int st = b / 1024, sb = b % 1024, swz = sb ^ (((sb >> 9) & 1) << 5); R = (st >> 1) * 16 + swz / 64; C = (st & 1) * 32 + (swz % 64) / 2; }
__host__ __device__ __forceinline__ int perm32(int rho) { const int n = rho >> 4, i = rho & 15; return 8 * (i >> 2) + 4 * n + (i & 3); }

struct Unit { int pm, pn, k0, nt, slab; };
struct Gemm { const bf16_t* A; const bf16_t* Bt; int M, N, K; };

struct UnitOrder {
    int nM, nN, nwg, G, c, ntf, tailS;
    __device__ __forceinline__ void init(int nM_, int nN_, int K, int G_, int c_, int tailS_) { nM = nM_; nN = nN_; nwg = nM * nN; G = G_; c = c_; ntf = K / BK; tailS = tailS_; }
    __device__ __forceinline__ bool next(int i, Unit& u) const {
        long L = (long)i * G + c;
        if (L < nwg) {
            int wgid = (int)L; { const int q = nwg / NXCD, r = nwg % NXCD, xcd = wgid % NXCD, off = wgid / NXCD; wgid = (xcd < r ? xcd * (q + 1) : r * (q + 1) + (xcd - r) * q) + off; }
            const int nig = WGM * nN, gid = wgid / nig, fm = gid * WGM, gsz = (nM - fm) < WGM ? (nM - fm) : WGM;
            u.pm = fm + ((wgid % nig) % gsz); u.pn = (wgid % nig) / gsz; u.k0 = 0; u.nt = ntf; u.slab = -1;
            if (tailS == -2) u.pm += nM * (u.pn < 12 ? (u.pn >> 2) : u.pn - 9);
            if (tailS == -1) { u.nt = 4; u.k0 = u.pn >= 8 ? 128 : 0; }
            return true;
        }
        L -= nwg; if (tailS <= 0 || L >= 8 * tailS) return false;
        int tile, sl; if (tailS == 4) { tile = (int)L >> 2; sl = (int)L & 3; } else { tile = (int)L / 11; sl = (int)L - 11 * tile; }
        u.pm = 64 + (tile >> 2); u.pn = tile & 3; u.k0 = sl * 256; u.nt = 4; u.slab = sl; return true;
    }
    __device__ __forceinline__ void a_ready(const Unit&) const {}
    __device__ __forceinline__ void done(const Unit&) const {}
};
template <class Epi, class Sched, bool ALIGN_EPI = false, bool SP2 = false>
__device__ __forceinline__ void gemm_phase(PG8_LAS unsigned char* lds, const Gemm g, const Sched& S, const Epi& E, const int tid) {
    const int wid = __builtin_amdgcn_readfirstlane(tid >> 6), lane = tid & 63, wr = wid >> 2, wc = wid & 3, fr = lane & 15, fq = lane >> 4;
    const int K = g.K;
    unsigned voffA[2], voffB[2];
#pragma unroll
    for (int i = 0; i < 2; ++i) { int R, C; stage_rc(tid * 16 + i * 8192, R, C); const int Rb = Epi::PERM ? ((R & ~31) + perm32(R & 31)) : R;
        voffA[i] = (unsigned)(R * K + C) * 2u; voffB[i] = (unsigned)(Rb * K + C) * 2u; }
    const size_t kstep = (size_t)(BK * 2);
    const size_t hstep = (size_t)HALF * K * 2;
    const size_t tstep = 2 * hstep;
    const unsigned ldsw = (unsigned)wid * 1024u;
    const int aoff = lds_byte(wr * 64 + fr, fq * 8), boff = lds_byte(wc * 32 + fr, fq * 8);
#define PG8_SA(b, h) (((b) * 2 + (h)) * HTB)
#define PG8_SB(b, h) ((4 + (b) * 2 + (h)) * HTB)
#define PG8_STAGE(bufoff, gbase, voff) do { _Pragma("unroll") for (int _i = 0; _i < 2; ++_i) \
        __builtin_amdgcn_global_load_lds((const unsigned*)((const char*)(gbase) + (voff)[_i]), (PG8_LAS unsigned*)(lds + (bufoff) + ldsw + _i * 8192), 16, 0, 0); } while (0)
#define PG8_LDA(dst, b, h) do { _Pragma("unroll") for (int m = 0; m < 4; ++m) _Pragma("unroll") for (int k = 0; k < 2; ++k) dst[m][k] = *(const PG8_LAS bf16x8*)(lds + PG8_SA(b, h) + aoff + m * 2048 + k * 1024); } while (0)
#define PG8_LDB(dst, b, h) do { _Pragma("unroll") for (int n = 0; n < 2; ++n) _Pragma("unroll") for (int k = 0; k < 2; ++k) dst[n][k] = *(const PG8_LAS bf16x8*)(lds + PG8_SB(b, h) + boff + n * 2048 + k * 1024); } while (0)
#define PG8_MMA(ai, bj, At, Bt) do { __builtin_amdgcn_s_setprio(1); _Pragma("unroll") for (int m = 0; m < 4; ++m) _Pragma("unroll") for (int n = 0; n < 2; ++n) _Pragma("unroll") for (int k = 0; k < 2; ++k) \
        acc[ai][bj][m][n] = __builtin_amdgcn_mfma_f32_16x16x32_bf16(Bt[n][k], At[m][k], acc[ai][bj][m][n], 0, 0, 0); __builtin_amdgcn_s_setprio(0); } while (0)
#define PG8_WAIT_V(n) asm volatile("s_waitcnt vmcnt(" #n ")" ::: "memory")
#define PG8_WAIT_L(n) asm volatile("s_waitcnt lgkmcnt(" #n ")" ::: "memory")
#define PG8_BAR __builtin_amdgcn_s_barrier()
#define PG8_SCHED __builtin_amdgcn_sched_barrier(0)
    Unit cur, nxt; int ui = 0;
    if (!S.next(0, cur)) return;
    f32x4 acc[2][2][4][2];
#pragma unroll
    for (int a = 0; a < 2; ++a)
#pragma unroll
        for (int b = 0; b < 2; ++b)
#pragma unroll
            for (int m = 0; m < 4; ++m)
#pragma unroll
                for (int n = 0; n < 2; ++n) acc[a][b][m][n] = (f32x4){0.f, 0.f, 0.f, 0.f};
    bf16x8 At[4][2], B0[2][2], B1[2][2];
    const char* cA = (const char*)g.A + (size_t)cur.pm * tstep + (size_t)cur.k0 * 2; const char* cB = (const char*)g.Bt + (size_t)cur.pn * tstep + (size_t)cur.k0 * 2;
    S.a_ready(cur);
    if constexpr (SP2) {
        PG8_STAGE(PG8_SB(0, 0), cB, voffB); PG8_STAGE(PG8_SB(0, 1), cB + hstep, voffB); PG8_STAGE(PG8_SA(0, 0), cA, voffA); PG8_STAGE(PG8_SA(0, 1), cA + hstep, voffA);
        if (wr == 1) PG8_BAR;
        PG8_WAIT_V(2); PG8_BAR;
        PG8_STAGE(PG8_SB(1, 0), cB + kstep, voffB); PG8_STAGE(PG8_SA(1, 0), cA + kstep, voffA); PG8_STAGE(PG8_SB(1, 1), cB + hstep + kstep, voffB);
        PG8_WAIT_V(6); PG8_BAR;
    } else {
        PG8_STAGE(PG8_SB(0, 0), cB, voffB); PG8_STAGE(PG8_SA(0, 0), cA, voffA); PG8_STAGE(PG8_SB(0, 1), cB + hstep, voffB); PG8_STAGE(PG8_SA(0, 1), cA + hstep, voffA);
        if (wr == 1) PG8_BAR;
        PG8_WAIT_V(4); PG8_BAR;
        PG8_STAGE(PG8_SB(1, 0), cB + kstep, voffB); PG8_STAGE(PG8_SA(1, 0), cA + kstep, voffA); PG8_STAGE(PG8_SB(1, 1), cB + hstep + kstep, voffB);
        PG8_WAIT_V(6); PG8_BAR;
    }
    for (;;) {
        const bool has_next = S.next(ui + 1, nxt);
        const char* nA = has_next ? (const char*)g.A + (size_t)nxt.pm * tstep + (size_t)nxt.k0 * 2 : cA; const char* nB = has_next ? (const char*)g.Bt + (size_t)nxt.pn * tstep + (size_t)nxt.k0 * 2 : cB;
        const int nt = cur.nt;
        for (int t = 0; t < nt; t += 2) {
            const bool last = (t == nt - 2);
            const char* a1 = cA + (size_t)(t + 1) * kstep;
            const char* a2 = last ? nA : cA + (size_t)(t + 2) * kstep; const char* b2 = last ? nB : cB + (size_t)(t + 2) * kstep;
            const char* a3 = a2 + kstep; const char* b3 = b2 + kstep;
            if (last && has_next) S.a_ready(nxt);
            if constexpr (SP2) {
            PG8_LDB(B0, 0, 0); PG8_LDB(B1, 0, 1); PG8_SCHED; PG8_LDA(At, 0, 0); PG8_STAGE(PG8_SA(1, 1), a1 + hstep, voffA);
            PG8_WAIT_V(8); PG8_WAIT_L(0); PG8_BAR; PG8_MMA(0, 0, At, B0); PG8_MMA(0, 1, At, B1); PG8_BAR; PG8_SCHED;
            PG8_LDA(At, 0, 1); PG8_STAGE(PG8_SB(0, 0), b2, voffB); PG8_STAGE(PG8_SB(0, 1), b2 + hstep, voffB); PG8_STAGE(PG8_SA(0, 0), a2, voffA);
            PG8_WAIT_V(8); PG8_WAIT_L(0); PG8_BAR; PG8_MMA(1, 0, At, B0); PG8_MMA(1, 1, At, B1); PG8_BAR; PG8_SCHED;
            PG8_LDB(B0, 1, 0); PG8_LDB(B1, 1, 1); PG8_SCHED; PG8_LDA(At, 1, 0); PG8_STAGE(PG8_SA(0, 1), a2 + hstep, voffA);
            PG8_WAIT_V(8); PG8_WAIT_L(0); PG8_BAR; PG8_MMA(0, 0, At, B0); PG8_MMA(0, 1, At, B1); PG8_BAR; PG8_SCHED;
            PG8_LDA(At, 1, 1); PG8_STAGE(PG8_SB(1, 0), b3, voffB); PG8_STAGE(PG8_SB(1, 1), b3 + hstep, voffB); PG8_STAGE(PG8_SA(1, 0), a3, voffA);
            PG8_WAIT_V(8); PG8_WAIT_L(0); PG8_BAR; PG8_MMA(1, 0, At, B0); PG8_MMA(1, 1, At, B1); PG8_BAR; PG8_SCHED;
            } else {
            PG8_LDB(B0, 0, 0); PG8_SCHED; PG8_LDA(At, 0, 0); PG8_STAGE(PG8_SA(1, 1), a1 + hstep, voffA);
            PG8_WAIT_L(8); PG8_BAR; PG8_WAIT_L(0); PG8_MMA(0, 0, At, B0); PG8_BAR; PG8_SCHED;
            PG8_LDB(B1, 0, 1); PG8_STAGE(PG8_SB(0, 0), b2, voffB);
            PG8_BAR; PG8_WAIT_L(0); PG8_MMA(0, 1, At, B1); PG8_BAR;
            PG8_LDA(At, 0, 1); PG8_STAGE(PG8_SA(0, 0), a2, voffA);
            PG8_BAR; PG8_WAIT_L(0); PG8_MMA(1, 0, At, B0); PG8_BAR; PG8_SCHED;
            PG8_STAGE(PG8_SB(0, 1), b2 + hstep, voffB);
            PG8_WAIT_V(6); PG8_BAR; PG8_MMA(1, 1, At, B1); PG8_BAR;
            PG8_LDB(B0, 1, 0); PG8_SCHED; PG8_LDA(At, 1, 0); PG8_STAGE(PG8_SA(0, 1), a2 + hstep, voffA);
            PG8_WAIT_L(8); PG8_BAR; PG8_WAIT_L(0); PG8_MMA(0, 0, At, B0); PG8_BAR; PG8_SCHED;
            PG8_LDB(B1, 1, 1); PG8_STAGE(PG8_SB(1, 0), b3, voffB);
            PG8_BAR; PG8_WAIT_L(0); PG8_MMA(0, 1, At, B1); PG8_BAR;
            PG8_LDA(At, 1, 1); PG8_STAGE(PG8_SA(1, 0), a3, voffA);
            PG8_BAR; PG8_WAIT_L(0); PG8_MMA(1, 0, At, B0); PG8_BAR; PG8_SCHED;
            PG8_STAGE(PG8_SB(1, 1), b3 + hstep, voffB);
            PG8_WAIT_V(6); PG8_BAR; PG8_MMA(1, 1, At, B1); PG8_BAR;
            }
        }
        if constexpr (ALIGN_EPI) { if (wr == 0) PG8_BAR; }
        if constexpr (!Epi::AFTER_DRAIN) { E(acc, cur, wr, wc, fr, fq); S.done(cur); }
        if (!has_next) break;
#pragma unroll
        for (int a = 0; a < 2; ++a)
#pragma unroll
            for (int b = 0; b < 2; ++b)
#pragma unroll
                for (int m = 0; m < 4; ++m)
#pragma unroll
                    for (int n = 0; n < 2; ++n) acc[a][b][m][n] = (f32x4){0.f, 0.f, 0.f, 0.f};
        cur = nxt; cA = nA; cB = nB; ++ui;
        if constexpr (ALIGN_EPI) { if (wr == 1) PG8_BAR; }
    }
    PG8_WAIT_V(0);
    if constexpr (!ALIGN_EPI) { if (wr == 0) PG8_BAR; }
    PG8_BAR;
    if constexpr (Epi::AFTER_DRAIN) { E.fused(acc, cur, wr, wc, fr, fq, lds, wid, lane); S.done(cur); }
#undef PG8_SA
#undef PG8_SB
#undef PG8_STAGE
#undef PG8_LDA
#undef PG8_LDB
#undef PG8_MMA
#undef PG8_WAIT_V
#undef PG8_WAIT_L
#undef PG8_BAR
#undef PG8_SCHED
}
}

#define GAS __attribute__((address_space(1)))
#define LAS __attribute__((address_space(3)))
typedef unsigned short bf16;
typedef unsigned v4u __attribute__((ext_vector_type(4)));
typedef float f32x4 __attribute__((ext_vector_type(4)));
typedef short bf16x8 __attribute__((ext_vector_type(8)));
typedef GAS unsigned gu32;
typedef GAS unsigned long long gu64;
#define RLX_AGENT __ATOMIC_RELAXED, __HIP_MEMORY_SCOPE_AGENT
#define LDS_WAIT() asm volatile("s_waitcnt lgkmcnt(0)" ::: "memory")
#define VM_WAIT() asm volatile("s_waitcnt vmcnt(0)" ::: "memory")
__device__ __forceinline__ unsigned long long rt() { return __builtin_amdgcn_s_memrealtime(); }
__device__ __forceinline__ unsigned f2bf(float f) { unsigned u = __builtin_bit_cast(unsigned, f); return (u + 0x7fffu + ((u >> 16) & 1u)) >> 16; }
__device__ __forceinline__ unsigned pk2(float lo, float hi) { return f2bf(lo) | (f2bf(hi) << 16); }

#define XB_TMO      128
#define XB_XCNT(j)  (256  + 64 * (j))
#define XB_XSUB(j)  (1280 + 64 * (j))
#define XB_XGEN(j)  (2304 + 64 * (j))
#define XB_TOP      3328
#define XB_TOPGEN   3392
#define XCD_BAR_WORDS 3456
#define XB_SPIN_CAP (1u << 18)

__device__ __forceinline__ unsigned xb_ld(unsigned* p)              { return __hip_atomic_load(p, __ATOMIC_RELAXED, __HIP_MEMORY_SCOPE_AGENT); }
__device__ __forceinline__ unsigned xb_add(unsigned* p, unsigned v) { return __hip_atomic_fetch_add(p, v, __ATOMIC_RELAXED, __HIP_MEMORY_SCOPE_AGENT); }
__device__ __forceinline__ unsigned xb_xcc_id() { return (unsigned)__builtin_amdgcn_s_getreg((3 << 11) | 20) & 0xFu; }
#define XB_SPIN(cond, bar) do { unsigned _sp = 0; while (cond) { __builtin_amdgcn_s_sleep(1); \
    if ((++_sp & 255u) == 0u) { if (xb_ld(&(bar)[XB_TMO])) break; if (_sp > XB_SPIN_CAP) { atomicAdd(&(bar)[XB_TMO], 1u); break; } } } } while (0)

struct XcdBarrier {
    unsigned* bar; unsigned x;
    volatile LAS unsigned* st;
};

__device__ __forceinline__ XcdBarrier xcd_barrier_post(unsigned* bar, volatile LAS unsigned* st) {
    XcdBarrier b; b.bar = bar; b.x = xb_xcc_id(); b.st = st;
    if (threadIdx.x == 0) (void)xb_add(&bar[XB_XCNT(b.x)], 1u);
    return b;
}
__device__ __forceinline__ void xcd_barrier_complete(unsigned* bar, unsigned x, unsigned& nloc, unsigned& nx) {
    const unsigned G = gridDim.x * gridDim.y * gridDim.z;
    unsigned sum, cnt, mine, sp = 0u;
    for (;;) {
        sum = 0u; cnt = 0u; mine = 0u;
#pragma unroll
        for (unsigned j = 0; j < 16; ++j) { const unsigned c = xb_ld(&bar[XB_XCNT(j)]); sum += c; cnt += (c > 0u) ? 1u : 0u; mine = (j == x) ? c : mine; }
        if (sum == G) break;
        __builtin_amdgcn_s_sleep(1);
        if ((++sp & 255u) == 0u) { if (xb_ld(&bar[XB_TMO])) break; if (sp > XB_SPIN_CAP) { atomicAdd(&bar[XB_TMO], 1u); break; } }
    }
    nloc = mine > 0u ? mine : 1u; nx = cnt > 0u ? cnt : 1u;
}

__device__ __forceinline__ void xcd_barrier(const XcdBarrier& b) {
    asm volatile("s_waitcnt vmcnt(0)" ::: "memory");
    __syncthreads();
    if (threadIdx.x == 0) {
        unsigned* bar = b.bar;
        __builtin_amdgcn_s_waitcnt(0);
        unsigned nloc = b.st[0], nx = b.st[1];
        if (nloc == 0u) { xcd_barrier_complete(bar, b.x, nloc, nx); b.st[0] = nloc; b.st[1] = nx; }
        const unsigned old = xb_add(&bar[XB_XSUB(b.x)], 1u);
        const unsigned gen = old / nloc;
        if (old + 1u == (gen + 1u) * nloc) {
            __builtin_amdgcn_fence(__ATOMIC_RELEASE, "agent");
            asm volatile("s_waitcnt vmcnt(0)" ::: "memory");
            const unsigned og = xb_add(&bar[XB_TOP], 1u);
            const unsigned tg = og / nx;
            if (og + 1u == (tg + 1u) * nx) xb_add(&bar[XB_TOPGEN], 1u);
            else XB_SPIN(xb_ld(&bar[XB_TOPGEN]) == tg, bar);
            __builtin_amdgcn_fence(__ATOMIC_ACQUIRE, "agent");
            xb_add(&bar[XB_XGEN(b.x)], 1u);
            asm volatile("s_waitcnt vmcnt(0)" ::: "memory");
        } else {
            XB_SPIN(xb_ld(&bar[XB_XGEN(b.x)]) == gen, bar);
            __builtin_amdgcn_fence(__ATOMIC_ACQUIRE, "agent");
            asm volatile("s_waitcnt vmcnt(0)" ::: "memory");
        }
    }
    __syncthreads();
}

constexpr int NWAVES = 8;
constexpr int D = 1024, FF = 2816;
constexpr int PB = 8, PT = 2048, SB = 128, STK = 4;
constexpr int MP = PB * PT, MS = SB * STK, M = MP + MS;
constexpr int NRW = 3584, KRW = 2048  , NRW2 = 3840  , NL2 = 3072, KL2 = 384, NIN = 3328;
constexpr float NORM_EPS = 1e-6f, GN_EPS = 64e-5f;
typedef pg8::bf16_t bf16;

constexpr size_t MiB = 1u << 20;
constexpr size_t WS_CTL = 0, CTL_ZERO_BYTES = 64 * 1024;
constexpr size_t WS_W = 1 * MiB;
constexpr size_t WS_XR = 20 * MiB;
constexpr size_t WS_BIG = 86 * MiB;
constexpr size_t WS_END = 256 * MiB;
constexpr size_t WS_YRAW = 256 * MiB, WS_BON = 288 * MiB, WS_W2 = 289 * MiB  , WS_END2 = 308 * MiB, WS_XM = 308 * MiB  , WS_END3 = 506 * MiB;
constexpr size_t W_GU = 0, W_D = (size_t)2 * FF * D * 2;
constexpr size_t W_RW = 0, W_L2 = (size_t)NRW * KRW * 2, W_O = W_L2 + (size_t)NL2 * KL2 * 2;
constexpr size_t W_IN = 0, W_OUT = (size_t)NIN * D * 2;
static_assert(W_D + (size_t)D * FF * 2 <= 19 * MiB && W_O + (size_t)D * D * 2 <= 19 * MiB && W_OUT + (size_t)D * D * 2 <= 19 * MiB, "weights region");
constexpr size_t B_H = 0, B_XN = 91 * MiB, B_SLAB = 124 * MiB;
constexpr size_t B_ACAT = 0, B_R = 66 * MiB, B_K = 99 * MiB, B_V = 132 * MiB, B_DEC = 0, B_AA = 33 * MiB;
constexpr size_t B_QKR = 0, B_VV = 33 * MiB, B_HO = 66 * MiB, B_OO = 124 * MiB, B_IF = 157 * MiB;
static_assert((size_t)M * FF * 2 <= 91 * MiB && (size_t)M * D * 2 == 33 * MiB && B_IF + (size_t)M * 16 * 4 <= 170 * MiB && B_SLAB + (size_t)11 * MS * D * 4 <= 170 * MiB, "BIG map");
constexpr size_t OS_GG = 0, OS_LORA = 33 * MiB;
static_assert(OS_LORA + (size_t)M * KL2 * 2 <= (size_t)MP * D * 4, "d_out scratch");
constexpr size_t O_Y = 0, O_P_S = 17301504, O_P_SHIFT = 17825792, O_P_C = 17833984, O_P_N = 18358272, O_P_M = 18362368, O_P_CONV = 18362432,
                 O_S_S = 18387008, O_S_SHIFT = 26775616, O_S_C = 26906688, O_S_N = 35295296, O_S_M = 35360832, O_S_CONV = 35361856, O_END = 35755072;
constexpr int CW_BAR = 1024;

constexpr int RING_BYTES = 131072, LDSCTL_OFF = RING_BYTES, MISC_OFF = LDSCTL_OFF + 320, TAB_OFF = LDSCTL_OFF + 1024, LDS_BYTES = 147456;

enum { I_XP = 0, I_XS, I_RS, I_RSHIFT, I_MC, I_MN, I_MM, I_MCONV, I_NFA, I_FAWG, I_FAWU, I_FAWD, I_NMIX, I_NFB, I_FBWG, I_FBWU, I_FBWD,
       I_MU, I_WR, I_WK, I_WV, I_WO, I_W0, I_W1, I_W2, I_A0, I_A1, I_A2, I_G1, I_G2, I_KK, I_KA, I_RK, I_GNW, I_GNB,
       I_WIN, I_BIF, I_CW, I_CB, I_MNW, I_WOUT, I_NFIN, N_IN };

typedef __bf16 bf16x2_t __attribute__((ext_vector_type(2)));
typedef float f32x2_t __attribute__((ext_vector_type(2)));
__device__ __forceinline__ unsigned pkbf(float lo, float hi) { f32x2_t v = {lo, hi}; bf16x2_t b = __builtin_convertvector(v, bf16x2_t); return __builtin_bit_cast(unsigned, b); }
__device__ __forceinline__ float bflo(unsigned u) { return __builtin_bit_cast(float, u << 16); }
__device__ __forceinline__ float bfhi(unsigned u) { return __builtin_bit_cast(float, u & 0xffff0000u); }
__device__ __forceinline__ float bf1(unsigned short u) { return __builtin_bit_cast(float, (unsigned)u << 16); }
__device__ __forceinline__ unsigned short f2bf1(float f) { return (unsigned short)(pkbf(f, 0.f) & 0xffffu); }
__device__ __forceinline__ void unpack8(v4u w, float (&o)[8]) { o[0] = bflo(w.x); o[1] = bfhi(w.x); o[2] = bflo(w.y); o[3] = bfhi(w.y); o[4] = bflo(w.z); o[5] = bfhi(w.z); o[6] = bflo(w.w); o[7] = bfhi(w.w); }
__device__ __forceinline__ v4u pack8(const float (&o)[8]) { v4u w; w.x = pkbf(o[0], o[1]); w.y = pkbf(o[2], o[3]); w.z = pkbf(o[4], o[5]); w.w = pkbf(o[6], o[7]); return w; }
__device__ __forceinline__ float sigmoidf_(float x) { return __builtin_amdgcn_rcpf(1.f + __expf(-x)); }
__device__ __forceinline__ float siluf_(float x) { return x * __builtin_amdgcn_rcpf(1.f + __expf(-x)); }
__device__ __forceinline__ float tanhf_(float x) { return 1.f - 2.f * __builtin_amdgcn_rcpf(__expf(2.f * x) + 1.f); }
__device__ __forceinline__ float logsigmoidf_(float x) { return fminf(x, 0.f) - __logf(1.f + __expf(-fabsf(x))); }
template <int CTRL> __device__ __forceinline__ float dppf(float x) { return __builtin_bit_cast(float, __builtin_amdgcn_update_dpp(0, __builtin_bit_cast(int, x), CTRL, 0xF, 0xF, true)); }
__device__ __forceinline__ float red4(float x) { x += dppf<0xB1>(x); x += dppf<0x4E>(x); return x; }
__device__ __forceinline__ float red8(float x) { x = red4(x); x += dppf<0x141>(x); return x; }
__device__ __forceinline__ float red16(float x) { x = red8(x); x += dppf<0x140>(x); return x; }
__device__ __forceinline__ float wave_sum(float v) {
#pragma unroll
    for (int o = 1; o < 64; o <<= 1) v += __shfl_xor(v, o);
    return v;
}

struct Frame {
    LAS unsigned char* lds;
    volatile LAS unsigned* MISC;
    gu32* ctl;
    volatile LAS unsigned long long* tab;
    int tid, lane, wave, vcu, G;
};
__device__ __forceinline__ const float* inptr(const Frame& F, int i) { const unsigned long long v = F.tab[i];
    const unsigned lo = __builtin_amdgcn_readfirstlane((unsigned)v), hi = __builtin_amdgcn_readfirstlane((unsigned)(v >> 32)); return (const float*)(const GAS float*)(((unsigned long long)hi << 32) | lo); }

using pg8::Unit; using pg8::BM; using pg8::HALF;
__device__ __forceinline__ void st8bf(bf16* p, f32x4 v0, f32x4 v1) { v4u w; w.x = pkbf(v0[0], v0[1]); w.y = pkbf(v0[2], v0[3]); w.z = pkbf(v1[0], v1[1]); w.w = pkbf(v1[2], v1[3]); *(v4u*)p = w; }

struct EpiSwiglu {
    static constexpr bool PERM = true, AFTER_DRAIN = false;
    bf16* H; int pvar;
    __device__ __forceinline__ void operator()(const f32x4 (&acc)[2][2][4][2], const Unit& u, int wr, int wc, int fr, int fq) const {
        if (pvar == 3) return;
        const int row0 = u.pm * BM + wr * 64 + fr, col0 = u.pn * 128 + wc * 32 + 8 * fq;
#pragma unroll
        for (int ai = 0; ai < 2; ++ai)
#pragma unroll
            for (int m = 0; m < 4; ++m) {
                f32x4 o[2];
#pragma unroll
                for (int n = 0; n < 2; ++n)
#pragma unroll
                    for (int i = 0; i < 4; ++i) { const float g = acc[ai][0][m][n][i], up = acc[ai][1][m][n][i]; o[n][i] = siluf_(g) * up; }
                st8bf(H + (size_t)(row0 + ai * HALF + m * 16) * FF + col0, o[0], o[1]);
            }
    }
};
__device__ __forceinline__ void ld8bf(const bf16* p, f32x4& a, f32x4& b) { const v4u w = *(const v4u*)p; a = (f32x4){bflo(w.x), bfhi(w.x), bflo(w.y), bfhi(w.y)}; b = (f32x4){bflo(w.z), bfhi(w.z), bflo(w.w), bfhi(w.w)}; }
struct EpiRes {
    static constexpr bool PERM = true, AFTER_DRAIN = false;
    const float* basef; const bf16* baseb; bf16* out; float* slab; float coef;
    __device__ __forceinline__ void operator()(const f32x4 (&acc)[2][2][4][2], const Unit& u, int wr, int wc, int fr, int fq) const {
        const int row0 = u.pm * BM + wr * 64 + fr, col0 = u.pn * BM + wc * 32 + 8 * fq;
        if (u.slab < 0) {
            if (basef) {
#pragma unroll
                for (int ai = 0; ai < 2; ++ai)
#pragma unroll
                    for (int m = 0; m < 4; ++m) { const size_t ro = (size_t)(row0 + ai * HALF + m * 16) * D + col0;
#pragma unroll
                        for (int bj = 0; bj < 2; ++bj) { const f32x4 b0 = *(const f32x4*)(basef + ro + bj * HALF), b1 = *(const f32x4*)(basef + ro + bj * HALF + 4);
                            st8bf(out + ro + bj * HALF, b0 + acc[ai][bj][m][0] * coef, b1 + acc[ai][bj][m][1] * coef); } }
            } else {
#pragma unroll
                for (int ai = 0; ai < 2; ++ai)
#pragma unroll
                    for (int m = 0; m < 4; ++m) { const size_t ro = (size_t)(row0 + ai * HALF + m * 16) * D + col0;
#pragma unroll
                        for (int bj = 0; bj < 2; ++bj) { f32x4 b0, b1; ld8bf(baseb + ro + bj * HALF, b0, b1);
                            st8bf(out + ro + bj * HALF, b0 + acc[ai][bj][m][0] * coef, b1 + acc[ai][bj][m][1] * coef); } }
            }
        } else {
            float* sl = slab + (size_t)u.slab * MS * D;
#pragma unroll
            for (int ai = 0; ai < 2; ++ai)
#pragma unroll
                for (int m = 0; m < 4; ++m) { const size_t ro = (size_t)(row0 + ai * HALF + m * 16 - MP) * D + col0;
#pragma unroll
                    for (int bj = 0; bj < 2; ++bj) { *(f32x4*)(sl + ro + bj * HALF) = acc[ai][bj][m][0]; *(f32x4*)(sl + ro + bj * HALF + 4) = acc[ai][bj][m][1]; } }
        }
    }
};
struct EpiRw {
    static constexpr bool PERM = true, AFTER_DRAIN = false;
    bf16 *R, *K, *V, *L;
    __device__ __forceinline__ void operator()(const f32x4 (&acc)[2][2][4][2], const Unit& u, int wr, int wc, int fr, int fq) const {
        const int mix = u.pn < 12 ? (u.pn >> 2) : u.pn - 9, row0 = (u.pm - (M / 256) * mix) * BM + wr * 64 + fr;
        if (u.pn < 12) {
            bf16 *p0 = R, *p1 = K, *p2 = V; asm volatile("" : "+s"(p0), "+s"(p1), "+s"(p2));
            bf16* dst = u.pn < 4 ? p0 : (u.pn < 8 ? p1 : p2); const int col0 = (u.pn & 3) * BM + wc * 32 + 8 * fq;
#pragma unroll
            for (int ai = 0; ai < 2; ++ai)
#pragma unroll
                for (int m = 0; m < 4; ++m) { bf16* rp = dst + (size_t)(row0 + ai * HALF + m * 16) * D + col0;
#pragma unroll
                    for (int bj = 0; bj < 2; ++bj) st8bf(rp + bj * HALF, acc[ai][bj][m][0], acc[ai][bj][m][1]); }
        } else {
            const int t = u.pn - 12;
#pragma unroll
            for (int bj = 0; bj < 2; ++bj) {
                const int cl = bj * HALF + wc * 32 + 8 * fq;
                if (t < 2 && cl >= 64) continue;
                const int lc = t == 0 ? cl : (t == 1 ? 64 + cl : 128 + cl);
                const int act = t == 0 ? 1 : (t == 1 ? 0 : (cl < 160 ? 2 : 3));
#pragma unroll
                for (int ai = 0; ai < 2; ++ai)
#pragma unroll
                    for (int m = 0; m < 4; ++m) {
                        f32x4 o[2];
#pragma unroll
                        for (int n = 0; n < 2; ++n)
#pragma unroll
                            for (int i = 0; i < 4; ++i) { const float x = acc[ai][bj][m][n][i]; o[n][i] = act == 1 ? tanhf_(x) : (act == 0 ? x : (act == 2 ? sigmoidf_(x) : 0.f)); }
                        st8bf(L + (size_t)(row0 + ai * HALF + m * 16) * KL2 + lc, o[0], o[1]);
                    }
            }
        }
    }
};
struct EpiL2 {
    static constexpr bool PERM = true, AFTER_DRAIN = false;
    bf16 *DEC, *AA, *GG; const float *w0, *a0;
    __device__ __forceinline__ void operator()(const f32x4 (&acc)[2][2][4][2], const Unit& u, int wr, int wc, int fr, int fq) const {
        const int row0 = u.pm * BM + wr * 64 + fr, kind = u.pn >> 2, col0 = (u.pn & 3) * BM + wc * 32 + 8 * fq;
        bf16 *p0 = DEC, *p1 = AA, *p2 = GG; const float *q0 = w0, *q1 = a0; asm volatile("" : "+s"(p0), "+s"(p1), "+s"(p2), "+s"(q0), "+s"(q1));
        bf16* dst = kind == 0 ? p0 : (kind == 1 ? p1 : p2); const float* bias = kind == 0 ? q0 : q1;
#pragma unroll
        for (int bj = 0; bj < 2; ++bj) {
            f32x4 bv[2];
#pragma unroll
            for (int n = 0; n < 2; ++n) bv[n] = kind < 2 ? *(const f32x4*)(bias + col0 + bj * HALF + 4 * n) : (f32x4){0.f, 0.f, 0.f, 0.f};
#pragma unroll
            for (int ai = 0; ai < 2; ++ai)
#pragma unroll
                for (int m = 0; m < 4; ++m) {
                    f32x4 o[2];
#pragma unroll
                    for (int n = 0; n < 2; ++n)
#pragma unroll
                        for (int i = 0; i < 4; ++i) { const float z = acc[ai][bj][m][n][i] + bv[n][i];
                            o[n][i] = kind == 0 ? (1.f - __expf(-0.60653065971f * sigmoidf_(z))) : (kind == 1 ? sigmoidf_(z) : z); }
                    st8bf(dst + (size_t)(row0 + ai * HALF + m * 16) * D + col0 + bj * HALF, o[0], o[1]);
                }
        }
    }
};
struct EpiIn {
    static constexpr bool PERM = true, AFTER_DRAIN = false;
    bf16 *QKR, *VV, *OO; float* IF; const float* bif; int pvar;
    __device__ __forceinline__ void operator()(const f32x4 (&acc)[2][2][4][2], const Unit& u, int wr, int wc, int fr, int fq) const {
        if (pvar == 3) return;
        const int row0 = u.pm * BM + wr * 64 + fr;
        if (u.pn < 12) {
            bf16 *p0 = QKR, *p1 = VV, *p2 = OO; asm volatile("" : "+s"(p0), "+s"(p1), "+s"(p2));
            const int kind = u.pn >> 2; bf16* dst = kind == 0 ? p0 : (kind == 1 ? p1 : p2); const int col0 = (u.pn & 3) * BM + wc * 32 + 8 * fq;
#pragma unroll
            for (int ai = 0; ai < 2; ++ai)
#pragma unroll
                for (int m = 0; m < 4; ++m) { bf16* rp = dst + (size_t)(row0 + ai * HALF + m * 16) * D + col0;
#pragma unroll
                    for (int bj = 0; bj < 2; ++bj) { f32x4 a = acc[ai][bj][m][0], b = acc[ai][bj][m][1];
                        if (kind == 2) {
#pragma unroll
                            for (int i = 0; i < 4; ++i) { a[i] = sigmoidf_(a[i]); b[i] = sigmoidf_(b[i]); } }
                        st8bf(rp + bj * HALF, a, b); } }
        } else if (u.pn == 12 && wc == 0 && fq < 2) {
            const f32x4 b0 = *(const f32x4*)(bif + 8 * fq), b1 = *(const f32x4*)(bif + 8 * fq + 4);
#pragma unroll
            for (int ai = 0; ai < 2; ++ai)
#pragma unroll
                for (int m = 0; m < 4; ++m) { f32x4 a = acc[ai][0][m][0] + b0, b = acc[ai][0][m][1] + b1;
                    if (fq == 1) {
#pragma unroll
                        for (int i = 0; i < 4; ++i) { a[i] = logsigmoidf_(a[i]); b[i] = logsigmoidf_(b[i]); } }
                    float* rp = IF + (size_t)(row0 + ai * HALF + m * 16) * 16 + 8 * fq; *(f32x4*)rp = a; *(f32x4*)(rp + 4) = b; }
        }
    }
};

struct CJ { const float* W; const float* sc; bf16* WT; int K, N, Npad, ldk, koff, rmode, roff, smode; };
__device__ __forceinline__ int cj_items(const CJ& j) { return (j.K / 32) * (j.Npad / 32); }
__device__ __forceinline__ void conv_load(const CJ& J, int item, int lane, f32x4 (&w)[4], float (&sc)[4]) {
    const int nblk = J.Npad / 32, kb = item / nblk, nb = item % nblk, k0 = 32 * kb, n0 = 32 * nb;
    const int r = lane >> 3, c4 = 4 * (lane & 7); const bool nok = n0 + c4 < J.N;
#pragma unroll
    for (int i = 0; i < 4; ++i) { const int kk = k0 + r + 8 * i;
        w[i] = nok ? *(const f32x4*)(J.W + (size_t)kk * J.N + n0 + c4) : (f32x4){0.f, 0.f, 0.f, 0.f};
        float s = 1.f; if (J.smode) { s = J.sc[kk]; if (J.smode == 2) s = 1.f - s; }
        sc[i] = s; }
}
__device__ __forceinline__ void conv_store(const CJ& J, LAS float* scr, int item, int lane, const f32x4 (&w)[4], const float (&sc)[4]) {
    const int nblk = J.Npad / 32, kb = item / nblk, nb = item % nblk, k0 = 32 * kb, n0 = 32 * nb;
    const int r = lane >> 3, c4 = 4 * (lane & 7);
#pragma unroll
    for (int i = 0; i < 4; ++i) { const f32x4 f = w[i] * sc[i]; LAS float* d = scr + (r + 8 * i) * 33 + c4; d[0] = f[0]; d[1] = f[1]; d[2] = f[2]; d[3] = f[3]; }
    LDS_WAIT(); asm volatile("" ::: "memory");
    const int rowbase = J.rmode == 0 ? J.roff + n0 : (n0 >> 7) * 256 + (n0 & 127) + J.roff;
    const int c = lane & 3;
#pragma unroll
    for (int j = 0; j < 2; ++j) { const int n = (lane >> 2) + 16 * j; const LAS float* s = scr + (8 * c) * 33 + n;
        v4u o; o.x = pkbf(s[0 * 33], s[1 * 33]); o.y = pkbf(s[2 * 33], s[3 * 33]); o.z = pkbf(s[4 * 33], s[5 * 33]); o.w = pkbf(s[6 * 33], s[7 * 33]);
        *(GAS v4u*)(J.WT + (size_t)(rowbase + n) * J.ldk + J.koff + k0 + 8 * c) = o; }
    LDS_WAIT(); asm volatile("" ::: "memory");
}
__device__ __forceinline__ CJ get_job(const Frame& F, int kind, int j, int layer, int ab, bf16* Wb) {
    CJ J; J.sc = nullptr; J.smode = 0; J.koff = 0; J.rmode = 0; J.roff = 0;
    if (kind == 0) {
        const float* wg = inptr(F, ab ? I_FBWG : I_FAWG) + (size_t)layer * D * FF; const float* wu = inptr(F, ab ? I_FBWU : I_FAWU) + (size_t)layer * D * FF; const float* wd = inptr(F, ab ? I_FBWD : I_FAWD) + (size_t)layer * D * FF;
        if (j < 2) { J.W = j == 0 ? wg : wu; J.K = D; J.N = FF; J.Npad = FF; J.WT = Wb + W_GU / 2; J.ldk = D; J.rmode = 1; J.roff = j == 0 ? 0 : 128; }
        else { J.W = wd; J.K = FF; J.N = D; J.Npad = D; J.WT = Wb + W_D / 2; J.ldk = FF; }
    } else if (kind == 1) {
        if (j < 6) {
            const int s = j;
            J.W = inptr(F, s == 0 ? I_WR : (s == 1 ? I_WK : (s == 2 ? I_WV : (s == 3 ? I_W1 : (s == 4 ? I_A1 : I_G1)))));
            J.N = s < 3 ? 1024 : (s < 5 ? 64 : 160); J.Npad = s < 3 ? 1024 : 256;
            J.roff = s < 3 ? 1024 * s : 3072 + 256 * (s - 3);
            J.K = D; J.ldk = D; J.WT = Wb + W_RW / 2;
        } else { J.W = inptr(F, I_WO); J.K = D; J.N = D; J.Npad = D; J.WT = Wb + W_O / 2; J.ldk = D; }
    } else {
        if (j == 0) { J.W = inptr(F, I_WIN); J.K = D; J.N = 3088; J.Npad = NIN; J.WT = Wb + W_IN / 2; J.ldk = D; }
        else { J.W = inptr(F, I_WOUT); J.K = D; J.N = D; J.Npad = D; J.WT = Wb + W_OUT / 2; J.ldk = D; }
    }
    return J;
}
__device__ __forceinline__ void convert_weights(const Frame& F, int kind, int layer, int ab, bf16* Wb, const int cu0 = 0) {
    LAS float* scr = (LAS float*)(F.lds + F.wave * 16384);
    const int gw = (F.vcu - cu0) * NWAVES + F.wave, NGW = (F.G - cu0) * NWAVES;
    const int njobs = kind == 0 ? 3 : (kind == 1 ? 7 : 2);
    int total = 0;
    for (int j = 0; j < njobs; ++j) { const CJ J = get_job(F, kind, j, layer, ab, Wb); total += cj_items(J); }
    if (gw < total) {
        int r = gw, j = 0; CJ J = get_job(F, kind, 0, layer, ab, Wb);
        while (r >= cj_items(J)) { r -= cj_items(J); ++j; J = get_job(F, kind, j, layer, ab, Wb); }
        f32x4 w[4]; float sc[4];
        conv_load(J, r, F.lane, w, sc);
        for (int g = gw; g < total;) {
            const int gn = g + NGW; int rn = 0; CJ Jn = J; f32x4 wn[4]; float sn[4];
#pragma unroll
            for (int i = 0; i < 4; ++i) { wn[i] = (f32x4){0.f, 0.f, 0.f, 0.f}; sn[i] = 0.f; }
            if (gn < total) {
                rn = gn; int jn = 0; Jn = get_job(F, kind, 0, layer, ab, Wb);
                while (rn >= cj_items(Jn)) { rn -= cj_items(Jn); ++jn; Jn = get_job(F, kind, jn, layer, ab, Wb); }
                conv_load(Jn, rn, F.lane, wn, sn);
            }
            conv_store(J, scr, r, F.lane, w, sc);
            J = Jn; r = rn; g = gn;
#pragma unroll
            for (int i = 0; i < 4; ++i) { w[i] = wn[i]; sc[i] = sn[i]; }
        }
    }
    if (kind == 1) {
        bf16* WT = Wb + W_L2 / 2; const float* w2 = inptr(F, I_W2); const float* a2 = inptr(F, I_A2); const float* g2 = inptr(F, I_G2);
        for (int idx = (F.vcu * NWAVES + F.wave) * 64 + F.lane; idx < 48 * NL2; idx += F.G * NWAVES * 64) {
            const int c = idx / NL2, n = idx % NL2, type = n >> 10, jj = n & 1023;
            const float* src = nullptr;
            if (type == 0 && c < 8) src = w2 + (size_t)(8 * c) * D + jj;
            else if (type == 1 && c >= 8 && c < 16) src = a2 + (size_t)(8 * (c - 8)) * D + jj;
            else if (type == 2 && c >= 16 && c < 36) src = g2 + (size_t)(8 * (c - 16)) * D + jj;
            float v[8];
#pragma unroll
            for (int e = 0; e < 8; ++e) v[e] = src ? src[(size_t)e * D] : 0.f;
            *(GAS v4u*)(WT + (size_t)n * KL2 + 8 * c) = pack8(v);
        }
    }
}

template <int MODE>
__device__ __forceinline__ void norm_finish(const int m, f32x4 (&v)[4], const f32x4 (&gv)[4], bf16* dst, const float* shift_in, float* out, const int lane) {
    const bool samp = m >= MP;
    float ss = 0.f;
#pragma unroll
    for (int j = 0; j < 4; ++j) ss += (v[j].x * v[j].x + v[j].y * v[j].y) + (v[j].z * v[j].z + v[j].w * v[j].w);
    const float r = 1.0f / sqrtf(wave_sum(ss) * (1.f / D) + NORM_EPS);
#pragma unroll
    for (int j = 0; j < 4; ++j) v[j] = v[j] * r * gv[j];
    if (MODE == 2) {
#pragma unroll
        for (int j = 0; j < 4; ++j) *(f32x4*)(out + O_Y + (size_t)m * D + 512 * (j >> 1) + 8 * lane + 4 * (j & 1)) = v[j];
    } else if (MODE == 0) {
#pragma unroll
        for (int j = 0; j < 2; ++j) st8bf(dst + (size_t)m * D + 512 * j + 8 * lane, v[2 * j], v[2 * j + 1]);
    } else {
        int t, b; bool first, last;
        if (!samp) { t = m & (PT - 1); b = m >> 11; first = t == 0; last = t == PT - 1; } else { const int mm = m - MP; t = mm & 3; b = mm >> 2; first = t == 0; last = t == 3; }
#pragma unroll
        for (int j = 0; j < 2; ++j) { const int eo = 512 * j + 8 * lane;
            st8bf(dst + (size_t)m * (2 * D) + eo, v[2 * j], v[2 * j + 1]);
            if (!last) st8bf(dst + (size_t)(m + 1) * (2 * D) + D + eo, v[2 * j], v[2 * j + 1]);
            else { float* so = out + (samp ? O_S_SHIFT : O_P_SHIFT) + (size_t)b * D + eo; *(f32x4*)so = v[2 * j]; *(f32x4*)(so + 4) = v[2 * j + 1]; }
            if (first) { f32x4 s0 = {0.f, 0.f, 0.f, 0.f}, s1 = s0;
                if (samp) { s0 = *(const f32x4*)(shift_in + (size_t)b * D + eo); s1 = *(const f32x4*)(shift_in + (size_t)b * D + eo + 4); }
                st8bf(dst + (size_t)m * (2 * D) + D + eo, s0, s1); }
        }
    }
}
template <bool F32>
__device__ __forceinline__ void row_load(const void* src, const size_t row, const int lane, f32x4 (&v)[4]) {
    if (F32) { const float* p = (const float*)src + row * D;
#pragma unroll
        for (int j = 0; j < 4; ++j) v[j] = *(const f32x4*)(p + 512 * (j >> 1) + 8 * lane + 4 * (j & 1));
    } else { const bf16* p = (const bf16*)src + row * D;
#pragma unroll
        for (int j = 0; j < 2; ++j) ld8bf(p + 512 * j + 8 * lane, v[2 * j], v[2 * j + 1]); }
}
template <int NS>
__device__ __forceinline__ void samp_row_fold(const float* slab, const int ms, const float coef, const int lane, f32x4 (&v)[4]) {
#pragma unroll
    for (int h = 0; h < 2; ++h) {
        f32x4 t[NS > 0 ? NS : 1][2];
#pragma unroll
        for (int s = 0; s < NS; ++s)
#pragma unroll
            for (int jj = 0; jj < 2; ++jj) t[s][jj] = *(const f32x4*)(slab + ((size_t)s * MS + ms) * D + 512 * h + 8 * lane + 4 * jj);
#pragma unroll
        for (int jj = 0; jj < 2; ++jj)
#pragma unroll
            for (int s = 0; s < NS; ++s) v[2 * h + jj] += t[s][jj] * coef;
    }
}
template <int MODE, bool PF32, bool SF32>
__device__ __forceinline__ void norm_rows(const Frame& F, const void* base_p, const void* base_s, int nslab, float coef, const float* slab, bf16* xr,
                                          const float* gain, bf16* dst, const float* shift_in, float* out, const int pvar = 0) {
    const int gw = F.vcu * NWAVES + F.wave, NGW = F.G * NWAVES, lane = F.lane;
    f32x4 gv[4];
#pragma unroll
    for (int j = 0; j < 4; ++j) gv[j] = *(const f32x4*)(gain + 512 * (j >> 1) + 8 * lane + 4 * (j & 1));
    for (int s = F.wave * F.G + F.vcu; s < MS; s += NWAVES * F.G) {
        const int m = MP + s; f32x4 v[4];
        row_load<SF32>(base_s, (size_t)s, lane, v);
        if (nslab == 11) samp_row_fold<11>(slab, s, coef, lane, v); else if (nslab == 4) samp_row_fold<4>(slab, s, coef, lane, v);
        if (nslab > 0 && MODE != 2 && pvar == 0) {
#pragma unroll
            for (int j = 0; j < 2; ++j) st8bf(xr + (size_t)m * D + 512 * j + 8 * lane, v[2 * j], v[2 * j + 1]); }
        norm_finish<MODE>(m, v, gv, dst, shift_in, out, lane);
    }
    int m = gw; f32x4 v[4];
    if (m < MP) row_load<PF32>(base_p, (size_t)m, lane, v);
    while (m < MP) {
        const int mn = m + NGW; f32x4 vn[4];
#pragma unroll
        for (int j = 0; j < 4; ++j) vn[j] = (f32x4){0.f, 0.f, 0.f, 0.f};
        if (mn < MP) row_load<PF32>(base_p, (size_t)mn, lane, vn);
        norm_finish<MODE>(m, v, gv, dst, shift_in, out, lane);
#pragma unroll
        for (int j = 0; j < 4; ++j) v[j] = vn[j];
        m = mn;
    }
}

__device__ __forceinline__ void mix_rows(const Frame& F, const bf16* xr_p, const float* xs_in, int nslab, float coef, const float* slab, bf16* xr, const float* gain, const float* mu, bf16* XM,
                                         const float* shift_in, float* out, const int pvar) {
    const int gw = F.vcu * NWAVES + F.wave, NGW = F.G * NWAVES, lane = F.lane;
    f32x4 gv[4];
#pragma unroll
    for (int j = 0; j < 4; ++j) gv[j] = *(const f32x4*)(gain + 512 * (j >> 1) + 8 * lane + 4 * (j & 1));
    __syncthreads();
    for (int i = F.tid; i < 6 * D / 8; i += NWAVES * 64) { const int s = i >> 7, e8 = i & 127; const float* mup = mu + ((0x541320 >> (4 * s)) & 15) * D + 8 * e8;
        const f32x4 ma = *(const f32x4*)mup, mb = *(const f32x4*)(mup + 4); v4u w; w.x = pkbf(ma[0], ma[1]); w.y = pkbf(ma[2], ma[3]); w.z = pkbf(mb[0], mb[1]); w.w = pkbf(mb[2], mb[3]);
        *(LAS v4u*)(F.lds + (s * D + 8 * e8) * 2) = w; }
    __syncthreads();
#define MIX_NORM(v) do { float ss_ = 0.f; \
        _Pragma("unroll") for (int j = 0; j < 4; ++j) ss_ += (v[j].x * v[j].x + v[j].y * v[j].y) + (v[j].z * v[j].z + v[j].w * v[j].w); \
        const float r_ = 1.0f / sqrtf(wave_sum(ss_) * (1.f / D) + NORM_EPS); \
        _Pragma("unroll") for (int j = 0; j < 4; ++j) v[j] = v[j] * r_ * gv[j]; } while (0)
#define MIX_EMIT(m, xn, pv) do { f32x4 df_[4]; int lo_ = 16 * lane; asm volatile("" : "+v"(lo_));     \
        _Pragma("unroll") for (int j = 0; j < 4; ++j) df_[j] = pv[j] - xn[j]; \
        _Pragma("unroll") for (int s = 0; s < 6; ++s) \
        _Pragma("unroll") for (int j = 0; j < 2; ++j) { const v4u mw = *(const LAS v4u*)(F.lds + (s * D + 512 * j) * 2 + lo_); const f32x4 ma = {bflo(mw.x), bfhi(mw.x), bflo(mw.y), bfhi(mw.y)}, mb = {bflo(mw.z), bfhi(mw.z), bflo(mw.w), bfhi(mw.w)}; \
            st8bf(XM + ((size_t)s * M + (m)) * D + 512 * j + 8 * lane, xn[2 * j] + ma * df_[2 * j], xn[2 * j + 1] + mb * df_[2 * j + 1]); } } while (0)
    for (int sq = F.wave * F.G + F.vcu; sq < SB; sq += NWAVES * F.G) {
        f32x4 pv[4];
#pragma unroll
        for (int j = 0; j < 4; ++j) pv[j] = *(const f32x4*)(shift_in + (size_t)sq * D + 512 * (j >> 1) + 8 * lane + 4 * (j & 1));
        for (int t = 0; t < STK; ++t) { const int srow = STK * sq + t, m = MP + srow; f32x4 v[4];
            row_load<true>(xs_in, (size_t)srow, lane, v);
            if (nslab == 11) samp_row_fold<11>(slab, srow, coef, lane, v); else if (nslab == 4) samp_row_fold<4>(slab, srow, coef, lane, v);
            if (nslab > 0 && pvar == 0) {
#pragma unroll
                for (int j = 0; j < 2; ++j) st8bf(xr + (size_t)m * D + 512 * j + 8 * lane, v[2 * j], v[2 * j + 1]); }
            MIX_NORM(v);
            MIX_EMIT(m, v, pv);
#pragma unroll
            for (int j = 0; j < 4; ++j) pv[j] = v[j];
        }
#pragma unroll
        for (int j = 0; j < 4; ++j) *(f32x4*)(out + O_S_SHIFT + (size_t)sq * D + 512 * (j >> 1) + 8 * lane + 4 * (j & 1)) = pv[j];
    }
    for (int blk = gw; blk < MP / 8; blk += NGW) {
        const int m0 = 8 * blk; f32x4 pv[4], v[4];
        row_load<false>(xr_p, (size_t)m0, lane, v);
        if ((m0 & (PT - 1)) == 0) {
#pragma unroll
            for (int j = 0; j < 4; ++j) pv[j] = (f32x4){0.f, 0.f, 0.f, 0.f};
        } else { row_load<false>(xr_p, (size_t)(m0 - 1), lane, pv); MIX_NORM(pv); }
        for (int i = 0; i < 8; ++i) { const int m = m0 + i; f32x4 vn[4];
#pragma unroll
            for (int j = 0; j < 4; ++j) vn[j] = (f32x4){0.f, 0.f, 0.f, 0.f};
            if (i < 7) row_load<false>(xr_p, (size_t)(m + 1), lane, vn);
            MIX_NORM(v);
            MIX_EMIT(m, v, pv);
            if ((m & (PT - 1)) == PT - 1) {
#pragma unroll
                for (int j = 0; j < 4; ++j) *(f32x4*)(out + O_P_SHIFT + (size_t)(m >> 11) * D + 512 * (j >> 1) + 8 * lane + 4 * (j & 1)) = v[j]; }
#pragma unroll
            for (int j = 0; j < 4; ++j) { pv[j] = v[j]; v[j] = vn[j]; }
        }
    }
#undef MIX_NORM
#undef MIX_EMIT
}

constexpr int RW_KK = 0, RW_DD = 4096, RW_BB = 8192, RW_KP = 12288, RW_RR = 16384, RW_VV = 20480, RW_YY = 24576;
__device__ __forceinline__ void rwkv_chain(const Frame& F, int row0, int T, int h, const float* S0, float* ST,
                                           const bf16* Rb, const bf16* Kb, const bf16* Vb, const bf16* Db, const bf16* Ab, bf16* Gb,
                                           const float* k_k, const float* k_a, const float* r_k, const float* gn_w, const float* gn_b, const bool do_store, const int pvar) {
    LAS float* L = (LAS float*)F.lds;
    const int tid = F.tid, lane = F.lane, w = F.wave;
    const int cg = tid & 7, tt = tid >> 3;
    const int srow = 8 * w + (lane >> 3);
    float S[8];
    if (S0) { const f32x4 a = *(const f32x4*)(S0 + srow * 64 + 8 * cg), b = *(const f32x4*)(S0 + srow * 64 + 8 * cg + 4);
        S[0] = a.x; S[1] = a.y; S[2] = a.z; S[3] = a.w; S[4] = b.x; S[5] = b.y; S[6] = b.z; S[7] = b.w; }
    else {
#pragma unroll
        for (int j = 0; j < 8; ++j) S[j] = 0.f; }
    const int ch = h * 64 + 8 * cg;
    float ckk[8], cka[8], crk[8], cgw[8], cgb[8];
#pragma unroll
    for (int j = 0; j < 8; ++j) { ckk[j] = k_k[ch + j]; cka[j] = k_a[ch + j]; crk[j] = r_k[ch + j]; cgw[j] = gn_w[ch + j]; cgb[j] = gn_b[ch + j]; }
    const int nch = (T + 63) >> 6;
    v4u pr = {0, 0, 0, 0}, pk = pr, pv = pr, pd = pr, pa = pr, pg = pr;
    { const int nt0 = T < 64 ? T : 64;
      if (tt < nt0) { const size_t off = (size_t)(row0 + tt) * D + ch;
          pr = *(const v4u*)(Rb + off); pk = *(const v4u*)(Kb + off); pv = *(const v4u*)(Vb + off); pd = *(const v4u*)(Db + off); pa = *(const v4u*)(Ab + off); pg = *(const v4u*)(Gb + off); } }
    float bon = 0.f, vv[8], gg[8];
    for (int c = 0; c < nch; ++c) {
        const int nt = (T - 64 * c) < 64 ? (T - 64 * c) : 64;
        const bool valid = tt < nt;
        {
            float r8[8], k8[8], d8[8], a8[8];
            unpack8(pr, r8); unpack8(pk, k8); unpack8(pv, vv); unpack8(pd, d8); unpack8(pa, a8); unpack8(pg, gg);
            float kk[8], ss = 0.f;
#pragma unroll
            for (int j = 0; j < 8; ++j) { kk[j] = k8[j] * ckk[j]; ss += kk[j] * kk[j]; }
            ss = red8(ss);
            const float inv = __builtin_amdgcn_rsqf(fmaxf(ss, 1e-24f));
            float kp[8], bsum = 0.f;
#pragma unroll
            for (int j = 0; j < 8; ++j) { kk[j] *= inv; kp[j] = k8[j] * (1.f + (a8[j] - 1.f) * cka[j]); bsum += r8[j] * kp[j] * crk[j]; }
            bon = red8(bsum);
            if (valid) {
                LAS float* p = L + tt * 64 + 8 * cg;
                *(LAS f32x4*)(p + RW_KK) = (f32x4){-kk[0], -kk[1], -kk[2], -kk[3]}; *(LAS f32x4*)(p + RW_KK + 4) = (f32x4){-kk[4], -kk[5], -kk[6], -kk[7]};
                *(LAS f32x4*)(p + RW_DD) = (f32x4){1.f - d8[0], 1.f - d8[1], 1.f - d8[2], 1.f - d8[3]}; *(LAS f32x4*)(p + RW_DD + 4) = (f32x4){1.f - d8[4], 1.f - d8[5], 1.f - d8[6], 1.f - d8[7]};
                *(LAS f32x4*)(p + RW_BB) = (f32x4){kk[0] * a8[0], kk[1] * a8[1], kk[2] * a8[2], kk[3] * a8[3]}; *(LAS f32x4*)(p + RW_BB + 4) = (f32x4){kk[4] * a8[4], kk[5] * a8[5], kk[6] * a8[6], kk[7] * a8[7]};
                *(LAS f32x4*)(p + RW_KP) = (f32x4){kp[0], kp[1], kp[2], kp[3]}; *(LAS f32x4*)(p + RW_KP + 4) = (f32x4){kp[4], kp[5], kp[6], kp[7]};
                *(LAS f32x4*)(p + RW_RR) = (f32x4){r8[0], r8[1], r8[2], r8[3]}; *(LAS f32x4*)(p + RW_RR + 4) = (f32x4){r8[4], r8[5], r8[6], r8[7]};
                *(LAS f32x4*)(p + RW_VV) = (f32x4){vv[0], vv[1], vv[2], vv[3]}; *(LAS f32x4*)(p + RW_VV + 4) = (f32x4){vv[4], vv[5], vv[6], vv[7]};
            }
        }
        __syncthreads();
        if (c + 1 < nch) { const int nt1 = (T - 64 * (c + 1)) < 64 ? (T - 64 * (c + 1)) : 64;
            if (tt < nt1) { const size_t off = (size_t)(row0 + 64 * (c + 1) + tt) * D + ch;
                pr = *(const v4u*)(Rb + off); pk = *(const v4u*)(Kb + off); pv = *(const v4u*)(Vb + off); pd = *(const v4u*)(Db + off); pa = *(const v4u*)(Ab + off); pg = *(const v4u*)(Gb + off); } }
        {
            typedef float f2 __attribute__((ext_vector_type(2)));
            f2 S2[4] = {{S[0], S[1]}, {S[2], S[3]}, {S[4], S[5]}, {S[6], S[7]}};
            const LAS float* p = L + 8 * cg;
            LAS float* yw = L + RW_YY + srow;
            const LAS float* vp = L + RW_VV + srow;
#define RW_LD(N, Dd, B, Q, R, VR, t_) do { const LAS float* p_ = p + (t_) * 64; \
                N[0] = *(const LAS f32x4*)(p_ + RW_KK); N[1] = *(const LAS f32x4*)(p_ + RW_KK + 4); Dd[0] = *(const LAS f32x4*)(p_ + RW_DD); Dd[1] = *(const LAS f32x4*)(p_ + RW_DD + 4); \
                B[0] = *(const LAS f32x4*)(p_ + RW_BB); B[1] = *(const LAS f32x4*)(p_ + RW_BB + 4); Q[0] = *(const LAS f32x4*)(p_ + RW_KP); Q[1] = *(const LAS f32x4*)(p_ + RW_KP + 4); \
                R[0] = *(const LAS f32x4*)(p_ + RW_RR); R[1] = *(const LAS f32x4*)(p_ + RW_RR + 4); VR = vp[(t_) * 64]; } while (0)
#define RW_STEP(N, Dd, B, Q, R, VR, t_) do { \
                f2 a_ = S2[0] * (f2){N[0].x, N[0].y}; a_ = S2[1] * (f2){N[0].z, N[0].w} + a_; a_ = S2[2] * (f2){N[1].x, N[1].y} + a_; a_ = S2[3] * (f2){N[1].z, N[1].w} + a_; \
                const float sa_ = red8(a_.x + a_.y); const f2 sv_ = {sa_, sa_}, vv_ = {VR, VR}; \
                S2[0] = S2[0] * (f2){Dd[0].x, Dd[0].y} + (sv_ * (f2){B[0].x, B[0].y} + vv_ * (f2){Q[0].x, Q[0].y}); \
                S2[1] = S2[1] * (f2){Dd[0].z, Dd[0].w} + (sv_ * (f2){B[0].z, B[0].w} + vv_ * (f2){Q[0].z, Q[0].w}); \
                S2[2] = S2[2] * (f2){Dd[1].x, Dd[1].y} + (sv_ * (f2){B[1].x, B[1].y} + vv_ * (f2){Q[1].x, Q[1].y}); \
                S2[3] = S2[3] * (f2){Dd[1].z, Dd[1].w} + (sv_ * (f2){B[1].z, B[1].w} + vv_ * (f2){Q[1].z, Q[1].w}); \
                f2 y_ = S2[0] * (f2){R[0].x, R[0].y}; y_ = S2[1] * (f2){R[0].z, R[0].w} + y_; y_ = S2[2] * (f2){R[1].x, R[1].y} + y_; y_ = S2[3] * (f2){R[1].z, R[1].w} + y_; \
                yw[(t_) * 64] = red8(y_.x + y_.y); } while (0)
            f32x4 nA[2], dA[2], bA[2], qA[2], rA[2]; float vA;
            for (int t = 0; t < nt; ++t) { RW_LD(nA, dA, bA, qA, rA, vA, t); RW_STEP(nA, dA, bA, qA, rA, vA, t); }
#undef RW_LD
#undef RW_STEP
            S[0] = S2[0].x; S[1] = S2[0].y; S[2] = S2[1].x; S[3] = S2[1].y; S[4] = S2[2].x; S[5] = S2[2].y; S[6] = S2[3].x; S[7] = S2[3].y;
        }
        __syncthreads();
        if (pvar != 4) {
            f32x4 y0 = {0.f, 0.f, 0.f, 0.f}, y1 = y0;
            if (valid) { y0 = *(const LAS f32x4*)(L + RW_YY + tt * 64 + 8 * cg); y1 = *(const LAS f32x4*)(L + RW_YY + tt * 64 + 8 * cg + 4); }
            float yy[8] = {y0.x, y0.y, y0.z, y0.w, y1.x, y1.y, y1.z, y1.w};
            float s1 = 0.f;
#pragma unroll
            for (int j = 0; j < 8; ++j) s1 += yy[j];
            const float mean = red8(s1) * (1.f / 64.f);
            float s2 = 0.f;
#pragma unroll
            for (int j = 0; j < 8; ++j) { yy[j] -= mean; s2 += yy[j] * yy[j]; }
            const float rstd = __builtin_amdgcn_rsqf(red8(s2) * (1.f / 64.f) + GN_EPS);
            float o[8];
#pragma unroll
            for (int j = 0; j < 8; ++j) o[j] = ((yy[j] * rstd) * cgw[j] + cgb[j] + bon * vv[j]) * gg[j];
            if (valid && do_store) *(v4u*)(Gb + (size_t)(row0 + 64 * c + tt) * D + ch) = pack8(o);
        }
    }
    *(f32x4*)(ST + srow * 64 + 8 * cg) = (f32x4){S[0], S[1], S[2], S[3]}; *(f32x4*)(ST + srow * 64 + 8 * cg + 4) = (f32x4){S[4], S[5], S[6], S[7]};
    __syncthreads();
}

constexpr int RH_TC = 32, RH_BUF = 12288;
constexpr int RH_KK = 0, RH_DD = 2048, RH_BB = 4096, RH_KP = 6144, RH_RR = 8192, RH_VV = 10240, RH_YY = 11264;
__device__ __forceinline__ void rwkv_half_chain(const Frame& F, int b, int h, int half, float* ST, const bf16* Rb, const bf16* Kb, const bf16* Vb, const bf16* Db, const bf16* Ab,
                                                bf16* YRAW, float* BON, const float* k_k, const float* k_a, const float* r_k, const int pvar) {
    LAS float* L = (LAS float*)F.lds;
    const int tid = F.tid, lane = F.lane, w = F.wave, row0 = b * PT;
    constexpr int nch = PT / RH_TC;
    if (w < 4) {
        const int srow = 8 * w + (lane >> 3), cq = lane & 7;
        f32x4 S4 = {0.f, 0.f, 0.f, 0.f}, S5 = S4;
        __syncthreads();
        __builtin_amdgcn_s_setprio(3);
        for (int c = 0; c < nch; ++c) {
            const LAS float* p = L + (c & 1) * RH_BUF + 8 * cq;
            LAS float* yw = L + (c & 1) * RH_BUF + RH_YY + srow;
            const LAS float* vp = L + (c & 1) * RH_BUF + RH_VV + srow;
#define RH_LD(N, Dd, B, Q, R, VR, t_) do { const LAS float* p_ = p + (t_) * 64; \
                N[0] = *(const LAS f32x4*)(p_ + RH_KK); N[1] = *(const LAS f32x4*)(p_ + RH_KK + 4); Dd[0] = *(const LAS f32x4*)(p_ + RH_DD); Dd[1] = *(const LAS f32x4*)(p_ + RH_DD + 4); \
                B[0] = *(const LAS f32x4*)(p_ + RH_BB); B[1] = *(const LAS f32x4*)(p_ + RH_BB + 4); Q[0] = *(const LAS f32x4*)(p_ + RH_KP); Q[1] = *(const LAS f32x4*)(p_ + RH_KP + 4); \
                R[0] = *(const LAS f32x4*)(p_ + RH_RR); R[1] = *(const LAS f32x4*)(p_ + RH_RR + 4); VR = vp[(t_) * 32]; } while (0)
#define RH_STEP(N, Dd, B, Q, R, VR, t_) do { \
                const f32x4 pa_ = S4 * N[0] + S5 * N[1]; const float sa_ = red8((pa_.x + pa_.y) + (pa_.z + pa_.w)); \
                S4 = S4 * Dd[0] + (B[0] * sa_ + Q[0] * VR); S5 = S5 * Dd[1] + (B[1] * sa_ + Q[1] * VR); \
                const f32x4 ya_ = S4 * R[0] + S5 * R[1]; yw[(t_) * 32] = red8((ya_.x + ya_.y) + (ya_.z + ya_.w)); } while (0)
            f32x4 nA[2], dA[2], bA[2], qA[2], rA[2], nB[2], dB[2], bB[2], qB[2], rB[2]; float vA, vB;
            RH_LD(nA, dA, bA, qA, rA, vA, 0);
            if (pvar != 3)
            for (int t = 0; t < RH_TC; t += 2) {
                RH_LD(nB, dB, bB, qB, rB, vB, t + 1);
                RH_STEP(nA, dA, bA, qA, rA, vA, t);
                RH_LD(nA, dA, bA, qA, rA, vA, (t + 2 < RH_TC ? t + 2 : t + 1));
                RH_STEP(nB, dB, bB, qB, rB, vB, t + 1);
            }
#undef RH_LD
#undef RH_STEP
            __syncthreads();
        }
        __builtin_amdgcn_s_setprio(0);
        *(f32x4*)(ST + (32 * half + srow) * 64 + 8 * cq) = S4; *(f32x4*)(ST + (32 * half + srow) * 64 + 8 * cq + 4) = S5;
    } else {
        const int ht = tid - 256, cg = ht & 7, tt = ht >> 3;
        const int ch = h * 64 + 8 * cg, vch = h * 64 + 32 * half + 4 * cg;
        float ckk[8], cka[8], crk[8];
#pragma unroll
        for (int j = 0; j < 8; ++j) { ckk[j] = k_k[ch + j]; cka[j] = k_a[ch + j]; crk[j] = r_k[ch + j]; }
        v4u pr, pk, pd, pa; uint2 pv;
#define RH_LOAD(cc) do { const size_t off_ = (size_t)(row0 + RH_TC * (cc) + tt) * D; pr = *(const v4u*)(Rb + off_ + ch); pk = *(const v4u*)(Kb + off_ + ch); pd = *(const v4u*)(Db + off_ + ch); \
            pa = *(const v4u*)(Ab + off_ + ch); pv = *(const uint2*)(Vb + off_ + vch); } while (0)
#define RH_PREP(cc) do { float r8[8], k8[8], d8[8], a8[8]; unpack8(pr, r8); unpack8(pk, k8); unpack8(pd, d8); unpack8(pa, a8); \
            float kk[8], ss = 0.f; _Pragma("unroll") for (int j = 0; j < 8; ++j) { kk[j] = k8[j] * ckk[j]; ss += kk[j] * kk[j]; } \
            ss = red8(ss); const float inv = __builtin_amdgcn_rsqf(fmaxf(ss, 1e-24f)); \
            float kp[8], bsum = 0.f; _Pragma("unroll") for (int j = 0; j < 8; ++j) { kk[j] *= inv; kp[j] = k8[j] * (1.f + (a8[j] - 1.f) * cka[j]); bsum += r8[j] * kp[j] * crk[j]; } \
            const float bon = red8(bsum); if (half == 0 && cg == 0) BON[(size_t)(row0 + RH_TC * (cc) + tt) * 16 + h] = bon; \
            LAS float* p = L + ((cc) & 1) * RH_BUF + tt * 64 + 8 * cg; \
            *(LAS f32x4*)(p + RH_KK) = (f32x4){-kk[0], -kk[1], -kk[2], -kk[3]}; *(LAS f32x4*)(p + RH_KK + 4) = (f32x4){-kk[4], -kk[5], -kk[6], -kk[7]}; \
            *(LAS f32x4*)(p + RH_DD) = (f32x4){1.f - d8[0], 1.f - d8[1], 1.f - d8[2], 1.f - d8[3]}; *(LAS f32x4*)(p + RH_DD + 4) = (f32x4){1.f - d8[4], 1.f - d8[5], 1.f - d8[6], 1.f - d8[7]}; \
            *(LAS f32x4*)(p + RH_BB) = (f32x4){kk[0] * a8[0], kk[1] * a8[1], kk[2] * a8[2], kk[3] * a8[3]}; *(LAS f32x4*)(p + RH_BB + 4) = (f32x4){kk[4] * a8[4], kk[5] * a8[5], kk[6] * a8[6], kk[7] * a8[7]}; \
            *(LAS f32x4*)(p + RH_KP) = (f32x4){kp[0], kp[1], kp[2], kp[3]}; *(LAS f32x4*)(p + RH_KP + 4) = (f32x4){kp[4], kp[5], kp[6], kp[7]}; \
            *(LAS f32x4*)(p + RH_RR) = (f32x4){r8[0], r8[1], r8[2], r8[3]}; *(LAS f32x4*)(p + RH_RR + 4) = (f32x4){r8[4], r8[5], r8[6], r8[7]}; \
            *(LAS f32x4*)(L + ((cc) & 1) * RH_BUF + RH_VV + tt * 32 + 4 * cg) = (f32x4){bflo(pv.x), bfhi(pv.x), bflo(pv.y), bfhi(pv.y)}; } while (0)
#define RH_POST(cc) do { const f32x4 y4 = *(const LAS f32x4*)(L + ((cc) & 1) * RH_BUF + RH_YY + tt * 32 + 4 * cg); uint2 o; o.x = pkbf(y4.x, y4.y); o.y = pkbf(y4.z, y4.w); \
            *(uint2*)(YRAW + (size_t)(row0 + RH_TC * (cc) + tt) * D + vch) = o; } while (0)
        RH_LOAD(0); RH_PREP(0); RH_LOAD(1);
        __syncthreads();
        for (int c = 0; c < nch; ++c) {
            if (c > 0) RH_POST(c - 1);
            if (c + 1 < nch) { RH_PREP(c + 1); if (c + 2 < nch) RH_LOAD(c + 2); }
            __syncthreads();
        }
        RH_POST(nch - 1);
#undef RH_LOAD
#undef RH_PREP
#undef RH_POST
    }
    __syncthreads();
}
__device__ __forceinline__ void rwkv_finish(const Frame& F, const bf16* YRAW, const float* BON, const bf16* Vb, bf16* Gb, const float* gn_w, const float* gn_b) {
    const int gt = (F.vcu * NWAVES + F.wave) * 64 + F.lane, NT = F.G * NWAVES * 64;
    for (int task = gt; task < MP * 128; task += NT) {
        const int cg = task & 7, hh = (task >> 3) & 15, row = task >> 7; const size_t off = (size_t)row * D + hh * 64 + 8 * cg;
        float yy[8], vv[8], gg[8]; unpack8(*(const v4u*)(YRAW + off), yy); unpack8(*(const v4u*)(Vb + off), vv); unpack8(*(const v4u*)(Gb + off), gg);
        const float bon = BON[(size_t)row * 16 + hh];
        float s1 = 0.f;
#pragma unroll
        for (int j = 0; j < 8; ++j) s1 += yy[j];
        const float mean = red8(s1) * (1.f / 64.f);
        float s2 = 0.f;
#pragma unroll
        for (int j = 0; j < 8; ++j) { yy[j] -= mean; s2 += yy[j] * yy[j]; }
        const float rstd = __builtin_amdgcn_rsqf(red8(s2) * (1.f / 64.f) + GN_EPS);
        const f32x4 w0 = *(const f32x4*)(gn_w + hh * 64 + 8 * cg), w1 = *(const f32x4*)(gn_w + hh * 64 + 8 * cg + 4), b0 = *(const f32x4*)(gn_b + hh * 64 + 8 * cg), b1 = *(const f32x4*)(gn_b + hh * 64 + 8 * cg + 4);
        const float gw[8] = {w0.x, w0.y, w0.z, w0.w, w1.x, w1.y, w1.z, w1.w}, gb[8] = {b0.x, b0.y, b0.z, b0.w, b1.x, b1.y, b1.z, b1.w};
        float o[8];
#pragma unroll
        for (int j = 0; j < 8; ++j) o[j] = ((yy[j] * rstd) * gw[j] + gb[j] + bon * vv[j]) * gg[j];
        *(v4u*)(Gb + off) = pack8(o);
    }
}

constexpr int PBY = 144;
constexpr int RPY = 272;
constexpr int ML_RQK = 0, ML_S = 0, ML_KT = 9216, ML_RV = 18432, ML_Q = 35840, ML_K = 45056, ML_HB = 35840, ML_VT = 54272, ML_C = 72704, ML_F = 91136;
constexpr int MF_N = 0, MF_QN = 64, MF_RS = 128, MF_HS = 256, MF_CW = 384, MF_B63 = 1024, MF_P63 = 1056, MF_MC = 1088  , MF_GB = 1152, MF_GP = MF_GB + 2048, MF_GA = MF_GP + 2048;
typedef __attribute__((address_space(3))) unsigned short lds_u16;
#define MFMA16(a, b, c) __builtin_amdgcn_mfma_f32_16x16x32_bf16((a), (b), (c), 0, 0, 0)
__device__ __forceinline__ void mlstm_gate_tables(const Frame& F, int b, int hh, const float* IFb) {
    LAS float* Fl = (LAS float*)(F.lds + ML_F); const int lane = F.lane, w = F.wave;
#pragma unroll
    for (int q = 0; q < 4; ++q) { const int cc = w + 8 * q; const size_t ro_ = (size_t)(b * PT + 64 * cc + lane) * 16;
        const float li = IFb[ro_ + hh], lf = IFb[ro_ + 8 + hh];
        float bc = lf;
#pragma unroll
        for (int o = 1; o < 64; o <<= 1) { const float x = __shfl_up(bc, o); if (lane >= o) bc += x; }
        const float av = li - bc; float pm = av;
#pragma unroll
        for (int o = 1; o < 64; o <<= 1) { const float x = __shfl_up(pm, o); if (lane >= o) pm = fmaxf(pm, x); }
        Fl[MF_GB + cc * 64 + lane] = bc; Fl[MF_GP + cc * 64 + lane] = pm; Fl[MF_GA + cc * 64 + lane] = av;
        if (lane == 63) { Fl[MF_B63 + cc] = bc; Fl[MF_P63 + cc] = pm; } }
    __syncthreads();
    if (F.tid == 0) { float mm = 0.f;
        for (int cc = 0; cc < PT / 64; ++cc) { Fl[MF_MC + cc] = mm; const float b6 = Fl[MF_B63 + cc]; mm = fmaxf(b6 + mm, b6 + Fl[MF_P63 + cc]); }
        Fl[MF_MC + PT / 64] = mm; }
    __syncthreads();
}
constexpr int ML_NSEG = 4, ML_SEGC = PT / 64 / ML_NSEG, ML_SEGSZ = 128 * 64 + 64;
__device__ __forceinline__ void mlstm_prompt_chain(const Frame& F, int b, int hh, const int seg, const bf16* QKR, const bf16* VVb, const bf16* OOb, const float* IFb, bf16* HOb,
                                                   const float* conv_w, const float* conv_b, const float* norm_w, float* NUM, float* DEN, bf16* Qs, float* SEG, const int pvar) {
    LAS unsigned char* lds = F.lds; LAS float* Fl = (LAS float*)(lds + ML_F);
    const bool defer = seg > 0; const int c_lo = seg * ML_SEGC, c_hi = c_lo + ML_SEGC;
    const int tid = F.tid, lane = F.lane, w = F.wave, fr = lane & 15, fq = lane >> 4;
    for (int i = tid; i < 128 * 72; i += 512) ((lds_u16*)(lds + ML_C))[i] = 0;
    if (tid < 64) Fl[MF_N + tid] = 0.f;
    for (int i = tid; i < 640; i += 512) { const int j = i >> 7, c = i & 127, gc = c < 64 ? hh * 64 + c : 512 + hh * 64 + (c - 64); Fl[MF_CW + i] = j < 4 ? conv_w[j * D + gc] : conv_b[gc]; }
    f32x4 Cacc[4];
#pragma unroll
    for (int k = 0; k < 4; ++k) Cacc[k] = (f32x4){0.f, 0.f, 0.f, 0.f};
    const int og = tid & 15, ot = tid >> 4;
    float nw[8];
#pragma unroll
    for (int e = 0; e < 8; ++e) nw[e] = norm_w[hh * 128 + 8 * og + e];
    v4u rq[3], rv[2], ro[2];
#define ML_LOAD_QKV(cc) do { const int rowc_ = b * PT + 64 * (cc); \
        _Pragma("unroll") for (int i = 0; i < 3; ++i) { const int q = tid + 512 * i, r = q >> 4, j = q & 15, tok = 64 * (cc) - 3 + r; rq[i] = (v4u){0u, 0u, 0u, 0u}; \
            if (q < 67 * 16 && tok >= 0) rq[i] = *(const v4u*)(QKR + (size_t)(b * PT + tok) * D + (j < 8 ? hh * 64 + 8 * j : 512 + hh * 64 + 8 * (j - 8))); } \
        _Pragma("unroll") for (int i = 0; i < 2; ++i) rv[i] = *(const v4u*)(VVb + (size_t)(rowc_ + ot + 32 * i) * D + hh * 128 + 8 * og); \
        } while (0)
#define ML_LOAD_O(cc) do { const int rowc_ = b * PT + 64 * (cc); \
        _Pragma("unroll") for (int i = 0; i < 2; ++i) ro[i] = *(const v4u*)(OOb + (size_t)(rowc_ + ot + 32 * i) * D + hh * 128 + 8 * og); } while (0)
    ML_LOAD_QKV(c_lo);
    mlstm_gate_tables(F, b, hh, IFb);
    for (int c = c_lo; c < c_hi; ++c) {
        const int rowc = b * PT + 64 * c;
        const float m_c = Fl[MF_MC + c], m_n = Fl[MF_MC + c + 1], b63 = Fl[MF_B63 + c];
#pragma unroll
        for (int i = 0; i < 3; ++i) { const int q = tid + 512 * i; if (q < 67 * 16) *(LAS v4u*)(lds + ML_RQK + (q >> 4) * RPY + 16 * (q & 15)) = rq[i]; }
#pragma unroll
        for (int i = 0; i < 2; ++i) *(LAS v4u*)(lds + ML_RV + (ot + 32 * i) * RPY + 16 * og) = rv[i];
        if (c + 1 < c_hi) ML_LOAD_QKV(c + 1);
        if (!defer) ML_LOAD_O(c);
        __syncthreads();
        float kreg[8] = {0.f, 0.f, 0.f, 0.f, 0.f, 0.f, 0.f, 0.f};
        if (pvar != 3)
#pragma unroll
        for (int i = 0; i < 2; ++i) {
            const int g = w + 8 * i, t = lane;
            float x[4][8];
#pragma unroll
            for (int j = 0; j < 4; ++j) unpack8(*(const LAS v4u*)(lds + ML_RQK + (t + j) * RPY + 16 * g), x[j]);
            float val[8];
#pragma unroll
            for (int h2 = 0; h2 < 2; ++h2) { f32x4 a = *(const LAS f32x4*)(Fl + MF_CW + 4 * 128 + 8 * g + 4 * h2);
#pragma unroll
                for (int j = 0; j < 4; ++j) { const f32x4 cw = *(const LAS f32x4*)(Fl + MF_CW + j * 128 + 8 * g + 4 * h2);
                    a.x += cw.x * x[j][4 * h2]; a.y += cw.y * x[j][4 * h2 + 1]; a.z += cw.z * x[j][4 * h2 + 2]; a.w += cw.w * x[j][4 * h2 + 3]; }
                val[4 * h2] = siluf_(a.x); val[4 * h2 + 1] = siluf_(a.y); val[4 * h2 + 2] = siluf_(a.z); val[4 * h2 + 3] = siluf_(a.w); }
            if (i == 0) {
#pragma unroll
                for (int e = 0; e < 8; ++e) val[e] *= 0.125f;
                *(LAS v4u*)(lds + ML_Q + t * PBY + 16 * w) = pack8(val);
            } else { *(LAS v4u*)(lds + ML_K + t * PBY + 16 * w) = pack8(val);
#pragma unroll
                for (int e = 0; e < 8; ++e) kreg[e] = val[e]; }
            const v4u vw = *(const LAS v4u*)(lds + ML_RV + t * RPY + 16 * g);
            lds_u16* vt = (lds_u16*)(lds + ML_VT) + (8 * g) * 72 + t;
            vt[0 * 72] = (unsigned short)(vw.x & 0xffffu); vt[1 * 72] = (unsigned short)(vw.x >> 16); vt[2 * 72] = (unsigned short)(vw.y & 0xffffu); vt[3 * 72] = (unsigned short)(vw.y >> 16);
            vt[4 * 72] = (unsigned short)(vw.z & 0xffffu); vt[5 * 72] = (unsigned short)(vw.z >> 16); vt[6 * 72] = (unsigned short)(vw.w & 0xffffu); vt[7 * 72] = (unsigned short)(vw.w >> 16);
        }
        __syncthreads();
        if (pvar != 4) {
        { const float wsv = __expf(b63 + Fl[MF_GA + c * 64 + lane] - m_n); lds_u16* kt = (lds_u16*)(lds + ML_KT) + (8 * w) * 72 + lane;
#pragma unroll
          for (int e = 0; e < 8; ++e) kt[e * 72] = f2bf1(kreg[e] * wsv); }
        { const int tq = tid >> 3, p = tid & 7; float q8[8]; unpack8(*(const LAS v4u*)(lds + ML_Q + tq * PBY + 16 * p), q8);
          float dsum = 0.f;
#pragma unroll
          for (int e = 0; e < 8; ++e) dsum += q8[e] * Fl[MF_N + 8 * p + e];
          dsum = red8(dsum); if (p == 0) Fl[MF_QN + tq] = dsum; }
        { const int ti = w >> 1, t = 16 * ti + fr; float rsum = 0.f; const float mxt = fmaxf(m_c, Fl[MF_GP + c * 64 + t]);
          typedef unsigned u2v_ __attribute__((ext_vector_type(2)));
#pragma unroll
          for (int jj = 0; jj < 2; ++jj) { const int sj = 2 * (w & 1) + jj; f32x4 acc = {0.f, 0.f, 0.f, 0.f};
#pragma unroll
              for (int ks = 0; ks < 2; ++ks) { const bf16x8 a = *(const LAS bf16x8*)(lds + ML_Q + (16 * ti + fr) * PBY + ks * 64 + fq * 16), bb = *(const LAS bf16x8*)(lds + ML_K + (16 * sj + fr) * PBY + ks * 64 + fq * 16);
                  acc = MFMA16(bb, a, acc); }
              const f32x4 av4 = *(const LAS f32x4*)(Fl + MF_GA + c * 64 + 16 * sj + 4 * fq);
#pragma unroll
              for (int r = 0; r < 4; ++r) { const int s_ = 16 * sj + 4 * fq + r; const float val = s_ <= t ? acc[r] * __expf(av4[r] - mxt) : 0.f; acc[r] = val; rsum += val; }
              u2v_ pw; pw.x = pkbf(acc[0], acc[1]); pw.y = pkbf(acc[2], acc[3]);
              *(LAS u2v_*)(lds + ML_S + (t * 72 + 16 * sj + 4 * fq) * 2) = pw; }
          rsum += __shfl_xor(rsum, 16); rsum += __shfl_xor(rsum, 32);
          if (fq == 0) Fl[MF_RS + t * 2 + (w & 1)] = rsum; }
        }
        __syncthreads();
        float hv[4][4] = {};
        if (pvar != 5) { const int ti = w & 3, t = 16 * ti + fr;
          const float mx = fmaxf(m_c, Fl[MF_GP + c * 64 + t]), wi = __expf(m_c - mx), ei = __expf(-(Fl[MF_GB + c * 64 + t] + mx));
          const float rden = __builtin_amdgcn_rcpf(fmaxf(fabsf(wi * Fl[MF_QN + t] + Fl[MF_RS + 2 * t] + Fl[MF_RS + 2 * t + 1]), ei)); float hq = 0.f;
#pragma unroll
          for (int i = 0; i < 4; ++i) { const int vt = 4 * (w >> 2) + i; f32x4 accA = {0.f, 0.f, 0.f, 0.f}, accB = accA;
#pragma unroll
              for (int ks = 0; ks < 2; ++ks) {
                  const bf16x8 aq = *(const LAS bf16x8*)(lds + ML_Q + (16 * ti + fr) * PBY + ks * 64 + fq * 16), bc = *(const LAS bf16x8*)(lds + ML_C + (16 * vt + fr) * PBY + ks * 64 + fq * 16);
                  accA = MFMA16(bc, aq, accA);
                  const bf16x8 as = *(const LAS bf16x8*)(lds + ML_S + (16 * ti + fr) * PBY + ks * 64 + fq * 16), bv = *(const LAS bf16x8*)(lds + ML_VT + (16 * vt + fr) * PBY + ks * 64 + fq * 16);
                  accB = MFMA16(bv, as, accB); }
              if (defer) { *(f32x4*)(NUM + (size_t)(rowc + t) * D + hh * 128 + 16 * vt + 4 * fq) = accA * wi + accB; }
              else {
#pragma unroll
              for (int r = 0; r < 4; ++r) { const float hh_ = (wi * accA[r] + accB[r]) * rden; hv[i][r] = hh_; hq += hh_ * hh_; } } }
          if (defer) { if (fq == 0 && (w >> 2) == 0) DEN[(size_t)(rowc + t) * 8 + hh] = wi * Fl[MF_QN + t] + Fl[MF_RS + 2 * t] + Fl[MF_RS + 2 * t + 1];
              *(v4u*)(Qs + (size_t)(rowc + (tid >> 3)) * 512 + hh * 64 + 8 * (tid & 7)) = *(const LAS v4u*)(lds + ML_Q + (tid >> 3) * PBY + 16 * (tid & 7)); }
          else { hq += __shfl_xor(hq, 16); hq += __shfl_xor(hq, 32);
              if (fq == 0) Fl[MF_HS + t * 2 + (w >> 2)] = hq; } }
        __syncthreads();
        if (pvar != 6) {
        if (!defer) { const int ti = w & 3, t = 16 * ti + fr; const float sc = __builtin_amdgcn_rsqf((Fl[MF_HS + 2 * t] + Fl[MF_HS + 2 * t + 1]) * (1.f / 128.f) + NORM_EPS);
          typedef unsigned u2v_ __attribute__((ext_vector_type(2)));
#pragma unroll
          for (int i = 0; i < 4; ++i) { u2v_ pw; pw.x = pkbf(hv[i][0] * sc, hv[i][1] * sc); pw.y = pkbf(hv[i][2] * sc, hv[i][3] * sc);
              *(LAS u2v_*)(lds + ML_HB + t * RPY + (16 * (4 * (w >> 2) + i) + 4 * fq) * 2) = pw; } }
        { const float wst = __expf(b63 + m_c - m_n);
          typedef unsigned u2v_ __attribute__((ext_vector_type(2)));
#pragma unroll
          for (int kt = 0; kt < 4; ++kt) { Cacc[kt] = Cacc[kt] * wst;
#pragma unroll
              for (int ks = 0; ks < 2; ++ks) { const bf16x8 a = *(const LAS bf16x8*)(lds + ML_VT + (16 * w + fr) * PBY + ks * 64 + fq * 16), bb = *(const LAS bf16x8*)(lds + ML_KT + (16 * kt + fr) * PBY + ks * 64 + fq * 16);
                  Cacc[kt] = MFMA16(bb, a, Cacc[kt]); }
              u2v_ pw; pw.x = pkbf(Cacc[kt][0], Cacc[kt][1]); pw.y = pkbf(Cacc[kt][2], Cacc[kt][3]);
              *(LAS u2v_*)(lds + ML_C + ((16 * w + fr) * 72 + 16 * kt + 4 * fq) * 2) = pw; }
          if (w == 0) { float sum = 0.f;
#pragma unroll
              for (int q = 0; q < 8; ++q) { float k8[8]; unpack8(*(const LAS v4u*)(lds + ML_KT + lane * PBY + 16 * q), k8);
#pragma unroll
                  for (int e = 0; e < 8; ++e) sum += k8[e]; }
              Fl[MF_N + lane] = wst * Fl[MF_N + lane] + sum; } }
        }
        __syncthreads();
        if (!defer)
#pragma unroll
        for (int i = 0; i < 2; ++i) { const int t = ot + 32 * i; float h8[8], o8[8]; unpack8(*(const LAS v4u*)(lds + ML_HB + t * RPY + 16 * og), h8); unpack8(ro[i], o8);
#pragma unroll
            for (int e = 0; e < 8; ++e) h8[e] = h8[e] * nw[e] * o8[e];
            *(v4u*)(HOb + (size_t)(rowc + t) * D + hh * 128 + 8 * og) = pack8(h8); }
    }
#undef ML_LOAD_QKV
#undef ML_LOAD_O
    { float* sp = SEG + (size_t)((b * 8 + hh) * ML_NSEG + seg) * ML_SEGSZ;
#pragma unroll
      for (int kt = 0; kt < 4; ++kt) *(f32x4*)(sp + (16 * w + fr) * 64 + 16 * kt + 4 * fq) = Cacc[kt];
      if (w == 0) sp[128 * 64 + lane] = Fl[MF_N + lane]; }
    __syncthreads();
}
__device__ __forceinline__ void mlstm_fix_seg(const Frame& F, int b, int hh, const int seg, const bf16* QKR, const bf16* OOb, const float* IFb, bf16* HOb, const float* norm_w,
                                              const float* NUM, const float* DEN, const bf16* Qs, const float* SEG, float* out) {
    LAS unsigned char* lds = F.lds; LAS float* Fl = (LAS float*)(lds + ML_F);
    const int tid = F.tid, lane = F.lane, w = F.wave, fr = lane & 15, fq = lane >> 4;
    const int og = tid & 15, ot = tid >> 4, chain = b * 8 + hh;
    typedef unsigned u2v_ __attribute__((ext_vector_type(2)));
    float nw[8];
#pragma unroll
    for (int e = 0; e < 8; ++e) nw[e] = norm_w[hh * 128 + 8 * og + e];
    const int c_lo = seg * ML_SEGC, c_hi = c_lo + ML_SEGC;
    v4u rq, ro[2]; f32x4 numl[4]; float denl;
#define MLF_LOAD(cc, RQ, RO, NL, DL) do { const int rowc_ = b * PT + 64 * (cc); \
        RQ = *(const v4u*)(Qs + (size_t)(rowc_ + (tid >> 3)) * 512 + hh * 64 + 8 * (tid & 7)); \
        _Pragma("unroll") for (int i = 0; i < 2; ++i) RO[i] = *(const v4u*)(OOb + (size_t)(rowc_ + ot + 32 * i) * D + hh * 128 + 8 * og); \
        _Pragma("unroll") for (int i = 0; i < 4; ++i) NL[i] = *(const f32x4*)(NUM + (size_t)(rowc_ + 16 * (w & 3) + fr) * D + hh * 128 + 16 * (4 * (w >> 2) + i) + 4 * fq); \
        DL = DEN[(size_t)(rowc_ + 16 * (w & 3) + fr) * 8 + hh]; } while (0)
    MLF_LOAD(c_lo, rq, ro, numl, denl);
    mlstm_gate_tables(F, b, hh, IFb);
    {
        f32x4 cin[4]; float nin = 0.f;
#pragma unroll
        for (int i = 0; i < 4; ++i) cin[i] = (f32x4){0.f, 0.f, 0.f, 0.f};
        for (int j = 0; j < seg; ++j) {
            float lw = 0.f;
            for (int cc = j * ML_SEGC; cc < (j + 1) * ML_SEGC; ++cc) lw += Fl[MF_B63 + cc] + Fl[MF_MC + cc] - Fl[MF_MC + cc + 1];
            const float Wj = __expf(lw); const float* sp = SEG + (size_t)(chain * ML_NSEG + j) * ML_SEGSZ;
#pragma unroll
            for (int i = 0; i < 4; ++i) cin[i] = cin[i] * Wj + *(const f32x4*)(sp + 4 * (tid + 512 * i));
            if (tid < 64) nin = nin * Wj + sp[128 * 64 + tid];
        }
#pragma unroll
        for (int i = 0; i < 4; ++i) { const int idx = tid + 512 * i, v = idx >> 4, k4 = (idx & 15) * 4; u2v_ pw; pw.x = pkbf(cin[i][0], cin[i][1]); pw.y = pkbf(cin[i][2], cin[i][3]);
            *(LAS u2v_*)(lds + ML_C + (v * 72 + k4) * 2) = pw; }
        if (tid < 64) Fl[MF_N + tid] = nin;
        if (seg == ML_NSEG - 1) {
            float lw = 0.f;
            for (int cc = seg * ML_SEGC; cc < (seg + 1) * ML_SEGC; ++cc) lw += Fl[MF_B63 + cc] + Fl[MF_MC + cc] - Fl[MF_MC + cc + 1];
            const float Wj = __expf(lw); const float* sp = SEG + (size_t)(chain * ML_NSEG + seg) * ML_SEGSZ;
#pragma unroll
            for (int i = 0; i < 4; ++i) *(f32x4*)(out + O_P_C + (size_t)chain * 8192 + 4 * (tid + 512 * i)) = cin[i] * Wj + *(const f32x4*)(sp + 4 * (tid + 512 * i));
            if (tid < 64) out[O_P_N + (size_t)chain * 64 + tid] = nin * Wj + sp[128 * 64 + tid];
            if (tid == 0) out[O_P_M + chain] = Fl[MF_MC + PT / 64];
            if (tid < 384) { const int j = tid >> 7, c = tid & 127, gc = c < 64 ? hh * 64 + c : 512 + hh * 64 + (c - 64);
                out[O_P_CONV + (size_t)(b * 3 + j) * D + gc] = bf1(QKR[(size_t)(b * PT + PT - 3 + j) * D + gc]); }
        }
    }
    float wc = 1.f;
    for (int c = c_lo; c < c_hi; ++c) {
        const int rowc = b * PT + 64 * c;
        const float m_c = Fl[MF_MC + c], m_n = Fl[MF_MC + c + 1], b63 = Fl[MF_B63 + c];
        *(LAS v4u*)(lds + ML_RQK + (tid >> 3) * PBY + 16 * (tid & 7)) = rq;
        v4u rqn = rq, ron[2] = {ro[0], ro[1]}; f32x4 numn[4] = {numl[0], numl[1], numl[2], numl[3]}; float denn = denl;
        if (c + 1 < c_hi) MLF_LOAD(c + 1, rqn, ron, numn, denn);
        __syncthreads();
        { const int tq = tid >> 3, p = tid & 7; float q8[8]; unpack8(*(const LAS v4u*)(lds + ML_RQK + tq * PBY + 16 * p), q8);
          float dsum = 0.f;
#pragma unroll
          for (int e = 0; e < 8; ++e) dsum += q8[e] * Fl[MF_N + 8 * p + e];
          dsum = red8(dsum); if (p == 0) Fl[MF_QN + tq] = dsum; }
        const int ti = w & 3, t = 16 * ti + fr;
        f32x4 accA[4];
#pragma unroll
        for (int i = 0; i < 4; ++i) { const int vt = 4 * (w >> 2) + i; accA[i] = (f32x4){0.f, 0.f, 0.f, 0.f};
#pragma unroll
            for (int ks = 0; ks < 2; ++ks) {
                const bf16x8 aq = *(const LAS bf16x8*)(lds + ML_RQK + (16 * ti + fr) * PBY + ks * 64 + fq * 16), bc = *(const LAS bf16x8*)(lds + ML_C + (16 * vt + fr) * PBY + ks * 64 + fq * 16);
                accA[i] = MFMA16(bc, aq, accA[i]); } }
        __syncthreads();
        float hv[4][4];
        { const float mx = fmaxf(m_c, Fl[MF_GP + c * 64 + t]), wi = __expf(m_c - mx) * wc, ei = __expf(-(Fl[MF_GB + c * 64 + t] + mx));
          const float rden = __builtin_amdgcn_rcpf(fmaxf(fabsf(wi * Fl[MF_QN + t] + denl), ei)); float hq = 0.f;
#pragma unroll
          for (int i = 0; i < 4; ++i)
#pragma unroll
              for (int r = 0; r < 4; ++r) { const float hh_ = (wi * accA[i][r] + numl[i][r]) * rden; hv[i][r] = hh_; hq += hh_ * hh_; }
          hq += __shfl_xor(hq, 16); hq += __shfl_xor(hq, 32);
          if (fq == 0) Fl[MF_HS + t * 2 + (w >> 2)] = hq; }
        __syncthreads();
        { const float sc = __builtin_amdgcn_rsqf((Fl[MF_HS + 2 * t] + Fl[MF_HS + 2 * t + 1]) * (1.f / 128.f) + NORM_EPS);
#pragma unroll
          for (int i = 0; i < 4; ++i) { u2v_ pw; pw.x = pkbf(hv[i][0] * sc, hv[i][1] * sc); pw.y = pkbf(hv[i][2] * sc, hv[i][3] * sc);
              *(LAS u2v_*)(lds + ML_HB + t * RPY + (16 * (4 * (w >> 2) + i) + 4 * fq) * 2) = pw; } }
        __syncthreads();
#pragma unroll
        for (int i = 0; i < 2; ++i) { const int t2 = ot + 32 * i; float h8[8], o8[8]; unpack8(*(const LAS v4u*)(lds + ML_HB + t2 * RPY + 16 * og), h8); unpack8(ro[i], o8);
#pragma unroll
            for (int e = 0; e < 8; ++e) h8[e] = h8[e] * nw[e] * o8[e];
            *(v4u*)(HOb + (size_t)(rowc + t2) * D + hh * 128 + 8 * og) = pack8(h8); }
        wc *= __expf(b63 + m_c - m_n);
        rq = rqn; ro[0] = ron[0]; ro[1] = ron[1]; denl = denn;
#pragma unroll
        for (int i = 0; i < 4; ++i) numl[i] = numn[i];
    }
#undef MLF_LOAD
    __syncthreads();
}
__device__ __forceinline__ void mlstm_sample_item(const Frame& F, int b, int hh, const bf16* QKR, const bf16* VVb, const bf16* OOb, const float* IFb, bf16* HOb,
                                                  const float* conv_w, const float* conv_b, const float* norm_w, const float* C0, const float* n0, const float* m0p, const float* conv0, float* out) {
    LAS float* L = (LAS float*)F.lds;
    constexpr int LQ = 0, LK = 256, LV = 512, LS = 1024, LQN = 1040, LHS = 1048;
    const int tid = F.tid, lane = F.lane, w = F.wave, row0 = MP + 4 * b;
    float li[4], lf[4];
#pragma unroll
    for (int t = 0; t < 4; ++t) { li[t] = IFb[(size_t)(row0 + t) * 16 + hh]; lf[t] = IFb[(size_t)(row0 + t) * 16 + 8 + hh]; }
    const float m0 = m0p[b * 8 + hh];
    float bc[4], av[4], mt[4], wi[4], wsv[4], ei[4], bm[4];
    { float run = 0.f, pm = -3.0e38f;
#pragma unroll
      for (int t = 0; t < 4; ++t) { run += lf[t]; bc[t] = run; av[t] = li[t] - run; pm = fmaxf(pm, av[t]); mt[t] = fmaxf(run + m0, run + pm); } }
    const float m_new = mt[3], wst = __expf(bc[3] + m0 - m_new);
#pragma unroll
    for (int t = 0; t < 4; ++t) { wi[t] = __expf(bc[t] + m0 - mt[t]); wsv[t] = __expf(bc[3] + av[t] - m_new); ei[t] = __expf(-mt[t]); bm[t] = bc[t] - mt[t]; }
    { const int t = tid >> 7, c = tid & 127, gc = c < 64 ? hh * 64 + c : 512 + hh * 64 + (c - 64);
      float x[4];
#pragma unroll
      for (int j = 0; j < 4; ++j) { const int p = t + j; x[j] = p < 3 ? conv0[(size_t)(b * 3 + p) * D + gc] : bf1(QKR[(size_t)(row0 + p - 3) * D + gc]); }
      float a = conv_b[gc];
#pragma unroll
      for (int j = 0; j < 4; ++j) a += conv_w[j * D + gc] * x[j];
      const float val = siluf_(a);
      if (c < 64) L[LQ + t * 64 + c] = val * 0.125f; else L[LK + t * 64 + (c - 64)] = val;
      if (t >= 1) out[O_S_CONV + (size_t)(b * 3 + t - 1) * D + gc] = x[3];
      L[LV + t * 128 + c] = bf1(VVb[(size_t)(row0 + t) * D + hh * 128 + c]); }
    __syncthreads();
    if (w == 0) { const int pair = lane >> 2, t = pair >> 2, s = pair & 3, part = lane & 3; float dsum = 0.f;
#pragma unroll
        for (int e = 0; e < 16; ++e) dsum += L[LQ + t * 64 + 16 * part + e] * L[LK + s * 64 + 16 * part + e];
        dsum = red4(dsum);
        const float bmt = t == 0 ? bm[0] : (t == 1 ? bm[1] : (t == 2 ? bm[2] : bm[3])), avs = s == 0 ? av[0] : (s == 1 ? av[1] : (s == 2 ? av[2] : av[3]));
        if (part == 0) L[LS + pair] = s <= t ? dsum * __expf(bmt + avs) : 0.f; }
    if (w == 1) { const int t = lane >> 4, part = lane & 15; float dsum = 0.f;
#pragma unroll
        for (int e = 0; e < 4; ++e) dsum += L[LQ + t * 64 + 4 * part + e] * n0[(size_t)(b * 8 + hh) * 64 + 4 * part + e];
        dsum = red16(dsum); if (part == 0) L[LQN + t] = dsum; }
    __syncthreads();
    const int v = tid >> 2, kq = tid & 3;
    float hvv[4];
    { const size_t coff = ((size_t)(b * 8 + hh) * 128 + v) * 64 + 16 * kq;
      float c0[16];
#pragma unroll
      for (int e4 = 0; e4 < 4; ++e4) { const f32x4 x = *(const f32x4*)(C0 + coff + 4 * e4); c0[4 * e4] = x.x; c0[4 * e4 + 1] = x.y; c0[4 * e4 + 2] = x.z; c0[4 * e4 + 3] = x.w; }
#pragma unroll
      for (int t = 0; t < 4; ++t) { float part = 0.f;
#pragma unroll
          for (int e = 0; e < 16; ++e) part += c0[e] * L[LQ + t * 64 + 16 * kq + e];
          const float inter = red4(part);
          float num = wi[t] * inter, den = wi[t] * L[LQN + t];
#pragma unroll
          for (int s = 0; s < 4; ++s) { const float sm = L[LS + t * 4 + s]; num += sm * L[LV + s * 128 + v]; den += sm; }
          hvv[t] = num / fmaxf(fabsf(den), ei[t]); }
#pragma unroll
      for (int t = 0; t < 4; ++t) { const float x = wave_sum(kq == 0 ? hvv[t] * hvv[t] : 0.f); if (lane == 0) L[LHS + w * 4 + t] = x; }
      float cn[16];
#pragma unroll
      for (int e = 0; e < 16; ++e) { float a = wst * c0[e];
#pragma unroll
          for (int s = 0; s < 4; ++s) a += wsv[s] * L[LV + s * 128 + v] * L[LK + s * 64 + 16 * kq + e];
          cn[e] = a; }
#pragma unroll
      for (int e4 = 0; e4 < 4; ++e4) *(f32x4*)(out + O_S_C + coff + 4 * e4) = (f32x4){cn[4 * e4], cn[4 * e4 + 1], cn[4 * e4 + 2], cn[4 * e4 + 3]}; }
    __syncthreads();
    if (kq == 0) {
#pragma unroll
        for (int t = 0; t < 4; ++t) { float tot = 0.f;
#pragma unroll
            for (int ww = 0; ww < 8; ++ww) tot += L[LHS + ww * 4 + t];
            const float sc = 1.0f / sqrtf(tot * (1.f / 128.f) + NORM_EPS); const size_t off = (size_t)(row0 + t) * D + hh * 128 + v;
            HOb[off] = f2bf1(hvv[t] * sc * norm_w[hh * 128 + v] * bf1(OOb[off])); } }
    if (tid < 64) { float a = wst * n0[(size_t)(b * 8 + hh) * 64 + tid];
#pragma unroll
        for (int s = 0; s < 4; ++s) a += wsv[s] * L[LK + s * 64 + tid];
        out[O_S_N + (size_t)(b * 8 + hh) * 64 + tid] = a; }
    if (tid == 0) out[O_S_M + b * 8 + hh] = m_new;
    __syncthreads();
}

constexpr int CA_AH = 0, CA_BH = 9216, CA_KH = 18432, CA_RH = 27648, CA_BT = 36864, CA_KT = 46080, CA_VT = 55296, CA_AB = 64512, CA_AK = 73728, CA_RB = 82944, CA_RK = 92160, CA_XT = 101376,
              CA_TD = 119808, CA_NF = 123904, CA_GL = 128000, CA_LG = CA_AB  , CA_AT = CA_KH  ;
__device__ __forceinline__ bf16x8 ldsfrag(LAS unsigned char* lds, int base, int row, int ks, int fq) { return *(const LAS bf16x8*)(lds + base + row * PBY + ks * 64 + fq * 16); }
__device__ __forceinline__ void rwkv_chunk_item(const Frame& F, int chain, int chunk, bf16* Rb, bf16* Kb, bf16* Vb, bf16* Db, bf16* Ab, bf16* Gb,
                                                const float* k_k, const float* k_a, const float* r_k, float* BON, bf16* dummy, v4u (&pf)[6], const int nchain, const int nchunk) {
    LAS unsigned char* lds = F.lds;
    const int tid = F.tid, lane = F.lane, w = F.wave, fr = lane & 15, fq = lane >> 4, cg = tid & 7, tt = tid >> 3;
    const int h = chain & 15, row0 = (chain >> 4) * PT + 64 * chunk, ch = h * 64 + 8 * cg;
    const size_t goff = (size_t)(row0 + tt) * D + ch;
    LAS float* LG = (LAS float*)(lds + CA_LG); LAS float* GLf = (LAS float*)(lds + CA_GL);
    float r8[8], kp[8], av[8], bv[8], rd[8];
    {
        float k8[8], v8[8], d8[8], a8[8];
        unpack8(pf[0], r8); unpack8(pf[1], k8); unpack8(pf[2], v8); unpack8(pf[3], d8); unpack8(pf[4], a8);
        float ss = 0.f;
#pragma unroll
        for (int j = 0; j < 8; ++j) { av[j] = k8[j] * k_k[ch + j]; ss += av[j] * av[j]; }
        ss = red8(ss); const float inv = __builtin_amdgcn_rsqf(fmaxf(ss, 1e-24f));
        float bsum = 0.f;
#pragma unroll
        for (int j = 0; j < 8; ++j) { const float kk = av[j] * inv; kp[j] = k8[j] * (1.f + (a8[j] - 1.f) * k_a[ch + j]); bv[j] = kk * a8[j]; av[j] = -kk; bsum += r8[j] * kp[j] * r_k[ch + j]; rd[j] = __builtin_amdgcn_rcpf(1.f - d8[j]); }
        const float bon = red8(bsum);
#pragma unroll
        for (int j = 0; j < 8; ++j) { LG[(8 * cg + j) * 64 + tt] = __logf(1.f - d8[j]); ((lds_u16*)(lds + CA_VT))[(8 * cg + j) * 72 + tt] = f2bf1(v8[j]); }
        if (cg == 0 && !dummy) BON[(size_t)(row0 + tt) * 16 + h] = bon;
    }
    for (int i = tid; i < 128 * 9; i += 512) ((LAS v4u*)(lds + CA_XT))[i] = (v4u){0u, 0u, 0u, 0u};
    __syncthreads();
    { float x[8];
#pragma unroll
      for (int q = 0; q < 8; ++q) x[q] = LG[(8 * w + q) * 64 + lane];
#pragma unroll
      for (int q = 0; q < 8; ++q) {
          float v = x[q];
          v += __builtin_bit_cast(float, __builtin_amdgcn_update_dpp(0, __builtin_bit_cast(int, v), 0x111, 0xF, 0xF, true));
          v += __builtin_bit_cast(float, __builtin_amdgcn_update_dpp(0, __builtin_bit_cast(int, v), 0x112, 0xF, 0xF, true));
          v += __builtin_bit_cast(float, __builtin_amdgcn_update_dpp(0, __builtin_bit_cast(int, v), 0x114, 0xF, 0xF, true));
          v += __builtin_bit_cast(float, __builtin_amdgcn_update_dpp(0, __builtin_bit_cast(int, v), 0x118, 0xF, 0xF, true));
          v += __builtin_bit_cast(float, __builtin_amdgcn_update_dpp(0, __builtin_bit_cast(int, v), 0x142, 0xA, 0xF, false));
          v += __builtin_bit_cast(float, __builtin_amdgcn_update_dpp(0, __builtin_bit_cast(int, v), 0x143, 0xC, 0xF, false));
          x[q] = v; }
#pragma unroll
      for (int q = 0; q < 8; ++q) LG[(8 * w + q) * 64 + lane] = x[q]; }
    __syncthreads();
    {
        float ah[8], bh[8], kh[8], rh[8];
#pragma unroll
        for (int j = 0; j < 8; ++j) { const float lg = LG[(8 * cg + j) * 64 + tt]; const float G = __expf(lg), Gm1 = G * rd[j], Gi = __builtin_amdgcn_rcpf(G);
            ah[j] = av[j] * Gm1; bh[j] = bv[j] * Gi; kh[j] = kp[j] * Gi; rh[j] = r8[j] * G;
            ((lds_u16*)(lds + CA_BT))[(8 * cg + j) * 72 + tt] = f2bf1(bh[j]); ((lds_u16*)(lds + CA_KT))[(8 * cg + j) * 72 + tt] = f2bf1(kh[j]);
            if (tt == 63) GLf[8 * cg + j] = G; }
        *(LAS v4u*)(lds + CA_AH + tt * PBY + 16 * cg) = pack8(ah); *(LAS v4u*)(lds + CA_BH + tt * PBY + 16 * cg) = pack8(bh);
        *(LAS v4u*)(lds + CA_KH + tt * PBY + 16 * cg) = pack8(kh); *(LAS v4u*)(lds + CA_RH + tt * PBY + 16 * cg) = pack8(rh);
    }
    __syncthreads();
    {
        const int mi = w >> 1, ti0 = 2 * (w & 1); const int abase = mi < 2 ? CA_AH : CA_RH, bbase = (mi & 1) ? CA_KH : CA_BH, dbase = CA_AB + mi * 9216;
        bf16x8 af[2][2], bfr[4][2];
#pragma unroll
        for (int a = 0; a < 2; ++a)
#pragma unroll
            for (int ks = 0; ks < 2; ++ks) af[a][ks] = ldsfrag(lds, abase, 16 * (ti0 + a) + fr, ks, fq);
#pragma unroll
        for (int sj = 0; sj < 4; ++sj)
#pragma unroll
            for (int ks = 0; ks < 2; ++ks) bfr[sj][ks] = ldsfrag(lds, bbase, 16 * sj + fr, ks, fq);
#pragma unroll
        for (int a = 0; a < 2; ++a)
#pragma unroll
            for (int sj = 0; sj < 4; ++sj) { const int ti = ti0 + a; f32x4 acc = {0.f, 0.f, 0.f, 0.f};
#pragma unroll
                for (int ks = 0; ks < 2; ++ks) acc = MFMA16(bfr[sj][ks], af[a][ks], acc);
                const int t = 16 * ti + fr;
#pragma unroll
                for (int r = 0; r < 4; ++r) { const int s = 16 * sj + 4 * fq + r; acc[r] = (mi < 2 ? s < t : s <= t) ? acc[r] : 0.f; }
                typedef unsigned u2v_ __attribute__((ext_vector_type(2))); u2v_ pw; pw.x = pkbf(acc[0], acc[1]); pw.y = pkbf(acc[2], acc[3]);
                *(LAS u2v_*)(lds + dbase + (t * 72 + 16 * sj + 4 * fq) * 2) = pw;
                if (mi == 0 && ti == sj) *(LAS f32x4*)(lds + CA_NF + (ti * 256 + fr * 16 + 4 * fq) * 4) = acc; }
    }
    __syncthreads();
    f32x4 rhs[4];
    if (w == 0) { const int blk = fq, c = fr; const LAS float* N = (const LAS float*)(lds + CA_NF) + blk * 256; float T[16];
#pragma unroll
        for (int i = 0; i < 16; ++i) { float s = (i == c) ? 1.f : 0.f;
#pragma unroll
            for (int j = 0; j < i; ++j) s += N[i * 16 + j] * T[j];
            T[i] = s; }
        lds_u16* td = (lds_u16*)(lds + CA_TD) + blk * 512;
#pragma unroll
        for (int i = 0; i < 16; ++i) { td[i * 32 + c] = f2bf1(T[i]); td[i * 32 + 16 + c] = 0; } }
    if (w < 4) {
#pragma unroll
        for (int i = 0; i < 4; ++i)
#pragma unroll
            for (int r = 0; r < 4; ++r) rhs[i][r] = bf1(((lds_u16*)(lds + CA_AH))[(16 * i + 4 * fq + r) * 72 + 16 * w + fr]);
    } else {
#pragma unroll
        for (int i = 0; i < 4; ++i) { f32x4 acc = {0.f, 0.f, 0.f, 0.f};
#pragma unroll
            for (int ks = 0; ks < 2; ++ks) acc = MFMA16(ldsfrag(lds, CA_AK, 16 * i + fr, ks, fq), ldsfrag(lds, CA_VT, 16 * (w - 4) + fr, ks, fq), acc);
            rhs[i] = acc; }
    }
    __syncthreads();
    {
        LAS unsigned char* AT = lds + CA_AT + w * 1024;
        *(LAS unsigned long long*)(AT + fr * 64 + 32 + fq * 8) = 0ull;
#pragma unroll
        for (int i = 0; i < 4; ++i) { f32x4 acc = rhs[i];
#pragma unroll
            for (int ks = 0; ks < 2; ++ks) acc = MFMA16(ldsfrag(lds, CA_AB, 16 * i + fr, ks, fq), ldsfrag(lds, CA_XT, 16 * w + fr, ks, fq), acc);
            typedef unsigned u2v __attribute__((ext_vector_type(2)));
            u2v pa; pa.x = pkbf(acc[0], acc[1]); pa.y = pkbf(acc[2], acc[3]);
            *(LAS u2v*)(AT + fr * 64 + fq * 8) = pa;
            asm volatile("s_waitcnt lgkmcnt(0)" ::: "memory");
            f32x4 xi = {0.f, 0.f, 0.f, 0.f};
            xi = MFMA16(*(const LAS bf16x8*)(lds + CA_TD + i * 1024 + fr * 64 + fq * 16), *(const LAS bf16x8*)(AT + fr * 64 + fq * 16), xi);
            u2v px; px.x = pkbf(xi[0], xi[1]); px.y = pkbf(xi[2], xi[3]);
            *(LAS u2v*)(lds + CA_XT + (16 * w + fr) * PBY + (16 * i + 4 * fq) * 2) = px;
            asm volatile("s_waitcnt lgkmcnt(0)" ::: "memory"); }
    }
    __syncthreads();
    if (nchain >= 0) { const size_t no = (size_t)((nchain >> 4) * PT + 64 * nchunk + tt) * D + (nchain & 15) * 64 + 8 * cg;
        pf[0] = *(const v4u*)(Rb + no); pf[1] = *(const v4u*)(Kb + no); pf[2] = *(const v4u*)(Vb + no); pf[3] = *(const v4u*)(Db + no); pf[4] = *(const v4u*)(Ab + no); }
    {
        const int mi = w >> 1, ti0 = 2 * (w & 1); const int obase = mi == 0 ? CA_AB : (mi == 1 ? CA_AK : (mi == 2 ? CA_AH : CA_KH));
        const int a1 = mi < 2 ? CA_RB : (mi == 2 ? CA_BT : CA_XT), a1o = mi == 3 ? 64 : 0, b1 = mi == 3 ? CA_BT : CA_XT, b1o = mi == 1 ? 64 : 0;
        const int a2 = mi == 1 ? CA_RK : CA_VT, b2 = mi == 1 ? CA_VT : CA_KT; const bool two = (mi & 1) != 0;
        bf16x8 af[2][2], bfr[4][2];
#pragma unroll
        for (int a = 0; a < 2; ++a)
#pragma unroll
            for (int ks = 0; ks < 2; ++ks) af[a][ks] = ldsfrag(lds, a1, a1o + 16 * (ti0 + a) + fr, ks, fq);
#pragma unroll
        for (int tj = 0; tj < 4; ++tj)
#pragma unroll
            for (int ks = 0; ks < 2; ++ks) bfr[tj][ks] = ldsfrag(lds, b1, b1o + 16 * tj + fr, ks, fq);
        f32x4 acc[2][4];
#pragma unroll
        for (int a = 0; a < 2; ++a)
#pragma unroll
            for (int tj = 0; tj < 4; ++tj) { acc[a][tj] = (f32x4){0.f, 0.f, 0.f, 0.f};
#pragma unroll
                for (int ks = 0; ks < 2; ++ks) acc[a][tj] = MFMA16(bfr[tj][ks], af[a][ks], acc[a][tj]); }
        if (two) {
#pragma unroll
            for (int a = 0; a < 2; ++a)
#pragma unroll
                for (int ks = 0; ks < 2; ++ks) af[a][ks] = ldsfrag(lds, a2, 16 * (ti0 + a) + fr, ks, fq);
#pragma unroll
            for (int tj = 0; tj < 4; ++tj)
#pragma unroll
                for (int ks = 0; ks < 2; ++ks) bfr[tj][ks] = ldsfrag(lds, b2, 16 * tj + fr, ks, fq);
#pragma unroll
            for (int a = 0; a < 2; ++a)
#pragma unroll
                for (int tj = 0; tj < 4; ++tj)
#pragma unroll
                    for (int ks = 0; ks < 2; ++ks) acc[a][tj] = MFMA16(bfr[tj][ks], af[a][ks], acc[a][tj]);
        }
#pragma unroll
        for (int a = 0; a < 2; ++a) { const int row = 16 * (ti0 + a) + fr; const float glr = GLf[row];
#pragma unroll
            for (int tj = 0; tj < 4; ++tj) { const int col = 16 * tj + 4 * fq; f32x4 val = acc[a][tj];
                typedef unsigned u2v_ __attribute__((ext_vector_type(2)));
                if (mi == 0) { const u2v_ rr = *(const LAS u2v_*)(lds + CA_RH + (row * 72 + col) * 2); val += (f32x4){bflo(rr.x), bfhi(rr.x), bflo(rr.y), bfhi(rr.y)}; }
                else if (mi == 2) {
#pragma unroll
                    for (int r = 0; r < 4; ++r) val[r] = glr * (val[r] + (row == col + r ? 1.f : 0.f)); }
                else if (mi == 3) val = val * *(const LAS f32x4*)(GLf + col);
                u2v_ pw; pw.x = pkbf(val[0], val[1]); pw.y = pkbf(val[2], val[3]);
                *(LAS u2v_*)(lds + obase + (row * 72 + col) * 2) = pw; } }
    }
    __syncthreads();
    *(v4u*)((dummy ? dummy : Rb) + goff) = *(const LAS v4u*)(lds + CA_AB + tt * PBY + 16 * cg);
    *(v4u*)((dummy ? dummy : Ab) + goff) = *(const LAS v4u*)(lds + CA_AK + tt * PBY + 16 * cg);
    *(v4u*)((dummy ? dummy : Kb) + goff) = *(const LAS v4u*)(lds + CA_AH + tt * PBY + 16 * cg);
    *(v4u*)((dummy ? dummy : Db) + goff) = *(const LAS v4u*)(lds + CA_KH + tt * PBY + 16 * cg);
    __syncthreads();
}
constexpr int CB_S = 0, CB_P2 = 9216, CB_P3 = 18432, CB_Y0 = 27648, CB_Z0 = 36864, CB_YS = 46080  ;
__device__ __forceinline__ void rwkv_state_chain(const Frame& F, int chain, float* ST, const bf16* Rb, const bf16* Kb, const bf16* Vb, const bf16* Db, const bf16* Ab, bf16* Gb, const float* BON, const float* gn_w, const float* gn_b, bf16* dummy) {
    LAS unsigned char* lds = F.lds;
    const int tid = F.tid, lane = F.lane, w = F.wave, fr = lane & 15, fq = lane >> 4, cg = tid & 7, tt = tid >> 3;
    const int h = chain & 15, rowc0 = (chain >> 4) * PT, ch = h * 64 + 8 * cg;
    for (int i = tid; i < 64 * 36; i += 512) ((LAS unsigned*)(lds + CB_S))[i] = 0u;
    f32x4 Sacc[2];
    Sacc[0] = (f32x4){0.f, 0.f, 0.f, 0.f}; Sacc[1] = Sacc[0];
    v4u q2, q3, qy, qz, qg, qb; float qbon;
    float cgw[8], cgb[8];
#pragma unroll
    for (int j = 0; j < 8; ++j) { cgw[j] = gn_w[ch + j]; cgb[j] = gn_b[ch + j]; }
#define CB_LOAD(cc) do { const size_t o_ = (size_t)(rowc0 + 64 * (cc) + tt) * D + ch; q2 = *(const v4u*)(Rb + o_); q3 = *(const v4u*)(Kb + o_); qy = *(const v4u*)(Ab + o_); qz = *(const v4u*)(Db + o_); \
        qg = *(const v4u*)(Gb + o_); qb = *(const v4u*)(Vb + o_); qbon = BON[(size_t)(rowc0 + 64 * (cc) + tt) * 16 + h]; } while (0)
    CB_LOAD(0);
    for (int c = 0; c < PT / 64; ++c) {
        *(LAS v4u*)(lds + CB_P2 + tt * PBY + 16 * cg) = q2; *(LAS v4u*)(lds + CB_P3 + tt * PBY + 16 * cg) = q3;
        *(LAS v4u*)(lds + CB_Y0 + tt * PBY + 16 * cg) = qy; *(LAS v4u*)(lds + CB_Z0 + tt * PBY + 16 * cg) = qz;
        float gw[8], gb[8]; unpack8(qg, gw); unpack8(qb, gb);
        const float bonc = qbon;
        if (c + 1 < PT / 64) CB_LOAD(c + 1);
        __syncthreads();
        f32x4 yacc[2];
        typedef unsigned u2v_ __attribute__((ext_vector_type(2)));
#pragma unroll
        for (int q = 0; q < 2; ++q) { const int tq = 2 * w + q, ti = tq >> 2, tj = tq & 3, row = 16 * ti + fr, col = 16 * tj + 4 * fq;
            const u2v_ y0 = *(const LAS u2v_*)(lds + CB_Y0 + (row * 72 + col) * 2), z0 = *(const LAS u2v_*)(lds + CB_Z0 + (row * 72 + col) * 2);
            f32x4 ya = {bflo(y0.x), bfhi(y0.x), bflo(y0.y), bfhi(y0.y)}, sa = {bflo(z0.x), bfhi(z0.x), bflo(z0.y), bfhi(z0.y)};
#pragma unroll
            for (int ks = 0; ks < 2; ++ks) { ya = MFMA16(ldsfrag(lds, CB_S, 16 * tj + fr, ks, fq), ldsfrag(lds, CB_P2, 16 * ti + fr, ks, fq), ya);
                                             sa = MFMA16(ldsfrag(lds, CB_P3, 16 * tj + fr, ks, fq), ldsfrag(lds, CB_S, 16 * ti + fr, ks, fq), sa); }
            yacc[q] = ya; Sacc[q] = sa; }
        __syncthreads();
#pragma unroll
        for (int q = 0; q < 2; ++q) { const int tq = 2 * w + q, ti = tq >> 2, tj = tq & 3, row = 16 * ti + fr, col = 16 * tj + 4 * fq;
            u2v_ pw; pw.x = pkbf(Sacc[q][0], Sacc[q][1]); pw.y = pkbf(Sacc[q][2], Sacc[q][3]);
            *(LAS u2v_*)(lds + CB_S + (row * 72 + col) * 2) = pw;
            *(LAS f32x4*)(lds + CB_YS + (row * 64 + col) * 4) = yacc[q]; }
        __syncthreads();
        { const f32x4 y0 = *(const LAS f32x4*)(lds + CB_YS + (tt * 64 + 8 * cg) * 4), y1 = *(const LAS f32x4*)(lds + CB_YS + (tt * 64 + 8 * cg + 4) * 4);
          float yy[8] = {y0.x, y0.y, y0.z, y0.w, y1.x, y1.y, y1.z, y1.w}; float s1 = 0.f;
#pragma unroll
          for (int j = 0; j < 8; ++j) s1 += yy[j];
          const float mean = red8(s1) * (1.f / 64.f); float s2 = 0.f;
#pragma unroll
          for (int j = 0; j < 8; ++j) { yy[j] -= mean; s2 += yy[j] * yy[j]; }
          const float rstd = __builtin_amdgcn_rsqf(red8(s2) * (1.f / 64.f) + GN_EPS);
          float o[8];
#pragma unroll
          for (int j = 0; j < 8; ++j) o[j] = ((yy[j] * rstd) * cgw[j] + cgb[j] + bonc * gb[j]) * gw[j];
          *(v4u*)((dummy ? dummy : Gb) + (size_t)(rowc0 + 64 * c + tt) * D + ch) = pack8(o); }
    }
#undef CB_LOAD
#pragma unroll
    for (int q = 0; q < 2; ++q) { const int tq = 2 * w + q, ti = tq >> 2, tj = tq & 3; *(f32x4*)(ST + (16 * ti + fr) * 64 + 16 * tj + 4 * fq) = Sacc[q]; }
    __syncthreads();
}

#ifndef MK_N_LAUNCHES
#define MK_N_LAUNCHES 1
#endif
constexpr int N_PHASES = 22;
#ifndef PROBE_PH
#define PROBE_PH (-1)
#define PROBE_N 1
#endif
#ifndef PROBE_VAR
#define PROBE_VAR 0
#endif
#ifndef EN_MASK
#define EN_MASK 0xff
#endif
constexpr bool EN_NORM = EN_MASK & 1, EN_UP = EN_MASK & 2, EN_RES = EN_MASK & 4, EN_RW = EN_MASK & 8, EN_L2 = EN_MASK & 16, EN_SCAN = EN_MASK & 32, EN_IN = EN_MASK & 64, EN_ML = EN_MASK & 128;
struct Args { const float* in[N_IN]; float* out; unsigned char* ws; int ph_lo, ph_hi; };
__global__ void __launch_bounds__(NWAVES * 64, 2) mega_fwd(Args args) {
    extern __shared__ __attribute__((aligned(16))) unsigned char lds_raw[];
    { const int t0 = threadIdx.x;
      for (int u = t0; u < (LDS_BYTES - LDSCTL_OFF) / 4; u += NWAVES * 64) ((LAS unsigned*)((LAS unsigned char*)lds_raw + LDSCTL_OFF))[u] = 0u; }
    __syncthreads();
    { const int t0 = threadIdx.x; if (t0 < N_IN) ((LAS unsigned long long*)((LAS unsigned char*)lds_raw + TAB_OFF))[t0] = (unsigned long long)args.in[t0]; }
    __syncthreads();
    XcdBarrier bar; bar.bar = (unsigned*)((gu32*)(args.ws + WS_CTL) + CW_BAR); bar.x = 0; bar.st = nullptr;
    if (args.ph_hi - args.ph_lo > 1) bar = xcd_barrier_post((unsigned*)((gu32*)(args.ws + WS_CTL) + CW_BAR), (volatile LAS unsigned*)((LAS unsigned char*)lds_raw + MISC_OFF) + 8);
    int ph = args.ph_lo, rep = 0;
    while (ph < args.ph_hi) {
        int tid_ = threadIdx.x; asm volatile("" : "+v"(tid_));
        unsigned char* ws = args.ws; float* out = args.out;
        Frame F;
        F.lds = (LAS unsigned char*)lds_raw;
        F.MISC = (volatile LAS unsigned*)(F.lds + MISC_OFF);
        F.tid = tid_; F.lane = F.tid & 63; F.wave = __builtin_amdgcn_readfirstlane(F.tid >> 6);
        F.G = gridDim.x; { const int bx = blockIdx.x; F.vcu = (F.G % 8 == 0) ? (bx % 8) * (F.G / 8) + bx / 8 : bx; }
        F.ctl = (gu32*)(ws + WS_CTL); F.tab = (volatile LAS unsigned long long*)(F.lds + TAB_OFF);
        bf16* Wb = (bf16*)(ws + WS_W); bf16* XR = (bf16*)(ws + WS_XR); unsigned char* big = ws + WS_BIG;
        bf16* Hb = (bf16*)(big + B_H); bf16* XN = (bf16*)(big + B_XN); float* SLAB = (float*)(big + B_SLAB);
        bf16* ACAT = (bf16*)(big + B_ACAT); bf16* Rb = (bf16*)(big + B_R); bf16* Kb = (bf16*)(big + B_K); bf16* Vb = (bf16*)(big + B_V); bf16* DECb = (bf16*)(big + B_DEC); bf16* AAb = (bf16*)(big + B_AA);
        bf16* QKR = (bf16*)(big + B_QKR); bf16* VVb = (bf16*)(big + B_VV); bf16* HOb = (bf16*)(big + B_HO); bf16* OOb = (bf16*)(big + B_OO); float* IFb = (float*)(big + B_IF);
        bf16* GGb = (bf16*)((unsigned char*)out + OS_GG); bf16* LORA = (bf16*)((unsigned char*)out + OS_LORA);
        const int c_id = (int)blockIdx.x;
        const int nrep = (ph == PROBE_PH && ph != 6 && !(ph == 16 && PROBE_VAR != 0)) ? PROBE_N : 1;
        const int pvar = (rep + 1 < nrep) ? PROBE_VAR : 0;
        if (EN_NORM && (ph == 0 || ph == 3 || ph == 8 || ph == 11 || ph == 14 || ph == 18 || ph == 21)) {
            int kind = 0, layer = 0, ab = 0, nslab = 0; float coef = 0.5f; const float* gain = nullptr;
            if (ph == 0) { kind = 0; layer = 0; ab = 0; gain = inptr(F, I_NFA); nslab = 0; }
            else if (ph == 3) { kind = 1; gain = inptr(F, I_NMIX); nslab = 11; }
            else if (ph == 8) { kind = 0; layer = 0; ab = 1; gain = inptr(F, I_NFB); nslab = 4; coef = 1.f; }
            else if (ph == 11) { kind = 0; layer = 1; ab = 0; gain = inptr(F, I_NFA) + D; nslab = 11; }
            else if (ph == 14) { kind = 2; gain = inptr(F, I_NMIX) + D; nslab = 11; }
            else if (ph == 18) { kind = -1; gain = inptr(F, I_NFB) + D; nslab = 4; coef = 1.f; }
            else { kind = -1; gain = inptr(F, I_NFIN); nslab = 11; }
            if (kind >= 0) convert_weights(F, kind, layer, ab, Wb);
            if (ph == 0) norm_rows<0, true, true>(F, inptr(F, I_XP), inptr(F, I_XS), nslab, coef, SLAB, XR, gain, XN, nullptr, out, pvar);
            else if (ph == 3) mix_rows(F, XR, inptr(F, I_XS), nslab, coef, SLAB, XR, gain, inptr(F, I_MU), (bf16*)(ws + WS_XM), inptr(F, I_RSHIFT), out, pvar);
            else if (ph == 21) norm_rows<2, false, false>(F, XR, XR + (size_t)MP * D, nslab, coef, SLAB, XR, gain, nullptr, nullptr, out, pvar);
            else norm_rows<0, false, false>(F, XR, XR + (size_t)MP * D, nslab, coef, SLAB, XR, gain, XN, nullptr, out, pvar);
        } else if (EN_UP && (ph == 1 || ph == 9 || ph == 12 || ph == 19)) {
            const bf16* Wu = ph == 19 ? (const bf16*)(ws + WS_W2) : Wb;
            pg8::Gemm g{XN, Wu + W_GU / 2, M, 2 * FF, D}; pg8::UnitOrder S; S.init(M / 256, 2 * FF / 256, D, F.G, c_id, 0);
            EpiSwiglu E{Hb, pvar};
            pg8::gemm_phase<EpiSwiglu, pg8::UnitOrder, true, true>(F.lds, g, S, E, F.tid);
        } else if (EN_RES && (ph == 2 || ph == 7 || ph == 10 || ph == 13 || ph == 17 || ph == 20)) {
            const bf16* A = Hb; const bf16* Bt = (ph == 20 ? (const bf16*)(ws + WS_W2) : Wb) + W_D / 2; int K = FF; float coef = 0.5f; const float* basef = nullptr;
            if (ph == 2) basef = inptr(F, I_XP);
            if (ph == 7) { A = GGb; Bt = Wb + W_O / 2; K = D; coef = 1.f; }
            if (ph == 17) { A = HOb; Bt = Wb + W_OUT / 2; K = D; coef = 1.f; }
            pg8::Gemm g{A, Bt, M, D, K}; pg8::UnitOrder S; S.init(MP / 256, D / 256, K, F.G, c_id, K / 256);
            EpiRes E{basef, XR, XR, SLAB, coef};
            pg8::gemm_phase<EpiRes, pg8::UnitOrder, true, true>(F.lds, g, S, E, F.tid);
        } else if (EN_RW && ph == 4) {
            pg8::Gemm g{(const bf16*)(ws + WS_XM), Wb + W_RW / 2, 6 * M, NRW2, D}; pg8::UnitOrder S; S.init(M / 256, NRW2 / 256, D, F.G, c_id, -2);
            EpiRw E{Rb, Kb, Vb, LORA};
            pg8::gemm_phase<EpiRw, pg8::UnitOrder, true, true>(F.lds, g, S, E, F.tid);
        } else if (EN_L2 && ph == 5) {
            pg8::Gemm g{LORA, Wb + W_L2 / 2, M, NL2, KL2}; pg8::UnitOrder S; S.init(M / 256, NL2 / 256, KL2, F.G, c_id, -1);
            EpiL2 E{DECb, AAb, GGb, inptr(F, I_W0), inptr(F, I_A0)};
            pg8::gemm_phase<EpiL2, pg8::UnitOrder, true, true>(F.lds, g, S, E, F.tid);
        } else if (EN_SCAN && ph == 6) {
            bf16* dummy = (bf16*)(ws + WS_YRAW);
            for (int dr = (PROBE_PH == 6 && PROBE_VAR == 5) ? PROBE_N - 1 : 0; dr >= 0; --dr) {
                v4u pf[6]; pf[5] = (v4u){0u, 0u, 0u, 0u};
                { const int it = F.vcu, cg_ = F.tid & 7, tt_ = F.tid >> 3; const size_t o = (size_t)(((it >> 5) >> 4) * PT + 64 * (it & 31) + tt_) * D + ((it >> 5) & 15) * 64 + 8 * cg_;
                  pf[0] = *(const v4u*)(Rb + o); pf[1] = *(const v4u*)(Kb + o); pf[2] = *(const v4u*)(Vb + o); pf[3] = *(const v4u*)(DECb + o); pf[4] = *(const v4u*)(AAb + o); }
                for (int it = F.vcu; it < PB * 16 * (PT / 64); it += F.G) { const int nx = it + F.G < PB * 16 * (PT / 64) ? it + F.G : -1;
                    rwkv_chunk_item(F, it >> 5, it & 31, Rb, Kb, Vb, DECb, AAb, GGb, inptr(F, I_KK), inptr(F, I_KA), inptr(F, I_RK), (float*)(ws + WS_BON), dr ? dummy : nullptr, pf, nx < 0 ? -1 : nx >> 5, nx & 31); }
            }
            xcd_barrier(bar);
            for (int dr = (PROBE_PH == 6 && PROBE_VAR == 6) ? PROBE_N - 1 : 0; dr >= 0; --dr)
                if (F.vcu < 128) rwkv_state_chain(F, F.vcu, out + O_P_S + (size_t)F.vcu * 4096, Rb, Kb, Vb, DECb, AAb, GGb, (const float*)(ws + WS_BON), inptr(F, I_GNW), inptr(F, I_GNB), dr ? dummy : nullptr);
            { const int i0 = F.vcu < 128 ? 2 * F.vcu : 256 + 14 * (F.vcu - 128), i1 = F.vcu < 128 ? i0 + 2 : i0 + 14;
              for (int i = i0; i < i1; ++i) { const int b = i >> 4, h = i & 15;
                  rwkv_chain(F, MP + b * STK, STK, h, inptr(F, I_RS) + (size_t)i * 4096, out + O_S_S + (size_t)i * 4096, Rb, Kb, Vb, DECb, AAb, GGb, inptr(F, I_KK), inptr(F, I_KA), inptr(F, I_RK), inptr(F, I_GNW), inptr(F, I_GNB), true, 0); } }
        } else if (EN_IN && ph == 15) {
            pg8::Gemm g{XN, Wb + W_IN / 2, M, NIN, D}; pg8::UnitOrder S; S.init(M / 256, NIN / 256, D, F.G, c_id, 0);
            EpiIn E{QKR, VVb, OOb, IFb, inptr(F, I_BIF), pvar};
            pg8::gemm_phase<EpiIn, pg8::UnitOrder, true, true>(F.lds, g, S, E, F.tid);
        } else if (EN_ML && ph == 16) {
            float* NUM = out + O_Y; float* DEN = (float*)(ws + WS_BON); bf16* Qs = (bf16*)(big + 100 * MiB)  ; float* SEG = (float*)(ws + WS_YRAW);
            for (int i = F.vcu; i < PB * 8 * ML_NSEG * ((PROBE_PH == 16 && PROBE_VAR == 1) ? PROBE_N : 1); i += F.G) { const int chain = i & 63, seg = (i >> 6) & 3;
                mlstm_prompt_chain(F, chain >> 3, chain & 7, seg, QKR, VVb, OOb, IFb, HOb, inptr(F, I_CW), inptr(F, I_CB), inptr(F, I_MNW), NUM, DEN, Qs, SEG, 0); }
            xcd_barrier(bar);
            for (int i = F.vcu; i < 256 * ((PROBE_PH == 16 && PROBE_VAR == 2) ? PROBE_N : 1) - 64; i += F.G) { const int chain = i & 63, seg = 1 + ((i >> 6) & 3); if (seg > 3) continue;
                mlstm_fix_seg(F, chain >> 3, chain & 7, seg, QKR, OOb, IFb, HOb, inptr(F, I_MNW), NUM, DEN, Qs, SEG, out); }
            if (F.G == 256) {
                if (F.vcu >= 192) { for (int j = 0; j < 9; ++j) { const int i = (F.vcu - 192) * 9 + j;
                    mlstm_sample_item(F, i >> 3, i & 7, QKR, VVb, OOb, IFb, HOb, inptr(F, I_CW), inptr(F, I_CB), inptr(F, I_MNW), inptr(F, I_MC), inptr(F, I_MN), inptr(F, I_MM), inptr(F, I_MCONV), out); } }
                else { for (int i = 576 + F.vcu; i < SB * 8; i += 192)
                    mlstm_sample_item(F, i >> 3, i & 7, QKR, VVb, OOb, IFb, HOb, inptr(F, I_CW), inptr(F, I_CB), inptr(F, I_MNW), inptr(F, I_MC), inptr(F, I_MN), inptr(F, I_MM), inptr(F, I_MCONV), out); }
            } else {
                for (int i = F.vcu; i < SB * 8; i += F.G)
                    mlstm_sample_item(F, i >> 3, i & 7, QKR, VVb, OOb, IFb, HOb, inptr(F, I_CW), inptr(F, I_CB), inptr(F, I_MNW), inptr(F, I_MC), inptr(F, I_MN), inptr(F, I_MM), inptr(F, I_MCONV), out);
            }
            if (rep + 1 == nrep) convert_weights(F, 0, 1, 1, (bf16*)(ws + WS_W2));
        }
        if (++rep < nrep) continue;
        rep = 0;
        if (ph + 1 < args.ph_hi) xcd_barrier(bar);
        ++ph;
    }
}

extern "C" void kernel_launch(void* const* d_in, const int* in_sizes, int n_in, void* d_out, int out_size, void* d_ws, size_t ws_size, hipStream_t stream) {
    static int grid = 0;
    if (grid == 0) {
        if (n_in != N_IN || out_size != (int)O_END || ws_size < WS_END3) { fprintf(stderr, "kernel_launch: unexpected shapes (n_in %d, out %d, ws %zu); nothing launched\n", n_in, out_size, ws_size); grid = -1; return; }
        int dev = 0, cus = 0, per_cu = 0;
        if (hipGetDevice(&dev) != hipSuccess || hipDeviceGetAttribute(&cus, hipDeviceAttributeMultiprocessorCount, dev) != hipSuccess) { grid = -1; return; }
        if (hipFuncSetAttribute((const void*)mega_fwd, hipFuncAttributeMaxDynamicSharedMemorySize, LDS_BYTES) != hipSuccess) { fprintf(stderr, "kernel_launch: hipFuncSetAttribute failed\n"); grid = -1; return; }
        if (hipOccupancyMaxActiveBlocksPerMultiprocessor(&per_cu, (const void*)mega_fwd, NWAVES * 64, LDS_BYTES) != hipSuccess || per_cu < 1) { fprintf(stderr, "kernel_launch: occupancy query says %d\n", per_cu); per_cu = 1; }
        (void)hipGetLastError();
        grid = cus;
    }
    if (grid < 0) return;
    (void)hipMemsetAsync((char*)d_ws + WS_CTL, 0, CTL_ZERO_BYTES, stream);
    Args a{};
    for (int i = 0; i < N_IN; ++i) a.in[i] = (const float*)d_in[i];
    a.out = (float*)d_out; a.ws = (unsigned char*)d_ws;
#if MK_N_LAUNCHES == 1
    a.ph_lo = 0; a.ph_hi = N_PHASES;
    { void* kargs[] = {(void*)&a};
      const hipError_t e = hipLaunchCooperativeKernel((const void*)mega_fwd, dim3(grid), dim3(NWAVES * 64), kargs, LDS_BYTES, stream);
      if (e != hipSuccess) fprintf(stderr, "kernel_launch: cooperative launch failed: %s (grid %d)\n", hipGetErrorString(e), grid); }
#else
    for (int p = 0; p < N_PHASES; ++p) { a.ph_lo = p; a.ph_hi = p + 1; hipLaunchKernelGGL(mega_fwd, dim3(grid), dim3(NWAVES * 64), LDS_BYTES, stream, a); }
#endif
}
```

```cpp
#include <hip/hip_runtime.h>
#include <cstdio>
#include <cstdint>
namespace pg8 {
#define PG8_LAS __attribute__((address_space(3)))
typedef unsigned short bf16_t;
typedef short bf16x8 __attribute__((ext_vector_type(8)));
typedef float f32x4 __attribute__((ext_vector_type(4)));
typedef unsigned u32x4 __attribute__((ext_vector_type(4)));
constexpr int BM = 256, BK = 64, HALF = 128, HTB = HALF * BK * 2  , STAGE_BYTES = 8 * HTB, NXCD = 8, WGM = 8;

__host__ __device__ __forceinline__ int lds_byte(int r, int c) { const int st = (r >> 4) * 2 + (c >> 5), rr = r & 15, cc = c & 31, ob = rr * 64 + cc * 2; return st * 1024 + (ob ^ (((ob >> 9) & 1) << 5)); }
__host__ __device__ __forceinline__ void stage_rc(int b, int& R, int& C) { const int st = b / 1024, sb = b % 1024, swz = sb ^ (((sb >> 9) & 1) << 5); R = (st >> 1) * 16 + swz / 64; C = (st & 1) * 32 + (swz % 64) / 2; }
__host__ __device__ __forceinline__ int perm32(int rho) { const int n = rho >> 4, i = rho & 15; return 8 * (i >> 2) + 4 * n + (i & 3); }

struct Unit { int pm, pn, k0, nt, slab; };
struct Gemm { const bf16_t* A; const bf16_t* Bt; int M, N, K; };

struct UnitOrder {
    int nM, nN, nwg, G, c, ntf, tailS;
    __device__ __forceinline__ void init(int nM_, int nN_, int K, int G_, int c_, int tailS_) { nM = nM_; nN = nN_; nwg = nM * nN; G = G_; c = c_; ntf = K / BK; tailS = tailS_; }
    __device__ __forceinline__ bool next(int i, Unit& u) const {
        long L = (long)i * G + c;
        if (L < nwg) {
            int wgid = (int)L; { const int q = nwg / NXCD, r = nwg % NXCD, xcd = wgid % NXCD, off = wgid / NXCD; wgid = (xcd < r ? xcd * (q + 1) : r * (q + 1) + (xcd - r) * q) + off; }
            const int nig = WGM * nN, gid = wgid / nig, fm = gid * WGM, gsz = (nM - fm) < WGM ? (nM - fm) : WGM;
            u.pm = fm + ((wgid % nig) % gsz); u.pn = (wgid % nig) / gsz; u.k0 = 0; u.nt = ntf; u.slab = -1;
            if (tailS == -2) u.pm += nM * (u.pn < 12 ? (u.pn >> 2) : u.pn - 9);
            if (tailS == -1) { u.nt = 4; u.k0 = u.pn >= 8 ? 128 : 0; }
            return true;
        }
        L -= nwg; if (tailS <= 0 || L >= 8 * tailS) return false;
        int tile, sl; if (tailS == 4) { tile = (int)L >> 2; sl = (int)L & 3; } else { tile = (int)L / 11; sl = (int)L - 11 * tile; }
        u.pm = 64 + (tile >> 2); u.pn = tile & 3; u.k0 = sl * 256; u.nt = 4; u.slab = sl; return true;
    }
    __device__ __forceinline__ void a_ready(const Unit&) const {}
    __device__ __forceinline__ void done(const Unit&) const {}
};
template <class Epi, class Sched, bool ALIGN_EPI = false, bool SP2 = false>
__device__ __forceinline__ void gemm_phase(PG8_LAS unsigned char* lds, const Gemm g, const Sched& S, const Epi& E, const int tid) {
    const int wid = __builtin_amdgcn_readfirstlane(tid >> 6), lane = tid & 63, wr = wid >> 2, wc = wid & 3, fr = lane & 15, fq = lane >> 4;
    const int K = g.K;
    unsigned voffA[2], voffB[2];
#pragma unroll
    for (int i = 0; i < 2; ++i) { int R, C; stage_rc(tid * 16 + i * 8192, R, C); const int Rb = Epi::PERM ? ((R & ~31) + perm32(R & 31)) : R;
        voffA[i] = (unsigned)(R * K + C) * 2u; voffB[i] = (unsigned)(Rb * K + C) * 2u; }
    const size_t kstep = (size_t)(BK * 2);
    const size_t hstep = (size_t)HALF * K * 2;
    const size_t tstep = 2 * hstep;
    const unsigned ldsw = (unsigned)wid * 1024u;
    const int aoff = lds_byte(wr * 64 + fr, fq * 8), boff = lds_byte(wc * 32 + fr, fq * 8);
#define PG8_SA(b, h) (((b) * 2 + (h)) * HTB)
#define PG8_SB(b, h) ((4 + (b) * 2 + (h)) * HTB)
#define PG8_STAGE(bufoff, gbase, voff) do { _Pragma("unroll") for (int _i = 0; _i < 2; ++_i) \
        __builtin_amdgcn_global_load_lds((const unsigned*)((const char*)(gbase) + (voff)[_i]), (PG8_LAS unsigned*)(lds + (bufoff) + ldsw + _i * 8192), 16, 0, 0); } while (0)
#define PG8_LDA(dst, b, h) do { _Pragma("unroll") for (int m = 0; m < 4; ++m) _Pragma("unroll") for (int k = 0; k < 2; ++k) dst[m][k] = *(const PG8_LAS bf16x8*)(lds + PG8_SA(b, h) + aoff + m * 2048 + k * 1024); } while (0)
#define PG8_LDB(dst, b, h) do { _Pragma("unroll") for (int n = 0; n < 2; ++n) _Pragma("unroll") for (int k = 0; k < 2; ++k) dst[n][k] = *(const PG8_LAS bf16x8*)(lds + PG8_SB(b, h) + boff + n * 2048 + k * 1024); } while (0)
#define PG8_MMA(ai, bj, At, Bt) do { __builtin_amdgcn_s_setprio(1); _Pragma("unroll") for (int m = 0; m < 4; ++m) _Pragma("unroll") for (int n = 0; n < 2; ++n) _Pragma("unroll") for (int k = 0; k < 2; ++k) \
        acc[ai][bj][m][n] = __builtin_amdgcn_mfma_f32_16x16x32_bf16(Bt[n][k], At[m][k], acc[ai][bj][m][n], 0, 0, 0); __builtin_amdgcn_s_setprio(0); } while (0)
#define PG8_WAIT_V(n) asm volatile("s_waitcnt vmcnt(" #n ")" ::: "memory")
#define PG8_WAIT_L(n) asm volatile("s_waitcnt lgkmcnt(" #n ")" ::: "memory")
#define PG8_BAR __builtin_amdgcn_s_barrier()
#define PG8_SCHED __builtin_amdgcn_sched_barrier(0)
    Unit cur, nxt; int ui = 0;
    if (!S.next(0, cur)) return;
    f32x4 acc[2][2][4][2];
#pragma unroll
    for (int a = 0; a < 2; ++a)
#pragma unroll
        for (int b = 0; b < 2; ++b)
#pragma unroll
            for (int m = 0; m < 4; ++m)
#pragma unroll
                for (int n = 0; n < 2; ++n) acc[a][b][m][n] = (f32x4){0.f, 0.f, 0.f, 0.f};
    bf16x8 At[4][2], B0[2][2], B1[2][2];
    const char* cA = (const char*)g.A + (size_t)cur.pm * tstep + (size_t)cur.k0 * 2; const char* cB = (const char*)g.Bt + (size_t)cur.pn * tstep + (size_t)cur.k0 * 2;
    S.a_ready(cur);
    if constexpr (SP2) {
        PG8_STAGE(PG8_SB(0, 0), cB, voffB); PG8_STAGE(PG8_SB(0, 1), cB + hstep, voffB); PG8_STAGE(PG8_SA(0, 0), cA, voffA); PG8_STAGE(PG8_SA(0, 1), cA + hstep, voffA);
        if (wr == 1) PG8_BAR;
        PG8_WAIT_V(2); PG8_BAR;
        PG8_STAGE(PG8_SB(1, 0), cB + kstep, voffB); PG8_STAGE(PG8_SA(1, 0), cA + kstep, voffA); PG8_STAGE(PG8_SB(1, 1), cB + hstep + kstep, voffB);
        PG8_WAIT_V(6); PG8_BAR;
    } else {
        PG8_STAGE(PG8_SB(0, 0), cB, voffB); PG8_STAGE(PG8_SA(0, 0), cA, voffA); PG8_STAGE(PG8_SB(0, 1), cB + hstep, voffB); PG8_STAGE(PG8_SA(0, 1), cA + hstep, voffA);
        if (wr == 1) PG8_BAR;
        PG8_WAIT_V(4); PG8_BAR;
        PG8_STAGE(PG8_SB(1, 0), cB + kstep, voffB); PG8_STAGE(PG8_SA(1, 0), cA + kstep, voffA); PG8_STAGE(PG8_SB(1, 1), cB + hstep + kstep, voffB);
        PG8_WAIT_V(6); PG8_BAR;
    }
    for (;;) {
        const bool has_next = S.next(ui + 1, nxt);
        const char* nA = has_next ? (const char*)g.A + (size_t)nxt.pm * tstep + (size_t)nxt.k0 * 2 : cA; const char* nB = has_next ? (const char*)g.Bt + (size_t)nxt.pn * tstep + (size_t)nxt.k0 * 2 : cB;
        const int nt = cur.nt;
        for (int t = 0; t < nt; t += 2) {
            const bool last = (t == nt - 2);
            const char* a1 = cA + (size_t)(t + 1) * kstep;
            const char* a2 = last ? nA : cA + (size_t)(t + 2) * kstep; const char* b2 = last ? nB : cB + (size_t)(t + 2) * kstep;
            const char* a3 = a2 + kstep; const char* b3 = b2 + kstep;
            if (last && has_next) S.a_ready(nxt);
            if constexpr (SP2) {
            PG8_LDB(B0, 0, 0); PG8_LDB(B1, 0, 1); PG8_SCHED; PG8_LDA(At, 0, 0); PG8_STAGE(PG8_SA(1, 1), a1 + hstep, voffA);
            PG8_WAIT_V(8); PG8_WAIT_L(0); PG8_BAR; PG8_MMA(0, 0, At, B0); PG8_MMA(0, 1, At, B1); PG8_BAR; PG8_SCHED;
            PG8_LDA(At, 0, 1); PG8_STAGE(PG8_SB(0, 0), b2, voffB); PG8_STAGE(PG8_SB(0, 1), b2 + hstep, voffB); PG8_STAGE(PG8_SA(0, 0), a2, voffA);
            PG8_WAIT_V(8); PG8_WAIT_L(0); PG8_BAR; PG8_MMA(1, 0, At, B0); PG8_MMA(1, 1, At, B1); PG8_BAR; PG8_SCHED;
            PG8_LDB(B0, 1, 0); PG8_LDB(B1, 1, 1); PG8_SCHED; PG8_LDA(At, 1, 0); PG8_STAGE(PG8_SA(0, 1), a2 + hstep, voffA);
            PG8_WAIT_V(8); PG8_WAIT_L(0); PG8_BAR; PG8_MMA(0, 0, At, B0); PG8_MMA(0, 1, At, B1); PG8_BAR; PG8_SCHED;
            PG8_LDA(At, 1, 1); PG8_STAGE(PG8_SB(1, 0), b3, voffB); PG8_STAGE(PG8_SB(1, 1), b3 + hstep, voffB); PG8_STAGE(PG8_SA(1, 0), a3, voffA);
            PG8_WAIT_V(8); PG8_WAIT_L(0); PG8_BAR; PG8_MMA(1, 0, At, B0); PG8_MMA(1, 1, At, B1); PG8_BAR; PG8_SCHED;
            } else {
            PG8_LDB(B0, 0, 0); PG8_SCHED; PG8_LDA(At, 0, 0); PG8_STAGE(PG8_SA(1, 1), a1 + hstep, voffA);
            PG8_WAIT_L(8); PG8_BAR; PG8_WAIT_L(0); PG8_MMA(0, 0, At, B0); PG8_BAR; PG8_SCHED;
            PG8_LDB(B1, 0, 1); PG8_STAGE(PG8_SB(0, 0), b2, voffB);
            PG8_BAR; PG8_WAIT_L(0); PG8_MMA(0, 1, At, B1); PG8_BAR;
            PG8_LDA(At, 0, 1); PG8_STAGE(PG8_SA(0, 0), a2, voffA);
            PG8_BAR; PG8_WAIT_L(0); PG8_MMA(1, 0, At, B0); PG8_BAR; PG8_SCHED;
            PG8_STAGE(PG8_SB(0, 1), b2 + hstep, voffB);
            PG8_WAIT_V(6); PG8_BAR; PG8_MMA(1, 1, At, B1); PG8_BAR;
            PG8_LDB(B0, 1, 0); PG8_SCHED; PG8_LDA(At, 1, 0); PG8_STAGE(PG8_SA(0, 1), a2 + hstep, voffA);
            PG8_WAIT_L(8); PG8_BAR; PG8_WAIT_L(0); PG8_MMA(0, 0, At, B0); PG8_BAR; PG8_SCHED;
            PG8_LDB(B1, 1, 1); PG8_STAGE(PG8_SB(1, 0), b3, voffB);
            PG8_BAR; PG8_WAIT_L(0); PG8_MMA(0, 1, At, B1); PG8_BAR;
            PG8_LDA(At, 1, 1); PG8_STAGE(PG8_SA(1, 0), a3, voffA);
            PG8_BAR; PG8_WAIT_L(0); PG8_MMA(1, 0, At, B0); PG8_BAR; PG8_SCHED;
            PG8_STAGE(PG8_SB(1, 1), b3 + hstep, voffB);
            PG8_WAIT_V(6); PG8_BAR; PG8_MMA(1, 1, At, B1); PG8_BAR;
            }
        }
        if constexpr (ALIGN_EPI) { if (wr == 0) PG8_BAR; }
        if constexpr (!Epi::AFTER_DRAIN) { E(acc, cur, wr, wc, fr, fq); S.done(cur); }
        if (!has_next) break;
#pragma unroll
        for (int a = 0; a < 2; ++a)
#pragma unroll
            for (int b = 0; b < 2; ++b)
#pragma unroll
                for (int m = 0; m < 4; ++m)
#pragma unroll
                    for (int n = 0; n < 2; ++n) acc[a][b][m][n] = (f32x4){0.f, 0.f, 0.f, 0.f};
        cur = nxt; cA = nA; cB = nB; ++ui;
        if constexpr (ALIGN_EPI) { if (wr == 1) PG8_BAR; }
    }
    PG8_WAIT_V(0);
    if constexpr (!ALIGN_EPI) { if (wr == 0) PG8_BAR; }
    PG8_BAR;
    if constexpr (Epi::AFTER_DRAIN) { E.fused(acc, cur, wr, wc, fr, fq, lds, wid, lane); S.done(cur); }
#undef PG8_SA
#undef PG8_SB
#undef PG8_STAGE
#undef PG8_LDA
#undef PG8_LDB
#undef PG8_MMA
#undef PG8_WAIT_V
#undef PG8_WAIT_L
#undef PG8_BAR
#undef PG8_SCHED
}
}

#define GAS __attribute__((address_space(1)))
#define LAS __attribute__((address_space(3)))
typedef unsigned short bf16;
typedef unsigned v4u __attribute__((ext_vector_type(4)));
typedef float f32x4 __attribute__((ext_vector_type(4)));
typedef short bf16x8 __attribute__((ext_vector_type(8)));
typedef GAS unsigned gu32;
typedef GAS unsigned long long gu64;
#define RLX_AGENT __ATOMIC_RELAXED, __HIP_MEMORY_SCOPE_AGENT
#define LDS_WAIT() asm volatile("s_waitcnt lgkmcnt(0)" ::: "memory")
#define VM_WAIT() asm volatile("s_waitcnt vmcnt(0)" ::: "memory")
__device__ __forceinline__ unsigned long long rt() { return __builtin_amdgcn_s_memrealtime(); }
__device__ __forceinline__ unsigned f2bf(float f) { unsigned u = __builtin_bit_cast(unsigned, f); return (u + 0x7fffu + ((u >> 16) & 1u)) >> 16; }
__device__ __forceinline__ unsigned pk2(float lo, float hi) { return f2bf(lo) | (f2bf(hi) << 16); }

#define XB_TMO      128
#define XB_XCNT(j)  (256  + 64 * (j))
#define XB_XSUB(j)  (1280 + 64 * (j))
#define XB_XGEN(j)  (2304 + 64 * (j))
#define XB_TOP      3328
#define XB_TOPGEN   3392
#define XCD_BAR_WORDS 3456
#define XB_SPIN_CAP (1u << 18)

__device__ __forceinline__ unsigned xb_ld(unsigned* p)              { return __hip_atomic_load(p, __ATOMIC_RELAXED, __HIP_MEMORY_SCOPE_AGENT); }
__device__ __forceinline__ unsigned xb_add(unsigned* p, unsigned v) { return __hip_atomic_fetch_add(p, v, __ATOMIC_RELAXED, __HIP_MEMORY_SCOPE_AGENT); }
__device__ __forceinline__ unsigned xb_xcc_id() { return (unsigned)__builtin_amdgcn_s_getreg((3 << 11) | 20) & 0xFu; }
#define XB_SPIN(cond, bar) do { unsigned _sp = 0; while (cond) { __builtin_amdgcn_s_sleep(1); \
    if ((++_sp & 255u) == 0u) { if (xb_ld(&(bar)[XB_TMO])) break; if (_sp > XB_SPIN_CAP) { atomicAdd(&(bar)[XB_TMO], 1u); break; } } } } while (0)

struct XcdBarrier {
    unsigned* bar; unsigned x;
    volatile LAS unsigned* st;
};

__device__ __forceinline__ XcdBarrier xcd_barrier_post(unsigned* bar, volatile LAS unsigned* st) {
    XcdBarrier b; b.bar = bar; b.x = xb_xcc_id(); b.st = st;
    if (threadIdx.x == 0) (void)xb_add(&bar[XB_XCNT(b.x)], 1u);
    return b;
}
__device__ __forceinline__ void xcd_barrier_complete(unsigned* bar, unsigned x, unsigned& nloc, unsigned& nx) {
    const unsigned G = gridDim.x * gridDim.y * gridDim.z;
    unsigned sum, cnt, mine, sp = 0u;
    for (;;) {
        sum = 0u; cnt = 0u; mine = 0u;
#pragma unroll
        for (unsigned j = 0; j < 16; ++j) { const unsigned c = xb_ld(&bar[XB_XCNT(j)]); sum += c; cnt += (c > 0u) ? 1u : 0u; mine = (j == x) ? c : mine; }
        if (sum == G) break;
        __builtin_amdgcn_s_sleep(1);
        if ((++sp & 255u) == 0u) { if (xb_ld(&bar[XB_TMO])) break; if (sp > XB_SPIN_CAP) { atomicAdd(&bar[XB_TMO], 1u); break; } }
    }
    nloc = mine > 0u ? mine : 1u; nx = cnt > 0u ? cnt : 1u;
}

__device__ __forceinline__ void xcd_barrier(const XcdBarrier& b) {
    asm volatile("s_waitcnt vmcnt(0)" ::: "memory");
    __syncthreads();
    if (threadIdx.x == 0) {
        unsigned* bar = b.bar;
        __builtin_amdgcn_s_waitcnt(0);
        unsigned nloc = b.st[0], nx = b.st[1];
        if (nloc == 0u) { xcd_barrier_complete(bar, b.x, nloc, nx); b.st[0] = nloc; b.st[1] = nx; }
        const unsigned old = xb_add(&bar[XB_XSUB(b.x)], 1u);
        const unsigned gen = old / nloc;
        if (old + 1u == (gen + 1u) * nloc) {
            __builtin_amdgcn_fence(__ATOMIC_RELEASE, "agent");
            asm volatile("s_waitcnt vmcnt(0)" ::: "memory");
            const unsigned og = xb_add(&bar[XB_TOP], 1u);
            const unsigned tg = og / nx;
            if (og + 1u == (tg + 1u) * nx) xb_add(&bar[XB_TOPGEN], 1u);
            else XB_SPIN(xb_ld(&bar[XB_TOPGEN]) == tg, bar);
            __builtin_amdgcn_fence(__ATOMIC_ACQUIRE, "agent");
            xb_add(&bar[XB_XGEN(b.x)], 1u);
            asm volatile("s_waitcnt vmcnt(0)" ::: "memory");
        } else {
            XB_SPIN(xb_ld(&bar[XB_XGEN(b.x)]) == gen, bar);
            __builtin_amdgcn_fence(__ATOMIC_ACQUIRE, "agent");
            asm volatile("s_waitcnt vmcnt(0)" ::: "memory");
        }
    }
    __syncthreads();
}

constexpr int NWAVES = 8;
constexpr int D = 1024, FF = 2816;
constexpr int PB = 8, PT = 2048, SB = 128, STK = 4;
constexpr int MP = PB * PT, MS = SB * STK, M = MP + MS;
constexpr int NRW = 3584, KRW = 2048  , NRW2 = 3840  , NL2 = 3072, KL2 = 384, NIN = 3328;
constexpr float NORM_EPS = 1e-6f, GN_EPS = 64e-5f;
typedef pg8::bf16_t bf16;

constexpr size_t MiB = 1u << 20;
constexpr size_t WS_CTL = 0, CTL_ZERO_BYTES = 64 * 1024;
constexpr size_t WS_W = 1 * MiB;
constexpr size_t WS_XR = 20 * MiB;
constexpr size_t WS_BIG = 86 * MiB;
constexpr size_t WS_END = 256 * MiB;
constexpr size_t WS_YRAW = 256 * MiB, WS_BON = 288 * MiB, WS_W2 = 289 * MiB  , WS_END2 = 308 * MiB, WS_XM = 308 * MiB  , WS_END3 = 506 * MiB;
constexpr size_t W_GU = 0, W_D = (size_t)2 * FF * D * 2;
constexpr size_t W_RW = 0, W_L2 = (size_t)NRW * KRW * 2, W_O = W_L2 + (size_t)NL2 * KL2 * 2;
constexpr size_t W_IN = 0, W_OUT = (size_t)NIN * D * 2;
static_assert(W_D + (size_t)D * FF * 2 <= 19 * MiB && W_O + (size_t)D * D * 2 <= 19 * MiB && W_OUT + (size_t)D * D * 2 <= 19 * MiB, "weights region");
constexpr size_t B_H = 0, B_XN = 91 * MiB, B_SLAB = 124 * MiB;
constexpr size_t B_ACAT = 0, B_R = 66 * MiB, B_K = 99 * MiB, B_V = 132 * MiB, B_DEC = 0, B_AA = 33 * MiB;
constexpr size_t B_QKR = 0, B_VV = 33 * MiB, B_HO = 66 * MiB, B_OO = 124 * MiB, B_IF = 157 * MiB;
static_assert((size_t)M * FF * 2 <= 91 * MiB && (size_t)M * D * 2 == 33 * MiB && B_IF + (size_t)M * 16 * 4 <= 170 * MiB && B_SLAB + (size_t)11 * MS * D * 4 <= 170 * MiB, "BIG map");
constexpr size_t OS_GG = 0, OS_LORA = 33 * MiB;
static_assert(OS_LORA + (size_t)M * KL2 * 2 <= (size_t)MP * D * 4, "d_out scratch");
constexpr size_t O_Y = 0, O_P_S = 17301504, O_P_SHIFT = 17825792, O_P_C = 17833984, O_P_N = 18358272, O_P_M = 18362368, O_P_CONV = 18362432,
                 O_S_S = 18387008, O_S_SHIFT = 26775616, O_S_C = 26906688, O_S_N = 35295296, O_S_M = 35360832, O_S_CONV = 35361856, O_END = 35755072;
constexpr int CW_BAR = 1024;

constexpr int RING_BYTES = 131072, LDSCTL_OFF = RING_BYTES, MISC_OFF = LDSCTL_OFF + 320, TAB_OFF = LDSCTL_OFF + 1024, LDS_BYTES = 147456;

enum { I_XP = 0, I_XS, I_RS, I_RSHIFT, I_MC, I_MN, I_MM, I_MCONV, I_NFA, I_FAWG, I_FAWU, I_FAWD, I_NMIX, I_NFB, I_FBWG, I_FBWU, I_FBWD,
       I_MU, I_WR, I_WK, I_WV, I_WO, I_W0, I_W1, I_W2, I_A0, I_A1, I_A2, I_G1, I_G2, I_KK, I_KA, I_RK, I_GNW, I_GNB,
       I_WIN, I_BIF, I_CW, I_CB, I_MNW, I_WOUT, I_NFIN, N_IN };

typedef __bf16 bf16x2_t __attribute__((ext_vector_type(2)));
typedef float f32x2_t __attribute__((ext_vector_type(2)));
__device__ __forceinline__ unsigned pkbf(float lo, float hi) { f32x2_t v = {lo, hi}; bf16x2_t b = __builtin_convertvector(v, bf16x2_t); return __builtin_bit_cast(unsigned, b); }
__device__ __forceinline__ float bflo(unsigned u) { return __builtin_bit_cast(float, u << 16); }
__device__ __forceinline__ float bfhi(unsigned u) { return __builtin_bit_cast(float, u & 0xffff0000u); }
__device__ __forceinline__ float bf1(unsigned short u) { return __builtin_bit_cast(float, (unsigned)u << 16); }
__device__ __forceinline__ unsigned short f2bf1(float f) { return (unsigned short)(pkbf(f, 0.f) & 0xffffu); }
__device__ __forceinline__ void unpack8(v4u w, float (&o)[8]) { o[0] = bflo(w.x); o[1] = bfhi(w.x); o[2] = bflo(w.y); o[3] = bfhi(w.y); o[4] = bflo(w.z); o[5] = bfhi(w.z); o[6] = bflo(w.w); o[7] = bfhi(w.w); }
__device__ __forceinline__ v4u pack8(const float (&o)[8]) { v4u w; w.x = pkbf(o[0], o[1]); w.y = pkbf(o[2], o[3]); w.z = pkbf(o[4], o[5]); w.w = pkbf(o[6], o[7]); return w; }
__device__ __forceinline__ float sigmoidf_(float x) { return __builtin_amdgcn_rcpf(1.f + __expf(-x)); }
__device__ __forceinline__ float siluf_(float x) { return x * __builtin_amdgcn_rcpf(1.f + __expf(-x)); }
__device__ __forceinline__ float tanhf_(float x) { return 1.f - 2.f * __builtin_amdgcn_rcpf(__expf(2.f * x) + 1.f); }
__device__ __forceinline__ float logsigmoidf_(float x) { return fminf(x, 0.f) - __logf(1.f + __expf(-fabsf(x))); }
template <int CTRL> __device__ __forceinline__ float dppf(float x) { return __builtin_bit_cast(float, __builtin_amdgcn_update_dpp(0, __builtin_bit_cast(int, x), CTRL, 0xF, 0xF, true)); }
__device__ __forceinline__ float red4(float x) { x += dppf<0xB1>(x); x += dppf<0x4E>(x); return x; }
__device__ __forceinline__ float red8(float x) { x = red4(x); x += dppf<0x141>(x); return x; }
__device__ __forceinline__ float red16(float x) { x = red8(x); x += dppf<0x140>(x); return x; }
__device__ __forceinline__ float wave_sum(float v) {
#pragma unroll
    for (int o = 1; o < 64; o <<= 1) v += __shfl_xor(v, o);
    return v;
}

struct Frame {
    LAS unsigned char* lds;
    volatile LAS unsigned* MISC;
    gu32* ctl;
    volatile LAS unsigned long long* tab;
    int tid, lane, wave, vcu, G;
};
__device__ __forceinline__ const float* inptr(const Frame& F, int i) { const unsigned long long v = F.tab[i];
    const unsigned lo = __builtin_amdgcn_readfirstlane((unsigned)v), hi = __builtin_amdgcn_readfirstlane((unsigned)(v >> 32)); return (const float*)(const GAS float*)(((unsigned long long)hi << 32) | lo); }

using pg8::Unit; using pg8::BM; using pg8::HALF;
__device__ __forceinline__ void st8bf(bf16* p, f32x4 v0, f32x4 v1) { v4u w; w.x = pkbf(v0[0], v0[1]); w.y = pkbf(v0[2], v0[3]); w.z = pkbf(v1[0], v1[1]); w.w = pkbf(v1[2], v1[3]); *(v4u*)p = w; }

struct EpiSwiglu {
    static constexpr bool PERM = true, AFTER_DRAIN = false;
    bf16* H; int pvar;
    __device__ __forceinline__ void operator()(const f32x4 (&acc)[2][2][4][2], const Unit& u, int wr, int wc, int fr, int fq) const {
        if (pvar == 3) return;
        const int row0 = u.pm * BM + wr * 64 + fr, col0 = u.pn * 128 + wc * 32 + 8 * fq;
#pragma unroll
        for (int ai = 0; ai < 2; ++ai)
#pragma unroll
            for (int m = 0; m < 4; ++m) {
                f32x4 o[2];
#pragma unroll
                for (int n = 0; n < 2; ++n)
#pragma unroll
                    for (int i = 0; i < 4; ++i) { const float g = acc[ai][0][m][n][i], up = acc[ai][1][m][n][i]; o[n][i] = siluf_(g) * up; }
                st8bf(H + (size_t)(row0 + ai * HALF + m * 16) * FF + col0, o[0], o[1]);
            }
    }
};
__device__ __forceinline__ void ld8bf(const bf16* p, f32x4& a, f32x4& b) { const v4u w = *(const v4u*)p; a = (f32x4){bflo(w.x), bfhi(w.x), bflo(w.y), bfhi(w.y)}; b = (f32x4){bflo(w.z), bfhi(w.z), bflo(w.w), bfhi(w.w)}; }
struct EpiRes {
    static constexpr bool PERM = true, AFTER_DRAIN = false;
    const float* basef; const bf16* baseb; bf16* out; float* slab; float coef;
    __device__ __forceinline__ void operator()(const f32x4 (&acc)[2][2][4][2], const Unit& u, int wr, int wc, int fr, int fq) const {
        const int row0 = u.pm * BM + wr * 64 + fr, col0 = u.pn * BM + wc * 32 + 8 * fq;
        if (u.slab < 0) {
            if (basef) {
#pragma unroll
                for (int ai = 0; ai < 2; ++ai)
#pragma unroll
                    for (int m = 0; m < 4; ++m) { const size_t ro = (size_t)(row0 + ai * HALF + m * 16) * D + col0;
#pragma unroll
                        for (int bj = 0; bj < 2; ++bj) { const f32x4 b0 = *(const f32x4*)(basef + ro + bj * HALF), b1 = *(const f32x4*)(basef + ro + bj * HALF + 4);
                            st8bf(out + ro + bj * HALF, b0 + acc[ai][bj][m][0] * coef, b1 + acc[ai][bj][m][1] * coef); } }
            } else {
#pragma unroll
                for (int ai = 0; ai < 2; ++ai)
#pragma unroll
                    for (int m = 0; m < 4; ++m) { const size_t ro = (size_t)(row0 + ai * HALF + m * 16) * D + col0;
#pragma unroll
                        for (int bj = 0; bj < 2; ++bj) { f32x4 b0, b1; ld8bf(baseb + ro + bj * HALF, b0, b1);
                            st8bf(out + ro + bj * HALF, b0 + acc[ai][bj][m][0] * coef, b1 + acc[ai][bj][m][1] * coef); } }
            }
        } else {
            float* sl = slab + (size_t)u.slab * MS * D;
#pragma unroll
            for (int ai = 0; ai < 2; ++ai)
#pragma unroll
                for (int m = 0; m < 4; ++m) { const size_t ro = (size_t)(row0 + ai * HALF + m * 16 - MP) * D + col0;
#pragma unroll
                    for (int bj = 0; bj < 2; ++bj) { *(f32x4*)(sl + ro + bj * HALF) = acc[ai][bj][m][0]; *(f32x4*)(sl + ro + bj * HALF + 4) = acc[ai][bj][m][1]; } }
        }
    }
};
struct EpiRw {
    static constexpr bool PERM = true, AFTER_DRAIN = false;
    bf16 *R, *K, *V, *L;
    __device__ __forceinline__ void operator()(const f32x4 (&acc)[2][2][4][2], const Unit& u, int wr, int wc, int fr, int fq) const {
        const int mix = u.pn < 12 ? (u.pn >> 2) : u.pn - 9, row0 = (u.pm - (M / 256) * mix) * BM + wr * 64 + fr;
        if (u.pn < 12) {
            bf16 *p0 = R, *p1 = K, *p2 = V; asm volatile("" : "+s"(p0), "+s"(p1), "+s"(p2));
            bf16* dst = u.pn < 4 ? p0 : (u.pn < 8 ? p1 : p2); const int col0 = (u.pn & 3) * BM + wc * 32 + 8 * fq;
#pragma unroll
            for (int ai = 0; ai < 2; ++ai)
#pragma unroll
                for (int m = 0; m < 4; ++m) { bf16* rp = dst + (size_t)(row0 + ai * HALF + m * 16) * D + col0;
#pragma unroll
                    for (int bj = 0; bj < 2; ++bj) st8bf(rp + bj * HALF, acc[ai][bj][m][0], acc[ai][bj][m][1]); }
        } else {
            const int t = u.pn - 12;
#pragma unroll
            for (int bj = 0; bj < 2; ++bj) {
                const int cl = bj * HALF + wc * 32 + 8 * fq;
                if (t < 2 && cl >= 64) continue;
                const int lc = t == 0 ? cl : (t == 1 ? 64 + cl : 128 + cl);
                const int act = t == 0 ? 1 : (t == 1 ? 0 : (cl < 160 ? 2 : 3));
#pragma unroll
                for (int ai = 0; ai < 2; ++ai)
#pragma unroll
                    for (int m = 0; m < 4; ++m) {
                        f32x4 o[2];
#pragma unroll
                        for (int n = 0; n < 2; ++n)
#pragma unroll
                            for (int i = 0; i < 4; ++i) { const float x = acc[ai][bj][m][n][i]; o[n][i] = act == 1 ? tanhf_(x) : (act == 0 ? x : (act == 2 ? sigmoidf_(x) : 0.f)); }
                        st8bf(L + (size_t)(row0 + ai * HALF + m * 16) * KL2 + lc, o[0], o[1]);
                    }
            }
        }
    }
};
struct EpiL2 {
    static constexpr bool PERM = true, AFTER_DRAIN = false;
    bf16 *DEC, *AA, *GG; const float *w0, *a0;
    __device__ __forceinline__ void operator()(const f32x4 (&acc)[2][2][4][2], const Unit& u, int wr, int wc, int fr, int fq) const {
        const int row0 = u.pm * BM + wr * 64 + fr, kind = u.pn >> 2, col0 = (u.pn & 3) * BM + wc * 32 + 8 * fq;
        bf16 *p0 = DEC, *p1 = AA, *p2 = GG; const float *q0 = w0, *q1 = a0; asm volatile("" : "+s"(p0), "+s"(p1), "+s"(p2), "+s"(q0), "+s"(q1));
        bf16* dst = kind == 0 ? p0 : (kind == 1 ? p1 : p2); const float* bias = kind == 0 ? q0 : q1;
#pragma unroll
        for (int bj = 0; bj < 2; ++bj) {
            f32x4 bv[2];
#pragma unroll
            for (int n = 0; n < 2; ++n) bv[n] = kind < 2 ? *(const f32x4*)(bias + col0 + bj * HALF + 4 * n) : (f32x4){0.f, 0.f, 0.f, 0.f};
#pragma unroll
            for (int ai = 0; ai < 2; ++ai)
#pragma unroll
                for (int m = 0; m < 4; ++m) {
                    f32x4 o[2];
#pragma unroll
                    for (int n = 0; n < 2; ++n)
#pragma unroll
                        for (int i = 0; i < 4; ++i) { const float z = acc[ai][bj][m][n][i] + bv[n][i];
                            o[n][i] = kind == 0 ? (1.f - __expf(-0.60653065971f * sigmoidf_(z))) : (kind == 1 ? sigmoidf_(z) : z); }
                    st8bf(dst + (size_t)(row0 + ai * HALF + m * 16) * D + col0 + bj * HALF, o[0], o[1]);
                }
        }
    }
};
struct EpiIn {
    static constexpr bool PERM = true, AFTER_DRAIN = false;
    bf16 *QKR, *VV, *OO; float* IF; const float* bif; int pvar;
    __device__ __forceinline__ void operator()(const f32x4 (&acc)[2][2][4][2], const Unit& u, int wr, int wc, int fr, int fq) const {
        if (pvar == 3) return;
        const int row0 = u.pm * BM + wr * 64 + fr;
        if (u.pn < 12) {
            bf16 *p0 = QKR, *p1 = VV, *p2 = OO; asm volatile("" : "+s"(p0), "+s"(p1), "+s"(p2));
            const int kind = u.pn >> 2; bf16* dst = kind == 0 ? p0 : (kind == 1 ? p1 : p2); const int col0 = (u.pn & 3) * BM + wc * 32 + 8 * fq;
#pragma unroll
            for (int ai = 0; ai < 2; ++ai)
#pragma unroll
                for (int m = 0; m < 4; ++m) { bf16* rp = dst + (size_t)(row0 + ai * HALF + m * 16) * D + col0;
#pragma unroll
                    for (int bj = 0; bj < 2; ++bj) { f32x4 a = acc[ai][bj][m][0], b = acc[ai][bj][m][1];
                        if (kind == 2) {
#pragma unroll
                            for (int i = 0; i < 4; ++i) { a[i] = sigmoidf_(a[i]); b[i] = sigmoidf_(b[i]); } }
                        st8bf(rp + bj * HALF, a, b); } }
        } else if (u.pn == 12 && wc == 0 && fq < 2) {
            const f32x4 b0 = *(const f32x4*)(bif + 8 * fq), b1 = *(const f32x4*)(bif + 8 * fq + 4);
#pragma unroll
            for (int ai = 0; ai < 2; ++ai)
#pragma unroll
                for (int m = 0; m < 4; ++m) { f32x4 a = acc[ai][0][m][0] + b0, b = acc[ai][0][m][1] + b1;
                    if (fq == 1) {
#pragma unroll
                        for (int i = 0; i < 4; ++i) { a[i] = logsigmoidf_(a[i]); b[i] = logsigmoidf_(b[i]); } }
                    float* rp = IF + (size_t)(row0 + ai * HALF + m * 16) * 16 + 8 * fq; *(f32x4*)rp = a; *(f32x4*)(rp + 4) = b; }
        }
    }
};

struct CJ { const float* W; const float* sc; bf16* WT; int K, N, Npad, ldk, koff, rmode, roff, smode; };
__device__ __forceinline__ int cj_items(const CJ& j) { return (j.K / 32) * (j.Npad / 32); }
__device__ __forceinline__ void conv_load(const CJ& J, int item, int lane, f32x4 (&w)[4], float (&sc)[4]) {
    const int nblk = J.Npad / 32, kb = item / nblk, nb = item % nblk, k0 = 32 * kb, n0 = 32 * nb;
    const int r = lane >> 3, c4 = 4 * (lane & 7); const bool nok = n0 + c4 < J.N;
#pragma unroll
    for (int i = 0; i < 4; ++i) { const int kk = k0 + r + 8 * i;
        w[i] = nok ? *(const f32x4*)(J.W + (size_t)kk * J.N + n0 + c4) : (f32x4){0.f, 0.f, 0.f, 0.f};
        float s = 1.f; if (J.smode) { s = J.sc[kk]; if (J.smode == 2) s = 1.f - s; }
        sc[i] = s; }
}
__device__ __forceinline__ void conv_store(const CJ& J, LAS float* scr, int item, int lane, const f32x4 (&w)[4], const float (&sc)[4]) {
    const int nblk = J.Npad / 32, kb = item / nblk, nb = item % nblk, k0 = 32 * kb, n0 = 32 * nb;
    const int r = lane >> 3, c4 = 4 * (lane & 7);
#pragma unroll
    for (int i = 0; i < 4; ++i) { const f32x4 f = w[i] * sc[i]; LAS float* d = scr + (r + 8 * i) * 33 + c4; d[0] = f[0]; d[1] = f[1]; d[2] = f[2]; d[3] = f[3]; }
    LDS_WAIT(); asm volatile("" ::: "memory");
    const int rowbase = J.rmode == 0 ? J.roff + n0 : (n0 >> 7) * 256 + (n0 & 127) + J.roff;
    const int c = lane & 3;
#pragma unroll
    for (int j = 0; j < 2; ++j) { const int n = (lane >> 2) + 16 * j; const LAS float* s = scr + (8 * c) * 33 + n;
        v4u o; o.x = pkbf(s[0 * 33], s[1 * 33]); o.y = pkbf(s[2 * 33], s[3 * 33]); o.z = pkbf(s[4 * 33], s[5 * 33]); o.w = pkbf(s[6 * 33], s[7 * 33]);
        *(GAS v4u*)(J.WT + (size_t)(rowbase + n) * J.ldk + J.koff + k0 + 8 * c) = o; }
    LDS_WAIT(); asm volatile("" ::: "memory");
}
__device__ __forceinline__ CJ get_job(const Frame& F, int kind, int j, int layer, int ab, bf16* Wb) {
    CJ J; J.sc = nullptr; J.smode = 0; J.koff = 0; J.rmode = 0; J.roff = 0;
    if (kind == 0) {
        const float* wg = inptr(F, ab ? I_FBWG : I_FAWG) + (size_t)layer * D * FF; const float* wu = inptr(F, ab ? I_FBWU : I_FAWU) + (size_t)layer * D * FF; const float* wd = inptr(F, ab ? I_FBWD : I_FAWD) + (size_t)layer * D * FF;
        if (j < 2) { J.W = j == 0 ? wg : wu; J.K = D; J.N = FF; J.Npad = FF; J.WT = Wb + W_GU / 2; J.ldk = D; J.rmode = 1; J.roff = j == 0 ? 0 : 128; }
        else { J.W = wd; J.K = FF; J.N = D; J.Npad = D; J.WT = Wb + W_D / 2; J.ldk = FF; }
    } else if (kind == 1) {
        if (j < 6) {
            const int s = j;
            J.W = inptr(F, s == 0 ? I_WR : (s == 1 ? I_WK : (s == 2 ? I_WV : (s == 3 ? I_W1 : (s == 4 ? I_A1 : I_G1)))));
            J.N = s < 3 ? 1024 : (s < 5 ? 64 : 160); J.Npad = s < 3 ? 1024 : 256;
            J.roff = s < 3 ? 1024 * s : 3072 + 256 * (s - 3);
            J.K = D; J.ldk = D; J.WT = Wb + W_RW / 2;
        } else { J.W = inptr(F, I_WO); J.K = D; J.N = D; J.Npad = D; J.WT = Wb + W_O / 2; J.ldk = D; }
    } else {
        if (j == 0) { J.W = inptr(F, I_WIN); J.K = D; J.N = 3088; J.Npad = NIN; J.WT = Wb + W_IN / 2; J.ldk = D; }
        else { J.W = inptr(F, I_WOUT); J.K = D; J.N = D; J.Npad = D; J.WT = Wb + W_OUT / 2; J.ldk = D; }
    }
    return J;
}
__device__ __forceinline__ void convert_weights(const Frame& F, int kind, int layer, int ab, bf16* Wb, const int cu0 = 0) {
    LAS float* scr = (LAS float*)(F.lds + F.wave * 16384);
    const int gw = (F.vcu - cu0) * NWAVES + F.wave, NGW = (F.G - cu0) * NWAVES;
    const int njobs = kind == 0 ? 3 : (kind == 1 ? 7 : 2);
    int total = 0;
    for (int j = 0; j < njobs; ++j) { const CJ J = get_job(F, kind, j, layer, ab, Wb); total += cj_items(J); }
    if (gw < total) {
        int r = gw, j = 0; CJ J = get_job(F, kind, 0, layer, ab, Wb);
        while (r >= cj_items(J)) { r -= cj_items(J); ++j; J = get_job(F, kind, j, layer, ab, Wb); }
        f32x4 w[4]; float sc[4];
        conv_load(J, r, F.lane, w, sc);
        for (int g = gw; g < total;) {
            const int gn = g + NGW; int rn = 0; CJ Jn = J; f32x4 wn[4]; float sn[4];
#pragma unroll
            for (int i = 0; i < 4; ++i) { wn[i] = (f32x4){0.f, 0.f, 0.f, 0.f}; sn[i] = 0.f; }
            if (gn < total) {
                rn = gn; int jn = 0; Jn = get_job(F, kind, 0, layer, ab, Wb);
                while (rn >= cj_items(Jn)) { rn -= cj_items(Jn); ++jn; Jn = get_job(F, kind, jn, layer, ab, Wb); }
                conv_load(Jn, rn, F.lane, wn, sn);
            }
            conv_store(J, scr, r, F.lane, w, sc);
            J = Jn; r = rn; g = gn;
#pragma unroll
            for (int i = 0; i < 4; ++i) { w[i] = wn[i]; sc[i] = sn[i]; }
        }
    }
    if (kind == 1) {
        bf16* WT = Wb + W_L2 / 2; const float* w2 = inptr(F, I_W2); const float* a2 = inptr(F, I_A2); const float* g2 = inptr(F, I_G2);
        for (int idx = (F.vcu * NWAVES + F.wave) * 64 + F.lane; idx < 48 * NL2; idx += F.G * NWAVES * 64) {
            const int c = idx / NL2, n = idx % NL2, type = n >> 10, jj = n & 1023;
            const float* src = nullptr;
            if (type == 0 && c < 8) src = w2 + (size_t)(8 * c) * D + jj;
            else if (type == 1 && c >= 8 && c < 16) src = a2 + (size_t)(8 * (c - 8)) * D + jj;
            else if (type == 2 && c >= 16 && c < 36) src = g2 + (size_t)(8 * (c - 16)) * D + jj;
            float v[8];
#pragma unroll
            for (int e = 0; e < 8; ++e) v[e] = src ? src[(size_t)e * D] : 0.f;
            *(GAS v4u*)(WT + (size_t)n * KL2 + 8 * c) = pack8(v);
        }
    }
}

template <int MODE>
__device__ __forceinline__ void norm_finish(const int m, f32x4 (&v)[4], const f32x4 (&gv)[4], bf16* dst, const float* shift_in, float* out, const int lane) {
    const bool samp = m >= MP;
    float ss = 0.f;
#pragma unroll
    for (int j = 0; j < 4; ++j) ss += (v[j].x * v[j].x + v[j].y * v[j].y) + (v[j].z * v[j].z + v[j].w * v[j].w);
    const float r = 1.0f / sqrtf(wave_sum(ss) * (1.f / D) + NORM_EPS);
#pragma unroll
    for (int j = 0; j < 4; ++j) v[j] = v[j] * r * gv[j];
    if (MODE == 2) {
#pragma unroll
        for (int j = 0; j < 4; ++j) *(f32x4*)(out + O_Y + (size_t)m * D + 512 * (j >> 1) + 8 * lane + 4 * (j & 1)) = v[j];
    } else if (MODE == 0) {
#pragma unroll
        for (int j = 0; j < 2; ++j) st8bf(dst + (size_t)m * D + 512 * j + 8 * lane, v[2 * j], v[2 * j + 1]);
    } else {
        int t, b; bool first, last;
        if (!samp) { t = m & (PT - 1); b = m >> 11; first = t == 0; last = t == PT - 1; } else { const int mm = m - MP; t = mm & 3; b = mm >> 2; first = t == 0; last = t == 3; }
#pragma unroll
        for (int j = 0; j < 2; ++j) { const int eo = 512 * j + 8 * lane;
            st8bf(dst + (size_t)m * (2 * D) + eo, v[2 * j], v[2 * j + 1]);
            if (!last) st8bf(dst + (size_t)(m + 1) * (2 * D) + D + eo, v[2 * j], v[2 * j + 1]);
            else { float* so = out + (samp ? O_S_SHIFT : O_P_SHIFT) + (size_t)b * D + eo; *(f32x4*)so = v[2 * j]; *(f32x4*)(so + 4) = v[2 * j + 1]; }
            if (first) { f32x4 s0 = {0.f, 0.f, 0.f, 0.f}, s1 = s0;
                if (samp) { s0 = *(const f32x4*)(shift_in + (size_t)b * D + eo); s1 = *(const f32x4*)(shift_in + (size_t)b * D + eo + 4); }
                st8bf(dst + (size_t)m * (2 * D) + D + eo, s0, s1); }
        }
    }
}
template <bool F32>
__device__ __forceinline__ void row_load(const void* src, const size_t row, const int lane, f32x4 (&v)[4]) {
    if (F32) { const float* p = (const float*)src + row * D;
#pragma unroll
        for (int j = 0; j < 4; ++j) v[j] = *(const f32x4*)(p + 512 * (j >> 1) + 8 * lane + 4 * (j & 1));
    } else { const bf16* p = (const bf16*)src + row * D;
#pragma unroll
        for (int j = 0; j < 2; ++j) ld8bf(p + 512 * j + 8 * lane, v[2 * j], v[2 * j + 1]); }
}
template <int NS>
__device__ __forceinline__ void samp_row_fold(const float* slab, const int ms, const float coef, const int lane, f32x4 (&v)[4]) {
#pragma unroll
    for (int h = 0; h < 2; ++h) {
        f32x4 t[NS > 0 ? NS : 1][2];
#pragma unroll
        for (int s = 0; s < NS; ++s)
#pragma unroll
            for (int jj = 0; jj < 2; ++jj) t[s][jj] = *(const f32x4*)(slab + ((size_t)s * MS + ms) * D + 512 * h + 8 * lane + 4 * jj);
#pragma unroll
        for (int jj = 0; jj < 2; ++jj)
#pragma unroll
            for (int s = 0; s < NS; ++s) v[2 * h + jj] += t[s][jj] * coef;
    }
}
template <int MODE, bool PF32, bool SF32>
__device__ __forceinline__ void norm_rows(const Frame& F, const void* base_p, const void* base_s, int nslab, float coef, const float* slab, bf16* xr,
                                          const float* gain, bf16* dst, const float* shift_in, float* out, const int pvar = 0) {
    const int gw = F.vcu * NWAVES + F.wave, NGW = F.G * NWAVES, lane = F.lane;
    f32x4 gv[4];
#pragma unroll
    for (int j = 0; j < 4; ++j) gv[j] = *(const f32x4*)(gain + 512 * (j >> 1) + 8 * lane + 4 * (j & 1));
    for (int s = F.wave * F.G + F.vcu; s < MS; s += NWAVES * F.G) {
        const int m = MP + s; f32x4 v[4];
        row_load<SF32>(base_s, (size_t)s, lane, v);
        if (nslab == 11) samp_row_fold<11>(slab, s, coef, lane, v); else if (nslab == 4) samp_row_fold<4>(slab, s, coef, lane, v);
        if (nslab > 0 && MODE != 2 && pvar == 0) {
#pragma unroll
            for (int j = 0; j < 2; ++j) st8bf(xr + (size_t)m * D + 512 * j + 8 * lane, v[2 * j], v[2 * j + 1]); }
        norm_finish<MODE>(m, v, gv, dst, shift_in, out, lane);
    }
    int m = gw; f32x4 v[4];
    if (m < MP) row_load<PF32>(base_p, (size_t)m, lane, v);
    while (m < MP) {
        const int mn = m + NGW; f32x4 vn[4];
#pragma unroll
        for (int j = 0; j < 4; ++j) vn[j] = (f32x4){0.f, 0.f, 0.f, 0.f};
        if (mn < MP) row_load<PF32>(base_p, (size_t)mn, lane, vn);
        norm_finish<MODE>(m, v, gv, dst, shift_in, out, lane);
#pragma unroll
        for (int j = 0; j < 4; ++j) v[j] = vn[j];
        m = mn;
    }
}

__device__ __forceinline__ void mix_rows(const Frame& F, const bf16* xr_p, const float* xs_in, int nslab, float coef, const float* slab, bf16* xr, const float* gain, const float* mu, bf16* XM,
                                         const float* shift_in, float* out, const int pvar) {
    const int gw = F.vcu * NWAVES + F.wave, NGW = F.G * NWAVES, lane = F.lane;
    f32x4 gv[4];
#pragma unroll
    for (int j = 0; j < 4; ++j) gv[j] = *(const f32x4*)(gain + 512 * (j >> 1) + 8 * lane + 4 * (j & 1));
    __syncthreads();
    for (int i = F.tid; i < 6 * D / 8; i += NWAVES * 64) { const int s = i >> 7, e8 = i & 127; const float* mup = mu + ((0x541320 >> (4 * s)) & 15) * D + 8 * e8;
        const f32x4 ma = *(const f32x4*)mup, mb = *(const f32x4*)(mup + 4); v4u w; w.x = pkbf(ma[0], ma[1]); w.y = pkbf(ma[2], ma[3]); w.z = pkbf(mb[0], mb[1]); w.w = pkbf(mb[2], mb[3]);
        *(LAS v4u*)(F.lds + (s * D + 8 * e8) * 2) = w; }
    __syncthreads();
#define MIX_NORM(v) do { float ss_ = 0.f; \
        _Pragma("unroll") for (int j = 0; j < 4; ++j) ss_ += (v[j].x * v[j].x + v[j].y * v[j].y) + (v[j].z * v[j].z + v[j].w * v[j].w); \
        const float r_ = 1.0f / sqrtf(wave_sum(ss_) * (1.f / D) + NORM_EPS); \
        _Pragma("unroll") for (int j = 0; j < 4; ++j) v[j] = v[j] * r_ * gv[j]; } while (0)
#define MIX_EMIT(m, xn, pv) do { f32x4 df_[4]; int lo_ = 16 * lane; asm volatile("" : "+v"(lo_));     \
        _Pragma("unroll") for (int j = 0; j < 4; ++j) df_[j] = pv[j] - xn[j]; \
        _Pragma("unroll") for (int s = 0; s < 6; ++s) \
        _Pragma("unroll") for (int j = 0; j < 2; ++j) { const v4u mw = *(const LAS v4u*)(F.lds + (s * D + 512 * j) * 2 + lo_); const f32x4 ma = {bflo(mw.x), bfhi(mw.x), bflo(mw.y), bfhi(mw.y)}, mb = {bflo(mw.z), bfhi(mw.z), bflo(mw.w), bfhi(mw.w)}; \
            st8bf(XM + ((size_t)s * M + (m)) * D + 512 * j + 8 * lane, xn[2 * j] + ma * df_[2 * j], xn[2 * j + 1] + mb * df_[2 * j + 1]); } } while (0)
    for (int sq = F.wave * F.G + F.vcu; sq < SB; sq += NWAVES * F.G) {
        f32x4 pv[4];
#pragma unroll
        for (int j = 0; j < 4; ++j) pv[j] = *(const f32x4*)(shift_in + (size_t)sq * D + 512 * (j >> 1) + 8 * lane + 4 * (j & 1));
        for (int t = 0; t < STK; ++t) { const int srow = STK * sq + t, m = MP + srow; f32x4 v[4];
            row_load<true>(xs_in, (size_t)srow, lane, v);
            if (nslab == 11) samp_row_fold<11>(slab, srow, coef, lane, v); else if (nslab == 4) samp_row_fold<4>(slab, srow, coef, lane, v);
            if (nslab > 0 && pvar == 0) {
#pragma unroll
                for (int j = 0; j < 2; ++j) st8bf(xr + (size_t)m * D + 512 * j + 8 * lane, v[2 * j], v[2 * j + 1]); }
            MIX_NORM(v);
            MIX_EMIT(m, v, pv);
#pragma unroll
            for (int j = 0; j < 4; ++j) pv[j] = v[j];
        }
#pragma unroll
        for (int j = 0; j < 4; ++j) *(f32x4*)(out + O_S_SHIFT + (size_t)sq * D + 512 * (j >> 1) + 8 * lane + 4 * (j & 1)) = pv[j];
    }
    for (int blk = gw; blk < MP / 8; blk += NGW) {
        const int m0 = 8 * blk; f32x4 pv[4], v[4];
        row_load<false>(xr_p, (size_t)m0, lane, v);
        if ((m0 & (PT - 1)) == 0) {
#pragma unroll
            for (int j = 0; j < 4; ++j) pv[j] = (f32x4){0.f, 0.f, 0.f, 0.f};
        } else { row_load<false>(xr_p, (size_t)(m0 - 1), lane, pv); MIX_NORM(pv); }
        for (int i = 0; i < 8; ++i) { const int m = m0 + i; f32x4 vn[4];
#pragma unroll
            for (int j = 0; j < 4; ++j) vn[j] = (f32x4){0.f, 0.f, 0.f, 0.f};
            if (i < 7) row_load<false>(xr_p, (size_t)(m + 1), lane, vn);
            MIX_NORM(v);
            MIX_EMIT(m, v, pv);
            if ((m & (PT - 1)) == PT - 1) {
#pragma unroll
                for (int j = 0; j < 4; ++j) *(f32x4*)(out + O_P_SHIFT + (size_t)(m >> 11) * D + 512 * (j >> 1) + 8 * lane + 4 * (j & 1)) = v[j]; }
#pragma unroll
            for (int j = 0; j < 4; ++j) { pv[j] = v[j]; v[j] = vn[j]; }
        }
    }
#undef MIX_NORM
#undef MIX_EMIT
}

constexpr int RW_KK = 0, RW_DD = 4096, RW_BB = 8192, RW_KP = 12288, RW_RR = 16384, RW_VV = 20480, RW_YY = 24576;
__device__ __forceinline__ void rwkv_chain(const Frame& F, int row0, int T, int h, const float* S0, float* ST,
                                           const bf16* Rb, const bf16* Kb, const bf16* Vb, const bf16* Db, const bf16* Ab, bf16* Gb,
                                           const float* k_k, const float* k_a, const float* r_k, const float* gn_w, const float* gn_b, const bool do_store, const int pvar) {
    LAS float* L = (LAS float*)F.lds;
    const int tid = F.tid, lane = F.lane, w = F.wave;
    const int cg = tid & 7, tt = tid >> 3;
    const int srow = 8 * w + (lane >> 3);
    float S[8];
    if (S0) { const f32x4 a = *(const f32x4*)(S0 + srow * 64 + 8 * cg), b = *(const f32x4*)(S0 + srow * 64 + 8 * cg + 4);
        S[0] = a.x; S[1] = a.y; S[2] = a.z; S[3] = a.w; S[4] = b.x; S[5] = b.y; S[6] = b.z; S[7] = b.w; }
    else {
#pragma unroll
        for (int j = 0; j < 8; ++j) S[j] = 0.f; }
    const int ch = h * 64 + 8 * cg;
    float ckk[8], cka[8], crk[8], cgw[8], cgb[8];
#pragma unroll
    for (int j = 0; j < 8; ++j) { ckk[j] = k_k[ch + j]; cka[j] = k_a[ch + j]; crk[j] = r_k[ch + j]; cgw[j] = gn_w[ch + j]; cgb[j] = gn_b[ch + j]; }
    const int nch = (T + 63) >> 6;
    v4u pr = {0, 0, 0, 0}, pk = pr, pv = pr, pd = pr, pa = pr, pg = pr;
    { const int nt0 = T < 64 ? T : 64;
      if (tt < nt0) { const size_t off = (size_t)(row0 + tt) * D + ch;
          pr = *(const v4u*)(Rb + off); pk = *(const v4u*)(Kb + off); pv = *(const v4u*)(Vb + off); pd = *(const v4u*)(Db + off); pa = *(const v4u*)(Ab + off); pg = *(const v4u*)(Gb + off); } }
    float bon = 0.f, vv[8], gg[8];
    for (int c = 0; c < nch; ++c) {
        const int nt = (T - 64 * c) < 64 ? (T - 64 * c) : 64;
        const bool valid = tt < nt;
        {
            float r8[8], k8[8], d8[8], a8[8];
            unpack8(pr, r8); unpack8(pk, k8); unpack8(pv, vv); unpack8(pd, d8); unpack8(pa, a8); unpack8(pg, gg);
            float kk[8], ss = 0.f;
#pragma unroll
            for (int j = 0; j < 8; ++j) { kk[j] = k8[j] * ckk[j]; ss += kk[j] * kk[j]; }
            ss = red8(ss);
            const float inv = __builtin_amdgcn_rsqf(fmaxf(ss, 1e-24f));
            float kp[8], bsum = 0.f;
#pragma unroll
            for (int j = 0; j < 8; ++j) { kk[j] *= inv; kp[j] = k8[j] * (1.f + (a8[j] - 1.f) * cka[j]); bsum += r8[j] * kp[j] * crk[j]; }
            bon = red8(bsum);
            if (valid) {
                LAS float* p = L + tt * 64 + 8 * cg;
                *(LAS f32x4*)(p + RW_KK) = (f32x4){-kk[0], -kk[1], -kk[2], -kk[3]}; *(LAS f32x4*)(p + RW_KK + 4) = (f32x4){-kk[4], -kk[5], -kk[6], -kk[7]};
                *(LAS f32x4*)(p + RW_DD) = (f32x4){1.f - d8[0], 1.f - d8[1], 1.f - d8[2], 1.f - d8[3]}; *(LAS f32x4*)(p + RW_DD + 4) = (f32x4){1.f - d8[4], 1.f - d8[5], 1.f - d8[6], 1.f - d8[7]};
                *(LAS f32x4*)(p + RW_BB) = (f32x4){kk[0] * a8[0], kk[1] * a8[1], kk[2] * a8[2], kk[3] * a8[3]}; *(LAS f32x4*)(p + RW_BB + 4) = (f32x4){kk[4] * a8[4], kk[5] * a8[5], kk[6] * a8[6], kk[7] * a8[7]};
                *(LAS f32x4*)(p + RW_KP) = (f32x4){kp[0], kp[1], kp[2], kp[3]}; *(LAS f32x4*)(p + RW_KP + 4) = (f32x4){kp[4], kp[5], kp[6], kp[7]};
                *(LAS f32x4*)(p + RW_RR) = (f32x4){r8[0], r8[1], r8[2], r8[3]}; *(LAS f32x4*)(p + RW_RR + 4) = (f32x4){r8[4], r8[5], r8[6], r8[7]};
                *(LAS f32x4*)(p + RW_VV) = (f32x4){vv[0], vv[1], vv[2], vv[3]}; *(LAS f32x4*)(p + RW_VV + 4) = (f32x4){vv[4], vv[5], vv[6], vv[7]};
            }
        }
        __syncthreads();
        if (c + 1 < nch) { const int nt1 = (T - 64 * (c + 1)) < 64 ? (T - 64 * (c + 1)) : 64;
            if (tt < nt1) { const size_t off = (size_t)(row0 + 64 * (c + 1) + tt) * D + ch;
                pr = *(const v4u*)(Rb + off); pk = *(const v4u*)(Kb + off); pv = *(const v4u*)(Vb + off); pd = *(const v4u*)(Db + off); pa = *(const v4u*)(Ab + off); pg = *(const v4u*)(Gb + off); } }
        {
            typedef float f2 __attribute__((ext_vector_type(2)));
            f2 S2[4] = {{S[0], S[1]}, {S[2], S[3]}, {S[4], S[5]}, {S[6], S[7]}};
            const LAS float* p = L + 8 * cg;
            LAS float* yw = L + RW_YY + srow;
            const LAS float* vp = L + RW_VV + srow;
#define RW_LD(N, Dd, B, Q, R, VR, t_) do { const LAS float* p_ = p + (t_) * 64; \
                N[0] = *(const LAS f32x4*)(p_ + RW_KK); N[1] = *(const LAS f32x4*)(p_ + RW_KK + 4); Dd[0] = *(const LAS f32x4*)(p_ + RW_DD); Dd[1] = *(const LAS f32x4*)(p_ + RW_DD + 4); \
                B[0] = *(const LAS f32x4*)(p_ + RW_BB); B[1] = *(const LAS f32x4*)(p_ + RW_BB + 4); Q[0] = *(const LAS f32x4*)(p_ + RW_KP); Q[1] = *(const LAS f32x4*)(p_ + RW_KP + 4); \
                R[0] = *(const LAS f32x4*)(p_ + RW_RR); R[1] = *(const LAS f32x4*)(p_ + RW_RR + 4); VR = vp[(t_) * 64]; } while (0)
#define RW_STEP(N, Dd, B, Q, R, VR, t_) do { \
                f2 a_ = S2[0] * (f2){N[0].x, N[0].y}; a_ = S2[1] * (f2){N[0].z, N[0].w} + a_; a_ = S2[2] * (f2){N[1].x, N[1].y} + a_; a_ = S2[3] * (f2){N[1].z, N[1].w} + a_; \
                const float sa_ = red8(a_.x + a_.y); const f2 sv_ = {sa_, sa_}, vv_ = {VR, VR}; \
                S2[0] = S2[0] * (f2){Dd[0].x, Dd[0].y} + (sv_ * (f2){B[0].x, B[0].y} + vv_ * (f2){Q[0].x, Q[0].y}); \
                S2[1] = S2[1] * (f2){Dd[0].z, Dd[0].w} + (sv_ * (f2){B[0].z, B[0].w} + vv_ * (f2){Q[0].z, Q[0].w}); \
                S2[2] = S2[2] * (f2){Dd[1].x, Dd[1].y} + (sv_ * (f2){B[1].x, B[1].y} + vv_ * (f2){Q[1].x, Q[1].y}); \
                S2[3] = S2[3] * (f2){Dd[1].z, Dd[1].w} + (sv_ * (f2){B[1].z, B[1].w} + vv_ * (f2){Q[1].z, Q[1].w}); \
                f2 y_ = S2[0] * (f2){R[0].x, R[0].y}; y_ = S2[1] * (f2){R[0].z, R[0].w} + y_; y_ = S2[2] * (f2){R[1].x, R[1].y} + y_; y_ = S2[3] * (f2){R[1].z, R[1].w} + y_; \
                yw[(t_) * 64] = red8(y_.x + y_.y); } while (0)
            f32x4 nA[2], dA[2], bA[2], qA[2], rA[2]; float vA;
            for (int t = 0; t < nt; ++t) { RW_LD(nA, dA, bA, qA, rA, vA, t); RW_STEP(nA, dA, bA, qA, rA, vA, t); }
#undef RW_LD
#undef RW_STEP
            S[0] = S2[0].x; S[1] = S2[0].y; S[2] = S2[1].x; S[3] = S2[1].y; S[4] = S2[2].x; S[5] = S2[2].y; S[6] = S2[3].x; S[7] = S2[3].y;
        }
        __syncthreads();
        if (pvar != 4) {
            f32x4 y0 = {0.f, 0.f, 0.f, 0.f}, y1 = y0;
            if (valid) { y0 = *(const LAS f32x4*)(L + RW_YY + tt * 64 + 8 * cg); y1 = *(const LAS f32x4*)(L + RW_YY + tt * 64 + 8 * cg + 4); }
            float yy[8] = {y0.x, y0.y, y0.z, y0.w, y1.x, y1.y, y1.z, y1.w};
            float s1 = 0.f;
#pragma unroll
            for (int j = 0; j < 8; ++j) s1 += yy[j];
            const float mean = red8(s1) * (1.f / 64.f);
            float s2 = 0.f;
#pragma unroll
            for (int j = 0; j < 8; ++j) { yy[j] -= mean; s2 += yy[j] * yy[j]; }
            const float rstd = __builtin_amdgcn_rsqf(red8(s2) * (1.f / 64.f) + GN_EPS);
            float o[8];
#pragma unroll
            for (int j = 0; j < 8; ++j) o[j] = ((yy[j] * rstd) * cgw[j] + cgb[j] + bon * vv[j]) * gg[j];
            if (valid && do_store) *(v4u*)(Gb + (size_t)(row0 + 64 * c + tt) * D + ch) = pack8(o);
        }
    }
    *(f32x4*)(ST + srow * 64 + 8 * cg) = (f32x4){S[0], S[1], S[2], S[3]}; *(f32x4*)(ST + srow * 64 + 8 * cg + 4) = (f32x4){S[4], S[5], S[6], S[7]};
    __syncthreads();
}

constexpr int RH_TC = 32, RH_BUF = 12288;
constexpr int RH_KK = 0, RH_DD = 2048, RH_BB = 4096, RH_KP = 6144, RH_RR = 8192, RH_VV = 10240, RH_YY = 11264;
__device__ __forceinline__ void rwkv_half_chain(const Frame& F, int b, int h, int half, float* ST, const bf16* Rb, const bf16* Kb, const bf16* Vb, const bf16* Db, const bf16* Ab,
                                                bf16* YRAW, float* BON, const float* k_k, const float* k_a, const float* r_k, const int pvar) {
    LAS float* L = (LAS float*)F.lds;
    const int tid = F.tid, lane = F.lane, w = F.wave, row0 = b * PT;
    constexpr int nch = PT / RH_TC;
    if (w < 4) {
        const int srow = 8 * w + (lane >> 3), cq = lane & 7;
        f32x4 S4 = {0.f, 0.f, 0.f, 0.f}, S5 = S4;
        __syncthreads();
        __builtin_amdgcn_s_setprio(3);
        for (int c = 0; c < nch; ++c) {
            const LAS float* p = L + (c & 1) * RH_BUF + 8 * cq;
            LAS float* yw = L + (c & 1) * RH_BUF + RH_YY + srow;
            const LAS float* vp = L + (c & 1) * RH_BUF + RH_VV + srow;
#define RH_LD(N, Dd, B, Q, R, VR, t_) do { const LAS float* p_ = p + (t_) * 64; \
                N[0] = *(const LAS f32x4*)(p_ + RH_KK); N[1] = *(const LAS f32x4*)(p_ + RH_KK + 4); Dd[0] = *(const LAS f32x4*)(p_ + RH_DD); Dd[1] = *(const LAS f32x4*)(p_ + RH_DD + 4); \
                B[0] = *(const LAS f32x4*)(p_ + RH_BB); B[1] = *(const LAS f32x4*)(p_ + RH_BB + 4); Q[0] = *(const LAS f32x4*)(p_ + RH_KP); Q[1] = *(const LAS f32x4*)(p_ + RH_KP + 4); \
                R[0] = *(const LAS f32x4*)(p_ + RH_RR); R[1] = *(const LAS f32x4*)(p_ + RH_RR + 4); VR = vp[(t_) * 32]; } while (0)
#define RH_STEP(N, Dd, B, Q, R, VR, t_) do { \
                const f32x4 pa_ = S4 * N[0] + S5 * N[1]; const float sa_ = red8((pa_.x + pa_.y) + (pa_.z + pa_.w)); \
                S4 = S4 * Dd[0] + (B[0] * sa_ + Q[0] * VR); S5 = S5 * Dd[1] + (B[1] * sa_ + Q[1] * VR); \
                const f32x4 ya_ = S4 * R[0] + S5 * R[1]; yw[(t_) * 32] = red8((ya_.x + ya_.y) + (ya_.z + ya_.w)); } while (0)
            f32x4 nA[2], dA[2], bA[2], qA[2], rA[2], nB[2], dB[2], bB[2], qB[2], rB[2]; float vA, vB;
            RH_LD(nA, dA, bA, qA, rA, vA, 0);
            if (pvar != 3)
            for (int t = 0; t < RH_TC; t += 2) {
                RH_LD(nB, dB, bB, qB, rB, vB, t + 1);
                RH_STEP(nA, dA, bA, qA, rA, vA, t);
                RH_LD(nA, dA, bA, qA, rA, vA, (t + 2 < RH_TC ? t + 2 : t + 1));
                RH_STEP(nB, dB, bB, qB, rB, vB, t + 1);
            }
#undef RH_LD
#undef RH_STEP
            __syncthreads();
        }
        __builtin_amdgcn_s_setprio(0);
        *(f32x4*)(ST + (32 * half + srow) * 64 + 8 * cq) = S4; *(f32x4*)(ST + (32 * half + srow) * 64 + 8 * cq + 4) = S5;
    } else {
        const int ht = tid - 256, cg = ht & 7, tt = ht >> 3;
        const int ch = h * 64 + 8 * cg, vch = h * 64 + 32 * half + 4 * cg;
        float ckk[8], cka[8], crk[8];
#pragma unroll
        for (int j = 0; j < 8; ++j) { ckk[j] = k_k[ch + j]; cka[j] = k_a[ch + j]; crk[j] = r_k[ch + j]; }
        v4u pr, pk, pd, pa; uint2 pv;
#define RH_LOAD(cc) do { const size_t off_ = (size_t)(row0 + RH_TC * (cc) + tt) * D; pr = *(const v4u*)(Rb + off_ + ch); pk = *(const v4u*)(Kb + off_ + ch); pd = *(const v4u*)(Db + off_ + ch); \
            pa = *(const v4u*)(Ab + off_ + ch); pv = *(const uint2*)(Vb + off_ + vch); } while (0)
#define RH_PREP(cc) do { float r8[8], k8[8], d8[8], a8[8]; unpack8(pr, r8); unpack8(pk, k8); unpack8(pd, d8); unpack8(pa, a8); \
            float kk[8], ss = 0.f; _Pragma("unroll") for (int j = 0; j < 8; ++j) { kk[j] = k8[j] * ckk[j]; ss += kk[j] * kk[j]; } \
            ss = red8(ss); const float inv = __builtin_amdgcn_rsqf(fmaxf(ss, 1e-24f)); \
            float kp[8], bsum = 0.f; _Pragma("unroll") for (int j = 0; j < 8; ++j) { kk[j] *= inv; kp[j] = k8[j] * (1.f + (a8[j] - 1.f) * cka[j]); bsum += r8[j] * kp[j] * crk[j]; } \
            const float bon = red8(bsum); if (half == 0 && cg == 0) BON[(size_t)(row0 + RH_TC * (cc) + tt) * 16 + h] = bon; \
            LAS float* p = L + ((cc) & 1) * RH_BUF + tt * 64 + 8 * cg; \
            *(LAS f32x4*)(p + RH_KK) = (f32x4){-kk[0], -kk[1], -kk[2], -kk[3]}; *(LAS f32x4*)(p + RH_KK + 4) = (f32x4){-kk[4], -kk[5], -kk[6], -kk[7]}; \
            *(LAS f32x4*)(p + RH_DD) = (f32x4){1.f - d8[0], 1.f - d8[1], 1.f - d8[2], 1.f - d8[3]}; *(LAS f32x4*)(p + RH_DD + 4) = (f32x4){1.f - d8[4], 1.f - d8[5], 1.f - d8[6], 1.f - d8[7]}; \
            *(LAS f32x4*)(p + RH_BB) = (f32x4){kk[0] * a8[0], kk[1] * a8[1], kk[2] * a8[2], kk[3] * a8[3]}; *(LAS f32x4*)(p + RH_BB + 4) = (f32x4){kk[4] * a8[4], kk[5] * a8[5], kk[6] * a8[6], kk[7] * a8[7]}; \
            *(LAS f32x4*)(p + RH_KP) = (f32x4){kp[0], kp[1], kp[2], kp[3]}; *(LAS f32x4*)(p + RH_KP + 4) = (f32x4){kp[4], kp[5], kp[6], kp[7]}; \
            *(LAS f32x4*)(p + RH_RR) = (f32x4){r8[0], r8[1], r8[2], r8[3]}; *(LAS f32x4*)(p + RH_RR + 4) = (f32x4){r8[4], r8[5], r8[6], r8[7]}; \
            *(LAS f32x4*)(L + ((cc) & 1) * RH_BUF + RH_VV + tt * 32 + 4 * cg) = (f32x4){bflo(pv.x), bfhi(pv.x), bflo(pv.y), bfhi(pv.y)}; } while (0)
#define RH_POST(cc) do { const f32x4 y4 = *(const LAS f32x4*)(L + ((cc) & 1) * RH_BUF + RH_YY + tt * 32 + 4 * cg); uint2 o; o.x = pkbf(y4.x, y4.y); o.y = pkbf(y4.z, y4.w); \
            *(uint2*)(YRAW + (size_t)(row0 + RH_TC * (cc) + tt) * D + vch) = o; } while (0)
        RH_LOAD(0); RH_PREP(0); RH_LOAD(1);
        __syncthreads();
        for (int c = 0; c < nch; ++c) {
            if (c > 0) RH_POST(c - 1);
            if (c + 1 < nch) { RH_PREP(c + 1); if (c + 2 < nch) RH_LOAD(c + 2); }
            __syncthreads();
        }
        RH_POST(nch - 1);
#undef RH_LOAD
#undef RH_PREP
#undef RH_POST
    }
    __syncthreads();
}
__device__ __forceinline__ void rwkv_finish(const Frame& F, const bf16* YRAW, const float* BON, const bf16* Vb, bf16* Gb, const float* gn_w, const float* gn_b) {
    const int gt = (F.vcu * NWAVES + F.wave) * 64 + F.lane, NT = F.G * NWAVES * 64;
    for (int task = gt; task < MP * 128; task += NT) {
        const int cg = task & 7, hh = (task >> 3) & 15, row = task >> 7; const size_t off = (size_t)row * D + hh * 64 + 8 * cg;
        float yy[8], vv[8], gg[8]; unpack8(*(const v4u*)(YRAW + off), yy); unpack8(*(const v4u*)(Vb + off), vv); unpack8(*(const v4u*)(Gb + off), gg);
        const float bon = BON[(size_t)row * 16 + hh];
        float s1 = 0.f;
#pragma unroll
        for (int j = 0; j < 8; ++j) s1 += yy[j];
        const float mean = red8(s1) * (1.f / 64.f);
        float s2 = 0.f;
#pragma unroll
        for (int j = 0; j < 8; ++j) { yy[j] -= mean; s2 += yy[j] * yy[j]; }
        const float rstd = __builtin_amdgcn_rsqf(red8(s2) * (1.f / 64.f) + GN_EPS);
        const f32x4 w0 = *(const f32x4*)(gn_w + hh * 64 + 8 * cg), w1 = *(const f32x4*)(gn_w + hh * 64 + 8 * cg + 4), b0 = *(const f32x4*)(gn_b + hh * 64 + 8 * cg), b1 = *(const f32x4*)(gn_b + hh * 64 + 8 * cg + 4);
        const float gw[8] = {w0.x, w0.y, w0.z, w0.w, w1.x, w1.y, w1.z, w1.w}, gb[8] = {b0.x, b0.y, b0.z, b0.w, b1.x, b1.y, b1.z, b1.w};
        float o[8];
#pragma unroll
        for (int j = 0; j < 8; ++j) o[j] = ((yy[j] * rstd) * gw[j] + gb[j] + bon * vv[j]) * gg[j];
        *(v4u*)(Gb + off) = pack8(o);
    }
}

constexpr int PBY = 144;
constexpr int RPY = 272;
constexpr int ML_RQK = 0, ML_S = 0, ML_KT = 9216, ML_RV = 18432, ML_Q = 35840, ML_K = 45056, ML_HB = 35840, ML_VT = 54272, ML_C = 72704, ML_F = 91136;
constexpr int MF_N = 0, MF_QN = 64, MF_RS = 128, MF_HS = 256, MF_CW = 384, MF_B63 = 1024, MF_P63 = 1056, MF_MC = 1088  , MF_GB = 1152, MF_GP = MF_GB + 2048, MF_GA = MF_GP + 2048;
typedef __attribute__((address_space(3))) unsigned short lds_u16;
#define MFMA16(a, b, c) __builtin_amdgcn_mfma_f32_16x16x32_bf16((a), (b), (c), 0, 0, 0)
__device__ __forceinline__ void mlstm_gate_tables(const Frame& F, int b, int hh, const float* IFb) {
    LAS float* Fl = (LAS float*)(F.lds + ML_F); const int lane = F.lane, w = F.wave;
#pragma unroll
    for (int q = 0; q < 4; ++q) { const int cc = w + 8 * q; const size_t ro_ = (size_t)(b * PT + 64 * cc + lane) * 16;
        const float li = IFb[ro_ + hh], lf = IFb[ro_ + 8 + hh];
        float bc = lf;
#pragma unroll
        for (int o = 1; o < 64; o <<= 1) { const float x = __shfl_up(bc, o); if (lane >= o) bc += x; }
        const float av = li - bc; float pm = av;
#pragma unroll
        for (int o = 1; o < 64; o <<= 1) { const float x = __shfl_up(pm, o); if (lane >= o) pm = fmaxf(pm, x); }
        Fl[MF_GB + cc * 64 + lane] = bc; Fl[MF_GP + cc * 64 + lane] = pm; Fl[MF_GA + cc * 64 + lane] = av;
        if (lane == 63) { Fl[MF_B63 + cc] = bc; Fl[MF_P63 + cc] = pm; } }
    __syncthreads();
    if (F.tid == 0) { float mm = 0.f;
        for (int cc = 0; cc < PT / 64; ++cc) { Fl[MF_MC + cc] = mm; const float b6 = Fl[MF_B63 + cc]; mm = fmaxf(b6 + mm, b6 + Fl[MF_P63 + cc]); }
        Fl[MF_MC + PT / 64] = mm; }
    __syncthreads();
}
constexpr int ML_NSEG = 4, ML_SEGC = PT / 64 / ML_NSEG, ML_SEGSZ = 128 * 64 + 64;
__device__ __forceinline__ void mlstm_prompt_chain(const Frame& F, int b, int hh, const int seg, const bf16* QKR, const bf16* VVb, const bf16* OOb, const float* IFb, bf16* HOb,
                                                   const float* conv_w, const float* conv_b, const float* norm_w, float* NUM, float* DEN, bf16* Qs, float* SEG, const int pvar) {
    LAS unsigned char* lds = F.lds; LAS float* Fl = (LAS float*)(lds + ML_F);
    const bool defer = seg > 0; const int c_lo = seg * ML_SEGC, c_hi = c_lo + ML_SEGC;
    const int tid = F.tid, lane = F.lane, w = F.wave, fr = lane & 15, fq = lane >> 4;
    for (int i = tid; i < 128 * 72; i += 512) ((lds_u16*)(lds + ML_C))[i] = 0;
    if (tid < 64) Fl[MF_N + tid] = 0.f;
    for (int i = tid; i < 640; i += 512) { const int j = i >> 7, c = i & 127, gc = c < 64 ? hh * 64 + c : 512 + hh * 64 + (c - 64); Fl[MF_CW + i] = j < 4 ? conv_w[j * D + gc] : conv_b[gc]; }
    f32x4 Cacc[4];
#pragma unroll
    for (int k = 0; k < 4; ++k) Cacc[k] = (f32x4){0.f, 0.f, 0.f, 0.f};
    const int og = tid & 15, ot = tid >> 4;
    float nw[8];
#pragma unroll
    for (int e = 0; e < 8; ++e) nw[e] = norm_w[hh * 128 + 8 * og + e];
    v4u rq[3], rv[2], ro[2];
#define ML_LOAD_QKV(cc) do { const int rowc_ = b * PT + 64 * (cc); \
        _Pragma("unroll") for (int i = 0; i < 3; ++i) { const int q = tid + 512 * i, r = q >> 4, j = q & 15, tok = 64 * (cc) - 3 + r; rq[i] = (v4u){0u, 0u, 0u, 0u}; \
            if (q < 67 * 16 && tok >= 0) rq[i] = *(const v4u*)(QKR + (size_t)(b * PT + tok) * D + (j < 8 ? hh * 64 + 8 * j : 512 + hh * 64 + 8 * (j - 8))); } \
        _Pragma("unroll") for (int i = 0; i < 2; ++i) rv[i] = *(const v4u*)(VVb + (size_t)(rowc_ + ot + 32 * i) * D + hh * 128 + 8 * og); \
        } while (0)
#define ML_LOAD_O(cc) do { const int rowc_ = b * PT + 64 * (cc); \
        _Pragma("unroll") for (int i = 0; i < 2; ++i) ro[i] = *(const v4u*)(OOb + (size_t)(rowc_ + ot + 32 * i) * D + hh * 128 + 8 * og); } while (0)
    ML_LOAD_QKV(c_lo);
    mlstm_gate_tables(F, b, hh, IFb);
    for (int c = c_lo; c < c_hi; ++c) {
        const int rowc = b * PT + 64 * c;
        const float m_c = Fl[MF_MC + c], m_n = Fl[MF_MC + c + 1], b63 = Fl[MF_B63 + c];
#pragma unroll
        for (int i = 0; i < 3; ++i) { const int q = tid + 512 * i; if (q < 67 * 16) *(LAS v4u*)(lds + ML_RQK + (q >> 4) * RPY + 16 * (q & 15)) = rq[i]; }
#pragma unroll
        for (int i = 0; i < 2; ++i) *(LAS v4u*)(lds + ML_RV + (ot + 32 * i) * RPY + 16 * og) = rv[i];
        if (c + 1 < c_hi) ML_LOAD_QKV(c + 1);
        if (!defer) ML_LOAD_O(c);
        __syncthreads();
        float kreg[8] = {0.f, 0.f, 0.f, 0.f, 0.f, 0.f, 0.f, 0.f};
        if (pvar != 3)
#pragma unroll
        for (int i = 0; i < 2; ++i) {
            const int g = w + 8 * i, t = lane;
            float x[4][8];
#pragma unroll
            for (int j = 0; j < 4; ++j) unpack8(*(const LAS v4u*)(lds + ML_RQK + (t + j) * RPY + 16 * g), x[j]);
            float val[8];
#pragma unroll
            for (int h2 = 0; h2 < 2; ++h2) { f32x4 a = *(const LAS f32x4*)(Fl + MF_CW + 4 * 128 + 8 * g + 4 * h2);
#pragma unroll
                for (int j = 0; j < 4; ++j) { const f32x4 cw = *(const LAS f32x4*)(Fl + MF_CW + j * 128 + 8 * g + 4 * h2);
                    a.x += cw.x * x[j][4 * h2]; a.y += cw.y * x[j][4 * h2 + 1]; a.z += cw.z * x[j][4 * h2 + 2]; a.w += cw.w * x[j][4 * h2 + 3]; }
                val[4 * h2] = siluf_(a.x); val[4 * h2 + 1] = siluf_(a.y); val[4 * h2 + 2] = siluf_(a.z); val[4 * h2 + 3] = siluf_(a.w); }
            if (i == 0) {
#pragma unroll
                for (int e = 0; e < 8; ++e) val[e] *= 0.125f;
                *(LAS v4u*)(lds + ML_Q + t * PBY + 16 * w) = pack8(val);
            } else { *(LAS v4u*)(lds + ML_K + t * PBY + 16 * w) = pack8(val);
#pragma unroll
                for (int e = 0; e < 8; ++e) kreg[e] = val[e]; }
            const v4u vw = *(const LAS v4u*)(lds + ML_RV + t * RPY + 16 * g);
            lds_u16* vt = (lds_u16*)(lds + ML_VT) + (8 * g) * 72 + t;
            vt[0 * 72] = (unsigned short)(vw.x & 0xffffu); vt[1 * 72] = (unsigned short)(vw.x >> 16); vt[2 * 72] = (unsigned short)(vw.y & 0xffffu); vt[3 * 72] = (unsigned short)(vw.y >> 16);
            vt[4 * 72] = (unsigned short)(vw.z & 0xffffu); vt[5 * 72] = (unsigned short)(vw.z >> 16); vt[6 * 72] = (unsigned short)(vw.w & 0xffffu); vt[7 * 72] = (unsigned short)(vw.w >> 16);
        }
        __syncthreads();
        if (pvar != 4) {
        { const float wsv = __expf(b63 + Fl[MF_GA + c * 64 + lane] - m_n); lds_u16* kt = (lds_u16*)(lds + ML_KT) + (8 * w) * 72 + lane;
#pragma unroll
          for (int e = 0; e < 8; ++e) kt[e * 72] = f2bf1(kreg[e] * wsv); }
        { const int tq = tid >> 3, p = tid & 7; float q8[8]; unpack8(*(const LAS v4u*)(lds + ML_Q + tq * PBY + 16 * p), q8);
          float dsum = 0.f;
#pragma unroll
          for (int e = 0; e < 8; ++e) dsum += q8[e] * Fl[MF_N + 8 * p + e];
          dsum = red8(dsum); if (p == 0) Fl[MF_QN + tq] = dsum; }
        { const int ti = w >> 1, t = 16 * ti + fr; float rsum = 0.f; const float mxt = fmaxf(m_c, Fl[MF_GP + c * 64 + t]);
          typedef unsigned u2v_ __attribute__((ext_vector_type(2)));
#pragma unroll
          for (int jj = 0; jj < 2; ++jj) { const int sj = 2 * (w & 1) + jj; f32x4 acc = {0.f, 0.f, 0.f, 0.f};
#pragma unroll
              for (int ks = 0; ks < 2; ++ks) { const bf16x8 a = *(const LAS bf16x8*)(lds + ML_Q + (16 * ti + fr) * PBY + ks * 64 + fq * 16), bb = *(const LAS bf16x8*)(lds + ML_K + (16 * sj + fr) * PBY + ks * 64 + fq * 16);
                  acc = MFMA16(bb, a, acc); }
              const f32x4 av4 = *(const LAS f32x4*)(Fl + MF_GA + c * 64 + 16 * sj + 4 * fq);
#pragma unroll
              for (int r = 0; r < 4; ++r) { const int s_ = 16 * sj + 4 * fq + r; const float val = s_ <= t ? acc[r] * __expf(av4[r] - mxt) : 0.f; acc[r] = val; rsum += val; }
              u2v_ pw; pw.x = pkbf(acc[0], acc[1]); pw.y = pkbf(acc[2], acc[3]);
              *(LAS u2v_*)(lds + ML_S + (t * 72 + 16 * sj + 4 * fq) * 2) = pw; }
          rsum += __shfl_xor(rsum, 16); rsum += __shfl_xor(rsum, 32);
          if (fq == 0) Fl[MF_RS + t * 2 + (w & 1)] = rsum; }
        }
        __syncthreads();
        float hv[4][4] = {};
        if (pvar != 5) { const int ti = w & 3, t = 16 * ti + fr;
          const float mx = fmaxf(m_c, Fl[MF_GP + c * 64 + t]), wi = __expf(m_c - mx), ei = __expf(-(Fl[MF_GB + c * 64 + t] + mx));
          const float rden = __builtin_amdgcn_rcpf(fmaxf(fabsf(wi * Fl[MF_QN + t] + Fl[MF_RS + 2 * t] + Fl[MF_RS + 2 * t + 1]), ei)); float hq = 0.f;
#pragma unroll
          for (int i = 0; i < 4; ++i) { const int vt = 4 * (w >> 2) + i; f32x4 accA = {0.f, 0.f, 0.f, 0.f}, accB = accA;
#pragma unroll
              for (int ks = 0; ks < 2; ++ks) {
                  const bf16x8 aq = *(const LAS bf16x8*)(lds + ML_Q + (16 * ti + fr) * PBY + ks * 64 + fq * 16), bc = *(const LAS bf16x8*)(lds + ML_C + (16 * vt + fr) * PBY + ks * 64 + fq * 16);
                  accA = MFMA16(bc, aq, accA);
                  const bf16x8 as = *(const LAS bf16x8*)(lds + ML_S + (16 * ti + fr) * PBY + ks * 64 + fq * 16), bv = *(const LAS bf16x8*)(lds + ML_VT + (16 * vt + fr) * PBY + ks * 64 + fq * 16);
                  accB = MFMA16(bv, as, accB); }
              if (defer) { *(f32x4*)(NUM + (size_t)(rowc + t) * D + hh * 128 + 16 * vt + 4 * fq) = accA * wi + accB; }
              else {
#pragma unroll
              for (int r = 0; r < 4; ++r) { const float hh_ = (wi * accA[r] + accB[r]) * rden; hv[i][r] = hh_; hq += hh_ * hh_; } } }
          if (defer) { if (fq == 0 && (w >> 2) == 0) DEN[(size_t)(rowc + t) * 8 + hh] = wi * Fl[MF_QN + t] + Fl[MF_RS + 2 * t] + Fl[MF_RS + 2 * t + 1];
              *(v4u*)(Qs + (size_t)(rowc + (tid >> 3)) * 512 + hh * 64 + 8 * (tid & 7)) = *(const LAS v4u*)(lds + ML_Q + (tid >> 3) * PBY + 16 * (tid & 7)); }
          else { hq += __shfl_xor(hq, 16); hq += __shfl_xor(hq, 32);
              if (fq == 0) Fl[MF_HS + t * 2 + (w >> 2)] = hq; } }
        __syncthreads();
        if (pvar != 6) {
        if (!defer) { const int ti = w & 3, t = 16 * ti + fr; const float sc = __builtin_amdgcn_rsqf((Fl[MF_HS + 2 * t] + Fl[MF_HS + 2 * t + 1]) * (1.f / 128.f) + NORM_EPS);
          typedef unsigned u2v_ __attribute__((ext_vector_type(2)));
#pragma unroll
          for (int i = 0; i < 4; ++i) { u2v_ pw; pw.x = pkbf(hv[i][0] * sc, hv[i][1] * sc); pw.y = pkbf(hv[i][2] * sc, hv[i][3] * sc);
              *(LAS u2v_*)(lds + ML_HB + t * RPY + (16 * (4 * (w >> 2) + i) + 4 * fq) * 2) = pw; } }
        { const float wst = __expf(b63 + m_c - m_n);
          typedef unsigned u2v_ __attribute__((ext_vector_type(2)));
#pragma unroll
          for (int kt = 0; kt < 4; ++kt) { Cacc[kt] = Cacc[kt] * wst;
#pragma unroll
              for (int ks = 0; ks < 2; ++ks) { const bf16x8 a = *(const LAS bf16x8*)(lds + ML_VT + (16 * w + fr) * PBY + ks * 64 + fq * 16), bb = *(const LAS bf16x8*)(lds + ML_KT + (16 * kt + fr) * PBY + ks * 64 + fq * 16);
                  Cacc[kt] = MFMA16(bb, a, Cacc[kt]); }
              u2v_ pw; pw.x = pkbf(Cacc[kt][0], Cacc[kt][1]); pw.y = pkbf(Cacc[kt][2], Cacc[kt][3]);
              *(LAS u2v_*)(lds + ML_C + ((16 * w + fr) * 72 + 16 * kt + 4 * fq) * 2) = pw; }
          if (w == 0) { float sum = 0.f;
#pragma unroll
              for (int q = 0; q < 8; ++q) { float k8[8]; unpack8(*(const LAS v4u*)(lds + ML_KT + lane * PBY + 16 * q), k8);
#pragma unroll
                  for (int e = 0; e < 8; ++e) sum += k8[e]; }
              Fl[MF_N + lane] = wst * Fl[MF_N + lane] + sum; } }
        }
        __syncthreads();
        if (!defer)
#pragma unroll
        for (int i = 0; i < 2; ++i) { const int t = ot + 32 * i; float h8[8], o8[8]; unpack8(*(const LAS v4u*)(lds + ML_HB + t * RPY + 16 * og), h8); unpack8(ro[i], o8);
#pragma unroll
            for (int e = 0; e < 8; ++e) h8[e] = h8[e] * nw[e] * o8[e];
            *(v4u*)(HOb + (size_t)(rowc + t) * D + hh * 128 + 8 * og) = pack8(h8); }
    }
#undef ML_LOAD_QKV
#undef ML_LOAD_O
    { float* sp = SEG + (size_t)((b * 8 + hh) * ML_NSEG + seg) * ML_SEGSZ;
#pragma unroll
      for (int kt = 0; kt < 4; ++kt) *(f32x4*)(sp + (16 * w + fr) * 64 + 16 * kt + 4 * fq) = Cacc[kt];
      if (w == 0) sp[128 * 64 + lane] = Fl[MF_N + lane]; }
    __syncthreads();
}
__device__ __forceinline__ void mlstm_fix_seg(const Frame& F, int b, int hh, const int seg, const bf16* QKR, const bf16* OOb, const float* IFb, bf16* HOb, const float* norm_w,
                                              const float* NUM, const float* DEN, const bf16* Qs, const float* SEG, float* out) {
    LAS unsigned char* lds = F.lds; LAS float* Fl = (LAS float*)(lds + ML_F);
    const int tid = F.tid, lane = F.lane, w = F.wave, fr = lane & 15, fq = lane >> 4;
    const int og = tid & 15, ot = tid >> 4, chain = b * 8 + hh;
    typedef unsigned u2v_ __attribute__((ext_vector_type(2)));
    float nw[8];
#pragma unroll
    for (int e = 0; e < 8; ++e) nw[e] = norm_w[hh * 128 + 8 * og + e];
    const int c_lo = seg * ML_SEGC, c_hi = c_lo + ML_SEGC;
    v4u rq, ro[2]; f32x4 numl[4]; float denl;
#define MLF_LOAD(cc, RQ, RO, NL, DL) do { const int rowc_ = b * PT + 64 * (cc); \
        RQ = *(const v4u*)(Qs + (size_t)(rowc_ + (tid >> 3)) * 512 + hh * 64 + 8 * (tid & 7)); \
        _Pragma("unroll") for (int i = 0; i < 2; ++i) RO[i] = *(const v4u*)(OOb + (size_t)(rowc_ + ot + 32 * i) * D + hh * 128 + 8 * og); \
        _Pragma("unroll") for (int i = 0; i < 4; ++i) NL[i] = *(const f32x4*)(NUM + (size_t)(rowc_ + 16 * (w & 3) + fr) * D + hh * 128 + 16 * (4 * (w >> 2) + i) + 4 * fq); \
        DL = DEN[(size_t)(rowc_ + 16 * (w & 3) + fr) * 8 + hh]; } while (0)
    MLF_LOAD(c_lo, rq, ro, numl, denl);
    mlstm_gate_tables(F, b, hh, IFb);
    {
        f32x4 cin[4]; float nin = 0.f;
#pragma unroll
        for (int i = 0; i < 4; ++i) cin[i] = (f32x4){0.f, 0.f, 0.f, 0.f};
        for (int j = 0; j < seg; ++j) {
            float lw = 0.f;
            for (int cc = j * ML_SEGC; cc < (j + 1) * ML_SEGC; ++cc) lw += Fl[MF_B63 + cc] + Fl[MF_MC + cc] - Fl[MF_MC + cc + 1];
            const float Wj = __expf(lw); const float* sp = SEG + (size_t)(chain * ML_NSEG + j) * ML_SEGSZ;
#pragma unroll
            for (int i = 0; i < 4; ++i) cin[i] = cin[i] * Wj + *(const f32x4*)(sp + 4 * (tid + 512 * i));
            if (tid < 64) nin = nin * Wj + sp[128 * 64 + tid];
        }
#pragma unroll
        for (int i = 0; i < 4; ++i) { const int idx = tid + 512 * i, v = idx >> 4, k4 = (idx & 15) * 4; u2v_ pw; pw.x = pkbf(cin[i][0], cin[i][1]); pw.y = pkbf(cin[i][2], cin[i][3]);
            *(LAS u2v_*)(lds + ML_C + (v * 72 + k4) * 2) = pw; }
        if (tid < 64) Fl[MF_N + tid] = nin;
        if (seg == ML_NSEG - 1) {
            float lw = 0.f;
            for (int cc = seg * ML_SEGC; cc < (seg + 1) * ML_SEGC; ++cc) lw += Fl[MF_B63 + cc] + Fl[MF_MC + cc] - Fl[MF_MC + cc + 1];
            const float Wj = __expf(lw); const float* sp = SEG + (size_t)(chain * ML_NSEG + seg) * ML_SEGSZ;
#pragma unroll
            for (int i = 0; i < 4; ++i) *(f32x4*)(out + O_P_C + (size_t)chain * 8192 + 4 * (tid + 512 * i)) = cin[i] * Wj + *(const f32x4*)(sp + 4 * (tid + 512 * i));
            if (tid < 64) out[O_P_N + (size_t)chain * 64 + tid] = nin * Wj + sp[128 * 64 + tid];
            if (tid == 0) out[O_P_M + chain] = Fl[MF_MC + PT / 64];
            if (tid < 384) { const int j = tid >> 7, c = tid & 127, gc = c < 64 ? hh * 64 + c : 512 + hh * 64 + (c - 64);
                out[O_P_CONV + (size_t)(b * 3 + j) * D + gc] = bf1(QKR[(size_t)(b * PT + PT - 3 + j) * D + gc]); }
        }
    }
    float wc = 1.f;
    for (int c = c_lo; c < c_hi; ++c) {
        const int rowc = b * PT + 64 * c;
        const float m_c = Fl[MF_MC + c], m_n = Fl[MF_MC + c + 1], b63 = Fl[MF_B63 + c];
        *(LAS v4u*)(lds + ML_RQK + (tid >> 3) * PBY + 16 * (tid & 7)) = rq;
        v4u rqn = rq, ron[2] = {ro[0], ro[1]}; f32x4 numn[4] = {numl[0], numl[1], numl[2], numl[3]}; float denn = denl;
        if (c + 1 < c_hi) MLF_LOAD(c + 1, rqn, ron, numn, denn);
        __syncthreads();
        { const int tq = tid >> 3, p = tid & 7; float q8[8]; unpack8(*(const LAS v4u*)(lds + ML_RQK + tq * PBY + 16 * p), q8);
          float dsum = 0.f;
#pragma unroll
          for (int e = 0; e < 8; ++e) dsum += q8[e] * Fl[MF_N + 8 * p + e];
          dsum = red8(dsum); if (p == 0) Fl[MF_QN + tq] = dsum; }
        const int ti = w & 3, t = 16 * ti + fr;
        f32x4 accA[4];
#pragma unroll
        for (int i = 0; i < 4; ++i) { const int vt = 4 * (w >> 2) + i; accA[i] = (f32x4){0.f, 0.f, 0.f, 0.f};
#pragma unroll
            for (int ks = 0; ks < 2; ++ks) {
                const bf16x8 aq = *(const LAS bf16x8*)(lds + ML_RQK + (16 * ti + fr) * PBY + ks * 64 + fq * 16), bc = *(const LAS bf16x8*)(lds + ML_C + (16 * vt + fr) * PBY + ks * 64 + fq * 16);
                accA[i] = MFMA16(bc, aq, accA[i]); } }
        __syncthreads();
        float hv[4][4];
        { const float mx = fmaxf(m_c, Fl[MF_GP + c * 64 + t]), wi = __expf(m_c - mx) * wc, ei = __expf(-(Fl[MF_GB + c * 64 + t] + mx));
          const float rden = __builtin_amdgcn_rcpf(fmaxf(fabsf(wi * Fl[MF_QN + t] + denl), ei)); float hq = 0.f;
#pragma unroll
          for (int i = 0; i < 4; ++i)
#pragma unroll
              for (int r = 0; r < 4; ++r) { const float hh_ = (wi * accA[i][r] + numl[i][r]) * rden; hv[i][r] = hh_; hq += hh_ * hh_; }
          hq += __shfl_xor(hq, 16); hq += __shfl_xor(hq, 32);
          if (fq == 0) Fl[MF_HS + t * 2 + (w >> 2)] = hq; }
        __syncthreads();
        { const float sc = __builtin_amdgcn_rsqf((Fl[MF_HS + 2 * t] + Fl[MF_HS + 2 * t + 1]) * (1.f / 128.f) + NORM_EPS);
#pragma unroll
          for (int i = 0; i < 4; ++i) { u2v_ pw; pw.x = pkbf(hv[i][0] * sc, hv[i][1] * sc); pw.y = pkbf(hv[i][2] * sc, hv[i][3] * sc);
              *(LAS u2v_*)(lds + ML_HB + t * RPY + (16 * (4 * (w >> 2) + i) + 4 * fq) * 2) = pw; } }
        __syncthreads();
#pragma unroll
        for (int i = 0; i < 2; ++i) { const int t2 = ot + 32 * i; float h8[8], o8[8]; unpack8(*(const LAS v4u*)(lds + ML_HB + t2 * RPY + 16 * og), h8); unpack8(ro[i], o8);
#pragma unroll
            for (int e = 0; e < 8; ++e) h8[e] = h8[e] * nw[e] * o8[e];
            *(v4u*)(HOb + (size_t)(rowc + t2) * D + hh * 128 + 8 * og) = pack8(h8); }
        wc *= __expf(b63 + m_c - m_n);
        rq = rqn; ro[0] = ron[0]; ro[1] = ron[1]; denl = denn;
#pragma unroll
        for (int i = 0; i < 4; ++i) numl[i] = numn[i];
    }
#undef MLF_LOAD
    __syncthreads();
}
__device__ __forceinline__ void mlstm_sample_item(const Frame& F, int b, int hh, const bf16* QKR, const bf16* VVb, const bf16* OOb, const float* IFb, bf16* HOb,
                                                  const float* conv_w, const float* conv_b, const float* norm_w, const float* C0, const float* n0, const float* m0p, const float* conv0, float* out) {
    LAS float* L = (LAS float*)F.lds;
    constexpr int LQ = 0, LK = 256, LV = 512, LS = 1024, LQN = 1040, LHS = 1048;
    const int tid = F.tid, lane = F.lane, w = F.wave, row0 = MP + 4 * b;
    float li[4], lf[4];
#pragma unroll
    for (int t = 0; t < 4; ++t) { li[t] = IFb[(size_t)(row0 + t) * 16 + hh]; lf[t] = IFb[(size_t)(row0 + t) * 16 + 8 + hh]; }
    const float m0 = m0p[b * 8 + hh];
    float bc[4], av[4], mt[4], wi[4], wsv[4], ei[4], bm[4];
    { float run = 0.f, pm = -3.0e38f;
#pragma unroll
      for (int t = 0; t < 4; ++t) { run += lf[t]; bc[t] = run; av[t] = li[t] - run; pm = fmaxf(pm, av[t]); mt[t] = fmaxf(run + m0, run + pm); } }
    const float m_new = mt[3], wst = __expf(bc[3] + m0 - m_new);
#pragma unroll
    for (int t = 0; t < 4; ++t) { wi[t] = __expf(bc[t] + m0 - mt[t]); wsv[t] = __expf(bc[3] + av[t] - m_new); ei[t] = __expf(-mt[t]); bm[t] = bc[t] - mt[t]; }
    { const int t = tid >> 7, c = tid & 127, gc = c < 64 ? hh * 64 + c : 512 + hh * 64 + (c - 64);
      float x[4];
#pragma unroll
      for (int j = 0; j < 4; ++j) { const int p = t + j; x[j] = p < 3 ? conv0[(size_t)(b * 3 + p) * D + gc] : bf1(QKR[(size_t)(row0 + p - 3) * D + gc]); }
      float a = conv_b[gc];
#pragma unroll
      for (int j = 0; j < 4; ++j) a += conv_w[j * D + gc] * x[j];
      const float val = siluf_(a);
      if (c < 64) L[LQ + t * 64 + c] = val * 0.125f; else L[LK + t * 64 + (c - 64)] = val;
      if (t >= 1) out[O_S_CONV + (size_t)(b * 3 + t - 1) * D + gc] = x[3];
      L[LV + t * 128 + c] = bf1(VVb[(size_t)(row0 + t) * D + hh * 128 + c]); }
    __syncthreads();
    if (w == 0) { const int pair = lane >> 2, t = pair >> 2, s = pair & 3, part = lane & 3; float dsum = 0.f;
#pragma unroll
        for (int e = 0; e < 16; ++e) dsum += L[LQ + t * 64 + 16 * part + e] * L[LK + s * 64 + 16 * part + e];
        dsum = red4(dsum);
        const float bmt = t == 0 ? bm[0] : (t == 1 ? bm[1] : (t == 2 ? bm[2] : bm[3])), avs = s == 0 ? av[0] : (s == 1 ? av[1] : (s == 2 ? av[2] : av[3]));
        if (part == 0) L[LS + pair] = s <= t ? dsum * __expf(bmt + avs) : 0.f; }
    if (w == 1) { const int t = lane >> 4, part = lane & 15; float dsum = 0.f;
#pragma unroll
        for (int e = 0; e < 4; ++e) dsum += L[LQ + t * 64 + 4 * part + e] * n0[(size_t)(b * 8 + hh) * 64 + 4 * part + e];
        dsum = red16(dsum); if (part == 0) L[LQN + t] = dsum; }
    __syncthreads();
    const int v = tid >> 2, kq = tid & 3;
    float hvv[4];
    { const size_t coff = ((size_t)(b * 8 + hh) * 128 + v) * 64 + 16 * kq;
      float c0[16];
#pragma unroll
      for (int e4 = 0; e4 < 4; ++e4) { const f32x4 x = *(const f32x4*)(C0 + coff + 4 * e4); c0[4 * e4] = x.x; c0[4 * e4 + 1] = x.y; c0[4 * e4 + 2] = x.z; c0[4 * e4 + 3] = x.w; }
#pragma unroll
      for (int t = 0; t < 4; ++t) { float part = 0.f;
#pragma unroll
          for (int e = 0; e < 16; ++e) part += c0[e] * L[LQ + t * 64 + 16 * kq + e];
          const float inter = red4(part);
          float num = wi[t] * inter, den = wi[t] * L[LQN + t];
#pragma unroll
          for (int s = 0; s < 4; ++s) { const float sm = L[LS + t * 4 + s]; num += sm * L[LV + s * 128 + v]; den += sm; }
          hvv[t] = num / fmaxf(fabsf(den), ei[t]); }
#pragma unroll
      for (int t = 0; t < 4; ++t) { const float x = wave_sum(kq == 0 ? hvv[t] * hvv[t] : 0.f); if (lane == 0) L[LHS + w * 4 + t] = x; }
      float cn[16];
#pragma unroll
      for (int e = 0; e < 16; ++e) { float a = wst * c0[e];
#pragma unroll
          for (int s = 0; s < 4; ++s) a += wsv[s] * L[LV + s * 128 + v] * L[LK + s * 64 + 16 * kq + e];
          cn[e] = a; }
#pragma unroll
      for (int e4 = 0; e4 < 4; ++e4) *(f32x4*)(out + O_S_C + coff + 4 * e4) = (f32x4){cn[4 * e4], cn[4 * e4 + 1], cn[4 * e4 + 2], cn[4 * e4 + 3]}; }
    __syncthreads();
    if (kq == 0) {
#pragma unroll
        for (int t = 0; t < 4; ++t) { float tot = 0.f;
#pragma unroll
            for (int ww = 0; ww < 8; ++ww) tot += L[LHS + ww * 4 + t];
            const float sc = 1.0f / sqrtf(tot * (1.f / 128.f) + NORM_EPS); const size_t off = (size_t)(row0 + t) * D + hh * 128 + v;
            HOb[off] = f2bf1(hvv[t] * sc * norm_w[hh * 128 + v] * bf1(OOb[off])); } }
    if (tid < 64) { float a = wst * n0[(size_t)(b * 8 + hh) * 64 + tid];
#pragma unroll
        for (int s = 0; s < 4; ++s) a += wsv[s] * L[LK + s * 64 + tid];
        out[O_S_N + (size_t)(b * 8 + hh) * 64 + tid] = a; }
    if (tid == 0) out[O_S_M + b * 8 + hh] = m_new;
    __syncthreads();
}

constexpr int CA_AH = 0, CA_BH = 9216, CA_KH = 18432, CA_RH = 27648, CA_BT = 36864, CA_KT = 46080, CA_VT = 55296, CA_AB = 64512, CA_AK = 73728, CA_RB = 82944, CA_RK = 92160, CA_XT = 101376,
              CA_TD = 119808, CA_NF = 123904, CA_GL = 128000, CA_LG = CA_AB  , CA_AT = CA_KH  ;
__device__ __forceinline__ bf16x8 ldsfrag(LAS unsigned char* lds, int base, int row, int ks, int fq) { return *(const LAS bf16x8*)(lds + base + row * PBY + ks * 64 + fq * 16); }
__device__ __forceinline__ void rwkv_chunk_item(const Frame& F, int chain, int chunk, bf16* Rb, bf16* Kb, bf16* Vb, bf16* Db, bf16* Ab, bf16* Gb,
                                                const float* k_k, const float* k_a, const float* r_k, float* BON, bf16* dummy, v4u (&pf)[6], const int nchain, const int nchunk) {
    LAS unsigned char* lds = F.lds;
    const int tid = F.tid, lane = F.lane, w = F.wave, fr = lane & 15, fq = lane >> 4, cg = tid & 7, tt = tid >> 3;
    const int h = chain & 15, row0 = (chain >> 4) * PT + 64 * chunk, ch = h * 64 + 8 * cg;
    const size_t goff = (size_t)(row0 + tt) * D + ch;
    LAS float* LG = (LAS float*)(lds + CA_LG); LAS float* GLf = (LAS float*)(lds + CA_GL);
    float r8[8], kp[8], av[8], bv[8], rd[8];
    {
        float k8[8], v8[8], d8[8], a8[8];
        unpack8(pf[0], r8); unpack8(pf[1], k8); unpack8(pf[2], v8); unpack8(pf[3], d8); unpack8(pf[4], a8);
        float ss = 0.f;
#pragma unroll
        for (int j = 0; j < 8; ++j) { av[j] = k8[j] * k_k[ch + j]; ss += av[j] * av[j]; }
        ss = red8(ss); const float inv = __builtin_amdgcn_rsqf(fmaxf(ss, 1e-24f));
        float bsum = 0.f;
#pragma unroll
        for (int j = 0; j < 8; ++j) { const float kk = av[j] * inv; kp[j] = k8[j] * (1.f + (a8[j] - 1.f) * k_a[ch + j]); bv[j] = kk * a8[j]; av[j] = -kk; bsum += r8[j] * kp[j] * r_k[ch + j]; rd[j] = __builtin_amdgcn_rcpf(1.f - d8[j]); }
        const float bon = red8(bsum);
#pragma unroll
        for (int j = 0; j < 8; ++j) { LG[(8 * cg + j) * 64 + tt] = __logf(1.f - d8[j]); ((lds_u16*)(lds + CA_VT))[(8 * cg + j) * 72 + tt] = f2bf1(v8[j]); }
        if (cg == 0 && !dummy) BON[(size_t)(row0 + tt) * 16 + h] = bon;
    }
    for (int i = tid; i < 128 * 9; i += 512) ((LAS v4u*)(lds + CA_XT))[i] = (v4u){0u, 0u, 0u, 0u};
    __syncthreads();
    { float x[8];
#pragma unroll
      for (int q = 0; q < 8; ++q) x[q] = LG[(8 * w + q) * 64 + lane];
#pragma unroll
      for (int q = 0; q < 8; ++q) {
          float v = x[q];
          v += __builtin_bit_cast(float, __builtin_amdgcn_update_dpp(0, __builtin_bit_cast(int, v), 0x111, 0xF, 0xF, true));
          v += __builtin_bit_cast(float, __builtin_amdgcn_update_dpp(0, __builtin_bit_cast(int, v), 0x112, 0xF, 0xF, true));
          v += __builtin_bit_cast(float, __builtin_amdgcn_update_dpp(0, __builtin_bit_cast(int, v), 0x114, 0xF, 0xF, true));
          v += __builtin_bit_cast(float, __builtin_amdgcn_update_dpp(0, __builtin_bit_cast(int, v), 0x118, 0xF, 0xF, true));
          v += __builtin_bit_cast(float, __builtin_amdgcn_update_dpp(0, __builtin_bit_cast(int, v), 0x142, 0xA, 0xF, false));
          v += __builtin_bit_cast(float, __builtin_amdgcn_update_dpp(0, __builtin_bit_cast(int, v), 0x143, 0xC, 0xF, false));
          x[q] = v; }
#pragma unroll
      for (int q = 0; q < 8; ++q) LG[(8 * w + q) * 64 + lane] = x[q]; }
    __syncthreads();
    {
        float ah[8], bh[8], kh[8], rh[8];
#pragma unroll
        for (int j = 0; j < 8; ++j) { const float lg = LG[(8 * cg + j) * 64 + tt]; const float G = __expf(lg), Gm1 = G * rd[j], Gi = __builtin_amdgcn_rcpf(G);
            ah[j] = av[j] * Gm1; bh[j] = bv[j] * Gi; kh[j] = kp[j] * Gi; rh[j] = r8[j] * G;
            ((lds_u16*)(lds + CA_BT))[(8 * cg + j) * 72 + tt] = f2bf1(bh[j]); ((lds_u16*)(lds + CA_KT))[(8 * cg + j) * 72 + tt] = f2bf1(kh[j]);
            if (tt == 63) GLf[8 * cg + j] = G; }
        *(LAS v4u*)(lds + CA_AH + tt * PBY + 16 * cg) = pack8(ah); *(LAS v4u*)(lds + CA_BH + tt * PBY + 16 * cg) = pack8(bh);
        *(LAS v4u*)(lds + CA_KH + tt * PBY + 16 * cg) = pack8(kh); *(LAS v4u*)(lds + CA_RH + tt * PBY + 16 * cg) = pack8(rh);
    }
    __syncthreads();
    {
        const int mi = w >> 1, ti0 = 2 * (w & 1); const int abase = mi < 2 ? CA_AH : CA_RH, bbase = (mi & 1) ? CA_KH : CA_BH, dbase = CA_AB + mi * 9216;
        bf16x8 af[2][2], bfr[4][2];
#pragma unroll
        for (int a = 0; a < 2; ++a)
#pragma unroll
            for (int ks = 0; ks < 2; ++ks) af[a][ks] = ldsfrag(lds, abase, 16 * (ti0 + a) + fr, ks, fq);
#pragma unroll
        for (int sj = 0; sj < 4; ++sj)
#pragma unroll
            for (int ks = 0; ks < 2; ++ks) bfr[sj][ks] = ldsfrag(lds, bbase, 16 * sj + fr, ks, fq);
#pragma unroll
        for (int a = 0; a < 2; ++a)
#pragma unroll
            for (int sj = 0; sj < 4; ++sj) { const int ti = ti0 + a; f32x4 acc = {0.f, 0.f, 0.f, 0.f};
#pragma unroll
                for (int ks = 0; ks < 2; ++ks) acc = MFMA16(bfr[sj][ks], af[a][ks], acc);
                const int t = 16 * ti + fr;
#pragma unroll
                for (int r = 0; r < 4; ++r) { const int s = 16 * sj + 4 * fq + r; acc[r] = (mi < 2 ? s < t : s <= t) ? acc[r] : 0.f; }
                typedef unsigned u2v_ __attribute__((ext_vector_type(2))); u2v_ pw; pw.x = pkbf(acc[0], acc[1]); pw.y = pkbf(acc[2], acc[3]);
                *(LAS u2v_*)(lds + dbase + (t * 72 + 16 * sj + 4 * fq) * 2) = pw;
                if (mi == 0 && ti == sj) *(LAS f32x4*)(lds + CA_NF + (ti * 256 + fr * 16 + 4 * fq) * 4) = acc; }
    }
    __syncthreads();
    f32x4 rhs[4];
    if (w == 0) { const int blk = fq, c = fr; const LAS float* N = (const LAS float*)(lds + CA_NF) + blk * 256; float T[16];
#pragma unroll
        for (int i = 0; i < 16; ++i) T[i] = (i == c) ? 1.f : 0.f;
#pragma unroll
        for (int j = 0; j < 15; ++j) {
#pragma unroll
            for (int i = j + 1; i < 16; ++i) T[i] += N[i * 16 + j] * T[j]; }
        lds_u16* td = (lds_u16*)(lds + CA_TD) + blk * 512;
#pragma unroll
        for (int i = 0; i < 16; ++i) { td[i * 32 + c] = f2bf1(T[i]); td[i * 32 + 16 + c] = 0; } }
    if (w < 4) {
#pragma unroll
        for (int i = 0; i < 4; ++i)
#pragma unroll
            for (int r = 0; r < 4; ++r) rhs[i][r] = bf1(((lds_u16*)(lds + CA_AH))[(16 * i + 4 * fq + r) * 72 + 16 * w + fr]);
    } else {
#pragma unroll
        for (int i = 0; i < 4; ++i) { f32x4 acc = {0.f, 0.f, 0.f, 0.f};
#pragma unroll
            for (int ks = 0; ks < 2; ++ks) acc = MFMA16(ldsfrag(lds, CA_AK, 16 * i + fr, ks, fq), ldsfrag(lds, CA_VT, 16 * (w - 4) + fr, ks, fq), acc);
            rhs[i] = acc; }
    }
    __syncthreads();
    {
        LAS unsigned char* AT = lds + CA_AT + w * 1024;
        *(LAS unsigned long long*)(AT + fr * 64 + 32 + fq * 8) = 0ull;
#pragma unroll
        for (int i = 0; i < 4; ++i) { f32x4 acc = rhs[i];
#pragma unroll
            for (int ks = 0; ks < 2; ++ks) acc = MFMA16(ldsfrag(lds, CA_AB, 16 * i + fr, ks, fq), ldsfrag(lds, CA_XT, 16 * w + fr, ks, fq), acc);
            typedef unsigned u2v __attribute__((ext_vector_type(2)));
            u2v pa; pa.x = pkbf(acc[0], acc[1]); pa.y = pkbf(acc[2], acc[3]);
            *(LAS u2v*)(AT + fr * 64 + fq * 8) = pa;
            asm volatile("s_waitcnt lgkmcnt(0)" ::: "memory");
            f32x4 xi = {0.f, 0.f, 0.f, 0.f};
            xi = MFMA16(*(const LAS bf16x8*)(lds + CA_TD + i * 1024 + fr * 64 + fq * 16), *(const LAS bf16x8*)(AT + fr * 64 + fq * 16), xi);
            u2v px; px.x = pkbf(xi[0], xi[1]); px.y = pkbf(xi[2], xi[3]);
            *(LAS u2v*)(lds + CA_XT + (16 * w + fr) * PBY + (16 * i + 4 * fq) * 2) = px;
            asm volatile("s_waitcnt lgkmcnt(0)" ::: "memory"); }
    }
    __syncthreads();
    if (nchain >= 0) { const size_t no = (size_t)((nchain >> 4) * PT + 64 * nchunk + tt) * D + (nchain & 15) * 64 + 8 * cg;
        pf[0] = *(const v4u*)(Rb + no); pf[1] = *(const v4u*)(Kb + no); pf[2] = *(const v4u*)(Vb + no); pf[3] = *(const v4u*)(Db + no); pf[4] = *(const v4u*)(Ab + no); }
    {
        const int mi = w >> 1, ti0 = 2 * (w & 1); const int obase = mi == 0 ? CA_AB : (mi == 1 ? CA_AK : (mi == 2 ? CA_AH : CA_KH));
        const int a1 = mi < 2 ? CA_RB : (mi == 2 ? CA_BT : CA_XT), a1o = mi == 3 ? 64 : 0, b1 = mi == 3 ? CA_BT : CA_XT, b1o = mi == 1 ? 64 : 0;
        const int a2 = mi == 1 ? CA_RK : CA_VT, b2 = mi == 1 ? CA_VT : CA_KT; const bool two = (mi & 1) != 0;
        bf16x8 af[2][2], bfr[4][2];
#pragma unroll
        for (int a = 0; a < 2; ++a)
#pragma unroll
            for (int ks = 0; ks < 2; ++ks) af[a][ks] = ldsfrag(lds, a1, a1o + 16 * (ti0 + a) + fr, ks, fq);
#pragma unroll
        for (int tj = 0; tj < 4; ++tj)
#pragma unroll
            for (int ks = 0; ks < 2; ++ks) bfr[tj][ks] = ldsfrag(lds, b1, b1o + 16 * tj + fr, ks, fq);
        f32x4 acc[2][4];
#pragma unroll
        for (int a = 0; a < 2; ++a)
#pragma unroll
            for (int tj = 0; tj < 4; ++tj) { acc[a][tj] = (f32x4){0.f, 0.f, 0.f, 0.f};
#pragma unroll
                for (int ks = 0; ks < 2; ++ks) acc[a][tj] = MFMA16(bfr[tj][ks], af[a][ks], acc[a][tj]); }
        if (two) {
#pragma unroll
            for (int a = 0; a < 2; ++a)
#pragma unroll
                for (int ks = 0; ks < 2; ++ks) af[a][ks] = ldsfrag(lds, a2, 16 * (ti0 + a) + fr, ks, fq);
#pragma unroll
            for (int tj = 0; tj < 4; ++tj)
#pragma unroll
                for (int ks = 0; ks < 2; ++ks) bfr[tj][ks] = ldsfrag(lds, b2, 16 * tj + fr, ks, fq);
#pragma unroll
            for (int a = 0; a < 2; ++a)
#pragma unroll
                for (int tj = 0; tj < 4; ++tj)
#pragma unroll
                    for (int ks = 0; ks < 2; ++ks) acc[a][tj] = MFMA16(bfr[tj][ks], af[a][ks], acc[a][tj]);
        }
#pragma unroll
        for (int a = 0; a < 2; ++a) { const int row = 16 * (ti0 + a) + fr; const float glr = GLf[row];
#pragma unroll
            for (int tj = 0; tj < 4; ++tj) { const int col = 16 * tj + 4 * fq; f32x4 val = acc[a][tj];
                typedef unsigned u2v_ __attribute__((ext_vector_type(2)));
                if (mi == 0) { const u2v_ rr = *(const LAS u2v_*)(lds + CA_RH + (row * 72 + col) * 2); val += (f32x4){bflo(rr.x), bfhi(rr.x), bflo(rr.y), bfhi(rr.y)}; }
                else if (mi == 2) {
#pragma unroll
                    for (int r = 0; r < 4; ++r) val[r] = glr * (val[r] + (row == col + r ? 1.f : 0.f)); }
                else if (mi == 3) val = val * *(const LAS f32x4*)(GLf + col);
                u2v_ pw; pw.x = pkbf(val[0], val[1]); pw.y = pkbf(val[2], val[3]);
                *(LAS u2v_*)(lds + obase + (row * 72 + col) * 2) = pw; } }
    }
    __syncthreads();
    *(v4u*)((dummy ? dummy : Rb) + goff) = *(const LAS v4u*)(lds + CA_AB + tt * PBY + 16 * cg);
    *(v4u*)((dummy ? dummy : Ab) + goff) = *(const LAS v4u*)(lds + CA_AK + tt * PBY + 16 * cg);
    *(v4u*)((dummy ? dummy : Kb) + goff) = *(const LAS v4u*)(lds + CA_AH + tt * PBY + 16 * cg);
    *(v4u*)((dummy ? dummy : Db) + goff) = *(const LAS v4u*)(lds + CA_KH + tt * PBY + 16 * cg);
    __syncthreads();
}
constexpr int CB_S = 0, CB_P2 = 9216, CB_P3 = 18432, CB_Y0 = 27648, CB_Z0 = 36864, CB_YS = 46080  ;
__device__ __forceinline__ void rwkv_state_chain(const Frame& F, int chain, float* ST, const bf16* Rb, const bf16* Kb, const bf16* Vb, const bf16* Db, const bf16* Ab, bf16* Gb, const float* BON, const float* gn_w, const float* gn_b, bf16* dummy) {
    LAS unsigned char* lds = F.lds;
    const int tid = F.tid, lane = F.lane, w = F.wave, fr = lane & 15, fq = lane >> 4, cg = tid & 7, tt = tid >> 3;
    const int h = chain & 15, rowc0 = (chain >> 4) * PT, ch = h * 64 + 8 * cg;
    for (int i = tid; i < 64 * 36; i += 512) ((LAS unsigned*)(lds + CB_S))[i] = 0u;
    f32x4 Sacc[2];
    Sacc[0] = (f32x4){0.f, 0.f, 0.f, 0.f}; Sacc[1] = Sacc[0];
    v4u q2, q3, qy, qz, qg, qb; float qbon;
    float cgw[8], cgb[8];
#pragma unroll
    for (int j = 0; j < 8; ++j) { cgw[j] = gn_w[ch + j]; cgb[j] = gn_b[ch + j]; }
#define CB_LOAD(cc) do { const size_t o_ = (size_t)(rowc0 + 64 * (cc) + tt) * D + ch; q2 = *(const v4u*)(Rb + o_); q3 = *(const v4u*)(Kb + o_); qy = *(const v4u*)(Ab + o_); qz = *(const v4u*)(Db + o_); \
        qg = *(const v4u*)(Gb + o_); qb = *(const v4u*)(Vb + o_); qbon = BON[(size_t)(rowc0 + 64 * (cc) + tt) * 16 + h]; } while (0)
    CB_LOAD(0);
    for (int c = 0; c < PT / 64; ++c) {
        *(LAS v4u*)(lds + CB_P2 + tt * PBY + 16 * cg) = q2; *(LAS v4u*)(lds + CB_P3 + tt * PBY + 16 * cg) = q3;
        *(LAS v4u*)(lds + CB_Y0 + tt * PBY + 16 * cg) = qy; *(LAS v4u*)(lds + CB_Z0 + tt * PBY + 16 * cg) = qz;
        float gw[8], gb[8]; unpack8(qg, gw); unpack8(qb, gb);
        const float bonc = qbon;
        if (c + 1 < PT / 64) CB_LOAD(c + 1);
        __syncthreads();
        f32x4 yacc[2];
        typedef unsigned u2v_ __attribute__((ext_vector_type(2)));
#pragma unroll
        for (int q = 0; q < 2; ++q) { const int tq = 2 * w + q, ti = tq >> 2, tj = tq & 3, row = 16 * ti + fr, col = 16 * tj + 4 * fq;
            const u2v_ y0 = *(const LAS u2v_*)(lds + CB_Y0 + (row * 72 + col) * 2), z0 = *(const LAS u2v_*)(lds + CB_Z0 + (row * 72 + col) * 2);
            f32x4 ya = {bflo(y0.x), bfhi(y0.x), bflo(y0.y), bfhi(y0.y)}, sa = {bflo(z0.x), bfhi(z0.x), bflo(z0.y), bfhi(z0.y)};
#pragma unroll
            for (int ks = 0; ks < 2; ++ks) { ya = MFMA16(ldsfrag(lds, CB_S, 16 * tj + fr, ks, fq), ldsfrag(lds, CB_P2, 16 * ti + fr, ks, fq), ya);
                                             sa = MFMA16(ldsfrag(lds, CB_P3, 16 * tj + fr, ks, fq), ldsfrag(lds, CB_S, 16 * ti + fr, ks, fq), sa); }
            yacc[q] = ya; Sacc[q] = sa; }
        __syncthreads();
#pragma unroll
        for (int q = 0; q < 2; ++q) { const int tq = 2 * w + q, ti = tq >> 2, tj = tq & 3, row = 16 * ti + fr, col = 16 * tj + 4 * fq;
            u2v_ pw; pw.x = pkbf(Sacc[q][0], Sacc[q][1]); pw.y = pkbf(Sacc[q][2], Sacc[q][3]);
            *(LAS u2v_*)(lds + CB_S + (row * 72 + col) * 2) = pw;
            *(LAS f32x4*)(lds + CB_YS + (row * 64 + col) * 4) = yacc[q]; }
        __syncthreads();
        { const f32x4 y0 = *(const LAS f32x4*)(lds + CB_YS + (tt * 64 + 8 * cg) * 4), y1 = *(const LAS f32x4*)(lds + CB_YS + (tt * 64 + 8 * cg + 4) * 4);
          float yy[8] = {y0.x, y0.y, y0.z, y0.w, y1.x, y1.y, y1.z, y1.w}; float s1 = 0.f;
#pragma unroll
          for (int j = 0; j < 8; ++j) s1 += yy[j];
          const float mean = red8(s1) * (1.f / 64.f); float s2 = 0.f;
#pragma unroll
          for (int j = 0; j < 8; ++j) { yy[j] -= mean; s2 += yy[j] * yy[j]; }
          const float rstd = __builtin_amdgcn_rsqf(red8(s2) * (1.f / 64.f) + GN_EPS);
          float o[8];
#pragma unroll
          for (int j = 0; j < 8; ++j) o[j] = ((yy[j] * rstd) * cgw[j] + cgb[j] + bonc * gb[j]) * gw[j];
          *(v4u*)((dummy ? dummy : Gb) + (size_t)(rowc0 + 64 * c + tt) * D + ch) = pack8(o); }
    }
#undef CB_LOAD
#pragma unroll
    for (int q = 0; q < 2; ++q) { const int tq = 2 * w + q, ti = tq >> 2, tj = tq & 3; *(f32x4*)(ST + (16 * ti + fr) * 64 + 16 * tj + 4 * fq) = Sacc[q]; }
    __syncthreads();
}

#ifndef MK_N_LAUNCHES
#define MK_N_LAUNCHES 1
#endif
constexpr int N_PHASES = 22;
#ifndef PROBE_PH
#define PROBE_PH (-1)
#define PROBE_N 1
#endif
#ifndef PROBE_VAR
#define PROBE_VAR 0
#endif
#ifndef EN_MASK
#define EN_MASK 0xff
#endif
constexpr bool EN_NORM = EN_MASK & 1, EN_UP = EN_MASK & 2, EN_RES = EN_MASK & 4, EN_RW = EN_MASK & 8, EN_L2 = EN_MASK & 16, EN_SCAN = EN_MASK & 32, EN_IN = EN_MASK & 64, EN_ML = EN_MASK & 128;
struct Args { const float* in[N_IN]; float* out; unsigned char* ws; int ph_lo, ph_hi; };
__global__ void __launch_bounds__(NWAVES * 64, 2) mega_fwd(Args args) {
    extern __shared__ __attribute__((aligned(16))) unsigned char lds_raw[];
    { const int t0 = threadIdx.x;
      for (int u = t0; u < (LDS_BYTES - LDSCTL_OFF) / 4; u += NWAVES * 64) ((LAS unsigned*)((LAS unsigned char*)lds_raw + LDSCTL_OFF))[u] = 0u; }
    __syncthreads();
    { const int t0 = threadIdx.x; if (t0 < N_IN) ((LAS unsigned long long*)((LAS unsigned char*)lds_raw + TAB_OFF))[t0] = (unsigned long long)args.in[t0]; }
    __syncthreads();
    XcdBarrier bar; bar.bar = (unsigned*)((gu32*)(args.ws + WS_CTL) + CW_BAR); bar.x = 0; bar.st = nullptr;
    if (args.ph_hi - args.ph_lo > 1) bar = xcd_barrier_post((unsigned*)((gu32*)(args.ws + WS_CTL) + CW_BAR), (volatile LAS unsigned*)((LAS unsigned char*)lds_raw + MISC_OFF) + 8);
    int ph = args.ph_lo, rep = 0;
    while (ph < args.ph_hi) {
        int tid_ = threadIdx.x; asm volatile("" : "+v"(tid_));
        unsigned char* ws = args.ws; float* out = args.out;
        Frame F;
        F.lds = (LAS unsigned char*)lds_raw;
        F.MISC = (volatile LAS unsigned*)(F.lds + MISC_OFF);
        F.tid = tid_; F.lane = F.tid & 63; F.wave = __builtin_amdgcn_readfirstlane(F.tid >> 6);
        F.G = gridDim.x; { const int bx = blockIdx.x; F.vcu = (F.G % 8 == 0) ? (bx % 8) * (F.G / 8) + bx / 8 : bx; }
        F.ctl = (gu32*)(ws + WS_CTL); F.tab = (volatile LAS unsigned long long*)(F.lds + TAB_OFF);
        bf16* Wb = (bf16*)(ws + WS_W); bf16* XR = (bf16*)(ws + WS_XR); unsigned char* big = ws + WS_BIG;
        bf16* Hb = (bf16*)(big + B_H); bf16* XN = (bf16*)(big + B_XN); float* SLAB = (float*)(big + B_SLAB);
        bf16* ACAT = (bf16*)(big + B_ACAT); bf16* Rb = (bf16*)(big + B_R); bf16* Kb = (bf16*)(big + B_K); bf16* Vb = (bf16*)(big + B_V); bf16* DECb = (bf16*)(big + B_DEC); bf16* AAb = (bf16*)(big + B_AA);
        bf16* QKR = (bf16*)(big + B_QKR); bf16* VVb = (bf16*)(big + B_VV); bf16* HOb = (bf16*)(big + B_HO); bf16* OOb = (bf16*)(big + B_OO); float* IFb = (float*)(big + B_IF);
        bf16* GGb = (bf16*)((unsigned char*)out + OS_GG); bf16* LORA = (bf16*)((unsigned char*)out + OS_LORA);
        const int c_id = (int)blockIdx.x;
        const int nrep = (ph == PROBE_PH && ph != 6 && !(ph == 16 && PROBE_VAR != 0)) ? PROBE_N : 1;
        const int pvar = (rep + 1 < nrep) ? PROBE_VAR : 0;
        if (EN_NORM && (ph == 0 || ph == 3 || ph == 8 || ph == 11 || ph == 14 || ph == 18 || ph == 21)) {
            int kind = 0, layer = 0, ab = 0, nslab = 0; float coef = 0.5f; const float* gain = nullptr;
            if (ph == 0) { kind = 0; layer = 0; ab = 0; gain = inptr(F, I_NFA); nslab = 0; }
            else if (ph == 3) { kind = 1; gain = inptr(F, I_NMIX); nslab = 11; }
            else if (ph == 8) { kind = 0; layer = 0; ab = 1; gain = inptr(F, I_NFB); nslab = 4; coef = 1.f; }
            else if (ph == 11) { kind = 0; layer = 1; ab = 0; gain = inptr(F, I_NFA) + D; nslab = 11; }
            else if (ph == 14) { kind = 2; gain = inptr(F, I_NMIX) + D; nslab = 11; }
            else if (ph == 18) { kind = -1; gain = inptr(F, I_NFB) + D; nslab = 4; coef = 1.f; }
            else { kind = -1; gain = inptr(F, I_NFIN); nslab = 11; }
            if (kind >= 0) convert_weights(F, kind, layer, ab, Wb);
            if (ph == 0) norm_rows<0, true, true>(F, inptr(F, I_XP), inptr(F, I_XS), nslab, coef, SLAB, XR, gain, XN, nullptr, out, pvar);
            else if (ph == 3) mix_rows(F, XR, inptr(F, I_XS), nslab, coef, SLAB, XR, gain, inptr(F, I_MU), (bf16*)(ws + WS_XM), inptr(F, I_RSHIFT), out, pvar);
            else if (ph == 21) norm_rows<2, false, false>(F, XR, XR + (size_t)MP * D, nslab, coef, SLAB, XR, gain, nullptr, nullptr, out, pvar);
            else norm_rows<0, false, false>(F, XR, XR + (size_t)MP * D, nslab, coef, SLAB, XR, gain, XN, nullptr, out, pvar);
        } else if (EN_UP && (ph == 1 || ph == 9 || ph == 12 || ph == 19)) {
            const bf16* Wu = ph == 19 ? (const bf16*)(ws + WS_W2) : Wb;
            pg8::Gemm g{XN, Wu + W_GU / 2, M, 2 * FF, D}; pg8::UnitOrder S; S.init(M / 256, 2 * FF / 256, D, F.G, c_id, 0);
            EpiSwiglu E{Hb, pvar};
            pg8::gemm_phase<EpiSwiglu, pg8::UnitOrder, true, true>(F.lds, g, S, E, F.tid);
        } else if (EN_RES && (ph == 2 || ph == 7 || ph == 10 || ph == 13 || ph == 17 || ph == 20)) {
            const bf16* A = Hb; const bf16* Bt = (ph == 20 ? (const bf16*)(ws + WS_W2) : Wb) + W_D / 2; int K = FF; float coef = 0.5f; const float* basef = nullptr;
            if (ph == 2) basef = inptr(F, I_XP);
            if (ph == 7) { A = GGb; Bt = Wb + W_O / 2; K = D; coef = 1.f; }
            if (ph == 17) { A = HOb; Bt = Wb + W_OUT / 2; K = D; coef = 1.f; }
            pg8::Gemm g{A, Bt, M, D, K}; pg8::UnitOrder S; S.init(MP / 256, D / 256, K, F.G, c_id, K / 256);
            EpiRes E{basef, XR, XR, SLAB, coef};
            pg8::gemm_phase<EpiRes, pg8::UnitOrder, true, true>(F.lds, g, S, E, F.tid);
        } else if (EN_RW && ph == 4) {
            pg8::Gemm g{(const bf16*)(ws + WS_XM), Wb + W_RW / 2, 6 * M, NRW2, D}; pg8::UnitOrder S; S.init(M / 256, NRW2 / 256, D, F.G, c_id, -2);
            EpiRw E{Rb, Kb, Vb, LORA};
            pg8::gemm_phase<EpiRw, pg8::UnitOrder, true, true>(F.lds, g, S, E, F.tid);
        } else if (EN_L2 && ph == 5) {
            pg8::Gemm g{LORA, Wb + W_L2 / 2, M, NL2, KL2}; pg8::UnitOrder S; S.init(M / 256, NL2 / 256, KL2, F.G, c_id, -1);
            EpiL2 E{DECb, AAb, GGb, inptr(F, I_W0), inptr(F, I_A0)};
            pg8::gemm_phase<EpiL2, pg8::UnitOrder, true, true>(F.lds, g, S, E, F.tid);
        } else if (EN_SCAN && ph == 6) {
            bf16* dummy = (bf16*)(ws + WS_YRAW);
            for (int dr = (PROBE_PH == 6 && PROBE_VAR == 5) ? PROBE_N - 1 : 0; dr >= 0; --dr) {
                v4u pf[6]; pf[5] = (v4u){0u, 0u, 0u, 0u};
                { const int it = F.vcu, cg_ = F.tid & 7, tt_ = F.tid >> 3; const size_t o = (size_t)(((it >> 5) >> 4) * PT + 64 * (it & 31) + tt_) * D + ((it >> 5) & 15) * 64 + 8 * cg_;
                  pf[0] = *(const v4u*)(Rb + o); pf[1] = *(const v4u*)(Kb + o); pf[2] = *(const v4u*)(Vb + o); pf[3] = *(const v4u*)(DECb + o); pf[4] = *(const v4u*)(AAb + o); }
                for (int it = F.vcu; it < PB * 16 * (PT / 64); it += F.G) { const int nx = it + F.G < PB * 16 * (PT / 64) ? it + F.G : -1;
                    rwkv_chunk_item(F, it >> 5, it & 31, Rb, Kb, Vb, DECb, AAb, GGb, inptr(F, I_KK), inptr(F, I_KA), inptr(F, I_RK), (float*)(ws + WS_BON), dr ? dummy : nullptr, pf, nx < 0 ? -1 : nx >> 5, nx & 31); }
            }
            xcd_barrier(bar);
            for (int dr = (PROBE_PH == 6 && PROBE_VAR == 6) ? PROBE_N - 1 : 0; dr >= 0; --dr)
                if (F.vcu < 128) rwkv_state_chain(F, F.vcu, out + O_P_S + (size_t)F.vcu * 4096, Rb, Kb, Vb, DECb, AAb, GGb, (const float*)(ws + WS_BON), inptr(F, I_GNW), inptr(F, I_GNB), dr ? dummy : nullptr);
            { const int i0 = F.vcu < 128 ? 2 * F.vcu : 256 + 14 * (F.vcu - 128), i1 = F.vcu < 128 ? i0 + 2 : i0 + 14;
              for (int i = i0; i < i1; ++i) { const int b = i >> 4, h = i & 15;
                  rwkv_chain(F, MP + b * STK, STK, h, inptr(F, I_RS) + (size_t)i * 4096, out + O_S_S + (size_t)i * 4096, Rb, Kb, Vb, DECb, AAb, GGb, inptr(F, I_KK), inptr(F, I_KA), inptr(F, I_RK), inptr(F, I_GNW), inptr(F, I_GNB), true, 0); } }
        } else if (EN_IN && ph == 15) {
            pg8::Gemm g{XN, Wb + W_IN / 2, M, NIN, D}; pg8::UnitOrder S; S.init(M / 256, NIN / 256, D, F.G, c_id, 0);
            EpiIn E{QKR, VVb, OOb, IFb, inptr(F, I_BIF), pvar};
            pg8::gemm_phase<EpiIn, pg8::UnitOrder, true, true>(F.lds, g, S, E, F.tid);
        } else if (EN_ML && ph == 16) {
            float* NUM = out + O_Y; float* DEN = (float*)(ws + WS_BON); bf16* Qs = (bf16*)(big + 100 * MiB)  ; float* SEG = (float*)(ws + WS_YRAW);
            for (int i = F.vcu; i < PB * 8 * ML_NSEG * ((PROBE_PH == 16 && PROBE_VAR == 1) ? PROBE_N : 1); i += F.G) { const int chain = i & 63, seg = (i >> 6) & 3;
                mlstm_prompt_chain(F, chain >> 3, chain & 7, seg, QKR, VVb, OOb, IFb, HOb, inptr(F, I_CW), inptr(F, I_CB), inptr(F, I_MNW), NUM, DEN, Qs, SEG, 0); }
            xcd_barrier(bar);
            for (int i = F.vcu; i < 256 * ((PROBE_PH == 16 && PROBE_VAR == 2) ? PROBE_N : 1) - 64; i += F.G) { const int chain = i & 63, seg = 1 + ((i >> 6) & 3); if (seg > 3) continue;
                mlstm_fix_seg(F, chain >> 3, chain & 7, seg, QKR, OOb, IFb, HOb, inptr(F, I_MNW), NUM, DEN, Qs, SEG, out); }
            if (F.G == 256) {
                if (F.vcu >= 192) { for (int j = 0; j < 9; ++j) { const int i = (F.vcu - 192) * 9 + j;
                    mlstm_sample_item(F, i >> 3, i & 7, QKR, VVb, OOb, IFb, HOb, inptr(F, I_CW), inptr(F, I_CB), inptr(F, I_MNW), inptr(F, I_MC), inptr(F, I_MN), inptr(F, I_MM), inptr(F, I_MCONV), out); } }
                else { for (int i = 576 + F.vcu; i < SB * 8; i += 192)
                    mlstm_sample_item(F, i >> 3, i & 7, QKR, VVb, OOb, IFb, HOb, inptr(F, I_CW), inptr(F, I_CB), inptr(F, I_MNW), inptr(F, I_MC), inptr(F, I_MN), inptr(F, I_MM), inptr(F, I_MCONV), out); }
            } else {
                for (int i = F.vcu; i < SB * 8; i += F.G)
                    mlstm_sample_item(F, i >> 3, i & 7, QKR, VVb, OOb, IFb, HOb, inptr(F, I_CW), inptr(F, I_CB), inptr(F, I_MNW), inptr(F, I_MC), inptr(F, I_MN), inptr(F, I_MM), inptr(F, I_MCONV), out);
            }
            if (rep + 1 == nrep) convert_weights(F, 0, 1, 1, (bf16*)(ws + WS_W2));
        }
        if (++rep < nrep) continue;
        rep = 0;
        if (ph + 1 < args.ph_hi) xcd_barrier(bar);
        ++ph;
    }
}

extern "C" void kernel_launch(void* const* d_in, const int* in_sizes, int n_in, void* d_out, int out_size, void* d_ws, size_t ws_size, hipStream_t stream) {
    static int grid = 0;
    if (grid == 0) {
        if (n_in != N_IN || out_size != (int)O_END || ws_size < WS_END3) { fprintf(stderr, "kernel_launch: unexpected shapes (n_in %d, out %d, ws %zu); nothing launched\n", n_in, out_size, ws_size); grid = -1; return; }
        int dev = 0, cus = 0, per_cu = 0;
        if (hipGetDevice(&dev) != hipSuccess || hipDeviceGetAttribute(&cus, hipDeviceAttributeMultiprocessorCount, dev) != hipSuccess) { grid = -1; return; }
        if (hipFuncSetAttribute((const void*)mega_fwd, hipFuncAttributeMaxDynamicSharedMemorySize, LDS_BYTES) != hipSuccess) { fprintf(stderr, "kernel_launch: hipFuncSetAttribute failed\n"); grid = -1; return; }
        if (hipOccupancyMaxActiveBlocksPerMultiprocessor(&per_cu, (const void*)mega_fwd, NWAVES * 64, LDS_BYTES) != hipSuccess || per_cu < 1) { fprintf(stderr, "kernel_launch: occupancy query says %d\n", per_cu); per_cu = 1; }
        (void)hipGetLastError();
        grid = cus;
    }
    if (grid < 0) return;
    (void)hipMemsetAsync((char*)d_ws + WS_CTL, 0, CTL_ZERO_BYTES, stream);
    Args a{};
    for (int i = 0; i < N_IN; ++i) a.in[i] = (const float*)d_in[i];
    a.out = (float*)d_out; a.ws = (unsigned char*)d_ws;
#if MK_N_LAUNCHES == 1
    a.ph_lo = 0; a.ph_hi = N_PHASES;
    { void* kargs[] = {(void*)&a};
      const hipError_t e = hipLaunchCooperativeKernel((const void*)mega_fwd, dim3(grid), dim3(NWAVES * 64), kargs, LDS_BYTES, stream);
      if (e != hipSuccess) fprintf(stderr, "kernel_launch: cooperative launch failed: %s (grid %d)\n", hipGetErrorString(e), grid); }
#else
    for (int p = 0; p < N_PHASES; ++p) { a.ph_lo = p; a.ph_hi = p + 1; hipLaunchKernelGGL(mega_fwd, dim3(grid), dim3(NWAVES * 64), LDS_BYTES, stream, a); }
#endif
}
```

```cpp
#include <hip/hip_runtime.h>
#include <cstdio>
#include <cstdint>
namespace pg8 {
#define PG8_LAS __attribute__((address_space(3)))
typedef unsigned short bf16_t;
typedef short bf16x8 __attribute__((ext_vector_type(8)));
typedef float f32x4 __attribute__((ext_vector_type(4)));
typedef unsigned u32x4 __attribute__((ext_vector_type(4)));
constexpr int BM = 256, BK = 64, HALF = 128, HTB = HALF * BK * 2  , STAGE_BYTES = 8 * HTB, NXCD = 8, WGM = 8;

__host__ __device__ __forceinline__ int lds_byte(int r, int c) { const int st = (r >> 4) * 2 + (c >> 5), rr = r & 15, cc = c & 31, ob = rr * 64 + cc * 2; return st * 1024 + (ob ^ (((ob >> 9) & 1) << 5)); }
__host__ __device__ __forceinline__ void stage_rc(int b, int& R, int& C) { const int st = b / 1024, sb = b % 1024, swz = sb ^ (((sb >> 9) & 1) << 5); R = (st >> 1) * 16 + swz / 64; C = (st & 1) * 32 + (swz % 64) / 2; }
__host__ __device__ __forceinline__ int perm32(int rho) { const int n = rho >> 4, i = rho & 15; return 8 * (i >> 2) + 4 * n + (i & 3); }

struct Unit { int pm, pn, k0, nt, slab; };
struct Gemm { const bf16_t* A; const bf16_t* Bt; int M, N, K; };

struct UnitOrder {
    int nM, nN, nwg, G, c, ntf, tailS;
    __device__ __forceinline__ void init(int nM_, int nN_, int K, int G_, int c_, int tailS_) { nM = nM_; nN = nN_; nwg = nM * nN; G = G_; c = c_; ntf = K / BK; tailS = tailS_; }
    __device__ __forceinline__ bool next(int i, Unit& u) const {
        long L = (long)i * G + c;
        if (L < nwg) {
            int wgid = (int)L; { const int q = nwg / NXCD, r = nwg % NXCD, xcd = wgid % NXCD, off = wgid / NXCD; wgid = (xcd < r ? xcd * (q + 1) : r * (q + 1) + (xcd - r) * q) + off; }
            const int nig = WGM * nN, gid = wgid / nig, fm = gid * WGM, gsz = (nM - fm) < WGM ? (nM - fm) : WGM;
            u.pm = fm + ((wgid % nig) % gsz); u.pn = (wgid % nig) / gsz; u.k0 = 0; u.nt = ntf; u.slab = -1;
            if (tailS == -2) u.pm += nM * (u.pn < 12 ? (u.pn >> 2) : u.pn - 9);
            if (tailS == -1) { u.nt = 4; u.k0 = u.pn >= 8 ? 128 : 0; }
            return true;
        }
        L -= nwg; if (tailS <= 0 || L >= 8 * tailS) return false;
        int tile, sl; if (tailS == 4) { tile = (int)L >> 2; sl = (int)L & 3; } else { tile = (int)L / 11; sl = (int)L - 11 * tile; }
        u.pm = 64 + (tile >> 2); u.pn = tile & 3; u.k0 = sl * 256; u.nt = 4; u.slab = sl; return true;
    }
    __device__ __forceinline__ void a_ready(const Unit&) const {}
    __device__ __forceinline__ void done(const Unit&) const {}
};
template <class Epi, class Sched, bool ALIGN_EPI = false, bool SP2 = false>
__device__ __forceinline__ void gemm_phase(PG8_LAS unsigned char* lds, const Gemm g, const Sched& S, const Epi& E, const int tid) {
    const int wid = __builtin_amdgcn_readfirstlane(tid >> 6), lane = tid & 63, wr = wid >> 2, wc = wid & 3, fr = lane & 15, fq = lane >> 4;
    const int K = g.K;
    unsigned voffA[2], voffB[2];
#pragma unroll
    for (int i = 0; i < 2; ++i) { int R, C; stage_rc(tid * 16 + i * 8192, R, C); const int Rb = Epi::PERM ? ((R & ~31) + perm32(R & 31)) : R;
        voffA[i] = (unsigned)(R * K + C) * 2u; voffB[i] = (unsigned)(Rb * K + C) * 2u; }
    const size_t kstep = (size_t)(BK * 2);
    const size_t hstep = (size_t)HALF * K * 2;
    const size_t tstep = 2 * hstep;
    const unsigned ldsw = (unsigned)wid * 1024u;
    const int aoff = lds_byte(wr * 64 + fr, fq * 8), boff = lds_byte(wc * 32 + fr, fq * 8);
#define PG8_SA(b, h) (((b) * 2 + (h)) * HTB)
#define PG8_SB(b, h) ((4 + (b) * 2 + (h)) * HTB)
#define PG8_STAGE(bufoff, gbase, voff) do { _Pragma("unroll") for (int _i = 0; _i < 2; ++_i) \
        __builtin_amdgcn_global_load_lds((const unsigned*)((const char*)(gbase) + (voff)[_i]), (PG8_LAS unsigned*)(lds + (bufoff) + ldsw + _i * 8192), 16, 0, 0); } while (0)
#define PG8_LDA(dst, b, h) do { _Pragma("unroll") for (int m = 0; m < 4; ++m) _Pragma("unroll") for (int k = 0; k < 2; ++k) dst[m][k] = *(const PG8_LAS bf16x8*)(lds + PG8_SA(b, h) + aoff + m * 2048 + k * 1024); } while (0)
#define PG8_LDB(dst, b, h) do { _Pragma("unroll") for (int n = 0; n < 2; ++n) _Pragma("unroll") for (int k = 0; k < 2; ++k) dst[n][k] = *(const PG8_LAS bf16x8*)(lds + PG8_SB(b, h) + boff + n * 2048 + k * 1024); } while (0)
#define PG8_MMA(ai, bj, At, Bt) do { __builtin_amdgcn_s_setprio(1); _Pragma("unroll") for (int m = 0; m < 4; ++m) _Pragma("unroll") for (int n = 0; n < 2; ++n) _Pragma("unroll") for (int k = 0; k < 2; ++k) \
        acc[ai][bj][m][n] = __builtin_amdgcn_mfma_f32_16x16x32_bf16(Bt[n][k], At[m][k], acc[ai][bj][m][n], 0, 0, 0); __builtin_amdgcn_s_setprio(0); } while (0)
#define PG8_WAIT_V(n) asm volatile("s_waitcnt vmcnt(" #n ")" ::: "memory")
#define PG8_WAIT_L(n) asm volatile("s_waitcnt lgkmcnt(" #n ")" ::: "memory")
#define PG8_BAR __builtin_amdgcn_s_barrier()
#define PG8_SCHED __builtin_amdgcn_sched_barrier(0)
    Unit cur, nxt; int ui = 0;
    if (!S.next(0, cur)) return;
    f32x4 acc[2][2][4][2];
#pragma unroll
    for (int a = 0; a < 2; ++a)
#pragma unroll
        for (int b = 0; b < 2; ++b)
#pragma unroll
            for (int m = 0; m < 4; ++m)
#pragma unroll
                for (int n = 0; n < 2; ++n) acc[a][b][m][n] = (f32x4){0.f, 0.f, 0.f, 0.f};
    bf16x8 At[4][2], B0[2][2], B1[2][2];
    const char* cA = (const char*)g.A + (size_t)cur.pm * tstep + (size_t)cur.k0 * 2; const char* cB = (const char*)g.Bt + (size_t)cur.pn * tstep + (size_t)cur.k0 * 2;
    S.a_ready(cur);
    if constexpr (SP2) {
        PG8_STAGE(PG8_SB(0, 0), cB, voffB); PG8_STAGE(PG8_SB(0, 1), cB + hstep, voffB); PG8_STAGE(PG8_SA(0, 0), cA, voffA); PG8_STAGE(PG8_SA(0, 1), cA + hstep, voffA);
        if (wr == 1) PG8_BAR;
        PG8_WAIT_V(2); PG8_BAR;
        PG8_STAGE(PG8_SB(1, 0), cB + kstep, voffB); PG8_STAGE(PG8_SA(1, 0), cA + kstep, voffA); PG8_STAGE(PG8_SB(1, 1), cB + hstep + kstep, voffB);
        PG8_WAIT_V(6); PG8_BAR;
    } else {
        PG8_STAGE(PG8_SB(0, 0), cB, voffB); PG8_STAGE(PG8_SA(0, 0), cA, voffA); PG8_STAGE(PG8_SB(0, 1), cB + hstep, voffB); PG8_STAGE(PG8_SA(0, 1), cA + hstep, voffA);
        if (wr == 1) PG8_BAR;
        PG8_WAIT_V(4); PG8_BAR;
        PG8_STAGE(PG8_SB(1, 0), cB + kstep, voffB); PG8_STAGE(PG8_SA(1, 0), cA + kstep, voffA); PG8_STAGE(PG8_SB(1, 1), cB + hstep + kstep, voffB);
        PG8_WAIT_V(6); PG8_BAR;
    }
    for (;;) {
        const bool has_next = S.next(ui + 1, nxt);
        const char* nA = has_next ? (const char*)g.A + (size_t)nxt.pm * tstep + (size_t)nxt.k0 * 2 : cA; const char* nB = has_next ? (const char*)g.Bt + (size_t)nxt.pn * tstep + (size_t)nxt.k0 * 2 : cB;
        const int nt = cur.nt;
        for (int t = 0; t < nt; t += 2) {
            const bool last = (t == nt - 2);
            const char* a1 = cA + (size_t)(t + 1) * kstep;
            const char* a2 = last ? nA : cA + (size_t)(t + 2) * kstep; const char* b2 = last ? nB : cB + (size_t)(t + 2) * kstep;
            const char* a3 = a2 + kstep; const char* b3 = b2 + kstep;
            if (last && has_next) S.a_ready(nxt);
            if constexpr (SP2) {
            PG8_LDB(B0, 0, 0); PG8_LDB(B1, 0, 1); PG8_SCHED; PG8_LDA(At, 0, 0); PG8_STAGE(PG8_SA(1, 1), a1 + hstep, voffA);
            PG8_WAIT_V(8); PG8_WAIT_L(0); PG8_BAR; PG8_MMA(0, 0, At, B0); PG8_MMA(0, 1, At, B1); PG8_BAR; PG8_SCHED;
            PG8_LDA(At, 0, 1); PG8_STAGE(PG8_SB(0, 0), b2, voffB); PG8_STAGE(PG8_SB(0, 1), b2 + hstep, voffB); PG8_STAGE(PG8_SA(0, 0), a2, voffA);
            PG8_WAIT_V(8); PG8_WAIT_L(0); PG8_BAR; PG8_MMA(1, 0, At, B0); PG8_MMA(1, 1, At, B1); PG8_BAR; PG8_SCHED;
            PG8_LDB(B0, 1, 0); PG8_LDB(B1, 1, 1); PG8_SCHED; PG8_LDA(At, 1, 0); PG8_STAGE(PG8_SA(0, 1), a2 + hstep, voffA);
            PG8_WAIT_V(8); PG8_WAIT_L(0); PG8_BAR; PG8_MMA(0, 0, At, B0); PG8_MMA(0, 1, At, B1); PG8_BAR; PG8_SCHED;
            PG8_LDA(At, 1, 1); PG8_STAGE(PG8_SB(1, 0), b3, voffB); PG8_STAGE(PG8_SB(1, 1), b3 + hstep, voffB); PG8_STAGE(PG8_SA(1, 0), a3, voffA);
            PG8_WAIT_V(8); PG8_WAIT_L(0); PG8_BAR; PG8_MMA(1, 0, At, B0); PG8_MMA(1, 1, At, B1); PG8_BAR; PG8_SCHED;
            } else {
            PG8_LDB(B0, 0, 0); PG8_SCHED; PG8_LDA(At, 0, 0); PG8_STAGE(PG8_SA(1, 1), a1 + hstep, voffA);
            PG8_WAIT_L(8); PG8_BAR; PG8_WAIT_L(0); PG8_MMA(0, 0, At, B0); PG8_BAR; PG8_SCHED;
            PG8_LDB(B1, 0, 1); PG8_STAGE(PG8_SB(0, 0), b2, voffB);
            PG8_BAR; PG8_WAIT_L(0); PG8_MMA(0, 1, At, B1); PG8_BAR;
            PG8_LDA(At, 0, 1); PG8_STAGE(PG8_SA(0, 0), a2, voffA);
            PG8_BAR; PG8_WAIT_L(0); PG8_MMA(1, 0, At, B0); PG8_BAR; PG8_SCHED;
            PG8_STAGE(PG8_SB(0, 1), b2 + hstep, voffB);
            PG8_WAIT_V(6); PG8_BAR; PG8_MMA(1, 1, At, B1); PG8_BAR;
            PG8_LDB(B0, 1, 0); PG8_SCHED; PG8_LDA(At, 1, 0); PG8_STAGE(PG8_SA(0, 1), a2 + hstep, voffA);
            PG8_WAIT_L(8); PG8_BAR; PG8_WAIT_L(0); PG8_MMA(0, 0, At, B0); PG8_BAR; PG8_SCHED;
            PG8_LDB(B1, 1, 1); PG8_STAGE(PG8_SB(1, 0), b3, voffB);
            PG8_BAR; PG8_WAIT_L(0); PG8_MMA(0, 1, At, B1); PG8_BAR;
            PG8_LDA(At, 1, 1); PG8_STAGE(PG8_SA(1, 0), a3, voffA);
            PG8_BAR; PG8_WAIT_L(0); PG8_MMA(1, 0, At, B0); PG8_BAR; PG8_SCHED;
            PG8_STAGE(PG8_SB(1, 1), b3 + hstep, voffB);
            PG8_WAIT_V(6); PG8_BAR; PG8_MMA(1, 1, At, B1); PG8_BAR;
            }
        }
        if constexpr (ALIGN_EPI) { if (wr == 0) PG8_BAR; }
        if constexpr (!Epi::AFTER_DRAIN) { E(acc, cur, wr, wc, fr, fq); S.done(cur); }
        if (!has_next) break;
#pragma unroll
        for (int a = 0; a < 2; ++a)
#pragma unroll
            for (int b = 0; b < 2; ++b)
#pragma unroll
                for (int m = 0; m < 4; ++m)
#pragma unroll
                    for (int n = 0; n < 2; ++n) acc[a][b][m][n] = (f32x4){0.f, 0.f, 0.f, 0.f};
        cur = nxt; cA = nA; cB = nB; ++ui;
        if constexpr (ALIGN_EPI) { if (wr == 1) PG8_BAR; }
    }
    PG8_WAIT_V(0);
    if constexpr (!ALIGN_EPI) { if (wr == 0) PG8_BAR; }
    PG8_BAR;
    if constexpr (Epi::AFTER_DRAIN) { E.fused(acc, cur, wr, wc, fr, fq, lds, wid, lane); S.done(cur); }
#undef PG8_SA
#undef PG8_SB
#undef PG8_STAGE
#undef PG8_LDA
#undef PG8_LDB
#undef PG8_MMA
#undef PG8_WAIT_V
#undef PG8_WAIT_L
#undef PG8_BAR
#undef PG8_SCHED
}
}

#define GAS __attribute__((address_space(1)))
#define LAS __attribute__((address_space(3)))
typedef unsigned short bf16;
typedef unsigned v4u __attribute__((ext_vector_type(4)));
typedef float f32x4 __attribute__((ext_vector_type(4)));
typedef short bf16x8 __attribute__((ext_vector_type(8)));
typedef GAS unsigned gu32;
typedef GAS unsigned long long gu64;
#define RLX_AGENT __ATOMIC_RELAXED, __HIP_MEMORY_SCOPE_AGENT
#define LDS_WAIT() asm volatile("s_waitcnt lgkmcnt(0)" ::: "memory")
#define VM_WAIT() asm volatile("s_waitcnt vmcnt(0)" ::: "memory")
__device__ __forceinline__ unsigned long long rt() { return __builtin_amdgcn_s_memrealtime(); }
__device__ __forceinline__ unsigned f2bf(float f) { unsigned u = __builtin_bit_cast(unsigned, f); return (u + 0x7fffu + ((u >> 16) & 1u)) >> 16; }
__device__ __forceinline__ unsigned pk2(float lo, float hi) { return f2bf(lo) | (f2bf(hi) << 16); }

#define XB_TMO      128
#define XB_XCNT(j)  (256  + 64 * (j))
#define XB_XSUB(j)  (1280 + 64 * (j))
#define XB_XGEN(j)  (2304 + 64 * (j))
#define XB_TOP      3328
#define XB_TOPGEN   3392
#define XCD_BAR_WORDS 3456
#define XB_SPIN_CAP (1u << 18)

__device__ __forceinline__ unsigned xb_ld(unsigned* p)              { return __hip_atomic_load(p, __ATOMIC_RELAXED, __HIP_MEMORY_SCOPE_AGENT); }
__device__ __forceinline__ unsigned xb_add(unsigned* p, unsigned v) { return __hip_atomic_fetch_add(p, v, __ATOMIC_RELAXED, __HIP_MEMORY_SCOPE_AGENT); }
__device__ __forceinline__ unsigned xb_xcc_id() { return (unsigned)__builtin_amdgcn_s_getreg((3 << 11) | 20) & 0xFu; }
#define XB_SPIN(cond, bar) do { unsigned _sp = 0; while (cond) { __builtin_amdgcn_s_sleep(1); \
    if ((++_sp & 255u) == 0u) { if (xb_ld(&(bar)[XB_TMO])) break; if (_sp > XB_SPIN_CAP) { atomicAdd(&(bar)[XB_TMO], 1u); break; } } } } while (0)

struct XcdBarrier {
    unsigned* bar; unsigned x;
    volatile LAS unsigned* st;
};

__device__ __forceinline__ XcdBarrier xcd_barrier_post(unsigned* bar, volatile LAS unsigned* st) {
    XcdBarrier b; b.bar = bar; b.x = xb_xcc_id(); b.st = st;
    if (threadIdx.x == 0) (void)xb_add(&bar[XB_XCNT(b.x)], 1u);
    return b;
}
__device__ __forceinline__ void xcd_barrier_complete(unsigned* bar, unsigned x, unsigned& nloc, unsigned& nx) {
    const unsigned G = gridDim.x * gridDim.y * gridDim.z;
    unsigned sum, cnt, mine, sp = 0u;
    for (;;) {
        sum = 0u; cnt = 0u; mine = 0u;
#pragma unroll
        for (unsigned j = 0; j < 16; ++j) { const unsigned c = xb_ld(&bar[XB_XCNT(j)]); sum += c; cnt += (c > 0u) ? 1u : 0u; mine = (j == x) ? c : mine; }
        if (sum == G) break;
        __builtin_amdgcn_s_sleep(1);
        if ((++sp & 255u) == 0u) { if (xb_ld(&bar[XB_TMO])) break; if (sp > XB_SPIN_CAP) { atomicAdd(&bar[XB_TMO], 1u); break; } }
    }
    nloc = mine > 0u ? mine : 1u; nx = cnt > 0u ? cnt : 1u;
}

__device__ __forceinline__ void xcd_barrier(const XcdBarrier& b) {
    asm volatile("s_waitcnt vmcnt(0)" ::: "memory");
    __syncthreads();
    if (threadIdx.x == 0) {
        unsigned* bar = b.bar;
        __builtin_amdgcn_s_waitcnt(0);
        unsigned nloc = b.st[0], nx = b.st[1];
        if (nloc == 0u) { xcd_barrier_complete(bar, b.x, nloc, nx); b.st[0] = nloc; b.st[1] = nx; }
        const unsigned old = xb_add(&bar[XB_XSUB(b.x)], 1u);
        const unsigned gen = old / nloc;
        if (old + 1u == (gen + 1u) * nloc) {
            __builtin_amdgcn_fence(__ATOMIC_RELEASE, "agent");
            asm volatile("s_waitcnt vmcnt(0)" ::: "memory");
            const unsigned og = xb_add(&bar[XB_TOP], 1u);
            const unsigned tg = og / nx;
            if (og + 1u == (tg + 1u) * nx) xb_add(&bar[XB_TOPGEN], 1u);
            else XB_SPIN(xb_ld(&bar[XB_TOPGEN]) == tg, bar);
            __builtin_amdgcn_fence(__ATOMIC_ACQUIRE, "agent");
            xb_add(&bar[XB_XGEN(b.x)], 1u);
            asm volatile("s_waitcnt vmcnt(0)" ::: "memory");
        } else {
            XB_SPIN(xb_ld(&bar[XB_XGEN(b.x)]) == gen, bar);
            __builtin_amdgcn_fence(__ATOMIC_ACQUIRE, "agent");
            asm volatile("s_waitcnt vmcnt(0)" ::: "memory");
        }
    }
    __syncthreads();
}

constexpr int NWAVES = 8;
constexpr int D = 1024, FF = 2816;
constexpr int PB = 8, PT = 2048, SB = 128, STK = 4;
constexpr int MP = PB * PT, MS = SB * STK, M = MP + MS;
constexpr int NRW = 3584, KRW = 2048  , NRW2 = 3840  , NL2 = 3072, KL2 = 384, NIN = 3328;
constexpr float NORM_EPS = 1e-6f, GN_EPS = 64e-5f;
typedef pg8::bf16_t bf16;

constexpr size_t MiB = 1u << 20;
constexpr size_t WS_CTL = 0, CTL_ZERO_BYTES = 64 * 1024;
constexpr size_t WS_W = 1 * MiB;
constexpr size_t WS_XR = 20 * MiB;
constexpr size_t WS_BIG = 86 * MiB;
constexpr size_t WS_END = 256 * MiB;
constexpr size_t WS_YRAW = 256 * MiB, WS_BON = 288 * MiB, WS_W2 = 289 * MiB  , WS_END2 = 308 * MiB, WS_XM = 308 * MiB  , WS_END3 = 506 * MiB;
constexpr size_t W_GU = 0, W_D = (size_t)2 * FF * D * 2;
constexpr size_t W_RW = 0, W_L2 = (size_t)NRW * KRW * 2, W_O = W_L2 + (size_t)NL2 * KL2 * 2;
constexpr size_t W_IN = 0, W_OUT = (size_t)NIN * D * 2;
static_assert(W_D + (size_t)D * FF * 2 <= 19 * MiB && W_O + (size_t)D * D * 2 <= 19 * MiB && W_OUT + (size_t)D * D * 2 <= 19 * MiB, "weights region");
constexpr size_t B_H = 0, B_XN = 91 * MiB, B_SLAB = 124 * MiB;
constexpr size_t B_ACAT = 0, B_R = 66 * MiB, B_K = 99 * MiB, B_V = 132 * MiB, B_DEC = 0, B_AA = 33 * MiB;
constexpr size_t B_QKR = 0, B_VV = 33 * MiB, B_HO = 66 * MiB, B_OO = 124 * MiB, B_IF = 157 * MiB;
static_assert((size_t)M * FF * 2 <= 91 * MiB && (size_t)M * D * 2 == 33 * MiB && B_IF + (size_t)M * 16 * 4 <= 170 * MiB && B_SLAB + (size_t)11 * MS * D * 4 <= 170 * MiB, "BIG map");
constexpr size_t OS_GG = 0, OS_LORA = 33 * MiB;
static_assert(OS_LORA + (size_t)M * KL2 * 2 <= (size_t)MP * D * 4, "d_out scratch");
constexpr size_t O_Y = 0, O_P_S = 17301504, O_P_SHIFT = 17825792, O_P_C = 17833984, O_P_N = 18358272, O_P_M = 18362368, O_P_CONV = 18362432,
                 O_S_S = 18387008, O_S_SHIFT = 26775616, O_S_C = 26906688, O_S_N = 35295296, O_S_M = 35360832, O_S_CONV = 35361856, O_END = 35755072;
constexpr int CW_BAR = 1024;

constexpr int RING_BYTES = 131072, LDSCTL_OFF = RING_BYTES, MISC_OFF = LDSCTL_OFF + 320, TAB_OFF = LDSCTL_OFF + 1024, LDS_BYTES = 147456;

enum { I_XP = 0, I_XS, I_RS, I_RSHIFT, I_MC, I_MN, I_MM, I_MCONV, I_NFA, I_FAWG, I_FAWU, I_FAWD, I_NMIX, I_NFB, I_FBWG, I_FBWU, I_FBWD,
       I_MU, I_WR, I_WK, I_WV, I_WO, I_W0, I_W1, I_W2, I_A0, I_A1, I_A2, I_G1, I_G2, I_KK, I_KA, I_RK, I_GNW, I_GNB,
       I_WIN, I_BIF, I_CW, I_CB, I_MNW, I_WOUT, I_NFIN, N_IN };

typedef __bf16 bf16x2_t __attribute__((ext_vector_type(2)));
typedef float f32x2_t __attribute__((ext_vector_type(2)));
__device__ __forceinline__ unsigned pkbf(float lo, float hi) { f32x2_t v = {lo, hi}; bf16x2_t b = __builtin_convertvector(v, bf16x2_t); return __builtin_bit_cast(unsigned, b); }
__device__ __forceinline__ float bflo(unsigned u) { return __builtin_bit_cast(float, u << 16); }
__device__ __forceinline__ float bfhi(unsigned u) { return __builtin_bit_cast(float, u & 0xffff0000u); }
__device__ __forceinline__ float bf1(unsigned short u) { return __builtin_bit_cast(float, (unsigned)u << 16); }
__device__ __forceinline__ unsigned short f2bf1(float f) { return (unsigned short)(pkbf(f, 0.f) & 0xffffu); }
__device__ __forceinline__ void unpack8(v4u w, float (&o)[8]) { o[0] = bflo(w.x); o[1] = bfhi(w.x); o[2] = bflo(w.y); o[3] = bfhi(w.y); o[4] = bflo(w.z); o[5] = bfhi(w.z); o[6] = bflo(w.w); o[7] = bfhi(w.w); }
__device__ __forceinline__ v4u pack8(const float (&o)[8]) { v4u w; w.x = pkbf(o[0], o[1]); w.y = pkbf(o[2], o[3]); w.z = pkbf(o[4], o[5]); w.w = pkbf(o[6], o[7]); return w; }
__device__ __forceinline__ float sigmoidf_(float x) { return __builtin_amdgcn_rcpf(1.f + __expf(-x)); }
__device__ __forceinline__ float siluf_(float x) { return x * __builtin_amdgcn_rcpf(1.f + __expf(-x)); }
__device__ __forceinline__ float tanhf_(float x) { return 1.f - 2.f * __builtin_amdgcn_rcpf(__expf(2.f * x) + 1.f); }
__device__ __forceinline__ float logsigmoidf_(float x) { return fminf(x, 0.f) - __logf(1.f + __expf(-fabsf(x))); }
template <int CTRL> __device__ __forceinline__ float dppf(float x) { return __builtin_bit_cast(float, __builtin_amdgcn_update_dpp(0, __builtin_bit_cast(int, x), CTRL, 0xF, 0xF, true)); }
__device__ __forceinline__ float red4(float x) { x += dppf<0xB1>(x); x += dppf<0x4E>(x); return x; }
__device__ __forceinline__ float red8(float x) { x = red4(x); x += dppf<0x141>(x); return x; }
__device__ __forceinline__ float red16(float x) { x = red8(x); x += dppf<0x140>(x); return x; }
__device__ __forceinline__ float wave_sum(float v) {
#pragma unroll
    for (int o = 1; o < 64; o <<= 1) v += __shfl_xor(v, o);
    return v;
}

struct Frame {
    LAS unsigned char* lds;
    volatile LAS unsigned* MISC;
    gu32* ctl;
    volatile LAS unsigned long long* tab;
    int tid, lane, wave, vcu, G;
};
__device__ __forceinline__ const float* inptr(const Frame& F, int i) { const unsigned long long v = F.tab[i];
    const unsigned lo = __builtin_amdgcn_readfirstlane((unsigned)v), hi = __builtin_amdgcn_readfirstlane((unsigned)(v >> 32)); return (const float*)(const GAS float*)(((unsigned long long)hi << 32) | lo); }

using pg8::Unit; using pg8::BM; using pg8::HALF;
__device__ __forceinline__ void st8bf(bf16* p, f32x4 v0, f32x4 v1) { v4u w; w.x = pkbf(v0[0], v0[1]); w.y = pkbf(v0[2], v0[3]); w.z = pkbf(v1[0], v1[1]); w.w = pkbf(v1[2], v1[3]); *(v4u*)p = w; }

struct EpiSwiglu {
    static constexpr bool PERM = true, AFTER_DRAIN = false;
    bf16* H; int pvar;
    __device__ __forceinline__ void operator()(const f32x4 (&acc)[2][2][4][2], const Unit& u, int wr, int wc, int fr, int fq) const {
        if (pvar == 3) return;
        const int row0 = u.pm * BM + wr * 64 + fr, col0 = u.pn * 128 + wc * 32 + 8 * fq;
#pragma unroll
        for (int ai = 0; ai < 2; ++ai)
#pragma unroll
            for (int m = 0; m < 4; ++m) {
                f32x4 o[2];
#pragma unroll
                for (int n = 0; n < 2; ++n)
#pragma unroll
                    for (int i = 0; i < 4; ++i) { const float g = acc[ai][0][m][n][i], up = acc[ai][1][m][n][i]; o[n][i] = siluf_(g) * up; }
                st8bf(H + (size_t)(row0 + ai * HALF + m * 16) * FF + col0, o[0], o[1]);
            }
    }
};
__device__ __forceinline__ void ld8bf(const bf16* p, f32x4& a, f32x4& b) { const v4u w = *(const v4u*)p; a = (f32x4){bflo(w.x), bfhi(w.x), bflo(w.y), bfhi(w.y)}; b = (f32x4){bflo(w.z), bfhi(w.z), bflo(w.w), bfhi(w.w)}; }
struct EpiRes {
    static constexpr bool PERM = true, AFTER_DRAIN = false;
    const float* basef; const bf16* baseb; bf16* out; float* slab; float coef;
    __device__ __forceinline__ void operator()(const f32x4 (&acc)[2][2][4][2], const Unit& u, int wr, int wc, int fr, int fq) const {
        const int row0 = u.pm * BM + wr * 64 + fr, col0 = u.pn * BM + wc * 32 + 8 * fq;
        if (u.slab < 0) {
            if (basef) {
#pragma unroll
                for (int ai = 0; ai < 2; ++ai)
#pragma unroll
                    for (int m = 0; m < 4; ++m) { const size_t ro = (size_t)(row0 + ai * HALF + m * 16) * D + col0;
#pragma unroll
                        for (int bj = 0; bj < 2; ++bj) { const f32x4 b0 = *(const f32x4*)(basef + ro + bj * HALF), b1 = *(const f32x4*)(basef + ro + bj * HALF + 4);
                            st8bf(out + ro + bj * HALF, b0 + acc[ai][bj][m][0] * coef, b1 + acc[ai][bj][m][1] * coef); } }
            } else {
#pragma unroll
                for (int ai = 0; ai < 2; ++ai)
#pragma unroll
                    for (int m = 0; m < 4; ++m) { const size_t ro = (size_t)(row0 + ai * HALF + m * 16) * D + col0;
#pragma unroll
                        for (int bj = 0; bj < 2; ++bj) { f32x4 b0, b1; ld8bf(baseb + ro + bj * HALF, b0, b1);
                            st8bf(out + ro + bj * HALF, b0 + acc[ai][bj][m][0] * coef, b1 + acc[ai][bj][m][1] * coef); } }
            }
        } else {
            float* sl = slab + (size_t)u.slab * MS * D;
#pragma unroll
            for (int ai = 0; ai < 2; ++ai)
#pragma unroll
                for (int m = 0; m < 4; ++m) { const size_t ro = (size_t)(row0 + ai * HALF + m * 16 - MP) * D + col0;
#pragma unroll
                    for (int bj = 0; bj < 2; ++bj) { *(f32x4*)(sl + ro + bj * HALF) = acc[ai][bj][m][0]; *(f32x4*)(sl + ro + bj * HALF + 4) = acc[ai][bj][m][1]; } }
        }
    }
};
struct EpiRw {
    static constexpr bool PERM = true, AFTER_DRAIN = false;
    bf16 *R, *K, *V, *L;
    __device__ __forceinline__ void operator()(const f32x4 (&acc)[2][2][4][2], const Unit& u, int wr, int wc, int fr, int fq) const {
        const int mix = u.pn < 12 ? (u.pn >> 2) : u.pn - 9, row0 = (u.pm - (M / 256) * mix) * BM + wr * 64 + fr;
        if (u.pn < 12) {
            bf16 *p0 = R, *p1 = K, *p2 = V; asm volatile("" : "+s"(p0), "+s"(p1), "+s"(p2));
            bf16* dst = u.pn < 4 ? p0 : (u.pn < 8 ? p1 : p2); const int col0 = (u.pn & 3) * BM + wc * 32 + 8 * fq;
#pragma unroll
            for (int ai = 0; ai < 2; ++ai)
#pragma unroll
                for (int m = 0; m < 4; ++m) { bf16* rp = dst + (size_t)(row0 + ai * HALF + m * 16) * D + col0;
#pragma unroll
                    for (int bj = 0; bj < 2; ++bj) st8bf(rp + bj * HALF, acc[ai][bj][m][0], acc[ai][bj][m][1]); }
        } else {
            const int t = u.pn - 12;
#pragma unroll
            for (int bj = 0; bj < 2; ++bj) {
                const int cl = bj * HALF + wc * 32 + 8 * fq;
                if (t < 2 && cl >= 64) continue;
                const int lc = t == 0 ? cl : (t == 1 ? 64 + cl : 128 + cl);
                const int act = t == 0 ? 1 : (t == 1 ? 0 : (cl < 160 ? 2 : 3));
#pragma unroll
                for (int ai = 0; ai < 2; ++ai)
#pragma unroll
                    for (int m = 0; m < 4; ++m) {
                        f32x4 o[2];
#pragma unroll
                        for (int n = 0; n < 2; ++n)
#pragma unroll
                            for (int i = 0; i < 4; ++i) { const float x = acc[ai][bj][m][n][i]; o[n][i] = act == 1 ? tanhf_(x) : (act == 0 ? x : (act == 2 ? sigmoidf_(x) : 0.f)); }
                        st8bf(L + (size_t)(row0 + ai * HALF + m * 16) * KL2 + lc, o[0], o[1]);
                    }
            }
        }
    }
};
struct EpiL2 {
    static constexpr bool PERM = true, AFTER_DRAIN = false;
    bf16 *DEC, *AA, *GG; const float *w0, *a0;
    __device__ __forceinline__ void operator()(const f32x4 (&acc)[2][2][4][2], const Unit& u, int wr, int wc, int fr, int fq) const {
        const int row0 = u.pm * BM + wr * 64 + fr, kind = u.pn >> 2, col0 = (u.pn & 3) * BM + wc * 32 + 8 * fq;
        bf16 *p0 = DEC, *p1 = AA, *p2 = GG; const float *q0 = w0, *q1 = a0; asm volatile("" : "+s"(p0), "+s"(p1), "+s"(p2), "+s"(q0), "+s"(q1));
        bf16* dst = kind == 0 ? p0 : (kind == 1 ? p1 : p2); const float* bias = kind == 0 ? q0 : q1;
#pragma unroll
        for (int bj = 0; bj < 2; ++bj) {
            f32x4 bv[2];
#pragma unroll
            for (int n = 0; n < 2; ++n) bv[n] = kind < 2 ? *(const f32x4*)(bias + col0 + bj * HALF + 4 * n) : (f32x4){0.f, 0.f, 0.f, 0.f};
#pragma unroll
            for (int ai = 0; ai < 2; ++ai)
#pragma unroll
                for (int m = 0; m < 4; ++m) {
                    f32x4 o[2];
#pragma unroll
                    for (int n = 0; n < 2; ++n)
#pragma unroll
                        for (int i = 0; i < 4; ++i) { const float z = acc[ai][bj][m][n][i] + bv[n][i];
                            o[n][i] = kind == 0 ? (1.f - __expf(-0.60653065971f * sigmoidf_(z))) : (kind == 1 ? sigmoidf_(z) : z); }
                    st8bf(dst + (size_t)(row0 + ai * HALF + m * 16) * D + col0 + bj * HALF, o[0], o[1]);
                }
        }
    }
};
struct EpiIn {
    static constexpr bool PERM = true, AFTER_DRAIN = false;
    bf16 *QKR, *VV, *OO; float* IF; const float* bif; int pvar;
    __device__ __forceinline__ void operator()(const f32x4 (&acc)[2][2][4][2], const Unit& u, int wr, int wc, int fr, int fq) const {
        if (pvar == 3) return;
        const int row0 = u.pm * BM + wr * 64 + fr;
        if (u.pn < 12) {
            bf16 *p0 = QKR, *p1 = VV, *p2 = OO; asm volatile("" : "+s"(p0), "+s"(p1), "+s"(p2));
            const int kind = u.pn >> 2; bf16* dst = kind == 0 ? p0 : (kind == 1 ? p1 : p2); const int col0 = (u.pn & 3) * BM + wc * 32 + 8 * fq;
#pragma unroll
            for (int ai = 0; ai < 2; ++ai)
#pragma unroll
                for (int m = 0; m < 4; ++m) { bf16* rp = dst + (size_t)(row0 + ai * HALF + m * 16) * D + col0;
#pragma unroll
                    for (int bj = 0; bj < 2; ++bj) { f32x4 a = acc[ai][bj][m][0], b = acc[ai][bj][m][1];
                        if (kind == 2) {
#pragma unroll
                            for (int i = 0; i < 4; ++i) { a[i] = sigmoidf_(a[i]); b[i] = sigmoidf_(b[i]); } }
                        st8bf(rp + bj * HALF, a, b); } }
        } else if (u.pn == 12 && wc == 0 && fq < 2) {
            const f32x4 b0 = *(const f32x4*)(bif + 8 * fq), b1 = *(const f32x4*)(bif + 8 * fq + 4);
#pragma unroll
            for (int ai = 0; ai < 2; ++ai)
#pragma unroll
                for (int m = 0; m < 4; ++m) { f32x4 a = acc[ai][0][m][0] + b0, b = acc[ai][0][m][1] + b1;
                    if (fq == 1) {
#pragma unroll
                        for (int i = 0; i < 4; ++i) { a[i] = logsigmoidf_(a[i]); b[i] = logsigmoidf_(b[i]); } }
                    float* rp = IF + (size_t)(row0 + ai * HALF + m * 16) * 16 + 8 * fq; *(f32x4*)rp = a; *(f32x4*)(rp + 4) = b; }
        }
    }
};

struct CJ { const float* W; const float* sc; bf16* WT; int K, N, Npad, ldk, koff, rmode, roff, smode; };
__device__ __forceinline__ int cj_items(const CJ& j) { return (j.K / 32) * (j.Npad / 32); }
__device__ __forceinline__ void conv_load(const CJ& J, int item, int lane, f32x4 (&w)[4], float (&sc)[4]) {
    const int nblk = J.Npad / 32, kb = item / nblk, nb = item % nblk, k0 = 32 * kb, n0 = 32 * nb;
    const int r = lane >> 3, c4 = 4 * (lane & 7); const bool nok = n0 + c4 < J.N;
#pragma unroll
    for (int i = 0; i < 4; ++i) { const int kk = k0 + r + 8 * i;
        w[i] = nok ? *(const f32x4*)(J.W + (size_t)kk * J.N + n0 + c4) : (f32x4){0.f, 0.f, 0.f, 0.f};
        float s = 1.f; if (J.smode) { s = J.sc[kk]; if (J.smode == 2) s = 1.f - s; }
        sc[i] = s; }
}
__device__ __forceinline__ void conv_store(const CJ& J, LAS float* scr, int item, int lane, const f32x4 (&w)[4], const float (&sc)[4]) {
    const int nblk = J.Npad / 32, kb = item / nblk, nb = item % nblk, k0 = 32 * kb, n0 = 32 * nb;
    const int r = lane >> 3, c4 = 4 * (lane & 7);
#pragma unroll
    for (int i = 0; i < 4; ++i) { const f32x4 f = w[i] * sc[i]; LAS float* d = scr + (r + 8 * i) * 33 + c4; d[0] = f[0]; d[1] = f[1]; d[2] = f[2]; d[3] = f[3]; }
    LDS_WAIT(); asm volatile("" ::: "memory");
    const int rowbase = J.rmode == 0 ? J.roff + n0 : (n0 >> 7) * 256 + (n0 & 127) + J.roff;
    const int c = lane & 3;
#pragma unroll
    for (int j = 0; j < 2; ++j) { const int n = (lane >> 2) + 16 * j; const LAS float* s = scr + (8 * c) * 33 + n;
        v4u o; o.x = pkbf(s[0 * 33], s[1 * 33]); o.y = pkbf(s[2 * 33], s[3 * 33]); o.z = pkbf(s[4 * 33], s[5 * 33]); o.w = pkbf(s[6 * 33], s[7 * 33]);
        *(GAS v4u*)(J.WT + (size_t)(rowbase + n) * J.ldk + J.koff + k0 + 8 * c) = o; }
    LDS_WAIT(); asm volatile("" ::: "memory");
}
__device__ __forceinline__ CJ get_job(const Frame& F, int kind, int j, int layer, int ab, bf16* Wb) {
    CJ J; J.sc = nullptr; J.smode = 0; J.koff = 0; J.rmode = 0; J.roff = 0;
    if (kind == 0) {
        const float* wg = inptr(F, ab ? I_FBWG : I_FAWG) + (size_t)layer * D * FF; const float* wu = inptr(F, ab ? I_FBWU : I_FAWU) + (size_t)layer * D * FF; const float* wd = inptr(F, ab ? I_FBWD : I_FAWD) + (size_t)layer * D * FF;
        if (j < 2) { J.W = j == 0 ? wg : wu; J.K = D; J.N = FF; J.Npad = FF; J.WT = Wb + W_GU / 2; J.ldk = D; J.rmode = 1; J.roff = j == 0 ? 0 : 128; }
        else { J.W = wd; J.K = FF; J.N = D; J.Npad = D; J.WT = Wb + W_D / 2; J.ldk = FF; }
    } else if (kind == 1) {
        if (j < 6) {
            const int s = j;
            J.W = inptr(F, s == 0 ? I_WR : (s == 1 ? I_WK : (s == 2 ? I_WV : (s == 3 ? I_W1 : (s == 4 ? I_A1 : I_G1)))));
            J.N = s < 3 ? 1024 : (s < 5 ? 64 : 160); J.Npad = s < 3 ? 1024 : 256;
            J.roff = s < 3 ? 1024 * s : 3072 + 256 * (s - 3);
            J.K = D; J.ldk = D; J.WT = Wb + W_RW / 2;
        } else { J.W = inptr(F, I_WO); J.K = D; J.N = D; J.Npad = D; J.WT = Wb + W_O / 2; J.ldk = D; }
    } else {
        if (j == 0) { J.W = inptr(F, I_WIN); J.K = D; J.N = 3088; J.Npad = NIN; J.WT = Wb + W_IN / 2; J.ldk = D; }
        else { J.W = inptr(F, I_WOUT); J.K = D; J.N = D; J.Npad = D; J.WT = Wb + W_OUT / 2; J.ldk = D; }
    }
    return J;
}
__device__ __forceinline__ void convert_weights(const Frame& F, int kind, int layer, int ab, bf16* Wb, const int cu0 = 0) {
    LAS float* scr = (LAS float*)(F.lds + F.wave * 16384);
    const int gw = (F.vcu - cu0) * NWAVES + F.wave, NGW = (F.G - cu0) * NWAVES;
    const int njobs = kind == 0 ? 3 : (kind == 1 ? 7 : 2);
    int total = 0;
    for (int j = 0; j < njobs; ++j) { const CJ J = get_job(F, kind, j, layer, ab, Wb); total += cj_items(J); }
    if (gw < total) {
        int r = gw, j = 0; CJ J = get_job(F, kind, 0, layer, ab, Wb);
        while (r >= cj_items(J)) { r -= cj_items(J); ++j; J = get_job(F, kind, j, layer, ab, Wb); }
        f32x4 w[4]; float sc[4];
        conv_load(J, r, F.lane, w, sc);
        for (int g = gw; g < total;) {
            const int gn = g + NGW; int rn = 0; CJ Jn = J; f32x4 wn[4]; float sn[4];
#pragma unroll
            for (int i = 0; i < 4; ++i) { wn[i] = (f32x4){0.f, 0.f, 0.f, 0.f}; sn[i] = 0.f; }
            if (gn < total) {
                rn = gn; int jn = 0; Jn = get_job(F, kind, 0, layer, ab, Wb);
                while (rn >= cj_items(Jn)) { rn -= cj_items(Jn); ++jn; Jn = get_job(F, kind, jn, layer, ab, Wb); }
                conv_load(Jn, rn, F.lane, wn, sn);
            }
            conv_store(J, scr, r, F.lane, w, sc);
            J = Jn; r = rn; g = gn;
#pragma unroll
            for (int i = 0; i < 4; ++i) { w[i] = wn[i]; sc[i] = sn[i]; }
        }
    }
    if (kind == 1) {
        bf16* WT = Wb + W_L2 / 2; const float* w2 = inptr(F, I_W2); const float* a2 = inptr(F, I_A2); const float* g2 = inptr(F, I_G2);
        for (int idx = (F.vcu * NWAVES + F.wave) * 64 + F.lane; idx < 48 * NL2; idx += F.G * NWAVES * 64) {
            const int c = idx / NL2, n = idx % NL2, type = n >> 10, jj = n & 1023;
            const float* src = nullptr;
            if (type == 0 && c < 8) src = w2 + (size_t)(8 * c) * D + jj;
            else if (type == 1 && c >= 8 && c < 16) src = a2 + (size_t)(8 * (c - 8)) * D + jj;
            else if (type == 2 && c >= 16 && c < 36) src = g2 + (size_t)(8 * (c - 16)) * D + jj;
            float v[8];
#pragma unroll
            for (int e = 0; e < 8; ++e) v[e] = src ? src[(size_t)e * D] : 0.f;
            *(GAS v4u*)(WT + (size_t)n * KL2 + 8 * c) = pack8(v);
        }
    }
}

template <int MODE>
__device__ __forceinline__ void norm_finish(const int m, f32x4 (&v)[4], const f32x4 (&gv)[4], bf16* dst, const float* shift_in, float* out, const int lane) {
    const bool samp = m >= MP;
    float ss = 0.f;
#pragma unroll
    for (int j = 0; j < 4; ++j) ss += (v[j].x * v[j].x + v[j].y * v[j].y) + (v[j].z * v[j].z + v[j].w * v[j].w);
    const float r = 1.0f / sqrtf(wave_sum(ss) * (1.f / D) + NORM_EPS);
#pragma unroll
    for (int j = 0; j < 4; ++j) v[j] = v[j] * r * gv[j];
    if (MODE == 2) {
#pragma unroll
        for (int j = 0; j < 4; ++j) *(f32x4*)(out + O_Y + (size_t)m * D + 512 * (j >> 1) + 8 * lane + 4 * (j & 1)) = v[j];
    } else if (MODE == 0) {
#pragma unroll
        for (int j = 0; j < 2; ++j) st8bf(dst + (size_t)m * D + 512 * j + 8 * lane, v[2 * j], v[2 * j + 1]);
    } else {
        int t, b; bool first, last;
        if (!samp) { t = m & (PT - 1); b = m >> 11; first = t == 0; last = t == PT - 1; } else { const int mm = m - MP; t = mm & 3; b = mm >> 2; first = t == 0; last = t == 3; }
#pragma unroll
        for (int j = 0; j < 2; ++j) { const int eo = 512 * j + 8 * lane;
            st8bf(dst + (size_t)m * (2 * D) + eo, v[2 * j], v[2 * j + 1]);
            if (!last) st8bf(dst + (size_t)(m + 1) * (2 * D) + D + eo, v[2 * j], v[2 * j + 1]);
            else { float* so = out + (samp ? O_S_SHIFT : O_P_SHIFT) + (size_t)b * D + eo; *(f32x4*)so = v[2 * j]; *(f32x4*)(so + 4) = v[2 * j + 1]; }
            if (first) { f32x4 s0 = {0.f, 0.f, 0.f, 0.f}, s1 = s0;
                if (samp) { s0 = *(const f32x4*)(shift_in + (size_t)b * D + eo); s1 = *(const f32x4*)(shift_in + (size_t)b * D + eo + 4); }
                st8bf(dst + (size_t)m * (2 * D) + D + eo, s0, s1); }
        }
    }
}
template <bool F32>
__device__ __forceinline__ void row_load(const void* src, const size_t row, const int lane, f32x4 (&v)[4]) {
    if (F32) { const float* p = (const float*)src + row * D;
#pragma unroll
        for (int j = 0; j < 4; ++j) v[j] = *(const f32x4*)(p + 512 * (j >> 1) + 8 * lane + 4 * (j & 1));
    } else { const bf16* p = (const bf16*)src + row * D;
#pragma unroll
        for (int j = 0; j < 2; ++j) ld8bf(p + 512 * j + 8 * lane, v[2 * j], v[2 * j + 1]); }
}
template <int NS>
__device__ __forceinline__ void samp_row_fold(const float* slab, const int ms, const float coef, const int lane, f32x4 (&v)[4]) {
#pragma unroll
    for (int h = 0; h < 2; ++h) {
        f32x4 t[NS > 0 ? NS : 1][2];
#pragma unroll
        for (int s = 0; s < NS; ++s)
#pragma unroll
            for (int jj = 0; jj < 2; ++jj) t[s][jj] = *(const f32x4*)(slab + ((size_t)s * MS + ms) * D + 512 * h + 8 * lane + 4 * jj);
#pragma unroll
        for (int jj = 0; jj < 2; ++jj)
#pragma unroll
            for (int s = 0; s < NS; ++s) v[2 * h + jj] += t[s][jj] * coef;
    }
}
template <int MODE, bool PF32, bool SF32>
__device__ __forceinline__ void norm_rows(const Frame& F, const void* base_p, const void* base_s, int nslab, float coef, const float* slab, bf16* xr,
                                          const float* gain, bf16* dst, const float* shift_in, float* out, const int pvar = 0) {
    const int gw = F.vcu * NWAVES + F.wave, NGW = F.G * NWAVES, lane = F.lane;
    f32x4 gv[4];
#pragma unroll
    for (int j = 0; j < 4; ++j) gv[j] = *(const f32x4*)(gain + 512 * (j >> 1) + 8 * lane + 4 * (j & 1));
    for (int s = F.wave * F.G + F.vcu; s < MS; s += NWAVES * F.G) {
        const int m = MP + s; f32x4 v[4];
        row_load<SF32>(base_s, (size_t)s, lane, v);
        if (nslab == 11) samp_row_fold<11>(slab, s, coef, lane, v); else if (nslab == 4) samp_row_fold<4>(slab, s, coef, lane, v);
        if (nslab > 0 && MODE != 2 && pvar == 0) {
#pragma unroll
            for (int j = 0; j < 2; ++j) st8bf(xr + (size_t)m * D + 512 * j + 8 * lane, v[2 * j], v[2 * j + 1]); }
        norm_finish<MODE>(m, v, gv, dst, shift_in, out, lane);
    }
    int m = gw; f32x4 v[4];
    if (m < MP) row_load<PF32>(base_p, (size_t)m, lane, v);
    while (m < MP) {
        const int mn = m + NGW; f32x4 vn[4];
#pragma unroll
        for (int j = 0; j < 4; ++j) vn[j] = (f32x4){0.f, 0.f, 0.f, 0.f};
        if (mn < MP) row_load<PF32>(base_p, (size_t)mn, lane, vn);
        norm_finish<MODE>(m, v, gv, dst, shift_in, out, lane);
#pragma unroll
        for (int j = 0; j < 4; ++j) v[j] = vn[j];
        m = mn;
    }
}

__device__ __forceinline__ void mix_rows(const Frame& F, const bf16* xr_p, const float* xs_in, int nslab, float coef, const float* slab, bf16* xr, const float* gain, const float* mu, bf16* XM,
                                         const float* shift_in, float* out, const int pvar) {
    const int gw = F.vcu * NWAVES + F.wave, NGW = F.G * NWAVES, lane = F.lane;
    f32x4 gv[4];
#pragma unroll
    for (int j = 0; j < 4; ++j) gv[j] = *(const f32x4*)(gain + 512 * (j >> 1) + 8 * lane + 4 * (j & 1));
    __syncthreads();
    for (int i = F.tid; i < 6 * D / 8; i += NWAVES * 64) { const int s = i >> 7, e8 = i & 127; const float* mup = mu + ((0x541320 >> (4 * s)) & 15) * D + 8 * e8;
        const f32x4 ma = *(const f32x4*)mup, mb = *(const f32x4*)(mup + 4); v4u w; w.x = pkbf(ma[0], ma[1]); w.y = pkbf(ma[2], ma[3]); w.z = pkbf(mb[0], mb[1]); w.w = pkbf(mb[2], mb[3]);
        *(LAS v4u*)(F.lds + (s * D + 8 * e8) * 2) = w; }
    __syncthreads();
#define MIX_NORM(v) do { float ss_ = 0.f; \
        _Pragma("unroll") for (int j = 0; j < 4; ++j) ss_ += (v[j].x * v[j].x + v[j].y * v[j].y) + (v[j].z * v[j].z + v[j].w * v[j].w); \
        const float r_ = 1.0f / sqrtf(wave_sum(ss_) * (1.f / D) + NORM_EPS); \
        _Pragma("unroll") for (int j = 0; j < 4; ++j) v[j] = v[j] * r_ * gv[j]; } while (0)
#define MIX_EMIT(m, xn, pv) do { f32x4 df_[4]; int lo_ = 16 * lane; asm volatile("" : "+v"(lo_));     \
        _Pragma("unroll") for (int j = 0; j < 4; ++j) df_[j] = pv[j] - xn[j]; \
        _Pragma("unroll") for (int s = 0; s < 6; ++s) \
        _Pragma("unroll") for (int j = 0; j < 2; ++j) { const v4u mw = *(const LAS v4u*)(F.lds + (s * D + 512 * j) * 2 + lo_); const f32x4 ma = {bflo(mw.x), bfhi(mw.x), bflo(mw.y), bfhi(mw.y)}, mb = {bflo(mw.z), bfhi(mw.z), bflo(mw.w), bfhi(mw.w)}; \
            st8bf(XM + ((size_t)s * M + (m)) * D + 512 * j + 8 * lane, xn[2 * j] + ma * df_[2 * j], xn[2 * j + 1] + mb * df_[2 * j + 1]); } } while (0)
    for (int sq = F.wave * F.G + F.vcu; sq < SB; sq += NWAVES * F.G) {
        f32x4 pv[4];
#pragma unroll
        for (int j = 0; j < 4; ++j) pv[j] = *(const f32x4*)(shift_in + (size_t)sq * D + 512 * (j >> 1) + 8 * lane + 4 * (j & 1));
        for (int t = 0; t < STK; ++t) { const int srow = STK * sq + t, m = MP + srow; f32x4 v[4];
            row_load<true>(xs_in, (size_t)srow, lane, v);
            if (nslab == 11) samp_row_fold<11>(slab, srow, coef, lane, v); else if (nslab == 4) samp_row_fold<4>(slab, srow, coef, lane, v);
            if (nslab > 0 && pvar == 0) {
#pragma unroll
                for (int j = 0; j < 2; ++j) st8bf(xr + (size_t)m * D + 512 * j + 8 * lane, v[2 * j], v[2 * j + 1]); }
            MIX_NORM(v);
            MIX_EMIT(m, v, pv);
#pragma unroll
            for (int j = 0; j < 4; ++j) pv[j] = v[j];
        }
#pragma unroll
        for (int j = 0; j < 4; ++j) *(f32x4*)(out + O_S_SHIFT + (size_t)sq * D + 512 * (j >> 1) + 8 * lane + 4 * (j & 1)) = pv[j];
    }
    for (int blk = gw; blk < MP / 8; blk += NGW) {
        const int m0 = 8 * blk; f32x4 pv[4], v[4];
        row_load<false>(xr_p, (size_t)m0, lane, v);
        if ((m0 & (PT - 1)) == 0) {
#pragma unroll
            for (int j = 0; j < 4; ++j) pv[j] = (f32x4){0.f, 0.f, 0.f, 0.f};
        } else { row_load<false>(xr_p, (size_t)(m0 - 1), lane, pv); MIX_NORM(pv); }
        for (int i = 0; i < 8; ++i) { const int m = m0 + i; f32x4 vn[4];
#pragma unroll
            for (int j = 0; j < 4; ++j) vn[j] = (f32x4){0.f, 0.f, 0.f, 0.f};
            if (i < 7) row_load<false>(xr_p, (size_t)(m + 1), lane, vn);
            MIX_NORM(v);
            MIX_EMIT(m, v, pv);
            if ((m & (PT - 1)) == PT - 1) {
#pragma unroll
                for (int j = 0; j < 4; ++j) *(f32x4*)(out + O_P_SHIFT + (size_t)(m >> 11) * D + 512 * (j >> 1) + 8 * lane + 4 * (j & 1)) = v[j]; }
#pragma unroll
            for (int j = 0; j < 4; ++j) { pv[j] = v[j]; v[j] = vn[j]; }
        }
    }
#undef MIX_NORM
#undef MIX_EMIT
}

constexpr int RW_KK = 0, RW_DD = 4096, RW_BB = 8192, RW_KP = 12288, RW_RR = 16384, RW_VV = 20480, RW_YY = 24576;
__device__ __forceinline__ void rwkv_chain(const Frame& F, int row0, int T, int h, const float* S0, float* ST,
                                           const bf16* Rb, const bf16* Kb, const bf16* Vb, const bf16* Db, const bf16* Ab, bf16* Gb,
                                           const float* k_k, const float* k_a, const float* r_k, const float* gn_w, const float* gn_b, const bool do_store, const int pvar) {
    LAS float* L = (LAS float*)F.lds;
    const int tid = F.tid, lane = F.lane, w = F.wave;
    const int cg = tid & 7, tt = tid >> 3;
    const int srow = 8 * w + (lane >> 3);
    float S[8];
    if (S0) { const f32x4 a = *(const f32x4*)(S0 + srow * 64 + 8 * cg), b = *(const f32x4*)(S0 + srow * 64 + 8 * cg + 4);
        S[0] = a.x; S[1] = a.y; S[2] = a.z; S[3] = a.w; S[4] = b.x; S[5] = b.y; S[6] = b.z; S[7] = b.w; }
    else {
#pragma unroll
        for (int j = 0; j < 8; ++j) S[j] = 0.f; }
    const int ch = h * 64 + 8 * cg;
    float ckk[8], cka[8], crk[8], cgw[8], cgb[8];
#pragma unroll
    for (int j = 0; j < 8; ++j) { ckk[j] = k_k[ch + j]; cka[j] = k_a[ch + j]; crk[j] = r_k[ch + j]; cgw[j] = gn_w[ch + j]; cgb[j] = gn_b[ch + j]; }
    const int nch = (T + 63) >> 6;
    v4u pr = {0, 0, 0, 0}, pk = pr, pv = pr, pd = pr, pa = pr, pg = pr;
    { const int nt0 = T < 64 ? T : 64;
      if (tt < nt0) { const size_t off = (size_t)(row0 + tt) * D + ch;
          pr = *(const v4u*)(Rb + off); pk = *(const v4u*)(Kb + off); pv = *(const v4u*)(Vb + off); pd = *(const v4u*)(Db + off); pa = *(const v4u*)(Ab + off); pg = *(const v4u*)(Gb + off); } }
    float bon = 0.f, vv[8], gg[8];
    for (int c = 0; c < nch; ++c) {
        const int nt = (T - 64 * c) < 64 ? (T - 64 * c) : 64;
        const bool valid = tt < nt;
        {
            float r8[8], k8[8], d8[8], a8[8];
            unpack8(pr, r8); unpack8(pk, k8); unpack8(pv, vv); unpack8(pd, d8); unpack8(pa, a8); unpack8(pg, gg);
            float kk[8], ss = 0.f;
#pragma unroll
            for (int j = 0; j < 8; ++j) { kk[j] = k8[j] * ckk[j]; ss += kk[j] * kk[j]; }
            ss = red8(ss);
            const float inv = __builtin_amdgcn_rsqf(fmaxf(ss, 1e-24f));
            float kp[8], bsum = 0.f;
#pragma unroll
            for (int j = 0; j < 8; ++j) { kk[j] *= inv; kp[j] = k8[j] * (1.f + (a8[j] - 1.f) * cka[j]); bsum += r8[j] * kp[j] * crk[j]; }
            bon = red8(bsum);
            if (valid) {
                LAS float* p = L + tt * 64 + 8 * cg;
                *(LAS f32x4*)(p + RW_KK) = (f32x4){-kk[0], -kk[1], -kk[2], -kk[3]}; *(LAS f32x4*)(p + RW_KK + 4) = (f32x4){-kk[4], -kk[5], -kk[6], -kk[7]};
                *(LAS f32x4*)(p + RW_DD) = (f32x4){1.f - d8[0], 1.f - d8[1], 1.f - d8[2], 1.f - d8[3]}; *(LAS f32x4*)(p + RW_DD + 4) = (f32x4){1.f - d8[4], 1.f - d8[5], 1.f - d8[6], 1.f - d8[7]};
                *(LAS f32x4*)(p + RW_BB) = (f32x4){kk[0] * a8[0], kk[1] * a8[1], kk[2] * a8[2], kk[3] * a8[3]}; *(LAS f32x4*)(p + RW_BB + 4) = (f32x4){kk[4] * a8[4], kk[5] * a8[5], kk[6] * a8[6], kk[7] * a8[7]};
                *(LAS f32x4*)(p + RW_KP) = (f32x4){kp[0], kp[1], kp[2], kp[3]}; *(LAS f32x4*)(p + RW_KP + 4) = (f32x4){kp[4], kp[5], kp[6], kp[7]};
                *(LAS f32x4*)(p + RW_RR) = (f32x4){r8[0], r8[1], r8[2], r8[3]}; *(LAS f32x4*)(p + RW_RR + 4) = (f32x4){r8[4], r8[5], r8[6], r8[7]};
                *(LAS f32x4*)(p + RW_VV) = (f32x4){vv[0], vv[1], vv[2], vv[3]}; *(LAS f32x4*)(p + RW_VV + 4) = (f32x4){vv[4], vv[5], vv[6], vv[7]};
            }
        }
        __syncthreads();
        if (c + 1 < nch) { const int nt1 = (T - 64 * (c + 1)) < 64 ? (T - 64 * (c + 1)) : 64;
            if (tt < nt1) { const size_t off = (size_t)(row0 + 64 * (c + 1) + tt) * D + ch;
                pr = *(const v4u*)(Rb + off); pk = *(const v4u*)(Kb + off); pv = *(const v4u*)(Vb + off); pd = *(const v4u*)(Db + off); pa = *(const v4u*)(Ab + off); pg = *(const v4u*)(Gb + off); } }
        {
            typedef float f2 __attribute__((ext_vector_type(2)));
            f2 S2[4] = {{S[0], S[1]}, {S[2], S[3]}, {S[4], S[5]}, {S[6], S[7]}};
            const LAS float* p = L + 8 * cg;
            LAS float* yw = L + RW_YY + srow;
            const LAS float* vp = L + RW_VV + srow;
#define RW_LD(N, Dd, B, Q, R, VR, t_) do { const LAS float* p_ = p + (t_) * 64; \
                N[0] = *(const LAS f32x4*)(p_ + RW_KK); N[1] = *(const LAS f32x4*)(p_ + RW_KK + 4); Dd[0] = *(const LAS f32x4*)(p_ + RW_DD); Dd[1] = *(const LAS f32x4*)(p_ + RW_DD + 4); \
                B[0] = *(const LAS f32x4*)(p_ + RW_BB); B[1] = *(const LAS f32x4*)(p_ + RW_BB + 4); Q[0] = *(const LAS f32x4*)(p_ + RW_KP); Q[1] = *(const LAS f32x4*)(p_ + RW_KP + 4); \
                R[0] = *(const LAS f32x4*)(p_ + RW_RR); R[1] = *(const LAS f32x4*)(p_ + RW_RR + 4); VR = vp[(t_) * 64]; } while (0)
#define RW_STEP(N, Dd, B, Q, R, VR, t_) do { \
                f2 a_ = S2[0] * (f2){N[0].x, N[0].y}; a_ = S2[1] * (f2){N[0].z, N[0].w} + a_; a_ = S2[2] * (f2){N[1].x, N[1].y} + a_; a_ = S2[3] * (f2){N[1].z, N[1].w} + a_; \
                const float sa_ = red8(a_.x + a_.y); const f2 sv_ = {sa_, sa_}, vv_ = {VR, VR}; \
                S2[0] = S2[0] * (f2){Dd[0].x, Dd[0].y} + (sv_ * (f2){B[0].x, B[0].y} + vv_ * (f2){Q[0].x, Q[0].y}); \
                S2[1] = S2[1] * (f2){Dd[0].z, Dd[0].w} + (sv_ * (f2){B[0].z, B[0].w} + vv_ * (f2){Q[0].z, Q[0].w}); \
                S2[2] = S2[2] * (f2){Dd[1].x, Dd[1].y} + (sv_ * (f2){B[1].x, B[1].y} + vv_ * (f2){Q[1].x, Q[1].y}); \
                S2[3] = S2[3] * (f2){Dd[1].z, Dd[1].w} + (sv_ * (f2){B[1].z, B[1].w} + vv_ * (f2){Q[1].z, Q[1].w}); \
                f2 y_ = S2[0] * (f2){R[0].x, R[0].y}; y_ = S2[1] * (f2){R[0].z, R[0].w} + y_; y_ = S2[2] * (f2){R[1].x, R[1].y} + y_; y_ = S2[3] * (f2){R[1].z, R[1].w} + y_; \
                yw[(t_) * 64] = red8(y_.x + y_.y); } while (0)
            f32x4 nA[2], dA[2], bA[2], qA[2], rA[2]; float vA;
            for (int t = 0; t < nt; ++t) { RW_LD(nA, dA, bA, qA, rA, vA, t); RW_STEP(nA, dA, bA, qA, rA, vA, t); }
#undef RW_LD
#undef RW_STEP
            S[0] = S2[0].x; S[1] = S2[0].y; S[2] = S2[1].x; S[3] = S2[1].y; S[4] = S2[2].x; S[5] = S2[2].y; S[6] = S2[3].x; S[7] = S2[3].y;
        }
        __syncthreads();
        if (pvar != 4) {
            f32x4 y0 = {0.f, 0.f, 0.f, 0.f}, y1 = y0;
            if (valid) { y0 = *(const LAS f32x4*)(L + RW_YY + tt * 64 + 8 * cg); y1 = *(const LAS f32x4*)(L + RW_YY + tt * 64 + 8 * cg + 4); }
            float yy[8] = {y0.x, y0.y, y0.z, y0.w, y1.x, y1.y, y1.z, y1.w};
            float s1 = 0.f;
#pragma unroll
            for (int j = 0; j < 8; ++j) s1 += yy[j];
            const float mean = red8(s1) * (1.f / 64.f);
            float s2 = 0.f;
#pragma unroll
            for (int j = 0; j < 8; ++j) { yy[j] -= mean; s2 += yy[j] * yy[j]; }
            const float rstd = __builtin_amdgcn_rsqf(red8(s2) * (1.f / 64.f) + GN_EPS);
            float o[8];
#pragma unroll
            for (int j = 0; j < 8; ++j) o[j] = ((yy[j] * rstd) * cgw[j] + cgb[j] + bon * vv[j]) * gg[j];
            if (valid && do_store) *(v4u*)(Gb + (size_t)(row0 + 64 * c + tt) * D + ch) = pack8(o);
        }
    }
    *(f32x4*)(ST + srow * 64 + 8 * cg) = (f32x4){S[0], S[1], S[2], S[3]}; *(f32x4*)(ST + srow * 64 + 8 * cg + 4) = (f32x4){S[4], S[5], S[6], S[7]};
    __syncthreads();
}

constexpr int RH_TC = 32, RH_BUF = 12288;
constexpr int RH_KK = 0, RH_DD = 2048, RH_BB = 4096, RH_KP = 6144, RH_RR = 8192, RH_VV = 10240, RH_YY = 11264;
__device__ __forceinline__ void rwkv_half_chain(const Frame& F, int b, int h, int half, float* ST, const bf16* Rb, const bf16* Kb, const bf16* Vb, const bf16* Db, const bf16* Ab,
                                                bf16* YRAW, float* BON, const float* k_k, const float* k_a, const float* r_k, const int pvar) {
    LAS float* L = (LAS float*)F.lds;
    const int tid = F.tid, lane = F.lane, w = F.wave, row0 = b * PT;
    constexpr int nch = PT / RH_TC;
    if (w < 4) {
        const int srow = 8 * w + (lane >> 3), cq = lane & 7;
        f32x4 S4 = {0.f, 0.f, 0.f, 0.f}, S5 = S4;
        __syncthreads();
        __builtin_amdgcn_s_setprio(3);
        for (int c = 0; c < nch; ++c) {
            const LAS float* p = L + (c & 1) * RH_BUF + 8 * cq;
            LAS float* yw = L + (c & 1) * RH_BUF + RH_YY + srow;
            const LAS float* vp = L + (c & 1) * RH_BUF + RH_VV + srow;
#define RH_LD(N, Dd, B, Q, R, VR, t_) do { const LAS float* p_ = p + (t_) * 64; \
                N[0] = *(const LAS f32x4*)(p_ + RH_KK); N[1] = *(const LAS f32x4*)(p_ + RH_KK + 4); Dd[0] = *(const LAS f32x4*)(p_ + RH_DD); Dd[1] = *(const LAS f32x4*)(p_ + RH_DD + 4); \
                B[0] = *(const LAS f32x4*)(p_ + RH_BB); B[1] = *(const LAS f32x4*)(p_ + RH_BB + 4); Q[0] = *(const LAS f32x4*)(p_ + RH_KP); Q[1] = *(const LAS f32x4*)(p_ + RH_KP + 4); \
                R[0] = *(const LAS f32x4*)(p_ + RH_RR); R[1] = *(const LAS f32x4*)(p_ + RH_RR + 4); VR = vp[(t_) * 32]; } while (0)
#define RH_STEP(N, Dd, B, Q, R, VR, t_) do { \
                const f32x4 pa_ = S4 * N[0] + S5 * N[1]; const float sa_ = red8((pa_.x + pa_.y) + (pa_.z + pa_.w)); \
                S4 = S4 * Dd[0] + (B[0] * sa_ + Q[0] * VR); S5 = S5 * Dd[1] + (B[1] * sa_ + Q[1] * VR); \
                const f32x4 ya_ = S4 * R[0] + S5 * R[1]; yw[(t_) * 32] = red8((ya_.x + ya_.y) + (ya_.z + ya_.w)); } while (0)
            f32x4 nA[2], dA[2], bA[2], qA[2], rA[2], nB[2], dB[2], bB[2], qB[2], rB[2]; float vA, vB;
            RH_LD(nA, dA, bA, qA, rA, vA, 0);
            if (pvar != 3)
            for (int t = 0; t < RH_TC; t += 2) {
                RH_LD(nB, dB, bB, qB, rB, vB, t + 1);
                RH_STEP(nA, dA, bA, qA, rA, vA, t);
                RH_LD(nA, dA, bA, qA, rA, vA, (t + 2 < RH_TC ? t + 2 : t + 1));
                RH_STEP(nB, dB, bB, qB, rB, vB, t + 1);
            }
#undef RH_LD
#undef RH_STEP
            __syncthreads();
        }
        __builtin_amdgcn_s_setprio(0);
        *(f32x4*)(ST + (32 * half + srow) * 64 + 8 * cq) = S4; *(f32x4*)(ST + (32 * half + srow) * 64 + 8 * cq + 4) = S5;
    } else {
        const int ht = tid - 256, cg = ht & 7, tt = ht >> 3;
        const int ch = h * 64 + 8 * cg, vch = h * 64 + 32 * half + 4 * cg;
        float ckk[8], cka[8], crk[8];
#pragma unroll
        for (int j = 0; j < 8; ++j) { ckk[j] = k_k[ch + j]; cka[j] = k_a[ch + j]; crk[j] = r_k[ch + j]; }
        v4u pr, pk, pd, pa; uint2 pv;
#define RH_LOAD(cc) do { const size_t off_ = (size_t)(row0 + RH_TC * (cc) + tt) * D; pr = *(const v4u*)(Rb + off_ + ch); pk = *(const v4u*)(Kb + off_ + ch); pd = *(const v4u*)(Db + off_ + ch); \
            pa = *(const v4u*)(Ab + off_ + ch); pv = *(const uint2*)(Vb + off_ + vch); } while (0)
#define RH_PREP(cc) do { float r8[8], k8[8], d8[8], a8[8]; unpack8(pr, r8); unpack8(pk, k8); unpack8(pd, d8); unpack8(pa, a8); \
            float kk[8], ss = 0.f; _Pragma("unroll") for (int j = 0; j < 8; ++j) { kk[j] = k8[j] * ckk[j]; ss += kk[j] * kk[j]; } \
            ss = red8(ss); const float inv = __builtin_amdgcn_rsqf(fmaxf(ss, 1e-24f)); \
            float kp[8], bsum = 0.f; _Pragma("unroll") for (int j = 0; j < 8; ++j) { kk[j] *= inv; kp[j] = k8[j] * (1.f + (a8[j] - 1.f) * cka[j]); bsum += r8[j] * kp[j] * crk[j]; } \
            const float bon = red8(bsum); if (half == 0 && cg == 0) BON[(size_t)(row0 + RH_TC * (cc) + tt) * 16 + h] = bon; \
            LAS float* p = L + ((cc) & 1) * RH_BUF + tt * 64 + 8 * cg; \
            *(LAS f32x4*)(p + RH_KK) = (f32x4){-kk[0], -kk[1], -kk[2], -kk[3]}; *(LAS f32x4*)(p + RH_KK + 4) = (f32x4){-kk[4], -kk[5], -kk[6], -kk[7]}; \
            *(LAS f32x4*)(p + RH_DD) = (f32x4){1.f - d8[0], 1.f - d8[1], 1.f - d8[2], 1.f - d8[3]}; *(LAS f32x4*)(p + RH_DD + 4) = (f32x4){1.f - d8[4], 1.f - d8[5], 1.f - d8[6], 1.f - d8[7]}; \
            *(LAS f32x4*)(p + RH_BB) = (f32x4){kk[0] * a8[0], kk[1] * a8[1], kk[2] * a8[2], kk[3] * a8[3]}; *(LAS f32x4*)(p + RH_BB + 4) = (f32x4){kk[4] * a8[4], kk[5] * a8[5], kk[6] * a8[6], kk[7] * a8[7]}; \
            *(LAS f32x4*)(p + RH_KP) = (f32x4){kp[0], kp[1], kp[2], kp[3]}; *(LAS f32x4*)(p + RH_KP + 4) = (f32x4){kp[4], kp[5], kp[6], kp[7]}; \
            *(LAS f32x4*)(p + RH_RR) = (f32x4){r8[0], r8[1], r8[2], r8[3]}; *(LAS f32x4*)(p + RH_RR + 4) = (f32x4){r8[4], r8[5], r8[6], r8[7]}; \
            *(LAS f32x4*)(L + ((cc) & 1) * RH_BUF + RH_VV + tt * 32 + 4 * cg) = (f32x4){bflo(pv.x), bfhi(pv.x), bflo(pv.y), bfhi(pv.y)}; } while (0)
#define RH_POST(cc) do { const f32x4 y4 = *(const LAS f32x4*)(L + ((cc) & 1) * RH_BUF + RH_YY + tt * 32 + 4 * cg); uint2 o; o.x = pkbf(y4.x, y4.y); o.y = pkbf(y4.z, y4.w); \
            *(uint2*)(YRAW + (size_t)(row0 + RH_TC * (cc) + tt) * D + vch) = o; } while (0)
        RH_LOAD(0); RH_PREP(0); RH_LOAD(1);
        __syncthreads();
        for (int c = 0; c < nch; ++c) {
            if (c > 0) RH_POST(c - 1);
            if (c + 1 < nch) { RH_PREP(c + 1); if (c + 2 < nch) RH_LOAD(c + 2); }
            __syncthreads();
        }
        RH_POST(nch - 1);
#undef RH_LOAD
#undef RH_PREP
#undef RH_POST
    }
    __syncthreads();
}
__device__ __forceinline__ void rwkv_finish(const Frame& F, const bf16* YRAW, const float* BON, const bf16* Vb, bf16* Gb, const float* gn_w, const float* gn_b) {
    const int gt = (F.vcu * NWAVES + F.wave) * 64 + F.lane, NT = F.G * NWAVES * 64;
    for (int task = gt; task < MP * 128; task += NT) {
        const int cg = task & 7, hh = (task >> 3) & 15, row = task >> 7; const size_t off = (size_t)row * D + hh * 64 + 8 * cg;
        float yy[8], vv[8], gg[8]; unpack8(*(const v4u*)(YRAW + off), yy); unpack8(*(const v4u*)(Vb + off), vv); unpack8(*(const v4u*)(Gb + off), gg);
        const float bon = BON[(size_t)row * 16 + hh];
        float s1 = 0.f;
#pragma unroll
        for (int j = 0; j < 8; ++j) s1 += yy[j];
        const float mean = red8(s1) * (1.f / 64.f);
        float s2 = 0.f;
#pragma unroll
        for (int j = 0; j < 8; ++j) { yy[j] -= mean; s2 += yy[j] * yy[j]; }
        const float rstd = __builtin_amdgcn_rsqf(red8(s2) * (1.f / 64.f) + GN_EPS);
        const f32x4 w0 = *(const f32x4*)(gn_w + hh * 64 + 8 * cg), w1 = *(const f32x4*)(gn_w + hh * 64 + 8 * cg + 4), b0 = *(const f32x4*)(gn_b + hh * 64 + 8 * cg), b1 = *(const f32x4*)(gn_b + hh * 64 + 8 * cg + 4);
        const float gw[8] = {w0.x, w0.y, w0.z, w0.w, w1.x, w1.y, w1.z, w1.w}, gb[8] = {b0.x, b0.y, b0.z, b0.w, b1.x, b1.y, b1.z, b1.w};
        float o[8];
#pragma unroll
        for (int j = 0; j < 8; ++j) o[j] = ((yy[j] * rstd) * gw[j] + gb[j] + bon * vv[j]) * gg[j];
        *(v4u*)(Gb + off) = pack8(o);
    }
}

constexpr int PBY = 144;
constexpr int RPY = 272;
constexpr int ML_RQK = 0, ML_S = 0, ML_KT = 9216, ML_RV = 18432, ML_Q = 35840, ML_K = 45056, ML_HB = 35840, ML_VT = 54272, ML_C = 72704, ML_F = 91136;
constexpr int MF_N = 0, MF_QN = 64, MF_RS = 128, MF_HS = 256, MF_CW = 384, MF_B63 = 1024, MF_P63 = 1056, MF_MC = 1088  , MF_GB = 1152, MF_GP = MF_GB + 2048, MF_GA = MF_GP + 2048;
typedef __attribute__((address_space(3))) unsigned short lds_u16;
#define MFMA16(a, b, c) __builtin_amdgcn_mfma_f32_16x16x32_bf16((a), (b), (c), 0, 0, 0)
__device__ __forceinline__ void mlstm_gate_tables(const Frame& F, int b, int hh, const float* IFb) {
    LAS float* Fl = (LAS float*)(F.lds + ML_F); const int lane = F.lane, w = F.wave;
#pragma unroll
    for (int q = 0; q < 4; ++q) { const int cc = w + 8 * q; const size_t ro_ = (size_t)(b * PT + 64 * cc + lane) * 16;
        const float li = IFb[ro_ + hh], lf = IFb[ro_ + 8 + hh];
        float bc = lf;
#pragma unroll
        for (int o = 1; o < 64; o <<= 1) { const float x = __shfl_up(bc, o); if (lane >= o) bc += x; }
        const float av = li - bc; float pm = av;
#pragma unroll
        for (int o = 1; o < 64; o <<= 1) { const float x = __shfl_up(pm, o); if (lane >= o) pm = fmaxf(pm, x); }
        Fl[MF_GB + cc * 64 + lane] = bc; Fl[MF_GP + cc * 64 + lane] = pm; Fl[MF_GA + cc * 64 + lane] = av;
        if (lane == 63) { Fl[MF_B63 + cc] = bc; Fl[MF_P63 + cc] = pm; } }
    __syncthreads();
    if (F.tid == 0) { float mm = 0.f;
        for (int cc = 0; cc < PT / 64; ++cc) { Fl[MF_MC + cc] = mm; const float b6 = Fl[MF_B63 + cc]; mm = fmaxf(b6 + mm, b6 + Fl[MF_P63 + cc]); }
        Fl[MF_MC + PT / 64] = mm; }
    __syncthreads();
}
constexpr int ML_NSEG = 4, ML_SEGC = PT / 64 / ML_NSEG, ML_SEGSZ = 128 * 64 + 64;
__device__ __forceinline__ void mlstm_prompt_chain(const Frame& F, int b, int hh, const int seg, const bf16* QKR, const bf16* VVb, const bf16* OOb, const float* IFb, bf16* HOb,
                                                   const float* conv_w, const float* conv_b, const float* norm_w, float* NUM, float* DEN, bf16* Qs, float* SEG, const int pvar) {
    LAS unsigned char* lds = F.lds; LAS float* Fl = (LAS float*)(lds + ML_F);
    const bool defer = seg > 0; const int c_lo = seg * ML_SEGC, c_hi = c_lo + ML_SEGC;
    const int tid = F.tid, lane = F.lane, w = F.wave, fr = lane & 15, fq = lane >> 4;
    for (int i = tid; i < 128 * 72; i += 512) ((lds_u16*)(lds + ML_C))[i] = 0;
    if (tid < 64) Fl[MF_N + tid] = 0.f;
    for (int i = tid; i < 640; i += 512) { const int j = i >> 7, c = i & 127, gc = c < 64 ? hh * 64 + c : 512 + hh * 64 + (c - 64); Fl[MF_CW + i] = j < 4 ? conv_w[j * D + gc] : conv_b[gc]; }
    f32x4 Cacc[4];
#pragma unroll
    for (int k = 0; k < 4; ++k) Cacc[k] = (f32x4){0.f, 0.f, 0.f, 0.f};
    const int og = tid & 15, ot = tid >> 4;
    float nw[8];
#pragma unroll
    for (int e = 0; e < 8; ++e) nw[e] = norm_w[hh * 128 + 8 * og + e];
    v4u rq[3], rv[2], ro[2];
#define ML_LOAD_QKV(cc) do { const int rowc_ = b * PT + 64 * (cc); \
        _Pragma("unroll") for (int i = 0; i < 3; ++i) { const int q = tid + 512 * i, r = q >> 4, j = q & 15, tok = 64 * (cc) - 3 + r; rq[i] = (v4u){0u, 0u, 0u, 0u}; \
            if (q < 67 * 16 && tok >= 0) rq[i] = *(const v4u*)(QKR + (size_t)(b * PT + tok) * D + (j < 8 ? hh * 64 + 8 * j : 512 + hh * 64 + 8 * (j - 8))); } \
        _Pragma("unroll") for (int i = 0; i < 2; ++i) rv[i] = *(const v4u*)(VVb + (size_t)(rowc_ + ot + 32 * i) * D + hh * 128 + 8 * og); \
        } while (0)
#define ML_LOAD_O(cc) do { const int rowc_ = b * PT + 64 * (cc); \
        _Pragma("unroll") for (int i = 0; i < 2; ++i) ro[i] = *(const v4u*)(OOb + (size_t)(rowc_ + ot + 32 * i) * D + hh * 128 + 8 * og); } while (0)
    ML_LOAD_QKV(c_lo);
    mlstm_gate_tables(F, b, hh, IFb);
    for (int c = c_lo; c < c_hi; ++c) {
        const int rowc = b * PT + 64 * c;
        const float m_c = Fl[MF_MC + c], m_n = Fl[MF_MC + c + 1], b63 = Fl[MF_B63 + c];
#pragma unroll
        for (int i = 0; i < 3; ++i) { const int q = tid + 512 * i; if (q < 67 * 16) *(LAS v4u*)(lds + ML_RQK + (q >> 4) * RPY + 16 * (q & 15)) = rq[i]; }
#pragma unroll
        for (int i = 0; i < 2; ++i) *(LAS v4u*)(lds + ML_RV + (ot + 32 * i) * RPY + 16 * og) = rv[i];
        if (c + 1 < c_hi) ML_LOAD_QKV(c + 1);
        if (!defer) ML_LOAD_O(c);
        __syncthreads();
        float kreg[8] = {0.f, 0.f, 0.f, 0.f, 0.f, 0.f, 0.f, 0.f};
        if (pvar != 3)
#pragma unroll
        for (int i = 0; i < 2; ++i) {
            const int g = w + 8 * i, t = lane;
            float x[4][8];
#pragma unroll
            for (int j = 0; j < 4; ++j) unpack8(*(const LAS v4u*)(lds + ML_RQK + (t + j) * RPY + 16 * g), x[j]);
            float val[8];
#pragma unroll
            for (int h2 = 0; h2 < 2; ++h2) { f32x4 a = *(const LAS f32x4*)(Fl + MF_CW + 4 * 128 + 8 * g + 4 * h2);
#pragma unroll
                for (int j = 0; j < 4; ++j) { const f32x4 cw = *(const LAS f32x4*)(Fl + MF_CW + j * 128 + 8 * g + 4 * h2);
                    a.x += cw.x * x[j][4 * h2]; a.y += cw.y * x[j][4 * h2 + 1]; a.z += cw.z * x[j][4 * h2 + 2]; a.w += cw.w * x[j][4 * h2 + 3]; }
                val[4 * h2] = siluf_(a.x); val[4 * h2 + 1] = siluf_(a.y); val[4 * h2 + 2] = siluf_(a.z); val[4 * h2 + 3] = siluf_(a.w); }
            if (i == 0) {
#pragma unroll
                for (int e = 0; e < 8; ++e) val[e] *= 0.125f;
                *(LAS v4u*)(lds + ML_Q + t * PBY + 16 * w) = pack8(val);
            } else { *(LAS v4u*)(lds + ML_K + t * PBY + 16 * w) = pack8(val);
#pragma unroll
                for (int e = 0; e < 8; ++e) kreg[e] = val[e]; }
            const v4u vw = *(const LAS v4u*)(lds + ML_RV + t * RPY + 16 * g);
            lds_u16* vt = (lds_u16*)(lds + ML_VT) + (8 * g) * 72 + t;
            vt[0 * 72] = (unsigned short)(vw.x & 0xffffu); vt[1 * 72] = (unsigned short)(vw.x >> 16); vt[2 * 72] = (unsigned short)(vw.y & 0xffffu); vt[3 * 72] = (unsigned short)(vw.y >> 16);
            vt[4 * 72] = (unsigned short)(vw.z & 0xffffu); vt[5 * 72] = (unsigned short)(vw.z >> 16); vt[6 * 72] = (unsigned short)(vw.w & 0xffffu); vt[7 * 72] = (unsigned short)(vw.w >> 16);
        }
        __syncthreads();
        if (pvar != 4) {
        { const float wsv = __expf(b63 + Fl[MF_GA + c * 64 + lane] - m_n); lds_u16* kt = (lds_u16*)(lds + ML_KT) + (8 * w) * 72 + lane;
#pragma unroll
          for (int e = 0; e < 8; ++e) kt[e * 72] = f2bf1(kreg[e] * wsv); }
        { const int tq = tid >> 3, p = tid & 7; float q8[8]; unpack8(*(const LAS v4u*)(lds + ML_Q + tq * PBY + 16 * p), q8);
          float dsum = 0.f;
#pragma unroll
          for (int e = 0; e < 8; ++e) dsum += q8[e] * Fl[MF_N + 8 * p + e];
          dsum = red8(dsum); if (p == 0) Fl[MF_QN + tq] = dsum; }
        { const int ti = w >> 1, t = 16 * ti + fr; float rsum = 0.f; const float mxt = fmaxf(m_c, Fl[MF_GP + c * 64 + t]);
          typedef unsigned u2v_ __attribute__((ext_vector_type(2)));
#pragma unroll
          for (int jj = 0; jj < 2; ++jj) { const int sj = 2 * (w & 1) + jj; f32x4 acc = {0.f, 0.f, 0.f, 0.f};
#pragma unroll
              for (int ks = 0; ks < 2; ++ks) { const bf16x8 a = *(const LAS bf16x8*)(lds + ML_Q + (16 * ti + fr) * PBY + ks * 64 + fq * 16), bb = *(const LAS bf16x8*)(lds + ML_K + (16 * sj + fr) * PBY + ks * 64 + fq * 16);
                  acc = MFMA16(bb, a, acc); }
              const f32x4 av4 = *(const LAS f32x4*)(Fl + MF_GA + c * 64 + 16 * sj + 4 * fq);
#pragma unroll
              for (int r = 0; r < 4; ++r) { const int s_ = 16 * sj + 4 * fq + r; const float val = s_ <= t ? acc[r] * __expf(av4[r] - mxt) : 0.f; acc[r] = val; rsum += val; }
              u2v_ pw; pw.x = pkbf(acc[0], acc[1]); pw.y = pkbf(acc[2], acc[3]);
              *(LAS u2v_*)(lds + ML_S + (t * 72 + 16 * sj + 4 * fq) * 2) = pw; }
          rsum += __shfl_xor(rsum, 16); rsum += __shfl_xor(rsum, 32);
          if (fq == 0) Fl[MF_RS + t * 2 + (w & 1)] = rsum; }
        }
        __syncthreads();
        float hv[4][4] = {};
        if (pvar != 5) { const int ti = w & 3, t = 16 * ti + fr;
          const float mx = fmaxf(m_c, Fl[MF_GP + c * 64 + t]), wi = __expf(m_c - mx), ei = __expf(-(Fl[MF_GB + c * 64 + t] + mx));
          const float rden = __builtin_amdgcn_rcpf(fmaxf(fabsf(wi * Fl[MF_QN + t] + Fl[MF_RS + 2 * t] + Fl[MF_RS + 2 * t + 1]), ei)); float hq = 0.f;
#pragma unroll
          for (int i = 0; i < 4; ++i) { const int vt = 4 * (w >> 2) + i; f32x4 accA = {0.f, 0.f, 0.f, 0.f}, accB = accA;
#pragma unroll
              for (int ks = 0; ks < 2; ++ks) {
                  const bf16x8 aq = *(const LAS bf16x8*)(lds + ML_Q + (16 * ti + fr) * PBY + ks * 64 + fq * 16), bc = *(const LAS bf16x8*)(lds + ML_C + (16 * vt + fr) * PBY + ks * 64 + fq * 16);
                  accA = MFMA16(bc, aq, accA);
                  const bf16x8 as = *(const LAS bf16x8*)(lds + ML_S + (16 * ti + fr) * PBY + ks * 64 + fq * 16), bv = *(const LAS bf16x8*)(lds + ML_VT + (16 * vt + fr) * PBY + ks * 64 + fq * 16);
                  accB = MFMA16(bv, as, accB); }
              if (defer) { *(f32x4*)(NUM + (size_t)(rowc + t) * D + hh * 128 + 16 * vt + 4 * fq) = accA * wi + accB; }
              else {
#pragma unroll
              for (int r = 0; r < 4; ++r) { const float hh_ = (wi * accA[r] + accB[r]) * rden; hv[i][r] = hh_; hq += hh_ * hh_; } } }
          if (defer) { if (fq == 0 && (w >> 2) == 0) DEN[(size_t)(rowc + t) * 8 + hh] = wi * Fl[MF_QN + t] + Fl[MF_RS + 2 * t] + Fl[MF_RS + 2 * t + 1];
              *(v4u*)(Qs + (size_t)(rowc + (tid >> 3)) * 512 + hh * 64 + 8 * (tid & 7)) = *(const LAS v4u*)(lds + ML_Q + (tid >> 3) * PBY + 16 * (tid & 7)); }
          else { hq += __shfl_xor(hq, 16); hq += __shfl_xor(hq, 32);
              if (fq == 0) Fl[MF_HS + t * 2 + (w >> 2)] = hq; } }
        __syncthreads();
        if (pvar != 6) {
        if (!defer) { const int ti = w & 3, t = 16 * ti + fr; const float sc = __builtin_amdgcn_rsqf((Fl[MF_HS + 2 * t] + Fl[MF_HS + 2 * t + 1]) * (1.f / 128.f) + NORM_EPS);
          typedef unsigned u2v_ __attribute__((ext_vector_type(2)));
#pragma unroll
          for (int i = 0; i < 4; ++i) { u2v_ pw; pw.x = pkbf(hv[i][0] * sc, hv[i][1] * sc); pw.y = pkbf(hv[i][2] * sc, hv[i][3] * sc);
              *(LAS u2v_*)(lds + ML_HB + t * RPY + (16 * (4 * (w >> 2) + i) + 4 * fq) * 2) = pw; } }
        { const float wst = __expf(b63 + m_c - m_n);
          typedef unsigned u2v_ __attribute__((ext_vector_type(2)));
#pragma unroll
          for (int kt = 0; kt < 4; ++kt) { Cacc[kt] = Cacc[kt] * wst;
#pragma unroll
              for (int ks = 0; ks < 2; ++ks) { const bf16x8 a = *(const LAS bf16x8*)(lds + ML_VT + (16 * w + fr) * PBY + ks * 64 + fq * 16), bb = *(const LAS bf16x8*)(lds + ML_KT + (16 * kt + fr) * PBY + ks * 64 + fq * 16);
                  Cacc[kt] = MFMA16(bb, a, Cacc[kt]); }
              u2v_ pw; pw.x = pkbf(Cacc[kt][0], Cacc[kt][1]); pw.y = pkbf(Cacc[kt][2], Cacc[kt][3]);
              *(LAS u2v_*)(lds + ML_C + ((16 * w + fr) * 72 + 16 * kt + 4 * fq) * 2) = pw; }
          if (w == 0) { float sum = 0.f;
#pragma unroll
              for (int q = 0; q < 8; ++q) { float k8[8]; unpack8(*(const LAS v4u*)(lds + ML_KT + lane * PBY + 16 * q), k8);
#pragma unroll
                  for (int e = 0; e < 8; ++e) sum += k8[e]; }
              Fl[MF_N + lane] = wst * Fl[MF_N + lane] + sum; } }
        }
        __syncthreads();
        if (!defer)
#pragma unroll
        for (int i = 0; i < 2; ++i) { const int t = ot + 32 * i; float h8[8], o8[8]; unpack8(*(const LAS v4u*)(lds + ML_HB + t * RPY + 16 * og), h8); unpack8(ro[i], o8);
#pragma unroll
            for (int e = 0; e < 8; ++e) h8[e] = h8[e] * nw[e] * o8[e];
            *(v4u*)(HOb + (size_t)(rowc + t) * D + hh * 128 + 8 * og) = pack8(h8); }
    }
#undef ML_LOAD_QKV
#undef ML_LOAD_O
    { float* sp = SEG + (size_t)((b * 8 + hh) * ML_NSEG + seg) * ML_SEGSZ;
#pragma unroll
      for (int kt = 0; kt < 4; ++kt) *(f32x4*)(sp + (16 * w + fr) * 64 + 16 * kt + 4 * fq) = Cacc[kt];
      if (w == 0) sp[128 * 64 + lane] = Fl[MF_N + lane]; }
    __syncthreads();
}
__device__ __forceinline__ void mlstm_fix_seg(const Frame& F, int b, int hh, const int seg, const bf16* QKR, const bf16* OOb, const float* IFb, bf16* HOb, const float* norm_w,
                                              const float* NUM, const float* DEN, const bf16* Qs, const float* SEG, float* out) {
    LAS unsigned char* lds = F.lds; LAS float* Fl = (LAS float*)(lds + ML_F);
    const int tid = F.tid, lane = F.lane, w = F.wave, fr = lane & 15, fq = lane >> 4;
    const int og = tid & 15, ot = tid >> 4, chain = b * 8 + hh;
    typedef unsigned u2v_ __attribute__((ext_vector_type(2)));
    float nw[8];
#pragma unroll
    for (int e = 0; e < 8; ++e) nw[e] = norm_w[hh * 128 + 8 * og + e];
    const int c_lo = seg * ML_SEGC, c_hi = c_lo + ML_SEGC;
    v4u rq, ro[2]; f32x4 numl[4]; float denl;
#define MLF_LOAD(cc, RQ, RO, NL, DL) do { const int rowc_ = b * PT + 64 * (cc); \
        RQ = *(const v4u*)(Qs + (size_t)(rowc_ + (tid >> 3)) * 512 + hh * 64 + 8 * (tid & 7)); \
        _Pragma("unroll") for (int i = 0; i < 2; ++i) RO[i] = *(const v4u*)(OOb + (size_t)(rowc_ + ot + 32 * i) * D + hh * 128 + 8 * og); \
        _Pragma("unroll") for (int i = 0; i < 4; ++i) NL[i] = *(const f32x4*)(NUM + (size_t)(rowc_ + 16 * (w & 3) + fr) * D + hh * 128 + 16 * (4 * (w >> 2) + i) + 4 * fq); \
        DL = DEN[(size_t)(rowc_ + 16 * (w & 3) + fr) * 8 + hh]; } while (0)
    MLF_LOAD(c_lo, rq, ro, numl, denl);
    mlstm_gate_tables(F, b, hh, IFb);
    {
        f32x4 cin[4]; float nin = 0.f;
#pragma unroll
        for (int i = 0; i < 4; ++i) cin[i] = (f32x4){0.f, 0.f, 0.f, 0.f};
        for (int j = 0; j < seg; ++j) {
            float lw = 0.f;
            for (int cc = j * ML_SEGC; cc < (j + 1) * ML_SEGC; ++cc) lw += Fl[MF_B63 + cc] + Fl[MF_MC + cc] - Fl[MF_MC + cc + 1];
            const float Wj = __expf(lw); const float* sp = SEG + (size_t)(chain * ML_NSEG + j) * ML_SEGSZ;
#pragma unroll
            for (int i = 0; i < 4; ++i) cin[i] = cin[i] * Wj + *(const f32x4*)(sp + 4 * (tid + 512 * i));
            if (tid < 64) nin = nin * Wj + sp[128 * 64 + tid];
        }
#pragma unroll
        for (int i = 0; i < 4; ++i) { const int idx = tid + 512 * i, v = idx >> 4, k4 = (idx & 15) * 4; u2v_ pw; pw.x = pkbf(cin[i][0], cin[i][1]); pw.y = pkbf(cin[i][2], cin[i][3]);
            *(LAS u2v_*)(lds + ML_C + (v * 72 + k4) * 2) = pw; }
        if (tid < 64) Fl[MF_N + tid] = nin;
        if (seg == ML_NSEG - 1) {
            float lw = 0.f;
            for (int cc = seg * ML_SEGC; cc < (seg + 1) * ML_SEGC; ++cc) lw += Fl[MF_B63 + cc] + Fl[MF_MC + cc] - Fl[MF_MC + cc + 1];
            const float Wj = __expf(lw); const float* sp = SEG + (size_t)(chain * ML_NSEG + seg) * ML_SEGSZ;
#pragma unroll
            for (int i = 0; i < 4; ++i) *(f32x4*)(out + O_P_C + (size_t)chain * 8192 + 4 * (tid + 512 * i)) = cin[i] * Wj + *(const f32x4*)(sp + 4 * (tid + 512 * i));
            if (tid < 64) out[O_P_N + (size_t)chain * 64 + tid] = nin * Wj + sp[128 * 64 + tid];
            if (tid == 0) out[O_P_M + chain] = Fl[MF_MC + PT / 64];
            if (tid < 384) { const int j = tid >> 7, c = tid & 127, gc = c < 64 ? hh * 64 + c : 512 + hh * 64 + (c - 64);
                out[O_P_CONV + (size_t)(b * 3 + j) * D + gc] = bf1(QKR[(size_t)(b * PT + PT - 3 + j) * D + gc]); }
        }
    }
    float wc = 1.f;
    for (int c = c_lo; c < c_hi; ++c) {
        const int rowc = b * PT + 64 * c;
        const float m_c = Fl[MF_MC + c], m_n = Fl[MF_MC + c + 1], b63 = Fl[MF_B63 + c];
        *(LAS v4u*)(lds + ML_RQK + (tid >> 3) * PBY + 16 * (tid & 7)) = rq;
        v4u rqn = rq, ron[2] = {ro[0], ro[1]}; f32x4 numn[4] = {numl[0], numl[1], numl[2], numl[3]}; float denn = denl;
        if (c + 1 < c_hi) MLF_LOAD(c + 1, rqn, ron, numn, denn);
        __syncthreads();
        { const int tq = tid >> 3, p = tid & 7; float q8[8]; unpack8(*(const LAS v4u*)(lds + ML_RQK + tq * PBY + 16 * p), q8);
          float dsum = 0.f;
#pragma unroll
          for (int e = 0; e < 8; ++e) dsum += q8[e] * Fl[MF_N + 8 * p + e];
          dsum = red8(dsum); if (p == 0) Fl[MF_QN + tq] = dsum; }
        const int ti = w & 3, t = 16 * ti + fr;
        f32x4 accA[4];
#pragma unroll
        for (int i = 0; i < 4; ++i) { const int vt = 4 * (w >> 2) + i; accA[i] = (f32x4){0.f, 0.f, 0.f, 0.f};
#pragma unroll
            for (int ks = 0; ks < 2; ++ks) {
                const bf16x8 aq = *(const LAS bf16x8*)(lds + ML_RQK + (16 * ti + fr) * PBY + ks * 64 + fq * 16), bc = *(const LAS bf16x8*)(lds + ML_C + (16 * vt + fr) * PBY + ks * 64 + fq * 16);
                accA[i] = MFMA16(bc, aq, accA[i]); } }
        __syncthreads();
        float hv[4][4];
        { const float mx = fmaxf(m_c, Fl[MF_GP + c * 64 + t]), wi = __expf(m_c - mx) * wc, ei = __expf(-(Fl[MF_GB + c * 64 + t] + mx));
          const float rden = __builtin_amdgcn_rcpf(fmaxf(fabsf(wi * Fl[MF_QN + t] + denl), ei)); float hq = 0.f;
#pragma unroll
          for (int i = 0; i < 4; ++i)
#pragma unroll
              for (int r = 0; r < 4; ++r) { const float hh_ = (wi * accA[i][r] + numl[i][r]) * rden; hv[i][r] = hh_; hq += hh_ * hh_; }
          hq += __shfl_xor(hq, 16); hq += __shfl_xor(hq, 32);
          if (fq == 0) Fl[MF_HS + t * 2 + (w >> 2)] = hq; }
        __syncthreads();
        { const float sc = __builtin_amdgcn_rsqf((Fl[MF_HS + 2 * t] + Fl[MF_HS + 2 * t + 1]) * (1.f / 128.f) + NORM_EPS);
#pragma unroll
          for (int i = 0; i < 4; ++i) { u2v_ pw; pw.x = pkbf(hv[i][0] * sc, hv[i][1] * sc); pw.y = pkbf(hv[i][2] * sc, hv[i][3] * sc);
              *(LAS u2v_*)(lds + ML_HB + t * RPY + (16 * (4 * (w >> 2) + i) + 4 * fq) * 2) = pw; } }
        __syncthreads();
#pragma unroll
        for (int i = 0; i < 2; ++i) { const int t2 = ot + 32 * i; float h8[8], o8[8]; unpack8(*(const LAS v4u*)(lds + ML_HB + t2 * RPY + 16 * og), h8); unpack8(ro[i], o8);
#pragma unroll
            for (int e = 0; e < 8; ++e) h8[e] = h8[e] * nw[e] * o8[e];
            *(v4u*)(HOb + (size_t)(rowc + t2) * D + hh * 128 + 8 * og) = pack8(h8); }
        wc *= __expf(b63 + m_c - m_n);
        rq = rqn; ro[0] = ron[0]; ro[1] = ron[1]; denl = denn;
#pragma unroll
        for (int i = 0; i < 4; ++i) numl[i] = numn[i];
    }
#undef MLF_LOAD
    __syncthreads();
}
__device__ __forceinline__ void mlstm_sample_item(const Frame& F, int b, int hh, const bf16* QKR, const bf16* VVb, const bf16* OOb, const float* IFb, bf16* HOb,
                                                  const float* conv_w, const float* conv_b, const float* norm_w, const float* C0, const float* n0, const float* m0p, const float* conv0, float* out) {
    LAS float* L = (LAS float*)F.lds;
    constexpr int LQ = 0, LK = 256, LV = 512, LS = 1024, LQN = 1040, LHS = 1048;
    const int tid = F.tid, lane = F.lane, w = F.wave, row0 = MP + 4 * b;
    float li[4], lf[4];
#pragma unroll
    for (int t = 0; t < 4; ++t) { li[t] = IFb[(size_t)(row0 + t) * 16 + hh]; lf[t] = IFb[(size_t)(row0 + t) * 16 + 8 + hh]; }
    const float m0 = m0p[b * 8 + hh];
    float bc[4], av[4], mt[4], wi[4], wsv[4], ei[4], bm[4];
    { float run = 0.f, pm = -3.0e38f;
#pragma unroll
      for (int t = 0; t < 4; ++t) { run += lf[t]; bc[t] = run; av[t] = li[t] - run; pm = fmaxf(pm, av[t]); mt[t] = fmaxf(run + m0, run + pm); } }
    const float m_new = mt[3], wst = __expf(bc[3] + m0 - m_new);
#pragma unroll
    for (int t = 0; t < 4; ++t) { wi[t] = __expf(bc[t] + m0 - mt[t]); wsv[t] = __expf(bc[3] + av[t] - m_new); ei[t] = __expf(-mt[t]); bm[t] = bc[t] - mt[t]; }
    { const int t = tid >> 7, c = tid & 127, gc = c < 64 ? hh * 64 + c : 512 + hh * 64 + (c - 64);
      float x[4];
#pragma unroll
      for (int j = 0; j < 4; ++j) { const int p = t + j; x[j] = p < 3 ? conv0[(size_t)(b * 3 + p) * D + gc] : bf1(QKR[(size_t)(row0 + p - 3) * D + gc]); }
      float a = conv_b[gc];
#pragma unroll
      for (int j = 0; j < 4; ++j) a += conv_w[j * D + gc] * x[j];
      const float val = siluf_(a);
      if (c < 64) L[LQ + t * 64 + c] = val * 0.125f; else L[LK + t * 64 + (c - 64)] = val;
      if (t >= 1) out[O_S_CONV + (size_t)(b * 3 + t - 1) * D + gc] = x[3];
      L[LV + t * 128 + c] = bf1(VVb[(size_t)(row0 + t) * D + hh * 128 + c]); }
    __syncthreads();
    if (w == 0) { const int pair = lane >> 2, t = pair >> 2, s = pair & 3, part = lane & 3; float dsum = 0.f;
#pragma unroll
        for (int e = 0; e < 16; ++e) dsum += L[LQ + t * 64 + 16 * part + e] * L[LK + s * 64 + 16 * part + e];
        dsum = red4(dsum);
        const float bmt = t == 0 ? bm[0] : (t == 1 ? bm[1] : (t == 2 ? bm[2] : bm[3])), avs = s == 0 ? av[0] : (s == 1 ? av[1] : (s == 2 ? av[2] : av[3]));
        if (part == 0) L[LS + pair] = s <= t ? dsum * __expf(bmt + avs) : 0.f; }
    if (w == 1) { const int t = lane >> 4, part = lane & 15; float dsum = 0.f;
#pragma unroll
        for (int e = 0; e < 4; ++e) dsum += L[LQ + t * 64 + 4 * part + e] * n0[(size_t)(b * 8 + hh) * 64 + 4 * part + e];
        dsum = red16(dsum); if (part == 0) L[LQN + t] = dsum; }
    __syncthreads();
    const int v = tid >> 2, kq = tid & 3;
    float hvv[4];
    { const size_t coff = ((size_t)(b * 8 + hh) * 128 + v) * 64 + 16 * kq;
      float c0[16];
#pragma unroll
      for (int e4 = 0; e4 < 4; ++e4) { const f32x4 x = *(const f32x4*)(C0 + coff + 4 * e4); c0[4 * e4] = x.x; c0[4 * e4 + 1] = x.y; c0[4 * e4 + 2] = x.z; c0[4 * e4 + 3] = x.w; }
#pragma unroll
      for (int t = 0; t < 4; ++t) { float part = 0.f;
#pragma unroll
          for (int e = 0; e < 16; ++e) part += c0[e] * L[LQ + t * 64 + 16 * kq + e];
          const float inter = red4(part);
          float num = wi[t] * inter, den = wi[t] * L[LQN + t];
#pragma unroll
          for (int s = 0; s < 4; ++s) { const float sm = L[LS + t * 4 + s]; num += sm * L[LV + s * 128 + v]; den += sm; }
          hvv[t] = num / fmaxf(fabsf(den), ei[t]); }
#pragma unroll
      for (int t = 0; t < 4; ++t) { const float x = wave_sum(kq == 0 ? hvv[t] * hvv[t] : 0.f); if (lane == 0) L[LHS + w * 4 + t] = x; }
      float cn[16];
#pragma unroll
      for (int e = 0; e < 16; ++e) { float a = wst * c0[e];
#pragma unroll
          for (int s = 0; s < 4; ++s) a += wsv[s] * L[LV + s * 128 + v] * L[LK + s * 64 + 16 * kq + e];
          cn[e] = a; }
#pragma unroll
      for (int e4 = 0; e4 < 4; ++e4) *(f32x4*)(out + O_S_C + coff + 4 * e4) = (f32x4){cn[4 * e4], cn[4 * e4 + 1], cn[4 * e4 + 2], cn[4 * e4 + 3]}; }
    __syncthreads();
    if (kq == 0) {
#pragma unroll
        for (int t = 0; t < 4; ++t) { float tot = 0.f;
#pragma unroll
            for (int ww = 0; ww < 8; ++ww) tot += L[LHS + ww * 4 + t];
            const float sc = 1.0f / sqrtf(tot * (1.f / 128.f) + NORM_EPS); const size_t off = (size_t)(row0 + t) * D + hh * 128 + v;
            HOb[off] = f2bf1(hvv[t] * sc * norm_w[hh * 128 + v] * bf1(OOb[off])); } }
    if (tid < 64) { float a = wst * n0[(size_t)(b * 8 + hh) * 64 + tid];
#pragma unroll
        for (int s = 0; s < 4; ++s) a += wsv[s] * L[LK + s * 64 + tid];
        out[O_S_N + (size_t)(b * 8 + hh) * 64 + tid] = a; }
    if (tid == 0) out[O_S_M + b * 8 + hh] = m_new;
    __syncthreads();
}

constexpr int CA_AH = 0, CA_BH = 9216, CA_KH = 18432, CA_RH = 27648, CA_BT = 36864, CA_KT = 46080, CA_VT = 55296, CA_AB = 64512, CA_AK = 73728, CA_RB = 82944, CA_RK = 92160, CA_XT = 101376,
              CA_TD = 119808, CA_NF = 123904, CA_GL = 128000, CA_LG = CA_AB  , CA_AT = CA_KH  ;
__device__ __forceinline__ bf16x8 ldsfrag(LAS unsigned char* lds, int base, int row, int ks, int fq) { return *(const LAS bf16x8*)(lds + base + row * PBY + ks * 64 + fq * 16); }
__device__ __forceinline__ void rwkv_chunk_item(const Frame& F, int chain, int chunk, bf16* Rb, bf16* Kb, bf16* Vb, bf16* Db, bf16* Ab, bf16* Gb,
                                                const float* k_k, const float* k_a, const float* r_k, float* BON, bf16* dummy, v4u (&pf)[6], const int nchain, const int nchunk) {
    LAS unsigned char* lds = F.lds;
    const int tid = F.tid, lane = F.lane, w = F.wave, fr = lane & 15, fq = lane >> 4, cg = tid & 7, tt = tid >> 3;
    const int h = chain & 15, row0 = (chain >> 4) * PT + 64 * chunk, ch = h * 64 + 8 * cg;
    const size_t goff = (size_t)(row0 + tt) * D + ch;
    LAS float* LG = (LAS float*)(lds + CA_LG); LAS float* GLf = (LAS float*)(lds + CA_GL);
    float r8[8], kp[8], av[8], bv[8], rd[8];
    {
        float k8[8], v8[8], d8[8], a8[8];
        unpack8(pf[0], r8); unpack8(pf[1], k8); unpack8(pf[2], v8); unpack8(pf[3], d8); unpack8(pf[4], a8);
        float ss = 0.f;
#pragma unroll
        for (int j = 0; j < 8; ++j) { av[j] = k8[j] * k_k[ch + j]; ss += av[j] * av[j]; }
        ss = red8(ss); const float inv = __builtin_amdgcn_rsqf(fmaxf(ss, 1e-24f));
        float bsum = 0.f;
#pragma unroll
        for (int j = 0; j < 8; ++j) { const float kk = av[j] * inv; kp[j] = k8[j] * (1.f + (a8[j] - 1.f) * k_a[ch + j]); bv[j] = kk * a8[j]; av[j] = -kk; bsum += r8[j] * kp[j] * r_k[ch + j]; rd[j] = __builtin_amdgcn_rcpf(1.f - d8[j]); }
        const float bon = red8(bsum);
#pragma unroll
        for (int j = 0; j < 8; ++j) { LG[(8 * cg + j) * 64 + tt] = __logf(1.f - d8[j]); ((lds_u16*)(lds + CA_VT))[(8 * cg + j) * 72 + tt] = f2bf1(v8[j]); }
        if (cg == 0 && !dummy) BON[(size_t)(row0 + tt) * 16 + h] = bon;
    }
    __syncthreads();
    { float x[8];
#pragma unroll
      for (int q = 0; q < 8; ++q) x[q] = LG[(8 * w + q) * 64 + lane];
#pragma unroll
      for (int q = 0; q < 8; ++q) {
          float v = x[q];
          v += __builtin_bit_cast(float, __builtin_amdgcn_update_dpp(0, __builtin_bit_cast(int, v), 0x111, 0xF, 0xF, true));
          v += __builtin_bit_cast(float, __builtin_amdgcn_update_dpp(0, __builtin_bit_cast(int, v), 0x112, 0xF, 0xF, true));
          v += __builtin_bit_cast(float, __builtin_amdgcn_update_dpp(0, __builtin_bit_cast(int, v), 0x114, 0xF, 0xF, true));
          v += __builtin_bit_cast(float, __builtin_amdgcn_update_dpp(0, __builtin_bit_cast(int, v), 0x118, 0xF, 0xF, true));
          v += __builtin_bit_cast(float, __builtin_amdgcn_update_dpp(0, __builtin_bit_cast(int, v), 0x142, 0xA, 0xF, false));
          v += __builtin_bit_cast(float, __builtin_amdgcn_update_dpp(0, __builtin_bit_cast(int, v), 0x143, 0xC, 0xF, false));
          x[q] = v; }
#pragma unroll
      for (int q = 0; q < 8; ++q) LG[(8 * w + q) * 64 + lane] = x[q]; }
    __syncthreads();
    {
        float ah[8], bh[8], kh[8], rh[8];
#pragma unroll
        for (int j = 0; j < 8; ++j) { const float lg = LG[(8 * cg + j) * 64 + tt]; const float G = __expf(lg), Gm1 = G * rd[j], Gi = __builtin_amdgcn_rcpf(G);
            ah[j] = av[j] * Gm1; bh[j] = bv[j] * Gi; kh[j] = kp[j] * Gi; rh[j] = r8[j] * G;
            ((lds_u16*)(lds + CA_BT))[(8 * cg + j) * 72 + tt] = f2bf1(bh[j]); ((lds_u16*)(lds + CA_KT))[(8 * cg + j) * 72 + tt] = f2bf1(kh[j]);
            if (tt == 63) GLf[8 * cg + j] = G; }
        *(LAS v4u*)(lds + CA_AH + tt * PBY + 16 * cg) = pack8(ah); *(LAS v4u*)(lds + CA_BH + tt * PBY + 16 * cg) = pack8(bh);
        *(LAS v4u*)(lds + CA_KH + tt * PBY + 16 * cg) = pack8(kh); *(LAS v4u*)(lds + CA_RH + tt * PBY + 16 * cg) = pack8(rh);
    }
    __syncthreads();
    {
        const int mi = w >> 1, ti0 = 2 * (w & 1); const int abase = mi < 2 ? CA_AH : CA_RH, bbase = (mi & 1) ? CA_KH : CA_BH, dbase = CA_AB + mi * 9216;
        bf16x8 af[2][2], bfr[4][2];
#pragma unroll
        for (int a = 0; a < 2; ++a)
#pragma unroll
            for (int ks = 0; ks < 2; ++ks) af[a][ks] = ldsfrag(lds, abase, 16 * (ti0 + a) + fr, ks, fq);
#pragma unroll
        for (int sj = 0; sj < 4; ++sj)
#pragma unroll
            for (int ks = 0; ks < 2; ++ks) bfr[sj][ks] = ldsfrag(lds, bbase, 16 * sj + fr, ks, fq);
#pragma unroll
        for (int a = 0; a < 2; ++a)
#pragma unroll
            for (int sj = 0; sj < 4; ++sj) { const int ti = ti0 + a; f32x4 acc = {0.f, 0.f, 0.f, 0.f};
#pragma unroll
                for (int ks = 0; ks < 2; ++ks) acc = MFMA16(bfr[sj][ks], af[a][ks], acc);
                const int t = 16 * ti + fr;
#pragma unroll
                for (int r = 0; r < 4; ++r) { const int s = 16 * sj + 4 * fq + r; acc[r] = (mi < 2 ? s < t : s <= t) ? acc[r] : 0.f; }
                typedef unsigned u2v_ __attribute__((ext_vector_type(2))); u2v_ pw; pw.x = pkbf(acc[0], acc[1]); pw.y = pkbf(acc[2], acc[3]);
                *(LAS u2v_*)(lds + dbase + (t * 72 + 16 * sj + 4 * fq) * 2) = pw;
                if (mi == 0 && ti == sj) *(LAS f32x4*)(lds + CA_NF + (ti * 256 + fr * 16 + 4 * fq) * 4) = acc; }
    }
    __syncthreads();
    f32x4 rhs[4];
    if (w == 0) { const int blk = fq, c = fr; const LAS float* N = (const LAS float*)(lds + CA_NF) + blk * 256; float T[16];
#pragma unroll
        for (int i = 0; i < 16; ++i) T[i] = (i == c) ? 1.f : 0.f;
#pragma unroll
        for (int j = 0; j < 15; ++j) {
#pragma unroll
            for (int i = j + 1; i < 16; ++i) T[i] += N[i * 16 + j] * T[j]; }
        lds_u16* td = (lds_u16*)(lds + CA_TD) + blk * 512;
#pragma unroll
        for (int i = 0; i < 16; ++i) { td[i * 32 + c] = f2bf1(T[i]); td[i * 32 + 16 + c] = 0; } }
    if (w < 4) {
#pragma unroll
        for (int i = 0; i < 4; ++i)
#pragma unroll
            for (int r = 0; r < 4; ++r) rhs[i][r] = bf1(((lds_u16*)(lds + CA_AH))[(16 * i + 4 * fq + r) * 72 + 16 * w + fr]);
    } else {
#pragma unroll
        for (int i = 0; i < 4; ++i) { f32x4 acc = {0.f, 0.f, 0.f, 0.f};
#pragma unroll
            for (int ks = 0; ks < 2; ++ks) acc = MFMA16(ldsfrag(lds, CA_AK, 16 * i + fr, ks, fq), ldsfrag(lds, CA_VT, 16 * (w - 4) + fr, ks, fq), acc);
            rhs[i] = acc; }
    }
    __syncthreads();
    {
        typedef unsigned u2v __attribute__((ext_vector_type(2)));
#define S5_FRAG(byteoff) ({ const u2v q_ = *(const LAS u2v*)(lds + (byteoff)); const v4u t_ = {q_.x, q_.y, 0u, 0u}; __builtin_bit_cast(bf16x8, t_); })
#define S5_PACK(v) ({ const v4u t_ = {pkbf((v)[0], (v)[1]), pkbf((v)[2], (v)[3]), 0u, 0u}; __builtin_bit_cast(bf16x8, t_); })
        bf16x8 tdf[4], abf[6];
#pragma unroll
        for (int i = 0; i < 4; ++i) tdf[i] = S5_FRAG(CA_TD + i * 1024 + fr * 64 + fq * 8);
        abf[0] = S5_FRAG(CA_AB + (16 + fr) * PBY + (0 + 4 * fq) * 2);
        abf[1] = S5_FRAG(CA_AB + (32 + fr) * PBY + (0 + 4 * fq) * 2);  abf[2] = S5_FRAG(CA_AB + (32 + fr) * PBY + (16 + 4 * fq) * 2);
        abf[3] = S5_FRAG(CA_AB + (48 + fr) * PBY + (0 + 4 * fq) * 2);  abf[4] = S5_FRAG(CA_AB + (48 + fr) * PBY + (16 + 4 * fq) * 2);  abf[5] = S5_FRAG(CA_AB + (48 + fr) * PBY + (32 + 4 * fq) * 2);
        const f32x4 z4 = {0.f, 0.f, 0.f, 0.f};
        const f32x4 x0 = MFMA16(tdf[0], S5_PACK(rhs[0]), z4);                 const bf16x8 xb0 = S5_PACK(x0);
        f32x4 a1 = MFMA16(abf[0], xb0, rhs[1]);
        const f32x4 x1 = MFMA16(tdf[1], S5_PACK(a1), z4);                     const bf16x8 xb1 = S5_PACK(x1);
        f32x4 a2 = MFMA16(abf[1], xb0, rhs[2]); a2 = MFMA16(abf[2], xb1, a2);
        const f32x4 x2 = MFMA16(tdf[2], S5_PACK(a2), z4);                     const bf16x8 xb2 = S5_PACK(x2);
        f32x4 a3 = MFMA16(abf[3], xb0, rhs[3]); a3 = MFMA16(abf[4], xb1, a3); a3 = MFMA16(abf[5], xb2, a3);
        const f32x4 x3 = MFMA16(tdf[3], S5_PACK(a3), z4);
        LAS unsigned char* xrow = lds + CA_XT + (16 * w + fr) * PBY + 8 * fq;
        { u2v p; p.x = pkbf(x0[0], x0[1]); p.y = pkbf(x0[2], x0[3]); *(LAS u2v*)(xrow) = p; }
        { u2v p; p.x = pkbf(x1[0], x1[1]); p.y = pkbf(x1[2], x1[3]); *(LAS u2v*)(xrow + 32) = p; }
        { u2v p; p.x = pkbf(x2[0], x2[1]); p.y = pkbf(x2[2], x2[3]); *(LAS u2v*)(xrow + 64) = p; }
        { u2v p; p.x = pkbf(x3[0], x3[1]); p.y = pkbf(x3[2], x3[3]); *(LAS u2v*)(xrow + 96) = p; }
#undef S5_FRAG
#undef S5_PACK
    }
    __syncthreads();
    if (nchain >= 0) { const size_t no = (size_t)((nchain >> 4) * PT + 64 * nchunk + tt) * D + (nchain & 15) * 64 + 8 * cg;
        pf[0] = *(const v4u*)(Rb + no); pf[1] = *(const v4u*)(Kb + no); pf[2] = *(const v4u*)(Vb + no); pf[3] = *(const v4u*)(Db + no); pf[4] = *(const v4u*)(Ab + no); }
    {
        const int mi = w >> 1, ti0 = 2 * (w & 1); const int obase = mi == 0 ? CA_AB : (mi == 1 ? CA_AK : (mi == 2 ? CA_AH : CA_KH));
        const int a1 = mi < 2 ? CA_RB : (mi == 2 ? CA_BT : CA_XT), a1o = mi == 3 ? 64 : 0, b1 = mi == 3 ? CA_BT : CA_XT, b1o = mi == 1 ? 64 : 0;
        const int a2 = mi == 1 ? CA_RK : CA_VT, b2 = mi == 1 ? CA_VT : CA_KT; const bool two = (mi & 1) != 0;
        bf16x8 af[2][2], bfr[4][2];
#pragma unroll
        for (int a = 0; a < 2; ++a)
#pragma unroll
            for (int ks = 0; ks < 2; ++ks) af[a][ks] = ldsfrag(lds, a1, a1o + 16 * (ti0 + a) + fr, ks, fq);
#pragma unroll
        for (int tj = 0; tj < 4; ++tj)
#pragma unroll
            for (int ks = 0; ks < 2; ++ks) bfr[tj][ks] = ldsfrag(lds, b1, b1o + 16 * tj + fr, ks, fq);
        f32x4 acc[2][4];
#pragma unroll
        for (int a = 0; a < 2; ++a)
#pragma unroll
            for (int tj = 0; tj < 4; ++tj) { acc[a][tj] = (f32x4){0.f, 0.f, 0.f, 0.f};
#pragma unroll
                for (int ks = 0; ks < 2; ++ks) acc[a][tj] = MFMA16(bfr[tj][ks], af[a][ks], acc[a][tj]); }
        if (two) {
#pragma unroll
            for (int a = 0; a < 2; ++a)
#pragma unroll
                for (int ks = 0; ks < 2; ++ks) af[a][ks] = ldsfrag(lds, a2, 16 * (ti0 + a) + fr, ks, fq);
#pragma unroll
            for (int tj = 0; tj < 4; ++tj)
#pragma unroll
                for (int ks = 0; ks < 2; ++ks) bfr[tj][ks] = ldsfrag(lds, b2, 16 * tj + fr, ks, fq);
#pragma unroll
            for (int a = 0; a < 2; ++a)
#pragma unroll
                for (int tj = 0; tj < 4; ++tj)
#pragma unroll
                    for (int ks = 0; ks < 2; ++ks) acc[a][tj] = MFMA16(bfr[tj][ks], af[a][ks], acc[a][tj]);
        }
#pragma unroll
        for (int a = 0; a < 2; ++a) { const int row = 16 * (ti0 + a) + fr; const float glr = GLf[row];
#pragma unroll
            for (int tj = 0; tj < 4; ++tj) { const int col = 16 * tj + 4 * fq; f32x4 val = acc[a][tj];
                typedef unsigned u2v_ __attribute__((ext_vector_type(2)));
                if (mi == 0) { const u2v_ rr = *(const LAS u2v_*)(lds + CA_RH + (row * 72 + col) * 2); val += (f32x4){bflo(rr.x), bfhi(rr.x), bflo(rr.y), bfhi(rr.y)}; }
                else if (mi == 2) {
#pragma unroll
                    for (int r = 0; r < 4; ++r) val[r] = glr * (val[r] + (row == col + r ? 1.f : 0.f)); }
                else if (mi == 3) val = val * *(const LAS f32x4*)(GLf + col);
                u2v_ pw; pw.x = pkbf(val[0], val[1]); pw.y = pkbf(val[2], val[3]);
                *(LAS u2v_*)(lds + obase + (row * 72 + col) * 2) = pw; } }
    }
    __syncthreads();
    *(v4u*)((dummy ? dummy : Rb) + goff) = *(const LAS v4u*)(lds + CA_AB + tt * PBY + 16 * cg);
    *(v4u*)((dummy ? dummy : Ab) + goff) = *(const LAS v4u*)(lds + CA_AK + tt * PBY + 16 * cg);
    *(v4u*)((dummy ? dummy : Kb) + goff) = *(const LAS v4u*)(lds + CA_AH + tt * PBY + 16 * cg);
    *(v4u*)((dummy ? dummy : Db) + goff) = *(const LAS v4u*)(lds + CA_KH + tt * PBY + 16 * cg);
    __syncthreads();
}
constexpr int CB_S = 0, CB_P2 = 9216, CB_P3 = 18432, CB_Y0 = 27648, CB_Z0 = 36864, CB_YS = 46080  ;
__device__ __forceinline__ void rwkv_state_chain(const Frame& F, int chain, float* ST, const bf16* Rb, const bf16* Kb, const bf16* Vb, const bf16* Db, const bf16* Ab, bf16* Gb, const float* BON, const float* gn_w, const float* gn_b, bf16* dummy) {
    LAS unsigned char* lds = F.lds;
    const int tid = F.tid, lane = F.lane, w = F.wave, fr = lane & 15, fq = lane >> 4, cg = tid & 7, tt = tid >> 3;
    const int h = chain & 15, rowc0 = (chain >> 4) * PT, ch = h * 64 + 8 * cg;
    for (int i = tid; i < 64 * 36; i += 512) ((LAS unsigned*)(lds + CB_S))[i] = 0u;
    f32x4 Sacc[2];
    Sacc[0] = (f32x4){0.f, 0.f, 0.f, 0.f}; Sacc[1] = Sacc[0];
    v4u q2, q3, qy, qz, qg, qb; float qbon;
    float cgw[8], cgb[8];
#pragma unroll
    for (int j = 0; j < 8; ++j) { cgw[j] = gn_w[ch + j]; cgb[j] = gn_b[ch + j]; }
#define CB_LOAD(cc) do { const size_t o_ = (size_t)(rowc0 + 64 * (cc) + tt) * D + ch; q2 = *(const v4u*)(Rb + o_); q3 = *(const v4u*)(Kb + o_); qy = *(const v4u*)(Ab + o_); qz = *(const v4u*)(Db + o_); \
        qg = *(const v4u*)(Gb + o_); qb = *(const v4u*)(Vb + o_); qbon = BON[(size_t)(rowc0 + 64 * (cc) + tt) * 16 + h]; } while (0)
    CB_LOAD(0);
    for (int c = 0; c < PT / 64; ++c) {
        *(LAS v4u*)(lds + CB_P2 + tt * PBY + 16 * cg) = q2; *(LAS v4u*)(lds + CB_P3 + tt * PBY + 16 * cg) = q3;
        *(LAS v4u*)(lds + CB_Y0 + tt * PBY + 16 * cg) = qy; *(LAS v4u*)(lds + CB_Z0 + tt * PBY + 16 * cg) = qz;
        float gw[8], gb[8]; unpack8(qg, gw); unpack8(qb, gb);
        const float bonc = qbon;
        if (c + 1 < PT / 64) CB_LOAD(c + 1);
        __syncthreads();
        f32x4 yacc[2];
        typedef unsigned u2v_ __attribute__((ext_vector_type(2)));
#pragma unroll
        for (int q = 0; q < 2; ++q) { const int tq = 2 * w + q, ti = tq >> 2, tj = tq & 3, row = 16 * ti + fr, col = 16 * tj + 4 * fq;
            const u2v_ y0 = *(const LAS u2v_*)(lds + CB_Y0 + (row * 72 + col) * 2), z0 = *(const LAS u2v_*)(lds + CB_Z0 + (row * 72 + col) * 2);
            f32x4 ya = {bflo(y0.x), bfhi(y0.x), bflo(y0.y), bfhi(y0.y)}, sa = {bflo(z0.x), bfhi(z0.x), bflo(z0.y), bfhi(z0.y)};
#pragma unroll
            for (int ks = 0; ks < 2; ++ks) { ya = MFMA16(ldsfrag(lds, CB_S, 16 * tj + fr, ks, fq), ldsfrag(lds, CB_P2, 16 * ti + fr, ks, fq), ya);
                                             sa = MFMA16(ldsfrag(lds, CB_P3, 16 * tj + fr, ks, fq), ldsfrag(lds, CB_S, 16 * ti + fr, ks, fq), sa); }
            yacc[q] = ya; Sacc[q] = sa; }
        __syncthreads();
#pragma unroll
        for (int q = 0; q < 2; ++q) { const int tq = 2 * w + q, ti = tq >> 2, tj = tq & 3, row = 16 * ti + fr, col = 16 * tj + 4 * fq;
            u2v_ pw; pw.x = pkbf(Sacc[q][0], Sacc[q][1]); pw.y = pkbf(Sacc[q][2], Sacc[q][3]);
            *(LAS u2v_*)(lds + CB_S + (row * 72 + col) * 2) = pw;
            *(LAS f32x4*)(lds + CB_YS + (row * 64 + col) * 4) = yacc[q]; }
        __syncthreads();
        { const f32x4 y0 = *(const LAS f32x4*)(lds + CB_YS + (tt * 64 + 8 * cg) * 4), y1 = *(const LAS f32x4*)(lds + CB_YS + (tt * 64 + 8 * cg + 4) * 4);
          float yy[8] = {y0.x, y0.y, y0.z, y0.w, y1.x, y1.y, y1.z, y1.w}; float s1 = 0.f;
#pragma unroll
          for (int j = 0; j < 8; ++j) s1 += yy[j];
          const float mean = red8(s1) * (1.f / 64.f); float s2 = 0.f;
#pragma unroll
          for (int j = 0; j < 8; ++j) { yy[j] -= mean; s2 += yy[j] * yy[j]; }
          const float rstd = __builtin_amdgcn_rsqf(red8(s2) * (1.f / 64.f) + GN_EPS);
          float o[8];
#pragma unroll
          for (int j = 0; j < 8; ++j) o[j] = ((yy[j] * rstd) * cgw[j] + cgb[j] + bonc * gb[j]) * gw[j];
          *(v4u*)((dummy ? dummy : Gb) + (size_t)(rowc0 + 64 * c + tt) * D + ch) = pack8(o); }
    }
#undef CB_LOAD
#pragma unroll
    for (int q = 0; q < 2; ++q) { const int tq = 2 * w + q, ti = tq >> 2, tj = tq & 3; *(f32x4*)(ST + (16 * ti + fr) * 64 + 16 * tj + 4 * fq) = Sacc[q]; }
    __syncthreads();
}

#ifndef MK_N_LAUNCHES
#define MK_N_LAUNCHES 1
#endif
constexpr int N_PHASES = 22;
#ifndef PROBE_PH
#define PROBE_PH (-1)
#define PROBE_N 1
#endif
#ifndef PROBE_VAR
#define PROBE_VAR 0
#endif
#ifndef EN_MASK
#define EN_MASK 0xff
#endif
constexpr bool EN_NORM = EN_MASK & 1, EN_UP = EN_MASK & 2, EN_RES = EN_MASK & 4, EN_RW = EN_MASK & 8, EN_L2 = EN_MASK & 16, EN_SCAN = EN_MASK & 32, EN_IN = EN_MASK & 64, EN_ML = EN_MASK & 128;
struct Args { const float* in[N_IN]; float* out; unsigned char* ws; int ph_lo, ph_hi; };
__global__ void __launch_bounds__(NWAVES * 64, 2) mega_fwd(Args args) {
    extern __shared__ __attribute__((aligned(16))) unsigned char lds_raw[];
    { const int t0 = threadIdx.x;
      for (int u = t0; u < (LDS_BYTES - LDSCTL_OFF) / 4; u += NWAVES * 64) ((LAS unsigned*)((LAS unsigned char*)lds_raw + LDSCTL_OFF))[u] = 0u; }
    __syncthreads();
    { const int t0 = threadIdx.x; if (t0 < N_IN) ((LAS unsigned long long*)((LAS unsigned char*)lds_raw + TAB_OFF))[t0] = (unsigned long long)args.in[t0]; }
    __syncthreads();
    XcdBarrier bar; bar.bar = (unsigned*)((gu32*)(args.ws + WS_CTL) + CW_BAR); bar.x = 0; bar.st = nullptr;
    if (args.ph_hi - args.ph_lo > 1) bar = xcd_barrier_post((unsigned*)((gu32*)(args.ws + WS_CTL) + CW_BAR), (volatile LAS unsigned*)((LAS unsigned char*)lds_raw + MISC_OFF) + 8);
    int ph = args.ph_lo, rep = 0;
    while (ph < args.ph_hi) {
        int tid_ = threadIdx.x; asm volatile("" : "+v"(tid_));
        unsigned char* ws = args.ws; float* out = args.out;
        Frame F;
        F.lds = (LAS unsigned char*)lds_raw;
        F.MISC = (volatile LAS unsigned*)(F.lds + MISC_OFF);
        F.tid = tid_; F.lane = F.tid & 63; F.wave = __builtin_amdgcn_readfirstlane(F.tid >> 6);
        F.G = gridDim.x; { const int bx = blockIdx.x; F.vcu = (F.G % 8 == 0) ? (bx % 8) * (F.G / 8) + bx / 8 : bx; }
        F.ctl = (gu32*)(ws + WS_CTL); F.tab = (volatile LAS unsigned long long*)(F.lds + TAB_OFF);
        bf16* Wb = (bf16*)(ws + WS_W); bf16* XR = (bf16*)(ws + WS_XR); unsigned char* big = ws + WS_BIG;
        bf16* Hb = (bf16*)(big + B_H); bf16* XN = (bf16*)(big + B_XN); float* SLAB = (float*)(big + B_SLAB);
        bf16* ACAT = (bf16*)(big + B_ACAT); bf16* Rb = (bf16*)(big + B_R); bf16* Kb = (bf16*)(big + B_K); bf16* Vb = (bf16*)(big + B_V); bf16* DECb = (bf16*)(big + B_DEC); bf16* AAb = (bf16*)(big + B_AA);
        bf16* QKR = (bf16*)(big + B_QKR); bf16* VVb = (bf16*)(big + B_VV); bf16* HOb = (bf16*)(big + B_HO); bf16* OOb = (bf16*)(big + B_OO); float* IFb = (float*)(big + B_IF);
        bf16* GGb = (bf16*)((unsigned char*)out + OS_GG); bf16* LORA = (bf16*)((unsigned char*)out + OS_LORA);
        const int c_id = (int)blockIdx.x;
        const int nrep = (ph == PROBE_PH && ph != 6 && !(ph == 16 && PROBE_VAR != 0)) ? PROBE_N : 1;
        const int pvar = (rep + 1 < nrep) ? PROBE_VAR : 0;
        if (EN_NORM && (ph == 0 || ph == 3 || ph == 8 || ph == 11 || ph == 14 || ph == 18 || ph == 21)) {
            int kind = 0, layer = 0, ab = 0, nslab = 0; float coef = 0.5f; const float* gain = nullptr;
            if (ph == 0) { kind = 0; layer = 0; ab = 0; gain = inptr(F, I_NFA); nslab = 0; }
            else if (ph == 3) { kind = 1; gain = inptr(F, I_NMIX); nslab = 11; }
            else if (ph == 8) { kind = 0; layer = 0; ab = 1; gain = inptr(F, I_NFB); nslab = 4; coef = 1.f; }
            else if (ph == 11) { kind = 0; layer = 1; ab = 0; gain = inptr(F, I_NFA) + D; nslab = 11; }
            else if (ph == 14) { kind = 2; gain = inptr(F, I_NMIX) + D; nslab = 11; }
            else if (ph == 18) { kind = -1; gain = inptr(F, I_NFB) + D; nslab = 4; coef = 1.f; }
            else { kind = -1; gain = inptr(F, I_NFIN); nslab = 11; }
            if (kind >= 0) convert_weights(F, kind, layer, ab, Wb);
            if (ph == 0) norm_rows<0, true, true>(F, inptr(F, I_XP), inptr(F, I_XS), nslab, coef, SLAB, XR, gain, XN, nullptr, out, pvar);
            else if (ph == 3) mix_rows(F, XR, inptr(F, I_XS), nslab, coef, SLAB, XR, gain, inptr(F, I_MU), (bf16*)(ws + WS_XM), inptr(F, I_RSHIFT), out, pvar);
            else if (ph == 21) norm_rows<2, false, false>(F, XR, XR + (size_t)MP * D, nslab, coef, SLAB, XR, gain, nullptr, nullptr, out, pvar);
            else norm_rows<0, false, false>(F, XR, XR + (size_t)MP * D, nslab, coef, SLAB, XR, gain, XN, nullptr, out, pvar);
        } else if (EN_UP && (ph == 1 || ph == 9 || ph == 12 || ph == 19)) {
            const bf16* Wu = ph == 19 ? (const bf16*)(ws + WS_W2) : Wb;
            pg8::Gemm g{XN, Wu + W_GU / 2, M, 2 * FF, D}; pg8::UnitOrder S; S.init(M / 256, 2 * FF / 256, D, F.G, c_id, 0);
            EpiSwiglu E{Hb, pvar};
            pg8::gemm_phase<EpiSwiglu, pg8::UnitOrder, true, true>(F.lds, g, S, E, F.tid);
        } else if (EN_RES && (ph == 2 || ph == 7 || ph == 10 || ph == 13 || ph == 17 || ph == 20)) {
            const bf16* A = Hb; const bf16* Bt = (ph == 20 ? (const bf16*)(ws + WS_W2) : Wb) + W_D / 2; int K = FF; float coef = 0.5f; const float* basef = nullptr;
            if (ph == 2) basef = inptr(F, I_XP);
            if (ph == 7) { A = GGb; Bt = Wb + W_O / 2; K = D; coef = 1.f; }
            if (ph == 17) { A = HOb; Bt = Wb + W_OUT / 2; K = D; coef = 1.f; }
            pg8::Gemm g{A, Bt, M, D, K}; pg8::UnitOrder S; S.init(MP / 256, D / 256, K, F.G, c_id, K / 256);
            EpiRes E{basef, XR, XR, SLAB, coef};
            pg8::gemm_phase<EpiRes, pg8::UnitOrder, true, true>(F.lds, g, S, E, F.tid);
        } else if (EN_RW && ph == 4) {
            pg8::Gemm g{(const bf16*)(ws + WS_XM), Wb + W_RW / 2, 6 * M, NRW2, D}; pg8::UnitOrder S; S.init(M / 256, NRW2 / 256, D, F.G, c_id, -2);
            EpiRw E{Rb, Kb, Vb, LORA};
            pg8::gemm_phase<EpiRw, pg8::UnitOrder, true, true>(F.lds, g, S, E, F.tid);
        } else if (EN_L2 && ph == 5) {
            pg8::Gemm g{LORA, Wb + W_L2 / 2, M, NL2, KL2}; pg8::UnitOrder S; S.init(M / 256, NL2 / 256, KL2, F.G, c_id, -1);
            EpiL2 E{DECb, AAb, GGb, inptr(F, I_W0), inptr(F, I_A0)};
            pg8::gemm_phase<EpiL2, pg8::UnitOrder, true, true>(F.lds, g, S, E, F.tid);
        } else if (EN_SCAN && ph == 6) {
            bf16* dummy = (bf16*)(ws + WS_YRAW);
            for (int dr = (PROBE_PH == 6 && PROBE_VAR == 5) ? PROBE_N - 1 : 0; dr >= 0; --dr) {
                v4u pf[6]; pf[5] = (v4u){0u, 0u, 0u, 0u};
                { const int it = F.vcu, cg_ = F.tid & 7, tt_ = F.tid >> 3; const size_t o = (size_t)(((it >> 5) >> 4) * PT + 64 * (it & 31) + tt_) * D + ((it >> 5) & 15) * 64 + 8 * cg_;
                  pf[0] = *(const v4u*)(Rb + o); pf[1] = *(const v4u*)(Kb + o); pf[2] = *(const v4u*)(Vb + o); pf[3] = *(const v4u*)(DECb + o); pf[4] = *(const v4u*)(AAb + o); }
                for (int it = F.vcu; it < PB * 16 * (PT / 64); it += F.G) { const int nx = it + F.G < PB * 16 * (PT / 64) ? it + F.G : -1;
                    rwkv_chunk_item(F, it >> 5, it & 31, Rb, Kb, Vb, DECb, AAb, GGb, inptr(F, I_KK), inptr(F, I_KA), inptr(F, I_RK), (float*)(ws + WS_BON), dr ? dummy : nullptr, pf, nx < 0 ? -1 : nx >> 5, nx & 31); }
            }
            xcd_barrier(bar);
            for (int dr = (PROBE_PH == 6 && PROBE_VAR == 6) ? PROBE_N - 1 : 0; dr >= 0; --dr)
                if (F.vcu < 128) rwkv_state_chain(F, F.vcu, out + O_P_S + (size_t)F.vcu * 4096, Rb, Kb, Vb, DECb, AAb, GGb, (const float*)(ws + WS_BON), inptr(F, I_GNW), inptr(F, I_GNB), dr ? dummy : nullptr);
            { const int i0 = F.vcu < 128 ? 2 * F.vcu : 256 + 14 * (F.vcu - 128), i1 = F.vcu < 128 ? i0 + 2 : i0 + 14;
              for (int i = i0; i < i1; ++i) { const int b = i >> 4, h = i & 15;
                  rwkv_chain(F, MP + b * STK, STK, h, inptr(F, I_RS) + (size_t)i * 4096, out + O_S_S + (size_t)i * 4096, Rb, Kb, Vb, DECb, AAb, GGb, inptr(F, I_KK), inptr(F, I_KA), inptr(F, I_RK), inptr(F, I_GNW), inptr(F, I_GNB), true, 0); } }
        } else if (EN_IN && ph == 15) {
            pg8::Gemm g{XN, Wb + W_IN / 2, M, NIN, D}; pg8::UnitOrder S; S.init(M / 256, NIN / 256, D, F.G, c_id, 0);
            EpiIn E{QKR, VVb, OOb, IFb, inptr(F, I_BIF), pvar};
            pg8::gemm_phase<EpiIn, pg8::UnitOrder, true, true>(F.lds, g, S, E, F.tid);
        } else if (EN_ML && ph == 16) {
            float* NUM = out + O_Y; float* DEN = (float*)(ws + WS_BON); bf16* Qs = (bf16*)(big + 100 * MiB)  ; float* SEG = (float*)(ws + WS_YRAW);
            for (int i = F.vcu; i < PB * 8 * ML_NSEG * ((PROBE_PH == 16 && PROBE_VAR == 1) ? PROBE_N : 1); i += F.G) { const int chain = i & 63, seg = (i >> 6) & 3;
                mlstm_prompt_chain(F, chain >> 3, chain & 7, seg, QKR, VVb, OOb, IFb, HOb, inptr(F, I_CW), inptr(F, I_CB), inptr(F, I_MNW), NUM, DEN, Qs, SEG, 0); }
            xcd_barrier(bar);
            for (int i = F.vcu; i < 256 * ((PROBE_PH == 16 && PROBE_VAR == 2) ? PROBE_N : 1) - 64; i += F.G) { const int chain = i & 63, seg = 1 + ((i >> 6) & 3); if (seg > 3) continue;
                mlstm_fix_seg(F, chain >> 3, chain & 7, seg, QKR, OOb, IFb, HOb, inptr(F, I_MNW), NUM, DEN, Qs, SEG, out); }
            if (F.G == 256) {
                if (F.vcu >= 192) { for (int j = 0; j < 9; ++j) { const int i = (F.vcu - 192) * 9 + j;
                    mlstm_sample_item(F, i >> 3, i & 7, QKR, VVb, OOb, IFb, HOb, inptr(F, I_CW), inptr(F, I_CB), inptr(F, I_MNW), inptr(F, I_MC), inptr(F, I_MN), inptr(F, I_MM), inptr(F, I_MCONV), out); } }
                else { for (int i = 576 + F.vcu; i < SB * 8; i += 192)
                    mlstm_sample_item(F, i >> 3, i & 7, QKR, VVb, OOb, IFb, HOb, inptr(F, I_CW), inptr(F, I_CB), inptr(F, I_MNW), inptr(F, I_MC), inptr(F, I_MN), inptr(F, I_MM), inptr(F, I_MCONV), out); }
            } else {
                for (int i = F.vcu; i < SB * 8; i += F.G)
                    mlstm_sample_item(F, i >> 3, i & 7, QKR, VVb, OOb, IFb, HOb, inptr(F, I_CW), inptr(F, I_CB), inptr(F, I_MNW), inptr(F, I_MC), inptr(F, I_MN), inptr(F, I_MM), inptr(F, I_MCONV), out);
            }
            if (rep + 1 == nrep) convert_weights(F, 0, 1, 1, (bf16*)(ws + WS_W2));
        }
        if (++rep < nrep) continue;
        rep = 0;
        if (ph + 1 < args.ph_hi) xcd_barrier(bar);
        ++ph;
    }
}

extern "C" void kernel_launch(void* const* d_in, const int* in_sizes, int n_in, void* d_out, int out_size, void* d_ws, size_t ws_size, hipStream_t stream) {
    static int grid = 0;
    if (grid == 0) {
        if (n_in != N_IN || out_size != (int)O_END || ws_size < WS_END3) { fprintf(stderr, "kernel_launch: unexpected shapes (n_in %d, out %d, ws %zu); nothing launched\n", n_in, out_size, ws_size); grid = -1; return; }
        int dev = 0, cus = 0, per_cu = 0;
        if (hipGetDevice(&dev) != hipSuccess || hipDeviceGetAttribute(&cus, hipDeviceAttributeMultiprocessorCount, dev) != hipSuccess) { grid = -1; return; }
        if (hipFuncSetAttribute((const void*)mega_fwd, hipFuncAttributeMaxDynamicSharedMemorySize, LDS_BYTES) != hipSuccess) { fprintf(stderr, "kernel_launch: hipFuncSetAttribute failed\n"); grid = -1; return; }
        if (hipOccupancyMaxActiveBlocksPerMultiprocessor(&per_cu, (const void*)mega_fwd, NWAVES * 64, LDS_BYTES) != hipSuccess || per_cu < 1) { fprintf(stderr, "kernel_launch: occupancy query says %d\n", per_cu); per_cu = 1; }
        (void)hipGetLastError();
        grid = cus;
    }
    if (grid < 0) return;
    (void)hipMemsetAsync((char*)d_ws + WS_CTL, 0, CTL_ZERO_BYTES, stream);
    Args a{};
    for (int i = 0; i < N_IN; ++i) a.in[i] = (const float*)d_in[i];
    a.out = (float*)d_out; a.ws = (unsigned char*)d_ws;
#if MK_N_LAUNCHES == 1
    a.ph_lo = 0; a.ph_hi = N_PHASES;
    { void* kargs[] = {(void*)&a};
      const hipError_t e = hipLaunchCooperativeKernel((const void*)mega_fwd, dim3(grid), dim3(NWAVES * 64), kargs, LDS_BYTES, stream);
      if (e != hipSuccess) fprintf(stderr, "kernel_launch: cooperative launch failed: %s (grid %d)\n", hipGetErrorString(e), grid); }
#else
    for (int p = 0; p < N_PHASES; ++p) { a.ph_lo = p; a.ph_hi = p + 1; hipLaunchKernelGGL(mega_fwd, dim3(grid), dim3(NWAVES * 64), LDS_BYTES, stream, a); }
#endif
}
```

```cpp
#include <hip/hip_runtime.h>
#include <cstdio>
#include <cstdint>
namespace pg8 {
#define PG8_LAS __attribute__((address_space(3)))
typedef unsigned short bf16_t;
typedef short bf16x8 __attribute__((ext_vector_type(8)));
typedef float f32x4 __attribute__((ext_vector_type(4)));
typedef unsigned u32x4 __attribute__((ext_vector_type(4)));
constexpr int BM = 256, BK = 64, HALF = 128, HTB = HALF * BK * 2  , STAGE_BYTES = 8 * HTB, NXCD = 8, WGM = 8;

__host__ __device__ __forceinline__ int lds_byte(int r, int c) { const int st = (r >> 4) * 2 + (c >> 5), rr = r & 15, cc = c & 31, ob = rr * 64 + cc * 2; return st * 1024 + (ob ^ (((ob >> 9) & 1) << 5)); }
__host__ __device__ __forceinline__ void stage_rc(int b, int& R, int& C) { const int st = b / 1024, sb = b % 1024, swz = sb ^ (((sb >> 9) & 1) << 5); R = (st >> 1) * 16 + swz / 64; C = (st & 1) * 32 + (swz % 64) / 2; }
__host__ __device__ __forceinline__ int perm32(int rho) { const int n = rho >> 4, i = rho & 15; return 8 * (i >> 2) + 4 * n + (i & 3); }

struct Unit { int pm, pn, k0, nt, slab; };
struct Gemm { const bf16_t* A; const bf16_t* Bt; int M, N, K; };

struct UnitOrder {
    int nM, nN, nwg, G, c, ntf, tailS;
    __device__ __forceinline__ void init(int nM_, int nN_, int K, int G_, int c_, int tailS_) { nM = nM_; nN = nN_; nwg = nM * nN; G = G_; c = c_; ntf = K / BK; tailS = tailS_; }
    __device__ __forceinline__ bool next(int i, Unit& u) const {
        long L = (long)i * G + c;
        if (L < nwg) {
            int wgid = (int)L; { const int q = nwg / NXCD, r = nwg % NXCD, xcd = wgid % NXCD, off = wgid / NXCD; wgid = (xcd < r ? xcd * (q + 1) : r * (q + 1) + (xcd - r) * q) + off; }
            const int nig = WGM * nN, gid = wgid / nig, fm = gid * WGM, gsz = (nM - fm) < WGM ? (nM - fm) : WGM;
            u.pm = fm + ((wgid % nig) % gsz); u.pn = (wgid % nig) / gsz; u.k0 = 0; u.nt = ntf; u.slab = -1;
            if (tailS == -2) u.pm += nM * (u.pn < 12 ? (u.pn >> 2) : u.pn - 9);
            if (tailS == -1) { u.nt = 4; u.k0 = u.pn >= 8 ? 128 : 0; }
            return true;
        }
        L -= nwg; if (tailS <= 0 || L >= 8 * tailS) return false;
        int tile, sl; if (tailS == 4) { tile = (int)L >> 2; sl = (int)L & 3; } else { tile = (int)L / 11; sl = (int)L - 11 * tile; }
        u.pm = 64 + (tile >> 2); u.pn = tile & 3; u.k0 = sl * 256; u.nt = 4; u.slab = sl; return true;
    }
    __device__ __forceinline__ void a_ready(const Unit&) const {}
    __device__ __forceinline__ void done(const Unit&) const {}
};
template <class Epi, class Sched, bool ALIGN_EPI = false, bool SP2 = false>
__device__ __forceinline__ void gemm_phase(PG8_LAS unsigned char* lds, const Gemm g, const Sched& S, const Epi& E, const int tid) {
    const int wid = __builtin_amdgcn_readfirstlane(tid >> 6), lane = tid & 63, wr = wid >> 2, wc = wid & 3, fr = lane & 15, fq = lane >> 4;
    const int K = g.K;
    unsigned voffA[2], voffB[2];
#pragma unroll
    for (int i = 0; i < 2; ++i) { int R, C; stage_rc(tid * 16 + i * 8192, R, C); const int Rb = Epi::PERM ? ((R & ~31) + perm32(R & 31)) : R;
        voffA[i] = (unsigned)(R * K + C) * 2u; voffB[i] = (unsigned)(Rb * K + C) * 2u; }
    const size_t kstep = (size_t)(BK * 2);
    const size_t hstep = (size_t)HALF * K * 2;
    const size_t tstep = 2 * hstep;
    const unsigned ldsw = (unsigned)wid * 1024u;
    const int aoff = lds_byte(wr * 64 + fr, fq * 8), boff = lds_byte(wc * 32 + fr, fq * 8);
#define PG8_SA(b, h) (((b) * 2 + (h)) * HTB)
#define PG8_SB(b, h) ((4 + (b) * 2 + (h)) * HTB)
#define PG8_STAGE(bufoff, gbase, voff) do { _Pragma("unroll") for (int _i = 0; _i < 2; ++_i) \
        __builtin_amdgcn_global_load_lds((const unsigned*)((const char*)(gbase) + (voff)[_i]), (PG8_LAS unsigned*)(lds + (bufoff) + ldsw + _i * 8192), 16, 0, 0); } while (0)
#define PG8_LDA(dst, b, h) do { _Pragma("unroll") for (int m = 0; m < 4; ++m) _Pragma("unroll") for (int k = 0; k < 2; ++k) dst[m][k] = *(const PG8_LAS bf16x8*)(lds + PG8_SA(b, h) + aoff + m * 2048 + k * 1024); } while (0)
#define PG8_LDB(dst, b, h) do { _Pragma("unroll") for (int n = 0; n < 2; ++n) _Pragma("unroll") for (int k = 0; k < 2; ++k) dst[n][k] = *(const PG8_LAS bf16x8*)(lds + PG8_SB(b, h) + boff + n * 2048 + k * 1024); } while (0)
#define PG8_MMA(ai, bj, At, Bt) do { __builtin_amdgcn_s_setprio(1); _Pragma("unroll") for (int m = 0; m < 4; ++m) _Pragma("unroll") for (int n = 0; n < 2; ++n) _Pragma("unroll") for (int k = 0; k < 2; ++k) \
        acc[ai][bj][m][n] = __builtin_amdgcn_mfma_f32_16x16x32_bf16(Bt[n][k], At[m][k], acc[ai][bj][m][n], 0, 0, 0); __builtin_amdgcn_s_setprio(0); } while (0)
#define PG8_WAIT_V(n) asm volatile("s_waitcnt vmcnt(" #n ")" ::: "memory")
#define PG8_WAIT_L(n) asm volatile("s_waitcnt lgkmcnt(" #n ")" ::: "memory")
#define PG8_BAR __builtin_amdgcn_s_barrier()
#define PG8_SCHED __builtin_amdgcn_sched_barrier(0)
    Unit cur, nxt; int ui = 0;
    if (!S.next(0, cur)) return;
    f32x4 acc[2][2][4][2];
#pragma unroll
    for (int a = 0; a < 2; ++a)
#pragma unroll
        for (int b = 0; b < 2; ++b)
#pragma unroll
            for (int m = 0; m < 4; ++m)
#pragma unroll
                for (int n = 0; n < 2; ++n) acc[a][b][m][n] = (f32x4){0.f, 0.f, 0.f, 0.f};
    bf16x8 At[4][2], B0[2][2], B1[2][2];
    const char* cA = (const char*)g.A + (size_t)cur.pm * tstep + (size_t)cur.k0 * 2; const char* cB = (const char*)g.Bt + (size_t)cur.pn * tstep + (size_t)cur.k0 * 2;
    S.a_ready(cur);
    if constexpr (SP2) {
        PG8_STAGE(PG8_SB(0, 0), cB, voffB); PG8_STAGE(PG8_SB(0, 1), cB + hstep, voffB); PG8_STAGE(PG8_SA(0, 0), cA, voffA); PG8_STAGE(PG8_SA(0, 1), cA + hstep, voffA);
        if (wr == 1) PG8_BAR;
        PG8_WAIT_V(2); PG8_BAR;
        PG8_STAGE(PG8_SB(1, 0), cB + kstep, voffB); PG8_STAGE(PG8_SA(1, 0), cA + kstep, voffA); PG8_STAGE(PG8_SB(1, 1), cB + hstep + kstep, voffB);
        PG8_WAIT_V(6); PG8_BAR;
    } else {
        PG8_STAGE(PG8_SB(0, 0), cB, voffB); PG8_STAGE(PG8_SA(0, 0), cA, voffA); PG8_STAGE(PG8_SB(0, 1), cB + hstep, voffB); PG8_STAGE(PG8_SA(0, 1), cA + hstep, voffA);
        if (wr == 1) PG8_BAR;
        PG8_WAIT_V(4); PG8_BAR;
        PG8_STAGE(PG8_SB(1, 0), cB + kstep, voffB); PG8_STAGE(PG8_SA(1, 0), cA + kstep, voffA); PG8_STAGE(PG8_SB(1, 1), cB + hstep + kstep, voffB);
        PG8_WAIT_V(6); PG8_BAR;
    }
    for (;;) {
        const bool has_next = S.next(ui + 1, nxt);
        const char* nA = has_next ? (const char*)g.A + (size_t)nxt.pm * tstep + (size_t)nxt.k0 * 2 : cA; const char* nB = has_next ? (const char*)g.Bt + (size_t)nxt.pn * tstep + (size_t)nxt.k0 * 2 : cB;
        const int nt = cur.nt;
        for (int t = 0; t < nt; t += 2) {
            const bool last = (t == nt - 2);
            const char* a1 = cA + (size_t)(t + 1) * kstep;
            const char* a2 = last ? nA : cA + (size_t)(t + 2) * kstep; const char* b2 = last ? nB : cB + (size_t)(t + 2) * kstep;
            const char* a3 = a2 + kstep; const char* b3 = b2 + kstep;
            if (last && has_next) S.a_ready(nxt);
            if constexpr (SP2) {
            PG8_LDB(B0, 0, 0); PG8_LDB(B1, 0, 1); PG8_SCHED; PG8_LDA(At, 0, 0); PG8_STAGE(PG8_SA(1, 1), a1 + hstep, voffA);
            PG8_WAIT_V(8); PG8_WAIT_L(0); PG8_BAR; PG8_MMA(0, 0, At, B0); PG8_MMA(0, 1, At, B1); PG8_BAR; PG8_SCHED;
            PG8_LDA(At, 0, 1); PG8_STAGE(PG8_SB(0, 0), b2, voffB); PG8_STAGE(PG8_SB(0, 1), b2 + hstep, voffB); PG8_STAGE(PG8_SA(0, 0), a2, voffA);
            PG8_WAIT_V(8); PG8_WAIT_L(0); PG8_BAR; PG8_MMA(1, 0, At, B0); PG8_MMA(1, 1, At, B1); PG8_BAR; PG8_SCHED;
            PG8_LDB(B0, 1, 0); PG8_LDB(B1, 1, 1); PG8_SCHED; PG8_LDA(At, 1, 0); PG8_STAGE(PG8_SA(0, 1), a2 + hstep, voffA);
            PG8_WAIT_V(8); PG8_WAIT_L(0); PG8_BAR; PG8_MMA(0, 0, At, B0); PG8_MMA(0, 1, At, B1); PG8_BAR; PG8_SCHED;
            PG8_LDA(At, 1, 1); PG8_STAGE(PG8_SB(1, 0), b3, voffB); PG8_STAGE(PG8_SB(1, 1), b3 + hstep, voffB); PG8_STAGE(PG8_SA(1, 0), a3, voffA);
            PG8_WAIT_V(8); PG8_WAIT_L(0); PG8_BAR; PG8_MMA(1, 0, At, B0); PG8_MMA(1, 1, At, B1); PG8_BAR; PG8_SCHED;
            } else {
            PG8_LDB(B0, 0, 0); PG8_SCHED; PG8_LDA(At, 0, 0); PG8_STAGE(PG8_SA(1, 1), a1 + hstep, voffA);
            PG8_WAIT_L(8); PG8_BAR; PG8_WAIT_L(0); PG8_MMA(0, 0, At, B0); PG8_BAR; PG8_SCHED;
            PG8_LDB(B1, 0, 1); PG8_STAGE(PG8_SB(0, 0), b2, voffB);
            PG8_BAR; PG8_WAIT_L(0); PG8_MMA(0, 1, At, B1); PG8_BAR;
            PG8_LDA(At, 0, 1); PG8_STAGE(PG8_SA(0, 0), a2, voffA);
            PG8_BAR; PG8_WAIT_L(0); PG8_MMA(1, 0, At, B0); PG8_BAR; PG8_SCHED;
            PG8_STAGE(PG8_SB(0, 1), b2 + hstep, voffB);
            PG8_WAIT_V(6); PG8_BAR; PG8_MMA(1, 1, At, B1); PG8_BAR;
            PG8_LDB(B0, 1, 0); PG8_SCHED; PG8_LDA(At, 1, 0); PG8_STAGE(PG8_SA(0, 1), a2 + hstep, voffA);
            PG8_WAIT_L(8); PG8_BAR; PG8_WAIT_L(0); PG8_MMA(0, 0, At, B0); PG8_BAR; PG8_SCHED;
            PG8_LDB(B1, 1, 1); PG8_STAGE(PG8_SB(1, 0), b3, voffB);
            PG8_BAR; PG8_WAIT_L(0); PG8_MMA(0, 1, At, B1); PG8_BAR;
            PG8_LDA(At, 1, 1); PG8_STAGE(PG8_SA(1, 0), a3, voffA);
            PG8_BAR; PG8_WAIT_L(0); PG8_MMA(1, 0, At, B0); PG8_BAR; PG8_SCHED;
            PG8_STAGE(PG8_SB(1, 1), b3 + hstep, voffB);
            PG8_WAIT_V(6); PG8_BAR; PG8_MMA(1, 1, At, B1); PG8_BAR;
            }
        }
        if constexpr (ALIGN_EPI) { if (wr == 0) PG8_BAR; }
        if constexpr (!Epi::AFTER_DRAIN) { E(acc, cur, wr, wc, fr, fq); S.done(cur); }
        if (!has_next) break;
#pragma unroll
        for (int a = 0; a < 2; ++a)
#pragma unroll
            for (int b = 0; b < 2; ++b)
#pragma unroll
                for (int m = 0; m < 4; ++m)
#pragma unroll
                    for (int n = 0; n < 2; ++n) acc[a][b][m][n] = (f32x4){0.f, 0.f, 0.f, 0.f};
        cur = nxt; cA = nA; cB = nB; ++ui;
        if constexpr (ALIGN_EPI) { if (wr == 1) PG8_BAR; }
    }
    PG8_WAIT_V(0);
    if constexpr (!ALIGN_EPI) { if (wr == 0) PG8_BAR; }
    PG8_BAR;
    if constexpr (Epi::AFTER_DRAIN) { E.fused(acc, cur, wr, wc, fr, fq, lds, wid, lane); S.done(cur); }
#undef PG8_SA
#undef PG8_SB
#undef PG8_STAGE
#undef PG8_LDA
#undef PG8_LDB
#undef PG8_MMA
#undef PG8_WAIT_V
#undef PG8_WAIT_L
#undef PG8_BAR
#undef PG8_SCHED
}
}

#define GAS __attribute__((address_space(1)))
#define LAS __attribute__((address_space(3)))
typedef unsigned short bf16;
typedef unsigned v4u __attribute__((ext_vector_type(4)));
typedef float f32x4 __attribute__((ext_vector_type(4)));
typedef short bf16x8 __attribute__((ext_vector_type(8)));
typedef GAS unsigned gu32;
typedef GAS unsigned long long gu64;
#define RLX_AGENT __ATOMIC_RELAXED, __HIP_MEMORY_SCOPE_AGENT
#define LDS_WAIT() asm volatile("s_waitcnt lgkmcnt(0)" ::: "memory")
#define VM_WAIT() asm volatile("s_waitcnt vmcnt(0)" ::: "memory")
__device__ __forceinline__ unsigned long long rt() { return __builtin_amdgcn_s_memrealtime(); }
__device__ __forceinline__ unsigned f2bf(float f) { unsigned u = __builtin_bit_cast(unsigned, f); return (u + 0x7fffu + ((u >> 16) & 1u)) >> 16; }
__device__ __forceinline__ unsigned pk2(float lo, float hi) { return f2bf(lo) | (f2bf(hi) << 16); }

#define XB_TMO      128
#define XB_XCNT(j)  (256  + 64 * (j))
#define XB_XSUB(j)  (1280 + 64 * (j))
#define XB_XGEN(j)  (2304 + 64 * (j))
#define XB_TOP      3328
#define XB_TOPGEN   3392
#define XCD_BAR_WORDS 3456
#define XB_SPIN_CAP (1u << 18)

__device__ __forceinline__ unsigned xb_ld(unsigned* p)              { return __hip_atomic_load(p, __ATOMIC_RELAXED, __HIP_MEMORY_SCOPE_AGENT); }
__device__ __forceinline__ unsigned xb_add(unsigned* p, unsigned v) { return __hip_atomic_fetch_add(p, v, __ATOMIC_RELAXED, __HIP_MEMORY_SCOPE_AGENT); }
__device__ __forceinline__ unsigned xb_xcc_id() { return (unsigned)__builtin_amdgcn_s_getreg((3 << 11) | 20) & 0xFu; }
#define XB_SPIN(cond, bar) do { unsigned _sp = 0; while (cond) { __builtin_amdgcn_s_sleep(1); \
    if ((++_sp & 255u) == 0u) { if (xb_ld(&(bar)[XB_TMO])) break; if (_sp > XB_SPIN_CAP) { atomicAdd(&(bar)[XB_TMO], 1u); break; } } } } while (0)

struct XcdBarrier {
    unsigned* bar; unsigned x;
    volatile LAS unsigned* st;
};

__device__ __forceinline__ XcdBarrier xcd_barrier_post(unsigned* bar, volatile LAS unsigned* st) {
    XcdBarrier b; b.bar = bar; b.x = xb_xcc_id(); b.st = st;
    if (threadIdx.x == 0) (void)xb_add(&bar[XB_XCNT(b.x)], 1u);
    return b;
}
__device__ __forceinline__ void xcd_barrier_complete(unsigned* bar, unsigned x, unsigned& nloc, unsigned& nx) {
    const unsigned G = gridDim.x * gridDim.y * gridDim.z;
    unsigned sum, cnt, mine, sp = 0u;
    for (;;) {
        sum = 0u; cnt = 0u; mine = 0u;
#pragma unroll
        for (unsigned j = 0; j < 16; ++j) { const unsigned c = xb_ld(&bar[XB_XCNT(j)]); sum += c; cnt += (c > 0u) ? 1u : 0u; mine = (j == x) ? c : mine; }
        if (sum == G) break;
        __builtin_amdgcn_s_sleep(1);
        if ((++sp & 255u) == 0u) { if (xb_ld(&bar[XB_TMO])) break; if (sp > XB_SPIN_CAP) { atomicAdd(&bar[XB_TMO], 1u); break; } }
    }
    nloc = mine > 0u ? mine : 1u; nx = cnt > 0u ? cnt : 1u;
}

__device__ __forceinline__ void xcd_barrier(const XcdBarrier& b) {
    asm volatile("s_waitcnt vmcnt(0)" ::: "memory");
    __syncthreads();
    if (threadIdx.x == 0) {
        unsigned* bar = b.bar;
        __builtin_amdgcn_s_waitcnt(0);
        unsigned nloc = b.st[0], nx = b.st[1];
        if (nloc == 0u) { xcd_barrier_complete(bar, b.x, nloc, nx); b.st[0] = nloc; b.st[1] = nx; }
        const unsigned old = xb_add(&bar[XB_XSUB(b.x)], 1u);
        const unsigned gen = old / nloc;
        if (old + 1u == (gen + 1u) * nloc) {
            __builtin_amdgcn_fence(__ATOMIC_RELEASE, "agent");
            asm volatile("s_waitcnt vmcnt(0)" ::: "memory");
            const unsigned og = xb_add(&bar[XB_TOP], 1u);
            const unsigned tg = og / nx;
            if (og + 1u == (tg + 1u) * nx) xb_add(&bar[XB_TOPGEN], 1u);
            else XB_SPIN(xb_ld(&bar[XB_TOPGEN]) == tg, bar);
            __builtin_amdgcn_fence(__ATOMIC_ACQUIRE, "agent");
            xb_add(&bar[XB_XGEN(b.x)], 1u);
            asm volatile("s_waitcnt vmcnt(0)" ::: "memory");
        } else {
            XB_SPIN(xb_ld(&bar[XB_XGEN(b.x)]) == gen, bar);
            __builtin_amdgcn_fence(__ATOMIC_ACQUIRE, "agent");
            asm volatile("s_waitcnt vmcnt(0)" ::: "memory");
        }
    }
    __syncthreads();
}

constexpr int NWAVES = 8;
constexpr int D = 1024, FF = 2816;
constexpr int PB = 8, PT = 2048, SB = 128, STK = 4;
constexpr int MP = PB * PT, MS = SB * STK, M = MP + MS;
constexpr int NRW = 3584, KRW = 2048  , NRW2 = 3840  , NL2 = 3072, KL2 = 384, NIN = 3328;
constexpr float NORM_EPS = 1e-6f, GN_EPS = 64e-5f;
typedef pg8::bf16_t bf16;

constexpr size_t MiB = 1u << 20;
constexpr size_t WS_CTL = 0, CTL_ZERO_BYTES = 64 * 1024;
constexpr size_t WS_W = 1 * MiB;
constexpr size_t WS_XR = 20 * MiB;
constexpr size_t WS_BIG = 86 * MiB;
constexpr size_t WS_END = 256 * MiB;
constexpr size_t WS_YRAW = 256 * MiB, WS_BON = 288 * MiB, WS_W2 = 289 * MiB  , WS_END2 = 308 * MiB, WS_XM = 308 * MiB  , WS_END3 = 506 * MiB;
constexpr size_t W_GU = 0, W_D = (size_t)2 * FF * D * 2;
constexpr size_t W_RW = 0, W_L2 = (size_t)NRW * KRW * 2, W_O = W_L2 + (size_t)NL2 * KL2 * 2;
constexpr size_t W_IN = 0, W_OUT = (size_t)NIN * D * 2;
static_assert(W_D + (size_t)D * FF * 2 <= 19 * MiB && W_O + (size_t)D * D * 2 <= 19 * MiB && W_OUT + (size_t)D * D * 2 <= 19 * MiB, "weights region");
constexpr size_t B_H = 0, B_XN = 91 * MiB, B_SLAB = 124 * MiB;
constexpr size_t B_ACAT = 0, B_R = 66 * MiB, B_K = 99 * MiB, B_V = 132 * MiB, B_DEC = 0, B_AA = 33 * MiB;
constexpr size_t B_QKR = 0, B_VV = 33 * MiB, B_HO = 66 * MiB, B_OO = 124 * MiB, B_IF = 157 * MiB;
static_assert((size_t)M * FF * 2 <= 91 * MiB && (size_t)M * D * 2 == 33 * MiB && B_IF + (size_t)M * 16 * 4 <= 170 * MiB && B_SLAB + (size_t)11 * MS * D * 4 <= 170 * MiB, "BIG map");
constexpr size_t OS_GG = 0, OS_LORA = 33 * MiB;
static_assert(OS_LORA + (size_t)M * KL2 * 2 <= (size_t)MP * D * 4, "d_out scratch");
constexpr size_t O_Y = 0, O_P_S = 17301504, O_P_SHIFT = 17825792, O_P_C = 17833984, O_P_N = 18358272, O_P_M = 18362368, O_P_CONV = 18362432,
                 O_S_S = 18387008, O_S_SHIFT = 26775616, O_S_C = 26906688, O_S_N = 35295296, O_S_M = 35360832, O_S_CONV = 35361856, O_END = 35755072;
constexpr int CW_BAR = 1024;

constexpr int RING_BYTES = 131072, LDSCTL_OFF = RING_BYTES, MISC_OFF = LDSCTL_OFF + 320, TAB_OFF = LDSCTL_OFF + 1024, LDS_BYTES = 147456;

enum { I_XP = 0, I_XS, I_RS, I_RSHIFT, I_MC, I_MN, I_MM, I_MCONV, I_NFA, I_FAWG, I_FAWU, I_FAWD, I_NMIX, I_NFB, I_FBWG, I_FBWU, I_FBWD,
       I_MU, I_WR, I_WK, I_WV, I_WO, I_W0, I_W1, I_W2, I_A0, I_A1, I_A2, I_G1, I_G2, I_KK, I_KA, I_RK, I_GNW, I_GNB,
       I_WIN, I_BIF, I_CW, I_CB, I_MNW, I_WOUT, I_NFIN, N_IN };

typedef __bf16 bf16x2_t __attribute__((ext_vector_type(2)));
typedef float f32x2_t __attribute__((ext_vector_type(2)));
__device__ __forceinline__ unsigned pkbf(float lo, float hi) { f32x2_t v = {lo, hi}; bf16x2_t b = __builtin_convertvector(v, bf16x2_t); return __builtin_bit_cast(unsigned, b); }
__device__ __forceinline__ float bflo(unsigned u) { return __builtin_bit_cast(float, u << 16); }
__device__ __forceinline__ float bfhi(unsigned u) { return __builtin_bit_cast(float, u & 0xffff0000u); }
__device__ __forceinline__ float bf1(unsigned short u) { return __builtin_bit_cast(float, (unsigned)u << 16); }
__device__ __forceinline__ unsigned short f2bf1(float f) { return (unsigned short)(pkbf(f, 0.f) & 0xffffu); }
__device__ __forceinline__ void unpack8(v4u w, float (&o)[8]) { o[0] = bflo(w.x); o[1] = bfhi(w.x); o[2] = bflo(w.y); o[3] = bfhi(w.y); o[4] = bflo(w.z); o[5] = bfhi(w.z); o[6] = bflo(w.w); o[7] = bfhi(w.w); }
__device__ __forceinline__ v4u pack8(const float (&o)[8]) { v4u w; w.x = pkbf(o[0], o[1]); w.y = pkbf(o[2], o[3]); w.z = pkbf(o[4], o[5]); w.w = pkbf(o[6], o[7]); return w; }
__device__ __forceinline__ float sigmoidf_(float x) { return __builtin_amdgcn_rcpf(1.f + __expf(-x)); }
__device__ __forceinline__ float siluf_(float x) { return x * __builtin_amdgcn_rcpf(1.f + __expf(-x)); }
__device__ __forceinline__ float tanhf_(float x) { return 1.f - 2.f * __builtin_amdgcn_rcpf(__expf(2.f * x) + 1.f); }
__device__ __forceinline__ float logsigmoidf_(float x) { return fminf(x, 0.f) - __logf(1.f + __expf(-fabsf(x))); }
template <int CTRL> __device__ __forceinline__ float dppf(float x) { return __builtin_bit_cast(float, __builtin_amdgcn_update_dpp(0, __builtin_bit_cast(int, x), CTRL, 0xF, 0xF, true)); }
__device__ __forceinline__ float red4(float x) { x += dppf<0xB1>(x); x += dppf<0x4E>(x); return x; }
__device__ __forceinline__ float red8(float x) { x = red4(x); x += dppf<0x141>(x); return x; }
__device__ __forceinline__ float red16(float x) { x = red8(x); x += dppf<0x140>(x); return x; }
__device__ __forceinline__ float wave_sum(float v) {
#pragma unroll
    for (int o = 1; o < 64; o <<= 1) v += __shfl_xor(v, o);
    return v;
}

struct Frame {
    LAS unsigned char* lds;
    volatile LAS unsigned* MISC;
    gu32* ctl;
    volatile LAS unsigned long long* tab;
    int tid, lane, wave, vcu, G;
};
__device__ __forceinline__ const float* inptr(const Frame& F, int i) { const unsigned long long v = F.tab[i];
    const unsigned lo = __builtin_amdgcn_readfirstlane((unsigned)v), hi = __builtin_amdgcn_readfirstlane((unsigned)(v >> 32)); return (const float*)(const GAS float*)(((unsigned long long)hi << 32) | lo); }

using pg8::Unit; using pg8::BM; using pg8::HALF;
__device__ __forceinline__ void st8bf(bf16* p, f32x4 v0, f32x4 v1) { v4u w; w.x = pkbf(v0[0], v0[1]); w.y = pkbf(v0[2], v0[3]); w.z = pkbf(v1[0], v1[1]); w.w = pkbf(v1[2], v1[3]); *(v4u*)p = w; }

struct EpiSwiglu {
    static constexpr bool PERM = true, AFTER_DRAIN = false;
    bf16* H; int pvar;
    __device__ __forceinline__ void operator()(const f32x4 (&acc)[2][2][4][2], const Unit& u, int wr, int wc, int fr, int fq) const {
        if (pvar == 3) return;
        const int row0 = u.pm * BM + wr * 64 + fr, col0 = u.pn * 128 + wc * 32 + 8 * fq;
#pragma unroll
        for (int ai = 0; ai < 2; ++ai)
#pragma unroll
            for (int m = 0; m < 4; ++m) {
                f32x4 o[2];
#pragma unroll
                for (int n = 0; n < 2; ++n)
#pragma unroll
                    for (int i = 0; i < 4; ++i) { const float g = acc[ai][0][m][n][i], up = acc[ai][1][m][n][i]; o[n][i] = siluf_(g) * up; }
                st8bf(H + (size_t)(row0 + ai * HALF + m * 16) * FF + col0, o[0], o[1]);
            }
    }
};
__device__ __forceinline__ void ld8bf(const bf16* p, f32x4& a, f32x4& b) { const v4u w = *(const v4u*)p; a = (f32x4){bflo(w.x), bfhi(w.x), bflo(w.y), bfhi(w.y)}; b = (f32x4){bflo(w.z), bfhi(w.z), bflo(w.w), bfhi(w.w)}; }
struct EpiRes {
    static constexpr bool PERM = true, AFTER_DRAIN = false;
    const float* basef; const bf16* baseb; bf16* out; float* slab; float coef;
    __device__ __forceinline__ void operator()(const f32x4 (&acc)[2][2][4][2], const Unit& u, int wr, int wc, int fr, int fq) const {
        const int row0 = u.pm * BM + wr * 64 + fr, col0 = u.pn * BM + wc * 32 + 8 * fq;
        if (u.slab < 0) {
            if (basef) {
#pragma unroll
                for (int ai = 0; ai < 2; ++ai)
#pragma unroll
                    for (int m = 0; m < 4; ++m) { const size_t ro = (size_t)(row0 + ai * HALF + m * 16) * D + col0;
#pragma unroll
                        for (int bj = 0; bj < 2; ++bj) { const f32x4 b0 = *(const f32x4*)(basef + ro + bj * HALF), b1 = *(const f32x4*)(basef + ro + bj * HALF + 4);
                            st8bf(out + ro + bj * HALF, b0 + acc[ai][bj][m][0] * coef, b1 + acc[ai][bj][m][1] * coef); } }
            } else {
#pragma unroll
                for (int ai = 0; ai < 2; ++ai)
#pragma unroll
                    for (int m = 0; m < 4; ++m) { const size_t ro = (size_t)(row0 + ai * HALF + m * 16) * D + col0;
#pragma unroll
                        for (int bj = 0; bj < 2; ++bj) { f32x4 b0, b1; ld8bf(baseb + ro + bj * HALF, b0, b1);
                            st8bf(out + ro + bj * HALF, b0 + acc[ai][bj][m][0] * coef, b1 + acc[ai][bj][m][1] * coef); } }
            }
        } else {
            float* sl = slab + (size_t)u.slab * MS * D;
#pragma unroll
            for (int ai = 0; ai < 2; ++ai)
#pragma unroll
                for (int m = 0; m < 4; ++m) { const size_t ro = (size_t)(row0 + ai * HALF + m * 16 - MP) * D + col0;
#pragma unroll
                    for (int bj = 0; bj < 2; ++bj) { *(f32x4*)(sl + ro + bj * HALF) = acc[ai][bj][m][0]; *(f32x4*)(sl + ro + bj * HALF + 4) = acc[ai][bj][m][1]; } }
        }
    }
};
struct EpiRw {
    static constexpr bool PERM = true, AFTER_DRAIN = false;
    bf16 *R, *K, *V, *L;
    __device__ __forceinline__ void operator()(const f32x4 (&acc)[2][2][4][2], const Unit& u, int wr, int wc, int fr, int fq) const {
        const int mix = u.pn < 12 ? (u.pn >> 2) : u.pn - 9, row0 = (u.pm - (M / 256) * mix) * BM + wr * 64 + fr;
        if (u.pn < 12) {
            bf16 *p0 = R, *p1 = K, *p2 = V; asm volatile("" : "+s"(p0), "+s"(p1), "+s"(p2));
            bf16* dst = u.pn < 4 ? p0 : (u.pn < 8 ? p1 : p2); const int col0 = (u.pn & 3) * BM + wc * 32 + 8 * fq;
#pragma unroll
            for (int ai = 0; ai < 2; ++ai)
#pragma unroll
                for (int m = 0; m < 4; ++m) { bf16* rp = dst + (size_t)(row0 + ai * HALF + m * 16) * D + col0;
#pragma unroll
                    for (int bj = 0; bj < 2; ++bj) st8bf(rp + bj * HALF, acc[ai][bj][m][0], acc[ai][bj][m][1]); }
        } else {
            const int t = u.pn - 12;
#pragma unroll
            for (int bj = 0; bj < 2; ++bj) {
                const int cl = bj * HALF + wc * 32 + 8 * fq;
                if (t < 2 && cl >= 64) continue;
                const int lc = t == 0 ? cl : (t == 1 ? 64 + cl : 128 + cl);
                const int act = t == 0 ? 1 : (t == 1 ? 0 : (cl < 160 ? 2 : 3));
#pragma unroll
                for (int ai = 0; ai < 2; ++ai)
#pragma unroll
                    for (int m = 0; m < 4; ++m) {
                        f32x4 o[2];
#pragma unroll
                        for (int n = 0; n < 2; ++n)
#pragma unroll
                            for (int i = 0; i < 4; ++i) { const float x = acc[ai][bj][m][n][i]; o[n][i] = act == 1 ? tanhf_(x) : (act == 0 ? x : (act == 2 ? sigmoidf_(x) : 0.f)); }
                        st8bf(L + (size_t)(row0 + ai * HALF + m * 16) * KL2 + lc, o[0], o[1]);
                    }
            }
        }
    }
};
struct EpiL2 {
    static constexpr bool PERM = true, AFTER_DRAIN = false;
    bf16 *DEC, *AA, *GG; const float *w0, *a0;
    __device__ __forceinline__ void operator()(const f32x4 (&acc)[2][2][4][2], const Unit& u, int wr, int wc, int fr, int fq) const {
        const int row0 = u.pm * BM + wr * 64 + fr, kind = u.pn >> 2, col0 = (u.pn & 3) * BM + wc * 32 + 8 * fq;
        bf16 *p0 = DEC, *p1 = AA, *p2 = GG; const float *q0 = w0, *q1 = a0; asm volatile("" : "+s"(p0), "+s"(p1), "+s"(p2), "+s"(q0), "+s"(q1));
        bf16* dst = kind == 0 ? p0 : (kind == 1 ? p1 : p2); const float* bias = kind == 0 ? q0 : q1;
#pragma unroll
        for (int bj = 0; bj < 2; ++bj) {
            f32x4 bv[2];
#pragma unroll
            for (int n = 0; n < 2; ++n) bv[n] = kind < 2 ? *(const f32x4*)(bias + col0 + bj * HALF + 4 * n) : (f32x4){0.f, 0.f, 0.f, 0.f};
#pragma unroll
            for (int ai = 0; ai < 2; ++ai)
#pragma unroll
                for (int m = 0; m < 4; ++m) {
                    f32x4 o[2];
#pragma unroll
                    for (int n = 0; n < 2; ++n)
#pragma unroll
                        for (int i = 0; i < 4; ++i) { const float z = acc[ai][bj][m][n][i] + bv[n][i];
                            o[n][i] = kind == 0 ? (1.f - __expf(-0.60653065971f * sigmoidf_(z))) : (kind == 1 ? sigmoidf_(z) : z); }
                    st8bf(dst + (size_t)(row0 + ai * HALF + m * 16) * D + col0 + bj * HALF, o[0], o[1]);
                }
        }
    }
};
struct EpiIn {
    static constexpr bool PERM = true, AFTER_DRAIN = false;
    bf16 *QKR, *VV, *OO; float* IF; const float* bif; int pvar;
    __device__ __forceinline__ void operator()(const f32x4 (&acc)[2][2][4][2], const Unit& u, int wr, int wc, int fr, int fq) const {
        if (pvar == 3) return;
        const int row0 = u.pm * BM + wr * 64 + fr;
        if (u.pn < 12) {
            bf16 *p0 = QKR, *p1 = VV, *p2 = OO; asm volatile("" : "+s"(p0), "+s"(p1), "+s"(p2));
            const int kind = u.pn >> 2; bf16* dst = kind == 0 ? p0 : (kind == 1 ? p1 : p2); const int col0 = (u.pn & 3) * BM + wc * 32 + 8 * fq;
#pragma unroll
            for (int ai = 0; ai < 2; ++ai)
#pragma unroll
                for (int m = 0; m < 4; ++m) { bf16* rp = dst + (size_t)(row0 + ai * HALF + m * 16) * D + col0;
#pragma unroll
                    for (int bj = 0; bj < 2; ++bj) { f32x4 a = acc[ai][bj][m][0], b = acc[ai][bj][m][1];
                        if (kind == 2) {
#pragma unroll
                            for (int i = 0; i < 4; ++i) { a[i] = sigmoidf_(a[i]); b[i] = sigmoidf_(b[i]); } }
                        st8bf(rp + bj * HALF, a, b); } }
        } else if (u.pn == 12 && wc == 0 && fq < 2) {
            const f32x4 b0 = *(const f32x4*)(bif + 8 * fq), b1 = *(const f32x4*)(bif + 8 * fq + 4);
#pragma unroll
            for (int ai = 0; ai < 2; ++ai)
#pragma unroll
                for (int m = 0; m < 4; ++m) { f32x4 a = acc[ai][0][m][0] + b0, b = acc[ai][0][m][1] + b1;
                    if (fq == 1) {
#pragma unroll
                        for (int i = 0; i < 4; ++i) { a[i] = logsigmoidf_(a[i]); b[i] = logsigmoidf_(b[i]); } }
                    float* rp = IF + (size_t)(row0 + ai * HALF + m * 16) * 16 + 8 * fq; *(f32x4*)rp = a; *(f32x4*)(rp + 4) = b; }
        }
    }
};

struct CJ { const float* W; const float* sc; bf16* WT; int K, N, Npad, ldk, koff, rmode, roff, smode; };
__device__ __forceinline__ int cj_items(const CJ& j) { return (j.K / 32) * (j.Npad / 32); }
__device__ __forceinline__ void conv_load(const CJ& J, int item, int lane, f32x4 (&w)[4], float (&sc)[4]) {
    const int nblk = J.Npad / 32, kb = item / nblk, nb = item % nblk, k0 = 32 * kb, n0 = 32 * nb;
    const int r = lane >> 3, c4 = 4 * (lane & 7); const bool nok = n0 + c4 < J.N;
#pragma unroll
    for (int i = 0; i < 4; ++i) { const int kk = k0 + r + 8 * i;
        w[i] = nok ? *(const f32x4*)(J.W + (size_t)kk * J.N + n0 + c4) : (f32x4){0.f, 0.f, 0.f, 0.f};
        float s = 1.f; if (J.smode) { s = J.sc[kk]; if (J.smode == 2) s = 1.f - s; }
        sc[i] = s; }
}
__device__ __forceinline__ void conv_store(const CJ& J, LAS float* scr, int item, int lane, const f32x4 (&w)[4], const float (&sc)[4]) {
    const int nblk = J.Npad / 32, kb = item / nblk, nb = item % nblk, k0 = 32 * kb, n0 = 32 * nb;
    const int r = lane >> 3, c4 = 4 * (lane & 7);
#pragma unroll
    for (int i = 0; i < 4; ++i) { const f32x4 f = w[i] * sc[i]; LAS float* d = scr + (r + 8 * i) * 33 + c4; d[0] = f[0]; d[1] = f[1]; d[2] = f[2]; d[3] = f[3]; }
    LDS_WAIT(); asm volatile("" ::: "memory");
    const int rowbase = J.rmode == 0 ? J.roff + n0 : (n0 >> 7) * 256 + (n0 & 127) + J.roff;
    const int c = lane & 3;
#pragma unroll
    for (int j = 0; j < 2; ++j) { const int n = (lane >> 2) + 16 * j; const LAS float* s = scr + (8 * c) * 33 + n;
        v4u o; o.x = pkbf(s[0 * 33], s[1 * 33]); o.y = pkbf(s[2 * 33], s[3 * 33]); o.z = pkbf(s[4 * 33], s[5 * 33]); o.w = pkbf(s[6 * 33], s[7 * 33]);
        *(GAS v4u*)(J.WT + (size_t)(rowbase + n) * J.ldk + J.koff + k0 + 8 * c) = o; }
    LDS_WAIT(); asm volatile("" ::: "memory");
}
__device__ __forceinline__ CJ get_job(const Frame& F, int kind, int j, int layer, int ab, bf16* Wb) {
    CJ J; J.sc = nullptr; J.smode = 0; J.koff = 0; J.rmode = 0; J.roff = 0;
    if (kind == 0) {
        const float* wg = inptr(F, ab ? I_FBWG : I_FAWG) + (size_t)layer * D * FF; const float* wu = inptr(F, ab ? I_FBWU : I_FAWU) + (size_t)layer * D * FF; const float* wd = inptr(F, ab ? I_FBWD : I_FAWD) + (size_t)layer * D * FF;
        if (j < 2) { J.W = j == 0 ? wg : wu; J.K = D; J.N = FF; J.Npad = FF; J.WT = Wb + W_GU / 2; J.ldk = D; J.rmode = 1; J.roff = j == 0 ? 0 : 128; }
        else { J.W = wd; J.K = FF; J.N = D; J.Npad = D; J.WT = Wb + W_D / 2; J.ldk = FF; }
    } else if (kind == 1) {
        if (j < 6) {
            const int s = j;
            J.W = inptr(F, s == 0 ? I_WR : (s == 1 ? I_WK : (s == 2 ? I_WV : (s == 3 ? I_W1 : (s == 4 ? I_A1 : I_G1)))));
            J.N = s < 3 ? 1024 : (s < 5 ? 64 : 160); J.Npad = s < 3 ? 1024 : 256;
            J.roff = s < 3 ? 1024 * s : 3072 + 256 * (s - 3);
            J.K = D; J.ldk = D; J.WT = Wb + W_RW / 2;
        } else { J.W = inptr(F, I_WO); J.K = D; J.N = D; J.Npad = D; J.WT = Wb + W_O / 2; J.ldk = D; }
    } else {
        if (j == 0) { J.W = inptr(F, I_WIN); J.K = D; J.N = 3088; J.Npad = NIN; J.WT = Wb + W_IN / 2; J.ldk = D; }
        else { J.W = inptr(F, I_WOUT); J.K = D; J.N = D; J.Npad = D; J.WT = Wb + W_OUT / 2; J.ldk = D; }
    }
    return J;
}
__device__ __forceinline__ void convert_weights(const Frame& F, int kind, int layer, int ab, bf16* Wb, const int cu0 = 0) {
    LAS float* scr = (LAS float*)(F.lds + F.wave * 16384);
    const int gw = (F.vcu - cu0) * NWAVES + F.wave, NGW = (F.G - cu0) * NWAVES;
    const int njobs = kind == 0 ? 3 : (kind == 1 ? 7 : 2);
    int total = 0;
    for (int j = 0; j < njobs; ++j) { const CJ J = get_job(F, kind, j, layer, ab, Wb); total += cj_items(J); }
    if (gw < total) {
        int r = gw, j = 0; CJ J = get_job(F, kind, 0, layer, ab, Wb);
        while (r >= cj_items(J)) { r -= cj_items(J); ++j; J = get_job(F, kind, j, layer, ab, Wb); }
        f32x4 w[4]; float sc[4];
        conv_load(J, r, F.lane, w, sc);
        for (int g = gw; g < total;) {
            const int gn = g + NGW; int rn = 0; CJ Jn = J; f32x4 wn[4]; float sn[4];
#pragma unroll
            for (int i = 0; i < 4; ++i) { wn[i] = (f32x4){0.f, 0.f, 0.f, 0.f}; sn[i] = 0.f; }
            if (gn < total) {
                rn = gn; int jn = 0; Jn = get_job(F, kind, 0, layer, ab, Wb);
                while (rn >= cj_items(Jn)) { rn -= cj_items(Jn); ++jn; Jn = get_job(F, kind, jn, layer, ab, Wb); }
                conv_load(Jn, rn, F.lane, wn, sn);
            }
            conv_store(J, scr, r, F.lane, w, sc);
            J = Jn; r = rn; g = gn;
#pragma unroll
            for (int i = 0; i < 4; ++i) { w[i] = wn[i]; sc[i] = sn[i]; }
        }
    }
    if (kind == 1) {
        bf16* WT = Wb + W_L2 / 2; const float* w2 = inptr(F, I_W2); const float* a2 = inptr(F, I_A2); const float* g2 = inptr(F, I_G2);
        for (int idx = (F.vcu * NWAVES + F.wave) * 64 + F.lane; idx < 48 * NL2; idx += F.G * NWAVES * 64) {
            const int c = idx / NL2, n = idx % NL2, type = n >> 10, jj = n & 1023;
            const float* src = nullptr;
            if (type == 0 && c < 8) src = w2 + (size_t)(8 * c) * D + jj;
            else if (type == 1 && c >= 8 && c < 16) src = a2 + (size_t)(8 * (c - 8)) * D + jj;
            else if (type == 2 && c >= 16 && c < 36) src = g2 + (size_t)(8 * (c - 16)) * D + jj;
            float v[8];
#pragma unroll
            for (int e = 0; e < 8; ++e) v[e] = src ? src[(size_t)e * D] : 0.f;
            *(GAS v4u*)(WT + (size_t)n * KL2 + 8 * c) = pack8(v);
        }
    }
}

template <int MODE>
__device__ __forceinline__ void norm_finish(const int m, f32x4 (&v)[4], const f32x4 (&gv)[4], bf16* dst, const float* shift_in, float* out, const int lane) {
    const bool samp = m >= MP;
    float ss = 0.f;
#pragma unroll
    for (int j = 0; j < 4; ++j) ss += (v[j].x * v[j].x + v[j].y * v[j].y) + (v[j].z * v[j].z + v[j].w * v[j].w);
    const float r = 1.0f / sqrtf(wave_sum(ss) * (1.f / D) + NORM_EPS);
#pragma unroll
    for (int j = 0; j < 4; ++j) v[j] = v[j] * r * gv[j];
    if (MODE == 2) {
#pragma unroll
        for (int j = 0; j < 4; ++j) *(f32x4*)(out + O_Y + (size_t)m * D + 512 * (j >> 1) + 8 * lane + 4 * (j & 1)) = v[j];
    } else if (MODE == 0) {
#pragma unroll
        for (int j = 0; j < 2; ++j) st8bf(dst + (size_t)m * D + 512 * j + 8 * lane, v[2 * j], v[2 * j + 1]);
    } else {
        int t, b; bool first, last;
        if (!samp) { t = m & (PT - 1); b = m >> 11; first = t == 0; last = t == PT - 1; } else { const int mm = m - MP; t = mm & 3; b = mm >> 2; first = t == 0; last = t == 3; }
#pragma unroll
        for (int j = 0; j < 2; ++j) { const int eo = 512 * j + 8 * lane;
            st8bf(dst + (size_t)m * (2 * D) + eo, v[2 * j], v[2 * j + 1]);
            if (!last) st8bf(dst + (size_t)(m + 1) * (2 * D) + D + eo, v[2 * j], v[2 * j + 1]);
            else { float* so = out + (samp ? O_S_SHIFT : O_P_SHIFT) + (size_t)b * D + eo; *(f32x4*)so = v[2 * j]; *(f32x4*)(so + 4) = v[2 * j + 1]; }
            if (first) { f32x4 s0 = {0.f, 0.f, 0.f, 0.f}, s1 = s0;
                if (samp) { s0 = *(const f32x4*)(shift_in + (size_t)b * D + eo); s1 = *(const f32x4*)(shift_in + (size_t)b * D + eo + 4); }
                st8bf(dst + (size_t)m * (2 * D) + D + eo, s0, s1); }
        }
    }
}
template <bool F32>
__device__ __forceinline__ void row_load(const void* src, const size_t row, const int lane, f32x4 (&v)[4]) {
    if (F32) { const float* p = (const float*)src + row * D;
#pragma unroll
        for (int j = 0; j < 4; ++j) v[j] = *(const f32x4*)(p + 512 * (j >> 1) + 8 * lane + 4 * (j & 1));
    } else { const bf16* p = (const bf16*)src + row * D;
#pragma unroll
        for (int j = 0; j < 2; ++j) ld8bf(p + 512 * j + 8 * lane, v[2 * j], v[2 * j + 1]); }
}
template <int NS>
__device__ __forceinline__ void samp_row_fold(const float* slab, const int ms, const float coef, const int lane, f32x4 (&v)[4]) {
#pragma unroll
    for (int h = 0; h < 2; ++h) {
        f32x4 t[NS > 0 ? NS : 1][2];
#pragma unroll
        for (int s = 0; s < NS; ++s)
#pragma unroll
            for (int jj = 0; jj < 2; ++jj) t[s][jj] = *(const f32x4*)(slab + ((size_t)s * MS + ms) * D + 512 * h + 8 * lane + 4 * jj);
#pragma unroll
        for (int jj = 0; jj < 2; ++jj)
#pragma unroll
            for (int s = 0; s < NS; ++s) v[2 * h + jj] += t[s][jj] * coef;
    }
}
template <int MODE, bool PF32, bool SF32>
__device__ __forceinline__ void norm_rows(const Frame& F, const void* base_p, const void* base_s, int nslab, float coef, const float* slab, bf16* xr,
                                          const float* gain, bf16* dst, const float* shift_in, float* out, const int pvar = 0) {
    const int gw = F.vcu * NWAVES + F.wave, NGW = F.G * NWAVES, lane = F.lane;
    f32x4 gv[4];
#pragma unroll
    for (int j = 0; j < 4; ++j) gv[j] = *(const f32x4*)(gain + 512 * (j >> 1) + 8 * lane + 4 * (j & 1));
    for (int s = F.wave * F.G + F.vcu; s < MS; s += NWAVES * F.G) {
        const int m = MP + s; f32x4 v[4];
        row_load<SF32>(base_s, (size_t)s, lane, v);
        if (nslab == 11) samp_row_fold<11>(slab, s, coef, lane, v); else if (nslab == 4) samp_row_fold<4>(slab, s, coef, lane, v);
        if (nslab > 0 && MODE != 2 && pvar == 0) {
#pragma unroll
            for (int j = 0; j < 2; ++j) st8bf(xr + (size_t)m * D + 512 * j + 8 * lane, v[2 * j], v[2 * j + 1]); }
        norm_finish<MODE>(m, v, gv, dst, shift_in, out, lane);
    }
    int m = gw; f32x4 v[4];
    if (m < MP) row_load<PF32>(base_p, (size_t)m, lane, v);
    while (m < MP) {
        const int mn = m + NGW; f32x4 vn[4];
#pragma unroll
        for (int j = 0; j < 4; ++j) vn[j] = (f32x4){0.f, 0.f, 0.f, 0.f};
        if (mn < MP) row_load<PF32>(base_p, (size_t)mn, lane, vn);
        norm_finish<MODE>(m, v, gv, dst, shift_in, out, lane);
#pragma unroll
        for (int j = 0; j < 4; ++j) v[j] = vn[j];
        m = mn;
    }
}

__device__ __forceinline__ void mix_rows(const Frame& F, const bf16* xr_p, const float* xs_in, int nslab, float coef, const float* slab, bf16* xr, const float* gain, const float* mu, bf16* XM,
                                         const float* shift_in, float* out, const int pvar) {
    const int gw = F.vcu * NWAVES + F.wave, NGW = F.G * NWAVES, lane = F.lane;
    f32x4 gv[4];
#pragma unroll
    for (int j = 0; j < 4; ++j) gv[j] = *(const f32x4*)(gain + 512 * (j >> 1) + 8 * lane + 4 * (j & 1));
    __syncthreads();
    for (int i = F.tid; i < 6 * D / 8; i += NWAVES * 64) { const int s = i >> 7, e8 = i & 127; const float* mup = mu + ((0x541320 >> (4 * s)) & 15) * D + 8 * e8;
        const f32x4 ma = *(const f32x4*)mup, mb = *(const f32x4*)(mup + 4); v4u w; w.x = pkbf(ma[0], ma[1]); w.y = pkbf(ma[2], ma[3]); w.z = pkbf(mb[0], mb[1]); w.w = pkbf(mb[2], mb[3]);
        *(LAS v4u*)(F.lds + (s * D + 8 * e8) * 2) = w; }
    __syncthreads();
#define MIX_NORM(v) do { float ss_ = 0.f; \
        _Pragma("unroll") for (int j = 0; j < 4; ++j) ss_ += (v[j].x * v[j].x + v[j].y * v[j].y) + (v[j].z * v[j].z + v[j].w * v[j].w); \
        const float r_ = 1.0f / sqrtf(wave_sum(ss_) * (1.f / D) + NORM_EPS); \
        _Pragma("unroll") for (int j = 0; j < 4; ++j) v[j] = v[j] * r_ * gv[j]; } while (0)
#define MIX_EMIT(m, xn, pv) do { f32x4 df_[4]; int lo_ = 16 * lane; asm volatile("" : "+v"(lo_));     \
        _Pragma("unroll") for (int j = 0; j < 4; ++j) df_[j] = pv[j] - xn[j]; \
        _Pragma("unroll") for (int s = 0; s < 6; ++s) \
        _Pragma("unroll") for (int j = 0; j < 2; ++j) { const v4u mw = *(const LAS v4u*)(F.lds + (s * D + 512 * j) * 2 + lo_); const f32x4 ma = {bflo(mw.x), bfhi(mw.x), bflo(mw.y), bfhi(mw.y)}, mb = {bflo(mw.z), bfhi(mw.z), bflo(mw.w), bfhi(mw.w)}; \
            st8bf(XM + ((size_t)s * M + (m)) * D + 512 * j + 8 * lane, xn[2 * j] + ma * df_[2 * j], xn[2 * j + 1] + mb * df_[2 * j + 1]); } } while (0)
    for (int sq = F.wave * F.G + F.vcu; sq < SB; sq += NWAVES * F.G) {
        f32x4 pv[4];
#pragma unroll
        for (int j = 0; j < 4; ++j) pv[j] = *(const f32x4*)(shift_in + (size_t)sq * D + 512 * (j >> 1) + 8 * lane + 4 * (j & 1));
        for (int t = 0; t < STK; ++t) { const int srow = STK * sq + t, m = MP + srow; f32x4 v[4];
            row_load<true>(xs_in, (size_t)srow, lane, v);
            if (nslab == 11) samp_row_fold<11>(slab, srow, coef, lane, v); else if (nslab == 4) samp_row_fold<4>(slab, srow, coef, lane, v);
            if (nslab > 0 && pvar == 0) {
#pragma unroll
                for (int j = 0; j < 2; ++j) st8bf(xr + (size_t)m * D + 512 * j + 8 * lane, v[2 * j], v[2 * j + 1]); }
            MIX_NORM(v);
            MIX_EMIT(m, v, pv);
#pragma unroll
            for (int j = 0; j < 4; ++j) pv[j] = v[j];
        }
#pragma unroll
        for (int j = 0; j < 4; ++j) *(f32x4*)(out + O_S_SHIFT + (size_t)sq * D + 512 * (j >> 1) + 8 * lane + 4 * (j & 1)) = pv[j];
    }
    for (int blk = gw; blk < MP / 8; blk += NGW) {
        const int m0 = 8 * blk; f32x4 pv[4], v[4];
        row_load<false>(xr_p, (size_t)m0, lane, v);
        if ((m0 & (PT - 1)) == 0) {
#pragma unroll
            for (int j = 0; j < 4; ++j) pv[j] = (f32x4){0.f, 0.f, 0.f, 0.f};
        } else { row_load<false>(xr_p, (size_t)(m0 - 1), lane, pv); MIX_NORM(pv); }
        for (int i = 0; i < 8; ++i) { const int m = m0 + i; f32x4 vn[4];
#pragma unroll
            for (int j = 0; j < 4; ++j) vn[j] = (f32x4){0.f, 0.f, 0.f, 0.f};
            if (i < 7) row_load<false>(xr_p, (size_t)(m + 1), lane, vn);
            MIX_NORM(v);
            MIX_EMIT(m, v, pv);
            if ((m & (PT - 1)) == PT - 1) {
#pragma unroll
                for (int j = 0; j < 4; ++j) *(f32x4*)(out + O_P_SHIFT + (size_t)(m >> 11) * D + 512 * (j >> 1) + 8 * lane + 4 * (j & 1)) = v[j]; }
#pragma unroll
            for (int j = 0; j < 4; ++j) { pv[j] = v[j]; v[j] = vn[j]; }
        }
    }
#undef MIX_NORM
#undef MIX_EMIT
}

constexpr int RW_KK = 0, RW_DD = 4096, RW_BB = 8192, RW_KP = 12288, RW_RR = 16384, RW_VV = 20480, RW_YY = 24576;
__device__ __forceinline__ void rwkv_chain(const Frame& F, int row0, int T, int h, const float* S0, float* ST,
                                           const bf16* Rb, const bf16* Kb, const bf16* Vb, const bf16* Db, const bf16* Ab, bf16* Gb,
                                           const float* k_k, const float* k_a, const float* r_k, const float* gn_w, const float* gn_b, const bool do_store, const int pvar) {
    LAS float* L = (LAS float*)F.lds;
    const int tid = F.tid, lane = F.lane, w = F.wave;
    const int cg = tid & 7, tt = tid >> 3;
    const int srow = 8 * w + (lane >> 3);
    float S[8];
    if (S0) { const f32x4 a = *(const f32x4*)(S0 + srow * 64 + 8 * cg), b = *(const f32x4*)(S0 + srow * 64 + 8 * cg + 4);
        S[0] = a.x; S[1] = a.y; S[2] = a.z; S[3] = a.w; S[4] = b.x; S[5] = b.y; S[6] = b.z; S[7] = b.w; }
    else {
#pragma unroll
        for (int j = 0; j < 8; ++j) S[j] = 0.f; }
    const int ch = h * 64 + 8 * cg;
    float ckk[8], cka[8], crk[8], cgw[8], cgb[8];
#pragma unroll
    for (int j = 0; j < 8; ++j) { ckk[j] = k_k[ch + j]; cka[j] = k_a[ch + j]; crk[j] = r_k[ch + j]; cgw[j] = gn_w[ch + j]; cgb[j] = gn_b[ch + j]; }
    const int nch = (T + 63) >> 6;
    v4u pr = {0, 0, 0, 0}, pk = pr, pv = pr, pd = pr, pa = pr, pg = pr;
    { const int nt0 = T < 64 ? T : 64;
      if (tt < nt0) { const size_t off = (size_t)(row0 + tt) * D + ch;
          pr = *(const v4u*)(Rb + off); pk = *(const v4u*)(Kb + off); pv = *(const v4u*)(Vb + off); pd = *(const v4u*)(Db + off); pa = *(const v4u*)(Ab + off); pg = *(const v4u*)(Gb + off); } }
    float bon = 0.f, vv[8], gg[8];
    for (int c = 0; c < nch; ++c) {
        const int nt = (T - 64 * c) < 64 ? (T - 64 * c) : 64;
        const bool valid = tt < nt;
        {
            float r8[8], k8[8], d8[8], a8[8];
            unpack8(pr, r8); unpack8(pk, k8); unpack8(pv, vv); unpack8(pd, d8); unpack8(pa, a8); unpack8(pg, gg);
            float kk[8], ss = 0.f;
#pragma unroll
            for (int j = 0; j < 8; ++j) { kk[j] = k8[j] * ckk[j]; ss += kk[j] * kk[j]; }
            ss = red8(ss);
            const float inv = __builtin_amdgcn_rsqf(fmaxf(ss, 1e-24f));
            float kp[8], bsum = 0.f;
#pragma unroll
            for (int j = 0; j < 8; ++j) { kk[j] *= inv; kp[j] = k8[j] * (1.f + (a8[j] - 1.f) * cka[j]); bsum += r8[j] * kp[j] * crk[j]; }
            bon = red8(bsum);
            if (valid) {
                LAS float* p = L + tt * 64 + 8 * cg;
                *(LAS f32x4*)(p + RW_KK) = (f32x4){-kk[0], -kk[1], -kk[2], -kk[3]}; *(LAS f32x4*)(p + RW_KK + 4) = (f32x4){-kk[4], -kk[5], -kk[6], -kk[7]};
                *(LAS f32x4*)(p + RW_DD) = (f32x4){1.f - d8[0], 1.f - d8[1], 1.f - d8[2], 1.f - d8[3]}; *(LAS f32x4*)(p + RW_DD + 4) = (f32x4){1.f - d8[4], 1.f - d8[5], 1.f - d8[6], 1.f - d8[7]};
                *(LAS f32x4*)(p + RW_BB) = (f32x4){kk[0] * a8[0], kk[1] * a8[1], kk[2] * a8[2], kk[3] * a8[3]}; *(LAS f32x4*)(p + RW_BB + 4) = (f32x4){kk[4] * a8[4], kk[5] * a8[5], kk[6] * a8[6], kk[7] * a8[7]};
                *(LAS f32x4*)(p + RW_KP) = (f32x4){kp[0], kp[1], kp[2], kp[3]}; *(LAS f32x4*)(p + RW_KP + 4) = (f32x4){kp[4], kp[5], kp[6], kp[7]};
                *(LAS f32x4*)(p + RW_RR) = (f32x4){r8[0], r8[1], r8[2], r8[3]}; *(LAS f32x4*)(p + RW_RR + 4) = (f32x4){r8[4], r8[5], r8[6], r8[7]};
                *(LAS f32x4*)(p + RW_VV) = (f32x4){vv[0], vv[1], vv[2], vv[3]}; *(LAS f32x4*)(p + RW_VV + 4) = (f32x4){vv[4], vv[5], vv[6], vv[7]};
            }
        }
        __syncthreads();
        if (c + 1 < nch) { const int nt1 = (T - 64 * (c + 1)) < 64 ? (T - 64 * (c + 1)) : 64;
            if (tt < nt1) { const size_t off = (size_t)(row0 + 64 * (c + 1) + tt) * D + ch;
                pr = *(const v4u*)(Rb + off); pk = *(const v4u*)(Kb + off); pv = *(const v4u*)(Vb + off); pd = *(const v4u*)(Db + off); pa = *(const v4u*)(Ab + off); pg = *(const v4u*)(Gb + off); } }
        {
            typedef float f2 __attribute__((ext_vector_type(2)));
            f2 S2[4] = {{S[0], S[1]}, {S[2], S[3]}, {S[4], S[5]}, {S[6], S[7]}};
            const LAS float* p = L + 8 * cg;
            LAS float* yw = L + RW_YY + srow;
            const LAS float* vp = L + RW_VV + srow;
#define RW_LD(N, Dd, B, Q, R, VR, t_) do { const LAS float* p_ = p + (t_) * 64; \
                N[0] = *(const LAS f32x4*)(p_ + RW_KK); N[1] = *(const LAS f32x4*)(p_ + RW_KK + 4); Dd[0] = *(const LAS f32x4*)(p_ + RW_DD); Dd[1] = *(const LAS f32x4*)(p_ + RW_DD + 4); \
                B[0] = *(const LAS f32x4*)(p_ + RW_BB); B[1] = *(const LAS f32x4*)(p_ + RW_BB + 4); Q[0] = *(const LAS f32x4*)(p_ + RW_KP); Q[1] = *(const LAS f32x4*)(p_ + RW_KP + 4); \
                R[0] = *(const LAS f32x4*)(p_ + RW_RR); R[1] = *(const LAS f32x4*)(p_ + RW_RR + 4); VR = vp[(t_) * 64]; } while (0)
#define RW_STEP(N, Dd, B, Q, R, VR, t_) do { \
                f2 a_ = S2[0] * (f2){N[0].x, N[0].y}; a_ = S2[1] * (f2){N[0].z, N[0].w} + a_; a_ = S2[2] * (f2){N[1].x, N[1].y} + a_; a_ = S2[3] * (f2){N[1].z, N[1].w} + a_; \
                const float sa_ = red8(a_.x + a_.y); const f2 sv_ = {sa_, sa_}, vv_ = {VR, VR}; \
                S2[0] = S2[0] * (f2){Dd[0].x, Dd[0].y} + (sv_ * (f2){B[0].x, B[0].y} + vv_ * (f2){Q[0].x, Q[0].y}); \
                S2[1] = S2[1] * (f2){Dd[0].z, Dd[0].w} + (sv_ * (f2){B[0].z, B[0].w} + vv_ * (f2){Q[0].z, Q[0].w}); \
                S2[2] = S2[2] * (f2){Dd[1].x, Dd[1].y} + (sv_ * (f2){B[1].x, B[1].y} + vv_ * (f2){Q[1].x, Q[1].y}); \
                S2[3] = S2[3] * (f2){Dd[1].z, Dd[1].w} + (sv_ * (f2){B[1].z, B[1].w} + vv_ * (f2){Q[1].z, Q[1].w}); \
                f2 y_ = S2[0] * (f2){R[0].x, R[0].y}; y_ = S2[1] * (f2){R[0].z, R[0].w} + y_; y_ = S2[2] * (f2){R[1].x, R[1].y} + y_; y_ = S2[3] * (f2){R[1].z, R[1].w} + y_; \
                yw[(t_) * 64] = red8(y_.x + y_.y); } while (0)
            f32x4 nA[2], dA[2], bA[2], qA[2], rA[2]; float vA;
            for (int t = 0; t < nt; ++t) { RW_LD(nA, dA, bA, qA, rA, vA, t); RW_STEP(nA, dA, bA, qA, rA, vA, t); }
#undef RW_LD
#undef RW_STEP
            S[0] = S2[0].x; S[1] = S2[0].y; S[2] = S2[1].x; S[3] = S2[1].y; S[4] = S2[2].x; S[5] = S2[2].y; S[6] = S2[3].x; S[7] = S2[3].y;
        }
        __syncthreads();
        if (pvar != 4) {
            f32x4 y0 = {0.f, 0.f, 0.f, 0.f}, y1 = y0;
            if (valid) { y0 = *(const LAS f32x4*)(L + RW_YY + tt * 64 + 8 * cg); y1 = *(const LAS f32x4*)(L + RW_YY + tt * 64 + 8 * cg + 4); }
            float yy[8] = {y0.x, y0.y, y0.z, y0.w, y1.x, y1.y, y1.z, y1.w};
            float s1 = 0.f;
#pragma unroll
            for (int j = 0; j < 8; ++j) s1 += yy[j];
            const float mean = red8(s1) * (1.f / 64.f);
            float s2 = 0.f;
#pragma unroll
            for (int j = 0; j < 8; ++j) { yy[j] -= mean; s2 += yy[j] * yy[j]; }
            const float rstd = __builtin_amdgcn_rsqf(red8(s2) * (1.f / 64.f) + GN_EPS);
            float o[8];
#pragma unroll
            for (int j = 0; j < 8; ++j) o[j] = ((yy[j] * rstd) * cgw[j] + cgb[j] + bon * vv[j]) * gg[j];
            if (valid && do_store) *(v4u*)(Gb + (size_t)(row0 + 64 * c + tt) * D + ch) = pack8(o);
        }
    }
    *(f32x4*)(ST + srow * 64 + 8 * cg) = (f32x4){S[0], S[1], S[2], S[3]}; *(f32x4*)(ST + srow * 64 + 8 * cg + 4) = (f32x4){S[4], S[5], S[6], S[7]};
    __syncthreads();
}

constexpr int RH_TC = 32, RH_BUF = 12288;
constexpr int RH_KK = 0, RH_DD = 2048, RH_BB = 4096, RH_KP = 6144, RH_RR = 8192, RH_VV = 10240, RH_YY = 11264;
__device__ __forceinline__ void rwkv_half_chain(const Frame& F, int b, int h, int half, float* ST, const bf16* Rb, const bf16* Kb, const bf16* Vb, const bf16* Db, const bf16* Ab,
                                                bf16* YRAW, float* BON, const float* k_k, const float* k_a, const float* r_k, const int pvar) {
    LAS float* L = (LAS float*)F.lds;
    const int tid = F.tid, lane = F.lane, w = F.wave, row0 = b * PT;
    constexpr int nch = PT / RH_TC;
    if (w < 4) {
        const int srow = 8 * w + (lane >> 3), cq = lane & 7;
        f32x4 S4 = {0.f, 0.f, 0.f, 0.f}, S5 = S4;
        __syncthreads();
        __builtin_amdgcn_s_setprio(3);
        for (int c = 0; c < nch; ++c) {
            const LAS float* p = L + (c & 1) * RH_BUF + 8 * cq;
            LAS float* yw = L + (c & 1) * RH_BUF + RH_YY + srow;
            const LAS float* vp = L + (c & 1) * RH_BUF + RH_VV + srow;
#define RH_LD(N, Dd, B, Q, R, VR, t_) do { const LAS float* p_ = p + (t_) * 64; \
                N[0] = *(const LAS f32x4*)(p_ + RH_KK); N[1] = *(const LAS f32x4*)(p_ + RH_KK + 4); Dd[0] = *(const LAS f32x4*)(p_ + RH_DD); Dd[1] = *(const LAS f32x4*)(p_ + RH_DD + 4); \
                B[0] = *(const LAS f32x4*)(p_ + RH_BB); B[1] = *(const LAS f32x4*)(p_ + RH_BB + 4); Q[0] = *(const LAS f32x4*)(p_ + RH_KP); Q[1] = *(const LAS f32x4*)(p_ + RH_KP + 4); \
                R[0] = *(const LAS f32x4*)(p_ + RH_RR); R[1] = *(const LAS f32x4*)(p_ + RH_RR + 4); VR = vp[(t_) * 32]; } while (0)
#define RH_STEP(N, Dd, B, Q, R, VR, t_) do { \
                const f32x4 pa_ = S4 * N[0] + S5 * N[1]; const float sa_ = red8((pa_.x + pa_.y) + (pa_.z + pa_.w)); \
                S4 = S4 * Dd[0] + (B[0] * sa_ + Q[0] * VR); S5 = S5 * Dd[1] + (B[1] * sa_ + Q[1] * VR); \
                const f32x4 ya_ = S4 * R[0] + S5 * R[1]; yw[(t_) * 32] = red8((ya_.x + ya_.y) + (ya_.z + ya_.w)); } while (0)
            f32x4 nA[2], dA[2], bA[2], qA[2], rA[2], nB[2], dB[2], bB[2], qB[2], rB[2]; float vA, vB;
            RH_LD(nA, dA, bA, qA, rA, vA, 0);
            if (pvar != 3)
            for (int t = 0; t < RH_TC; t += 2) {
                RH_LD(nB, dB, bB, qB, rB, vB, t + 1);
                RH_STEP(nA, dA, bA, qA, rA, vA, t);
                RH_LD(nA, dA, bA, qA, rA, vA, (t + 2 < RH_TC ? t + 2 : t + 1));
                RH_STEP(nB, dB, bB, qB, rB, vB, t + 1);
            }
#undef RH_LD
#undef RH_STEP
            __syncthreads();
        }
        __builtin_amdgcn_s_setprio(0);
        *(f32x4*)(ST + (32 * half + srow) * 64 + 8 * cq) = S4; *(f32x4*)(ST + (32 * half + srow) * 64 + 8 * cq + 4) = S5;
    } else {
        const int ht = tid - 256, cg = ht & 7, tt = ht >> 3;
        const int ch = h * 64 + 8 * cg, vch = h * 64 + 32 * half + 4 * cg;
        float ckk[8], cka[8], crk[8];
#pragma unroll
        for (int j = 0; j < 8; ++j) { ckk[j] = k_k[ch + j]; cka[j] = k_a[ch + j]; crk[j] = r_k[ch + j]; }
        v4u pr, pk, pd, pa; uint2 pv;
#define RH_LOAD(cc) do { const size_t off_ = (size_t)(row0 + RH_TC * (cc) + tt) * D; pr = *(const v4u*)(Rb + off_ + ch); pk = *(const v4u*)(Kb + off_ + ch); pd = *(const v4u*)(Db + off_ + ch); \
            pa = *(const v4u*)(Ab + off_ + ch); pv = *(const uint2*)(Vb + off_ + vch); } while (0)
#define RH_PREP(cc) do { float r8[8], k8[8], d8[8], a8[8]; unpack8(pr, r8); unpack8(pk, k8); unpack8(pd, d8); unpack8(pa, a8); \
            float kk[8], ss = 0.f; _Pragma("unroll") for (int j = 0; j < 8; ++j) { kk[j] = k8[j] * ckk[j]; ss += kk[j] * kk[j]; } \
            ss = red8(ss); const float inv = __builtin_amdgcn_rsqf(fmaxf(ss, 1e-24f)); \
            float kp[8], bsum = 0.f; _Pragma("unroll") for (int j = 0; j < 8; ++j) { kk[j] *= inv; kp[j] = k8[j] * (1.f + (a8[j] - 1.f) * cka[j]); bsum += r8[j] * kp[j] * crk[j]; } \
            const float bon = red8(bsum); if (half == 0 && cg == 0) BON[(size_t)(row0 + RH_TC * (cc) + tt) * 16 + h] = bon; \
            LAS float* p = L + ((cc) & 1) * RH_BUF + tt * 64 + 8 * cg; \
            *(LAS f32x4*)(p + RH_KK) = (f32x4){-kk[0], -kk[1], -kk[2], -kk[3]}; *(LAS f32x4*)(p + RH_KK + 4) = (f32x4){-kk[4], -kk[5], -kk[6], -kk[7]}; \
            *(LAS f32x4*)(p + RH_DD) = (f32x4){1.f - d8[0], 1.f - d8[1], 1.f - d8[2], 1.f - d8[3]}; *(LAS f32x4*)(p + RH_DD + 4) = (f32x4){1.f - d8[4], 1.f - d8[5], 1.f - d8[6], 1.f - d8[7]}; \
            *(LAS f32x4*)(p + RH_BB) = (f32x4){kk[0] * a8[0], kk[1] * a8[1], kk[2] * a8[2], kk[3] * a8[3]}; *(LAS f32x4*)(p + RH_BB + 4) = (f32x4){kk[4] * a8[4], kk[5] * a8[5], kk[6] * a8[6], kk[7] * a8[7]}; \
            *(LAS f32x4*)(p + RH_KP) = (f32x4){kp[0], kp[1], kp[2], kp[3]}; *(LAS f32x4*)(p + RH_KP + 4) = (f32x4){kp[4], kp[5], kp[6], kp[7]}; \
            *(LAS f32x4*)(p + RH_RR) = (f32x4){r8[0], r8[1], r8[2], r8[3]}; *(LAS f32x4*)(p + RH_RR + 4) = (f32x4){r8[4], r8[5], r8[6], r8[7]}; \
            *(LAS f32x4*)(L + ((cc) & 1) * RH_BUF + RH_VV + tt * 32 + 4 * cg) = (f32x4){bflo(pv.x), bfhi(pv.x), bflo(pv.y), bfhi(pv.y)}; } while (0)
#define RH_POST(cc) do { const f32x4 y4 = *(const LAS f32x4*)(L + ((cc) & 1) * RH_BUF + RH_YY + tt * 32 + 4 * cg); uint2 o; o.x = pkbf(y4.x, y4.y); o.y = pkbf(y4.z, y4.w); \
            *(uint2*)(YRAW + (size_t)(row0 + RH_TC * (cc) + tt) * D + vch) = o; } while (0)
        RH_LOAD(0); RH_PREP(0); RH_LOAD(1);
        __syncthreads();
        for (int c = 0; c < nch; ++c) {
            if (c > 0) RH_POST(c - 1);
            if (c + 1 < nch) { RH_PREP(c + 1); if (c + 2 < nch) RH_LOAD(c + 2); }
            __syncthreads();
        }
        RH_POST(nch - 1);
#undef RH_LOAD
#undef RH_PREP
#undef RH_POST
    }
    __syncthreads();
}
__device__ __forceinline__ void rwkv_finish(const Frame& F, const bf16* YRAW, const float* BON, const bf16* Vb, bf16* Gb, const float* gn_w, const float* gn_b) {
    const int gt = (F.vcu * NWAVES + F.wave) * 64 + F.lane, NT = F.G * NWAVES * 64;
    for (int task = gt; task < MP * 128; task += NT) {
        const int cg = task & 7, hh = (task >> 3) & 15, row = task >> 7; const size_t off = (size_t)row * D + hh * 64 + 8 * cg;
        float yy[8], vv[8], gg[8]; unpack8(*(const v4u*)(YRAW + off), yy); unpack8(*(const v4u*)(Vb + off), vv); unpack8(*(const v4u*)(Gb + off), gg);
        const float bon = BON[(size_t)row * 16 + hh];
        float s1 = 0.f;
#pragma unroll
        for (int j = 0; j < 8; ++j) s1 += yy[j];
        const float mean = red8(s1) * (1.f / 64.f);
        float s2 = 0.f;
#pragma unroll
        for (int j = 0; j < 8; ++j) { yy[j] -= mean; s2 += yy[j] * yy[j]; }
        const float rstd = __builtin_amdgcn_rsqf(red8(s2) * (1.f / 64.f) + GN_EPS);
        const f32x4 w0 = *(const f32x4*)(gn_w + hh * 64 + 8 * cg), w1 = *(const f32x4*)(gn_w + hh * 64 + 8 * cg + 4), b0 = *(const f32x4*)(gn_b + hh * 64 + 8 * cg), b1 = *(const f32x4*)(gn_b + hh * 64 + 8 * cg + 4);
        const float gw[8] = {w0.x, w0.y, w0.z, w0.w, w1.x, w1.y, w1.z, w1.w}, gb[8] = {b0.x, b0.y, b0.z, b0.w, b1.x, b1.y, b1.z, b1.w};
        float o[8];
#pragma unroll
        for (int j = 0; j < 8; ++j) o[j] = ((yy[j] * rstd) * gw[j] + gb[j] + bon * vv[j]) * gg[j];
        *(v4u*)(Gb + off) = pack8(o);
    }
}

constexpr int PBY = 144;
constexpr int RPY = 272;
constexpr int ML_RQK = 0, ML_S = 0, ML_KT = 9216, ML_RV = 18432, ML_Q = 35840, ML_K = 45056, ML_HB = 35840, ML_VT = 54272, ML_C = 72704, ML_F = 91136;
constexpr int MF_N = 0, MF_QN = 64, MF_RS = 128, MF_HS = 256, MF_CW = 384, MF_B63 = 1024, MF_P63 = 1056, MF_MC = 1088  , MF_GB = 1152, MF_GP = MF_GB + 2048, MF_GA = MF_GP + 2048;
typedef __attribute__((address_space(3))) unsigned short lds_u16;
#define MFMA16(a, b, c) __builtin_amdgcn_mfma_f32_16x16x32_bf16((a), (b), (c), 0, 0, 0)
__device__ __forceinline__ void mlstm_gate_tables(const Frame& F, int b, int hh, const float* IFb) {
    LAS float* Fl = (LAS float*)(F.lds + ML_F); const int lane = F.lane, w = F.wave;
#pragma unroll
    for (int q = 0; q < 4; ++q) { const int cc = w + 8 * q; const size_t ro_ = (size_t)(b * PT + 64 * cc + lane) * 16;
        const float li = IFb[ro_ + hh], lf = IFb[ro_ + 8 + hh];
        float bc = lf;
#pragma unroll
        for (int o = 1; o < 64; o <<= 1) { const float x = __shfl_up(bc, o); if (lane >= o) bc += x; }
        const float av = li - bc; float pm = av;
#pragma unroll
        for (int o = 1; o < 64; o <<= 1) { const float x = __shfl_up(pm, o); if (lane >= o) pm = fmaxf(pm, x); }
        Fl[MF_GB + cc * 64 + lane] = bc; Fl[MF_GP + cc * 64 + lane] = pm; Fl[MF_GA + cc * 64 + lane] = av;
        if (lane == 63) { Fl[MF_B63 + cc] = bc; Fl[MF_P63 + cc] = pm; } }
    __syncthreads();
    if (F.tid == 0) { float mm = 0.f;
        for (int cc = 0; cc < PT / 64; ++cc) { Fl[MF_MC + cc] = mm; const float b6 = Fl[MF_B63 + cc]; mm = fmaxf(b6 + mm, b6 + Fl[MF_P63 + cc]); }
        Fl[MF_MC + PT / 64] = mm; }
    __syncthreads();
}
constexpr int ML_NSEG = 4, ML_SEGC = PT / 64 / ML_NSEG, ML_SEGSZ = 128 * 64 + 64;
__device__ __forceinline__ void mlstm_prompt_chain(const Frame& F, int b, int hh, const int seg, const bf16* QKR, const bf16* VVb, const bf16* OOb, const float* IFb, bf16* HOb,
                                                   const float* conv_w, const float* conv_b, const float* norm_w, float* NUM, float* DEN, bf16* Qs, float* SEG, const int pvar) {
    LAS unsigned char* lds = F.lds; LAS float* Fl = (LAS float*)(lds + ML_F);
    const bool defer = seg > 0; const int c_lo = seg * ML_SEGC, c_hi = c_lo + ML_SEGC;
    const int tid = F.tid, lane = F.lane, w = F.wave, fr = lane & 15, fq = lane >> 4;
    for (int i = tid; i < 128 * 72; i += 512) ((lds_u16*)(lds + ML_C))[i] = 0;
    if (tid < 64) Fl[MF_N + tid] = 0.f;
    for (int i = tid; i < 640; i += 512) { const int j = i >> 7, c = i & 127, gc = c < 64 ? hh * 64 + c : 512 + hh * 64 + (c - 64); Fl[MF_CW + i] = j < 4 ? conv_w[j * D + gc] : conv_b[gc]; }
    f32x4 Cacc[4];
#pragma unroll
    for (int k = 0; k < 4; ++k) Cacc[k] = (f32x4){0.f, 0.f, 0.f, 0.f};
    const int og = tid & 15, ot = tid >> 4;
    float nw[8];
#pragma unroll
    for (int e = 0; e < 8; ++e) nw[e] = norm_w[hh * 128 + 8 * og + e];
    v4u rq[3], rv[2], ro[2];
#define ML_LOAD_QKV(cc) do { const int rowc_ = b * PT + 64 * (cc); \
        _Pragma("unroll") for (int i = 0; i < 3; ++i) { const int q = tid + 512 * i, r = q >> 4, j = q & 15, tok = 64 * (cc) - 3 + r; rq[i] = (v4u){0u, 0u, 0u, 0u}; \
            if (q < 67 * 16 && tok >= 0) rq[i] = *(const v4u*)(QKR + (size_t)(b * PT + tok) * D + (j < 8 ? hh * 64 + 8 * j : 512 + hh * 64 + 8 * (j - 8))); } \
        _Pragma("unroll") for (int i = 0; i < 2; ++i) rv[i] = *(const v4u*)(VVb + (size_t)(rowc_ + ot + 32 * i) * D + hh * 128 + 8 * og); \
        } while (0)
#define ML_LOAD_O(cc) do { const int rowc_ = b * PT + 64 * (cc); \
        _Pragma("unroll") for (int i = 0; i < 2; ++i) ro[i] = *(const v4u*)(OOb + (size_t)(rowc_ + ot + 32 * i) * D + hh * 128 + 8 * og); } while (0)
    ML_LOAD_QKV(c_lo);
    mlstm_gate_tables(F, b, hh, IFb);
    for (int c = c_lo; c < c_hi; ++c) {
        const int rowc = b * PT + 64 * c;
        const float m_c = Fl[MF_MC + c], m_n = Fl[MF_MC + c + 1], b63 = Fl[MF_B63 + c];
#pragma unroll
        for (int i = 0; i < 3; ++i) { const int q = tid + 512 * i; if (q < 67 * 16) *(LAS v4u*)(lds + ML_RQK + (q >> 4) * RPY + 16 * (q & 15)) = rq[i]; }
#pragma unroll
        for (int i = 0; i < 2; ++i) *(LAS v4u*)(lds + ML_RV + (ot + 32 * i) * RPY + 16 * og) = rv[i];
        if (c + 1 < c_hi) ML_LOAD_QKV(c + 1);
        if (!defer) ML_LOAD_O(c);
        __syncthreads();
        float kreg[8] = {0.f, 0.f, 0.f, 0.f, 0.f, 0.f, 0.f, 0.f};
        if (pvar != 3)
#pragma unroll
        for (int i = 0; i < 2; ++i) {
            const int g = w + 8 * i, t = lane;
            float x[4][8];
#pragma unroll
            for (int j = 0; j < 4; ++j) unpack8(*(const LAS v4u*)(lds + ML_RQK + (t + j) * RPY + 16 * g), x[j]);
            float val[8];
#pragma unroll
            for (int h2 = 0; h2 < 2; ++h2) { f32x4 a = *(const LAS f32x4*)(Fl + MF_CW + 4 * 128 + 8 * g + 4 * h2);
#pragma unroll
                for (int j = 0; j < 4; ++j) { const f32x4 cw = *(const LAS f32x4*)(Fl + MF_CW + j * 128 + 8 * g + 4 * h2);
                    a.x += cw.x * x[j][4 * h2]; a.y += cw.y * x[j][4 * h2 + 1]; a.z += cw.z * x[j][4 * h2 + 2]; a.w += cw.w * x[j][4 * h2 + 3]; }
                val[4 * h2] = siluf_(a.x); val[4 * h2 + 1] = siluf_(a.y); val[4 * h2 + 2] = siluf_(a.z); val[4 * h2 + 3] = siluf_(a.w); }
            if (i == 0) {
#pragma unroll
                for (int e = 0; e < 8; ++e) val[e] *= 0.125f;
                *(LAS v4u*)(lds + ML_Q + t * PBY + 16 * w) = pack8(val);
            } else { *(LAS v4u*)(lds + ML_K + t * PBY + 16 * w) = pack8(val);
#pragma unroll
                for (int e = 0; e < 8; ++e) kreg[e] = val[e]; }
            const v4u vw = *(const LAS v4u*)(lds + ML_RV + t * RPY + 16 * g);
            lds_u16* vt = (lds_u16*)(lds + ML_VT) + (8 * g) * 72 + t;
            vt[0 * 72] = (unsigned short)(vw.x & 0xffffu); vt[1 * 72] = (unsigned short)(vw.x >> 16); vt[2 * 72] = (unsigned short)(vw.y & 0xffffu); vt[3 * 72] = (unsigned short)(vw.y >> 16);
            vt[4 * 72] = (unsigned short)(vw.z & 0xffffu); vt[5 * 72] = (unsigned short)(vw.z >> 16); vt[6 * 72] = (unsigned short)(vw.w & 0xffffu); vt[7 * 72] = (unsigned short)(vw.w >> 16);
        }
        __syncthreads();
        if (pvar != 4) {
        { const float wsv = __expf(b63 + Fl[MF_GA + c * 64 + lane] - m_n); lds_u16* kt = (lds_u16*)(lds + ML_KT) + (8 * w) * 72 + lane;
#pragma unroll
          for (int e = 0; e < 8; ++e) kt[e * 72] = f2bf1(kreg[e] * wsv); }
        { const int tq = tid >> 3, p = tid & 7; float q8[8]; unpack8(*(const LAS v4u*)(lds + ML_Q + tq * PBY + 16 * p), q8);
          float dsum = 0.f;
#pragma unroll
          for (int e = 0; e < 8; ++e) dsum += q8[e] * Fl[MF_N + 8 * p + e];
          dsum = red8(dsum); if (p == 0) Fl[MF_QN + tq] = dsum; }
        { const int ti = w >> 1, t = 16 * ti + fr; float rsum = 0.f; const float mxt = fmaxf(m_c, Fl[MF_GP + c * 64 + t]);
          typedef unsigned u2v_ __attribute__((ext_vector_type(2)));
#pragma unroll
          for (int jj = 0; jj < 2; ++jj) { const int sj = 2 * (w & 1) + jj; f32x4 acc = {0.f, 0.f, 0.f, 0.f};
#pragma unroll
              for (int ks = 0; ks < 2; ++ks) { const bf16x8 a = *(const LAS bf16x8*)(lds + ML_Q + (16 * ti + fr) * PBY + ks * 64 + fq * 16), bb = *(const LAS bf16x8*)(lds + ML_K + (16 * sj + fr) * PBY + ks * 64 + fq * 16);
                  acc = MFMA16(bb, a, acc); }
              const f32x4 av4 = *(const LAS f32x4*)(Fl + MF_GA + c * 64 + 16 * sj + 4 * fq);
#pragma unroll
              for (int r = 0; r < 4; ++r) { const int s_ = 16 * sj + 4 * fq + r; const float val = s_ <= t ? acc[r] * __expf(av4[r] - mxt) : 0.f; acc[r] = val; rsum += val; }
              u2v_ pw; pw.x = pkbf(acc[0], acc[1]); pw.y = pkbf(acc[2], acc[3]);
              *(LAS u2v_*)(lds + ML_S + (t * 72 + 16 * sj + 4 * fq) * 2) = pw; }
          rsum += __shfl_xor(rsum, 16); rsum += __shfl_xor(rsum, 32);
          if (fq == 0) Fl[MF_RS + t * 2 + (w & 1)] = rsum; }
        }
        __syncthreads();
        float hv[4][4] = {};
        if (pvar != 5) { const int ti = w & 3, t = 16 * ti + fr;
          const float mx = fmaxf(m_c, Fl[MF_GP + c * 64 + t]), wi = __expf(m_c - mx), ei = __expf(-(Fl[MF_GB + c * 64 + t] + mx));
          const float rden = __builtin_amdgcn_rcpf(fmaxf(fabsf(wi * Fl[MF_QN + t] + Fl[MF_RS + 2 * t] + Fl[MF_RS + 2 * t + 1]), ei)); float hq = 0.f;
#pragma unroll
          for (int i = 0; i < 4; ++i) { const int vt = 4 * (w >> 2) + i; f32x4 accA = {0.f, 0.f, 0.f, 0.f}, accB = accA;
#pragma unroll
              for (int ks = 0; ks < 2; ++ks) {
                  const bf16x8 aq = *(const LAS bf16x8*)(lds + ML_Q + (16 * ti + fr) * PBY + ks * 64 + fq * 16), bc = *(const LAS bf16x8*)(lds + ML_C + (16 * vt + fr) * PBY + ks * 64 + fq * 16);
                  accA = MFMA16(bc, aq, accA);
                  const bf16x8 as = *(const LAS bf16x8*)(lds + ML_S + (16 * ti + fr) * PBY + ks * 64 + fq * 16), bv = *(const LAS bf16x8*)(lds + ML_VT + (16 * vt + fr) * PBY + ks * 64 + fq * 16);
                  accB = MFMA16(bv, as, accB); }
              if (defer) { *(f32x4*)(NUM + (size_t)(rowc + t) * D + hh * 128 + 16 * vt + 4 * fq) = accA * wi + accB; }
              else {
#pragma unroll
              for (int r = 0; r < 4; ++r) { const float hh_ = (wi * accA[r] + accB[r]) * rden; hv[i][r] = hh_; hq += hh_ * hh_; } } }
          if (defer) { if (fq == 0 && (w >> 2) == 0) DEN[(size_t)(rowc + t) * 8 + hh] = wi * Fl[MF_QN + t] + Fl[MF_RS + 2 * t] + Fl[MF_RS + 2 * t + 1];
              *(v4u*)(Qs + (size_t)(rowc + (tid >> 3)) * 512 + hh * 64 + 8 * (tid & 7)) = *(const LAS v4u*)(lds + ML_Q + (tid >> 3) * PBY + 16 * (tid & 7)); }
          else { hq += __shfl_xor(hq, 16); hq += __shfl_xor(hq, 32);
              if (fq == 0) Fl[MF_HS + t * 2 + (w >> 2)] = hq; } }
        __syncthreads();
        if (pvar != 6) {
        if (!defer) { const int ti = w & 3, t = 16 * ti + fr; const float sc = __builtin_amdgcn_rsqf((Fl[MF_HS + 2 * t] + Fl[MF_HS + 2 * t + 1]) * (1.f / 128.f) + NORM_EPS);
          typedef unsigned u2v_ __attribute__((ext_vector_type(2)));
#pragma unroll
          for (int i = 0; i < 4; ++i) { u2v_ pw; pw.x = pkbf(hv[i][0] * sc, hv[i][1] * sc); pw.y = pkbf(hv[i][2] * sc, hv[i][3] * sc);
              *(LAS u2v_*)(lds + ML_HB + t * RPY + (16 * (4 * (w >> 2) + i) + 4 * fq) * 2) = pw; } }
        { const float wst = __expf(b63 + m_c - m_n);
          typedef unsigned u2v_ __attribute__((ext_vector_type(2)));
#pragma unroll
          for (int kt = 0; kt < 4; ++kt) { Cacc[kt] = Cacc[kt] * wst;
#pragma unroll
              for (int ks = 0; ks < 2; ++ks) { const bf16x8 a = *(const LAS bf16x8*)(lds + ML_VT + (16 * w + fr) * PBY + ks * 64 + fq * 16), bb = *(const LAS bf16x8*)(lds + ML_KT + (16 * kt + fr) * PBY + ks * 64 + fq * 16);
                  Cacc[kt] = MFMA16(bb, a, Cacc[kt]); }
              u2v_ pw; pw.x = pkbf(Cacc[kt][0], Cacc[kt][1]); pw.y = pkbf(Cacc[kt][2], Cacc[kt][3]);
              *(LAS u2v_*)(lds + ML_C + ((16 * w + fr) * 72 + 16 * kt + 4 * fq) * 2) = pw; }
          if (w == 0) { float sum = 0.f;
#pragma unroll
              for (int q = 0; q < 8; ++q) { float k8[8]; unpack8(*(const LAS v4u*)(lds + ML_KT + lane * PBY + 16 * q), k8);
#pragma unroll
                  for (int e = 0; e < 8; ++e) sum += k8[e]; }
              Fl[MF_N + lane] = wst * Fl[MF_N + lane] + sum; } }
        }
        __syncthreads();
        if (!defer)
#pragma unroll
        for (int i = 0; i < 2; ++i) { const int t = ot + 32 * i; float h8[8], o8[8]; unpack8(*(const LAS v4u*)(lds + ML_HB + t * RPY + 16 * og), h8); unpack8(ro[i], o8);
#pragma unroll
            for (int e = 0; e < 8; ++e) h8[e] = h8[e] * nw[e] * o8[e];
            *(v4u*)(HOb + (size_t)(rowc + t) * D + hh * 128 + 8 * og) = pack8(h8); }
    }
#undef ML_LOAD_QKV
#undef ML_LOAD_O
    { float* sp = SEG + (size_t)((b * 8 + hh) * ML_NSEG + seg) * ML_SEGSZ;
#pragma unroll
      for (int kt = 0; kt < 4; ++kt) *(f32x4*)(sp + (16 * w + fr) * 64 + 16 * kt + 4 * fq) = Cacc[kt];
      if (w == 0) sp[128 * 64 + lane] = Fl[MF_N + lane]; }
    __syncthreads();
}
__device__ __forceinline__ void mlstm_fix_seg(const Frame& F, int b, int hh, const int seg, const bf16* QKR, const bf16* OOb, const float* IFb, bf16* HOb, const float* norm_w,
                                              const float* NUM, const float* DEN, const bf16* Qs, const float* SEG, float* out) {
    LAS unsigned char* lds = F.lds; LAS float* Fl = (LAS float*)(lds + ML_F);
    const int tid = F.tid, lane = F.lane, w = F.wave, fr = lane & 15, fq = lane >> 4;
    const int og = tid & 15, ot = tid >> 4, chain = b * 8 + hh;
    typedef unsigned u2v_ __attribute__((ext_vector_type(2)));
    float nw[8];
#pragma unroll
    for (int e = 0; e < 8; ++e) nw[e] = norm_w[hh * 128 + 8 * og + e];
    const int c_lo = seg * ML_SEGC, c_hi = c_lo + ML_SEGC;
    v4u rq, ro[2]; f32x4 numl[4]; float denl;
#define MLF_LOAD(cc, RQ, RO, NL, DL) do { const int rowc_ = b * PT + 64 * (cc); \
        RQ = *(const v4u*)(Qs + (size_t)(rowc_ + (tid >> 3)) * 512 + hh * 64 + 8 * (tid & 7)); \
        _Pragma("unroll") for (int i = 0; i < 2; ++i) RO[i] = *(const v4u*)(OOb + (size_t)(rowc_ + ot + 32 * i) * D + hh * 128 + 8 * og); \
        _Pragma("unroll") for (int i = 0; i < 4; ++i) NL[i] = *(const f32x4*)(NUM + (size_t)(rowc_ + 16 * (w & 3) + fr) * D + hh * 128 + 16 * (4 * (w >> 2) + i) + 4 * fq); \
        DL = DEN[(size_t)(rowc_ + 16 * (w & 3) + fr) * 8 + hh]; } while (0)
    MLF_LOAD(c_lo, rq, ro, numl, denl);
    mlstm_gate_tables(F, b, hh, IFb);
    {
        f32x4 cin[4]; float nin = 0.f;
#pragma unroll
        for (int i = 0; i < 4; ++i) cin[i] = (f32x4){0.f, 0.f, 0.f, 0.f};
        for (int j = 0; j < seg; ++j) {
            float lw = 0.f;
            for (int cc = j * ML_SEGC; cc < (j + 1) * ML_SEGC; ++cc) lw += Fl[MF_B63 + cc] + Fl[MF_MC + cc] - Fl[MF_MC + cc + 1];
            const float Wj = __expf(lw); const float* sp = SEG + (size_t)(chain * ML_NSEG + j) * ML_SEGSZ;
#pragma unroll
            for (int i = 0; i < 4; ++i) cin[i] = cin[i] * Wj + *(const f32x4*)(sp + 4 * (tid + 512 * i));
            if (tid < 64) nin = nin * Wj + sp[128 * 64 + tid];
        }
#pragma unroll
        for (int i = 0; i < 4; ++i) { const int idx = tid + 512 * i, v = idx >> 4, k4 = (idx & 15) * 4; u2v_ pw; pw.x = pkbf(cin[i][0], cin[i][1]); pw.y = pkbf(cin[i][2], cin[i][3]);
            *(LAS u2v_*)(lds + ML_C + (v * 72 + k4) * 2) = pw; }
        if (tid < 64) Fl[MF_N + tid] = nin;
        if (seg == ML_NSEG - 1) {
            float lw = 0.f;
            for (int cc = seg * ML_SEGC; cc < (seg + 1) * ML_SEGC; ++cc) lw += Fl[MF_B63 + cc] + Fl[MF_MC + cc] - Fl[MF_MC + cc + 1];
            const float Wj = __expf(lw); const float* sp = SEG + (size_t)(chain * ML_NSEG + seg) * ML_SEGSZ;
#pragma unroll
            for (int i = 0; i < 4; ++i) *(f32x4*)(out + O_P_C + (size_t)chain * 8192 + 4 * (tid + 512 * i)) = cin[i] * Wj + *(const f32x4*)(sp + 4 * (tid + 512 * i));
            if (tid < 64) out[O_P_N + (size_t)chain * 64 + tid] = nin * Wj + sp[128 * 64 + tid];
            if (tid == 0) out[O_P_M + chain] = Fl[MF_MC + PT / 64];
            if (tid < 384) { const int j = tid >> 7, c = tid & 127, gc = c < 64 ? hh * 64 + c : 512 + hh * 64 + (c - 64);
                out[O_P_CONV + (size_t)(b * 3 + j) * D + gc] = bf1(QKR[(size_t)(b * PT + PT - 3 + j) * D + gc]); }
        }
    }
    float wc = 1.f;
    for (int c = c_lo; c < c_hi; ++c) {
        const int rowc = b * PT + 64 * c;
        const float m_c = Fl[MF_MC + c], m_n = Fl[MF_MC + c + 1], b63 = Fl[MF_B63 + c];
        *(LAS v4u*)(lds + ML_RQK + (tid >> 3) * PBY + 16 * (tid & 7)) = rq;
        v4u rqn = rq, ron[2] = {ro[0], ro[1]}; f32x4 numn[4] = {numl[0], numl[1], numl[2], numl[3]}; float denn = denl;
        if (c + 1 < c_hi) MLF_LOAD(c + 1, rqn, ron, numn, denn);
        __syncthreads();
        { const int tq = tid >> 3, p = tid & 7; float q8[8]; unpack8(*(const LAS v4u*)(lds + ML_RQK + tq * PBY + 16 * p), q8);
          float dsum = 0.f;
#pragma unroll
          for (int e = 0; e < 8; ++e) dsum += q8[e] * Fl[MF_N + 8 * p + e];
          dsum = red8(dsum); if (p == 0) Fl[MF_QN + tq] = dsum; }
        const int ti = w & 3, t = 16 * ti + fr;
        f32x4 accA[4];
#pragma unroll
        for (int i = 0; i < 4; ++i) { const int vt = 4 * (w >> 2) + i; accA[i] = (f32x4){0.f, 0.f, 0.f, 0.f};
#pragma unroll
            for (int ks = 0; ks < 2; ++ks) {
                const bf16x8 aq = *(const LAS bf16x8*)(lds + ML_RQK + (16 * ti + fr) * PBY + ks * 64 + fq * 16), bc = *(const LAS bf16x8*)(lds + ML_C + (16 * vt + fr) * PBY + ks * 64 + fq * 16);
                accA[i] = MFMA16(bc, aq, accA[i]); } }
        __syncthreads();
        float hv[4][4];
        { const float mx = fmaxf(m_c, Fl[MF_GP + c * 64 + t]), wi = __expf(m_c - mx) * wc, ei = __expf(-(Fl[MF_GB + c * 64 + t] + mx));
          const float rden = __builtin_amdgcn_rcpf(fmaxf(fabsf(wi * Fl[MF_QN + t] + denl), ei)); float hq = 0.f;
#pragma unroll
          for (int i = 0; i < 4; ++i)
#pragma unroll
              for (int r = 0; r < 4; ++r) { const float hh_ = (wi * accA[i][r] + numl[i][r]) * rden; hv[i][r] = hh_; hq += hh_ * hh_; }
          hq += __shfl_xor(hq, 16); hq += __shfl_xor(hq, 32);
          if (fq == 0) Fl[MF_HS + t * 2 + (w >> 2)] = hq; }
        __syncthreads();
        { const float sc = __builtin_amdgcn_rsqf((Fl[MF_HS + 2 * t] + Fl[MF_HS + 2 * t + 1]) * (1.f / 128.f) + NORM_EPS);
#pragma unroll
          for (int i = 0; i < 4; ++i) { u2v_ pw; pw.x = pkbf(hv[i][0] * sc, hv[i][1] * sc); pw.y = pkbf(hv[i][2] * sc, hv[i][3] * sc);
              *(LAS u2v_*)(lds + ML_HB + t * RPY + (16 * (4 * (w >> 2) + i) + 4 * fq) * 2) = pw; } }
        __syncthreads();
#pragma unroll
        for (int i = 0; i < 2; ++i) { const int t2 = ot + 32 * i; float h8[8], o8[8]; unpack8(*(const LAS v4u*)(lds + ML_HB + t2 * RPY + 16 * og), h8); unpack8(ro[i], o8);
#pragma unroll
            for (int e = 0; e < 8; ++e) h8[e] = h8[e] * nw[e] * o8[e];
            *(v4u*)(HOb + (size_t)(rowc + t2) * D + hh * 128 + 8 * og) = pack8(h8); }
        wc *= __expf(b63 + m_c - m_n);
        rq = rqn; ro[0] = ron[0]; ro[1] = ron[1]; denl = denn;
#pragma unroll
        for (int i = 0; i < 4; ++i) numl[i] = numn[i];
    }
#undef MLF_LOAD
    __syncthreads();
}
__device__ __forceinline__ void mlstm_sample_item(const Frame& F, int b, int hh, const bf16* QKR, const bf16* VVb, const bf16* OOb, const float* IFb, bf16* HOb,
                                                  const float* conv_w, const float* conv_b, const float* norm_w, const float* C0, const float* n0, const float* m0p, const float* conv0, float* out) {
    LAS float* L = (LAS float*)F.lds;
    constexpr int LQ = 0, LK = 256, LV = 512, LS = 1024, LQN = 1040, LHS = 1048;
    const int tid = F.tid, lane = F.lane, w = F.wave, row0 = MP + 4 * b;
    float li[4], lf[4];
#pragma unroll
    for (int t = 0; t < 4; ++t) { li[t] = IFb[(size_t)(row0 + t) * 16 + hh]; lf[t] = IFb[(size_t)(row0 + t) * 16 + 8 + hh]; }
    const float m0 = m0p[b * 8 + hh];
    float bc[4], av[4], mt[4], wi[4], wsv[4], ei[4], bm[4];
    { float run = 0.f, pm = -3.0e38f;
#pragma unroll
      for (int t = 0; t < 4; ++t) { run += lf[t]; bc[t] = run; av[t] = li[t] - run; pm = fmaxf(pm, av[t]); mt[t] = fmaxf(run + m0, run + pm); } }
    const float m_new = mt[3], wst = __expf(bc[3] + m0 - m_new);
#pragma unroll
    for (int t = 0; t < 4; ++t) { wi[t] = __expf(bc[t] + m0 - mt[t]); wsv[t] = __expf(bc[3] + av[t] - m_new); ei[t] = __expf(-mt[t]); bm[t] = bc[t] - mt[t]; }
    { const int t = tid >> 7, c = tid & 127, gc = c < 64 ? hh * 64 + c : 512 + hh * 64 + (c - 64);
      float x[4];
#pragma unroll
      for (int j = 0; j < 4; ++j) { const int p = t + j; x[j] = p < 3 ? conv0[(size_t)(b * 3 + p) * D + gc] : bf1(QKR[(size_t)(row0 + p - 3) * D + gc]); }
      float a = conv_b[gc];
#pragma unroll
      for (int j = 0; j < 4; ++j) a += conv_w[j * D + gc] * x[j];
      const float val = siluf_(a);
      if (c < 64) L[LQ + t * 64 + c] = val * 0.125f; else L[LK + t * 64 + (c - 64)] = val;
      if (t >= 1) out[O_S_CONV + (size_t)(b * 3 + t - 1) * D + gc] = x[3];
      L[LV + t * 128 + c] = bf1(VVb[(size_t)(row0 + t) * D + hh * 128 + c]); }
    __syncthreads();
    if (w == 0) { const int pair = lane >> 2, t = pair >> 2, s = pair & 3, part = lane & 3; float dsum = 0.f;
#pragma unroll
        for (int e = 0; e < 16; ++e) dsum += L[LQ + t * 64 + 16 * part + e] * L[LK + s * 64 + 16 * part + e];
        dsum = red4(dsum);
        const float bmt = t == 0 ? bm[0] : (t == 1 ? bm[1] : (t == 2 ? bm[2] : bm[3])), avs = s == 0 ? av[0] : (s == 1 ? av[1] : (s == 2 ? av[2] : av[3]));
        if (part == 0) L[LS + pair] = s <= t ? dsum * __expf(bmt + avs) : 0.f; }
    if (w == 1) { const int t = lane >> 4, part = lane & 15; float dsum = 0.f;
#pragma unroll
        for (int e = 0; e < 4; ++e) dsum += L[LQ + t * 64 + 4 * part + e] * n0[(size_t)(b * 8 + hh) * 64 + 4 * part + e];
        dsum = red16(dsum); if (part == 0) L[LQN + t] = dsum; }
    __syncthreads();
    const int v = tid >> 2, kq = tid & 3;
    float hvv[4];
    { const size_t coff = ((size_t)(b * 8 + hh) * 128 + v) * 64 + 16 * kq;
      float c0[16];
#pragma unroll
      for (int e4 = 0; e4 < 4; ++e4) { const f32x4 x = *(const f32x4*)(C0 + coff + 4 * e4); c0[4 * e4] = x.x; c0[4 * e4 + 1] = x.y; c0[4 * e4 + 2] = x.z; c0[4 * e4 + 3] = x.w; }
#pragma unroll
      for (int t = 0; t < 4; ++t) { float part = 0.f;
#pragma unroll
          for (int e = 0; e < 16; ++e) part += c0[e] * L[LQ + t * 64 + 16 * kq + e];
          const float inter = red4(part);
          float num = wi[t] * inter, den = wi[t] * L[LQN + t];
#pragma unroll
          for (int s = 0; s < 4; ++s) { const float sm = L[LS + t * 4 + s]; num += sm * L[LV + s * 128 + v]; den += sm; }
          hvv[t] = num / fmaxf(fabsf(den), ei[t]); }
#pragma unroll
      for (int t = 0; t < 4; ++t) { const float x = wave_sum(kq == 0 ? hvv[t] * hvv[t] : 0.f); if (lane == 0) L[LHS + w * 4 + t] = x; }
      float cn[16];
#pragma unroll
      for (int e = 0; e < 16; ++e) { float a = wst * c0[e];
#pragma unroll
          for (int s = 0; s < 4; ++s) a += wsv[s] * L[LV + s * 128 + v] * L[LK + s * 64 + 16 * kq + e];
          cn[e] = a; }
#pragma unroll
      for (int e4 = 0; e4 < 4; ++e4) *(f32x4*)(out + O_S_C + coff + 4 * e4) = (f32x4){cn[4 * e4], cn[4 * e4 + 1], cn[4 * e4 + 2], cn[4 * e4 + 3]}; }
    __syncthreads();
    if (kq == 0) {
#pragma unroll
        for (int t = 0; t < 4; ++t) { float tot = 0.f;
#pragma unroll
            for (int ww = 0; ww < 8; ++ww) tot += L[LHS + ww * 4 + t];
            const float sc = 1.0f / sqrtf(tot * (1.f / 128.f) + NORM_EPS); const size_t off = (size_t)(row0 + t) * D + hh * 128 + v;
            HOb[off] = f2bf1(hvv[t] * sc * norm_w[hh * 128 + v] * bf1(OOb[off])); } }
    if (tid < 64) { float a = wst * n0[(size_t)(b * 8 + hh) * 64 + tid];
#pragma unroll
        for (int s = 0; s < 4; ++s) a += wsv[s] * L[LK + s * 64 + tid];
        out[O_S_N + (size_t)(b * 8 + hh) * 64 + tid] = a; }
    if (tid == 0) out[O_S_M + b * 8 + hh] = m_new;
    __syncthreads();
}

constexpr int CA_AH = 0, CA_BH = 9216, CA_KH = 18432, CA_RH = 27648, CA_BT = 36864, CA_KT = 46080, CA_VT = 55296, CA_AB = 64512, CA_AK = 73728, CA_RB = 82944, CA_RK = 92160, CA_XT = 101376,
              CA_TD = 119808, CA_NF = 123904, CA_GL = 128000, CA_LG = CA_AB  , CA_AT = CA_KH  ;
__device__ __forceinline__ bf16x8 ldsfrag(LAS unsigned char* lds, int base, int row, int ks, int fq) { return *(const LAS bf16x8*)(lds + base + row * PBY + ks * 64 + fq * 16); }
__device__ __forceinline__ bf16x8 ldsfrag_sw(LAS unsigned char* lds, int base, int row, int ks, int fq, int sw) { const int blk = (ks * 4 + fq) ^ (sw ? ((row >> 3) & 7) : 0); return *(const LAS bf16x8*)(lds + base + row * PBY + blk * 16); }
__device__ __forceinline__ int tr_idx(int cg, int j, int tt) { return (8 * cg + j) * 72 + ((((tt >> 3) ^ cg) & 7) << 3) + (tt & 7); }
__device__ __forceinline__ void rwkv_chunk_item(const Frame& F, int chain, int chunk, bf16* Rb, bf16* Kb, bf16* Vb, bf16* Db, bf16* Ab, bf16* Gb,
                                                const float* k_k, const float* k_a, const float* r_k, float* BON, bf16* dummy, v4u (&pf)[6], const int nchain, const int nchunk) {
    LAS unsigned char* lds = F.lds;
    const int tid = F.tid, lane = F.lane, w = F.wave, fr = lane & 15, fq = lane >> 4, cg = tid & 7, tt = tid >> 3;
    const int h = chain & 15, row0 = (chain >> 4) * PT + 64 * chunk, ch = h * 64 + 8 * cg;
    const size_t goff = (size_t)(row0 + tt) * D + ch;
    LAS float* LG = (LAS float*)(lds + CA_LG); LAS float* GLf = (LAS float*)(lds + CA_GL);
    float r8[8], kp[8], av[8], bv[8], rd[8];
    {
        float k8[8], v8[8], d8[8], a8[8];
        unpack8(pf[0], r8); unpack8(pf[1], k8); unpack8(pf[2], v8); unpack8(pf[3], d8); unpack8(pf[4], a8);
        float ss = 0.f;
#pragma unroll
        for (int j = 0; j < 8; ++j) { av[j] = k8[j] * k_k[ch + j]; ss += av[j] * av[j]; }
        ss = red8(ss); const float inv = __builtin_amdgcn_rsqf(fmaxf(ss, 1e-24f));
        float bsum = 0.f;
#pragma unroll
        for (int j = 0; j < 8; ++j) { const float kk = av[j] * inv; kp[j] = k8[j] * (1.f + (a8[j] - 1.f) * k_a[ch + j]); bv[j] = kk * a8[j]; av[j] = -kk; bsum += r8[j] * kp[j] * r_k[ch + j]; rd[j] = __builtin_amdgcn_rcpf(1.f - d8[j]); }
        const float bon = red8(bsum);
#pragma unroll
        for (int j = 0; j < 8; ++j) { LG[(8 * cg + j) * 65 + tt] = __logf(1.f - d8[j]); ((lds_u16*)(lds + CA_VT))[tr_idx(cg, j, tt)] = f2bf1(v8[j]); }
        if (cg == 0 && !dummy) BON[(size_t)(row0 + tt) * 16 + h] = bon;
    }
    __syncthreads();
    { float x[8];
#pragma unroll
      for (int q = 0; q < 8; ++q) x[q] = LG[(8 * w + q) * 65 + lane];
#pragma unroll
      for (int q = 0; q < 8; ++q) {
          float v = x[q];
          v += __builtin_bit_cast(float, __builtin_amdgcn_update_dpp(0, __builtin_bit_cast(int, v), 0x111, 0xF, 0xF, true));
          v += __builtin_bit_cast(float, __builtin_amdgcn_update_dpp(0, __builtin_bit_cast(int, v), 0x112, 0xF, 0xF, true));
          v += __builtin_bit_cast(float, __builtin_amdgcn_update_dpp(0, __builtin_bit_cast(int, v), 0x114, 0xF, 0xF, true));
          v += __builtin_bit_cast(float, __builtin_amdgcn_update_dpp(0, __builtin_bit_cast(int, v), 0x118, 0xF, 0xF, true));
          v += __builtin_bit_cast(float, __builtin_amdgcn_update_dpp(0, __builtin_bit_cast(int, v), 0x142, 0xA, 0xF, false));
          v += __builtin_bit_cast(float, __builtin_amdgcn_update_dpp(0, __builtin_bit_cast(int, v), 0x143, 0xC, 0xF, false));
          x[q] = v; }
#pragma unroll
      for (int q = 0; q < 8; ++q) LG[(8 * w + q) * 65 + lane] = x[q]; }
    __syncthreads();
    {
        float ah[8], bh[8], kh[8], rh[8];
#pragma unroll
        for (int j = 0; j < 8; ++j) { const float lg = LG[(8 * cg + j) * 65 + tt]; const float G = __expf(lg), Gm1 = G * rd[j], Gi = __builtin_amdgcn_rcpf(G);
            ah[j] = av[j] * Gm1; bh[j] = bv[j] * Gi; kh[j] = kp[j] * Gi; rh[j] = r8[j] * G;
            ((lds_u16*)(lds + CA_BT))[tr_idx(cg, j, tt)] = f2bf1(bh[j]); ((lds_u16*)(lds + CA_KT))[tr_idx(cg, j, tt)] = f2bf1(kh[j]);
            if (tt == 63) GLf[8 * cg + j] = G; }
        *(LAS v4u*)(lds + CA_AH + tt * PBY + 16 * cg) = pack8(ah); *(LAS v4u*)(lds + CA_BH + tt * PBY + 16 * cg) = pack8(bh);
        *(LAS v4u*)(lds + CA_KH + tt * PBY + 16 * cg) = pack8(kh); *(LAS v4u*)(lds + CA_RH + tt * PBY + 16 * cg) = pack8(rh);
    }
    __syncthreads();
    {
        const int mi = w >> 1, ti0 = 2 * (w & 1); const int abase = mi < 2 ? CA_AH : CA_RH, bbase = (mi & 1) ? CA_KH : CA_BH, dbase = CA_AB + mi * 9216;
        bf16x8 af[2][2], bfr[4][2];
#pragma unroll
        for (int a = 0; a < 2; ++a)
#pragma unroll
            for (int ks = 0; ks < 2; ++ks) af[a][ks] = ldsfrag(lds, abase, 16 * (ti0 + a) + fr, ks, fq);
#pragma unroll
        for (int sj = 0; sj < 4; ++sj)
#pragma unroll
            for (int ks = 0; ks < 2; ++ks) bfr[sj][ks] = ldsfrag(lds, bbase, 16 * sj + fr, ks, fq);
#pragma unroll
        for (int a = 0; a < 2; ++a)
#pragma unroll
            for (int sj = 0; sj < 4; ++sj) { const int ti = ti0 + a; f32x4 acc = {0.f, 0.f, 0.f, 0.f};
#pragma unroll
                for (int ks = 0; ks < 2; ++ks) acc = MFMA16(bfr[sj][ks], af[a][ks], acc);
                const int t = 16 * ti + fr;
#pragma unroll
                for (int r = 0; r < 4; ++r) { const int s = 16 * sj + 4 * fq + r; acc[r] = (mi < 2 ? s < t : s <= t) ? acc[r] : 0.f; }
                typedef unsigned u2v_ __attribute__((ext_vector_type(2))); u2v_ pw; pw.x = pkbf(acc[0], acc[1]); pw.y = pkbf(acc[2], acc[3]);
                *(LAS u2v_*)(lds + dbase + (t * 72 + 16 * sj + 4 * fq) * 2) = pw;
                if (mi == 0 && ti == sj) *(LAS f32x4*)(lds + CA_NF + (ti * 256 + fr * 16 + 4 * fq) * 4) = acc; }
    }
    __syncthreads();
    f32x4 rhs[4];
    if (w == 0) { const int blk = fq, c = fr; const LAS float* N = (const LAS float*)(lds + CA_NF) + blk * 256; float T[16];
#pragma unroll
        for (int i = 0; i < 16; ++i) T[i] = (i == c) ? 1.f : 0.f;
#pragma unroll
        for (int j = 0; j < 15; ++j) {
#pragma unroll
            for (int i = j + 1; i < 16; ++i) T[i] += N[i * 16 + j] * T[j]; }
        lds_u16* td = (lds_u16*)(lds + CA_TD) + blk * 512;
#pragma unroll
        for (int i = 0; i < 16; ++i) { td[i * 32 + c] = f2bf1(T[i]); td[i * 32 + 16 + c] = 0; } }
    if (w < 4) {
#pragma unroll
        for (int i = 0; i < 4; ++i)
#pragma unroll
            for (int r = 0; r < 4; ++r) rhs[i][r] = bf1(((lds_u16*)(lds + CA_AH))[(16 * i + 4 * fq + r) * 72 + 16 * w + fr]);
    } else {
#pragma unroll
        for (int i = 0; i < 4; ++i) { f32x4 acc = {0.f, 0.f, 0.f, 0.f};
#pragma unroll
            for (int ks = 0; ks < 2; ++ks) acc = MFMA16(ldsfrag(lds, CA_AK, 16 * i + fr, ks, fq), ldsfrag_sw(lds, CA_VT, 16 * (w - 4) + fr, ks, fq, 1), acc);
            rhs[i] = acc; }
    }
    __syncthreads();
    {
        typedef unsigned u2v __attribute__((ext_vector_type(2)));
#define S5_FRAG(byteoff) ({ const u2v q_ = *(const LAS u2v*)(lds + (byteoff)); const v4u t_ = {q_.x, q_.y, 0u, 0u}; __builtin_bit_cast(bf16x8, t_); })
#define S5_PACK(v) ({ const v4u t_ = {pkbf((v)[0], (v)[1]), pkbf((v)[2], (v)[3]), 0u, 0u}; __builtin_bit_cast(bf16x8, t_); })
        bf16x8 tdf[4], abf[6];
#pragma unroll
        for (int i = 0; i < 4; ++i) tdf[i] = S5_FRAG(CA_TD + i * 1024 + fr * 64 + fq * 8);
        abf[0] = S5_FRAG(CA_AB + (16 + fr) * PBY + (0 + 4 * fq) * 2);
        abf[1] = S5_FRAG(CA_AB + (32 + fr) * PBY + (0 + 4 * fq) * 2);  abf[2] = S5_FRAG(CA_AB + (32 + fr) * PBY + (16 + 4 * fq) * 2);
        abf[3] = S5_FRAG(CA_AB + (48 + fr) * PBY + (0 + 4 * fq) * 2);  abf[4] = S5_FRAG(CA_AB + (48 + fr) * PBY + (16 + 4 * fq) * 2);  abf[5] = S5_FRAG(CA_AB + (48 + fr) * PBY + (32 + 4 * fq) * 2);
        const f32x4 z4 = {0.f, 0.f, 0.f, 0.f};
        const f32x4 x0 = MFMA16(tdf[0], S5_PACK(rhs[0]), z4);                 const bf16x8 xb0 = S5_PACK(x0);
        f32x4 a1 = MFMA16(abf[0], xb0, rhs[1]);
        const f32x4 x1 = MFMA16(tdf[1], S5_PACK(a1), z4);                     const bf16x8 xb1 = S5_PACK(x1);
        f32x4 a2 = MFMA16(abf[1], xb0, rhs[2]); a2 = MFMA16(abf[2], xb1, a2);
        const f32x4 x2 = MFMA16(tdf[2], S5_PACK(a2), z4);                     const bf16x8 xb2 = S5_PACK(x2);
        f32x4 a3 = MFMA16(abf[3], xb0, rhs[3]); a3 = MFMA16(abf[4], xb1, a3); a3 = MFMA16(abf[5], xb2, a3);
        const f32x4 x3 = MFMA16(tdf[3], S5_PACK(a3), z4);
        LAS unsigned char* xrow = lds + CA_XT + (16 * w + fr) * PBY + 8 * fq;
        { u2v p; p.x = pkbf(x0[0], x0[1]); p.y = pkbf(x0[2], x0[3]); *(LAS u2v*)(xrow) = p; }
        { u2v p; p.x = pkbf(x1[0], x1[1]); p.y = pkbf(x1[2], x1[3]); *(LAS u2v*)(xrow + 32) = p; }
        { u2v p; p.x = pkbf(x2[0], x2[1]); p.y = pkbf(x2[2], x2[3]); *(LAS u2v*)(xrow + 64) = p; }
        { u2v p; p.x = pkbf(x3[0], x3[1]); p.y = pkbf(x3[2], x3[3]); *(LAS u2v*)(xrow + 96) = p; }
#undef S5_FRAG
#undef S5_PACK
    }
    __syncthreads();
    if (nchain >= 0) { const size_t no = (size_t)((nchain >> 4) * PT + 64 * nchunk + tt) * D + (nchain & 15) * 64 + 8 * cg;
        pf[0] = *(const v4u*)(Rb + no); pf[1] = *(const v4u*)(Kb + no); pf[2] = *(const v4u*)(Vb + no); pf[3] = *(const v4u*)(Db + no); pf[4] = *(const v4u*)(Ab + no); }
    {
        const int mi = w >> 1, ti0 = 2 * (w & 1); const int obase = mi == 0 ? CA_AB : (mi == 1 ? CA_AK : (mi == 2 ? CA_AH : CA_KH));
        const int a1 = mi < 2 ? CA_RB : (mi == 2 ? CA_BT : CA_XT), a1o = mi == 3 ? 64 : 0, b1 = mi == 3 ? CA_BT : CA_XT, b1o = mi == 1 ? 64 : 0;
        const int a2 = mi == 1 ? CA_RK : CA_VT, b2 = mi == 1 ? CA_VT : CA_KT; const bool two = (mi & 1) != 0;
        const int ma1 = mi == 2 ? 7 : 0, mb1 = mi == 3 ? 7 : 0, ma2 = mi != 1 ? 7 : 0;
        bf16x8 af[2][2], bfr[4][2];
#pragma unroll
        for (int a = 0; a < 2; ++a)
#pragma unroll
            for (int ks = 0; ks < 2; ++ks) af[a][ks] = *(const LAS bf16x8*)(lds + a1 + (a1o + 16 * (ti0 + a) + fr) * PBY + (((ks * 4 + fq) ^ (((2 * (ti0 + a) + (fr >> 3)) & ma1))) << 4));
#pragma unroll
        for (int tj = 0; tj < 4; ++tj)
#pragma unroll
            for (int ks = 0; ks < 2; ++ks) bfr[tj][ks] = *(const LAS bf16x8*)(lds + b1 + (b1o + 16 * tj + fr) * PBY + (((ks * 4 + fq) ^ (((2 * tj + (fr >> 3)) & mb1))) << 4));
        f32x4 acc[2][4];
#pragma unroll
        for (int a = 0; a < 2; ++a)
#pragma unroll
            for (int tj = 0; tj < 4; ++tj) { acc[a][tj] = (f32x4){0.f, 0.f, 0.f, 0.f};
#pragma unroll
                for (int ks = 0; ks < 2; ++ks) acc[a][tj] = MFMA16(bfr[tj][ks], af[a][ks], acc[a][tj]); }
        if (two) {
#pragma unroll
            for (int a = 0; a < 2; ++a)
#pragma unroll
                for (int ks = 0; ks < 2; ++ks) af[a][ks] = *(const LAS bf16x8*)(lds + a2 + (16 * (ti0 + a) + fr) * PBY + (((ks * 4 + fq) ^ (((2 * (ti0 + a) + (fr >> 3)) & ma2))) << 4));
#pragma unroll
            for (int tj = 0; tj < 4; ++tj)
#pragma unroll
                for (int ks = 0; ks < 2; ++ks) bfr[tj][ks] = ldsfrag_sw(lds, b2, 16 * tj + fr, ks, fq, 1);
#pragma unroll
            for (int a = 0; a < 2; ++a)
#pragma unroll
                for (int tj = 0; tj < 4; ++tj)
#pragma unroll
                    for (int ks = 0; ks < 2; ++ks) acc[a][tj] = MFMA16(bfr[tj][ks], af[a][ks], acc[a][tj]);
        }
#pragma unroll
        for (int a = 0; a < 2; ++a) { const int row = 16 * (ti0 + a) + fr; const float glr = GLf[row];
#pragma unroll
            for (int tj = 0; tj < 4; ++tj) { const int col = 16 * tj + 4 * fq; f32x4 val = acc[a][tj];
                typedef unsigned u2v_ __attribute__((ext_vector_type(2)));
                if (mi == 0) { const u2v_ rr = *(const LAS u2v_*)(lds + CA_RH + (row * 72 + col) * 2); val += (f32x4){bflo(rr.x), bfhi(rr.x), bflo(rr.y), bfhi(rr.y)}; }
                else if (mi == 2) {
#pragma unroll
                    for (int r = 0; r < 4; ++r) val[r] = glr * (val[r] + (row == col + r ? 1.f : 0.f)); }
                else if (mi == 3) val = val * *(const LAS f32x4*)(GLf + col);
                u2v_ pw; pw.x = pkbf(val[0], val[1]); pw.y = pkbf(val[2], val[3]);
                *(LAS u2v_*)(lds + obase + (row * 72 + col) * 2) = pw; } }
    }
    __syncthreads();
    *(v4u*)((dummy ? dummy : Rb) + goff) = *(const LAS v4u*)(lds + CA_AB + tt * PBY + 16 * cg);
    *(v4u*)((dummy ? dummy : Ab) + goff) = *(const LAS v4u*)(lds + CA_AK + tt * PBY + 16 * cg);
    *(v4u*)((dummy ? dummy : Kb) + goff) = *(const LAS v4u*)(lds + CA_AH + tt * PBY + 16 * cg);
    *(v4u*)((dummy ? dummy : Db) + goff) = *(const LAS v4u*)(lds + CA_KH + tt * PBY + 16 * cg);
    __syncthreads();
}
constexpr int CB_S = 0, CB_P2 = 9216, CB_P3 = 18432, CB_Y0 = 27648, CB_Z0 = 36864, CB_YS = 46080  ;
__device__ __forceinline__ void rwkv_state_chain(const Frame& F, int chain, float* ST, const bf16* Rb, const bf16* Kb, const bf16* Vb, const bf16* Db, const bf16* Ab, bf16* Gb, const float* BON, const float* gn_w, const float* gn_b, bf16* dummy) {
    LAS unsigned char* lds = F.lds;
    const int tid = F.tid, lane = F.lane, w = F.wave, fr = lane & 15, fq = lane >> 4, cg = tid & 7, tt = tid >> 3;
    const int h = chain & 15, rowc0 = (chain >> 4) * PT, ch = h * 64 + 8 * cg;
    for (int i = tid; i < 64 * 36; i += 512) ((LAS unsigned*)(lds + CB_S))[i] = 0u;
    f32x4 Sacc[2];
    Sacc[0] = (f32x4){0.f, 0.f, 0.f, 0.f}; Sacc[1] = Sacc[0];
    v4u q2, q3, qy, qz, qg, qb; float qbon;
    float cgw[8], cgb[8];
#pragma unroll
    for (int j = 0; j < 8; ++j) { cgw[j] = gn_w[ch + j]; cgb[j] = gn_b[ch + j]; }
#define CB_LOAD(cc) do { const size_t o_ = (size_t)(rowc0 + 64 * (cc) + tt) * D + ch; q2 = *(const v4u*)(Rb + o_); q3 = *(const v4u*)(Kb + o_); qy = *(const v4u*)(Ab + o_); qz = *(const v4u*)(Db + o_); \
        qg = *(const v4u*)(Gb + o_); qb = *(const v4u*)(Vb + o_); qbon = BON[(size_t)(rowc0 + 64 * (cc) + tt) * 16 + h]; } while (0)
    CB_LOAD(0);
    for (int c = 0; c < PT / 64; ++c) {
        *(LAS v4u*)(lds + CB_P2 + tt * PBY + 16 * cg) = q2; *(LAS v4u*)(lds + CB_P3 + tt * PBY + 16 * cg) = q3;
        *(LAS v4u*)(lds + CB_Y0 + tt * PBY + 16 * cg) = qy; *(LAS v4u*)(lds + CB_Z0 + tt * PBY + 16 * cg) = qz;
        float gw[8], gb[8]; unpack8(qg, gw); unpack8(qb, gb);
        const float bonc = qbon;
        if (c + 1 < PT / 64) CB_LOAD(c + 1);
        __syncthreads();
        f32x4 yacc[2];
        typedef unsigned u2v_ __attribute__((ext_vector_type(2)));
#pragma unroll
        for (int q = 0; q < 2; ++q) { const int tq = 2 * w + q, ti = tq >> 2, tj = tq & 3, row = 16 * ti + fr, col = 16 * tj + 4 * fq;
            const u2v_ y0 = *(const LAS u2v_*)(lds + CB_Y0 + (row * 72 + col) * 2), z0 = *(const LAS u2v_*)(lds + CB_Z0 + (row * 72 + col) * 2);
            f32x4 ya = {bflo(y0.x), bfhi(y0.x), bflo(y0.y), bfhi(y0.y)}, sa = {bflo(z0.x), bfhi(z0.x), bflo(z0.y), bfhi(z0.y)};
#pragma unroll
            for (int ks = 0; ks < 2; ++ks) { ya = MFMA16(ldsfrag(lds, CB_S, 16 * tj + fr, ks, fq), ldsfrag(lds, CB_P2, 16 * ti + fr, ks, fq), ya);
                                             sa = MFMA16(ldsfrag(lds, CB_P3, 16 * tj + fr, ks, fq), ldsfrag(lds, CB_S, 16 * ti + fr, ks, fq), sa); }
            yacc[q] = ya; Sacc[q] = sa; }
        __syncthreads();
#pragma unroll
        for (int q = 0; q < 2; ++q) { const int tq = 2 * w + q, ti = tq >> 2, tj = tq & 3, row = 16 * ti + fr, col = 16 * tj + 4 * fq;
            u2v_ pw; pw.x = pkbf(Sacc[q][0], Sacc[q][1]); pw.y = pkbf(Sacc[q][2], Sacc[q][3]);
            *(LAS u2v_*)(lds + CB_S + (row * 72 + col) * 2) = pw;
            *(LAS f32x4*)(lds + CB_YS + (row * 64 + col) * 4) = yacc[q]; }
        __syncthreads();
        { const f32x4 y0 = *(const LAS f32x4*)(lds + CB_YS + (tt * 64 + 8 * cg) * 4), y1 = *(const LAS f32x4*)(lds + CB_YS + (tt * 64 + 8 * cg + 4) * 4);
          float yy[8] = {y0.x, y0.y, y0.z, y0.w, y1.x, y1.y, y1.z, y1.w}; float s1 = 0.f;
#pragma unroll
          for (int j = 0; j < 8; ++j) s1 += yy[j];
          const float mean = red8(s1) * (1.f / 64.f); float s2 = 0.f;
#pragma unroll
          for (int j = 0; j < 8; ++j) { yy[j] -= mean; s2 += yy[j] * yy[j]; }
          const float rstd = __builtin_amdgcn_rsqf(red8(s2) * (1.f / 64.f) + GN_EPS);
          float o[8];
#pragma unroll
          for (int j = 0; j < 8; ++j) o[j] = ((yy[j] * rstd) * cgw[j] + cgb[j] + bonc * gb[j]) * gw[j];
          *(v4u*)((dummy ? dummy : Gb) + (size_t)(rowc0 + 64 * c + tt) * D + ch) = pack8(o); }
    }
#undef CB_LOAD
#pragma unroll
    for (int q = 0; q < 2; ++q) { const int tq = 2 * w + q, ti = tq >> 2, tj = tq & 3; *(f32x4*)(ST + (16 * ti + fr) * 64 + 16 * tj + 4 * fq) = Sacc[q]; }
    __syncthreads();
}

#ifndef MK_N_LAUNCHES
#define MK_N_LAUNCHES 1
#endif
constexpr int N_PHASES = 22;
#ifndef PROBE_PH
#define PROBE_PH (-1)
#define PROBE_N 1
#endif
#ifndef PROBE_VAR
#define PROBE_VAR 0
#endif
#ifndef EN_MASK
#define EN_MASK 0xff
#endif
constexpr bool EN_NORM = EN_MASK & 1, EN_UP = EN_MASK & 2, EN_RES = EN_MASK & 4, EN_RW = EN_MASK & 8, EN_L2 = EN_MASK & 16, EN_SCAN = EN_MASK & 32, EN_IN = EN_MASK & 64, EN_ML = EN_MASK & 128;
struct Args { const float* in[N_IN]; float* out; unsigned char* ws; int ph_lo, ph_hi; };
__global__ void __launch_bounds__(NWAVES * 64, 2) mega_fwd(Args args) {
    extern __shared__ __attribute__((aligned(16))) unsigned char lds_raw[];
    { const int t0 = threadIdx.x;
      for (int u = t0; u < (LDS_BYTES - LDSCTL_OFF) / 4; u += NWAVES * 64) ((LAS unsigned*)((LAS unsigned char*)lds_raw + LDSCTL_OFF))[u] = 0u; }
    __syncthreads();
    { const int t0 = threadIdx.x; if (t0 < N_IN) ((LAS unsigned long long*)((LAS unsigned char*)lds_raw + TAB_OFF))[t0] = (unsigned long long)args.in[t0]; }
    __syncthreads();
    XcdBarrier bar; bar.bar = (unsigned*)((gu32*)(args.ws + WS_CTL) + CW_BAR); bar.x = 0; bar.st = nullptr;
    if (args.ph_hi - args.ph_lo > 1) bar = xcd_barrier_post((unsigned*)((gu32*)(args.ws + WS_CTL) + CW_BAR), (volatile LAS unsigned*)((LAS unsigned char*)lds_raw + MISC_OFF) + 8);
    int ph = args.ph_lo, rep = 0;
    while (ph < args.ph_hi) {
        int tid_ = threadIdx.x; asm volatile("" : "+v"(tid_));
        unsigned char* ws = args.ws; float* out = args.out;
        Frame F;
        F.lds = (LAS unsigned char*)lds_raw;
        F.MISC = (volatile LAS unsigned*)(F.lds + MISC_OFF);
        F.tid = tid_; F.lane = F.tid & 63; F.wave = __builtin_amdgcn_readfirstlane(F.tid >> 6);
        F.G = gridDim.x; { const int bx = blockIdx.x; F.vcu = (F.G % 8 == 0) ? (bx % 8) * (F.G / 8) + bx / 8 : bx; }
        F.ctl = (gu32*)(ws + WS_CTL); F.tab = (volatile LAS unsigned long long*)(F.lds + TAB_OFF);
        bf16* Wb = (bf16*)(ws + WS_W); bf16* XR = (bf16*)(ws + WS_XR); unsigned char* big = ws + WS_BIG;
        bf16* Hb = (bf16*)(big + B_H); bf16* XN = (bf16*)(big + B_XN); float* SLAB = (float*)(big + B_SLAB);
        bf16* ACAT = (bf16*)(big + B_ACAT); bf16* Rb = (bf16*)(big + B_R); bf16* Kb = (bf16*)(big + B_K); bf16* Vb = (bf16*)(big + B_V); bf16* DECb = (bf16*)(big + B_DEC); bf16* AAb = (bf16*)(big + B_AA);
        bf16* QKR = (bf16*)(big + B_QKR); bf16* VVb = (bf16*)(big + B_VV); bf16* HOb = (bf16*)(big + B_HO); bf16* OOb = (bf16*)(big + B_OO); float* IFb = (float*)(big + B_IF);
        bf16* GGb = (bf16*)((unsigned char*)out + OS_GG); bf16* LORA = (bf16*)((unsigned char*)out + OS_LORA);
        const int c_id = (int)blockIdx.x;
        const int nrep = (ph == PROBE_PH && ph != 6 && !(ph == 16 && PROBE_VAR != 0)) ? PROBE_N : 1;
        const int pvar = (rep + 1 < nrep) ? PROBE_VAR : 0;
        if (EN_NORM && (ph == 0 || ph == 3 || ph == 8 || ph == 11 || ph == 14 || ph == 18 || ph == 21)) {
            int kind = 0, layer = 0, ab = 0, nslab = 0; float coef = 0.5f; const float* gain = nullptr;
            if (ph == 0) { kind = 0; layer = 0; ab = 0; gain = inptr(F, I_NFA); nslab = 0; }
            else if (ph == 3) { kind = 1; gain = inptr(F, I_NMIX); nslab = 11; }
            else if (ph == 8) { kind = 0; layer = 0; ab = 1; gain = inptr(F, I_NFB); nslab = 4; coef = 1.f; }
            else if (ph == 11) { kind = 0; layer = 1; ab = 0; gain = inptr(F, I_NFA) + D; nslab = 11; }
            else if (ph == 14) { kind = 2; gain = inptr(F, I_NMIX) + D; nslab = 11; }
            else if (ph == 18) { kind = -1; gain = inptr(F, I_NFB) + D; nslab = 4; coef = 1.f; }
            else { kind = -1; gain = inptr(F, I_NFIN); nslab = 11; }
            if (kind >= 0) convert_weights(F, kind, layer, ab, Wb);
            if (ph == 0) norm_rows<0, true, true>(F, inptr(F, I_XP), inptr(F, I_XS), nslab, coef, SLAB, XR, gain, XN, nullptr, out, pvar);
            else if (ph == 3) mix_rows(F, XR, inptr(F, I_XS), nslab, coef, SLAB, XR, gain, inptr(F, I_MU), (bf16*)(ws + WS_XM), inptr(F, I_RSHIFT), out, pvar);
            else if (ph == 21) norm_rows<2, false, false>(F, XR, XR + (size_t)MP * D, nslab, coef, SLAB, XR, gain, nullptr, nullptr, out, pvar);
            else norm_rows<0, false, false>(F, XR, XR + (size_t)MP * D, nslab, coef, SLAB, XR, gain, XN, nullptr, out, pvar);
        } else if (EN_UP && (ph == 1 || ph == 9 || ph == 12 || ph == 19)) {
            const bf16* Wu = ph == 19 ? (const bf16*)(ws + WS_W2) : Wb;
            pg8::Gemm g{XN, Wu + W_GU / 2, M, 2 * FF, D}; pg8::UnitOrder S; S.init(M / 256, 2 * FF / 256, D, F.G, c_id, 0);
            EpiSwiglu E{Hb, pvar};
            pg8::gemm_phase<EpiSwiglu, pg8::UnitOrder, true, true>(F.lds, g, S, E, F.tid);
        } else if (EN_RES && (ph == 2 || ph == 7 || ph == 10 || ph == 13 || ph == 17 || ph == 20)) {
            const bf16* A = Hb; const bf16* Bt = (ph == 20 ? (const bf16*)(ws + WS_W2) : Wb) + W_D / 2; int K = FF; float coef = 0.5f; const float* basef = nullptr;
            if (ph == 2) basef = inptr(F, I_XP);
            if (ph == 7) { A = GGb; Bt = Wb + W_O / 2; K = D; coef = 1.f; }
            if (ph == 17) { A = HOb; Bt = Wb + W_OUT / 2; K = D; coef = 1.f; }
            pg8::Gemm g{A, Bt, M, D, K}; pg8::UnitOrder S; S.init(MP / 256, D / 256, K, F.G, c_id, K / 256);
            EpiRes E{basef, XR, XR, SLAB, coef};
            pg8::gemm_phase<EpiRes, pg8::UnitOrder, true, true>(F.lds, g, S, E, F.tid);
        } else if (EN_RW && ph == 4) {
            pg8::Gemm g{(const bf16*)(ws + WS_XM), Wb + W_RW / 2, 6 * M, NRW2, D}; pg8::UnitOrder S; S.init(M / 256, NRW2 / 256, D, F.G, c_id, -2);
            EpiRw E{Rb, Kb, Vb, LORA};
            pg8::gemm_phase<EpiRw, pg8::UnitOrder, true, true>(F.lds, g, S, E, F.tid);
        } else if (EN_L2 && ph == 5) {
            pg8::Gemm g{LORA, Wb + W_L2 / 2, M, NL2, KL2}; pg8::UnitOrder S; S.init(M / 256, NL2 / 256, KL2, F.G, c_id, -1);
            EpiL2 E{DECb, AAb, GGb, inptr(F, I_W0), inptr(F, I_A0)};
            pg8::gemm_phase<EpiL2, pg8::UnitOrder, true, true>(F.lds, g, S, E, F.tid);
        } else if (EN_SCAN && ph == 6) {
            bf16* dummy = (bf16*)(ws + WS_YRAW);
            for (int dr = (PROBE_PH == 6 && PROBE_VAR == 5) ? PROBE_N - 1 : 0; dr >= 0; --dr) {
                v4u pf[6]; pf[5] = (v4u){0u, 0u, 0u, 0u};
                { const int it = F.vcu, cg_ = F.tid & 7, tt_ = F.tid >> 3; const size_t o = (size_t)(((it >> 5) >> 4) * PT + 64 * (it & 31) + tt_) * D + ((it >> 5) & 15) * 64 + 8 * cg_;
                  pf[0] = *(const v4u*)(Rb + o); pf[1] = *(const v4u*)(Kb + o); pf[2] = *(const v4u*)(Vb + o); pf[3] = *(const v4u*)(DECb + o); pf[4] = *(const v4u*)(AAb + o); }
                for (int it = F.vcu; it < PB * 16 * (PT / 64); it += F.G) { const int nx = it + F.G < PB * 16 * (PT / 64) ? it + F.G : -1;
                    rwkv_chunk_item(F, it >> 5, it & 31, Rb, Kb, Vb, DECb, AAb, GGb, inptr(F, I_KK), inptr(F, I_KA), inptr(F, I_RK), (float*)(ws + WS_BON), dr ? dummy : nullptr, pf, nx < 0 ? -1 : nx >> 5, nx & 31); }
            }
            xcd_barrier(bar);
            for (int dr = (PROBE_PH == 6 && PROBE_VAR == 6) ? PROBE_N - 1 : 0; dr >= 0; --dr)
                if (F.vcu < 128) rwkv_state_chain(F, F.vcu, out + O_P_S + (size_t)F.vcu * 4096, Rb, Kb, Vb, DECb, AAb, GGb, (const float*)(ws + WS_BON), inptr(F, I_GNW), inptr(F, I_GNB), dr ? dummy : nullptr);
            { const int i0 = F.vcu < 128 ? 2 * F.vcu : 256 + 14 * (F.vcu - 128), i1 = F.vcu < 128 ? i0 + 2 : i0 + 14;
              for (int i = i0; i < i1; ++i) { const int b = i >> 4, h = i & 15;
                  rwkv_chain(F, MP + b * STK, STK, h, inptr(F, I_RS) + (size_t)i * 4096, out + O_S_S + (size_t)i * 4096, Rb, Kb, Vb, DECb, AAb, GGb, inptr(F, I_KK), inptr(F, I_KA), inptr(F, I_RK), inptr(F, I_GNW), inptr(F, I_GNB), true, 0); } }
        } else if (EN_IN && ph == 15) {
            pg8::Gemm g{XN, Wb + W_IN / 2, M, NIN, D}; pg8::UnitOrder S; S.init(M / 256, NIN / 256, D, F.G, c_id, 0);
            EpiIn E{QKR, VVb, OOb, IFb, inptr(F, I_BIF), pvar};
            pg8::gemm_phase<EpiIn, pg8::UnitOrder, true, true>(F.lds, g, S, E, F.tid);
        } else if (EN_ML && ph == 16) {
            float* NUM = out + O_Y; float* DEN = (float*)(ws + WS_BON); bf16* Qs = (bf16*)(big + 100 * MiB)  ; float* SEG = (float*)(ws + WS_YRAW);
            for (int i = F.vcu; i < PB * 8 * ML_NSEG * ((PROBE_PH == 16 && PROBE_VAR == 1) ? PROBE_N : 1); i += F.G) { const int chain = i & 63, seg = (i >> 6) & 3;
                mlstm_prompt_chain(F, chain >> 3, chain & 7, seg, QKR, VVb, OOb, IFb, HOb, inptr(F, I_CW), inptr(F, I_CB), inptr(F, I_MNW), NUM, DEN, Qs, SEG, 0); }
            xcd_barrier(bar);
            for (int i = F.vcu; i < 256 * ((PROBE_PH == 16 && PROBE_VAR == 2) ? PROBE_N : 1) - 64; i += F.G) { const int chain = i & 63, seg = 1 + ((i >> 6) & 3); if (seg > 3) continue;
                mlstm_fix_seg(F, chain >> 3, chain & 7, seg, QKR, OOb, IFb, HOb, inptr(F, I_MNW), NUM, DEN, Qs, SEG, out); }
            if (F.G == 256) {
                if (F.vcu >= 192) { for (int j = 0; j < 9; ++j) { const int i = (F.vcu - 192) * 9 + j;
                    mlstm_sample_item(F, i >> 3, i & 7, QKR, VVb, OOb, IFb, HOb, inptr(F, I_CW), inptr(F, I_CB), inptr(F, I_MNW), inptr(F, I_MC), inptr(F, I_MN), inptr(F, I_MM), inptr(F, I_MCONV), out); } }
                else { for (int i = 576 + F.vcu; i < SB * 8; i += 192)
                    mlstm_sample_item(F, i >> 3, i & 7, QKR, VVb, OOb, IFb, HOb, inptr(F, I_CW), inptr(F, I_CB), inptr(F, I_MNW), inptr(F, I_MC), inptr(F, I_MN), inptr(F, I_MM), inptr(F, I_MCONV), out); }
            } else {
                for (int i = F.vcu; i < SB * 8; i += F.G)
                    mlstm_sample_item(F, i >> 3, i & 7, QKR, VVb, OOb, IFb, HOb, inptr(F, I_CW), inptr(F, I_CB), inptr(F, I_MNW), inptr(F, I_MC), inptr(F, I_MN), inptr(F, I_MM), inptr(F, I_MCONV), out);
            }
            if (rep + 1 == nrep) convert_weights(F, 0, 1, 1, (bf16*)(ws + WS_W2));
        }
        if (++rep < nrep) continue;
        rep = 0;
        if (ph + 1 < args.ph_hi) xcd_barrier(bar);
        ++ph;
    }
}

extern "C" void kernel_launch(void* const* d_in, const int* in_sizes, int n_in, void* d_out, int out_size, void* d_ws, size_t ws_size, hipStream_t stream) {
    static int grid = 0;
    if (grid == 0) {
        if (n_in != N_IN || out_size != (int)O_END || ws_size < WS_END3) { fprintf(stderr, "kernel_launch: unexpected shapes (n_in %d, out %d, ws %zu); nothing launched\n", n_in, out_size, ws_size); grid = -1; return; }
        int dev = 0, cus = 0, per_cu = 0;
        if (hipGetDevice(&dev) != hipSuccess || hipDeviceGetAttribute(&cus, hipDeviceAttributeMultiprocessorCount, dev) != hipSuccess) { grid = -1; return; }
        if (hipFuncSetAttribute((const void*)mega_fwd, hipFuncAttributeMaxDynamicSharedMemorySize, LDS_BYTES) != hipSuccess) { fprintf(stderr, "kernel_launch: hipFuncSetAttribute failed\n"); grid = -1; return; }
        if (hipOccupancyMaxActiveBlocksPerMultiprocessor(&per_cu, (const void*)mega_fwd, NWAVES * 64, LDS_BYTES) != hipSuccess || per_cu < 1) { fprintf(stderr, "kernel_launch: occupancy query says %d\n", per_cu); per_cu = 1; }
        (void)hipGetLastError();
        grid = cus;
    }
    if (grid < 0) return;
    (void)hipMemsetAsync((char*)d_ws + WS_CTL, 0, CTL_ZERO_BYTES, stream);
    Args a{};
    for (int i = 0; i < N_IN; ++i) a.in[i] = (const float*)d_in[i];
    a.out = (float*)d_out; a.ws = (unsigned char*)d_ws;
#if MK_N_LAUNCHES == 1
    a.ph_lo = 0; a.ph_hi = N_PHASES;
    { void* kargs[] = {(void*)&a};
      const hipError_t e = hipLaunchCooperativeKernel((const void*)mega_fwd, dim3(grid), dim3(NWAVES * 64), kargs, LDS_BYTES, stream);
      if (e != hipSuccess) fprintf(stderr, "kernel_launch: cooperative launch failed: %s (grid %d)\n", hipGetErrorString(e), grid); }
#else
    for (int p = 0; p < N_PHASES; ++p) { a.ph_lo = p; a.ph_hi = p + 1; hipLaunchKernelGGL(mega_fwd, dim3(grid), dim3(NWAVES * 64), LDS_BYTES, stream, a); }
#endif
}
```

```cpp
#include <hip/hip_runtime.h>
#include <cstdio>
#include <cstdint>
namespace pg8 {
#define PG8_LAS __attribute__((address_space(3)))
typedef unsigned short bf16_t;
typedef short bf16x8 __attribute__((ext_vector_type(8)));
typedef float f32x4 __attribute__((ext_vector_type(4)));
typedef unsigned u32x4 __attribute__((ext_vector_type(4)));
constexpr int BM = 256, BK = 64, HALF = 128, HTB = HALF * BK * 2  , STAGE_BYTES = 8 * HTB, NXCD = 8, WGM = 8;

__host__ __device__ __forceinline__ int lds_byte(int r, int c) { const int st = (r >> 4) * 2 + (c >> 5), rr = r & 15, cc = c & 31, ob = rr * 64 + cc * 2; return st * 1024 + (ob ^ (((ob >> 9) & 1) << 5)); }
__host__ __device__ __forceinline__ void stage_rc(int b, int& R, int& C) { const int st = b / 1024, sb = b % 1024, swz = sb ^ (((sb >> 9) & 1) << 5); R = (st >> 1) * 16 + swz / 64; C = (st & 1) * 32 + (swz % 64) / 2; }
__host__ __device__ __forceinline__ int perm32(int rho) { const int n = rho >> 4, i = rho & 15; return 8 * (i >> 2) + 4 * n + (i & 3); }

struct Unit { int pm, pn, k0, nt, slab; };
struct Gemm { const bf16_t* A; const bf16_t* Bt; int M, N, K; };

struct UnitOrder {
    int nM, nN, nwg, G, c, ntf, tailS;
    __device__ __forceinline__ void init(int nM_, int nN_, int K, int G_, int c_, int tailS_) { nM = nM_; nN = nN_; nwg = nM * nN; G = G_; c = c_; ntf = K / BK; tailS = tailS_; }
    __device__ __forceinline__ bool next(int i, Unit& u) const {
        long L = (long)i * G + c;
        if (L < nwg) {
            int wgid = (int)L; { const int q = nwg / NXCD, r = nwg % NXCD, xcd = wgid % NXCD, off = wgid / NXCD; wgid = (xcd < r ? xcd * (q + 1) : r * (q + 1) + (xcd - r) * q) + off; }
            const int nig = WGM * nN, gid = wgid / nig, fm = gid * WGM, gsz = (nM - fm) < WGM ? (nM - fm) : WGM;
            u.pm = fm + ((wgid % nig) % gsz); u.pn = (wgid % nig) / gsz; u.k0 = 0; u.nt = ntf; u.slab = -1;
            if (tailS == -2) u.pm += nM * (u.pn < 12 ? (u.pn >> 2) : u.pn - 9);
            if (tailS == -1) { u.nt = 4; u.k0 = u.pn >= 8 ? 128 : 0; }
            return true;
        }
        L -= nwg; if (tailS <= 0 || L >= 8 * tailS) return false;
        int tile, sl; if (tailS == 4) { tile = (int)L >> 2; sl = (int)L & 3; } else { tile = (int)L / 11; sl = (int)L - 11 * tile; }
        u.pm = 64 + (tile >> 2); u.pn = tile & 3; u.k0 = sl * 256; u.nt = 4; u.slab = sl; return true;
    }
    __device__ __forceinline__ void a_ready(const Unit&) const {}
    __device__ __forceinline__ void done(const Unit&) const {}
};
template <class Epi, class Sched, bool ALIGN_EPI = false, bool SP2 = false>
__device__ __forceinline__ void gemm_phase(PG8_LAS unsigned char* lds, const Gemm g, const Sched& S, const Epi& E, const int tid) {
    const int wid = __builtin_amdgcn_readfirstlane(tid >> 6), lane = tid & 63, wr = wid >> 2, wc = wid & 3, fr = lane & 15, fq = lane >> 4;
    const int K = g.K;
    unsigned voffA[2], voffB[2];
#pragma unroll
    for (int i = 0; i < 2; ++i) { int R, C; stage_rc(tid * 16 + i * 8192, R, C); const int Rb = Epi::PERM ? ((R & ~31) + perm32(R & 31)) : R;
        voffA[i] = (unsigned)(R * K + C) * 2u; voffB[i] = (unsigned)(Rb * K + C) * 2u; }
    const size_t kstep = (size_t)(BK * 2);
    const size_t hstep = (size_t)HALF * K * 2;
    const size_t tstep = 2 * hstep;
    const unsigned ldsw = (unsigned)wid * 1024u;
    const int aoff = lds_byte(wr * 64 + fr, fq * 8), boff = lds_byte(wc * 32 + fr, fq * 8);
#define PG8_SA(b, h) (((b) * 2 + (h)) * HTB)
#define PG8_SB(b, h) ((4 + (b) * 2 + (h)) * HTB)
#define PG8_STAGE(bufoff, gbase, voff) do { _Pragma("unroll") for (int _i = 0; _i < 2; ++_i) \
        __builtin_amdgcn_global_load_lds((const unsigned*)((const char*)(gbase) + (voff)[_i]), (PG8_LAS unsigned*)(lds + (bufoff) + ldsw + _i * 8192), 16, 0, 0); } while (0)
#define PG8_LDA(dst, b, h) do { _Pragma("unroll") for (int m = 0; m < 4; ++m) _Pragma("unroll") for (int k = 0; k < 2; ++k) dst[m][k] = *(const PG8_LAS bf16x8*)(lds + PG8_SA(b, h) + aoff + m * 2048 + k * 1024); } while (0)
#define PG8_LDB(dst, b, h) do { _Pragma("unroll") for (int n = 0; n < 2; ++n) _Pragma("unroll") for (int k = 0; k < 2; ++k) dst[n][k] = *(const PG8_LAS bf16x8*)(lds + PG8_SB(b, h) + boff + n * 2048 + k * 1024); } while (0)
#define PG8_MMA(ai, bj, At, Bt) do { __builtin_amdgcn_s_setprio(1); _Pragma("unroll") for (int m = 0; m < 4; ++m) _Pragma("unroll") for (int n = 0; n < 2; ++n) _Pragma("unroll") for (int k = 0; k < 2; ++k) \
        acc[ai][bj][m][n] = __builtin_amdgcn_mfma_f32_16x16x32_bf16(Bt[n][k], At[m][k], acc[ai][bj][m][n], 0, 0, 0); __builtin_amdgcn_s_setprio(0); } while (0)
#define PG8_WAIT_V(n) asm volatile("s_waitcnt vmcnt(" #n ")" ::: "memory")
#define PG8_WAIT_L(n) asm volatile("s_waitcnt lgkmcnt(" #n ")" ::: "memory")
#define PG8_BAR __builtin_amdgcn_s_barrier()
#define PG8_SCHED __builtin_amdgcn_sched_barrier(0)
    Unit cur, nxt; int ui = 0;
    if (!S.next(0, cur)) return;
    f32x4 acc[2][2][4][2];
#pragma unroll
    for (int a = 0; a < 2; ++a)
#pragma unroll
        for (int b = 0; b < 2; ++b)
#pragma unroll
            for (int m = 0; m < 4; ++m)
#pragma unroll
                for (int n = 0; n < 2; ++n) acc[a][b][m][n] = (f32x4){0.f, 0.f, 0.f, 0.f};
    bf16x8 At[4][2], B0[2][2], B1[2][2];
    const char* cA = (const char*)g.A + (size_t)cur.pm * tstep + (size_t)cur.k0 * 2; const char* cB = (const char*)g.Bt + (size_t)cur.pn * tstep + (size_t)cur.k0 * 2;
    S.a_ready(cur);
    if constexpr (SP2) {
        PG8_STAGE(PG8_SB(0, 0), cB, voffB); PG8_STAGE(PG8_SB(0, 1), cB + hstep, voffB); PG8_STAGE(PG8_SA(0, 0), cA, voffA); PG8_STAGE(PG8_SA(0, 1), cA + hstep, voffA);
        if (wr == 1) PG8_BAR;
        PG8_WAIT_V(2); PG8_BAR;
        PG8_STAGE(PG8_SB(1, 0), cB + kstep, voffB); PG8_STAGE(PG8_SA(1, 0), cA + kstep, voffA); PG8_STAGE(PG8_SB(1, 1), cB + hstep + kstep, voffB);
        PG8_WAIT_V(6); PG8_BAR;
    } else {
        PG8_STAGE(PG8_SB(0, 0), cB, voffB); PG8_STAGE(PG8_SA(0, 0), cA, voffA); PG8_STAGE(PG8_SB(0, 1), cB + hstep, voffB); PG8_STAGE(PG8_SA(0, 1), cA + hstep, voffA);
        if (wr == 1) PG8_BAR;
        PG8_WAIT_V(4); PG8_BAR;
        PG8_STAGE(PG8_SB(1, 0), cB + kstep, voffB); PG8_STAGE(PG8_SA(1, 0), cA + kstep, voffA); PG8_STAGE(PG8_SB(1, 1), cB + hstep + kstep, voffB);
        PG8_WAIT_V(6); PG8_BAR;
    }
    for (;;) {
        const bool has_next = S.next(ui + 1, nxt);
        const char* nA = has_next ? (const char*)g.A + (size_t)nxt.pm * tstep + (size_t)nxt.k0 * 2 : cA; const char* nB = has_next ? (const char*)g.Bt + (size_t)nxt.pn * tstep + (size_t)nxt.k0 * 2 : cB;
        const int nt = cur.nt;
        for (int t = 0; t < nt; t += 2) {
            const bool last = (t == nt - 2);
            const char* a1 = cA + (size_t)(t + 1) * kstep;
            const char* a2 = last ? nA : cA + (size_t)(t + 2) * kstep; const char* b2 = last ? nB : cB + (size_t)(t + 2) * kstep;
            const char* a3 = a2 + kstep; const char* b3 = b2 + kstep;
            if (last && has_next) S.a_ready(nxt);
            if constexpr (SP2) {
            PG8_LDB(B0, 0, 0); PG8_LDB(B1, 0, 1); PG8_SCHED; PG8_LDA(At, 0, 0); PG8_STAGE(PG8_SA(1, 1), a1 + hstep, voffA);
            PG8_WAIT_V(8); PG8_WAIT_L(0); PG8_BAR; PG8_MMA(0, 0, At, B0); PG8_MMA(0, 1, At, B1); PG8_BAR; PG8_SCHED;
            PG8_LDA(At, 0, 1); PG8_STAGE(PG8_SB(0, 0), b2, voffB); PG8_STAGE(PG8_SB(0, 1), b2 + hstep, voffB); PG8_STAGE(PG8_SA(0, 0), a2, voffA);
            PG8_WAIT_V(8); PG8_WAIT_L(0); PG8_BAR; PG8_MMA(1, 0, At, B0); PG8_MMA(1, 1, At, B1); PG8_BAR; PG8_SCHED;
            PG8_LDB(B0, 1, 0); PG8_LDB(B1, 1, 1); PG8_SCHED; PG8_LDA(At, 1, 0); PG8_STAGE(PG8_SA(0, 1), a2 + hstep, voffA);
            PG8_WAIT_V(8); PG8_WAIT_L(0); PG8_BAR; PG8_MMA(0, 0, At, B0); PG8_MMA(0, 1, At, B1); PG8_BAR; PG8_SCHED;
            PG8_LDA(At, 1, 1); PG8_STAGE(PG8_SB(1, 0), b3, voffB); PG8_STAGE(PG8_SB(1, 1), b3 + hstep, voffB); PG8_STAGE(PG8_SA(1, 0), a3, voffA);
            PG8_WAIT_V(8); PG8_WAIT_L(0); PG8_BAR; PG8_MMA(1, 0, At, B0); PG8_MMA(1, 1, At, B1); PG8_BAR; PG8_SCHED;
            } else {
            PG8_LDB(B0, 0, 0); PG8_SCHED; PG8_LDA(At, 0, 0); PG8_STAGE(PG8_SA(1, 1), a1 + hstep, voffA);
            PG8_WAIT_L(8); PG8_BAR; PG8_WAIT_L(0); PG8_MMA(0, 0, At, B0); PG8_BAR; PG8_SCHED;
            PG8_LDB(B1, 0, 1); PG8_STAGE(PG8_SB(0, 0), b2, voffB);
            PG8_BAR; PG8_WAIT_L(0); PG8_MMA(0, 1, At, B1); PG8_BAR;
            PG8_LDA(At, 0, 1); PG8_STAGE(PG8_SA(0, 0), a2, voffA);
            PG8_BAR; PG8_WAIT_L(0); PG8_MMA(1, 0, At, B0); PG8_BAR; PG8_SCHED;
            PG8_STAGE(PG8_SB(0, 1), b2 + hstep, voffB);
            PG8_WAIT_V(6); PG8_BAR; PG8_MMA(1, 1, At, B1); PG8_BAR;
            PG8_LDB(B0, 1, 0); PG8_SCHED; PG8_LDA(At, 1, 0); PG8_STAGE(PG8_SA(0, 1), a2 + hstep, voffA);
            PG8_WAIT_L(8); PG8_BAR; PG8_WAIT_L(0); PG8_MMA(0, 0, At, B0); PG8_BAR; PG8_SCHED;
            PG8_LDB(B1, 1, 1); PG8_STAGE(PG8_SB(1, 0), b3, voffB);
            PG8_BAR; PG8_WAIT_L(0); PG8_MMA(0, 1, At, B1); PG8_BAR;
            PG8_LDA(At, 1, 1); PG8_STAGE(PG8_SA(1, 0), a3, voffA);
            PG8_BAR; PG8_WAIT_L(0); PG8_MMA(1, 0, At, B0); PG8_BAR; PG8_SCHED;
            PG8_STAGE(PG8_SB(1, 1), b3 + hstep, voffB);
            PG8_WAIT_V(6); PG8_BAR; PG8_MMA(1, 1, At, B1); PG8_BAR;
            }
        }
        if constexpr (ALIGN_EPI) { if (wr == 0) PG8_BAR; }
        if constexpr (!Epi::AFTER_DRAIN) { E(acc, cur, wr, wc, fr, fq); S.done(cur); }
        if (!has_next) break;
#pragma unroll
        for (int a = 0; a < 2; ++a)
#pragma unroll
            for (int b = 0; b < 2; ++b)
#pragma unroll
                for (int m = 0; m < 4; ++m)
#pragma unroll
                    for (int n = 0; n < 2; ++n) acc[a][b][m][n] = (f32x4){0.f, 0.f, 0.f, 0.f};
        cur = nxt; cA = nA; cB = nB; ++ui;
        if constexpr (ALIGN_EPI) { if (wr == 1) PG8_BAR; }
    }
    PG8_WAIT_V(0);
    if constexpr (!ALIGN_EPI) { if (wr == 0) PG8_BAR; }
    PG8_BAR;
    if constexpr (Epi::AFTER_DRAIN) { E.fused(acc, cur, wr, wc, fr, fq, lds, wid, lane); S.done(cur); }
#undef PG8_SA
#undef PG8_SB
#undef PG8_STAGE
#undef PG8_LDA
#undef PG8_LDB
#undef PG8_MMA
#undef PG8_WAIT_V
#undef PG8_WAIT_L
#undef PG8_BAR
#undef PG8_SCHED
}
}

#define GAS __attribute__((address_space(1)))
#define LAS __attribute__((address_space(3)))
typedef unsigned short bf16;
typedef unsigned v4u __attribute__((ext_vector_type(4)));
typedef float f32x4 __attribute__((ext_vector_type(4)));
typedef short bf16x8 __attribute__((ext_vector_type(8)));
typedef GAS unsigned gu32;
typedef GAS unsigned long long gu64;
#define RLX_AGENT __ATOMIC_RELAXED, __HIP_MEMORY_SCOPE_AGENT
#define LDS_WAIT() asm volatile("s_waitcnt lgkmcnt(0)" ::: "memory")
#define VM_WAIT() asm volatile("s_waitcnt vmcnt(0)" ::: "memory")
__device__ __forceinline__ unsigned long long rt() { return __builtin_amdgcn_s_memrealtime(); }
__device__ __forceinline__ unsigned f2bf(float f) { unsigned u = __builtin_bit_cast(unsigned, f); return (u + 0x7fffu + ((u >> 16) & 1u)) >> 16; }
__device__ __forceinline__ unsigned pk2(float lo, float hi) { return f2bf(lo) | (f2bf(hi) << 16); }

#define XB_TMO      128
#define XB_XCNT(j)  (256  + 64 * (j))
#define XB_XSUB(j)  (1280 + 64 * (j))
#define XB_XGEN(j)  (2304 + 64 * (j))
#define XB_TOP      3328
#define XB_TOPGEN   3392
#define XCD_BAR_WORDS 3456
#define XB_SPIN_CAP (1u << 18)

__device__ __forceinline__ unsigned xb_ld(unsigned* p)              { return __hip_atomic_load(p, __ATOMIC_RELAXED, __HIP_MEMORY_SCOPE_AGENT); }
__device__ __forceinline__ unsigned xb_add(unsigned* p, unsigned v) { return __hip_atomic_fetch_add(p, v, __ATOMIC_RELAXED, __HIP_MEMORY_SCOPE_AGENT); }
__device__ __forceinline__ unsigned xb_xcc_id() { return (unsigned)__builtin_amdgcn_s_getreg((3 << 11) | 20) & 0xFu; }
#define XB_SPIN(cond, bar) do { unsigned _sp = 0; while (cond) { __builtin_amdgcn_s_sleep(1); \
    if ((++_sp & 255u) == 0u) { if (xb_ld(&(bar)[XB_TMO])) break; if (_sp > XB_SPIN_CAP) { atomicAdd(&(bar)[XB_TMO], 1u); break; } } } } while (0)

struct XcdBarrier {
    unsigned* bar; unsigned x;
    volatile LAS unsigned* st;
};

__device__ __forceinline__ XcdBarrier xcd_barrier_post(unsigned* bar, volatile LAS unsigned* st) {
    XcdBarrier b; b.bar = bar; b.x = xb_xcc_id(); b.st = st;
    if (threadIdx.x == 0) (void)xb_add(&bar[XB_XCNT(b.x)], 1u);
    return b;
}
__device__ __forceinline__ void xcd_barrier_complete(unsigned* bar, unsigned x, unsigned& nloc, unsigned& nx) {
    const unsigned G = gridDim.x * gridDim.y * gridDim.z;
    unsigned sum, cnt, mine, sp = 0u;
    for (;;) {
        sum = 0u; cnt = 0u; mine = 0u;
        unsigned cv[16];
#pragma unroll
        for (unsigned j = 0; j < 16; ++j) cv[j] = xb_ld(&bar[XB_XCNT(j)]);
#pragma unroll
        for (unsigned j = 0; j < 16; ++j) { const unsigned c = cv[j]; sum += c; cnt += (c > 0u) ? 1u : 0u; mine = (j == x) ? c : mine; }
        if (sum == G) break;
        __builtin_amdgcn_s_sleep(1);
        if ((++sp & 255u) == 0u) { if (xb_ld(&bar[XB_TMO])) break; if (sp > XB_SPIN_CAP) { atomicAdd(&bar[XB_TMO], 1u); break; } }
    }
    nloc = mine > 0u ? mine : 1u; nx = cnt > 0u ? cnt : 1u;
}

__device__ __forceinline__ void xcd_barrier(const XcdBarrier& b) {
    asm volatile("s_waitcnt vmcnt(0)" ::: "memory");
    __syncthreads();
    if (threadIdx.x == 0) {
        unsigned* bar = b.bar;
        __builtin_amdgcn_s_waitcnt(0);
        unsigned nloc = b.st[0], nx = b.st[1];
        if (nloc == 0u) { xcd_barrier_complete(bar, b.x, nloc, nx); b.st[0] = nloc; b.st[1] = nx; }
        const unsigned old = xb_add(&bar[XB_XSUB(b.x)], 1u);
        const unsigned gen = old / nloc;
        if (old + 1u == (gen + 1u) * nloc) {
            __builtin_amdgcn_fence(__ATOMIC_RELEASE, "agent");
            asm volatile("s_waitcnt vmcnt(0)" ::: "memory");
            const unsigned og = xb_add(&bar[XB_TOP], 1u);
            const unsigned tg = og / nx;
            if (og + 1u == (tg + 1u) * nx) xb_add(&bar[XB_TOPGEN], 1u);
            else XB_SPIN(xb_ld(&bar[XB_TOPGEN]) == tg, bar);
            __builtin_amdgcn_fence(__ATOMIC_ACQUIRE, "agent");
            xb_add(&bar[XB_XGEN(b.x)], 1u);
            asm volatile("s_waitcnt vmcnt(0)" ::: "memory");
        } else {
            XB_SPIN(xb_ld(&bar[XB_XGEN(b.x)]) == gen, bar);
            __builtin_amdgcn_fence(__ATOMIC_ACQUIRE, "agent");
            asm volatile("s_waitcnt vmcnt(0)" ::: "memory");
        }
    }
    __syncthreads();
}

constexpr int NWAVES = 8;
constexpr int D = 1024, FF = 2816;
constexpr int PB = 8, PT = 2048, SB = 128, STK = 4;
constexpr int MP = PB * PT, MS = SB * STK, M = MP + MS;
constexpr int NRW = 3584, KRW = 2048  , NRW2 = 3840  , NL2 = 3072, KL2 = 384, NIN = 3328;
constexpr float NORM_EPS = 1e-6f, GN_EPS = 64e-5f;
typedef pg8::bf16_t bf16;

constexpr size_t MiB = 1u << 20;
constexpr size_t WS_CTL = 0, CTL_ZERO_BYTES = 64 * 1024;
constexpr size_t WS_W = 1 * MiB;
constexpr size_t WS_XR = 20 * MiB;
constexpr size_t WS_BIG = 86 * MiB;
constexpr size_t WS_END = 256 * MiB;
constexpr size_t WS_YRAW = 256 * MiB, WS_BON = 288 * MiB, WS_W2 = 289 * MiB  , WS_END2 = 308 * MiB, WS_XM = 308 * MiB  , WS_END3 = 506 * MiB;
constexpr size_t W_GU = 0, W_D = (size_t)2 * FF * D * 2;
constexpr size_t W_RW = 0, W_L2 = (size_t)NRW * KRW * 2, W_O = W_L2 + (size_t)NL2 * KL2 * 2;
constexpr size_t W_IN = 0, W_OUT = (size_t)NIN * D * 2;
static_assert(W_D + (size_t)D * FF * 2 <= 19 * MiB && W_O + (size_t)D * D * 2 <= 19 * MiB && W_OUT + (size_t)D * D * 2 <= 19 * MiB, "weights region");
constexpr size_t B_H = 0, B_XN = 91 * MiB, B_SLAB = 124 * MiB;
constexpr size_t B_ACAT = 0, B_DEC = 0, B_AA = 33 * MiB + 1 * 12288, B_R = 66 * MiB + 2 * 12288, B_K = 99 * MiB + 3 * 12288, B_V = 132 * MiB + 4 * 12288;
constexpr size_t B_QKR = 0, B_VV = 33 * MiB, B_HO = 66 * MiB, B_OO = 124 * MiB, B_IF = 157 * MiB;
static_assert((size_t)M * FF * 2 <= 91 * MiB && (size_t)M * D * 2 == 33 * MiB && B_IF + (size_t)M * 16 * 4 <= 170 * MiB && B_SLAB + (size_t)11 * MS * D * 4 <= 170 * MiB, "BIG map");
constexpr size_t OS_GG = 0, OS_LORA = 33 * MiB;
static_assert(OS_LORA + (size_t)M * KL2 * 2 <= (size_t)MP * D * 4, "d_out scratch");
constexpr size_t O_Y = 0, O_P_S = 17301504, O_P_SHIFT = 17825792, O_P_C = 17833984, O_P_N = 18358272, O_P_M = 18362368, O_P_CONV = 18362432,
                 O_S_S = 18387008, O_S_SHIFT = 26775616, O_S_C = 26906688, O_S_N = 35295296, O_S_M = 35360832, O_S_CONV = 35361856, O_END = 35755072;
constexpr int CW_BAR = 1024;

constexpr int RING_BYTES = 131072, LDSCTL_OFF = RING_BYTES, MISC_OFF = LDSCTL_OFF + 320, TAB_OFF = LDSCTL_OFF + 1024, BIAS_OFF = LDSCTL_OFF + 2048  , LDS_BYTES = 147456;

enum { I_XP = 0, I_XS, I_RS, I_RSHIFT, I_MC, I_MN, I_MM, I_MCONV, I_NFA, I_FAWG, I_FAWU, I_FAWD, I_NMIX, I_NFB, I_FBWG, I_FBWU, I_FBWD,
       I_MU, I_WR, I_WK, I_WV, I_WO, I_W0, I_W1, I_W2, I_A0, I_A1, I_A2, I_G1, I_G2, I_KK, I_KA, I_RK, I_GNW, I_GNB,
       I_WIN, I_BIF, I_CW, I_CB, I_MNW, I_WOUT, I_NFIN, N_IN };

typedef __bf16 bf16x2_t __attribute__((ext_vector_type(2)));
typedef float f32x2_t __attribute__((ext_vector_type(2)));
__device__ __forceinline__ unsigned pkbf(float lo, float hi) { f32x2_t v = {lo, hi}; bf16x2_t b = __builtin_convertvector(v, bf16x2_t); return __builtin_bit_cast(unsigned, b); }
__device__ __forceinline__ float bflo(unsigned u) { return __builtin_bit_cast(float, u << 16); }
__device__ __forceinline__ float bfhi(unsigned u) { return __builtin_bit_cast(float, u & 0xffff0000u); }
__device__ __forceinline__ float bf1(unsigned short u) { return __builtin_bit_cast(float, (unsigned)u << 16); }
__device__ __forceinline__ unsigned short f2bf1(float f) { return (unsigned short)(pkbf(f, 0.f) & 0xffffu); }
__device__ __forceinline__ void unpack8(v4u w, float (&o)[8]) { o[0] = bflo(w.x); o[1] = bfhi(w.x); o[2] = bflo(w.y); o[3] = bfhi(w.y); o[4] = bflo(w.z); o[5] = bfhi(w.z); o[6] = bflo(w.w); o[7] = bfhi(w.w); }
__device__ __forceinline__ v4u pack8(const float (&o)[8]) { v4u w; w.x = pkbf(o[0], o[1]); w.y = pkbf(o[2], o[3]); w.z = pkbf(o[4], o[5]); w.w = pkbf(o[6], o[7]); return w; }
__device__ __forceinline__ float sigmoidf_(float x) { return __builtin_amdgcn_rcpf(1.f + __expf(-x)); }
__device__ __forceinline__ float siluf_(float x) { return x * __builtin_amdgcn_rcpf(1.f + __expf(-x)); }
__device__ __forceinline__ float tanhf_(float x) { return 1.f - 2.f * __builtin_amdgcn_rcpf(__expf(2.f * x) + 1.f); }
__device__ __forceinline__ float logsigmoidf_(float x) { return fminf(x, 0.f) - __logf(1.f + __expf(-fabsf(x))); }
template <int CTRL> __device__ __forceinline__ float dppf(float x) { return __builtin_bit_cast(float, __builtin_amdgcn_update_dpp(0, __builtin_bit_cast(int, x), CTRL, 0xF, 0xF, true)); }
__device__ __forceinline__ float red4(float x) { x += dppf<0xB1>(x); x += dppf<0x4E>(x); return x; }
__device__ __forceinline__ float red8(float x) { x = red4(x); x += dppf<0x141>(x); return x; }
__device__ __forceinline__ float red16(float x) { x = red8(x); x += dppf<0x140>(x); return x; }
__device__ __forceinline__ float wave_sum(float v) {
#pragma unroll
    for (int o = 1; o < 64; o <<= 1) v += __shfl_xor(v, o);
    return v;
}

struct Frame {
    LAS unsigned char* lds;
    volatile LAS unsigned* MISC;
    gu32* ctl;
    volatile LAS unsigned long long* tab;
    int tid, lane, wave, vcu, G;
};
__device__ __forceinline__ const float* inptr(const Frame& F, int i) { const unsigned long long v = F.tab[i];
    const unsigned lo = __builtin_amdgcn_readfirstlane((unsigned)v), hi = __builtin_amdgcn_readfirstlane((unsigned)(v >> 32)); return (const float*)(const GAS float*)(((unsigned long long)hi << 32) | lo); }

using pg8::Unit; using pg8::BM; using pg8::HALF;
__device__ __forceinline__ void st8bf(bf16* p, f32x4 v0, f32x4 v1) { v4u w; w.x = pkbf(v0[0], v0[1]); w.y = pkbf(v0[2], v0[3]); w.z = pkbf(v1[0], v1[1]); w.w = pkbf(v1[2], v1[3]); *(v4u*)p = w; }

struct EpiSwiglu {
    static constexpr bool PERM = true, AFTER_DRAIN = false;
    bf16* H; int pvar;
    __device__ __forceinline__ void operator()(const f32x4 (&acc)[2][2][4][2], const Unit& u, int wr, int wc, int fr, int fq) const {
        if (pvar == 3) return;
        const int row0 = u.pm * BM + wr * 64 + fr, col0 = u.pn * 128 + wc * 32 + 8 * fq;
#pragma unroll
        for (int ai = 0; ai < 2; ++ai)
#pragma unroll
            for (int m = 0; m < 4; ++m) {
                f32x4 o[2];
#pragma unroll
                for (int n = 0; n < 2; ++n)
#pragma unroll
                    for (int i = 0; i < 4; ++i) { const float g = acc[ai][0][m][n][i], up = acc[ai][1][m][n][i]; o[n][i] = siluf_(g) * up; }
                st8bf(H + (size_t)(row0 + ai * HALF + m * 16) * FF + col0, o[0], o[1]);
            }
    }
};
__device__ __forceinline__ void ld8bf(const bf16* p, f32x4& a, f32x4& b) { const v4u w = *(const v4u*)p; a = (f32x4){bflo(w.x), bfhi(w.x), bflo(w.y), bfhi(w.y)}; b = (f32x4){bflo(w.z), bfhi(w.z), bflo(w.w), bfhi(w.w)}; }
struct EpiRes {
    static constexpr bool PERM = true, AFTER_DRAIN = false;
    const float* basef; const bf16* baseb; bf16* out; float* slab; float coef;
    __device__ __forceinline__ void operator()(const f32x4 (&acc)[2][2][4][2], const Unit& u, int wr, int wc, int fr, int fq) const {
        const int row0 = u.pm * BM + wr * 64 + fr, col0 = u.pn * BM + wc * 32 + 8 * fq;
        if (u.slab < 0) {
            if (basef) {
#pragma unroll
                for (int ai = 0; ai < 2; ++ai) {
                    f32x4 bq[4][2][2];
#pragma unroll
                    for (int m = 0; m < 4; ++m) { const size_t ro = (size_t)(row0 + ai * HALF + m * 16) * D + col0;
#pragma unroll
                        for (int bj = 0; bj < 2; ++bj) { bq[m][bj][0] = *(const f32x4*)(basef + ro + bj * HALF); bq[m][bj][1] = *(const f32x4*)(basef + ro + bj * HALF + 4); } }
#pragma unroll
                    for (int m = 0; m < 4; ++m) { const size_t ro = (size_t)(row0 + ai * HALF + m * 16) * D + col0;
#pragma unroll
                        for (int bj = 0; bj < 2; ++bj) st8bf(out + ro + bj * HALF, bq[m][bj][0] + acc[ai][bj][m][0] * coef, bq[m][bj][1] + acc[ai][bj][m][1] * coef); }
                }
            } else {
                v4u bw[2][4][2];
#pragma unroll
                for (int ai = 0; ai < 2; ++ai)
#pragma unroll
                    for (int m = 0; m < 4; ++m) { const size_t ro = (size_t)(row0 + ai * HALF + m * 16) * D + col0;
#pragma unroll
                        for (int bj = 0; bj < 2; ++bj) bw[ai][m][bj] = *(const v4u*)(baseb + ro + bj * HALF); }
#pragma unroll
                for (int ai = 0; ai < 2; ++ai)
#pragma unroll
                    for (int m = 0; m < 4; ++m) { const size_t ro = (size_t)(row0 + ai * HALF + m * 16) * D + col0;
#pragma unroll
                        for (int bj = 0; bj < 2; ++bj) { const v4u w_ = bw[ai][m][bj];
                            const f32x4 b0 = {bflo(w_.x), bfhi(w_.x), bflo(w_.y), bfhi(w_.y)}, b1 = {bflo(w_.z), bfhi(w_.z), bflo(w_.w), bfhi(w_.w)};
                            st8bf(out + ro + bj * HALF, b0 + acc[ai][bj][m][0] * coef, b1 + acc[ai][bj][m][1] * coef); } }
            }
        } else {
            float* sl = slab + (size_t)u.slab * MS * D;
#pragma unroll
            for (int ai = 0; ai < 2; ++ai)
#pragma unroll
                for (int m = 0; m < 4; ++m) { const size_t ro = (size_t)(row0 + ai * HALF + m * 16 - MP) * D + col0;
#pragma unroll
                    for (int bj = 0; bj < 2; ++bj) { *(f32x4*)(sl + ro + bj * HALF) = acc[ai][bj][m][0]; *(f32x4*)(sl + ro + bj * HALF + 4) = acc[ai][bj][m][1]; } }
        }
    }
};
struct EpiRw {
    static constexpr bool PERM = true, AFTER_DRAIN = false;
    bf16 *R, *K, *V, *L;
    __device__ __forceinline__ void operator()(const f32x4 (&acc)[2][2][4][2], const Unit& u, int wr, int wc, int fr, int fq) const {
        const int mix = u.pn < 12 ? (u.pn >> 2) : u.pn - 9, row0 = (u.pm - (M / 256) * mix) * BM + wr * 64 + fr;
        if (u.pn < 12) {
            bf16 *p0 = R, *p1 = K, *p2 = V; asm volatile("" : "+s"(p0), "+s"(p1), "+s"(p2));
            bf16* dst = u.pn < 4 ? p0 : (u.pn < 8 ? p1 : p2); const int col0 = (u.pn & 3) * BM + wc * 32 + 8 * fq;
#pragma unroll
            for (int ai = 0; ai < 2; ++ai)
#pragma unroll
                for (int m = 0; m < 4; ++m) { bf16* rp = dst + (size_t)(row0 + ai * HALF + m * 16) * D + col0;
#pragma unroll
                    for (int bj = 0; bj < 2; ++bj) st8bf(rp + bj * HALF, acc[ai][bj][m][0], acc[ai][bj][m][1]); }
        } else {
            const int t = u.pn - 12;
#pragma unroll
            for (int bj = 0; bj < 2; ++bj) {
                const int cl = bj * HALF + wc * 32 + 8 * fq;
                if (t < 2 && cl >= 64) continue;
                const int lc = t == 0 ? cl : (t == 1 ? 64 + cl : 128 + cl);
                const int act = t == 0 ? 1 : (t == 1 ? 0 : (cl < 160 ? 2 : 3));
#pragma unroll
                for (int ai = 0; ai < 2; ++ai)
#pragma unroll
                    for (int m = 0; m < 4; ++m) {
                        f32x4 o[2];
#pragma unroll
                        for (int n = 0; n < 2; ++n)
#pragma unroll
                            for (int i = 0; i < 4; ++i) { const float x = acc[ai][bj][m][n][i]; o[n][i] = act == 1 ? tanhf_(x) : (act == 0 ? x : (act == 2 ? sigmoidf_(x) : 0.f)); }
                        st8bf(L + (size_t)(row0 + ai * HALF + m * 16) * KL2 + lc, o[0], o[1]);
                    }
            }
        }
    }
};
struct EpiL2 {
    static constexpr bool PERM = true, AFTER_DRAIN = false;
    bf16 *DEC, *AA, *GG; const LAS float* lb;
    __device__ __forceinline__ void operator()(const f32x4 (&acc)[2][2][4][2], const Unit& u, int wr, int wc, int fr, int fq) const {
        const int row0 = u.pm * BM + wr * 64 + fr, kind = u.pn >> 2, col0 = (u.pn & 3) * BM + wc * 32 + 8 * fq;
        bf16 *p0 = DEC, *p1 = AA, *p2 = GG; asm volatile("" : "+s"(p0), "+s"(p1), "+s"(p2));
        bf16* dst = kind == 0 ? p0 : (kind == 1 ? p1 : p2); const LAS float* bias = lb + (kind == 0 ? 0 : D);
#pragma unroll
        for (int bj = 0; bj < 2; ++bj) {
            f32x4 bv[2];
#pragma unroll
            for (int n = 0; n < 2; ++n) bv[n] = kind < 2 ? *(const LAS f32x4*)(bias + col0 + bj * HALF + 4 * n) : (f32x4){0.f, 0.f, 0.f, 0.f};
#pragma unroll
            for (int ai = 0; ai < 2; ++ai)
#pragma unroll
                for (int m = 0; m < 4; ++m) {
                    f32x4 o[2];
#pragma unroll
                    for (int n = 0; n < 2; ++n)
#pragma unroll
                        for (int i = 0; i < 4; ++i) { const float z = acc[ai][bj][m][n][i] + bv[n][i];
                            o[n][i] = kind == 0 ? (1.f - __expf(-0.60653065971f * sigmoidf_(z))) : (kind == 1 ? sigmoidf_(z) : z); }
                    st8bf(dst + (size_t)(row0 + ai * HALF + m * 16) * D + col0 + bj * HALF, o[0], o[1]);
                }
        }
    }
};
struct EpiIn {
    static constexpr bool PERM = true, AFTER_DRAIN = false;
    bf16 *QKR, *VV, *OO; float* IF; const float* bif; int pvar;
    __device__ __forceinline__ void operator()(const f32x4 (&acc)[2][2][4][2], const Unit& u, int wr, int wc, int fr, int fq) const {
        if (pvar == 3) return;
        const int row0 = u.pm * BM + wr * 64 + fr;
        if (u.pn < 12) {
            bf16 *p0 = QKR, *p1 = VV, *p2 = OO; asm volatile("" : "+s"(p0), "+s"(p1), "+s"(p2));
            const int kind = u.pn >> 2; bf16* dst = kind == 0 ? p0 : (kind == 1 ? p1 : p2); const int col0 = (u.pn & 3) * BM + wc * 32 + 8 * fq;
#pragma unroll
            for (int ai = 0; ai < 2; ++ai)
#pragma unroll
                for (int m = 0; m < 4; ++m) { bf16* rp = dst + (size_t)(row0 + ai * HALF + m * 16) * D + col0;
#pragma unroll
                    for (int bj = 0; bj < 2; ++bj) { f32x4 a = acc[ai][bj][m][0], b = acc[ai][bj][m][1];
                        if (kind == 2) {
#pragma unroll
                            for (int i = 0; i < 4; ++i) { a[i] = sigmoidf_(a[i]); b[i] = sigmoidf_(b[i]); } }
                        st8bf(rp + bj * HALF, a, b); } }
        } else if (u.pn == 12 && wc == 0 && fq < 2) {
            const f32x4 b0 = *(const f32x4*)(bif + 8 * fq), b1 = *(const f32x4*)(bif + 8 * fq + 4);
#pragma unroll
            for (int ai = 0; ai < 2; ++ai)
#pragma unroll
                for (int m = 0; m < 4; ++m) { f32x4 a = acc[ai][0][m][0] + b0, b = acc[ai][0][m][1] + b1;
                    if (fq == 1) {
#pragma unroll
                        for (int i = 0; i < 4; ++i) { a[i] = logsigmoidf_(a[i]); b[i] = logsigmoidf_(b[i]); } }
                    float* rp = IF + (size_t)(row0 + ai * HALF + m * 16) * 16 + 8 * fq; *(f32x4*)rp = a; *(f32x4*)(rp + 4) = b; }
        }
    }
};

struct CJ { const float* W; const float* sc; bf16* WT; int K, N, Npad, ldk, koff, rmode, roff, smode; };
__device__ __forceinline__ int cj_items(const CJ& j) { return (j.K / 32) * (j.Npad / 32); }
__device__ __forceinline__ void conv_load(const CJ& J, int item, int lane, f32x4 (&w)[4], float (&sc)[4]) {
    const int nblk = J.Npad / 32, kb = item / nblk, nb = item % nblk, k0 = 32 * kb, n0 = 32 * nb;
    const int r = lane >> 3, c4 = 4 * (lane & 7); const bool nok = n0 + c4 < J.N;
#pragma unroll
    for (int i = 0; i < 4; ++i) { const int kk = k0 + r + 8 * i;
        w[i] = nok ? *(const f32x4*)(J.W + (size_t)kk * J.N + n0 + c4) : (f32x4){0.f, 0.f, 0.f, 0.f};
        float s = 1.f; if (J.smode) { s = J.sc[kk]; if (J.smode == 2) s = 1.f - s; }
        sc[i] = s; }
}
__device__ __forceinline__ void conv_store(const CJ& J, LAS float* scr, int item, int lane, const f32x4 (&w)[4], const float (&sc)[4]) {
    const int nblk = J.Npad / 32, kb = item / nblk, nb = item % nblk, k0 = 32 * kb, n0 = 32 * nb;
    const int r = lane >> 3, c4 = 4 * (lane & 7);
#pragma unroll
    for (int i = 0; i < 4; ++i) { const f32x4 f = w[i] * sc[i]; LAS float* d = scr + (r + 8 * i) * 33 + c4; d[0] = f[0]; d[1] = f[1]; d[2] = f[2]; d[3] = f[3]; }
    LDS_WAIT(); asm volatile("" ::: "memory");
    const int rowbase = J.rmode == 0 ? J.roff + n0 : (n0 >> 7) * 256 + (n0 & 127) + J.roff;
    const int c = lane & 3;
#pragma unroll
    for (int j = 0; j < 2; ++j) { const int n = (lane >> 2) + 16 * j; const LAS float* s = scr + (8 * c) * 33 + n;
        v4u o; o.x = pkbf(s[0 * 33], s[1 * 33]); o.y = pkbf(s[2 * 33], s[3 * 33]); o.z = pkbf(s[4 * 33], s[5 * 33]); o.w = pkbf(s[6 * 33], s[7 * 33]);
        *(GAS v4u*)(J.WT + (size_t)(rowbase + n) * J.ldk + J.koff + k0 + 8 * c) = o; }
    LDS_WAIT(); asm volatile("" ::: "memory");
}
__device__ __forceinline__ CJ get_job(const Frame& F, int kind, int j, int layer, int ab, bf16* Wb) {
    CJ J; J.sc = nullptr; J.smode = 0; J.koff = 0; J.rmode = 0; J.roff = 0;
    if (kind == 0) {
        const float* wg = inptr(F, ab ? I_FBWG : I_FAWG) + (size_t)layer * D * FF; const float* wu = inptr(F, ab ? I_FBWU : I_FAWU) + (size_t)layer * D * FF; const float* wd = inptr(F, ab ? I_FBWD : I_FAWD) + (size_t)layer * D * FF;
        if (j < 2) { J.W = j == 0 ? wg : wu; J.K = D; J.N = FF; J.Npad = FF; J.WT = Wb + W_GU / 2; J.ldk = D; J.rmode = 1; J.roff = j == 0 ? 0 : 128; }
        else { J.W = wd; J.K = FF; J.N = D; J.Npad = D; J.WT = Wb + W_D / 2; J.ldk = FF; }
    } else if (kind == 1) {
        if (j < 6) {
            const int s = j;
            J.W = inptr(F, s == 0 ? I_WR : (s == 1 ? I_WK : (s == 2 ? I_WV : (s == 3 ? I_W1 : (s == 4 ? I_A1 : I_G1)))));
            J.N = s < 3 ? 1024 : (s < 5 ? 64 : 160); J.Npad = s < 3 ? 1024 : 256;
            J.roff = s < 3 ? 1024 * s : 3072 + 256 * (s - 3);
            J.K = D; J.ldk = D; J.WT = Wb + W_RW / 2;
        } else { J.W = inptr(F, I_WO); J.K = D; J.N = D; J.Npad = D; J.WT = Wb + W_O / 2; J.ldk = D; }
    } else {
        if (j == 0) { J.W = inptr(F, I_WIN); J.K = D; J.N = 3088; J.Npad = NIN; J.WT = Wb + W_IN / 2; J.ldk = D; }
        else { J.W = inptr(F, I_WOUT); J.K = D; J.N = D; J.Npad = D; J.WT = Wb + W_OUT / 2; J.ldk = D; }
    }
    return J;
}
__device__ __forceinline__ void convert_weights(const Frame& F, int kind, int layer, int ab, bf16* Wb, const int cu0 = 0) {
    LAS float* scr = (LAS float*)(F.lds + F.wave * 16384);
    const int gw = (F.vcu - cu0) * NWAVES + F.wave, NGW = (F.G - cu0) * NWAVES;
    const int njobs = kind == 0 ? 3 : (kind == 1 ? 7 : 2);
    int total = 0;
    for (int j = 0; j < njobs; ++j) { const CJ J = get_job(F, kind, j, layer, ab, Wb); total += cj_items(J); }
    if (gw < total) {
        int r = gw, j = 0; CJ J = get_job(F, kind, 0, layer, ab, Wb);
        while (r >= cj_items(J)) { r -= cj_items(J); ++j; J = get_job(F, kind, j, layer, ab, Wb); }
        f32x4 w[4]; float sc[4];
        conv_load(J, r, F.lane, w, sc);
        for (int g = gw; g < total;) {
            const int gn = g + NGW; int rn = 0; CJ Jn = J; f32x4 wn[4]; float sn[4];
#pragma unroll
            for (int i = 0; i < 4; ++i) { wn[i] = (f32x4){0.f, 0.f, 0.f, 0.f}; sn[i] = 0.f; }
            if (gn < total) {
                rn = gn; int jn = 0; Jn = get_job(F, kind, 0, layer, ab, Wb);
                while (rn >= cj_items(Jn)) { rn -= cj_items(Jn); ++jn; Jn = get_job(F, kind, jn, layer, ab, Wb); }
                conv_load(Jn, rn, F.lane, wn, sn);
            }
            conv_store(J, scr, r, F.lane, w, sc);
            J = Jn; r = rn; g = gn;
#pragma unroll
            for (int i = 0; i < 4; ++i) { w[i] = wn[i]; sc[i] = sn[i]; }
        }
    }
    if (kind == 1) {
        bf16* WT = Wb + W_L2 / 2; const float* w2 = inptr(F, I_W2); const float* a2 = inptr(F, I_A2); const float* g2 = inptr(F, I_G2);
        for (int idx = (F.vcu * NWAVES + F.wave) * 64 + F.lane; idx < 48 * NL2; idx += F.G * NWAVES * 64) {
            const int c = idx / NL2, n = idx % NL2, type = n >> 10, jj = n & 1023;
            const float* src = nullptr;
            if (type == 0 && c < 8) src = w2 + (size_t)(8 * c) * D + jj;
            else if (type == 1 && c >= 8 && c < 16) src = a2 + (size_t)(8 * (c - 8)) * D + jj;
            else if (type == 2 && c >= 16 && c < 36) src = g2 + (size_t)(8 * (c - 16)) * D + jj;
            float v[8];
#pragma unroll
            for (int e = 0; e < 8; ++e) v[e] = src ? src[(size_t)e * D] : 0.f;
            *(GAS v4u*)(WT + (size_t)n * KL2 + 8 * c) = pack8(v);
        }
    }
}

template <int MODE>
__device__ __forceinline__ void norm_finish(const int m, f32x4 (&v)[4], const f32x4 (&gv)[4], bf16* dst, const float* shift_in, float* out, const int lane) {
    const bool samp = m >= MP;
    float ss = 0.f;
#pragma unroll
    for (int j = 0; j < 4; ++j) ss += (v[j].x * v[j].x + v[j].y * v[j].y) + (v[j].z * v[j].z + v[j].w * v[j].w);
    const float r = 1.0f / sqrtf(wave_sum(ss) * (1.f / D) + NORM_EPS);
#pragma unroll
    for (int j = 0; j < 4; ++j) v[j] = v[j] * r * gv[j];
    if (MODE == 2) {
#pragma unroll
        for (int j = 0; j < 4; ++j) *(f32x4*)(out + O_Y + (size_t)m * D + 512 * (j >> 1) + 8 * lane + 4 * (j & 1)) = v[j];
    } else if (MODE == 0) {
#pragma unroll
        for (int j = 0; j < 2; ++j) st8bf(dst + (size_t)m * D + 512 * j + 8 * lane, v[2 * j], v[2 * j + 1]);
    } else {
        int t, b; bool first, last;
        if (!samp) { t = m & (PT - 1); b = m >> 11; first = t == 0; last = t == PT - 1; } else { const int mm = m - MP; t = mm & 3; b = mm >> 2; first = t == 0; last = t == 3; }
#pragma unroll
        for (int j = 0; j < 2; ++j) { const int eo = 512 * j + 8 * lane;
            st8bf(dst + (size_t)m * (2 * D) + eo, v[2 * j], v[2 * j + 1]);
            if (!last) st8bf(dst + (size_t)(m + 1) * (2 * D) + D + eo, v[2 * j], v[2 * j + 1]);
            else { float* so = out + (samp ? O_S_SHIFT : O_P_SHIFT) + (size_t)b * D + eo; *(f32x4*)so = v[2 * j]; *(f32x4*)(so + 4) = v[2 * j + 1]; }
            if (first) { f32x4 s0 = {0.f, 0.f, 0.f, 0.f}, s1 = s0;
                if (samp) { s0 = *(const f32x4*)(shift_in + (size_t)b * D + eo); s1 = *(const f32x4*)(shift_in + (size_t)b * D + eo + 4); }
                st8bf(dst + (size_t)m * (2 * D) + D + eo, s0, s1); }
        }
    }
}
template <bool F32>
__device__ __forceinline__ void row_load(const void* src, const size_t row, const int lane, f32x4 (&v)[4]) {
    if (F32) { const float* p = (const float*)src + row * D;
#pragma unroll
        for (int j = 0; j < 4; ++j) v[j] = *(const f32x4*)(p + 512 * (j >> 1) + 8 * lane + 4 * (j & 1));
    } else { const bf16* p = (const bf16*)src + row * D;
#pragma unroll
        for (int j = 0; j < 2; ++j) ld8bf(p + 512 * j + 8 * lane, v[2 * j], v[2 * j + 1]); }
}
template <int NS>
__device__ __forceinline__ void samp_row_fold(const float* slab, const int ms, const float coef, const int lane, f32x4 (&v)[4]) {
#pragma unroll
    for (int h = 0; h < 2; ++h) {
        f32x4 t[NS > 0 ? NS : 1][2];
#pragma unroll
        for (int s = 0; s < NS; ++s)
#pragma unroll
            for (int jj = 0; jj < 2; ++jj) t[s][jj] = *(const f32x4*)(slab + ((size_t)s * MS + ms) * D + 512 * h + 8 * lane + 4 * jj);
#pragma unroll
        for (int jj = 0; jj < 2; ++jj)
#pragma unroll
            for (int s = 0; s < NS; ++s) v[2 * h + jj] += t[s][jj] * coef;
    }
}
template <int MODE, bool PF32, bool SF32>
__device__ __forceinline__ void norm_rows(const Frame& F, const void* base_p, const void* base_s, int nslab, float coef, const float* slab, bf16* xr,
                                          const float* gain, bf16* dst, const float* shift_in, float* out, const int pvar = 0) {
    const int gw = F.vcu * NWAVES + F.wave, NGW = F.G * NWAVES, lane = F.lane;
    f32x4 gv[4];
#pragma unroll
    for (int j = 0; j < 4; ++j) gv[j] = *(const f32x4*)(gain + 512 * (j >> 1) + 8 * lane + 4 * (j & 1));
    for (int s = F.wave * F.G + F.vcu; s < MS; s += NWAVES * F.G) {
        const int m = MP + s; f32x4 v[4];
        row_load<SF32>(base_s, (size_t)s, lane, v);
        if (nslab == 11) samp_row_fold<11>(slab, s, coef, lane, v); else if (nslab == 4) samp_row_fold<4>(slab, s, coef, lane, v);
        if (nslab > 0 && MODE != 2 && pvar == 0) {
#pragma unroll
            for (int j = 0; j < 2; ++j) st8bf(xr + (size_t)m * D + 512 * j + 8 * lane, v[2 * j], v[2 * j + 1]); }
        norm_finish<MODE>(m, v, gv, dst, shift_in, out, lane);
    }
    const bool xa = F.G == 256; const int mstep = xa ? 256 : NGW, mend = xa ? PT * ((F.vcu >> 5) + 1) : MP;
    int m = xa ? PT * (F.vcu >> 5) + (F.vcu & 31) * NWAVES + F.wave : gw; f32x4 v[4];
    if (m < mend) row_load<PF32>(base_p, (size_t)m, lane, v);
    while (m < mend) {
        const int mn = m + mstep; f32x4 vn[4];
#pragma unroll
        for (int j = 0; j < 4; ++j) vn[j] = (f32x4){0.f, 0.f, 0.f, 0.f};
        if (mn < mend) row_load<PF32>(base_p, (size_t)mn, lane, vn);
        norm_finish<MODE>(m, v, gv, dst, shift_in, out, lane);
#pragma unroll
        for (int j = 0; j < 4; ++j) v[j] = vn[j];
        m = mn;
    }
}

__device__ __forceinline__ void mix_rows(const Frame& F, const bf16* xr_p, const float* xs_in, int nslab, float coef, const float* slab, bf16* xr, const float* gain, const float* mu, bf16* XM,
                                         const float* shift_in, float* out, const int pvar) {
    const int gw = F.vcu * NWAVES + F.wave, NGW = F.G * NWAVES, lane = F.lane;
    f32x4 gv[4];
#pragma unroll
    for (int j = 0; j < 4; ++j) gv[j] = *(const f32x4*)(gain + 512 * (j >> 1) + 8 * lane + 4 * (j & 1));
    __syncthreads();
    for (int i = F.tid; i < 6 * D / 8; i += NWAVES * 64) { const int s = i >> 7, e8 = i & 127; const float* mup = mu + ((0x541320 >> (4 * s)) & 15) * D + 8 * e8;
        const f32x4 ma = *(const f32x4*)mup, mb = *(const f32x4*)(mup + 4); v4u w; w.x = pkbf(ma[0], ma[1]); w.y = pkbf(ma[2], ma[3]); w.z = pkbf(mb[0], mb[1]); w.w = pkbf(mb[2], mb[3]);
        *(LAS v4u*)(F.lds + (s * D + 8 * e8) * 2) = w; }
    __syncthreads();
#define MIX_NORM(v) do { float ss_ = 0.f; \
        _Pragma("unroll") for (int j = 0; j < 4; ++j) ss_ += (v[j].x * v[j].x + v[j].y * v[j].y) + (v[j].z * v[j].z + v[j].w * v[j].w); \
        const float r_ = 1.0f / sqrtf(wave_sum(ss_) * (1.f / D) + NORM_EPS); \
        _Pragma("unroll") for (int j = 0; j < 4; ++j) v[j] = v[j] * r_ * gv[j]; } while (0)
#define MIX_EMIT(m, xn, pv) do { f32x4 df_[4]; int lo_ = 16 * lane; asm volatile("" : "+v"(lo_));     \
        _Pragma("unroll") for (int j = 0; j < 4; ++j) df_[j] = pv[j] - xn[j]; \
        _Pragma("unroll") for (int s = 0; s < 6; ++s) \
        _Pragma("unroll") for (int j = 0; j < 2; ++j) { const v4u mw = *(const LAS v4u*)(F.lds + (s * D + 512 * j) * 2 + lo_); const f32x4 ma = {bflo(mw.x), bfhi(mw.x), bflo(mw.y), bfhi(mw.y)}, mb = {bflo(mw.z), bfhi(mw.z), bflo(mw.w), bfhi(mw.w)}; \
            st8bf(XM + ((size_t)s * M + (m)) * D + 512 * j + 8 * lane, xn[2 * j] + ma * df_[2 * j], xn[2 * j + 1] + mb * df_[2 * j + 1]); } } while (0)
    for (int sq = (F.G == 256 ? (((F.vcu & 1) == 0 && F.wave == 0) ? (F.vcu >> 1) : SB) : F.wave * F.G + F.vcu); sq < SB; sq += NWAVES * F.G) {
        f32x4 pv[4];
#pragma unroll
        for (int j = 0; j < 4; ++j) pv[j] = *(const f32x4*)(shift_in + (size_t)sq * D + 512 * (j >> 1) + 8 * lane + 4 * (j & 1));
        for (int t = 0; t < STK; ++t) { const int srow = STK * sq + t, m = MP + srow; f32x4 v[4];
            row_load<true>(xs_in, (size_t)srow, lane, v);
            if (nslab == 11) samp_row_fold<11>(slab, srow, coef, lane, v); else if (nslab == 4) samp_row_fold<4>(slab, srow, coef, lane, v);
            if (nslab > 0 && pvar == 0) {
#pragma unroll
                for (int j = 0; j < 2; ++j) st8bf(xr + (size_t)m * D + 512 * j + 8 * lane, v[2 * j], v[2 * j + 1]); }
            MIX_NORM(v);
            MIX_EMIT(m, v, pv);
#pragma unroll
            for (int j = 0; j < 4; ++j) pv[j] = v[j];
        }
#pragma unroll
        for (int j = 0; j < 4; ++j) *(f32x4*)(out + O_S_SHIFT + (size_t)sq * D + 512 * (j >> 1) + 8 * lane + 4 * (j & 1)) = pv[j];
    }
    for (int blk = gw; blk < MP / 8; blk += NGW) {
        const int m0 = 8 * blk; f32x4 pv[4], v[4];
        row_load<false>(xr_p, (size_t)m0, lane, v);
        if ((m0 & (PT - 1)) == 0) {
#pragma unroll
            for (int j = 0; j < 4; ++j) pv[j] = (f32x4){0.f, 0.f, 0.f, 0.f};
        } else { row_load<false>(xr_p, (size_t)(m0 - 1), lane, pv); MIX_NORM(pv); }
        for (int i = 0; i < 8; ++i) { const int m = m0 + i; f32x4 vn[4];
#pragma unroll
            for (int j = 0; j < 4; ++j) vn[j] = (f32x4){0.f, 0.f, 0.f, 0.f};
            if (i < 7) row_load<false>(xr_p, (size_t)(m + 1), lane, vn);
            MIX_NORM(v);
            MIX_EMIT(m, v, pv);
            if ((m & (PT - 1)) == PT - 1) {
#pragma unroll
                for (int j = 0; j < 4; ++j) *(f32x4*)(out + O_P_SHIFT + (size_t)(m >> 11) * D + 512 * (j >> 1) + 8 * lane + 4 * (j & 1)) = v[j]; }
#pragma unroll
            for (int j = 0; j < 4; ++j) { pv[j] = v[j]; v[j] = vn[j]; }
        }
    }
#undef MIX_NORM
#undef MIX_EMIT
}

constexpr int RW_KK = 0, RW_DD = 4096, RW_BB = 8192, RW_KP = 12288, RW_RR = 16384, RW_VV = 20480, RW_YY = 24576;
__device__ __forceinline__ void rwkv_chain(const Frame& F, int row0, int T, int h, const float* S0, float* ST,
                                           const bf16* Rb, const bf16* Kb, const bf16* Vb, const bf16* Db, const bf16* Ab, bf16* Gb,
                                           const float* k_k, const float* k_a, const float* r_k, const float* gn_w, const float* gn_b, const bool do_store, const int pvar) {
    LAS float* L = (LAS float*)F.lds;
    const int tid = F.tid, lane = F.lane, w = F.wave;
    const int cg = tid & 7, tt = tid >> 3;
    const int srow = 8 * w + (lane >> 3);
    float S[8];
    if (S0) { const f32x4 a = *(const f32x4*)(S0 + srow * 64 + 8 * cg), b = *(const f32x4*)(S0 + srow * 64 + 8 * cg + 4);
        S[0] = a.x; S[1] = a.y; S[2] = a.z; S[3] = a.w; S[4] = b.x; S[5] = b.y; S[6] = b.z; S[7] = b.w; }
    else {
#pragma unroll
        for (int j = 0; j < 8; ++j) S[j] = 0.f; }
    const int ch = h * 64 + 8 * cg;
    float ckk[8], cka[8], crk[8], cgw[8], cgb[8];
#pragma unroll
    for (int j = 0; j < 8; ++j) { ckk[j] = k_k[ch + j]; cka[j] = k_a[ch + j]; crk[j] = r_k[ch + j]; cgw[j] = gn_w[ch + j]; cgb[j] = gn_b[ch + j]; }
    const int nch = (T + 63) >> 6;
    v4u pr = {0, 0, 0, 0}, pk = pr, pv = pr, pd = pr, pa = pr, pg = pr;
    { const int nt0 = T < 64 ? T : 64;
      if (tt < nt0) { const size_t off = (size_t)(row0 + tt) * D + ch;
          pr = *(const v4u*)(Rb + off); pk = *(const v4u*)(Kb + off); pv = *(const v4u*)(Vb + off); pd = *(const v4u*)(Db + off); pa = *(const v4u*)(Ab + off); pg = *(const v4u*)(Gb + off); } }
    float bon = 0.f, vv[8], gg[8];
    for (int c = 0; c < nch; ++c) {
        const int nt = (T - 64 * c) < 64 ? (T - 64 * c) : 64;
        const bool valid = tt < nt;
        {
            float r8[8], k8[8], d8[8], a8[8];
            unpack8(pr, r8); unpack8(pk, k8); unpack8(pv, vv); unpack8(pd, d8); unpack8(pa, a8); unpack8(pg, gg);
            float kk[8], ss = 0.f;
#pragma unroll
            for (int j = 0; j < 8; ++j) { kk[j] = k8[j] * ckk[j]; ss += kk[j] * kk[j]; }
            ss = red8(ss);
            const float inv = __builtin_amdgcn_rsqf(fmaxf(ss, 1e-24f));
            float kp[8], bsum = 0.f;
#pragma unroll
            for (int j = 0; j < 8; ++j) { kk[j] *= inv; kp[j] = k8[j] * (1.f + (a8[j] - 1.f) * cka[j]); bsum += r8[j] * kp[j] * crk[j]; }
            bon = red8(bsum);
            if (valid) {
                LAS float* p = L + tt * 64 + 8 * cg;
                *(LAS f32x4*)(p + RW_KK) = (f32x4){-kk[0], -kk[1], -kk[2], -kk[3]}; *(LAS f32x4*)(p + RW_KK + 4) = (f32x4){-kk[4], -kk[5], -kk[6], -kk[7]};
                *(LAS f32x4*)(p + RW_DD) = (f32x4){1.f - d8[0], 1.f - d8[1], 1.f - d8[2], 1.f - d8[3]}; *(LAS f32x4*)(p + RW_DD + 4) = (f32x4){1.f - d8[4], 1.f - d8[5], 1.f - d8[6], 1.f - d8[7]};
                *(LAS f32x4*)(p + RW_BB) = (f32x4){kk[0] * a8[0], kk[1] * a8[1], kk[2] * a8[2], kk[3] * a8[3]}; *(LAS f32x4*)(p + RW_BB + 4) = (f32x4){kk[4] * a8[4], kk[5] * a8[5], kk[6] * a8[6], kk[7] * a8[7]};
                *(LAS f32x4*)(p + RW_KP) = (f32x4){kp[0], kp[1], kp[2], kp[3]}; *(LAS f32x4*)(p + RW_KP + 4) = (f32x4){kp[4], kp[5], kp[6], kp[7]};
                *(LAS f32x4*)(p + RW_RR) = (f32x4){r8[0], r8[1], r8[2], r8[3]}; *(LAS f32x4*)(p + RW_RR + 4) = (f32x4){r8[4], r8[5], r8[6], r8[7]};
                *(LAS f32x4*)(p + RW_VV) = (f32x4){vv[0], vv[1], vv[2], vv[3]}; *(LAS f32x4*)(p + RW_VV + 4) = (f32x4){vv[4], vv[5], vv[6], vv[7]};
            }
        }
        __syncthreads();
        if (c + 1 < nch) { const int nt1 = (T - 64 * (c + 1)) < 64 ? (T - 64 * (c + 1)) : 64;
            if (tt < nt1) { const size_t off = (size_t)(row0 + 64 * (c + 1) + tt) * D + ch;
                pr = *(const v4u*)(Rb + off); pk = *(const v4u*)(Kb + off); pv = *(const v4u*)(Vb + off); pd = *(const v4u*)(Db + off); pa = *(const v4u*)(Ab + off); pg = *(const v4u*)(Gb + off); } }
        {
            typedef float f2 __attribute__((ext_vector_type(2)));
            f2 S2[4] = {{S[0], S[1]}, {S[2], S[3]}, {S[4], S[5]}, {S[6], S[7]}};
            const LAS float* p = L + 8 * cg;
            LAS float* yw = L + RW_YY + srow;
            const LAS float* vp = L + RW_VV + srow;
#define RW_LD(N, Dd, B, Q, R, VR, t_) do { const LAS float* p_ = p + (t_) * 64; \
                N[0] = *(const LAS f32x4*)(p_ + RW_KK); N[1] = *(const LAS f32x4*)(p_ + RW_KK + 4); Dd[0] = *(const LAS f32x4*)(p_ + RW_DD); Dd[1] = *(const LAS f32x4*)(p_ + RW_DD + 4); \
                B[0] = *(const LAS f32x4*)(p_ + RW_BB); B[1] = *(const LAS f32x4*)(p_ + RW_BB + 4); Q[0] = *(const LAS f32x4*)(p_ + RW_KP); Q[1] = *(const LAS f32x4*)(p_ + RW_KP + 4); \
                R[0] = *(const LAS f32x4*)(p_ + RW_RR); R[1] = *(const LAS f32x4*)(p_ + RW_RR + 4); VR = vp[(t_) * 64]; } while (0)
#define RW_STEP(N, Dd, B, Q, R, VR, t_) do { \
                f2 a_ = S2[0] * (f2){N[0].x, N[0].y}; a_ = S2[1] * (f2){N[0].z, N[0].w} + a_; a_ = S2[2] * (f2){N[1].x, N[1].y} + a_; a_ = S2[3] * (f2){N[1].z, N[1].w} + a_; \
                const float sa_ = red8(a_.x + a_.y); const f2 sv_ = {sa_, sa_}, vv_ = {VR, VR}; \
                S2[0] = S2[0] * (f2){Dd[0].x, Dd[0].y} + (sv_ * (f2){B[0].x, B[0].y} + vv_ * (f2){Q[0].x, Q[0].y}); \
                S2[1] = S2[1] * (f2){Dd[0].z, Dd[0].w} + (sv_ * (f2){B[0].z, B[0].w} + vv_ * (f2){Q[0].z, Q[0].w}); \
                S2[2] = S2[2] * (f2){Dd[1].x, Dd[1].y} + (sv_ * (f2){B[1].x, B[1].y} + vv_ * (f2){Q[1].x, Q[1].y}); \
                S2[3] = S2[3] * (f2){Dd[1].z, Dd[1].w} + (sv_ * (f2){B[1].z, B[1].w} + vv_ * (f2){Q[1].z, Q[1].w}); \
                f2 y_ = S2[0] * (f2){R[0].x, R[0].y}; y_ = S2[1] * (f2){R[0].z, R[0].w} + y_; y_ = S2[2] * (f2){R[1].x, R[1].y} + y_; y_ = S2[3] * (f2){R[1].z, R[1].w} + y_; \
                yw[(t_) * 64] = red8(y_.x + y_.y); } while (0)
            f32x4 nA[2], dA[2], bA[2], qA[2], rA[2]; float vA;
            for (int t = 0; t < nt; ++t) { RW_LD(nA, dA, bA, qA, rA, vA, t); RW_STEP(nA, dA, bA, qA, rA, vA, t); }
#undef RW_LD
#undef RW_STEP
            S[0] = S2[0].x; S[1] = S2[0].y; S[2] = S2[1].x; S[3] = S2[1].y; S[4] = S2[2].x; S[5] = S2[2].y; S[6] = S2[3].x; S[7] = S2[3].y;
        }
        __syncthreads();
        if (pvar != 4) {
            f32x4 y0 = {0.f, 0.f, 0.f, 0.f}, y1 = y0;
            if (valid) { y0 = *(const LAS f32x4*)(L + RW_YY + tt * 64 + 8 * cg); y1 = *(const LAS f32x4*)(L + RW_YY + tt * 64 + 8 * cg + 4); }
            float yy[8] = {y0.x, y0.y, y0.z, y0.w, y1.x, y1.y, y1.z, y1.w};
            float s1 = 0.f;
#pragma unroll
            for (int j = 0; j < 8; ++j) s1 += yy[j];
            const float mean = red8(s1) * (1.f / 64.f);
            float s2 = 0.f;
#pragma unroll
            for (int j = 0; j < 8; ++j) { yy[j] -= mean; s2 += yy[j] * yy[j]; }
            const float rstd = __builtin_amdgcn_rsqf(red8(s2) * (1.f / 64.f) + GN_EPS);
            float o[8];
#pragma unroll
            for (int j = 0; j < 8; ++j) o[j] = ((yy[j] * rstd) * cgw[j] + cgb[j] + bon * vv[j]) * gg[j];
            if (valid && do_store) *(v4u*)(Gb + (size_t)(row0 + 64 * c + tt) * D + ch) = pack8(o);
        }
    }
    *(f32x4*)(ST + srow * 64 + 8 * cg) = (f32x4){S[0], S[1], S[2], S[3]}; *(f32x4*)(ST + srow * 64 + 8 * cg + 4) = (f32x4){S[4], S[5], S[6], S[7]};
    __syncthreads();
}

constexpr int RH_TC = 32, RH_BUF = 12288;
constexpr int RH_KK = 0, RH_DD = 2048, RH_BB = 4096, RH_KP = 6144, RH_RR = 8192, RH_VV = 10240, RH_YY = 11264;
__device__ __forceinline__ void rwkv_half_chain(const Frame& F, int b, int h, int half, float* ST, const bf16* Rb, const bf16* Kb, const bf16* Vb, const bf16* Db, const bf16* Ab,
                                                bf16* YRAW, float* BON, const float* k_k, const float* k_a, const float* r_k, const int pvar) {
    LAS float* L = (LAS float*)F.lds;
    const int tid = F.tid, lane = F.lane, w = F.wave, row0 = b * PT;
    constexpr int nch = PT / RH_TC;
    if (w < 4) {
        const int srow = 8 * w + (lane >> 3), cq = lane & 7;
        f32x4 S4 = {0.f, 0.f, 0.f, 0.f}, S5 = S4;
        __syncthreads();
        __builtin_amdgcn_s_setprio(3);
        for (int c = 0; c < nch; ++c) {
            const LAS float* p = L + (c & 1) * RH_BUF + 8 * cq;
            LAS float* yw = L + (c & 1) * RH_BUF + RH_YY + srow;
            const LAS float* vp = L + (c & 1) * RH_BUF + RH_VV + srow;
#define RH_LD(N, Dd, B, Q, R, VR, t_) do { const LAS float* p_ = p + (t_) * 64; \
                N[0] = *(const LAS f32x4*)(p_ + RH_KK); N[1] = *(const LAS f32x4*)(p_ + RH_KK + 4); Dd[0] = *(const LAS f32x4*)(p_ + RH_DD); Dd[1] = *(const LAS f32x4*)(p_ + RH_DD + 4); \
                B[0] = *(const LAS f32x4*)(p_ + RH_BB); B[1] = *(const LAS f32x4*)(p_ + RH_BB + 4); Q[0] = *(const LAS f32x4*)(p_ + RH_KP); Q[1] = *(const LAS f32x4*)(p_ + RH_KP + 4); \
                R[0] = *(const LAS f32x4*)(p_ + RH_RR); R[1] = *(const LAS f32x4*)(p_ + RH_RR + 4); VR = vp[(t_) * 32]; } while (0)
#define RH_STEP(N, Dd, B, Q, R, VR, t_) do { \
                const f32x4 pa_ = S4 * N[0] + S5 * N[1]; const float sa_ = red8((pa_.x + pa_.y) + (pa_.z + pa_.w)); \
                S4 = S4 * Dd[0] + (B[0] * sa_ + Q[0] * VR); S5 = S5 * Dd[1] + (B[1] * sa_ + Q[1] * VR); \
                const f32x4 ya_ = S4 * R[0] + S5 * R[1]; yw[(t_) * 32] = red8((ya_.x + ya_.y) + (ya_.z + ya_.w)); } while (0)
            f32x4 nA[2], dA[2], bA[2], qA[2], rA[2], nB[2], dB[2], bB[2], qB[2], rB[2]; float vA, vB;
            RH_LD(nA, dA, bA, qA, rA, vA, 0);
            if (pvar != 3)
            for (int t = 0; t < RH_TC; t += 2) {
                RH_LD(nB, dB, bB, qB, rB, vB, t + 1);
                RH_STEP(nA, dA, bA, qA, rA, vA, t);
                RH_LD(nA, dA, bA, qA, rA, vA, (t + 2 < RH_TC ? t + 2 : t + 1));
                RH_STEP(nB, dB, bB, qB, rB, vB, t + 1);
            }
#undef RH_LD
#undef RH_STEP
            __syncthreads();
        }
        __builtin_amdgcn_s_setprio(0);
        *(f32x4*)(ST + (32 * half + srow) * 64 + 8 * cq) = S4; *(f32x4*)(ST + (32 * half + srow) * 64 + 8 * cq + 4) = S5;
    } else {
        const int ht = tid - 256, cg = ht & 7, tt = ht >> 3;
        const int ch = h * 64 + 8 * cg, vch = h * 64 + 32 * half + 4 * cg;
        float ckk[8], cka[8], crk[8];
#pragma unroll
        for (int j = 0; j < 8; ++j) { ckk[j] = k_k[ch + j]; cka[j] = k_a[ch + j]; crk[j] = r_k[ch + j]; }
        v4u pr, pk, pd, pa; uint2 pv;
#define RH_LOAD(cc) do { const size_t off_ = (size_t)(row0 + RH_TC * (cc) + tt) * D; pr = *(const v4u*)(Rb + off_ + ch); pk = *(const v4u*)(Kb + off_ + ch); pd = *(const v4u*)(Db + off_ + ch); \
            pa = *(const v4u*)(Ab + off_ + ch); pv = *(const uint2*)(Vb + off_ + vch); } while (0)
#define RH_PREP(cc) do { float r8[8], k8[8], d8[8], a8[8]; unpack8(pr, r8); unpack8(pk, k8); unpack8(pd, d8); unpack8(pa, a8); \
            float kk[8], ss = 0.f; _Pragma("unroll") for (int j = 0; j < 8; ++j) { kk[j] = k8[j] * ckk[j]; ss += kk[j] * kk[j]; } \
            ss = red8(ss); const float inv = __builtin_amdgcn_rsqf(fmaxf(ss, 1e-24f)); \
            float kp[8], bsum = 0.f; _Pragma("unroll") for (int j = 0; j < 8; ++j) { kk[j] *= inv; kp[j] = k8[j] * (1.f + (a8[j] - 1.f) * cka[j]); bsum += r8[j] * kp[j] * crk[j]; } \
            const float bon = red8(bsum); if (half == 0 && cg == 0) BON[(size_t)(row0 + RH_TC * (cc) + tt) * 16 + h] = bon; \
            LAS float* p = L + ((cc) & 1) * RH_BUF + tt * 64 + 8 * cg; \
            *(LAS f32x4*)(p + RH_KK) = (f32x4){-kk[0], -kk[1], -kk[2], -kk[3]}; *(LAS f32x4*)(p + RH_KK + 4) = (f32x4){-kk[4], -kk[5], -kk[6], -kk[7]}; \
            *(LAS f32x4*)(p + RH_DD) = (f32x4){1.f - d8[0], 1.f - d8[1], 1.f - d8[2], 1.f - d8[3]}; *(LAS f32x4*)(p + RH_DD + 4) = (f32x4){1.f - d8[4], 1.f - d8[5], 1.f - d8[6], 1.f - d8[7]}; \
            *(LAS f32x4*)(p + RH_BB) = (f32x4){kk[0] * a8[0], kk[1] * a8[1], kk[2] * a8[2], kk[3] * a8[3]}; *(LAS f32x4*)(p + RH_BB + 4) = (f32x4){kk[4] * a8[4], kk[5] * a8[5], kk[6] * a8[6], kk[7] * a8[7]}; \
            *(LAS f32x4*)(p + RH_KP) = (f32x4){kp[0], kp[1], kp[2], kp[3]}; *(LAS f32x4*)(p + RH_KP + 4) = (f32x4){kp[4], kp[5], kp[6], kp[7]}; \
            *(LAS f32x4*)(p + RH_RR) = (f32x4){r8[0], r8[1], r8[2], r8[3]}; *(LAS f32x4*)(p + RH_RR + 4) = (f32x4){r8[4], r8[5], r8[6], r8[7]}; \
            *(LAS f32x4*)(L + ((cc) & 1) * RH_BUF + RH_VV + tt * 32 + 4 * cg) = (f32x4){bflo(pv.x), bfhi(pv.x), bflo(pv.y), bfhi(pv.y)}; } while (0)
#define RH_POST(cc) do { const f32x4 y4 = *(const LAS f32x4*)(L + ((cc) & 1) * RH_BUF + RH_YY + tt * 32 + 4 * cg); uint2 o; o.x = pkbf(y4.x, y4.y); o.y = pkbf(y4.z, y4.w); \
            *(uint2*)(YRAW + (size_t)(row0 + RH_TC * (cc) + tt) * D + vch) = o; } while (0)
        RH_LOAD(0); RH_PREP(0); RH_LOAD(1);
        __syncthreads();
        for (int c = 0; c < nch; ++c) {
            if (c > 0) RH_POST(c - 1);
            if (c + 1 < nch) { RH_PREP(c + 1); if (c + 2 < nch) RH_LOAD(c + 2); }
            __syncthreads();
        }
        RH_POST(nch - 1);
#undef RH_LOAD
#undef RH_PREP
#undef RH_POST
    }
    __syncthreads();
}
__device__ __forceinline__ void rwkv_finish(const Frame& F, const bf16* YRAW, const float* BON, const bf16* Vb, bf16* Gb, const float* gn_w, const float* gn_b) {
    const int gt = (F.vcu * NWAVES + F.wave) * 64 + F.lane, NT = F.G * NWAVES * 64;
    for (int task = gt; task < MP * 128; task += NT) {
        const int cg = task & 7, hh = (task >> 3) & 15, row = task >> 7; const size_t off = (size_t)row * D + hh * 64 + 8 * cg;
        float yy[8], vv[8], gg[8]; unpack8(*(const v4u*)(YRAW + off), yy); unpack8(*(const v4u*)(Vb + off), vv); unpack8(*(const v4u*)(Gb + off), gg);
        const float bon = BON[(size_t)row * 16 + hh];
        float s1 = 0.f;
#pragma unroll
        for (int j = 0; j < 8; ++j) s1 += yy[j];
        const float mean = red8(s1) * (1.f / 64.f);
        float s2 = 0.f;
#pragma unroll
        for (int j = 0; j < 8; ++j) { yy[j] -= mean; s2 += yy[j] * yy[j]; }
        const float rstd = __builtin_amdgcn_rsqf(red8(s2) * (1.f / 64.f) + GN_EPS);
        const f32x4 w0 = *(const f32x4*)(gn_w + hh * 64 + 8 * cg), w1 = *(const f32x4*)(gn_w + hh * 64 + 8 * cg + 4), b0 = *(const f32x4*)(gn_b + hh * 64 + 8 * cg), b1 = *(const f32x4*)(gn_b + hh * 64 + 8 * cg + 4);
        const float gw[8] = {w0.x, w0.y, w0.z, w0.w, w1.x, w1.y, w1.z, w1.w}, gb[8] = {b0.x, b0.y, b0.z, b0.w, b1.x, b1.y, b1.z, b1.w};
        float o[8];
#pragma unroll
        for (int j = 0; j < 8; ++j) o[j] = ((yy[j] * rstd) * gw[j] + gb[j] + bon * vv[j]) * gg[j];
        *(v4u*)(Gb + off) = pack8(o);
    }
}

constexpr int PBY = 144;
constexpr int RPY = 272;
constexpr int ML_RQK = 0, ML_S = 0, ML_KT = 9216, ML_RV = 18432, ML_Q = 35840, ML_K = 45056, ML_HB = 35840, ML_VT = 54272, ML_C = 72704, ML_F = 91136;
constexpr int MF_N = 0, MF_QN = 64, MF_RS = 128, MF_HS = 256, MF_CW = 384, MF_B63 = 1024, MF_P63 = 1056, MF_MC = 1088  , MF_GB = 1152, MF_GP = MF_GB + 2048, MF_GA = MF_GP + 2048;
typedef __attribute__((address_space(3))) unsigned short lds_u16;
#define MFMA16(a, b, c) __builtin_amdgcn_mfma_f32_16x16x32_bf16((a), (b), (c), 0, 0, 0)
__device__ __forceinline__ void mlstm_gate_tables(const Frame& F, int b, int hh, const float* IFb) {
    LAS float* Fl = (LAS float*)(F.lds + ML_F); const int lane = F.lane, w = F.wave;
#pragma unroll
    for (int q = 0; q < 4; ++q) { const int cc = w + 8 * q; const size_t ro_ = (size_t)(b * PT + 64 * cc + lane) * 16;
        const float li = IFb[ro_ + hh], lf = IFb[ro_ + 8 + hh];
        float bc = lf;
        bc += __builtin_bit_cast(float, __builtin_amdgcn_update_dpp(0, __builtin_bit_cast(int, bc), 0x111, 0xF, 0xF, true));
        bc += __builtin_bit_cast(float, __builtin_amdgcn_update_dpp(0, __builtin_bit_cast(int, bc), 0x112, 0xF, 0xF, true));
        bc += __builtin_bit_cast(float, __builtin_amdgcn_update_dpp(0, __builtin_bit_cast(int, bc), 0x114, 0xF, 0xF, true));
        bc += __builtin_bit_cast(float, __builtin_amdgcn_update_dpp(0, __builtin_bit_cast(int, bc), 0x118, 0xF, 0xF, true));
        bc += __builtin_bit_cast(float, __builtin_amdgcn_update_dpp(0, __builtin_bit_cast(int, bc), 0x142, 0xA, 0xF, false));
        bc += __builtin_bit_cast(float, __builtin_amdgcn_update_dpp(0, __builtin_bit_cast(int, bc), 0x143, 0xC, 0xF, false));
        const float av = li - bc; float pm = av; const int NEG_ = __builtin_bit_cast(int, -3.0e38f);
        pm = fmaxf(pm, __builtin_bit_cast(float, __builtin_amdgcn_update_dpp(NEG_, __builtin_bit_cast(int, pm), 0x111, 0xF, 0xF, false)));
        pm = fmaxf(pm, __builtin_bit_cast(float, __builtin_amdgcn_update_dpp(NEG_, __builtin_bit_cast(int, pm), 0x112, 0xF, 0xF, false)));
        pm = fmaxf(pm, __builtin_bit_cast(float, __builtin_amdgcn_update_dpp(NEG_, __builtin_bit_cast(int, pm), 0x114, 0xF, 0xF, false)));
        pm = fmaxf(pm, __builtin_bit_cast(float, __builtin_amdgcn_update_dpp(NEG_, __builtin_bit_cast(int, pm), 0x118, 0xF, 0xF, false)));
        pm = fmaxf(pm, __builtin_bit_cast(float, __builtin_amdgcn_update_dpp(NEG_, __builtin_bit_cast(int, pm), 0x142, 0xA, 0xF, false)));
        pm = fmaxf(pm, __builtin_bit_cast(float, __builtin_amdgcn_update_dpp(NEG_, __builtin_bit_cast(int, pm), 0x143, 0xC, 0xF, false)));
        Fl[MF_GB + cc * 64 + lane] = bc; Fl[MF_GP + cc * 64 + lane] = pm; Fl[MF_GA + cc * 64 + lane] = av;
        if (lane == 63) { Fl[MF_B63 + cc] = bc; Fl[MF_P63 + cc] = pm; } }
    __syncthreads();
    if (w == 0) {
        const int cc = lane & 31; float a = Fl[MF_B63 + cc], d = a + Fl[MF_P63 + cc];
#pragma unroll
        for (int o = 1; o < 32; o <<= 1) { const float pa = __shfl_up(a, o), pd = __shfl_up(d, o); if (cc >= o) { d = fmaxf(pd + a, d); a = pa + a; } }
        const float mnext = fmaxf(a, d);
        if (lane < 32) { Fl[MF_MC + cc + 1] = mnext; if (cc == 0) Fl[MF_MC] = 0.f; } }
    __syncthreads();
}
constexpr int ML_NSEG = 4, ML_SEGC = PT / 64 / ML_NSEG, ML_SEGSZ = 128 * 64 + 64;
__device__ __forceinline__ void mlstm_prompt_chain(const Frame& F, int b, int hh, const int seg, const bf16* QKR, const bf16* VVb, const bf16* OOb, const float* IFb, bf16* HOb,
                                                   const float* conv_w, const float* conv_b, const float* norm_w, float* NUM, float* DEN, bf16* Qs, float* SEG, const int pvar) {
    LAS unsigned char* lds = F.lds; LAS float* Fl = (LAS float*)(lds + ML_F);
    const bool defer = seg > 0; const int c_lo = seg * ML_SEGC, c_hi = c_lo + ML_SEGC;
    const int tid = F.tid, lane = F.lane, w = F.wave, fr = lane & 15, fq = lane >> 4;
    for (int i = tid; i < 128 * 72; i += 512) ((lds_u16*)(lds + ML_C))[i] = 0;
    if (tid < 64) Fl[MF_N + tid] = 0.f;
    for (int i = tid; i < 640; i += 512) { const int j = i >> 7, c = i & 127, gc = c < 64 ? hh * 64 + c : 512 + hh * 64 + (c - 64); Fl[MF_CW + i] = j < 4 ? conv_w[j * D + gc] : conv_b[gc]; }
    f32x4 Cacc[4];
#pragma unroll
    for (int k = 0; k < 4; ++k) Cacc[k] = (f32x4){0.f, 0.f, 0.f, 0.f};
    const int og = tid & 15, ot = tid >> 4;
    float nw[8];
#pragma unroll
    for (int e = 0; e < 8; ++e) nw[e] = norm_w[hh * 128 + 8 * og + e];
    v4u rq[3], rv[2], ro[2];
#define ML_LOAD_QKV(cc) do { const int rowc_ = b * PT + 64 * (cc); \
        _Pragma("unroll") for (int i = 0; i < 3; ++i) { const int q = tid + 512 * i, r = q >> 4, j = q & 15, tok = 64 * (cc) - 3 + r; rq[i] = (v4u){0u, 0u, 0u, 0u}; \
            if (q < 67 * 16 && tok >= 0) rq[i] = *(const v4u*)(QKR + (size_t)(b * PT + tok) * D + (j < 8 ? hh * 64 + 8 * j : 512 + hh * 64 + 8 * (j - 8))); } \
        _Pragma("unroll") for (int i = 0; i < 2; ++i) rv[i] = *(const v4u*)(VVb + (size_t)(rowc_ + ot + 32 * i) * D + hh * 128 + 8 * og); \
        } while (0)
#define ML_LOAD_O(cc) do { const int rowc_ = b * PT + 64 * (cc); \
        _Pragma("unroll") for (int i = 0; i < 2; ++i) ro[i] = *(const v4u*)(OOb + (size_t)(rowc_ + ot + 32 * i) * D + hh * 128 + 8 * og); } while (0)
    ML_LOAD_QKV(c_lo);
    mlstm_gate_tables(F, b, hh, IFb);
    for (int c = c_lo; c < c_hi; ++c) {
        const int rowc = b * PT + 64 * c;
        const float m_c = Fl[MF_MC + c], m_n = Fl[MF_MC + c + 1], b63 = Fl[MF_B63 + c];
#pragma unroll
        for (int i = 0; i < 3; ++i) { const int q = tid + 512 * i; if (q < 67 * 16) *(LAS v4u*)(lds + ML_RQK + (q >> 4) * RPY + 16 * (q & 15)) = rq[i]; }
#pragma unroll
        for (int i = 0; i < 2; ++i) *(LAS v4u*)(lds + ML_RV + (ot + 32 * i) * RPY + 16 * og) = rv[i];
        if (c + 1 < c_hi) ML_LOAD_QKV(c + 1);
        if (!defer) ML_LOAD_O(c);
        __syncthreads();
        float kreg[8] = {0.f, 0.f, 0.f, 0.f, 0.f, 0.f, 0.f, 0.f};
        if (pvar != 3)
#pragma unroll
        for (int i = 0; i < 2; ++i) {
            const int g = w + 8 * i, t = lane;
            float x[4][8];
#pragma unroll
            for (int j = 0; j < 4; ++j) unpack8(*(const LAS v4u*)(lds + ML_RQK + (t + j) * RPY + 16 * g), x[j]);
            float val[8];
#pragma unroll
            for (int h2 = 0; h2 < 2; ++h2) { f32x4 a = *(const LAS f32x4*)(Fl + MF_CW + 4 * 128 + 8 * g + 4 * h2);
#pragma unroll
                for (int j = 0; j < 4; ++j) { const f32x4 cw = *(const LAS f32x4*)(Fl + MF_CW + j * 128 + 8 * g + 4 * h2);
                    a.x += cw.x * x[j][4 * h2]; a.y += cw.y * x[j][4 * h2 + 1]; a.z += cw.z * x[j][4 * h2 + 2]; a.w += cw.w * x[j][4 * h2 + 3]; }
                val[4 * h2] = siluf_(a.x); val[4 * h2 + 1] = siluf_(a.y); val[4 * h2 + 2] = siluf_(a.z); val[4 * h2 + 3] = siluf_(a.w); }
            if (i == 0) {
#pragma unroll
                for (int e = 0; e < 8; ++e) val[e] *= 0.125f;
                *(LAS v4u*)(lds + ML_Q + t * PBY + 16 * w) = pack8(val);
            } else { *(LAS v4u*)(lds + ML_K + t * PBY + 16 * w) = pack8(val);
#pragma unroll
                for (int e = 0; e < 8; ++e) kreg[e] = val[e]; }
            const v4u vw = *(const LAS v4u*)(lds + ML_RV + t * RPY + 16 * g);
            lds_u16* vt = (lds_u16*)(lds + ML_VT) + (8 * g) * 72 + t;
            vt[0 * 72] = (unsigned short)(vw.x & 0xffffu); vt[1 * 72] = (unsigned short)(vw.x >> 16); vt[2 * 72] = (unsigned short)(vw.y & 0xffffu); vt[3 * 72] = (unsigned short)(vw.y >> 16);
            vt[4 * 72] = (unsigned short)(vw.z & 0xffffu); vt[5 * 72] = (unsigned short)(vw.z >> 16); vt[6 * 72] = (unsigned short)(vw.w & 0xffffu); vt[7 * 72] = (unsigned short)(vw.w >> 16);
        }
        __syncthreads();
        if (pvar != 4) {
        { const float wsv = __expf(b63 + Fl[MF_GA + c * 64 + lane] - m_n); lds_u16* kt = (lds_u16*)(lds + ML_KT) + (8 * w) * 72 + lane;
#pragma unroll
          for (int e = 0; e < 8; ++e) kt[e * 72] = f2bf1(kreg[e] * wsv); }
        { const int tq = tid >> 3, p = tid & 7; float q8[8]; unpack8(*(const LAS v4u*)(lds + ML_Q + tq * PBY + 16 * p), q8);
          float dsum = 0.f;
#pragma unroll
          for (int e = 0; e < 8; ++e) dsum += q8[e] * Fl[MF_N + 8 * p + e];
          dsum = red8(dsum); if (p == 0) Fl[MF_QN + tq] = dsum; }
        { const int ti = w >> 1, t = 16 * ti + fr; float rsum = 0.f; const float mxt = fmaxf(m_c, Fl[MF_GP + c * 64 + t]);
          typedef unsigned u2v_ __attribute__((ext_vector_type(2)));
#pragma unroll
          for (int jj = 0; jj < 2; ++jj) { const int sj = 2 * (w & 1) + jj; f32x4 acc = {0.f, 0.f, 0.f, 0.f};
#pragma unroll
              for (int ks = 0; ks < 2; ++ks) { const bf16x8 a = *(const LAS bf16x8*)(lds + ML_Q + (16 * ti + fr) * PBY + ks * 64 + fq * 16), bb = *(const LAS bf16x8*)(lds + ML_K + (16 * sj + fr) * PBY + ks * 64 + fq * 16);
                  acc = MFMA16(bb, a, acc); }
              const f32x4 av4 = *(const LAS f32x4*)(Fl + MF_GA + c * 64 + 16 * sj + 4 * fq);
#pragma unroll
              for (int r = 0; r < 4; ++r) { const int s_ = 16 * sj + 4 * fq + r; const float val = s_ <= t ? acc[r] * __expf(av4[r] - mxt) : 0.f; acc[r] = val; rsum += val; }
              u2v_ pw; pw.x = pkbf(acc[0], acc[1]); pw.y = pkbf(acc[2], acc[3]);
              *(LAS u2v_*)(lds + ML_S + (t * 72 + 16 * sj + 4 * fq) * 2) = pw; }
          rsum += __shfl_xor(rsum, 16); rsum += __shfl_xor(rsum, 32);
          if (fq == 0) Fl[MF_RS + t * 2 + (w & 1)] = rsum; }
        }
        __syncthreads();
        float hv[4][4] = {};
        if (pvar != 5) { const int ti = w & 3, t = 16 * ti + fr;
          const float mx = fmaxf(m_c, Fl[MF_GP + c * 64 + t]), wi = __expf(m_c - mx), ei = __expf(-(Fl[MF_GB + c * 64 + t] + mx));
          const float rden = __builtin_amdgcn_rcpf(fmaxf(fabsf(wi * Fl[MF_QN + t] + Fl[MF_RS + 2 * t] + Fl[MF_RS + 2 * t + 1]), ei)); float hq = 0.f;
#pragma unroll
          for (int i = 0; i < 4; ++i) { const int vt = 4 * (w >> 2) + i; f32x4 accA = {0.f, 0.f, 0.f, 0.f}, accB = accA;
#pragma unroll
              for (int ks = 0; ks < 2; ++ks) {
                  const bf16x8 aq = *(const LAS bf16x8*)(lds + ML_Q + (16 * ti + fr) * PBY + ks * 64 + fq * 16), bc = *(const LAS bf16x8*)(lds + ML_C + (16 * vt + fr) * PBY + ks * 64 + fq * 16);
                  accA = MFMA16(bc, aq, accA);
                  const bf16x8 as = *(const LAS bf16x8*)(lds + ML_S + (16 * ti + fr) * PBY + ks * 64 + fq * 16), bv = *(const LAS bf16x8*)(lds + ML_VT + (16 * vt + fr) * PBY + ks * 64 + fq * 16);
                  accB = MFMA16(bv, as, accB); }
              if (defer) { *(f32x4*)(NUM + (size_t)(rowc + t) * D + hh * 128 + 16 * vt + 4 * fq) = accA * wi + accB; }
              else {
#pragma unroll
              for (int r = 0; r < 4; ++r) { const float hh_ = (wi * accA[r] + accB[r]) * rden; hv[i][r] = hh_; hq += hh_ * hh_; } } }
          if (defer) { if (fq == 0 && (w >> 2) == 0) DEN[(size_t)(rowc + t) * 8 + hh] = wi * Fl[MF_QN + t] + Fl[MF_RS + 2 * t] + Fl[MF_RS + 2 * t + 1];
              *(v4u*)(Qs + (size_t)(rowc + (tid >> 3)) * 512 + hh * 64 + 8 * (tid & 7)) = *(const LAS v4u*)(lds + ML_Q + (tid >> 3) * PBY + 16 * (tid & 7)); }
          else { hq += __shfl_xor(hq, 16); hq += __shfl_xor(hq, 32);
              if (fq == 0) Fl[MF_HS + t * 2 + (w >> 2)] = hq; } }
        __syncthreads();
        if (pvar != 6) {
        if (!defer) { const int ti = w & 3, t = 16 * ti + fr; const float sc = __builtin_amdgcn_rsqf((Fl[MF_HS + 2 * t] + Fl[MF_HS + 2 * t + 1]) * (1.f / 128.f) + NORM_EPS);
          typedef unsigned u2v_ __attribute__((ext_vector_type(2)));
#pragma unroll
          for (int i = 0; i < 4; ++i) { u2v_ pw; pw.x = pkbf(hv[i][0] * sc, hv[i][1] * sc); pw.y = pkbf(hv[i][2] * sc, hv[i][3] * sc);
              *(LAS u2v_*)(lds + ML_HB + t * RPY + (16 * (4 * (w >> 2) + i) + 4 * fq) * 2) = pw; } }
        { const float wst = __expf(b63 + m_c - m_n);
          typedef unsigned u2v_ __attribute__((ext_vector_type(2)));
#pragma unroll
          for (int kt = 0; kt < 4; ++kt) { Cacc[kt] = Cacc[kt] * wst;
#pragma unroll
              for (int ks = 0; ks < 2; ++ks) { const bf16x8 a = *(const LAS bf16x8*)(lds + ML_VT + (16 * w + fr) * PBY + ks * 64 + fq * 16), bb = *(const LAS bf16x8*)(lds + ML_KT + (16 * kt + fr) * PBY + ks * 64 + fq * 16);
                  Cacc[kt] = MFMA16(bb, a, Cacc[kt]); }
              u2v_ pw; pw.x = pkbf(Cacc[kt][0], Cacc[kt][1]); pw.y = pkbf(Cacc[kt][2], Cacc[kt][3]);
              *(LAS u2v_*)(lds + ML_C + ((16 * w + fr) * 72 + 16 * kt + 4 * fq) * 2) = pw; }
          { const int kr = tid >> 3, part = tid & 7; float k8[8]; unpack8(*(const LAS v4u*)(lds + ML_KT + kr * PBY + 16 * part), k8);
            float sum = ((k8[0] + k8[1]) + (k8[2] + k8[3])) + ((k8[4] + k8[5]) + (k8[6] + k8[7]));
            sum = red8(sum);
            if (part == 0) Fl[MF_N + kr] = wst * Fl[MF_N + kr] + sum; } }
        }
        __syncthreads();
        if (!defer)
#pragma unroll
        for (int i = 0; i < 2; ++i) { const int t = ot + 32 * i; float h8[8], o8[8]; unpack8(*(const LAS v4u*)(lds + ML_HB + t * RPY + 16 * og), h8); unpack8(ro[i], o8);
#pragma unroll
            for (int e = 0; e < 8; ++e) h8[e] = h8[e] * nw[e] * o8[e];
            *(v4u*)(HOb + (size_t)(rowc + t) * D + hh * 128 + 8 * og) = pack8(h8); }
    }
#undef ML_LOAD_QKV
#undef ML_LOAD_O
    { float* sp = SEG + (size_t)((b * 8 + hh) * ML_NSEG + seg) * ML_SEGSZ;
#pragma unroll
      for (int kt = 0; kt < 4; ++kt) *(f32x4*)(sp + (16 * w + fr) * 64 + 16 * kt + 4 * fq) = Cacc[kt];
      if (w == 0) sp[128 * 64 + lane] = Fl[MF_N + lane]; }
    __syncthreads();
}
__device__ __forceinline__ void mlstm_fix_seg(const Frame& F, int b, int hh, const int seg, const bf16* QKR, const bf16* OOb, const float* IFb, bf16* HOb, const float* norm_w,
                                              const float* NUM, const float* DEN, const bf16* Qs, const float* SEG, float* out) {
    LAS unsigned char* lds = F.lds; LAS float* Fl = (LAS float*)(lds + ML_F);
    const int tid = F.tid, lane = F.lane, w = F.wave, fr = lane & 15, fq = lane >> 4;
    const int og = tid & 15, ot = tid >> 4, chain = b * 8 + hh;
    typedef unsigned u2v_ __attribute__((ext_vector_type(2)));
    float nw[8];
#pragma unroll
    for (int e = 0; e < 8; ++e) nw[e] = norm_w[hh * 128 + 8 * og + e];
    const int c_lo = seg * ML_SEGC, c_hi = c_lo + ML_SEGC;
    v4u rq, ro[2]; f32x4 numl[4]; float denl;
#define MLF_LOAD(cc, RQ, RO, NL, DL) do { const int rowc_ = b * PT + 64 * (cc); \
        RQ = *(const v4u*)(Qs + (size_t)(rowc_ + (tid >> 3)) * 512 + hh * 64 + 8 * (tid & 7)); \
        _Pragma("unroll") for (int i = 0; i < 2; ++i) RO[i] = *(const v4u*)(OOb + (size_t)(rowc_ + ot + 32 * i) * D + hh * 128 + 8 * og); \
        _Pragma("unroll") for (int i = 0; i < 4; ++i) NL[i] = *(const f32x4*)(NUM + (size_t)(rowc_ + 16 * (w & 3) + fr) * D + hh * 128 + 16 * (4 * (w >> 2) + i) + 4 * fq); \
        DL = DEN[(size_t)(rowc_ + 16 * (w & 3) + fr) * 8 + hh]; } while (0)
    MLF_LOAD(c_lo, rq, ro, numl, denl);
    f32x4 sg[ML_NSEG][4]; float sn[ML_NSEG];
#pragma unroll
    for (int j = 0; j < ML_NSEG; ++j) { const float* sp = SEG + (size_t)(chain * ML_NSEG + j) * ML_SEGSZ;
#pragma unroll
        for (int i = 0; i < 4; ++i) sg[j][i] = *(const f32x4*)(sp + 4 * (tid + 512 * i));
        sn[j] = sp[128 * 64 + (tid & 63)]; }
    mlstm_gate_tables(F, b, hh, IFb);
    {
        f32x4 cin[4]; float nin = 0.f;
#pragma unroll
        for (int i = 0; i < 4; ++i) cin[i] = (f32x4){0.f, 0.f, 0.f, 0.f};
#pragma unroll
        for (int j = 0; j < ML_NSEG - 1; ++j) if (j < seg) {
            float lw = 0.f;
            for (int cc = j * ML_SEGC; cc < (j + 1) * ML_SEGC; ++cc) lw += Fl[MF_B63 + cc] + Fl[MF_MC + cc] - Fl[MF_MC + cc + 1];
            const float Wj = __expf(lw);
#pragma unroll
            for (int i = 0; i < 4; ++i) cin[i] = cin[i] * Wj + sg[j][i];
            nin = nin * Wj + sn[j];
        }
#pragma unroll
        for (int i = 0; i < 4; ++i) { const int idx = tid + 512 * i, v = idx >> 4, k4 = (idx & 15) * 4; u2v_ pw; pw.x = pkbf(cin[i][0], cin[i][1]); pw.y = pkbf(cin[i][2], cin[i][3]);
            *(LAS u2v_*)(lds + ML_C + (v * 72 + k4) * 2) = pw; }
        if (tid < 64) Fl[MF_N + tid] = nin;
        if (seg == ML_NSEG - 1) {
            float lw = 0.f;
            for (int cc = seg * ML_SEGC; cc < (seg + 1) * ML_SEGC; ++cc) lw += Fl[MF_B63 + cc] + Fl[MF_MC + cc] - Fl[MF_MC + cc + 1];
            const float Wj = __expf(lw);
#pragma unroll
            for (int i = 0; i < 4; ++i) *(f32x4*)(out + O_P_C + (size_t)chain * 8192 + 4 * (tid + 512 * i)) = cin[i] * Wj + sg[ML_NSEG - 1][i];
            if (tid < 64) out[O_P_N + (size_t)chain * 64 + tid] = nin * Wj + sn[ML_NSEG - 1];
            if (tid == 0) out[O_P_M + chain] = Fl[MF_MC + PT / 64];
            if (tid < 384) { const int j = tid >> 7, c = tid & 127, gc = c < 64 ? hh * 64 + c : 512 + hh * 64 + (c - 64);
                out[O_P_CONV + (size_t)(b * 3 + j) * D + gc] = bf1(QKR[(size_t)(b * PT + PT - 3 + j) * D + gc]); }
        }
    }
    float wc = 1.f;
    for (int c = c_lo; c < c_hi; ++c) {
        const int rowc = b * PT + 64 * c;
        const float m_c = Fl[MF_MC + c], m_n = Fl[MF_MC + c + 1], b63 = Fl[MF_B63 + c];
        *(LAS v4u*)(lds + ML_RQK + (tid >> 3) * PBY + 16 * (tid & 7)) = rq;
        v4u rqn = rq, ron[2] = {ro[0], ro[1]}; f32x4 numn[4] = {numl[0], numl[1], numl[2], numl[3]}; float denn = denl;
        if (c + 1 < c_hi) MLF_LOAD(c + 1, rqn, ron, numn, denn);
        __syncthreads();
        { const int tq = tid >> 3, p = tid & 7; float q8[8]; unpack8(*(const LAS v4u*)(lds + ML_RQK + tq * PBY + 16 * p), q8);
          float dsum = 0.f;
#pragma unroll
          for (int e = 0; e < 8; ++e) dsum += q8[e] * Fl[MF_N + 8 * p + e];
          dsum = red8(dsum); if (p == 0) Fl[MF_QN + tq] = dsum; }
        const int ti = w & 3, t = 16 * ti + fr;
        f32x4 accA[4];
#pragma unroll
        for (int i = 0; i < 4; ++i) { const int vt = 4 * (w >> 2) + i; accA[i] = (f32x4){0.f, 0.f, 0.f, 0.f};
#pragma unroll
            for (int ks = 0; ks < 2; ++ks) {
                const bf16x8 aq = *(const LAS bf16x8*)(lds + ML_RQK + (16 * ti + fr) * PBY + ks * 64 + fq * 16), bc = *(const LAS bf16x8*)(lds + ML_C + (16 * vt + fr) * PBY + ks * 64 + fq * 16);
                accA[i] = MFMA16(bc, aq, accA[i]); } }
        __syncthreads();
        float hv[4][4];
        { const float mx = fmaxf(m_c, Fl[MF_GP + c * 64 + t]), wi = __expf(m_c - mx) * wc, ei = __expf(-(Fl[MF_GB + c * 64 + t] + mx));
          const float rden = __builtin_amdgcn_rcpf(fmaxf(fabsf(wi * Fl[MF_QN + t] + denl), ei)); float hq = 0.f;
#pragma unroll
          for (int i = 0; i < 4; ++i)
#pragma unroll
              for (int r = 0; r < 4; ++r) { const float hh_ = (wi * accA[i][r] + numl[i][r]) * rden; hv[i][r] = hh_; hq += hh_ * hh_; }
          hq += __shfl_xor(hq, 16); hq += __shfl_xor(hq, 32);
          if (fq == 0) Fl[MF_HS + t * 2 + (w >> 2)] = hq; }
        __syncthreads();
        { const float sc = __builtin_amdgcn_rsqf((Fl[MF_HS + 2 * t] + Fl[MF_HS + 2 * t + 1]) * (1.f / 128.f) + NORM_EPS);
#pragma unroll
          for (int i = 0; i < 4; ++i) { u2v_ pw; pw.x = pkbf(hv[i][0] * sc, hv[i][1] * sc); pw.y = pkbf(hv[i][2] * sc, hv[i][3] * sc);
              *(LAS u2v_*)(lds + ML_HB + t * RPY + (16 * (4 * (w >> 2) + i) + 4 * fq) * 2) = pw; } }
        __syncthreads();
#pragma unroll
        for (int i = 0; i < 2; ++i) { const int t2 = ot + 32 * i; float h8[8], o8[8]; unpack8(*(const LAS v4u*)(lds + ML_HB + t2 * RPY + 16 * og), h8); unpack8(ro[i], o8);
#pragma unroll
            for (int e = 0; e < 8; ++e) h8[e] = h8[e] * nw[e] * o8[e];
            *(v4u*)(HOb + (size_t)(rowc + t2) * D + hh * 128 + 8 * og) = pack8(h8); }
        wc *= __expf(b63 + m_c - m_n);
        rq = rqn; ro[0] = ron[0]; ro[1] = ron[1]; denl = denn;
#pragma unroll
        for (int i = 0; i < 4; ++i) numl[i] = numn[i];
    }
#undef MLF_LOAD
    __syncthreads();
}
__device__ __forceinline__ void mlstm_sample_item(const Frame& F, int b, int hh, const bf16* QKR, const bf16* VVb, const bf16* OOb, const float* IFb, bf16* HOb,
                                                  const float* conv_w, const float* conv_b, const float* norm_w, const float* C0, const float* n0, const float* m0p, const float* conv0, float* out) {
    LAS float* L = (LAS float*)F.lds;
    constexpr int LQ = 0, LK = 256, LV = 512, LS = 1024, LQN = 1040, LHS = 1048;
    const int tid = F.tid, lane = F.lane, w = F.wave, row0 = MP + 4 * b;
    const int v = tid >> 2, kq = tid & 3; const size_t coff = ((size_t)(b * 8 + hh) * 128 + v) * 64 + 16 * kq;
    f32x4 c0q[4];
#pragma unroll
    for (int e4 = 0; e4 < 4; ++e4) c0q[e4] = *(const f32x4*)(C0 + coff + 4 * e4);
    float n0q[4]; { const int part_ = lane & 15;
#pragma unroll
        for (int e = 0; e < 4; ++e) n0q[e] = n0[(size_t)(b * 8 + hh) * 64 + 4 * part_ + e]; }
    const float n0t = n0[(size_t)(b * 8 + hh) * 64 + (tid & 63)];
    const float nwv = norm_w[hh * 128 + v]; unsigned short ogv[4]; float nwv_, n0t_;
#pragma unroll
    for (int t = 0; t < 4; ++t) ogv[t] = OOb[(size_t)(row0 + t) * D + hh * 128 + v];
    float li[4], lf[4];
#pragma unroll
    for (int t = 0; t < 4; ++t) { li[t] = IFb[(size_t)(row0 + t) * 16 + hh]; lf[t] = IFb[(size_t)(row0 + t) * 16 + 8 + hh]; }
    float m0 = m0p[b * 8 + hh];
    { unsigned g0 = ogv[0], g1 = ogv[1], g2 = ogv[2], g3 = ogv[3]; float nw_ = nwv, nt_ = n0t;
      asm volatile("" : "+v"(c0q[0]), "+v"(c0q[1]), "+v"(c0q[2]), "+v"(c0q[3]), "+v"(n0q[0]), "+v"(n0q[1]), "+v"(n0q[2]), "+v"(n0q[3]), "+v"(g0), "+v"(g1), "+v"(g2), "+v"(g3), "+v"(nw_), "+v"(nt_));
      asm volatile("" : "+v"(li[0]), "+v"(li[1]), "+v"(li[2]), "+v"(li[3]), "+v"(lf[0]), "+v"(lf[1]), "+v"(lf[2]), "+v"(lf[3]), "+v"(m0));
      ogv[0] = (unsigned short)g0; ogv[1] = (unsigned short)g1; ogv[2] = (unsigned short)g2; ogv[3] = (unsigned short)g3; nwv_ = nw_; n0t_ = nt_; }
    float bc[4], av[4], mt[4], wi[4], wsv[4], ei[4], bm[4];
    { float run = 0.f, pm = -3.0e38f;
#pragma unroll
      for (int t = 0; t < 4; ++t) { run += lf[t]; bc[t] = run; av[t] = li[t] - run; pm = fmaxf(pm, av[t]); mt[t] = fmaxf(run + m0, run + pm); } }
    const float m_new = mt[3], wst = __expf(bc[3] + m0 - m_new);
#pragma unroll
    for (int t = 0; t < 4; ++t) { wi[t] = __expf(bc[t] + m0 - mt[t]); wsv[t] = __expf(bc[3] + av[t] - m_new); ei[t] = __expf(-mt[t]); bm[t] = bc[t] - mt[t]; }
    { const int t = tid >> 7, c = tid & 127, gc = c < 64 ? hh * 64 + c : 512 + hh * 64 + (c - 64);
      float x[4], xc[4], cw[4]; unsigned xq[4];
#pragma unroll
      for (int j = 0; j < 4; ++j) { const int p = t + j; cw[j] = conv_w[j * D + gc];
          xc[j] = conv0[(size_t)(b * 3 + (p < 3 ? p : 2)) * D + gc]; xq[j] = QKR[(size_t)(row0 + (p < 3 ? 0 : p - 3)) * D + gc]; }
      unsigned vraw = VVb[(size_t)(row0 + t) * D + hh * 128 + c];
      float a = conv_b[gc];
      asm volatile("" : "+v"(cw[0]), "+v"(cw[1]), "+v"(cw[2]), "+v"(cw[3]), "+v"(xc[0]), "+v"(xc[1]), "+v"(xc[2]), "+v"(xc[3]), "+v"(xq[0]), "+v"(xq[1]), "+v"(xq[2]), "+v"(xq[3]), "+v"(vraw), "+v"(a));
#pragma unroll
      for (int j = 0; j < 4; ++j) { x[j] = (t + j) < 3 ? xc[j] : bf1((unsigned short)xq[j]); a += cw[j] * x[j]; }
      const float val = siluf_(a);
      if (c < 64) L[LQ + t * 64 + c] = val * 0.125f; else L[LK + t * 64 + (c - 64)] = val;
      if (t >= 1) out[O_S_CONV + (size_t)(b * 3 + t - 1) * D + gc] = x[3];
      L[LV + t * 128 + c] = bf1((unsigned short)vraw); }
    __syncthreads();
    if (w == 0) { const int pair = lane >> 2, t = pair >> 2, s = pair & 3, part = lane & 3; float dsum = 0.f;
#pragma unroll
        for (int e = 0; e < 16; ++e) dsum += L[LQ + t * 64 + 16 * part + e] * L[LK + s * 64 + 16 * part + e];
        dsum = red4(dsum);
        const float bmt = t == 0 ? bm[0] : (t == 1 ? bm[1] : (t == 2 ? bm[2] : bm[3])), avs = s == 0 ? av[0] : (s == 1 ? av[1] : (s == 2 ? av[2] : av[3]));
        if (part == 0) L[LS + pair] = s <= t ? dsum * __expf(bmt + avs) : 0.f; }
    if (w == 1) { const int t = lane >> 4, part = lane & 15; float dsum = 0.f;
#pragma unroll
        for (int e = 0; e < 4; ++e) dsum += L[LQ + t * 64 + 4 * part + e] * n0q[e];
        dsum = red16(dsum); if (part == 0) L[LQN + t] = dsum; }
    __syncthreads();
    float hvv[4];
    { float c0[16];
#pragma unroll
      for (int e4 = 0; e4 < 4; ++e4) { const f32x4 x = c0q[e4]; c0[4 * e4] = x.x; c0[4 * e4 + 1] = x.y; c0[4 * e4 + 2] = x.z; c0[4 * e4 + 3] = x.w; }
      f32x4 q4[4][4], k4[4][4], smv[4]; float lv[4], qn[4];
#pragma unroll
      for (int t = 0; t < 4; ++t) {
#pragma unroll
          for (int e4 = 0; e4 < 4; ++e4) { q4[t][e4] = *(const LAS f32x4*)(L + LQ + t * 64 + 16 * kq + 4 * e4); k4[t][e4] = *(const LAS f32x4*)(L + LK + t * 64 + 16 * kq + 4 * e4); }
          smv[t] = *(const LAS f32x4*)(L + LS + t * 4); lv[t] = L[LV + t * 128 + v]; qn[t] = L[LQN + t]; }
#pragma unroll
      for (int t = 0; t < 4; ++t) { float part = 0.f;
#pragma unroll
          for (int e = 0; e < 16; ++e) part += c0[e] * q4[t][e >> 2][e & 3];
          const float inter = red4(part);
          float num = wi[t] * inter, den = wi[t] * qn[t];
#pragma unroll
          for (int s = 0; s < 4; ++s) { const float sm = smv[t][s]; num += sm * lv[s]; den += sm; }
          hvv[t] = num / fmaxf(fabsf(den), ei[t]); }
#pragma unroll
      for (int t = 0; t < 4; ++t) { const float x = wave_sum(kq == 0 ? hvv[t] * hvv[t] : 0.f); if (lane == 0) L[LHS + w * 4 + t] = x; }
      float cn[16];
#pragma unroll
      for (int e = 0; e < 16; ++e) { float a = wst * c0[e];
#pragma unroll
          for (int s = 0; s < 4; ++s) a += (wsv[s] * lv[s]) * k4[s][e >> 2][e & 3];
          cn[e] = a; }
#pragma unroll
      for (int e4 = 0; e4 < 4; ++e4) *(f32x4*)(out + O_S_C + coff + 4 * e4) = (f32x4){cn[4 * e4], cn[4 * e4 + 1], cn[4 * e4 + 2], cn[4 * e4 + 3]}; }
    __syncthreads();
    if (kq == 0) {
#pragma unroll
        for (int t = 0; t < 4; ++t) { float tot = 0.f;
#pragma unroll
            for (int ww = 0; ww < 8; ++ww) tot += L[LHS + ww * 4 + t];
            const float sc = 1.0f / sqrtf(tot * (1.f / 128.f) + NORM_EPS); const size_t off = (size_t)(row0 + t) * D + hh * 128 + v;
            HOb[off] = f2bf1(hvv[t] * sc * nwv_ * bf1(ogv[t])); } }
    if (tid < 64) { float a = wst * n0t_;
#pragma unroll
        for (int s = 0; s < 4; ++s) a += wsv[s] * L[LK + s * 64 + tid];
        out[O_S_N + (size_t)(b * 8 + hh) * 64 + tid] = a; }
    if (tid == 0) out[O_S_M + b * 8 + hh] = m_new;
    __syncthreads();
}

constexpr int CA_AH = 0, CA_BH = 9216, CA_KH = 18432, CA_RH = 27648, CA_BT = 36864, CA_KT = 46080, CA_VT = 55296, CA_AB = 64512, CA_AK = 73728, CA_RB = 82944, CA_RK = 92160, CA_XT = 101376,
              CA_TD = 119808, CA_NF = 123904  , CA_GL = 128256, CA_LG = CA_AB  , CA_AT = CA_KH  ;
__device__ __forceinline__ bf16x8 ldsfrag(LAS unsigned char* lds, int base, int row, int ks, int fq) { return *(const LAS bf16x8*)(lds + base + row * PBY + ks * 64 + fq * 16); }
__device__ __forceinline__ bf16x8 ldsfrag_sw(LAS unsigned char* lds, int base, int row, int ks, int fq, int sw) { const int blk = (ks * 4 + fq) ^ (sw ? ((row >> 3) & 7) : 0); return *(const LAS bf16x8*)(lds + base + row * PBY + blk * 16); }
__device__ __forceinline__ int tr_idx(int cg, int j, int tt) { return (8 * cg + j) * 72 + ((((tt >> 3) ^ cg) & 7) << 3) + (tt & 7); }
__device__ __forceinline__ void rwkv_chunk_item(const Frame& F, int chain, int chunk, bf16* Rb, bf16* Kb, bf16* Vb, bf16* Db, bf16* Ab, bf16* Gb,
                                                const float* k_k, const float* k_a, const float* r_k, float* BON, bf16* dummy, v4u (&pf)[6], const int nchain, const int nchunk) {
    LAS unsigned char* lds = F.lds;
    const int tid = F.tid, lane = F.lane, w = F.wave, fr = lane & 15, fq = lane >> 4, cg = tid & 7, tt = tid >> 3;
    const int h = chain & 15, row0 = (chain >> 4) * PT + 64 * chunk, ch = h * 64 + 8 * cg;
    const size_t goff = (size_t)(row0 + tt) * D + ch;
    LAS float* LG = (LAS float*)(lds + CA_LG); LAS float* GLf = (LAS float*)(lds + CA_GL);
    float r8[8], kp[8], av[8], bv[8], rd[8];
    {
        float k8[8], v8[8], d8[8], a8[8];
        unpack8(pf[0], r8); unpack8(pf[1], k8); unpack8(pf[2], v8); unpack8(pf[3], d8); unpack8(pf[4], a8);
        float ss = 0.f;
#pragma unroll
        for (int j = 0; j < 8; ++j) { av[j] = k8[j] * k_k[ch + j]; ss += av[j] * av[j]; }
        ss = red8(ss); const float inv = __builtin_amdgcn_rsqf(fmaxf(ss, 1e-24f));
        float bsum = 0.f;
#pragma unroll
        for (int j = 0; j < 8; ++j) { const float kk = av[j] * inv; kp[j] = k8[j] * (1.f + (a8[j] - 1.f) * k_a[ch + j]); bv[j] = kk * a8[j]; av[j] = -kk; bsum += r8[j] * kp[j] * r_k[ch + j]; rd[j] = __builtin_amdgcn_rcpf(1.f - d8[j]); }
        const float bon = red8(bsum);
#pragma unroll
        for (int j = 0; j < 8; ++j) { LG[(8 * cg + j) * 65 + tt] = __logf(1.f - d8[j]); ((lds_u16*)(lds + CA_VT))[tr_idx(cg, j, tt)] = f2bf1(v8[j]); }
        if (cg == 0 && !dummy) BON[(size_t)(row0 + tt) * 16 + h] = bon;
    }
    __syncthreads();
    { float x[8];
#pragma unroll
      for (int q = 0; q < 8; ++q) x[q] = LG[(8 * w + q) * 65 + lane];
#pragma unroll
      for (int q = 0; q < 8; ++q) {
          float v = x[q];
          v += __builtin_bit_cast(float, __builtin_amdgcn_update_dpp(0, __builtin_bit_cast(int, v), 0x111, 0xF, 0xF, true));
          v += __builtin_bit_cast(float, __builtin_amdgcn_update_dpp(0, __builtin_bit_cast(int, v), 0x112, 0xF, 0xF, true));
          v += __builtin_bit_cast(float, __builtin_amdgcn_update_dpp(0, __builtin_bit_cast(int, v), 0x114, 0xF, 0xF, true));
          v += __builtin_bit_cast(float, __builtin_amdgcn_update_dpp(0, __builtin_bit_cast(int, v), 0x118, 0xF, 0xF, true));
          v += __builtin_bit_cast(float, __builtin_amdgcn_update_dpp(0, __builtin_bit_cast(int, v), 0x142, 0xA, 0xF, false));
          v += __builtin_bit_cast(float, __builtin_amdgcn_update_dpp(0, __builtin_bit_cast(int, v), 0x143, 0xC, 0xF, false));
          x[q] = v; }
#pragma unroll
      for (int q = 0; q < 8; ++q) LG[(8 * w + q) * 65 + lane] = x[q]; }
    __syncthreads();
    {
        float ah[8], bh[8], kh[8], rh[8];
#pragma unroll
        for (int j = 0; j < 8; ++j) { const float lg = LG[(8 * cg + j) * 65 + tt]; const float G = __expf(lg), Gm1 = G * rd[j], Gi = __builtin_amdgcn_rcpf(G);
            ah[j] = av[j] * Gm1; bh[j] = bv[j] * Gi; kh[j] = kp[j] * Gi; rh[j] = r8[j] * G;
            ((lds_u16*)(lds + CA_BT))[tr_idx(cg, j, tt)] = f2bf1(bh[j]); ((lds_u16*)(lds + CA_KT))[tr_idx(cg, j, tt)] = f2bf1(kh[j]);
            if (tt == 63) GLf[8 * cg + j] = G; }
        *(LAS v4u*)(lds + CA_AH + tt * PBY + 16 * cg) = pack8(ah); *(LAS v4u*)(lds + CA_BH + tt * PBY + 16 * cg) = pack8(bh);
        *(LAS v4u*)(lds + CA_KH + tt * PBY + 16 * cg) = pack8(kh); *(LAS v4u*)(lds + CA_RH + tt * PBY + 16 * cg) = pack8(rh);
    }
    __syncthreads();
    {
        const int mi = w >> 1, hh_ = w & 1; const int abase = mi < 2 ? CA_AH : CA_RH, bbase = (mi & 1) ? CA_KH : CA_BH, dbase = CA_AB + mi * 9216;
        bf16x8 af[2][2], bfr[4][2];
#pragma unroll
        for (int a = 0; a < 2; ++a) { const int ti = a == 0 ? hh_ : 3 - hh_;
#pragma unroll
            for (int ks = 0; ks < 2; ++ks) af[a][ks] = ldsfrag(lds, abase, 16 * ti + fr, ks, fq); }
#pragma unroll
        for (int sj = 0; sj < 4; ++sj)
#pragma unroll
            for (int ks = 0; ks < 2; ++ks) bfr[sj][ks] = ldsfrag(lds, bbase, 16 * sj + fr, ks, fq);
#pragma unroll
        for (int a = 0; a < 2; ++a)
#pragma unroll
            for (int sj = 0; sj < 4; ++sj) { const int ti = a == 0 ? hh_ : 3 - hh_; f32x4 acc = {0.f, 0.f, 0.f, 0.f};
                const int t = 16 * ti + fr;
                if (sj <= ti) {
#pragma unroll
                    for (int ks = 0; ks < 2; ++ks) acc = MFMA16(bfr[sj][ks], af[a][ks], acc);
                    if (sj == ti) {
#pragma unroll
                        for (int r = 0; r < 4; ++r) { const int s = 16 * sj + 4 * fq + r; acc[r] = (mi < 2 ? s < t : s <= t) ? acc[r] : 0.f; } }
                }
                typedef unsigned u2v_ __attribute__((ext_vector_type(2))); u2v_ pw; pw.x = pkbf(acc[0], acc[1]); pw.y = pkbf(acc[2], acc[3]);
                *(LAS u2v_*)(lds + dbase + (t * 72 + 16 * sj + 4 * fq) * 2) = pw;
                if (mi == 0 && ti == sj) *(LAS f32x4*)(lds + CA_NF + (ti * 264 + fr * 16 + 4 * fq) * 4) = acc; }
    }
    __syncthreads();
    f32x4 rhs[4];
    if (w == 0) { const int blk = fq, c = fr; const LAS float* N = (const LAS float*)(lds + CA_NF) + blk * 264; float T[16];
#pragma unroll
        for (int i = 0; i < 16; ++i) T[i] = (i == c) ? 1.f : 0.f;
#pragma unroll
        for (int j = 0; j < 15; ++j) {
#pragma unroll
            for (int i = j + 1; i < 16; ++i) T[i] += N[i * 16 + j] * T[j]; }
        lds_u16* td = (lds_u16*)(lds + CA_TD) + blk * 272;
#pragma unroll
        for (int i = 0; i < 16; ++i) td[i * 16 + c] = f2bf1(T[i]); }
    if (w < 4) {
#pragma unroll
        for (int i = 0; i < 4; ++i)
#pragma unroll
            for (int r = 0; r < 4; ++r) rhs[i][r] = bf1(((lds_u16*)(lds + CA_AH))[(16 * i + 4 * fq + r) * 72 + 16 * w + fr]);
    } else {
#pragma unroll
        for (int i = 0; i < 4; ++i) { f32x4 acc = {0.f, 0.f, 0.f, 0.f};
#pragma unroll
            for (int ks = 0; ks < 2; ++ks) acc = MFMA16(ldsfrag(lds, CA_AK, 16 * i + fr, ks, fq), ldsfrag_sw(lds, CA_VT, 16 * (w - 4) + fr, ks, fq, 1), acc);
            rhs[i] = acc; }
    }
    __syncthreads();
    {
        typedef unsigned u2v __attribute__((ext_vector_type(2)));
#define S5_FRAG(byteoff) ({ const u2v q_ = *(const LAS u2v*)(lds + (byteoff)); const v4u t_ = {q_.x, q_.y, 0u, 0u}; __builtin_bit_cast(bf16x8, t_); })
#define S5_PACK(v) ({ const v4u t_ = {pkbf((v)[0], (v)[1]), pkbf((v)[2], (v)[3]), 0u, 0u}; __builtin_bit_cast(bf16x8, t_); })
        bf16x8 tdf[4], abf[6];
#pragma unroll
        for (int i = 0; i < 4; ++i) tdf[i] = S5_FRAG(CA_TD + i * 544 + fr * 32 + fq * 8);
        abf[0] = S5_FRAG(CA_AB + (16 + fr) * PBY + (0 + 4 * fq) * 2);
        abf[1] = S5_FRAG(CA_AB + (32 + fr) * PBY + (0 + 4 * fq) * 2);  abf[2] = S5_FRAG(CA_AB + (32 + fr) * PBY + (16 + 4 * fq) * 2);
        abf[3] = S5_FRAG(CA_AB + (48 + fr) * PBY + (0 + 4 * fq) * 2);  abf[4] = S5_FRAG(CA_AB + (48 + fr) * PBY + (16 + 4 * fq) * 2);  abf[5] = S5_FRAG(CA_AB + (48 + fr) * PBY + (32 + 4 * fq) * 2);
        const f32x4 z4 = {0.f, 0.f, 0.f, 0.f};
        const f32x4 x0 = MFMA16(tdf[0], S5_PACK(rhs[0]), z4);                 const bf16x8 xb0 = S5_PACK(x0);
        f32x4 a1 = MFMA16(abf[0], xb0, rhs[1]);
        const f32x4 x1 = MFMA16(tdf[1], S5_PACK(a1), z4);                     const bf16x8 xb1 = S5_PACK(x1);
        f32x4 a2 = MFMA16(abf[1], xb0, rhs[2]); a2 = MFMA16(abf[2], xb1, a2);
        const f32x4 x2 = MFMA16(tdf[2], S5_PACK(a2), z4);                     const bf16x8 xb2 = S5_PACK(x2);
        f32x4 a3 = MFMA16(abf[3], xb0, rhs[3]); a3 = MFMA16(abf[4], xb1, a3); a3 = MFMA16(abf[5], xb2, a3);
        const f32x4 x3 = MFMA16(tdf[3], S5_PACK(a3), z4);
        LAS unsigned char* xrow = lds + CA_XT + (16 * w + fr) * PBY + 8 * fq;
        { u2v p; p.x = pkbf(x0[0], x0[1]); p.y = pkbf(x0[2], x0[3]); *(LAS u2v*)(xrow) = p; }
        { u2v p; p.x = pkbf(x1[0], x1[1]); p.y = pkbf(x1[2], x1[3]); *(LAS u2v*)(xrow + 32) = p; }
        { u2v p; p.x = pkbf(x2[0], x2[1]); p.y = pkbf(x2[2], x2[3]); *(LAS u2v*)(xrow + 64) = p; }
        { u2v p; p.x = pkbf(x3[0], x3[1]); p.y = pkbf(x3[2], x3[3]); *(LAS u2v*)(xrow + 96) = p; }
#undef S5_FRAG
#undef S5_PACK
    }
    __syncthreads();
    if (nchain >= 0) { const size_t no = (size_t)((nchain >> 4) * PT + 64 * nchunk + tt) * D + (nchain & 15) * 64 + 8 * cg;
        pf[0] = *(const v4u*)(Rb + no); pf[1] = *(const v4u*)(Kb + no); pf[2] = *(const v4u*)(Vb + no); pf[3] = *(const v4u*)(Db + no); pf[4] = *(const v4u*)(Ab + no); }
    {
        const int mi = w >> 1, ti0 = 2 * (w & 1); const int obase = mi == 0 ? CA_AB : (mi == 1 ? CA_AK : (mi == 2 ? CA_AH : CA_KH));
        const int a1 = mi < 2 ? CA_RB : (mi == 2 ? CA_BT : CA_XT), a1o = mi == 3 ? 64 : 0, b1 = mi == 3 ? CA_BT : CA_XT, b1o = mi == 1 ? 64 : 0;
        const int a2 = mi == 1 ? CA_RK : CA_VT, b2 = mi == 1 ? CA_VT : CA_KT; const bool two = (mi & 1) != 0;
        const int ma1 = mi == 2 ? 7 : 0, mb1 = mi == 3 ? 7 : 0, ma2 = mi != 1 ? 7 : 0;
        bf16x8 af[2][2], bfr[4][2];
#pragma unroll
        for (int a = 0; a < 2; ++a)
#pragma unroll
            for (int ks = 0; ks < 2; ++ks) af[a][ks] = *(const LAS bf16x8*)(lds + a1 + (a1o + 16 * (ti0 + a) + fr) * PBY + (((ks * 4 + fq) ^ (((2 * (ti0 + a) + (fr >> 3)) & ma1))) << 4));
#pragma unroll
        for (int tj = 0; tj < 4; ++tj)
#pragma unroll
            for (int ks = 0; ks < 2; ++ks) bfr[tj][ks] = *(const LAS bf16x8*)(lds + b1 + (b1o + 16 * tj + fr) * PBY + (((ks * 4 + fq) ^ (((2 * tj + (fr >> 3)) & mb1))) << 4));
        f32x4 acc[2][4];
#pragma unroll
        for (int a = 0; a < 2; ++a)
#pragma unroll
            for (int tj = 0; tj < 4; ++tj) { acc[a][tj] = (f32x4){0.f, 0.f, 0.f, 0.f};
#pragma unroll
                for (int ks = 0; ks < 2; ++ks) acc[a][tj] = MFMA16(bfr[tj][ks], af[a][ks], acc[a][tj]); }
        if (two) {
#pragma unroll
            for (int a = 0; a < 2; ++a)
#pragma unroll
                for (int ks = 0; ks < 2; ++ks) af[a][ks] = *(const LAS bf16x8*)(lds + a2 + (16 * (ti0 + a) + fr) * PBY + (((ks * 4 + fq) ^ (((2 * (ti0 + a) + (fr >> 3)) & ma2))) << 4));
#pragma unroll
            for (int tj = 0; tj < 4; ++tj)
#pragma unroll
                for (int ks = 0; ks < 2; ++ks) bfr[tj][ks] = ldsfrag_sw(lds, b2, 16 * tj + fr, ks, fq, 1);
#pragma unroll
            for (int a = 0; a < 2; ++a)
#pragma unroll
                for (int tj = 0; tj < 4; ++tj)
#pragma unroll
                    for (int ks = 0; ks < 2; ++ks) acc[a][tj] = MFMA16(bfr[tj][ks], af[a][ks], acc[a][tj]);
        }
#pragma unroll
        for (int a = 0; a < 2; ++a) { const int row = 16 * (ti0 + a) + fr; const float glr = GLf[row];
#pragma unroll
            for (int tj = 0; tj < 4; ++tj) { const int col = 16 * tj + 4 * fq; f32x4 val = acc[a][tj];
                typedef unsigned u2v_ __attribute__((ext_vector_type(2)));
                if (mi == 0) { const u2v_ rr = *(const LAS u2v_*)(lds + CA_RH + (row * 72 + col) * 2); val += (f32x4){bflo(rr.x), bfhi(rr.x), bflo(rr.y), bfhi(rr.y)}; }
                else if (mi == 2) {
#pragma unroll
                    for (int r = 0; r < 4; ++r) val[r] = glr * (val[r] + (row == col + r ? 1.f : 0.f)); }
                else if (mi == 3) val = val * *(const LAS f32x4*)(GLf + col);
                u2v_ pw; pw.x = pkbf(val[0], val[1]); pw.y = pkbf(val[2], val[3]);
                *(LAS u2v_*)(lds + obase + (row * 72 + col) * 2) = pw; } }
    }
    __syncthreads();
    *(v4u*)((dummy ? dummy : Rb) + goff) = *(const LAS v4u*)(lds + CA_AB + tt * PBY + 16 * cg);
    *(v4u*)((dummy ? dummy : Ab) + goff) = *(const LAS v4u*)(lds + CA_AK + tt * PBY + 16 * cg);
    *(v4u*)((dummy ? dummy : Kb) + goff) = *(const LAS v4u*)(lds + CA_AH + tt * PBY + 16 * cg);
    *(v4u*)((dummy ? dummy : Db) + goff) = *(const LAS v4u*)(lds + CA_KH + tt * PBY + 16 * cg);
    __syncthreads();
}
constexpr int CB_S = 0, CB_P2 = 9216, CB_P3 = 18432, CB_Y0 = 27648, CB_Z0 = 36864, CB_YS = 46080  ;
__device__ __forceinline__ void rwkv_state_chain(const Frame& F, int chain, float* ST, const bf16* Rb, const bf16* Kb, const bf16* Vb, const bf16* Db, const bf16* Ab, bf16* Gb, const float* BON, const float* gn_w, const float* gn_b, bf16* dummy) {
    LAS unsigned char* lds = F.lds;
    const int tid = F.tid, lane = F.lane, w = F.wave, fr = lane & 15, fq = lane >> 4, cg = tid & 7, tt = tid >> 3;
    const int h = chain & 15, rowc0 = (chain >> 4) * PT, ch = h * 64 + 8 * cg;
    for (int i = tid; i < 64 * 36; i += 512) ((LAS unsigned*)(lds + CB_S))[i] = 0u;
    f32x4 Sacc[2];
    Sacc[0] = (f32x4){0.f, 0.f, 0.f, 0.f}; Sacc[1] = Sacc[0];
    v4u q2, q3, qy, qz, qg, qb; float qbon;
    float cgw[8], cgb[8];
#pragma unroll
    for (int j = 0; j < 8; ++j) { cgw[j] = gn_w[ch + j]; cgb[j] = gn_b[ch + j]; }
#define CB_LOAD(cc) do { const size_t o_ = (size_t)(rowc0 + 64 * (cc) + tt) * D + ch; q2 = *(const v4u*)(Rb + o_); q3 = *(const v4u*)(Kb + o_); qy = *(const v4u*)(Ab + o_); qz = *(const v4u*)(Db + o_); \
        qg = *(const v4u*)(Gb + o_); qb = *(const v4u*)(Vb + o_); qbon = BON[(size_t)(rowc0 + 64 * (cc) + tt) * 16 + h]; } while (0)
    CB_LOAD(0);
    for (int c = 0; c < PT / 64; ++c) {
        *(LAS v4u*)(lds + CB_P2 + tt * PBY + 16 * cg) = q2; *(LAS v4u*)(lds + CB_P3 + tt * PBY + 16 * cg) = q3;
        *(LAS v4u*)(lds + CB_Y0 + tt * PBY + 16 * cg) = qy; *(LAS v4u*)(lds + CB_Z0 + tt * PBY + 16 * cg) = qz;
        float gw[8], gb[8]; unpack8(qg, gw); unpack8(qb, gb);
        const float bonc = qbon;
        if (c + 1 < PT / 64) CB_LOAD(c + 1);
        __syncthreads();
        f32x4 yacc[2];
        typedef unsigned u2v_ __attribute__((ext_vector_type(2)));
#pragma unroll
        for (int q = 0; q < 2; ++q) { const int tq = 2 * w + q, ti = tq >> 2, tj = tq & 3, row = 16 * ti + fr, col = 16 * tj + 4 * fq;
            const u2v_ y0 = *(const LAS u2v_*)(lds + CB_Y0 + (row * 72 + col) * 2), z0 = *(const LAS u2v_*)(lds + CB_Z0 + (row * 72 + col) * 2);
            f32x4 ya = {bflo(y0.x), bfhi(y0.x), bflo(y0.y), bfhi(y0.y)}, sa = {bflo(z0.x), bfhi(z0.x), bflo(z0.y), bfhi(z0.y)};
#pragma unroll
            for (int ks = 0; ks < 2; ++ks) { ya = MFMA16(ldsfrag(lds, CB_S, 16 * tj + fr, ks, fq), ldsfrag(lds, CB_P2, 16 * ti + fr, ks, fq), ya);
                                             sa = MFMA16(ldsfrag(lds, CB_P3, 16 * tj + fr, ks, fq), ldsfrag(lds, CB_S, 16 * ti + fr, ks, fq), sa); }
            yacc[q] = ya; Sacc[q] = sa; }
        __syncthreads();
#pragma unroll
        for (int q = 0; q < 2; ++q) { const int tq = 2 * w + q, ti = tq >> 2, tj = tq & 3, row = 16 * ti + fr, col = 16 * tj + 4 * fq;
            u2v_ pw; pw.x = pkbf(Sacc[q][0], Sacc[q][1]); pw.y = pkbf(Sacc[q][2], Sacc[q][3]);
            *(LAS u2v_*)(lds + CB_S + (row * 72 + col) * 2) = pw;
            *(LAS f32x4*)(lds + CB_YS + (row * 68 + col) * 4) = yacc[q]; }
        __syncthreads();
        { const f32x4 y0 = *(const LAS f32x4*)(lds + CB_YS + (tt * 68 + 8 * cg) * 4), y1 = *(const LAS f32x4*)(lds + CB_YS + (tt * 68 + 8 * cg + 4) * 4);
          float yy[8] = {y0.x, y0.y, y0.z, y0.w, y1.x, y1.y, y1.z, y1.w}; float s1 = 0.f;
#pragma unroll
          for (int j = 0; j < 8; ++j) s1 += yy[j];
          const float mean = red8(s1) * (1.f / 64.f); float s2 = 0.f;
#pragma unroll
          for (int j = 0; j < 8; ++j) { yy[j] -= mean; s2 += yy[j] * yy[j]; }
          const float rstd = __builtin_amdgcn_rsqf(red8(s2) * (1.f / 64.f) + GN_EPS);
          float o[8];
#pragma unroll
          for (int j = 0; j < 8; ++j) o[j] = ((yy[j] * rstd) * cgw[j] + cgb[j] + bonc * gb[j]) * gw[j];
          *(v4u*)((dummy ? dummy : Gb) + (size_t)(rowc0 + 64 * c + tt) * D + ch) = pack8(o); }
    }
#undef CB_LOAD
#pragma unroll
    for (int q = 0; q < 2; ++q) { const int tq = 2 * w + q, ti = tq >> 2, tj = tq & 3; *(f32x4*)(ST + (16 * ti + fr) * 64 + 16 * tj + 4 * fq) = Sacc[q]; }
    __syncthreads();
}

#ifndef MK_N_LAUNCHES
#define MK_N_LAUNCHES 1
#endif
constexpr int N_PHASES = 22;
#ifndef PROBE_PH
#define PROBE_PH (-1)
#define PROBE_N 1
#endif
#ifndef PROBE_VAR
#define PROBE_VAR 0
#endif
#ifndef EN_MASK
#define EN_MASK 0xff
#endif
constexpr bool EN_NORM = EN_MASK & 1, EN_UP = EN_MASK & 2, EN_RES = EN_MASK & 4, EN_RW = EN_MASK & 8, EN_L2 = EN_MASK & 16, EN_SCAN = EN_MASK & 32, EN_IN = EN_MASK & 64, EN_ML = EN_MASK & 128;
struct Args { const float* in[N_IN]; float* out; unsigned char* ws; int ph_lo, ph_hi; };
__global__ void __launch_bounds__(NWAVES * 64, 2) mega_fwd(Args args) {
    extern __shared__ __attribute__((aligned(16))) unsigned char lds_raw[];
    { const int t0 = threadIdx.x;
      for (int u = t0; u < (LDS_BYTES - LDSCTL_OFF) / 4; u += NWAVES * 64) ((LAS unsigned*)((LAS unsigned char*)lds_raw + LDSCTL_OFF))[u] = 0u; }
    __syncthreads();
    { const int t0 = threadIdx.x; if (t0 < N_IN) ((LAS unsigned long long*)((LAS unsigned char*)lds_raw + TAB_OFF))[t0] = (unsigned long long)args.in[t0]; }
    __syncthreads();
    XcdBarrier bar; bar.bar = (unsigned*)((gu32*)(args.ws + WS_CTL) + CW_BAR); bar.x = 0; bar.st = nullptr;
    if (args.ph_hi - args.ph_lo > 1) bar = xcd_barrier_post((unsigned*)((gu32*)(args.ws + WS_CTL) + CW_BAR), (volatile LAS unsigned*)((LAS unsigned char*)lds_raw + MISC_OFF) + 8);
    int ph = args.ph_lo, rep = 0;
    while (ph < args.ph_hi) {
        int tid_ = threadIdx.x; asm volatile("" : "+v"(tid_));
        unsigned char* ws = args.ws; float* out = args.out;
        Frame F;
        F.lds = (LAS unsigned char*)lds_raw;
        F.MISC = (volatile LAS unsigned*)(F.lds + MISC_OFF);
        F.tid = tid_; F.lane = F.tid & 63; F.wave = __builtin_amdgcn_readfirstlane(F.tid >> 6);
        F.G = gridDim.x; { const int bx = blockIdx.x; F.vcu = (F.G % 8 == 0) ? (bx % 8) * (F.G / 8) + bx / 8 : bx; }
        F.ctl = (gu32*)(ws + WS_CTL); F.tab = (volatile LAS unsigned long long*)(F.lds + TAB_OFF);
        bf16* Wb = (bf16*)(ws + WS_W); bf16* XR = (bf16*)(ws + WS_XR); unsigned char* big = ws + WS_BIG;
        bf16* Hb = (bf16*)(big + B_H); bf16* XN = (bf16*)(big + B_XN); float* SLAB = (float*)(big + B_SLAB);
        bf16* ACAT = (bf16*)(big + B_ACAT); bf16* Rb = (bf16*)(big + B_R); bf16* Kb = (bf16*)(big + B_K); bf16* Vb = (bf16*)(big + B_V); bf16* DECb = (bf16*)(big + B_DEC); bf16* AAb = (bf16*)(big + B_AA);
        bf16* QKR = (bf16*)(big + B_QKR); bf16* VVb = (bf16*)(big + B_VV); bf16* HOb = (bf16*)(big + B_HO); bf16* OOb = (bf16*)(big + B_OO); float* IFb = (float*)(big + B_IF);
        bf16* GGb = (bf16*)((unsigned char*)out + OS_GG); bf16* LORA = (bf16*)((unsigned char*)out + OS_LORA);
        const int c_id = (int)blockIdx.x;
        const int nrep = (ph == PROBE_PH && ph != 6 && !(ph == 16 && PROBE_VAR != 0)) ? PROBE_N : 1;
        const int pvar = (rep + 1 < nrep) ? PROBE_VAR : 0;
        if (EN_NORM && (ph == 0 || ph == 3 || ph == 8 || ph == 11 || ph == 14 || ph == 18 || ph == 21)) {
            int kind = 0, layer = 0, ab = 0, nslab = 0; float coef = 0.5f; const float* gain = nullptr;
            if (ph == 0) { kind = 0; layer = 0; ab = 0; gain = inptr(F, I_NFA); nslab = 0; }
            else if (ph == 3) { kind = 1; gain = inptr(F, I_NMIX); nslab = 11; }
            else if (ph == 8) { kind = 0; layer = 0; ab = 1; gain = inptr(F, I_NFB); nslab = 4; coef = 1.f; }
            else if (ph == 11) { kind = 0; layer = 1; ab = 0; gain = inptr(F, I_NFA) + D; nslab = 11; }
            else if (ph == 14) { kind = 2; gain = inptr(F, I_NMIX) + D; nslab = 11; }
            else if (ph == 18) { kind = -1; gain = inptr(F, I_NFB) + D; nslab = 4; coef = 1.f; }
            else { kind = -1; gain = inptr(F, I_NFIN); nslab = 11; }
            if (kind >= 0) convert_weights(F, kind, layer, ab, Wb);
            if (ph == 0) norm_rows<0, true, true>(F, inptr(F, I_XP), inptr(F, I_XS), nslab, coef, SLAB, XR, gain, XN, nullptr, out, pvar);
            else if (ph == 3) mix_rows(F, XR, inptr(F, I_XS), nslab, coef, SLAB, XR, gain, inptr(F, I_MU), (bf16*)(ws + WS_XM), inptr(F, I_RSHIFT), out, pvar);
            else if (ph == 21) norm_rows<2, false, false>(F, XR, XR + (size_t)MP * D, nslab, coef, SLAB, XR, gain, nullptr, nullptr, out, pvar);
            else norm_rows<0, false, false>(F, XR, XR + (size_t)MP * D, nslab, coef, SLAB, XR, gain, XN, nullptr, out, pvar);
        } else if (EN_UP && (ph == 1 || ph == 9 || ph == 12 || ph == 19)) {
            const bf16* Wu = ph == 19 ? (const bf16*)(ws + WS_W2) : Wb;
            pg8::Gemm g{XN, Wu + W_GU / 2, M, 2 * FF, D}; pg8::UnitOrder S; S.init(M / 256, 2 * FF / 256, D, F.G, c_id, 0);
            EpiSwiglu E{Hb, pvar};
            pg8::gemm_phase<EpiSwiglu, pg8::UnitOrder, true, true>(F.lds, g, S, E, F.tid);
        } else if (EN_RES && (ph == 2 || ph == 7 || ph == 10 || ph == 13 || ph == 17 || ph == 20)) {
            const bf16* A = Hb; const bf16* Bt = (ph == 20 ? (const bf16*)(ws + WS_W2) : Wb) + W_D / 2; int K = FF; float coef = 0.5f; const float* basef = nullptr;
            if (ph == 2) basef = inptr(F, I_XP);
            if (ph == 7) { A = GGb; Bt = Wb + W_O / 2; K = D; coef = 1.f; }
            if (ph == 17) { A = HOb; Bt = Wb + W_OUT / 2; K = D; coef = 1.f; }
            pg8::Gemm g{A, Bt, M, D, K}; pg8::UnitOrder S; S.init(MP / 256, D / 256, K, F.G, c_id, K / 256);
            if (pvar && PROBE_PH >= 0) coef = 0.f;
            EpiRes E{basef, XR, XR, SLAB, coef};
            pg8::gemm_phase<EpiRes, pg8::UnitOrder, true, true>(F.lds, g, S, E, F.tid);
        } else if (EN_RW && ph == 4) {
            pg8::Gemm g{(const bf16*)(ws + WS_XM), Wb + W_RW / 2, 6 * M, NRW2, D}; pg8::UnitOrder S; S.init(M / 256, NRW2 / 256, D, F.G, c_id, -2);
            EpiRw E{Rb, Kb, Vb, LORA};
            pg8::gemm_phase<EpiRw, pg8::UnitOrder, true, true>(F.lds, g, S, E, F.tid);
        } else if (EN_L2 && ph == 5) {
            pg8::Gemm g{LORA, Wb + W_L2 / 2, M, NL2, KL2}; pg8::UnitOrder S; S.init(M / 256, NL2 / 256, KL2, F.G, c_id, -1);
            { const float* s0 = inptr(F, I_W0); const float* s1 = inptr(F, I_A0);
              for (int i = F.tid; i < 2 * D / 4; i += NWAVES * 64) { const float* sp = i < D / 4 ? s0 + 4 * i : s1 + 4 * (i - D / 4); *(LAS f32x4*)(F.lds + BIAS_OFF + 16 * i) = *(const f32x4*)sp; }
              __syncthreads(); }
            EpiL2 E{DECb, AAb, GGb, (const LAS float*)(F.lds + BIAS_OFF)};
            pg8::gemm_phase<EpiL2, pg8::UnitOrder, true, true>(F.lds, g, S, E, F.tid);
        } else if (EN_SCAN && ph == 6) {
            bf16* dummy = (bf16*)(ws + WS_YRAW);
            for (int dr = (PROBE_PH == 6 && PROBE_VAR == 5) ? PROBE_N - 1 : 0; dr >= 0; --dr) {
                v4u pf[6]; pf[5] = (v4u){0u, 0u, 0u, 0u};
                { const int it = F.vcu, cg_ = F.tid & 7, tt_ = F.tid >> 3; const size_t o = (size_t)(((it >> 5) >> 4) * PT + 64 * (it & 31) + tt_) * D + ((it >> 5) & 15) * 64 + 8 * cg_;
                  pf[0] = *(const v4u*)(Rb + o); pf[1] = *(const v4u*)(Kb + o); pf[2] = *(const v4u*)(Vb + o); pf[3] = *(const v4u*)(DECb + o); pf[4] = *(const v4u*)(AAb + o); }
                for (int it = F.vcu; it < PB * 16 * (PT / 64); it += F.G) { const int nx = it + F.G < PB * 16 * (PT / 64) ? it + F.G : -1;
                    rwkv_chunk_item(F, it >> 5, it & 31, Rb, Kb, Vb, DECb, AAb, GGb, inptr(F, I_KK), inptr(F, I_KA), inptr(F, I_RK), (float*)(ws + WS_BON), dr ? dummy : nullptr, pf, nx < 0 ? -1 : nx >> 5, nx & 31); }
            }
            xcd_barrier(bar);
            for (int dr = (PROBE_PH == 6 && PROBE_VAR == 6) ? PROBE_N - 1 : 0; dr >= 0; --dr)
                if ((F.vcu & 1) == 0 && F.vcu < 256) rwkv_state_chain(F, (F.vcu >> 5) + 8 * ((F.vcu & 31) >> 1), out + O_P_S + (size_t)((F.vcu >> 5) + 8 * ((F.vcu & 31) >> 1)) * 4096, Rb, Kb, Vb, DECb, AAb, GGb, (const float*)(ws + WS_BON), inptr(F, I_GNW), inptr(F, I_GNB), dr ? dummy : nullptr);
            { const bool odd_ = (F.vcu & 1) != 0 && F.vcu < 256; const int i0 = odd_ ? 16 * (F.vcu >> 1) : 0, i1 = odd_ ? i0 + 16 : 0;
              constexpr int CREP = (PROBE_PH == 6 && PROBE_VAR == 7) ? PROBE_N : 1;
              const int ni = i1 - i0;
              for (int k = 0; k < ni * CREP; ++k) { const int i = i0 + k % (ni > 0 ? ni : 1), b = i >> 4, h = i & 15;
                  rwkv_chain(F, MP + b * STK, STK, h, inptr(F, I_RS) + (size_t)i * 4096, out + O_S_S + (size_t)i * 4096, Rb, Kb, Vb, DECb, AAb, GGb, inptr(F, I_KK), inptr(F, I_KA), inptr(F, I_RK), inptr(F, I_GNW), inptr(F, I_GNB), k >= ni * (CREP - 1), 0); } }
        } else if (EN_IN && ph == 15) {
            pg8::Gemm g{XN, Wb + W_IN / 2, M, NIN, D}; pg8::UnitOrder S; S.init(M / 256, NIN / 256, D, F.G, c_id, 0);
            EpiIn E{QKR, VVb, OOb, IFb, inptr(F, I_BIF), pvar};
            pg8::gemm_phase<EpiIn, pg8::UnitOrder, true, true>(F.lds, g, S, E, F.tid);
        } else if (EN_ML && ph == 16) {
            float* NUM = out + O_Y; float* DEN = (float*)(ws + WS_BON); bf16* Qs = (bf16*)(big + 100 * MiB)  ; float* SEG = (float*)(ws + WS_YRAW);
            for (int i = F.vcu; i < PB * 8 * ML_NSEG * ((PROBE_PH == 16 && PROBE_VAR == 1) ? PROBE_N : 1); i += F.G) { const int chain = (i >> 2) & 63, seg = i & 3;
                mlstm_prompt_chain(F, chain >> 3, chain & 7, seg, QKR, VVb, OOb, IFb, HOb, inptr(F, I_CW), inptr(F, I_CB), inptr(F, I_MNW), NUM, DEN, Qs, SEG, 0); }
            xcd_barrier(bar);
            for (int i = F.vcu; i < 256 * ((PROBE_PH == 16 && PROBE_VAR == 2) ? PROBE_N : 1); i += F.G) { const int chain = (i >> 2) & 63, seg = i & 3; if (seg == 0) continue;
                mlstm_fix_seg(F, chain >> 3, chain & 7, seg, QKR, OOb, IFb, HOb, inptr(F, I_MNW), NUM, DEN, Qs, SEG, out); }
            if (F.G == 256) {
                constexpr int SREP = (PROBE_PH == 16 && PROBE_VAR == 3) ? PROBE_N : 1;
                if ((F.vcu & 3) == 0) { for (int j = 0; j < 7 * SREP; ++j) { const int i = (F.vcu >> 2) * 7 + j % 7;
                    mlstm_sample_item(F, i >> 3, i & 7, QKR, VVb, OOb, IFb, HOb, inptr(F, I_CW), inptr(F, I_CB), inptr(F, I_MNW), inptr(F, I_MC), inptr(F, I_MN), inptr(F, I_MM), inptr(F, I_MCONV), out); } }
                else { const int t_ = (F.vcu >> 2) * 3 + (F.vcu & 3) - 1; for (int k = 0; k < 3 * SREP; ++k) { const int i = 448 + t_ + 192 * (k % 3); if (i < SB * 8)
                    mlstm_sample_item(F, i >> 3, i & 7, QKR, VVb, OOb, IFb, HOb, inptr(F, I_CW), inptr(F, I_CB), inptr(F, I_MNW), inptr(F, I_MC), inptr(F, I_MN), inptr(F, I_MM), inptr(F, I_MCONV), out); } }
            } else {
                for (int i = F.vcu; i < SB * 8; i += F.G)
                    mlstm_sample_item(F, i >> 3, i & 7, QKR, VVb, OOb, IFb, HOb, inptr(F, I_CW), inptr(F, I_CB), inptr(F, I_MNW), inptr(F, I_MC), inptr(F, I_MN), inptr(F, I_MM), inptr(F, I_MCONV), out);
            }
            if (rep + 1 == nrep) convert_weights(F, 0, 1, 1, (bf16*)(ws + WS_W2));
        }
        if (++rep < nrep) continue;
        rep = 0;
        if (ph + 1 < args.ph_hi) xcd_barrier(bar);
        ++ph;
    }
}

extern "C" void kernel_launch(void* const* d_in, const int* in_sizes, int n_in, void* d_out, int out_size, void* d_ws, size_t ws_size, hipStream_t stream) {
    static int grid = 0;
    if (grid == 0) {
        if (n_in != N_IN || out_size != (int)O_END || ws_size < WS_END3) { fprintf(stderr, "kernel_launch: unexpected shapes (n_in %d, out %d, ws %zu); nothing launched\n", n_in, out_size, ws_size); grid = -1; return; }
        int dev = 0, cus = 0, per_cu = 0;
        if (hipGetDevice(&dev) != hipSuccess || hipDeviceGetAttribute(&cus, hipDeviceAttributeMultiprocessorCount, dev) != hipSuccess) { grid = -1; return; }
        if (hipFuncSetAttribute((const void*)mega_fwd, hipFuncAttributeMaxDynamicSharedMemorySize, LDS_BYTES) != hipSuccess) { fprintf(stderr, "kernel_launch: hipFuncSetAttribute failed\n"); grid = -1; return; }
        if (hipOccupancyMaxActiveBlocksPerMultiprocessor(&per_cu, (const void*)mega_fwd, NWAVES * 64, LDS_BYTES) != hipSuccess || per_cu < 1) { fprintf(stderr, "kernel_launch: occupancy query says %d\n", per_cu); per_cu = 1; }
        (void)hipGetLastError();
        grid = cus;
    }
    if (grid < 0) return;
    (void)hipMemsetAsync((char*)d_ws + WS_CTL, 0, CTL_ZERO_BYTES, stream);
    Args a{};
    for (int i = 0; i < N_IN; ++i) a.in[i] = (const float*)d_in[i];
    a.out = (float*)d_out; a.ws = (unsigned char*)d_ws;
#if MK_N_LAUNCHES == 1
    a.ph_lo = 0; a.ph_hi = N_PHASES;
    { void* kargs[] = {(void*)&a};
      const hipError_t e = hipLaunchCooperativeKernel((const void*)mega_fwd, dim3(grid), dim3(NWAVES * 64), kargs, LDS_BYTES, stream);
      if (e != hipSuccess) fprintf(stderr, "kernel_launch: cooperative launch failed: %s (grid %d)\n", hipGetErrorString(e), grid); }
#else
    for (int p = 0; p < N_PHASES; ++p) { a.ph_lo = p; a.ph_hi = p + 1; hipLaunchKernelGGL(mega_fwd, dim3(grid), dim3(NWAVES * 64), LDS_BYTES, stream, a); }
#endif
}
```
